# Optimizing an MI355X kernel written in HIP

```python
import math
import jax
import jax.numpy as jnp
from jax import lax
import numpy as np

D_MODEL = 1024
BATCH = 4
SEQ = 4096
DEPTH = 2

CTX_LEN = 256
GRID_W = 64

LRU_WIDTH = 384
LRU_BLOCKS = 6
LRU_BLOCK = LRU_WIDTH // LRU_BLOCKS
LRU_CONV = 4
LRU_C = 8.0
HY_WIDTH = 256
HY_ORDER = 2
HY_SHORT = 3
HY_BANDS = 16
HY_EMB = 2 * HY_BANDS + 1
HY_FILT_HID = 64
HY_MAX_DECAY = math.log(1e-2) / 0.3
HY_MIN_DECAY = math.log(1e-2) / 1.5
NA_HEADS = 6
NA_HEAD_DIM = 64
NA_WIDTH = NA_HEADS * NA_HEAD_DIM
NA_WIN_R = 8
NA_WIN_C = 16
S5_WIDTH = 256
S5_GROUP = 16
S5_GROUPS = S5_WIDTH // S5_GROUP
S5_STATE = 64
N_BRANCH = 4
OFF_A = 0
OFF_B = OFF_A + 2 * LRU_WIDTH
OFF_C = OFF_B + 3 * HY_WIDTH
OFF_D = OFF_C + 3 * NA_WIDTH
OFF_G = OFF_D + S5_WIDTH
IN_COLS = OFF_G + N_BRANCH * D_MODEL
FF_DENSE = 2816
N_EXPERTS = 8
TOP_K = 2
FF_EXPERT = 3584
LN_EPS = 1e-5
F32 = jnp.float32

kernel_name = 'hybrid_gated_mixers_diffusion_block'


def layer_norm(x, g=None, b=None):
    xf = x.astype(F32)
    mu = jnp.mean(xf, axis=-1, keepdims=True)
    var = jnp.mean(jnp.square(xf - mu), axis=-1, keepdims=True)
    y = (xf - mu) * lax.rsqrt(var + LN_EPS)
    if g is not None:
        y = y * g.astype(F32) + b.astype(F32)
    return y.astype(x.dtype)


def modulate(x, shift, scale):
    return layer_norm(x) * (1.0 + scale) + shift


def dw_conv(x, w, b):
    k_w = w.shape[0]
    left = k_w // 2
    L = x.shape[1]
    xp = jnp.pad(x, ((0, 0), (left, k_w - 1 - left), (0, 0)))
    y = xp[:, 0:L] * w[0]
    for k in range(1, k_w):
        y = y + xp[:, k:k + L] * w[k]
    return y + b


def linear_scan(a, b, h0, reverse):
    def combine(e1, e2):
        a1, b1 = e1
        a2, b2 = e2
        return a1 * a2, a2 * b1 + b2
    a_cum, b_cum = lax.associative_scan(combine, (a, b), reverse=reverse, axis=0)
    return b_cum + a_cum * h0


def complex_scan(a_re, a_im, b_re, b_im, h0_re, h0_im, reverse):
    def combine(e1, e2):
        ar1, ai1, br1, bi1 = e1
        ar2, ai2, br2, bi2 = e2
        return (ar1 * ar2 - ai1 * ai2, ar1 * ai2 + ai1 * ar2,
                ar2 * br1 - ai2 * bi1 + br2, ar2 * bi1 + ai2 * br1 + bi2)
    ar, ai, br, bi = lax.associative_scan(combine, (a_re, a_im, b_re, b_im), reverse=reverse, axis=0)
    return br + ar * h0_re - ai * h0_im, bi + ar * h0_im + ai * h0_re


def rglru_scan(xc, w_r, b_r, w_i, b_i, lam, h0, reverse):
    bsz, L, _ = xc.shape
    xb = xc.reshape(bsz, L, LRU_BLOCKS, LRU_BLOCK)
    gate_r = jax.nn.sigmoid(jnp.einsum('blgi,gij->blgj', xb, w_r.astype(F32)).reshape(bsz, L, LRU_WIDTH) + b_r)
    gate_i = jax.nn.sigmoid(jnp.einsum('blgi,gij->blgj', xb, w_i.astype(F32)).reshape(bsz, L, LRU_WIDTH) + b_i)
    log_a = -LRU_C * gate_r * jax.nn.softplus(-lam.astype(F32))
    a = jnp.exp(log_a)
    b = jnp.sqrt(-jnp.expm1(2.0 * log_a)) * gate_i * xc
    h = linear_scan(jnp.swapaxes(a, 0, 1), jnp.swapaxes(b, 0, 1), h0, reverse)
    return jnp.swapaxes(h, 0, 1)


def rglru_mixer(pa_c, pa_l, lp, with_ctx):
    def conv_in(pa):
        return dw_conv(pa[..., LRU_WIDTH:], lp['lru_conv_w'], lp['lru_conv_b']).astype(F32)

    def run(xc, d, h0, reverse):
        return rglru_scan(xc, lp['lru_w_r'][d], lp['lru_b_r'][d], lp['lru_w_i'][d], lp['lru_b_i'][d],
                          lp['lru_lambda'][d], h0, reverse)

    xc_c, xc_l = conv_in(pa_c), conv_in(pa_l)
    hc_f = run(xc_c, 0, 0.0, False)
    hc_b = run(xc_c, 1, 0.0, True)
    hl_f = run(xc_l, 0, hc_f[:, -1], False)
    hl_b = run(xc_l, 1, hc_b[:, 0], True)
    y_l = (jax.nn.gelu(pa_l[..., :LRU_WIDTH].astype(F32)) * (hl_f + hl_b)).astype(pa_l.dtype)
    y_c = None
    if with_ctx:
        y_c = (jax.nn.gelu(pa_c[..., :LRU_WIDTH].astype(F32)) * (hc_f + hc_b)).astype(pa_c.dtype)
    return y_c, y_l


def hyena_filters(L, w1, b1, w2, b2, w3, b3, freq):
    t = jnp.arange(L, dtype=F32)
    t_norm = t / L
    bands = jnp.arange(1, HY_BANDS + 1, dtype=F32)
    ang = (2.0 * math.pi / L) * t[:, None] * bands[None, :]
    feat = jnp.concatenate([t_norm[:, None], jnp.cos(ang), jnp.sin(ang)], axis=-1)
    h = jnp.sin(freq * (feat @ w1 + b1))
    h = jnp.sin(freq * (h @ w2 + b2))
    h = (h @ w3 + b3).reshape(L, 2, HY_ORDER, HY_WIDTH)
    deltas = jnp.abs(jnp.linspace(HY_MIN_DECAY, HY_MAX_DECAY, HY_WIDTH, dtype=F32))
    window = jnp.exp(-t_norm[:, None] * deltas[None, :])
    return h * window[:, None, None, :]


def bidir_kernel(h_f, h_b):
    k = jnp.concatenate([h_f, jnp.zeros_like(h_f[:1]), h_b[:0:-1]], axis=0)
    return k / (jnp.sum(jnp.abs(k), axis=0, keepdims=True) + 1e-6)


def long_conv(z, k, bias):
    L = z.shape[1]
    kf = jnp.fft.rfft(k, axis=0)
    zf = jnp.fft.rfft(z, n=2 * L, axis=1)
    y = jnp.fft.irfft(zf * kf[None], n=2 * L, axis=1)[:, :L]
    return y + z * bias


def hyena_sequence(pb, lp):
    L = pb.shape[1]
    z = dw_conv(pb, lp['hy_conv_w'], lp['hy_conv_b']).astype(F32)
    v, x1, x2 = jnp.split(z, 3, axis=-1)
    h = hyena_filters(L, lp['hy_w1'], lp['hy_b1'], lp['hy_w2'], lp['hy_b2'], lp['hy_w3'], lp['hy_b3'], lp['hy_freq'])
    y = v
    for o, gate in enumerate((x1, x2)):
        y = gate * long_conv(y, bidir_kernel(h[:, 0, o], h[:, 1, o]), lp['hy_bias'][o])
    return y.astype(pb.dtype)


def natten_mixer(pc_c, pc_l, rpb, with_ctx):
    bsz, L, _ = pc_l.shape
    rows = L // GRID_W
    kr = min(NA_WIN_R, rows)
    nw = kr * NA_WIN_C
    scale = NA_HEAD_DIM ** -0.5

    def split_heads(p):
        return [p[..., i * NA_WIDTH:(i + 1) * NA_WIDTH].reshape(p.shape[0], p.shape[1], NA_HEADS, NA_HEAD_DIM)
                for i in range(3)]

    q_l, k_l, v_l = split_heads(pc_l)
    q_c, k_c, v_c = split_heads(pc_c)
    kg = k_l.reshape(bsz, rows, GRID_W, NA_HEADS, NA_HEAD_DIM)
    vg = v_l.reshape(bsz, rows, GRID_W, NA_HEADS, NA_HEAD_DIM)
    qg = jnp.moveaxis((q_l * scale).reshape(bsz, rows, GRID_W, NA_HEADS, NA_HEAD_DIM), 1, 0)
    row_ids = jnp.arange(rows)
    row_start = jnp.clip(row_ids - kr // 2, 0, rows - kr)
    cols = jnp.arange(GRID_W)
    col_idx = jnp.clip(cols - NA_WIN_C // 2, 0, GRID_W - NA_WIN_C)[:, None] + jnp.arange(NA_WIN_C)[None, :]
    dc_idx = col_idx - cols[:, None] + (NA_WIN_C - 1)

    def row_block(args):
        q_r, r, rs = args
        k_win = lax.dynamic_slice_in_dim(kg, rs, kr, axis=1)[:, :, col_idx]
        v_win = lax.dynamic_slice_in_dim(vg, rs, kr, axis=1)[:, :, col_idx]
        dr_idx = rs + jnp.arange(kr) - r + (NA_WIN_R - 1)
        bias = rpb[:, dr_idx[:, None, None], dc_idx[None, :, :]]
        s_win = jnp.einsum('bwhd,biwjhd->bhwij', q_r, k_win) + jnp.transpose(bias, (0, 2, 1, 3))[None]
        s_ctx = jnp.einsum('bwhd,bnhd->bhwn', q_r, k_c)
        s = jnp.concatenate([s_win.reshape(bsz, NA_HEADS, GRID_W, nw), s_ctx], axis=-1)
        pr = jax.nn.softmax(s.astype(F32), axis=-1).astype(v_l.dtype)
        p_win = pr[..., :nw].reshape(bsz, NA_HEADS, GRID_W, kr, NA_WIN_C)
        return (jnp.einsum('bhwij,biwjhd->bwhd', p_win, v_win)
                + jnp.einsum('bhwn,bnhd->bwhd', pr[..., nw:], v_c))

    o_l = lax.map(row_block, (qg, row_ids, row_start))
    y_l = jnp.moveaxis(o_l, 0, 1).reshape(bsz, L, NA_WIDTH)
    y_c = None
    if with_ctx:
        s = jnp.einsum('bqhd,bkhd->bhqk', q_c * scale, k_c)
        pr = jax.nn.softmax(s.astype(F32), axis=-1).astype(v_c.dtype)
        y_c = jnp.einsum('bhqk,bkhd->bqhd', pr, v_c).reshape(bsz, q_c.shape[1], NA_WIDTH)
    return y_c, y_l


def s5_discretise(a_re, a_im, log_dt, b_re, b_im):
    a_re, a_im = a_re.astype(F32), a_im.astype(F32)
    dt = jnp.exp(log_dt.astype(F32))[:, None]
    mag = jnp.exp(dt * a_re)
    ab_re = mag * jnp.cos(dt * a_im)
    ab_im = mag * jnp.sin(dt * a_im)
    den = jnp.square(a_re) + jnp.square(a_im)
    f_re = ((ab_re - 1.0) * a_re + ab_im * a_im) / den
    f_im = (ab_im * a_re - (ab_re - 1.0) * a_im) / den
    b_re, b_im = b_re.astype(F32), b_im.astype(F32)
    bb_re = f_re[..., None] * b_re - f_im[..., None] * b_im
    bb_im = f_re[..., None] * b_im + f_im[..., None] * b_re
    return ab_re, ab_im, bb_re, bb_im


def s5_states(u, disc, h0_re, h0_im, reverse):
    ab_re, ab_im, bb_re, bb_im = disc
    L = u.shape[1]
    bu_re = jnp.einsum('blgi,gpi->lbgp', u, bb_re)
    bu_im = jnp.einsum('blgi,gpi->lbgp', u, bb_im)
    a_re = jnp.broadcast_to(ab_re[None, None], (L, 1) + ab_re.shape)
    a_im = jnp.broadcast_to(ab_im[None, None], (L, 1) + ab_im.shape)
    return complex_scan(a_re, a_im, bu_re, bu_im, h0_re, h0_im, reverse)


def s5_readout(h_re, h_im, c_re, c_im):
    return (jnp.einsum('lbgp,gop->blgo', h_re, c_re.astype(F32))
            - jnp.einsum('lbgp,gop->blgo', h_im, c_im.astype(F32)))


def s5_mixer(pd_c, pd_l, lp, with_ctx):
    def groups(pd):
        return pd.astype(F32).reshape(pd.shape[0], pd.shape[1], S5_GROUPS, S5_GROUP)

    discs = [s5_discretise(lp['s5_a_re'][d], lp['s5_a_im'][d], lp['s5_log_dt'][d],
                           lp['s5_b_re'][d], lp['s5_b_im'][d]) for d in range(2)]
    u_c, u_l = groups(pd_c), groups(pd_l)
    hc_f = s5_states(u_c, discs[0], 0.0, 0.0, False)
    hc_b = s5_states(u_c, discs[1], 0.0, 0.0, True)
    hl_f = s5_states(u_l, discs[0], hc_f[0][-1], hc_f[1][-1], False)
    hl_b = s5_states(u_l, discs[1], hc_b[0][0], hc_b[1][0], True)

    def out(h_f, h_b, pd):
        y = (s5_readout(h_f[0], h_f[1], lp['s5_c_re'][0], lp['s5_c_im'][0])
             + s5_readout(h_b[0], h_b[1], lp['s5_c_re'][1], lp['s5_c_im'][1]))
        y = y.reshape(pd.shape) + lp['s5_d'] * pd.astype(F32)
        g = jax.nn.gelu(y)
        return (g * jax.nn.sigmoid(g @ lp['s5_w_glu'].astype(F32) + lp['s5_b_glu'])).astype(pd.dtype)

    y_l = out(hl_f, hl_b, pd_l)
    y_c = out(hc_f, hc_b, pd_c) if with_ctx else None
    return y_c, y_l


def merge_branches(pg, ys, lp):
    gates = jax.nn.sigmoid(pg.astype(F32)).reshape(pg.shape[:-1] + (N_BRANCH, D_MODEL)).astype(pg.dtype)
    projs = (lp['w_br_a'], lp['w_br_b'], lp['w_br_c'], lp['w_br_d'])
    merged = gates[..., 0, :] * (ys[0] @ projs[0])
    for i in range(1, N_BRANCH):
        merged = merged + gates[..., i, :] * (ys[i] @ projs[i])
    return merged @ lp['w_out']


def token_mixer(u_c, u_l, lp, with_ctx):
    p_l = u_l @ lp['w_in']
    p_c = u_c @ (lp['w_in'] if with_ctx else lp['w_in'][:, :OFF_G])
    ya_c, ya_l = rglru_mixer(p_c[..., OFF_A:OFF_B], p_l[..., OFF_A:OFF_B], lp, with_ctx)
    yb_l = hyena_sequence(p_l[..., OFF_B:OFF_C], lp)
    yc_c, yc_l = natten_mixer(p_c[..., OFF_C:OFF_D], p_l[..., OFF_C:OFF_D], lp['na_rpb'], with_ctx)
    yd_c, yd_l = s5_mixer(p_c[..., OFF_D:OFF_G], p_l[..., OFF_D:OFF_G], lp, with_ctx)
    m_l = merge_branches(p_l[..., OFF_G:], (ya_l, yb_l, yc_l, yd_l), lp)
    if not with_ctx:
        return None, m_l
    yb_c = hyena_sequence(p_c[..., OFF_B:OFF_C], lp)
    m_c = merge_branches(p_c[..., OFF_G:], (ya_c, yb_c, yc_c, yd_c), lp)
    return m_c, m_l


def swiglu(u, w_gate, w_up, w_down):
    return (jax.nn.silu(u @ w_gate) * (u @ w_up)) @ w_down


def moe_swiglu(u, w_router, w_gate, w_up, w_down):
    logits = (u @ w_router).astype(F32)
    top_v, top_i = lax.top_k(logits, TOP_K)
    weights = jax.nn.softmax(top_v, axis=-1)
    gate = jnp.sum(jax.nn.one_hot(top_i, N_EXPERTS, dtype=F32) * weights[..., None], axis=-2).astype(u.dtype)
    out = gate[..., 0:1] * swiglu(u, w_gate[0], w_up[0], w_down[0])
    for e in range(1, N_EXPERTS):
        out = out + gate[..., e:e + 1] * swiglu(u, w_gate[e], w_up[e], w_down[e])
    return out


def setup_inputs(seed: int = 0) -> dict:
    key = jax.random.key(seed)
    keys = iter(jax.random.split(key, 64))

    def nrm(shape, std):
        return std * jax.random.normal(next(keys), shape, jnp.float32)

    D = D_MODEL
    beta = (8.0 * DEPTH) ** -0.25
    n_dense = (DEPTH + 1) // 2
    n_moe = DEPTH // 2
    a_target = jax.random.uniform(next(keys), (DEPTH, 2, LRU_WIDTH), jnp.float32, 0.9, 0.999)
    s_root = a_target ** (1.0 / LRU_C)
    state_n = jnp.arange(S5_STATE, dtype=jnp.float32)
    return {
        'x': nrm((BATCH, SEQ, D), 1.0),
        'c': nrm((BATCH, D), 1.0),
        'ctx': nrm((BATCH, CTX_LEN, D), 1.0),
        'c_ctx': nrm((D,), 1.0),
        'w_mod': nrm((DEPTH, D, 6 * D), 0.5 * D ** -0.5),
        'b_mod': nrm((DEPTH, 6 * D), 0.01),
        'w_in': nrm((DEPTH, D, IN_COLS), D ** -0.5),
        'lru_conv_w': nrm((DEPTH, LRU_CONV, LRU_WIDTH), LRU_CONV ** -0.5),
        'lru_conv_b': nrm((DEPTH, LRU_WIDTH), 0.01),
        'lru_w_r': nrm((DEPTH, 2, LRU_BLOCKS, LRU_BLOCK, LRU_BLOCK), LRU_BLOCK ** -0.5),
        'lru_b_r': nrm((DEPTH, 2, LRU_WIDTH), 0.01),
        'lru_w_i': nrm((DEPTH, 2, LRU_BLOCKS, LRU_BLOCK, LRU_BLOCK), LRU_BLOCK ** -0.5),
        'lru_b_i': nrm((DEPTH, 2, LRU_WIDTH), 0.01),
        'lru_lambda': jnp.log(s_root) - jnp.log1p(-s_root),
        'hy_conv_w': nrm((DEPTH, HY_SHORT, 3 * HY_WIDTH), HY_SHORT ** -0.5),
        'hy_conv_b': nrm((DEPTH, 3 * HY_WIDTH), 0.01),
        'hy_w1': nrm((DEPTH, HY_EMB, HY_FILT_HID), HY_EMB ** -0.5),
        'hy_b1': nrm((DEPTH, HY_FILT_HID), 0.1),
        'hy_w2': nrm((DEPTH, HY_FILT_HID, HY_FILT_HID), HY_FILT_HID ** -0.5),
        'hy_b2': nrm((DEPTH, HY_FILT_HID), 0.1),
        'hy_w3': nrm((DEPTH, HY_FILT_HID, 2 * HY_ORDER * HY_WIDTH), HY_FILT_HID ** -0.5),
        'hy_b3': nrm((DEPTH, 2 * HY_ORDER * HY_WIDTH), 0.01),
        'hy_freq': 1.0 + nrm((DEPTH, HY_FILT_HID), 0.01),
        'hy_bias': nrm((DEPTH, HY_ORDER, HY_WIDTH), 0.5),
        'na_rpb': nrm((DEPTH, NA_HEADS, 2 * NA_WIN_R - 1, 2 * NA_WIN_C - 1), 0.1),
        's5_a_re': -0.5 + nrm((DEPTH, 2, S5_GROUPS, S5_STATE), 0.01),
        's5_a_im': math.pi * state_n + nrm((DEPTH, 2, S5_GROUPS, S5_STATE), 0.01),
        's5_log_dt': jax.random.uniform(next(keys), (DEPTH, 2, S5_GROUPS), jnp.float32, math.log(1e-3), math.log(1e-1)),
        's5_b_re': nrm((DEPTH, 2, S5_GROUPS, S5_STATE, S5_GROUP), (2 * S5_GROUP) ** -0.5),
        's5_b_im': nrm((DEPTH, 2, S5_GROUPS, S5_STATE, S5_GROUP), (2 * S5_GROUP) ** -0.5),
        's5_c_re': nrm((DEPTH, 2, S5_GROUPS, S5_GROUP, S5_STATE), (2 * S5_STATE) ** -0.5),
        's5_c_im': nrm((DEPTH, 2, S5_GROUPS, S5_GROUP, S5_STATE), (2 * S5_STATE) ** -0.5),
        's5_d': nrm((DEPTH, S5_WIDTH), 1.0),
        's5_w_glu': nrm((DEPTH, S5_WIDTH, S5_WIDTH), S5_WIDTH ** -0.5),
        's5_b_glu': nrm((DEPTH, S5_WIDTH), 0.01),
        'w_br_a': nrm((DEPTH, LRU_WIDTH, D), beta * LRU_WIDTH ** -0.5),
        'w_br_b': nrm((DEPTH, HY_WIDTH, D), beta * HY_WIDTH ** -0.5),
        'w_br_c': nrm((DEPTH, NA_WIDTH, D), beta * NA_WIDTH ** -0.5),
        'w_br_d': nrm((DEPTH, S5_WIDTH, D), beta * S5_WIDTH ** -0.5),
        'w_out': nrm((DEPTH, D, D), beta * D ** -0.5),
        'ln1_g': 1.0 + nrm((DEPTH, D), 0.01),
        'ln1_b': nrm((DEPTH, D), 0.01),
        'ln2_g': 1.0 + nrm((DEPTH, D), 0.01),
        'ln2_b': nrm((DEPTH, D), 0.01),
        'ff_w_gate': nrm((n_dense, D, FF_DENSE), D ** -0.5),
        'ff_w_up': nrm((n_dense, D, FF_DENSE), D ** -0.5),
        'ff_w_down': nrm((n_dense, FF_DENSE, D), beta * FF_DENSE ** -0.5),
        'moe_router': nrm((n_moe, D, N_EXPERTS), D ** -0.5),
        'moe_w_gate': nrm((n_moe, N_EXPERTS, D, FF_EXPERT), D ** -0.5),
        'moe_w_up': nrm((n_moe, N_EXPERTS, D, FF_EXPERT), D ** -0.5),
        'moe_w_down': nrm((n_moe, N_EXPERTS, FF_EXPERT, D), beta * FF_EXPERT ** -0.5),
    }


def reference(x, c, ctx, c_ctx, w_mod, b_mod, w_in, lru_conv_w, lru_conv_b, lru_w_r, lru_b_r, lru_w_i, lru_b_i,
              lru_lambda, hy_conv_w, hy_conv_b, hy_w1, hy_b1, hy_w2, hy_b2, hy_w3, hy_b3, hy_freq, hy_bias, na_rpb,
              s5_a_re, s5_a_im, s5_log_dt, s5_b_re, s5_b_im, s5_c_re, s5_c_im, s5_d, s5_w_glu, s5_b_glu,
              w_br_a, w_br_b, w_br_c, w_br_d, w_out, ln1_g, ln1_b, ln2_g, ln2_b,
              ff_w_gate, ff_w_up, ff_w_down, moe_router, moe_w_gate, moe_w_up, moe_w_down):
    alpha = (2.0 * DEPTH) ** 0.25
    for l in range(DEPTH):
        with_ctx = l < DEPTH - 1
        lp = {
            'w_in': w_in[l], 'lru_conv_w': lru_conv_w[l], 'lru_conv_b': lru_conv_b[l],
            'lru_w_r': lru_w_r[l], 'lru_b_r': lru_b_r[l], 'lru_w_i': lru_w_i[l], 'lru_b_i': lru_b_i[l],
            'lru_lambda': lru_lambda[l], 'hy_conv_w': hy_conv_w[l], 'hy_conv_b': hy_conv_b[l],
            'hy_w1': hy_w1[l], 'hy_b1': hy_b1[l], 'hy_w2': hy_w2[l], 'hy_b2': hy_b2[l], 'hy_w3': hy_w3[l],
            'hy_b3': hy_b3[l], 'hy_freq': hy_freq[l], 'hy_bias': hy_bias[l], 'na_rpb': na_rpb[l],
            's5_a_re': s5_a_re[l], 's5_a_im': s5_a_im[l], 's5_log_dt': s5_log_dt[l], 's5_b_re': s5_b_re[l],
            's5_b_im': s5_b_im[l], 's5_c_re': s5_c_re[l], 's5_c_im': s5_c_im[l], 's5_d': s5_d[l],
            's5_w_glu': s5_w_glu[l], 's5_b_glu': s5_b_glu[l], 'w_br_a': w_br_a[l], 'w_br_b': w_br_b[l],
            'w_br_c': w_br_c[l], 'w_br_d': w_br_d[l], 'w_out': w_out[l],
        }
        mod_l = (jax.nn.silu(c) @ w_mod[l] + b_mod[l])[:, None, :]
        mod_c = jax.nn.silu(c_ctx) @ w_mod[l] + b_mod[l]
        sh1, sc1, g1, sh2, sc2, g2 = jnp.split(mod_l, 6, axis=-1)
        csh1, csc1, cg1, csh2, csc2, cg2 = jnp.split(mod_c, 6, axis=-1)
        m_c, m_l = token_mixer(modulate(ctx, csh1, csc1), modulate(x, sh1, sc1), lp, with_ctx)
        x = layer_norm(alpha * x + g1 * m_l, ln1_g[l], ln1_b[l])
        if with_ctx:
            ctx = layer_norm(alpha * ctx + cg1 * m_c, ln1_g[l], ln1_b[l])

        def ffn(u):
            if l % 2 == 0:
                return swiglu(u, ff_w_gate[l // 2], ff_w_up[l // 2], ff_w_down[l // 2])
            return moe_swiglu(u, moe_router[l // 2], moe_w_gate[l // 2], moe_w_up[l // 2], moe_w_down[l // 2])

        x = layer_norm(alpha * x + g2 * ffn(modulate(x, sh2, sc2)), ln2_g[l], ln2_b[l])
        if with_ctx:
            ctx = layer_norm(alpha * ctx + cg2 * ffn(modulate(ctx, csh2, csc2)), ln2_g[l], ln2_b[l])
    return x
```

```cpp
#include <hip/hip_runtime.h>
#include <stdint.h>
#include <math.h>

namespace {
constexpr int D = 1024, NB = 4, SEQ = 4096, CTXL = 256;
constexpr int RL = NB * SEQ, RC = NB * CTXL, RT = RL + RC;
constexpr int OFF_A = 0, OFF_B = 768, OFF_C = 1536, OFF_D = 2688, OFF_G = 2944, IN_COLS = 7040;
constexpr int PM = OFF_G;
constexpr int FF_DENSE = 2816, NE = 8, FF_E = 3584;
constexpr int YW = 1280;
constexpr float ALPHA = 1.41421356237309515f;

__device__ __forceinline__ float sigm(float x) { return 1.f / (1.f + expf(-x)); }
__device__ __forceinline__ float silu(float x) { return x / (1.f + expf(-x)); }
__device__ __forceinline__ float gelu_t(float x) { return 0.5f * x * (1.f + tanhf(0.7978845608028654f * (x + 0.044715f * x * x * x))); }
__device__ __forceinline__ float softplus(float x) { return fmaxf(x, 0.f) + log1pf(expf(-fabsf(x))); }
__device__ __forceinline__ float wave_sum(float v) { for (int o = 32; o; o >>= 1) v += __shfl_xor(v, o); return v; }
__device__ __forceinline__ float wave_max(float v) { for (int o = 32; o; o >>= 1) v = fmaxf(v, __shfl_xor(v, o)); return v; }
__device__ __forceinline__ float block_sum256(float v, float* sh) {
    v = wave_sum(v);
    if ((threadIdx.x & 63) == 0) sh[threadIdx.x >> 6] = v;
    __syncthreads();
    const float r = (sh[0] + sh[1]) + (sh[2] + sh[3]);
    __syncthreads();
    return r;
}
__device__ __forceinline__ void row_seq(int r, int& start, int& len, int& pos, int& b) {
    if (r < RL) { b = r >> 12; start = b << 12; len = SEQ; pos = r & 4095; }
    else { const int q = r - RL; b = q >> 8; start = RL + (b << 8); len = CTXL; pos = q & 255; }
}

__global__ void k_mod(const float* c, const float* c_ctx, const float* w_mod, const float* b_mod, float* MOD) {
    __shared__ float s[5][1024];
    const int l = blockIdx.y, n = blockIdx.x * 256 + threadIdx.x;
    for (int i = threadIdx.x; i < 5 * 1024; i += 256) { const int r = i >> 10, k = i & 1023; s[r][k] = silu(r < 4 ? c[r * 1024 + k] : c_ctx[k]); }
    __syncthreads();
    float a0 = 0, a1 = 0, a2 = 0, a3 = 0, a4 = 0;
    const float* w = w_mod + (size_t)l * 1024 * 6144 + n;
    for (int k = 0; k < 1024; ++k) { const float wv = w[(size_t)k * 6144]; a0 += s[0][k] * wv; a1 += s[1][k] * wv; a2 += s[2][k] * wv; a3 += s[3][k] * wv; a4 += s[4][k] * wv; }
    const float bb = b_mod[l * 6144 + n];
    float* o = MOD + (size_t)l * 5 * 6144 + n;
    o[0] = a0 + bb; o[6144] = a1 + bb; o[2 * 6144] = a2 + bb; o[3 * 6144] = a3 + bb; o[4 * 6144] = a4 + bb;
}
__global__ void k_hy_filt(int L, const float* w1, const float* b1, const float* w2, const float* b2, const float* w3, const float* b3, const float* freq, float* HF) {
    __shared__ float feat[33], h1[64], h2[64];
    const int t = blockIdx.x, tid = threadIdx.x;
    const float tn = (float)t / (float)L;
    if (tid < 33) {
        if (tid == 0) feat[0] = tn;
        else { const int band = (tid - 1) % 16 + 1; const int m = (int)(((long)t * band) % L); const double ang = 2.0 * M_PI * (double)m / (double)L;
            feat[tid] = tid <= 16 ? (float)cos(ang) : (float)sin(ang); }
    }
    __syncthreads();
    if (tid < 64) { float a = b1[tid]; for (int i = 0; i < 33; ++i) a += feat[i] * w1[i * 64 + tid]; h1[tid] = sinf(freq[tid] * a); }
    __syncthreads();
    if (tid < 64) { float a = b2[tid]; for (int i = 0; i < 64; ++i) a += h1[i] * w2[i * 64 + tid]; h2[tid] = sinf(freq[tid] * a); }
    __syncthreads();
    const float dmin = 3.0701134573253945f, dmax = 15.350567286626973f;
    for (int n = tid; n < 1024; n += 256) {
        float a = b3[n]; for (int i = 0; i < 64; ++i) a += h2[i] * w3[i * 1024 + n];
        const int ch = n & 255; const float delta = dmin + (dmax - dmin) * (float)ch / 255.0f;
        HF[(size_t)t * 1024 + n] = a * expf(-tn * delta);
    }
}
__global__ void k_hy_norm(int L, const float* HF, float* NORM) {
    __shared__ float sh[4];
    const int o = blockIdx.x >> 8, ch = blockIdx.x & 255;
    float s = 0.f;
    for (int t = threadIdx.x; t < L; t += 256) { s += fabsf(HF[(size_t)t * 1024 + o * 256 + ch]); if (t >= 1) s += fabsf(HF[(size_t)t * 1024 + 512 + o * 256 + ch]); }
    s = block_sum256(s, sh);
    if (threadIdx.x == 0) NORM[blockIdx.x] = s + 1e-6f;
}
__global__ void k_s5_disc(const float* a_re, const float* a_im, const float* log_dt, const float* b_re, const float* b_im, float* AB, float* BB) {
    const int i = blockIdx.x * blockDim.x + threadIdx.x; if (i >= 2048) return;
    const int d = i >> 10, g = (i >> 6) & 15;
    const double ar = a_re[i], ai = a_im[i], dt = exp((double)log_dt[d * 16 + g]);
    const double mag = exp(dt * ar), abr = mag * cos(dt * ai), abi = mag * sin(dt * ai), den = ar * ar + ai * ai;
    const double fr = ((abr - 1.0) * ar + abi * ai) / den, fi = (abi * ar - (abr - 1.0) * ai) / den;
    AB[i * 2] = (float)abr; AB[i * 2 + 1] = (float)abi;
    for (int k = 0; k < 16; ++k) { const double br = b_re[i * 16 + k], bi = b_im[i * 16 + k]; BB[(i * 16 + k) * 2] = (float)(fr * br - fi * bi); BB[(i * 16 + k) * 2 + 1] = (float)(fr * bi + fi * br); }
}

__global__ void k_lnmod(const float* X, const float* MODL, int sh_off, float* U) {
    __shared__ float sh[4];
    const int r = blockIdx.x, mr = r < RL ? (r >> 12) : 4;
    const float4 v = *(const float4*)(X + (size_t)r * D + threadIdx.x * 4);
    const float mu = block_sum256((v.x + v.y) + (v.z + v.w), sh) * (1.f / D);
    const float dx = v.x - mu, dy = v.y - mu, dz = v.z - mu, dw = v.w - mu;
    const float var = block_sum256((dx * dx + dy * dy) + (dz * dz + dw * dw), sh) * (1.f / D);
    const float rs = rsqrtf(var + 1e-5f);
    const float4 s = *(const float4*)(MODL + (size_t)mr * 6144 + sh_off + threadIdx.x * 4);
    const float4 c = *(const float4*)(MODL + (size_t)mr * 6144 + sh_off + 1024 + threadIdx.x * 4);
    float4 o; o.x = dx * rs * (1.f + c.x) + s.x; o.y = dy * rs * (1.f + c.y) + s.y; o.z = dz * rs * (1.f + c.z) + s.z; o.w = dw * rs * (1.f + c.w) + s.w;
    *(float4*)(U + (size_t)r * D + threadIdx.x * 4) = o;
}
__global__ void k_resln(float* X, const float* M, const float* MODL, int g_off, const float* lg, const float* lb, float* OUT) {
    __shared__ float sh[4];
    const int r = blockIdx.x, mr = r < RL ? (r >> 12) : 4;
    const float4 x = *(const float4*)(X + (size_t)r * D + threadIdx.x * 4);
    const float4 m = *(const float4*)(M + (size_t)r * D + threadIdx.x * 4);
    const float4 g = *(const float4*)(MODL + (size_t)mr * 6144 + g_off + threadIdx.x * 4);
    const float vx = ALPHA * x.x + g.x * m.x, vy = ALPHA * x.y + g.y * m.y, vz = ALPHA * x.z + g.z * m.z, vw = ALPHA * x.w + g.w * m.w;
    const float mu = block_sum256((vx + vy) + (vz + vw), sh) * (1.f / D);
    const float dx = vx - mu, dy = vy - mu, dz = vz - mu, dw = vw - mu;
    const float var = block_sum256((dx * dx + dy * dy) + (dz * dz + dw * dw), sh) * (1.f / D);
    const float rs = rsqrtf(var + 1e-5f);
    const float4 a = *(const float4*)(lg + threadIdx.x * 4), b = *(const float4*)(lb + threadIdx.x * 4);
    float4 o; o.x = dx * rs * a.x + b.x; o.y = dy * rs * a.y + b.y; o.z = dz * rs * a.z + b.z; o.w = dw * rs * a.w + b.w;
    *(float4*)(X + (size_t)r * D + threadIdx.x * 4) = o;
    if (OUT && r < RL) *(float4*)(OUT + (size_t)r * D + threadIdx.x * 4) = o;
}

struct GemmArgs {
    const float* A; int lda; const int* arow;
    const float* B; int ldb;
    float* C; int ldc; const int* crow;
    int M; const int* Mptr; int N, K;
    int mode;
    const float* G; int ldg; int accum; const float* wt;
};
__global__ __launch_bounds__(256) void k_sgemm(GemmArgs g) {
    __shared__ float As[8][128 + 4];
    __shared__ float Bs[8][128 + 4];
    int M = g.M; if (g.Mptr) { const int mm = *g.Mptr; M = mm < M ? mm : M; }
    const int m0 = blockIdx.y * 128, n0 = blockIdx.x * 128;
    if (m0 >= M) return;
    const int tid = threadIdx.x, tx = tid & 15, ty = tid >> 4;
    const int arow_l = tid >> 1, akk = (tid & 1) * 4;
    const int bkr = tid >> 5, bnn = (tid & 31) * 4;
    const int am = m0 + arow_l;
    const float* ap = nullptr;
    if (am < M) ap = g.A + (size_t)(g.arow ? g.arow[am] : am) * g.lda + akk;
    const float* bp = g.B + (size_t)bkr * g.ldb + n0 + bnn;
    float acc[8][8];
#pragma unroll
    for (int i = 0; i < 8; ++i)
#pragma unroll
        for (int j = 0; j < 8; ++j) acc[i][j] = 0.f;
    for (int k0 = 0; k0 < g.K; k0 += 8) {
        float4 av = make_float4(0.f, 0.f, 0.f, 0.f);
        if (ap) av = *(const float4*)(ap + k0);
        const float4 bv = *(const float4*)(bp + (size_t)k0 * g.ldb);
        __syncthreads();
        As[akk + 0][arow_l] = av.x; As[akk + 1][arow_l] = av.y; As[akk + 2][arow_l] = av.z; As[akk + 3][arow_l] = av.w;
        *(float4*)&Bs[bkr][bnn] = bv;
        __syncthreads();
#pragma unroll
        for (int kk = 0; kk < 8; ++kk) {
            const float4 a0 = *(const float4*)&As[kk][ty * 4], a1 = *(const float4*)&As[kk][64 + ty * 4];
            const float4 b0 = *(const float4*)&Bs[kk][tx * 4], b1 = *(const float4*)&Bs[kk][64 + tx * 4];
            const float a[8] = {a0.x, a0.y, a0.z, a0.w, a1.x, a1.y, a1.z, a1.w};
            const float b[8] = {b0.x, b0.y, b0.z, b0.w, b1.x, b1.y, b1.z, b1.w};
#pragma unroll
            for (int i = 0; i < 8; ++i)
#pragma unroll
                for (int j = 0; j < 8; ++j) acc[i][j] += a[i] * b[j];
        }
    }
#pragma unroll
    for (int i = 0; i < 8; ++i) {
        const int m = m0 + (i < 4 ? ty * 4 + i : 64 + ty * 4 + (i - 4));
        if (m >= M) continue;
        float* cp = g.C + (size_t)(g.crow ? g.crow[m] : m) * g.ldc + n0;
#pragma unroll
        for (int h = 0; h < 2; ++h) {
            const int n = h * 64 + tx * 4;
            float4 v = make_float4(acc[i][h * 4 + 0], acc[i][h * 4 + 1], acc[i][h * 4 + 2], acc[i][h * 4 + 3]);
            if (g.mode == 1) { const float4 c = *(const float4*)(cp + n); v.x *= silu(c.x); v.y *= silu(c.y); v.z *= silu(c.z); v.w *= silu(c.w); }
            else if (g.mode == 2) { const float4 q = *(const float4*)(g.G + (size_t)m * g.ldg + n0 + n); v.x *= sigm(q.x); v.y *= sigm(q.y); v.z *= sigm(q.z); v.w *= sigm(q.w);
                if (g.accum) { const float4 c = *(const float4*)(cp + n); v.x += c.x; v.y += c.y; v.z += c.z; v.w += c.w; } }
            else if (g.mode == 3) { const float w = g.wt[m]; const float4 c = *(const float4*)(cp + n); v.x = c.x + w * v.x; v.y = c.y + w * v.y; v.z = c.z + w * v.z; v.w = c.w + w * v.w; }
            *(float4*)(cp + n) = v;
        }
    }
}

__global__ __launch_bounds__(64) void k_lru_scan(const float* P, const float* conv_w, const float* conv_b, const float* w_r, const float* b_r, const float* w_i, const float* b_i,
                                                  const float* lam, float* H  ) {
    __shared__ float xs[64];
    const int g = blockIdx.x, d = blockIdx.y, b = blockIdx.z, j = threadIdx.x, ch = g * 64 + j;
    float wr[64], wi[64];
#pragma unroll
    for (int i = 0; i < 64; ++i) { wr[i] = w_r[((size_t)(d * 6 + g) * 64 + i) * 64 + j]; wi[i] = w_i[((size_t)(d * 6 + g) * 64 + i) * 64 + j]; }
    const float br = b_r[d * 384 + ch], bi = b_i[d * 384 + ch], sp = softplus(-lam[d * 384 + ch]);
    const float cw0 = conv_w[0 * 384 + ch], cw1 = conv_w[1 * 384 + ch], cw2 = conv_w[2 * 384 + ch], cw3 = conv_w[3 * 384 + ch], cb = conv_b[ch];
    float h = 0.f;
    for (int seg = 0; seg < 2; ++seg) {
        const int start = seg == 0 ? RL + b * CTXL : b * SEQ, len = seg == 0 ? CTXL : SEQ;
        for (int s = 0; s < len; ++s) {
            const int pos = d == 0 ? s : len - 1 - s;
            const float* pr = P + (size_t)(start + pos) * PM + OFF_A + 384 + ch;
            float xc = cb + cw2 * pr[0];
            if (pos >= 2) xc += cw0 * pr[-2 * PM];
            if (pos >= 1) xc += cw1 * pr[-1 * PM];
            if (pos + 1 < len) xc += cw3 * pr[PM];
            __syncthreads();
            xs[j] = xc;
            __syncthreads();
            float sr = br, si = bi;
#pragma unroll
            for (int i = 0; i < 64; ++i) { const float x = xs[i]; sr += x * wr[i]; si += x * wi[i]; }
            const float la = -8.0f * sigm(sr) * sp;
            const float a = expf(la), bt = sqrtf(-expm1f(2.0f * la)) * sigm(si) * xc;
            h = a * h + bt;
            H[((size_t)d * RT + start + pos) * 384 + ch] = h;
        }
    }
}
__global__ void k_lru_out(const float* P, const float* H, float* Y) {
    const int i = blockIdx.x * 256 + threadIdx.x; if (i >= RT * 384) return;
    const int r = i / 384, ch = i % 384;
    Y[(size_t)r * YW + ch] = gelu_t(P[(size_t)r * PM + OFF_A + ch]) * (H[(size_t)r * 384 + ch] + H[((size_t)RT + r) * 384 + ch]);
}

__global__ void k_hy_conv(const float* P, const float* cw, const float* cb, float* ZT) {
    const int i = blockIdx.x * 256 + threadIdx.x; if (i >= RT * 768) return;
    const int r = i / 768, ch = i % 768;
    int start, len, pos, b; row_seq(r, start, len, pos, b);
    const float* pr = P + (size_t)r * PM + OFF_B + ch;
    float z = cb[ch] + cw[768 + ch] * pr[0];
    if (pos >= 1) z += cw[ch] * pr[-PM];
    if (pos + 1 < len) z += cw[2 * 768 + ch] * pr[PM];
    ZT[(size_t)ch * RT + r] = z;
}
__global__ __launch_bounds__(256) void k_hy_long(const float* ZIN  , const float* GATE  , const float* HFl, const float* HFc, const float* NORMl, const float* NORMc,
                                                  const float* hbias  , int order, float* OUTT, float* Yrow, int do_ctx) {
    extern __shared__ float lds[];
    const int ch = blockIdx.x, b = blockIdx.y, seg = blockIdx.z;
    if (seg == 1 && !do_ctx) return;
    const int L = seg == 0 ? SEQ : CTXL, start = seg == 0 ? b * SEQ : RL + b * CTXL;
    const float* HF = seg == 0 ? HFl : HFc;
    const float inv = 1.0f / (seg == 0 ? NORMl : NORMc)[order * 256 + ch];
    float* kk = lds;
    float* z = lds + 2 * L;
    for (int i = threadIdx.x; i < 2 * L; i += 256) { const int d = i - L; float v = 0.f;
        if (d >= 0) v = HF[(size_t)d * 1024 + order * 256 + ch]; else if (d > -L) v = HF[(size_t)(-d) * 1024 + 512 + order * 256 + ch];
        kk[i] = v; }
    for (int i = threadIdx.x; i < L; i += 256) z[i] = ZIN[(size_t)ch * RT + start + i];
    __syncthreads();
    const float bias = hbias[order * 256 + ch];
    for (int t0 = threadIdx.x; t0 < L; t0 += 256 * 4) {
        float a0 = 0, a1 = 0, a2 = 0, a3 = 0;
        const float* k0 = kk + L + t0;
        if (L >= 1024) {
            for (int s = 0; s < L; ++s) { const float zs = z[s]; a0 += k0[-s] * zs; a1 += k0[256 - s] * zs; a2 += k0[512 - s] * zs; a3 += k0[768 - s] * zs; }
        } else {
            for (int s = 0; s < L; ++s) a0 += k0[-s] * z[s];
        }
        const float acc[4] = {a0, a1, a2, a3};
#pragma unroll
        for (int q = 0; q < 4; ++q) { const int t = t0 + q * 256; if (t >= L || (L < 1024 && q > 0)) break;
            const float o = GATE[(size_t)ch * RT + start + t] * (acc[q] * inv + bias * z[t]);
            if (OUTT) OUTT[(size_t)ch * RT + start + t] = o; else Yrow[(size_t)(start + t) * YW + 384 + ch] = o; }
    }
}

__global__ __launch_bounds__(64) void k_na(const float* P, const float* rpb, float* Y, int row0) {
    __shared__ float qs[64], ps[384]; __shared__ int kr[384];
    const int r = row0 + blockIdx.x, h = blockIdx.y, lane = threadIdx.x;
    int start, len, pos, b; row_seq(r, start, len, pos, b);
    qs[lane] = P[(size_t)r * PM + OFF_C + h * 64 + lane] * 0.125f;
    const bool lat = r < RL;
    const int nk = lat ? 384 : 256;
    int rr = 0, w = 0, rs = 0, cs = 0;
    if (lat) { rr = pos >> 6; w = pos & 63; rs = min(max(rr - 4, 0), 56); cs = min(max(w - 8, 0), 48); }
    __syncthreads();
    float s[6]; float mx = -3.0e38f;
#pragma unroll
    for (int m = 0; m < 6; ++m) {
        const int j = lane + 64 * m; s[m] = -3.0e38f;
        if (j < nk) {
            int krow; float bias = 0.f;
            if (lat && j < 128) { const int i = j >> 4, jj = j & 15; krow = start + (rs + i) * 64 + cs + jj; bias = rpb[(h * 15 + (rs + i - rr + 7)) * 31 + (cs + jj - w + 15)]; }
            else krow = RL + b * CTXL + (lat ? j - 128 : j);
            kr[j] = krow;
            const float* kp = P + (size_t)krow * PM + OFF_C + 384 + h * 64;
            float a = 0.f;
            for (int dd = 0; dd < 64; ++dd) a += qs[dd] * kp[dd];
            s[m] = a + bias; mx = fmaxf(mx, s[m]);
        }
    }
    mx = wave_max(mx);
    float sum = 0.f;
#pragma unroll
    for (int m = 0; m < 6; ++m) { const int j = lane + 64 * m; if (j < nk) { s[m] = expf(s[m] - mx); sum += s[m]; } }
    sum = wave_sum(sum);
    const float inv = 1.f / sum;
#pragma unroll
    for (int m = 0; m < 6; ++m) { const int j = lane + 64 * m; if (j < nk) ps[j] = s[m] * inv; }
    __syncthreads();
    float o = 0.f;
    for (int j = 0; j < nk; ++j) o += ps[j] * P[(size_t)kr[j] * PM + OFF_C + 768 + h * 64 + lane];
    Y[(size_t)r * YW + 640 + h * 64 + lane] = o;
}

__global__ __launch_bounds__(64) void k_s5_scan(const float* P, const float* AB, const float* BB, const float* c_re, const float* c_im, float* YP  ) {
    const int g = blockIdx.x, d = blockIdx.y, b = blockIdx.z, p = threadIdx.x;
    const int sidx = (d * 16 + g) * 64 + p;
    const float abr = AB[sidx * 2], abi = AB[sidx * 2 + 1];
    float bbr[16], bbi[16], cr[16], ci[16];
#pragma unroll
    for (int i = 0; i < 16; ++i) { bbr[i] = BB[(sidx * 16 + i) * 2]; bbi[i] = BB[(sidx * 16 + i) * 2 + 1];
        cr[i] = c_re[((size_t)(d * 16 + g) * 16 + i) * 64 + p]; ci[i] = c_im[((size_t)(d * 16 + g) * 16 + i) * 64 + p]; }
    float hr = 0.f, hi = 0.f;
    for (int seg = 0; seg < 2; ++seg) {
        const int start = seg == 0 ? RL + b * CTXL : b * SEQ, len = seg == 0 ? CTXL : SEQ;
        for (int s = 0; s < len; ++s) {
            const int pos = d == 0 ? s : len - 1 - s;
            const float* u = P + (size_t)(start + pos) * PM + OFF_D + g * 16;
            float br = 0.f, bi = 0.f;
#pragma unroll
            for (int i = 0; i < 16; ++i) { const float uv = u[i]; br += bbr[i] * uv; bi += bbi[i] * uv; }
            const float nr = abr * hr - abi * hi + br, ni = abr * hi + abi * hr + bi;
            hr = nr; hi = ni;
            float mine = 0.f;
#pragma unroll
            for (int o = 0; o < 16; ++o) { const float v = wave_sum(hr * cr[o] - hi * ci[o]); if (p == o) mine = v; }
            if (p < 16) YP[((size_t)d * RT + start + pos) * 256 + g * 16 + p] = mine;
        }
    }
}
__global__ __launch_bounds__(256) void k_s5_out(const float* P, const float* YP, const float* s5d, const float* wglu, const float* bglu, float* Y) {
    __shared__ float gl[256];
    const int r = blockIdx.x, n = threadIdx.x;
    const float y = YP[(size_t)r * 256 + n] + YP[((size_t)RT + r) * 256 + n] + s5d[n] * P[(size_t)r * PM + OFF_D + n];
    const float gv = gelu_t(y);
    gl[n] = gv;
    __syncthreads();
    float a = bglu[n];
    for (int k = 0; k < 256; ++k) a += gl[k] * wglu[k * 256 + n];
    Y[(size_t)r * YW + 1024 + n] = gv * sigm(a);
}

__global__ __launch_bounds__(64) void k_router(const float* U, const float* wr, int* cnt, int* list, float* wts) {
    const int r = blockIdx.x, lane = threadIdx.x;
    float a[8];
#pragma unroll
    for (int e = 0; e < 8; ++e) a[e] = 0.f;
    for (int k = lane; k < D; k += 64) { const float u = U[(size_t)r * D + k];
#pragma unroll
        for (int e = 0; e < 8; ++e) a[e] += u * wr[k * 8 + e]; }
#pragma unroll
    for (int e = 0; e < 8; ++e) a[e] = wave_sum(a[e]);
    if (lane == 0) {
        int i1 = 0; float v1 = a[0];
#pragma unroll
        for (int e = 1; e < 8; ++e) if (a[e] > v1) { v1 = a[e]; i1 = e; }
        int i2 = -1; float v2 = -3.0e38f;
#pragma unroll
        for (int e = 0; e < 8; ++e) if (e != i1 && a[e] > v2) { v2 = a[e]; i2 = e; }
        const float e2 = expf(v2 - v1), w1 = 1.f / (1.f + e2), w2 = e2 / (1.f + e2);
        const int b = r >> 12;
        int p1 = atomicAdd(&cnt[b * 8 + i1], 1); list[(b * 8 + i1) * SEQ + p1] = r; wts[(b * 8 + i1) * SEQ + p1] = w1;
        int p2 = atomicAdd(&cnt[b * 8 + i2], 1); list[(b * 8 + i2) * SEQ + p2] = r; wts[(b * 8 + i2) * SEQ + p2] = w2;
    }
}

void sgemm(hipStream_t st, const float* A, int lda, const int* arow, const float* B, int ldb, float* C, int ldc, const int* crow, int M, const int* Mptr, int N, int K,
           int mode = 0, const float* G = nullptr, int ldg = 0, int accum = 0, const float* wt = nullptr) {
    GemmArgs g{}; g.A = A; g.lda = lda; g.arow = arow; g.B = B; g.ldb = ldb; g.C = C; g.ldc = ldc; g.crow = crow; g.M = M; g.Mptr = Mptr; g.N = N; g.K = K;
    g.mode = mode; g.G = G; g.ldg = ldg; g.accum = accum; g.wt = wt;
    hipLaunchKernelGGL(k_sgemm, dim3(N / 128, (M + 127) / 128), dim3(256), 0, st, g);
}
}

extern "C" void kernel_launch(void* const* d_in, const int* in_sizes, int n_in, void* d_out, int out_size, void* d_ws, size_t ws_size, hipStream_t stream) {
    const float* x = (const float*)d_in[0]; const float* c = (const float*)d_in[1]; const float* ctx = (const float*)d_in[2]; const float* c_ctx = (const float*)d_in[3];
    const float* w_mod = (const float*)d_in[4]; const float* b_mod = (const float*)d_in[5]; const float* w_in = (const float*)d_in[6];
    const float* lru_conv_w = (const float*)d_in[7]; const float* lru_conv_b = (const float*)d_in[8]; const float* lru_w_r = (const float*)d_in[9]; const float* lru_b_r = (const float*)d_in[10];
    const float* lru_w_i = (const float*)d_in[11]; const float* lru_b_i = (const float*)d_in[12]; const float* lru_lambda = (const float*)d_in[13];
    const float* hy_conv_w = (const float*)d_in[14]; const float* hy_conv_b = (const float*)d_in[15]; const float* hy_w1 = (const float*)d_in[16]; const float* hy_b1 = (const float*)d_in[17];
    const float* hy_w2 = (const float*)d_in[18]; const float* hy_b2 = (const float*)d_in[19]; const float* hy_w3 = (const float*)d_in[20]; const float* hy_b3 = (const float*)d_in[21];
    const float* hy_freq = (const float*)d_in[22]; const float* hy_bias = (const float*)d_in[23]; const float* na_rpb = (const float*)d_in[24];
    const float* s5_a_re = (const float*)d_in[25]; const float* s5_a_im = (const float*)d_in[26]; const float* s5_log_dt = (const float*)d_in[27];
    const float* s5_b_re = (const float*)d_in[28]; const float* s5_b_im = (const float*)d_in[29]; const float* s5_c_re = (const float*)d_in[30]; const float* s5_c_im = (const float*)d_in[31];
    const float* s5_d = (const float*)d_in[32]; const float* s5_w_glu = (const float*)d_in[33]; const float* s5_b_glu = (const float*)d_in[34];
    const float* w_br[4] = {(const float*)d_in[35], (const float*)d_in[36], (const float*)d_in[37], (const float*)d_in[38]};
    const float* w_out = (const float*)d_in[39]; const float* ln1_g = (const float*)d_in[40]; const float* ln1_b = (const float*)d_in[41]; const float* ln2_g = (const float*)d_in[42]; const float* ln2_b = (const float*)d_in[43];
    const float* ff_w_gate = (const float*)d_in[44]; const float* ff_w_up = (const float*)d_in[45]; const float* ff_w_down = (const float*)d_in[46];
    const float* moe_router = (const float*)d_in[47]; const float* moe_w_gate = (const float*)d_in[48]; const float* moe_w_up = (const float*)d_in[49]; const float* moe_w_down = (const float*)d_in[50];
    float* out = (float*)d_out;

    float* ws = (float*)d_ws; size_t off = 0;
    auto take = [&](size_t n) { float* p = ws + off; off += (n + 63) & ~(size_t)63; return p; };
    float* MOD = take(2 * 5 * 6144);
    float* HFl = take((size_t)SEQ * 1024); float* HFc = take((size_t)CTXL * 1024); float* NORMl = take(512); float* NORMc = take(512);
    float* S5AB = take(4096); float* S5BB = take(65536);
    int* cnt = (int*)take(64); int* list = (int*)take(32 * SEQ); float* wts = take(32 * SEQ);
    float* XS = take((size_t)RT * D);
    float* U = take((size_t)RT * D);
    float* Y = take((size_t)RT * YW);
    float* BIG = ws + off;
    float* P = BIG;
    float* HLRU = P + (size_t)RT * PM;
    float* YP = HLRU + (size_t)2 * RT * 384;
    float* ZT = HLRU;
    float* Y1T = YP;
    const size_t need = (off + (size_t)RT * PM + (size_t)2 * RT * 384 + (size_t)2 * RT * 256) * 4;
    if (need > ws_size) return;
    float* PG = BIG;
    float* MG = PG + (size_t)4352 * 4096;
    float* Mbuf = U;
    float* FF = Y;
    float* Gb = BIG;

    hipMemcpyAsync(XS, x, (size_t)RL * D * 4, hipMemcpyDeviceToDevice, stream);
    hipMemcpyAsync(XS + (size_t)RL * D, ctx, (size_t)RC * D * 4, hipMemcpyDeviceToDevice, stream);
    hipLaunchKernelGGL(k_mod, dim3(24, 2), dim3(256), 0, stream, c, c_ctx, w_mod, b_mod, MOD);

    for (int l = 0; l < 2; ++l) {
        const bool with_ctx = (l == 0);
        const float* MODL = MOD + (size_t)l * 5 * 6144;
        hipLaunchKernelGGL(k_hy_filt, dim3(SEQ), dim3(256), 0, stream, SEQ, hy_w1 + l * 33 * 64, hy_b1 + l * 64, hy_w2 + l * 4096, hy_b2 + l * 64, hy_w3 + (size_t)l * 65536, hy_b3 + l * 1024, hy_freq + l * 64, HFl);
        hipLaunchKernelGGL(k_hy_norm, dim3(512), dim3(256), 0, stream, SEQ, HFl, NORMl);
        if (with_ctx) {
            hipLaunchKernelGGL(k_hy_filt, dim3(CTXL), dim3(256), 0, stream, CTXL, hy_w1 + l * 33 * 64, hy_b1 + l * 64, hy_w2 + l * 4096, hy_b2 + l * 64, hy_w3 + (size_t)l * 65536, hy_b3 + l * 1024, hy_freq + l * 64, HFc);
            hipLaunchKernelGGL(k_hy_norm, dim3(512), dim3(256), 0, stream, CTXL, HFc, NORMc);
        }
        hipLaunchKernelGGL(k_s5_disc, dim3(8), dim3(256), 0, stream, s5_a_re + l * 2048, s5_a_im + l * 2048, s5_log_dt + l * 32, s5_b_re + l * 32768, s5_b_im + l * 32768, S5AB, S5BB);
        hipLaunchKernelGGL(k_lnmod, dim3(RT), dim3(256), 0, stream, XS, MODL, 0, U);
        sgemm(stream, U, D, nullptr, w_in + (size_t)l * D * IN_COLS, IN_COLS, P, PM, nullptr, RT, nullptr, PM, D);
        hipLaunchKernelGGL(k_lru_scan, dim3(6, 2, 4), dim3(64), 0, stream, P, lru_conv_w + l * 4 * 384, lru_conv_b + l * 384, lru_w_r + (size_t)l * 2 * 6 * 4096, lru_b_r + l * 768,
                           lru_w_i + (size_t)l * 2 * 6 * 4096, lru_b_i + l * 768, lru_lambda + l * 768, HLRU);
        hipLaunchKernelGGL(k_lru_out, dim3((RT * 384 + 255) / 256), dim3(256), 0, stream, P, HLRU, Y);
        hipLaunchKernelGGL(k_s5_scan, dim3(16, 2, 4), dim3(64), 0, stream, P, S5AB, S5BB, s5_c_re + l * 32768, s5_c_im + l * 32768, YP);
        hipLaunchKernelGGL(k_s5_out, dim3(RT), dim3(256), 0, stream, P, YP, s5_d + l * 256, s5_w_glu + l * 65536, s5_b_glu + l * 256, Y);
        hipLaunchKernelGGL(k_hy_conv, dim3((RT * 768 + 255) / 256), dim3(256), 0, stream, P, hy_conv_w + l * 3 * 768, hy_conv_b + l * 768, ZT);
        hipLaunchKernelGGL(k_hy_long, dim3(256, 4, 2), dim3(256), 3 * SEQ * 4, stream, ZT, ZT + (size_t)256 * RT, HFl, HFc, NORMl, NORMc, hy_bias + l * 512, 0, Y1T, (float*)nullptr, with_ctx ? 1 : 0);
        hipLaunchKernelGGL(k_hy_long, dim3(256, 4, 2), dim3(256), 3 * SEQ * 4, stream, Y1T, ZT + (size_t)512 * RT, HFl, HFc, NORMl, NORMc, hy_bias + l * 512, 1, (float*)nullptr, Y, with_ctx ? 1 : 0);
        hipLaunchKernelGGL(k_na, dim3(with_ctx ? RT : RL, 6), dim3(64), 0, stream, P, na_rpb + l * 6 * 15 * 31, Y, 0);
        const int CH = with_ctx ? 4352 : 4096, NCH = 4;
        const int koff[4] = {0, 384, 640, 1024}, kdim[4] = {384, 256, 384, 256};
        for (int q = 0; q < NCH; ++q) {
            const size_t r0 = (size_t)q * CH;
            sgemm(stream, U + r0 * D, D, nullptr, w_in + (size_t)l * D * IN_COLS + OFF_G, IN_COLS, PG, 4096, nullptr, CH, nullptr, 4096, D);
            for (int i = 0; i < 4; ++i)
                sgemm(stream, Y + r0 * YW + koff[i], YW, nullptr, w_br[i] + (size_t)l * kdim[i] * D, D, MG, D, nullptr, CH, nullptr, D, kdim[i], 2, PG + i * 1024, 4096, i > 0 ? 1 : 0);
            sgemm(stream, MG, D, nullptr, w_out + (size_t)l * D * D, D, Mbuf + r0 * D, D, nullptr, CH, nullptr, D, D);
        }
        const int rows_act = with_ctx ? RT : RL;
        hipLaunchKernelGGL(k_resln, dim3(rows_act), dim3(256), 0, stream, XS, Mbuf, MODL, 2048, ln1_g + l * D, ln1_b + l * D, (float*)nullptr);
        hipLaunchKernelGGL(k_lnmod, dim3(rows_act), dim3(256), 0, stream, XS, MODL, 3072, U);
        if (l == 0) {
            for (int q = 0; q < 4; ++q) {
                const size_t r0 = (size_t)q * 4352;
                sgemm(stream, U + r0 * D, D, nullptr, ff_w_gate, FF_DENSE, Gb, FF_DENSE, nullptr, 4352, nullptr, FF_DENSE, D);
                sgemm(stream, U + r0 * D, D, nullptr, ff_w_up, FF_DENSE, Gb, FF_DENSE, nullptr, 4352, nullptr, FF_DENSE, D, 1);
                sgemm(stream, Gb, FF_DENSE, nullptr, ff_w_down, D, FF + r0 * D, D, nullptr, 4352, nullptr, D, FF_DENSE);
            }
        } else {
            hipMemsetAsync(cnt, 0, 64 * 4, stream);
            hipMemsetAsync(FF, 0, (size_t)RL * D * 4, stream);
            hipLaunchKernelGGL(k_router, dim3(RL), dim3(64), 0, stream, U, moe_router, cnt, list, wts);
            for (int be = 0; be < 32; ++be) {
                const int e = be & 7;
                sgemm(stream, U, D, list + be * SEQ, moe_w_gate + (size_t)e * D * FF_E, FF_E, Gb, FF_E, nullptr, SEQ, cnt + be, FF_E, D);
                sgemm(stream, U, D, list + be * SEQ, moe_w_up + (size_t)e * D * FF_E, FF_E, Gb, FF_E, nullptr, SEQ, cnt + be, FF_E, D, 1);
                sgemm(stream, Gb, FF_E, nullptr, moe_w_down + (size_t)e * FF_E * D, D, FF, D, list + be * SEQ, SEQ, cnt + be, D, FF_E, 3, nullptr, 0, 0, wts + be * SEQ);
            }
        }
        hipLaunchKernelGGL(k_resln, dim3(rows_act), dim3(256), 0, stream, XS, FF, MODL, 5120, ln2_g + l * D, ln2_b + l * D, l == 1 ? out : (float*)nullptr);
    }
}
```

```cpp
#include <hip/hip_runtime.h>
#include <stdint.h>
#include <math.h>

#define LAS __attribute__((address_space(3)))
typedef unsigned short bf16_t;
typedef short bf16x8 __attribute__((ext_vector_type(8)));
typedef float f32x4 __attribute__((ext_vector_type(4)));
typedef float f32x2 __attribute__((ext_vector_type(2)));
typedef unsigned u32x4 __attribute__((ext_vector_type(4)));
typedef unsigned u32x2 __attribute__((ext_vector_type(2)));

namespace {
constexpr int D = 1024, NB = 4, SEQ = 4096, CTXL = 256;
constexpr int RL = NB * SEQ, RC = NB * CTXL, RT = RL + RC;
constexpr int IN_COLS = 7040;
constexpr int FF_DENSE = 2816, NE = 8, FF_E = 3584;
constexpr float ALPHA = 1.41421356237309515f;
constexpr int LDP = 5888, PC_AG = 0, PC_AC = 384, PC_D = 768, PC_Q = 1024, PC_K = 1408, PC_G = 1792;
constexpr int NPT = 1280, PT_V = 768;
constexpr int YW = 1280, YC_A = 0, YC_B = 384, YC_C = 640, YC_D = 1024;
constexpr int MOE_TILES_PASS = 68;
constexpr int MOE_ROWS_MAX = 2 * RL + NE * 256;

constexpr size_t al256(size_t x) { return (x + 255) & ~(size_t)255; }
constexpr size_t WS_CTL = 0, CTL_BYTES = 131072;
constexpr int CW_BAR = 0;
constexpr int CW_MOECNT = 24576;
constexpr int CW_QUEUE = 28672;
constexpr int CW_HYN = 29696;
constexpr size_t WS_MOD = WS_CTL + CTL_BYTES;
constexpr size_t WS_HYN = WS_MOD + al256(2 * 5 * 6144 * 4);
constexpr size_t WS_S5AB = WS_HYN + 4096;
constexpr size_t WS_S5BB = WS_S5AB + 16384;
constexpr size_t WS_AB16 = WS_S5BB + 262144;
constexpr size_t WS_TILEE = WS_AB16 + 32768;
constexpr size_t WS_TOK = WS_TILEE + 1024;
constexpr size_t WS_SLOTW = WS_TOK + (size_t)RL * 32;
constexpr size_t WS_KFL = al256(WS_SLOTW + (size_t)MOE_ROWS_MAX * 4);
constexpr size_t WS_KFC = WS_KFL + (size_t)2 * 1024 * SEQ * 2;
constexpr size_t WS_XSC = WS_KFC + (size_t)1024 * CTXL * 2;
constexpr size_t WS_UB = WS_XSC + (size_t)RC * D * 4;
constexpr size_t SZ_WINR = (size_t)LDP * 1024 * 2, SZ_WINHY = (size_t)NPT * 1024 * 2, SZ_WBR = (size_t)1024 * 1280 * 2, SZ_WOUT = (size_t)1024 * 4096 * 2;
constexpr size_t SZ_WL = SZ_WINR + SZ_WINHY + SZ_WBR + SZ_WOUT;
constexpr size_t WS_WL = WS_UB + (size_t)RT * D * 2;
constexpr size_t WS_FFGU = WS_WL + 2 * SZ_WL;
constexpr size_t WS_FFD = WS_FFGU + (size_t)2 * FF_DENSE * 1024 * 2;
constexpr size_t WS_WGLU = WS_FFD + (size_t)1024 * FF_DENSE * 2;
constexpr size_t WS_OPS = WS_WGLU + (size_t)2 * 256 * 256 * 2;
constexpr size_t WS_OPY = WS_OPS + (size_t)32 * 256 * 256 * 2;
constexpr size_t WS_LW = WS_OPY + (size_t)32 * 256 * 512 * 2;
constexpr size_t WS_PR = WS_LW + (size_t)48 * 4096 * 2;
constexpr size_t WS_PT = WS_PR + (size_t)RT * LDP * 2;
constexpr size_t WS_YB = WS_PT + (size_t)NPT * RT * 2;
constexpr size_t WS_PRE = WS_YB + (size_t)RT * YW * 2;
constexpr size_t WS_EXTRA = WS_PRE + (size_t)RT * D * 4;
constexpr size_t SZ_EXTRA = (size_t)2 * RT * 384 * 4 + (size_t)RT * 256 * 4;
constexpr size_t WS_END = WS_EXTRA + SZ_EXTRA;
constexpr int NCHK = RT / 16, NCHKP = 1280;
constexpr size_t WS_US = WS_PRE;
constexpr size_t WS_S5S = WS_US + (size_t)16 * NCHKP * 512 * 2;
constexpr size_t WS_GL = WS_S5S + (size_t)16 * NCHKP * 256 * 4;
static_assert(WS_GL + (size_t)RT * 256 * 2 <= WS_EXTRA, "s5 overlay");
constexpr size_t WS_H = WS_PR;
constexpr size_t WS_MOEGU = WS_PR;
constexpr size_t WS_MOED = WS_MOEGU + (size_t)NE * 2 * FF_E * 1024 * 2;
constexpr size_t WS_HM = WS_MOED + (size_t)NE * 1024 * FF_E * 2;
constexpr size_t WS_LT = WS_EXTRA;
constexpr size_t WS_LAGG = WS_LT + (size_t)RT * 3 * 384 * 2;
constexpr size_t WS_LHIN = WS_LAGG + (size_t)NCHK * 2 * 384 * 8;
constexpr size_t WS_YT = WS_LHIN + (size_t)NCHK * 2 * 384 * 4;
static_assert(WS_YT + (size_t)256 * RT * 2 <= WS_EXTRA + SZ_EXTRA, "lru / hyena overlay");
constexpr size_t WS_AG = WS_EXTRA;
static_assert(WS_HM + (size_t)MOE_TILES_PASS * 256 * FF_E * 2 <= WS_EXTRA, "moe hidden overlay");
static_assert((size_t)MOE_ROWS_MAX * 1024 * 2 <= SZ_EXTRA, "moe gather overlay");
static_assert((size_t)RT * FF_DENSE * 2 <= (size_t)RT * LDP * 2, "dense hidden overlay");

__device__ __forceinline__ float sigm(float x) { return 1.f / (1.f + __expf(-x)); }
__device__ __forceinline__ float sigm_acc(float x) { return 1.f / (1.f + expf(-x)); }
__device__ __forceinline__ float silu_acc(float x) { return x / (1.f + expf(-x)); }
__device__ __forceinline__ float gelu_t(float x) { return 0.5f * x * (1.f + tanhf(0.7978845608028654f * (x + 0.044715f * x * x * x))); }
__device__ __forceinline__ float gelu_f(float x) { return x * sigm(1.5957691216057308f * (x + 0.044715f * x * x * x)); }
__device__ __forceinline__ float softplus(float x) { return fmaxf(x, 0.f) + log1pf(expf(-fabsf(x))); }
__device__ __forceinline__ float wave_sum(float v) { for (int o = 32; o; o >>= 1) v += __shfl_xor(v, o); return v; }
__device__ __forceinline__ float wave_max(float v) { for (int o = 32; o; o >>= 1) v = fmaxf(v, __shfl_xor(v, o)); return v; }
__device__ __forceinline__ float bf2f(bf16_t b) { return __uint_as_float(((unsigned)b) << 16); }
__device__ __forceinline__ bf16_t f2bf(float f) { unsigned u = __float_as_uint(f); u += 0x7FFFu + ((u >> 16) & 1u); return (bf16_t)(u >> 16); }
__device__ __forceinline__ unsigned cvt_pk_bf16(float lo, float hi) { unsigned r; asm volatile("v_cvt_pk_bf16_f32 %0, %1, %2" : "=v"(r) : "v"(lo), "v"(hi)); return r; }
__device__ __forceinline__ float bflo(unsigned w) { return __uint_as_float(w << 16); }
__device__ __forceinline__ float bfhi(unsigned w) { return __uint_as_float(w & 0xFFFF0000u); }
__device__ __forceinline__ void row_seq(int r, int& start, int& len, int& pos, int& b) {
    if (r < RL) { b = r >> 12; start = b << 12; len = SEQ; pos = r & 4095; }
    else { const int q = r - RL; b = q >> 8; start = RL + (b << 8); len = CTXL; pos = q & 255; }
}

#define XB_TMO      128
#define XB_XCNT(j)  (256  + 64 * (j))
#define XB_XSUB(j)  (1280 + 64 * (j))
#define XB_XGEN(j)  (2304 + 64 * (j))
#define XB_TOP      3328
#define XB_TOPGEN   3392
#define XCD_BAR_WORDS 3456
#define XB_SPIN_CAP (1u << 18)
__device__ __forceinline__ unsigned xb_ld(unsigned* p)              { return __hip_atomic_load(p, __ATOMIC_RELAXED, __HIP_MEMORY_SCOPE_AGENT); }
__device__ __forceinline__ unsigned xb_add(unsigned* p, unsigned v) { return __hip_atomic_fetch_add(p, v, __ATOMIC_RELAXED, __HIP_MEMORY_SCOPE_AGENT); }
__device__ __forceinline__ unsigned xb_xcc_id() { return (unsigned)__builtin_amdgcn_s_getreg((3 << 11) | 20) & 0xFu; }
#define XB_SPIN(cond, bar) do { unsigned _sp = 0; while (cond) { __builtin_amdgcn_s_sleep(1); \
    if ((++_sp & 255u) == 0u) { if (xb_ld(&(bar)[XB_TMO])) break; if (_sp > XB_SPIN_CAP) { atomicAdd(&(bar)[XB_TMO], 1u); break; } } } } while (0)
struct XcdBarrier { unsigned* bar; unsigned x; volatile LAS unsigned* st; };
__device__ __forceinline__ XcdBarrier xcd_barrier_post(unsigned* bar, volatile LAS unsigned* st) {
    XcdBarrier b; b.bar = bar; b.x = xb_xcc_id(); b.st = st;
    if (threadIdx.x == 0) (void)xb_add(&bar[XB_XCNT(b.x)], 1u);
    return b;
}
__device__ __forceinline__ void xcd_barrier_complete(unsigned* bar, unsigned x, unsigned& nloc, unsigned& nx) {
    const unsigned G = gridDim.x * gridDim.y * gridDim.z;
    unsigned sum, cnt, mine, sp = 0u;
    for (;;) {
        sum = 0u; cnt = 0u; mine = 0u;
#pragma unroll
        for (unsigned j = 0; j < 16; ++j) { const unsigned c = xb_ld(&bar[XB_XCNT(j)]); sum += c; cnt += (c > 0u) ? 1u : 0u; mine = (j == x) ? c : mine; }
        if (sum == G) break;
        __builtin_amdgcn_s_sleep(1);
        if ((++sp & 255u) == 0u) { if (xb_ld(&bar[XB_TMO])) break; if (sp > XB_SPIN_CAP) { atomicAdd(&bar[XB_TMO], 1u); break; } }
    }
    nloc = mine > 0u ? mine : 1u; nx = cnt > 0u ? cnt : 1u;
}
__device__ __forceinline__ void xcd_barrier(const XcdBarrier& b) {
    asm volatile("s_waitcnt vmcnt(0)" ::: "memory");
    __syncthreads();
    if (threadIdx.x == 0) {
        unsigned* bar = b.bar;
        __builtin_amdgcn_s_waitcnt(0);
        unsigned nloc = b.st[0], nx = b.st[1];
        if (nloc == 0u) { xcd_barrier_complete(bar, b.x, nloc, nx); b.st[0] = nloc; b.st[1] = nx; }
        const unsigned old = xb_add(&bar[XB_XSUB(b.x)], 1u);
        const unsigned gen = old / nloc;
        if (old + 1u == (gen + 1u) * nloc) {
            __builtin_amdgcn_fence(__ATOMIC_RELEASE, "agent");
            asm volatile("s_waitcnt vmcnt(0)" ::: "memory");
            const unsigned og = xb_add(&bar[XB_TOP], 1u);
            const unsigned tg = og / nx;
            if (og + 1u == (tg + 1u) * nx) xb_add(&bar[XB_TOPGEN], 1u);
            else XB_SPIN(xb_ld(&bar[XB_TOPGEN]) == tg, bar);
            __builtin_amdgcn_fence(__ATOMIC_ACQUIRE, "agent");
            xb_add(&bar[XB_XGEN(b.x)], 1u);
            asm volatile("s_waitcnt vmcnt(0)" ::: "memory");
        } else {
            XB_SPIN(xb_ld(&bar[XB_XGEN(b.x)]) == gen, bar);
            __builtin_amdgcn_fence(__ATOMIC_ACQUIRE, "agent");
            asm volatile("s_waitcnt vmcnt(0)" ::: "memory");
        }
    }
    __syncthreads();
}

namespace pg8 {
constexpr int BM = 256, BK = 64, HALF = 128, HTB = HALF * BK * 2, STAGE_BYTES = 8 * HTB, NXCD = 8, WGM = 8;
__host__ __device__ __forceinline__ int lds_byte(int r, int c) { const int st = (r >> 4) * 2 + (c >> 5), rr = r & 15, cc = c & 31, ob = rr * 64 + cc * 2; return st * 1024 + (ob ^ (((ob >> 9) & 1) << 5)); }
__host__ __device__ __forceinline__ void stage_rc(int b, int& R, int& C) { const int st = b / 1024, sb = b % 1024, swz = sb ^ (((sb >> 9) & 1) << 5); R = (st >> 1) * 16 + swz / 64; C = (st & 1) * 32 + (swz % 64) / 2; }
__host__ __device__ __forceinline__ int perm32(int rho) { const int n = rho >> 4, i = rho & 15; return 8 * (i >> 2) + 4 * n + (i & 3); }

struct Unit { const char* a; const char* b; int nt; int pm, pn, kind; };

__device__ __forceinline__ void rect_map(int wgid, int nM, int nN, int& pm, int& pn) {
    const int nwg = nM * nN;
    { const int q = nwg / NXCD, r = nwg % NXCD, xcd = wgid % NXCD, off = wgid / NXCD; wgid = (xcd < r ? xcd * (q + 1) : r * (q + 1) + (xcd - r) * q) + off; }
    const int nig = WGM * nN, gid = wgid / nig, fm = gid * WGM, gsz = (nM - fm) < WGM ? (nM - fm) : WGM;
    pm = fm + ((wgid % nig) % gsz); pn = (wgid % nig) / gsz;
}

template <int lda, int ldb, class Epi, class Sched>
__device__ __forceinline__ void gemm_phase(LAS unsigned char* lds, const Sched& S, const Epi& E) {
    int tid_ = threadIdx.x; asm volatile("" : "+v"(tid_));
    const int tid = tid_, wid = __builtin_amdgcn_readfirstlane(tid >> 6), lane = tid & 63, wr = wid >> 2, wc = wid & 3, fr = lane & 15, fq = lane >> 4;
    unsigned voffA[2], voffB[2];
#pragma unroll
    for (int i = 0; i < 2; ++i) { int R, C; stage_rc(tid * 16 + i * 8192, R, C); const int Rb = (R & ~31) + perm32(R & 31);
        voffA[i] = (unsigned)(R * lda + C) * 2u; voffB[i] = (unsigned)(Rb * ldb + C) * 2u; }
    const size_t kstep = (size_t)(BK * 2);
    const size_t hstepA = (size_t)HALF * lda * 2, hstepB = (size_t)HALF * ldb * 2;
    const unsigned ldsw = (unsigned)wid * 1024u;
    const int aoff = lds_byte(wr * 64 + fr, fq * 8), boff = lds_byte(wc * 32 + fr, fq * 8);
#define PG8_SA(b, h) (((b) * 2 + (h)) * HTB)
#define PG8_SB(b, h) ((4 + (b) * 2 + (h)) * HTB)
#define PG8_STAGE(bufoff, gbase, voff) do { _Pragma("unroll") for (int _i = 0; _i < 2; ++_i) \
        __builtin_amdgcn_global_load_lds((const unsigned*)((const char*)(gbase) + (voff)[_i]), (LAS unsigned*)(lds + (bufoff) + ldsw + _i * 8192), 16, 0, 0); } while (0)
#define PG8_LDA(dst, b, h) do { _Pragma("unroll") for (int m = 0; m < 4; ++m) _Pragma("unroll") for (int k = 0; k < 2; ++k) dst[m][k] = *(const LAS bf16x8*)(lds + PG8_SA(b, h) + aoff + m * 2048 + k * 1024); } while (0)
#define PG8_LDB(dst, b, h) do { _Pragma("unroll") for (int n = 0; n < 2; ++n) _Pragma("unroll") for (int k = 0; k < 2; ++k) dst[n][k] = *(const LAS bf16x8*)(lds + PG8_SB(b, h) + boff + n * 2048 + k * 1024); } while (0)
#define PG8_MMA(ai, bj, At, Bt) do { __builtin_amdgcn_s_setprio(1); _Pragma("unroll") for (int m = 0; m < 4; ++m) _Pragma("unroll") for (int n = 0; n < 2; ++n) _Pragma("unroll") for (int k = 0; k < 2; ++k) \
        acc[ai][bj][m][n] = __builtin_amdgcn_mfma_f32_16x16x32_bf16(Bt[n][k], At[m][k], acc[ai][bj][m][n], 0, 0, 0); __builtin_amdgcn_s_setprio(0); } while (0)
#define PG8_WAIT_V(n) asm volatile("s_waitcnt vmcnt(" #n ")" ::: "memory")
#define PG8_WAIT_L(n) asm volatile("s_waitcnt lgkmcnt(" #n ")" ::: "memory")
#define PG8_BAR __builtin_amdgcn_s_barrier()
#define PG8_SCHED __builtin_amdgcn_sched_barrier(0)
    Unit cur, nxt; int ui = 0;
    if (!S.next(0, cur)) return;
    f32x4 acc[2][2][4][2];
#pragma unroll
    for (int a = 0; a < 2; ++a)
#pragma unroll
        for (int b = 0; b < 2; ++b)
#pragma unroll
            for (int m = 0; m < 4; ++m)
#pragma unroll
                for (int n = 0; n < 2; ++n) acc[a][b][m][n] = (f32x4){0.f, 0.f, 0.f, 0.f};
    bf16x8 At[4][2], B0[2][2], B1[2][2];
    const char* cA = cur.a; const char* cB = cur.b;
    PG8_STAGE(PG8_SB(0, 0), cB, voffB); PG8_STAGE(PG8_SA(0, 0), cA, voffA); PG8_STAGE(PG8_SB(0, 1), cB + hstepB, voffB); PG8_STAGE(PG8_SA(0, 1), cA + hstepA, voffA);
    if (wr == 1) PG8_BAR;
    PG8_WAIT_V(4); PG8_BAR;
    PG8_STAGE(PG8_SB(1, 0), cB + kstep, voffB); PG8_STAGE(PG8_SA(1, 0), cA + kstep, voffA); PG8_STAGE(PG8_SB(1, 1), cB + hstepB + kstep, voffB);
    PG8_WAIT_V(6); PG8_BAR;
    for (;;) {
        const bool has_next = S.next(ui + 1, nxt);
        const char* nA = has_next ? nxt.a : cA; const char* nB = has_next ? nxt.b : cB;
        const int nt = cur.nt;
        for (int t = 0; t < nt; t += 2) {
            const bool last = (t == nt - 2);
            const char* a1 = cA + (size_t)(t + 1) * kstep;
            const char* a2 = last ? nA : cA + (size_t)(t + 2) * kstep; const char* b2 = last ? nB : cB + (size_t)(t + 2) * kstep;
            const char* a3 = a2 + kstep; const char* b3 = b2 + kstep;
            PG8_LDB(B0, 0, 0); PG8_SCHED; PG8_LDA(At, 0, 0); PG8_STAGE(PG8_SA(1, 1), a1 + hstepA, voffA);
            PG8_WAIT_L(8); PG8_BAR; PG8_WAIT_L(0); PG8_MMA(0, 0, At, B0); PG8_BAR; PG8_SCHED;
            PG8_LDB(B1, 0, 1); PG8_STAGE(PG8_SB(0, 0), b2, voffB);
            PG8_BAR; PG8_WAIT_L(0); PG8_MMA(0, 1, At, B1); PG8_BAR;
            PG8_LDA(At, 0, 1); PG8_STAGE(PG8_SA(0, 0), a2, voffA);
            PG8_BAR; PG8_WAIT_L(0); PG8_MMA(1, 0, At, B0); PG8_BAR; PG8_SCHED;
            PG8_STAGE(PG8_SB(0, 1), b2 + hstepB, voffB);
            PG8_WAIT_V(6); PG8_BAR; PG8_MMA(1, 1, At, B1); PG8_BAR;
            PG8_LDB(B0, 1, 0); PG8_SCHED; PG8_LDA(At, 1, 0); PG8_STAGE(PG8_SA(0, 1), a2 + hstepA, voffA);
            PG8_WAIT_L(8); PG8_BAR; PG8_WAIT_L(0); PG8_MMA(0, 0, At, B0); PG8_BAR; PG8_SCHED;
            PG8_LDB(B1, 1, 1); PG8_STAGE(PG8_SB(1, 0), b3, voffB);
            PG8_BAR; PG8_WAIT_L(0); PG8_MMA(0, 1, At, B1); PG8_BAR;
            PG8_LDA(At, 1, 1); PG8_STAGE(PG8_SA(1, 0), a3, voffA);
            PG8_BAR; PG8_WAIT_L(0); PG8_MMA(1, 0, At, B0); PG8_BAR; PG8_SCHED;
            PG8_STAGE(PG8_SB(1, 1), b3 + hstepB, voffB);
            PG8_WAIT_V(6); PG8_BAR; PG8_MMA(1, 1, At, B1); PG8_BAR;
        }
        E(acc, cur, wr, wc, fr, fq);
        if (!has_next) break;
#pragma unroll
        for (int a = 0; a < 2; ++a)
#pragma unroll
            for (int b = 0; b < 2; ++b)
#pragma unroll
                for (int m = 0; m < 4; ++m)
#pragma unroll
                    for (int n = 0; n < 2; ++n) acc[a][b][m][n] = (f32x4){0.f, 0.f, 0.f, 0.f};
        cur = nxt; cA = nA; cB = nB; ++ui;
    }
    PG8_WAIT_V(0);
    if (wr == 0) PG8_BAR;
    PG8_BAR;
#undef PG8_SA
#undef PG8_SB
#undef PG8_STAGE
#undef PG8_LDA
#undef PG8_LDB
#undef PG8_MMA
#undef PG8_WAIT_V
#undef PG8_WAIT_L
#undef PG8_BAR
#undef PG8_SCHED
}

struct PartC { long long aOff, bOff; unsigned aStep, bStep; int nM, nN, nt, kind, start, nGrp; unsigned aGrp, bGrp; };
struct TabSched {
    const PartC* parts; const char* ws; int np, total, G, c;
    __device__ __forceinline__ bool next(int i, Unit& u) const {
        const int L = i * G + c; if (L >= total) return false;
        int q = 0;
#pragma unroll
        for (int k = 1; k < 4; ++k) if (k < np && L >= parts[k].start) q = k;
        const PartC P = parts[q];
        const int per = P.nM * P.nN, idx = L - P.start, grp = idx / per;
        int pm, pn; rect_map(idx - grp * per, P.nM, P.nN, pm, pn);
        u.a = ws + P.aOff + (size_t)grp * P.aGrp + (size_t)pm * P.aStep; u.b = ws + P.bOff + (size_t)grp * P.bGrp + (size_t)pn * P.bStep; u.nt = P.nt; u.pm = pm; u.pn = pn; u.kind = P.kind + grp; return true;
    }
};
struct MoeSched {
    const char* A; const char* B; const int* tile_e; unsigned aStep, bStep; size_t bExp; int nN, nt, tile0, ntile, G, c;
    __device__ __forceinline__ bool next(int i, Unit& u) const {
        const int L = i * G + c; if (L >= ntile * nN) return false;
        const int mt = tile0 + L / nN, pn = L % nN;
        const int e = __builtin_amdgcn_readfirstlane(__hip_atomic_load(tile_e + mt, __ATOMIC_RELAXED, __HIP_MEMORY_SCOPE_AGENT));
        u.a = A + (size_t)(mt - tile0) * aStep; u.b = B + (size_t)e * bExp + (size_t)pn * bStep; u.nt = nt; u.pm = mt; u.pn = pn; u.kind = e; return true;
    }
};

#define EPI_ROWS(u) const int row0 = (u).pm * BM + wr * 64 + fr, colt = wc * 32 + 8 * fq
struct EpiProj {
    bf16_t* PRp; bf16_t* PTp; bf16_t* USp; int sig_from;
    __device__ __forceinline__ void operator()(const f32x4 (&acc)[2][2][4][2], const Unit& u, int wr, int wc, int fr, int fq) const {
        EPI_ROWS(u);
        bf16_t* base = u.kind == 1 ? PTp : PRp; const int ldc = u.kind == 1 ? RT : LDP; const bool sg = (u.kind == 0 && u.pn >= sig_from);
#pragma unroll
        for (int ai = 0; ai < 2; ++ai)
#pragma unroll
            for (int m = 0; m < 4; ++m) { bf16_t* rowp = base + (size_t)(row0 + ai * HALF + m * 16) * ldc + u.pn * BM + colt;
#pragma unroll
                for (int bj = 0; bj < 2; ++bj) { f32x4 v0 = acc[ai][bj][m][0], v1 = acc[ai][bj][m][1];
                    if (sg) {
#pragma unroll
                        for (int j = 0; j < 4; ++j) { v0[j] = sigm(v0[j]); v1[j] = sigm(v1[j]); } }
                    u32x4 w; w.x = cvt_pk_bf16(v0[0], v0[1]); w.y = cvt_pk_bf16(v0[2], v0[3]); w.z = cvt_pk_bf16(v1[0], v1[1]); w.w = cvt_pk_bf16(v1[2], v1[3]);
                    *(u32x4*)(rowp + bj * HALF) = w;
                    if (u.kind == 0 && u.pn == 3) { const int r = row0 + ai * HALF + m * 16, cc = colt + bj * HALF;
                        *(u32x4*)(USp + ((size_t)(cc >> 4) * NCHKP + (r >> 4)) * 512 + (r & 15) * 16 + (cc & 15)) = w; } } }
    }
};
struct EpiS5State {
    float* Sp;
    __device__ __forceinline__ void operator()(const f32x4 (&acc)[2][2][4][2], const Unit& u, int wr, int wc, int fr, int fq) const {
        EPI_ROWS(u);
#pragma unroll
        for (int ai = 0; ai < 2; ++ai)
#pragma unroll
            for (int m = 0; m < 4; ++m) { float* op = Sp + ((size_t)u.kind * NCHKP + row0 + ai * HALF + m * 16) * 256 + colt;
#pragma unroll
                for (int bj = 0; bj < 2; ++bj)
#pragma unroll
                    for (int n = 0; n < 2; ++n) *(f32x4*)(op + bj * HALF + 4 * n) = acc[ai][bj][m][n]; }
    }
};
struct EpiS5Main {
    bf16_t* GLp; const bf16_t* PRp; const float* dvec;
    __device__ __forceinline__ void operator()(const f32x4 (&acc)[2][2][4][2], const Unit& u, int wr, int wc, int fr, int fq) const {
        EPI_ROWS(u);
#pragma unroll
        for (int ai = 0; ai < 2; ++ai)
#pragma unroll
            for (int m = 0; m < 4; ++m) { const int n = row0 + ai * HALF + m * 16; if (n >= NCHK) continue;
#pragma unroll
                for (int bj = 0; bj < 2; ++bj) { const int c = colt + bj * HALF, r = 16 * n + (c >> 4), col = 16 * u.kind + (c & 15);
                    const u32x4 uv = *(const u32x4*)(PRp + (size_t)r * LDP + PC_D + col);
                    const f32x4 d0 = *(const f32x4*)(dvec + col), d1 = *(const f32x4*)(dvec + col + 4);
                    const f32x4 v0 = acc[ai][bj][m][0], v1 = acc[ai][bj][m][1];
                    u32x4 w; w.x = cvt_pk_bf16(gelu_f(v0[0] + d0[0] * bflo(uv.x)), gelu_f(v0[1] + d0[1] * bfhi(uv.x))); w.y = cvt_pk_bf16(gelu_f(v0[2] + d0[2] * bflo(uv.y)), gelu_f(v0[3] + d0[3] * bfhi(uv.y)));
                    w.z = cvt_pk_bf16(gelu_f(v1[0] + d1[0] * bflo(uv.z)), gelu_f(v1[1] + d1[1] * bfhi(uv.z))); w.w = cvt_pk_bf16(gelu_f(v1[2] + d1[2] * bflo(uv.w)), gelu_f(v1[3] + d1[3] * bfhi(uv.w)));
                    *(u32x4*)(GLp + (size_t)r * 256 + col) = w; } }
    }
};
struct EpiS5Glu {
    bf16_t* YBp; const bf16_t* GLp; const float* bvec;
    __device__ __forceinline__ void operator()(const f32x4 (&acc)[2][2][4][2], const Unit& u, int wr, int wc, int fr, int fq) const {
        EPI_ROWS(u);
#pragma unroll
        for (int ai = 0; ai < 2; ++ai)
#pragma unroll
            for (int m = 0; m < 4; ++m) { const int r = row0 + ai * HALF + m * 16;
#pragma unroll
                for (int bj = 0; bj < 2; ++bj) { const int c = colt + bj * HALF;
                    const u32x4 gv = *(const u32x4*)(GLp + (size_t)r * 256 + c);
                    const f32x4 b0 = *(const f32x4*)(bvec + c), b1 = *(const f32x4*)(bvec + c + 4);
                    const f32x4 v0 = acc[ai][bj][m][0] + b0, v1 = acc[ai][bj][m][1] + b1;
                    u32x4 w; w.x = cvt_pk_bf16(bflo(gv.x) * sigm(v0[0]), bfhi(gv.x) * sigm(v0[1])); w.y = cvt_pk_bf16(bflo(gv.y) * sigm(v0[2]), bfhi(gv.y) * sigm(v0[3]));
                    w.z = cvt_pk_bf16(bflo(gv.z) * sigm(v1[0]), bfhi(gv.z) * sigm(v1[1])); w.w = cvt_pk_bf16(bflo(gv.w) * sigm(v1[2]), bfhi(gv.w) * sigm(v1[3]));
                    *(u32x4*)(YBp + (size_t)r * YW + YC_D + c) = w; } }
    }
};
struct EpiGate {
    bf16_t* PRp;
    __device__ __forceinline__ void operator()(const f32x4 (&acc)[2][2][4][2], const Unit& u, int wr, int wc, int fr, int fq) const {
        EPI_ROWS(u);
#pragma unroll
        for (int ai = 0; ai < 2; ++ai)
#pragma unroll
            for (int m = 0; m < 4; ++m) { bf16_t* rowp = PRp + (size_t)(row0 + ai * HALF + m * 16) * LDP + PC_G + u.kind * 1024 + u.pn * BM + colt;
#pragma unroll
                for (int bj = 0; bj < 2; ++bj) { const f32x4 v0 = acc[ai][bj][m][0], v1 = acc[ai][bj][m][1];
                    const u32x4 g = *(const u32x4*)(rowp + bj * HALF);
                    u32x4 w; w.x = cvt_pk_bf16(v0[0] * bflo(g.x), v0[1] * bfhi(g.x)); w.y = cvt_pk_bf16(v0[2] * bflo(g.y), v0[3] * bfhi(g.y));
                    w.z = cvt_pk_bf16(v1[0] * bflo(g.z), v1[1] * bfhi(g.z)); w.w = cvt_pk_bf16(v1[2] * bflo(g.w), v1[3] * bfhi(g.w));
                    *(u32x4*)(rowp + bj * HALF) = w; } }
    }
};
struct EpiRes {
    float* PREp; const float* xlat; const float* xctx; const float* gvec;
    __device__ __forceinline__ void operator()(const f32x4 (&acc)[2][2][4][2], const Unit& u, int wr, int wc, int fr, int fq) const {
        EPI_ROWS(u);
#pragma unroll
        for (int ai = 0; ai < 2; ++ai)
#pragma unroll
            for (int m = 0; m < 4; ++m) { const int r = row0 + ai * HALF + m * 16; const int c0 = u.pn * BM + colt;
                const float* xin = (r < RL ? xlat + (size_t)r * D : xctx + (size_t)(r - RL) * D) + c0;
                const float* gp = gvec + (size_t)(r < RL ? (r >> 12) : 4) * 6144 + c0;
                float* op = PREp + (size_t)r * D + c0;
#pragma unroll
                for (int bj = 0; bj < 2; ++bj)
#pragma unroll
                    for (int n = 0; n < 2; ++n) { const f32x4 x = *(const f32x4*)(xin + bj * HALF + 4 * n), g = *(const f32x4*)(gp + bj * HALF + 4 * n);
                        *(f32x4*)(op + bj * HALF + 4 * n) = x * ALPHA + g * acc[ai][bj][m][n]; } }
    }
};
struct EpiSwiglu {
    bf16_t* Hp; int ldh; int row_sub;
    __device__ __forceinline__ void operator()(const f32x4 (&acc)[2][2][4][2], const Unit& u, int wr, int wc, int fr, int fq) const {
        const int row0 = (u.pm - row_sub) * BM + wr * 64 + fr, colt = wc * 32 + 8 * fq;
#pragma unroll
        for (int ai = 0; ai < 2; ++ai)
#pragma unroll
            for (int m = 0; m < 4; ++m) { bf16_t* rowp = Hp + (size_t)(row0 + ai * HALF + m * 16) * ldh + u.pn * HALF + colt;
                f32x4 h0, h1;
#pragma unroll
                for (int j = 0; j < 4; ++j) { const float g0 = acc[ai][0][m][0][j], g1 = acc[ai][0][m][1][j];
                    h0[j] = g0 * sigm(g0) * acc[ai][1][m][0][j]; h1[j] = g1 * sigm(g1) * acc[ai][1][m][1][j]; }
                u32x4 w; w.x = cvt_pk_bf16(h0[0], h0[1]); w.y = cvt_pk_bf16(h0[2], h0[3]); w.z = cvt_pk_bf16(h1[0], h1[1]); w.w = cvt_pk_bf16(h1[2], h1[3]);
                *(u32x4*)rowp = w; }
    }
};
struct EpiMoeDown {
    bf16_t* O2; const float* slotw;
    __device__ __forceinline__ void operator()(const f32x4 (&acc)[2][2][4][2], const Unit& u, int wr, int wc, int fr, int fq) const {
        EPI_ROWS(u);
#pragma unroll
        for (int ai = 0; ai < 2; ++ai)
#pragma unroll
            for (int m = 0; m < 4; ++m) { const int r = row0 + ai * HALF + m * 16; const float w8 = slotw[r];
                bf16_t* rowp = O2 + (size_t)r * D + u.pn * BM + colt;
#pragma unroll
                for (int bj = 0; bj < 2; ++bj) { const f32x4 v0 = acc[ai][bj][m][0] * w8, v1 = acc[ai][bj][m][1] * w8;
                    u32x4 w; w.x = cvt_pk_bf16(v0[0], v0[1]); w.y = cvt_pk_bf16(v0[2], v0[3]); w.z = cvt_pk_bf16(v1[0], v1[1]); w.w = cvt_pk_bf16(v1[2], v1[3]);
                    *(u32x4*)(rowp + bj * HALF) = w; } }
    }
};
}

struct Job { int in_idx; int src_off; int lds; int K; int N; long long dst_off; int ldd; int kcol0; int G, GS, R0; int tile0; };
struct JobTable { Job j[96]; int n; int total; };
constexpr int BIGG = 1 << 30;
constexpr void add_job(JobTable& t, int in_idx, long long src_off, int lds, int K, int N, size_t dst_off, int ldd, int kcol0, int G, int GS, int R0) {
    Job& q = t.j[t.n]; q.in_idx = in_idx; q.src_off = (int)src_off; q.lds = lds; q.K = K; q.N = N; q.dst_off = (long long)dst_off; q.ldd = ldd; q.kcol0 = kcol0; q.G = G; q.GS = GS; q.R0 = R0;
    q.tile0 = t.total; t.total += (K / 64) * (N / 64); t.n++;
}
constexpr JobTable make_jobs(int which) {
    JobTable t{}; t.n = 0; t.total = 0;
    if (which == 0) {
        for (int l = 0; l < 2; ++l) {
            const size_t base = WS_WL + (size_t)l * SZ_WL; const long long wsrc = (long long)l * 1024 * IN_COLS;
            add_job(t, 6, wsrc + 0, IN_COLS, 1024, 768, base, 1024, 0, BIGG, 0, 0);
            add_job(t, 6, wsrc + 2688, IN_COLS, 1024, 256, base, 1024, 0, BIGG, 0, PC_D);
            add_job(t, 6, wsrc + 1536, IN_COLS, 1024, 768, base, 1024, 0, BIGG, 0, PC_Q);
            add_job(t, 6, wsrc + 2944, IN_COLS, 1024, 4096, base, 1024, 0, BIGG, 0, PC_G);
            add_job(t, 6, wsrc + 768, IN_COLS, 1024, 768, base + SZ_WINR, 1024, 0, BIGG, 0, 0);
            add_job(t, 6, wsrc + 2304, IN_COLS, 1024, 384, base + SZ_WINR, 1024, 0, BIGG, 0, PT_V);
            const int kd[4] = {384, 256, 384, 256}, ko[4] = {0, 384, 640, 1024};
            for (int i = 0; i < 4; ++i) add_job(t, 35 + i, (long long)l * kd[i] * 1024, 1024, kd[i], 1024, base + SZ_WINR + SZ_WINHY, 1280, ko[i], BIGG, 0, 0);
            for (int i = 0; i < 4; ++i) add_job(t, 39, (long long)l * 1024 * 1024, 1024, 1024, 1024, base + SZ_WINR + SZ_WINHY + SZ_WBR, 4096, i * 1024, BIGG, 0, 0);
        }
        for (int q = 0; q < 24; ++q) for (int mat = 0; mat < 2; ++mat)
            add_job(t, mat == 0 ? 9 : 11, (long long)q * 4096, 64, 64, 64, WS_LW + (size_t)(((q / 6) * 2 + mat) * 6 + q % 6) * 4096 * 2, 64, 0, BIGG, 0, 0);
        for (int l = 0; l < 2; ++l) add_job(t, 33, (long long)l * 65536, 256, 256, 256, WS_WGLU + (size_t)l * 256 * 256 * 2, 256, 0, BIGG, 0, 0);
        add_job(t, 44, 0, FF_DENSE, 1024, FF_DENSE, WS_FFGU, 1024, 0, 128, 256, 0);
        add_job(t, 45, 0, FF_DENSE, 1024, FF_DENSE, WS_FFGU, 1024, 0, 128, 256, 128);
        add_job(t, 46, 0, 1024, FF_DENSE, 1024, WS_FFD, FF_DENSE, 0, BIGG, 0, 0);
    } else {
        for (int e = 0; e < NE; ++e) {
            add_job(t, 48, (long long)e * 1024 * FF_E, FF_E, 1024, FF_E, WS_MOEGU + (size_t)e * 2 * FF_E * 1024 * 2, 1024, 0, 128, 256, 0);
            add_job(t, 49, (long long)e * 1024 * FF_E, FF_E, 1024, FF_E, WS_MOEGU + (size_t)e * 2 * FF_E * 1024 * 2, 1024, 0, 128, 256, 128);
            add_job(t, 50, (long long)e * FF_E * 1024, 1024, FF_E, 1024, WS_MOED + (size_t)e * 1024 * FF_E * 2, FF_E, 0, BIGG, 0, 0);
        }
    }
    return t;
}
__device__ const JobTable JT_SMALL = make_jobs(0);
__device__ const JobTable JT_MOE = make_jobs(1);

struct PartTable { pg8::PartC p[24]; };
constexpr pg8::PartC mk_part(size_t aOff, size_t bOff, unsigned aStep, unsigned bStep, int nM, int nN, int nt, int kind, int start) {
    pg8::PartC q{}; q.aOff = (long long)aOff; q.bOff = (long long)bOff; q.aStep = aStep; q.bStep = bStep; q.nM = nM; q.nN = nN; q.nt = nt; q.kind = kind; q.start = start; q.nGrp = 1; q.aGrp = 0; q.bGrp = 0; return q;
}
constexpr PartTable make_parts() {
    PartTable t{};
    for (int l = 0; l < 2; ++l) {
        const size_t WL = WS_WL + (size_t)l * SZ_WL; const int nMrow = l == 0 ? 68 : 64;
        t.p[l * 8 + 0] = mk_part(WS_UB, WL, 256u * 1024u * 2u, 256u * 1024u * 2u, 68, 23, 16, 0, 0);
        t.p[l * 8 + 1] = mk_part(WL + SZ_WINR, WS_UB, 256u * 1024u * 2u, 256u * 1024u * 2u, 5, 68, 16, 1, 68 * 23);
        const int kd[4] = {384, 256, 384, 256}, ko[4] = {0, 384, 640, 1024};
        for (int i = 0; i < 4; ++i) t.p[l * 8 + 2 + i] = mk_part(WS_YB + ko[i] * 2, WL + SZ_WINR + SZ_WINHY + ko[i] * 2, 256u * 1280u * 2u, 256u * 1280u * 2u, nMrow, 4, kd[i] / 64, i, i * nMrow * 4);
        t.p[l * 8 + 6] = mk_part(WS_PR + PC_G * 2, WL + SZ_WINR + SZ_WINHY + SZ_WBR, 256u * (unsigned)LDP * 2u, 256u * 4096u * 2u, nMrow, 4, 64, 0, 0);
    }
    for (int l = 0; l < 2; ++l) {
        pg8::PartC q = mk_part(WS_US, WS_OPS + (size_t)l * 16 * 256 * 256 * 2, 256u * 512u * 2u, 0u, 5, 1, 4, 0, 0); q.nGrp = 16; q.aGrp = (unsigned)(NCHKP * 512 * 2); q.bGrp = 256u * 256u * 2u; t.p[18 + l * 3] = q;
        q = mk_part(WS_US, WS_OPY + (size_t)l * 16 * 256 * 512 * 2, 256u * 512u * 2u, 0u, 5, 1, 8, 0, 0); q.nGrp = 16; q.aGrp = (unsigned)(NCHKP * 512 * 2); q.bGrp = 256u * 512u * 2u; t.p[19 + l * 3] = q;
        t.p[20 + l * 3] = mk_part(WS_GL, WS_WGLU + (size_t)l * 256 * 256 * 2, 256u * 256u * 2u, 0u, l == 0 ? 68 : 64, 1, 4, 0, 0);
    }
    t.p[16] = mk_part(WS_UB, WS_FFGU, 256u * 1024u * 2u, 256u * 1024u * 2u, 68, 22, 16, 0, 0);
    t.p[17] = mk_part(WS_H, WS_FFD, 256u * (unsigned)FF_DENSE * 2u, 256u * (unsigned)FF_DENSE * 2u, 68, 4, 44, 0, 0);
    return t;
}
__device__ const PartTable PARTS = make_parts();

struct Args {
    const float* in[51];
    float* out; unsigned char* ws;
    int ph_lo, ph_hi, bar_region, pad0;
};
__device__ __forceinline__ const float* sel_in(const Args& a, int idx) {
    const float* p = a.in[6];
    p = idx == 9 ? a.in[9] : p; p = idx == 11 ? a.in[11] : p; p = idx == 33 ? a.in[33] : p; p = idx == 35 ? a.in[35] : p; p = idx == 36 ? a.in[36] : p; p = idx == 37 ? a.in[37] : p; p = idx == 38 ? a.in[38] : p; p = idx == 39 ? a.in[39] : p;
    p = idx == 44 ? a.in[44] : p; p = idx == 45 ? a.in[45] : p; p = idx == 46 ? a.in[46] : p; p = idx == 48 ? a.in[48] : p; p = idx == 49 ? a.in[49] : p; p = idx == 50 ? a.in[50] : p;
    return p;
}

__device__ __forceinline__ void convert_tiles(const Args& a, const JobTable& JT, LAS float* tile, int first, int stride) {
    const int tid = threadIdx.x;
    for (int t = first; t < JT.total; t += stride) {
        int ji = 0;
        for (int k = 1; k < JT.n; ++k) if (t >= JT.j[k].tile0) ji = k;
        const Job& q = JT.j[ji];
        const int lt = t - q.tile0, nTn = q.N / 64, k0 = (lt / nTn) * 64, n0 = (lt % nTn) * 64;
        const float* src = sel_in(a, q.in_idx) + (size_t)q.src_off + (size_t)k0 * q.lds + n0;
        __syncthreads();
#pragma unroll
        for (int p = 0; p < 2; ++p) { const int kk = (tid >> 4) + 32 * p, nn = (tid & 15) * 4;
            const f32x4 v = *(const f32x4*)(src + (size_t)kk * q.lds + nn);
            tile[kk * 65 + nn] = v[0]; tile[kk * 65 + nn + 1] = v[1]; tile[kk * 65 + nn + 2] = v[2]; tile[kk * 65 + nn + 3] = v[3]; }
        __syncthreads();
        const int n = tid >> 3, k8 = (tid & 7) * 8, ng = n0 + n;
        const int drow = (ng / q.G) * q.GS + (ng % q.G) + q.R0;
        u32x4 w;
        w.x = cvt_pk_bf16(tile[(k8 + 0) * 65 + n], tile[(k8 + 1) * 65 + n]); w.y = cvt_pk_bf16(tile[(k8 + 2) * 65 + n], tile[(k8 + 3) * 65 + n]);
        w.z = cvt_pk_bf16(tile[(k8 + 4) * 65 + n], tile[(k8 + 5) * 65 + n]); w.w = cvt_pk_bf16(tile[(k8 + 6) * 65 + n], tile[(k8 + 7) * 65 + n]);
        *(u32x4*)((bf16_t*)(a.ws + q.dst_off) + (size_t)drow * q.ldd + q.kcol0 + k0 + k8) = w;
    }
}

__device__ __forceinline__ int opaque(int v) { asm volatile("" : "+v"(v)); return v; }
struct RowV { f32x4 v[4]; };
__device__ __forceinline__ RowV row_load(const float* p, int lane) { RowV r;
#pragma unroll
    for (int i = 0; i < 4; ++i) r.v[i] = *(const f32x4*)(p + 256 * i + 4 * lane); return r; }
__device__ __forceinline__ void row_store(float* p, int lane, const RowV& r) {
#pragma unroll
    for (int i = 0; i < 4; ++i) *(f32x4*)(p + 256 * i + 4 * lane) = r.v[i]; }
__device__ __forceinline__ void row_store_bf16(bf16_t* p, int lane, const RowV& r) {
#pragma unroll
    for (int i = 0; i < 4; ++i) { u32x2 w; w.x = cvt_pk_bf16(r.v[i][0], r.v[i][1]); w.y = cvt_pk_bf16(r.v[i][2], r.v[i][3]); *(u32x2*)(p + 256 * i + 4 * lane) = w; } }
__device__ __forceinline__ RowV row_norm(const RowV& x) {
    float s = 0.f;
#pragma unroll
    for (int i = 0; i < 4; ++i) s += (x.v[i][0] + x.v[i][1]) + (x.v[i][2] + x.v[i][3]);
    const float mu = wave_sum(s) * (1.f / D);
    RowV d; float q = 0.f;
#pragma unroll
    for (int i = 0; i < 4; ++i) { d.v[i] = x.v[i] - mu; q += (d.v[i][0] * d.v[i][0] + d.v[i][1] * d.v[i][1]) + (d.v[i][2] * d.v[i][2] + d.v[i][3] * d.v[i][3]); }
    const float rs = rsqrtf(wave_sum(q) * (1.f / D) + 1e-5f);
#pragma unroll
    for (int i = 0; i < 4; ++i) d.v[i] = d.v[i] * rs;
    return d;
}
__device__ __forceinline__ RowV row_affine(const RowV& n, const float* g, const float* b, int lane) {
    RowV o;
#pragma unroll
    for (int i = 0; i < 4; ++i) o.v[i] = n.v[i] * *(const f32x4*)(g + 256 * i + 4 * lane) + *(const f32x4*)(b + 256 * i + 4 * lane);
    return o;
}
__device__ __forceinline__ RowV row_modulate(const RowV& n, const float* sh, const float* sc, int lane) {
    RowV o;
#pragma unroll
    for (int i = 0; i < 4; ++i) o.v[i] = n.v[i] * (*(const f32x4*)(sc + 256 * i + 4 * lane) + 1.0f) + *(const f32x4*)(sh + 256 * i + 4 * lane);
    return o;
}

constexpr int LDS_BYTES = 159744;
constexpr int MISC_OFF = 159488;
constexpr int NPH_LAYER = 16;
#ifndef SPLIT
#define SPLIT 0
#endif

__global__ void __launch_bounds__(512, 2) mk_fwd(Args a) {
    extern __shared__ __attribute__((aligned(16))) unsigned char shm[];
    LAS unsigned char* lds = (LAS unsigned char*)shm;
    volatile LAS unsigned* MISC = (volatile LAS unsigned*)(lds + MISC_OFF);
    const int tid0 = threadIdx.x, wave = __builtin_amdgcn_readfirstlane(tid0 >> 6);
    const int G = gridDim.x, bid = blockIdx.x;
    if (tid0 < (LDS_BYTES - MISC_OFF) / 4) MISC[tid0] = 0u;
    __syncthreads();
    unsigned char* ws = a.ws;
    unsigned* ctl = (unsigned*)(ws + WS_CTL);
    XcdBarrier bar = xcd_barrier_post(ctl + CW_BAR + a.bar_region * XCD_BAR_WORDS, MISC + 8);
    const int lo = a.ph_lo, hi = a.ph_hi;
#ifndef PHMASK
#define PHMASK 0xFFFF
#endif
#define IN(k) (lo <= (k) && (k) < hi)
#define SEAM(k) do { if (lo <= (k) && (k) + 1 < hi) xcd_barrier(bar); } while (0)
    float* MOD = (float*)(ws + WS_MOD);
    bf16_t* UB = (bf16_t*)(ws + WS_UB); bf16_t* PR = (bf16_t*)(ws + WS_PR); bf16_t* PT = (bf16_t*)(ws + WS_PT); bf16_t* YB = (bf16_t*)(ws + WS_YB);
    float* PRE = (float*)(ws + WS_PRE); float* XSC = (float*)(ws + WS_XSC);
    const float* x_in = a.in[0]; const float* ctx_in = a.in[2];

    if (((PHMASK >> 0) & 1) && IN(0)) {
        const int tid = opaque(tid0), lane = tid & 63;
        convert_tiles(a, JT_SMALL, (LAS float*)lds, bid, G);
        __syncthreads();
        LAS float* sc = (LAS float*)lds;
        for (int i = tid; i < 5 * 1024; i += 512) { const int r = i >> 10, k = i & 1023; sc[i] = silu_acc(r < 4 ? a.in[1][r * 1024 + k] : a.in[3][k]); }
        __syncthreads();
        for (int u = bid; u < 2 * 96 * 8; u += G) {
            const int l = u / (96 * 8), rem = u % (96 * 8), cg = rem / 8, ks = rem % 8;
            const int n = cg * 64 + lane;
            const float* w = a.in[4] + (size_t)l * 1024 * 6144 + n;
            float a0 = 0, a1 = 0, a2 = 0, a3 = 0, a4 = 0;
            const int kb = ks * 128 + wave * 16;
#pragma unroll 4
            for (int k = kb; k < kb + 16; ++k) { const float wv = w[(size_t)k * 6144]; a0 += sc[k] * wv; a1 += sc[1024 + k] * wv; a2 += sc[2048 + k] * wv; a3 += sc[3072 + k] * wv; a4 += sc[4096 + k] * wv; }
            if (ks == 0 && wave == 0) { const float bb = a.in[5][l * 6144 + n]; a0 += bb; a1 += bb; a2 += bb; a3 += bb; a4 += bb; }
            float* o = MOD + (size_t)l * 5 * 6144 + n;
            atomicAdd(o, a0); atomicAdd(o + 6144, a1); atomicAdd(o + 2 * 6144, a2); atomicAdd(o + 3 * 6144, a3); atomicAdd(o + 4 * 6144, a4);
        }
        __syncthreads();
        for (int u = bid; u < 132; u += G) {
            const bool isc = u >= 128; const int l = isc ? 0 : (u >> 6), blk = isc ? u - 128 : (u & 63), L = isc ? CTXL : SEQ, t0 = blk * 64;
            LAS float* feat = (LAS float*)lds;
            LAS float* h1 = feat + 64 * 33;
            LAS float* h2 = h1 + 4096;
            const float* w1 = a.in[16] + l * 33 * 64; const float* b1 = a.in[17] + l * 64; const float* w2 = a.in[18] + l * 4096; const float* b2 = a.in[19] + l * 64;
            const float* w3 = a.in[20] + (size_t)l * 65536; const float* b3 = a.in[21] + l * 1024; const float* fq = a.in[22] + l * 64;
            __syncthreads();
            for (int i = tid; i < 64 * 33; i += 512) { const int tt = i / 33, f = i - tt * 33, t = t0 + tt; float v;
                if (f == 0) v = (float)t / (float)L;
                else { const int band = (f - 1) % 16 + 1; const int m = (int)(((long)t * band) % L); const double ang = 2.0 * M_PI * (double)m / (double)L; v = f <= 16 ? (float)cos(ang) : (float)sin(ang); }
                feat[i] = v; }
            __syncthreads();
            for (int i = tid; i < 4096; i += 512) { const int tt = i >> 6, j = i & 63; float sacc = b1[j];
                for (int f = 0; f < 33; ++f) sacc += feat[tt * 33 + f] * w1[f * 64 + j];
                h1[i] = sinf(fq[j] * sacc); }
            __syncthreads();
            for (int i = tid; i < 4096; i += 512) { const int tt = i >> 6, j = i & 63; float sacc = b2[j];
                for (int f = 0; f < 64; ++f) sacc += h1[tt * 64 + f] * w2[f * 64 + j];
                h2[i] = sinf(fq[j] * sacc); }
            __syncthreads();
            const float dmin = 3.0701134573253945f, dmax = 15.350567286626973f;
#pragma unroll 1
            for (int jj = 0; jj < 2; ++jj) {
                const int n = tid + 512 * jj, dir = n >> 9, o = (n >> 8) & 1, c = n & 255;
                float wc[64];
#pragma unroll
                for (int i = 0; i < 64; ++i) wc[i] = w3[i * 1024 + n];
                const float bb = b3[n], delta = dmin + (dmax - dmin) * (float)c / 255.0f;
                bf16_t* dst = isc ? (bf16_t*)(ws + WS_KFC) + ((size_t)(dir * 2 + o) * 256 + c) * CTXL + t0 : (bf16_t*)(ws + WS_KFL) + ((size_t)((l * 2 + dir) * 2 + o) * 256 + c) * SEQ + t0;
                float asum = 0.f;
#pragma unroll 1
                for (int tg = 0; tg < 8; ++tg) {
                    float v[8];
#pragma unroll
                    for (int q = 0; q < 8; ++q) { float sacc = bb; const LAS float* hp = h2 + (tg * 8 + q) * 64;
#pragma unroll
                        for (int i = 0; i < 64; ++i) sacc += hp[i] * wc[i];
                        const int t = t0 + tg * 8 + q;
                        v[q] = sacc * expf(-((float)t / (float)L) * delta);
                        if (!(dir == 1 && t == 0)) asum += fabsf(v[q]); }
                    u32x4 w; w.x = cvt_pk_bf16(v[0], v[1]); w.y = cvt_pk_bf16(v[2], v[3]); w.z = cvt_pk_bf16(v[4], v[5]); w.w = cvt_pk_bf16(v[6], v[7]);
                    *(u32x4*)(dst + tg * 8) = w;
                }
                atomicAdd((float*)(ctl + CW_HYN) + (isc ? 1024 + o * 256 + c : (l * 2 + o) * 256 + c), asum);
            }
        }
        __syncthreads();
        for (int u = bid; u < 32; u += G) {
            const int l = u >> 4, g = u & 15;
            LAS float* PW = (LAS float*)lds;
            LAS float* BBs = PW + 2 * 64 * 17 * 2;
            LAS float* Cs = BBs + 2 * 64 * 16 * 2;
            LAS float* KT = Cs + 2 * 16 * 64 * 2;
            __syncthreads();
            if (tid < 128) {
                const int d = tid >> 6, p = tid & 63, idx = l * 2048 + (d * 16 + g) * 64 + p;
                const double ar = a.in[25][idx], ai = a.in[26][idx], dt = exp((double)a.in[27][l * 32 + d * 16 + g]);
                const double mag = exp(dt * ar), abr = mag * cos(dt * ai), abi = mag * sin(dt * ai), den = ar * ar + ai * ai;
                const double fr = ((abr - 1.0) * ar + abi * ai) / den, fi = (abi * ar - (abr - 1.0) * ai) / den;
                double pr = 1.0, pi = 0.0;
                for (int k = 0; k <= 16; ++k) { PW[((d * 64 + p) * 17 + k) * 2] = (float)pr; PW[((d * 64 + p) * 17 + k) * 2 + 1] = (float)pi; const double nr = pr * abr - pi * abi, ni = pr * abi + pi * abr; pr = nr; pi = ni; }
                float* a16 = (float*)(ws + WS_AB16) + ((size_t)((l * 2 + d) * 16 + g) * 64 + p) * 2;
                a16[0] = PW[((d * 64 + p) * 17 + 16) * 2]; a16[1] = PW[((d * 64 + p) * 17 + 16) * 2 + 1];
                for (int i = 0; i < 16; ++i) { const double br = a.in[28][(size_t)idx * 16 + i], bi = a.in[29][(size_t)idx * 16 + i];
                    BBs[((d * 64 + p) * 16 + i) * 2] = (float)(fr * br - fi * bi); BBs[((d * 64 + p) * 16 + i) * 2 + 1] = (float)(fr * bi + fi * br); }
            }
            for (int i = tid; i < 2048; i += 512) { const int d = i >> 10, o = (i >> 6) & 15, p = i & 63; const size_t ci = (size_t)l * 32768 + ((size_t)(d * 16 + g) * 16 + o) * 64 + p;
                Cs[i * 2] = a.in[30][ci]; Cs[i * 2 + 1] = a.in[31][ci]; }
            __syncthreads();
            for (int e = tid; e < 8192; e += 512) { const int d = e >> 12, k = (e >> 8) & 15, o = (e >> 4) & 15, i = e & 15;
                float acc = 0.f;
                for (int p = 0; p < 64; ++p) { const float cr = Cs[((d * 16 + o) * 64 + p) * 2], ci = Cs[((d * 16 + o) * 64 + p) * 2 + 1], pr = PW[((d * 64 + p) * 17 + k) * 2], pi = PW[((d * 64 + p) * 17 + k) * 2 + 1];
                    const float tr = cr * pr - ci * pi, ti = cr * pi + ci * pr;
                    acc += tr * BBs[((d * 64 + p) * 16 + i) * 2] - ti * BBs[((d * 64 + p) * 16 + i) * 2 + 1]; }
                KT[e] = acc; }
            __syncthreads();
            bf16_t* OPS = (bf16_t*)(ws + WS_OPS) + (size_t)(l * 16 + g) * 256 * 256;
            bf16_t* OPY = (bf16_t*)(ws + WS_OPY) + (size_t)(l * 16 + g) * 256 * 512;
            for (int e = tid; e < 256 * 32; e += 512) {
                const int row = e >> 5, c0 = (e & 31) * 8, d = row >> 7, p = (row >> 1) & 63, ri = row & 1, sx = c0 >> 4, i0 = c0 & 15, k = d == 0 ? 15 - sx : sx;
                const float pr = PW[((d * 64 + p) * 17 + k) * 2], pi = PW[((d * 64 + p) * 17 + k) * 2 + 1];
                float v[8];
#pragma unroll
                for (int j = 0; j < 8; ++j) { const float br = BBs[((d * 64 + p) * 16 + i0 + j) * 2], bi = BBs[((d * 64 + p) * 16 + i0 + j) * 2 + 1]; v[j] = ri == 0 ? pr * br - pi * bi : pr * bi + pi * br; }
                u32x4 w; w.x = cvt_pk_bf16(v[0], v[1]); w.y = cvt_pk_bf16(v[2], v[3]); w.z = cvt_pk_bf16(v[4], v[5]); w.w = cvt_pk_bf16(v[6], v[7]);
                *(u32x4*)(OPS + (size_t)row * 256 + c0) = w; }
            for (int e = tid; e < 256 * 64; e += 512) {
                const int row = e >> 6, c0 = (e & 63) * 8, t = row >> 4, o = row & 15;
                float v[8];
                if (c0 < 256) { const int sx = c0 >> 4, i0 = c0 & 15;
#pragma unroll
                    for (int j = 0; j < 8; ++j) { float x = 0.f; if (sx <= t) x += KT[((0 * 16 + (t - sx)) * 16 + o) * 16 + i0 + j]; if (sx >= t) x += KT[((1 * 16 + (sx - t)) * 16 + o) * 16 + i0 + j]; v[j] = x; } }
                else { const int c2 = c0 - 256, d = c2 >> 7, k = d == 0 ? t + 1 : 16 - t;
#pragma unroll
                    for (int j = 0; j < 8; ++j) { const int p = ((c2 + j) >> 1) & 63, ri = (c2 + j) & 1;
                        const float cr = Cs[((d * 16 + o) * 64 + p) * 2], ci = Cs[((d * 16 + o) * 64 + p) * 2 + 1], pr = PW[((d * 64 + p) * 17 + k) * 2], pi = PW[((d * 64 + p) * 17 + k) * 2 + 1];
                        v[j] = ri == 0 ? cr * pr - ci * pi : -(cr * pi + ci * pr); } }
                u32x4 w; w.x = cvt_pk_bf16(v[0], v[1]); w.y = cvt_pk_bf16(v[2], v[3]); w.z = cvt_pk_bf16(v[4], v[5]); w.w = cvt_pk_bf16(v[6], v[7]);
                *(u32x4*)(OPY + (size_t)row * 512 + c0) = w; }
        }
        __syncthreads();
    }
    SEAM(0);

    for (int l = 0; l < 2; ++l) {
        const int P0 = 1 + l * NPH_LAYER;
        const float* MODL = MOD + (size_t)l * 5 * 6144;
        const unsigned char* WL = ws + WS_WL + (size_t)l * SZ_WL;
        const int nMrow = (l == 0) ? 68 : 64;
        const float* xlat = (l == 0) ? x_in : a.out; const float* xctx = (l == 0) ? ctx_in : XSC;

        if (((PHMASK >> 1) & 1) && l == 0 && IN(P0 + 0)) {
            const int lane = opaque(tid0) & 63;
            for (int r = bid * 8 + wave; r < RT; r += G * 8) {
                const float* src = r < RL ? x_in + (size_t)r * D : ctx_in + (size_t)(r - RL) * D;
                const float* mv = MODL + (size_t)(r < RL ? (r >> 12) : 4) * 6144;
                const RowV n = row_norm(row_load(src, lane));
                row_store_bf16(UB + (size_t)r * D, lane, row_modulate(n, mv, mv + 1024, lane));
            }
        }
        if (l == 0) SEAM(P0 + 0);

        if (((PHMASK >> 2) & 1) && IN(P0 + 1)) {
            const pg8::TabSched S{PARTS.p + l * 8, (const char*)ws, 2, 68 * 23 + 5 * 68, G, bid};
            pg8::EpiProj E{PR, PT, (bf16_t*)(ws + WS_US), 7};
            pg8::gemm_phase<1024, 1024>(lds, S, E);
        }
        SEAM(P0 + 1);
        if (((PHMASK >> 13) & 1) && IN(P0 + 2)) {
            const int tid = opaque(tid0), lane = tid & 63;
            LAS float* rp = (LAS float*)lds;
            for (int i = tid; i < 6 * 465; i += 512) rp[i] = a.in[24][l * 2790 + i];
            __syncthreads();
            const int qn = lane & 15, g = lane >> 4;
            const int nunits = 6144 + (l == 0 ? 384 : 0);
            for (int u = bid * 8 + wave; u < nunits; u += G * 8) {
                const bool lat = u < 6144;
                const int uu = lat ? u : u - 6144;
                const int h = uu % 6; int t = uu / 6;
                int b, r = 0, qb, tq, rs = 0, bs = 0, w = 0, cs = 0;
                if (lat) { qb = t & 3; t >>= 2; r = t & 63; b = t >> 6; rs = r - 4 < 0 ? 0 : (r - 4 > 56 ? 56 : r - 4); bs = qb == 0 ? 0 : (qb == 1 ? 8 : (qb == 2 ? 24 : 32));
                    w = 16 * qb + qn; cs = w - 8 < 0 ? 0 : (w - 8 > 48 ? 48 : w - 8); tq = b * SEQ + r * 64 + w; }
                else { qb = t & 15; b = t >> 4; tq = RL + b * CTXL + 16 * qb + qn; }
                const bf16_t* qp = PR + (size_t)tq * LDP + PC_Q + h * 64 + 8 * g;
                const bf16x8 q0 = *(const bf16x8*)qp, q1 = *(const bf16x8*)(qp + 32);
                f32x4 S[32];
                if (lat) {
#pragma unroll
                    for (int p = 0; p < 8; ++p) {
                        const int base = b * SEQ + (rs + p) * 64 + bs;
#pragma unroll
                        for (int hf = 0; hf < 2; ++hf) {
                            const bf16_t* kp = PR + (size_t)(base + 8 * (qn >> 2) + (qn & 3) + 4 * hf) * LDP + PC_K + h * 64 + 8 * g;
                            const bf16x8 k0 = *(const bf16x8*)kp, k1 = *(const bf16x8*)(kp + 32);
                            f32x4 acc = {0.f, 0.f, 0.f, 0.f};
                            acc = __builtin_amdgcn_mfma_f32_16x16x32_bf16(k0, q0, acc, 0, 0, 0);
                            acc = __builtin_amdgcn_mfma_f32_16x16x32_bf16(k1, q1, acc, 0, 0, 0);
                            const int rowoff = (h * 15 + (rs + p - r + 7)) * 31;
#pragma unroll
                            for (int j = 0; j < 4; ++j) { const int c = bs + 8 * g + 4 * hf + j; const bool ok = (c >= cs) && (c < cs + 16);
                                const int dc = ok ? c - w + 15 : 0;
                                acc[j] = ok ? acc[j] * 0.125f + rp[rowoff + dc] : -3.0e38f; }
                            S[2 * p + hf] = acc;
                        }
                    }
                } else {
#pragma unroll
                    for (int p = 0; p < 16; ++p) S[p] = (f32x4){-3.0e38f, -3.0e38f, -3.0e38f, -3.0e38f};
                }
#pragma unroll
                for (int p = 0; p < 8; ++p) {
                    const int base = RL + b * CTXL + 32 * p;
#pragma unroll
                    for (int hf = 0; hf < 2; ++hf) {
                        const bf16_t* kp = PR + (size_t)(base + 8 * (qn >> 2) + (qn & 3) + 4 * hf) * LDP + PC_K + h * 64 + 8 * g;
                        const bf16x8 k0 = *(const bf16x8*)kp, k1 = *(const bf16x8*)(kp + 32);
                        f32x4 acc = {0.f, 0.f, 0.f, 0.f};
                        acc = __builtin_amdgcn_mfma_f32_16x16x32_bf16(k0, q0, acc, 0, 0, 0);
                        acc = __builtin_amdgcn_mfma_f32_16x16x32_bf16(k1, q1, acc, 0, 0, 0);
                        S[16 + 2 * p + hf] = acc * 0.125f;
                    }
                }
                float mx = -3.0e38f;
#pragma unroll
                for (int i = 0; i < 32; ++i) mx = fmaxf(fmaxf(mx, fmaxf(S[i][0], S[i][1])), fmaxf(S[i][2], S[i][3]));
                mx = fmaxf(mx, __shfl_xor(mx, 16)); mx = fmaxf(mx, __shfl_xor(mx, 32));
                float sum = 0.f;
#pragma unroll
                for (int i = 0; i < 32; ++i) {
#pragma unroll
                    for (int j = 0; j < 4; ++j) { const float e = __expf(S[i][j] - mx); S[i][j] = e; sum += e; } }
                sum += __shfl_xor(sum, 16); sum += __shfl_xor(sum, 32);
                const float inv = 1.0f / sum;
                f32x4 O[4];
#pragma unroll
                for (int dt = 0; dt < 4; ++dt) O[dt] = (f32x4){0.f, 0.f, 0.f, 0.f};
                const bf16_t* vt = PT + (size_t)(PT_V + h * 64 + qn) * RT + 8 * g;
#pragma unroll
                for (int p = 0; p < 16; ++p) {
                    if (p < 8 && !lat) continue;
                    const int base = p < 8 ? b * SEQ + (rs + p) * 64 + bs : RL + b * CTXL + 32 * (p - 8);
                    u32x4 pw; pw.x = cvt_pk_bf16(S[2 * p][0], S[2 * p][1]); pw.y = cvt_pk_bf16(S[2 * p][2], S[2 * p][3]); pw.z = cvt_pk_bf16(S[2 * p + 1][0], S[2 * p + 1][1]); pw.w = cvt_pk_bf16(S[2 * p + 1][2], S[2 * p + 1][3]);
                    bf16x8 pf; __builtin_memcpy(&pf, &pw, 16);
#pragma unroll
                    for (int dt = 0; dt < 4; ++dt) { const bf16x8 vf = *(const bf16x8*)(vt + (size_t)(16 * dt) * RT + base);
                        O[dt] = __builtin_amdgcn_mfma_f32_16x16x32_bf16(vf, pf, O[dt], 0, 0, 0); }
                }
                bf16_t* op = YB + (size_t)tq * YW + YC_C + h * 64 + 4 * g;
#pragma unroll
                for (int dt = 0; dt < 4; ++dt) { u32x2 o2; o2.x = cvt_pk_bf16(O[dt][0] * inv, O[dt][1] * inv); o2.y = cvt_pk_bf16(O[dt][2] * inv, O[dt][3] * inv); *(u32x2*)(op + 16 * dt) = o2; }
            }
            __syncthreads();
            {
                const int tid = opaque(tid0), lane = tid & 63;
                LAS float* XC = (LAS float*)lds;
                LAS f32x2* AB = (LAS f32x2*)(lds + 16 * 384 * 4);
                const float* cw = a.in[7] + l * 4 * 384; const float* cb = a.in[8] + l * 384;
                const bf16_t* LW = (const bf16_t*)(ws + WS_LW) + (size_t)l * 24 * 4096;
                bf16_t* LT = (bf16_t*)(ws + WS_LT); f32x2* LAGG = (f32x2*)(ws + WS_LAGG);
                const int dir = (wave >> 2) & 1, ntile = wave & 3, tk = lane & 15, kg = lane >> 4;
                for (int n = bid; n < NCHK; n += G) {
                    const int r0 = 16 * n; int start, len, pos0, bb; row_seq(r0, start, len, pos0, bb);
                    __syncthreads();
#pragma unroll
                    for (int i = 0; i < 12; ++i) { const int idx = tid + 512 * i, tok = idx / 384, ch = idx - tok * 384, pos = pos0 + tok;
                        const bf16_t* pr = PR + (size_t)(r0 + tok) * LDP + PC_AC + ch;
                        float xc = cb[ch] + cw[2 * 384 + ch] * bf2f(pr[0]);
                        if (pos >= 2) xc += cw[ch] * bf2f(pr[-2 * LDP]);
                        if (pos >= 1) xc += cw[384 + ch] * bf2f(pr[-LDP]);
                        if (pos + 1 < len) xc += cw[3 * 384 + ch] * bf2f(pr[LDP]);
                        XC[idx] = xc; }
                    __syncthreads();
#pragma unroll 1
                    for (int g = 0; g < 6; ++g) {
                        f32x4 ar = {0.f, 0.f, 0.f, 0.f}, ai = {0.f, 0.f, 0.f, 0.f};
#pragma unroll
                        for (int ks = 0; ks < 2; ++ks) {
                            const LAS float* xp = XC + tk * 384 + g * 64 + 32 * ks + 8 * kg;
                            const f32x4 x0 = *(const LAS f32x4*)xp, x1 = *(const LAS f32x4*)(xp + 4);
                            u32x4 xw; xw.x = cvt_pk_bf16(x0[0], x0[1]); xw.y = cvt_pk_bf16(x0[2], x0[3]); xw.z = cvt_pk_bf16(x1[0], x1[1]); xw.w = cvt_pk_bf16(x1[2], x1[3]);
                            bf16x8 xf; __builtin_memcpy(&xf, &xw, 16);
                            const bf16_t* wp = LW + ((size_t)((dir * 2 + 0) * 6 + g) * 64 + 16 * ntile + tk) * 64 + 32 * ks + 8 * kg;
                            const bf16x8 wr8 = *(const bf16x8*)wp, wi8 = *(const bf16x8*)(wp + 6 * 4096);
                            ar = __builtin_amdgcn_mfma_f32_16x16x32_bf16(xf, wr8, ar, 0, 0, 0);
                            ai = __builtin_amdgcn_mfma_f32_16x16x32_bf16(xf, wi8, ai, 0, 0, 0);
                        }
                        const int ch = g * 64 + 16 * ntile + tk;
                        const float br = a.in[10][l * 768 + dir * 384 + ch], bi = a.in[12][l * 768 + dir * 384 + ch], sp = softplus(-a.in[13][l * 768 + dir * 384 + ch]);
#pragma unroll
                        for (int j = 0; j < 4; ++j) { const int tok = 4 * kg + j;
                            const float la = -8.0f * sigm_acc(ar[j] + br) * sp;
                            const float av = expf(la), bt = sqrtf(-expm1f(2.0f * la)) * sigm_acc(ai[j] + bi) * XC[tok * 384 + ch];
                            AB[(dir * 16 + tok) * 384 + ch] = (f32x2){av, bt}; }
                    }
                    __syncthreads();
                    if (tid < 384) {
                        float hf = 0.f, pf = 1.f, hb = 0.f, pb = 1.f;
#pragma unroll
                        for (int t = 0; t < 16; ++t) {
                            const f32x2 f = AB[t * 384 + tid], bk = AB[(16 + 15 - t) * 384 + tid];
                            hf = f[0] * hf + f[1]; pf *= f[0]; hb = bk[0] * hb + bk[1]; pb *= bk[0];
                            AB[t * 384 + tid] = (f32x2){pf, hf}; AB[(16 + 15 - t) * 384 + tid] = (f32x2){pb, hb}; }
                        LAGG[((size_t)n * 2 + 0) * 384 + tid] = (f32x2){pf, hf}; LAGG[((size_t)n * 2 + 1) * 384 + tid] = (f32x2){pb, hb};
                    }
                    __syncthreads();
#pragma unroll
                    for (int i = 0; i < 12; ++i) { const int idx = tid + 512 * i, tok = idx / 384, ch = idx - tok * 384;
                        const f32x2 f = AB[idx], bk = AB[16 * 384 + idx];
                        bf16_t* o = LT + (size_t)(r0 + tok) * 1152 + ch;
                        o[0] = f2bf(f[1] + bk[1]); o[384] = f2bf(f[0]); o[768] = f2bf(bk[0]); }
                }
                __syncthreads();
            }
            {
                const int tid = opaque(tid0), lane = tid & 63;
                constexpr int ZS = SEQ + 16;
                LAS bf16_t* R0 = (LAS bf16_t*)lds;
                LAS bf16_t* R1 = R0 + 8224;
                LAS bf16_t* ZA = R1 + 8224;
                const LAS unsigned* Rdw = (const LAS unsigned*)lds;
#define HY_ZF(b, s) ((b) * ZS + ((s) & ~63) + (((((s) >> 3) & 7) ^ (((s) >> 7) & 1)) << 3) + ((s) & 7))
                const float* hcw = a.in[14] + l * 3 * 768; const float* hcb = a.in[15] + l * 768;
                const float* nrm = (const float*)(ctl + CW_HYN);
                bf16_t* YT = (bf16_t*)(ws + WS_YT);
                const int r32 = lane & 31, hh = lane >> 5, il = r32 >> 2, bq = r32 & 3, iblk = 8 * wave + il;
                const int x0b = 4095 - r32 + 8 * hh, par = x0b & 1;
                const int abase = (par ? 4112 : 0) + ((x0b - par) >> 1);
                for (int c = bid; c < 256; c += G) {
                    __syncthreads();
#pragma unroll 1
                    for (int it = tid; it < 3 * 4 * 512; it += 512) {
                        const int arr = it >> 11, b = (it >> 9) & 3, s8 = (it & 511) * 8, ch = arr * 256 + c;
                        const bf16_t* pp = PT + (size_t)ch * RT + b * SEQ + s8;
                        const u32x4 pv = *(const u32x4*)pp;
                        const float w0 = hcw[ch], w1 = hcw[768 + ch], w2 = hcw[1536 + ch], cb0 = hcb[ch];
                        float p[10];
                        p[0] = s8 > 0 ? bf2f(pp[-1]) : 0.f; p[9] = s8 + 8 < SEQ ? bf2f(pp[8]) : 0.f;
                        p[1] = bflo(pv.x); p[2] = bfhi(pv.x); p[3] = bflo(pv.y); p[4] = bfhi(pv.y); p[5] = bflo(pv.z); p[6] = bfhi(pv.z); p[7] = bflo(pv.w); p[8] = bfhi(pv.w);
                        float z[8];
#pragma unroll
                        for (int j = 0; j < 8; ++j) z[j] = cb0 + w0 * p[j] + w1 * p[j + 1] + w2 * p[j + 2];
                        u32x4 w; w.x = cvt_pk_bf16(z[0], z[1]); w.y = cvt_pk_bf16(z[2], z[3]); w.z = cvt_pk_bf16(z[4], z[5]); w.w = cvt_pk_bf16(z[6], z[7]);
                        *(LAS u32x4*)(ZA + arr * 4 * ZS + HY_ZF(b, s8)) = w;
                    }
#pragma unroll 1
                    for (int o = 0; o < 2; ++o) {
                        const bf16_t* kf = (const bf16_t*)(ws + WS_KFL) + ((size_t)((l * 2 + 0) * 2 + o) * 256 + c) * SEQ;
                        const bf16_t* kb = (const bf16_t*)(ws + WS_KFL) + ((size_t)((l * 2 + 1) * 2 + o) * 256 + c) * SEQ;
                        for (int x = tid; x < 8192; x += 512) R0[x] = x < 4096 ? kf[4095 - x] : (x <= 8190 ? kb[x - 4095] : (bf16_t)0);
                        __syncthreads();
                        for (int x = tid; x < 8192; x += 512) R1[x] = x < 8191 ? R0[x + 1] : (bf16_t)0;
                        __syncthreads();
                        const LAS bf16_t* Z = ZA + (o == 0 ? 0 : 4 * ZS) + bq * ZS;
                        typedef float f32x16 __attribute__((ext_vector_type(16)));
                        f32x16 acc0, acc1;
#pragma unroll
                        for (int q = 0; q < 16; ++q) { acc0[q] = 0.f; acc1[q] = 0.f; }
                        const int dlo = 8 * wave - 63, dhi = 8 * wave + 7;
#pragma unroll 1
                        for (int dl = dlo; dl <= dhi; ++dl) {
                            const int j = iblk - dl; const bool ok = (j >= 0) && (j < 64); const int jc = j < 0 ? 0 : (j > 63 ? 63 : j);
                            const LAS bf16_t* zp = Z + jc * 64; const int sw = (jc >> 1) & 1;
                            const LAS unsigned* ap = Rdw + abase - 32 * dl;
                            bf16x8 bf[4];
#pragma unroll
                            for (int kk = 0; kk < 4; ++kk) { bf16x8 t = *(const LAS bf16x8*)(zp + (((2 * kk + hh) ^ sw) << 3)); bf[kk] = ok ? t : (bf16x8){0, 0, 0, 0, 0, 0, 0, 0}; }
#pragma unroll
                            for (int kk = 0; kk < 4; ++kk) {
                                const LAS unsigned* a0 = ap + 8 * kk; const LAS unsigned* a1 = ap - 16 + 8 * kk;
                                u32x4 w0 = {a0[0], a0[1], a0[2], a0[3]}, w1 = {a1[0], a1[1], a1[2], a1[3]};
                                bf16x8 f0, f1; __builtin_memcpy(&f0, &w0, 16); __builtin_memcpy(&f1, &w1, 16);
                                acc0 = __builtin_amdgcn_mfma_f32_32x32x16_bf16(f0, bf[kk], acc0, 0, 0, 0);
                                acc1 = __builtin_amdgcn_mfma_f32_32x32x16_bf16(f1, bf[kk], acc1, 0, 0, 0);
                            }
                        }
                        const float inv = 1.0f / (nrm[(l * 2 + o) * 256 + c] + 1e-6f), hb = a.in[23][(l * 2 + o) * 256 + c];
                        LAS bf16_t* GI = ZA + (o + 1) * 4 * ZS;
                        const LAS bf16_t* ZI = ZA + (o == 0 ? 0 : 4 * ZS);
#pragma unroll
                        for (int q = 0; q < 16; ++q) {
                            const int a0r = (q & 3) + 8 * (q >> 2) + 4 * hh, t0 = 64 * iblk + a0r, t1 = t0 + 32;
                            const int i0 = HY_ZF(bq, t0), i1 = HY_ZF(bq, t1);
                            const float zv0 = bf2f(ZI[i0]), zv1 = bf2f(ZI[i1]);
                            const float y0 = bf2f(GI[i0]) * (acc0[q] * inv + hb * zv0), y1v = bf2f(GI[i1]) * (acc1[q] * inv + hb * zv1);
                            GI[i0] = f2bf(y0); GI[i1] = f2bf(y1v);
                        }
                        __syncthreads();
                    }
                    for (int it = tid; it < 4 * 512; it += 512) { const int b = it >> 9, s8 = (it & 511) * 8;
                        *(u32x4*)(YT + (size_t)c * RT + b * SEQ + s8) = *(const LAS u32x4*)(ZA + 2 * 4 * ZS + HY_ZF(b, s8)); }
                    if (l == 0) {
                        __syncthreads();
                        LAS float* zc = (LAS float*)lds;
                        LAS float* kc = zc + 3072;
                        LAS float* y1c = kc + 1024;
                        for (int it = tid; it < 3072; it += 512) { const int arr = it >> 10, b = (it >> 8) & 3, sx = it & 255, ch = arr * 256 + c;
                            const bf16_t* pp = PT + (size_t)ch * RT + RL + b * CTXL + sx;
                            float z = hcb[ch] + hcw[768 + ch] * bf2f(pp[0]); if (sx > 0) z += hcw[ch] * bf2f(pp[-1]); if (sx + 1 < CTXL) z += hcw[1536 + ch] * bf2f(pp[1]);
                            zc[it] = z; }
                        for (int it = tid; it < 1024; it += 512) { const int o = it >> 9, dir = (it >> 8) & 1, tt = it & 255; kc[it] = bf2f(((const bf16_t*)(ws + WS_KFC))[((size_t)(dir * 2 + o) * 256 + c) * CTXL + tt]); }
                        __syncthreads();
#pragma unroll 1
                        for (int o = 0; o < 2; ++o) {
                            const float inv = 1.0f / (nrm[1024 + o * 256 + c] + 1e-6f), hb = a.in[23][o * 256 + c];
                            for (int it = tid; it < 1024; it += 512) { const int b = it >> 8, t = it & 255;
                                const LAS float* zi = o == 0 ? zc + b * 256 : y1c + b * 256;
                                const LAS float* kfc = kc + (o * 2 + 0) * 256; const LAS float* kbc = kc + (o * 2 + 1) * 256;
                                float acc = 0.f;
                                for (int sx = 0; sx <= t; ++sx) acc += kfc[t - sx] * zi[sx];
                                for (int sx = t + 1; sx < CTXL; ++sx) acc += kbc[sx - t] * zi[sx];
                                const float y = zc[(o + 1) * 1024 + b * 256 + t] * (acc * inv + hb * zi[t]);
                                if (o == 0) y1c[it] = y; else YT[(size_t)c * RT + RL + b * CTXL + t] = f2bf(y); }
                            __syncthreads();
                        }
                    }
                }
#undef HY_ZF
                __syncthreads();
            }
            {
                const pg8::TabSched S{PARTS.p + 18 + l * 3, (const char*)ws, 1, 80, G, bid};
                pg8::EpiS5State E{(float*)(ws + WS_S5S)};
                pg8::gemm_phase<512, 256>(lds, S, E);
            }
        }
        SEAM(P0 + 2);
        if (((PHMASK >> 14) & 1) && IN(P0 + 3)) {
            const int tid = opaque(tid0), lane = tid & 63;
            LAS float* st = (LAS float*)lds;
            const float* S5S = (const float*)(ws + WS_S5S); bf16_t* US = (bf16_t*)(ws + WS_US);
            for (int u = bid; u < 128; u += G) {
                const int d = u & 1, g = (u >> 1) & 15, b = u >> 5;
                __syncthreads();
                for (int i = tid; i < 272 * 32; i += 512) { const int q = i >> 5, c4 = (i & 31) * 4; const int n = q < 16 ? 1024 + 16 * b + q : 256 * b + (q - 16);
                    const f32x4 v = *(const f32x4*)(S5S + ((size_t)g * NCHKP + n) * 256 + d * 128 + c4);
                    st[q * 128 + c4] = v[0]; st[q * 128 + c4 + 1] = v[1]; st[q * 128 + c4 + 2] = v[2]; st[q * 128 + c4 + 3] = v[3]; }
                __syncthreads();
                if (wave == 0) {
                    const float* ab = (const float*)(ws + WS_AB16) + ((size_t)((l * 2 + d) * 16 + g) * 64 + lane) * 2;
                    const float ar = ab[0], ai = ab[1];
                    float hr = 0.f, hi = 0.f;
                    for (int k = 0; k < 272; ++k) {
                        const int q = d == 0 ? k : (k < 16 ? 15 - k : 287 - k);
                        const int n = q < 16 ? 1024 + 16 * b + q : 256 * b + (q - 16);
                        *(unsigned*)(US + ((size_t)g * NCHKP + n) * 512 + 256 + d * 128 + 2 * lane) = cvt_pk_bf16(hr, hi);
                        const float sr = st[q * 128 + 2 * lane], si = st[q * 128 + 2 * lane + 1];
                        const float nr = ar * hr - ai * hi + sr, ni = ar * hi + ai * hr + si;
                        hr = nr; hi = ni;
                    }
                }
            }
            __syncthreads();
            for (int u = bid - 128; u >= 0 && u < 48; u += G) {
                const int cb6 = u % 6, d = (u / 6) & 1, b = u / 12;
                LAS f32x2* sa = (LAS f32x2*)lds;
                const f32x2* LAGG = (const f32x2*)(ws + WS_LAGG); float* HIN = (float*)(ws + WS_LHIN);
                __syncthreads();
                for (int i = tid; i < 272 * 64; i += 512) { const int q = i >> 6, c = i & 63; const int n = q < 16 ? 1024 + 16 * b + q : 256 * b + (q - 16);
                    sa[i] = LAGG[((size_t)n * 2 + d) * 384 + cb6 * 64 + c]; }
                __syncthreads();
                if (wave == 0) {
                    float h = 0.f;
                    for (int k = 0; k < 272; ++k) {
                        const int q = d == 0 ? k : (k < 16 ? 15 - k : 287 - k);
                        const int n = q < 16 ? 1024 + 16 * b + q : 256 * b + (q - 16);
                        HIN[((size_t)n * 2 + d) * 384 + cb6 * 64 + lane] = h;
                        const f32x2 v = sa[q * 64 + lane];
                        h = v[0] * h + v[1];
                    }
                }
            }
            __syncthreads();
        }
        SEAM(P0 + 3);
        if (((PHMASK >> 15) & 1) && IN(P0 + 4)) {
            const pg8::TabSched S{PARTS.p + 19 + l * 3, (const char*)ws, 1, 80, G, bid};
            pg8::EpiS5Main E{(bf16_t*)(ws + WS_GL), PR, a.in[32] + l * 256};
            pg8::gemm_phase<512, 512>(lds, S, E);
            {
                const int tid = opaque(tid0);
                const bf16_t* YT = (const bf16_t*)(ws + WS_YT);
                LAS bf16_t* tl = (LAS bf16_t*)lds;
                const int nrt = nMrow * 4;
                for (int t = bid; t < 4 * nrt; t += G) {
                    const int c0 = (t & 3) * 64, r0 = (t >> 2) * 64;
                    __syncthreads();
                    { const int cc = tid >> 3, r8 = (tid & 7) * 8; *(LAS u32x4*)(tl + cc * 72 + r8) = *(const u32x4*)(YT + (size_t)(c0 + cc) * RT + r0 + r8); }
                    __syncthreads();
                    { const int rr = tid >> 3, c8 = (tid & 7) * 8; unsigned short e[8];
#pragma unroll
                        for (int j = 0; j < 8; ++j) e[j] = tl[(c8 + j) * 72 + rr];
                        u32x4 w; w.x = e[0] | ((unsigned)e[1] << 16); w.y = e[2] | ((unsigned)e[3] << 16); w.z = e[4] | ((unsigned)e[5] << 16); w.w = e[6] | ((unsigned)e[7] << 16);
                        *(u32x4*)(YB + (size_t)(r0 + rr) * YW + YC_B + c0 + c8) = w; }
                }
                __syncthreads();
            }
            {
                const int tid = opaque(tid0);
                const bf16_t* LT = (const bf16_t*)(ws + WS_LT); const float* HIN = (const float*)(ws + WS_LHIN);
                const int nrows = nMrow * 256;
                for (int it = bid * 512 + tid; it < nrows * 48; it += G * 512) {
                    const int r = it / 48, c8 = (it - r * 48) * 8, n = r >> 4;
                    const u32x4 gt = *(const u32x4*)(PR + (size_t)r * LDP + PC_AG + c8);
                    const bf16_t* lt = LT + (size_t)r * 1152 + c8;
                    const u32x4 sv = *(const u32x4*)lt, pf = *(const u32x4*)(lt + 384), pb = *(const u32x4*)(lt + 768);
                    const float* hf = HIN + ((size_t)n * 2 + 0) * 384 + c8; const float* hb = hf + 384;
                    const f32x4 hf0 = *(const f32x4*)hf, hf1 = *(const f32x4*)(hf + 4), hb0 = *(const f32x4*)hb, hb1 = *(const f32x4*)(hb + 4);
                    u32x4 w;
                    w.x = cvt_pk_bf16(gelu_f(bflo(gt.x)) * (bflo(sv.x) + bflo(pf.x) * hf0[0] + bflo(pb.x) * hb0[0]), gelu_f(bfhi(gt.x)) * (bfhi(sv.x) + bfhi(pf.x) * hf0[1] + bfhi(pb.x) * hb0[1]));
                    w.y = cvt_pk_bf16(gelu_f(bflo(gt.y)) * (bflo(sv.y) + bflo(pf.y) * hf0[2] + bflo(pb.y) * hb0[2]), gelu_f(bfhi(gt.y)) * (bfhi(sv.y) + bfhi(pf.y) * hf0[3] + bfhi(pb.y) * hb0[3]));
                    w.z = cvt_pk_bf16(gelu_f(bflo(gt.z)) * (bflo(sv.z) + bflo(pf.z) * hf1[0] + bflo(pb.z) * hb1[0]), gelu_f(bfhi(gt.z)) * (bfhi(sv.z) + bfhi(pf.z) * hf1[1] + bfhi(pb.z) * hb1[1]));
                    w.w = cvt_pk_bf16(gelu_f(bflo(gt.w)) * (bflo(sv.w) + bflo(pf.w) * hf1[2] + bflo(pb.w) * hb1[2]), gelu_f(bfhi(gt.w)) * (bfhi(sv.w) + bfhi(pf.w) * hf1[3] + bfhi(pb.w) * hb1[3]));
                    *(u32x4*)(YB + (size_t)r * YW + YC_A + c8) = w;
                }
            }
        }
        SEAM(P0 + 4);
        if (((PHMASK >> 15) & 1) && IN(P0 + 5)) {
            const pg8::TabSched S{PARTS.p + 20 + l * 3, (const char*)ws, 1, nMrow, G, bid};
            pg8::EpiS5Glu E{YB, (const bf16_t*)(ws + WS_GL), a.in[34] + l * 256};
            pg8::gemm_phase<256, 256>(lds, S, E);
        }
        SEAM(P0 + 5);
        if (((PHMASK >> 3) & 1) && IN(P0 + 6)) {
            const pg8::TabSched S{PARTS.p + l * 8 + 2, (const char*)ws, 4, 4 * nMrow * 4, G, bid};
            pg8::EpiGate E{PR};
            pg8::gemm_phase<1280, 1280>(lds, S, E);
        }
        SEAM(P0 + 6);
        if (((PHMASK >> 4) & 1) && IN(P0 + 7)) {
            const pg8::TabSched S{PARTS.p + l * 8 + 6, (const char*)ws, 1, nMrow * 4, G, bid};
            pg8::EpiRes E{PRE, xlat, xctx, MODL + 2048};
            pg8::gemm_phase<LDP, 4096>(lds, S, E);
        }
        SEAM(P0 + 7);
        if (((PHMASK >> 5) & 1) && IN(P0 + 8)) {
            const int lane = opaque(tid0) & 63;
            if (l == 1) convert_tiles(a, JT_MOE, (LAS float*)lds, bid, G);
            const float* lg = a.in[40] + l * D; const float* lb = a.in[41] + l * D;
            const int nrows = nMrow * 256;
            for (int r = bid * 8 + wave; r < nrows; r += G * 8) {
                const float* mv = MODL + (size_t)(r < RL ? (r >> 12) : 4) * 6144;
                const RowV x1 = row_affine(row_norm(row_load(PRE + (size_t)r * D, lane)), lg, lb, lane);
                row_store(r < RL ? a.out + (size_t)r * D : XSC + (size_t)(r - RL) * D, lane, x1);
                const RowV u2 = row_modulate(row_norm(x1), mv + 3072, mv + 4096, lane);
                row_store_bf16(UB + (size_t)r * D, lane, u2);
                if (l == 1) {
                    float lg8[8];
#pragma unroll
                    for (int e = 0; e < 8; ++e) lg8[e] = 0.f;
                    const float* wr = a.in[47];
#pragma unroll
                    for (int i = 0; i < 4; ++i)
#pragma unroll
                        for (int j = 0; j < 4; ++j) { const float uv = u2.v[i][j]; const float* wp = wr + (size_t)(256 * i + 4 * lane + j) * 8;
                            const f32x4 w0 = *(const f32x4*)wp, w1 = *(const f32x4*)(wp + 4);
                            lg8[0] += uv * w0[0]; lg8[1] += uv * w0[1]; lg8[2] += uv * w0[2]; lg8[3] += uv * w0[3]; lg8[4] += uv * w1[0]; lg8[5] += uv * w1[1]; lg8[6] += uv * w1[2]; lg8[7] += uv * w1[3]; }
#pragma unroll
                    for (int e = 0; e < 8; ++e) lg8[e] = wave_sum(lg8[e]);
                    if (lane == 0) {
                        int i1 = 0; float v1 = lg8[0];
#pragma unroll
                        for (int e = 1; e < 8; ++e) if (lg8[e] > v1) { v1 = lg8[e]; i1 = e; }
                        int i2 = 0; float v2 = -3.0e38f;
#pragma unroll
                        for (int e = 0; e < 8; ++e) if (e != i1 && lg8[e] > v2) { v2 = lg8[e]; i2 = e; }
                        const float e2 = expf(v2 - v1), w1 = 1.f / (1.f + e2), w2 = e2 / (1.f + e2);
                        int* tk = (int*)(ws + WS_TOK) + (size_t)r * 8;
                        tk[0] = i1; tk[1] = i2; ((float*)tk)[2] = w1; ((float*)tk)[3] = w2;
                        tk[4] = (int)atomicAdd(ctl + CW_MOECNT + 64 * i1, 1u); tk[5] = (int)atomicAdd(ctl + CW_MOECNT + 64 * i2, 1u);
                    }
                }
            }
        }
        SEAM(P0 + 8);
        if (l == 0) {
            if (((PHMASK >> 6) & 1) && IN(P0 + 9)) {
                const pg8::TabSched S{PARTS.p + 16, (const char*)ws, 1, 68 * 22, G, bid};
                pg8::EpiSwiglu E{(bf16_t*)(ws + WS_H), FF_DENSE, 0};
                pg8::gemm_phase<1024, 1024>(lds, S, E);
            }
            SEAM(P0 + 9);
            if (((PHMASK >> 7) & 1) && IN(P0 + 10)) {
                const pg8::TabSched S{PARTS.p + 17, (const char*)ws, 1, 68 * 4, G, bid};
                pg8::EpiRes E{PRE, a.out, XSC, MODL + 5120};
                pg8::gemm_phase<FF_DENSE, FF_DENSE>(lds, S, E);
            }
            SEAM(P0 + 10);
            if (((PHMASK >> 8) & 1) && IN(P0 + 11)) {
                const int lane = opaque(tid0) & 63;
                const float* lg = a.in[42]; const float* lb = a.in[43];
                const float* MODN = MOD + (size_t)5 * 6144;
                for (int r = bid * 8 + wave; r < RT; r += G * 8) {
                    const float* mv = MODN + (size_t)(r < RL ? (r >> 12) : 4) * 6144;
                    const RowV x2 = row_affine(row_norm(row_load(PRE + (size_t)r * D, lane)), lg, lb, lane);
                    row_store(r < RL ? a.out + (size_t)r * D : XSC + (size_t)(r - RL) * D, lane, x2);
                    row_store_bf16(UB + (size_t)r * D, lane, row_modulate(row_norm(x2), mv, mv + 1024, lane));
                }
            }
            SEAM(P0 + 11);
        } else {
            bf16_t* AG = (bf16_t*)(ws + WS_AG); float* slotw = (float*)(ws + WS_SLOTW); int* tile_e = (int*)(ws + WS_TILEE);
            if (((PHMASK >> 9) & 1) && IN(P0 + 9)) {
                const int tid = opaque(tid0), lane = tid & 63;
                int ts[NE + 1]; ts[0] = 0;
#pragma unroll
                for (int e = 0; e < NE; ++e) { const unsigned c = __hip_atomic_load(ctl + CW_MOECNT + 64 * e, __ATOMIC_RELAXED, __HIP_MEMORY_SCOPE_AGENT); ts[e + 1] = ts[e] + (int)((c + 255u) >> 8); }
                if (bid == 0) for (int mt = tid; mt < ts[NE]; mt += 512) { int e = 0;
#pragma unroll
                    for (int k = 1; k < NE; ++k) e += (mt >= ts[k]) ? 1 : 0;
                    tile_e[mt] = e; }
                for (int r = bid * 8 + wave; r < RL; r += G * 8) {
                    int* tk = (int*)(ws + WS_TOK) + (size_t)r * 8;
                    const u32x4 v0 = *(const u32x4*)(UB + (size_t)r * D + lane * 16), v1 = *(const u32x4*)(UB + (size_t)r * D + lane * 16 + 8);
#pragma unroll
                    for (int k = 0; k < 2; ++k) {
                        const int e = tk[k], pos = tk[4 + k];
                        int st = 0;
#pragma unroll
                        for (int q = 0; q < NE; ++q) st = (e == q) ? ts[q] : st;
                        const int srow = st * 256 + pos;
                        *(u32x4*)(AG + (size_t)srow * D + lane * 16) = v0; *(u32x4*)(AG + (size_t)srow * D + lane * 16 + 8) = v1;
                        if (lane == 0) { slotw[srow] = ((const float*)tk)[2 + k]; tk[6 + k] = srow; }
                    }
                }
            }
            SEAM(P0 + 9);
            int ttl = 0;
            if (lo <= P0 + 13 && P0 + 10 < hi) {
#pragma unroll
                for (int e = 0; e < NE; ++e) { const unsigned c = __hip_atomic_load(ctl + CW_MOECNT + 64 * e, __ATOMIC_RELAXED, __HIP_MEMORY_SCOPE_AGENT); ttl += (int)((c + 255u) >> 8); }
                ttl = __builtin_amdgcn_readfirstlane(ttl);
            }
#pragma unroll
            for (int pass = 0; pass < 2; ++pass) {
                const int tile0 = pass * MOE_TILES_PASS; int ntile = ttl - tile0; ntile = ntile < 0 ? 0 : (ntile > MOE_TILES_PASS ? MOE_TILES_PASS : ntile);
                if (((PHMASK >> 10) & 1) && IN(P0 + 10 + 2 * pass)) {
                    const pg8::MoeSched S{(const char*)AG + (size_t)tile0 * 256 * 1024 * 2, (const char*)(ws + WS_MOEGU), tile_e, 256u * 1024u * 2u, 256u * 1024u * 2u, (size_t)2 * FF_E * 1024 * 2, 28, 16, tile0, ntile, G, bid};
                    pg8::EpiSwiglu E{(bf16_t*)(ws + WS_HM), FF_E, tile0};
                    pg8::gemm_phase<1024, 1024>(lds, S, E);
                }
                SEAM(P0 + 10 + 2 * pass);
                if (((PHMASK >> 11) & 1) && IN(P0 + 11 + 2 * pass)) {
                    const pg8::MoeSched S{(const char*)(ws + WS_HM), (const char*)(ws + WS_MOED), tile_e, 256u * (unsigned)FF_E * 2u, 256u * (unsigned)FF_E * 2u, (size_t)1024 * FF_E * 2, 4, 56, tile0, ntile, G, bid};
                    pg8::EpiMoeDown E{AG, slotw};
                    pg8::gemm_phase<FF_E, FF_E>(lds, S, E);
                }
                SEAM(P0 + 11 + 2 * pass);
            }
            if (((PHMASK >> 12) & 1) && IN(P0 + 14)) {
                const int lane = opaque(tid0) & 63;
                const float* lg = a.in[42] + D; const float* lb = a.in[43] + D;
                for (int r = bid * 8 + wave; r < RL; r += G * 8) {
                    const int* tk = (const int*)(ws + WS_TOK) + (size_t)r * 8;
                    const bf16_t* oa = AG + (size_t)tk[6] * D; const bf16_t* ob = AG + (size_t)tk[7] * D;
                    const float* gv = MODL + (size_t)(r >> 12) * 6144 + 5120;
                    RowV x1 = row_load(a.out + (size_t)r * D, lane), pre;
#pragma unroll
                    for (int i = 0; i < 4; ++i) { const u32x2 va = *(const u32x2*)(oa + 256 * i + 4 * lane), vb = *(const u32x2*)(ob + 256 * i + 4 * lane);
                        const f32x4 f = {bflo(va.x) + bflo(vb.x), bfhi(va.x) + bfhi(vb.x), bflo(va.y) + bflo(vb.y), bfhi(va.y) + bfhi(vb.y)};
                        pre.v[i] = x1.v[i] * ALPHA + *(const f32x4*)(gv + 256 * i + 4 * lane) * f; }
                    row_store(a.out + (size_t)r * D, lane, row_affine(row_norm(pre), lg, lb, lane));
                }
            }
        }
    }
#undef IN
#undef SEAM
}

}

extern "C" void kernel_launch(void* const* d_in, const int* in_sizes, int n_in, void* d_out, int out_size, void* d_ws, size_t ws_size, hipStream_t stream) {
    static int grid = 0;
    if (grid == 0) {
        if (n_in != 51 || ws_size < WS_END) { grid = -1; return; }
        int dev = 0, cus = 0;
        if (hipGetDevice(&dev) != hipSuccess || hipDeviceGetAttribute(&cus, hipDeviceAttributeMultiprocessorCount, dev) != hipSuccess) { grid = -1; return; }
        if (hipFuncSetAttribute((const void*)mk_fwd, hipFuncAttributeMaxDynamicSharedMemorySize, LDS_BYTES) != hipSuccess) { grid = -1; return; }
        grid = cus;
    }
    if (grid < 0) return;
    const float* const* in = (const float* const*)d_in;
    unsigned char* ws = (unsigned char*)d_ws;
    (void)hipMemsetAsync(ws + WS_CTL, 0, CTL_BYTES + al256(2 * 5 * 6144 * 4), stream);
    for (int l = 0; l < 2; ++l) (void)hipMemsetAsync(ws + WS_WL + (size_t)l * SZ_WL + SZ_WINR + (size_t)1152 * 1024 * 2, 0, (size_t)128 * 1024 * 2, stream);
    Args a{};
    for (int i = 0; i < 51; ++i) a.in[i] = in[i];
    a.out = (float*)d_out; a.ws = ws;
    int nlaunch = 0;
    auto run1 = [&](int lo, int hi) { a.ph_lo = lo; a.ph_hi = hi; a.bar_region = nlaunch < 5 ? nlaunch : 5; nlaunch++; hipLaunchKernelGGL(mk_fwd, dim3(grid), dim3(512), LDS_BYTES, stream, a); };
    auto run = [&](int lo, int hi) {
#if defined(SPLIT) && SPLIT
        for (int k = lo; k < hi; ++k) { const int q = (k - 1) % NPH_LAYER, l = (k - 1) / NPH_LAYER; if (k > 0 && (q > 14 || (l == 0 && q > 11) || (l == 1 && q == 0))) continue; run1(k, k + 1); }
#else
        run1(lo, hi);
#endif
    };
    run(0, 1 + 2 * NPH_LAYER);
}
```

```cpp
#include <hip/hip_runtime.h>
#include <stdint.h>
#include <math.h>

#define LAS __attribute__((address_space(3)))
typedef unsigned short bf16_t;
typedef short bf16x8 __attribute__((ext_vector_type(8)));
typedef float f32x4 __attribute__((ext_vector_type(4)));
typedef float f32x2 __attribute__((ext_vector_type(2)));
typedef unsigned u32x4 __attribute__((ext_vector_type(4)));
typedef unsigned u32x2 __attribute__((ext_vector_type(2)));

namespace {
constexpr int D = 1024, NB = 4, SEQ = 4096, CTXL = 256;
constexpr int RL = NB * SEQ, RC = NB * CTXL, RT = RL + RC;
constexpr int IN_COLS = 7040;
constexpr int FF_DENSE = 2816, NE = 8, FF_E = 3584;
constexpr float ALPHA = 1.41421356237309515f;
constexpr int LDP = 5888, PC_AG = 0, PC_AC = 384, PC_D = 768, PC_Q = 1024, PC_K = 1408, PC_G = 1792;
constexpr int NPT = 1280, PT_V = 768;
constexpr int YW = 1280, YC_A = 0, YC_B = 384, YC_C = 640, YC_D = 1024;
constexpr int MOE_TILES_PASS = 68;
constexpr int MOE_ROWS_MAX = 2 * RL + NE * 256;

constexpr size_t al256(size_t x) { return (x + 255) & ~(size_t)255; }
constexpr size_t WS_CTL = 0, CTL_BYTES = 131072;
constexpr int CW_BAR = 0;
constexpr int CW_MOECNT = 24576;
constexpr int CW_QUEUE = 28672;
constexpr int CW_HYN = 29696;
constexpr size_t WS_MOD = WS_CTL + CTL_BYTES;
constexpr size_t WS_HYN = WS_MOD + al256(2 * 5 * 6144 * 4);
constexpr size_t WS_S5AB = WS_HYN + 4096;
constexpr size_t WS_S5BB = WS_S5AB + 16384;
constexpr size_t WS_AB16 = WS_S5BB + 262144;
constexpr size_t WS_TILEE = WS_AB16 + 32768;
constexpr size_t WS_TOK = WS_TILEE + 1024;
constexpr size_t WS_SLOTW = WS_TOK + (size_t)RL * 32;
constexpr size_t WS_KFL = al256(WS_SLOTW + (size_t)MOE_ROWS_MAX * 4);
constexpr size_t WS_KFC = WS_KFL + (size_t)2 * 1024 * SEQ * 2;
constexpr size_t WS_XSC = WS_KFC + (size_t)1024 * CTXL * 2;
constexpr size_t WS_UB = WS_XSC + (size_t)RC * D * 4;
constexpr size_t SZ_WINR = (size_t)LDP * 1024 * 2, SZ_WINHY = (size_t)NPT * 1024 * 2, SZ_WBR = (size_t)1024 * 1280 * 2, SZ_WOUT = (size_t)1024 * 1024 * 2;
constexpr size_t SZ_WL = SZ_WINR + SZ_WINHY + SZ_WBR + SZ_WOUT;
constexpr size_t WS_WL = WS_UB + (size_t)RT * D * 2;
constexpr size_t WS_FFGU = WS_WL + 2 * SZ_WL;
constexpr size_t WS_FFD = WS_FFGU + (size_t)2 * FF_DENSE * 1024 * 2;
constexpr size_t WS_WGLU = WS_FFD + (size_t)1024 * FF_DENSE * 2;
constexpr size_t WS_OPS = WS_WGLU + (size_t)2 * 256 * 256 * 2;
constexpr size_t WS_OPY = WS_OPS + (size_t)32 * 256 * 256 * 2;
constexpr size_t WS_LW = WS_OPY + (size_t)32 * 256 * 512 * 2;
constexpr size_t WS_PR = WS_LW + (size_t)48 * 4096 * 2;
constexpr size_t WS_PT = WS_PR + (size_t)RT * LDP * 2;
constexpr size_t WS_YB = WS_PT + (size_t)NPT * RT * 2;
constexpr size_t WS_PRE = WS_YB + (size_t)RT * YW * 2;
constexpr size_t WS_EXTRA = WS_PRE + (size_t)RT * D * 4;
constexpr size_t SZ_EXTRA = (size_t)2 * RT * 384 * 4 + (size_t)RT * 256 * 4;
constexpr size_t WS_END = WS_EXTRA + SZ_EXTRA;
constexpr int NCHK = RT / 16, NCHKP = 1280;
constexpr size_t WS_US = WS_PRE;
constexpr size_t WS_S5S = WS_US + (size_t)16 * NCHKP * 512 * 2;
constexpr size_t WS_GL = WS_S5S + (size_t)16 * NCHKP * 256 * 4;
static_assert(WS_GL + (size_t)RT * 256 * 2 <= WS_EXTRA, "s5 overlay");
constexpr size_t WS_H = WS_PR;
constexpr size_t WS_MOEGU = WS_PR;
constexpr size_t WS_MOED = WS_MOEGU + (size_t)NE * 2 * FF_E * 1024 * 2;
constexpr size_t WS_HM = WS_MOED + (size_t)NE * 1024 * FF_E * 2;
constexpr size_t WS_LT = WS_EXTRA;
constexpr size_t WS_LAGG = WS_LT + (size_t)RT * 3 * 384 * 2;
constexpr size_t WS_LHIN = WS_LAGG + (size_t)NCHK * 2 * 384 * 8;
constexpr size_t WS_YT = WS_LHIN + (size_t)NCHK * 2 * 384 * 4;
static_assert(WS_YT + (size_t)256 * RT * 2 <= WS_EXTRA + SZ_EXTRA, "lru / hyena overlay");
constexpr size_t WS_AG = WS_EXTRA;
static_assert(WS_HM + (size_t)MOE_TILES_PASS * 256 * FF_E * 2 <= WS_EXTRA, "moe hidden overlay");
static_assert((size_t)MOE_ROWS_MAX * 1024 * 2 <= SZ_EXTRA, "moe gather overlay");
static_assert((size_t)RT * FF_DENSE * 2 <= (size_t)RT * LDP * 2, "dense hidden overlay");

__device__ __forceinline__ float sigm(float x) { return 1.f / (1.f + __expf(-x)); }
__device__ __forceinline__ float sigm_acc(float x) { return 1.f / (1.f + expf(-x)); }
__device__ __forceinline__ float silu_acc(float x) { return x / (1.f + expf(-x)); }
__device__ __forceinline__ float gelu_t(float x) { return 0.5f * x * (1.f + tanhf(0.7978845608028654f * (x + 0.044715f * x * x * x))); }
__device__ __forceinline__ float gelu_f(float x) { return x * sigm(1.5957691216057308f * (x + 0.044715f * x * x * x)); }
__device__ __forceinline__ float softplus(float x) { return fmaxf(x, 0.f) + log1pf(expf(-fabsf(x))); }
__device__ __forceinline__ float wave_sum(float v) { for (int o = 32; o; o >>= 1) v += __shfl_xor(v, o); return v; }
__device__ __forceinline__ float wave_max(float v) { for (int o = 32; o; o >>= 1) v = fmaxf(v, __shfl_xor(v, o)); return v; }
__device__ __forceinline__ float bf2f(bf16_t b) { return __uint_as_float(((unsigned)b) << 16); }
__device__ __forceinline__ bf16_t f2bf(float f) { unsigned u = __float_as_uint(f); u += 0x7FFFu + ((u >> 16) & 1u); return (bf16_t)(u >> 16); }
__device__ __forceinline__ unsigned cvt_pk_bf16(float lo, float hi) { unsigned r; asm volatile("v_cvt_pk_bf16_f32 %0, %1, %2" : "=v"(r) : "v"(lo), "v"(hi)); return r; }
__device__ __forceinline__ float bflo(unsigned w) { return __uint_as_float(w << 16); }
__device__ __forceinline__ float bfhi(unsigned w) { return __uint_as_float(w & 0xFFFF0000u); }
__device__ __forceinline__ void row_seq(int r, int& start, int& len, int& pos, int& b) {
    if (r < RL) { b = r >> 12; start = b << 12; len = SEQ; pos = r & 4095; }
    else { const int q = r - RL; b = q >> 8; start = RL + (b << 8); len = CTXL; pos = q & 255; }
}

#define XB_TMO      128
#define XB_XCNT(j)  (256  + 64 * (j))
#define XB_XSUB(j)  (1280 + 64 * (j))
#define XB_XGEN(j)  (2304 + 64 * (j))
#define XB_TOP      3328
#define XB_TOPGEN   3392
#define XCD_BAR_WORDS 3456
#define XB_SPIN_CAP (1u << 18)
__device__ __forceinline__ unsigned xb_ld(unsigned* p)              { return __hip_atomic_load(p, __ATOMIC_RELAXED, __HIP_MEMORY_SCOPE_AGENT); }
__device__ __forceinline__ unsigned xb_add(unsigned* p, unsigned v) { return __hip_atomic_fetch_add(p, v, __ATOMIC_RELAXED, __HIP_MEMORY_SCOPE_AGENT); }
__device__ __forceinline__ unsigned xb_xcc_id() { return (unsigned)__builtin_amdgcn_s_getreg((3 << 11) | 20) & 0xFu; }
#define XB_SPIN(cond, bar) do { unsigned _sp = 0; while (cond) { __builtin_amdgcn_s_sleep(1); \
    if ((++_sp & 255u) == 0u) { if (xb_ld(&(bar)[XB_TMO])) break; if (_sp > XB_SPIN_CAP) { atomicAdd(&(bar)[XB_TMO], 1u); break; } } } } while (0)
struct XcdBarrier { unsigned* bar; unsigned x; volatile LAS unsigned* st; };
__device__ __forceinline__ XcdBarrier xcd_barrier_post(unsigned* bar, volatile LAS unsigned* st) {
    XcdBarrier b; b.bar = bar; b.x = xb_xcc_id(); b.st = st;
    if (threadIdx.x == 0) (void)xb_add(&bar[XB_XCNT(b.x)], 1u);
    return b;
}
__device__ __forceinline__ void xcd_barrier_complete(unsigned* bar, unsigned x, unsigned& nloc, unsigned& nx) {
    const unsigned G = gridDim.x * gridDim.y * gridDim.z;
    unsigned sum, cnt, mine, sp = 0u;
    for (;;) {
        sum = 0u; cnt = 0u; mine = 0u;
#pragma unroll
        for (unsigned j = 0; j < 16; ++j) { const unsigned c = xb_ld(&bar[XB_XCNT(j)]); sum += c; cnt += (c > 0u) ? 1u : 0u; mine = (j == x) ? c : mine; }
        if (sum == G) break;
        __builtin_amdgcn_s_sleep(1);
        if ((++sp & 255u) == 0u) { if (xb_ld(&bar[XB_TMO])) break; if (sp > XB_SPIN_CAP) { atomicAdd(&bar[XB_TMO], 1u); break; } }
    }
    nloc = mine > 0u ? mine : 1u; nx = cnt > 0u ? cnt : 1u;
}
__device__ __forceinline__ void xcd_barrier(const XcdBarrier& b) {
    asm volatile("s_waitcnt vmcnt(0)" ::: "memory");
    __syncthreads();
    if (threadIdx.x == 0) {
        unsigned* bar = b.bar;
        __builtin_amdgcn_s_waitcnt(0);
        unsigned nloc = b.st[0], nx = b.st[1];
        if (nloc == 0u) { xcd_barrier_complete(bar, b.x, nloc, nx); b.st[0] = nloc; b.st[1] = nx; }
        const unsigned old = xb_add(&bar[XB_XSUB(b.x)], 1u);
        const unsigned gen = old / nloc;
        if (old + 1u == (gen + 1u) * nloc) {
            __builtin_amdgcn_fence(__ATOMIC_RELEASE, "agent");
            asm volatile("s_waitcnt vmcnt(0)" ::: "memory");
            const unsigned og = xb_add(&bar[XB_TOP], 1u);
            const unsigned tg = og / nx;
            if (og + 1u == (tg + 1u) * nx) xb_add(&bar[XB_TOPGEN], 1u);
            else XB_SPIN(xb_ld(&bar[XB_TOPGEN]) == tg, bar);
            __builtin_amdgcn_fence(__ATOMIC_ACQUIRE, "agent");
            xb_add(&bar[XB_XGEN(b.x)], 1u);
            asm volatile("s_waitcnt vmcnt(0)" ::: "memory");
        } else {
            XB_SPIN(xb_ld(&bar[XB_XGEN(b.x)]) == gen, bar);
            __builtin_amdgcn_fence(__ATOMIC_ACQUIRE, "agent");
            asm volatile("s_waitcnt vmcnt(0)" ::: "memory");
        }
    }
    __syncthreads();
}

namespace pg8 {
constexpr int BM = 256, BK = 64, HALF = 128, HTB = HALF * BK * 2, STAGE_BYTES = 8 * HTB, NXCD = 8, WGM = 8;
__host__ __device__ __forceinline__ int lds_byte(int r, int c) { const int st = (r >> 4) * 2 + (c >> 5), rr = r & 15, cc = c & 31, ob = rr * 64 + cc * 2; return st * 1024 + (ob ^ (((ob >> 9) & 1) << 5)); }
__host__ __device__ __forceinline__ void stage_rc(int b, int& R, int& C) { const int st = b / 1024, sb = b % 1024, swz = sb ^ (((sb >> 9) & 1) << 5); R = (st >> 1) * 16 + swz / 64; C = (st & 1) * 32 + (swz % 64) / 2; }
__host__ __device__ __forceinline__ int perm32(int rho) { const int n = rho >> 4, i = rho & 15; return 8 * (i >> 2) + 4 * n + (i & 3); }

struct Unit { const char* a; const char* b; int nt; int pm, pn, kind; };

__device__ __forceinline__ void rect_map(int wgid, int nM, int nN, int& pm, int& pn) {
    const int nwg = nM * nN;
    { const int q = nwg / NXCD, r = nwg % NXCD, xcd = wgid % NXCD, off = wgid / NXCD; wgid = (xcd < r ? xcd * (q + 1) : r * (q + 1) + (xcd - r) * q) + off; }
    const int nig = WGM * nN, gid = wgid / nig, fm = gid * WGM, gsz = (nM - fm) < WGM ? (nM - fm) : WGM;
    pm = fm + ((wgid % nig) % gsz); pn = (wgid % nig) / gsz;
}

template <int lda, int ldb, class Epi, class Sched>
__device__ __forceinline__ void gemm_phase(LAS unsigned char* lds, const Sched& S, const Epi& E) {
    int tid_ = threadIdx.x; asm volatile("" : "+v"(tid_));
    const int tid = tid_, wid = __builtin_amdgcn_readfirstlane(tid >> 6), lane = tid & 63, wr = wid >> 2, wc = wid & 3, fr = lane & 15, fq = lane >> 4;
    unsigned voffA[2], voffB[2];
#pragma unroll
    for (int i = 0; i < 2; ++i) { int R, C; stage_rc(tid * 16 + i * 8192, R, C); const int Rb = (R & ~31) + perm32(R & 31);
        voffA[i] = (unsigned)(R * lda + C) * 2u; voffB[i] = (unsigned)(Rb * ldb + C) * 2u; }
    const size_t kstep = (size_t)(BK * 2);
    const size_t hstepA = (size_t)HALF * lda * 2, hstepB = (size_t)HALF * ldb * 2;
    const unsigned ldsw = (unsigned)wid * 1024u;
    const int aoff = lds_byte(wr * 64 + fr, fq * 8), boff = lds_byte(wc * 32 + fr, fq * 8);
#define PG8_SA(b, h) (((b) * 2 + (h)) * HTB)
#define PG8_SB(b, h) ((4 + (b) * 2 + (h)) * HTB)
#define PG8_STAGE(bufoff, gbase, voff) do { _Pragma("unroll") for (int _i = 0; _i < 2; ++_i) \
        __builtin_amdgcn_global_load_lds((const unsigned*)((const char*)(gbase) + (voff)[_i]), (LAS unsigned*)(lds + (bufoff) + ldsw + _i * 8192), 16, 0, 0); } while (0)
#define PG8_LDA(dst, b, h) do { _Pragma("unroll") for (int m = 0; m < 4; ++m) _Pragma("unroll") for (int k = 0; k < 2; ++k) dst[m][k] = *(const LAS bf16x8*)(lds + PG8_SA(b, h) + aoff + m * 2048 + k * 1024); } while (0)
#define PG8_LDB(dst, b, h) do { _Pragma("unroll") for (int n = 0; n < 2; ++n) _Pragma("unroll") for (int k = 0; k < 2; ++k) dst[n][k] = *(const LAS bf16x8*)(lds + PG8_SB(b, h) + boff + n * 2048 + k * 1024); } while (0)
#define PG8_MMA(ai, bj, At, Bt) do { __builtin_amdgcn_s_setprio(1); _Pragma("unroll") for (int m = 0; m < 4; ++m) _Pragma("unroll") for (int n = 0; n < 2; ++n) _Pragma("unroll") for (int k = 0; k < 2; ++k) \
        acc[ai][bj][m][n] = __builtin_amdgcn_mfma_f32_16x16x32_bf16(Bt[n][k], At[m][k], acc[ai][bj][m][n], 0, 0, 0); __builtin_amdgcn_s_setprio(0); } while (0)
#define PG8_WAIT_V(n) asm volatile("s_waitcnt vmcnt(" #n ")" ::: "memory")
#define PG8_WAIT_L(n) asm volatile("s_waitcnt lgkmcnt(" #n ")" ::: "memory")
#define PG8_BAR __builtin_amdgcn_s_barrier()
#define PG8_SCHED __builtin_amdgcn_sched_barrier(0)
    Unit cur, nxt; int ui = 0;
    if (!S.next(0, cur)) return;
    f32x4 acc[2][2][4][2];
#pragma unroll
    for (int a = 0; a < 2; ++a)
#pragma unroll
        for (int b = 0; b < 2; ++b)
#pragma unroll
            for (int m = 0; m < 4; ++m)
#pragma unroll
                for (int n = 0; n < 2; ++n) acc[a][b][m][n] = (f32x4){0.f, 0.f, 0.f, 0.f};
    bf16x8 At[4][2], B0[2][2], B1[2][2];
    const char* cA = cur.a; const char* cB = cur.b;
    PG8_STAGE(PG8_SB(0, 0), cB, voffB); PG8_STAGE(PG8_SA(0, 0), cA, voffA); PG8_STAGE(PG8_SB(0, 1), cB + hstepB, voffB); PG8_STAGE(PG8_SA(0, 1), cA + hstepA, voffA);
    if (wr == 1) PG8_BAR;
    PG8_WAIT_V(4); PG8_BAR;
    PG8_STAGE(PG8_SB(1, 0), cB + kstep, voffB); PG8_STAGE(PG8_SA(1, 0), cA + kstep, voffA); PG8_STAGE(PG8_SB(1, 1), cB + hstepB + kstep, voffB);
    PG8_WAIT_V(6); PG8_BAR;
    for (;;) {
        const bool has_next = S.next(ui + 1, nxt);
        const char* nA = has_next ? nxt.a : cA; const char* nB = has_next ? nxt.b : cB;
        const int nt = cur.nt;
        for (int t = 0; t < nt; t += 2) {
            const bool last = (t == nt - 2);
            const char* a1 = cA + (size_t)(t + 1) * kstep;
            const char* a2 = last ? nA : cA + (size_t)(t + 2) * kstep; const char* b2 = last ? nB : cB + (size_t)(t + 2) * kstep;
            const char* a3 = a2 + kstep; const char* b3 = b2 + kstep;
            PG8_LDB(B0, 0, 0); PG8_SCHED; PG8_LDA(At, 0, 0); PG8_STAGE(PG8_SA(1, 1), a1 + hstepA, voffA);
            PG8_WAIT_L(8); PG8_BAR; PG8_WAIT_L(0); PG8_MMA(0, 0, At, B0); PG8_BAR; PG8_SCHED;
            PG8_LDB(B1, 0, 1); PG8_STAGE(PG8_SB(0, 0), b2, voffB);
            PG8_BAR; PG8_WAIT_L(0); PG8_MMA(0, 1, At, B1); PG8_BAR;
            PG8_LDA(At, 0, 1); PG8_STAGE(PG8_SA(0, 0), a2, voffA);
            PG8_BAR; PG8_WAIT_L(0); PG8_MMA(1, 0, At, B0); PG8_BAR; PG8_SCHED;
            PG8_STAGE(PG8_SB(0, 1), b2 + hstepB, voffB);
            PG8_WAIT_V(6); PG8_BAR; PG8_MMA(1, 1, At, B1); PG8_BAR;
            PG8_LDB(B0, 1, 0); PG8_SCHED; PG8_LDA(At, 1, 0); PG8_STAGE(PG8_SA(0, 1), a2 + hstepA, voffA);
            PG8_WAIT_L(8); PG8_BAR; PG8_WAIT_L(0); PG8_MMA(0, 0, At, B0); PG8_BAR; PG8_SCHED;
            PG8_LDB(B1, 1, 1); PG8_STAGE(PG8_SB(1, 0), b3, voffB);
            PG8_BAR; PG8_WAIT_L(0); PG8_MMA(0, 1, At, B1); PG8_BAR;
            PG8_LDA(At, 1, 1); PG8_STAGE(PG8_SA(1, 0), a3, voffA);
            PG8_BAR; PG8_WAIT_L(0); PG8_MMA(1, 0, At, B0); PG8_BAR; PG8_SCHED;
            PG8_STAGE(PG8_SB(1, 1), b3 + hstepB, voffB);
            PG8_WAIT_V(6); PG8_BAR; PG8_MMA(1, 1, At, B1); PG8_BAR;
        }
        E(acc, cur, wr, wc, fr, fq);
        if (!has_next) break;
#pragma unroll
        for (int a = 0; a < 2; ++a)
#pragma unroll
            for (int b = 0; b < 2; ++b)
#pragma unroll
                for (int m = 0; m < 4; ++m)
#pragma unroll
                    for (int n = 0; n < 2; ++n) acc[a][b][m][n] = (f32x4){0.f, 0.f, 0.f, 0.f};
        cur = nxt; cA = nA; cB = nB; ++ui;
    }
    PG8_WAIT_V(0);
    if (wr == 0) PG8_BAR;
    PG8_BAR;
#undef PG8_SA
#undef PG8_SB
#undef PG8_STAGE
#undef PG8_LDA
#undef PG8_LDB
#undef PG8_MMA
#undef PG8_WAIT_V
#undef PG8_WAIT_L
#undef PG8_BAR
#undef PG8_SCHED
}

struct PartC { long long aOff, bOff; unsigned aStep, bStep; int nM, nN, nt, kind, start, nGrp; unsigned aGrp, bGrp; };
struct TabSched {
    const PartC* parts; const char* ws; int np, total, G, c;
    __device__ __forceinline__ bool next(int i, Unit& u) const {
        const int L = i * G + c; if (L >= total) return false;
        int q = 0;
#pragma unroll
        for (int k = 1; k < 4; ++k) if (k < np && L >= parts[k].start) q = k;
        const PartC P = parts[q];
        const int per = P.nM * P.nN, idx = L - P.start, grp = idx / per;
        int pm, pn; rect_map(idx - grp * per, P.nM, P.nN, pm, pn);
        u.a = ws + P.aOff + (size_t)grp * P.aGrp + (size_t)pm * P.aStep; u.b = ws + P.bOff + (size_t)grp * P.bGrp + (size_t)pn * P.bStep; u.nt = P.nt; u.pm = pm; u.pn = pn; u.kind = P.kind + grp; return true;
    }
};
struct MergeSched {
    const char* ws; long long aOff, bOff; int nM, G, c;
    __device__ __forceinline__ bool next(int i, Unit& u) const {
        const int T = (i >> 2) * G + c, br = i & 3; if (T >= nM * 4) return false;
        int pm, pn; rect_map(T, nM, 4, pm, pn);
        const int ko = br == 0 ? 0 : (br == 1 ? 384 : (br == 2 ? 640 : 1024));
        u.a = ws + aOff + (size_t)pm * (256u * 1280u * 2u) + ko * 2; u.b = ws + bOff + (size_t)pn * (256u * 1280u * 2u) + ko * 2; u.nt = (br & 1) ? 4 : 6; u.pm = pm; u.pn = pn; u.kind = br; return true;
    }
};
struct MoeSched {
    const char* A; const char* B; const int* tile_e; unsigned aStep, bStep; size_t bExp; int nN, nt, tile0, ntile, G, c;
    __device__ __forceinline__ bool next(int i, Unit& u) const {
        const int L = i * G + c; if (L >= ntile * nN) return false;
        const int mt = tile0 + L / nN, pn = L % nN;
        const int e = __builtin_amdgcn_readfirstlane(__hip_atomic_load(tile_e + mt, __ATOMIC_RELAXED, __HIP_MEMORY_SCOPE_AGENT));
        u.a = A + (size_t)(mt - tile0) * aStep; u.b = B + (size_t)e * bExp + (size_t)pn * bStep; u.nt = nt; u.pm = mt; u.pn = pn; u.kind = e; return true;
    }
};

#define EPI_ROWS(u) const int row0 = (u).pm * BM + wr * 64 + fr, colt = wc * 32 + 8 * fq
struct EpiProj {
    bf16_t* PRp; bf16_t* PTp; bf16_t* USp; int sig_from;
    __device__ __forceinline__ void operator()(const f32x4 (&acc)[2][2][4][2], const Unit& u, int wr, int wc, int fr, int fq) const {
        EPI_ROWS(u);
        bf16_t* base = u.kind == 1 ? PTp : PRp; const int ldc = u.kind == 1 ? RT : LDP; const bool sg = (u.kind == 0 && u.pn >= sig_from);
#pragma unroll
        for (int ai = 0; ai < 2; ++ai)
#pragma unroll
            for (int m = 0; m < 4; ++m) { bf16_t* rowp = base + (size_t)(row0 + ai * HALF + m * 16) * ldc + u.pn * BM + colt;
#pragma unroll
                for (int bj = 0; bj < 2; ++bj) { f32x4 v0 = acc[ai][bj][m][0], v1 = acc[ai][bj][m][1];
                    if (sg) {
#pragma unroll
                        for (int j = 0; j < 4; ++j) { v0[j] = sigm(v0[j]); v1[j] = sigm(v1[j]); } }
                    u32x4 w; w.x = cvt_pk_bf16(v0[0], v0[1]); w.y = cvt_pk_bf16(v0[2], v0[3]); w.z = cvt_pk_bf16(v1[0], v1[1]); w.w = cvt_pk_bf16(v1[2], v1[3]);
                    *(u32x4*)(rowp + bj * HALF) = w;
                    if (u.kind == 0 && u.pn == 3) { const int r = row0 + ai * HALF + m * 16, cc = colt + bj * HALF;
                        *(u32x4*)(USp + ((size_t)(cc >> 4) * NCHKP + (r >> 4)) * 512 + (r & 15) * 16 + (cc & 15)) = w; } } }
    }
};
struct EpiS5State {
    float* Sp;
    __device__ __forceinline__ void operator()(const f32x4 (&acc)[2][2][4][2], const Unit& u, int wr, int wc, int fr, int fq) const {
        EPI_ROWS(u);
#pragma unroll
        for (int ai = 0; ai < 2; ++ai)
#pragma unroll
            for (int m = 0; m < 4; ++m) { float* op = Sp + ((size_t)u.kind * NCHKP + row0 + ai * HALF + m * 16) * 256 + colt;
#pragma unroll
                for (int bj = 0; bj < 2; ++bj)
#pragma unroll
                    for (int n = 0; n < 2; ++n) *(f32x4*)(op + bj * HALF + 4 * n) = acc[ai][bj][m][n]; }
    }
};
struct EpiS5Main {
    bf16_t* GLp; const bf16_t* PRp; const float* dvec;
    __device__ __forceinline__ void operator()(const f32x4 (&acc)[2][2][4][2], const Unit& u, int wr, int wc, int fr, int fq) const {
        EPI_ROWS(u);
#pragma unroll
        for (int ai = 0; ai < 2; ++ai)
#pragma unroll
            for (int m = 0; m < 4; ++m) { const int n = row0 + ai * HALF + m * 16; if (n >= NCHK) continue;
#pragma unroll
                for (int bj = 0; bj < 2; ++bj) { const int c = colt + bj * HALF, r = 16 * n + (c >> 4), col = 16 * u.kind + (c & 15);
                    const u32x4 uv = *(const u32x4*)(PRp + (size_t)r * LDP + PC_D + col);
                    const f32x4 d0 = *(const f32x4*)(dvec + col), d1 = *(const f32x4*)(dvec + col + 4);
                    const f32x4 v0 = acc[ai][bj][m][0], v1 = acc[ai][bj][m][1];
                    u32x4 w; w.x = cvt_pk_bf16(gelu_f(v0[0] + d0[0] * bflo(uv.x)), gelu_f(v0[1] + d0[1] * bfhi(uv.x))); w.y = cvt_pk_bf16(gelu_f(v0[2] + d0[2] * bflo(uv.y)), gelu_f(v0[3] + d0[3] * bfhi(uv.y)));
                    w.z = cvt_pk_bf16(gelu_f(v1[0] + d1[0] * bflo(uv.z)), gelu_f(v1[1] + d1[1] * bfhi(uv.z))); w.w = cvt_pk_bf16(gelu_f(v1[2] + d1[2] * bflo(uv.w)), gelu_f(v1[3] + d1[3] * bfhi(uv.w)));
                    *(u32x4*)(GLp + (size_t)r * 256 + col) = w; } }
    }
};
struct EpiS5Glu {
    bf16_t* YBp; const bf16_t* GLp; const float* bvec;
    __device__ __forceinline__ void operator()(const f32x4 (&acc)[2][2][4][2], const Unit& u, int wr, int wc, int fr, int fq) const {
        EPI_ROWS(u);
#pragma unroll
        for (int ai = 0; ai < 2; ++ai)
#pragma unroll
            for (int m = 0; m < 4; ++m) { const int r = row0 + ai * HALF + m * 16;
#pragma unroll
                for (int bj = 0; bj < 2; ++bj) { const int c = colt + bj * HALF;
                    const u32x4 gv = *(const u32x4*)(GLp + (size_t)r * 256 + c);
                    const f32x4 b0 = *(const f32x4*)(bvec + c), b1 = *(const f32x4*)(bvec + c + 4);
                    const f32x4 v0 = acc[ai][bj][m][0] + b0, v1 = acc[ai][bj][m][1] + b1;
                    u32x4 w; w.x = cvt_pk_bf16(bflo(gv.x) * sigm(v0[0]), bfhi(gv.x) * sigm(v0[1])); w.y = cvt_pk_bf16(bflo(gv.y) * sigm(v0[2]), bfhi(gv.y) * sigm(v0[3]));
                    w.z = cvt_pk_bf16(bflo(gv.z) * sigm(v1[0]), bfhi(gv.z) * sigm(v1[1])); w.w = cvt_pk_bf16(bflo(gv.w) * sigm(v1[2]), bfhi(gv.w) * sigm(v1[3]));
                    *(u32x4*)(YBp + (size_t)r * YW + YC_D + c) = w; } }
    }
};
struct EpiGate {
    const bf16_t* PRp; bf16_t* MGp;
    __device__ __forceinline__ void operator()(const f32x4 (&acc)[2][2][4][2], const Unit& u, int wr, int wc, int fr, int fq) const {
        EPI_ROWS(u);
        if (u.kind != 0) { __builtin_amdgcn_fence(__ATOMIC_ACQUIRE, "agent"); asm volatile("s_waitcnt vmcnt(0)" ::: "memory"); }
#pragma unroll
        for (int ai = 0; ai < 2; ++ai)
#pragma unroll
            for (int m = 0; m < 4; ++m) { const int r = row0 + ai * HALF + m * 16; const bf16_t* gp = PRp + (size_t)r * LDP + PC_G + u.kind * 1024 + u.pn * BM + colt; bf16_t* mp = MGp + (size_t)r * D + u.pn * BM + colt;
#pragma unroll
                for (int bj = 0; bj < 2; ++bj) { const f32x4 v0 = acc[ai][bj][m][0], v1 = acc[ai][bj][m][1];
                    const u32x4 g = *(const u32x4*)(gp + bj * HALF);
                    f32x4 o0 = {v0[0] * bflo(g.x), v0[1] * bfhi(g.x), v0[2] * bflo(g.y), v0[3] * bfhi(g.y)}, o1 = {v1[0] * bflo(g.z), v1[1] * bfhi(g.z), v1[2] * bflo(g.w), v1[3] * bfhi(g.w)};
                    if (u.kind != 0) { const u32x4 p = *(const u32x4*)(mp + bj * HALF);
                        o0 = o0 + (f32x4){bflo(p.x), bfhi(p.x), bflo(p.y), bfhi(p.y)}; o1 = o1 + (f32x4){bflo(p.z), bfhi(p.z), bflo(p.w), bfhi(p.w)}; }
                    u32x4 w; w.x = cvt_pk_bf16(o0[0], o0[1]); w.y = cvt_pk_bf16(o0[2], o0[3]); w.z = cvt_pk_bf16(o1[0], o1[1]); w.w = cvt_pk_bf16(o1[2], o1[3]);
                    *(u32x4*)(mp + bj * HALF) = w; } }
    }
};
struct EpiRes {
    float* PREp; const float* xlat; const float* xctx; const float* gvec;
    float* partp;
    __device__ __forceinline__ void operator()(const f32x4 (&acc)[2][2][4][2], const Unit& u, int wr, int wc, int fr, int fq) const {
        EPI_ROWS(u);
        if (u.kind != 0) {
#pragma unroll
            for (int ai = 0; ai < 2; ++ai)
#pragma unroll
                for (int m = 0; m < 4; ++m) { const int r = row0 + ai * HALF + m * 16; const int c0 = u.pn * BM + colt;
                    const float* gp = gvec + (size_t)4 * 6144 + c0;
                    float* op = partp + ((size_t)(u.kind - 1) * RC + r) * D + c0;
#pragma unroll
                    for (int bj = 0; bj < 2; ++bj)
#pragma unroll
                        for (int n = 0; n < 2; ++n) *(f32x4*)(op + bj * HALF + 4 * n) = *(const f32x4*)(gp + bj * HALF + 4 * n) * acc[ai][bj][m][n]; }
            return;
        }
#pragma unroll
        for (int ai = 0; ai < 2; ++ai)
#pragma unroll
            for (int m = 0; m < 4; ++m) { const int r = row0 + ai * HALF + m * 16; const int c0 = u.pn * BM + colt;
                const float* xin = (r < RL ? xlat + (size_t)r * D : xctx + (size_t)(r - RL) * D) + c0;
                const float* gp = gvec + (size_t)(r < RL ? (r >> 12) : 4) * 6144 + c0;
                float* op = PREp + (size_t)r * D + c0;
#pragma unroll
                for (int bj = 0; bj < 2; ++bj)
#pragma unroll
                    for (int n = 0; n < 2; ++n) { const f32x4 x = *(const f32x4*)(xin + bj * HALF + 4 * n), g = *(const f32x4*)(gp + bj * HALF + 4 * n);
                        *(f32x4*)(op + bj * HALF + 4 * n) = x * ALPHA + g * acc[ai][bj][m][n]; } }
    }
};
struct EpiSwiglu {
    bf16_t* Hp; int ldh; int row_sub;
    __device__ __forceinline__ void operator()(const f32x4 (&acc)[2][2][4][2], const Unit& u, int wr, int wc, int fr, int fq) const {
        const int row0 = (u.pm - row_sub) * BM + wr * 64 + fr, colt = wc * 32 + 8 * fq;
#pragma unroll
        for (int ai = 0; ai < 2; ++ai)
#pragma unroll
            for (int m = 0; m < 4; ++m) { bf16_t* rowp = Hp + (size_t)(row0 + ai * HALF + m * 16) * ldh + u.pn * HALF + colt;
                f32x4 h0, h1;
#pragma unroll
                for (int j = 0; j < 4; ++j) { const float g0 = acc[ai][0][m][0][j], g1 = acc[ai][0][m][1][j];
                    h0[j] = g0 * sigm(g0) * acc[ai][1][m][0][j]; h1[j] = g1 * sigm(g1) * acc[ai][1][m][1][j]; }
                u32x4 w; w.x = cvt_pk_bf16(h0[0], h0[1]); w.y = cvt_pk_bf16(h0[2], h0[3]); w.z = cvt_pk_bf16(h1[0], h1[1]); w.w = cvt_pk_bf16(h1[2], h1[3]);
                *(u32x4*)rowp = w; }
    }
};
struct EpiMoeDown {
    bf16_t* O2; const float* slotw;
    __device__ __forceinline__ void operator()(const f32x4 (&acc)[2][2][4][2], const Unit& u, int wr, int wc, int fr, int fq) const {
        EPI_ROWS(u);
#pragma unroll
        for (int ai = 0; ai < 2; ++ai)
#pragma unroll
            for (int m = 0; m < 4; ++m) { const int r = row0 + ai * HALF + m * 16; const float w8 = slotw[r];
                bf16_t* rowp = O2 + (size_t)r * D + u.pn * BM + colt;
#pragma unroll
                for (int bj = 0; bj < 2; ++bj) { const f32x4 v0 = acc[ai][bj][m][0] * w8, v1 = acc[ai][bj][m][1] * w8;
                    u32x4 w; w.x = cvt_pk_bf16(v0[0], v0[1]); w.y = cvt_pk_bf16(v0[2], v0[3]); w.z = cvt_pk_bf16(v1[0], v1[1]); w.w = cvt_pk_bf16(v1[2], v1[3]);
                    *(u32x4*)(rowp + bj * HALF) = w; } }
    }
};
}

struct Job { int in_idx; int src_off; int lds; int K; int N; long long dst_off; int ldd; int kcol0; int G, GS, R0; int tile0; };
struct JobTable { Job j[96]; int n; int total; };
constexpr int BIGG = 1 << 30;
constexpr void add_job(JobTable& t, int in_idx, long long src_off, int lds, int K, int N, size_t dst_off, int ldd, int kcol0, int G, int GS, int R0) {
    Job& q = t.j[t.n]; q.in_idx = in_idx; q.src_off = (int)src_off; q.lds = lds; q.K = K; q.N = N; q.dst_off = (long long)dst_off; q.ldd = ldd; q.kcol0 = kcol0; q.G = G; q.GS = GS; q.R0 = R0;
    q.tile0 = t.total; t.total += (K / 64) * (N / 64); t.n++;
}
constexpr JobTable make_jobs(int which) {
    JobTable t{}; t.n = 0; t.total = 0;
    if (which == 0) {
        for (int l = 0; l < 2; ++l) {
            const size_t base = WS_WL + (size_t)l * SZ_WL; const long long wsrc = (long long)l * 1024 * IN_COLS;
            add_job(t, 6, wsrc + 0, IN_COLS, 1024, 768, base, 1024, 0, BIGG, 0, 0);
            add_job(t, 6, wsrc + 2688, IN_COLS, 1024, 256, base, 1024, 0, BIGG, 0, PC_D);
            add_job(t, 6, wsrc + 1536, IN_COLS, 1024, 768, base, 1024, 0, BIGG, 0, PC_Q);
            add_job(t, 6, wsrc + 2944, IN_COLS, 1024, 4096, base, 1024, 0, BIGG, 0, PC_G);
            add_job(t, 6, wsrc + 768, IN_COLS, 1024, 768, base + SZ_WINR, 1024, 0, BIGG, 0, 0);
            add_job(t, 6, wsrc + 2304, IN_COLS, 1024, 384, base + SZ_WINR, 1024, 0, BIGG, 0, PT_V);
            const int kd[4] = {384, 256, 384, 256}, ko[4] = {0, 384, 640, 1024};
            for (int i = 0; i < 4; ++i) add_job(t, 35 + i, (long long)l * kd[i] * 1024, 1024, kd[i], 1024, base + SZ_WINR + SZ_WINHY, 1280, ko[i], BIGG, 0, 0);
            add_job(t, 39, (long long)l * 1024 * 1024, 1024, 1024, 1024, base + SZ_WINR + SZ_WINHY + SZ_WBR, 1024, 0, BIGG, 0, 0);
        }
        for (int q = 0; q < 24; ++q) for (int mat = 0; mat < 2; ++mat)
            add_job(t, mat == 0 ? 9 : 11, (long long)q * 4096, 64, 64, 64, WS_LW + (size_t)(((q / 6) * 2 + mat) * 6 + q % 6) * 4096 * 2, 64, 0, BIGG, 0, 0);
        for (int l = 0; l < 2; ++l) add_job(t, 33, (long long)l * 65536, 256, 256, 256, WS_WGLU + (size_t)l * 256 * 256 * 2, 256, 0, BIGG, 0, 0);
        add_job(t, 44, 0, FF_DENSE, 1024, FF_DENSE, WS_FFGU, 1024, 0, 128, 256, 0);
        add_job(t, 45, 0, FF_DENSE, 1024, FF_DENSE, WS_FFGU, 1024, 0, 128, 256, 128);
        add_job(t, 46, 0, 1024, FF_DENSE, 1024, WS_FFD, FF_DENSE, 0, BIGG, 0, 0);
    } else {
        for (int e = 0; e < NE; ++e) {
            add_job(t, 48, (long long)e * 1024 * FF_E, FF_E, 1024, FF_E, WS_MOEGU + (size_t)e * 2 * FF_E * 1024 * 2, 1024, 0, 128, 256, 0);
            add_job(t, 49, (long long)e * 1024 * FF_E, FF_E, 1024, FF_E, WS_MOEGU + (size_t)e * 2 * FF_E * 1024 * 2, 1024, 0, 128, 256, 128);
            add_job(t, 50, (long long)e * FF_E * 1024, 1024, FF_E, 1024, WS_MOED + (size_t)e * 1024 * FF_E * 2, FF_E, 0, BIGG, 0, 0);
        }
    }
    return t;
}
__device__ const JobTable JT_SMALL = make_jobs(0);
__device__ const JobTable JT_MOE = make_jobs(1);

struct PartTable { pg8::PartC p[32]; };
constexpr pg8::PartC mk_part(size_t aOff, size_t bOff, unsigned aStep, unsigned bStep, int nM, int nN, int nt, int kind, int start) {
    pg8::PartC q{}; q.aOff = (long long)aOff; q.bOff = (long long)bOff; q.aStep = aStep; q.bStep = bStep; q.nM = nM; q.nN = nN; q.nt = nt; q.kind = kind; q.start = start; q.nGrp = 1; q.aGrp = 0; q.bGrp = 0; return q;
}
constexpr PartTable make_parts() {
    PartTable t{};
    for (int l = 0; l < 2; ++l) {
        const size_t WL = WS_WL + (size_t)l * SZ_WL; const int nMrow = l == 0 ? 68 : 64;
        t.p[l * 8 + 0] = mk_part(WS_UB, WL, 256u * 1024u * 2u, 256u * 1024u * 2u, 68, 23, 16, 0, 0);
        t.p[l * 8 + 1] = mk_part(WL + SZ_WINR, WS_UB, 256u * 1024u * 2u, 256u * 1024u * 2u, 5, 68, 16, 1, 68 * 23);
        const int kd[4] = {384, 256, 384, 256}, ko[4] = {0, 384, 640, 1024};
        for (int i = 0; i < 4; ++i) t.p[l * 8 + 2 + i] = mk_part(WS_YB + ko[i] * 2, WL + SZ_WINR + SZ_WINHY + ko[i] * 2, 256u * 1280u * 2u, 256u * 1280u * 2u, nMrow, 4, kd[i] / 64, i, i * nMrow * 4);
        t.p[l * 8 + 6] = mk_part(WS_UB, WL + SZ_WINR + SZ_WINHY + SZ_WBR, 256u * 1024u * 2u, 256u * 1024u * 2u, nMrow, 4, 16, 0, 0);
    }
    for (int l = 0; l < 2; ++l) {
        pg8::PartC q = mk_part(WS_US, WS_OPS + (size_t)l * 16 * 256 * 256 * 2, 256u * 512u * 2u, 0u, 5, 1, 4, 0, 0); q.nGrp = 16; q.aGrp = (unsigned)(NCHKP * 512 * 2); q.bGrp = 256u * 256u * 2u; t.p[18 + l * 3] = q;
        q = mk_part(WS_US, WS_OPY + (size_t)l * 16 * 256 * 512 * 2, 256u * 512u * 2u, 0u, 5, 1, 8, 0, 0); q.nGrp = 16; q.aGrp = (unsigned)(NCHKP * 512 * 2); q.bGrp = 256u * 512u * 2u; t.p[19 + l * 3] = q;
        t.p[20 + l * 3] = mk_part(WS_GL, WS_WGLU + (size_t)l * 256 * 256 * 2, 256u * 256u * 2u, 0u, l == 0 ? 68 : 64, 1, 4, 0, 0);
    }
    {
        const size_t WL0 = WS_WL;
        t.p[24] = mk_part(WS_UB, WL0 + SZ_WINR + SZ_WINHY + SZ_WBR, 256u * 1024u * 2u, 256u * 1024u * 2u, 64, 4, 16, 0, 0);
        pg8::PartC q = mk_part(WS_UB + (size_t)64 * 256 * 1024 * 2, WL0 + SZ_WINR + SZ_WINHY + SZ_WBR, 256u * 1024u * 2u, 256u * 1024u * 2u, 4, 4, 4, 1, 256); q.nGrp = 4; q.aGrp = 512u; q.bGrp = 512u; t.p[25] = q;
        t.p[26] = mk_part(WS_H, WS_FFD, 256u * (unsigned)FF_DENSE * 2u, 256u * (unsigned)FF_DENSE * 2u, 64, 4, 44, 0, 0);
        q = mk_part(WS_H + (size_t)64 * 256 * FF_DENSE * 2, WS_FFD, 256u * (unsigned)FF_DENSE * 2u, 256u * (unsigned)FF_DENSE * 2u, 4, 4, 12, 1, 256); q.nGrp = 3; q.aGrp = 1536u; q.bGrp = 1536u; t.p[27] = q;
        t.p[28] = mk_part(WS_H + (size_t)64 * 256 * FF_DENSE * 2 + 36 * 128, WS_FFD + 36 * 128, 256u * (unsigned)FF_DENSE * 2u, 256u * (unsigned)FF_DENSE * 2u, 4, 4, 8, 4, 256 + 48);
    }
    t.p[16] = mk_part(WS_UB, WS_FFGU, 256u * 1024u * 2u, 256u * 1024u * 2u, 68, 22, 16, 0, 0);
    t.p[17] = mk_part(WS_H, WS_FFD, 256u * (unsigned)FF_DENSE * 2u, 256u * (unsigned)FF_DENSE * 2u, 68, 4, 44, 0, 0);
    return t;
}
__device__ const PartTable PARTS = make_parts();

struct Args {
    const float* in[51];
    float* out; unsigned char* ws;
    int ph_lo, ph_hi, bar_region, pad0;
};
__device__ __forceinline__ const float* sel_in(const Args& a, int idx) {
    const float* p = a.in[6];
    p = idx == 9 ? a.in[9] : p; p = idx == 11 ? a.in[11] : p; p = idx == 33 ? a.in[33] : p; p = idx == 35 ? a.in[35] : p; p = idx == 36 ? a.in[36] : p; p = idx == 37 ? a.in[37] : p; p = idx == 38 ? a.in[38] : p; p = idx == 39 ? a.in[39] : p;
    p = idx == 44 ? a.in[44] : p; p = idx == 45 ? a.in[45] : p; p = idx == 46 ? a.in[46] : p; p = idx == 48 ? a.in[48] : p; p = idx == 49 ? a.in[49] : p; p = idx == 50 ? a.in[50] : p;
    return p;
}

__device__ __forceinline__ void convert_tiles(const Args& a, const JobTable& JT, LAS float* tile, int first, int stride) {
    const int tid = threadIdx.x;
    for (int t0 = first; t0 < JT.total; t0 += 4 * stride) {
        f32x4 v[4][2]; int jis[4];
#pragma unroll
        for (int u = 0; u < 4; ++u) {
            const int t = t0 + u * stride; jis[u] = -1;
            if (t < JT.total) {
                int ji = 0;
                for (int k = 1; k < JT.n; ++k) if (t >= JT.j[k].tile0) ji = k;
                jis[u] = ji;
                const Job& q = JT.j[ji];
                const int lt = t - q.tile0, nTn = q.N / 64, k0 = (lt / nTn) * 64, n0 = (lt % nTn) * 64;
                const float* src = sel_in(a, q.in_idx) + (size_t)q.src_off + (size_t)k0 * q.lds + n0;
#pragma unroll
                for (int p = 0; p < 2; ++p) v[u][p] = *(const f32x4*)(src + (size_t)((tid >> 4) + 32 * p) * q.lds + (tid & 15) * 4);
            }
        }
        __syncthreads();
#pragma unroll
        for (int u = 0; u < 4; ++u) if (jis[u] >= 0) {
#pragma unroll
            for (int p = 0; p < 2; ++p) { const int kk = (tid >> 4) + 32 * p, nn = (tid & 15) * 4; LAS float* tp = tile + u * (64 * 65) + kk * 65 + nn;
                tp[0] = v[u][p][0]; tp[1] = v[u][p][1]; tp[2] = v[u][p][2]; tp[3] = v[u][p][3]; } }
        __syncthreads();
#pragma unroll
        for (int u = 0; u < 4; ++u) if (jis[u] >= 0) {
            const Job& q = JT.j[jis[u]];
            const int t = t0 + u * stride, lt = t - q.tile0, nTn = q.N / 64, k0 = (lt / nTn) * 64, n0 = (lt % nTn) * 64;
            const int n = tid >> 3, k8 = (tid & 7) * 8, ng = n0 + n;
            const int drow = (ng / q.G) * q.GS + (ng % q.G) + q.R0;
            const LAS float* tp = tile + u * (64 * 65) + n;
            u32x4 w;
            w.x = cvt_pk_bf16(tp[(k8 + 0) * 65], tp[(k8 + 1) * 65]); w.y = cvt_pk_bf16(tp[(k8 + 2) * 65], tp[(k8 + 3) * 65]);
            w.z = cvt_pk_bf16(tp[(k8 + 4) * 65], tp[(k8 + 5) * 65]); w.w = cvt_pk_bf16(tp[(k8 + 6) * 65], tp[(k8 + 7) * 65]);
            *(u32x4*)((bf16_t*)(a.ws + q.dst_off) + (size_t)drow * q.ldd + q.kcol0 + k0 + k8) = w;
        }
    }
}

__device__ __forceinline__ int opaque(int v) { asm volatile("" : "+v"(v)); return v; }
struct RowV { f32x4 v[4]; };
__device__ __forceinline__ RowV row_load(const float* p, int lane) { RowV r;
#pragma unroll
    for (int i = 0; i < 4; ++i) r.v[i] = *(const f32x4*)(p + 256 * i + 4 * lane); return r; }
__device__ __forceinline__ void row_store(float* p, int lane, const RowV& r) {
#pragma unroll
    for (int i = 0; i < 4; ++i) *(f32x4*)(p + 256 * i + 4 * lane) = r.v[i]; }
__device__ __forceinline__ void row_store_bf16(bf16_t* p, int lane, const RowV& r) {
#pragma unroll
    for (int i = 0; i < 4; ++i) { u32x2 w; w.x = cvt_pk_bf16(r.v[i][0], r.v[i][1]); w.y = cvt_pk_bf16(r.v[i][2], r.v[i][3]); *(u32x2*)(p + 256 * i + 4 * lane) = w; } }
__device__ __forceinline__ RowV row_norm(const RowV& x) {
    float s = 0.f;
#pragma unroll
    for (int i = 0; i < 4; ++i) s += (x.v[i][0] + x.v[i][1]) + (x.v[i][2] + x.v[i][3]);
    const float mu = wave_sum(s) * (1.f / D);
    RowV d; float q = 0.f;
#pragma unroll
    for (int i = 0; i < 4; ++i) { d.v[i] = x.v[i] - mu; q += (d.v[i][0] * d.v[i][0] + d.v[i][1] * d.v[i][1]) + (d.v[i][2] * d.v[i][2] + d.v[i][3] * d.v[i][3]); }
    const float rs = rsqrtf(wave_sum(q) * (1.f / D) + 1e-5f);
#pragma unroll
    for (int i = 0; i < 4; ++i) d.v[i] = d.v[i] * rs;
    return d;
}
__device__ __forceinline__ RowV row_affine(const RowV& n, const float* g, const float* b, int lane) {
    RowV o;
#pragma unroll
    for (int i = 0; i < 4; ++i) o.v[i] = n.v[i] * *(const f32x4*)(g + 256 * i + 4 * lane) + *(const f32x4*)(b + 256 * i + 4 * lane);
    return o;
}
__device__ __forceinline__ RowV row_modulate(const RowV& n, const float* sh, const float* sc, int lane) {
    RowV o;
#pragma unroll
    for (int i = 0; i < 4; ++i) o.v[i] = n.v[i] * (*(const f32x4*)(sc + 256 * i + 4 * lane) + 1.0f) + *(const f32x4*)(sh + 256 * i + 4 * lane);
    return o;
}

constexpr int LDS_BYTES = 159744;
constexpr int MISC_OFF = 159488;
constexpr int NPH_LAYER = 16;
#ifndef SPLIT
#define SPLIT 0
#endif

__global__ void __launch_bounds__(512, 2) mk_fwd(Args a) {
    extern __shared__ __attribute__((aligned(16))) unsigned char shm[];
    LAS unsigned char* lds = (LAS unsigned char*)shm;
    volatile LAS unsigned* MISC = (volatile LAS unsigned*)(lds + MISC_OFF);
    const int tid0 = threadIdx.x, wave = __builtin_amdgcn_readfirstlane(tid0 >> 6);
    const int G = gridDim.x, bid = blockIdx.x;
    if (tid0 < (LDS_BYTES - MISC_OFF) / 4) MISC[tid0] = 0u;
    __syncthreads();
    unsigned char* ws = a.ws;
    unsigned* ctl = (unsigned*)(ws + WS_CTL);
    XcdBarrier bar = xcd_barrier_post(ctl + CW_BAR + a.bar_region * XCD_BAR_WORDS, MISC + 8);
    const int lo = a.ph_lo, hi = a.ph_hi;
#ifndef PHMASK
#define PHMASK 0xFFFF
#endif
#define IN(k) (lo <= (k) && (k) < hi)
#define SEAM(k) do { if (lo <= (k) && (k) + 1 < hi) xcd_barrier(bar); } while (0)
    float* MOD = (float*)(ws + WS_MOD);
    bf16_t* UB = (bf16_t*)(ws + WS_UB); bf16_t* PR = (bf16_t*)(ws + WS_PR); bf16_t* PT = (bf16_t*)(ws + WS_PT); bf16_t* YB = (bf16_t*)(ws + WS_YB);
    float* PRE = (float*)(ws + WS_PRE); float* XSC = (float*)(ws + WS_XSC);
    const float* x_in = a.in[0]; const float* ctx_in = a.in[2];

    if (((PHMASK >> 0) & 1) && IN(0)) {
        const int tid = opaque(tid0), lane = tid & 63;
        convert_tiles(a, JT_SMALL, (LAS float*)lds, bid, G);
        __syncthreads();
        LAS float* sc = (LAS float*)lds;
        for (int i = tid; i < 5 * 1024; i += 512) { const int r = i >> 10, k = i & 1023; sc[i] = silu_acc(r < 4 ? a.in[1][r * 1024 + k] : a.in[3][k]); }
        __syncthreads();
        for (int u = bid; u < 2 * 96 * 8; u += G) {
            const int l = u / (96 * 8), rem = u % (96 * 8), cg = rem / 8, ks = rem % 8;
            const int n = cg * 64 + lane;
            const float* w = a.in[4] + (size_t)l * 1024 * 6144 + n;
            float a0 = 0, a1 = 0, a2 = 0, a3 = 0, a4 = 0;
            const int kb = ks * 128 + wave * 16;
#pragma unroll 4
            for (int k = kb; k < kb + 16; ++k) { const float wv = w[(size_t)k * 6144]; a0 += sc[k] * wv; a1 += sc[1024 + k] * wv; a2 += sc[2048 + k] * wv; a3 += sc[3072 + k] * wv; a4 += sc[4096 + k] * wv; }
            if (ks == 0 && wave == 0) { const float bb = a.in[5][l * 6144 + n]; a0 += bb; a1 += bb; a2 += bb; a3 += bb; a4 += bb; }
            float* o = MOD + (size_t)l * 5 * 6144 + n;
            atomicAdd(o, a0); atomicAdd(o + 6144, a1); atomicAdd(o + 2 * 6144, a2); atomicAdd(o + 3 * 6144, a3); atomicAdd(o + 4 * 6144, a4);
        }
        __syncthreads();
        for (int u = bid; u < 132; u += G) {
            const bool isc = u >= 128; const int l = isc ? 0 : (u >> 6), blk = isc ? u - 128 : (u & 63), L = isc ? CTXL : SEQ, t0 = blk * 64;
            LAS float* feat = (LAS float*)lds;
            LAS float* h1 = feat + 64 * 33;
            LAS float* h2 = h1 + 4096;
            const float* w1 = a.in[16] + l * 33 * 64; const float* b1 = a.in[17] + l * 64; const float* w2 = a.in[18] + l * 4096; const float* b2 = a.in[19] + l * 64;
            const float* w3 = a.in[20] + (size_t)l * 65536; const float* b3 = a.in[21] + l * 1024; const float* fq = a.in[22] + l * 64;
            __syncthreads();
            for (int i = tid; i < 64 * 33; i += 512) { const int tt = i / 33, f = i - tt * 33, t = t0 + tt; float v;
                if (f == 0) v = (float)t / (float)L;
                else { const int band = (f - 1) % 16 + 1; const int m = (int)(((long)t * band) % L); const double ang = 2.0 * M_PI * (double)m / (double)L; v = f <= 16 ? (float)cos(ang) : (float)sin(ang); }
                feat[i] = v; }
            __syncthreads();
            for (int i = tid; i < 4096; i += 512) { const int tt = i >> 6, j = i & 63; float sacc = b1[j];
                for (int f = 0; f < 33; ++f) sacc += feat[tt * 33 + f] * w1[f * 64 + j];
                h1[i] = sinf(fq[j] * sacc); }
            __syncthreads();
            for (int i = tid; i < 4096; i += 512) { const int tt = i >> 6, j = i & 63; float sacc = b2[j];
                for (int f = 0; f < 64; ++f) sacc += h1[tt * 64 + f] * w2[f * 64 + j];
                h2[i] = sinf(fq[j] * sacc); }
            __syncthreads();
            const float dmin = 3.0701134573253945f, dmax = 15.350567286626973f;
#pragma unroll 1
            for (int jj = 0; jj < 2; ++jj) {
                const int n = tid + 512 * jj, dir = n >> 9, o = (n >> 8) & 1, c = n & 255;
                float wc[64];
#pragma unroll
                for (int i = 0; i < 64; ++i) wc[i] = w3[i * 1024 + n];
                const float bb = b3[n], delta = dmin + (dmax - dmin) * (float)c / 255.0f;
                bf16_t* dst = isc ? (bf16_t*)(ws + WS_KFC) + ((size_t)(dir * 2 + o) * 256 + c) * CTXL + t0 : (bf16_t*)(ws + WS_KFL) + ((size_t)((l * 2 + dir) * 2 + o) * 256 + c) * SEQ + t0;
                float asum = 0.f;
#pragma unroll 1
                for (int tg = 0; tg < 8; ++tg) {
                    float v[8];
#pragma unroll
                    for (int q = 0; q < 8; ++q) { float sacc = bb; const LAS float* hp = h2 + (tg * 8 + q) * 64;
#pragma unroll
                        for (int i = 0; i < 64; ++i) sacc += hp[i] * wc[i];
                        const int t = t0 + tg * 8 + q;
                        v[q] = sacc * expf(-((float)t / (float)L) * delta);
                        if (!(dir == 1 && t == 0)) asum += fabsf(v[q]); }
                    u32x4 w; w.x = cvt_pk_bf16(v[0], v[1]); w.y = cvt_pk_bf16(v[2], v[3]); w.z = cvt_pk_bf16(v[4], v[5]); w.w = cvt_pk_bf16(v[6], v[7]);
                    *(u32x4*)(dst + tg * 8) = w;
                }
                atomicAdd((float*)(ctl + CW_HYN) + (isc ? 1024 + o * 256 + c : (l * 2 + o) * 256 + c), asum);
            }
        }
        __syncthreads();
        for (int u = bid; u < 32; u += G) {
            const int l = u >> 4, g = u & 15;
            LAS float* PW = (LAS float*)lds;
            LAS float* BBs = PW + 2 * 64 * 17 * 2;
            LAS float* Cs = BBs + 2 * 64 * 16 * 2;
            LAS float* KT = Cs + 2 * 16 * 64 * 2;
            __syncthreads();
            if (tid < 128) {
                const int d = tid >> 6, p = tid & 63, idx = l * 2048 + (d * 16 + g) * 64 + p;
                const double ar = a.in[25][idx], ai = a.in[26][idx], dt = exp((double)a.in[27][l * 32 + d * 16 + g]);
                const double mag = exp(dt * ar), abr = mag * cos(dt * ai), abi = mag * sin(dt * ai), den = ar * ar + ai * ai;
                const double fr = ((abr - 1.0) * ar + abi * ai) / den, fi = (abi * ar - (abr - 1.0) * ai) / den;
                double pr = 1.0, pi = 0.0;
                for (int k = 0; k <= 16; ++k) { PW[((d * 64 + p) * 17 + k) * 2] = (float)pr; PW[((d * 64 + p) * 17 + k) * 2 + 1] = (float)pi; const double nr = pr * abr - pi * abi, ni = pr * abi + pi * abr; pr = nr; pi = ni; }
                float* a16 = (float*)(ws + WS_AB16) + ((size_t)((l * 2 + d) * 16 + g) * 64 + p) * 2;
                a16[0] = PW[((d * 64 + p) * 17 + 16) * 2]; a16[1] = PW[((d * 64 + p) * 17 + 16) * 2 + 1];
                for (int i = 0; i < 16; ++i) { const double br = a.in[28][(size_t)idx * 16 + i], bi = a.in[29][(size_t)idx * 16 + i];
                    BBs[((d * 64 + p) * 16 + i) * 2] = (float)(fr * br - fi * bi); BBs[((d * 64 + p) * 16 + i) * 2 + 1] = (float)(fr * bi + fi * br); }
            }
            for (int i = tid; i < 2048; i += 512) { const int d = i >> 10, o = (i >> 6) & 15, p = i & 63; const size_t ci = (size_t)l * 32768 + ((size_t)(d * 16 + g) * 16 + o) * 64 + p;
                Cs[i * 2] = a.in[30][ci]; Cs[i * 2 + 1] = a.in[31][ci]; }
            __syncthreads();
            for (int e = tid; e < 8192; e += 512) { const int d = e >> 12, k = (e >> 8) & 15, o = (e >> 4) & 15, i = e & 15;
                float acc = 0.f;
                for (int p = 0; p < 64; ++p) { const float cr = Cs[((d * 16 + o) * 64 + p) * 2], ci = Cs[((d * 16 + o) * 64 + p) * 2 + 1], pr = PW[((d * 64 + p) * 17 + k) * 2], pi = PW[((d * 64 + p) * 17 + k) * 2 + 1];
                    const float tr = cr * pr - ci * pi, ti = cr * pi + ci * pr;
                    acc += tr * BBs[((d * 64 + p) * 16 + i) * 2] - ti * BBs[((d * 64 + p) * 16 + i) * 2 + 1]; }
                KT[e] = acc; }
            __syncthreads();
            bf16_t* OPS = (bf16_t*)(ws + WS_OPS) + (size_t)(l * 16 + g) * 256 * 256;
            bf16_t* OPY = (bf16_t*)(ws + WS_OPY) + (size_t)(l * 16 + g) * 256 * 512;
            for (int e = tid; e < 256 * 32; e += 512) {
                const int row = e >> 5, c0 = (e & 31) * 8, d = row >> 7, p = (row >> 1) & 63, ri = row & 1, sx = c0 >> 4, i0 = c0 & 15, k = d == 0 ? 15 - sx : sx;
                const float pr = PW[((d * 64 + p) * 17 + k) * 2], pi = PW[((d * 64 + p) * 17 + k) * 2 + 1];
                float v[8];
#pragma unroll
                for (int j = 0; j < 8; ++j) { const float br = BBs[((d * 64 + p) * 16 + i0 + j) * 2], bi = BBs[((d * 64 + p) * 16 + i0 + j) * 2 + 1]; v[j] = ri == 0 ? pr * br - pi * bi : pr * bi + pi * br; }
                u32x4 w; w.x = cvt_pk_bf16(v[0], v[1]); w.y = cvt_pk_bf16(v[2], v[3]); w.z = cvt_pk_bf16(v[4], v[5]); w.w = cvt_pk_bf16(v[6], v[7]);
                *(u32x4*)(OPS + (size_t)row * 256 + c0) = w; }
            for (int e = tid; e < 256 * 64; e += 512) {
                const int row = e >> 6, c0 = (e & 63) * 8, t = row >> 4, o = row & 15;
                float v[8];
                if (c0 < 256) { const int sx = c0 >> 4, i0 = c0 & 15;
#pragma unroll
                    for (int j = 0; j < 8; ++j) { float x = 0.f; if (sx <= t) x += KT[((0 * 16 + (t - sx)) * 16 + o) * 16 + i0 + j]; if (sx >= t) x += KT[((1 * 16 + (sx - t)) * 16 + o) * 16 + i0 + j]; v[j] = x; } }
                else { const int c2 = c0 - 256, d = c2 >> 7, k = d == 0 ? t + 1 : 16 - t;
#pragma unroll
                    for (int j = 0; j < 8; ++j) { const int p = ((c2 + j) >> 1) & 63, ri = (c2 + j) & 1;
                        const float cr = Cs[((d * 16 + o) * 64 + p) * 2], ci = Cs[((d * 16 + o) * 64 + p) * 2 + 1], pr = PW[((d * 64 + p) * 17 + k) * 2], pi = PW[((d * 64 + p) * 17 + k) * 2 + 1];
                        v[j] = ri == 0 ? cr * pr - ci * pi : -(cr * pi + ci * pr); } }
                u32x4 w; w.x = cvt_pk_bf16(v[0], v[1]); w.y = cvt_pk_bf16(v[2], v[3]); w.z = cvt_pk_bf16(v[4], v[5]); w.w = cvt_pk_bf16(v[6], v[7]);
                *(u32x4*)(OPY + (size_t)row * 512 + c0) = w; }
        }
        __syncthreads();
    }
    SEAM(0);

    for (int l = 0; l < 2; ++l) {
        const int P0 = 1 + l * NPH_LAYER;
        const float* MODL = MOD + (size_t)l * 5 * 6144;
        const unsigned char* WL = ws + WS_WL + (size_t)l * SZ_WL;
        const int nMrow = (l == 0) ? 68 : 64;
        const float* xlat = (l == 0) ? x_in : a.out; const float* xctx = (l == 0) ? ctx_in : XSC;

        if (((PHMASK >> 1) & 1) && l == 0 && IN(P0 + 0)) {
            const int lane = opaque(tid0) & 63;
            for (int r = bid * 8 + wave; r < RT; r += G * 8) {
                const float* src = r < RL ? x_in + (size_t)r * D : ctx_in + (size_t)(r - RL) * D;
                const float* mv = MODL + (size_t)(r < RL ? (r >> 12) : 4) * 6144;
                const RowV n = row_norm(row_load(src, lane));
                row_store_bf16(UB + (size_t)r * D, lane, row_modulate(n, mv, mv + 1024, lane));
            }
        }
        if (l == 0) SEAM(P0 + 0);

        if (((PHMASK >> 2) & 1) && IN(P0 + 1)) {
            const pg8::TabSched S{PARTS.p + l * 8, (const char*)ws, 2, 68 * 23 + 5 * 68, G, bid};
            pg8::EpiProj E{PR, PT, (bf16_t*)(ws + WS_US), 7};
            pg8::gemm_phase<1024, 1024>(lds, S, E);
        }
        SEAM(P0 + 1);
        if (((PHMASK >> 13) & 1) && IN(P0 + 2)) {
            const int tid = opaque(tid0), lane = tid & 63;
            LAS float* rp = (LAS float*)lds;
            for (int i = tid; i < 6 * 465; i += 512) rp[i] = a.in[24][l * 2790 + i];
            __syncthreads();
            const int qn = lane & 15, g = lane >> 4;
            const int nunits = 6144 + (l == 0 ? 384 : 0);
            for (int u = bid * 8 + wave; u < nunits; u += G * 8) {
                const bool lat = u < 6144;
                const int uu = lat ? u : u - 6144;
                const int h = uu % 6; int t = uu / 6;
                int b, r = 0, qb, tq, rs = 0, bs = 0, w = 0, cs = 0;
                if (lat) { qb = t & 3; t >>= 2; r = t & 63; b = t >> 6; rs = r - 4 < 0 ? 0 : (r - 4 > 56 ? 56 : r - 4); bs = qb == 0 ? 0 : (qb == 1 ? 8 : (qb == 2 ? 24 : 32));
                    w = 16 * qb + qn; cs = w - 8 < 0 ? 0 : (w - 8 > 48 ? 48 : w - 8); tq = b * SEQ + r * 64 + w; }
                else { qb = t & 15; b = t >> 4; tq = RL + b * CTXL + 16 * qb + qn; }
                const bf16_t* qp = PR + (size_t)tq * LDP + PC_Q + h * 64 + 8 * g;
                const bf16x8 q0 = *(const bf16x8*)qp, q1 = *(const bf16x8*)(qp + 32);
                f32x4 S[32];
                if (lat) {
#pragma unroll
                    for (int p = 0; p < 8; ++p) {
                        const int base = b * SEQ + (rs + p) * 64 + bs;
#pragma unroll
                        for (int hf = 0; hf < 2; ++hf) {
                            const bf16_t* kp = PR + (size_t)(base + 8 * (qn >> 2) + (qn & 3) + 4 * hf) * LDP + PC_K + h * 64 + 8 * g;
                            const bf16x8 k0 = *(const bf16x8*)kp, k1 = *(const bf16x8*)(kp + 32);
                            f32x4 acc = {0.f, 0.f, 0.f, 0.f};
                            acc = __builtin_amdgcn_mfma_f32_16x16x32_bf16(k0, q0, acc, 0, 0, 0);
                            acc = __builtin_amdgcn_mfma_f32_16x16x32_bf16(k1, q1, acc, 0, 0, 0);
                            const int rowoff = (h * 15 + (rs + p - r + 7)) * 31;
#pragma unroll
                            for (int j = 0; j < 4; ++j) { const int c = bs + 8 * g + 4 * hf + j; const bool ok = (c >= cs) && (c < cs + 16);
                                const int dc = ok ? c - w + 15 : 0;
                                acc[j] = ok ? acc[j] * 0.125f + rp[rowoff + dc] : -3.0e38f; }
                            S[2 * p + hf] = acc;
                        }
                    }
                } else {
#pragma unroll
                    for (int p = 0; p < 16; ++p) S[p] = (f32x4){-3.0e38f, -3.0e38f, -3.0e38f, -3.0e38f};
                }
#pragma unroll
                for (int p = 0; p < 8; ++p) {
                    const int base = RL + b * CTXL + 32 * p;
#pragma unroll
                    for (int hf = 0; hf < 2; ++hf) {
                        const bf16_t* kp = PR + (size_t)(base + 8 * (qn >> 2) + (qn & 3) + 4 * hf) * LDP + PC_K + h * 64 + 8 * g;
                        const bf16x8 k0 = *(const bf16x8*)kp, k1 = *(const bf16x8*)(kp + 32);
                        f32x4 acc = {0.f, 0.f, 0.f, 0.f};
                        acc = __builtin_amdgcn_mfma_f32_16x16x32_bf16(k0, q0, acc, 0, 0, 0);
                        acc = __builtin_amdgcn_mfma_f32_16x16x32_bf16(k1, q1, acc, 0, 0, 0);
                        S[16 + 2 * p + hf] = acc * 0.125f;
                    }
                }
                float mx = -3.0e38f;
#pragma unroll
                for (int i = 0; i < 32; ++i) mx = fmaxf(fmaxf(mx, fmaxf(S[i][0], S[i][1])), fmaxf(S[i][2], S[i][3]));
                mx = fmaxf(mx, __shfl_xor(mx, 16)); mx = fmaxf(mx, __shfl_xor(mx, 32));
                float sum = 0.f;
#pragma unroll
                for (int i = 0; i < 32; ++i) {
#pragma unroll
                    for (int j = 0; j < 4; ++j) { const float e = __expf(S[i][j] - mx); S[i][j] = e; sum += e; } }
                sum += __shfl_xor(sum, 16); sum += __shfl_xor(sum, 32);
                const float inv = 1.0f / sum;
                f32x4 O[4];
#pragma unroll
                for (int dt = 0; dt < 4; ++dt) O[dt] = (f32x4){0.f, 0.f, 0.f, 0.f};
                const bf16_t* vt = PT + (size_t)(PT_V + h * 64 + qn) * RT + 8 * g;
#pragma unroll
                for (int p = 0; p < 16; ++p) {
                    if (p < 8 && !lat) continue;
                    const int base = p < 8 ? b * SEQ + (rs + p) * 64 + bs : RL + b * CTXL + 32 * (p - 8);
                    u32x4 pw; pw.x = cvt_pk_bf16(S[2 * p][0], S[2 * p][1]); pw.y = cvt_pk_bf16(S[2 * p][2], S[2 * p][3]); pw.z = cvt_pk_bf16(S[2 * p + 1][0], S[2 * p + 1][1]); pw.w = cvt_pk_bf16(S[2 * p + 1][2], S[2 * p + 1][3]);
                    bf16x8 pf; __builtin_memcpy(&pf, &pw, 16);
#pragma unroll
                    for (int dt = 0; dt < 4; ++dt) { const bf16x8 vf = *(const bf16x8*)(vt + (size_t)(16 * dt) * RT + base);
                        O[dt] = __builtin_amdgcn_mfma_f32_16x16x32_bf16(vf, pf, O[dt], 0, 0, 0); }
                }
                bf16_t* op = YB + (size_t)tq * YW + YC_C + h * 64 + 4 * g;
#pragma unroll
                for (int dt = 0; dt < 4; ++dt) { u32x2 o2; o2.x = cvt_pk_bf16(O[dt][0] * inv, O[dt][1] * inv); o2.y = cvt_pk_bf16(O[dt][2] * inv, O[dt][3] * inv); *(u32x2*)(op + 16 * dt) = o2; }
            }
            __syncthreads();
            {
                const int tid = opaque(tid0), lane = tid & 63;
                LAS float* XC = (LAS float*)lds;
                LAS f32x2* AB = (LAS f32x2*)(lds + 16 * 384 * 4);
                const float* cw = a.in[7] + l * 4 * 384; const float* cb = a.in[8] + l * 384;
                const bf16_t* LW = (const bf16_t*)(ws + WS_LW) + (size_t)l * 24 * 4096;
                bf16_t* LT = (bf16_t*)(ws + WS_LT); f32x2* LAGG = (f32x2*)(ws + WS_LAGG);
                const int dir = (wave >> 2) & 1, ntile = wave & 3, tk = lane & 15, kg = lane >> 4;
                LAS float* CT = (LAS float*)(lds + 16 * 384 * 4 + 2 * 16 * 384 * 8);
                for (int i = tid; i < 768; i += 512) { CT[i] = a.in[10][l * 768 + i]; CT[768 + i] = a.in[12][l * 768 + i]; CT[1536 + i] = -8.0f * softplus(-a.in[13][l * 768 + i]); }
                for (int n = bid; n < NCHK; n += G) {
                    const int r0 = 16 * n; int start, len, pos0, bb; row_seq(r0, start, len, pos0, bb);
                    __syncthreads();
#pragma unroll
                    for (int i = 0; i < 12; ++i) { const int idx = tid + 512 * i, tok = idx / 384, ch = idx - tok * 384, pos = pos0 + tok;
                        const bf16_t* pr = PR + (size_t)(r0 + tok) * LDP + PC_AC + ch;
                        float xc = cb[ch] + cw[2 * 384 + ch] * bf2f(pr[0]);
                        if (pos >= 2) xc += cw[ch] * bf2f(pr[-2 * LDP]);
                        if (pos >= 1) xc += cw[384 + ch] * bf2f(pr[-LDP]);
                        if (pos + 1 < len) xc += cw[3 * 384 + ch] * bf2f(pr[LDP]);
                        XC[idx] = xc; }
                    __syncthreads();
#pragma unroll 1
                    for (int g = 0; g < 6; ++g) {
                        f32x4 ar = {0.f, 0.f, 0.f, 0.f}, ai = {0.f, 0.f, 0.f, 0.f};
#pragma unroll
                        for (int ks = 0; ks < 2; ++ks) {
                            const LAS float* xp = XC + tk * 384 + g * 64 + 32 * ks + 8 * kg;
                            const f32x4 x0 = *(const LAS f32x4*)xp, x1 = *(const LAS f32x4*)(xp + 4);
                            u32x4 xw; xw.x = cvt_pk_bf16(x0[0], x0[1]); xw.y = cvt_pk_bf16(x0[2], x0[3]); xw.z = cvt_pk_bf16(x1[0], x1[1]); xw.w = cvt_pk_bf16(x1[2], x1[3]);
                            bf16x8 xf; __builtin_memcpy(&xf, &xw, 16);
                            const bf16_t* wp = LW + ((size_t)((dir * 2 + 0) * 6 + g) * 64 + 16 * ntile + tk) * 64 + 32 * ks + 8 * kg;
                            const bf16x8 wr8 = *(const bf16x8*)wp, wi8 = *(const bf16x8*)(wp + 6 * 4096);
                            ar = __builtin_amdgcn_mfma_f32_16x16x32_bf16(xf, wr8, ar, 0, 0, 0);
                            ai = __builtin_amdgcn_mfma_f32_16x16x32_bf16(xf, wi8, ai, 0, 0, 0);
                        }
                        const int ch = g * 64 + 16 * ntile + tk;
                        const float br = CT[dir * 384 + ch], bi = CT[768 + dir * 384 + ch], sp8 = CT[1536 + dir * 384 + ch];
#pragma unroll
                        for (int j = 0; j < 4; ++j) { const int tok = 4 * kg + j;
                            const float la = sigm(ar[j] + br) * sp8, y = 2.0f * la;
                            const float av = 1.0f + la * (1.0f + la * (0.5f + la * (0.16666667f + la * (0.041666667f + la * 0.0083333333f))));
                            const float om = -y * (1.0f + y * (0.5f + y * (0.16666667f + y * (0.041666667f + y * (0.0083333333f + y * 0.0013888889f)))));
                            const float bt = __builtin_sqrtf(om) * sigm(ai[j] + bi) * XC[tok * 384 + ch];
                            AB[(dir * 16 + tok) * 384 + ch] = (f32x2){av, bt}; }
                    }
                    __syncthreads();
                    if (tid < 384) {
                        float hf = 0.f, pf = 1.f, hb = 0.f, pb = 1.f;
#pragma unroll
                        for (int t = 0; t < 16; ++t) {
                            const f32x2 f = AB[t * 384 + tid], bk = AB[(16 + 15 - t) * 384 + tid];
                            hf = f[0] * hf + f[1]; pf *= f[0]; hb = bk[0] * hb + bk[1]; pb *= bk[0];
                            AB[t * 384 + tid] = (f32x2){pf, hf}; AB[(16 + 15 - t) * 384 + tid] = (f32x2){pb, hb}; }
                        LAGG[((size_t)n * 2 + 0) * 384 + tid] = (f32x2){pf, hf}; LAGG[((size_t)n * 2 + 1) * 384 + tid] = (f32x2){pb, hb};
                    }
                    __syncthreads();
#pragma unroll
                    for (int i = 0; i < 12; ++i) { const int idx = tid + 512 * i, tok = idx / 384, ch = idx - tok * 384;
                        const f32x2 f = AB[idx], bk = AB[16 * 384 + idx];
                        bf16_t* o = LT + (size_t)(r0 + tok) * 1152 + ch;
                        o[0] = f2bf(f[1] + bk[1]); o[384] = f2bf(f[0]); o[768] = f2bf(bk[0]); }
                }
                __syncthreads();
            }
            {
                const int tid = opaque(tid0), lane = tid & 63;
                constexpr int ZS = SEQ + 16;
                LAS bf16_t* R0 = (LAS bf16_t*)lds;
                LAS bf16_t* R1 = R0 + 8224;
                LAS bf16_t* ZA = R1 + 8224;
                const LAS unsigned* Rdw = (const LAS unsigned*)lds;
#define HY_ZF(b, s) ((b) * ZS + ((s) & ~63) + (((((s) >> 3) & 7) ^ (((s) >> 7) & 1)) << 3) + ((s) & 7))
                const float* hcw = a.in[14] + l * 3 * 768; const float* hcb = a.in[15] + l * 768;
                const float* nrm = (const float*)(ctl + CW_HYN);
                bf16_t* YT = (bf16_t*)(ws + WS_YT);
                const int r32 = lane & 31, hh = lane >> 5, il = r32 >> 2, bq = r32 & 3, iblk = 8 * wave + il;
                const int x0b = 4095 - r32 + 8 * hh, par = x0b & 1;
                const int abase = (par ? 4112 : 0) + ((x0b - par) >> 1);
                for (int c = bid; c < 256; c += G) {
                    __syncthreads();
#pragma unroll 1
                    for (int it = tid; it < 3 * 4 * 512; it += 512) {
                        const int arr = it >> 11, b = (it >> 9) & 3, s8 = (it & 511) * 8, ch = arr * 256 + c;
                        const bf16_t* pp = PT + (size_t)ch * RT + b * SEQ + s8;
                        const u32x4 pv = *(const u32x4*)pp;
                        const float w0 = hcw[ch], w1 = hcw[768 + ch], w2 = hcw[1536 + ch], cb0 = hcb[ch];
                        float p[10];
                        p[0] = s8 > 0 ? bf2f(pp[-1]) : 0.f; p[9] = s8 + 8 < SEQ ? bf2f(pp[8]) : 0.f;
                        p[1] = bflo(pv.x); p[2] = bfhi(pv.x); p[3] = bflo(pv.y); p[4] = bfhi(pv.y); p[5] = bflo(pv.z); p[6] = bfhi(pv.z); p[7] = bflo(pv.w); p[8] = bfhi(pv.w);
                        float z[8];
#pragma unroll
                        for (int j = 0; j < 8; ++j) z[j] = cb0 + w0 * p[j] + w1 * p[j + 1] + w2 * p[j + 2];
                        u32x4 w; w.x = cvt_pk_bf16(z[0], z[1]); w.y = cvt_pk_bf16(z[2], z[3]); w.z = cvt_pk_bf16(z[4], z[5]); w.w = cvt_pk_bf16(z[6], z[7]);
                        *(LAS u32x4*)(ZA + arr * 4 * ZS + HY_ZF(b, s8)) = w;
                    }
#pragma unroll 1
                    for (int o = 0; o < 2; ++o) {
                        const bf16_t* kf = (const bf16_t*)(ws + WS_KFL) + ((size_t)((l * 2 + 0) * 2 + o) * 256 + c) * SEQ;
                        const bf16_t* kb = (const bf16_t*)(ws + WS_KFL) + ((size_t)((l * 2 + 1) * 2 + o) * 256 + c) * SEQ;
                        for (int x = tid; x < 8192; x += 512) R0[x] = x < 4096 ? kf[4095 - x] : (x <= 8190 ? kb[x - 4095] : (bf16_t)0);
                        __syncthreads();
                        for (int x = tid; x < 8192; x += 512) R1[x] = x < 8191 ? R0[x + 1] : (bf16_t)0;
                        __syncthreads();
                        const LAS bf16_t* Z = ZA + (o == 0 ? 0 : 4 * ZS) + bq * ZS;
                        typedef float f32x16 __attribute__((ext_vector_type(16)));
                        f32x16 acc0, acc1;
#pragma unroll
                        for (int q = 0; q < 16; ++q) { acc0[q] = 0.f; acc1[q] = 0.f; }
                        const int dlo = 8 * wave - 63, dhi = 8 * wave + 7;
#pragma unroll 1
                        for (int dl = dlo; dl <= dhi; ++dl) {
                            const int j = iblk - dl; const bool ok = (j >= 0) && (j < 64); const int jc = j < 0 ? 0 : (j > 63 ? 63 : j);
                            const LAS bf16_t* zp = Z + jc * 64; const int sw = (jc >> 1) & 1;
                            const LAS unsigned* ap = Rdw + abase - 32 * dl;
                            bf16x8 bf[4];
#pragma unroll
                            for (int kk = 0; kk < 4; ++kk) { bf16x8 t = *(const LAS bf16x8*)(zp + (((2 * kk + hh) ^ sw) << 3)); bf[kk] = ok ? t : (bf16x8){0, 0, 0, 0, 0, 0, 0, 0}; }
#pragma unroll
                            for (int kk = 0; kk < 4; ++kk) {
                                const LAS unsigned* a0 = ap + 8 * kk; const LAS unsigned* a1 = ap - 16 + 8 * kk;
                                u32x4 w0 = {a0[0], a0[1], a0[2], a0[3]}, w1 = {a1[0], a1[1], a1[2], a1[3]};
                                bf16x8 f0, f1; __builtin_memcpy(&f0, &w0, 16); __builtin_memcpy(&f1, &w1, 16);
                                acc0 = __builtin_amdgcn_mfma_f32_32x32x16_bf16(f0, bf[kk], acc0, 0, 0, 0);
                                acc1 = __builtin_amdgcn_mfma_f32_32x32x16_bf16(f1, bf[kk], acc1, 0, 0, 0);
                            }
                        }
                        const float inv = 1.0f / (nrm[(l * 2 + o) * 256 + c] + 1e-6f), hb = a.in[23][(l * 2 + o) * 256 + c];
                        LAS bf16_t* GI = ZA + (o + 1) * 4 * ZS;
                        const LAS bf16_t* ZI = ZA + (o == 0 ? 0 : 4 * ZS);
#pragma unroll
                        for (int q = 0; q < 16; ++q) {
                            const int a0r = (q & 3) + 8 * (q >> 2) + 4 * hh, t0 = 64 * iblk + a0r, t1 = t0 + 32;
                            const int i0 = HY_ZF(bq, t0), i1 = HY_ZF(bq, t1);
                            const float zv0 = bf2f(ZI[i0]), zv1 = bf2f(ZI[i1]);
                            const float y0 = bf2f(GI[i0]) * (acc0[q] * inv + hb * zv0), y1v = bf2f(GI[i1]) * (acc1[q] * inv + hb * zv1);
                            GI[i0] = f2bf(y0); GI[i1] = f2bf(y1v);
                        }
                        __syncthreads();
                    }
                    for (int it = tid; it < 4 * 512; it += 512) { const int b = it >> 9, s8 = (it & 511) * 8;
                        *(u32x4*)(YT + (size_t)c * RT + b * SEQ + s8) = *(const LAS u32x4*)(ZA + 2 * 4 * ZS + HY_ZF(b, s8)); }
                    if (l == 0) {
                        __syncthreads();
                        LAS float* zc = (LAS float*)lds;
                        LAS float* kc = zc + 3072;
                        LAS float* y1c = kc + 1024;
                        for (int it = tid; it < 3072; it += 512) { const int arr = it >> 10, b = (it >> 8) & 3, sx = it & 255, ch = arr * 256 + c;
                            const bf16_t* pp = PT + (size_t)ch * RT + RL + b * CTXL + sx;
                            float z = hcb[ch] + hcw[768 + ch] * bf2f(pp[0]); if (sx > 0) z += hcw[ch] * bf2f(pp[-1]); if (sx + 1 < CTXL) z += hcw[1536 + ch] * bf2f(pp[1]);
                            zc[it] = z; }
                        for (int it = tid; it < 1024; it += 512) { const int o = it >> 9, dir = (it >> 8) & 1, tt = it & 255; kc[it] = bf2f(((const bf16_t*)(ws + WS_KFC))[((size_t)(dir * 2 + o) * 256 + c) * CTXL + tt]); }
                        __syncthreads();
#pragma unroll 1
                        for (int o = 0; o < 2; ++o) {
                            const float inv = 1.0f / (nrm[1024 + o * 256 + c] + 1e-6f), hb = a.in[23][o * 256 + c];
                            for (int it = tid; it < 1024; it += 512) { const int b = it >> 8, t = it & 255;
                                const LAS float* zi = o == 0 ? zc + b * 256 : y1c + b * 256;
                                const LAS float* kfc = kc + (o * 2 + 0) * 256; const LAS float* kbc = kc + (o * 2 + 1) * 256;
                                float acc = 0.f;
                                for (int sx = 0; sx <= t; ++sx) acc += kfc[t - sx] * zi[sx];
                                for (int sx = t + 1; sx < CTXL; ++sx) acc += kbc[sx - t] * zi[sx];
                                const float y = zc[(o + 1) * 1024 + b * 256 + t] * (acc * inv + hb * zi[t]);
                                if (o == 0) y1c[it] = y; else YT[(size_t)c * RT + RL + b * CTXL + t] = f2bf(y); }
                            __syncthreads();
                        }
                    }
                }
#undef HY_ZF
                __syncthreads();
            }
            {
                const pg8::TabSched S{PARTS.p + 18 + l * 3, (const char*)ws, 1, 80, G, bid};
                pg8::EpiS5State E{(float*)(ws + WS_S5S)};
                pg8::gemm_phase<512, 256>(lds, S, E);
            }
        }
        SEAM(P0 + 2);
        if (((PHMASK >> 14) & 1) && IN(P0 + 3)) {
            const int tid = opaque(tid0), lane = tid & 63;
            LAS float* st = (LAS float*)lds;
            const float* S5S = (const float*)(ws + WS_S5S); bf16_t* US = (bf16_t*)(ws + WS_US);
            for (int u = bid; u < 128; u += G) {
                const int d = u & 1, g = (u >> 1) & 15, b = u >> 5;
                __syncthreads();
                for (int i = tid; i < 272 * 32; i += 512) { const int q = i >> 5, c4 = (i & 31) * 4; const int n = q < 16 ? 1024 + 16 * b + q : 256 * b + (q - 16);
                    const f32x4 v = *(const f32x4*)(S5S + ((size_t)g * NCHKP + n) * 256 + d * 128 + c4);
                    st[q * 128 + c4] = v[0]; st[q * 128 + c4 + 1] = v[1]; st[q * 128 + c4 + 2] = v[2]; st[q * 128 + c4 + 3] = v[3]; }
                __syncthreads();
                if (wave == 0) {
                    const float* ab = (const float*)(ws + WS_AB16) + ((size_t)((l * 2 + d) * 16 + g) * 64 + lane) * 2;
                    const float ar = ab[0], ai = ab[1];
                    float hr = 0.f, hi = 0.f;
                    for (int k = 0; k < 272; ++k) {
                        const int q = d == 0 ? k : (k < 16 ? 15 - k : 287 - k);
                        const int n = q < 16 ? 1024 + 16 * b + q : 256 * b + (q - 16);
                        *(unsigned*)(US + ((size_t)g * NCHKP + n) * 512 + 256 + d * 128 + 2 * lane) = cvt_pk_bf16(hr, hi);
                        const float sr = st[q * 128 + 2 * lane], si = st[q * 128 + 2 * lane + 1];
                        const float nr = ar * hr - ai * hi + sr, ni = ar * hi + ai * hr + si;
                        hr = nr; hi = ni;
                    }
                }
            }
            __syncthreads();
            for (int u = bid - 128; u >= 0 && u < 48; u += G) {
                const int cb6 = u % 6, d = (u / 6) & 1, b = u / 12;
                LAS f32x2* sa = (LAS f32x2*)lds;
                const f32x2* LAGG = (const f32x2*)(ws + WS_LAGG); float* HIN = (float*)(ws + WS_LHIN);
                __syncthreads();
                for (int i = tid; i < 272 * 64; i += 512) { const int q = i >> 6, c = i & 63; const int n = q < 16 ? 1024 + 16 * b + q : 256 * b + (q - 16);
                    sa[i] = LAGG[((size_t)n * 2 + d) * 384 + cb6 * 64 + c]; }
                __syncthreads();
                if (wave == 0) {
                    float h = 0.f;
                    for (int k = 0; k < 272; ++k) {
                        const int q = d == 0 ? k : (k < 16 ? 15 - k : 287 - k);
                        const int n = q < 16 ? 1024 + 16 * b + q : 256 * b + (q - 16);
                        HIN[((size_t)n * 2 + d) * 384 + cb6 * 64 + lane] = h;
                        const f32x2 v = sa[q * 64 + lane];
                        h = v[0] * h + v[1];
                    }
                }
            }
            __syncthreads();
        }
        SEAM(P0 + 3);
        if (((PHMASK >> 15) & 1) && IN(P0 + 4)) {
            const pg8::TabSched S{PARTS.p + 19 + l * 3, (const char*)ws, 1, 80, G, bid};
            pg8::EpiS5Main E{(bf16_t*)(ws + WS_GL), PR, a.in[32] + l * 256};
            pg8::gemm_phase<512, 512>(lds, S, E);
            {
                const int tid = opaque(tid0);
                const bf16_t* YT = (const bf16_t*)(ws + WS_YT);
                LAS bf16_t* tl = (LAS bf16_t*)lds;
                const int nrt = nMrow * 4;
                for (int t = bid; t < 4 * nrt; t += G) {
                    const int c0 = (t & 3) * 64, r0 = (t >> 2) * 64;
                    __syncthreads();
                    { const int cc = tid >> 3, r8 = (tid & 7) * 8; *(LAS u32x4*)(tl + cc * 72 + r8) = *(const u32x4*)(YT + (size_t)(c0 + cc) * RT + r0 + r8); }
                    __syncthreads();
                    { const int rr = tid >> 3, c8 = (tid & 7) * 8; unsigned short e[8];
#pragma unroll
                        for (int j = 0; j < 8; ++j) e[j] = tl[(c8 + j) * 72 + rr];
                        u32x4 w; w.x = e[0] | ((unsigned)e[1] << 16); w.y = e[2] | ((unsigned)e[3] << 16); w.z = e[4] | ((unsigned)e[5] << 16); w.w = e[6] | ((unsigned)e[7] << 16);
                        *(u32x4*)(YB + (size_t)(r0 + rr) * YW + YC_B + c0 + c8) = w; }
                }
                __syncthreads();
            }
            {
                const int tid = opaque(tid0);
                const bf16_t* LT = (const bf16_t*)(ws + WS_LT); const float* HIN = (const float*)(ws + WS_LHIN);
                const int nrows = nMrow * 256;
                for (int it = bid * 512 + tid; it < nrows * 48; it += G * 512) {
                    const int r = it / 48, c8 = (it - r * 48) * 8, n = r >> 4;
                    const u32x4 gt = *(const u32x4*)(PR + (size_t)r * LDP + PC_AG + c8);
                    const bf16_t* lt = LT + (size_t)r * 1152 + c8;
                    const u32x4 sv = *(const u32x4*)lt, pf = *(const u32x4*)(lt + 384), pb = *(const u32x4*)(lt + 768);
                    const float* hf = HIN + ((size_t)n * 2 + 0) * 384 + c8; const float* hb = hf + 384;
                    const f32x4 hf0 = *(const f32x4*)hf, hf1 = *(const f32x4*)(hf + 4), hb0 = *(const f32x4*)hb, hb1 = *(const f32x4*)(hb + 4);
                    u32x4 w;
                    w.x = cvt_pk_bf16(gelu_f(bflo(gt.x)) * (bflo(sv.x) + bflo(pf.x) * hf0[0] + bflo(pb.x) * hb0[0]), gelu_f(bfhi(gt.x)) * (bfhi(sv.x) + bfhi(pf.x) * hf0[1] + bfhi(pb.x) * hb0[1]));
                    w.y = cvt_pk_bf16(gelu_f(bflo(gt.y)) * (bflo(sv.y) + bflo(pf.y) * hf0[2] + bflo(pb.y) * hb0[2]), gelu_f(bfhi(gt.y)) * (bfhi(sv.y) + bfhi(pf.y) * hf0[3] + bfhi(pb.y) * hb0[3]));
                    w.z = cvt_pk_bf16(gelu_f(bflo(gt.z)) * (bflo(sv.z) + bflo(pf.z) * hf1[0] + bflo(pb.z) * hb1[0]), gelu_f(bfhi(gt.z)) * (bfhi(sv.z) + bfhi(pf.z) * hf1[1] + bfhi(pb.z) * hb1[1]));
                    w.w = cvt_pk_bf16(gelu_f(bflo(gt.w)) * (bflo(sv.w) + bflo(pf.w) * hf1[2] + bflo(pb.w) * hb1[2]), gelu_f(bfhi(gt.w)) * (bfhi(sv.w) + bfhi(pf.w) * hf1[3] + bfhi(pb.w) * hb1[3]));
                    *(u32x4*)(YB + (size_t)r * YW + YC_A + c8) = w;
                }
            }
        }
        SEAM(P0 + 4);
        if (((PHMASK >> 15) & 1) && IN(P0 + 5)) {
            const pg8::TabSched S{PARTS.p + 20 + l * 3, (const char*)ws, 1, nMrow, G, bid};
            pg8::EpiS5Glu E{YB, (const bf16_t*)(ws + WS_GL), a.in[34] + l * 256};
            pg8::gemm_phase<256, 256>(lds, S, E);
        }
        SEAM(P0 + 5);
        if (((PHMASK >> 3) & 1) && IN(P0 + 6)) {
            const pg8::MergeSched S{(const char*)ws, (long long)WS_YB, (long long)(WS_WL + (size_t)l * SZ_WL + SZ_WINR + SZ_WINHY), nMrow, G, bid};
            pg8::EpiGate E{PR, UB};
            pg8::gemm_phase<1280, 1280>(lds, S, E);
        }
        SEAM(P0 + 6);
        if (((PHMASK >> 4) & 1) && IN(P0 + 7)) {
            const pg8::TabSched S{l == 0 ? PARTS.p + 24 : PARTS.p + 14, (const char*)ws, l == 0 ? 2 : 1, l == 0 ? 256 + 64 : 256, G, bid};
            pg8::EpiRes E{PRE, xlat, xctx, MODL + 2048, (float*)(ws + WS_EXTRA)};
            pg8::gemm_phase<1024, 1024>(lds, S, E);
        }
        SEAM(P0 + 7);
        if (((PHMASK >> 5) & 1) && IN(P0 + 8)) {
            const int lane = opaque(tid0) & 63;
            if (l == 1) convert_tiles(a, JT_MOE, (LAS float*)lds, bid, G);
            const float* lg = a.in[40] + l * D; const float* lb = a.in[41] + l * D;
            const int nrows = nMrow * 256;
            for (int r = bid * 8 + wave; r < nrows; r += G * 8) {
                const float* mv = MODL + (size_t)(r < RL ? (r >> 12) : 4) * 6144;
                RowV pre;
                if (r < RL) pre = row_load(PRE + (size_t)r * D, lane);
                else { const float* pp = (const float*)(ws + WS_EXTRA) + (size_t)(r - RL) * D; const RowV xin = row_load(ctx_in + (size_t)(r - RL) * D, lane), p0 = row_load(pp, lane), p1 = row_load(pp + (size_t)RC * D, lane), p2 = row_load(pp + (size_t)2 * RC * D, lane), p3 = row_load(pp + (size_t)3 * RC * D, lane);
#pragma unroll
                    for (int i = 0; i < 4; ++i) pre.v[i] = xin.v[i] * ALPHA + ((p0.v[i] + p1.v[i]) + (p2.v[i] + p3.v[i])); }
                const RowV x1 = row_affine(row_norm(pre), lg, lb, lane);
                row_store(r < RL ? a.out + (size_t)r * D : XSC + (size_t)(r - RL) * D, lane, x1);
                const RowV u2 = row_modulate(row_norm(x1), mv + 3072, mv + 4096, lane);
                row_store_bf16(UB + (size_t)r * D, lane, u2);
                if (l == 1) {
                    float lg8[8];
#pragma unroll
                    for (int e = 0; e < 8; ++e) lg8[e] = 0.f;
                    const float* wr = a.in[47];
#pragma unroll
                    for (int i = 0; i < 4; ++i)
#pragma unroll
                        for (int j = 0; j < 4; ++j) { const float uv = u2.v[i][j]; const float* wp = wr + (size_t)(256 * i + 4 * lane + j) * 8;
                            const f32x4 w0 = *(const f32x4*)wp, w1 = *(const f32x4*)(wp + 4);
                            lg8[0] += uv * w0[0]; lg8[1] += uv * w0[1]; lg8[2] += uv * w0[2]; lg8[3] += uv * w0[3]; lg8[4] += uv * w1[0]; lg8[5] += uv * w1[1]; lg8[6] += uv * w1[2]; lg8[7] += uv * w1[3]; }
#pragma unroll
                    for (int e = 0; e < 8; ++e) lg8[e] = wave_sum(lg8[e]);
                    if (lane == 0) {
                        int i1 = 0; float v1 = lg8[0];
#pragma unroll
                        for (int e = 1; e < 8; ++e) if (lg8[e] > v1) { v1 = lg8[e]; i1 = e; }
                        int i2 = 0; float v2 = -3.0e38f;
#pragma unroll
                        for (int e = 0; e < 8; ++e) if (e != i1 && lg8[e] > v2) { v2 = lg8[e]; i2 = e; }
                        const float e2 = expf(v2 - v1), w1 = 1.f / (1.f + e2), w2 = e2 / (1.f + e2);
                        int* tk = (int*)(ws + WS_TOK) + (size_t)r * 8;
                        tk[0] = i1; tk[1] = i2; ((float*)tk)[2] = w1; ((float*)tk)[3] = w2;
                        tk[4] = (int)atomicAdd(ctl + CW_MOECNT + 64 * i1, 1u); tk[5] = (int)atomicAdd(ctl + CW_MOECNT + 64 * i2, 1u);
                    }
                }
            }
        }
        SEAM(P0 + 8);
        if (l == 0) {
            if (((PHMASK >> 6) & 1) && IN(P0 + 9)) {
                const pg8::TabSched S{PARTS.p + 16, (const char*)ws, 1, 68 * 22, G, bid};
                pg8::EpiSwiglu E{(bf16_t*)(ws + WS_H), FF_DENSE, 0};
                pg8::gemm_phase<1024, 1024>(lds, S, E);
            }
            SEAM(P0 + 9);
            if (((PHMASK >> 7) & 1) && IN(P0 + 10)) {
                const pg8::TabSched S{PARTS.p + 26, (const char*)ws, 3, 256 + 48 + 16, G, bid};
                pg8::EpiRes E{PRE, a.out, XSC, MODL + 5120, (float*)(ws + WS_EXTRA)};
                pg8::gemm_phase<FF_DENSE, FF_DENSE>(lds, S, E);
            }
            SEAM(P0 + 10);
            if (((PHMASK >> 8) & 1) && IN(P0 + 11)) {
                const int lane = opaque(tid0) & 63;
                const float* lg = a.in[42]; const float* lb = a.in[43];
                const float* MODN = MOD + (size_t)5 * 6144;
                for (int r = bid * 8 + wave; r < RT; r += G * 8) {
                    const float* mv = MODN + (size_t)(r < RL ? (r >> 12) : 4) * 6144;
                    RowV pre;
                    if (r < RL) pre = row_load(PRE + (size_t)r * D, lane);
                    else { const float* pp = (const float*)(ws + WS_EXTRA) + (size_t)(r - RL) * D; const RowV xin = row_load(XSC + (size_t)(r - RL) * D, lane), p0 = row_load(pp, lane), p1 = row_load(pp + (size_t)RC * D, lane), p2 = row_load(pp + (size_t)2 * RC * D, lane), p3 = row_load(pp + (size_t)3 * RC * D, lane);
#pragma unroll
                        for (int i = 0; i < 4; ++i) pre.v[i] = xin.v[i] * ALPHA + ((p0.v[i] + p1.v[i]) + (p2.v[i] + p3.v[i])); }
                    const RowV x2 = row_affine(row_norm(pre), lg, lb, lane);
                    row_store(r < RL ? a.out + (size_t)r * D : XSC + (size_t)(r - RL) * D, lane, x2);
                    row_store_bf16(UB + (size_t)r * D, lane, row_modulate(row_norm(x2), mv, mv + 1024, lane));
                }
            }
            SEAM(P0 + 11);
        } else {
            bf16_t* AG = (bf16_t*)(ws + WS_AG); float* slotw = (float*)(ws + WS_SLOTW); int* tile_e = (int*)(ws + WS_TILEE);
            if (((PHMASK >> 9) & 1) && IN(P0 + 9)) {
                const int tid = opaque(tid0), lane = tid & 63;
                int ts[NE + 1]; ts[0] = 0;
#pragma unroll
                for (int e = 0; e < NE; ++e) { const unsigned c = __hip_atomic_load(ctl + CW_MOECNT + 64 * e, __ATOMIC_RELAXED, __HIP_MEMORY_SCOPE_AGENT); ts[e + 1] = ts[e] + (int)((c + 255u) >> 8); }
                if (bid == 0) for (int mt = tid; mt < ts[NE]; mt += 512) { int e = 0;
#pragma unroll
                    for (int k = 1; k < NE; ++k) e += (mt >= ts[k]) ? 1 : 0;
                    tile_e[mt] = e; }
                for (int r = bid * 8 + wave; r < RL; r += G * 8) {
                    int* tk = (int*)(ws + WS_TOK) + (size_t)r * 8;
                    const u32x4 v0 = *(const u32x4*)(UB + (size_t)r * D + lane * 16), v1 = *(const u32x4*)(UB + (size_t)r * D + lane * 16 + 8);
#pragma unroll
                    for (int k = 0; k < 2; ++k) {
                        const int e = tk[k], pos = tk[4 + k];
                        int st = 0;
#pragma unroll
                        for (int q = 0; q < NE; ++q) st = (e == q) ? ts[q] : st;
                        const int srow = st * 256 + pos;
                        *(u32x4*)(AG + (size_t)srow * D + lane * 16) = v0; *(u32x4*)(AG + (size_t)srow * D + lane * 16 + 8) = v1;
                        if (lane == 0) { slotw[srow] = ((const float*)tk)[2 + k]; tk[6 + k] = srow; }
                    }
                }
            }
            SEAM(P0 + 9);
            int ttl = 0;
            if (lo <= P0 + 13 && P0 + 10 < hi) {
#pragma unroll
                for (int e = 0; e < NE; ++e) { const unsigned c = __hip_atomic_load(ctl + CW_MOECNT + 64 * e, __ATOMIC_RELAXED, __HIP_MEMORY_SCOPE_AGENT); ttl += (int)((c + 255u) >> 8); }
                ttl = __builtin_amdgcn_readfirstlane(ttl);
            }
#pragma unroll
            for (int pass = 0; pass < 2; ++pass) {
                const int tile0 = pass * MOE_TILES_PASS; int ntile = ttl - tile0; ntile = ntile < 0 ? 0 : (ntile > MOE_TILES_PASS ? MOE_TILES_PASS : ntile);
                if (((PHMASK >> 10) & 1) && IN(P0 + 10 + 2 * pass)) {
                    const pg8::MoeSched S{(const char*)AG + (size_t)tile0 * 256 * 1024 * 2, (const char*)(ws + WS_MOEGU), tile_e, 256u * 1024u * 2u, 256u * 1024u * 2u, (size_t)2 * FF_E * 1024 * 2, 28, 16, tile0, ntile, G, bid};
                    pg8::EpiSwiglu E{(bf16_t*)(ws + WS_HM), FF_E, tile0};
                    pg8::gemm_phase<1024, 1024>(lds, S, E);
                }
                SEAM(P0 + 10 + 2 * pass);
                if (((PHMASK >> 11) & 1) && IN(P0 + 11 + 2 * pass)) {
                    const pg8::MoeSched S{(const char*)(ws + WS_HM), (const char*)(ws + WS_MOED), tile_e, 256u * (unsigned)FF_E * 2u, 256u * (unsigned)FF_E * 2u, (size_t)1024 * FF_E * 2, 4, 56, tile0, ntile, G, bid};
                    pg8::EpiMoeDown E{AG, slotw};
                    pg8::gemm_phase<FF_E, FF_E>(lds, S, E);
                }
                SEAM(P0 + 11 + 2 * pass);
            }
            if (((PHMASK >> 12) & 1) && IN(P0 + 14)) {
                const int lane = opaque(tid0) & 63;
                const float* lg = a.in[42] + D; const float* lb = a.in[43] + D;
                for (int r = bid * 8 + wave; r < RL; r += G * 8) {
                    const int* tk = (const int*)(ws + WS_TOK) + (size_t)r * 8;
                    const bf16_t* oa = AG + (size_t)tk[6] * D; const bf16_t* ob = AG + (size_t)tk[7] * D;
                    const float* gv = MODL + (size_t)(r >> 12) * 6144 + 5120;
                    RowV x1 = row_load(a.out + (size_t)r * D, lane), pre;
#pragma unroll
                    for (int i = 0; i < 4; ++i) { const u32x2 va = *(const u32x2*)(oa + 256 * i + 4 * lane), vb = *(const u32x2*)(ob + 256 * i + 4 * lane);
                        const f32x4 f = {bflo(va.x) + bflo(vb.x), bfhi(va.x) + bfhi(vb.x), bflo(va.y) + bflo(vb.y), bfhi(va.y) + bfhi(vb.y)};
                        pre.v[i] = x1.v[i] * ALPHA + *(const f32x4*)(gv + 256 * i + 4 * lane) * f; }
                    row_store(a.out + (size_t)r * D, lane, row_affine(row_norm(pre), lg, lb, lane));
                }
            }
        }
    }
#undef IN
#undef SEAM
}

}

extern "C" void kernel_launch(void* const* d_in, const int* in_sizes, int n_in, void* d_out, int out_size, void* d_ws, size_t ws_size, hipStream_t stream) {
    static int grid = 0;
    if (grid == 0) {
        if (n_in != 51 || ws_size < WS_END) { grid = -1; return; }
        int dev = 0, cus = 0;
        if (hipGetDevice(&dev) != hipSuccess || hipDeviceGetAttribute(&cus, hipDeviceAttributeMultiprocessorCount, dev) != hipSuccess) { grid = -1; return; }
        if (hipFuncSetAttribute((const void*)mk_fwd, hipFuncAttributeMaxDynamicSharedMemorySize, LDS_BYTES) != hipSuccess) { grid = -1; return; }
        grid = cus;
    }
    if (grid < 0) return;
    const float* const* in = (const float* const*)d_in;
    unsigned char* ws = (unsigned char*)d_ws;
    (void)hipMemsetAsync(ws + WS_CTL, 0, CTL_BYTES + al256(2 * 5 * 6144 * 4), stream);
    for (int l = 0; l < 2; ++l) (void)hipMemsetAsync(ws + WS_WL + (size_t)l * SZ_WL + SZ_WINR + (size_t)1152 * 1024 * 2, 0, (size_t)128 * 1024 * 2, stream);
    Args a{};
    for (int i = 0; i < 51; ++i) a.in[i] = in[i];
    a.out = (float*)d_out; a.ws = ws;
    int nlaunch = 0;
    auto run1 = [&](int lo, int hi) { a.ph_lo = lo; a.ph_hi = hi; a.bar_region = nlaunch < 5 ? nlaunch : 5; nlaunch++; hipLaunchKernelGGL(mk_fwd, dim3(grid), dim3(512), LDS_BYTES, stream, a); };
    auto run = [&](int lo, int hi) {
#if defined(SPLIT) && SPLIT
        for (int k = lo; k < hi; ++k) { const int q = (k - 1) % NPH_LAYER, l = (k - 1) / NPH_LAYER; if (k > 0 && (q > 14 || (l == 0 && q > 11) || (l == 1 && q == 0))) continue; run1(k, k + 1); }
#else
        run1(lo, hi);
#endif
    };
    run(0, 1 + 2 * NPH_LAYER);
}
```

```cpp
#include <hip/hip_runtime.h>
#include <stdint.h>
#include <math.h>

#define LAS __attribute__((address_space(3)))
typedef unsigned short bf16_t;
typedef short bf16x8 __attribute__((ext_vector_type(8)));
typedef float f32x4 __attribute__((ext_vector_type(4)));
typedef float f32x2 __attribute__((ext_vector_type(2)));
typedef unsigned u32x4 __attribute__((ext_vector_type(4)));
typedef unsigned u32x2 __attribute__((ext_vector_type(2)));

namespace {
constexpr int D = 1024, NB = 4, SEQ = 4096, CTXL = 256;
constexpr int RL = NB * SEQ, RC = NB * CTXL, RT = RL + RC;
constexpr int IN_COLS = 7040;
constexpr int FF_DENSE = 2816, NE = 8, FF_E = 3584;
constexpr float ALPHA = 1.41421356237309515f;
constexpr int LDP = 5888, PC_AG = 0, PC_AC = 384, PC_D = 768, PC_Q = 1024, PC_K = 1408, PC_G = 1792;
constexpr int NPT = 1280, PT_V = 768;
constexpr int YW = 1280, YC_A = 0, YC_B = 384, YC_C = 640, YC_D = 1024;
constexpr int MOE_P0 = 64, MOE_HCAP = 72;
constexpr int MOE_ROWS_MAX = 2 * RL + NE * 256;

constexpr size_t al256(size_t x) { return (x + 255) & ~(size_t)255; }
constexpr size_t WS_CTL = 0, CTL_BYTES = 131072;
constexpr int CW_BAR = 0;
constexpr int CW_MOECNT = 24576;
constexpr int CW_QUEUE = 28672;
constexpr int CW_HYN = 29696;
constexpr size_t WS_MOD = WS_CTL + CTL_BYTES;
constexpr size_t WS_HYN = WS_MOD + al256(2 * 5 * 6144 * 4);
constexpr size_t WS_S5AB = WS_HYN + 4096;
constexpr size_t WS_S5BB = WS_S5AB + 16384;
constexpr size_t WS_AB16 = WS_S5BB + 262144;
constexpr size_t WS_TILEE = WS_AB16 + 32768;
constexpr size_t WS_TOK = WS_TILEE + 1024;
constexpr size_t WS_SLOTW = WS_TOK + (size_t)RL * 32;
constexpr size_t WS_KFL = al256(WS_SLOTW + (size_t)MOE_ROWS_MAX * 4);
constexpr size_t WS_KFC = WS_KFL + (size_t)2 * 1024 * SEQ * 2;
constexpr size_t WS_XSC = WS_KFC + (size_t)1024 * CTXL * 2;
constexpr size_t WS_UB = WS_XSC + (size_t)RC * D * 4;
constexpr size_t SZ_WINR = (size_t)LDP * 1024 * 2, SZ_WINHY = (size_t)NPT * 1024 * 2, SZ_WBR = (size_t)1024 * 1280 * 2, SZ_WOUT = (size_t)1024 * 1024 * 2;
constexpr size_t SZ_WL = SZ_WINR + SZ_WINHY + SZ_WBR + SZ_WOUT;
constexpr size_t WS_WL = WS_UB + (size_t)RT * D * 2;
constexpr size_t WS_FFGU = WS_WL + 2 * SZ_WL;
constexpr size_t WS_FFD = WS_FFGU + (size_t)2 * FF_DENSE * 1024 * 2;
constexpr size_t WS_WGLU = WS_FFD + (size_t)1024 * FF_DENSE * 2;
constexpr size_t WS_OPS = WS_WGLU + (size_t)2 * 256 * 256 * 2;
constexpr size_t WS_OPY = WS_OPS + (size_t)32 * 256 * 256 * 2;
constexpr size_t WS_LW = WS_OPY + (size_t)32 * 256 * 512 * 2;
constexpr size_t WS_PR = WS_LW + (size_t)48 * 4096 * 2;
constexpr size_t WS_PT = WS_PR + (size_t)RT * LDP * 2;
constexpr size_t WS_YB = WS_PT + (size_t)NPT * RT * 2;
constexpr size_t WS_PRE = WS_YB + (size_t)RT * YW * 2;
constexpr size_t WS_EXTRA = WS_PRE + (size_t)RT * D * 4;
constexpr size_t SZ_EXTRA = (size_t)2 * RT * 384 * 4 + (size_t)RT * 256 * 4;
constexpr size_t WS_END = WS_EXTRA + SZ_EXTRA;
constexpr int NCHK = RT / 16, NCHKP = 1280;
constexpr size_t WS_US = WS_PRE;
constexpr size_t WS_S5S = WS_US + (size_t)16 * NCHKP * 512 * 2;
constexpr size_t WS_GL = WS_S5S + (size_t)16 * NCHKP * 256 * 4;
static_assert(WS_GL + (size_t)RT * 256 * 2 <= WS_EXTRA, "s5 overlay");
constexpr size_t WS_H = WS_PR;
constexpr size_t WS_MOEGU = WS_PR;
constexpr size_t WS_MOED = WS_MOEGU + (size_t)NE * 2 * FF_E * 1024 * 2;
constexpr size_t WS_HM = WS_MOED + (size_t)NE * 1024 * FF_E * 2;
constexpr size_t WS_LT = WS_EXTRA;
constexpr size_t WS_LAGG = WS_LT + (size_t)RT * 3 * 384 * 2;
constexpr size_t WS_LHIN = WS_LAGG + (size_t)NCHK * 2 * 384 * 8;
constexpr size_t WS_YT = WS_LHIN + (size_t)NCHK * 2 * 384 * 4;
static_assert(WS_YT + (size_t)256 * RT * 2 <= WS_EXTRA + SZ_EXTRA, "lru / hyena overlay");
constexpr size_t WS_MGC = WS_EXTRA + (size_t)4 * RC * D * 4;
constexpr size_t WS_AG = WS_EXTRA;
static_assert(WS_HM + (size_t)MOE_HCAP * 256 * FF_E * 2 <= WS_EXTRA, "moe hidden overlay");
constexpr size_t WS_O2X = WS_PRE + ((size_t)32 << 20);
static_assert(WS_HM + (size_t)MOE_HCAP * 256 * FF_E * 2 <= WS_O2X && WS_O2X + (size_t)4 * 2048 * D * 4 <= WS_EXTRA, "moe excess sums");
static_assert((size_t)MOE_ROWS_MAX * 1024 * 2 <= SZ_EXTRA, "moe gather overlay");
static_assert((size_t)RT * FF_DENSE * 2 <= (size_t)RT * LDP * 2, "dense hidden overlay");

__device__ __forceinline__ float sigm(float x) { return __builtin_amdgcn_rcpf(1.f + __builtin_amdgcn_exp2f(-1.44269504089f * x)); }
__device__ __forceinline__ float sigm_acc(float x) { return 1.f / (1.f + expf(-x)); }
__device__ __forceinline__ float silu_acc(float x) { return x / (1.f + expf(-x)); }
__device__ __forceinline__ float gelu_t(float x) { return 0.5f * x * (1.f + tanhf(0.7978845608028654f * (x + 0.044715f * x * x * x))); }
__device__ __forceinline__ float gelu_f(float x) { return x * sigm(1.5957691216057308f * (x + 0.044715f * x * x * x)); }
__device__ __forceinline__ float softplus(float x) { return fmaxf(x, 0.f) + log1pf(expf(-fabsf(x))); }
__device__ __forceinline__ float wave_sum(float v) { for (int o = 32; o; o >>= 1) v += __shfl_xor(v, o); return v; }
__device__ __forceinline__ float wave_max(float v) { for (int o = 32; o; o >>= 1) v = fmaxf(v, __shfl_xor(v, o)); return v; }
__device__ __forceinline__ float bf2f(bf16_t b) { return __uint_as_float(((unsigned)b) << 16); }
__device__ __forceinline__ bf16_t f2bf(float f) { unsigned u = __float_as_uint(f); u += 0x7FFFu + ((u >> 16) & 1u); return (bf16_t)(u >> 16); }
__device__ __forceinline__ unsigned cvt_pk_bf16(float lo, float hi) { unsigned r; asm volatile("v_cvt_pk_bf16_f32 %0, %1, %2" : "=v"(r) : "v"(lo), "v"(hi)); return r; }
__device__ __forceinline__ float bflo(unsigned w) { return __uint_as_float(w << 16); }
__device__ __forceinline__ float bfhi(unsigned w) { return __uint_as_float(w & 0xFFFF0000u); }
__device__ __forceinline__ void row_seq(int r, int& start, int& len, int& pos, int& b) {
    if (r < RL) { b = r >> 12; start = b << 12; len = SEQ; pos = r & 4095; }
    else { const int q = r - RL; b = q >> 8; start = RL + (b << 8); len = CTXL; pos = q & 255; }
}

#define XB_TMO      128
#define XB_XCNT(j)  (256  + 64 * (j))
#define XB_XSUB(j)  (1280 + 64 * (j))
#define XB_XGEN(j)  (2304 + 64 * (j))
#define XB_TOP      3328
#define XB_TOPGEN   3392
#define XCD_BAR_WORDS 3456
#define XB_SPIN_CAP (1u << 18)
__device__ __forceinline__ unsigned xb_ld(unsigned* p)              { return __hip_atomic_load(p, __ATOMIC_RELAXED, __HIP_MEMORY_SCOPE_AGENT); }
__device__ __forceinline__ unsigned xb_add(unsigned* p, unsigned v) { return __hip_atomic_fetch_add(p, v, __ATOMIC_RELAXED, __HIP_MEMORY_SCOPE_AGENT); }
__device__ __forceinline__ unsigned xb_xcc_id() { return (unsigned)__builtin_amdgcn_s_getreg((3 << 11) | 20) & 0xFu; }
#define XB_SPIN(cond, bar) do { unsigned _sp = 0; while (cond) { __builtin_amdgcn_s_sleep(1); \
    if ((++_sp & 255u) == 0u) { if (xb_ld(&(bar)[XB_TMO])) break; if (_sp > XB_SPIN_CAP) { atomicAdd(&(bar)[XB_TMO], 1u); break; } } } } while (0)
struct XcdBarrier { unsigned* bar; unsigned x; volatile LAS unsigned* st; };
__device__ __forceinline__ XcdBarrier xcd_barrier_post(unsigned* bar, volatile LAS unsigned* st) {
    XcdBarrier b; b.bar = bar; b.x = xb_xcc_id(); b.st = st;
    if (threadIdx.x == 0) (void)xb_add(&bar[XB_XCNT(b.x)], 1u);
    return b;
}
__device__ __forceinline__ void xcd_barrier_complete(unsigned* bar, unsigned x, unsigned& nloc, unsigned& nx) {
    const unsigned G = gridDim.x * gridDim.y * gridDim.z;
    unsigned sum, cnt, mine, sp = 0u;
    for (;;) {
        sum = 0u; cnt = 0u; mine = 0u;
#pragma unroll
        for (unsigned j = 0; j < 16; ++j) { const unsigned c = xb_ld(&bar[XB_XCNT(j)]); sum += c; cnt += (c > 0u) ? 1u : 0u; mine = (j == x) ? c : mine; }
        if (sum == G) break;
        __builtin_amdgcn_s_sleep(1);
        if ((++sp & 255u) == 0u) { if (xb_ld(&bar[XB_TMO])) break; if (sp > XB_SPIN_CAP) { atomicAdd(&bar[XB_TMO], 1u); break; } }
    }
    nloc = mine > 0u ? mine : 1u; nx = cnt > 0u ? cnt : 1u;
}
__device__ __forceinline__ void xcd_barrier(const XcdBarrier& b) {
    asm volatile("s_waitcnt vmcnt(0)" ::: "memory");
    __syncthreads();
    if (threadIdx.x == 0) {
        unsigned* bar = b.bar;
        __builtin_amdgcn_s_waitcnt(0);
        unsigned nloc = b.st[0], nx = b.st[1];
        if (nloc == 0u) { xcd_barrier_complete(bar, b.x, nloc, nx); b.st[0] = nloc; b.st[1] = nx; }
        const unsigned old = xb_add(&bar[XB_XSUB(b.x)], 1u);
        const unsigned gen = old / nloc;
        if (old + 1u == (gen + 1u) * nloc) {
            __builtin_amdgcn_fence(__ATOMIC_RELEASE, "agent");
            asm volatile("s_waitcnt vmcnt(0)" ::: "memory");
            const unsigned og = xb_add(&bar[XB_TOP], 1u);
            const unsigned tg = og / nx;
            if (og + 1u == (tg + 1u) * nx) xb_add(&bar[XB_TOPGEN], 1u);
            else XB_SPIN(xb_ld(&bar[XB_TOPGEN]) == tg, bar);
            __builtin_amdgcn_fence(__ATOMIC_ACQUIRE, "agent");
            xb_add(&bar[XB_XGEN(b.x)], 1u);
            asm volatile("s_waitcnt vmcnt(0)" ::: "memory");
        } else {
            XB_SPIN(xb_ld(&bar[XB_XGEN(b.x)]) == gen, bar);
            __builtin_amdgcn_fence(__ATOMIC_ACQUIRE, "agent");
            asm volatile("s_waitcnt vmcnt(0)" ::: "memory");
        }
    }
    __syncthreads();
}

namespace pg8 {
constexpr int BM = 256, BK = 64, HALF = 128, HTB = HALF * BK * 2, STAGE_BYTES = 8 * HTB, NXCD = 8, WGM = 8;
__host__ __device__ __forceinline__ int lds_byte(int r, int c) { const int st = (r >> 4) * 2 + (c >> 5), rr = r & 15, cc = c & 31, ob = rr * 64 + cc * 2; return st * 1024 + (ob ^ (((ob >> 9) & 1) << 5)); }
__host__ __device__ __forceinline__ void stage_rc(int b, int& R, int& C) { const int st = b / 1024, sb = b % 1024, swz = sb ^ (((sb >> 9) & 1) << 5); R = (st >> 1) * 16 + swz / 64; C = (st & 1) * 32 + (swz % 64) / 2; }
__host__ __device__ __forceinline__ int perm32(int rho) { const int n = rho >> 4, i = rho & 15; return 8 * (i >> 2) + 4 * n + (i & 3); }

struct Unit { const char* a; const char* b; int nt; int pm, pn, kind; };

__device__ __forceinline__ void rect_map(int wgid, int nM, int nN, int& pm, int& pn) {
    const int nwg = nM * nN;
    { const int q = nwg / NXCD, r = nwg % NXCD, xcd = wgid % NXCD, off = wgid / NXCD; wgid = (xcd < r ? xcd * (q + 1) : r * (q + 1) + (xcd - r) * q) + off; }
    const int nig = WGM * nN, gid = wgid / nig, fm = gid * WGM, gsz = (nM - fm) < WGM ? (nM - fm) : WGM;
    pm = fm + ((wgid % nig) % gsz); pn = (wgid % nig) / gsz;
}

template <int lda, int ldb, class Epi, class Sched>
__device__ __forceinline__ void gemm_phase(LAS unsigned char* lds, const Sched& S, const Epi& E) {
    int tid_ = threadIdx.x; asm volatile("" : "+v"(tid_));
    const int tid = tid_, wid = __builtin_amdgcn_readfirstlane(tid >> 6), lane = tid & 63, wr = wid >> 2, wc = wid & 3, fr = lane & 15, fq = lane >> 4;
    unsigned voffA[2], voffB[2];
#pragma unroll
    for (int i = 0; i < 2; ++i) { int R, C; stage_rc(tid * 16 + i * 8192, R, C); const int Rb = (R & ~31) + perm32(R & 31);
        voffA[i] = (unsigned)(R * lda + C) * 2u; voffB[i] = (unsigned)(Rb * ldb + C) * 2u; }
    const size_t kstep = (size_t)(BK * 2);
    const size_t hstepA = (size_t)HALF * lda * 2, hstepB = (size_t)HALF * ldb * 2;
    const unsigned ldsw = (unsigned)wid * 1024u;
    const int aoff = lds_byte(wr * 64 + fr, fq * 8), boff = lds_byte(wc * 32 + fr, fq * 8);
#define PG8_SA(b, h) (((b) * 2 + (h)) * HTB)
#define PG8_SB(b, h) ((4 + (b) * 2 + (h)) * HTB)
#define PG8_STAGE(bufoff, gbase, voff) do { _Pragma("unroll") for (int _i = 0; _i < 2; ++_i) \
        __builtin_amdgcn_global_load_lds((const unsigned*)((const char*)(gbase) + (voff)[_i]), (LAS unsigned*)(lds + (bufoff) + ldsw + _i * 8192), 16, 0, 0); } while (0)
#define PG8_LDA(dst, b, h) do { _Pragma("unroll") for (int m = 0; m < 4; ++m) _Pragma("unroll") for (int k = 0; k < 2; ++k) dst[m][k] = *(const LAS bf16x8*)(lds + PG8_SA(b, h) + aoff + m * 2048 + k * 1024); } while (0)
#define PG8_LDB(dst, b, h) do { _Pragma("unroll") for (int n = 0; n < 2; ++n) _Pragma("unroll") for (int k = 0; k < 2; ++k) dst[n][k] = *(const LAS bf16x8*)(lds + PG8_SB(b, h) + boff + n * 2048 + k * 1024); } while (0)
#define PG8_MMA(ai, bj, At, Bt) do { __builtin_amdgcn_s_setprio(1); _Pragma("unroll") for (int m = 0; m < 4; ++m) _Pragma("unroll") for (int n = 0; n < 2; ++n) _Pragma("unroll") for (int k = 0; k < 2; ++k) \
        acc[ai][bj][m][n] = __builtin_amdgcn_mfma_f32_16x16x32_bf16(Bt[n][k], At[m][k], acc[ai][bj][m][n], 0, 0, 0); __builtin_amdgcn_s_setprio(0); } while (0)
#define PG8_WAIT_V(n) asm volatile("s_waitcnt vmcnt(" #n ")" ::: "memory")
#define PG8_WAIT_L(n) asm volatile("s_waitcnt lgkmcnt(" #n ")" ::: "memory")
#define PG8_BAR __builtin_amdgcn_s_barrier()
#define PG8_SCHED __builtin_amdgcn_sched_barrier(0)
    Unit cur, nxt; int ui = 0;
    if (!S.next(0, cur)) return;
    f32x4 acc[2][2][4][2];
#pragma unroll
    for (int a = 0; a < 2; ++a)
#pragma unroll
        for (int b = 0; b < 2; ++b)
#pragma unroll
            for (int m = 0; m < 4; ++m)
#pragma unroll
                for (int n = 0; n < 2; ++n) acc[a][b][m][n] = (f32x4){0.f, 0.f, 0.f, 0.f};
    bf16x8 At[4][2], B0[2][2], B1[2][2];
    const char* cA = cur.a; const char* cB = cur.b;
    PG8_STAGE(PG8_SB(0, 0), cB, voffB); PG8_STAGE(PG8_SA(0, 0), cA, voffA); PG8_STAGE(PG8_SB(0, 1), cB + hstepB, voffB); PG8_STAGE(PG8_SA(0, 1), cA + hstepA, voffA);
    if (wr == 1) PG8_BAR;
    PG8_WAIT_V(4); PG8_BAR;
    PG8_STAGE(PG8_SB(1, 0), cB + kstep, voffB); PG8_STAGE(PG8_SA(1, 0), cA + kstep, voffA); PG8_STAGE(PG8_SB(1, 1), cB + hstepB + kstep, voffB);
    PG8_WAIT_V(6); PG8_BAR;
    for (;;) {
        const bool has_next = S.next(ui + 1, nxt);
        const char* nA = has_next ? nxt.a : cA; const char* nB = has_next ? nxt.b : cB;
        const int nt = cur.nt;
        for (int t = 0; t < nt; t += 2) {
            const bool last = (t == nt - 2);
            const char* a1 = cA + (size_t)(t + 1) * kstep;
            const char* a2 = last ? nA : cA + (size_t)(t + 2) * kstep; const char* b2 = last ? nB : cB + (size_t)(t + 2) * kstep;
            const char* a3 = a2 + kstep; const char* b3 = b2 + kstep;
            PG8_LDB(B0, 0, 0); PG8_SCHED; PG8_LDA(At, 0, 0); PG8_STAGE(PG8_SA(1, 1), a1 + hstepA, voffA);
            PG8_WAIT_L(8); PG8_BAR; PG8_WAIT_L(0); PG8_MMA(0, 0, At, B0); PG8_BAR; PG8_SCHED;
            PG8_LDB(B1, 0, 1); PG8_STAGE(PG8_SB(0, 0), b2, voffB);
            PG8_BAR; PG8_WAIT_L(0); PG8_MMA(0, 1, At, B1); PG8_BAR;
            PG8_LDA(At, 0, 1); PG8_STAGE(PG8_SA(0, 0), a2, voffA);
            PG8_BAR; PG8_WAIT_L(0); PG8_MMA(1, 0, At, B0); PG8_BAR; PG8_SCHED;
            PG8_STAGE(PG8_SB(0, 1), b2 + hstepB, voffB);
            PG8_WAIT_V(6); PG8_BAR; PG8_MMA(1, 1, At, B1); PG8_BAR;
            PG8_LDB(B0, 1, 0); PG8_SCHED; PG8_LDA(At, 1, 0); PG8_STAGE(PG8_SA(0, 1), a2 + hstepA, voffA);
            PG8_WAIT_L(8); PG8_BAR; PG8_WAIT_L(0); PG8_MMA(0, 0, At, B0); PG8_BAR; PG8_SCHED;
            PG8_LDB(B1, 1, 1); PG8_STAGE(PG8_SB(1, 0), b3, voffB);
            PG8_BAR; PG8_WAIT_L(0); PG8_MMA(0, 1, At, B1); PG8_BAR;
            PG8_LDA(At, 1, 1); PG8_STAGE(PG8_SA(1, 0), a3, voffA);
            PG8_BAR; PG8_WAIT_L(0); PG8_MMA(1, 0, At, B0); PG8_BAR; PG8_SCHED;
            PG8_STAGE(PG8_SB(1, 1), b3 + hstepB, voffB);
            PG8_WAIT_V(6); PG8_BAR; PG8_MMA(1, 1, At, B1); PG8_BAR;
        }
        E(acc, cur, wr, wc, fr, fq);
        if (!has_next) break;
#pragma unroll
        for (int a = 0; a < 2; ++a)
#pragma unroll
            for (int b = 0; b < 2; ++b)
#pragma unroll
                for (int m = 0; m < 4; ++m)
#pragma unroll
                    for (int n = 0; n < 2; ++n) acc[a][b][m][n] = (f32x4){0.f, 0.f, 0.f, 0.f};
        cur = nxt; cA = nA; cB = nB; ++ui;
    }
    PG8_WAIT_V(0);
    if (wr == 0) PG8_BAR;
    PG8_BAR;
#undef PG8_SA
#undef PG8_SB
#undef PG8_STAGE
#undef PG8_LDA
#undef PG8_LDB
#undef PG8_MMA
#undef PG8_WAIT_V
#undef PG8_WAIT_L
#undef PG8_BAR
#undef PG8_SCHED
}

struct PartC { long long aOff, bOff; unsigned aStep, bStep; int nM, nN, nt, kind, start, nGrp; unsigned aGrp, bGrp; };
struct TabSched {
    const PartC* parts; const char* ws; int np, total, G, c;
    __device__ __forceinline__ bool next(int i, Unit& u) const {
        const int L = i * G + c; if (L >= total) return false;
        int q = 0;
#pragma unroll
        for (int k = 1; k < 4; ++k) if (k < np && L >= parts[k].start) q = k;
        const PartC P = parts[q];
        const int per = P.nM * P.nN, idx = L - P.start, grp = idx / per;
        int pm, pn; rect_map(idx - grp * per, P.nM, P.nN, pm, pn);
        u.a = ws + P.aOff + (size_t)grp * P.aGrp + (size_t)pm * P.aStep; u.b = ws + P.bOff + (size_t)grp * P.bGrp + (size_t)pn * P.bStep; u.nt = P.nt; u.pm = pm; u.pn = pn; u.kind = P.kind + grp; return true;
    }
};
struct MergeSched {
    const char* ws; long long aOff, bOff; int nM, G, c;
    int nCtx;
    __device__ __forceinline__ bool next(int i, Unit& u) const {
        int T = (i >> 2) * G + c, br = i & 3; bool ctxu = false;
        if (T >= nM * 4) {
            const int j = (i - 4 * ((nM * 4 - c + G - 1) / G)) * G + c;
            if (j < 0 || j >= nCtx) return false;
            T = nM * 4 + (j >> 2); br = j & 3; ctxu = true;
        }
        int pm, pn;
        if (!ctxu) rect_map(T, nM, 4, pm, pn); else { const int t = T - nM * 4; pm = nM + (t >> 2); pn = t & 3; }
        const int ko = br == 0 ? 0 : (br == 1 ? 384 : (br == 2 ? 640 : 1024));
        u.a = ws + aOff + (size_t)pm * (256u * 1280u * 2u) + ko * 2; u.b = ws + bOff + (size_t)pn * (256u * 1280u * 2u) + ko * 2; u.nt = (br & 1) ? 4 : 6; u.pm = pm; u.pn = pn; u.kind = ctxu ? 4 + br : br; return true;
    }
};
struct MoeSched {
    const char* A; const char* B; const int* tile_e; unsigned aStep, bStep; size_t bExp; int nN, nt, tile0, ntile, G, c;
    __device__ __forceinline__ bool next(int i, Unit& u) const {
        const int L = i * G + c; if (L >= ntile * nN) return false;
        const int mt = tile0 + L / nN, pn = L % nN;
        const int e = __builtin_amdgcn_readfirstlane(__hip_atomic_load(tile_e + mt, __ATOMIC_RELAXED, __HIP_MEMORY_SCOPE_AGENT));
        u.a = A + (size_t)(mt - tile0) * aStep; u.b = B + (size_t)e * bExp + (size_t)pn * bStep; u.nt = nt; u.pm = mt; u.pn = pn; u.kind = e; return true;
    }
};

struct MoeTailSched {
    const char* A; const char* B; const int* tile_e; int tile0, nfull, nex, G, c;
    __device__ __forceinline__ bool next(int i, Unit& u) const {
        const int L = i * G + c; int mt, pn, nt = 56, flag = 0; size_t koff = 0;
        if (L < nfull * 4) { mt = tile0 + (L >> 2); pn = L & 3; }
        else { const int idx = L - nfull * 4; if (idx >= nex * 16) return false; const int sp = idx & 3, tu = idx >> 2; mt = 128 + (tu >> 2); pn = tu & 3; nt = 14; koff = (size_t)sp * 14 * 128; flag = 8 + 16 * sp; }
        const int e = __builtin_amdgcn_readfirstlane(__hip_atomic_load(tile_e + mt, __ATOMIC_RELAXED, __HIP_MEMORY_SCOPE_AGENT));
        u.a = A + (size_t)(mt - tile0) * (256u * (unsigned)FF_E * 2u) + koff; u.b = B + (size_t)e * ((size_t)1024 * FF_E * 2) + (size_t)pn * (256u * (unsigned)FF_E * 2u) + koff;
        u.nt = nt; u.pm = mt; u.pn = pn; u.kind = e | flag; return true;
    }
};

#define EPI_ROWS(u) const int row0 = (u).pm * BM + wr * 64 + fr, colt = wc * 32 + 8 * fq
struct EpiProj {
    bf16_t* PRp; bf16_t* PTp; bf16_t* USp; int sig_from;
    __device__ __forceinline__ void operator()(const f32x4 (&acc)[2][2][4][2], const Unit& u, int wr, int wc, int fr, int fq) const {
        EPI_ROWS(u);
        bf16_t* base = u.kind == 1 ? PTp : PRp; const int ldc = u.kind == 1 ? RT : LDP; const bool sg = (u.kind == 0 && u.pn >= sig_from);
#pragma unroll
        for (int ai = 0; ai < 2; ++ai)
#pragma unroll
            for (int m = 0; m < 4; ++m) { bf16_t* rowp = base + (size_t)(row0 + ai * HALF + m * 16) * ldc + u.pn * BM + colt;
#pragma unroll
                for (int bj = 0; bj < 2; ++bj) { f32x4 v0 = acc[ai][bj][m][0], v1 = acc[ai][bj][m][1];
                    if (sg) {
#pragma unroll
                        for (int j = 0; j < 4; ++j) { v0[j] = sigm(v0[j]); v1[j] = sigm(v1[j]); } }
                    u32x4 w; w.x = cvt_pk_bf16(v0[0], v0[1]); w.y = cvt_pk_bf16(v0[2], v0[3]); w.z = cvt_pk_bf16(v1[0], v1[1]); w.w = cvt_pk_bf16(v1[2], v1[3]);
                    *(u32x4*)(rowp + bj * HALF) = w;
                    if (u.kind == 0 && u.pn == 3) { const int r = row0 + ai * HALF + m * 16, cc = colt + bj * HALF;
                        *(u32x4*)(USp + ((size_t)(cc >> 4) * NCHKP + (r >> 4)) * 512 + (r & 15) * 16 + (cc & 15)) = w; } } }
    }
};
struct EpiS5State {
    float* Sp;
    __device__ __forceinline__ void operator()(const f32x4 (&acc)[2][2][4][2], const Unit& u, int wr, int wc, int fr, int fq) const {
        EPI_ROWS(u);
#pragma unroll
        for (int ai = 0; ai < 2; ++ai)
#pragma unroll
            for (int m = 0; m < 4; ++m) { float* op = Sp + ((size_t)u.kind * NCHKP + row0 + ai * HALF + m * 16) * 256 + colt;
#pragma unroll
                for (int bj = 0; bj < 2; ++bj)
#pragma unroll
                    for (int n = 0; n < 2; ++n) *(f32x4*)(op + bj * HALF + 4 * n) = acc[ai][bj][m][n]; }
    }
};
struct EpiS5Main {
    bf16_t* GLp; const bf16_t* PRp; const float* dvec;
    __device__ __forceinline__ void operator()(const f32x4 (&acc)[2][2][4][2], const Unit& u, int wr, int wc, int fr, int fq) const {
        EPI_ROWS(u);
        const int cl = 16 * u.kind + (colt & 15);
        const f32x4 d0 = *(const f32x4*)(dvec + cl), d1 = *(const f32x4*)(dvec + cl + 4);
#pragma unroll
        for (int ai = 0; ai < 2; ++ai) {
            u32x4 uq[4][2];
#pragma unroll
            for (int m = 0; m < 4; ++m) { const int n = row0 + ai * HALF + m * 16;
#pragma unroll
                for (int bj = 0; bj < 2; ++bj) { const int c = colt + bj * HALF, r = 16 * (n < NCHK ? n : 0) + (c >> 4); uq[m][bj] = *(const u32x4*)(PRp + (size_t)r * LDP + PC_D + cl); } }
#pragma unroll
            for (int m = 0; m < 4; ++m) { const int n = row0 + ai * HALF + m * 16; if (n >= NCHK) continue;
#pragma unroll
                for (int bj = 0; bj < 2; ++bj) { const int c = colt + bj * HALF, r = 16 * n + (c >> 4); const u32x4 uv = uq[m][bj];
                    const f32x4 v0 = acc[ai][bj][m][0], v1 = acc[ai][bj][m][1];
                    u32x4 w; w.x = cvt_pk_bf16(gelu_f(v0[0] + d0[0] * bflo(uv.x)), gelu_f(v0[1] + d0[1] * bfhi(uv.x))); w.y = cvt_pk_bf16(gelu_f(v0[2] + d0[2] * bflo(uv.y)), gelu_f(v0[3] + d0[3] * bfhi(uv.y)));
                    w.z = cvt_pk_bf16(gelu_f(v1[0] + d1[0] * bflo(uv.z)), gelu_f(v1[1] + d1[1] * bfhi(uv.z))); w.w = cvt_pk_bf16(gelu_f(v1[2] + d1[2] * bflo(uv.w)), gelu_f(v1[3] + d1[3] * bfhi(uv.w)));
                    *(u32x4*)(GLp + (size_t)r * 256 + cl) = w; } }
        }
    }
};
struct EpiS5Glu {
    bf16_t* YBp; const bf16_t* GLp; const float* bvec;
    __device__ __forceinline__ void operator()(const f32x4 (&acc)[2][2][4][2], const Unit& u, int wr, int wc, int fr, int fq) const {
        EPI_ROWS(u);
        f32x4 bq[2][2];
#pragma unroll
        for (int bj = 0; bj < 2; ++bj) { bq[bj][0] = *(const f32x4*)(bvec + colt + bj * HALF); bq[bj][1] = *(const f32x4*)(bvec + colt + bj * HALF + 4); }
#pragma unroll
        for (int ai = 0; ai < 2; ++ai) {
            u32x4 gq[4][2];
#pragma unroll
            for (int m = 0; m < 4; ++m)
#pragma unroll
                for (int bj = 0; bj < 2; ++bj) gq[m][bj] = *(const u32x4*)(GLp + (size_t)(row0 + ai * HALF + m * 16) * 256 + colt + bj * HALF);
#pragma unroll
            for (int m = 0; m < 4; ++m) { const int r = row0 + ai * HALF + m * 16;
#pragma unroll
                for (int bj = 0; bj < 2; ++bj) { const int c = colt + bj * HALF; const u32x4 gv = gq[m][bj];
                    const f32x4 v0 = acc[ai][bj][m][0] + bq[bj][0], v1 = acc[ai][bj][m][1] + bq[bj][1];
                    u32x4 w; w.x = cvt_pk_bf16(bflo(gv.x) * sigm(v0[0]), bfhi(gv.x) * sigm(v0[1])); w.y = cvt_pk_bf16(bflo(gv.y) * sigm(v0[2]), bfhi(gv.y) * sigm(v0[3]));
                    w.z = cvt_pk_bf16(bflo(gv.z) * sigm(v1[0]), bfhi(gv.z) * sigm(v1[1])); w.w = cvt_pk_bf16(bflo(gv.w) * sigm(v1[2]), bfhi(gv.w) * sigm(v1[3]));
                    *(u32x4*)(YBp + (size_t)r * YW + YC_D + c) = w; } }
        }
    }
};
struct EpiGate {
    const bf16_t* PRp; bf16_t* MGp; bf16_t* MGCp;
    __device__ __forceinline__ void operator()(const f32x4 (&acc)[2][2][4][2], const Unit& u, int wr, int wc, int fr, int fq) const {
        EPI_ROWS(u);
        const int br = u.kind & 3; const bool acc_prev = (u.kind >= 1 && u.kind <= 3);
        bf16_t* OB = u.kind >= 4 ? MGCp + (size_t)br * RC * D - (size_t)RL * D : MGp;
        if (acc_prev) { __builtin_amdgcn_fence(__ATOMIC_ACQUIRE, "agent"); asm volatile("s_waitcnt vmcnt(0)" ::: "memory"); }
#pragma unroll
        for (int am = 0; am < 4; ++am) { const int ai = am >> 1, m0 = (am & 1) * 2;
            u32x4 g[4][2], p[4][2];
#pragma unroll
            for (int m = m0; m < m0 + 2; ++m) { const int r = row0 + ai * HALF + m * 16;
#pragma unroll
                for (int bj = 0; bj < 2; ++bj) { g[m][bj] = *(const u32x4*)(PRp + (size_t)r * LDP + PC_G + br * 1024 + u.pn * BM + colt + bj * HALF);
                    p[m][bj] = acc_prev ? *(const u32x4*)(MGp + (size_t)r * D + u.pn * BM + colt + bj * HALF) : (u32x4){0u, 0u, 0u, 0u}; } }
#pragma unroll
            for (int m = m0; m < m0 + 2; ++m) { const int r = row0 + ai * HALF + m * 16; bf16_t* mp = OB + (size_t)r * D + u.pn * BM + colt;
#pragma unroll
                for (int bj = 0; bj < 2; ++bj) { const f32x4 v0 = acc[ai][bj][m][0], v1 = acc[ai][bj][m][1]; const u32x4 gg = g[m][bj], pp = p[m][bj];
                    const f32x4 o0 = {v0[0] * bflo(gg.x) + bflo(pp.x), v0[1] * bfhi(gg.x) + bfhi(pp.x), v0[2] * bflo(gg.y) + bflo(pp.y), v0[3] * bfhi(gg.y) + bfhi(pp.y)};
                    const f32x4 o1 = {v1[0] * bflo(gg.z) + bflo(pp.z), v1[1] * bfhi(gg.z) + bfhi(pp.z), v1[2] * bflo(gg.w) + bflo(pp.w), v1[3] * bfhi(gg.w) + bfhi(pp.w)};
                    u32x4 w; w.x = cvt_pk_bf16(o0[0], o0[1]); w.y = cvt_pk_bf16(o0[2], o0[3]); w.z = cvt_pk_bf16(o1[0], o1[1]); w.w = cvt_pk_bf16(o1[2], o1[3]);
                    *(u32x4*)(mp + bj * HALF) = w; } }
        }
    }
};
struct EpiRes {
    float* PREp; const float* xlat; const float* xctx; const float* gvec;
    float* partp;
    __device__ __forceinline__ void operator()(const f32x4 (&acc)[2][2][4][2], const Unit& u, int wr, int wc, int fr, int fq) const {
        EPI_ROWS(u);
        if (u.kind != 0) {
            f32x4 gc[2][2];
#pragma unroll
            for (int bj = 0; bj < 2; ++bj)
#pragma unroll
                for (int n = 0; n < 2; ++n) gc[bj][n] = *(const f32x4*)(gvec + (size_t)4 * 6144 + u.pn * BM + colt + bj * HALF + 4 * n);
#pragma unroll
            for (int ai = 0; ai < 2; ++ai)
#pragma unroll
                for (int m = 0; m < 4; ++m) { const int r = row0 + ai * HALF + m * 16; const int c0 = u.pn * BM + colt;
                    float* op = partp + ((size_t)(u.kind - 1) * RC + r) * D + c0;
#pragma unroll
                    for (int bj = 0; bj < 2; ++bj)
#pragma unroll
                        for (int n = 0; n < 2; ++n) *(f32x4*)(op + bj * HALF + 4 * n) = gc[bj][n] * acc[ai][bj][m][n]; }
            return;
        }
        const int c0 = u.pn * BM + colt, rt0 = u.pm * BM;
        const float* gp = gvec + (size_t)(rt0 < RL ? (rt0 >> 12) : 4) * 6144 + c0;
        f32x4 gq[2][2];
#pragma unroll
        for (int bj = 0; bj < 2; ++bj)
#pragma unroll
            for (int n = 0; n < 2; ++n) gq[bj][n] = *(const f32x4*)(gp + bj * HALF + 4 * n);
#pragma unroll
        for (int am = 0; am < 4; ++am) { const int ai = am >> 1, m0 = (am & 1) * 2;
            f32x4 xq[4][2][2];
#pragma unroll
            for (int m = m0; m < m0 + 2; ++m) { const int r = row0 + ai * HALF + m * 16;
                const float* xin = (r < RL ? xlat + (size_t)r * D : xctx + (size_t)(r - RL) * D) + c0;
#pragma unroll
                for (int bj = 0; bj < 2; ++bj)
#pragma unroll
                    for (int n = 0; n < 2; ++n) xq[m][bj][n] = *(const f32x4*)(xin + bj * HALF + 4 * n); }
#pragma unroll
            for (int m = m0; m < m0 + 2; ++m) { const int r = row0 + ai * HALF + m * 16; float* op = PREp + (size_t)r * D + c0;
#pragma unroll
                for (int bj = 0; bj < 2; ++bj)
#pragma unroll
                    for (int n = 0; n < 2; ++n) *(f32x4*)(op + bj * HALF + 4 * n) = xq[m][bj][n] * ALPHA + gq[bj][n] * acc[ai][bj][m][n]; }
        }
    }
};
struct EpiSwiglu {
    bf16_t* Hp; int ldh; int row_sub;
    __device__ __forceinline__ void operator()(const f32x4 (&acc)[2][2][4][2], const Unit& u, int wr, int wc, int fr, int fq) const {
        const int row0 = (u.pm - row_sub) * BM + wr * 64 + fr, colt = wc * 32 + 8 * fq;
#pragma unroll
        for (int ai = 0; ai < 2; ++ai)
#pragma unroll
            for (int m = 0; m < 4; ++m) { bf16_t* rowp = Hp + (size_t)(row0 + ai * HALF + m * 16) * ldh + u.pn * HALF + colt;
                f32x4 h0, h1;
#pragma unroll
                for (int j = 0; j < 4; ++j) { const float g0 = acc[ai][0][m][0][j], g1 = acc[ai][0][m][1][j];
                    h0[j] = g0 * sigm(g0) * acc[ai][1][m][0][j]; h1[j] = g1 * sigm(g1) * acc[ai][1][m][1][j]; }
                u32x4 w; w.x = cvt_pk_bf16(h0[0], h0[1]); w.y = cvt_pk_bf16(h0[2], h0[3]); w.z = cvt_pk_bf16(h1[0], h1[1]); w.w = cvt_pk_bf16(h1[2], h1[3]);
                *(u32x4*)rowp = w; }
    }
};
struct EpiMoeDown {
    bf16_t* O2; const float* slotw; float* O2X;
    __device__ __forceinline__ void operator()(const f32x4 (&acc)[2][2][4][2], const Unit& u, int wr, int wc, int fr, int fq) const {
        EPI_ROWS(u);
        float wq[2][4];
        if (u.kind & 8) {
            const int sp = (u.kind >> 4) & 3;
#pragma unroll
            for (int ai = 0; ai < 2; ++ai)
#pragma unroll
                for (int m = 0; m < 4; ++m) { const int r = row0 + ai * HALF + m * 16; const float w8 = slotw[r]; float* op = O2X + ((size_t)sp * 2048 + (r - 128 * 256)) * D + u.pn * BM + colt;
#pragma unroll
                    for (int bj = 0; bj < 2; ++bj)
#pragma unroll
                        for (int n = 0; n < 2; ++n) *(f32x4*)(op + bj * HALF + 4 * n) = acc[ai][bj][m][n] * w8; }
            return;
        }
#pragma unroll
        for (int ai = 0; ai < 2; ++ai)
#pragma unroll
            for (int m = 0; m < 4; ++m) wq[ai][m] = slotw[row0 + ai * HALF + m * 16];
#pragma unroll
        for (int ai = 0; ai < 2; ++ai)
#pragma unroll
            for (int m = 0; m < 4; ++m) { const int r = row0 + ai * HALF + m * 16; const float w8 = wq[ai][m];
                bf16_t* rowp = O2 + (size_t)r * D + u.pn * BM + colt;
#pragma unroll
                for (int bj = 0; bj < 2; ++bj) { const f32x4 v0 = acc[ai][bj][m][0] * w8, v1 = acc[ai][bj][m][1] * w8;
                    u32x4 w; w.x = cvt_pk_bf16(v0[0], v0[1]); w.y = cvt_pk_bf16(v0[2], v0[3]); w.z = cvt_pk_bf16(v1[0], v1[1]); w.w = cvt_pk_bf16(v1[2], v1[3]);
                    *(u32x4*)(rowp + bj * HALF) = w; } }
    }
};
}

struct Job { int in_idx; int src_off; int lds; int K; int N; long long dst_off; int ldd; int kcol0; int G, GS, R0; int tile0; };
struct JobTable { Job j[96]; int n; int total; };
constexpr int BIGG = 1 << 30;
constexpr void add_job(JobTable& t, int in_idx, long long src_off, int lds, int K, int N, size_t dst_off, int ldd, int kcol0, int G, int GS, int R0) {
    Job& q = t.j[t.n]; q.in_idx = in_idx; q.src_off = (int)src_off; q.lds = lds; q.K = K; q.N = N; q.dst_off = (long long)dst_off; q.ldd = ldd; q.kcol0 = kcol0; q.G = G; q.GS = GS; q.R0 = R0;
    q.tile0 = t.total; t.total += (K / 64) * (N / 64); t.n++;
}
constexpr JobTable make_jobs(int which) {
    JobTable t{}; t.n = 0; t.total = 0;
    if (which == 0) {
        for (int l = 0; l < 2; ++l) {
            const size_t base = WS_WL + (size_t)l * SZ_WL; const long long wsrc = (long long)l * 1024 * IN_COLS;
            add_job(t, 6, wsrc + 0, IN_COLS, 1024, 768, base, 1024, 0, BIGG, 0, 0);
            add_job(t, 6, wsrc + 2688, IN_COLS, 1024, 256, base, 1024, 0, BIGG, 0, PC_D);
            add_job(t, 6, wsrc + 1536, IN_COLS, 1024, 768, base, 1024, 0, BIGG, 0, PC_Q);
            add_job(t, 6, wsrc + 2944, IN_COLS, 1024, 4096, base, 1024, 0, BIGG, 0, PC_G);
            add_job(t, 6, wsrc + 768, IN_COLS, 1024, 768, base + SZ_WINR, 1024, 0, BIGG, 0, 0);
            add_job(t, 6, wsrc + 2304, IN_COLS, 1024, 384, base + SZ_WINR, 1024, 0, BIGG, 0, PT_V);
            const int kd[4] = {384, 256, 384, 256}, ko[4] = {0, 384, 640, 1024};
            for (int i = 0; i < 4; ++i) add_job(t, 35 + i, (long long)l * kd[i] * 1024, 1024, kd[i], 1024, base + SZ_WINR + SZ_WINHY, 1280, ko[i], BIGG, 0, 0);
            add_job(t, 39, (long long)l * 1024 * 1024, 1024, 1024, 1024, base + SZ_WINR + SZ_WINHY + SZ_WBR, 1024, 0, BIGG, 0, 0);
        }
        for (int q = 0; q < 24; ++q) for (int mat = 0; mat < 2; ++mat)
            add_job(t, mat == 0 ? 9 : 11, (long long)q * 4096, 64, 64, 64, WS_LW + (size_t)(((q / 6) * 2 + mat) * 6 + q % 6) * 4096 * 2, 64, 0, BIGG, 0, 0);
        for (int l = 0; l < 2; ++l) add_job(t, 33, (long long)l * 65536, 256, 256, 256, WS_WGLU + (size_t)l * 256 * 256 * 2, 256, 0, BIGG, 0, 0);
        add_job(t, 44, 0, FF_DENSE, 1024, FF_DENSE, WS_FFGU, 1024, 0, 128, 256, 0);
        add_job(t, 45, 0, FF_DENSE, 1024, FF_DENSE, WS_FFGU, 1024, 0, 128, 256, 128);
        add_job(t, 46, 0, 1024, FF_DENSE, 1024, WS_FFD, FF_DENSE, 0, BIGG, 0, 0);
    } else {
        for (int e = 0; e < NE; ++e) {
            add_job(t, 48, (long long)e * 1024 * FF_E, FF_E, 1024, FF_E, WS_MOEGU + (size_t)e * 2 * FF_E * 1024 * 2, 1024, 0, 128, 256, 0);
            add_job(t, 49, (long long)e * 1024 * FF_E, FF_E, 1024, FF_E, WS_MOEGU + (size_t)e * 2 * FF_E * 1024 * 2, 1024, 0, 128, 256, 128);
            add_job(t, 50, (long long)e * FF_E * 1024, 1024, FF_E, 1024, WS_MOED + (size_t)e * 1024 * FF_E * 2, FF_E, 0, BIGG, 0, 0);
        }
    }
    return t;
}
__device__ const JobTable JT_SMALL = make_jobs(0);
__device__ const JobTable JT_MOE = make_jobs(1);

struct PartTable { pg8::PartC p[32]; };
constexpr pg8::PartC mk_part(size_t aOff, size_t bOff, unsigned aStep, unsigned bStep, int nM, int nN, int nt, int kind, int start) {
    pg8::PartC q{}; q.aOff = (long long)aOff; q.bOff = (long long)bOff; q.aStep = aStep; q.bStep = bStep; q.nM = nM; q.nN = nN; q.nt = nt; q.kind = kind; q.start = start; q.nGrp = 1; q.aGrp = 0; q.bGrp = 0; return q;
}
constexpr PartTable make_parts() {
    PartTable t{};
    for (int l = 0; l < 2; ++l) {
        const size_t WL = WS_WL + (size_t)l * SZ_WL; const int nMrow = l == 0 ? 68 : 64;
        t.p[l * 8 + 0] = mk_part(WS_UB, WL, 256u * 1024u * 2u, 256u * 1024u * 2u, 68, 23, 16, 0, 0);
        t.p[l * 8 + 1] = mk_part(WL + SZ_WINR, WS_UB, 256u * 1024u * 2u, 256u * 1024u * 2u, 5, 68, 16, 1, 68 * 23);
        const int kd[4] = {384, 256, 384, 256}, ko[4] = {0, 384, 640, 1024};
        for (int i = 0; i < 4; ++i) t.p[l * 8 + 2 + i] = mk_part(WS_YB + ko[i] * 2, WL + SZ_WINR + SZ_WINHY + ko[i] * 2, 256u * 1280u * 2u, 256u * 1280u * 2u, nMrow, 4, kd[i] / 64, i, i * nMrow * 4);
        t.p[l * 8 + 6] = mk_part(WS_UB, WL + SZ_WINR + SZ_WINHY + SZ_WBR, 256u * 1024u * 2u, 256u * 1024u * 2u, nMrow, 4, 16, 0, 0);
    }
    for (int l = 0; l < 2; ++l) {
        pg8::PartC q = mk_part(WS_US, WS_OPS + (size_t)l * 16 * 256 * 256 * 2, 256u * 512u * 2u, 0u, 5, 1, 4, 0, 0); q.nGrp = 16; q.aGrp = (unsigned)(NCHKP * 512 * 2); q.bGrp = 256u * 256u * 2u; t.p[18 + l * 3] = q;
        q = mk_part(WS_US, WS_OPY + (size_t)l * 16 * 256 * 512 * 2, 256u * 512u * 2u, 0u, 5, 1, 8, 0, 0); q.nGrp = 16; q.aGrp = (unsigned)(NCHKP * 512 * 2); q.bGrp = 256u * 512u * 2u; t.p[19 + l * 3] = q;
        t.p[20 + l * 3] = mk_part(WS_GL, WS_WGLU + (size_t)l * 256 * 256 * 2, 256u * 256u * 2u, 0u, l == 0 ? 68 : 64, 1, 4, 0, 0);
    }
    {
        const size_t WL0 = WS_WL;
        t.p[24] = mk_part(WS_UB, WL0 + SZ_WINR + SZ_WINHY + SZ_WBR, 256u * 1024u * 2u, 256u * 1024u * 2u, 64, 4, 16, 0, 0);
        pg8::PartC q = mk_part(WS_MGC, WL0 + SZ_WINR + SZ_WINHY + SZ_WBR, 256u * 1024u * 2u, 256u * 1024u * 2u, 4, 4, 16, 1, 256); q.nGrp = 4; q.aGrp = (unsigned)(RC * D * 2); q.bGrp = 0u; t.p[25] = q;
        t.p[26] = mk_part(WS_H, WS_FFD, 256u * (unsigned)FF_DENSE * 2u, 256u * (unsigned)FF_DENSE * 2u, 64, 4, 44, 0, 0);
        q = mk_part(WS_H + (size_t)64 * 256 * FF_DENSE * 2, WS_FFD, 256u * (unsigned)FF_DENSE * 2u, 256u * (unsigned)FF_DENSE * 2u, 4, 4, 12, 1, 256); q.nGrp = 3; q.aGrp = 1536u; q.bGrp = 1536u; t.p[27] = q;
        t.p[28] = mk_part(WS_H + (size_t)64 * 256 * FF_DENSE * 2 + 36 * 128, WS_FFD + 36 * 128, 256u * (unsigned)FF_DENSE * 2u, 256u * (unsigned)FF_DENSE * 2u, 4, 4, 8, 4, 256 + 48);
    }
    t.p[16] = mk_part(WS_UB, WS_FFGU, 256u * 1024u * 2u, 256u * 1024u * 2u, 68, 22, 16, 0, 0);
    t.p[17] = mk_part(WS_H, WS_FFD, 256u * (unsigned)FF_DENSE * 2u, 256u * (unsigned)FF_DENSE * 2u, 68, 4, 44, 0, 0);
    return t;
}
__device__ const PartTable PARTS = make_parts();

struct Args {
    const float* in[51];
    float* out; unsigned char* ws;
    int ph_lo, ph_hi, bar_region, pad0;
};
__device__ __forceinline__ const float* sel_in(const Args& a, int idx) {
    const float* p = a.in[6];
    p = idx == 9 ? a.in[9] : p; p = idx == 11 ? a.in[11] : p; p = idx == 33 ? a.in[33] : p; p = idx == 35 ? a.in[35] : p; p = idx == 36 ? a.in[36] : p; p = idx == 37 ? a.in[37] : p; p = idx == 38 ? a.in[38] : p; p = idx == 39 ? a.in[39] : p;
    p = idx == 44 ? a.in[44] : p; p = idx == 45 ? a.in[45] : p; p = idx == 46 ? a.in[46] : p; p = idx == 48 ? a.in[48] : p; p = idx == 49 ? a.in[49] : p; p = idx == 50 ? a.in[50] : p;
    return p;
}

__device__ __forceinline__ void convert_step(const Args& a, const JobTable& JT, LAS float* tile, int t0, int stride) {
    const int tid = threadIdx.x;
    {
        f32x4 v[4][2]; int jis[4];
#pragma unroll
        for (int u = 0; u < 4; ++u) {
            const int t = t0 + u * stride; jis[u] = -1;
            if (t < JT.total) {
                int ji = 0;
                for (int k = 1; k < JT.n; ++k) if (t >= JT.j[k].tile0) ji = k;
                jis[u] = ji;
                const Job& q = JT.j[ji];
                const int lt = t - q.tile0, nTn = q.N / 64, k0 = (lt / nTn) * 64, n0 = (lt % nTn) * 64;
                const float* src = sel_in(a, q.in_idx) + (size_t)q.src_off + (size_t)k0 * q.lds + n0;
#pragma unroll
                for (int p = 0; p < 2; ++p) v[u][p] = *(const f32x4*)(src + (size_t)((tid >> 4) + 32 * p) * q.lds + (tid & 15) * 4);
            }
        }
        __syncthreads();
#pragma unroll
        for (int u = 0; u < 4; ++u) if (jis[u] >= 0) {
#pragma unroll
            for (int p = 0; p < 2; ++p) { const int kk = (tid >> 4) + 32 * p, nn = (tid & 15) * 4; LAS float* tp = tile + u * (64 * 65) + kk * 65 + nn;
                tp[0] = v[u][p][0]; tp[1] = v[u][p][1]; tp[2] = v[u][p][2]; tp[3] = v[u][p][3]; } }
        __syncthreads();
#pragma unroll
        for (int u = 0; u < 4; ++u) if (jis[u] >= 0) {
            const Job& q = JT.j[jis[u]];
            const int t = t0 + u * stride, lt = t - q.tile0, nTn = q.N / 64, k0 = (lt / nTn) * 64, n0 = (lt % nTn) * 64;
            const int n = tid >> 3, k8 = (tid & 7) * 8, ng = n0 + n;
            const int drow = (ng / q.G) * q.GS + (ng % q.G) + q.R0;
            const LAS float* tp = tile + u * (64 * 65) + n;
            u32x4 w;
            w.x = cvt_pk_bf16(tp[(k8 + 0) * 65], tp[(k8 + 1) * 65]); w.y = cvt_pk_bf16(tp[(k8 + 2) * 65], tp[(k8 + 3) * 65]);
            w.z = cvt_pk_bf16(tp[(k8 + 4) * 65], tp[(k8 + 5) * 65]); w.w = cvt_pk_bf16(tp[(k8 + 6) * 65], tp[(k8 + 7) * 65]);
            *(u32x4*)((bf16_t*)(a.ws + q.dst_off) + (size_t)drow * q.ldd + q.kcol0 + k0 + k8) = w;
        }
    }
}
__device__ __forceinline__ void convert_tiles(const Args& a, const JobTable& JT, LAS float* tile, int first, int stride) {
    for (int t0 = first; t0 < JT.total; t0 += 4 * stride) convert_step(a, JT, tile, t0, stride);
}

__device__ __forceinline__ int opaque(int v) { asm volatile("" : "+v"(v)); return v; }
#define PIN8(a) asm volatile("" : "+v"((a)[0]), "+v"((a)[1]), "+v"((a)[2]), "+v"((a)[3]), "+v"((a)[4]), "+v"((a)[5]), "+v"((a)[6]), "+v"((a)[7]))
#define PIN16(a) do { PIN8(a); PIN8((a) + 8); } while (0)
struct RowV { f32x4 v[4]; };
__device__ __forceinline__ RowV row_load(const float* p, int lane) { RowV r;
#pragma unroll
    for (int i = 0; i < 4; ++i) r.v[i] = *(const f32x4*)(p + 256 * i + 4 * lane); return r; }
__device__ __forceinline__ void row_store(float* p, int lane, const RowV& r) {
#pragma unroll
    for (int i = 0; i < 4; ++i) *(f32x4*)(p + 256 * i + 4 * lane) = r.v[i]; }
__device__ __forceinline__ void row_store_bf16(bf16_t* p, int lane, const RowV& r) {
#pragma unroll
    for (int i = 0; i < 4; ++i) { u32x2 w; w.x = cvt_pk_bf16(r.v[i][0], r.v[i][1]); w.y = cvt_pk_bf16(r.v[i][2], r.v[i][3]); *(u32x2*)(p + 256 * i + 4 * lane) = w; } }
__device__ __forceinline__ RowV row_norm(const RowV& x) {
    float s = 0.f;
#pragma unroll
    for (int i = 0; i < 4; ++i) s += (x.v[i][0] + x.v[i][1]) + (x.v[i][2] + x.v[i][3]);
    const float mu = wave_sum(s) * (1.f / D);
    RowV d; float q = 0.f;
#pragma unroll
    for (int i = 0; i < 4; ++i) { d.v[i] = x.v[i] - mu; q += (d.v[i][0] * d.v[i][0] + d.v[i][1] * d.v[i][1]) + (d.v[i][2] * d.v[i][2] + d.v[i][3] * d.v[i][3]); }
    const float rs = rsqrtf(wave_sum(q) * (1.f / D) + 1e-5f);
#pragma unroll
    for (int i = 0; i < 4; ++i) d.v[i] = d.v[i] * rs;
    return d;
}
__device__ __forceinline__ RowV row_affine(const RowV& n, const float* g, const float* b, int lane) {
    RowV o;
#pragma unroll
    for (int i = 0; i < 4; ++i) o.v[i] = n.v[i] * *(const f32x4*)(g + 256 * i + 4 * lane) + *(const f32x4*)(b + 256 * i + 4 * lane);
    return o;
}
__device__ __forceinline__ RowV row_modulate(const RowV& n, const float* sh, const float* sc, int lane) {
    RowV o;
#pragma unroll
    for (int i = 0; i < 4; ++i) o.v[i] = n.v[i] * (*(const f32x4*)(sc + 256 * i + 4 * lane) + 1.0f) + *(const f32x4*)(sh + 256 * i + 4 * lane);
    return o;
}

constexpr int LDS_BYTES = 159744;
constexpr int MISC_OFF = 159488;
constexpr int NPH_LAYER = 16;
#ifndef SPLIT
#define SPLIT 0
#endif

__global__ void __launch_bounds__(512, 2) mk_fwd(Args a) {
    extern __shared__ __attribute__((aligned(16))) unsigned char shm[];
    LAS unsigned char* lds = (LAS unsigned char*)shm;
    volatile LAS unsigned* MISC = (volatile LAS unsigned*)(lds + MISC_OFF);
    const int tid0 = threadIdx.x, wave = __builtin_amdgcn_readfirstlane(tid0 >> 6);
    const int G = gridDim.x, bid = blockIdx.x;
    if (tid0 < (LDS_BYTES - MISC_OFF) / 4) MISC[tid0] = 0u;
    __syncthreads();
    unsigned char* ws = a.ws;
    unsigned* ctl = (unsigned*)(ws + WS_CTL);
    XcdBarrier bar = xcd_barrier_post(ctl + CW_BAR + a.bar_region * XCD_BAR_WORDS, MISC + 8);
    const int lo = a.ph_lo, hi = a.ph_hi;
#ifndef PHMASK
#define PHMASK 0xFFFF
#endif
#define IN(k) (lo <= (k) && (k) < hi)
#define SEAM(k) do { if (lo <= (k) && (k) + 1 < hi) xcd_barrier(bar); } while (0)
    float* MOD = (float*)(ws + WS_MOD);
    bf16_t* UB = (bf16_t*)(ws + WS_UB); bf16_t* PR = (bf16_t*)(ws + WS_PR); bf16_t* PT = (bf16_t*)(ws + WS_PT); bf16_t* YB = (bf16_t*)(ws + WS_YB);
    float* PRE = (float*)(ws + WS_PRE); float* XSC = (float*)(ws + WS_XSC);
    const float* x_in = a.in[0]; const float* ctx_in = a.in[2];

    if (((PHMASK >> 0) & 1) && IN(0)) {
        const int tid = opaque(tid0), lane = tid & 63;
        __syncthreads();
        LAS float* sc = (LAS float*)lds;
        for (int i = tid; i < 5 * 1024; i += 512) { const int r = i >> 10, k = i & 1023; sc[i] = silu_acc(r < 4 ? a.in[1][r * 1024 + k] : a.in[3][k]); }
        __syncthreads();
        for (int u = bid; u < 2 * 96 * 8; u += G) {
            const int l = u / (96 * 8), rem = u % (96 * 8), cg = rem / 8, ks = rem % 8;
            const int n = cg * 64 + lane;
            const float* w = a.in[4] + (size_t)l * 1024 * 6144 + n;
            float a0 = 0, a1 = 0, a2 = 0, a3 = 0, a4 = 0;
            const int kb = ks * 128 + wave * 16;
#pragma unroll 4
            for (int k = kb; k < kb + 16; ++k) { const float wv = w[(size_t)k * 6144]; a0 += sc[k] * wv; a1 += sc[1024 + k] * wv; a2 += sc[2048 + k] * wv; a3 += sc[3072 + k] * wv; a4 += sc[4096 + k] * wv; }
            if (ks == 0 && wave == 0) { const float bb = a.in[5][l * 6144 + n]; a0 += bb; a1 += bb; a2 += bb; a3 += bb; a4 += bb; }
            float* o = MOD + (size_t)l * 5 * 6144 + n;
            atomicAdd(o, a0); atomicAdd(o + 6144, a1); atomicAdd(o + 2 * 6144, a2); atomicAdd(o + 3 * 6144, a3); atomicAdd(o + 4 * 6144, a4);
        }
        __syncthreads();
        for (int u = bid; u < 132; u += G) {
            const bool isc = u >= 128; const int l = isc ? 0 : (u >> 6), blk = isc ? u - 128 : (u & 63), L = isc ? CTXL : SEQ, t0 = blk * 64;
            LAS float* feat = (LAS float*)lds;
            LAS float* h1 = feat + 64 * 33;
            LAS float* h2 = h1 + 4096;
            const float* w1 = a.in[16] + l * 33 * 64; const float* b1 = a.in[17] + l * 64; const float* w2 = a.in[18] + l * 4096; const float* b2 = a.in[19] + l * 64;
            const float* w3 = a.in[20] + (size_t)l * 65536; const float* b3 = a.in[21] + l * 1024; const float* fq = a.in[22] + l * 64;
            __syncthreads();
            for (int i = tid; i < 64 * 33; i += 512) { const int tt = i / 33, f = i - tt * 33, t = t0 + tt; float v;
                if (f == 0) v = (float)t / (float)L;
                else { const int band = (f - 1) % 16 + 1; const int m = (int)(((long)t * band) % L); const double ang = 2.0 * M_PI * (double)m / (double)L; v = f <= 16 ? (float)cos(ang) : (float)sin(ang); }
                feat[i] = v; }
            __syncthreads();
            for (int i = tid; i < 4096; i += 512) { const int tt = i >> 6, j = i & 63; float sacc = b1[j];
                for (int f = 0; f < 33; ++f) sacc += feat[tt * 33 + f] * w1[f * 64 + j];
                h1[i] = sinf(fq[j] * sacc); }
            __syncthreads();
            for (int i = tid; i < 4096; i += 512) { const int tt = i >> 6, j = i & 63; float sacc = b2[j];
                for (int f = 0; f < 64; ++f) sacc += h1[tt * 64 + f] * w2[f * 64 + j];
                h2[i] = sinf(fq[j] * sacc); }
            __syncthreads();
            const float dmin = 3.0701134573253945f, dmax = 15.350567286626973f;
#pragma unroll 1
            for (int jj = 0; jj < 2; ++jj) {
                const int n = tid + 512 * jj, dir = n >> 9, o = (n >> 8) & 1, c = n & 255;
                float wc[64];
#pragma unroll
                for (int i = 0; i < 64; ++i) wc[i] = w3[i * 1024 + n];
                const float bb = b3[n], delta = dmin + (dmax - dmin) * (float)c / 255.0f;
                bf16_t* dst = isc ? (bf16_t*)(ws + WS_KFC) + ((size_t)(dir * 2 + o) * 256 + c) * CTXL + t0 : (bf16_t*)(ws + WS_KFL) + ((size_t)((l * 2 + dir) * 2 + o) * 256 + c) * SEQ + t0;
                float asum = 0.f;
#pragma unroll 1
                for (int tg = 0; tg < 8; ++tg) {
                    float v[8];
#pragma unroll
                    for (int q = 0; q < 8; ++q) { float sacc = bb; const LAS float* hp = h2 + (tg * 8 + q) * 64;
#pragma unroll
                        for (int i = 0; i < 64; ++i) sacc += hp[i] * wc[i];
                        const int t = t0 + tg * 8 + q;
                        v[q] = sacc * expf(-((float)t / (float)L) * delta);
                        if (!(dir == 1 && t == 0)) asum += fabsf(v[q]); }
                    u32x4 w; w.x = cvt_pk_bf16(v[0], v[1]); w.y = cvt_pk_bf16(v[2], v[3]); w.z = cvt_pk_bf16(v[4], v[5]); w.w = cvt_pk_bf16(v[6], v[7]);
                    *(u32x4*)(dst + tg * 8) = w;
                }
                atomicAdd((float*)(ctl + CW_HYN) + (isc ? 1024 + o * 256 + c : (l * 2 + o) * 256 + c), asum);
            }
        }
        __syncthreads();
        for (int u = bid - 132; u >= 0 && u < 32; u += G) {
            const int l = u >> 4, g = u & 15;
            LAS float* PW = (LAS float*)lds;
            LAS float* BBs = PW + 2 * 64 * 17 * 2;
            LAS float* Cs = BBs + 2 * 64 * 16 * 2;
            LAS float* KT = Cs + 2 * 16 * 64 * 2;
            __syncthreads();
            if (tid < 128) {
                const int d = tid >> 6, p = tid & 63, idx = l * 2048 + (d * 16 + g) * 64 + p;
                const double ar = a.in[25][idx], ai = a.in[26][idx], dt = exp((double)a.in[27][l * 32 + d * 16 + g]);
                const double mag = exp(dt * ar), abr = mag * cos(dt * ai), abi = mag * sin(dt * ai), den = ar * ar + ai * ai;
                const double fr = ((abr - 1.0) * ar + abi * ai) / den, fi = (abi * ar - (abr - 1.0) * ai) / den;
                double pr = 1.0, pi = 0.0;
                for (int k = 0; k <= 16; ++k) { PW[((d * 64 + p) * 17 + k) * 2] = (float)pr; PW[((d * 64 + p) * 17 + k) * 2 + 1] = (float)pi; const double nr = pr * abr - pi * abi, ni = pr * abi + pi * abr; pr = nr; pi = ni; }
                float* a16 = (float*)(ws + WS_AB16) + ((size_t)((l * 2 + d) * 16 + g) * 64 + p) * 2;
                a16[0] = PW[((d * 64 + p) * 17 + 16) * 2]; a16[1] = PW[((d * 64 + p) * 17 + 16) * 2 + 1];
                for (int i = 0; i < 16; ++i) { const double br = a.in[28][(size_t)idx * 16 + i], bi = a.in[29][(size_t)idx * 16 + i];
                    BBs[((d * 64 + p) * 16 + i) * 2] = (float)(fr * br - fi * bi); BBs[((d * 64 + p) * 16 + i) * 2 + 1] = (float)(fr * bi + fi * br); }
            }
            for (int i = tid; i < 2048; i += 512) { const int d = i >> 10, o = (i >> 6) & 15, p = i & 63; const size_t ci = (size_t)l * 32768 + ((size_t)(d * 16 + g) * 16 + o) * 64 + p;
                Cs[i * 2] = a.in[30][ci]; Cs[i * 2 + 1] = a.in[31][ci]; }
            __syncthreads();
            for (int e = tid; e < 8192; e += 512) { const int d = e >> 12, k = (e >> 8) & 15, o = (e >> 4) & 15, i = e & 15;
                float acc = 0.f;
                for (int p = 0; p < 64; ++p) { const float cr = Cs[((d * 16 + o) * 64 + p) * 2], ci = Cs[((d * 16 + o) * 64 + p) * 2 + 1], pr = PW[((d * 64 + p) * 17 + k) * 2], pi = PW[((d * 64 + p) * 17 + k) * 2 + 1];
                    const float tr = cr * pr - ci * pi, ti = cr * pi + ci * pr;
                    acc += tr * BBs[((d * 64 + p) * 16 + i) * 2] - ti * BBs[((d * 64 + p) * 16 + i) * 2 + 1]; }
                KT[e] = acc; }
            __syncthreads();
            bf16_t* OPS = (bf16_t*)(ws + WS_OPS) + (size_t)(l * 16 + g) * 256 * 256;
            bf16_t* OPY = (bf16_t*)(ws + WS_OPY) + (size_t)(l * 16 + g) * 256 * 512;
            for (int e = tid; e < 256 * 32; e += 512) {
                const int row = e >> 5, c0 = (e & 31) * 8, d = row >> 7, p = (row >> 1) & 63, ri = row & 1, sx = c0 >> 4, i0 = c0 & 15, k = d == 0 ? 15 - sx : sx;
                const float pr = PW[((d * 64 + p) * 17 + k) * 2], pi = PW[((d * 64 + p) * 17 + k) * 2 + 1];
                float v[8];
#pragma unroll
                for (int j = 0; j < 8; ++j) { const float br = BBs[((d * 64 + p) * 16 + i0 + j) * 2], bi = BBs[((d * 64 + p) * 16 + i0 + j) * 2 + 1]; v[j] = ri == 0 ? pr * br - pi * bi : pr * bi + pi * br; }
                u32x4 w; w.x = cvt_pk_bf16(v[0], v[1]); w.y = cvt_pk_bf16(v[2], v[3]); w.z = cvt_pk_bf16(v[4], v[5]); w.w = cvt_pk_bf16(v[6], v[7]);
                *(u32x4*)(OPS + (size_t)row * 256 + c0) = w; }
            for (int e = tid; e < 256 * 64; e += 512) {
                const int row = e >> 6, c0 = (e & 63) * 8, t = row >> 4, o = row & 15;
                float v[8];
                if (c0 < 256) { const int sx = c0 >> 4, i0 = c0 & 15;
#pragma unroll
                    for (int j = 0; j < 8; ++j) { float x = 0.f; if (sx <= t) x += KT[((0 * 16 + (t - sx)) * 16 + o) * 16 + i0 + j]; if (sx >= t) x += KT[((1 * 16 + (sx - t)) * 16 + o) * 16 + i0 + j]; v[j] = x; } }
                else { const int c2 = c0 - 256, d = c2 >> 7, k = d == 0 ? t + 1 : 16 - t;
#pragma unroll
                    for (int j = 0; j < 8; ++j) { const int p = ((c2 + j) >> 1) & 63, ri = (c2 + j) & 1;
                        const float cr = Cs[((d * 16 + o) * 64 + p) * 2], ci = Cs[((d * 16 + o) * 64 + p) * 2 + 1], pr = PW[((d * 64 + p) * 17 + k) * 2], pi = PW[((d * 64 + p) * 17 + k) * 2 + 1];
                        v[j] = ri == 0 ? cr * pr - ci * pi : -(cr * pi + ci * pr); } }
                u32x4 w; w.x = cvt_pk_bf16(v[0], v[1]); w.y = cvt_pk_bf16(v[2], v[3]); w.z = cvt_pk_bf16(v[4], v[5]); w.w = cvt_pk_bf16(v[6], v[7]);
                *(u32x4*)(OPY + (size_t)row * 512 + c0) = w; }
        }
        __syncthreads();
        for (;;) {
            __syncthreads();
            if (tid == 0) MISC[16] = atomicAdd(ctl + CW_QUEUE, 4u);
            __syncthreads();
            const int base = (int)MISC[16];
            if (base >= JT_SMALL.total) break;
            convert_step(a, JT_SMALL, (LAS float*)lds, base, 1);
        }
        __syncthreads();
    }
    SEAM(0);

    for (int l = 0; l < 2; ++l) {
        const int P0 = 1 + l * NPH_LAYER;
        const float* MODL = MOD + (size_t)l * 5 * 6144;
        const unsigned char* WL = ws + WS_WL + (size_t)l * SZ_WL;
        const int nMrow = (l == 0) ? 68 : 64;
        const float* xlat = (l == 0) ? x_in : a.out; const float* xctx = (l == 0) ? ctx_in : XSC;

        if (((PHMASK >> 1) & 1) && l == 0 && IN(P0 + 0)) {
            const int lane = opaque(tid0) & 63;
            for (int r = bid * 8 + wave; r < RT; r += G * 8) {
                const float* src = r < RL ? x_in + (size_t)r * D : ctx_in + (size_t)(r - RL) * D;
                const float* mv = MODL + (size_t)(r < RL ? (r >> 12) : 4) * 6144;
                const RowV n = row_norm(row_load(src, lane));
                row_store_bf16(UB + (size_t)r * D, lane, row_modulate(n, mv, mv + 1024, lane));
            }
        }
        if (l == 0) SEAM(P0 + 0);

        if (((PHMASK >> 2) & 1) && IN(P0 + 1)) {
            const pg8::TabSched S{PARTS.p + l * 8, (const char*)ws, 2, 68 * 23 + 5 * 68, G, bid};
            pg8::EpiProj E{PR, PT, (bf16_t*)(ws + WS_US), 7};
            pg8::gemm_phase<1024, 1024>(lds, S, E);
        }
        SEAM(P0 + 1);
        if (((PHMASK >> 13) & 1) && IN(P0 + 2)) {
            const int tid = opaque(tid0), lane = tid & 63;
            LAS float* rp = (LAS float*)lds;
            for (int i = tid; i < 6 * 465; i += 512) rp[i] = a.in[24][l * 2790 + i];
            __syncthreads();
            const int qn = lane & 15, g = lane >> 4;
            const int nunits = 6144 + (l == 0 ? 384 : 0);
            for (int u = bid * 8 + wave; u < nunits; u += G * 8) {
                const bool lat = u < 6144;
                const int uu = lat ? u : u - 6144;
                const int h = uu % 6; int t = uu / 6;
                int b, r = 0, qb, tq, rs = 0, bs = 0, w = 0, cs = 0;
                if (lat) { qb = t & 3; t >>= 2; r = t & 63; b = t >> 6; rs = r - 4 < 0 ? 0 : (r - 4 > 56 ? 56 : r - 4); bs = qb == 0 ? 0 : (qb == 1 ? 8 : (qb == 2 ? 24 : 32));
                    w = 16 * qb + qn; cs = w - 8 < 0 ? 0 : (w - 8 > 48 ? 48 : w - 8); tq = b * SEQ + r * 64 + w; }
                else { qb = t & 15; b = t >> 4; tq = RL + b * CTXL + 16 * qb + qn; }
                const bf16_t* qp = PR + (size_t)tq * LDP + PC_Q + h * 64 + 8 * g;
                const bf16x8 q0 = *(const bf16x8*)qp, q1 = *(const bf16x8*)(qp + 32);
                f32x4 S[32];
                const int koff = 8 * (qn >> 2) + (qn & 3);
                if (lat) {
#pragma unroll
                    for (int pb = 0; pb < 2; ++pb) {
                        bf16x8 kf[16];
#pragma unroll
                        for (int q = 0; q < 8; ++q) { const int p = pb * 4 + (q >> 1), hf = q & 1;
                            const bf16_t* kp = PR + (size_t)(b * SEQ + (rs + p) * 64 + bs + koff + 4 * hf) * LDP + PC_K + h * 64 + 8 * g;
                            kf[2 * q] = *(const bf16x8*)kp; kf[2 * q + 1] = *(const bf16x8*)(kp + 32); }
                        PIN16(kf);
#pragma unroll
                        for (int q = 0; q < 8; ++q) { const int p = pb * 4 + (q >> 1), hf = q & 1;
                            f32x4 acc = {0.f, 0.f, 0.f, 0.f};
                            acc = __builtin_amdgcn_mfma_f32_16x16x32_bf16(kf[2 * q], q0, acc, 0, 0, 0);
                            acc = __builtin_amdgcn_mfma_f32_16x16x32_bf16(kf[2 * q + 1], q1, acc, 0, 0, 0);
                            const int rowoff = (h * 15 + (rs + p - r + 7)) * 31;
#pragma unroll
                            for (int j = 0; j < 4; ++j) { const int c = bs + 8 * g + 4 * hf + j; const bool ok = (c >= cs) && (c < cs + 16);
                                const int dc = ok ? c - w + 15 : 0;
                                acc[j] = ok ? acc[j] * 0.125f + rp[rowoff + dc] : -3.0e38f; }
                            S[2 * p + hf] = acc; }
                    }
                } else {
#pragma unroll
                    for (int p = 0; p < 16; ++p) S[p] = (f32x4){-3.0e38f, -3.0e38f, -3.0e38f, -3.0e38f};
                }
#pragma unroll
                for (int pb = 0; pb < 2; ++pb) {
                    bf16x8 kf[16];
#pragma unroll
                    for (int q = 0; q < 8; ++q) { const int p = pb * 4 + (q >> 1), hf = q & 1;
                        const bf16_t* kp = PR + (size_t)(RL + b * CTXL + 32 * p + koff + 4 * hf) * LDP + PC_K + h * 64 + 8 * g;
                        kf[2 * q] = *(const bf16x8*)kp; kf[2 * q + 1] = *(const bf16x8*)(kp + 32); }
                    PIN16(kf);
#pragma unroll
                    for (int q = 0; q < 8; ++q) { const int p = pb * 4 + (q >> 1), hf = q & 1;
                        f32x4 acc = {0.f, 0.f, 0.f, 0.f};
                        acc = __builtin_amdgcn_mfma_f32_16x16x32_bf16(kf[2 * q], q0, acc, 0, 0, 0);
                        acc = __builtin_amdgcn_mfma_f32_16x16x32_bf16(kf[2 * q + 1], q1, acc, 0, 0, 0);
                        S[16 + 2 * p + hf] = acc * 0.125f; }
                }
                float mx = -3.0e38f;
#pragma unroll
                for (int i = 0; i < 32; ++i) mx = fmaxf(fmaxf(mx, fmaxf(S[i][0], S[i][1])), fmaxf(S[i][2], S[i][3]));
                mx = fmaxf(mx, __shfl_xor(mx, 16)); mx = fmaxf(mx, __shfl_xor(mx, 32));
                float sum = 0.f;
#pragma unroll
                for (int i = 0; i < 32; ++i) {
#pragma unroll
                    for (int j = 0; j < 4; ++j) { const float e = __expf(S[i][j] - mx); S[i][j] = e; sum += e; } }
                sum += __shfl_xor(sum, 16); sum += __shfl_xor(sum, 32);
                const float inv = 1.0f / sum;
                f32x4 O[4];
#pragma unroll
                for (int dt = 0; dt < 4; ++dt) O[dt] = (f32x4){0.f, 0.f, 0.f, 0.f};
                const bf16_t* vt = PT + (size_t)(PT_V + h * 64 + qn) * RT + 8 * g;
#pragma unroll
                for (int pq = 0; pq < 4; ++pq) {
                    if (pq < 2 && !lat) continue;
                    bf16x8 vf[16];
#pragma unroll
                    for (int q = 0; q < 4; ++q) { const int p = pq * 4 + q;
                        const int base = p < 8 ? b * SEQ + (rs + p) * 64 + bs : RL + b * CTXL + 32 * (p - 8);
#pragma unroll
                        for (int dt = 0; dt < 4; ++dt) vf[4 * q + dt] = *(const bf16x8*)(vt + (size_t)(16 * dt) * RT + base); }
                    PIN16(vf);
#pragma unroll
                    for (int q = 0; q < 4; ++q) { const int p = pq * 4 + q;
                        u32x4 pw; pw.x = cvt_pk_bf16(S[2 * p][0], S[2 * p][1]); pw.y = cvt_pk_bf16(S[2 * p][2], S[2 * p][3]); pw.z = cvt_pk_bf16(S[2 * p + 1][0], S[2 * p + 1][1]); pw.w = cvt_pk_bf16(S[2 * p + 1][2], S[2 * p + 1][3]);
                        bf16x8 pf; __builtin_memcpy(&pf, &pw, 16);
#pragma unroll
                        for (int dt = 0; dt < 4; ++dt) O[dt] = __builtin_amdgcn_mfma_f32_16x16x32_bf16(vf[4 * q + dt], pf, O[dt], 0, 0, 0); }
                }
                bf16_t* op = YB + (size_t)tq * YW + YC_C + h * 64 + 4 * g;
#pragma unroll
                for (int dt = 0; dt < 4; ++dt) { u32x2 o2; o2.x = cvt_pk_bf16(O[dt][0] * inv, O[dt][1] * inv); o2.y = cvt_pk_bf16(O[dt][2] * inv, O[dt][3] * inv); *(u32x2*)(op + 16 * dt) = o2; }
            }
            __syncthreads();
            {
                const int tid = opaque(tid0), lane = tid & 63;
                LAS float* XC = (LAS float*)lds;
                LAS f32x2* AB = (LAS f32x2*)(lds + 16 * 384 * 4);
                const float* cw = a.in[7] + l * 4 * 384; const float* cb = a.in[8] + l * 384;
                const bf16_t* LW = (const bf16_t*)(ws + WS_LW) + (size_t)l * 24 * 4096;
                bf16_t* LT = (bf16_t*)(ws + WS_LT); f32x2* LAGG = (f32x2*)(ws + WS_LAGG);
                const int dir = (wave >> 2) & 1, ntile = wave & 3, tk = lane & 15, kg = lane >> 4;
                LAS float* CT = (LAS float*)(lds + 16 * 384 * 4 + 2 * 16 * 384 * 8);
                for (int i = tid; i < 768; i += 512) { CT[i] = a.in[10][l * 768 + i]; CT[768 + i] = a.in[12][l * 768 + i]; CT[1536 + i] = -8.0f * softplus(-a.in[13][l * 768 + i]); }
                float cwv[60];
#pragma unroll
                for (int i = 0; i < 12; ++i) { const int idx = tid + 512 * i, ch = idx % 384;
                    cwv[5 * i] = cw[ch]; cwv[5 * i + 1] = cw[384 + ch]; cwv[5 * i + 2] = cw[768 + ch]; cwv[5 * i + 3] = cw[1152 + ch]; cwv[5 * i + 4] = cb[ch]; }
                PIN16(cwv); PIN16(cwv + 16); PIN16(cwv + 32); PIN8(cwv + 48); asm volatile("" : "+v"(cwv[56]), "+v"(cwv[57]), "+v"(cwv[58]), "+v"(cwv[59]));
                for (int n = bid; n < NCHK; n += G) {
                    const int r0 = 16 * n; int start, len, pos0, bb; row_seq(r0, start, len, pos0, bb);
                    __syncthreads();
                    unsigned pin[48];
#pragma unroll
                    for (int i = 0; i < 12; ++i) { const int idx = tid + 512 * i, tok = idx / 384, ch = idx - tok * 384, pos = pos0 + tok;
                        const bf16_t* pr = PR + (size_t)(r0 + tok) * LDP + PC_AC + ch;
                        pin[4 * i + 0] = pos >= 2 ? pr[-2 * LDP] : 0; pin[4 * i + 1] = pos >= 1 ? pr[-LDP] : 0; pin[4 * i + 2] = pr[0]; pin[4 * i + 3] = pos + 1 < len ? pr[LDP] : 0; }
                    PIN16(pin); PIN16(pin + 16); PIN16(pin + 32);
#pragma unroll
                    for (int i = 0; i < 12; ++i) { const int idx = tid + 512 * i, tok = idx / 384, ch = idx - tok * 384;
                        XC[idx] = cwv[5 * i + 4] + cwv[5 * i] * bflo(pin[4 * i]) + cwv[5 * i + 1] * bflo(pin[4 * i + 1]) + cwv[5 * i + 2] * bflo(pin[4 * i + 2]) + cwv[5 * i + 3] * bflo(pin[4 * i + 3]); }
                    __syncthreads();
#pragma unroll 2
                    for (int g = 0; g < 6; ++g) {
                        bf16x8 wq[4];
#pragma unroll
                        for (int ks = 0; ks < 2; ++ks) { const bf16_t* wp = LW + ((size_t)((dir * 2 + 0) * 6 + g) * 64 + 16 * ntile + tk) * 64 + 32 * ks + 8 * kg; wq[2 * ks] = *(const bf16x8*)wp; wq[2 * ks + 1] = *(const bf16x8*)(wp + 6 * 4096); }
                        asm volatile("" : "+v"(wq[0]), "+v"(wq[1]), "+v"(wq[2]), "+v"(wq[3]));
                        f32x4 ar = {0.f, 0.f, 0.f, 0.f}, ai = {0.f, 0.f, 0.f, 0.f};
#pragma unroll
                        for (int ks = 0; ks < 2; ++ks) {
                            const LAS float* xp = XC + tk * 384 + g * 64 + 32 * ks + 8 * kg;
                            const f32x4 x0 = *(const LAS f32x4*)xp, x1 = *(const LAS f32x4*)(xp + 4);
                            u32x4 xw; xw.x = cvt_pk_bf16(x0[0], x0[1]); xw.y = cvt_pk_bf16(x0[2], x0[3]); xw.z = cvt_pk_bf16(x1[0], x1[1]); xw.w = cvt_pk_bf16(x1[2], x1[3]);
                            bf16x8 xf; __builtin_memcpy(&xf, &xw, 16);
                            ar = __builtin_amdgcn_mfma_f32_16x16x32_bf16(xf, wq[2 * ks], ar, 0, 0, 0);
                            ai = __builtin_amdgcn_mfma_f32_16x16x32_bf16(xf, wq[2 * ks + 1], ai, 0, 0, 0);
                        }
                        const int ch = g * 64 + 16 * ntile + tk;
                        const float br = CT[dir * 384 + ch], bi = CT[768 + dir * 384 + ch], sp8 = CT[1536 + dir * 384 + ch];
#pragma unroll
                        for (int j = 0; j < 4; ++j) { const int tok = 4 * kg + j;
                            const float la = sigm(ar[j] + br) * sp8, y = 2.0f * la;
                            const float av = 1.0f + la * (1.0f + la * (0.5f + la * (0.16666667f + la * (0.041666667f + la * 0.0083333333f))));
                            const float om = -y * (1.0f + y * (0.5f + y * (0.16666667f + y * (0.041666667f + y * (0.0083333333f + y * 0.0013888889f)))));
                            const float bt = __builtin_sqrtf(om) * sigm(ai[j] + bi) * XC[tok * 384 + ch];
                            AB[(dir * 16 + tok) * 384 + ch] = (f32x2){av, bt}; }
                    }
                    __syncthreads();
                    if (tid < 384) {
                        float hf = 0.f, pf = 1.f, hb = 0.f, pb = 1.f;
#pragma unroll
                        for (int t = 0; t < 16; ++t) {
                            const f32x2 f = AB[t * 384 + tid], bk = AB[(16 + 15 - t) * 384 + tid];
                            hf = f[0] * hf + f[1]; pf *= f[0]; hb = bk[0] * hb + bk[1]; pb *= bk[0];
                            AB[t * 384 + tid] = (f32x2){pf, hf}; AB[(16 + 15 - t) * 384 + tid] = (f32x2){pb, hb}; }
                        LAGG[((size_t)n * 2 + 0) * 384 + tid] = (f32x2){pf, hf}; LAGG[((size_t)n * 2 + 1) * 384 + tid] = (f32x2){pb, hb};
                    }
                    __syncthreads();
#pragma unroll
                    for (int i = 0; i < 12; ++i) { const int idx = tid + 512 * i, tok = idx / 384, ch = idx - tok * 384;
                        const f32x2 f = AB[idx], bk = AB[16 * 384 + idx];
                        bf16_t* o = LT + (size_t)(r0 + tok) * 1152 + ch;
                        o[0] = f2bf(f[1] + bk[1]); o[384] = f2bf(f[0]); o[768] = f2bf(bk[0]); }
                }
                __syncthreads();
            }
            {
                const int tid = opaque(tid0), lane = tid & 63;
                constexpr int ZS = SEQ + 16;
                LAS bf16_t* R0 = (LAS bf16_t*)lds;
                LAS bf16_t* R1 = R0 + 8224;
                LAS bf16_t* ZA = R1 + 8224;
                const LAS unsigned* Rdw = (const LAS unsigned*)lds;
#define HY_ZF(b, s) ((b) * ZS + ((s) & ~63) + (((((s) >> 3) & 7) ^ (((s) >> 7) & 1)) << 3) + ((s) & 7))
                const float* hcw = a.in[14] + l * 3 * 768; const float* hcb = a.in[15] + l * 768;
                const float* nrm = (const float*)(ctl + CW_HYN);
                bf16_t* YT = (bf16_t*)(ws + WS_YT);
                const int r32 = lane & 31, hh = lane >> 5, il = r32 >> 2, bq = r32 & 3, iblk = 8 * wave + il;
                const int x0b = 4095 - r32 + 8 * hh, par = x0b & 1;
                const int abase = (par ? 4112 : 0) + ((x0b - par) >> 1);
                for (int c = bid; c < 256; c += G) {
                    __syncthreads();
#pragma unroll 1
                    for (int it = tid; it < 3 * 4 * 512; it += 512) {
                        const int arr = it >> 11, b = (it >> 9) & 3, s8 = (it & 511) * 8, ch = arr * 256 + c;
                        const bf16_t* pp = PT + (size_t)ch * RT + b * SEQ + s8;
                        const u32x4 pv = *(const u32x4*)pp;
                        const float w0 = hcw[ch], w1 = hcw[768 + ch], w2 = hcw[1536 + ch], cb0 = hcb[ch];
                        float p[10];
                        p[0] = s8 > 0 ? bf2f(pp[-1]) : 0.f; p[9] = s8 + 8 < SEQ ? bf2f(pp[8]) : 0.f;
                        p[1] = bflo(pv.x); p[2] = bfhi(pv.x); p[3] = bflo(pv.y); p[4] = bfhi(pv.y); p[5] = bflo(pv.z); p[6] = bfhi(pv.z); p[7] = bflo(pv.w); p[8] = bfhi(pv.w);
                        float z[8];
#pragma unroll
                        for (int j = 0; j < 8; ++j) z[j] = cb0 + w0 * p[j] + w1 * p[j + 1] + w2 * p[j + 2];
                        u32x4 w; w.x = cvt_pk_bf16(z[0], z[1]); w.y = cvt_pk_bf16(z[2], z[3]); w.z = cvt_pk_bf16(z[4], z[5]); w.w = cvt_pk_bf16(z[6], z[7]);
                        *(LAS u32x4*)(ZA + arr * 4 * ZS + HY_ZF(b, s8)) = w;
                    }
#pragma unroll 1
                    for (int o = 0; o < 2; ++o) {
                        const bf16_t* kf = (const bf16_t*)(ws + WS_KFL) + ((size_t)((l * 2 + 0) * 2 + o) * 256 + c) * SEQ;
                        const bf16_t* kb = (const bf16_t*)(ws + WS_KFL) + ((size_t)((l * 2 + 1) * 2 + o) * 256 + c) * SEQ;
                        { unsigned tv[16];
#pragma unroll
                          for (int q = 0; q < 16; ++q) { const int x = tid + 512 * q; tv[q] = x < 4096 ? kf[4095 - x] : (x <= 8190 ? kb[x - 4095] : (bf16_t)0); }
                          PIN16(tv);
#pragma unroll
                          for (int q = 0; q < 16; ++q) R0[tid + 512 * q] = (bf16_t)tv[q]; }
                        __syncthreads();
                        for (int x = tid; x < 8192; x += 512) R1[x] = x < 8191 ? R0[x + 1] : (bf16_t)0;
                        __syncthreads();
                        const LAS bf16_t* Z = ZA + (o == 0 ? 0 : 4 * ZS) + bq * ZS;
                        typedef float f32x16 __attribute__((ext_vector_type(16)));
                        f32x16 acc0, acc1;
#pragma unroll
                        for (int q = 0; q < 16; ++q) { acc0[q] = 0.f; acc1[q] = 0.f; }
                        const int dlo = 8 * wave - 63, dhi = 8 * wave + 7;
#pragma unroll 1
                        for (int dl = dlo; dl <= dhi; ++dl) {
                            const int j = iblk - dl; const bool ok = (j >= 0) && (j < 64); const int jc = j < 0 ? 0 : (j > 63 ? 63 : j);
                            const LAS bf16_t* zp = Z + jc * 64; const int sw = (jc >> 1) & 1;
                            const LAS unsigned* ap = Rdw + abase - 32 * dl;
                            bf16x8 bf[4];
#pragma unroll
                            for (int kk = 0; kk < 4; ++kk) { bf16x8 t = *(const LAS bf16x8*)(zp + (((2 * kk + hh) ^ sw) << 3)); bf[kk] = ok ? t : (bf16x8){0, 0, 0, 0, 0, 0, 0, 0}; }
#pragma unroll
                            for (int kk = 0; kk < 4; ++kk) {
                                const LAS unsigned* a0 = ap + 8 * kk; const LAS unsigned* a1 = ap - 16 + 8 * kk;
                                u32x4 w0 = {a0[0], a0[1], a0[2], a0[3]}, w1 = {a1[0], a1[1], a1[2], a1[3]};
                                bf16x8 f0, f1; __builtin_memcpy(&f0, &w0, 16); __builtin_memcpy(&f1, &w1, 16);
                                acc0 = __builtin_amdgcn_mfma_f32_32x32x16_bf16(f0, bf[kk], acc0, 0, 0, 0);
                                acc1 = __builtin_amdgcn_mfma_f32_32x32x16_bf16(f1, bf[kk], acc1, 0, 0, 0);
                            }
                        }
                        const float inv = 1.0f / (nrm[(l * 2 + o) * 256 + c] + 1e-6f), hb = a.in[23][(l * 2 + o) * 256 + c];
                        LAS bf16_t* GI = ZA + (o + 1) * 4 * ZS;
                        const LAS bf16_t* ZI = ZA + (o == 0 ? 0 : 4 * ZS);
#pragma unroll
                        for (int q = 0; q < 16; ++q) {
                            const int a0r = (q & 3) + 8 * (q >> 2) + 4 * hh, t0 = 64 * iblk + a0r, t1 = t0 + 32;
                            const int i0 = HY_ZF(bq, t0), i1 = HY_ZF(bq, t1);
                            const float zv0 = bf2f(ZI[i0]), zv1 = bf2f(ZI[i1]);
                            const float y0 = bf2f(GI[i0]) * (acc0[q] * inv + hb * zv0), y1v = bf2f(GI[i1]) * (acc1[q] * inv + hb * zv1);
                            GI[i0] = f2bf(y0); GI[i1] = f2bf(y1v);
                        }
                        __syncthreads();
                    }
                    for (int it = tid; it < 4 * 512; it += 512) { const int b = it >> 9, s8 = (it & 511) * 8;
                        *(u32x4*)(YT + (size_t)c * RT + b * SEQ + s8) = *(const LAS u32x4*)(ZA + 2 * 4 * ZS + HY_ZF(b, s8)); }
                    if (l == 0) {
                        __syncthreads();
                        LAS float* zc = (LAS float*)lds;
                        LAS float* kc = zc + 3072;
                        LAS float* y1c = kc + 1024;
                        for (int it = tid; it < 3072; it += 512) { const int arr = it >> 10, b = (it >> 8) & 3, sx = it & 255, ch = arr * 256 + c;
                            const bf16_t* pp = PT + (size_t)ch * RT + RL + b * CTXL + sx;
                            float z = hcb[ch] + hcw[768 + ch] * bf2f(pp[0]); if (sx > 0) z += hcw[ch] * bf2f(pp[-1]); if (sx + 1 < CTXL) z += hcw[1536 + ch] * bf2f(pp[1]);
                            zc[it] = z; }
                        for (int it = tid; it < 1024; it += 512) { const int o = it >> 9, dir = (it >> 8) & 1, tt = it & 255; kc[it] = bf2f(((const bf16_t*)(ws + WS_KFC))[((size_t)(dir * 2 + o) * 256 + c) * CTXL + tt]); }
                        __syncthreads();
#pragma unroll 1
                        for (int o = 0; o < 2; ++o) {
                            const float inv = 1.0f / (nrm[1024 + o * 256 + c] + 1e-6f), hb = a.in[23][o * 256 + c];
                            for (int it = tid; it < 1024; it += 512) { const int b = it >> 8, t = it & 255;
                                const LAS float* zi = o == 0 ? zc + b * 256 : y1c + b * 256;
                                const LAS float* kfc = kc + (o * 2 + 0) * 256; const LAS float* kbc = kc + (o * 2 + 1) * 256;
                                float acc = 0.f;
                                for (int sx = 0; sx <= t; ++sx) acc += kfc[t - sx] * zi[sx];
                                for (int sx = t + 1; sx < CTXL; ++sx) acc += kbc[sx - t] * zi[sx];
                                const float y = zc[(o + 1) * 1024 + b * 256 + t] * (acc * inv + hb * zi[t]);
                                if (o == 0) y1c[it] = y; else YT[(size_t)c * RT + RL + b * CTXL + t] = f2bf(y); }
                            __syncthreads();
                        }
                    }
                }
#undef HY_ZF
                __syncthreads();
            }
            {
                const pg8::TabSched S{PARTS.p + 18 + l * 3, (const char*)ws, 1, 80, G, bid};
                pg8::EpiS5State E{(float*)(ws + WS_S5S)};
                pg8::gemm_phase<512, 256>(lds, S, E);
            }
        }
        SEAM(P0 + 2);
        if (((PHMASK >> 14) & 1) && IN(P0 + 3)) {
            const int tid = opaque(tid0), lane = tid & 63;
            LAS float* st = (LAS float*)lds;
            const float* S5S = (const float*)(ws + WS_S5S); bf16_t* US = (bf16_t*)(ws + WS_US);
            for (int u = bid; u < 128; u += G) {
                const int d = u & 1, g = (u >> 1) & 15, b = u >> 5;
                __syncthreads();
                for (int i = tid; i < 272 * 32; i += 512) { const int q = i >> 5, c4 = (i & 31) * 4; const int n = q < 16 ? 1024 + 16 * b + q : 256 * b + (q - 16);
                    const f32x4 v = *(const f32x4*)(S5S + ((size_t)g * NCHKP + n) * 256 + d * 128 + c4);
                    st[q * 128 + c4] = v[0]; st[q * 128 + c4 + 1] = v[1]; st[q * 128 + c4 + 2] = v[2]; st[q * 128 + c4 + 3] = v[3]; }
                __syncthreads();
                if (wave == 0) {
                    const float* ab = (const float*)(ws + WS_AB16) + ((size_t)((l * 2 + d) * 16 + g) * 64 + lane) * 2;
                    const float ar = ab[0], ai = ab[1];
                    float hr = 0.f, hi = 0.f;
                    for (int k = 0; k < 272; ++k) {
                        const int q = d == 0 ? k : (k < 16 ? 15 - k : 287 - k);
                        const int n = q < 16 ? 1024 + 16 * b + q : 256 * b + (q - 16);
                        *(unsigned*)(US + ((size_t)g * NCHKP + n) * 512 + 256 + d * 128 + 2 * lane) = cvt_pk_bf16(hr, hi);
                        const float sr = st[q * 128 + 2 * lane], si = st[q * 128 + 2 * lane + 1];
                        const float nr = ar * hr - ai * hi + sr, ni = ar * hi + ai * hr + si;
                        hr = nr; hi = ni;
                    }
                }
            }
            __syncthreads();
            for (int u = bid - 128; u >= 0 && u < 48; u += G) {
                const int cb6 = u % 6, d = (u / 6) & 1, b = u / 12;
                LAS f32x2* sa = (LAS f32x2*)lds;
                const f32x2* LAGG = (const f32x2*)(ws + WS_LAGG); float* HIN = (float*)(ws + WS_LHIN);
                __syncthreads();
                for (int i = tid; i < 272 * 64; i += 512) { const int q = i >> 6, c = i & 63; const int n = q < 16 ? 1024 + 16 * b + q : 256 * b + (q - 16);
                    sa[i] = LAGG[((size_t)n * 2 + d) * 384 + cb6 * 64 + c]; }
                __syncthreads();
                if (wave == 0) {
                    float h = 0.f;
                    for (int k = 0; k < 272; ++k) {
                        const int q = d == 0 ? k : (k < 16 ? 15 - k : 287 - k);
                        const int n = q < 16 ? 1024 + 16 * b + q : 256 * b + (q - 16);
                        HIN[((size_t)n * 2 + d) * 384 + cb6 * 64 + lane] = h;
                        const f32x2 v = sa[q * 64 + lane];
                        h = v[0] * h + v[1];
                    }
                }
            }
            __syncthreads();
        }
        SEAM(P0 + 3);
        if (((PHMASK >> 15) & 1) && IN(P0 + 4)) {
            const pg8::TabSched S{PARTS.p + 19 + l * 3, (const char*)ws, 1, 80, G, bid};
            pg8::EpiS5Main E{(bf16_t*)(ws + WS_GL), PR, a.in[32] + l * 256};
            pg8::gemm_phase<512, 512>(lds, S, E);
            {
                const int tid = opaque(tid0);
                const bf16_t* YT = (const bf16_t*)(ws + WS_YT);
                LAS bf16_t* tl = (LAS bf16_t*)lds;
                const int nrt = nMrow * 4;
                for (int t = bid; t < 4 * nrt; t += G) {
                    const int c0 = (t & 3) * 64, r0 = (t >> 2) * 64;
                    __syncthreads();
                    { const int cc = tid >> 3, r8 = (tid & 7) * 8; *(LAS u32x4*)(tl + cc * 72 + r8) = *(const u32x4*)(YT + (size_t)(c0 + cc) * RT + r0 + r8); }
                    __syncthreads();
                    { const int rr = tid >> 3, c8 = (tid & 7) * 8; unsigned short e[8];
#pragma unroll
                        for (int j = 0; j < 8; ++j) e[j] = tl[(c8 + j) * 72 + rr];
                        u32x4 w; w.x = e[0] | ((unsigned)e[1] << 16); w.y = e[2] | ((unsigned)e[3] << 16); w.z = e[4] | ((unsigned)e[5] << 16); w.w = e[6] | ((unsigned)e[7] << 16);
                        *(u32x4*)(YB + (size_t)(r0 + rr) * YW + YC_B + c0 + c8) = w; }
                }
                __syncthreads();
            }
            {
                const int tid = opaque(tid0);
                const bf16_t* LT = (const bf16_t*)(ws + WS_LT); const float* HIN = (const float*)(ws + WS_LHIN);
                const int nrows = nMrow * 256;
                for (int it = bid * 512 + tid; it < nrows * 48; it += G * 512) {
                    const int r = it / 48, c8 = (it - r * 48) * 8, n = r >> 4;
                    const u32x4 gt = *(const u32x4*)(PR + (size_t)r * LDP + PC_AG + c8);
                    const bf16_t* lt = LT + (size_t)r * 1152 + c8;
                    const u32x4 sv = *(const u32x4*)lt, pf = *(const u32x4*)(lt + 384), pb = *(const u32x4*)(lt + 768);
                    const float* hf = HIN + ((size_t)n * 2 + 0) * 384 + c8; const float* hb = hf + 384;
                    const f32x4 hf0 = *(const f32x4*)hf, hf1 = *(const f32x4*)(hf + 4), hb0 = *(const f32x4*)hb, hb1 = *(const f32x4*)(hb + 4);
                    u32x4 w;
                    w.x = cvt_pk_bf16(gelu_f(bflo(gt.x)) * (bflo(sv.x) + bflo(pf.x) * hf0[0] + bflo(pb.x) * hb0[0]), gelu_f(bfhi(gt.x)) * (bfhi(sv.x) + bfhi(pf.x) * hf0[1] + bfhi(pb.x) * hb0[1]));
                    w.y = cvt_pk_bf16(gelu_f(bflo(gt.y)) * (bflo(sv.y) + bflo(pf.y) * hf0[2] + bflo(pb.y) * hb0[2]), gelu_f(bfhi(gt.y)) * (bfhi(sv.y) + bfhi(pf.y) * hf0[3] + bfhi(pb.y) * hb0[3]));
                    w.z = cvt_pk_bf16(gelu_f(bflo(gt.z)) * (bflo(sv.z) + bflo(pf.z) * hf1[0] + bflo(pb.z) * hb1[0]), gelu_f(bfhi(gt.z)) * (bfhi(sv.z) + bfhi(pf.z) * hf1[1] + bfhi(pb.z) * hb1[1]));
                    w.w = cvt_pk_bf16(gelu_f(bflo(gt.w)) * (bflo(sv.w) + bflo(pf.w) * hf1[2] + bflo(pb.w) * hb1[2]), gelu_f(bfhi(gt.w)) * (bfhi(sv.w) + bfhi(pf.w) * hf1[3] + bfhi(pb.w) * hb1[3]));
                    *(u32x4*)(YB + (size_t)r * YW + YC_A + c8) = w;
                }
            }
        }
        SEAM(P0 + 4);
        if (((PHMASK >> 15) & 1) && IN(P0 + 5)) {
            const pg8::TabSched S{PARTS.p + 20 + l * 3, (const char*)ws, 1, nMrow, G, bid};
            pg8::EpiS5Glu E{YB, (const bf16_t*)(ws + WS_GL), a.in[34] + l * 256};
            pg8::gemm_phase<256, 256>(lds, S, E);
        }
        SEAM(P0 + 5);
        if (((PHMASK >> 3) & 1) && IN(P0 + 6)) {
            const pg8::MergeSched S{(const char*)ws, (long long)WS_YB, (long long)(WS_WL + (size_t)l * SZ_WL + SZ_WINR + SZ_WINHY), 64, G, bid, l == 0 ? 64 : 0};
            pg8::EpiGate E{PR, UB, (bf16_t*)(ws + WS_MGC)};
            pg8::gemm_phase<1280, 1280>(lds, S, E);
        }
        SEAM(P0 + 6);
        if (((PHMASK >> 4) & 1) && IN(P0 + 7)) {
            const pg8::TabSched S{l == 0 ? PARTS.p + 24 : PARTS.p + 14, (const char*)ws, l == 0 ? 2 : 1, l == 0 ? 256 + 64 : 256, G, bid};
            pg8::EpiRes E{PRE, xlat, xctx, MODL + 2048, (float*)(ws + WS_EXTRA)};
            pg8::gemm_phase<1024, 1024>(lds, S, E);
        }
        SEAM(P0 + 7);
        if (((PHMASK >> 5) & 1) && IN(P0 + 8)) {
            const int lane = opaque(tid0) & 63;
            if (l == 1) convert_tiles(a, JT_MOE, (LAS float*)lds, bid, G);
            const float* lg = a.in[40] + l * D; const float* lb = a.in[41] + l * D;
            const int nrows = nMrow * 256;
            for (int r = bid * 8 + wave; r < nrows; r += G * 8) {
                const float* mv = MODL + (size_t)(r < RL ? (r >> 12) : 4) * 6144;
                RowV pre;
                if (r < RL) pre = row_load(PRE + (size_t)r * D, lane);
                else { const float* pp = (const float*)(ws + WS_EXTRA) + (size_t)(r - RL) * D; const RowV xin = row_load(ctx_in + (size_t)(r - RL) * D, lane), p0 = row_load(pp, lane), p1 = row_load(pp + (size_t)RC * D, lane), p2 = row_load(pp + (size_t)2 * RC * D, lane), p3 = row_load(pp + (size_t)3 * RC * D, lane);
#pragma unroll
                    for (int i = 0; i < 4; ++i) pre.v[i] = xin.v[i] * ALPHA + ((p0.v[i] + p1.v[i]) + (p2.v[i] + p3.v[i])); }
                const RowV x1 = row_affine(row_norm(pre), lg, lb, lane);
                row_store(r < RL ? a.out + (size_t)r * D : XSC + (size_t)(r - RL) * D, lane, x1);
                const RowV u2 = row_modulate(row_norm(x1), mv + 3072, mv + 4096, lane);
                row_store_bf16(UB + (size_t)r * D, lane, u2);
                if (l == 1) {
                    float lg8[8];
#pragma unroll
                    for (int e = 0; e < 8; ++e) lg8[e] = 0.f;
                    f32x4 rw[32];
#pragma unroll
                    for (int q = 0; q < 16; ++q) { const float* wp = a.in[47] + (size_t)(256 * (q >> 2) + 4 * lane + (q & 3)) * 8; rw[2 * q] = *(const f32x4*)wp; rw[2 * q + 1] = *(const f32x4*)(wp + 4); }
                    PIN16(rw); PIN16(rw + 16);
#pragma unroll
                    for (int i = 0; i < 4; ++i)
#pragma unroll
                        for (int j = 0; j < 4; ++j) { const float uv = u2.v[i][j];
                            const f32x4 w0 = rw[2 * (4 * i + j)], w1 = rw[2 * (4 * i + j) + 1];
                            lg8[0] += uv * w0[0]; lg8[1] += uv * w0[1]; lg8[2] += uv * w0[2]; lg8[3] += uv * w0[3]; lg8[4] += uv * w1[0]; lg8[5] += uv * w1[1]; lg8[6] += uv * w1[2]; lg8[7] += uv * w1[3]; }
#pragma unroll
                    for (int e = 0; e < 8; ++e) lg8[e] = wave_sum(lg8[e]);
                    if (lane == 0) {
                        int i1 = 0; float v1 = lg8[0];
#pragma unroll
                        for (int e = 1; e < 8; ++e) if (lg8[e] > v1) { v1 = lg8[e]; i1 = e; }
                        int i2 = 0; float v2 = -3.0e38f;
#pragma unroll
                        for (int e = 0; e < 8; ++e) if (e != i1 && lg8[e] > v2) { v2 = lg8[e]; i2 = e; }
                        const float e2 = expf(v2 - v1), w1 = 1.f / (1.f + e2), w2 = e2 / (1.f + e2);
                        int* tk = (int*)(ws + WS_TOK) + (size_t)r * 8;
                        tk[0] = i1; tk[1] = i2; ((float*)tk)[2] = w1; ((float*)tk)[3] = w2;
                        tk[4] = (int)atomicAdd(ctl + CW_MOECNT + 64 * i1, 1u); tk[5] = (int)atomicAdd(ctl + CW_MOECNT + 64 * i2, 1u);
                    }
                }
            }
        }
        SEAM(P0 + 8);
        if (l == 0) {
            if (((PHMASK >> 6) & 1) && IN(P0 + 9)) {
                const pg8::TabSched S{PARTS.p + 16, (const char*)ws, 1, 68 * 22, G, bid};
                pg8::EpiSwiglu E{(bf16_t*)(ws + WS_H), FF_DENSE, 0};
                pg8::gemm_phase<1024, 1024>(lds, S, E);
            }
            SEAM(P0 + 9);
            if (((PHMASK >> 7) & 1) && IN(P0 + 10)) {
                const pg8::TabSched S{PARTS.p + 26, (const char*)ws, 3, 256 + 48 + 16, G, bid};
                pg8::EpiRes E{PRE, a.out, XSC, MODL + 5120, (float*)(ws + WS_EXTRA)};
                pg8::gemm_phase<FF_DENSE, FF_DENSE>(lds, S, E);
            }
            SEAM(P0 + 10);
            if (((PHMASK >> 8) & 1) && IN(P0 + 11)) {
                const int lane = opaque(tid0) & 63;
                const float* lg = a.in[42]; const float* lb = a.in[43];
                const float* MODN = MOD + (size_t)5 * 6144;
                for (int r = bid * 8 + wave; r < RT; r += G * 8) {
                    const float* mv = MODN + (size_t)(r < RL ? (r >> 12) : 4) * 6144;
                    RowV pre;
                    if (r < RL) pre = row_load(PRE + (size_t)r * D, lane);
                    else { const float* pp = (const float*)(ws + WS_EXTRA) + (size_t)(r - RL) * D; const RowV xin = row_load(XSC + (size_t)(r - RL) * D, lane), p0 = row_load(pp, lane), p1 = row_load(pp + (size_t)RC * D, lane), p2 = row_load(pp + (size_t)2 * RC * D, lane), p3 = row_load(pp + (size_t)3 * RC * D, lane);
#pragma unroll
                        for (int i = 0; i < 4; ++i) pre.v[i] = xin.v[i] * ALPHA + ((p0.v[i] + p1.v[i]) + (p2.v[i] + p3.v[i])); }
                    const RowV x2 = row_affine(row_norm(pre), lg, lb, lane);
                    row_store(r < RL ? a.out + (size_t)r * D : XSC + (size_t)(r - RL) * D, lane, x2);
                    row_store_bf16(UB + (size_t)r * D, lane, row_modulate(row_norm(x2), mv, mv + 1024, lane));
                }
            }
            SEAM(P0 + 11);
        } else {
            bf16_t* AG = (bf16_t*)(ws + WS_AG); float* slotw = (float*)(ws + WS_SLOTW); int* tile_e = (int*)(ws + WS_TILEE);
            if (((PHMASK >> 9) & 1) && IN(P0 + 9)) {
                const int tid = opaque(tid0), lane = tid & 63;
                int ts[NE + 1]; ts[0] = 0;
#pragma unroll
                for (int e = 0; e < NE; ++e) { const unsigned c = __hip_atomic_load(ctl + CW_MOECNT + 64 * e, __ATOMIC_RELAXED, __HIP_MEMORY_SCOPE_AGENT); ts[e + 1] = ts[e] + (int)((c + 255u) >> 8); }
                if (bid == 0) for (int mt = tid; mt < ts[NE]; mt += 512) { int e = 0;
#pragma unroll
                    for (int k = 1; k < NE; ++k) e += (mt >= ts[k]) ? 1 : 0;
                    tile_e[mt] = e; }
                for (int r = bid * 8 + wave; r < RL; r += G * 8) {
                    int* tk = (int*)(ws + WS_TOK) + (size_t)r * 8;
                    const u32x4 v0 = *(const u32x4*)(UB + (size_t)r * D + lane * 16), v1 = *(const u32x4*)(UB + (size_t)r * D + lane * 16 + 8);
#pragma unroll
                    for (int k = 0; k < 2; ++k) {
                        const int e = tk[k], pos = tk[4 + k];
                        int st = 0;
#pragma unroll
                        for (int q = 0; q < NE; ++q) st = (e == q) ? ts[q] : st;
                        const int srow = st * 256 + pos;
                        *(u32x4*)(AG + (size_t)srow * D + lane * 16) = v0; *(u32x4*)(AG + (size_t)srow * D + lane * 16 + 8) = v1;
                        if (lane == 0) { slotw[srow] = ((const float*)tk)[2 + k]; tk[6 + k] = srow; }
                    }
                }
            }
            SEAM(P0 + 9);
            int ttl = 0;
            if (lo <= P0 + 13 && P0 + 10 < hi) {
#pragma unroll
                for (int e = 0; e < NE; ++e) { const unsigned c = __hip_atomic_load(ctl + CW_MOECNT + 64 * e, __ATOMIC_RELAXED, __HIP_MEMORY_SCOPE_AGENT); ttl += (int)((c + 255u) >> 8); }
                ttl = __builtin_amdgcn_readfirstlane(ttl);
            }
#pragma unroll
            for (int pass = 0; pass < 2; ++pass) {
                const int tile0 = pass * MOE_P0; int ntile = pass == 0 ? (ttl < MOE_P0 ? ttl : MOE_P0) : ttl - MOE_P0; ntile = ntile < 0 ? 0 : (ntile > MOE_HCAP ? MOE_HCAP : ntile);
                if (((PHMASK >> 10) & 1) && IN(P0 + 10 + 2 * pass)) {
                    const pg8::MoeSched S{(const char*)AG + (size_t)tile0 * 256 * 1024 * 2, (const char*)(ws + WS_MOEGU), tile_e, 256u * 1024u * 2u, 256u * 1024u * 2u, (size_t)2 * FF_E * 1024 * 2, 28, 16, tile0, ntile, G, bid};
                    pg8::EpiSwiglu E{(bf16_t*)(ws + WS_HM), FF_E, tile0};
                    pg8::gemm_phase<1024, 1024>(lds, S, E);
                }
                SEAM(P0 + 10 + 2 * pass);
                if (((PHMASK >> 11) & 1) && IN(P0 + 11 + 2 * pass)) {
                    pg8::EpiMoeDown E{AG, slotw, (float*)(ws + WS_O2X)};
                    { const int nfull = pass == 0 ? ntile : (ttl < 128 ? ttl : 128) - MOE_P0, nex = pass == 0 ? 0 : ttl - 128;
                        const pg8::MoeTailSched S{(const char*)(ws + WS_HM), (const char*)(ws + WS_MOED), tile_e, tile0, nfull < 0 ? 0 : nfull, nex < 0 ? 0 : nex, G, bid};
                        pg8::gemm_phase<FF_E, FF_E>(lds, S, E); }
                }
                SEAM(P0 + 11 + 2 * pass);
            }
            if (((PHMASK >> 12) & 1) && IN(P0 + 14)) {
                const int lane = opaque(tid0) & 63;
                const float* lg = a.in[42] + D; const float* lb = a.in[43] + D;
                for (int r = bid * 8 + wave; r < RL; r += G * 8) {
                    const int* tk = (const int*)(ws + WS_TOK) + (size_t)r * 8;
                    const int sa = tk[6], sb = tk[7];
                    const bf16_t* oa = AG + (size_t)sa * D; const bf16_t* ob = AG + (size_t)sb * D;
                    const float* gv = MODL + (size_t)(r >> 12) * 6144 + 5120;
                    RowV x1 = row_load(a.out + (size_t)r * D, lane), gq = row_load(gv, lane), pre;
                    u32x2 va[4], vb[4];
#pragma unroll
                    for (int i = 0; i < 4; ++i) { va[i] = *(const u32x2*)(oa + 256 * i + 4 * lane); vb[i] = *(const u32x2*)(ob + 256 * i + 4 * lane); }
                    asm volatile("" : "+v"(va[0]), "+v"(va[1]), "+v"(va[2]), "+v"(va[3]), "+v"(vb[0]), "+v"(vb[1]), "+v"(vb[2]), "+v"(vb[3]), "+v"(x1.v[0]), "+v"(x1.v[1]), "+v"(x1.v[2]), "+v"(x1.v[3]), "+v"(gq.v[0]), "+v"(gq.v[1]), "+v"(gq.v[2]), "+v"(gq.v[3]));
#pragma unroll
                    for (int i = 0; i < 4; ++i) {
                        f32x4 fa = {bflo(va[i].x), bfhi(va[i].x), bflo(va[i].y), bfhi(va[i].y)}, fb = {bflo(vb[i].x), bfhi(vb[i].x), bflo(vb[i].y), bfhi(vb[i].y)};
                        if (sa >= 128 * 256) { const float* px = (const float*)(ws + WS_O2X) + (size_t)(sa - 128 * 256) * D + 256 * i + 4 * lane; fa = (*(const f32x4*)px + *(const f32x4*)(px + (size_t)2048 * D)) + (*(const f32x4*)(px + (size_t)2 * 2048 * D) + *(const f32x4*)(px + (size_t)3 * 2048 * D)); }
                        if (sb >= 128 * 256) { const float* px = (const float*)(ws + WS_O2X) + (size_t)(sb - 128 * 256) * D + 256 * i + 4 * lane; fb = (*(const f32x4*)px + *(const f32x4*)(px + (size_t)2048 * D)) + (*(const f32x4*)(px + (size_t)2 * 2048 * D) + *(const f32x4*)(px + (size_t)3 * 2048 * D)); }
                        pre.v[i] = x1.v[i] * ALPHA + gq.v[i] * (fa + fb); }
                    row_store(a.out + (size_t)r * D, lane, row_affine(row_norm(pre), lg, lb, lane));
                }
            }
        }
    }
#undef IN
#undef SEAM
}

}

extern "C" void kernel_launch(void* const* d_in, const int* in_sizes, int n_in, void* d_out, int out_size, void* d_ws, size_t ws_size, hipStream_t stream) {
    static int grid = 0;
    if (grid == 0) {
        if (n_in != 51 || ws_size < WS_END) { grid = -1; return; }
        int dev = 0, cus = 0;
        if (hipGetDevice(&dev) != hipSuccess || hipDeviceGetAttribute(&cus, hipDeviceAttributeMultiprocessorCount, dev) != hipSuccess) { grid = -1; return; }
        if (hipFuncSetAttribute((const void*)mk_fwd, hipFuncAttributeMaxDynamicSharedMemorySize, LDS_BYTES) != hipSuccess) { grid = -1; return; }
        grid = cus;
    }
    if (grid < 0) return;
    const float* const* in = (const float* const*)d_in;
    unsigned char* ws = (unsigned char*)d_ws;
    (void)hipMemsetAsync(ws + WS_CTL, 0, CTL_BYTES + al256(2 * 5 * 6144 * 4), stream);
    for (int l = 0; l < 2; ++l) (void)hipMemsetAsync(ws + WS_WL + (size_t)l * SZ_WL + SZ_WINR + (size_t)1152 * 1024 * 2, 0, (size_t)128 * 1024 * 2, stream);
    Args a{};
    for (int i = 0; i < 51; ++i) a.in[i] = in[i];
    a.out = (float*)d_out; a.ws = ws;
    int nlaunch = 0;
    auto run1 = [&](int lo, int hi) { a.ph_lo = lo; a.ph_hi = hi; a.bar_region = nlaunch < 5 ? nlaunch : 5; nlaunch++; hipLaunchKernelGGL(mk_fwd, dim3(grid), dim3(512), LDS_BYTES, stream, a); };
    auto run = [&](int lo, int hi) {
#if defined(SPLIT) && SPLIT
        for (int k = lo; k < hi; ++k) { const int q = (k - 1) % NPH_LAYER, l = (k - 1) / NPH_LAYER; if (k > 0 && (q > 14 || (l == 0 && q > 11) || (l == 1 && q == 0))) continue; run1(k, k + 1); }
#else
        run1(lo, hi);
#endif
    };
    run(0, 1 + 2 * NPH_LAYER);
}
```

```cpp
#include <hip/hip_runtime.h>
#include <stdint.h>
#include <math.h>

#define LAS __attribute__((address_space(3)))
typedef unsigned short bf16_t;
typedef short bf16x8 __attribute__((ext_vector_type(8)));
typedef float f32x4 __attribute__((ext_vector_type(4)));
typedef float f32x2 __attribute__((ext_vector_type(2)));
typedef unsigned u32x4 __attribute__((ext_vector_type(4)));
typedef unsigned u32x2 __attribute__((ext_vector_type(2)));

namespace {
constexpr int D = 1024, NB = 4, SEQ = 4096, CTXL = 256;
constexpr int RL = NB * SEQ, RC = NB * CTXL, RT = RL + RC;
constexpr int IN_COLS = 7040;
constexpr int FF_DENSE = 2816, NE = 8, FF_E = 3584;
constexpr float ALPHA = 1.41421356237309515f;
constexpr int LDP = 1792, PC_AG = 0, PC_AC = 384, PC_D = 768, PC_Q = 1024, PC_K = 1408, PC_G = 1792;
constexpr int NPT = 1280, PT_V = 768;
constexpr int YW = 1280, YC_A = 0, YC_B = 384, YC_C = 640, YC_D = 1024;
constexpr int MOE_P0 = 64, MOE_HCAP = 72;
constexpr int MOE_ROWS_MAX = 2 * RL + NE * 256;

constexpr size_t al256(size_t x) { return (x + 255) & ~(size_t)255; }
constexpr size_t WS_CTL = 0, CTL_BYTES = 131072;
constexpr int CW_BAR = 0;
constexpr int CW_MOECNT = 24576;
constexpr int CW_QUEUE = 28672;
constexpr int CW_HYN = 29696;
constexpr size_t WS_MOD = WS_CTL + CTL_BYTES;
constexpr size_t WS_HYN = WS_MOD + al256(2 * 5 * 6144 * 4);
constexpr size_t WS_S5AB = WS_HYN + 4096;
constexpr size_t WS_S5BB = WS_S5AB + 16384;
constexpr size_t WS_AB16 = WS_S5BB + 262144;
constexpr size_t WS_TILEE = WS_AB16 + 32768;
constexpr size_t WS_TOK = WS_TILEE + 1024;
constexpr size_t WS_SLOTW = WS_TOK + (size_t)RL * 32;
constexpr size_t WS_KFL = al256(WS_SLOTW + (size_t)MOE_ROWS_MAX * 4);
constexpr size_t WS_KFC = WS_KFL + (size_t)2 * 1024 * SEQ * 2;
constexpr size_t WS_XSC = WS_KFC + (size_t)1024 * CTXL * 2;
constexpr size_t WS_UB = WS_XSC + (size_t)RC * D * 4;
constexpr size_t SZ_WINR = (size_t)(1792 + 4096) * 1024 * 2, SZ_WINHY = (size_t)NPT * 1024 * 2, SZ_WBR = (size_t)1024 * 1280 * 2, SZ_WOUT = (size_t)1024 * 1024 * 2;
constexpr size_t SZ_WL = SZ_WINR + SZ_WINHY + SZ_WBR + SZ_WOUT;
constexpr size_t WS_WL = WS_UB + (size_t)RT * D * 2;
constexpr size_t WS_FFGU = WS_WL + 2 * SZ_WL;
constexpr size_t WS_FFD = WS_FFGU + (size_t)2 * FF_DENSE * 1024 * 2;
constexpr size_t WS_WGLU = WS_FFD + (size_t)1024 * FF_DENSE * 2;
constexpr size_t WS_OPS = WS_WGLU + (size_t)2 * 256 * 256 * 2;
constexpr size_t WS_OPY = WS_OPS + (size_t)32 * 256 * 256 * 2;
constexpr size_t WS_LW = WS_OPY + (size_t)32 * 256 * 512 * 2;
constexpr size_t WS_PR = WS_LW + (size_t)48 * 4096 * 2;
constexpr size_t WS_PT = WS_PR + (size_t)RT * 5888 * 2;
constexpr size_t WS_GQ = WS_PR + (size_t)RT * LDP * 2;
constexpr size_t WS_YB = WS_PT + (size_t)NPT * RT * 2;
constexpr size_t WS_PRE = WS_YB + (size_t)RT * YW * 2;
constexpr size_t WS_EXTRA = WS_PRE + (size_t)RT * D * 4;
constexpr size_t SZ_EXTRA = (size_t)2 * RT * 384 * 4 + (size_t)RT * 256 * 4;
constexpr size_t WS_END = WS_EXTRA + SZ_EXTRA;
constexpr int NCHK = RT / 16, NCHKP = 1280;
constexpr size_t WS_US = WS_PRE;
constexpr size_t WS_S5S = WS_US + (size_t)16 * NCHKP * 512 * 2;
constexpr size_t WS_GL = WS_S5S + (size_t)16 * NCHKP * 256 * 4;
static_assert(WS_GL + (size_t)RT * 256 * 2 <= WS_EXTRA, "s5 overlay");
constexpr size_t WS_H = WS_PR;
constexpr size_t WS_MOEGU = WS_PR;
constexpr size_t WS_MOED = WS_MOEGU + (size_t)NE * 2 * FF_E * 1024 * 2;
constexpr size_t WS_HM = WS_MOED + (size_t)NE * 1024 * FF_E * 2;
constexpr size_t WS_LT = WS_EXTRA;
constexpr size_t WS_LAGG = WS_LT + (size_t)RT * 3 * 384 * 2;
constexpr size_t WS_LHIN = WS_LAGG + (size_t)NCHK * 2 * 384 * 8;
constexpr size_t WS_YT = WS_LHIN + (size_t)NCHK * 2 * 384 * 4;
static_assert(WS_YT + (size_t)256 * RT * 2 <= WS_EXTRA + SZ_EXTRA, "lru / hyena overlay");
constexpr size_t WS_MGC = WS_EXTRA + (size_t)4 * RC * D * 4;
constexpr size_t WS_AG = WS_EXTRA;
static_assert(WS_HM + (size_t)MOE_HCAP * 256 * FF_E * 2 <= WS_EXTRA, "moe hidden overlay");
constexpr size_t WS_O2X = WS_PRE + ((size_t)32 << 20);
static_assert(WS_HM + (size_t)MOE_HCAP * 256 * FF_E * 2 <= WS_O2X && WS_O2X + (size_t)4 * 2048 * D * 4 <= WS_EXTRA, "moe excess sums");
static_assert((size_t)MOE_ROWS_MAX * 1024 * 2 <= SZ_EXTRA, "moe gather overlay");
static_assert((size_t)RT * FF_DENSE * 2 <= (size_t)RT * 5888 * 2 && WS_GQ + (size_t)RT * 4096 <= WS_PT, "dense hidden overlay / gate bytes");

__device__ __forceinline__ float sigm(float x) { return __builtin_amdgcn_rcpf(1.f + __builtin_amdgcn_exp2f(-1.44269504089f * x)); }
__device__ __forceinline__ float sigm_acc(float x) { return 1.f / (1.f + expf(-x)); }
__device__ __forceinline__ float silu_acc(float x) { return x / (1.f + expf(-x)); }
__device__ __forceinline__ float gelu_t(float x) { return 0.5f * x * (1.f + tanhf(0.7978845608028654f * (x + 0.044715f * x * x * x))); }
__device__ __forceinline__ float gelu_f(float x) { return x * sigm(1.5957691216057308f * (x + 0.044715f * x * x * x)); }
__device__ __forceinline__ float softplus(float x) { return fmaxf(x, 0.f) + log1pf(expf(-fabsf(x))); }
__device__ __forceinline__ float wave_sum(float v) { for (int o = 32; o; o >>= 1) v += __shfl_xor(v, o); return v; }
__device__ __forceinline__ float wave_max(float v) { for (int o = 32; o; o >>= 1) v = fmaxf(v, __shfl_xor(v, o)); return v; }
__device__ __forceinline__ float bf2f(bf16_t b) { return __uint_as_float(((unsigned)b) << 16); }
__device__ __forceinline__ bf16_t f2bf(float f) { unsigned u = __float_as_uint(f); u += 0x7FFFu + ((u >> 16) & 1u); return (bf16_t)(u >> 16); }
__device__ __forceinline__ unsigned cvt_pk_bf16(float lo, float hi) { unsigned r; asm volatile("v_cvt_pk_bf16_f32 %0, %1, %2" : "=v"(r) : "v"(lo), "v"(hi)); return r; }
__device__ __forceinline__ float bflo(unsigned w) { return __uint_as_float(w << 16); }
__device__ __forceinline__ float bfhi(unsigned w) { return __uint_as_float(w & 0xFFFF0000u); }
__device__ __forceinline__ void row_seq(int r, int& start, int& len, int& pos, int& b) {
    if (r < RL) { b = r >> 12; start = b << 12; len = SEQ; pos = r & 4095; }
    else { const int q = r - RL; b = q >> 8; start = RL + (b << 8); len = CTXL; pos = q & 255; }
}

#define XB_TMO      128
#define XB_XCNT(j)  (256  + 64 * (j))
#define XB_XSUB(j)  (1280 + 64 * (j))
#define XB_XGEN(j)  (2304 + 64 * (j))
#define XB_TOP      3328
#define XB_TOPGEN   3392
#define XCD_BAR_WORDS 3456
#define XB_SPIN_CAP (1u << 18)
__device__ __forceinline__ unsigned xb_ld(unsigned* p)              { return __hip_atomic_load(p, __ATOMIC_RELAXED, __HIP_MEMORY_SCOPE_AGENT); }
__device__ __forceinline__ unsigned xb_add(unsigned* p, unsigned v) { return __hip_atomic_fetch_add(p, v, __ATOMIC_RELAXED, __HIP_MEMORY_SCOPE_AGENT); }
__device__ __forceinline__ unsigned xb_xcc_id() { return (unsigned)__builtin_amdgcn_s_getreg((3 << 11) | 20) & 0xFu; }
#define XB_SPIN(cond, bar) do { unsigned _sp = 0; while (cond) { __builtin_amdgcn_s_sleep(1); \
    if ((++_sp & 255u) == 0u) { if (xb_ld(&(bar)[XB_TMO])) break; if (_sp > XB_SPIN_CAP) { atomicAdd(&(bar)[XB_TMO], 1u); break; } } } } while (0)
struct XcdBarrier { unsigned* bar; unsigned x; volatile LAS unsigned* st; };
__device__ __forceinline__ XcdBarrier xcd_barrier_post(unsigned* bar, volatile LAS unsigned* st) {
    XcdBarrier b; b.bar = bar; b.x = xb_xcc_id(); b.st = st;
    if (threadIdx.x == 0) (void)xb_add(&bar[XB_XCNT(b.x)], 1u);
    return b;
}
__device__ __forceinline__ void xcd_barrier_complete(unsigned* bar, unsigned x, unsigned& nloc, unsigned& nx) {
    const unsigned G = gridDim.x * gridDim.y * gridDim.z;
    unsigned sum, cnt, mine, sp = 0u;
    for (;;) {
        sum = 0u; cnt = 0u; mine = 0u;
#pragma unroll
        for (unsigned j = 0; j < 16; ++j) { const unsigned c = xb_ld(&bar[XB_XCNT(j)]); sum += c; cnt += (c > 0u) ? 1u : 0u; mine = (j == x) ? c : mine; }
        if (sum == G) break;
        __builtin_amdgcn_s_sleep(1);
        if ((++sp & 255u) == 0u) { if (xb_ld(&bar[XB_TMO])) break; if (sp > XB_SPIN_CAP) { atomicAdd(&bar[XB_TMO], 1u); break; } }
    }
    nloc = mine > 0u ? mine : 1u; nx = cnt > 0u ? cnt : 1u;
}
__device__ __forceinline__ void xcd_barrier(const XcdBarrier& b) {
    asm volatile("s_waitcnt vmcnt(0)" ::: "memory");
    __syncthreads();
    if (threadIdx.x == 0) {
        unsigned* bar = b.bar;
        __builtin_amdgcn_s_waitcnt(0);
        unsigned nloc = b.st[0], nx = b.st[1];
        if (nloc == 0u) { xcd_barrier_complete(bar, b.x, nloc, nx); b.st[0] = nloc; b.st[1] = nx; }
        const unsigned old = xb_add(&bar[XB_XSUB(b.x)], 1u);
        const unsigned gen = old / nloc;
        if (old + 1u == (gen + 1u) * nloc) {
            __builtin_amdgcn_fence(__ATOMIC_RELEASE, "agent");
            asm volatile("s_waitcnt vmcnt(0)" ::: "memory");
            const unsigned og = xb_add(&bar[XB_TOP], 1u);
            const unsigned tg = og / nx;
            if (og + 1u == (tg + 1u) * nx) xb_add(&bar[XB_TOPGEN], 1u);
            else XB_SPIN(xb_ld(&bar[XB_TOPGEN]) == tg, bar);
            __builtin_amdgcn_fence(__ATOMIC_ACQUIRE, "agent");
            xb_add(&bar[XB_XGEN(b.x)], 1u);
            asm volatile("s_waitcnt vmcnt(0)" ::: "memory");
        } else {
            XB_SPIN(xb_ld(&bar[XB_XGEN(b.x)]) == gen, bar);
            __builtin_amdgcn_fence(__ATOMIC_ACQUIRE, "agent");
            asm volatile("s_waitcnt vmcnt(0)" ::: "memory");
        }
    }
    __syncthreads();
}

namespace pg8 {
constexpr int BM = 256, BK = 64, HALF = 128, HTB = HALF * BK * 2, STAGE_BYTES = 8 * HTB, NXCD = 8, WGM = 8;
__host__ __device__ __forceinline__ int lds_byte(int r, int c) { const int st = (r >> 4) * 2 + (c >> 5), rr = r & 15, cc = c & 31, ob = rr * 64 + cc * 2; return st * 1024 + (ob ^ (((ob >> 9) & 1) << 5)); }
__host__ __device__ __forceinline__ void stage_rc(int b, int& R, int& C) { const int st = b / 1024, sb = b % 1024, swz = sb ^ (((sb >> 9) & 1) << 5); R = (st >> 1) * 16 + swz / 64; C = (st & 1) * 32 + (swz % 64) / 2; }
__host__ __device__ __forceinline__ int perm32(int rho) { const int n = rho >> 4, i = rho & 15; return 8 * (i >> 2) + 4 * n + (i & 3); }

struct Unit { const char* a; const char* b; int nt; int pm, pn, kind; };

__device__ __forceinline__ void rect_map(int wgid, int nM, int nN, int& pm, int& pn) {
    const int nwg = nM * nN;
    { const int q = nwg / NXCD, r = nwg % NXCD, xcd = wgid % NXCD, off = wgid / NXCD; wgid = (xcd < r ? xcd * (q + 1) : r * (q + 1) + (xcd - r) * q) + off; }
    const int nig = WGM * nN, gid = wgid / nig, fm = gid * WGM, gsz = (nM - fm) < WGM ? (nM - fm) : WGM;
    pm = fm + ((wgid % nig) % gsz); pn = (wgid % nig) / gsz;
}

template <int lda, int ldb, class Epi, class Sched>
__device__ __forceinline__ void gemm_phase(LAS unsigned char* lds, const Sched& S, const Epi& E) {
    int tid_ = threadIdx.x; asm volatile("" : "+v"(tid_));
    const int tid = tid_, wid = __builtin_amdgcn_readfirstlane(tid >> 6), lane = tid & 63, wr = wid >> 2, wc = wid & 3, fr = lane & 15, fq = lane >> 4;
    unsigned voffA[2], voffB[2];
#pragma unroll
    for (int i = 0; i < 2; ++i) { int R, C; stage_rc(tid * 16 + i * 8192, R, C); const int Rb = (R & ~31) + perm32(R & 31);
        voffA[i] = (unsigned)(R * lda + C) * 2u; voffB[i] = (unsigned)(Rb * ldb + C) * 2u; }
    const size_t kstep = (size_t)(BK * 2);
    const size_t hstepA = (size_t)HALF * lda * 2, hstepB = (size_t)HALF * ldb * 2;
    const unsigned ldsw = (unsigned)wid * 1024u;
    const int aoff = lds_byte(wr * 64 + fr, fq * 8), boff = lds_byte(wc * 32 + fr, fq * 8);
#define PG8_SA(b, h) (((b) * 2 + (h)) * HTB)
#define PG8_SB(b, h) ((4 + (b) * 2 + (h)) * HTB)
#define PG8_STAGE(bufoff, gbase, voff) do { _Pragma("unroll") for (int _i = 0; _i < 2; ++_i) \
        __builtin_amdgcn_global_load_lds((const unsigned*)((const char*)(gbase) + (voff)[_i]), (LAS unsigned*)(lds + (bufoff) + ldsw + _i * 8192), 16, 0, 0); } while (0)
#define PG8_LDA(dst, b, h) do { _Pragma("unroll") for (int m = 0; m < 4; ++m) _Pragma("unroll") for (int k = 0; k < 2; ++k) dst[m][k] = *(const LAS bf16x8*)(lds + PG8_SA(b, h) + aoff + m * 2048 + k * 1024); } while (0)
#define PG8_LDB(dst, b, h) do { _Pragma("unroll") for (int n = 0; n < 2; ++n) _Pragma("unroll") for (int k = 0; k < 2; ++k) dst[n][k] = *(const LAS bf16x8*)(lds + PG8_SB(b, h) + boff + n * 2048 + k * 1024); } while (0)
#define PG8_MMA(ai, bj, At, Bt) do { __builtin_amdgcn_s_setprio(1); _Pragma("unroll") for (int m = 0; m < 4; ++m) _Pragma("unroll") for (int n = 0; n < 2; ++n) _Pragma("unroll") for (int k = 0; k < 2; ++k) \
        acc[ai][bj][m][n] = __builtin_amdgcn_mfma_f32_16x16x32_bf16(Bt[n][k], At[m][k], acc[ai][bj][m][n], 0, 0, 0); __builtin_amdgcn_s_setprio(0); } while (0)
#define PG8_WAIT_V(n) asm volatile("s_waitcnt vmcnt(" #n ")" ::: "memory")
#define PG8_WAIT_L(n) asm volatile("s_waitcnt lgkmcnt(" #n ")" ::: "memory")
#define PG8_BAR __builtin_amdgcn_s_barrier()
#define PG8_SCHED __builtin_amdgcn_sched_barrier(0)
    Unit cur, nxt; int ui = 0;
    if (!S.next(0, cur)) return;
    f32x4 acc[2][2][4][2];
#pragma unroll
    for (int a = 0; a < 2; ++a)
#pragma unroll
        for (int b = 0; b < 2; ++b)
#pragma unroll
            for (int m = 0; m < 4; ++m)
#pragma unroll
                for (int n = 0; n < 2; ++n) acc[a][b][m][n] = (f32x4){0.f, 0.f, 0.f, 0.f};
    bf16x8 At[4][2], B0[2][2], B1[2][2];
    const char* cA = cur.a; const char* cB = cur.b;
    PG8_STAGE(PG8_SB(0, 0), cB, voffB); PG8_STAGE(PG8_SA(0, 0), cA, voffA); PG8_STAGE(PG8_SB(0, 1), cB + hstepB, voffB); PG8_STAGE(PG8_SA(0, 1), cA + hstepA, voffA);
    if (wr == 1) PG8_BAR;
    PG8_WAIT_V(4); PG8_BAR;
    PG8_STAGE(PG8_SB(1, 0), cB + kstep, voffB); PG8_STAGE(PG8_SA(1, 0), cA + kstep, voffA); PG8_STAGE(PG8_SB(1, 1), cB + hstepB + kstep, voffB);
    PG8_WAIT_V(6); PG8_BAR;
    for (;;) {
        const bool has_next = S.next(ui + 1, nxt);
        const char* nA = has_next ? nxt.a : cA; const char* nB = has_next ? nxt.b : cB;
        const int nt = cur.nt;
        for (int t = 0; t < nt; t += 2) {
            const bool last = (t == nt - 2);
            const char* a1 = cA + (size_t)(t + 1) * kstep;
            const char* a2 = last ? nA : cA + (size_t)(t + 2) * kstep; const char* b2 = last ? nB : cB + (size_t)(t + 2) * kstep;
            const char* a3 = a2 + kstep; const char* b3 = b2 + kstep;
            PG8_LDB(B0, 0, 0); PG8_SCHED; PG8_LDA(At, 0, 0); PG8_STAGE(PG8_SA(1, 1), a1 + hstepA, voffA);
            PG8_WAIT_L(8); PG8_BAR; PG8_WAIT_L(0); PG8_MMA(0, 0, At, B0); PG8_BAR; PG8_SCHED;
            PG8_LDB(B1, 0, 1); PG8_STAGE(PG8_SB(0, 0), b2, voffB);
            PG8_BAR; PG8_WAIT_L(0); PG8_MMA(0, 1, At, B1); PG8_BAR;
            PG8_LDA(At, 0, 1); PG8_STAGE(PG8_SA(0, 0), a2, voffA);
            PG8_BAR; PG8_WAIT_L(0); PG8_MMA(1, 0, At, B0); PG8_BAR; PG8_SCHED;
            PG8_STAGE(PG8_SB(0, 1), b2 + hstepB, voffB);
            PG8_WAIT_V(6); PG8_BAR; PG8_MMA(1, 1, At, B1); PG8_BAR;
            PG8_LDB(B0, 1, 0); PG8_SCHED; PG8_LDA(At, 1, 0); PG8_STAGE(PG8_SA(0, 1), a2 + hstepA, voffA);
            PG8_WAIT_L(8); PG8_BAR; PG8_WAIT_L(0); PG8_MMA(0, 0, At, B0); PG8_BAR; PG8_SCHED;
            PG8_LDB(B1, 1, 1); PG8_STAGE(PG8_SB(1, 0), b3, voffB);
            PG8_BAR; PG8_WAIT_L(0); PG8_MMA(0, 1, At, B1); PG8_BAR;
            PG8_LDA(At, 1, 1); PG8_STAGE(PG8_SA(1, 0), a3, voffA);
            PG8_BAR; PG8_WAIT_L(0); PG8_MMA(1, 0, At, B0); PG8_BAR; PG8_SCHED;
            PG8_STAGE(PG8_SB(1, 1), b3 + hstepB, voffB);
            PG8_WAIT_V(6); PG8_BAR; PG8_MMA(1, 1, At, B1); PG8_BAR;
        }
        E(acc, cur, wr, wc, fr, fq);
        if (!has_next) break;
#pragma unroll
        for (int a = 0; a < 2; ++a)
#pragma unroll
            for (int b = 0; b < 2; ++b)
#pragma unroll
                for (int m = 0; m < 4; ++m)
#pragma unroll
                    for (int n = 0; n < 2; ++n) acc[a][b][m][n] = (f32x4){0.f, 0.f, 0.f, 0.f};
        cur = nxt; cA = nA; cB = nB; ++ui;
    }
    PG8_WAIT_V(0);
    if (wr == 0) PG8_BAR;
    PG8_BAR;
#undef PG8_SA
#undef PG8_SB
#undef PG8_STAGE
#undef PG8_LDA
#undef PG8_LDB
#undef PG8_MMA
#undef PG8_WAIT_V
#undef PG8_WAIT_L
#undef PG8_BAR
#undef PG8_SCHED
}

struct PartC { long long aOff, bOff; unsigned aStep, bStep; int nM, nN, nt, kind, start, nGrp; unsigned aGrp, bGrp; };
struct TabSched {
    const PartC* parts; const char* ws; int np, total, G, c;
    __device__ __forceinline__ bool next(int i, Unit& u) const {
        const int L = i * G + c; if (L >= total) return false;
        int q = 0;
#pragma unroll
        for (int k = 1; k < 4; ++k) if (k < np && L >= parts[k].start) q = k;
        const PartC P = parts[q];
        const int per = P.nM * P.nN, idx = L - P.start, grp = idx / per;
        int pm, pn; rect_map(idx - grp * per, P.nM, P.nN, pm, pn);
        u.a = ws + P.aOff + (size_t)grp * P.aGrp + (size_t)pm * P.aStep; u.b = ws + P.bOff + (size_t)grp * P.bGrp + (size_t)pn * P.bStep; u.nt = P.nt; u.pm = pm; u.pn = pn; u.kind = P.kind + grp; return true;
    }
};
struct MergeSched {
    const char* ws; long long aOff, bOff; int nM, G, c;
    int nCtx;
    __device__ __forceinline__ bool next(int i, Unit& u) const {
        int T = (i >> 2) * G + c, br = i & 3; bool ctxu = false;
        if (T >= nM * 4) {
            const int j = (i - 4 * ((nM * 4 - c + G - 1) / G)) * G + c;
            if (j < 0 || j >= nCtx) return false;
            T = nM * 4 + (j >> 2); br = j & 3; ctxu = true;
        }
        int pm, pn;
        if (!ctxu) rect_map(T, nM, 4, pm, pn); else { const int t = T - nM * 4; pm = nM + (t >> 2); pn = t & 3; }
        const int ko = br == 0 ? 0 : (br == 1 ? 384 : (br == 2 ? 640 : 1024));
        u.a = ws + aOff + (size_t)pm * (256u * 1280u * 2u) + ko * 2; u.b = ws + bOff + (size_t)pn * (256u * 1280u * 2u) + ko * 2; u.nt = (br & 1) ? 4 : 6; u.pm = pm; u.pn = pn; u.kind = ctxu ? 4 + br : br; return true;
    }
};
struct MoeSched {
    const char* A; const char* B; const int* tile_e; unsigned aStep, bStep; size_t bExp; int nN, nt, tile0, ntile, G, c;
    __device__ __forceinline__ bool next(int i, Unit& u) const {
        const int L = i * G + c; if (L >= ntile * nN) return false;
        const int mt = tile0 + L / nN, pn = L % nN;
        const int e = __builtin_amdgcn_readfirstlane(__hip_atomic_load(tile_e + mt, __ATOMIC_RELAXED, __HIP_MEMORY_SCOPE_AGENT));
        u.a = A + (size_t)(mt - tile0) * aStep; u.b = B + (size_t)e * bExp + (size_t)pn * bStep; u.nt = nt; u.pm = mt; u.pn = pn; u.kind = e; return true;
    }
};

struct MoeTailSched {
    const char* A; const char* B; const int* tile_e; int tile0, nfull, nex, G, c;
    __device__ __forceinline__ bool next(int i, Unit& u) const {
        const int L = i * G + c; int mt, pn, nt = 56, flag = 0; size_t koff = 0;
        if (L < nfull * 4) { mt = tile0 + (L >> 2); pn = L & 3; }
        else { const int idx = L - nfull * 4; if (idx >= nex * 16) return false; const int sp = idx & 3, tu = idx >> 2; mt = 128 + (tu >> 2); pn = tu & 3; nt = 14; koff = (size_t)sp * 14 * 128; flag = 8 + 16 * sp; }
        const int e = __builtin_amdgcn_readfirstlane(__hip_atomic_load(tile_e + mt, __ATOMIC_RELAXED, __HIP_MEMORY_SCOPE_AGENT));
        u.a = A + (size_t)(mt - tile0) * (256u * (unsigned)FF_E * 2u) + koff; u.b = B + (size_t)e * ((size_t)1024 * FF_E * 2) + (size_t)pn * (256u * (unsigned)FF_E * 2u) + koff;
        u.nt = nt; u.pm = mt; u.pn = pn; u.kind = e | flag; return true;
    }
};

#define EPI_ROWS(u) const int row0 = (u).pm * BM + wr * 64 + fr, colt = wc * 32 + 8 * fq
struct EpiProj {
    bf16_t* PRp; bf16_t* PTp; bf16_t* USp; int sig_from; unsigned char* GQp;
    __device__ __forceinline__ void operator()(const f32x4 (&acc)[2][2][4][2], const Unit& u, int wr, int wc, int fr, int fq) const {
        EPI_ROWS(u);
        bf16_t* base = u.kind == 1 ? PTp : PRp; const int ldc = u.kind == 1 ? RT : LDP; const bool sg = (u.kind == 0 && u.pn >= sig_from);
        if (sg) {
#pragma unroll
            for (int ai = 0; ai < 2; ++ai)
#pragma unroll
                for (int m = 0; m < 4; ++m) { unsigned char* rowp = GQp + (size_t)(row0 + ai * HALF + m * 16) * 4096 + (u.pn - sig_from) * BM + colt;
#pragma unroll
                    for (int bj = 0; bj < 2; ++bj) { const f32x4 v0 = acc[ai][bj][m][0], v1 = acc[ai][bj][m][1];
                        unsigned lo = 0u, hi = 0u;
                        lo = __builtin_amdgcn_cvt_pk_u8_f32(sigm(v0[0]) * 255.0f, 0, lo); lo = __builtin_amdgcn_cvt_pk_u8_f32(sigm(v0[1]) * 255.0f, 1, lo); lo = __builtin_amdgcn_cvt_pk_u8_f32(sigm(v0[2]) * 255.0f, 2, lo); lo = __builtin_amdgcn_cvt_pk_u8_f32(sigm(v0[3]) * 255.0f, 3, lo);
                        hi = __builtin_amdgcn_cvt_pk_u8_f32(sigm(v1[0]) * 255.0f, 0, hi); hi = __builtin_amdgcn_cvt_pk_u8_f32(sigm(v1[1]) * 255.0f, 1, hi); hi = __builtin_amdgcn_cvt_pk_u8_f32(sigm(v1[2]) * 255.0f, 2, hi); hi = __builtin_amdgcn_cvt_pk_u8_f32(sigm(v1[3]) * 255.0f, 3, hi);
                        *(u32x2*)(rowp + bj * HALF) = (u32x2){lo, hi}; } }
            return;
        }
#pragma unroll
        for (int ai = 0; ai < 2; ++ai)
#pragma unroll
            for (int m = 0; m < 4; ++m) { bf16_t* rowp = base + (size_t)(row0 + ai * HALF + m * 16) * ldc + u.pn * BM + colt;
#pragma unroll
                for (int bj = 0; bj < 2; ++bj) { f32x4 v0 = acc[ai][bj][m][0], v1 = acc[ai][bj][m][1];
                    if (sg) {
#pragma unroll
                        for (int j = 0; j < 4; ++j) { v0[j] = sigm(v0[j]); v1[j] = sigm(v1[j]); } }
                    u32x4 w; w.x = cvt_pk_bf16(v0[0], v0[1]); w.y = cvt_pk_bf16(v0[2], v0[3]); w.z = cvt_pk_bf16(v1[0], v1[1]); w.w = cvt_pk_bf16(v1[2], v1[3]);
                    *(u32x4*)(rowp + bj * HALF) = w;
                    if (u.kind == 0 && u.pn == 3) { const int r = row0 + ai * HALF + m * 16, cc = colt + bj * HALF;
                        *(u32x4*)(USp + ((size_t)(cc >> 4) * NCHKP + (r >> 4)) * 512 + (r & 15) * 16 + (cc & 15)) = w; } } }
    }
};
struct EpiS5State {
    float* Sp;
    __device__ __forceinline__ void operator()(const f32x4 (&acc)[2][2][4][2], const Unit& u, int wr, int wc, int fr, int fq) const {
        EPI_ROWS(u);
#pragma unroll
        for (int ai = 0; ai < 2; ++ai)
#pragma unroll
            for (int m = 0; m < 4; ++m) { float* op = Sp + ((size_t)u.kind * NCHKP + row0 + ai * HALF + m * 16) * 256 + colt;
#pragma unroll
                for (int bj = 0; bj < 2; ++bj)
#pragma unroll
                    for (int n = 0; n < 2; ++n) *(f32x4*)(op + bj * HALF + 4 * n) = acc[ai][bj][m][n]; }
    }
};
struct EpiS5Main {
    bf16_t* GLp; const bf16_t* PRp; const float* dvec;
    __device__ __forceinline__ void operator()(const f32x4 (&acc)[2][2][4][2], const Unit& u, int wr, int wc, int fr, int fq) const {
        EPI_ROWS(u);
        const int cl = 16 * u.kind + (colt & 15);
        const f32x4 d0 = *(const f32x4*)(dvec + cl), d1 = *(const f32x4*)(dvec + cl + 4);
#pragma unroll
        for (int ai = 0; ai < 2; ++ai) {
            u32x4 uq[4][2];
#pragma unroll
            for (int m = 0; m < 4; ++m) { const int n = row0 + ai * HALF + m * 16;
#pragma unroll
                for (int bj = 0; bj < 2; ++bj) { const int c = colt + bj * HALF, r = 16 * (n < NCHK ? n : 0) + (c >> 4); uq[m][bj] = *(const u32x4*)(PRp + (size_t)r * LDP + PC_D + cl); } }
#pragma unroll
            for (int m = 0; m < 4; ++m) { const int n = row0 + ai * HALF + m * 16; if (n >= NCHK) continue;
#pragma unroll
                for (int bj = 0; bj < 2; ++bj) { const int c = colt + bj * HALF, r = 16 * n + (c >> 4); const u32x4 uv = uq[m][bj];
                    const f32x4 v0 = acc[ai][bj][m][0], v1 = acc[ai][bj][m][1];
                    u32x4 w; w.x = cvt_pk_bf16(gelu_f(v0[0] + d0[0] * bflo(uv.x)), gelu_f(v0[1] + d0[1] * bfhi(uv.x))); w.y = cvt_pk_bf16(gelu_f(v0[2] + d0[2] * bflo(uv.y)), gelu_f(v0[3] + d0[3] * bfhi(uv.y)));
                    w.z = cvt_pk_bf16(gelu_f(v1[0] + d1[0] * bflo(uv.z)), gelu_f(v1[1] + d1[1] * bfhi(uv.z))); w.w = cvt_pk_bf16(gelu_f(v1[2] + d1[2] * bflo(uv.w)), gelu_f(v1[3] + d1[3] * bfhi(uv.w)));
                    *(u32x4*)(GLp + (size_t)r * 256 + cl) = w; } }
        }
    }
};
struct EpiS5Glu {
    bf16_t* YBp; const bf16_t* GLp; const float* bvec;
    __device__ __forceinline__ void operator()(const f32x4 (&acc)[2][2][4][2], const Unit& u, int wr, int wc, int fr, int fq) const {
        EPI_ROWS(u);
        f32x4 bq[2][2];
#pragma unroll
        for (int bj = 0; bj < 2; ++bj) { bq[bj][0] = *(const f32x4*)(bvec + colt + bj * HALF); bq[bj][1] = *(const f32x4*)(bvec + colt + bj * HALF + 4); }
#pragma unroll
        for (int ai = 0; ai < 2; ++ai) {
            u32x4 gq[4][2];
#pragma unroll
            for (int m = 0; m < 4; ++m)
#pragma unroll
                for (int bj = 0; bj < 2; ++bj) gq[m][bj] = *(const u32x4*)(GLp + (size_t)(row0 + ai * HALF + m * 16) * 256 + colt + bj * HALF);
#pragma unroll
            for (int m = 0; m < 4; ++m) { const int r = row0 + ai * HALF + m * 16;
#pragma unroll
                for (int bj = 0; bj < 2; ++bj) { const int c = colt + bj * HALF; const u32x4 gv = gq[m][bj];
                    const f32x4 v0 = acc[ai][bj][m][0] + bq[bj][0], v1 = acc[ai][bj][m][1] + bq[bj][1];
                    u32x4 w; w.x = cvt_pk_bf16(bflo(gv.x) * sigm(v0[0]), bfhi(gv.x) * sigm(v0[1])); w.y = cvt_pk_bf16(bflo(gv.y) * sigm(v0[2]), bfhi(gv.y) * sigm(v0[3]));
                    w.z = cvt_pk_bf16(bflo(gv.z) * sigm(v1[0]), bfhi(gv.z) * sigm(v1[1])); w.w = cvt_pk_bf16(bflo(gv.w) * sigm(v1[2]), bfhi(gv.w) * sigm(v1[3]));
                    *(u32x4*)(YBp + (size_t)r * YW + YC_D + c) = w; } }
        }
    }
};
struct EpiGate {
    const unsigned char* GQp; bf16_t* MGp; bf16_t* MGCp;
    __device__ __forceinline__ void operator()(const f32x4 (&acc)[2][2][4][2], const Unit& u, int wr, int wc, int fr, int fq) const {
        EPI_ROWS(u);
        const int br = u.kind & 3; const bool acc_prev = (u.kind >= 1 && u.kind <= 3);
        bf16_t* OB = u.kind >= 4 ? MGCp + (size_t)br * RC * D - (size_t)RL * D : MGp;
        if (acc_prev) { __builtin_amdgcn_fence(__ATOMIC_ACQUIRE, "agent"); asm volatile("s_waitcnt vmcnt(0)" ::: "memory"); }
#pragma unroll
        for (int am = 0; am < 4; ++am) { const int ai = am >> 1, m0 = (am & 1) * 2;
            u32x2 g[4][2]; u32x4 p[4][2];
#pragma unroll
            for (int m = m0; m < m0 + 2; ++m) { const int r = row0 + ai * HALF + m * 16;
#pragma unroll
                for (int bj = 0; bj < 2; ++bj) { g[m][bj] = *(const u32x2*)(GQp + (size_t)r * 4096 + br * 1024 + u.pn * BM + colt + bj * HALF);
                    p[m][bj] = acc_prev ? *(const u32x4*)(MGp + (size_t)r * D + u.pn * BM + colt + bj * HALF) : (u32x4){0u, 0u, 0u, 0u}; } }
#pragma unroll
            for (int m = m0; m < m0 + 2; ++m) { const int r = row0 + ai * HALF + m * 16; bf16_t* mp = OB + (size_t)r * D + u.pn * BM + colt;
#pragma unroll
                for (int bj = 0; bj < 2; ++bj) { const f32x4 v0 = acc[ai][bj][m][0] * (1.0f / 255.0f), v1 = acc[ai][bj][m][1] * (1.0f / 255.0f); const u32x2 gg = g[m][bj]; const u32x4 pp = p[m][bj];
                    const f32x4 o0 = {v0[0] * (float)(gg.x & 255u) + bflo(pp.x), v0[1] * (float)((gg.x >> 8) & 255u) + bfhi(pp.x), v0[2] * (float)((gg.x >> 16) & 255u) + bflo(pp.y), v0[3] * (float)(gg.x >> 24) + bfhi(pp.y)};
                    const f32x4 o1 = {v1[0] * (float)(gg.y & 255u) + bflo(pp.z), v1[1] * (float)((gg.y >> 8) & 255u) + bfhi(pp.z), v1[2] * (float)((gg.y >> 16) & 255u) + bflo(pp.w), v1[3] * (float)(gg.y >> 24) + bfhi(pp.w)};
                    u32x4 w; w.x = cvt_pk_bf16(o0[0], o0[1]); w.y = cvt_pk_bf16(o0[2], o0[3]); w.z = cvt_pk_bf16(o1[0], o1[1]); w.w = cvt_pk_bf16(o1[2], o1[3]);
                    *(u32x4*)(mp + bj * HALF) = w; } }
        }
    }
};
struct EpiRes {
    float* PREp; const float* xlat; const float* xctx; const float* gvec;
    float* partp;
    __device__ __forceinline__ void operator()(const f32x4 (&acc)[2][2][4][2], const Unit& u, int wr, int wc, int fr, int fq) const {
        EPI_ROWS(u);
        if (u.kind != 0) {
            f32x4 gc[2][2];
#pragma unroll
            for (int bj = 0; bj < 2; ++bj)
#pragma unroll
                for (int n = 0; n < 2; ++n) gc[bj][n] = *(const f32x4*)(gvec + (size_t)4 * 6144 + u.pn * BM + colt + bj * HALF + 4 * n);
#pragma unroll
            for (int ai = 0; ai < 2; ++ai)
#pragma unroll
                for (int m = 0; m < 4; ++m) { const int r = row0 + ai * HALF + m * 16; const int c0 = u.pn * BM + colt;
                    float* op = partp + ((size_t)(u.kind - 1) * RC + r) * D + c0;
#pragma unroll
                    for (int bj = 0; bj < 2; ++bj)
#pragma unroll
                        for (int n = 0; n < 2; ++n) *(f32x4*)(op + bj * HALF + 4 * n) = gc[bj][n] * acc[ai][bj][m][n]; }
            return;
        }
        const int c0 = u.pn * BM + colt, rt0 = u.pm * BM;
        const float* gp = gvec + (size_t)(rt0 < RL ? (rt0 >> 12) : 4) * 6144 + c0;
        f32x4 gq[2][2];
#pragma unroll
        for (int bj = 0; bj < 2; ++bj)
#pragma unroll
            for (int n = 0; n < 2; ++n) gq[bj][n] = *(const f32x4*)(gp + bj * HALF + 4 * n);
#pragma unroll
        for (int am = 0; am < 4; ++am) { const int ai = am >> 1, m0 = (am & 1) * 2;
            f32x4 xq[4][2][2];
#pragma unroll
            for (int m = m0; m < m0 + 2; ++m) { const int r = row0 + ai * HALF + m * 16;
                const float* xin = (r < RL ? xlat + (size_t)r * D : xctx + (size_t)(r - RL) * D) + c0;
#pragma unroll
                for (int bj = 0; bj < 2; ++bj)
#pragma unroll
                    for (int n = 0; n < 2; ++n) xq[m][bj][n] = *(const f32x4*)(xin + bj * HALF + 4 * n); }
#pragma unroll
            for (int m = m0; m < m0 + 2; ++m) { const int r = row0 + ai * HALF + m * 16; float* op = PREp + (size_t)r * D + c0;
#pragma unroll
                for (int bj = 0; bj < 2; ++bj)
#pragma unroll
                    for (int n = 0; n < 2; ++n) *(f32x4*)(op + bj * HALF + 4 * n) = xq[m][bj][n] * ALPHA + gq[bj][n] * acc[ai][bj][m][n]; }
        }
    }
};
struct EpiSwiglu {
    bf16_t* Hp; int ldh; int row_sub;
    __device__ __forceinline__ void operator()(const f32x4 (&acc)[2][2][4][2], const Unit& u, int wr, int wc, int fr, int fq) const {
        const int row0 = (u.pm - row_sub) * BM + wr * 64 + fr, colt = wc * 32 + 8 * fq;
#pragma unroll
        for (int ai = 0; ai < 2; ++ai)
#pragma unroll
            for (int m = 0; m < 4; ++m) { bf16_t* rowp = Hp + (size_t)(row0 + ai * HALF + m * 16) * ldh + u.pn * HALF + colt;
                f32x4 h0, h1;
#pragma unroll
                for (int j = 0; j < 4; ++j) { const float g0 = acc[ai][0][m][0][j], g1 = acc[ai][0][m][1][j];
                    h0[j] = g0 * sigm(g0) * acc[ai][1][m][0][j]; h1[j] = g1 * sigm(g1) * acc[ai][1][m][1][j]; }
                u32x4 w; w.x = cvt_pk_bf16(h0[0], h0[1]); w.y = cvt_pk_bf16(h0[2], h0[3]); w.z = cvt_pk_bf16(h1[0], h1[1]); w.w = cvt_pk_bf16(h1[2], h1[3]);
                *(u32x4*)rowp = w; }
    }
};
struct EpiMoeDown {
    bf16_t* O2; const float* slotw; float* O2X;
    __device__ __forceinline__ void operator()(const f32x4 (&acc)[2][2][4][2], const Unit& u, int wr, int wc, int fr, int fq) const {
        EPI_ROWS(u);
        float wq[2][4];
        if (u.kind & 8) {
            const int sp = (u.kind >> 4) & 3;
#pragma unroll
            for (int ai = 0; ai < 2; ++ai)
#pragma unroll
                for (int m = 0; m < 4; ++m) { const int r = row0 + ai * HALF + m * 16; const float w8 = slotw[r]; float* op = O2X + ((size_t)sp * 2048 + (r - 128 * 256)) * D + u.pn * BM + colt;
#pragma unroll
                    for (int bj = 0; bj < 2; ++bj)
#pragma unroll
                        for (int n = 0; n < 2; ++n) *(f32x4*)(op + bj * HALF + 4 * n) = acc[ai][bj][m][n] * w8; }
            return;
        }
#pragma unroll
        for (int ai = 0; ai < 2; ++ai)
#pragma unroll
            for (int m = 0; m < 4; ++m) wq[ai][m] = slotw[row0 + ai * HALF + m * 16];
#pragma unroll
        for (int ai = 0; ai < 2; ++ai)
#pragma unroll
            for (int m = 0; m < 4; ++m) { const int r = row0 + ai * HALF + m * 16; const float w8 = wq[ai][m];
                bf16_t* rowp = O2 + (size_t)r * D + u.pn * BM + colt;
#pragma unroll
                for (int bj = 0; bj < 2; ++bj) { const f32x4 v0 = acc[ai][bj][m][0] * w8, v1 = acc[ai][bj][m][1] * w8;
                    u32x4 w; w.x = cvt_pk_bf16(v0[0], v0[1]); w.y = cvt_pk_bf16(v0[2], v0[3]); w.z = cvt_pk_bf16(v1[0], v1[1]); w.w = cvt_pk_bf16(v1[2], v1[3]);
                    *(u32x4*)(rowp + bj * HALF) = w; } }
    }
};
}

struct Job { int in_idx; int src_off; int lds; int K; int N; long long dst_off; int ldd; int kcol0; int G, GS, R0; int tile0; };
struct JobTable { Job j[96]; int n; int total; };
constexpr int BIGG = 1 << 30;
constexpr void add_job(JobTable& t, int in_idx, long long src_off, int lds, int K, int N, size_t dst_off, int ldd, int kcol0, int G, int GS, int R0) {
    Job& q = t.j[t.n]; q.in_idx = in_idx; q.src_off = (int)src_off; q.lds = lds; q.K = K; q.N = N; q.dst_off = (long long)dst_off; q.ldd = ldd; q.kcol0 = kcol0; q.G = G; q.GS = GS; q.R0 = R0;
    q.tile0 = t.total; t.total += (K / 64) * (N / 64); t.n++;
}
constexpr JobTable make_jobs(int which) {
    JobTable t{}; t.n = 0; t.total = 0;
    if (which == 0) {
        for (int l = 0; l < 2; ++l) {
            const size_t base = WS_WL + (size_t)l * SZ_WL; const long long wsrc = (long long)l * 1024 * IN_COLS;
            add_job(t, 6, wsrc + 0, IN_COLS, 1024, 768, base, 1024, 0, BIGG, 0, 0);
            add_job(t, 6, wsrc + 2688, IN_COLS, 1024, 256, base, 1024, 0, BIGG, 0, PC_D);
            add_job(t, 6, wsrc + 1536, IN_COLS, 1024, 768, base, 1024, 0, BIGG, 0, PC_Q);
            add_job(t, 6, wsrc + 2944, IN_COLS, 1024, 4096, base, 1024, 0, BIGG, 0, PC_G);
            add_job(t, 6, wsrc + 768, IN_COLS, 1024, 768, base + SZ_WINR, 1024, 0, BIGG, 0, 0);
            add_job(t, 6, wsrc + 2304, IN_COLS, 1024, 384, base + SZ_WINR, 1024, 0, BIGG, 0, PT_V);
            const int kd[4] = {384, 256, 384, 256}, ko[4] = {0, 384, 640, 1024};
            for (int i = 0; i < 4; ++i) add_job(t, 35 + i, (long long)l * kd[i] * 1024, 1024, kd[i], 1024, base + SZ_WINR + SZ_WINHY, 1280, ko[i], BIGG, 0, 0);
            add_job(t, 39, (long long)l * 1024 * 1024, 1024, 1024, 1024, base + SZ_WINR + SZ_WINHY + SZ_WBR, 1024, 0, BIGG, 0, 0);
        }
        for (int q = 0; q < 24; ++q) for (int mat = 0; mat < 2; ++mat)
            add_job(t, mat == 0 ? 9 : 11, (long long)q * 4096, 64, 64, 64, WS_LW + (size_t)(((q / 6) * 2 + mat) * 6 + q % 6) * 4096 * 2, 64, 0, BIGG, 0, 0);
        for (int l = 0; l < 2; ++l) add_job(t, 33, (long long)l * 65536, 256, 256, 256, WS_WGLU + (size_t)l * 256 * 256 * 2, 256, 0, BIGG, 0, 0);
        add_job(t, 44, 0, FF_DENSE, 1024, FF_DENSE, WS_FFGU, 1024, 0, 128, 256, 0);
        add_job(t, 45, 0, FF_DENSE, 1024, FF_DENSE, WS_FFGU, 1024, 0, 128, 256, 128);
        add_job(t, 46, 0, 1024, FF_DENSE, 1024, WS_FFD, FF_DENSE, 0, BIGG, 0, 0);
    } else {
        for (int e = 0; e < NE; ++e) {
            add_job(t, 48, (long long)e * 1024 * FF_E, FF_E, 1024, FF_E, WS_MOEGU + (size_t)e * 2 * FF_E * 1024 * 2, 1024, 0, 128, 256, 0);
            add_job(t, 49, (long long)e * 1024 * FF_E, FF_E, 1024, FF_E, WS_MOEGU + (size_t)e * 2 * FF_E * 1024 * 2, 1024, 0, 128, 256, 128);
            add_job(t, 50, (long long)e * FF_E * 1024, 1024, FF_E, 1024, WS_MOED + (size_t)e * 1024 * FF_E * 2, FF_E, 0, BIGG, 0, 0);
        }
    }
    return t;
}
__device__ const JobTable JT_SMALL = make_jobs(0);
__device__ const JobTable JT_MOE = make_jobs(1);

struct PartTable { pg8::PartC p[32]; };
constexpr pg8::PartC mk_part(size_t aOff, size_t bOff, unsigned aStep, unsigned bStep, int nM, int nN, int nt, int kind, int start) {
    pg8::PartC q{}; q.aOff = (long long)aOff; q.bOff = (long long)bOff; q.aStep = aStep; q.bStep = bStep; q.nM = nM; q.nN = nN; q.nt = nt; q.kind = kind; q.start = start; q.nGrp = 1; q.aGrp = 0; q.bGrp = 0; return q;
}
constexpr PartTable make_parts() {
    PartTable t{};
    for (int l = 0; l < 2; ++l) {
        const size_t WL = WS_WL + (size_t)l * SZ_WL; const int nMrow = l == 0 ? 68 : 64;
        t.p[l * 8 + 0] = mk_part(WS_UB, WL, 256u * 1024u * 2u, 256u * 1024u * 2u, 68, 23, 16, 0, 0);
        t.p[l * 8 + 1] = mk_part(WL + SZ_WINR, WS_UB, 256u * 1024u * 2u, 256u * 1024u * 2u, 5, 68, 16, 1, 68 * 23);
        const int kd[4] = {384, 256, 384, 256}, ko[4] = {0, 384, 640, 1024};
        for (int i = 0; i < 4; ++i) t.p[l * 8 + 2 + i] = mk_part(WS_YB + ko[i] * 2, WL + SZ_WINR + SZ_WINHY + ko[i] * 2, 256u * 1280u * 2u, 256u * 1280u * 2u, nMrow, 4, kd[i] / 64, i, i * nMrow * 4);
        t.p[l * 8 + 6] = mk_part(WS_UB, WL + SZ_WINR + SZ_WINHY + SZ_WBR, 256u * 1024u * 2u, 256u * 1024u * 2u, nMrow, 4, 16, 0, 0);
    }
    for (int l = 0; l < 2; ++l) {
        pg8::PartC q = mk_part(WS_US, WS_OPS + (size_t)l * 16 * 256 * 256 * 2, 256u * 512u * 2u, 0u, 5, 1, 4, 0, 0); q.nGrp = 16; q.aGrp = (unsigned)(NCHKP * 512 * 2); q.bGrp = 256u * 256u * 2u; t.p[18 + l * 3] = q;
        q = mk_part(WS_US, WS_OPY + (size_t)l * 16 * 256 * 512 * 2, 256u * 512u * 2u, 0u, 5, 1, 8, 0, 0); q.nGrp = 16; q.aGrp = (unsigned)(NCHKP * 512 * 2); q.bGrp = 256u * 512u * 2u; t.p[19 + l * 3] = q;
        t.p[20 + l * 3] = mk_part(WS_GL, WS_WGLU + (size_t)l * 256 * 256 * 2, 256u * 256u * 2u, 0u, l == 0 ? 68 : 64, 1, 4, 0, 0);
    }
    {
        const size_t WL0 = WS_WL;
        t.p[24] = mk_part(WS_UB, WL0 + SZ_WINR + SZ_WINHY + SZ_WBR, 256u * 1024u * 2u, 256u * 1024u * 2u, 64, 4, 16, 0, 0);
        pg8::PartC q = mk_part(WS_MGC, WL0 + SZ_WINR + SZ_WINHY + SZ_WBR, 256u * 1024u * 2u, 256u * 1024u * 2u, 4, 4, 16, 1, 256); q.nGrp = 4; q.aGrp = (unsigned)(RC * D * 2); q.bGrp = 0u; t.p[25] = q;
        t.p[26] = mk_part(WS_H, WS_FFD, 256u * (unsigned)FF_DENSE * 2u, 256u * (unsigned)FF_DENSE * 2u, 64, 4, 44, 0, 0);
        q = mk_part(WS_H + (size_t)64 * 256 * FF_DENSE * 2, WS_FFD, 256u * (unsigned)FF_DENSE * 2u, 256u * (unsigned)FF_DENSE * 2u, 4, 4, 12, 1, 256); q.nGrp = 3; q.aGrp = 1536u; q.bGrp = 1536u; t.p[27] = q;
        t.p[28] = mk_part(WS_H + (size_t)64 * 256 * FF_DENSE * 2 + 36 * 128, WS_FFD + 36 * 128, 256u * (unsigned)FF_DENSE * 2u, 256u * (unsigned)FF_DENSE * 2u, 4, 4, 8, 4, 256 + 48);
    }
    t.p[16] = mk_part(WS_UB, WS_FFGU, 256u * 1024u * 2u, 256u * 1024u * 2u, 68, 22, 16, 0, 0);
    t.p[17] = mk_part(WS_H, WS_FFD, 256u * (unsigned)FF_DENSE * 2u, 256u * (unsigned)FF_DENSE * 2u, 68, 4, 44, 0, 0);
    return t;
}
__device__ const PartTable PARTS = make_parts();

struct Args {
    const float* in[51];
    float* out; unsigned char* ws;
    int ph_lo, ph_hi, bar_region, pad0;
};
__device__ __forceinline__ const float* sel_in(const Args& a, int idx) {
    const float* p = a.in[6];
    p = idx == 9 ? a.in[9] : p; p = idx == 11 ? a.in[11] : p; p = idx == 33 ? a.in[33] : p; p = idx == 35 ? a.in[35] : p; p = idx == 36 ? a.in[36] : p; p = idx == 37 ? a.in[37] : p; p = idx == 38 ? a.in[38] : p; p = idx == 39 ? a.in[39] : p;
    p = idx == 44 ? a.in[44] : p; p = idx == 45 ? a.in[45] : p; p = idx == 46 ? a.in[46] : p; p = idx == 48 ? a.in[48] : p; p = idx == 49 ? a.in[49] : p; p = idx == 50 ? a.in[50] : p;
    return p;
}

__device__ __forceinline__ void convert_step(const Args& a, const JobTable& JT, LAS float* tile, int t0, int stride) {
    const int tid = threadIdx.x;
    {
        f32x4 v[4][2]; int jis[4];
#pragma unroll
        for (int u = 0; u < 4; ++u) {
            const int t = t0 + u * stride; jis[u] = -1;
            if (t < JT.total) {
                int ji = 0;
                for (int k = 1; k < JT.n; ++k) if (t >= JT.j[k].tile0) ji = k;
                jis[u] = ji;
                const Job& q = JT.j[ji];
                const int lt = t - q.tile0, nTn = q.N / 64, k0 = (lt / nTn) * 64, n0 = (lt % nTn) * 64;
                const float* src = sel_in(a, q.in_idx) + (size_t)q.src_off + (size_t)k0 * q.lds + n0;
#pragma unroll
                for (int p = 0; p < 2; ++p) v[u][p] = *(const f32x4*)(src + (size_t)((tid >> 4) + 32 * p) * q.lds + (tid & 15) * 4);
            }
        }
        __syncthreads();
#pragma unroll
        for (int u = 0; u < 4; ++u) if (jis[u] >= 0) {
#pragma unroll
            for (int p = 0; p < 2; ++p) { const int kk = (tid >> 4) + 32 * p, nn = (tid & 15) * 4; LAS float* tp = tile + u * (64 * 65) + kk * 65 + nn;
                tp[0] = v[u][p][0]; tp[1] = v[u][p][1]; tp[2] = v[u][p][2]; tp[3] = v[u][p][3]; } }
        __syncthreads();
#pragma unroll
        for (int u = 0; u < 4; ++u) if (jis[u] >= 0) {
            const Job& q = JT.j[jis[u]];
            const int t = t0 + u * stride, lt = t - q.tile0, nTn = q.N / 64, k0 = (lt / nTn) * 64, n0 = (lt % nTn) * 64;
            const int n = tid >> 3, k8 = (tid & 7) * 8, ng = n0 + n;
            const int drow = (ng / q.G) * q.GS + (ng % q.G) + q.R0;
            const LAS float* tp = tile + u * (64 * 65) + n;
            u32x4 w;
            w.x = cvt_pk_bf16(tp[(k8 + 0) * 65], tp[(k8 + 1) * 65]); w.y = cvt_pk_bf16(tp[(k8 + 2) * 65], tp[(k8 + 3) * 65]);
            w.z = cvt_pk_bf16(tp[(k8 + 4) * 65], tp[(k8 + 5) * 65]); w.w = cvt_pk_bf16(tp[(k8 + 6) * 65], tp[(k8 + 7) * 65]);
            *(u32x4*)((bf16_t*)(a.ws + q.dst_off) + (size_t)drow * q.ldd + q.kcol0 + k0 + k8) = w;
        }
    }
}
__device__ __forceinline__ void convert_tiles(const Args& a, const JobTable& JT, LAS float* tile, int first, int stride) {
    for (int t0 = first; t0 < JT.total; t0 += 4 * stride) convert_step(a, JT, tile, t0, stride);
}

__device__ __forceinline__ int opaque(int v) { asm volatile("" : "+v"(v)); return v; }
#define PIN8(a) asm volatile("" : "+v"((a)[0]), "+v"((a)[1]), "+v"((a)[2]), "+v"((a)[3]), "+v"((a)[4]), "+v"((a)[5]), "+v"((a)[6]), "+v"((a)[7]))
#define PIN16(a) do { PIN8(a); PIN8((a) + 8); } while (0)
struct RowV { f32x4 v[4]; };
__device__ __forceinline__ RowV row_load(const float* p, int lane) { RowV r;
#pragma unroll
    for (int i = 0; i < 4; ++i) r.v[i] = *(const f32x4*)(p + 256 * i + 4 * lane); return r; }
__device__ __forceinline__ void row_store(float* p, int lane, const RowV& r) {
#pragma unroll
    for (int i = 0; i < 4; ++i) *(f32x4*)(p + 256 * i + 4 * lane) = r.v[i]; }
__device__ __forceinline__ void row_store_bf16(bf16_t* p, int lane, const RowV& r) {
#pragma unroll
    for (int i = 0; i < 4; ++i) { u32x2 w; w.x = cvt_pk_bf16(r.v[i][0], r.v[i][1]); w.y = cvt_pk_bf16(r.v[i][2], r.v[i][3]); *(u32x2*)(p + 256 * i + 4 * lane) = w; } }
__device__ __forceinline__ RowV row_norm(const RowV& x) {
    float s = 0.f;
#pragma unroll
    for (int i = 0; i < 4; ++i) s += (x.v[i][0] + x.v[i][1]) + (x.v[i][2] + x.v[i][3]);
    const float mu = wave_sum(s) * (1.f / D);
    RowV d; float q = 0.f;
#pragma unroll
    for (int i = 0; i < 4; ++i) { d.v[i] = x.v[i] - mu; q += (d.v[i][0] * d.v[i][0] + d.v[i][1] * d.v[i][1]) + (d.v[i][2] * d.v[i][2] + d.v[i][3] * d.v[i][3]); }
    const float rs = rsqrtf(wave_sum(q) * (1.f / D) + 1e-5f);
#pragma unroll
    for (int i = 0; i < 4; ++i) d.v[i] = d.v[i] * rs;
    return d;
}
__device__ __forceinline__ RowV row_affine(const RowV& n, const float* g, const float* b, int lane) {
    RowV o;
#pragma unroll
    for (int i = 0; i < 4; ++i) o.v[i] = n.v[i] * *(const f32x4*)(g + 256 * i + 4 * lane) + *(const f32x4*)(b + 256 * i + 4 * lane);
    return o;
}
__device__ __forceinline__ RowV row_modulate(const RowV& n, const float* sh, const float* sc, int lane) {
    RowV o;
#pragma unroll
    for (int i = 0; i < 4; ++i) o.v[i] = n.v[i] * (*(const f32x4*)(sc + 256 * i + 4 * lane) + 1.0f) + *(const f32x4*)(sh + 256 * i + 4 * lane);
    return o;
}

constexpr int LDS_BYTES = 159744;
constexpr int MISC_OFF = 159488;
constexpr int NPH_LAYER = 16;
#ifndef SPLIT
#define SPLIT 0
#endif
#ifndef REPMASK
#define REPMASK 0x8
#endif
#define REPEAT(id) for (int rep_ = 0; rep_ < 1 + ((REPMASK >> (id)) & 1); ++rep_)

__global__ void __launch_bounds__(512, 2) mk_fwd(Args a) {
    extern __shared__ __attribute__((aligned(16))) unsigned char shm[];
    LAS unsigned char* lds = (LAS unsigned char*)shm;
    volatile LAS unsigned* MISC = (volatile LAS unsigned*)(lds + MISC_OFF);
    const int tid0 = threadIdx.x, wave = __builtin_amdgcn_readfirstlane(tid0 >> 6);
    const int G = gridDim.x, bid = blockIdx.x;
    if (tid0 < (LDS_BYTES - MISC_OFF) / 4) MISC[tid0] = 0u;
    __syncthreads();
    unsigned char* ws = a.ws;
    unsigned* ctl = (unsigned*)(ws + WS_CTL);
    XcdBarrier bar = xcd_barrier_post(ctl + CW_BAR + a.bar_region * XCD_BAR_WORDS, MISC + 8);
    const int lo = a.ph_lo, hi = a.ph_hi;
#ifndef PHMASK
#define PHMASK 0xFFFF
#endif
#define IN(k) (lo <= (k) && (k) < hi)
#define SEAM(k) do { if (lo <= (k) && (k) + 1 < hi) xcd_barrier(bar); } while (0)
    float* MOD = (float*)(ws + WS_MOD);
    bf16_t* UB = (bf16_t*)(ws + WS_UB); bf16_t* PR = (bf16_t*)(ws + WS_PR); bf16_t* PT = (bf16_t*)(ws + WS_PT); bf16_t* YB = (bf16_t*)(ws + WS_YB);
    float* PRE = (float*)(ws + WS_PRE); float* XSC = (float*)(ws + WS_XSC);
    const float* x_in = a.in[0]; const float* ctx_in = a.in[2];

    if (((PHMASK >> 0) & 1) && IN(0)) {
        const int tid = opaque(tid0), lane = tid & 63;
        __syncthreads();
        LAS float* sc = (LAS float*)lds;
        for (int i = tid; i < 5 * 1024; i += 512) { const int r = i >> 10, k = i & 1023; sc[i] = silu_acc(r < 4 ? a.in[1][r * 1024 + k] : a.in[3][k]); }
        __syncthreads();
        for (int u = bid; u < 2 * 96 * 8; u += G) {
            const int l = u / (96 * 8), rem = u % (96 * 8), cg = rem / 8, ks = rem % 8;
            const int n = cg * 64 + lane;
            const float* w = a.in[4] + (size_t)l * 1024 * 6144 + n;
            float a0 = 0, a1 = 0, a2 = 0, a3 = 0, a4 = 0;
            const int kb = ks * 128 + wave * 16;
#pragma unroll 4
            for (int k = kb; k < kb + 16; ++k) { const float wv = w[(size_t)k * 6144]; a0 += sc[k] * wv; a1 += sc[1024 + k] * wv; a2 += sc[2048 + k] * wv; a3 += sc[3072 + k] * wv; a4 += sc[4096 + k] * wv; }
            if (ks == 0 && wave == 0) { const float bb = a.in[5][l * 6144 + n]; a0 += bb; a1 += bb; a2 += bb; a3 += bb; a4 += bb; }
            float* o = MOD + (size_t)l * 5 * 6144 + n;
            atomicAdd(o, a0); atomicAdd(o + 6144, a1); atomicAdd(o + 2 * 6144, a2); atomicAdd(o + 3 * 6144, a3); atomicAdd(o + 4 * 6144, a4);
        }
        __syncthreads();
        for (int u = bid; u < 132; u += G) {
            const bool isc = u >= 128; const int l = isc ? 0 : (u >> 6), blk = isc ? u - 128 : (u & 63), L = isc ? CTXL : SEQ, t0 = blk * 64;
            LAS float* feat = (LAS float*)lds;
            LAS float* h1 = feat + 64 * 33;
            LAS float* h2 = h1 + 4096;
            const float* w1 = a.in[16] + l * 33 * 64; const float* b1 = a.in[17] + l * 64; const float* w2 = a.in[18] + l * 4096; const float* b2 = a.in[19] + l * 64;
            const float* w3 = a.in[20] + (size_t)l * 65536; const float* b3 = a.in[21] + l * 1024; const float* fq = a.in[22] + l * 64;
            __syncthreads();
            for (int i = tid; i < 64 * 33; i += 512) { const int tt = i / 33, f = i - tt * 33, t = t0 + tt; float v;
                if (f == 0) v = (float)t / (float)L;
                else { const int band = (f - 1) % 16 + 1; const int m = (int)(((long)t * band) % L); const double ang = 2.0 * M_PI * (double)m / (double)L; v = f <= 16 ? (float)cos(ang) : (float)sin(ang); }
                feat[i] = v; }
            __syncthreads();
            for (int i = tid; i < 4096; i += 512) { const int tt = i >> 6, j = i & 63; float sacc = b1[j];
                for (int f = 0; f < 33; ++f) sacc += feat[tt * 33 + f] * w1[f * 64 + j];
                h1[i] = sinf(fq[j] * sacc); }
            __syncthreads();
            for (int i = tid; i < 4096; i += 512) { const int tt = i >> 6, j = i & 63; float sacc = b2[j];
                for (int f = 0; f < 64; ++f) sacc += h1[tt * 64 + f] * w2[f * 64 + j];
                h2[i] = sinf(fq[j] * sacc); }
            __syncthreads();
            const float dmin = 3.0701134573253945f, dmax = 15.350567286626973f;
#pragma unroll 1
            for (int jj = 0; jj < 2; ++jj) {
                const int n = tid + 512 * jj, dir = n >> 9, o = (n >> 8) & 1, c = n & 255;
                float wc[64];
#pragma unroll
                for (int i = 0; i < 64; ++i) wc[i] = w3[i * 1024 + n];
                const float bb = b3[n], delta = dmin + (dmax - dmin) * (float)c / 255.0f;
                bf16_t* dst = isc ? (bf16_t*)(ws + WS_KFC) + ((size_t)(dir * 2 + o) * 256 + c) * CTXL + t0 : (bf16_t*)(ws + WS_KFL) + ((size_t)((l * 2 + dir) * 2 + o) * 256 + c) * SEQ + t0;
                float asum = 0.f;
#pragma unroll 1
                for (int tg = 0; tg < 8; ++tg) {
                    float v[8];
#pragma unroll
                    for (int q = 0; q < 8; ++q) { float sacc = bb; const LAS float* hp = h2 + (tg * 8 + q) * 64;
#pragma unroll
                        for (int i = 0; i < 64; ++i) sacc += hp[i] * wc[i];
                        const int t = t0 + tg * 8 + q;
                        v[q] = sacc * expf(-((float)t / (float)L) * delta);
                        if (!(dir == 1 && t == 0)) asum += fabsf(v[q]); }
                    u32x4 w; w.x = cvt_pk_bf16(v[0], v[1]); w.y = cvt_pk_bf16(v[2], v[3]); w.z = cvt_pk_bf16(v[4], v[5]); w.w = cvt_pk_bf16(v[6], v[7]);
                    *(u32x4*)(dst + tg * 8) = w;
                }
                atomicAdd((float*)(ctl + CW_HYN) + (isc ? 1024 + o * 256 + c : (l * 2 + o) * 256 + c), asum);
            }
        }
        __syncthreads();
        for (int u = bid - 132; u >= 0 && u < 32; u += G) {
            const int l = u >> 4, g = u & 15;
            LAS float* PW = (LAS float*)lds;
            LAS float* BBs = PW + 2 * 64 * 17 * 2;
            LAS float* Cs = BBs + 2 * 64 * 16 * 2;
            LAS float* KT = Cs + 2 * 16 * 64 * 2;
            __syncthreads();
            if (tid < 128) {
                const int d = tid >> 6, p = tid & 63, idx = l * 2048 + (d * 16 + g) * 64 + p;
                const double ar = a.in[25][idx], ai = a.in[26][idx], dt = exp((double)a.in[27][l * 32 + d * 16 + g]);
                const double mag = exp(dt * ar), abr = mag * cos(dt * ai), abi = mag * sin(dt * ai), den = ar * ar + ai * ai;
                const double fr = ((abr - 1.0) * ar + abi * ai) / den, fi = (abi * ar - (abr - 1.0) * ai) / den;
                double pr = 1.0, pi = 0.0;
                for (int k = 0; k <= 16; ++k) { PW[((d * 64 + p) * 17 + k) * 2] = (float)pr; PW[((d * 64 + p) * 17 + k) * 2 + 1] = (float)pi; const double nr = pr * abr - pi * abi, ni = pr * abi + pi * abr; pr = nr; pi = ni; }
                float* a16 = (float*)(ws + WS_AB16) + ((size_t)((l * 2 + d) * 16 + g) * 64 + p) * 2;
                a16[0] = PW[((d * 64 + p) * 17 + 16) * 2]; a16[1] = PW[((d * 64 + p) * 17 + 16) * 2 + 1];
                for (int i = 0; i < 16; ++i) { const double br = a.in[28][(size_t)idx * 16 + i], bi = a.in[29][(size_t)idx * 16 + i];
                    BBs[((d * 64 + p) * 16 + i) * 2] = (float)(fr * br - fi * bi); BBs[((d * 64 + p) * 16 + i) * 2 + 1] = (float)(fr * bi + fi * br); }
            }
            for (int i = tid; i < 2048; i += 512) { const int d = i >> 10, o = (i >> 6) & 15, p = i & 63; const size_t ci = (size_t)l * 32768 + ((size_t)(d * 16 + g) * 16 + o) * 64 + p;
                Cs[i * 2] = a.in[30][ci]; Cs[i * 2 + 1] = a.in[31][ci]; }
            __syncthreads();
            for (int e = tid; e < 8192; e += 512) { const int d = e >> 12, k = (e >> 8) & 15, o = (e >> 4) & 15, i = e & 15;
                float acc = 0.f;
                for (int p = 0; p < 64; ++p) { const float cr = Cs[((d * 16 + o) * 64 + p) * 2], ci = Cs[((d * 16 + o) * 64 + p) * 2 + 1], pr = PW[((d * 64 + p) * 17 + k) * 2], pi = PW[((d * 64 + p) * 17 + k) * 2 + 1];
                    const float tr = cr * pr - ci * pi, ti = cr * pi + ci * pr;
                    acc += tr * BBs[((d * 64 + p) * 16 + i) * 2] - ti * BBs[((d * 64 + p) * 16 + i) * 2 + 1]; }
                KT[e] = acc; }
            __syncthreads();
            bf16_t* OPS = (bf16_t*)(ws + WS_OPS) + (size_t)(l * 16 + g) * 256 * 256;
            bf16_t* OPY = (bf16_t*)(ws + WS_OPY) + (size_t)(l * 16 + g) * 256 * 512;
            for (int e = tid; e < 256 * 32; e += 512) {
                const int row = e >> 5, c0 = (e & 31) * 8, d = row >> 7, p = (row >> 1) & 63, ri = row & 1, sx = c0 >> 4, i0 = c0 & 15, k = d == 0 ? 15 - sx : sx;
                const float pr = PW[((d * 64 + p) * 17 + k) * 2], pi = PW[((d * 64 + p) * 17 + k) * 2 + 1];
                float v[8];
#pragma unroll
                for (int j = 0; j < 8; ++j) { const float br = BBs[((d * 64 + p) * 16 + i0 + j) * 2], bi = BBs[((d * 64 + p) * 16 + i0 + j) * 2 + 1]; v[j] = ri == 0 ? pr * br - pi * bi : pr * bi + pi * br; }
                u32x4 w; w.x = cvt_pk_bf16(v[0], v[1]); w.y = cvt_pk_bf16(v[2], v[3]); w.z = cvt_pk_bf16(v[4], v[5]); w.w = cvt_pk_bf16(v[6], v[7]);
                *(u32x4*)(OPS + (size_t)row * 256 + c0) = w; }
            for (int e = tid; e < 256 * 64; e += 512) {
                const int row = e >> 6, c0 = (e & 63) * 8, t = row >> 4, o = row & 15;
                float v[8];
                if (c0 < 256) { const int sx = c0 >> 4, i0 = c0 & 15;
#pragma unroll
                    for (int j = 0; j < 8; ++j) { float x = 0.f; if (sx <= t) x += KT[((0 * 16 + (t - sx)) * 16 + o) * 16 + i0 + j]; if (sx >= t) x += KT[((1 * 16 + (sx - t)) * 16 + o) * 16 + i0 + j]; v[j] = x; } }
                else { const int c2 = c0 - 256, d = c2 >> 7, k = d == 0 ? t + 1 : 16 - t;
#pragma unroll
                    for (int j = 0; j < 8; ++j) { const int p = ((c2 + j) >> 1) & 63, ri = (c2 + j) & 1;
                        const float cr = Cs[((d * 16 + o) * 64 + p) * 2], ci = Cs[((d * 16 + o) * 64 + p) * 2 + 1], pr = PW[((d * 64 + p) * 17 + k) * 2], pi = PW[((d * 64 + p) * 17 + k) * 2 + 1];
                        v[j] = ri == 0 ? cr * pr - ci * pi : -(cr * pi + ci * pr); } }
                u32x4 w; w.x = cvt_pk_bf16(v[0], v[1]); w.y = cvt_pk_bf16(v[2], v[3]); w.z = cvt_pk_bf16(v[4], v[5]); w.w = cvt_pk_bf16(v[6], v[7]);
                *(u32x4*)(OPY + (size_t)row * 512 + c0) = w; }
        }
        __syncthreads();
        for (;;) {
            __syncthreads();
            if (tid == 0) MISC[16] = atomicAdd(ctl + CW_QUEUE, 4u);
            __syncthreads();
            const int base = (int)MISC[16];
            if (base >= JT_SMALL.total) break;
            convert_step(a, JT_SMALL, (LAS float*)lds, base, 1);
        }
        __syncthreads();
    }
    SEAM(0);

    for (int l = 0; l < 2; ++l) {
        const int P0 = 1 + l * NPH_LAYER;
        const float* MODL = MOD + (size_t)l * 5 * 6144;
        const unsigned char* WL = ws + WS_WL + (size_t)l * SZ_WL;
        const int nMrow = (l == 0) ? 68 : 64;
        const float* xlat = (l == 0) ? x_in : a.out; const float* xctx = (l == 0) ? ctx_in : XSC;

        if (((PHMASK >> 1) & 1) && l == 0 && IN(P0 + 0)) {
            const int lane = opaque(tid0) & 63;
            for (int r = bid * 8 + wave; r < RT; r += G * 8) {
                const float* src = r < RL ? x_in + (size_t)r * D : ctx_in + (size_t)(r - RL) * D;
                const float* mv = MODL + (size_t)(r < RL ? (r >> 12) : 4) * 6144;
                const RowV n = row_norm(row_load(src, lane));
                row_store_bf16(UB + (size_t)r * D, lane, row_modulate(n, mv, mv + 1024, lane));
            }
        }
        if (l == 0) SEAM(P0 + 0);

        if (((PHMASK >> 2) & 1) && IN(P0 + 1)) {
            const pg8::TabSched S{PARTS.p + l * 8, (const char*)ws, 2, 68 * 23 + 5 * 68, G, bid};
            pg8::EpiProj E{PR, PT, (bf16_t*)(ws + WS_US), 7, ws + WS_GQ};
            pg8::gemm_phase<1024, 1024>(lds, S, E);
        }
        SEAM(P0 + 1);
        if (((PHMASK >> 13) & 1) && IN(P0 + 2)) {
            const int tid = opaque(tid0), lane = tid & 63;
            LAS float* rp = (LAS float*)lds;
            for (int i = tid; i < 6 * 465; i += 512) rp[i] = a.in[24][l * 2790 + i];
            __syncthreads();
            LAS bf16_t* CK = (LAS bf16_t*)(lds + 11264);
            LAS bf16_t* CV = (LAS bf16_t*)(lds + 11264 + 256 * 144);
            const int ngroups = 768 + (l == 0 ? 48 : 0);
            for (int gi = bid; gi < ngroups; gi += G) {
                const bool lat = gi < 768;
                const int combo = lat ? gi >> 5 : (gi - 768) >> 1, b = combo / 6, h = combo - 6 * b;
                const int v = lat ? ((gi & 31) << 3) + wave : (((gi - 768) & 1) << 3) + wave;
                __syncthreads();
                const int tid2 = opaque(tid);
#pragma unroll
                for (int k = 0; k < 4; ++k) { const int c = tid2 + 512 * k, tok = c >> 3, part = c & 7;
                    *(LAS u32x4*)(CK + tok * 72 + part * 8) = *(const u32x4*)(PR + (size_t)(RL + b * CTXL + tok) * LDP + PC_K + h * 64 + part * 8); }
#pragma unroll
                for (int k = 0; k < 4; ++k) { const int c = tid2 + 512 * k, dd = c >> 5, part = c & 31;
                    *(LAS u32x4*)(CV + dd * 264 + part * 8) = *(const u32x4*)(PT + (size_t)(PT_V + h * 64 + dd) * RT + RL + b * CTXL + part * 8); }
                __syncthreads();
                const int ln2 = opaque(lane), qn = ln2 & 15, g = ln2 >> 4;
                int r = 0, qb, tq, rs = 0, bs = 0, w = 0, cs = 0;
                if (lat) { qb = v & 3; r = v >> 2; rs = r - 4 < 0 ? 0 : (r - 4 > 56 ? 56 : r - 4); bs = qb == 0 ? 0 : (qb == 1 ? 8 : (qb == 2 ? 24 : 32));
                    w = 16 * qb + qn; cs = w - 8 < 0 ? 0 : (w - 8 > 48 ? 48 : w - 8); tq = b * SEQ + r * 64 + w; }
                else { qb = v; tq = RL + b * CTXL + 16 * qb + qn; }
                const bf16_t* qp = PR + (size_t)tq * LDP + PC_Q + h * 64 + 8 * g;
                const bf16x8 q0 = *(const bf16x8*)qp, q1 = *(const bf16x8*)(qp + 32);
                f32x4 S[32];
                const int koff = 8 * (qn >> 2) + (qn & 3);
                if (lat) {
#pragma unroll
                    for (int pb = 0; pb < 4; ++pb) {
                        bf16x8 kf[8];
#pragma unroll
                        for (int q = 0; q < 4; ++q) { const int p = pb * 2 + (q >> 1), hf = q & 1;
                            const bf16_t* kp = PR + (size_t)(b * SEQ + (rs + p) * 64 + bs + koff + 4 * hf) * LDP + PC_K + h * 64 + 8 * g;
                            kf[2 * q] = *(const bf16x8*)kp; kf[2 * q + 1] = *(const bf16x8*)(kp + 32); }
                        PIN8(kf);
#pragma unroll
                        for (int q = 0; q < 4; ++q) { const int p = pb * 2 + (q >> 1), hf = q & 1;
                            f32x4 acc = {0.f, 0.f, 0.f, 0.f};
                            acc = __builtin_amdgcn_mfma_f32_16x16x32_bf16(kf[2 * q], q0, acc, 0, 0, 0);
                            acc = __builtin_amdgcn_mfma_f32_16x16x32_bf16(kf[2 * q + 1], q1, acc, 0, 0, 0);
                            const int rowoff = (h * 15 + (rs + p - r + 7)) * 31;
#pragma unroll
                            for (int j = 0; j < 4; ++j) { const int c = bs + 8 * g + 4 * hf + j; const bool ok = (c >= cs) && (c < cs + 16);
                                const int dc = ok ? c - w + 15 : 0;
                                acc[j] = ok ? acc[j] * 0.125f + rp[rowoff + dc] : -3.0e38f; }
                            S[2 * p + hf] = acc; }
                    }
                } else {
#pragma unroll
                    for (int p = 0; p < 16; ++p) S[p] = (f32x4){-3.0e38f, -3.0e38f, -3.0e38f, -3.0e38f};
                }
#pragma unroll
                for (int p = 0; p < 8; ++p)
#pragma unroll
                    for (int hf = 0; hf < 2; ++hf) { const LAS bf16_t* kp = CK + (32 * p + koff + 4 * hf) * 72 + 8 * g;
                        const bf16x8 k0 = *(const LAS bf16x8*)kp, k1 = *(const LAS bf16x8*)(kp + 32);
                        f32x4 acc = {0.f, 0.f, 0.f, 0.f};
                        acc = __builtin_amdgcn_mfma_f32_16x16x32_bf16(k0, q0, acc, 0, 0, 0);
                        acc = __builtin_amdgcn_mfma_f32_16x16x32_bf16(k1, q1, acc, 0, 0, 0);
                        S[16 + 2 * p + hf] = acc * 0.125f; if (hf == 1 && (p & 1)) __builtin_amdgcn_sched_barrier(0); }
                float mx = -3.0e38f;
#pragma unroll
                for (int i = 0; i < 32; ++i) mx = fmaxf(fmaxf(mx, fmaxf(S[i][0], S[i][1])), fmaxf(S[i][2], S[i][3]));
                mx = fmaxf(mx, __shfl_xor(mx, 16)); mx = fmaxf(mx, __shfl_xor(mx, 32));
                float sum = 0.f;
#pragma unroll
                for (int i = 0; i < 32; ++i) {
#pragma unroll
                    for (int j = 0; j < 4; ++j) { const float e = __expf(S[i][j] - mx); S[i][j] = e; sum += e; } }
                sum += __shfl_xor(sum, 16); sum += __shfl_xor(sum, 32);
                const float inv = 1.0f / sum;
                f32x4 O[4];
#pragma unroll
                for (int dt = 0; dt < 4; ++dt) O[dt] = (f32x4){0.f, 0.f, 0.f, 0.f};
                const bf16_t* vt = PT + (size_t)(PT_V + h * 64 + qn) * RT + 8 * g;
                if (lat) {
#pragma unroll
                    for (int pq = 0; pq < 2; ++pq) {
                        bf16x8 vf[16];
#pragma unroll
                        for (int q = 0; q < 4; ++q) { const int p = pq * 4 + q; const int base = b * SEQ + (rs + p) * 64 + bs;
#pragma unroll
                            for (int dt = 0; dt < 4; ++dt) vf[4 * q + dt] = *(const bf16x8*)(vt + (size_t)(16 * dt) * RT + base); }
                        PIN16(vf);
#pragma unroll
                        for (int q = 0; q < 4; ++q) { const int p = pq * 4 + q;
                            u32x4 pw; pw.x = cvt_pk_bf16(S[2 * p][0], S[2 * p][1]); pw.y = cvt_pk_bf16(S[2 * p][2], S[2 * p][3]); pw.z = cvt_pk_bf16(S[2 * p + 1][0], S[2 * p + 1][1]); pw.w = cvt_pk_bf16(S[2 * p + 1][2], S[2 * p + 1][3]);
                            bf16x8 pf; __builtin_memcpy(&pf, &pw, 16);
#pragma unroll
                            for (int dt = 0; dt < 4; ++dt) O[dt] = __builtin_amdgcn_mfma_f32_16x16x32_bf16(vf[4 * q + dt], pf, O[dt], 0, 0, 0); }
                    }
                }
#pragma unroll
                for (int p = 8; p < 16; ++p) {
                    u32x4 pw; pw.x = cvt_pk_bf16(S[2 * p][0], S[2 * p][1]); pw.y = cvt_pk_bf16(S[2 * p][2], S[2 * p][3]); pw.z = cvt_pk_bf16(S[2 * p + 1][0], S[2 * p + 1][1]); pw.w = cvt_pk_bf16(S[2 * p + 1][2], S[2 * p + 1][3]);
                    bf16x8 pf; __builtin_memcpy(&pf, &pw, 16);
#pragma unroll
                    for (int dt = 0; dt < 4; ++dt) { const bf16x8 vfl = *(const LAS bf16x8*)(CV + (16 * dt + qn) * 264 + 32 * (p - 8) + 8 * g);
                        O[dt] = __builtin_amdgcn_mfma_f32_16x16x32_bf16(vfl, pf, O[dt], 0, 0, 0); }
                    if (p & 1) __builtin_amdgcn_sched_barrier(0);
                }
                bf16_t* op = YB + (size_t)tq * YW + YC_C + h * 64 + 4 * g;
#pragma unroll
                for (int dt = 0; dt < 4; ++dt) { u32x2 o2; o2.x = cvt_pk_bf16(O[dt][0] * inv, O[dt][1] * inv); o2.y = cvt_pk_bf16(O[dt][2] * inv, O[dt][3] * inv); *(u32x2*)(op + 16 * dt) = o2; }
            }
            __syncthreads();
            {
                const int tid = opaque(tid0), lane = tid & 63;
                LAS float* XC = (LAS float*)lds;
                LAS f32x2* AB = (LAS f32x2*)(lds + 16 * 384 * 4);
                const float* cw = a.in[7] + l * 4 * 384; const float* cb = a.in[8] + l * 384;
                const bf16_t* LW = (const bf16_t*)(ws + WS_LW) + (size_t)l * 24 * 4096;
                bf16_t* LT = (bf16_t*)(ws + WS_LT); f32x2* LAGG = (f32x2*)(ws + WS_LAGG);
                const int dir = (wave >> 2) & 1, ntile = wave & 3, tk = lane & 15, kg = lane >> 4;
                LAS float* CT = (LAS float*)(lds + 16 * 384 * 4 + 2 * 16 * 384 * 8);
                for (int i = tid; i < 768; i += 512) { CT[i] = a.in[10][l * 768 + i]; CT[768 + i] = a.in[12][l * 768 + i]; CT[1536 + i] = -8.0f * softplus(-a.in[13][l * 768 + i]); }
                float cwv[60];
#pragma unroll
                for (int i = 0; i < 12; ++i) { const int idx = tid + 512 * i, ch = idx % 384;
                    cwv[5 * i] = cw[ch]; cwv[5 * i + 1] = cw[384 + ch]; cwv[5 * i + 2] = cw[768 + ch]; cwv[5 * i + 3] = cw[1152 + ch]; cwv[5 * i + 4] = cb[ch]; }
                PIN16(cwv); PIN16(cwv + 16); PIN16(cwv + 32); PIN8(cwv + 48); asm volatile("" : "+v"(cwv[56]), "+v"(cwv[57]), "+v"(cwv[58]), "+v"(cwv[59]));
                for (int n = bid; n < NCHK; n += G) {
                    const int r0 = 16 * n; int start, len, pos0, bb; row_seq(r0, start, len, pos0, bb);
                    __syncthreads();
                    unsigned pin[48];
#pragma unroll
                    for (int i = 0; i < 12; ++i) { const int idx = tid + 512 * i, tok = idx / 384, ch = idx - tok * 384, pos = pos0 + tok;
                        const bf16_t* pr = PR + (size_t)(r0 + tok) * LDP + PC_AC + ch;
                        pin[4 * i + 0] = pos >= 2 ? pr[-2 * LDP] : 0; pin[4 * i + 1] = pos >= 1 ? pr[-LDP] : 0; pin[4 * i + 2] = pr[0]; pin[4 * i + 3] = pos + 1 < len ? pr[LDP] : 0; }
                    PIN16(pin); PIN16(pin + 16); PIN16(pin + 32);
#pragma unroll
                    for (int i = 0; i < 12; ++i) { const int idx = tid + 512 * i, tok = idx / 384, ch = idx - tok * 384;
                        XC[idx] = cwv[5 * i + 4] + cwv[5 * i] * bflo(pin[4 * i]) + cwv[5 * i + 1] * bflo(pin[4 * i + 1]) + cwv[5 * i + 2] * bflo(pin[4 * i + 2]) + cwv[5 * i + 3] * bflo(pin[4 * i + 3]); }
                    __syncthreads();
#pragma unroll 2
                    for (int g = 0; g < 6; ++g) {
                        bf16x8 wq[4];
#pragma unroll
                        for (int ks = 0; ks < 2; ++ks) { const bf16_t* wp = LW + ((size_t)((dir * 2 + 0) * 6 + g) * 64 + 16 * ntile + tk) * 64 + 32 * ks + 8 * kg; wq[2 * ks] = *(const bf16x8*)wp; wq[2 * ks + 1] = *(const bf16x8*)(wp + 6 * 4096); }
                        asm volatile("" : "+v"(wq[0]), "+v"(wq[1]), "+v"(wq[2]), "+v"(wq[3]));
                        f32x4 ar = {0.f, 0.f, 0.f, 0.f}, ai = {0.f, 0.f, 0.f, 0.f};
#pragma unroll
                        for (int ks = 0; ks < 2; ++ks) {
                            const LAS float* xp = XC + tk * 384 + g * 64 + 32 * ks + 8 * kg;
                            const f32x4 x0 = *(const LAS f32x4*)xp, x1 = *(const LAS f32x4*)(xp + 4);
                            u32x4 xw; xw.x = cvt_pk_bf16(x0[0], x0[1]); xw.y = cvt_pk_bf16(x0[2], x0[3]); xw.z = cvt_pk_bf16(x1[0], x1[1]); xw.w = cvt_pk_bf16(x1[2], x1[3]);
                            bf16x8 xf; __builtin_memcpy(&xf, &xw, 16);
                            ar = __builtin_amdgcn_mfma_f32_16x16x32_bf16(xf, wq[2 * ks], ar, 0, 0, 0);
                            ai = __builtin_amdgcn_mfma_f32_16x16x32_bf16(xf, wq[2 * ks + 1], ai, 0, 0, 0);
                        }
                        const int ch = g * 64 + 16 * ntile + tk;
                        const float br = CT[dir * 384 + ch], bi = CT[768 + dir * 384 + ch], sp8 = CT[1536 + dir * 384 + ch];
#pragma unroll
                        for (int j = 0; j < 4; ++j) { const int tok = 4 * kg + j;
                            const float la = sigm(ar[j] + br) * sp8, y = 2.0f * la;
                            const float av = 1.0f + la * (1.0f + la * (0.5f + la * (0.16666667f + la * (0.041666667f + la * 0.0083333333f))));
                            const float om = -y * (1.0f + y * (0.5f + y * (0.16666667f + y * (0.041666667f + y * (0.0083333333f + y * 0.0013888889f)))));
                            const float bt = __builtin_sqrtf(om) * sigm(ai[j] + bi) * XC[tok * 384 + ch];
                            AB[(dir * 16 + tok) * 384 + ch] = (f32x2){av, bt}; }
                    }
                    __syncthreads();
                    if (tid < 384) {
                        float hf = 0.f, pf = 1.f, hb = 0.f, pb = 1.f;
#pragma unroll
                        for (int t = 0; t < 16; ++t) {
                            const f32x2 f = AB[t * 384 + tid], bk = AB[(16 + 15 - t) * 384 + tid];
                            hf = f[0] * hf + f[1]; pf *= f[0]; hb = bk[0] * hb + bk[1]; pb *= bk[0];
                            AB[t * 384 + tid] = (f32x2){pf, hf}; AB[(16 + 15 - t) * 384 + tid] = (f32x2){pb, hb}; }
                        LAGG[((size_t)n * 2 + 0) * 384 + tid] = (f32x2){pf, hf}; LAGG[((size_t)n * 2 + 1) * 384 + tid] = (f32x2){pb, hb};
                    }
                    __syncthreads();
#pragma unroll
                    for (int i = 0; i < 12; ++i) { const int idx = tid + 512 * i, tok = idx / 384, ch = idx - tok * 384;
                        const f32x2 f = AB[idx], bk = AB[16 * 384 + idx];
                        bf16_t* o = LT + (size_t)(r0 + tok) * 1152 + ch;
                        o[0] = f2bf(f[1] + bk[1]); o[384] = f2bf(f[0]); o[768] = f2bf(bk[0]); }
                }
                __syncthreads();
            }
            {
                const int tid = opaque(tid0), lane = tid & 63;
                constexpr int ZS = SEQ + 16;
                LAS bf16_t* R0 = (LAS bf16_t*)lds;
                LAS bf16_t* R1 = R0 + 8224;
                LAS bf16_t* ZA = R1 + 8224;
                const LAS unsigned* Rdw = (const LAS unsigned*)lds;
#define HY_ZF(b, s) ((b) * ZS + ((s) & ~63) + (((((s) >> 3) & 7) ^ (((s) >> 7) & 1)) << 3) + ((s) & 7))
                const float* hcw = a.in[14] + l * 3 * 768; const float* hcb = a.in[15] + l * 768;
                const float* nrm = (const float*)(ctl + CW_HYN);
                bf16_t* YT = (bf16_t*)(ws + WS_YT);
                const int r32 = lane & 31, hh = lane >> 5, il = r32 >> 2, bq = r32 & 3, iblk = 8 * wave + il;
                const int x0b = 4095 - r32 + 8 * hh, par = x0b & 1;
                const int abase = (par ? 4112 : 0) + ((x0b - par) >> 1);
                for (int c = bid; c < 256; c += G) {
                    __syncthreads();
REPEAT(2)
#pragma unroll 1
                    for (int it = tid; it < 3 * 4 * 512; it += 512) {
                        const int arr = it >> 11, b = (it >> 9) & 3, s8 = (it & 511) * 8, ch = arr * 256 + c;
                        const bf16_t* pp = PT + (size_t)ch * RT + b * SEQ + s8;
                        const u32x4 pv = *(const u32x4*)pp;
                        const float w0 = hcw[ch], w1 = hcw[768 + ch], w2 = hcw[1536 + ch], cb0 = hcb[ch];
                        float p[10];
                        p[0] = s8 > 0 ? bf2f(pp[-1]) : 0.f; p[9] = s8 + 8 < SEQ ? bf2f(pp[8]) : 0.f;
                        p[1] = bflo(pv.x); p[2] = bfhi(pv.x); p[3] = bflo(pv.y); p[4] = bfhi(pv.y); p[5] = bflo(pv.z); p[6] = bfhi(pv.z); p[7] = bflo(pv.w); p[8] = bfhi(pv.w);
                        float z[8];
#pragma unroll
                        for (int j = 0; j < 8; ++j) z[j] = cb0 + w0 * p[j] + w1 * p[j + 1] + w2 * p[j + 2];
                        u32x4 w; w.x = cvt_pk_bf16(z[0], z[1]); w.y = cvt_pk_bf16(z[2], z[3]); w.z = cvt_pk_bf16(z[4], z[5]); w.w = cvt_pk_bf16(z[6], z[7]);
                        *(LAS u32x4*)(ZA + arr * 4 * ZS + HY_ZF(b, s8)) = w;
                    }
#pragma unroll 1
                    for (int o = 0; o < 2; ++o) {
                        const bf16_t* kf = (const bf16_t*)(ws + WS_KFL) + ((size_t)((l * 2 + 0) * 2 + o) * 256 + c) * SEQ;
                        const bf16_t* kb = (const bf16_t*)(ws + WS_KFL) + ((size_t)((l * 2 + 1) * 2 + o) * 256 + c) * SEQ;
                        REPEAT(0) {
                        { unsigned tv[16];
#pragma unroll
                          for (int q = 0; q < 16; ++q) { const int x = tid + 512 * q; tv[q] = x < 4096 ? kf[4095 - x] : (x <= 8190 ? kb[x - 4095] : (bf16_t)0); }
                          PIN16(tv);
#pragma unroll
                          for (int q = 0; q < 16; ++q) R0[tid + 512 * q] = (bf16_t)tv[q]; }
                        __syncthreads();
                        for (int x = tid; x < 8192; x += 512) R1[x] = x < 8191 ? R0[x + 1] : (bf16_t)0;
                        __syncthreads();
                        }
                        const LAS bf16_t* Z = ZA + (o == 0 ? 0 : 4 * ZS) + bq * ZS;
                        typedef float f32x16 __attribute__((ext_vector_type(16)));
                        f32x16 acc0, acc1;
                        REPEAT(3) {
#pragma unroll
                        for (int q = 0; q < 16; ++q) { acc0[q] = 0.f; acc1[q] = 0.f; }
                        const int dlo = 8 * wave - 63, dhi = 8 * wave + 7;
#pragma unroll 1
                        for (int dl = dlo; dl <= dhi; ++dl) {
                            const int j = iblk - dl; const bool ok = (j >= 0) && (j < 64); const int jc = j < 0 ? 0 : (j > 63 ? 63 : j);
                            const LAS bf16_t* zp = Z + jc * 64; const int sw = (jc >> 1) & 1;
                            const LAS unsigned* ap = Rdw + abase - 32 * dl;
                            bf16x8 bf[4];
#pragma unroll
                            for (int kk = 0; kk < 4; ++kk) { bf16x8 t = *(const LAS bf16x8*)(zp + (((2 * kk + hh) ^ sw) << 3)); bf[kk] = ok ? t : (bf16x8){0, 0, 0, 0, 0, 0, 0, 0}; }
#pragma unroll
                            for (int kk = 0; kk < 4; ++kk) {
                                const LAS unsigned* a0 = ap + 8 * kk; const LAS unsigned* a1 = ap - 16 + 8 * kk;
                                u32x4 w0 = {a0[0], a0[1], a0[2], a0[3]}, w1 = {a1[0], a1[1], a1[2], a1[3]};
                                bf16x8 f0, f1; __builtin_memcpy(&f0, &w0, 16); __builtin_memcpy(&f1, &w1, 16);
                                acc0 = __builtin_amdgcn_mfma_f32_32x32x16_bf16(f0, bf[kk], acc0, 0, 0, 0);
                                acc1 = __builtin_amdgcn_mfma_f32_32x32x16_bf16(f1, bf[kk], acc1, 0, 0, 0);
                            }
                        }
                        }
                        const float inv = 1.0f / (nrm[(l * 2 + o) * 256 + c] + 1e-6f), hb = a.in[23][(l * 2 + o) * 256 + c];
                        LAS bf16_t* GI = ZA + (o + 1) * 4 * ZS;
                        const LAS bf16_t* ZI = ZA + (o == 0 ? 0 : 4 * ZS);
#pragma unroll
                        for (int q = 0; q < 16; ++q) {
                            const int a0r = (q & 3) + 8 * (q >> 2) + 4 * hh, t0 = 64 * iblk + a0r, t1 = t0 + 32;
                            const int i0 = HY_ZF(bq, t0), i1 = HY_ZF(bq, t1);
                            const float zv0 = bf2f(ZI[i0]), zv1 = bf2f(ZI[i1]);
                            const float y0 = bf2f(GI[i0]) * (acc0[q] * inv + hb * zv0), y1v = bf2f(GI[i1]) * (acc1[q] * inv + hb * zv1);
                            GI[i0] = f2bf(y0); GI[i1] = f2bf(y1v);
                        }
                        __syncthreads();
                    }
                    for (int it = tid; it < 4 * 512; it += 512) { const int b = it >> 9, s8 = (it & 511) * 8;
                        *(u32x4*)(YT + (size_t)c * RT + b * SEQ + s8) = *(const LAS u32x4*)(ZA + 2 * 4 * ZS + HY_ZF(b, s8)); }
                    REPEAT(1) if (l == 0) {
                        __syncthreads();
                        LAS float* zc = (LAS float*)lds;
                        LAS float* kc = zc + 3072;
                        LAS float* y1c = kc + 1024;
                        for (int it = tid; it < 3072; it += 512) { const int arr = it >> 10, b = (it >> 8) & 3, sx = it & 255, ch = arr * 256 + c;
                            const bf16_t* pp = PT + (size_t)ch * RT + RL + b * CTXL + sx;
                            float z = hcb[ch] + hcw[768 + ch] * bf2f(pp[0]); if (sx > 0) z += hcw[ch] * bf2f(pp[-1]); if (sx + 1 < CTXL) z += hcw[1536 + ch] * bf2f(pp[1]);
                            zc[it] = z; }
                        for (int it = tid; it < 1024; it += 512) { const int o = it >> 9, d = (it & 511) - 256;
                            const bf16_t* kfc = (const bf16_t*)(ws + WS_KFC) + ((size_t)(0 * 2 + o) * 256 + c) * CTXL; const bf16_t* kbc = (const bf16_t*)(ws + WS_KFC) + ((size_t)(1 * 2 + o) * 256 + c) * CTXL;
                            kc[it] = d >= 0 ? bf2f(kfc[d]) : (d > -256 ? bf2f(kbc[-d]) : 0.f); }
                        __syncthreads();
#pragma unroll 1
                        for (int o = 0; o < 2; ++o) {
                            const float inv = 1.0f / (nrm[1024 + o * 256 + c] + 1e-6f), hb = a.in[23][o * 256 + c];
                            for (int it = tid; it < 1024; it += 512) { const int b = it >> 8, t = it & 255;
                                const LAS float* zi = o == 0 ? zc + b * 256 : y1c + b * 256;
                                const LAS float* kk = kc + o * 512 + 256 + t;
                                float acc = 0.f;
#pragma unroll 16
                                for (int sx = 0; sx < CTXL; ++sx) acc += kk[-sx] * zi[sx];
                                const float y = zc[(o + 1) * 1024 + b * 256 + t] * (acc * inv + hb * zi[t]);
                                if (o == 0) y1c[it] = y; else YT[(size_t)c * RT + RL + b * CTXL + t] = f2bf(y); }
                            __syncthreads();
                        }
                    }
                }
#undef HY_ZF
                __syncthreads();
            }
            {
                const pg8::TabSched S{PARTS.p + 18 + l * 3, (const char*)ws, 1, 80, G, bid};
                pg8::EpiS5State E{(float*)(ws + WS_S5S)};
                pg8::gemm_phase<512, 256>(lds, S, E);
            }
        }
        SEAM(P0 + 2);
        if (((PHMASK >> 14) & 1) && IN(P0 + 3)) {
            const int tid = opaque(tid0), lane = tid & 63;
            LAS float* st = (LAS float*)lds;
            const float* S5S = (const float*)(ws + WS_S5S); bf16_t* US = (bf16_t*)(ws + WS_US);
            for (int u = bid; u < 128; u += G) {
                const int d = u & 1, g = (u >> 1) & 15, b = u >> 5;
                __syncthreads();
                for (int i = tid; i < 272 * 32; i += 512) { const int q = i >> 5, c4 = (i & 31) * 4; const int n = q < 16 ? 1024 + 16 * b + q : 256 * b + (q - 16);
                    const f32x4 v = *(const f32x4*)(S5S + ((size_t)g * NCHKP + n) * 256 + d * 128 + c4);
                    st[q * 128 + c4] = v[0]; st[q * 128 + c4 + 1] = v[1]; st[q * 128 + c4 + 2] = v[2]; st[q * 128 + c4 + 3] = v[3]; }
                __syncthreads();
                if (wave == 0) {
                    const float* ab = (const float*)(ws + WS_AB16) + ((size_t)((l * 2 + d) * 16 + g) * 64 + lane) * 2;
                    const float ar = ab[0], ai = ab[1];
                    float hr = 0.f, hi = 0.f;
                    for (int k = 0; k < 272; ++k) {
                        const int q = d == 0 ? k : (k < 16 ? 15 - k : 287 - k);
                        const int n = q < 16 ? 1024 + 16 * b + q : 256 * b + (q - 16);
                        *(unsigned*)(US + ((size_t)g * NCHKP + n) * 512 + 256 + d * 128 + 2 * lane) = cvt_pk_bf16(hr, hi);
                        const float sr = st[q * 128 + 2 * lane], si = st[q * 128 + 2 * lane + 1];
                        const float nr = ar * hr - ai * hi + sr, ni = ar * hi + ai * hr + si;
                        hr = nr; hi = ni;
                    }
                }
            }
            __syncthreads();
            for (int u = bid - 128; u >= 0 && u < 48; u += G) {
                const int cb6 = u % 6, d = (u / 6) & 1, b = u / 12;
                LAS f32x2* sa = (LAS f32x2*)lds;
                const f32x2* LAGG = (const f32x2*)(ws + WS_LAGG); float* HIN = (float*)(ws + WS_LHIN);
                __syncthreads();
                for (int i = tid; i < 272 * 64; i += 512) { const int q = i >> 6, c = i & 63; const int n = q < 16 ? 1024 + 16 * b + q : 256 * b + (q - 16);
                    sa[i] = LAGG[((size_t)n * 2 + d) * 384 + cb6 * 64 + c]; }
                __syncthreads();
                if (wave == 0) {
                    float h = 0.f;
                    for (int k = 0; k < 272; ++k) {
                        const int q = d == 0 ? k : (k < 16 ? 15 - k : 287 - k);
                        const int n = q < 16 ? 1024 + 16 * b + q : 256 * b + (q - 16);
                        HIN[((size_t)n * 2 + d) * 384 + cb6 * 64 + lane] = h;
                        const f32x2 v = sa[q * 64 + lane];
                        h = v[0] * h + v[1];
                    }
                }
            }
            __syncthreads();
        }
        SEAM(P0 + 3);
        if (((PHMASK >> 15) & 1) && IN(P0 + 4)) {
            const pg8::TabSched S{PARTS.p + 19 + l * 3, (const char*)ws, 1, 80, G, bid};
            pg8::EpiS5Main E{(bf16_t*)(ws + WS_GL), PR, a.in[32] + l * 256};
            pg8::gemm_phase<512, 512>(lds, S, E);
            {
                const int tid = opaque(tid0);
                const bf16_t* YT = (const bf16_t*)(ws + WS_YT);
                LAS bf16_t* tl = (LAS bf16_t*)lds;
                const int nrt = nMrow * 4;
                for (int t = bid; t < 4 * nrt; t += G) {
                    const int c0 = (t & 3) * 64, r0 = (t >> 2) * 64;
                    __syncthreads();
                    { const int cc = tid >> 3, r8 = (tid & 7) * 8; *(LAS u32x4*)(tl + cc * 72 + r8) = *(const u32x4*)(YT + (size_t)(c0 + cc) * RT + r0 + r8); }
                    __syncthreads();
                    { const int rr = tid >> 3, c8 = (tid & 7) * 8; unsigned short e[8];
#pragma unroll
                        for (int j = 0; j < 8; ++j) e[j] = tl[(c8 + j) * 72 + rr];
                        u32x4 w; w.x = e[0] | ((unsigned)e[1] << 16); w.y = e[2] | ((unsigned)e[3] << 16); w.z = e[4] | ((unsigned)e[5] << 16); w.w = e[6] | ((unsigned)e[7] << 16);
                        *(u32x4*)(YB + (size_t)(r0 + rr) * YW + YC_B + c0 + c8) = w; }
                }
                __syncthreads();
            }
            {
                const int tid = opaque(tid0);
                const bf16_t* LT = (const bf16_t*)(ws + WS_LT); const float* HIN = (const float*)(ws + WS_LHIN);
                const int nrows = nMrow * 256;
                for (int it = bid * 512 + tid; it < nrows * 48; it += G * 512) {
                    const int r = it / 48, c8 = (it - r * 48) * 8, n = r >> 4;
                    const u32x4 gt = *(const u32x4*)(PR + (size_t)r * LDP + PC_AG + c8);
                    const bf16_t* lt = LT + (size_t)r * 1152 + c8;
                    const u32x4 sv = *(const u32x4*)lt, pf = *(const u32x4*)(lt + 384), pb = *(const u32x4*)(lt + 768);
                    const float* hf = HIN + ((size_t)n * 2 + 0) * 384 + c8; const float* hb = hf + 384;
                    const f32x4 hf0 = *(const f32x4*)hf, hf1 = *(const f32x4*)(hf + 4), hb0 = *(const f32x4*)hb, hb1 = *(const f32x4*)(hb + 4);
                    u32x4 w;
                    w.x = cvt_pk_bf16(gelu_f(bflo(gt.x)) * (bflo(sv.x) + bflo(pf.x) * hf0[0] + bflo(pb.x) * hb0[0]), gelu_f(bfhi(gt.x)) * (bfhi(sv.x) + bfhi(pf.x) * hf0[1] + bfhi(pb.x) * hb0[1]));
                    w.y = cvt_pk_bf16(gelu_f(bflo(gt.y)) * (bflo(sv.y) + bflo(pf.y) * hf0[2] + bflo(pb.y) * hb0[2]), gelu_f(bfhi(gt.y)) * (bfhi(sv.y) + bfhi(pf.y) * hf0[3] + bfhi(pb.y) * hb0[3]));
                    w.z = cvt_pk_bf16(gelu_f(bflo(gt.z)) * (bflo(sv.z) + bflo(pf.z) * hf1[0] + bflo(pb.z) * hb1[0]), gelu_f(bfhi(gt.z)) * (bfhi(sv.z) + bfhi(pf.z) * hf1[1] + bfhi(pb.z) * hb1[1]));
                    w.w = cvt_pk_bf16(gelu_f(bflo(gt.w)) * (bflo(sv.w) + bflo(pf.w) * hf1[2] + bflo(pb.w) * hb1[2]), gelu_f(bfhi(gt.w)) * (bfhi(sv.w) + bfhi(pf.w) * hf1[3] + bfhi(pb.w) * hb1[3]));
                    *(u32x4*)(YB + (size_t)r * YW + YC_A + c8) = w;
                }
            }
        }
        SEAM(P0 + 4);
        if (((PHMASK >> 15) & 1) && IN(P0 + 5)) {
            const pg8::TabSched S{PARTS.p + 20 + l * 3, (const char*)ws, 1, nMrow, G, bid};
            pg8::EpiS5Glu E{YB, (const bf16_t*)(ws + WS_GL), a.in[34] + l * 256};
            pg8::gemm_phase<256, 256>(lds, S, E);
        }
        SEAM(P0 + 5);
        if (((PHMASK >> 3) & 1) && IN(P0 + 6)) {
            const pg8::MergeSched S{(const char*)ws, (long long)WS_YB, (long long)(WS_WL + (size_t)l * SZ_WL + SZ_WINR + SZ_WINHY), 64, G, bid, l == 0 ? 64 : 0};
            pg8::EpiGate E{ws + WS_GQ, UB, (bf16_t*)(ws + WS_MGC)};
            pg8::gemm_phase<1280, 1280>(lds, S, E);
        }
        SEAM(P0 + 6);
        if (((PHMASK >> 4) & 1) && IN(P0 + 7)) {
            const pg8::TabSched S{l == 0 ? PARTS.p + 24 : PARTS.p + 14, (const char*)ws, l == 0 ? 2 : 1, l == 0 ? 256 + 64 : 256, G, bid};
            pg8::EpiRes E{PRE, xlat, xctx, MODL + 2048, (float*)(ws + WS_EXTRA)};
            pg8::gemm_phase<1024, 1024>(lds, S, E);
        }
        SEAM(P0 + 7);
        if (((PHMASK >> 5) & 1) && IN(P0 + 8)) {
            const int lane = opaque(tid0) & 63;
            if (l == 1) convert_tiles(a, JT_MOE, (LAS float*)lds, bid, G);
            const float* lg = a.in[40] + l * D; const float* lb = a.in[41] + l * D;
            const int nrows = nMrow * 256;
            for (int r = bid * 8 + wave; r < nrows; r += G * 8) {
                const float* mv = MODL + (size_t)(r < RL ? (r >> 12) : 4) * 6144;
                RowV pre;
                if (r < RL) pre = row_load(PRE + (size_t)r * D, lane);
                else { const float* pp = (const float*)(ws + WS_EXTRA) + (size_t)(r - RL) * D; const RowV xin = row_load(ctx_in + (size_t)(r - RL) * D, lane), p0 = row_load(pp, lane), p1 = row_load(pp + (size_t)RC * D, lane), p2 = row_load(pp + (size_t)2 * RC * D, lane), p3 = row_load(pp + (size_t)3 * RC * D, lane);
#pragma unroll
                    for (int i = 0; i < 4; ++i) pre.v[i] = xin.v[i] * ALPHA + ((p0.v[i] + p1.v[i]) + (p2.v[i] + p3.v[i])); }
                const RowV x1 = row_affine(row_norm(pre), lg, lb, lane);
                row_store(r < RL ? a.out + (size_t)r * D : XSC + (size_t)(r - RL) * D, lane, x1);
                const RowV u2 = row_modulate(row_norm(x1), mv + 3072, mv + 4096, lane);
                row_store_bf16(UB + (size_t)r * D, lane, u2);
                if (l == 1) {
                    float lg8[8];
#pragma unroll
                    for (int e = 0; e < 8; ++e) lg8[e] = 0.f;
                    f32x4 rw[32];
#pragma unroll
                    for (int q = 0; q < 16; ++q) { const float* wp = a.in[47] + (size_t)(256 * (q >> 2) + 4 * lane + (q & 3)) * 8; rw[2 * q] = *(const f32x4*)wp; rw[2 * q + 1] = *(const f32x4*)(wp + 4); }
                    PIN16(rw); PIN16(rw + 16);
#pragma unroll
                    for (int i = 0; i < 4; ++i)
#pragma unroll
                        for (int j = 0; j < 4; ++j) { const float uv = u2.v[i][j];
                            const f32x4 w0 = rw[2 * (4 * i + j)], w1 = rw[2 * (4 * i + j) + 1];
                            lg8[0] += uv * w0[0]; lg8[1] += uv * w0[1]; lg8[2] += uv * w0[2]; lg8[3] += uv * w0[3]; lg8[4] += uv * w1[0]; lg8[5] += uv * w1[1]; lg8[6] += uv * w1[2]; lg8[7] += uv * w1[3]; }
#pragma unroll
                    for (int e = 0; e < 8; ++e) lg8[e] = wave_sum(lg8[e]);
                    if (lane == 0) {
                        int i1 = 0; float v1 = lg8[0];
#pragma unroll
                        for (int e = 1; e < 8; ++e) if (lg8[e] > v1) { v1 = lg8[e]; i1 = e; }
                        int i2 = 0; float v2 = -3.0e38f;
#pragma unroll
                        for (int e = 0; e < 8; ++e) if (e != i1 && lg8[e] > v2) { v2 = lg8[e]; i2 = e; }
                        const float e2 = expf(v2 - v1), w1 = 1.f / (1.f + e2), w2 = e2 / (1.f + e2);
                        int* tk = (int*)(ws + WS_TOK) + (size_t)r * 8;
                        tk[0] = i1; tk[1] = i2; ((float*)tk)[2] = w1; ((float*)tk)[3] = w2;
                        tk[4] = (int)atomicAdd(ctl + CW_MOECNT + 64 * i1, 1u); tk[5] = (int)atomicAdd(ctl + CW_MOECNT + 64 * i2, 1u);
                    }
                }
            }
        }
        SEAM(P0 + 8);
        if (l == 0) {
            if (((PHMASK >> 6) & 1) && IN(P0 + 9)) {
                const pg8::TabSched S{PARTS.p + 16, (const char*)ws, 1, 68 * 22, G, bid};
                pg8::EpiSwiglu E{(bf16_t*)(ws + WS_H), FF_DENSE, 0};
                pg8::gemm_phase<1024, 1024>(lds, S, E);
            }
            SEAM(P0 + 9);
            if (((PHMASK >> 7) & 1) && IN(P0 + 10)) {
                const pg8::TabSched S{PARTS.p + 26, (const char*)ws, 3, 256 + 48 + 16, G, bid};
                pg8::EpiRes E{PRE, a.out, XSC, MODL + 5120, (float*)(ws + WS_EXTRA)};
                pg8::gemm_phase<FF_DENSE, FF_DENSE>(lds, S, E);
            }
            SEAM(P0 + 10);
            if (((PHMASK >> 8) & 1) && IN(P0 + 11)) {
                const int lane = opaque(tid0) & 63;
                const float* lg = a.in[42]; const float* lb = a.in[43];
                const float* MODN = MOD + (size_t)5 * 6144;
                for (int r = bid * 8 + wave; r < RT; r += G * 8) {
                    const float* mv = MODN + (size_t)(r < RL ? (r >> 12) : 4) * 6144;
                    RowV pre;
                    if (r < RL) pre = row_load(PRE + (size_t)r * D, lane);
                    else { const float* pp = (const float*)(ws + WS_EXTRA) + (size_t)(r - RL) * D; const RowV xin = row_load(XSC + (size_t)(r - RL) * D, lane), p0 = row_load(pp, lane), p1 = row_load(pp + (size_t)RC * D, lane), p2 = row_load(pp + (size_t)2 * RC * D, lane), p3 = row_load(pp + (size_t)3 * RC * D, lane);
#pragma unroll
                        for (int i = 0; i < 4; ++i) pre.v[i] = xin.v[i] * ALPHA + ((p0.v[i] + p1.v[i]) + (p2.v[i] + p3.v[i])); }
                    const RowV x2 = row_affine(row_norm(pre), lg, lb, lane);
                    row_store(r < RL ? a.out + (size_t)r * D : XSC + (size_t)(r - RL) * D, lane, x2);
                    row_store_bf16(UB + (size_t)r * D, lane, row_modulate(row_norm(x2), mv, mv + 1024, lane));
                }
            }
            SEAM(P0 + 11);
        } else {
            bf16_t* AG = (bf16_t*)(ws + WS_AG); float* slotw = (float*)(ws + WS_SLOTW); int* tile_e = (int*)(ws + WS_TILEE);
            if (((PHMASK >> 9) & 1) && IN(P0 + 9)) {
                const int tid = opaque(tid0), lane = tid & 63;
                int ts[NE + 1]; ts[0] = 0;
#pragma unroll
                for (int e = 0; e < NE; ++e) { const unsigned c = __hip_atomic_load(ctl + CW_MOECNT + 64 * e, __ATOMIC_RELAXED, __HIP_MEMORY_SCOPE_AGENT); ts[e + 1] = ts[e] + (int)((c + 255u) >> 8); }
                if (bid == 0) for (int mt = tid; mt < ts[NE]; mt += 512) { int e = 0;
#pragma unroll
                    for (int k = 1; k < NE; ++k) e += (mt >= ts[k]) ? 1 : 0;
                    tile_e[mt] = e; }
                for (int r = bid * 8 + wave; r < RL; r += G * 8) {
                    int* tk = (int*)(ws + WS_TOK) + (size_t)r * 8;
                    const u32x4 v0 = *(const u32x4*)(UB + (size_t)r * D + lane * 16), v1 = *(const u32x4*)(UB + (size_t)r * D + lane * 16 + 8);
#pragma unroll
                    for (int k = 0; k < 2; ++k) {
                        const int e = tk[k], pos = tk[4 + k];
                        int st = 0;
#pragma unroll
                        for (int q = 0; q < NE; ++q) st = (e == q) ? ts[q] : st;
                        const int srow = st * 256 + pos;
                        *(u32x4*)(AG + (size_t)srow * D + lane * 16) = v0; *(u32x4*)(AG + (size_t)srow * D + lane * 16 + 8) = v1;
                        if (lane == 0) { slotw[srow] = ((const float*)tk)[2 + k]; tk[6 + k] = srow; }
                    }
                }
            }
            SEAM(P0 + 9);
            int ttl = 0;
            if (lo <= P0 + 13 && P0 + 10 < hi) {
#pragma unroll
                for (int e = 0; e < NE; ++e) { const unsigned c = __hip_atomic_load(ctl + CW_MOECNT + 64 * e, __ATOMIC_RELAXED, __HIP_MEMORY_SCOPE_AGENT); ttl += (int)((c + 255u) >> 8); }
                ttl = __builtin_amdgcn_readfirstlane(ttl);
            }
#pragma unroll
            for (int pass = 0; pass < 2; ++pass) {
                const int tile0 = pass * MOE_P0; int ntile = pass == 0 ? (ttl < MOE_P0 ? ttl : MOE_P0) : ttl - MOE_P0; ntile = ntile < 0 ? 0 : (ntile > MOE_HCAP ? MOE_HCAP : ntile);
                if (((PHMASK >> 10) & 1) && IN(P0 + 10 + 2 * pass)) {
                    const pg8::MoeSched S{(const char*)AG + (size_t)tile0 * 256 * 1024 * 2, (const char*)(ws + WS_MOEGU), tile_e, 256u * 1024u * 2u, 256u * 1024u * 2u, (size_t)2 * FF_E * 1024 * 2, 28, 16, tile0, ntile, G, bid};
                    pg8::EpiSwiglu E{(bf16_t*)(ws + WS_HM), FF_E, tile0};
                    pg8::gemm_phase<1024, 1024>(lds, S, E);
                }
                SEAM(P0 + 10 + 2 * pass);
                if (((PHMASK >> 11) & 1) && IN(P0 + 11 + 2 * pass)) {
                    pg8::EpiMoeDown E{AG, slotw, (float*)(ws + WS_O2X)};
                    { const int nfull = pass == 0 ? ntile : (ttl < 128 ? ttl : 128) - MOE_P0, nex = pass == 0 ? 0 : ttl - 128;
                        const pg8::MoeTailSched S{(const char*)(ws + WS_HM), (const char*)(ws + WS_MOED), tile_e, tile0, nfull < 0 ? 0 : nfull, nex < 0 ? 0 : nex, G, bid};
                        pg8::gemm_phase<FF_E, FF_E>(lds, S, E); }
                }
                SEAM(P0 + 11 + 2 * pass);
            }
            if (((PHMASK >> 12) & 1) && IN(P0 + 14)) {
                const int lane = opaque(tid0) & 63;
                const float* lg = a.in[42] + D; const float* lb = a.in[43] + D;
                for (int r = bid * 8 + wave; r < RL; r += G * 8) {
                    const int* tk = (const int*)(ws + WS_TOK) + (size_t)r * 8;
                    const int sa = tk[6], sb = tk[7];
                    const bf16_t* oa = AG + (size_t)sa * D; const bf16_t* ob = AG + (size_t)sb * D;
                    const float* gv = MODL + (size_t)(r >> 12) * 6144 + 5120;
                    RowV x1 = row_load(a.out + (size_t)r * D, lane), gq = row_load(gv, lane), pre;
                    u32x2 va[4], vb[4];
#pragma unroll
                    for (int i = 0; i < 4; ++i) { va[i] = *(const u32x2*)(oa + 256 * i + 4 * lane); vb[i] = *(const u32x2*)(ob + 256 * i + 4 * lane); }
                    asm volatile("" : "+v"(va[0]), "+v"(va[1]), "+v"(va[2]), "+v"(va[3]), "+v"(vb[0]), "+v"(vb[1]), "+v"(vb[2]), "+v"(vb[3]), "+v"(x1.v[0]), "+v"(x1.v[1]), "+v"(x1.v[2]), "+v"(x1.v[3]), "+v"(gq.v[0]), "+v"(gq.v[1]), "+v"(gq.v[2]), "+v"(gq.v[3]));
#pragma unroll
                    for (int i = 0; i < 4; ++i) {
                        f32x4 fa = {bflo(va[i].x), bfhi(va[i].x), bflo(va[i].y), bfhi(va[i].y)}, fb = {bflo(vb[i].x), bfhi(vb[i].x), bflo(vb[i].y), bfhi(vb[i].y)};
                        if (sa >= 128 * 256) { const float* px = (const float*)(ws + WS_O2X) + (size_t)(sa - 128 * 256) * D + 256 * i + 4 * lane; fa = (*(const f32x4*)px + *(const f32x4*)(px + (size_t)2048 * D)) + (*(const f32x4*)(px + (size_t)2 * 2048 * D) + *(const f32x4*)(px + (size_t)3 * 2048 * D)); }
                        if (sb >= 128 * 256) { const float* px = (const float*)(ws + WS_O2X) + (size_t)(sb - 128 * 256) * D + 256 * i + 4 * lane; fb = (*(const f32x4*)px + *(const f32x4*)(px + (size_t)2048 * D)) + (*(const f32x4*)(px + (size_t)2 * 2048 * D) + *(const f32x4*)(px + (size_t)3 * 2048 * D)); }
                        pre.v[i] = x1.v[i] * ALPHA + gq.v[i] * (fa + fb); }
                    row_store(a.out + (size_t)r * D, lane, row_affine(row_norm(pre), lg, lb, lane));
                }
            }
        }
    }
#undef IN
#undef SEAM
}

}

extern "C" void kernel_launch(void* const* d_in, const int* in_sizes, int n_in, void* d_out, int out_size, void* d_ws, size_t ws_size, hipStream_t stream) {
    static int grid = 0;
    if (grid == 0) {
        if (n_in != 51 || ws_size < WS_END) { grid = -1; return; }
        int dev = 0, cus = 0;
        if (hipGetDevice(&dev) != hipSuccess || hipDeviceGetAttribute(&cus, hipDeviceAttributeMultiprocessorCount, dev) != hipSuccess) { grid = -1; return; }
        if (hipFuncSetAttribute((const void*)mk_fwd, hipFuncAttributeMaxDynamicSharedMemorySize, LDS_BYTES) != hipSuccess) { grid = -1; return; }
        grid = cus;
    }
    if (grid < 0) return;
    const float* const* in = (const float* const*)d_in;
    unsigned char* ws = (unsigned char*)d_ws;
    (void)hipMemsetAsync(ws + WS_CTL, 0, CTL_BYTES + al256(2 * 5 * 6144 * 4), stream);
    for (int l = 0; l < 2; ++l) (void)hipMemsetAsync(ws + WS_WL + (size_t)l * SZ_WL + SZ_WINR + (size_t)1152 * 1024 * 2, 0, (size_t)128 * 1024 * 2, stream);
    Args a{};
    for (int i = 0; i < 51; ++i) a.in[i] = in[i];
    a.out = (float*)d_out; a.ws = ws;
    int nlaunch = 0;
    auto run1 = [&](int lo, int hi) { a.ph_lo = lo; a.ph_hi = hi; a.bar_region = nlaunch < 5 ? nlaunch : 5; nlaunch++; hipLaunchKernelGGL(mk_fwd, dim3(grid), dim3(512), LDS_BYTES, stream, a); };
    auto run = [&](int lo, int hi) {
#if defined(SPLIT) && SPLIT
        for (int k = lo; k < hi; ++k) { const int q = (k - 1) % NPH_LAYER, l = (k - 1) / NPH_LAYER; if (k > 0 && (q > 14 || (l == 0 && q > 11) || (l == 1 && q == 0))) continue; run1(k, k + 1); }
#else
        run1(lo, hi);
#endif
    };
    run(0, 1 + 2 * NPH_LAYER);
}
```

```cpp
#include <hip/hip_runtime.h>
#include <stdint.h>
#include <math.h>

#define LAS __attribute__((address_space(3)))
typedef unsigned short bf16_t;
typedef short bf16x8 __attribute__((ext_vector_type(8)));
typedef float f32x4 __attribute__((ext_vector_type(4)));
typedef float f32x2 __attribute__((ext_vector_type(2)));
typedef unsigned u32x4 __attribute__((ext_vector_type(4)));
typedef unsigned u32x2 __attribute__((ext_vector_type(2)));

namespace {
constexpr int D = 1024, NB = 4, SEQ = 4096, CTXL = 256;
constexpr int RL = NB * SEQ, RC = NB * CTXL, RT = RL + RC;
constexpr int IN_COLS = 7040;
constexpr int FF_DENSE = 2816, NE = 8, FF_E = 3584;
constexpr float ALPHA = 1.41421356237309515f;
constexpr int LDP = 1792, PC_AG = 0, PC_AC = 384, PC_D = 768, PC_Q = 1024, PC_K = 1408, PC_G = 1792;
constexpr int NPT = 1280, PT_V = 768;
constexpr int YW = 1280, YC_A = 0, YC_B = 384, YC_C = 640, YC_D = 1024;
constexpr int MOE_P0 = 64, MOE_HCAP = 72;
constexpr int MOE_ROWS_MAX = 2 * RL + NE * 256;

constexpr size_t al256(size_t x) { return (x + 255) & ~(size_t)255; }
constexpr size_t WS_CTL = 0, CTL_BYTES = 131072;
constexpr int CW_BAR = 0;
constexpr int CW_MOECNT = 24576;
constexpr int CW_QUEUE = 28672;
constexpr int CW_HYN = 29696;
constexpr size_t WS_MOD = WS_CTL + CTL_BYTES;
constexpr size_t WS_HYN = WS_MOD + al256(2 * 5 * 6144 * 4);
constexpr size_t WS_S5AB = WS_HYN + 4096;
constexpr size_t WS_S5BB = WS_S5AB + 16384;
constexpr size_t WS_AB16 = WS_S5BB + 262144;
constexpr size_t WS_TILEE = WS_AB16 + 32768;
constexpr size_t WS_TOK = WS_TILEE + 1024;
constexpr size_t WS_SLOTW = WS_TOK + (size_t)RL * 32;
constexpr size_t WS_KFL = al256(WS_SLOTW + (size_t)MOE_ROWS_MAX * 4);
constexpr size_t WS_KFC = WS_KFL + (size_t)2 * 1024 * SEQ * 2;
constexpr size_t WS_XSC = WS_KFC + (size_t)1024 * CTXL * 2;
constexpr size_t WS_UB = WS_XSC + (size_t)RC * D * 4;
constexpr size_t SZ_WINR = (size_t)(1792 + 4096) * 1024 * 2, SZ_WINHY = (size_t)NPT * 1024 * 2, SZ_WBR = (size_t)1024 * 1280 * 2, SZ_WOUT = (size_t)1024 * 1024 * 2;
constexpr size_t SZ_WL = SZ_WINR + SZ_WINHY + SZ_WBR + SZ_WOUT;
constexpr size_t WS_WL = WS_UB + (size_t)RT * D * 2;
constexpr size_t WS_FFGU = WS_WL + 2 * SZ_WL;
constexpr size_t WS_FFD = WS_FFGU + (size_t)2 * FF_DENSE * 1024 * 2;
constexpr size_t WS_WGLU = WS_FFD + (size_t)1024 * FF_DENSE * 2;
constexpr size_t WS_OPS = WS_WGLU + (size_t)2 * 256 * 256 * 2;
constexpr size_t WS_OPY = WS_OPS + (size_t)32 * 256 * 256 * 2;
constexpr size_t WS_LW = WS_OPY + (size_t)32 * 256 * 512 * 2;
constexpr size_t WS_PR = WS_LW + (size_t)48 * 4096 * 2;
constexpr size_t WS_PT = WS_PR + (size_t)RT * 5888 * 2;
constexpr size_t WS_GQ = WS_PR + (size_t)RT * LDP * 2;
constexpr size_t WS_YB = WS_PT + (size_t)NPT * RT * 2;
constexpr size_t WS_PRE = WS_YB + (size_t)RT * YW * 2;
constexpr size_t WS_EXTRA = WS_PRE + (size_t)RT * D * 4;
constexpr size_t SZ_EXTRA = (size_t)2 * RT * 384 * 4 + (size_t)RT * 256 * 4;
constexpr size_t WS_END = WS_EXTRA + SZ_EXTRA;
constexpr int NCHK = RT / 16, NCHKP = 1280;
constexpr size_t WS_US = WS_PRE;
constexpr size_t WS_S5S = WS_US + (size_t)16 * NCHKP * 512 * 2;
constexpr size_t WS_GL = WS_S5S + (size_t)16 * NCHKP * 256 * 4;
static_assert(WS_GL + (size_t)RT * 256 * 2 <= WS_EXTRA, "s5 overlay");
constexpr size_t WS_H = WS_PR;
constexpr size_t WS_MOEGU = WS_PR;
constexpr size_t WS_MOED = WS_MOEGU + (size_t)NE * 2 * FF_E * 1024 * 2;
constexpr size_t WS_HM = WS_MOED + (size_t)NE * 1024 * FF_E * 2;
constexpr size_t WS_LT = WS_EXTRA;
constexpr size_t WS_LAGG = WS_LT + (size_t)RT * 3 * 384 * 2;
constexpr size_t WS_LHIN = WS_LAGG + (size_t)NCHK * 2 * 384 * 8;
constexpr size_t WS_YT = WS_LHIN + (size_t)NCHK * 2 * 384 * 4;
static_assert(WS_YT + (size_t)256 * RT * 2 <= WS_EXTRA + SZ_EXTRA, "lru / hyena overlay");
constexpr size_t WS_MGC = WS_EXTRA + (size_t)4 * RC * D * 4;
constexpr size_t WS_AG = WS_EXTRA;
static_assert(WS_HM + (size_t)MOE_HCAP * 256 * FF_E * 2 <= WS_EXTRA, "moe hidden overlay");
constexpr size_t WS_O2X = WS_PRE + ((size_t)32 << 20);
static_assert(WS_HM + (size_t)MOE_HCAP * 256 * FF_E * 2 <= WS_O2X && WS_O2X + (size_t)4 * 2048 * D * 4 <= WS_EXTRA, "moe excess sums");
static_assert((size_t)MOE_ROWS_MAX * 1024 * 2 <= SZ_EXTRA, "moe gather overlay");
static_assert((size_t)RT * FF_DENSE * 2 <= (size_t)RT * 5888 * 2 && WS_GQ + (size_t)RT * 4096 <= WS_PT, "dense hidden overlay / gate bytes");

__device__ __forceinline__ float sigm(float x) { return __builtin_amdgcn_rcpf(1.f + __builtin_amdgcn_exp2f(-1.44269504089f * x)); }
__device__ __forceinline__ float sigm_acc(float x) { return 1.f / (1.f + expf(-x)); }
__device__ __forceinline__ float silu_acc(float x) { return x / (1.f + expf(-x)); }
__device__ __forceinline__ float gelu_t(float x) { return 0.5f * x * (1.f + tanhf(0.7978845608028654f * (x + 0.044715f * x * x * x))); }
__device__ __forceinline__ float gelu_f(float x) { return x * sigm(1.5957691216057308f * (x + 0.044715f * x * x * x)); }
__device__ __forceinline__ float softplus(float x) { return fmaxf(x, 0.f) + log1pf(expf(-fabsf(x))); }
__device__ __forceinline__ float wave_sum(float v) { for (int o = 32; o; o >>= 1) v += __shfl_xor(v, o); return v; }
__device__ __forceinline__ float wave_max(float v) { for (int o = 32; o; o >>= 1) v = fmaxf(v, __shfl_xor(v, o)); return v; }
__device__ __forceinline__ float bf2f(bf16_t b) { return __uint_as_float(((unsigned)b) << 16); }
__device__ __forceinline__ bf16_t f2bf(float f) { unsigned u = __float_as_uint(f); u += 0x7FFFu + ((u >> 16) & 1u); return (bf16_t)(u >> 16); }
__device__ __forceinline__ unsigned cvt_pk_bf16(float lo, float hi) { unsigned r; asm volatile("v_cvt_pk_bf16_f32 %0, %1, %2" : "=v"(r) : "v"(lo), "v"(hi)); return r; }
__device__ __forceinline__ float bflo(unsigned w) { return __uint_as_float(w << 16); }
__device__ __forceinline__ float bfhi(unsigned w) { return __uint_as_float(w & 0xFFFF0000u); }
__device__ __forceinline__ void row_seq(int r, int& start, int& len, int& pos, int& b) {
    if (r < RL) { b = r >> 12; start = b << 12; len = SEQ; pos = r & 4095; }
    else { const int q = r - RL; b = q >> 8; start = RL + (b << 8); len = CTXL; pos = q & 255; }
}

#define XB_TMO      128
#define XB_XCNT(j)  (256  + 64 * (j))
#define XB_XSUB(j)  (1280 + 64 * (j))
#define XB_XGEN(j)  (2304 + 64 * (j))
#define XB_TOP      3328
#define XB_TOPGEN   3392
#define XCD_BAR_WORDS 3456
#define XB_SPIN_CAP (1u << 18)
__device__ __forceinline__ unsigned xb_ld(unsigned* p)              { return __hip_atomic_load(p, __ATOMIC_RELAXED, __HIP_MEMORY_SCOPE_AGENT); }
__device__ __forceinline__ unsigned xb_add(unsigned* p, unsigned v) { return __hip_atomic_fetch_add(p, v, __ATOMIC_RELAXED, __HIP_MEMORY_SCOPE_AGENT); }
__device__ __forceinline__ unsigned xb_xcc_id() { return (unsigned)__builtin_amdgcn_s_getreg((3 << 11) | 20) & 0xFu; }
#define XB_SPIN(cond, bar) do { unsigned _sp = 0; while (cond) { __builtin_amdgcn_s_sleep(1); \
    if ((++_sp & 255u) == 0u) { if (xb_ld(&(bar)[XB_TMO])) break; if (_sp > XB_SPIN_CAP) { atomicAdd(&(bar)[XB_TMO], 1u); break; } } } } while (0)
struct XcdBarrier { unsigned* bar; unsigned x; volatile LAS unsigned* st; };
__device__ __forceinline__ XcdBarrier xcd_barrier_post(unsigned* bar, volatile LAS unsigned* st) {
    XcdBarrier b; b.bar = bar; b.x = xb_xcc_id(); b.st = st;
    if (threadIdx.x == 0) (void)xb_add(&bar[XB_XCNT(b.x)], 1u);
    return b;
}
__device__ __forceinline__ void xcd_barrier_complete(unsigned* bar, unsigned x, unsigned& nloc, unsigned& nx) {
    const unsigned G = gridDim.x * gridDim.y * gridDim.z;
    unsigned sum, cnt, mine, sp = 0u;
    for (;;) {
        sum = 0u; cnt = 0u; mine = 0u;
#pragma unroll
        for (unsigned j = 0; j < 16; ++j) { const unsigned c = xb_ld(&bar[XB_XCNT(j)]); sum += c; cnt += (c > 0u) ? 1u : 0u; mine = (j == x) ? c : mine; }
        if (sum == G) break;
        __builtin_amdgcn_s_sleep(1);
        if ((++sp & 255u) == 0u) { if (xb_ld(&bar[XB_TMO])) break; if (sp > XB_SPIN_CAP) { atomicAdd(&bar[XB_TMO], 1u); break; } }
    }
    nloc = mine > 0u ? mine : 1u; nx = cnt > 0u ? cnt : 1u;
}
__device__ __forceinline__ void xcd_barrier(const XcdBarrier& b) {
    asm volatile("s_waitcnt vmcnt(0)" ::: "memory");
    __syncthreads();
    if (threadIdx.x == 0) {
        unsigned* bar = b.bar;
        __builtin_amdgcn_s_waitcnt(0);
        unsigned nloc = b.st[0], nx = b.st[1];
        if (nloc == 0u) { xcd_barrier_complete(bar, b.x, nloc, nx); b.st[0] = nloc; b.st[1] = nx; }
        const unsigned old = xb_add(&bar[XB_XSUB(b.x)], 1u);
        const unsigned gen = old / nloc;
        if (old + 1u == (gen + 1u) * nloc) {
            __builtin_amdgcn_fence(__ATOMIC_RELEASE, "agent");
            asm volatile("s_waitcnt vmcnt(0)" ::: "memory");
            const unsigned og = xb_add(&bar[XB_TOP], 1u);
            const unsigned tg = og / nx;
            if (og + 1u == (tg + 1u) * nx) xb_add(&bar[XB_TOPGEN], 1u);
            else XB_SPIN(xb_ld(&bar[XB_TOPGEN]) == tg, bar);
            __builtin_amdgcn_fence(__ATOMIC_ACQUIRE, "agent");
            xb_add(&bar[XB_XGEN(b.x)], 1u);
            asm volatile("s_waitcnt vmcnt(0)" ::: "memory");
        } else {
            XB_SPIN(xb_ld(&bar[XB_XGEN(b.x)]) == gen, bar);
            __builtin_amdgcn_fence(__ATOMIC_ACQUIRE, "agent");
            asm volatile("s_waitcnt vmcnt(0)" ::: "memory");
        }
    }
    __syncthreads();
}

namespace pg8 {
constexpr int BM = 256, BK = 64, HALF = 128, HTB = HALF * BK * 2, STAGE_BYTES = 8 * HTB, NXCD = 8, WGM = 8;
__host__ __device__ __forceinline__ int lds_byte(int r, int c) { const int st = (r >> 4) * 2 + (c >> 5), rr = r & 15, cc = c & 31, ob = rr * 64 + cc * 2; return st * 1024 + (ob ^ (((ob >> 9) & 1) << 5)); }
__host__ __device__ __forceinline__ void stage_rc(int b, int& R, int& C) { const int st = b / 1024, sb = b % 1024, swz = sb ^ (((sb >> 9) & 1) << 5); R = (st >> 1) * 16 + swz / 64; C = (st & 1) * 32 + (swz % 64) / 2; }
__host__ __device__ __forceinline__ int perm32(int rho) { const int n = rho >> 4, i = rho & 15; return 8 * (i >> 2) + 4 * n + (i & 3); }

struct Unit { const char* a; const char* b; int nt; int pm, pn, kind; };

__device__ __forceinline__ void rect_map(int wgid, int nM, int nN, int& pm, int& pn) {
    const int nwg = nM * nN;
    { const int q = nwg / NXCD, r = nwg % NXCD, xcd = wgid % NXCD, off = wgid / NXCD; wgid = (xcd < r ? xcd * (q + 1) : r * (q + 1) + (xcd - r) * q) + off; }
    const int nig = WGM * nN, gid = wgid / nig, fm = gid * WGM, gsz = (nM - fm) < WGM ? (nM - fm) : WGM;
    pm = fm + ((wgid % nig) % gsz); pn = (wgid % nig) / gsz;
}

template <int lda, int ldb, class Epi, class Sched>
__device__ __forceinline__ void gemm_phase(LAS unsigned char* lds, const Sched& S, const Epi& E) {
    int tid_ = threadIdx.x; asm volatile("" : "+v"(tid_));
    const int tid = tid_, wid = __builtin_amdgcn_readfirstlane(tid >> 6), lane = tid & 63, wr = wid >> 2, wc = wid & 3, fr = lane & 15, fq = lane >> 4;
    unsigned voffA[2], voffB[2];
#pragma unroll
    for (int i = 0; i < 2; ++i) { int R, C; stage_rc(tid * 16 + i * 8192, R, C); const int Rb = (R & ~31) + perm32(R & 31);
        voffA[i] = (unsigned)(R * lda + C) * 2u; voffB[i] = (unsigned)(Rb * ldb + C) * 2u; }
    const size_t kstep = (size_t)(BK * 2);
    const size_t hstepA = (size_t)HALF * lda * 2, hstepB = (size_t)HALF * ldb * 2;
    const unsigned ldsw = (unsigned)wid * 1024u;
    const int aoff = lds_byte(wr * 64 + fr, fq * 8), boff = lds_byte(wc * 32 + fr, fq * 8);
#define PG8_SA(b, h) (((b) * 2 + (h)) * HTB)
#define PG8_SB(b, h) ((4 + (b) * 2 + (h)) * HTB)
#define PG8_STAGE(bufoff, gbase, voff) do { _Pragma("unroll") for (int _i = 0; _i < 2; ++_i) \
        __builtin_amdgcn_global_load_lds((const unsigned*)((const char*)(gbase) + (voff)[_i]), (LAS unsigned*)(lds + (bufoff) + ldsw + _i * 8192), 16, 0, 0); } while (0)
#define PG8_LDA(dst, b, h) do { _Pragma("unroll") for (int m = 0; m < 4; ++m) _Pragma("unroll") for (int k = 0; k < 2; ++k) dst[m][k] = *(const LAS bf16x8*)(lds + PG8_SA(b, h) + aoff + m * 2048 + k * 1024); } while (0)
#define PG8_LDB(dst, b, h) do { _Pragma("unroll") for (int n = 0; n < 2; ++n) _Pragma("unroll") for (int k = 0; k < 2; ++k) dst[n][k] = *(const LAS bf16x8*)(lds + PG8_SB(b, h) + boff + n * 2048 + k * 1024); } while (0)
#define PG8_MMA(ai, bj, At, Bt) do { __builtin_amdgcn_s_setprio(1); _Pragma("unroll") for (int m = 0; m < 4; ++m) _Pragma("unroll") for (int n = 0; n < 2; ++n) _Pragma("unroll") for (int k = 0; k < 2; ++k) \
        acc[ai][bj][m][n] = __builtin_amdgcn_mfma_f32_16x16x32_bf16(Bt[n][k], At[m][k], acc[ai][bj][m][n], 0, 0, 0); __builtin_amdgcn_s_setprio(0); } while (0)
#define PG8_WAIT_V(n) asm volatile("s_waitcnt vmcnt(" #n ")" ::: "memory")
#define PG8_WAIT_L(n) asm volatile("s_waitcnt lgkmcnt(" #n ")" ::: "memory")
#define PG8_BAR __builtin_amdgcn_s_barrier()
#define PG8_SCHED __builtin_amdgcn_sched_barrier(0)
    Unit cur, nxt; int ui = 0;
    if (!S.next(0, cur)) return;
    f32x4 acc[2][2][4][2];
#pragma unroll
    for (int a = 0; a < 2; ++a)
#pragma unroll
        for (int b = 0; b < 2; ++b)
#pragma unroll
            for (int m = 0; m < 4; ++m)
#pragma unroll
                for (int n = 0; n < 2; ++n) acc[a][b][m][n] = (f32x4){0.f, 0.f, 0.f, 0.f};
    bf16x8 At[4][2], B0[2][2], B1[2][2];
    const char* cA = cur.a; const char* cB = cur.b;
    PG8_STAGE(PG8_SB(0, 0), cB, voffB); PG8_STAGE(PG8_SA(0, 0), cA, voffA); PG8_STAGE(PG8_SB(0, 1), cB + hstepB, voffB); PG8_STAGE(PG8_SA(0, 1), cA + hstepA, voffA);
    if (wr == 1) PG8_BAR;
    PG8_WAIT_V(4); PG8_BAR;
    PG8_STAGE(PG8_SB(1, 0), cB + kstep, voffB); PG8_STAGE(PG8_SA(1, 0), cA + kstep, voffA); PG8_STAGE(PG8_SB(1, 1), cB + hstepB + kstep, voffB);
    PG8_WAIT_V(6); PG8_BAR;
    for (;;) {
        const bool has_next = S.next(ui + 1, nxt);
        const char* nA = has_next ? nxt.a : cA; const char* nB = has_next ? nxt.b : cB;
        const int nt = cur.nt;
        for (int t = 0; t < nt; t += 2) {
            const bool last = (t == nt - 2);
            const char* a1 = cA + (size_t)(t + 1) * kstep;
            const char* a2 = last ? nA : cA + (size_t)(t + 2) * kstep; const char* b2 = last ? nB : cB + (size_t)(t + 2) * kstep;
            const char* a3 = a2 + kstep; const char* b3 = b2 + kstep;
            PG8_LDB(B0, 0, 0); PG8_SCHED; PG8_LDA(At, 0, 0); PG8_STAGE(PG8_SA(1, 1), a1 + hstepA, voffA);
            PG8_WAIT_L(8); PG8_BAR; PG8_WAIT_L(0); PG8_MMA(0, 0, At, B0); PG8_BAR; PG8_SCHED;
            PG8_LDB(B1, 0, 1); PG8_STAGE(PG8_SB(0, 0), b2, voffB);
            PG8_BAR; PG8_WAIT_L(0); PG8_MMA(0, 1, At, B1); PG8_BAR;
            PG8_LDA(At, 0, 1); PG8_STAGE(PG8_SA(0, 0), a2, voffA);
            PG8_BAR; PG8_WAIT_L(0); PG8_MMA(1, 0, At, B0); PG8_BAR; PG8_SCHED;
            PG8_STAGE(PG8_SB(0, 1), b2 + hstepB, voffB);
            PG8_WAIT_V(6); PG8_BAR; PG8_MMA(1, 1, At, B1); PG8_BAR;
            PG8_LDB(B0, 1, 0); PG8_SCHED; PG8_LDA(At, 1, 0); PG8_STAGE(PG8_SA(0, 1), a2 + hstepA, voffA);
            PG8_WAIT_L(8); PG8_BAR; PG8_WAIT_L(0); PG8_MMA(0, 0, At, B0); PG8_BAR; PG8_SCHED;
            PG8_LDB(B1, 1, 1); PG8_STAGE(PG8_SB(1, 0), b3, voffB);
            PG8_BAR; PG8_WAIT_L(0); PG8_MMA(0, 1, At, B1); PG8_BAR;
            PG8_LDA(At, 1, 1); PG8_STAGE(PG8_SA(1, 0), a3, voffA);
            PG8_BAR; PG8_WAIT_L(0); PG8_MMA(1, 0, At, B0); PG8_BAR; PG8_SCHED;
            PG8_STAGE(PG8_SB(1, 1), b3 + hstepB, voffB);
            PG8_WAIT_V(6); PG8_BAR; PG8_MMA(1, 1, At, B1); PG8_BAR;
        }
        E(acc, cur, wr, wc, fr, fq);
        if (!has_next) break;
#pragma unroll
        for (int a = 0; a < 2; ++a)
#pragma unroll
            for (int b = 0; b < 2; ++b)
#pragma unroll
                for (int m = 0; m < 4; ++m)
#pragma unroll
                    for (int n = 0; n < 2; ++n) acc[a][b][m][n] = (f32x4){0.f, 0.f, 0.f, 0.f};
        cur = nxt; cA = nA; cB = nB; ++ui;
    }
    PG8_WAIT_V(0);
    if (wr == 0) PG8_BAR;
    PG8_BAR;
#undef PG8_SA
#undef PG8_SB
#undef PG8_STAGE
#undef PG8_LDA
#undef PG8_LDB
#undef PG8_MMA
#undef PG8_WAIT_V
#undef PG8_WAIT_L
#undef PG8_BAR
#undef PG8_SCHED
}

struct PartC { long long aOff, bOff; unsigned aStep, bStep; int nM, nN, nt, kind, start, nGrp; unsigned aGrp, bGrp; };
struct TabSched {
    const PartC* parts; const char* ws; int np, total, G, c;
    __device__ __forceinline__ bool next(int i, Unit& u) const {
        const int L = i * G + c; if (L >= total) return false;
        int q = 0;
#pragma unroll
        for (int k = 1; k < 4; ++k) if (k < np && L >= parts[k].start) q = k;
        const PartC P = parts[q];
        const int per = P.nM * P.nN, idx = L - P.start, grp = idx / per;
        int pm, pn; rect_map(idx - grp * per, P.nM, P.nN, pm, pn);
        u.a = ws + P.aOff + (size_t)grp * P.aGrp + (size_t)pm * P.aStep; u.b = ws + P.bOff + (size_t)grp * P.bGrp + (size_t)pn * P.bStep; u.nt = P.nt; u.pm = pm; u.pn = pn; u.kind = P.kind + grp; return true;
    }
};
struct MergeSched {
    const char* ws; long long aOff, bOff; int nM, G, c;
    int nCtx;
    __device__ __forceinline__ bool next(int i, Unit& u) const {
        int T = (i >> 2) * G + c, br = i & 3; bool ctxu = false;
        if (T >= nM * 4) {
            const int j = (i - 4 * ((nM * 4 - c + G - 1) / G)) * G + c;
            if (j < 0 || j >= nCtx) return false;
            T = nM * 4 + (j >> 2); br = j & 3; ctxu = true;
        }
        int pm, pn;
        if (!ctxu) rect_map(T, nM, 4, pm, pn); else { const int t = T - nM * 4; pm = nM + (t >> 2); pn = t & 3; }
        const int ko = br == 0 ? 0 : (br == 1 ? 384 : (br == 2 ? 640 : 1024));
        u.a = ws + aOff + (size_t)pm * (256u * 1280u * 2u) + ko * 2; u.b = ws + bOff + (size_t)pn * (256u * 1280u * 2u) + ko * 2; u.nt = (br & 1) ? 4 : 6; u.pm = pm; u.pn = pn; u.kind = ctxu ? 4 + br : br; return true;
    }
};
struct MoeSched {
    const char* A; const char* B; const int* tile_e; unsigned aStep, bStep; size_t bExp; int nN, nt, tile0, ntile, G, c;
    __device__ __forceinline__ bool next(int i, Unit& u) const {
        const int L = i * G + c; if (L >= ntile * nN) return false;
        const int mt = tile0 + L / nN, pn = L % nN;
        const int e = __builtin_amdgcn_readfirstlane(__hip_atomic_load(tile_e + mt, __ATOMIC_RELAXED, __HIP_MEMORY_SCOPE_AGENT));
        u.a = A + (size_t)(mt - tile0) * aStep; u.b = B + (size_t)e * bExp + (size_t)pn * bStep; u.nt = nt; u.pm = mt; u.pn = pn; u.kind = e; return true;
    }
};

struct MoeTailSched {
    const char* A; const char* B; const int* tile_e; int tile0, nfull, nex, G, c;
    __device__ __forceinline__ bool next(int i, Unit& u) const {
        const int L = i * G + c; int mt, pn, nt = 56, flag = 0; size_t koff = 0;
        if (L < nfull * 4) { mt = tile0 + (L >> 2); pn = L & 3; }
        else { const int idx = L - nfull * 4; if (idx >= nex * 16) return false; const int sp = idx & 3, tu = idx >> 2; mt = 128 + (tu >> 2); pn = tu & 3; nt = 14; koff = (size_t)sp * 14 * 128; flag = 8 + 16 * sp; }
        const int e = __builtin_amdgcn_readfirstlane(__hip_atomic_load(tile_e + mt, __ATOMIC_RELAXED, __HIP_MEMORY_SCOPE_AGENT));
        u.a = A + (size_t)(mt - tile0) * (256u * (unsigned)FF_E * 2u) + koff; u.b = B + (size_t)e * ((size_t)1024 * FF_E * 2) + (size_t)pn * (256u * (unsigned)FF_E * 2u) + koff;
        u.nt = nt; u.pm = mt; u.pn = pn; u.kind = e | flag; return true;
    }
};

#define EPI_ROWS(u) const int row0 = (u).pm * BM + wr * 64 + fr, colt = wc * 32 + 8 * fq
struct EpiProj {
    bf16_t* PRp; bf16_t* PTp; bf16_t* USp; int sig_from; unsigned char* GQp;
    __device__ __forceinline__ void operator()(const f32x4 (&acc)[2][2][4][2], const Unit& u, int wr, int wc, int fr, int fq) const {
        EPI_ROWS(u);
        bf16_t* base = u.kind == 1 ? PTp : PRp; const int ldc = u.kind == 1 ? RT : LDP; const bool sg = (u.kind == 0 && u.pn >= sig_from);
        if (sg) {
#pragma unroll
            for (int ai = 0; ai < 2; ++ai)
#pragma unroll
                for (int m = 0; m < 4; ++m) { unsigned char* rowp = GQp + (size_t)(row0 + ai * HALF + m * 16) * 4096 + (u.pn - sig_from) * BM + colt;
#pragma unroll
                    for (int bj = 0; bj < 2; ++bj) { const f32x4 v0 = acc[ai][bj][m][0], v1 = acc[ai][bj][m][1];
                        unsigned lo = 0u, hi = 0u;
                        lo = __builtin_amdgcn_cvt_pk_u8_f32(sigm(v0[0]) * 255.0f, 0, lo); lo = __builtin_amdgcn_cvt_pk_u8_f32(sigm(v0[1]) * 255.0f, 1, lo); lo = __builtin_amdgcn_cvt_pk_u8_f32(sigm(v0[2]) * 255.0f, 2, lo); lo = __builtin_amdgcn_cvt_pk_u8_f32(sigm(v0[3]) * 255.0f, 3, lo);
                        hi = __builtin_amdgcn_cvt_pk_u8_f32(sigm(v1[0]) * 255.0f, 0, hi); hi = __builtin_amdgcn_cvt_pk_u8_f32(sigm(v1[1]) * 255.0f, 1, hi); hi = __builtin_amdgcn_cvt_pk_u8_f32(sigm(v1[2]) * 255.0f, 2, hi); hi = __builtin_amdgcn_cvt_pk_u8_f32(sigm(v1[3]) * 255.0f, 3, hi);
                        *(u32x2*)(rowp + bj * HALF) = (u32x2){lo, hi}; } }
            return;
        }
#pragma unroll
        for (int ai = 0; ai < 2; ++ai)
#pragma unroll
            for (int m = 0; m < 4; ++m) { bf16_t* rowp = base + (size_t)(row0 + ai * HALF + m * 16) * ldc + u.pn * BM + colt;
#pragma unroll
                for (int bj = 0; bj < 2; ++bj) { f32x4 v0 = acc[ai][bj][m][0], v1 = acc[ai][bj][m][1];
                    if (sg) {
#pragma unroll
                        for (int j = 0; j < 4; ++j) { v0[j] = sigm(v0[j]); v1[j] = sigm(v1[j]); } }
                    u32x4 w; w.x = cvt_pk_bf16(v0[0], v0[1]); w.y = cvt_pk_bf16(v0[2], v0[3]); w.z = cvt_pk_bf16(v1[0], v1[1]); w.w = cvt_pk_bf16(v1[2], v1[3]);
                    *(u32x4*)(rowp + bj * HALF) = w;
                    if (u.kind == 0 && u.pn == 3) { const int r = row0 + ai * HALF + m * 16, cc = colt + bj * HALF;
                        *(u32x4*)(USp + ((size_t)(cc >> 4) * NCHKP + (r >> 4)) * 512 + (r & 15) * 16 + (cc & 15)) = w; } } }
    }
};
struct EpiS5State {
    float* Sp;
    __device__ __forceinline__ void operator()(const f32x4 (&acc)[2][2][4][2], const Unit& u, int wr, int wc, int fr, int fq) const {
        EPI_ROWS(u);
#pragma unroll
        for (int ai = 0; ai < 2; ++ai)
#pragma unroll
            for (int m = 0; m < 4; ++m) { float* op = Sp + ((size_t)u.kind * NCHKP + row0 + ai * HALF + m * 16) * 256 + colt;
#pragma unroll
                for (int bj = 0; bj < 2; ++bj)
#pragma unroll
                    for (int n = 0; n < 2; ++n) *(f32x4*)(op + bj * HALF + 4 * n) = acc[ai][bj][m][n]; }
    }
};
struct EpiS5Main {
    bf16_t* GLp; const bf16_t* PRp; const float* dvec;
    __device__ __forceinline__ void operator()(const f32x4 (&acc)[2][2][4][2], const Unit& u, int wr, int wc, int fr, int fq) const {
        EPI_ROWS(u);
        const int cl = 16 * u.kind + (colt & 15);
        const f32x4 d0 = *(const f32x4*)(dvec + cl), d1 = *(const f32x4*)(dvec + cl + 4);
#pragma unroll
        for (int ai = 0; ai < 2; ++ai) {
            u32x4 uq[4][2];
#pragma unroll
            for (int m = 0; m < 4; ++m) { const int n = row0 + ai * HALF + m * 16;
#pragma unroll
                for (int bj = 0; bj < 2; ++bj) { const int c = colt + bj * HALF, r = 16 * (n < NCHK ? n : 0) + (c >> 4); uq[m][bj] = *(const u32x4*)(PRp + (size_t)r * LDP + PC_D + cl); } }
#pragma unroll
            for (int m = 0; m < 4; ++m) { const int n = row0 + ai * HALF + m * 16; if (n >= NCHK) continue;
#pragma unroll
                for (int bj = 0; bj < 2; ++bj) { const int c = colt + bj * HALF, r = 16 * n + (c >> 4); const u32x4 uv = uq[m][bj];
                    const f32x4 v0 = acc[ai][bj][m][0], v1 = acc[ai][bj][m][1];
                    u32x4 w; w.x = cvt_pk_bf16(gelu_f(v0[0] + d0[0] * bflo(uv.x)), gelu_f(v0[1] + d0[1] * bfhi(uv.x))); w.y = cvt_pk_bf16(gelu_f(v0[2] + d0[2] * bflo(uv.y)), gelu_f(v0[3] + d0[3] * bfhi(uv.y)));
                    w.z = cvt_pk_bf16(gelu_f(v1[0] + d1[0] * bflo(uv.z)), gelu_f(v1[1] + d1[1] * bfhi(uv.z))); w.w = cvt_pk_bf16(gelu_f(v1[2] + d1[2] * bflo(uv.w)), gelu_f(v1[3] + d1[3] * bfhi(uv.w)));
                    *(u32x4*)(GLp + (size_t)r * 256 + cl) = w; } }
        }
    }
};
struct EpiS5Glu {
    bf16_t* YBp; const bf16_t* GLp; const float* bvec;
    __device__ __forceinline__ void operator()(const f32x4 (&acc)[2][2][4][2], const Unit& u, int wr, int wc, int fr, int fq) const {
        EPI_ROWS(u);
        f32x4 bq[2][2];
#pragma unroll
        for (int bj = 0; bj < 2; ++bj) { bq[bj][0] = *(const f32x4*)(bvec + colt + bj * HALF); bq[bj][1] = *(const f32x4*)(bvec + colt + bj * HALF + 4); }
#pragma unroll
        for (int ai = 0; ai < 2; ++ai) {
            u32x4 gq[4][2];
#pragma unroll
            for (int m = 0; m < 4; ++m)
#pragma unroll
                for (int bj = 0; bj < 2; ++bj) gq[m][bj] = *(const u32x4*)(GLp + (size_t)(row0 + ai * HALF + m * 16) * 256 + colt + bj * HALF);
#pragma unroll
            for (int m = 0; m < 4; ++m) { const int r = row0 + ai * HALF + m * 16;
#pragma unroll
                for (int bj = 0; bj < 2; ++bj) { const int c = colt + bj * HALF; const u32x4 gv = gq[m][bj];
                    const f32x4 v0 = acc[ai][bj][m][0] + bq[bj][0], v1 = acc[ai][bj][m][1] + bq[bj][1];
                    u32x4 w; w.x = cvt_pk_bf16(bflo(gv.x) * sigm(v0[0]), bfhi(gv.x) * sigm(v0[1])); w.y = cvt_pk_bf16(bflo(gv.y) * sigm(v0[2]), bfhi(gv.y) * sigm(v0[3]));
                    w.z = cvt_pk_bf16(bflo(gv.z) * sigm(v1[0]), bfhi(gv.z) * sigm(v1[1])); w.w = cvt_pk_bf16(bflo(gv.w) * sigm(v1[2]), bfhi(gv.w) * sigm(v1[3]));
                    *(u32x4*)(YBp + (size_t)r * YW + YC_D + c) = w; } }
        }
    }
};
struct EpiGate {
    const unsigned char* GQp; bf16_t* MGp; bf16_t* MGCp;
    __device__ __forceinline__ void operator()(const f32x4 (&acc)[2][2][4][2], const Unit& u, int wr, int wc, int fr, int fq) const {
        EPI_ROWS(u);
        const int br = u.kind & 3; const bool acc_prev = (u.kind >= 1 && u.kind <= 3);
        bf16_t* OB = u.kind >= 4 ? MGCp + (size_t)br * RC * D - (size_t)RL * D : MGp;
        if (acc_prev) { __builtin_amdgcn_fence(__ATOMIC_ACQUIRE, "agent"); asm volatile("s_waitcnt vmcnt(0)" ::: "memory"); }
#pragma unroll
        for (int am = 0; am < 4; ++am) { const int ai = am >> 1, m0 = (am & 1) * 2;
            u32x2 g[4][2]; u32x4 p[4][2];
#pragma unroll
            for (int m = m0; m < m0 + 2; ++m) { const int r = row0 + ai * HALF + m * 16;
#pragma unroll
                for (int bj = 0; bj < 2; ++bj) { g[m][bj] = *(const u32x2*)(GQp + (size_t)r * 4096 + br * 1024 + u.pn * BM + colt + bj * HALF);
                    p[m][bj] = acc_prev ? *(const u32x4*)(MGp + (size_t)r * D + u.pn * BM + colt + bj * HALF) : (u32x4){0u, 0u, 0u, 0u}; } }
#pragma unroll
            for (int m = m0; m < m0 + 2; ++m) { const int r = row0 + ai * HALF + m * 16; bf16_t* mp = OB + (size_t)r * D + u.pn * BM + colt;
#pragma unroll
                for (int bj = 0; bj < 2; ++bj) { const f32x4 v0 = acc[ai][bj][m][0] * (1.0f / 255.0f), v1 = acc[ai][bj][m][1] * (1.0f / 255.0f); const u32x2 gg = g[m][bj]; const u32x4 pp = p[m][bj];
                    const f32x4 o0 = {v0[0] * (float)(gg.x & 255u) + bflo(pp.x), v0[1] * (float)((gg.x >> 8) & 255u) + bfhi(pp.x), v0[2] * (float)((gg.x >> 16) & 255u) + bflo(pp.y), v0[3] * (float)(gg.x >> 24) + bfhi(pp.y)};
                    const f32x4 o1 = {v1[0] * (float)(gg.y & 255u) + bflo(pp.z), v1[1] * (float)((gg.y >> 8) & 255u) + bfhi(pp.z), v1[2] * (float)((gg.y >> 16) & 255u) + bflo(pp.w), v1[3] * (float)(gg.y >> 24) + bfhi(pp.w)};
                    u32x4 w; w.x = cvt_pk_bf16(o0[0], o0[1]); w.y = cvt_pk_bf16(o0[2], o0[3]); w.z = cvt_pk_bf16(o1[0], o1[1]); w.w = cvt_pk_bf16(o1[2], o1[3]);
                    *(u32x4*)(mp + bj * HALF) = w; } }
        }
    }
};
struct EpiRes {
    float* PREp; const float* xlat; const float* xctx; const float* gvec;
    float* partp;
    __device__ __forceinline__ void operator()(const f32x4 (&acc)[2][2][4][2], const Unit& u, int wr, int wc, int fr, int fq) const {
        EPI_ROWS(u);
        if (u.kind != 0) {
            f32x4 gc[2][2];
#pragma unroll
            for (int bj = 0; bj < 2; ++bj)
#pragma unroll
                for (int n = 0; n < 2; ++n) gc[bj][n] = *(const f32x4*)(gvec + (size_t)4 * 6144 + u.pn * BM + colt + bj * HALF + 4 * n);
#pragma unroll
            for (int ai = 0; ai < 2; ++ai)
#pragma unroll
                for (int m = 0; m < 4; ++m) { const int r = row0 + ai * HALF + m * 16; const int c0 = u.pn * BM + colt;
                    float* op = partp + ((size_t)(u.kind - 1) * RC + r) * D + c0;
#pragma unroll
                    for (int bj = 0; bj < 2; ++bj)
#pragma unroll
                        for (int n = 0; n < 2; ++n) *(f32x4*)(op + bj * HALF + 4 * n) = gc[bj][n] * acc[ai][bj][m][n]; }
            return;
        }
        const int c0 = u.pn * BM + colt, rt0 = u.pm * BM;
        const float* gp = gvec + (size_t)(rt0 < RL ? (rt0 >> 12) : 4) * 6144 + c0;
        f32x4 gq[2][2];
#pragma unroll
        for (int bj = 0; bj < 2; ++bj)
#pragma unroll
            for (int n = 0; n < 2; ++n) gq[bj][n] = *(const f32x4*)(gp + bj * HALF + 4 * n);
#pragma unroll
        for (int am = 0; am < 4; ++am) { const int ai = am >> 1, m0 = (am & 1) * 2;
            f32x4 xq[4][2][2];
#pragma unroll
            for (int m = m0; m < m0 + 2; ++m) { const int r = row0 + ai * HALF + m * 16;
                const float* xin = (r < RL ? xlat + (size_t)r * D : xctx + (size_t)(r - RL) * D) + c0;
#pragma unroll
                for (int bj = 0; bj < 2; ++bj)
#pragma unroll
                    for (int n = 0; n < 2; ++n) xq[m][bj][n] = *(const f32x4*)(xin + bj * HALF + 4 * n); }
#pragma unroll
            for (int m = m0; m < m0 + 2; ++m) { const int r = row0 + ai * HALF + m * 16; float* op = PREp + (size_t)r * D + c0;
#pragma unroll
                for (int bj = 0; bj < 2; ++bj)
#pragma unroll
                    for (int n = 0; n < 2; ++n) *(f32x4*)(op + bj * HALF + 4 * n) = xq[m][bj][n] * ALPHA + gq[bj][n] * acc[ai][bj][m][n]; }
        }
    }
};
struct EpiSwiglu {
    bf16_t* Hp; int ldh; int row_sub;
    __device__ __forceinline__ void operator()(const f32x4 (&acc)[2][2][4][2], const Unit& u, int wr, int wc, int fr, int fq) const {
        const int row0 = (u.pm - row_sub) * BM + wr * 64 + fr, colt = wc * 32 + 8 * fq;
#pragma unroll
        for (int ai = 0; ai < 2; ++ai)
#pragma unroll
            for (int m = 0; m < 4; ++m) { bf16_t* rowp = Hp + (size_t)(row0 + ai * HALF + m * 16) * ldh + u.pn * HALF + colt;
                f32x4 h0, h1;
#pragma unroll
                for (int j = 0; j < 4; ++j) { const float g0 = acc[ai][0][m][0][j], g1 = acc[ai][0][m][1][j];
                    h0[j] = g0 * sigm(g0) * acc[ai][1][m][0][j]; h1[j] = g1 * sigm(g1) * acc[ai][1][m][1][j]; }
                u32x4 w; w.x = cvt_pk_bf16(h0[0], h0[1]); w.y = cvt_pk_bf16(h0[2], h0[3]); w.z = cvt_pk_bf16(h1[0], h1[1]); w.w = cvt_pk_bf16(h1[2], h1[3]);
                *(u32x4*)rowp = w; }
    }
};
struct EpiMoeDown {
    bf16_t* O2; const float* slotw; float* O2X;
    __device__ __forceinline__ void operator()(const f32x4 (&acc)[2][2][4][2], const Unit& u, int wr, int wc, int fr, int fq) const {
        EPI_ROWS(u);
        float wq[2][4];
        if (u.kind & 8) {
            const int sp = (u.kind >> 4) & 3;
#pragma unroll
            for (int ai = 0; ai < 2; ++ai)
#pragma unroll
                for (int m = 0; m < 4; ++m) { const int r = row0 + ai * HALF + m * 16; const float w8 = slotw[r]; float* op = O2X + ((size_t)sp * 2048 + (r - 128 * 256)) * D + u.pn * BM + colt;
#pragma unroll
                    for (int bj = 0; bj < 2; ++bj)
#pragma unroll
                        for (int n = 0; n < 2; ++n) *(f32x4*)(op + bj * HALF + 4 * n) = acc[ai][bj][m][n] * w8; }
            return;
        }
#pragma unroll
        for (int ai = 0; ai < 2; ++ai)
#pragma unroll
            for (int m = 0; m < 4; ++m) wq[ai][m] = slotw[row0 + ai * HALF + m * 16];
#pragma unroll
        for (int ai = 0; ai < 2; ++ai)
#pragma unroll
            for (int m = 0; m < 4; ++m) { const int r = row0 + ai * HALF + m * 16; const float w8 = wq[ai][m];
                bf16_t* rowp = O2 + (size_t)r * D + u.pn * BM + colt;
#pragma unroll
                for (int bj = 0; bj < 2; ++bj) { const f32x4 v0 = acc[ai][bj][m][0] * w8, v1 = acc[ai][bj][m][1] * w8;
                    u32x4 w; w.x = cvt_pk_bf16(v0[0], v0[1]); w.y = cvt_pk_bf16(v0[2], v0[3]); w.z = cvt_pk_bf16(v1[0], v1[1]); w.w = cvt_pk_bf16(v1[2], v1[3]);
                    *(u32x4*)(rowp + bj * HALF) = w; } }
    }
};
}

struct Job { int in_idx; int src_off; int lds; int K; int N; long long dst_off; int ldd; int kcol0; int G, GS, R0; int tile0; };
struct JobTable { Job j[96]; int n; int total; };
constexpr int BIGG = 1 << 30;
constexpr void add_job(JobTable& t, int in_idx, long long src_off, int lds, int K, int N, size_t dst_off, int ldd, int kcol0, int G, int GS, int R0) {
    Job& q = t.j[t.n]; q.in_idx = in_idx; q.src_off = (int)src_off; q.lds = lds; q.K = K; q.N = N; q.dst_off = (long long)dst_off; q.ldd = ldd; q.kcol0 = kcol0; q.G = G; q.GS = GS; q.R0 = R0;
    q.tile0 = t.total; t.total += (K / 64) * (N / 64); t.n++;
}
constexpr JobTable make_jobs(int which) {
    JobTable t{}; t.n = 0; t.total = 0;
    if (which == 0) {
        for (int l = 0; l < 2; ++l) {
            const size_t base = WS_WL + (size_t)l * SZ_WL; const long long wsrc = (long long)l * 1024 * IN_COLS;
            add_job(t, 6, wsrc + 0, IN_COLS, 1024, 768, base, 1024, 0, BIGG, 0, 0);
            add_job(t, 6, wsrc + 2688, IN_COLS, 1024, 256, base, 1024, 0, BIGG, 0, PC_D);
            add_job(t, 6, wsrc + 1536, IN_COLS, 1024, 768, base, 1024, 0, BIGG, 0, PC_Q);
            add_job(t, 6, wsrc + 2944, IN_COLS, 1024, 4096, base, 1024, 0, BIGG, 0, PC_G);
            add_job(t, 6, wsrc + 768, IN_COLS, 1024, 768, base + SZ_WINR, 1024, 0, BIGG, 0, 0);
            add_job(t, 6, wsrc + 2304, IN_COLS, 1024, 384, base + SZ_WINR, 1024, 0, BIGG, 0, PT_V);
            const int kd[4] = {384, 256, 384, 256}, ko[4] = {0, 384, 640, 1024};
            for (int i = 0; i < 4; ++i) add_job(t, 35 + i, (long long)l * kd[i] * 1024, 1024, kd[i], 1024, base + SZ_WINR + SZ_WINHY, 1280, ko[i], BIGG, 0, 0);
            add_job(t, 39, (long long)l * 1024 * 1024, 1024, 1024, 1024, base + SZ_WINR + SZ_WINHY + SZ_WBR, 1024, 0, BIGG, 0, 0);
        }
        for (int q = 0; q < 24; ++q) for (int mat = 0; mat < 2; ++mat)
            add_job(t, mat == 0 ? 9 : 11, (long long)q * 4096, 64, 64, 64, WS_LW + (size_t)(((q / 6) * 2 + mat) * 6 + q % 6) * 4096 * 2, 64, 0, BIGG, 0, 0);
        for (int l = 0; l < 2; ++l) add_job(t, 33, (long long)l * 65536, 256, 256, 256, WS_WGLU + (size_t)l * 256 * 256 * 2, 256, 0, BIGG, 0, 0);
        add_job(t, 44, 0, FF_DENSE, 1024, FF_DENSE, WS_FFGU, 1024, 0, 128, 256, 0);
        add_job(t, 45, 0, FF_DENSE, 1024, FF_DENSE, WS_FFGU, 1024, 0, 128, 256, 128);
        add_job(t, 46, 0, 1024, FF_DENSE, 1024, WS_FFD, FF_DENSE, 0, BIGG, 0, 0);
    } else {
        for (int e = 0; e < NE; ++e) {
            add_job(t, 48, (long long)e * 1024 * FF_E, FF_E, 1024, FF_E, WS_MOEGU + (size_t)e * 2 * FF_E * 1024 * 2, 1024, 0, 128, 256, 0);
            add_job(t, 49, (long long)e * 1024 * FF_E, FF_E, 1024, FF_E, WS_MOEGU + (size_t)e * 2 * FF_E * 1024 * 2, 1024, 0, 128, 256, 128);
            add_job(t, 50, (long long)e * FF_E * 1024, 1024, FF_E, 1024, WS_MOED + (size_t)e * 1024 * FF_E * 2, FF_E, 0, BIGG, 0, 0);
        }
    }
    return t;
}
__device__ const JobTable JT_SMALL = make_jobs(0);
__device__ const JobTable JT_MOE = make_jobs(1);

struct PartTable { pg8::PartC p[32]; };
constexpr pg8::PartC mk_part(size_t aOff, size_t bOff, unsigned aStep, unsigned bStep, int nM, int nN, int nt, int kind, int start) {
    pg8::PartC q{}; q.aOff = (long long)aOff; q.bOff = (long long)bOff; q.aStep = aStep; q.bStep = bStep; q.nM = nM; q.nN = nN; q.nt = nt; q.kind = kind; q.start = start; q.nGrp = 1; q.aGrp = 0; q.bGrp = 0; return q;
}
constexpr PartTable make_parts() {
    PartTable t{};
    for (int l = 0; l < 2; ++l) {
        const size_t WL = WS_WL + (size_t)l * SZ_WL; const int nMrow = l == 0 ? 68 : 64;
        t.p[l * 8 + 0] = mk_part(WS_UB, WL, 256u * 1024u * 2u, 256u * 1024u * 2u, 68, 23, 16, 0, 0);
        t.p[l * 8 + 1] = mk_part(WL + SZ_WINR, WS_UB, 256u * 1024u * 2u, 256u * 1024u * 2u, 5, 68, 16, 1, 68 * 23);
        const int kd[4] = {384, 256, 384, 256}, ko[4] = {0, 384, 640, 1024};
        for (int i = 0; i < 4; ++i) t.p[l * 8 + 2 + i] = mk_part(WS_YB + ko[i] * 2, WL + SZ_WINR + SZ_WINHY + ko[i] * 2, 256u * 1280u * 2u, 256u * 1280u * 2u, nMrow, 4, kd[i] / 64, i, i * nMrow * 4);
        t.p[l * 8 + 6] = mk_part(WS_UB, WL + SZ_WINR + SZ_WINHY + SZ_WBR, 256u * 1024u * 2u, 256u * 1024u * 2u, nMrow, 4, 16, 0, 0);
    }
    for (int l = 0; l < 2; ++l) {
        pg8::PartC q = mk_part(WS_US, WS_OPS + (size_t)l * 16 * 256 * 256 * 2, 256u * 512u * 2u, 0u, 5, 1, 4, 0, 0); q.nGrp = 16; q.aGrp = (unsigned)(NCHKP * 512 * 2); q.bGrp = 256u * 256u * 2u; t.p[18 + l * 3] = q;
        q = mk_part(WS_US, WS_OPY + (size_t)l * 16 * 256 * 512 * 2, 256u * 512u * 2u, 0u, 5, 1, 8, 0, 0); q.nGrp = 16; q.aGrp = (unsigned)(NCHKP * 512 * 2); q.bGrp = 256u * 512u * 2u; t.p[19 + l * 3] = q;
        t.p[20 + l * 3] = mk_part(WS_GL, WS_WGLU + (size_t)l * 256 * 256 * 2, 256u * 256u * 2u, 0u, l == 0 ? 68 : 64, 1, 4, 0, 0);
    }
    {
        const size_t WL0 = WS_WL;
        t.p[24] = mk_part(WS_UB, WL0 + SZ_WINR + SZ_WINHY + SZ_WBR, 256u * 1024u * 2u, 256u * 1024u * 2u, 64, 4, 16, 0, 0);
        pg8::PartC q = mk_part(WS_MGC, WL0 + SZ_WINR + SZ_WINHY + SZ_WBR, 256u * 1024u * 2u, 256u * 1024u * 2u, 4, 4, 16, 1, 256); q.nGrp = 4; q.aGrp = (unsigned)(RC * D * 2); q.bGrp = 0u; t.p[25] = q;
        t.p[26] = mk_part(WS_H, WS_FFD, 256u * (unsigned)FF_DENSE * 2u, 256u * (unsigned)FF_DENSE * 2u, 64, 4, 44, 0, 0);
        q = mk_part(WS_H + (size_t)64 * 256 * FF_DENSE * 2, WS_FFD, 256u * (unsigned)FF_DENSE * 2u, 256u * (unsigned)FF_DENSE * 2u, 4, 4, 12, 1, 256); q.nGrp = 3; q.aGrp = 1536u; q.bGrp = 1536u; t.p[27] = q;
        t.p[28] = mk_part(WS_H + (size_t)64 * 256 * FF_DENSE * 2 + 36 * 128, WS_FFD + 36 * 128, 256u * (unsigned)FF_DENSE * 2u, 256u * (unsigned)FF_DENSE * 2u, 4, 4, 8, 4, 256 + 48);
    }
    t.p[16] = mk_part(WS_UB, WS_FFGU, 256u * 1024u * 2u, 256u * 1024u * 2u, 68, 22, 16, 0, 0);
    t.p[17] = mk_part(WS_H, WS_FFD, 256u * (unsigned)FF_DENSE * 2u, 256u * (unsigned)FF_DENSE * 2u, 68, 4, 44, 0, 0);
    return t;
}
__device__ const PartTable PARTS = make_parts();

struct Args {
    const float* in[51];
    float* out; unsigned char* ws;
    int ph_lo, ph_hi, bar_region, pad0;
};
__device__ __forceinline__ const float* sel_in(const Args& a, int idx) {
    const float* p = a.in[6];
    p = idx == 9 ? a.in[9] : p; p = idx == 11 ? a.in[11] : p; p = idx == 33 ? a.in[33] : p; p = idx == 35 ? a.in[35] : p; p = idx == 36 ? a.in[36] : p; p = idx == 37 ? a.in[37] : p; p = idx == 38 ? a.in[38] : p; p = idx == 39 ? a.in[39] : p;
    p = idx == 44 ? a.in[44] : p; p = idx == 45 ? a.in[45] : p; p = idx == 46 ? a.in[46] : p; p = idx == 48 ? a.in[48] : p; p = idx == 49 ? a.in[49] : p; p = idx == 50 ? a.in[50] : p;
    return p;
}

__device__ __forceinline__ void convert_step(const Args& a, const JobTable& JT, LAS float* tile, int t0, int stride) {
    const int tid = threadIdx.x;
    {
        f32x4 v[4][2]; int jis[4];
#pragma unroll
        for (int u = 0; u < 4; ++u) {
            const int t = t0 + u * stride; jis[u] = -1;
            if (t < JT.total) {
                int ji = 0;
                for (int k = 1; k < JT.n; ++k) if (t >= JT.j[k].tile0) ji = k;
                jis[u] = ji;
                const Job& q = JT.j[ji];
                const int lt = t - q.tile0, nTn = q.N / 64, k0 = (lt / nTn) * 64, n0 = (lt % nTn) * 64;
                const float* src = sel_in(a, q.in_idx) + (size_t)q.src_off + (size_t)k0 * q.lds + n0;
#pragma unroll
                for (int p = 0; p < 2; ++p) v[u][p] = *(const f32x4*)(src + (size_t)((tid >> 4) + 32 * p) * q.lds + (tid & 15) * 4);
            }
        }
        __syncthreads();
#pragma unroll
        for (int u = 0; u < 4; ++u) if (jis[u] >= 0) {
#pragma unroll
            for (int p = 0; p < 2; ++p) { const int kk = (tid >> 4) + 32 * p, nn = (tid & 15) * 4; LAS float* tp = tile + u * (64 * 65) + kk * 65 + nn;
                tp[0] = v[u][p][0]; tp[1] = v[u][p][1]; tp[2] = v[u][p][2]; tp[3] = v[u][p][3]; } }
        __syncthreads();
#pragma unroll
        for (int u = 0; u < 4; ++u) if (jis[u] >= 0) {
            const Job& q = JT.j[jis[u]];
            const int t = t0 + u * stride, lt = t - q.tile0, nTn = q.N / 64, k0 = (lt / nTn) * 64, n0 = (lt % nTn) * 64;
            const int n = tid >> 3, k8 = (tid & 7) * 8, ng = n0 + n;
            const int drow = (ng / q.G) * q.GS + (ng % q.G) + q.R0;
            const LAS float* tp = tile + u * (64 * 65) + n;
            u32x4 w;
            w.x = cvt_pk_bf16(tp[(k8 + 0) * 65], tp[(k8 + 1) * 65]); w.y = cvt_pk_bf16(tp[(k8 + 2) * 65], tp[(k8 + 3) * 65]);
            w.z = cvt_pk_bf16(tp[(k8 + 4) * 65], tp[(k8 + 5) * 65]); w.w = cvt_pk_bf16(tp[(k8 + 6) * 65], tp[(k8 + 7) * 65]);
            *(u32x4*)((bf16_t*)(a.ws + q.dst_off) + (size_t)drow * q.ldd + q.kcol0 + k0 + k8) = w;
        }
    }
}
__device__ __forceinline__ void convert_tiles(const Args& a, const JobTable& JT, LAS float* tile, int first, int stride) {
    for (int t0 = first; t0 < JT.total; t0 += 4 * stride) convert_step(a, JT, tile, t0, stride);
}

__device__ __forceinline__ int opaque(int v) { asm volatile("" : "+v"(v)); return v; }
#define PIN8(a) asm volatile("" : "+v"((a)[0]), "+v"((a)[1]), "+v"((a)[2]), "+v"((a)[3]), "+v"((a)[4]), "+v"((a)[5]), "+v"((a)[6]), "+v"((a)[7]))
#define PIN16(a) do { PIN8(a); PIN8((a) + 8); } while (0)
struct RowV { f32x4 v[4]; };
__device__ __forceinline__ RowV row_load(const float* p, int lane) { RowV r;
#pragma unroll
    for (int i = 0; i < 4; ++i) r.v[i] = *(const f32x4*)(p + 256 * i + 4 * lane); return r; }
__device__ __forceinline__ void row_store(float* p, int lane, const RowV& r) {
#pragma unroll
    for (int i = 0; i < 4; ++i) *(f32x4*)(p + 256 * i + 4 * lane) = r.v[i]; }
__device__ __forceinline__ void row_store_bf16(bf16_t* p, int lane, const RowV& r) {
#pragma unroll
    for (int i = 0; i < 4; ++i) { u32x2 w; w.x = cvt_pk_bf16(r.v[i][0], r.v[i][1]); w.y = cvt_pk_bf16(r.v[i][2], r.v[i][3]); *(u32x2*)(p + 256 * i + 4 * lane) = w; } }
__device__ __forceinline__ RowV row_norm(const RowV& x) {
    float s = 0.f;
#pragma unroll
    for (int i = 0; i < 4; ++i) s += (x.v[i][0] + x.v[i][1]) + (x.v[i][2] + x.v[i][3]);
    const float mu = wave_sum(s) * (1.f / D);
    RowV d; float q = 0.f;
#pragma unroll
    for (int i = 0; i < 4; ++i) { d.v[i] = x.v[i] - mu; q += (d.v[i][0] * d.v[i][0] + d.v[i][1] * d.v[i][1]) + (d.v[i][2] * d.v[i][2] + d.v[i][3] * d.v[i][3]); }
    const float rs = rsqrtf(wave_sum(q) * (1.f / D) + 1e-5f);
#pragma unroll
    for (int i = 0; i < 4; ++i) d.v[i] = d.v[i] * rs;
    return d;
}
__device__ __forceinline__ RowV row_affine(const RowV& n, const float* g, const float* b, int lane) {
    RowV o;
#pragma unroll
    for (int i = 0; i < 4; ++i) o.v[i] = n.v[i] * *(const f32x4*)(g + 256 * i + 4 * lane) + *(const f32x4*)(b + 256 * i + 4 * lane);
    return o;
}
__device__ __forceinline__ RowV row_modulate(const RowV& n, const float* sh, const float* sc, int lane) {
    RowV o;
#pragma unroll
    for (int i = 0; i < 4; ++i) o.v[i] = n.v[i] * (*(const f32x4*)(sc + 256 * i + 4 * lane) + 1.0f) + *(const f32x4*)(sh + 256 * i + 4 * lane);
    return o;
}

constexpr int LDS_BYTES = 159744;
constexpr int MISC_OFF = 159488;
constexpr int NPH_LAYER = 16;
#ifndef SPLIT
#define SPLIT 0
#endif

__global__ void __launch_bounds__(512, 2) mk_fwd(Args a) {
    extern __shared__ __attribute__((aligned(16))) unsigned char shm[];
    LAS unsigned char* lds = (LAS unsigned char*)shm;
    volatile LAS unsigned* MISC = (volatile LAS unsigned*)(lds + MISC_OFF);
    const int tid0 = threadIdx.x, wave = __builtin_amdgcn_readfirstlane(tid0 >> 6);
    const int G = gridDim.x, bid = blockIdx.x;
    if (tid0 < (LDS_BYTES - MISC_OFF) / 4) MISC[tid0] = 0u;
    __syncthreads();
    unsigned char* ws = a.ws;
    unsigned* ctl = (unsigned*)(ws + WS_CTL);
    XcdBarrier bar = xcd_barrier_post(ctl + CW_BAR + a.bar_region * XCD_BAR_WORDS, MISC + 8);
    const int lo = a.ph_lo, hi = a.ph_hi;
#ifndef PHMASK
#define PHMASK 0xFFFF
#endif
#define IN(k) (lo <= (k) && (k) < hi)
#define SEAM(k) do { if (lo <= (k) && (k) + 1 < hi) xcd_barrier(bar); } while (0)
    float* MOD = (float*)(ws + WS_MOD);
    bf16_t* UB = (bf16_t*)(ws + WS_UB); bf16_t* PR = (bf16_t*)(ws + WS_PR); bf16_t* PT = (bf16_t*)(ws + WS_PT); bf16_t* YB = (bf16_t*)(ws + WS_YB);
    float* PRE = (float*)(ws + WS_PRE); float* XSC = (float*)(ws + WS_XSC);
    const float* x_in = a.in[0]; const float* ctx_in = a.in[2];

    if (((PHMASK >> 0) & 1) && IN(0)) {
        const int tid = opaque(tid0), lane = tid & 63;
        __syncthreads();
        LAS float* sc = (LAS float*)lds;
        for (int i = tid; i < 5 * 1024; i += 512) { const int r = i >> 10, k = i & 1023; sc[i] = silu_acc(r < 4 ? a.in[1][r * 1024 + k] : a.in[3][k]); }
        __syncthreads();
        for (int u = bid; u < 2 * 96 * 8; u += G) {
            const int l = u / (96 * 8), rem = u % (96 * 8), cg = rem / 8, ks = rem % 8;
            const int n = cg * 64 + lane;
            const float* w = a.in[4] + (size_t)l * 1024 * 6144 + n;
            float a0 = 0, a1 = 0, a2 = 0, a3 = 0, a4 = 0;
            const int kb = ks * 128 + wave * 16;
#pragma unroll 4
            for (int k = kb; k < kb + 16; ++k) { const float wv = w[(size_t)k * 6144]; a0 += sc[k] * wv; a1 += sc[1024 + k] * wv; a2 += sc[2048 + k] * wv; a3 += sc[3072 + k] * wv; a4 += sc[4096 + k] * wv; }
            if (ks == 0 && wave == 0) { const float bb = a.in[5][l * 6144 + n]; a0 += bb; a1 += bb; a2 += bb; a3 += bb; a4 += bb; }
            float* o = MOD + (size_t)l * 5 * 6144 + n;
            atomicAdd(o, a0); atomicAdd(o + 6144, a1); atomicAdd(o + 2 * 6144, a2); atomicAdd(o + 3 * 6144, a3); atomicAdd(o + 4 * 6144, a4);
        }
        __syncthreads();
        for (int u = bid; u < 132; u += G) {
            const bool isc = u >= 128; const int l = isc ? 0 : (u >> 6), blk = isc ? u - 128 : (u & 63), L = isc ? CTXL : SEQ, t0 = blk * 64;
            LAS float* feat = (LAS float*)lds;
            LAS float* h1 = feat + 64 * 33;
            LAS float* h2 = h1 + 4096;
            const float* w1 = a.in[16] + l * 33 * 64; const float* b1 = a.in[17] + l * 64; const float* w2 = a.in[18] + l * 4096; const float* b2 = a.in[19] + l * 64;
            const float* w3 = a.in[20] + (size_t)l * 65536; const float* b3 = a.in[21] + l * 1024; const float* fq = a.in[22] + l * 64;
            __syncthreads();
            for (int i = tid; i < 64 * 33; i += 512) { const int tt = i / 33, f = i - tt * 33, t = t0 + tt; float v;
                if (f == 0) v = (float)t / (float)L;
                else { const int band = (f - 1) % 16 + 1; const int m = (int)(((long)t * band) % L); const double ang = 2.0 * M_PI * (double)m / (double)L; v = f <= 16 ? (float)cos(ang) : (float)sin(ang); }
                feat[i] = v; }
            __syncthreads();
            for (int i = tid; i < 4096; i += 512) { const int tt = i >> 6, j = i & 63; float sacc = b1[j];
                for (int f = 0; f < 33; ++f) sacc += feat[tt * 33 + f] * w1[f * 64 + j];
                h1[i] = sinf(fq[j] * sacc); }
            __syncthreads();
            for (int i = tid; i < 4096; i += 512) { const int tt = i >> 6, j = i & 63; float sacc = b2[j];
                for (int f = 0; f < 64; ++f) sacc += h1[tt * 64 + f] * w2[f * 64 + j];
                h2[i] = sinf(fq[j] * sacc); }
            __syncthreads();
            const float dmin = 3.0701134573253945f, dmax = 15.350567286626973f;
#pragma unroll 1
            for (int jj = 0; jj < 2; ++jj) {
                const int n = tid + 512 * jj, dir = n >> 9, o = (n >> 8) & 1, c = n & 255;
                float wc[64];
#pragma unroll
                for (int i = 0; i < 64; ++i) wc[i] = w3[i * 1024 + n];
                const float bb = b3[n], delta = dmin + (dmax - dmin) * (float)c / 255.0f;
                bf16_t* dst = isc ? (bf16_t*)(ws + WS_KFC) + ((size_t)(dir * 2 + o) * 256 + c) * CTXL + t0 : (bf16_t*)(ws + WS_KFL) + ((size_t)((l * 2 + dir) * 2 + o) * 256 + c) * SEQ + t0;
                float asum = 0.f;
#pragma unroll 1
                for (int tg = 0; tg < 8; ++tg) {
                    float v[8];
#pragma unroll
                    for (int q = 0; q < 8; ++q) { float sacc = bb; const LAS float* hp = h2 + (tg * 8 + q) * 64;
#pragma unroll
                        for (int i = 0; i < 64; ++i) sacc += hp[i] * wc[i];
                        const int t = t0 + tg * 8 + q;
                        v[q] = sacc * expf(-((float)t / (float)L) * delta);
                        if (!(dir == 1 && t == 0)) asum += fabsf(v[q]); }
                    u32x4 w; w.x = cvt_pk_bf16(v[0], v[1]); w.y = cvt_pk_bf16(v[2], v[3]); w.z = cvt_pk_bf16(v[4], v[5]); w.w = cvt_pk_bf16(v[6], v[7]);
                    *(u32x4*)(dst + tg * 8) = w;
                }
                atomicAdd((float*)(ctl + CW_HYN) + (isc ? 1024 + o * 256 + c : (l * 2 + o) * 256 + c), asum);
            }
        }
        __syncthreads();
        for (int u = bid - 132; u >= 0 && u < 32; u += G) {
            const int l = u >> 4, g = u & 15;
            LAS float* PW = (LAS float*)lds;
            LAS float* BBs = PW + 2 * 64 * 17 * 2;
            LAS float* Cs = BBs + 2 * 64 * 16 * 2;
            LAS float* KT = Cs + 2 * 16 * 64 * 2;
            __syncthreads();
            if (tid < 128) {
                const int d = tid >> 6, p = tid & 63, idx = l * 2048 + (d * 16 + g) * 64 + p;
                const double ar = a.in[25][idx], ai = a.in[26][idx], dt = exp((double)a.in[27][l * 32 + d * 16 + g]);
                const double mag = exp(dt * ar), abr = mag * cos(dt * ai), abi = mag * sin(dt * ai), den = ar * ar + ai * ai;
                const double fr = ((abr - 1.0) * ar + abi * ai) / den, fi = (abi * ar - (abr - 1.0) * ai) / den;
                double pr = 1.0, pi = 0.0;
                for (int k = 0; k <= 16; ++k) { PW[((d * 64 + p) * 17 + k) * 2] = (float)pr; PW[((d * 64 + p) * 17 + k) * 2 + 1] = (float)pi; const double nr = pr * abr - pi * abi, ni = pr * abi + pi * abr; pr = nr; pi = ni; }
                float* a16 = (float*)(ws + WS_AB16) + ((size_t)((l * 2 + d) * 16 + g) * 64 + p) * 2;
                a16[0] = PW[((d * 64 + p) * 17 + 16) * 2]; a16[1] = PW[((d * 64 + p) * 17 + 16) * 2 + 1];
                for (int i = 0; i < 16; ++i) { const double br = a.in[28][(size_t)idx * 16 + i], bi = a.in[29][(size_t)idx * 16 + i];
                    BBs[((d * 64 + p) * 16 + i) * 2] = (float)(fr * br - fi * bi); BBs[((d * 64 + p) * 16 + i) * 2 + 1] = (float)(fr * bi + fi * br); }
            }
            for (int i = tid; i < 2048; i += 512) { const int d = i >> 10, o = (i >> 6) & 15, p = i & 63; const size_t ci = (size_t)l * 32768 + ((size_t)(d * 16 + g) * 16 + o) * 64 + p;
                Cs[i * 2] = a.in[30][ci]; Cs[i * 2 + 1] = a.in[31][ci]; }
            __syncthreads();
            for (int e = tid; e < 8192; e += 512) { const int d = e >> 12, k = (e >> 8) & 15, o = (e >> 4) & 15, i = e & 15;
                float acc = 0.f;
                for (int p = 0; p < 64; ++p) { const float cr = Cs[((d * 16 + o) * 64 + p) * 2], ci = Cs[((d * 16 + o) * 64 + p) * 2 + 1], pr = PW[((d * 64 + p) * 17 + k) * 2], pi = PW[((d * 64 + p) * 17 + k) * 2 + 1];
                    const float tr = cr * pr - ci * pi, ti = cr * pi + ci * pr;
                    acc += tr * BBs[((d * 64 + p) * 16 + i) * 2] - ti * BBs[((d * 64 + p) * 16 + i) * 2 + 1]; }
                KT[e] = acc; }
            __syncthreads();
            bf16_t* OPS = (bf16_t*)(ws + WS_OPS) + (size_t)(l * 16 + g) * 256 * 256;
            bf16_t* OPY = (bf16_t*)(ws + WS_OPY) + (size_t)(l * 16 + g) * 256 * 512;
            for (int e = tid; e < 256 * 32; e += 512) {
                const int row = e >> 5, c0 = (e & 31) * 8, d = row >> 7, p = (row >> 1) & 63, ri = row & 1, sx = c0 >> 4, i0 = c0 & 15, k = d == 0 ? 15 - sx : sx;
                const float pr = PW[((d * 64 + p) * 17 + k) * 2], pi = PW[((d * 64 + p) * 17 + k) * 2 + 1];
                float v[8];
#pragma unroll
                for (int j = 0; j < 8; ++j) { const float br = BBs[((d * 64 + p) * 16 + i0 + j) * 2], bi = BBs[((d * 64 + p) * 16 + i0 + j) * 2 + 1]; v[j] = ri == 0 ? pr * br - pi * bi : pr * bi + pi * br; }
                u32x4 w; w.x = cvt_pk_bf16(v[0], v[1]); w.y = cvt_pk_bf16(v[2], v[3]); w.z = cvt_pk_bf16(v[4], v[5]); w.w = cvt_pk_bf16(v[6], v[7]);
                *(u32x4*)(OPS + (size_t)row * 256 + c0) = w; }
            for (int e = tid; e < 256 * 64; e += 512) {
                const int row = e >> 6, c0 = (e & 63) * 8, t = row >> 4, o = row & 15;
                float v[8];
                if (c0 < 256) { const int sx = c0 >> 4, i0 = c0 & 15;
#pragma unroll
                    for (int j = 0; j < 8; ++j) { float x = 0.f; if (sx <= t) x += KT[((0 * 16 + (t - sx)) * 16 + o) * 16 + i0 + j]; if (sx >= t) x += KT[((1 * 16 + (sx - t)) * 16 + o) * 16 + i0 + j]; v[j] = x; } }
                else { const int c2 = c0 - 256, d = c2 >> 7, k = d == 0 ? t + 1 : 16 - t;
#pragma unroll
                    for (int j = 0; j < 8; ++j) { const int p = ((c2 + j) >> 1) & 63, ri = (c2 + j) & 1;
                        const float cr = Cs[((d * 16 + o) * 64 + p) * 2], ci = Cs[((d * 16 + o) * 64 + p) * 2 + 1], pr = PW[((d * 64 + p) * 17 + k) * 2], pi = PW[((d * 64 + p) * 17 + k) * 2 + 1];
                        v[j] = ri == 0 ? cr * pr - ci * pi : -(cr * pi + ci * pr); } }
                u32x4 w; w.x = cvt_pk_bf16(v[0], v[1]); w.y = cvt_pk_bf16(v[2], v[3]); w.z = cvt_pk_bf16(v[4], v[5]); w.w = cvt_pk_bf16(v[6], v[7]);
                *(u32x4*)(OPY + (size_t)row * 512 + c0) = w; }
        }
        __syncthreads();
        for (;;) {
            __syncthreads();
            if (tid == 0) MISC[16] = atomicAdd(ctl + CW_QUEUE, 4u);
            __syncthreads();
            const int base = (int)MISC[16];
            if (base >= JT_SMALL.total) break;
            convert_step(a, JT_SMALL, (LAS float*)lds, base, 1);
        }
        __syncthreads();
    }
    SEAM(0);

    for (int l = 0; l < 2; ++l) {
        const int P0 = 1 + l * NPH_LAYER;
        const float* MODL = MOD + (size_t)l * 5 * 6144;
        const unsigned char* WL = ws + WS_WL + (size_t)l * SZ_WL;
        const int nMrow = (l == 0) ? 68 : 64;
        const float* xlat = (l == 0) ? x_in : a.out; const float* xctx = (l == 0) ? ctx_in : XSC;

        if (((PHMASK >> 1) & 1) && l == 0 && IN(P0 + 0)) {
            const int lane = opaque(tid0) & 63;
            for (int r = bid * 8 + wave; r < RT; r += G * 8) {
                const float* src = r < RL ? x_in + (size_t)r * D : ctx_in + (size_t)(r - RL) * D;
                const float* mv = MODL + (size_t)(r < RL ? (r >> 12) : 4) * 6144;
                const RowV n = row_norm(row_load(src, lane));
                row_store_bf16(UB + (size_t)r * D, lane, row_modulate(n, mv, mv + 1024, lane));
            }
        }
        if (l == 0) SEAM(P0 + 0);

        if (((PHMASK >> 2) & 1) && IN(P0 + 1)) {
            const pg8::TabSched S{PARTS.p + l * 8, (const char*)ws, 2, 68 * 23 + 5 * 68, G, bid};
            pg8::EpiProj E{PR, PT, (bf16_t*)(ws + WS_US), 7, ws + WS_GQ};
            pg8::gemm_phase<1024, 1024>(lds, S, E);
        }
        SEAM(P0 + 1);
        if (((PHMASK >> 13) & 1) && IN(P0 + 2)) {
            const int tid = opaque(tid0), lane = tid & 63;
            LAS float* rp = (LAS float*)lds;
            for (int i = tid; i < 6 * 465; i += 512) rp[i] = a.in[24][l * 2790 + i];
            __syncthreads();
            LAS bf16_t* CK = (LAS bf16_t*)(lds + 11264);
            LAS bf16_t* CV = (LAS bf16_t*)(lds + 11264 + 256 * 144);
            const int ngroups = 768 + (l == 0 ? 48 : 0);
            for (int gi = bid; gi < ngroups; gi += G) {
                const bool lat = gi < 768;
                const int combo = lat ? gi >> 5 : (gi - 768) >> 1, b = combo / 6, h = combo - 6 * b;
                const int v = lat ? ((gi & 31) << 3) + wave : (((gi - 768) & 1) << 3) + wave;
                __syncthreads();
                const int tid2 = opaque(tid);
#pragma unroll
                for (int k = 0; k < 4; ++k) { const int c = tid2 + 512 * k, tok = c >> 3, part = c & 7;
                    *(LAS u32x4*)(CK + tok * 72 + part * 8) = *(const u32x4*)(PR + (size_t)(RL + b * CTXL + tok) * LDP + PC_K + h * 64 + part * 8); }
#pragma unroll
                for (int k = 0; k < 4; ++k) { const int c = tid2 + 512 * k, dd = c >> 5, part = c & 31;
                    *(LAS u32x4*)(CV + dd * 264 + part * 8) = *(const u32x4*)(PT + (size_t)(PT_V + h * 64 + dd) * RT + RL + b * CTXL + part * 8); }
                __syncthreads();
                const int ln2 = opaque(lane), qn = ln2 & 15, g = ln2 >> 4;
                int r = 0, qb, tq, rs = 0, bs = 0, w = 0, cs = 0;
                if (lat) { qb = v & 3; r = v >> 2; rs = r - 4 < 0 ? 0 : (r - 4 > 56 ? 56 : r - 4); bs = qb == 0 ? 0 : (qb == 1 ? 8 : (qb == 2 ? 24 : 32));
                    w = 16 * qb + qn; cs = w - 8 < 0 ? 0 : (w - 8 > 48 ? 48 : w - 8); tq = b * SEQ + r * 64 + w; }
                else { qb = v; tq = RL + b * CTXL + 16 * qb + qn; }
                const bf16_t* qp = PR + (size_t)tq * LDP + PC_Q + h * 64 + 8 * g;
                const bf16x8 q0 = *(const bf16x8*)qp, q1 = *(const bf16x8*)(qp + 32);
                f32x4 S[32];
                const int koff = 8 * (qn >> 2) + (qn & 3);
                if (lat) {
#pragma unroll
                    for (int pb = 0; pb < 4; ++pb) {
                        bf16x8 kf[8];
#pragma unroll
                        for (int q = 0; q < 4; ++q) { const int p = pb * 2 + (q >> 1), hf = q & 1;
                            const bf16_t* kp = PR + (size_t)(b * SEQ + (rs + p) * 64 + bs + koff + 4 * hf) * LDP + PC_K + h * 64 + 8 * g;
                            kf[2 * q] = *(const bf16x8*)kp; kf[2 * q + 1] = *(const bf16x8*)(kp + 32); }
                        PIN8(kf);
#pragma unroll
                        for (int q = 0; q < 4; ++q) { const int p = pb * 2 + (q >> 1), hf = q & 1;
                            f32x4 acc = {0.f, 0.f, 0.f, 0.f};
                            acc = __builtin_amdgcn_mfma_f32_16x16x32_bf16(kf[2 * q], q0, acc, 0, 0, 0);
                            acc = __builtin_amdgcn_mfma_f32_16x16x32_bf16(kf[2 * q + 1], q1, acc, 0, 0, 0);
                            const int rowoff = (h * 15 + (rs + p - r + 7)) * 31;
#pragma unroll
                            for (int j = 0; j < 4; ++j) { const int c = bs + 8 * g + 4 * hf + j; const bool ok = (c >= cs) && (c < cs + 16);
                                const int dc = ok ? c - w + 15 : 0;
                                acc[j] = ok ? acc[j] * 0.125f + rp[rowoff + dc] : -3.0e38f; }
                            S[2 * p + hf] = acc; }
                    }
                } else {
#pragma unroll
                    for (int p = 0; p < 16; ++p) S[p] = (f32x4){-3.0e38f, -3.0e38f, -3.0e38f, -3.0e38f};
                }
#pragma unroll
                for (int p = 0; p < 8; ++p)
#pragma unroll
                    for (int hf = 0; hf < 2; ++hf) { const LAS bf16_t* kp = CK + (32 * p + koff + 4 * hf) * 72 + 8 * g;
                        const bf16x8 k0 = *(const LAS bf16x8*)kp, k1 = *(const LAS bf16x8*)(kp + 32);
                        f32x4 acc = {0.f, 0.f, 0.f, 0.f};
                        acc = __builtin_amdgcn_mfma_f32_16x16x32_bf16(k0, q0, acc, 0, 0, 0);
                        acc = __builtin_amdgcn_mfma_f32_16x16x32_bf16(k1, q1, acc, 0, 0, 0);
                        S[16 + 2 * p + hf] = acc * 0.125f; if (hf == 1 && (p & 1)) __builtin_amdgcn_sched_barrier(0); }
                float mx = -3.0e38f;
#pragma unroll
                for (int i = 0; i < 32; ++i) mx = fmaxf(fmaxf(mx, fmaxf(S[i][0], S[i][1])), fmaxf(S[i][2], S[i][3]));
                mx = fmaxf(mx, __shfl_xor(mx, 16)); mx = fmaxf(mx, __shfl_xor(mx, 32));
                float sum = 0.f;
#pragma unroll
                for (int i = 0; i < 32; ++i) {
#pragma unroll
                    for (int j = 0; j < 4; ++j) { const float e = __expf(S[i][j] - mx); S[i][j] = e; sum += e; } }
                sum += __shfl_xor(sum, 16); sum += __shfl_xor(sum, 32);
                const float inv = 1.0f / sum;
                f32x4 O[4];
#pragma unroll
                for (int dt = 0; dt < 4; ++dt) O[dt] = (f32x4){0.f, 0.f, 0.f, 0.f};
                const bf16_t* vt = PT + (size_t)(PT_V + h * 64 + qn) * RT + 8 * g;
                if (lat) {
#pragma unroll
                    for (int pq = 0; pq < 2; ++pq) {
                        bf16x8 vf[16];
#pragma unroll
                        for (int q = 0; q < 4; ++q) { const int p = pq * 4 + q; const int base = b * SEQ + (rs + p) * 64 + bs;
#pragma unroll
                            for (int dt = 0; dt < 4; ++dt) vf[4 * q + dt] = *(const bf16x8*)(vt + (size_t)(16 * dt) * RT + base); }
                        PIN16(vf);
#pragma unroll
                        for (int q = 0; q < 4; ++q) { const int p = pq * 4 + q;
                            u32x4 pw; pw.x = cvt_pk_bf16(S[2 * p][0], S[2 * p][1]); pw.y = cvt_pk_bf16(S[2 * p][2], S[2 * p][3]); pw.z = cvt_pk_bf16(S[2 * p + 1][0], S[2 * p + 1][1]); pw.w = cvt_pk_bf16(S[2 * p + 1][2], S[2 * p + 1][3]);
                            bf16x8 pf; __builtin_memcpy(&pf, &pw, 16);
#pragma unroll
                            for (int dt = 0; dt < 4; ++dt) O[dt] = __builtin_amdgcn_mfma_f32_16x16x32_bf16(vf[4 * q + dt], pf, O[dt], 0, 0, 0); }
                    }
                }
#pragma unroll
                for (int p = 8; p < 16; ++p) {
                    u32x4 pw; pw.x = cvt_pk_bf16(S[2 * p][0], S[2 * p][1]); pw.y = cvt_pk_bf16(S[2 * p][2], S[2 * p][3]); pw.z = cvt_pk_bf16(S[2 * p + 1][0], S[2 * p + 1][1]); pw.w = cvt_pk_bf16(S[2 * p + 1][2], S[2 * p + 1][3]);
                    bf16x8 pf; __builtin_memcpy(&pf, &pw, 16);
#pragma unroll
                    for (int dt = 0; dt < 4; ++dt) { const bf16x8 vfl = *(const LAS bf16x8*)(CV + (16 * dt + qn) * 264 + 32 * (p - 8) + 8 * g);
                        O[dt] = __builtin_amdgcn_mfma_f32_16x16x32_bf16(vfl, pf, O[dt], 0, 0, 0); }
                    if (p & 1) __builtin_amdgcn_sched_barrier(0);
                }
                bf16_t* op = YB + (size_t)tq * YW + YC_C + h * 64 + 4 * g;
#pragma unroll
                for (int dt = 0; dt < 4; ++dt) { u32x2 o2; o2.x = cvt_pk_bf16(O[dt][0] * inv, O[dt][1] * inv); o2.y = cvt_pk_bf16(O[dt][2] * inv, O[dt][3] * inv); *(u32x2*)(op + 16 * dt) = o2; }
            }
            __syncthreads();
            {
                const int tid = opaque(tid0), lane = tid & 63;
                LAS float* XC = (LAS float*)lds;
                LAS f32x2* AB = (LAS f32x2*)(lds + 16 * 384 * 4);
                const float* cw = a.in[7] + l * 4 * 384; const float* cb = a.in[8] + l * 384;
                const bf16_t* LW = (const bf16_t*)(ws + WS_LW) + (size_t)l * 24 * 4096;
                bf16_t* LT = (bf16_t*)(ws + WS_LT); f32x2* LAGG = (f32x2*)(ws + WS_LAGG);
                const int dir = (wave >> 2) & 1, ntile = wave & 3, tk = lane & 15, kg = lane >> 4;
                LAS float* CT = (LAS float*)(lds + 16 * 384 * 4 + 2 * 16 * 384 * 8);
                for (int i = tid; i < 768; i += 512) { CT[i] = a.in[10][l * 768 + i]; CT[768 + i] = a.in[12][l * 768 + i]; CT[1536 + i] = -8.0f * softplus(-a.in[13][l * 768 + i]); }
                float cwv[60];
#pragma unroll
                for (int i = 0; i < 12; ++i) { const int idx = tid + 512 * i, ch = idx % 384;
                    cwv[5 * i] = cw[ch]; cwv[5 * i + 1] = cw[384 + ch]; cwv[5 * i + 2] = cw[768 + ch]; cwv[5 * i + 3] = cw[1152 + ch]; cwv[5 * i + 4] = cb[ch]; }
                PIN16(cwv); PIN16(cwv + 16); PIN16(cwv + 32); PIN8(cwv + 48); asm volatile("" : "+v"(cwv[56]), "+v"(cwv[57]), "+v"(cwv[58]), "+v"(cwv[59]));
                for (int n = bid; n < NCHK; n += G) {
                    const int r0 = 16 * n; int start, len, pos0, bb; row_seq(r0, start, len, pos0, bb);
                    __syncthreads();
                    unsigned pin[48];
#pragma unroll
                    for (int i = 0; i < 12; ++i) { const int idx = tid + 512 * i, tok = idx / 384, ch = idx - tok * 384, pos = pos0 + tok;
                        const bf16_t* pr = PR + (size_t)(r0 + tok) * LDP + PC_AC + ch;
                        pin[4 * i + 0] = pos >= 2 ? pr[-2 * LDP] : 0; pin[4 * i + 1] = pos >= 1 ? pr[-LDP] : 0; pin[4 * i + 2] = pr[0]; pin[4 * i + 3] = pos + 1 < len ? pr[LDP] : 0; }
                    PIN16(pin); PIN16(pin + 16); PIN16(pin + 32);
#pragma unroll
                    for (int i = 0; i < 12; ++i) { const int idx = tid + 512 * i, tok = idx / 384, ch = idx - tok * 384;
                        XC[idx] = cwv[5 * i + 4] + cwv[5 * i] * bflo(pin[4 * i]) + cwv[5 * i + 1] * bflo(pin[4 * i + 1]) + cwv[5 * i + 2] * bflo(pin[4 * i + 2]) + cwv[5 * i + 3] * bflo(pin[4 * i + 3]); }
                    __syncthreads();
#pragma unroll 2
                    for (int g = 0; g < 6; ++g) {
                        bf16x8 wq[4];
#pragma unroll
                        for (int ks = 0; ks < 2; ++ks) { const bf16_t* wp = LW + ((size_t)((dir * 2 + 0) * 6 + g) * 64 + 16 * ntile + tk) * 64 + 32 * ks + 8 * kg; wq[2 * ks] = *(const bf16x8*)wp; wq[2 * ks + 1] = *(const bf16x8*)(wp + 6 * 4096); }
                        asm volatile("" : "+v"(wq[0]), "+v"(wq[1]), "+v"(wq[2]), "+v"(wq[3]));
                        f32x4 ar = {0.f, 0.f, 0.f, 0.f}, ai = {0.f, 0.f, 0.f, 0.f};
#pragma unroll
                        for (int ks = 0; ks < 2; ++ks) {
                            const LAS float* xp = XC + tk * 384 + g * 64 + 32 * ks + 8 * kg;
                            const f32x4 x0 = *(const LAS f32x4*)xp, x1 = *(const LAS f32x4*)(xp + 4);
                            u32x4 xw; xw.x = cvt_pk_bf16(x0[0], x0[1]); xw.y = cvt_pk_bf16(x0[2], x0[3]); xw.z = cvt_pk_bf16(x1[0], x1[1]); xw.w = cvt_pk_bf16(x1[2], x1[3]);
                            bf16x8 xf; __builtin_memcpy(&xf, &xw, 16);
                            ar = __builtin_amdgcn_mfma_f32_16x16x32_bf16(xf, wq[2 * ks], ar, 0, 0, 0);
                            ai = __builtin_amdgcn_mfma_f32_16x16x32_bf16(xf, wq[2 * ks + 1], ai, 0, 0, 0);
                        }
                        const int ch = g * 64 + 16 * ntile + tk;
                        const float br = CT[dir * 384 + ch], bi = CT[768 + dir * 384 + ch], sp8 = CT[1536 + dir * 384 + ch];
#pragma unroll
                        for (int j = 0; j < 4; ++j) { const int tok = 4 * kg + j;
                            const float la = sigm(ar[j] + br) * sp8, y = 2.0f * la;
                            const float av = 1.0f + la * (1.0f + la * (0.5f + la * (0.16666667f + la * (0.041666667f + la * 0.0083333333f))));
                            const float om = -y * (1.0f + y * (0.5f + y * (0.16666667f + y * (0.041666667f + y * (0.0083333333f + y * 0.0013888889f)))));
                            const float bt = __builtin_sqrtf(om) * sigm(ai[j] + bi) * XC[tok * 384 + ch];
                            AB[(dir * 16 + tok) * 384 + ch] = (f32x2){av, bt}; }
                    }
                    __syncthreads();
                    if (tid < 384) {
                        float hf = 0.f, pf = 1.f, hb = 0.f, pb = 1.f;
#pragma unroll
                        for (int t = 0; t < 16; ++t) {
                            const f32x2 f = AB[t * 384 + tid], bk = AB[(16 + 15 - t) * 384 + tid];
                            hf = f[0] * hf + f[1]; pf *= f[0]; hb = bk[0] * hb + bk[1]; pb *= bk[0];
                            AB[t * 384 + tid] = (f32x2){pf, hf}; AB[(16 + 15 - t) * 384 + tid] = (f32x2){pb, hb}; }
                        LAGG[((size_t)n * 2 + 0) * 384 + tid] = (f32x2){pf, hf}; LAGG[((size_t)n * 2 + 1) * 384 + tid] = (f32x2){pb, hb};
                    }
                    __syncthreads();
#pragma unroll
                    for (int i = 0; i < 12; ++i) { const int idx = tid + 512 * i, tok = idx / 384, ch = idx - tok * 384;
                        const f32x2 f = AB[idx], bk = AB[16 * 384 + idx];
                        bf16_t* o = LT + (size_t)(r0 + tok) * 1152 + ch;
                        o[0] = f2bf(f[1] + bk[1]); o[384] = f2bf(f[0]); o[768] = f2bf(bk[0]); }
                }
                __syncthreads();
            }
            {
                const int tid = opaque(tid0), lane = tid & 63;
                constexpr int ZS = SEQ + 16;
                LAS bf16_t* R0 = (LAS bf16_t*)lds;
                LAS bf16_t* R1 = R0 + 8224;
                LAS bf16_t* ZA = R1 + 8224;
                const LAS unsigned* Rdw = (const LAS unsigned*)lds;
#define HY_ZF(b, s) ((b) * ZS + ((s) & ~63) + (((((s) >> 3) & 7) ^ (((s) >> 7) & 1)) << 3) + ((s) & 7))
                const float* hcw = a.in[14] + l * 3 * 768; const float* hcb = a.in[15] + l * 768;
                const float* nrm = (const float*)(ctl + CW_HYN);
                bf16_t* YT = (bf16_t*)(ws + WS_YT);
                const int r32 = lane & 31, hh = lane >> 5, il = r32 >> 2, bq = r32 & 3, iblk = 8 * wave + il;
                const int x0b = 4095 - r32 + 8 * hh, par = x0b & 1;
                const int abase = (par ? 4112 : 0) + ((x0b - par) >> 1);
                for (int c = bid; c < 256; c += G) {
                    __syncthreads();
#pragma unroll 1
                    for (int it = tid; it < 3 * 4 * 512; it += 512) {
                        const int arr = it >> 11, b = (it >> 9) & 3, s8 = (it & 511) * 8, ch = arr * 256 + c;
                        const bf16_t* pp = PT + (size_t)ch * RT + b * SEQ + s8;
                        const u32x4 pv = *(const u32x4*)pp;
                        const float w0 = hcw[ch], w1 = hcw[768 + ch], w2 = hcw[1536 + ch], cb0 = hcb[ch];
                        float p[10];
                        p[0] = s8 > 0 ? bf2f(pp[-1]) : 0.f; p[9] = s8 + 8 < SEQ ? bf2f(pp[8]) : 0.f;
                        p[1] = bflo(pv.x); p[2] = bfhi(pv.x); p[3] = bflo(pv.y); p[4] = bfhi(pv.y); p[5] = bflo(pv.z); p[6] = bfhi(pv.z); p[7] = bflo(pv.w); p[8] = bfhi(pv.w);
                        float z[8];
#pragma unroll
                        for (int j = 0; j < 8; ++j) z[j] = cb0 + w0 * p[j] + w1 * p[j + 1] + w2 * p[j + 2];
                        u32x4 w; w.x = cvt_pk_bf16(z[0], z[1]); w.y = cvt_pk_bf16(z[2], z[3]); w.z = cvt_pk_bf16(z[4], z[5]); w.w = cvt_pk_bf16(z[6], z[7]);
                        *(LAS u32x4*)(ZA + arr * 4 * ZS + HY_ZF(b, s8)) = w;
                    }
#pragma unroll 1
                    for (int o = 0; o < 2; ++o) {
                        const bf16_t* kf = (const bf16_t*)(ws + WS_KFL) + ((size_t)((l * 2 + 0) * 2 + o) * 256 + c) * SEQ;
                        const bf16_t* kb = (const bf16_t*)(ws + WS_KFL) + ((size_t)((l * 2 + 1) * 2 + o) * 256 + c) * SEQ;
                        { unsigned tv[16];
#pragma unroll
                          for (int q = 0; q < 16; ++q) { const int x = tid + 512 * q; tv[q] = x < 4096 ? kf[4095 - x] : (x <= 8190 ? kb[x - 4095] : (bf16_t)0); }
                          PIN16(tv);
#pragma unroll
                          for (int q = 0; q < 16; ++q) R0[tid + 512 * q] = (bf16_t)tv[q]; }
                        __syncthreads();
                        for (int x = tid; x < 8192; x += 512) R1[x] = x < 8191 ? R0[x + 1] : (bf16_t)0;
                        __syncthreads();
                        const LAS bf16_t* Z = ZA + (o == 0 ? 0 : 4 * ZS) + bq * ZS;
                        typedef float f32x16 __attribute__((ext_vector_type(16)));
                        f32x16 acc0, acc1;
#pragma unroll
                        for (int q = 0; q < 16; ++q) { acc0[q] = 0.f; acc1[q] = 0.f; }
                        const int dlo = 8 * wave - 63, dhi = 8 * wave + 7;
#define HY_AF(dst, off_) do { const LAS unsigned* a_ = ap + (off_); u32x4 w_ = {a_[0], a_[1], a_[2], a_[3]}; __builtin_memcpy(&dst, &w_, 16); } while (0)
                        {
                            bf16x8 f16, f24;
                            { const LAS unsigned* ap = Rdw + abase - 32 * dlo; HY_AF(f16, 16); HY_AF(f24, 24); }
#pragma unroll 1
                            for (int dl = dlo; dl <= dhi; ++dl) {
                                const int j = iblk - dl; const bool ok = (j >= 0) && (j < 64); const int jc = j < 0 ? 0 : (j > 63 ? 63 : j);
                                const LAS bf16_t* zp = Z + jc * 64; const int sw = (jc >> 1) & 1;
                                const LAS unsigned* ap = Rdw + abase - 32 * dl;
                                bf16x8 bf[4], fm16, fm8, f0, f8;
#pragma unroll
                                for (int kk = 0; kk < 4; ++kk) { bf16x8 t = *(const LAS bf16x8*)(zp + (((2 * kk + hh) ^ sw) << 3)); bf[kk] = ok ? t : (bf16x8){0, 0, 0, 0, 0, 0, 0, 0}; }
                                HY_AF(fm16, -16); HY_AF(fm8, -8); HY_AF(f0, 0); HY_AF(f8, 8);
                                acc0 = __builtin_amdgcn_mfma_f32_32x32x16_bf16(f0, bf[0], acc0, 0, 0, 0);  acc1 = __builtin_amdgcn_mfma_f32_32x32x16_bf16(fm16, bf[0], acc1, 0, 0, 0);
                                acc0 = __builtin_amdgcn_mfma_f32_32x32x16_bf16(f8, bf[1], acc0, 0, 0, 0);  acc1 = __builtin_amdgcn_mfma_f32_32x32x16_bf16(fm8, bf[1], acc1, 0, 0, 0);
                                acc0 = __builtin_amdgcn_mfma_f32_32x32x16_bf16(f16, bf[2], acc0, 0, 0, 0); acc1 = __builtin_amdgcn_mfma_f32_32x32x16_bf16(f0, bf[2], acc1, 0, 0, 0);
                                acc0 = __builtin_amdgcn_mfma_f32_32x32x16_bf16(f24, bf[3], acc0, 0, 0, 0); acc1 = __builtin_amdgcn_mfma_f32_32x32x16_bf16(f8, bf[3], acc1, 0, 0, 0);
                                f16 = fm16; f24 = fm8;
                            }
                        }
#undef HY_AF
                        const float inv = 1.0f / (nrm[(l * 2 + o) * 256 + c] + 1e-6f), hb = a.in[23][(l * 2 + o) * 256 + c];
                        LAS bf16_t* GI = ZA + (o + 1) * 4 * ZS;
                        const LAS bf16_t* ZI = ZA + (o == 0 ? 0 : 4 * ZS);
#pragma unroll
                        for (int q = 0; q < 16; ++q) {
                            const int a0r = (q & 3) + 8 * (q >> 2) + 4 * hh, t0 = 64 * iblk + a0r, t1 = t0 + 32;
                            const int i0 = HY_ZF(bq, t0), i1 = HY_ZF(bq, t1);
                            const float zv0 = bf2f(ZI[i0]), zv1 = bf2f(ZI[i1]);
                            const float y0 = bf2f(GI[i0]) * (acc0[q] * inv + hb * zv0), y1v = bf2f(GI[i1]) * (acc1[q] * inv + hb * zv1);
                            GI[i0] = f2bf(y0); GI[i1] = f2bf(y1v);
                        }
                        __syncthreads();
                    }
                    for (int it = tid; it < 4 * 512; it += 512) { const int b = it >> 9, s8 = (it & 511) * 8;
                        *(u32x4*)(YT + (size_t)c * RT + b * SEQ + s8) = *(const LAS u32x4*)(ZA + 2 * 4 * ZS + HY_ZF(b, s8)); }
                    if (l == 0) {
                        __syncthreads();
                        LAS float* zc = (LAS float*)lds;
                        LAS float* kc = zc + 3072;
                        LAS float* y1c = kc + 1024;
                        for (int it = tid; it < 3072; it += 512) { const int arr = it >> 10, b = (it >> 8) & 3, sx = it & 255, ch = arr * 256 + c;
                            const bf16_t* pp = PT + (size_t)ch * RT + RL + b * CTXL + sx;
                            float z = hcb[ch] + hcw[768 + ch] * bf2f(pp[0]); if (sx > 0) z += hcw[ch] * bf2f(pp[-1]); if (sx + 1 < CTXL) z += hcw[1536 + ch] * bf2f(pp[1]);
                            zc[it] = z; }
                        for (int it = tid; it < 1024; it += 512) { const int o = it >> 9, d = (it & 511) - 256;
                            const bf16_t* kfc = (const bf16_t*)(ws + WS_KFC) + ((size_t)(0 * 2 + o) * 256 + c) * CTXL; const bf16_t* kbc = (const bf16_t*)(ws + WS_KFC) + ((size_t)(1 * 2 + o) * 256 + c) * CTXL;
                            kc[it] = d >= 0 ? bf2f(kfc[d]) : (d > -256 ? bf2f(kbc[-d]) : 0.f); }
                        __syncthreads();
#pragma unroll 1
                        for (int o = 0; o < 2; ++o) {
                            const float inv = 1.0f / (nrm[1024 + o * 256 + c] + 1e-6f), hb = a.in[23][o * 256 + c];
                            for (int it = tid; it < 1024; it += 512) { const int b = it >> 8, t = it & 255;
                                const LAS float* zi = o == 0 ? zc + b * 256 : y1c + b * 256;
                                const LAS float* kk = kc + o * 512 + 256 + t;
                                float acc = 0.f;
#pragma unroll 16
                                for (int sx = 0; sx < CTXL; ++sx) acc += kk[-sx] * zi[sx];
                                const float y = zc[(o + 1) * 1024 + b * 256 + t] * (acc * inv + hb * zi[t]);
                                if (o == 0) y1c[it] = y; else YT[(size_t)c * RT + RL + b * CTXL + t] = f2bf(y); }
                            __syncthreads();
                        }
                    }
                }
#undef HY_ZF
                __syncthreads();
            }
            {
                const pg8::TabSched S{PARTS.p + 18 + l * 3, (const char*)ws, 1, 80, G, bid};
                pg8::EpiS5State E{(float*)(ws + WS_S5S)};
                pg8::gemm_phase<512, 256>(lds, S, E);
            }
        }
        SEAM(P0 + 2);
        if (((PHMASK >> 14) & 1) && IN(P0 + 3)) {
            const int tid = opaque(tid0), lane = tid & 63;
            LAS float* st = (LAS float*)lds;
            const float* S5S = (const float*)(ws + WS_S5S); bf16_t* US = (bf16_t*)(ws + WS_US);
            for (int u = bid; u < 128; u += G) {
                const int d = u & 1, g = (u >> 1) & 15, b = u >> 5;
                __syncthreads();
                for (int i = tid; i < 272 * 32; i += 512) { const int q = i >> 5, c4 = (i & 31) * 4; const int n = q < 16 ? 1024 + 16 * b + q : 256 * b + (q - 16);
                    const f32x4 v = *(const f32x4*)(S5S + ((size_t)g * NCHKP + n) * 256 + d * 128 + c4);
                    st[q * 128 + c4] = v[0]; st[q * 128 + c4 + 1] = v[1]; st[q * 128 + c4 + 2] = v[2]; st[q * 128 + c4 + 3] = v[3]; }
                __syncthreads();
                if (wave == 0) {
                    const float* ab = (const float*)(ws + WS_AB16) + ((size_t)((l * 2 + d) * 16 + g) * 64 + lane) * 2;
                    const float ar = ab[0], ai = ab[1];
                    float hr = 0.f, hi = 0.f;
                    for (int k = 0; k < 272; ++k) {
                        const int q = d == 0 ? k : (k < 16 ? 15 - k : 287 - k);
                        const int n = q < 16 ? 1024 + 16 * b + q : 256 * b + (q - 16);
                        *(unsigned*)(US + ((size_t)g * NCHKP + n) * 512 + 256 + d * 128 + 2 * lane) = cvt_pk_bf16(hr, hi);
                        const float sr = st[q * 128 + 2 * lane], si = st[q * 128 + 2 * lane + 1];
                        const float nr = ar * hr - ai * hi + sr, ni = ar * hi + ai * hr + si;
                        hr = nr; hi = ni;
                    }
                }
            }
            __syncthreads();
            for (int u = bid - 128; u >= 0 && u < 48; u += G) {
                const int cb6 = u % 6, d = (u / 6) & 1, b = u / 12;
                LAS f32x2* sa = (LAS f32x2*)lds;
                const f32x2* LAGG = (const f32x2*)(ws + WS_LAGG); float* HIN = (float*)(ws + WS_LHIN);
                __syncthreads();
                for (int i = tid; i < 272 * 64; i += 512) { const int q = i >> 6, c = i & 63; const int n = q < 16 ? 1024 + 16 * b + q : 256 * b + (q - 16);
                    sa[i] = LAGG[((size_t)n * 2 + d) * 384 + cb6 * 64 + c]; }
                __syncthreads();
                if (wave == 0) {
                    float h = 0.f;
                    for (int k = 0; k < 272; ++k) {
                        const int q = d == 0 ? k : (k < 16 ? 15 - k : 287 - k);
                        const int n = q < 16 ? 1024 + 16 * b + q : 256 * b + (q - 16);
                        HIN[((size_t)n * 2 + d) * 384 + cb6 * 64 + lane] = h;
                        const f32x2 v = sa[q * 64 + lane];
                        h = v[0] * h + v[1];
                    }
                }
            }
            __syncthreads();
        }
        SEAM(P0 + 3);
        if (((PHMASK >> 15) & 1) && IN(P0 + 4)) {
            const pg8::TabSched S{PARTS.p + 19 + l * 3, (const char*)ws, 1, 80, G, bid};
            pg8::EpiS5Main E{(bf16_t*)(ws + WS_GL), PR, a.in[32] + l * 256};
            pg8::gemm_phase<512, 512>(lds, S, E);
            {
                const int tid = opaque(tid0);
                const bf16_t* YT = (const bf16_t*)(ws + WS_YT);
                LAS bf16_t* tl = (LAS bf16_t*)lds;
                const int nrt = nMrow * 4;
                for (int t = bid; t < 4 * nrt; t += G) {
                    const int c0 = (t & 3) * 64, r0 = (t >> 2) * 64;
                    __syncthreads();
                    { const int cc = tid >> 3, r8 = (tid & 7) * 8; *(LAS u32x4*)(tl + cc * 72 + r8) = *(const u32x4*)(YT + (size_t)(c0 + cc) * RT + r0 + r8); }
                    __syncthreads();
                    { const int rr = tid >> 3, c8 = (tid & 7) * 8; unsigned short e[8];
#pragma unroll
                        for (int j = 0; j < 8; ++j) e[j] = tl[(c8 + j) * 72 + rr];
                        u32x4 w; w.x = e[0] | ((unsigned)e[1] << 16); w.y = e[2] | ((unsigned)e[3] << 16); w.z = e[4] | ((unsigned)e[5] << 16); w.w = e[6] | ((unsigned)e[7] << 16);
                        *(u32x4*)(YB + (size_t)(r0 + rr) * YW + YC_B + c0 + c8) = w; }
                }
                __syncthreads();
            }
            {
                const int tid = opaque(tid0);
                const bf16_t* LT = (const bf16_t*)(ws + WS_LT); const float* HIN = (const float*)(ws + WS_LHIN);
                const int nrows = nMrow * 256;
                for (int it = bid * 512 + tid; it < nrows * 48; it += G * 512) {
                    const int r = it / 48, c8 = (it - r * 48) * 8, n = r >> 4;
                    const u32x4 gt = *(const u32x4*)(PR + (size_t)r * LDP + PC_AG + c8);
                    const bf16_t* lt = LT + (size_t)r * 1152 + c8;
                    const u32x4 sv = *(const u32x4*)lt, pf = *(const u32x4*)(lt + 384), pb = *(const u32x4*)(lt + 768);
                    const float* hf = HIN + ((size_t)n * 2 + 0) * 384 + c8; const float* hb = hf + 384;
                    const f32x4 hf0 = *(const f32x4*)hf, hf1 = *(const f32x4*)(hf + 4), hb0 = *(const f32x4*)hb, hb1 = *(const f32x4*)(hb + 4);
                    u32x4 w;
                    w.x = cvt_pk_bf16(gelu_f(bflo(gt.x)) * (bflo(sv.x) + bflo(pf.x) * hf0[0] + bflo(pb.x) * hb0[0]), gelu_f(bfhi(gt.x)) * (bfhi(sv.x) + bfhi(pf.x) * hf0[1] + bfhi(pb.x) * hb0[1]));
                    w.y = cvt_pk_bf16(gelu_f(bflo(gt.y)) * (bflo(sv.y) + bflo(pf.y) * hf0[2] + bflo(pb.y) * hb0[2]), gelu_f(bfhi(gt.y)) * (bfhi(sv.y) + bfhi(pf.y) * hf0[3] + bfhi(pb.y) * hb0[3]));
                    w.z = cvt_pk_bf16(gelu_f(bflo(gt.z)) * (bflo(sv.z) + bflo(pf.z) * hf1[0] + bflo(pb.z) * hb1[0]), gelu_f(bfhi(gt.z)) * (bfhi(sv.z) + bfhi(pf.z) * hf1[1] + bfhi(pb.z) * hb1[1]));
                    w.w = cvt_pk_bf16(gelu_f(bflo(gt.w)) * (bflo(sv.w) + bflo(pf.w) * hf1[2] + bflo(pb.w) * hb1[2]), gelu_f(bfhi(gt.w)) * (bfhi(sv.w) + bfhi(pf.w) * hf1[3] + bfhi(pb.w) * hb1[3]));
                    *(u32x4*)(YB + (size_t)r * YW + YC_A + c8) = w;
                }
            }
        }
        SEAM(P0 + 4);
        if (((PHMASK >> 15) & 1) && IN(P0 + 5)) {
            const pg8::TabSched S{PARTS.p + 20 + l * 3, (const char*)ws, 1, nMrow, G, bid};
            pg8::EpiS5Glu E{YB, (const bf16_t*)(ws + WS_GL), a.in[34] + l * 256};
            pg8::gemm_phase<256, 256>(lds, S, E);
        }
        SEAM(P0 + 5);
        if (((PHMASK >> 3) & 1) && IN(P0 + 6)) {
            const pg8::MergeSched S{(const char*)ws, (long long)WS_YB, (long long)(WS_WL + (size_t)l * SZ_WL + SZ_WINR + SZ_WINHY), 64, G, bid, l == 0 ? 64 : 0};
            pg8::EpiGate E{ws + WS_GQ, UB, (bf16_t*)(ws + WS_MGC)};
            pg8::gemm_phase<1280, 1280>(lds, S, E);
        }
        SEAM(P0 + 6);
        if (((PHMASK >> 4) & 1) && IN(P0 + 7)) {
            const pg8::TabSched S{l == 0 ? PARTS.p + 24 : PARTS.p + 14, (const char*)ws, l == 0 ? 2 : 1, l == 0 ? 256 + 64 : 256, G, bid};
            pg8::EpiRes E{PRE, xlat, xctx, MODL + 2048, (float*)(ws + WS_EXTRA)};
            pg8::gemm_phase<1024, 1024>(lds, S, E);
        }
        SEAM(P0 + 7);
        if (((PHMASK >> 5) & 1) && IN(P0 + 8)) {
            const int lane = opaque(tid0) & 63;
            if (l == 1) convert_tiles(a, JT_MOE, (LAS float*)lds, bid, G);
            const float* lg = a.in[40] + l * D; const float* lb = a.in[41] + l * D;
            const int nrows = nMrow * 256;
            for (int r = bid * 8 + wave; r < nrows; r += G * 8) {
                const float* mv = MODL + (size_t)(r < RL ? (r >> 12) : 4) * 6144;
                RowV pre;
                if (r < RL) pre = row_load(PRE + (size_t)r * D, lane);
                else { const float* pp = (const float*)(ws + WS_EXTRA) + (size_t)(r - RL) * D; const RowV xin = row_load(ctx_in + (size_t)(r - RL) * D, lane), p0 = row_load(pp, lane), p1 = row_load(pp + (size_t)RC * D, lane), p2 = row_load(pp + (size_t)2 * RC * D, lane), p3 = row_load(pp + (size_t)3 * RC * D, lane);
#pragma unroll
                    for (int i = 0; i < 4; ++i) pre.v[i] = xin.v[i] * ALPHA + ((p0.v[i] + p1.v[i]) + (p2.v[i] + p3.v[i])); }
                const RowV x1 = row_affine(row_norm(pre), lg, lb, lane);
                row_store(r < RL ? a.out + (size_t)r * D : XSC + (size_t)(r - RL) * D, lane, x1);
                const RowV u2 = row_modulate(row_norm(x1), mv + 3072, mv + 4096, lane);
                row_store_bf16(UB + (size_t)r * D, lane, u2);
                if (l == 1) {
                    float lg8[8];
#pragma unroll
                    for (int e = 0; e < 8; ++e) lg8[e] = 0.f;
                    f32x4 rw[32];
#pragma unroll
                    for (int q = 0; q < 16; ++q) { const float* wp = a.in[47] + (size_t)(256 * (q >> 2) + 4 * lane + (q & 3)) * 8; rw[2 * q] = *(const f32x4*)wp; rw[2 * q + 1] = *(const f32x4*)(wp + 4); }
                    PIN16(rw); PIN16(rw + 16);
#pragma unroll
                    for (int i = 0; i < 4; ++i)
#pragma unroll
                        for (int j = 0; j < 4; ++j) { const float uv = u2.v[i][j];
                            const f32x4 w0 = rw[2 * (4 * i + j)], w1 = rw[2 * (4 * i + j) + 1];
                            lg8[0] += uv * w0[0]; lg8[1] += uv * w0[1]; lg8[2] += uv * w0[2]; lg8[3] += uv * w0[3]; lg8[4] += uv * w1[0]; lg8[5] += uv * w1[1]; lg8[6] += uv * w1[2]; lg8[7] += uv * w1[3]; }
#pragma unroll
                    for (int e = 0; e < 8; ++e) lg8[e] = wave_sum(lg8[e]);
                    if (lane == 0) {
                        int i1 = 0; float v1 = lg8[0];
#pragma unroll
                        for (int e = 1; e < 8; ++e) if (lg8[e] > v1) { v1 = lg8[e]; i1 = e; }
                        int i2 = 0; float v2 = -3.0e38f;
#pragma unroll
                        for (int e = 0; e < 8; ++e) if (e != i1 && lg8[e] > v2) { v2 = lg8[e]; i2 = e; }
                        const float e2 = expf(v2 - v1), w1 = 1.f / (1.f + e2), w2 = e2 / (1.f + e2);
                        int* tk = (int*)(ws + WS_TOK) + (size_t)r * 8;
                        tk[0] = i1; tk[1] = i2; ((float*)tk)[2] = w1; ((float*)tk)[3] = w2;
                        tk[4] = (int)atomicAdd(ctl + CW_MOECNT + 64 * i1, 1u); tk[5] = (int)atomicAdd(ctl + CW_MOECNT + 64 * i2, 1u);
                    }
                }
            }
        }
        SEAM(P0 + 8);
        if (l == 0) {
            if (((PHMASK >> 6) & 1) && IN(P0 + 9)) {
                const pg8::TabSched S{PARTS.p + 16, (const char*)ws, 1, 68 * 22, G, bid};
                pg8::EpiSwiglu E{(bf16_t*)(ws + WS_H), FF_DENSE, 0};
                pg8::gemm_phase<1024, 1024>(lds, S, E);
            }
            SEAM(P0 + 9);
            if (((PHMASK >> 7) & 1) && IN(P0 + 10)) {
                const pg8::TabSched S{PARTS.p + 26, (const char*)ws, 3, 256 + 48 + 16, G, bid};
                pg8::EpiRes E{PRE, a.out, XSC, MODL + 5120, (float*)(ws + WS_EXTRA)};
                pg8::gemm_phase<FF_DENSE, FF_DENSE>(lds, S, E);
            }
            SEAM(P0 + 10);
            if (((PHMASK >> 8) & 1) && IN(P0 + 11)) {
                const int lane = opaque(tid0) & 63;
                const float* lg = a.in[42]; const float* lb = a.in[43];
                const float* MODN = MOD + (size_t)5 * 6144;
                for (int r = bid * 8 + wave; r < RT; r += G * 8) {
                    const float* mv = MODN + (size_t)(r < RL ? (r >> 12) : 4) * 6144;
                    RowV pre;
                    if (r < RL) pre = row_load(PRE + (size_t)r * D, lane);
                    else { const float* pp = (const float*)(ws + WS_EXTRA) + (size_t)(r - RL) * D; const RowV xin = row_load(XSC + (size_t)(r - RL) * D, lane), p0 = row_load(pp, lane), p1 = row_load(pp + (size_t)RC * D, lane), p2 = row_load(pp + (size_t)2 * RC * D, lane), p3 = row_load(pp + (size_t)3 * RC * D, lane);
#pragma unroll
                        for (int i = 0; i < 4; ++i) pre.v[i] = xin.v[i] * ALPHA + ((p0.v[i] + p1.v[i]) + (p2.v[i] + p3.v[i])); }
                    const RowV x2 = row_affine(row_norm(pre), lg, lb, lane);
                    row_store(r < RL ? a.out + (size_t)r * D : XSC + (size_t)(r - RL) * D, lane, x2);
                    row_store_bf16(UB + (size_t)r * D, lane, row_modulate(row_norm(x2), mv, mv + 1024, lane));
                }
            }
            SEAM(P0 + 11);
        } else {
            bf16_t* AG = (bf16_t*)(ws + WS_AG); float* slotw = (float*)(ws + WS_SLOTW); int* tile_e = (int*)(ws + WS_TILEE);
            if (((PHMASK >> 9) & 1) && IN(P0 + 9)) {
                const int tid = opaque(tid0), lane = tid & 63;
                int ts[NE + 1]; ts[0] = 0;
#pragma unroll
                for (int e = 0; e < NE; ++e) { const unsigned c = __hip_atomic_load(ctl + CW_MOECNT + 64 * e, __ATOMIC_RELAXED, __HIP_MEMORY_SCOPE_AGENT); ts[e + 1] = ts[e] + (int)((c + 255u) >> 8); }
                if (bid == 0) for (int mt = tid; mt < ts[NE]; mt += 512) { int e = 0;
#pragma unroll
                    for (int k = 1; k < NE; ++k) e += (mt >= ts[k]) ? 1 : 0;
                    tile_e[mt] = e; }
                for (int r = bid * 8 + wave; r < RL; r += G * 8) {
                    int* tk = (int*)(ws + WS_TOK) + (size_t)r * 8;
                    const u32x4 v0 = *(const u32x4*)(UB + (size_t)r * D + lane * 16), v1 = *(const u32x4*)(UB + (size_t)r * D + lane * 16 + 8);
#pragma unroll
                    for (int k = 0; k < 2; ++k) {
                        const int e = tk[k], pos = tk[4 + k];
                        int st = 0;
#pragma unroll
                        for (int q = 0; q < NE; ++q) st = (e == q) ? ts[q] : st;
                        const int srow = st * 256 + pos;
                        *(u32x4*)(AG + (size_t)srow * D + lane * 16) = v0; *(u32x4*)(AG + (size_t)srow * D + lane * 16 + 8) = v1;
                        if (lane == 0) { slotw[srow] = ((const float*)tk)[2 + k]; tk[6 + k] = srow; }
                    }
                }
            }
            SEAM(P0 + 9);
            int ttl = 0;
            if (lo <= P0 + 13 && P0 + 10 < hi) {
#pragma unroll
                for (int e = 0; e < NE; ++e) { const unsigned c = __hip_atomic_load(ctl + CW_MOECNT + 64 * e, __ATOMIC_RELAXED, __HIP_MEMORY_SCOPE_AGENT); ttl += (int)((c + 255u) >> 8); }
                ttl = __builtin_amdgcn_readfirstlane(ttl);
            }
#pragma unroll
            for (int pass = 0; pass < 2; ++pass) {
                const int tile0 = pass * MOE_P0; int ntile = pass == 0 ? (ttl < MOE_P0 ? ttl : MOE_P0) : ttl - MOE_P0; ntile = ntile < 0 ? 0 : (ntile > MOE_HCAP ? MOE_HCAP : ntile);
                if (((PHMASK >> 10) & 1) && IN(P0 + 10 + 2 * pass)) {
                    const pg8::MoeSched S{(const char*)AG + (size_t)tile0 * 256 * 1024 * 2, (const char*)(ws + WS_MOEGU), tile_e, 256u * 1024u * 2u, 256u * 1024u * 2u, (size_t)2 * FF_E * 1024 * 2, 28, 16, tile0, ntile, G, bid};
                    pg8::EpiSwiglu E{(bf16_t*)(ws + WS_HM), FF_E, tile0};
                    pg8::gemm_phase<1024, 1024>(lds, S, E);
                }
                SEAM(P0 + 10 + 2 * pass);
                if (((PHMASK >> 11) & 1) && IN(P0 + 11 + 2 * pass)) {
                    pg8::EpiMoeDown E{AG, slotw, (float*)(ws + WS_O2X)};
                    { const int nfull = pass == 0 ? ntile : (ttl < 128 ? ttl : 128) - MOE_P0, nex = pass == 0 ? 0 : ttl - 128;
                        const pg8::MoeTailSched S{(const char*)(ws + WS_HM), (const char*)(ws + WS_MOED), tile_e, tile0, nfull < 0 ? 0 : nfull, nex < 0 ? 0 : nex, G, bid};
                        pg8::gemm_phase<FF_E, FF_E>(lds, S, E); }
                }
                SEAM(P0 + 11 + 2 * pass);
            }
            if (((PHMASK >> 12) & 1) && IN(P0 + 14)) {
                const int lane = opaque(tid0) & 63;
                const float* lg = a.in[42] + D; const float* lb = a.in[43] + D;
                for (int r = bid * 8 + wave; r < RL; r += G * 8) {
                    const int* tk = (const int*)(ws + WS_TOK) + (size_t)r * 8;
                    const int sa = tk[6], sb = tk[7];
                    const bf16_t* oa = AG + (size_t)sa * D; const bf16_t* ob = AG + (size_t)sb * D;
                    const float* gv = MODL + (size_t)(r >> 12) * 6144 + 5120;
                    RowV x1 = row_load(a.out + (size_t)r * D, lane), gq = row_load(gv, lane), pre;
                    u32x2 va[4], vb[4];
#pragma unroll
                    for (int i = 0; i < 4; ++i) { va[i] = *(const u32x2*)(oa + 256 * i + 4 * lane); vb[i] = *(const u32x2*)(ob + 256 * i + 4 * lane); }
                    asm volatile("" : "+v"(va[0]), "+v"(va[1]), "+v"(va[2]), "+v"(va[3]), "+v"(vb[0]), "+v"(vb[1]), "+v"(vb[2]), "+v"(vb[3]), "+v"(x1.v[0]), "+v"(x1.v[1]), "+v"(x1.v[2]), "+v"(x1.v[3]), "+v"(gq.v[0]), "+v"(gq.v[1]), "+v"(gq.v[2]), "+v"(gq.v[3]));
#pragma unroll
                    for (int i = 0; i < 4; ++i) {
                        f32x4 fa = {bflo(va[i].x), bfhi(va[i].x), bflo(va[i].y), bfhi(va[i].y)}, fb = {bflo(vb[i].x), bfhi(vb[i].x), bflo(vb[i].y), bfhi(vb[i].y)};
                        if (sa >= 128 * 256) { const float* px = (const float*)(ws + WS_O2X) + (size_t)(sa - 128 * 256) * D + 256 * i + 4 * lane; fa = (*(const f32x4*)px + *(const f32x4*)(px + (size_t)2048 * D)) + (*(const f32x4*)(px + (size_t)2 * 2048 * D) + *(const f32x4*)(px + (size_t)3 * 2048 * D)); }
                        if (sb >= 128 * 256) { const float* px = (const float*)(ws + WS_O2X) + (size_t)(sb - 128 * 256) * D + 256 * i + 4 * lane; fb = (*(const f32x4*)px + *(const f32x4*)(px + (size_t)2048 * D)) + (*(const f32x4*)(px + (size_t)2 * 2048 * D) + *(const f32x4*)(px + (size_t)3 * 2048 * D)); }
                        pre.v[i] = x1.v[i] * ALPHA + gq.v[i] * (fa + fb); }
                    row_store(a.out + (size_t)r * D, lane, row_affine(row_norm(pre), lg, lb, lane));
                }
            }
        }
    }
#undef IN
#undef SEAM
}

}

extern "C" void kernel_launch(void* const* d_in, const int* in_sizes, int n_in, void* d_out, int out_size, void* d_ws, size_t ws_size, hipStream_t stream) {
    static int grid = 0;
    if (grid == 0) {
        if (n_in != 51 || ws_size < WS_END) { grid = -1; return; }
        int dev = 0, cus = 0;
        if (hipGetDevice(&dev) != hipSuccess || hipDeviceGetAttribute(&cus, hipDeviceAttributeMultiprocessorCount, dev) != hipSuccess) { grid = -1; return; }
        if (hipFuncSetAttribute((const void*)mk_fwd, hipFuncAttributeMaxDynamicSharedMemorySize, LDS_BYTES) != hipSuccess) { grid = -1; return; }
        grid = cus;
    }
    if (grid < 0) return;
    const float* const* in = (const float* const*)d_in;
    unsigned char* ws = (unsigned char*)d_ws;
    (void)hipMemsetAsync(ws + WS_CTL, 0, CTL_BYTES + al256(2 * 5 * 6144 * 4), stream);
    for (int l = 0; l < 2; ++l) (void)hipMemsetAsync(ws + WS_WL + (size_t)l * SZ_WL + SZ_WINR + (size_t)1152 * 1024 * 2, 0, (size_t)128 * 1024 * 2, stream);
    Args a{};
    for (int i = 0; i < 51; ++i) a.in[i] = in[i];
    a.out = (float*)d_out; a.ws = ws;
    int nlaunch = 0;
    auto run1 = [&](int lo, int hi) { a.ph_lo = lo; a.ph_hi = hi; a.bar_region = nlaunch < 5 ? nlaunch : 5; nlaunch++; hipLaunchKernelGGL(mk_fwd, dim3(grid), dim3(512), LDS_BYTES, stream, a); };
    auto run = [&](int lo, int hi) {
#if defined(SPLIT) && SPLIT
        for (int k = lo; k < hi; ++k) { const int q = (k - 1) % NPH_LAYER, l = (k - 1) / NPH_LAYER; if (k > 0 && (q > 14 || (l == 0 && q > 11) || (l == 1 && q == 0))) continue; run1(k, k + 1); }
#else
        run1(lo, hi);
#endif
    };
    run(0, 1 + 2 * NPH_LAYER);
}
```

```cpp
#include <hip/hip_runtime.h>
#include <stdint.h>
#include <math.h>

#define LAS __attribute__((address_space(3)))
typedef unsigned short bf16_t;
typedef short bf16x8 __attribute__((ext_vector_type(8)));
typedef float f32x4 __attribute__((ext_vector_type(4)));
typedef float f32x2 __attribute__((ext_vector_type(2)));
typedef unsigned u32x4 __attribute__((ext_vector_type(4)));
typedef unsigned u32x2 __attribute__((ext_vector_type(2)));

namespace {
constexpr int D = 1024, NB = 4, SEQ = 4096, CTXL = 256;
constexpr int RL = NB * SEQ, RC = NB * CTXL, RT = RL + RC;
constexpr int IN_COLS = 7040;
constexpr int FF_DENSE = 2816, NE = 8, FF_E = 3584;
constexpr float ALPHA = 1.41421356237309515f;
constexpr int LDP = 1792, PC_AG = 0, PC_AC = 384, PC_D = 768, PC_Q = 1024, PC_K = 1408, PC_G = 1792;
constexpr int NPT = 1280, PT_V = 768;
constexpr int YW = 1280, YC_A = 0, YC_B = 384, YC_C = 640, YC_D = 1024;
constexpr int MOE_P0 = 64, MOE_HCAP = 72;
constexpr int MOE_ROWS_MAX = 2 * RL + NE * 256;

constexpr size_t al256(size_t x) { return (x + 255) & ~(size_t)255; }
constexpr size_t WS_CTL = 0, CTL_BYTES = 131072;
constexpr int CW_BAR = 0;
constexpr int CW_MOECNT = 24576;
constexpr int CW_QUEUE = 28672;
constexpr int CW_HYN = 29696;
constexpr size_t WS_MOD = WS_CTL + CTL_BYTES;
constexpr size_t WS_HYN = WS_MOD + al256(2 * 5 * 6144 * 4);
constexpr size_t WS_S5AB = WS_HYN + 4096;
constexpr size_t WS_S5BB = WS_S5AB + 16384;
constexpr size_t WS_AB16 = WS_S5BB + 262144;
constexpr size_t WS_TILEE = WS_AB16 + 32768;
constexpr size_t WS_TOK = WS_TILEE + 1024;
constexpr size_t WS_SLOTW = WS_TOK + (size_t)RL * 32;
constexpr size_t WS_KFL = al256(WS_SLOTW + (size_t)MOE_ROWS_MAX * 4);
constexpr size_t WS_KFC = WS_KFL + (size_t)2 * 1024 * SEQ * 2;
constexpr size_t WS_XSC = WS_KFC + (size_t)1024 * CTXL * 2;
constexpr size_t WS_UB = WS_XSC + (size_t)RC * D * 4;
constexpr size_t SZ_WINR = (size_t)(1792 + 4096) * 1024 * 2, SZ_WINHY = (size_t)NPT * 1024 * 2, SZ_WBR = (size_t)1024 * 1280 * 2, SZ_WOUT = (size_t)1024 * 1024 * 2;
constexpr size_t SZ_WL = SZ_WINR + SZ_WINHY + SZ_WBR + SZ_WOUT;
constexpr size_t WS_WL = WS_UB + (size_t)RT * D * 2;
constexpr size_t WS_FFGU = WS_WL + 2 * SZ_WL;
constexpr size_t WS_FFD = WS_FFGU + (size_t)2 * FF_DENSE * 1024 * 2;
constexpr size_t WS_WGLU = WS_FFD + (size_t)1024 * FF_DENSE * 2;
constexpr size_t WS_OPS = WS_WGLU + (size_t)2 * 256 * 256 * 2;
constexpr size_t WS_OPY = WS_OPS + (size_t)32 * 256 * 256 * 2;
constexpr size_t WS_LW = WS_OPY + (size_t)32 * 256 * 512 * 2;
constexpr size_t WS_PR = WS_LW + (size_t)48 * 4096 * 2;
constexpr size_t WS_PT = WS_PR + (size_t)RT * 5888 * 2;
constexpr size_t WS_GQ = WS_PR + (size_t)RT * LDP * 2;
constexpr size_t WS_YB = WS_PT + (size_t)NPT * RT * 2;
constexpr size_t WS_PRE = WS_YB + (size_t)RT * YW * 2;
constexpr size_t WS_EXTRA = WS_PRE + (size_t)RT * D * 4;
constexpr size_t SZ_EXTRA = (size_t)2 * RT * 384 * 4 + (size_t)RT * 256 * 4;
constexpr size_t WS_END = WS_EXTRA + SZ_EXTRA;
constexpr int NCHK = RT / 16, NCHKP = 1280;
constexpr size_t WS_US = WS_PRE;
constexpr size_t WS_S5S = WS_US + (size_t)16 * NCHKP * 512 * 2;
constexpr size_t WS_GL = WS_S5S + (size_t)16 * NCHKP * 256 * 4;
static_assert(WS_GL + (size_t)RT * 256 * 2 <= WS_EXTRA, "s5 overlay");
constexpr size_t WS_H = WS_PR;
constexpr size_t WS_MOEGU = WS_PR;
constexpr size_t WS_MOED = WS_MOEGU + (size_t)NE * 2 * FF_E * 1024 * 2;
constexpr size_t WS_HM = WS_MOED + (size_t)NE * 1024 * FF_E * 2;
constexpr size_t WS_LT = WS_EXTRA;
constexpr size_t WS_LAGG = WS_LT + (size_t)RT * 3 * 384 * 2;
constexpr size_t WS_LHIN = WS_LAGG + (size_t)NCHK * 2 * 384 * 8;
constexpr size_t WS_YT = WS_LHIN + (size_t)NCHK * 2 * 384 * 4;
static_assert(WS_YT + (size_t)256 * RT * 2 <= WS_EXTRA + SZ_EXTRA, "lru / hyena overlay");
constexpr size_t WS_MGC = WS_EXTRA + (size_t)4 * RC * D * 4;
constexpr size_t WS_AG = WS_EXTRA;
static_assert(WS_HM + (size_t)MOE_HCAP * 256 * FF_E * 2 <= WS_EXTRA, "moe hidden overlay");
constexpr size_t WS_O2X = WS_PRE + ((size_t)32 << 20);
static_assert(WS_HM + (size_t)MOE_HCAP * 256 * FF_E * 2 <= WS_O2X && WS_O2X + (size_t)4 * 2048 * D * 4 <= WS_EXTRA, "moe excess sums");
static_assert((size_t)MOE_ROWS_MAX * 1024 * 2 <= SZ_EXTRA, "moe gather overlay");
static_assert((size_t)RT * FF_DENSE * 2 <= (size_t)RT * 5888 * 2 && WS_GQ + (size_t)RT * 4096 <= WS_PT, "dense hidden overlay / gate bytes");

__device__ __forceinline__ float sigm(float x) { return __builtin_amdgcn_rcpf(1.f + __builtin_amdgcn_exp2f(-1.44269504089f * x)); }
__device__ __forceinline__ float sigm_acc(float x) { return 1.f / (1.f + expf(-x)); }
__device__ __forceinline__ float silu_acc(float x) { return x / (1.f + expf(-x)); }
__device__ __forceinline__ float gelu_t(float x) { return 0.5f * x * (1.f + tanhf(0.7978845608028654f * (x + 0.044715f * x * x * x))); }
__device__ __forceinline__ float gelu_f(float x) { return x * sigm(1.5957691216057308f * (x + 0.044715f * x * x * x)); }
__device__ __forceinline__ float softplus(float x) { return fmaxf(x, 0.f) + log1pf(expf(-fabsf(x))); }
__device__ __forceinline__ float wave_sum(float v) { for (int o = 32; o; o >>= 1) v += __shfl_xor(v, o); return v; }
__device__ __forceinline__ float wave_max(float v) { for (int o = 32; o; o >>= 1) v = fmaxf(v, __shfl_xor(v, o)); return v; }
__device__ __forceinline__ float bf2f(bf16_t b) { return __uint_as_float(((unsigned)b) << 16); }
__device__ __forceinline__ bf16_t f2bf(float f) { unsigned u = __float_as_uint(f); u += 0x7FFFu + ((u >> 16) & 1u); return (bf16_t)(u >> 16); }
__device__ __forceinline__ unsigned cvt_pk_bf16(float lo, float hi) { unsigned r; asm volatile("v_cvt_pk_bf16_f32 %0, %1, %2" : "=v"(r) : "v"(lo), "v"(hi)); return r; }
__device__ __forceinline__ float bflo(unsigned w) { return __uint_as_float(w << 16); }
__device__ __forceinline__ float bfhi(unsigned w) { return __uint_as_float(w & 0xFFFF0000u); }
__device__ __forceinline__ void row_seq(int r, int& start, int& len, int& pos, int& b) {
    if (r < RL) { b = r >> 12; start = b << 12; len = SEQ; pos = r & 4095; }
    else { const int q = r - RL; b = q >> 8; start = RL + (b << 8); len = CTXL; pos = q & 255; }
}

#define XB_TMO      128
#define XB_XCNT(j)  (256  + 64 * (j))
#define XB_XSUB(j)  (1280 + 64 * (j))
#define XB_XGEN(j)  (2304 + 64 * (j))
#define XB_TOP      3328
#define XB_TOPGEN   3392
#define XCD_BAR_WORDS 3456
#define XB_SPIN_CAP (1u << 18)
__device__ __forceinline__ unsigned xb_ld(unsigned* p)              { return __hip_atomic_load(p, __ATOMIC_RELAXED, __HIP_MEMORY_SCOPE_AGENT); }
__device__ __forceinline__ unsigned xb_add(unsigned* p, unsigned v) { return __hip_atomic_fetch_add(p, v, __ATOMIC_RELAXED, __HIP_MEMORY_SCOPE_AGENT); }
__device__ __forceinline__ unsigned xb_xcc_id() { return (unsigned)__builtin_amdgcn_s_getreg((3 << 11) | 20) & 0xFu; }
#define XB_SPIN(cond, bar) do { unsigned _sp = 0; while (cond) { __builtin_amdgcn_s_sleep(1); \
    if ((++_sp & 255u) == 0u) { if (xb_ld(&(bar)[XB_TMO])) break; if (_sp > XB_SPIN_CAP) { atomicAdd(&(bar)[XB_TMO], 1u); break; } } } } while (0)
struct XcdBarrier { unsigned* bar; unsigned x; volatile LAS unsigned* st; };
__device__ __forceinline__ XcdBarrier xcd_barrier_post(unsigned* bar, volatile LAS unsigned* st) {
    XcdBarrier b; b.bar = bar; b.x = xb_xcc_id(); b.st = st;
    if (threadIdx.x == 0) (void)xb_add(&bar[XB_XCNT(b.x)], 1u);
    return b;
}
__device__ __forceinline__ void xcd_barrier_complete(unsigned* bar, unsigned x, unsigned& nloc, unsigned& nx) {
    const unsigned G = gridDim.x * gridDim.y * gridDim.z;
    unsigned sum, cnt, mine, sp = 0u;
    for (;;) {
        sum = 0u; cnt = 0u; mine = 0u;
#pragma unroll
        for (unsigned j = 0; j < 16; ++j) { const unsigned c = xb_ld(&bar[XB_XCNT(j)]); sum += c; cnt += (c > 0u) ? 1u : 0u; mine = (j == x) ? c : mine; }
        if (sum == G) break;
        __builtin_amdgcn_s_sleep(1);
        if ((++sp & 255u) == 0u) { if (xb_ld(&bar[XB_TMO])) break; if (sp > XB_SPIN_CAP) { atomicAdd(&bar[XB_TMO], 1u); break; } }
    }
    nloc = mine > 0u ? mine : 1u; nx = cnt > 0u ? cnt : 1u;
}
__device__ __forceinline__ void xcd_barrier(const XcdBarrier& b) {
    asm volatile("s_waitcnt vmcnt(0)" ::: "memory");
    __syncthreads();
    if (threadIdx.x == 0) {
        unsigned* bar = b.bar;
        __builtin_amdgcn_s_waitcnt(0);
        unsigned nloc = b.st[0], nx = b.st[1];
        if (nloc == 0u) { xcd_barrier_complete(bar, b.x, nloc, nx); b.st[0] = nloc; b.st[1] = nx; }
        const unsigned old = xb_add(&bar[XB_XSUB(b.x)], 1u);
        const unsigned gen = old / nloc;
        if (old + 1u == (gen + 1u) * nloc) {
            __builtin_amdgcn_fence(__ATOMIC_RELEASE, "agent");
            asm volatile("s_waitcnt vmcnt(0)" ::: "memory");
            const unsigned og = xb_add(&bar[XB_TOP], 1u);
            const unsigned tg = og / nx;
            if (og + 1u == (tg + 1u) * nx) xb_add(&bar[XB_TOPGEN], 1u);
            else XB_SPIN(xb_ld(&bar[XB_TOPGEN]) == tg, bar);
            __builtin_amdgcn_fence(__ATOMIC_ACQUIRE, "agent");
            xb_add(&bar[XB_XGEN(b.x)], 1u);
            asm volatile("s_waitcnt vmcnt(0)" ::: "memory");
        } else {
            XB_SPIN(xb_ld(&bar[XB_XGEN(b.x)]) == gen, bar);
            __builtin_amdgcn_fence(__ATOMIC_ACQUIRE, "agent");
            asm volatile("s_waitcnt vmcnt(0)" ::: "memory");
        }
    }
    __syncthreads();
}

namespace pg8 {
constexpr int BM = 256, BK = 64, HALF = 128, HTB = HALF * BK * 2, STAGE_BYTES = 8 * HTB, NXCD = 8, WGM = 8;
__host__ __device__ __forceinline__ int lds_byte(int r, int c) { const int st = (r >> 4) * 2 + (c >> 5), rr = r & 15, cc = c & 31, ob = rr * 64 + cc * 2; return st * 1024 + (ob ^ (((ob >> 9) & 1) << 5)); }
__host__ __device__ __forceinline__ void stage_rc(int b, int& R, int& C) { const int st = b / 1024, sb = b % 1024, swz = sb ^ (((sb >> 9) & 1) << 5); R = (st >> 1) * 16 + swz / 64; C = (st & 1) * 32 + (swz % 64) / 2; }
__host__ __device__ __forceinline__ int perm32(int rho) { const int n = rho >> 4, i = rho & 15; return 8 * (i >> 2) + 4 * n + (i & 3); }

struct Unit { const char* a; const char* b; int nt; int pm, pn, kind; };

__device__ __forceinline__ void rect_map(int wgid, int nM, int nN, int& pm, int& pn) {
    const int nwg = nM * nN;
    { const int q = nwg / NXCD, r = nwg % NXCD, xcd = wgid % NXCD, off = wgid / NXCD; wgid = (xcd < r ? xcd * (q + 1) : r * (q + 1) + (xcd - r) * q) + off; }
    const int nig = WGM * nN, gid = wgid / nig, fm = gid * WGM, gsz = (nM - fm) < WGM ? (nM - fm) : WGM;
    pm = fm + ((wgid % nig) % gsz); pn = (wgid % nig) / gsz;
}

template <int lda, int ldb, class Epi, class Sched>
__device__ __forceinline__ void gemm_phase(LAS unsigned char* lds, const Sched& S, const Epi& E) {
    int tid_ = threadIdx.x; asm volatile("" : "+v"(tid_));
    const int tid = tid_, wid = __builtin_amdgcn_readfirstlane(tid >> 6), lane = tid & 63, wr = wid >> 2, wc = wid & 3, fr = lane & 15, fq = lane >> 4;
    unsigned voffA[2], voffB[2];
#pragma unroll
    for (int i = 0; i < 2; ++i) { int R, C; stage_rc(tid * 16 + i * 8192, R, C); const int Rb = (R & ~31) + perm32(R & 31);
        voffA[i] = (unsigned)(R * lda + C) * 2u; voffB[i] = (unsigned)(Rb * ldb + C) * 2u; }
    const size_t kstep = (size_t)(BK * 2);
    const size_t hstepA = (size_t)HALF * lda * 2, hstepB = (size_t)HALF * ldb * 2;
    const unsigned ldsw = (unsigned)wid * 1024u;
    const int aoff = lds_byte(wr * 64 + fr, fq * 8), boff = lds_byte(wc * 32 + fr, fq * 8);
#define PG8_SA(b, h) (((b) * 2 + (h)) * HTB)
#define PG8_SB(b, h) ((4 + (b) * 2 + (h)) * HTB)
#define PG8_STAGE(bufoff, gbase, voff) do { _Pragma("unroll") for (int _i = 0; _i < 2; ++_i) \
        __builtin_amdgcn_global_load_lds((const unsigned*)((const char*)(gbase) + (voff)[_i]), (LAS unsigned*)(lds + (bufoff) + ldsw + _i * 8192), 16, 0, 0); } while (0)
#define PG8_LDA(dst, b, h) do { _Pragma("unroll") for (int m = 0; m < 4; ++m) _Pragma("unroll") for (int k = 0; k < 2; ++k) dst[m][k] = *(const LAS bf16x8*)(lds + PG8_SA(b, h) + aoff + m * 2048 + k * 1024); } while (0)
#define PG8_LDB(dst, b, h) do { _Pragma("unroll") for (int n = 0; n < 2; ++n) _Pragma("unroll") for (int k = 0; k < 2; ++k) dst[n][k] = *(const LAS bf16x8*)(lds + PG8_SB(b, h) + boff + n * 2048 + k * 1024); } while (0)
#define PG8_MMA(ai, bj, At, Bt) do { __builtin_amdgcn_s_setprio(1); _Pragma("unroll") for (int m = 0; m < 4; ++m) _Pragma("unroll") for (int n = 0; n < 2; ++n) _Pragma("unroll") for (int k = 0; k < 2; ++k) \
        acc[ai][bj][m][n] = __builtin_amdgcn_mfma_f32_16x16x32_bf16(Bt[n][k], At[m][k], acc[ai][bj][m][n], 0, 0, 0); __builtin_amdgcn_s_setprio(0); } while (0)
#define PG8_WAIT_V(n) asm volatile("s_waitcnt vmcnt(" #n ")" ::: "memory")
#define PG8_WAIT_L(n) asm volatile("s_waitcnt lgkmcnt(" #n ")" ::: "memory")
#define PG8_BAR __builtin_amdgcn_s_barrier()
#define PG8_SCHED __builtin_amdgcn_sched_barrier(0)
    Unit cur, nxt; int ui = 0;
    if (!S.next(0, cur)) return;
    f32x4 acc[2][2][4][2];
#pragma unroll
    for (int a = 0; a < 2; ++a)
#pragma unroll
        for (int b = 0; b < 2; ++b)
#pragma unroll
            for (int m = 0; m < 4; ++m)
#pragma unroll
                for (int n = 0; n < 2; ++n) acc[a][b][m][n] = (f32x4){0.f, 0.f, 0.f, 0.f};
    bf16x8 At[4][2], B0[2][2], B1[2][2];
    const char* cA = cur.a; const char* cB = cur.b;
    PG8_STAGE(PG8_SB(0, 0), cB, voffB); PG8_STAGE(PG8_SA(0, 0), cA, voffA); PG8_STAGE(PG8_SB(0, 1), cB + hstepB, voffB); PG8_STAGE(PG8_SA(0, 1), cA + hstepA, voffA);
    if (wr == 1) PG8_BAR;
    PG8_WAIT_V(4); PG8_BAR;
    PG8_STAGE(PG8_SB(1, 0), cB + kstep, voffB); PG8_STAGE(PG8_SA(1, 0), cA + kstep, voffA); PG8_STAGE(PG8_SB(1, 1), cB + hstepB + kstep, voffB);
    PG8_WAIT_V(6); PG8_BAR;
    for (;;) {
        const bool has_next = S.next(ui + 1, nxt);
        const char* nA = has_next ? nxt.a : cA; const char* nB = has_next ? nxt.b : cB;
        const int nt = cur.nt;
        for (int t = 0; t < nt; t += 2) {
            const bool last = (t == nt - 2);
            const char* a1 = cA + (size_t)(t + 1) * kstep;
            const char* a2 = last ? nA : cA + (size_t)(t + 2) * kstep; const char* b2 = last ? nB : cB + (size_t)(t + 2) * kstep;
            const char* a3 = a2 + kstep; const char* b3 = b2 + kstep;
            PG8_LDB(B0, 0, 0); PG8_SCHED; PG8_LDA(At, 0, 0); PG8_STAGE(PG8_SA(1, 1), a1 + hstepA, voffA);
            PG8_WAIT_L(8); PG8_BAR; PG8_WAIT_L(0); PG8_MMA(0, 0, At, B0); PG8_BAR; PG8_SCHED;
            PG8_LDB(B1, 0, 1); PG8_STAGE(PG8_SB(0, 0), b2, voffB);
            PG8_BAR; PG8_WAIT_L(0); PG8_MMA(0, 1, At, B1); PG8_BAR;
            PG8_LDA(At, 0, 1); PG8_STAGE(PG8_SA(0, 0), a2, voffA);
            PG8_BAR; PG8_WAIT_L(0); PG8_MMA(1, 0, At, B0); PG8_BAR; PG8_SCHED;
            PG8_STAGE(PG8_SB(0, 1), b2 + hstepB, voffB);
            PG8_WAIT_V(6); PG8_BAR; PG8_MMA(1, 1, At, B1); PG8_BAR;
            PG8_LDB(B0, 1, 0); PG8_SCHED; PG8_LDA(At, 1, 0); PG8_STAGE(PG8_SA(0, 1), a2 + hstepA, voffA);
            PG8_WAIT_L(8); PG8_BAR; PG8_WAIT_L(0); PG8_MMA(0, 0, At, B0); PG8_BAR; PG8_SCHED;
            PG8_LDB(B1, 1, 1); PG8_STAGE(PG8_SB(1, 0), b3, voffB);
            PG8_BAR; PG8_WAIT_L(0); PG8_MMA(0, 1, At, B1); PG8_BAR;
            PG8_LDA(At, 1, 1); PG8_STAGE(PG8_SA(1, 0), a3, voffA);
            PG8_BAR; PG8_WAIT_L(0); PG8_MMA(1, 0, At, B0); PG8_BAR; PG8_SCHED;
            PG8_STAGE(PG8_SB(1, 1), b3 + hstepB, voffB);
            PG8_WAIT_V(6); PG8_BAR; PG8_MMA(1, 1, At, B1); PG8_BAR;
        }
        E(acc, cur, wr, wc, fr, fq);
        if (!has_next) break;
#pragma unroll
        for (int a = 0; a < 2; ++a)
#pragma unroll
            for (int b = 0; b < 2; ++b)
#pragma unroll
                for (int m = 0; m < 4; ++m)
#pragma unroll
                    for (int n = 0; n < 2; ++n) acc[a][b][m][n] = (f32x4){0.f, 0.f, 0.f, 0.f};
        cur = nxt; cA = nA; cB = nB; ++ui;
    }
    PG8_WAIT_V(0);
    if (wr == 0) PG8_BAR;
    PG8_BAR;
#undef PG8_SA
#undef PG8_SB
#undef PG8_STAGE
#undef PG8_LDA
#undef PG8_LDB
#undef PG8_MMA
#undef PG8_WAIT_V
#undef PG8_WAIT_L
#undef PG8_BAR
#undef PG8_SCHED
}

struct PartC { long long aOff, bOff; unsigned aStep, bStep; int nM, nN, nt, kind, start, nGrp; unsigned aGrp, bGrp; };
struct TabSched {
    const PartC* parts; const char* ws; int np, total, G, c;
    __device__ __forceinline__ bool next(int i, Unit& u) const {
        const int L = i * G + c; if (L >= total) return false;
        int q = 0;
#pragma unroll
        for (int k = 1; k < 4; ++k) if (k < np && L >= parts[k].start) q = k;
        const PartC P = parts[q];
        const int per = P.nM * P.nN, idx = L - P.start, grp = idx / per;
        int pm, pn; rect_map(idx - grp * per, P.nM, P.nN, pm, pn);
        u.a = ws + P.aOff + (size_t)grp * P.aGrp + (size_t)pm * P.aStep; u.b = ws + P.bOff + (size_t)grp * P.bGrp + (size_t)pn * P.bStep; u.nt = P.nt; u.pm = pm; u.pn = pn; u.kind = P.kind + grp; return true;
    }
};
struct MergeSched {
    const char* ws; long long aOff, bOff; int nM, G, c;
    int nCtx;
    __device__ __forceinline__ bool next(int i, Unit& u) const {
        int T = (i >> 2) * G + c, br = i & 3; bool ctxu = false;
        if (T >= nM * 4) {
            const int j = (i - 4 * ((nM * 4 - c + G - 1) / G)) * G + c;
            if (j < 0 || j >= nCtx) return false;
            T = nM * 4 + (j >> 2); br = j & 3; ctxu = true;
        }
        int pm, pn;
        if (!ctxu) rect_map(T, nM, 4, pm, pn); else { const int t = T - nM * 4; pm = nM + (t >> 2); pn = t & 3; }
        const int ko = br == 0 ? 0 : (br == 1 ? 384 : (br == 2 ? 640 : 1024));
        u.a = ws + aOff + (size_t)pm * (256u * 1280u * 2u) + ko * 2; u.b = ws + bOff + (size_t)pn * (256u * 1280u * 2u) + ko * 2; u.nt = (br & 1) ? 4 : 6; u.pm = pm; u.pn = pn; u.kind = ctxu ? 4 + br : br; return true;
    }
};
struct MoeSched {
    const char* A; const char* B; const int* tile_e; unsigned aStep, bStep; size_t bExp; int nN, nt, tile0, ntile, G, c;
    __device__ __forceinline__ bool next(int i, Unit& u) const {
        const int L = i * G + c; if (L >= ntile * nN) return false;
        const int mt = tile0 + L / nN, pn = L % nN;
        const int e = __builtin_amdgcn_readfirstlane(__hip_atomic_load(tile_e + mt, __ATOMIC_RELAXED, __HIP_MEMORY_SCOPE_AGENT));
        u.a = A + (size_t)(mt - tile0) * aStep; u.b = B + (size_t)e * bExp + (size_t)pn * bStep; u.nt = nt; u.pm = mt; u.pn = pn; u.kind = e; return true;
    }
};

struct MoeTailSched {
    const char* A; const char* B; const int* tile_e; int tile0, nfull, nex, G, c;
    __device__ __forceinline__ bool next(int i, Unit& u) const {
        const int L = i * G + c; int mt, pn, nt = 56, flag = 0; size_t koff = 0;
        if (L < nfull * 4) { mt = tile0 + (L >> 2); pn = L & 3; }
        else { const int idx = L - nfull * 4; if (idx >= nex * 16) return false; const int sp = idx & 3, tu = idx >> 2; mt = 128 + (tu >> 2); pn = tu & 3; nt = 14; koff = (size_t)sp * 14 * 128; flag = 8 + 16 * sp; }
        const int e = __builtin_amdgcn_readfirstlane(__hip_atomic_load(tile_e + mt, __ATOMIC_RELAXED, __HIP_MEMORY_SCOPE_AGENT));
        u.a = A + (size_t)(mt - tile0) * (256u * (unsigned)FF_E * 2u) + koff; u.b = B + (size_t)e * ((size_t)1024 * FF_E * 2) + (size_t)pn * (256u * (unsigned)FF_E * 2u) + koff;
        u.nt = nt; u.pm = mt; u.pn = pn; u.kind = e | flag; return true;
    }
};

#define EPI_ROWS(u) const int row0 = (u).pm * BM + wr * 64 + fr, colt = wc * 32 + 8 * fq
struct EpiProj {
    bf16_t* PRp; bf16_t* PTp; bf16_t* USp; int sig_from; unsigned char* GQp;
    __device__ __forceinline__ void operator()(const f32x4 (&acc)[2][2][4][2], const Unit& u, int wr, int wc, int fr, int fq) const {
        EPI_ROWS(u);
        bf16_t* base = u.kind == 1 ? PTp : PRp; const int ldc = u.kind == 1 ? RT : LDP; const bool sg = (u.kind == 0 && u.pn >= sig_from);
        if (sg) {
#pragma unroll
            for (int ai = 0; ai < 2; ++ai)
#pragma unroll
                for (int m = 0; m < 4; ++m) { unsigned char* rowp = GQp + (size_t)(row0 + ai * HALF + m * 16) * 4096 + (u.pn - sig_from) * BM + colt;
#pragma unroll
                    for (int bj = 0; bj < 2; ++bj) { const f32x4 v0 = acc[ai][bj][m][0], v1 = acc[ai][bj][m][1];
                        unsigned lo = 0u, hi = 0u;
                        lo = __builtin_amdgcn_cvt_pk_u8_f32(sigm(v0[0]) * 255.0f, 0, lo); lo = __builtin_amdgcn_cvt_pk_u8_f32(sigm(v0[1]) * 255.0f, 1, lo); lo = __builtin_amdgcn_cvt_pk_u8_f32(sigm(v0[2]) * 255.0f, 2, lo); lo = __builtin_amdgcn_cvt_pk_u8_f32(sigm(v0[3]) * 255.0f, 3, lo);
                        hi = __builtin_amdgcn_cvt_pk_u8_f32(sigm(v1[0]) * 255.0f, 0, hi); hi = __builtin_amdgcn_cvt_pk_u8_f32(sigm(v1[1]) * 255.0f, 1, hi); hi = __builtin_amdgcn_cvt_pk_u8_f32(sigm(v1[2]) * 255.0f, 2, hi); hi = __builtin_amdgcn_cvt_pk_u8_f32(sigm(v1[3]) * 255.0f, 3, hi);
                        *(u32x2*)(rowp + bj * HALF) = (u32x2){lo, hi}; } }
            return;
        }
#pragma unroll
        for (int ai = 0; ai < 2; ++ai)
#pragma unroll
            for (int m = 0; m < 4; ++m) { bf16_t* rowp = base + (size_t)(row0 + ai * HALF + m * 16) * ldc + u.pn * BM + colt;
#pragma unroll
                for (int bj = 0; bj < 2; ++bj) { f32x4 v0 = acc[ai][bj][m][0], v1 = acc[ai][bj][m][1];
                    if (sg) {
#pragma unroll
                        for (int j = 0; j < 4; ++j) { v0[j] = sigm(v0[j]); v1[j] = sigm(v1[j]); } }
                    u32x4 w; w.x = cvt_pk_bf16(v0[0], v0[1]); w.y = cvt_pk_bf16(v0[2], v0[3]); w.z = cvt_pk_bf16(v1[0], v1[1]); w.w = cvt_pk_bf16(v1[2], v1[3]);
                    *(u32x4*)(rowp + bj * HALF) = w;
                    if (u.kind == 0 && u.pn == 3) { const int r = row0 + ai * HALF + m * 16, cc = colt + bj * HALF;
                        *(u32x4*)(USp + ((size_t)(cc >> 4) * NCHKP + (r >> 4)) * 512 + (r & 15) * 16 + (cc & 15)) = w; } } }
    }
};
struct EpiS5State {
    float* Sp;
    __device__ __forceinline__ void operator()(const f32x4 (&acc)[2][2][4][2], const Unit& u, int wr, int wc, int fr, int fq) const {
        EPI_ROWS(u);
#pragma unroll
        for (int ai = 0; ai < 2; ++ai)
#pragma unroll
            for (int m = 0; m < 4; ++m) { float* op = Sp + ((size_t)u.kind * NCHKP + row0 + ai * HALF + m * 16) * 256 + colt;
#pragma unroll
                for (int bj = 0; bj < 2; ++bj)
#pragma unroll
                    for (int n = 0; n < 2; ++n) *(f32x4*)(op + bj * HALF + 4 * n) = acc[ai][bj][m][n]; }
    }
};
struct EpiS5Main {
    bf16_t* GLp; const bf16_t* PRp; const float* dvec;
    __device__ __forceinline__ void operator()(const f32x4 (&acc)[2][2][4][2], const Unit& u, int wr, int wc, int fr, int fq) const {
        EPI_ROWS(u);
        const int cl = 16 * u.kind + (colt & 15);
        const f32x4 d0 = *(const f32x4*)(dvec + cl), d1 = *(const f32x4*)(dvec + cl + 4);
#pragma unroll
        for (int ai = 0; ai < 2; ++ai) {
            u32x4 uq[4][2];
#pragma unroll
            for (int m = 0; m < 4; ++m) { const int n = row0 + ai * HALF + m * 16;
#pragma unroll
                for (int bj = 0; bj < 2; ++bj) { const int c = colt + bj * HALF, r = 16 * (n < NCHK ? n : 0) + (c >> 4); uq[m][bj] = *(const u32x4*)(PRp + (size_t)r * LDP + PC_D + cl); } }
#pragma unroll
            for (int m = 0; m < 4; ++m) { const int n = row0 + ai * HALF + m * 16; if (n >= NCHK) continue;
#pragma unroll
                for (int bj = 0; bj < 2; ++bj) { const int c = colt + bj * HALF, r = 16 * n + (c >> 4); const u32x4 uv = uq[m][bj];
                    const f32x4 v0 = acc[ai][bj][m][0], v1 = acc[ai][bj][m][1];
                    u32x4 w; w.x = cvt_pk_bf16(gelu_f(v0[0] + d0[0] * bflo(uv.x)), gelu_f(v0[1] + d0[1] * bfhi(uv.x))); w.y = cvt_pk_bf16(gelu_f(v0[2] + d0[2] * bflo(uv.y)), gelu_f(v0[3] + d0[3] * bfhi(uv.y)));
                    w.z = cvt_pk_bf16(gelu_f(v1[0] + d1[0] * bflo(uv.z)), gelu_f(v1[1] + d1[1] * bfhi(uv.z))); w.w = cvt_pk_bf16(gelu_f(v1[2] + d1[2] * bflo(uv.w)), gelu_f(v1[3] + d1[3] * bfhi(uv.w)));
                    *(u32x4*)(GLp + (size_t)r * 256 + cl) = w; } }
        }
    }
};
struct EpiS5Glu {
    bf16_t* YBp; const bf16_t* GLp; const float* bvec;
    __device__ __forceinline__ void operator()(const f32x4 (&acc)[2][2][4][2], const Unit& u, int wr, int wc, int fr, int fq) const {
        EPI_ROWS(u);
        f32x4 bq[2][2];
#pragma unroll
        for (int bj = 0; bj < 2; ++bj) { bq[bj][0] = *(const f32x4*)(bvec + colt + bj * HALF); bq[bj][1] = *(const f32x4*)(bvec + colt + bj * HALF + 4); }
#pragma unroll
        for (int ai = 0; ai < 2; ++ai) {
            u32x4 gq[4][2];
#pragma unroll
            for (int m = 0; m < 4; ++m)
#pragma unroll
                for (int bj = 0; bj < 2; ++bj) gq[m][bj] = *(const u32x4*)(GLp + (size_t)(row0 + ai * HALF + m * 16) * 256 + colt + bj * HALF);
#pragma unroll
            for (int m = 0; m < 4; ++m) { const int r = row0 + ai * HALF + m * 16;
#pragma unroll
                for (int bj = 0; bj < 2; ++bj) { const int c = colt + bj * HALF; const u32x4 gv = gq[m][bj];
                    const f32x4 v0 = acc[ai][bj][m][0] + bq[bj][0], v1 = acc[ai][bj][m][1] + bq[bj][1];
                    u32x4 w; w.x = cvt_pk_bf16(bflo(gv.x) * sigm(v0[0]), bfhi(gv.x) * sigm(v0[1])); w.y = cvt_pk_bf16(bflo(gv.y) * sigm(v0[2]), bfhi(gv.y) * sigm(v0[3]));
                    w.z = cvt_pk_bf16(bflo(gv.z) * sigm(v1[0]), bfhi(gv.z) * sigm(v1[1])); w.w = cvt_pk_bf16(bflo(gv.w) * sigm(v1[2]), bfhi(gv.w) * sigm(v1[3]));
                    *(u32x4*)(YBp + (size_t)r * YW + YC_D + c) = w; } }
        }
    }
};
struct EpiGate {
    const unsigned char* GQp; bf16_t* MGp; bf16_t* MGCp;
    __device__ __forceinline__ void operator()(const f32x4 (&acc)[2][2][4][2], const Unit& u, int wr, int wc, int fr, int fq) const {
        EPI_ROWS(u);
        const int br = u.kind & 3; const bool acc_prev = (u.kind >= 1 && u.kind <= 3);
        bf16_t* OB = u.kind >= 4 ? MGCp + (size_t)br * RC * D - (size_t)RL * D : MGp;
#pragma unroll
        for (int ai = 0; ai < 2; ++ai) {
            u32x2 g[4][2]; u32x4 p[4][2];
#pragma unroll
            for (int m = 0; m < 4; ++m)
#pragma unroll
                for (int bj = 0; bj < 2; ++bj) { const int r = row0 + ai * HALF + m * 16;
                    g[m][bj] = *(const u32x2*)(GQp + (size_t)r * 4096 + br * 1024 + u.pn * BM + colt + bj * HALF);
                    p[m][bj] = acc_prev ? *(const u32x4*)(MGp + (size_t)r * D + u.pn * BM + colt + bj * HALF) : (u32x4){0u, 0u, 0u, 0u}; }
#pragma unroll
            for (int m = 0; m < 4; ++m) { const int r = row0 + ai * HALF + m * 16; bf16_t* mp = OB + (size_t)r * D + u.pn * BM + colt;
#pragma unroll
                for (int bj = 0; bj < 2; ++bj) { const f32x4 v0 = acc[ai][bj][m][0] * (1.0f / 255.0f), v1 = acc[ai][bj][m][1] * (1.0f / 255.0f); const u32x2 gg = g[m][bj]; const u32x4 pp = p[m][bj];
                    const f32x4 o0 = {v0[0] * (float)(gg.x & 255u) + bflo(pp.x), v0[1] * (float)((gg.x >> 8) & 255u) + bfhi(pp.x), v0[2] * (float)((gg.x >> 16) & 255u) + bflo(pp.y), v0[3] * (float)(gg.x >> 24) + bfhi(pp.y)};
                    const f32x4 o1 = {v1[0] * (float)(gg.y & 255u) + bflo(pp.z), v1[1] * (float)((gg.y >> 8) & 255u) + bfhi(pp.z), v1[2] * (float)((gg.y >> 16) & 255u) + bflo(pp.w), v1[3] * (float)(gg.y >> 24) + bfhi(pp.w)};
                    u32x4 w; w.x = cvt_pk_bf16(o0[0], o0[1]); w.y = cvt_pk_bf16(o0[2], o0[3]); w.z = cvt_pk_bf16(o1[0], o1[1]); w.w = cvt_pk_bf16(o1[2], o1[3]);
                    *(u32x4*)(mp + bj * HALF) = w; } }
        }
    }
};
struct EpiRes {
    float* PREp; const float* xlat; const float* xctx; const float* gvec;
    float* partp;
    __device__ __forceinline__ void operator()(const f32x4 (&acc)[2][2][4][2], const Unit& u, int wr, int wc, int fr, int fq) const {
        EPI_ROWS(u);
        if (u.kind != 0) {
            f32x4 gc[2][2];
#pragma unroll
            for (int bj = 0; bj < 2; ++bj)
#pragma unroll
                for (int n = 0; n < 2; ++n) gc[bj][n] = *(const f32x4*)(gvec + (size_t)4 * 6144 + u.pn * BM + colt + bj * HALF + 4 * n);
#pragma unroll
            for (int ai = 0; ai < 2; ++ai)
#pragma unroll
                for (int m = 0; m < 4; ++m) { const int r = row0 + ai * HALF + m * 16; const int c0 = u.pn * BM + colt;
                    float* op = partp + ((size_t)(u.kind - 1) * RC + r) * D + c0;
#pragma unroll
                    for (int bj = 0; bj < 2; ++bj)
#pragma unroll
                        for (int n = 0; n < 2; ++n) *(f32x4*)(op + bj * HALF + 4 * n) = gc[bj][n] * acc[ai][bj][m][n]; }
            return;
        }
        const int c0 = u.pn * BM + colt, rt0 = u.pm * BM;
        const float* gp = gvec + (size_t)(rt0 < RL ? (rt0 >> 12) : 4) * 6144 + c0;
        f32x4 gq[2][2];
#pragma unroll
        for (int bj = 0; bj < 2; ++bj)
#pragma unroll
            for (int n = 0; n < 2; ++n) gq[bj][n] = *(const f32x4*)(gp + bj * HALF + 4 * n);
#pragma unroll
        for (int am = 0; am < 4; ++am) { const int ai = am >> 1, m0 = (am & 1) * 2;
            f32x4 xq[4][2][2];
#pragma unroll
            for (int m = m0; m < m0 + 2; ++m) { const int r = row0 + ai * HALF + m * 16;
                const float* xin = (r < RL ? xlat + (size_t)r * D : xctx + (size_t)(r - RL) * D) + c0;
#pragma unroll
                for (int bj = 0; bj < 2; ++bj)
#pragma unroll
                    for (int n = 0; n < 2; ++n) xq[m][bj][n] = *(const f32x4*)(xin + bj * HALF + 4 * n); }
#pragma unroll
            for (int m = m0; m < m0 + 2; ++m) { const int r = row0 + ai * HALF + m * 16; float* op = PREp + (size_t)r * D + c0;
#pragma unroll
                for (int bj = 0; bj < 2; ++bj)
#pragma unroll
                    for (int n = 0; n < 2; ++n) *(f32x4*)(op + bj * HALF + 4 * n) = xq[m][bj][n] * ALPHA + gq[bj][n] * acc[ai][bj][m][n]; }
        }
    }
};
struct EpiSwiglu {
    bf16_t* Hp; int ldh; int row_sub;
    __device__ __forceinline__ void operator()(const f32x4 (&acc)[2][2][4][2], const Unit& u, int wr, int wc, int fr, int fq) const {
        const int row0 = (u.pm - row_sub) * BM + wr * 64 + fr, colt = wc * 32 + 8 * fq;
#pragma unroll
        for (int ai = 0; ai < 2; ++ai)
#pragma unroll
            for (int m = 0; m < 4; ++m) { bf16_t* rowp = Hp + (size_t)(row0 + ai * HALF + m * 16) * ldh + u.pn * HALF + colt;
                f32x4 h0, h1;
#pragma unroll
                for (int j = 0; j < 4; ++j) { const float g0 = acc[ai][0][m][0][j], g1 = acc[ai][0][m][1][j];
                    h0[j] = g0 * sigm(g0) * acc[ai][1][m][0][j]; h1[j] = g1 * sigm(g1) * acc[ai][1][m][1][j]; }
                u32x4 w; w.x = cvt_pk_bf16(h0[0], h0[1]); w.y = cvt_pk_bf16(h0[2], h0[3]); w.z = cvt_pk_bf16(h1[0], h1[1]); w.w = cvt_pk_bf16(h1[2], h1[3]);
                *(u32x4*)rowp = w; }
    }
};
struct EpiMoeDown {
    bf16_t* O2; const float* slotw; float* O2X;
    __device__ __forceinline__ void operator()(const f32x4 (&acc)[2][2][4][2], const Unit& u, int wr, int wc, int fr, int fq) const {
        EPI_ROWS(u);
        float wq[2][4];
        if (u.kind & 8) {
            const int sp = (u.kind >> 4) & 3;
#pragma unroll
            for (int ai = 0; ai < 2; ++ai)
#pragma unroll
                for (int m = 0; m < 4; ++m) { const int r = row0 + ai * HALF + m * 16; const float w8 = slotw[r]; float* op = O2X + ((size_t)sp * 2048 + (r - 128 * 256)) * D + u.pn * BM + colt;
#pragma unroll
                    for (int bj = 0; bj < 2; ++bj)
#pragma unroll
                        for (int n = 0; n < 2; ++n) *(f32x4*)(op + bj * HALF + 4 * n) = acc[ai][bj][m][n] * w8; }
            return;
        }
#pragma unroll
        for (int ai = 0; ai < 2; ++ai)
#pragma unroll
            for (int m = 0; m < 4; ++m) wq[ai][m] = slotw[row0 + ai * HALF + m * 16];
#pragma unroll
        for (int ai = 0; ai < 2; ++ai)
#pragma unroll
            for (int m = 0; m < 4; ++m) { const int r = row0 + ai * HALF + m * 16; const float w8 = wq[ai][m];
                bf16_t* rowp = O2 + (size_t)r * D + u.pn * BM + colt;
#pragma unroll
                for (int bj = 0; bj < 2; ++bj) { const f32x4 v0 = acc[ai][bj][m][0] * w8, v1 = acc[ai][bj][m][1] * w8;
                    u32x4 w; w.x = cvt_pk_bf16(v0[0], v0[1]); w.y = cvt_pk_bf16(v0[2], v0[3]); w.z = cvt_pk_bf16(v1[0], v1[1]); w.w = cvt_pk_bf16(v1[2], v1[3]);
                    *(u32x4*)(rowp + bj * HALF) = w; } }
    }
};
}

struct Job { int in_idx; int src_off; int lds; int K; int N; long long dst_off; int ldd; int kcol0; int G, GS, R0; int tile0; };
struct JobTable { Job j[96]; int n; int total; };
constexpr int BIGG = 1 << 30;
constexpr void add_job(JobTable& t, int in_idx, long long src_off, int lds, int K, int N, size_t dst_off, int ldd, int kcol0, int G, int GS, int R0) {
    Job& q = t.j[t.n]; q.in_idx = in_idx; q.src_off = (int)src_off; q.lds = lds; q.K = K; q.N = N; q.dst_off = (long long)dst_off; q.ldd = ldd; q.kcol0 = kcol0; q.G = G; q.GS = GS; q.R0 = R0;
    q.tile0 = t.total; t.total += (K / 64) * (N / 64); t.n++;
}
constexpr JobTable make_jobs(int which) {
    JobTable t{}; t.n = 0; t.total = 0;
    if (which == 0) {
        for (int l = 0; l < 2; ++l) {
            const size_t base = WS_WL + (size_t)l * SZ_WL; const long long wsrc = (long long)l * 1024 * IN_COLS;
            add_job(t, 6, wsrc + 0, IN_COLS, 1024, 768, base, 1024, 0, BIGG, 0, 0);
            add_job(t, 6, wsrc + 2688, IN_COLS, 1024, 256, base, 1024, 0, BIGG, 0, PC_D);
            add_job(t, 6, wsrc + 1536, IN_COLS, 1024, 768, base, 1024, 0, BIGG, 0, PC_Q);
            add_job(t, 6, wsrc + 2944, IN_COLS, 1024, 4096, base, 1024, 0, BIGG, 0, PC_G);
            add_job(t, 6, wsrc + 768, IN_COLS, 1024, 768, base + SZ_WINR, 1024, 0, BIGG, 0, 0);
            add_job(t, 6, wsrc + 2304, IN_COLS, 1024, 384, base + SZ_WINR, 1024, 0, BIGG, 0, PT_V);
            const int kd[4] = {384, 256, 384, 256}, ko[4] = {0, 384, 640, 1024};
            for (int i = 0; i < 4; ++i) add_job(t, 35 + i, (long long)l * kd[i] * 1024, 1024, kd[i], 1024, base + SZ_WINR + SZ_WINHY, 1280, ko[i], BIGG, 0, 0);
            add_job(t, 39, (long long)l * 1024 * 1024, 1024, 1024, 1024, base + SZ_WINR + SZ_WINHY + SZ_WBR, 1024, 0, BIGG, 0, 0);
        }
        for (int q = 0; q < 24; ++q) for (int mat = 0; mat < 2; ++mat)
            add_job(t, mat == 0 ? 9 : 11, (long long)q * 4096, 64, 64, 64, WS_LW + (size_t)(((q / 6) * 2 + mat) * 6 + q % 6) * 4096 * 2, 64, 0, BIGG, 0, 0);
        for (int l = 0; l < 2; ++l) add_job(t, 33, (long long)l * 65536, 256, 256, 256, WS_WGLU + (size_t)l * 256 * 256 * 2, 256, 0, BIGG, 0, 0);
        add_job(t, 44, 0, FF_DENSE, 1024, FF_DENSE, WS_FFGU, 1024, 0, 128, 256, 0);
        add_job(t, 45, 0, FF_DENSE, 1024, FF_DENSE, WS_FFGU, 1024, 0, 128, 256, 128);
        add_job(t, 46, 0, 1024, FF_DENSE, 1024, WS_FFD, FF_DENSE, 0, BIGG, 0, 0);
    } else {
        for (int e = 0; e < NE; ++e) {
            add_job(t, 48, (long long)e * 1024 * FF_E, FF_E, 1024, FF_E, WS_MOEGU + (size_t)e * 2 * FF_E * 1024 * 2, 1024, 0, 128, 256, 0);
            add_job(t, 49, (long long)e * 1024 * FF_E, FF_E, 1024, FF_E, WS_MOEGU + (size_t)e * 2 * FF_E * 1024 * 2, 1024, 0, 128, 256, 128);
            add_job(t, 50, (long long)e * FF_E * 1024, 1024, FF_E, 1024, WS_MOED + (size_t)e * 1024 * FF_E * 2, FF_E, 0, BIGG, 0, 0);
        }
    }
    return t;
}
__device__ const JobTable JT_SMALL = make_jobs(0);
__device__ const JobTable JT_MOE = make_jobs(1);

struct PartTable { pg8::PartC p[32]; };
constexpr pg8::PartC mk_part(size_t aOff, size_t bOff, unsigned aStep, unsigned bStep, int nM, int nN, int nt, int kind, int start) {
    pg8::PartC q{}; q.aOff = (long long)aOff; q.bOff = (long long)bOff; q.aStep = aStep; q.bStep = bStep; q.nM = nM; q.nN = nN; q.nt = nt; q.kind = kind; q.start = start; q.nGrp = 1; q.aGrp = 0; q.bGrp = 0; return q;
}
constexpr PartTable make_parts() {
    PartTable t{};
    for (int l = 0; l < 2; ++l) {
        const size_t WL = WS_WL + (size_t)l * SZ_WL; const int nMrow = l == 0 ? 68 : 64;
        t.p[l * 8 + 0] = mk_part(WS_UB, WL, 256u * 1024u * 2u, 256u * 1024u * 2u, 68, 23, 16, 0, 0);
        t.p[l * 8 + 1] = mk_part(WL + SZ_WINR, WS_UB, 256u * 1024u * 2u, 256u * 1024u * 2u, 5, 68, 16, 1, 68 * 23);
        const int kd[4] = {384, 256, 384, 256}, ko[4] = {0, 384, 640, 1024};
        for (int i = 0; i < 4; ++i) t.p[l * 8 + 2 + i] = mk_part(WS_YB + ko[i] * 2, WL + SZ_WINR + SZ_WINHY + ko[i] * 2, 256u * 1280u * 2u, 256u * 1280u * 2u, nMrow, 4, kd[i] / 64, i, i * nMrow * 4);
        t.p[l * 8 + 6] = mk_part(WS_UB, WL + SZ_WINR + SZ_WINHY + SZ_WBR, 256u * 1024u * 2u, 256u * 1024u * 2u, nMrow, 4, 16, 0, 0);
    }
    for (int l = 0; l < 2; ++l) {
        pg8::PartC q = mk_part(WS_US, WS_OPS + (size_t)l * 16 * 256 * 256 * 2, 256u * 512u * 2u, 0u, 5, 1, 4, 0, 0); q.nGrp = 16; q.aGrp = (unsigned)(NCHKP * 512 * 2); q.bGrp = 256u * 256u * 2u; t.p[18 + l * 3] = q;
        q = mk_part(WS_US, WS_OPY + (size_t)l * 16 * 256 * 512 * 2, 256u * 512u * 2u, 0u, 5, 1, 8, 0, 0); q.nGrp = 16; q.aGrp = (unsigned)(NCHKP * 512 * 2); q.bGrp = 256u * 512u * 2u; t.p[19 + l * 3] = q;
        t.p[20 + l * 3] = mk_part(WS_GL, WS_WGLU + (size_t)l * 256 * 256 * 2, 256u * 256u * 2u, 0u, l == 0 ? 68 : 64, 1, 4, 0, 0);
    }
    {
        const size_t WL0 = WS_WL;
        t.p[24] = mk_part(WS_UB, WL0 + SZ_WINR + SZ_WINHY + SZ_WBR, 256u * 1024u * 2u, 256u * 1024u * 2u, 64, 4, 16, 0, 0);
        pg8::PartC q = mk_part(WS_MGC, WL0 + SZ_WINR + SZ_WINHY + SZ_WBR, 256u * 1024u * 2u, 256u * 1024u * 2u, 4, 4, 16, 1, 256); q.nGrp = 4; q.aGrp = (unsigned)(RC * D * 2); q.bGrp = 0u; t.p[25] = q;
        t.p[26] = mk_part(WS_H, WS_FFD, 256u * (unsigned)FF_DENSE * 2u, 256u * (unsigned)FF_DENSE * 2u, 64, 4, 44, 0, 0);
        q = mk_part(WS_H + (size_t)64 * 256 * FF_DENSE * 2, WS_FFD, 256u * (unsigned)FF_DENSE * 2u, 256u * (unsigned)FF_DENSE * 2u, 4, 4, 12, 1, 256); q.nGrp = 3; q.aGrp = 1536u; q.bGrp = 1536u; t.p[27] = q;
        t.p[28] = mk_part(WS_H + (size_t)64 * 256 * FF_DENSE * 2 + 36 * 128, WS_FFD + 36 * 128, 256u * (unsigned)FF_DENSE * 2u, 256u * (unsigned)FF_DENSE * 2u, 4, 4, 8, 4, 256 + 48);
    }
    t.p[16] = mk_part(WS_UB, WS_FFGU, 256u * 1024u * 2u, 256u * 1024u * 2u, 68, 22, 16, 0, 0);
    t.p[17] = mk_part(WS_H, WS_FFD, 256u * (unsigned)FF_DENSE * 2u, 256u * (unsigned)FF_DENSE * 2u, 68, 4, 44, 0, 0);
    return t;
}
__device__ const PartTable PARTS = make_parts();

struct Args {
    const float* in[51];
    float* out; unsigned char* ws;
    int ph_lo, ph_hi, bar_region, pad0;
};
__device__ __forceinline__ const float* sel_in(const Args& a, int idx) {
    const float* p = a.in[6];
    p = idx == 9 ? a.in[9] : p; p = idx == 11 ? a.in[11] : p; p = idx == 33 ? a.in[33] : p; p = idx == 35 ? a.in[35] : p; p = idx == 36 ? a.in[36] : p; p = idx == 37 ? a.in[37] : p; p = idx == 38 ? a.in[38] : p; p = idx == 39 ? a.in[39] : p;
    p = idx == 44 ? a.in[44] : p; p = idx == 45 ? a.in[45] : p; p = idx == 46 ? a.in[46] : p; p = idx == 48 ? a.in[48] : p; p = idx == 49 ? a.in[49] : p; p = idx == 50 ? a.in[50] : p;
    return p;
}

struct ConvRegs { f32x4 v[4][2]; int jis[4]; };
__device__ __forceinline__ void conv_load(const Args& a, const JobTable& JT, int t0, int stride, ConvRegs& R) {
    int tid = threadIdx.x; asm volatile("" : "+v"(tid));
#pragma unroll
    for (int u = 0; u < 4; ++u) {
        const int t = t0 + u * stride; R.jis[u] = -1;
        if (t < JT.total) {
            int ji = 0;
            for (int k = 1; k < JT.n; ++k) if (t >= JT.j[k].tile0) ji = k;
            R.jis[u] = ji;
            const Job& q = JT.j[ji];
            const int lt = t - q.tile0, nTn = q.N / 64, k0 = (lt / nTn) * 64, n0 = (lt % nTn) * 64;
            const float* src = sel_in(a, q.in_idx) + (size_t)q.src_off + (size_t)k0 * q.lds + n0;
#pragma unroll
            for (int p = 0; p < 2; ++p) R.v[u][p] = *(const f32x4*)(src + (size_t)((tid >> 4) + 32 * p) * q.lds + (tid & 15) * 4);
        }
    }
}
__device__ __forceinline__ void conv_store(const Args& a, const JobTable& JT, LAS float* tile, int t0, int stride, const ConvRegs& R) {
    int tid = threadIdx.x; asm volatile("" : "+v"(tid));
    __syncthreads();
#pragma unroll
    for (int u = 0; u < 4; ++u) if (R.jis[u] >= 0) {
#pragma unroll
        for (int p = 0; p < 2; ++p) { const int kk = (tid >> 4) + 32 * p, nn = (tid & 15) * 4; LAS float* tp = tile + u * (64 * 65) + kk * 65 + nn;
            tp[0] = R.v[u][p][0]; tp[1] = R.v[u][p][1]; tp[2] = R.v[u][p][2]; tp[3] = R.v[u][p][3]; } }
    __syncthreads();
#pragma unroll
    for (int u = 0; u < 4; ++u) if (R.jis[u] >= 0) {
        const Job& q = JT.j[R.jis[u]];
        const int t = t0 + u * stride, lt = t - q.tile0, nTn = q.N / 64, k0 = (lt / nTn) * 64, n0 = (lt % nTn) * 64;
        const int n = tid >> 3, k8 = (tid & 7) * 8, ng = n0 + n;
        const int drow = (ng / q.G) * q.GS + (ng % q.G) + q.R0;
        const LAS float* tp = tile + u * (64 * 65) + n;
        u32x4 w;
        w.x = cvt_pk_bf16(tp[(k8 + 0) * 65], tp[(k8 + 1) * 65]); w.y = cvt_pk_bf16(tp[(k8 + 2) * 65], tp[(k8 + 3) * 65]);
        w.z = cvt_pk_bf16(tp[(k8 + 4) * 65], tp[(k8 + 5) * 65]); w.w = cvt_pk_bf16(tp[(k8 + 6) * 65], tp[(k8 + 7) * 65]);
        *(u32x4*)((bf16_t*)(a.ws + q.dst_off) + (size_t)drow * q.ldd + q.kcol0 + k0 + k8) = w;
    }
}
__device__ __forceinline__ void convert_step(const Args& a, const JobTable& JT, LAS float* tile, int t0, int stride) { ConvRegs R; conv_load(a, JT, t0, stride, R); conv_store(a, JT, tile, t0, stride, R); }
__device__ __forceinline__ void convert_tiles_pipelined(const Args& a, const JobTable& JT, LAS float* tile, int first, int stride) {
    ConvRegs cur; int t0 = first;
    if (t0 >= JT.total) return;
    conv_load(a, JT, t0, stride, cur);
    for (;;) {
        const int tn = t0 + 4 * stride; const bool more = tn < JT.total;
        ConvRegs nxt;
        if (more) conv_load(a, JT, tn, stride, nxt);
        conv_store(a, JT, tile, t0, stride, cur);
        if (!more) break;
        cur = nxt; t0 = tn;
    }
}
__device__ __forceinline__ void convert_tiles(const Args& a, const JobTable& JT, LAS float* tile, int first, int stride) {
    for (int t0 = first; t0 < JT.total; t0 += 4 * stride) convert_step(a, JT, tile, t0, stride);
}

__device__ __forceinline__ int opaque(int v) { asm volatile("" : "+v"(v)); return v; }
#define PIN8(a) asm volatile("" : "+v"((a)[0]), "+v"((a)[1]), "+v"((a)[2]), "+v"((a)[3]), "+v"((a)[4]), "+v"((a)[5]), "+v"((a)[6]), "+v"((a)[7]))
#define PIN16(a) do { PIN8(a); PIN8((a) + 8); } while (0)
struct RowV { f32x4 v[4]; };
__device__ __forceinline__ RowV row_load(const float* p, int lane) { RowV r;
#pragma unroll
    for (int i = 0; i < 4; ++i) r.v[i] = *(const f32x4*)(p + 256 * i + 4 * lane); return r; }
__device__ __forceinline__ void row_store(float* p, int lane, const RowV& r) {
#pragma unroll
    for (int i = 0; i < 4; ++i) *(f32x4*)(p + 256 * i + 4 * lane) = r.v[i]; }
__device__ __forceinline__ void row_store_bf16(bf16_t* p, int lane, const RowV& r) {
#pragma unroll
    for (int i = 0; i < 4; ++i) { u32x2 w; w.x = cvt_pk_bf16(r.v[i][0], r.v[i][1]); w.y = cvt_pk_bf16(r.v[i][2], r.v[i][3]); *(u32x2*)(p + 256 * i + 4 * lane) = w; } }
__device__ __forceinline__ RowV row_norm(const RowV& x) {
    float s = 0.f;
#pragma unroll
    for (int i = 0; i < 4; ++i) s += (x.v[i][0] + x.v[i][1]) + (x.v[i][2] + x.v[i][3]);
    const float mu = wave_sum(s) * (1.f / D);
    RowV d; float q = 0.f;
#pragma unroll
    for (int i = 0; i < 4; ++i) { d.v[i] = x.v[i] - mu; q += (d.v[i][0] * d.v[i][0] + d.v[i][1] * d.v[i][1]) + (d.v[i][2] * d.v[i][2] + d.v[i][3] * d.v[i][3]); }
    const float rs = rsqrtf(wave_sum(q) * (1.f / D) + 1e-5f);
#pragma unroll
    for (int i = 0; i < 4; ++i) d.v[i] = d.v[i] * rs;
    return d;
}
__device__ __forceinline__ RowV row_affine(const RowV& n, const float* g, const float* b, int lane) {
    RowV o;
#pragma unroll
    for (int i = 0; i < 4; ++i) o.v[i] = n.v[i] * *(const f32x4*)(g + 256 * i + 4 * lane) + *(const f32x4*)(b + 256 * i + 4 * lane);
    return o;
}
__device__ __forceinline__ RowV row_modulate(const RowV& n, const float* sh, const float* sc, int lane) {
    RowV o;
#pragma unroll
    for (int i = 0; i < 4; ++i) o.v[i] = n.v[i] * (*(const f32x4*)(sc + 256 * i + 4 * lane) + 1.0f) + *(const f32x4*)(sh + 256 * i + 4 * lane);
    return o;
}

constexpr int LDS_BYTES = 159744;
constexpr int MISC_OFF = 159488;
constexpr int NPH_LAYER = 16;
#ifndef SPLIT
#define SPLIT 0
#endif

__global__ void __launch_bounds__(512, 2) mk_fwd(Args a) {
    extern __shared__ __attribute__((aligned(16))) unsigned char shm[];
    LAS unsigned char* lds = (LAS unsigned char*)shm;
    volatile LAS unsigned* MISC = (volatile LAS unsigned*)(lds + MISC_OFF);
    const int tid0 = threadIdx.x, wave = __builtin_amdgcn_readfirstlane(tid0 >> 6);
    const int G = gridDim.x, bid = blockIdx.x;
    if (tid0 < (LDS_BYTES - MISC_OFF) / 4) MISC[tid0] = 0u;
    __syncthreads();
    unsigned char* ws = a.ws;
    unsigned* ctl = (unsigned*)(ws + WS_CTL);
    XcdBarrier bar = xcd_barrier_post(ctl + CW_BAR + a.bar_region * XCD_BAR_WORDS, MISC + 8);
    const int lo = a.ph_lo, hi = a.ph_hi;
#ifndef PHMASK
#define PHMASK 0xFFFF
#endif
#define IN(k) (lo <= (k) && (k) < hi)
#define SEAM(k) do { if (lo <= (k) && (k) + 1 < hi) xcd_barrier(bar); } while (0)
    float* MOD = (float*)(ws + WS_MOD);
    bf16_t* UB = (bf16_t*)(ws + WS_UB); bf16_t* PR = (bf16_t*)(ws + WS_PR); bf16_t* PT = (bf16_t*)(ws + WS_PT); bf16_t* YB = (bf16_t*)(ws + WS_YB);
    float* PRE = (float*)(ws + WS_PRE); float* XSC = (float*)(ws + WS_XSC);
    const float* x_in = a.in[0]; const float* ctx_in = a.in[2];

    if (((PHMASK >> 0) & 1) && IN(0)) {
        const int tid = opaque(tid0), lane = tid & 63;
        __syncthreads();
        LAS float* sc = (LAS float*)lds;
        for (int i = tid; i < 5 * 1024; i += 512) { const int r = i >> 10, k = i & 1023; sc[i] = silu_acc(r < 4 ? a.in[1][r * 1024 + k] : a.in[3][k]); }
        __syncthreads();
        for (int u = bid; u < 2 * 96 * 8; u += G) {
            const int l = u / (96 * 8), rem = u % (96 * 8), cg = rem / 8, ks = rem % 8;
            const int n = cg * 64 + lane;
            const float* w = a.in[4] + (size_t)l * 1024 * 6144 + n;
            float a0 = 0, a1 = 0, a2 = 0, a3 = 0, a4 = 0;
            const int kb = ks * 128 + wave * 16;
#pragma unroll 4
            for (int k = kb; k < kb + 16; ++k) { const float wv = w[(size_t)k * 6144]; a0 += sc[k] * wv; a1 += sc[1024 + k] * wv; a2 += sc[2048 + k] * wv; a3 += sc[3072 + k] * wv; a4 += sc[4096 + k] * wv; }
            if (ks == 0 && wave == 0) { const float bb = a.in[5][l * 6144 + n]; a0 += bb; a1 += bb; a2 += bb; a3 += bb; a4 += bb; }
            float* o = MOD + (size_t)l * 5 * 6144 + n;
            atomicAdd(o, a0); atomicAdd(o + 6144, a1); atomicAdd(o + 2 * 6144, a2); atomicAdd(o + 3 * 6144, a3); atomicAdd(o + 4 * 6144, a4);
        }
        __syncthreads();
        for (int u = bid; u < 132; u += G) {
            const bool isc = u >= 128; const int l = isc ? 0 : (u >> 6), blk = isc ? u - 128 : (u & 63), L = isc ? CTXL : SEQ, t0 = blk * 64;
            LAS float* feat = (LAS float*)lds;
            LAS float* h1 = feat + 64 * 33;
            LAS float* h2 = h1 + 4096;
            const float* w1 = a.in[16] + l * 33 * 64; const float* b1 = a.in[17] + l * 64; const float* w2 = a.in[18] + l * 4096; const float* b2 = a.in[19] + l * 64;
            const float* w3 = a.in[20] + (size_t)l * 65536; const float* b3 = a.in[21] + l * 1024; const float* fq = a.in[22] + l * 64;
            __syncthreads();
            for (int i = tid; i < 64 * 33; i += 512) { const int tt = i / 33, f = i - tt * 33, t = t0 + tt; float v;
                if (f == 0) v = (float)t / (float)L;
                else { const int band = (f - 1) % 16 + 1; const int m = (int)(((long)t * band) % L); const double ang = 2.0 * M_PI * (double)m / (double)L; v = f <= 16 ? (float)cos(ang) : (float)sin(ang); }
                feat[i] = v; }
            __syncthreads();
            for (int i = tid; i < 4096; i += 512) { const int tt = i >> 6, j = i & 63; float sacc = b1[j];
                for (int f = 0; f < 33; ++f) sacc += feat[tt * 33 + f] * w1[f * 64 + j];
                h1[i] = sinf(fq[j] * sacc); }
            __syncthreads();
            for (int i = tid; i < 4096; i += 512) { const int tt = i >> 6, j = i & 63; float sacc = b2[j];
                for (int f = 0; f < 64; ++f) sacc += h1[tt * 64 + f] * w2[f * 64 + j];
                h2[i] = sinf(fq[j] * sacc); }
            __syncthreads();
            const float dmin = 3.0701134573253945f, dmax = 15.350567286626973f;
#pragma unroll 1
            for (int jj = 0; jj < 2; ++jj) {
                const int n = tid + 512 * jj, dir = n >> 9, o = (n >> 8) & 1, c = n & 255;
                float wc[64];
#pragma unroll
                for (int i = 0; i < 64; ++i) wc[i] = w3[i * 1024 + n];
                const float bb = b3[n], delta = dmin + (dmax - dmin) * (float)c / 255.0f;
                bf16_t* dst = isc ? (bf16_t*)(ws + WS_KFC) + ((size_t)(dir * 2 + o) * 256 + c) * CTXL + t0 : (bf16_t*)(ws + WS_KFL) + ((size_t)((l * 2 + dir) * 2 + o) * 256 + c) * SEQ + t0;
                float asum = 0.f;
#pragma unroll 1
                for (int tg = 0; tg < 8; ++tg) {
                    float v[8];
#pragma unroll
                    for (int q = 0; q < 8; ++q) { float sacc = bb; const LAS float* hp = h2 + (tg * 8 + q) * 64;
#pragma unroll
                        for (int i = 0; i < 64; ++i) sacc += hp[i] * wc[i];
                        const int t = t0 + tg * 8 + q;
                        v[q] = sacc * expf(-((float)t / (float)L) * delta);
                        if (!(dir == 1 && t == 0)) asum += fabsf(v[q]); }
                    u32x4 w; w.x = cvt_pk_bf16(v[0], v[1]); w.y = cvt_pk_bf16(v[2], v[3]); w.z = cvt_pk_bf16(v[4], v[5]); w.w = cvt_pk_bf16(v[6], v[7]);
                    *(u32x4*)(dst + tg * 8) = w;
                }
                atomicAdd((float*)(ctl + CW_HYN) + (isc ? 1024 + o * 256 + c : (l * 2 + o) * 256 + c), asum);
            }
        }
        __syncthreads();
        for (int u = bid - 132; u >= 0 && u < 32; u += G) {
            const int l = u >> 4, g = u & 15;
            LAS float* PW = (LAS float*)lds;
            LAS float* BBs = PW + 2 * 64 * 17 * 2;
            LAS float* Cs = BBs + 2 * 64 * 16 * 2;
            LAS float* KT = Cs + 2 * 16 * 64 * 2;
            __syncthreads();
            if (tid < 128) {
                const int d = tid >> 6, p = tid & 63, idx = l * 2048 + (d * 16 + g) * 64 + p;
                const double ar = a.in[25][idx], ai = a.in[26][idx], dt = exp((double)a.in[27][l * 32 + d * 16 + g]);
                const double mag = exp(dt * ar), abr = mag * cos(dt * ai), abi = mag * sin(dt * ai), den = ar * ar + ai * ai;
                const double fr = ((abr - 1.0) * ar + abi * ai) / den, fi = (abi * ar - (abr - 1.0) * ai) / den;
                double pr = 1.0, pi = 0.0;
                for (int k = 0; k <= 16; ++k) { PW[((d * 64 + p) * 17 + k) * 2] = (float)pr; PW[((d * 64 + p) * 17 + k) * 2 + 1] = (float)pi; const double nr = pr * abr - pi * abi, ni = pr * abi + pi * abr; pr = nr; pi = ni; }
                float* a16 = (float*)(ws + WS_AB16) + ((size_t)((l * 2 + d) * 16 + g) * 64 + p) * 2;
                a16[0] = PW[((d * 64 + p) * 17 + 16) * 2]; a16[1] = PW[((d * 64 + p) * 17 + 16) * 2 + 1];
                for (int i = 0; i < 16; ++i) { const double br = a.in[28][(size_t)idx * 16 + i], bi = a.in[29][(size_t)idx * 16 + i];
                    BBs[((d * 64 + p) * 16 + i) * 2] = (float)(fr * br - fi * bi); BBs[((d * 64 + p) * 16 + i) * 2 + 1] = (float)(fr * bi + fi * br); }
            }
            for (int i = tid; i < 2048; i += 512) { const int d = i >> 10, o = (i >> 6) & 15, p = i & 63; const size_t ci = (size_t)l * 32768 + ((size_t)(d * 16 + g) * 16 + o) * 64 + p;
                Cs[i * 2] = a.in[30][ci]; Cs[i * 2 + 1] = a.in[31][ci]; }
            __syncthreads();
            for (int e = tid; e < 8192; e += 512) { const int d = e >> 12, k = (e >> 8) & 15, o = (e >> 4) & 15, i = e & 15;
                float acc = 0.f;
                for (int p = 0; p < 64; ++p) { const float cr = Cs[((d * 16 + o) * 64 + p) * 2], ci = Cs[((d * 16 + o) * 64 + p) * 2 + 1], pr = PW[((d * 64 + p) * 17 + k) * 2], pi = PW[((d * 64 + p) * 17 + k) * 2 + 1];
                    const float tr = cr * pr - ci * pi, ti = cr * pi + ci * pr;
                    acc += tr * BBs[((d * 64 + p) * 16 + i) * 2] - ti * BBs[((d * 64 + p) * 16 + i) * 2 + 1]; }
                KT[e] = acc; }
            __syncthreads();
            bf16_t* OPS = (bf16_t*)(ws + WS_OPS) + (size_t)(l * 16 + g) * 256 * 256;
            bf16_t* OPY = (bf16_t*)(ws + WS_OPY) + (size_t)(l * 16 + g) * 256 * 512;
            for (int e = tid; e < 256 * 32; e += 512) {
                const int row = e >> 5, c0 = (e & 31) * 8, d = row >> 7, p = (row >> 1) & 63, ri = row & 1, sx = c0 >> 4, i0 = c0 & 15, k = d == 0 ? 15 - sx : sx;
                const float pr = PW[((d * 64 + p) * 17 + k) * 2], pi = PW[((d * 64 + p) * 17 + k) * 2 + 1];
                float v[8];
#pragma unroll
                for (int j = 0; j < 8; ++j) { const float br = BBs[((d * 64 + p) * 16 + i0 + j) * 2], bi = BBs[((d * 64 + p) * 16 + i0 + j) * 2 + 1]; v[j] = ri == 0 ? pr * br - pi * bi : pr * bi + pi * br; }
                u32x4 w; w.x = cvt_pk_bf16(v[0], v[1]); w.y = cvt_pk_bf16(v[2], v[3]); w.z = cvt_pk_bf16(v[4], v[5]); w.w = cvt_pk_bf16(v[6], v[7]);
                *(u32x4*)(OPS + (size_t)row * 256 + c0) = w; }
            for (int e = tid; e < 256 * 64; e += 512) {
                const int row = e >> 6, c0 = (e & 63) * 8, t = row >> 4, o = row & 15;
                float v[8];
                if (c0 < 256) { const int sx = c0 >> 4, i0 = c0 & 15;
#pragma unroll
                    for (int j = 0; j < 8; ++j) { float x = 0.f; if (sx <= t) x += KT[((0 * 16 + (t - sx)) * 16 + o) * 16 + i0 + j]; if (sx >= t) x += KT[((1 * 16 + (sx - t)) * 16 + o) * 16 + i0 + j]; v[j] = x; } }
                else { const int c2 = c0 - 256, d = c2 >> 7, k = d == 0 ? t + 1 : 16 - t;
#pragma unroll
                    for (int j = 0; j < 8; ++j) { const int p = ((c2 + j) >> 1) & 63, ri = (c2 + j) & 1;
                        const float cr = Cs[((d * 16 + o) * 64 + p) * 2], ci = Cs[((d * 16 + o) * 64 + p) * 2 + 1], pr = PW[((d * 64 + p) * 17 + k) * 2], pi = PW[((d * 64 + p) * 17 + k) * 2 + 1];
                        v[j] = ri == 0 ? cr * pr - ci * pi : -(cr * pi + ci * pr); } }
                u32x4 w; w.x = cvt_pk_bf16(v[0], v[1]); w.y = cvt_pk_bf16(v[2], v[3]); w.z = cvt_pk_bf16(v[4], v[5]); w.w = cvt_pk_bf16(v[6], v[7]);
                *(u32x4*)(OPY + (size_t)row * 512 + c0) = w; }
        }
        __syncthreads();
        for (;;) {
            __syncthreads();
            if (tid == 0) MISC[16] = atomicAdd(ctl + CW_QUEUE, 4u);
            __syncthreads();
            const int base = (int)MISC[16];
            if (base >= JT_SMALL.total) break;
            convert_step(a, JT_SMALL, (LAS float*)lds, base, 1);
        }
        __syncthreads();
    }
    SEAM(0);

    for (int l = 0; l < 2; ++l) {
        const int P0 = 1 + l * NPH_LAYER;
        const float* MODL = MOD + (size_t)l * 5 * 6144;
        const unsigned char* WL = ws + WS_WL + (size_t)l * SZ_WL;
        const int nMrow = (l == 0) ? 68 : 64;
        const float* xlat = (l == 0) ? x_in : a.out; const float* xctx = (l == 0) ? ctx_in : XSC;

        if (((PHMASK >> 1) & 1) && l == 0 && IN(P0 + 0)) {
            const int lane = opaque(tid0) & 63;
            for (int r = bid * 8 + wave; r < RT; r += G * 8) {
                const float* src = r < RL ? x_in + (size_t)r * D : ctx_in + (size_t)(r - RL) * D;
                const float* mv = MODL + (size_t)(r < RL ? (r >> 12) : 4) * 6144;
                const RowV n = row_norm(row_load(src, lane));
                row_store_bf16(UB + (size_t)r * D, lane, row_modulate(n, mv, mv + 1024, lane));
            }
        }
        if (l == 0) SEAM(P0 + 0);

        if (((PHMASK >> 2) & 1) && IN(P0 + 1)) {
            const pg8::TabSched S{PARTS.p + l * 8, (const char*)ws, 2, 68 * 23 + 5 * 68, G, bid};
            pg8::EpiProj E{PR, PT, (bf16_t*)(ws + WS_US), 7, ws + WS_GQ};
            pg8::gemm_phase<1024, 1024>(lds, S, E);
        }
        SEAM(P0 + 1);
        if (((PHMASK >> 13) & 1) && IN(P0 + 2)) {
            const int tid = opaque(tid0), lane = tid & 63;
            LAS float* rp = (LAS float*)lds;
            for (int i = tid; i < 6 * 465; i += 512) rp[i] = a.in[24][l * 2790 + i];
            __syncthreads();
            LAS bf16_t* CK = (LAS bf16_t*)(lds + 11264);
            LAS bf16_t* CV = (LAS bf16_t*)(lds + 11264 + 256 * 144);
            const int ngroups = 768 + (l == 0 ? 48 : 0);
            for (int gi = bid; gi < ngroups; gi += G) {
                const bool lat = gi < 768;
                const int combo = lat ? gi >> 5 : (gi - 768) >> 1, b = combo / 6, h = combo - 6 * b;
                const int v = lat ? ((gi & 31) << 3) + wave : (((gi - 768) & 1) << 3) + wave;
                __syncthreads();
                const int tid2 = opaque(tid);
#pragma unroll
                for (int k = 0; k < 4; ++k) { const int c = tid2 + 512 * k, tok = c >> 3, part = c & 7;
                    *(LAS u32x4*)(CK + tok * 72 + part * 8) = *(const u32x4*)(PR + (size_t)(RL + b * CTXL + tok) * LDP + PC_K + h * 64 + part * 8); }
#pragma unroll
                for (int k = 0; k < 4; ++k) { const int c = tid2 + 512 * k, dd = c >> 5, part = c & 31;
                    *(LAS u32x4*)(CV + dd * 264 + part * 8) = *(const u32x4*)(PT + (size_t)(PT_V + h * 64 + dd) * RT + RL + b * CTXL + part * 8); }
                __syncthreads();
                const int ln2 = opaque(lane), qn = ln2 & 15, g = ln2 >> 4;
                int r = 0, qb, tq, rs = 0, bs = 0, w = 0, cs = 0;
                if (lat) { qb = v & 3; r = v >> 2; rs = r - 4 < 0 ? 0 : (r - 4 > 56 ? 56 : r - 4); bs = qb == 0 ? 0 : (qb == 1 ? 8 : (qb == 2 ? 24 : 32));
                    w = 16 * qb + qn; cs = w - 8 < 0 ? 0 : (w - 8 > 48 ? 48 : w - 8); tq = b * SEQ + r * 64 + w; }
                else { qb = v; tq = RL + b * CTXL + 16 * qb + qn; }
                const bf16_t* qp = PR + (size_t)tq * LDP + PC_Q + h * 64 + 8 * g;
                const bf16x8 q0 = *(const bf16x8*)qp, q1 = *(const bf16x8*)(qp + 32);
                f32x4 S[32];
                const int koff = 8 * (qn >> 2) + (qn & 3);
                if (lat) {
#pragma unroll
                    for (int pb = 0; pb < 4; ++pb) {
                        bf16x8 kf[8];
#pragma unroll
                        for (int q = 0; q < 4; ++q) { const int p = pb * 2 + (q >> 1), hf = q & 1;
                            const bf16_t* kp = PR + (size_t)(b * SEQ + (rs + p) * 64 + bs + koff + 4 * hf) * LDP + PC_K + h * 64 + 8 * g;
                            kf[2 * q] = *(const bf16x8*)kp; kf[2 * q + 1] = *(const bf16x8*)(kp + 32); }
                        PIN8(kf);
#pragma unroll
                        for (int q = 0; q < 4; ++q) { const int p = pb * 2 + (q >> 1), hf = q & 1;
                            f32x4 acc = {0.f, 0.f, 0.f, 0.f};
                            acc = __builtin_amdgcn_mfma_f32_16x16x32_bf16(kf[2 * q], q0, acc, 0, 0, 0);
                            acc = __builtin_amdgcn_mfma_f32_16x16x32_bf16(kf[2 * q + 1], q1, acc, 0, 0, 0);
                            const int rowoff = (h * 15 + (rs + p - r + 7)) * 31;
#pragma unroll
                            for (int j = 0; j < 4; ++j) { const int c = bs + 8 * g + 4 * hf + j; const bool ok = (c >= cs) && (c < cs + 16);
                                const int dc = ok ? c - w + 15 : 0;
                                acc[j] = ok ? acc[j] * 0.125f + rp[rowoff + dc] : -3.0e38f; }
                            S[2 * p + hf] = acc; }
                    }
                } else {
#pragma unroll
                    for (int p = 0; p < 16; ++p) S[p] = (f32x4){-3.0e38f, -3.0e38f, -3.0e38f, -3.0e38f};
                }
#pragma unroll
                for (int p = 0; p < 8; ++p)
#pragma unroll
                    for (int hf = 0; hf < 2; ++hf) { const LAS bf16_t* kp = CK + (32 * p + koff + 4 * hf) * 72 + 8 * g;
                        const bf16x8 k0 = *(const LAS bf16x8*)kp, k1 = *(const LAS bf16x8*)(kp + 32);
                        f32x4 acc = {0.f, 0.f, 0.f, 0.f};
                        acc = __builtin_amdgcn_mfma_f32_16x16x32_bf16(k0, q0, acc, 0, 0, 0);
                        acc = __builtin_amdgcn_mfma_f32_16x16x32_bf16(k1, q1, acc, 0, 0, 0);
                        S[16 + 2 * p + hf] = acc * 0.125f; if (hf == 1 && (p & 1)) __builtin_amdgcn_sched_barrier(0); }
                float mx = -3.0e38f;
#pragma unroll
                for (int i = 0; i < 32; ++i) mx = fmaxf(fmaxf(mx, fmaxf(S[i][0], S[i][1])), fmaxf(S[i][2], S[i][3]));
                mx = fmaxf(mx, __shfl_xor(mx, 16)); mx = fmaxf(mx, __shfl_xor(mx, 32));
                float sum = 0.f;
#pragma unroll
                for (int i = 0; i < 32; ++i) {
#pragma unroll
                    for (int j = 0; j < 4; ++j) { const float e = __expf(S[i][j] - mx); S[i][j] = e; sum += e; } }
                sum += __shfl_xor(sum, 16); sum += __shfl_xor(sum, 32);
                const float inv = 1.0f / sum;
                f32x4 O[4];
#pragma unroll
                for (int dt = 0; dt < 4; ++dt) O[dt] = (f32x4){0.f, 0.f, 0.f, 0.f};
                const bf16_t* vt = PT + (size_t)(PT_V + h * 64 + qn) * RT + 8 * g;
                if (lat) {
#pragma unroll
                    for (int pq = 0; pq < 2; ++pq) {
                        bf16x8 vf[16];
#pragma unroll
                        for (int q = 0; q < 4; ++q) { const int p = pq * 4 + q; const int base = b * SEQ + (rs + p) * 64 + bs;
#pragma unroll
                            for (int dt = 0; dt < 4; ++dt) vf[4 * q + dt] = *(const bf16x8*)(vt + (size_t)(16 * dt) * RT + base); }
                        PIN16(vf);
#pragma unroll
                        for (int q = 0; q < 4; ++q) { const int p = pq * 4 + q;
                            u32x4 pw; pw.x = cvt_pk_bf16(S[2 * p][0], S[2 * p][1]); pw.y = cvt_pk_bf16(S[2 * p][2], S[2 * p][3]); pw.z = cvt_pk_bf16(S[2 * p + 1][0], S[2 * p + 1][1]); pw.w = cvt_pk_bf16(S[2 * p + 1][2], S[2 * p + 1][3]);
                            bf16x8 pf; __builtin_memcpy(&pf, &pw, 16);
#pragma unroll
                            for (int dt = 0; dt < 4; ++dt) O[dt] = __builtin_amdgcn_mfma_f32_16x16x32_bf16(vf[4 * q + dt], pf, O[dt], 0, 0, 0); }
                    }
                }
#pragma unroll
                for (int p = 8; p < 16; ++p) {
                    u32x4 pw; pw.x = cvt_pk_bf16(S[2 * p][0], S[2 * p][1]); pw.y = cvt_pk_bf16(S[2 * p][2], S[2 * p][3]); pw.z = cvt_pk_bf16(S[2 * p + 1][0], S[2 * p + 1][1]); pw.w = cvt_pk_bf16(S[2 * p + 1][2], S[2 * p + 1][3]);
                    bf16x8 pf; __builtin_memcpy(&pf, &pw, 16);
#pragma unroll
                    for (int dt = 0; dt < 4; ++dt) { const bf16x8 vfl = *(const LAS bf16x8*)(CV + (16 * dt + qn) * 264 + 32 * (p - 8) + 8 * g);
                        O[dt] = __builtin_amdgcn_mfma_f32_16x16x32_bf16(vfl, pf, O[dt], 0, 0, 0); }
                    if (p & 1) __builtin_amdgcn_sched_barrier(0);
                }
                bf16_t* op = YB + (size_t)tq * YW + YC_C + h * 64 + 4 * g;
#pragma unroll
                for (int dt = 0; dt < 4; ++dt) { u32x2 o2; o2.x = cvt_pk_bf16(O[dt][0] * inv, O[dt][1] * inv); o2.y = cvt_pk_bf16(O[dt][2] * inv, O[dt][3] * inv); *(u32x2*)(op + 16 * dt) = o2; }
            }
            __syncthreads();
            {
                const int tid = opaque(tid0), lane = tid & 63;
                LAS float* XC = (LAS float*)lds;
                LAS f32x2* AB = (LAS f32x2*)(lds + 16 * 384 * 4);
                const float* cw = a.in[7] + l * 4 * 384; const float* cb = a.in[8] + l * 384;
                const bf16_t* LW = (const bf16_t*)(ws + WS_LW) + (size_t)l * 24 * 4096;
                bf16_t* LT = (bf16_t*)(ws + WS_LT); f32x2* LAGG = (f32x2*)(ws + WS_LAGG);
                const int dir = (wave >> 2) & 1, ntile = wave & 3, tk = lane & 15, kg = lane >> 4;
                LAS float* CT = (LAS float*)(lds + 16 * 384 * 4 + 2 * 16 * 384 * 8);
                for (int i = tid; i < 768; i += 512) { CT[i] = a.in[10][l * 768 + i]; CT[768 + i] = a.in[12][l * 768 + i]; CT[1536 + i] = -8.0f * softplus(-a.in[13][l * 768 + i]); }
                float cwv[60];
#pragma unroll
                for (int i = 0; i < 12; ++i) { const int idx = tid + 512 * i, ch = idx % 384;
                    cwv[5 * i] = cw[ch]; cwv[5 * i + 1] = cw[384 + ch]; cwv[5 * i + 2] = cw[768 + ch]; cwv[5 * i + 3] = cw[1152 + ch]; cwv[5 * i + 4] = cb[ch]; }
                PIN16(cwv); PIN16(cwv + 16); PIN16(cwv + 32); PIN8(cwv + 48); asm volatile("" : "+v"(cwv[56]), "+v"(cwv[57]), "+v"(cwv[58]), "+v"(cwv[59]));
                for (int n = bid; n < NCHK; n += G) {
                    const int r0 = 16 * n; int start, len, pos0, bb; row_seq(r0, start, len, pos0, bb);
                    __syncthreads();
                    unsigned pin[48];
#pragma unroll
                    for (int i = 0; i < 12; ++i) { const int idx = tid + 512 * i, tok = idx / 384, ch = idx - tok * 384, pos = pos0 + tok;
                        const bf16_t* pr = PR + (size_t)(r0 + tok) * LDP + PC_AC + ch;
                        pin[4 * i + 0] = pos >= 2 ? pr[-2 * LDP] : 0; pin[4 * i + 1] = pos >= 1 ? pr[-LDP] : 0; pin[4 * i + 2] = pr[0]; pin[4 * i + 3] = pos + 1 < len ? pr[LDP] : 0; }
                    PIN16(pin); PIN16(pin + 16); PIN16(pin + 32);
#pragma unroll
                    for (int i = 0; i < 12; ++i) { const int idx = tid + 512 * i, tok = idx / 384, ch = idx - tok * 384;
                        XC[idx] = cwv[5 * i + 4] + cwv[5 * i] * bflo(pin[4 * i]) + cwv[5 * i + 1] * bflo(pin[4 * i + 1]) + cwv[5 * i + 2] * bflo(pin[4 * i + 2]) + cwv[5 * i + 3] * bflo(pin[4 * i + 3]); }
                    __syncthreads();
#pragma unroll 2
                    for (int g = 0; g < 6; ++g) {
                        bf16x8 wq[4];
#pragma unroll
                        for (int ks = 0; ks < 2; ++ks) { const bf16_t* wp = LW + ((size_t)((dir * 2 + 0) * 6 + g) * 64 + 16 * ntile + tk) * 64 + 32 * ks + 8 * kg; wq[2 * ks] = *(const bf16x8*)wp; wq[2 * ks + 1] = *(const bf16x8*)(wp + 6 * 4096); }
                        asm volatile("" : "+v"(wq[0]), "+v"(wq[1]), "+v"(wq[2]), "+v"(wq[3]));
                        f32x4 ar = {0.f, 0.f, 0.f, 0.f}, ai = {0.f, 0.f, 0.f, 0.f};
#pragma unroll
                        for (int ks = 0; ks < 2; ++ks) {
                            const LAS float* xp = XC + tk * 384 + g * 64 + 32 * ks + 8 * kg;
                            const f32x4 x0 = *(const LAS f32x4*)xp, x1 = *(const LAS f32x4*)(xp + 4);
                            u32x4 xw; xw.x = cvt_pk_bf16(x0[0], x0[1]); xw.y = cvt_pk_bf16(x0[2], x0[3]); xw.z = cvt_pk_bf16(x1[0], x1[1]); xw.w = cvt_pk_bf16(x1[2], x1[3]);
                            bf16x8 xf; __builtin_memcpy(&xf, &xw, 16);
                            ar = __builtin_amdgcn_mfma_f32_16x16x32_bf16(xf, wq[2 * ks], ar, 0, 0, 0);
                            ai = __builtin_amdgcn_mfma_f32_16x16x32_bf16(xf, wq[2 * ks + 1], ai, 0, 0, 0);
                        }
                        const int ch = g * 64 + 16 * ntile + tk;
                        const float br = CT[dir * 384 + ch], bi = CT[768 + dir * 384 + ch], sp8 = CT[1536 + dir * 384 + ch];
#pragma unroll
                        for (int j = 0; j < 4; ++j) { const int tok = 4 * kg + j;
                            const float la = sigm(ar[j] + br) * sp8, y = 2.0f * la;
                            const float av = 1.0f + la * (1.0f + la * (0.5f + la * (0.16666667f + la * (0.041666667f + la * 0.0083333333f))));
                            const float om = -y * (1.0f + y * (0.5f + y * (0.16666667f + y * (0.041666667f + y * (0.0083333333f + y * 0.0013888889f)))));
                            const float bt = __builtin_sqrtf(om) * sigm(ai[j] + bi) * XC[tok * 384 + ch];
                            AB[(dir * 16 + tok) * 384 + ch] = (f32x2){av, bt}; }
                    }
                    __syncthreads();
                    if (tid < 384) {
                        float hf = 0.f, pf = 1.f, hb = 0.f, pb = 1.f;
#pragma unroll
                        for (int t = 0; t < 16; ++t) {
                            const f32x2 f = AB[t * 384 + tid], bk = AB[(16 + 15 - t) * 384 + tid];
                            hf = f[0] * hf + f[1]; pf *= f[0]; hb = bk[0] * hb + bk[1]; pb *= bk[0];
                            AB[t * 384 + tid] = (f32x2){pf, hf}; AB[(16 + 15 - t) * 384 + tid] = (f32x2){pb, hb}; }
                        LAGG[((size_t)n * 2 + 0) * 384 + tid] = (f32x2){pf, hf}; LAGG[((size_t)n * 2 + 1) * 384 + tid] = (f32x2){pb, hb};
                    }
                    __syncthreads();
#pragma unroll
                    for (int i = 0; i < 12; ++i) { const int idx = tid + 512 * i, tok = idx / 384, ch = idx - tok * 384;
                        const f32x2 f = AB[idx], bk = AB[16 * 384 + idx];
                        bf16_t* o = LT + (size_t)(r0 + tok) * 1152 + ch;
                        o[0] = f2bf(f[1] + bk[1]); o[384] = f2bf(f[0]); o[768] = f2bf(bk[0]); }
                }
                __syncthreads();
            }
            {
                const int tid = opaque(tid0), lane = tid & 63;
                constexpr int ZS = SEQ + 16;
                LAS bf16_t* R0 = (LAS bf16_t*)lds;
                LAS bf16_t* R1 = R0 + 8224;
                LAS bf16_t* ZA = R1 + 8224;
                const LAS unsigned* Rdw = (const LAS unsigned*)lds;
#define HY_ZF(b, s) ((b) * ZS + ((s) & ~63) + (((((s) >> 3) & 7) ^ (((s) >> 7) & 1)) << 3) + ((s) & 7))
                const float* hcw = a.in[14] + l * 3 * 768; const float* hcb = a.in[15] + l * 768;
                const float* nrm = (const float*)(ctl + CW_HYN);
                bf16_t* YT = (bf16_t*)(ws + WS_YT);
                const int r32 = lane & 31, hh = lane >> 5, il = r32 >> 2, bq = r32 & 3, iblk = 8 * wave + il;
                const int x0b = 4095 - r32 + 8 * hh, par = x0b & 1;
                const int abase = (par ? 4112 : 0) + ((x0b - par) >> 1);
                for (int c = bid; c < 256; c += G) {
                    __syncthreads();
#pragma unroll 1
                    for (int it = tid; it < 3 * 4 * 512; it += 512) {
                        const int arr = it >> 11, b = (it >> 9) & 3, s8 = (it & 511) * 8, ch = arr * 256 + c;
                        const bf16_t* pp = PT + (size_t)ch * RT + b * SEQ + s8;
                        const u32x4 pv = *(const u32x4*)pp;
                        const float w0 = hcw[ch], w1 = hcw[768 + ch], w2 = hcw[1536 + ch], cb0 = hcb[ch];
                        float p[10];
                        p[0] = s8 > 0 ? bf2f(pp[-1]) : 0.f; p[9] = s8 + 8 < SEQ ? bf2f(pp[8]) : 0.f;
                        p[1] = bflo(pv.x); p[2] = bfhi(pv.x); p[3] = bflo(pv.y); p[4] = bfhi(pv.y); p[5] = bflo(pv.z); p[6] = bfhi(pv.z); p[7] = bflo(pv.w); p[8] = bfhi(pv.w);
                        float z[8];
#pragma unroll
                        for (int j = 0; j < 8; ++j) z[j] = cb0 + w0 * p[j] + w1 * p[j + 1] + w2 * p[j + 2];
                        u32x4 w; w.x = cvt_pk_bf16(z[0], z[1]); w.y = cvt_pk_bf16(z[2], z[3]); w.z = cvt_pk_bf16(z[4], z[5]); w.w = cvt_pk_bf16(z[6], z[7]);
                        *(LAS u32x4*)(ZA + arr * 4 * ZS + HY_ZF(b, s8)) = w;
                    }
#pragma unroll 1
                    for (int o = 0; o < 2; ++o) {
                        const bf16_t* kf = (const bf16_t*)(ws + WS_KFL) + ((size_t)((l * 2 + 0) * 2 + o) * 256 + c) * SEQ;
                        const bf16_t* kb = (const bf16_t*)(ws + WS_KFL) + ((size_t)((l * 2 + 1) * 2 + o) * 256 + c) * SEQ;
                        { unsigned tv[16];
#pragma unroll
                          for (int q = 0; q < 16; ++q) { const int x = tid + 512 * q; tv[q] = x < 4096 ? kf[4095 - x] : (x <= 8190 ? kb[x - 4095] : (bf16_t)0); }
                          PIN16(tv);
#pragma unroll
                          for (int q = 0; q < 16; ++q) R0[tid + 512 * q] = (bf16_t)tv[q]; }
                        __syncthreads();
                        for (int x = tid; x < 8192; x += 512) R1[x] = x < 8191 ? R0[x + 1] : (bf16_t)0;
                        __syncthreads();
                        const LAS bf16_t* Z = ZA + (o == 0 ? 0 : 4 * ZS) + bq * ZS;
                        typedef float f32x16 __attribute__((ext_vector_type(16)));
                        f32x16 acc0, acc1;
#pragma unroll
                        for (int q = 0; q < 16; ++q) { acc0[q] = 0.f; acc1[q] = 0.f; }
                        const int dlo = 8 * wave - 63, dhi = 8 * wave + 7;
#define HY_AF(dst, off_) do { const LAS unsigned* a_ = ap + (off_); u32x4 w_ = {a_[0], a_[1], a_[2], a_[3]}; __builtin_memcpy(&dst, &w_, 16); } while (0)
                        {
                            bf16x8 f16, f24;
                            { const LAS unsigned* ap = Rdw + abase - 32 * dlo; HY_AF(f16, 16); HY_AF(f24, 24); }
#pragma unroll 1
                            for (int dl = dlo; dl <= dhi; ++dl) {
                                const int j = iblk - dl; const bool ok = (j >= 0) && (j < 64); const int jc = j < 0 ? 0 : (j > 63 ? 63 : j);
                                const LAS bf16_t* zp = Z + jc * 64; const int sw = (jc >> 1) & 1;
                                const LAS unsigned* ap = Rdw + abase - 32 * dl;
                                bf16x8 bf[4], fm16, fm8, f0, f8;
#pragma unroll
                                for (int kk = 0; kk < 4; ++kk) { bf16x8 t = *(const LAS bf16x8*)(zp + (((2 * kk + hh) ^ sw) << 3)); bf[kk] = ok ? t : (bf16x8){0, 0, 0, 0, 0, 0, 0, 0}; }
                                HY_AF(fm16, -16); HY_AF(fm8, -8); HY_AF(f0, 0); HY_AF(f8, 8);
                                acc0 = __builtin_amdgcn_mfma_f32_32x32x16_bf16(f0, bf[0], acc0, 0, 0, 0);  acc1 = __builtin_amdgcn_mfma_f32_32x32x16_bf16(fm16, bf[0], acc1, 0, 0, 0);
                                acc0 = __builtin_amdgcn_mfma_f32_32x32x16_bf16(f8, bf[1], acc0, 0, 0, 0);  acc1 = __builtin_amdgcn_mfma_f32_32x32x16_bf16(fm8, bf[1], acc1, 0, 0, 0);
                                acc0 = __builtin_amdgcn_mfma_f32_32x32x16_bf16(f16, bf[2], acc0, 0, 0, 0); acc1 = __builtin_amdgcn_mfma_f32_32x32x16_bf16(f0, bf[2], acc1, 0, 0, 0);
                                acc0 = __builtin_amdgcn_mfma_f32_32x32x16_bf16(f24, bf[3], acc0, 0, 0, 0); acc1 = __builtin_amdgcn_mfma_f32_32x32x16_bf16(f8, bf[3], acc1, 0, 0, 0);
                                f16 = fm16; f24 = fm8;
                            }
                        }
#undef HY_AF
                        const float inv = 1.0f / (nrm[(l * 2 + o) * 256 + c] + 1e-6f), hb = a.in[23][(l * 2 + o) * 256 + c];
                        LAS bf16_t* GI = ZA + (o + 1) * 4 * ZS;
                        const LAS bf16_t* ZI = ZA + (o == 0 ? 0 : 4 * ZS);
#pragma unroll
                        for (int q = 0; q < 16; ++q) {
                            const int a0r = (q & 3) + 8 * (q >> 2) + 4 * hh, t0 = 64 * iblk + a0r, t1 = t0 + 32;
                            const int i0 = HY_ZF(bq, t0), i1 = HY_ZF(bq, t1);
                            const float zv0 = bf2f(ZI[i0]), zv1 = bf2f(ZI[i1]);
                            const float y0 = bf2f(GI[i0]) * (acc0[q] * inv + hb * zv0), y1v = bf2f(GI[i1]) * (acc1[q] * inv + hb * zv1);
                            GI[i0] = f2bf(y0); GI[i1] = f2bf(y1v);
                        }
                        __syncthreads();
                    }
                    for (int it = tid; it < 4 * 512; it += 512) { const int b = it >> 9, s8 = (it & 511) * 8;
                        *(u32x4*)(YT + (size_t)c * RT + b * SEQ + s8) = *(const LAS u32x4*)(ZA + 2 * 4 * ZS + HY_ZF(b, s8)); }
                    if (l == 0) {
                        __syncthreads();
                        LAS float* zc = (LAS float*)lds;
                        LAS float* kc = zc + 3072;
                        LAS float* y1c = kc + 1024;
                        for (int it = tid; it < 3072; it += 512) { const int arr = it >> 10, b = (it >> 8) & 3, sx = it & 255, ch = arr * 256 + c;
                            const bf16_t* pp = PT + (size_t)ch * RT + RL + b * CTXL + sx;
                            float z = hcb[ch] + hcw[768 + ch] * bf2f(pp[0]); if (sx > 0) z += hcw[ch] * bf2f(pp[-1]); if (sx + 1 < CTXL) z += hcw[1536 + ch] * bf2f(pp[1]);
                            zc[it] = z; }
                        for (int it = tid; it < 1024; it += 512) { const int o = it >> 9, d = (it & 511) - 256;
                            const bf16_t* kfc = (const bf16_t*)(ws + WS_KFC) + ((size_t)(0 * 2 + o) * 256 + c) * CTXL; const bf16_t* kbc = (const bf16_t*)(ws + WS_KFC) + ((size_t)(1 * 2 + o) * 256 + c) * CTXL;
                            kc[it] = d >= 0 ? bf2f(kfc[d]) : (d > -256 ? bf2f(kbc[-d]) : 0.f); }
                        __syncthreads();
#pragma unroll 1
                        for (int o = 0; o < 2; ++o) {
                            const float inv = 1.0f / (nrm[1024 + o * 256 + c] + 1e-6f), hb = a.in[23][o * 256 + c];
                            for (int it = tid; it < 1024; it += 512) { const int b = it >> 8, t = it & 255;
                                const LAS float* zi = o == 0 ? zc + b * 256 : y1c + b * 256;
                                const LAS float* kk = kc + o * 512 + 256 + t;
                                float acc = 0.f;
#pragma unroll 16
                                for (int sx = 0; sx < CTXL; ++sx) acc += kk[-sx] * zi[sx];
                                const float y = zc[(o + 1) * 1024 + b * 256 + t] * (acc * inv + hb * zi[t]);
                                if (o == 0) y1c[it] = y; else YT[(size_t)c * RT + RL + b * CTXL + t] = f2bf(y); }
                            __syncthreads();
                        }
                    }
                }
#undef HY_ZF
                __syncthreads();
            }
            {
                const pg8::TabSched S{PARTS.p + 18 + l * 3, (const char*)ws, 1, 80, G, bid};
                pg8::EpiS5State E{(float*)(ws + WS_S5S)};
                pg8::gemm_phase<512, 256>(lds, S, E);
            }
        }
        SEAM(P0 + 2);
        if (((PHMASK >> 14) & 1) && IN(P0 + 3)) {
            const int tid = opaque(tid0), lane = tid & 63;
            LAS float* st = (LAS float*)lds;
            const float* S5S = (const float*)(ws + WS_S5S); bf16_t* US = (bf16_t*)(ws + WS_US);
            for (int u = bid; u < 128; u += G) {
                const int d = u & 1, g = (u >> 1) & 15, b = u >> 5;
                __syncthreads();
                for (int i = tid; i < 272 * 32; i += 512) { const int q = i >> 5, c4 = (i & 31) * 4; const int n = q < 16 ? 1024 + 16 * b + q : 256 * b + (q - 16);
                    const f32x4 v = *(const f32x4*)(S5S + ((size_t)g * NCHKP + n) * 256 + d * 128 + c4);
                    st[q * 128 + c4] = v[0]; st[q * 128 + c4 + 1] = v[1]; st[q * 128 + c4 + 2] = v[2]; st[q * 128 + c4 + 3] = v[3]; }
                __syncthreads();
                if (wave == 0) {
                    const float* ab = (const float*)(ws + WS_AB16) + ((size_t)((l * 2 + d) * 16 + g) * 64 + lane) * 2;
                    const float ar = ab[0], ai = ab[1];
                    float hr = 0.f, hi = 0.f;
                    for (int k = 0; k < 272; ++k) {
                        const int q = d == 0 ? k : (k < 16 ? 15 - k : 287 - k);
                        const int n = q < 16 ? 1024 + 16 * b + q : 256 * b + (q - 16);
                        *(unsigned*)(US + ((size_t)g * NCHKP + n) * 512 + 256 + d * 128 + 2 * lane) = cvt_pk_bf16(hr, hi);
                        const float sr = st[q * 128 + 2 * lane], si = st[q * 128 + 2 * lane + 1];
                        const float nr = ar * hr - ai * hi + sr, ni = ar * hi + ai * hr + si;
                        hr = nr; hi = ni;
                    }
                }
            }
            __syncthreads();
            for (int u = bid - 128; u >= 0 && u < 48; u += G) {
                const int cb6 = u % 6, d = (u / 6) & 1, b = u / 12;
                LAS f32x2* sa = (LAS f32x2*)lds;
                const f32x2* LAGG = (const f32x2*)(ws + WS_LAGG); float* HIN = (float*)(ws + WS_LHIN);
                __syncthreads();
                for (int i = tid; i < 272 * 64; i += 512) { const int q = i >> 6, c = i & 63; const int n = q < 16 ? 1024 + 16 * b + q : 256 * b + (q - 16);
                    sa[i] = LAGG[((size_t)n * 2 + d) * 384 + cb6 * 64 + c]; }
                __syncthreads();
                if (wave == 0) {
                    float h = 0.f;
                    for (int k = 0; k < 272; ++k) {
                        const int q = d == 0 ? k : (k < 16 ? 15 - k : 287 - k);
                        const int n = q < 16 ? 1024 + 16 * b + q : 256 * b + (q - 16);
                        HIN[((size_t)n * 2 + d) * 384 + cb6 * 64 + lane] = h;
                        const f32x2 v = sa[q * 64 + lane];
                        h = v[0] * h + v[1];
                    }
                }
            }
            __syncthreads();
        }
        SEAM(P0 + 3);
        if (((PHMASK >> 15) & 1) && IN(P0 + 4)) {
            const pg8::TabSched S{PARTS.p + 19 + l * 3, (const char*)ws, 1, 80, G, bid};
            pg8::EpiS5Main E{(bf16_t*)(ws + WS_GL), PR, a.in[32] + l * 256};
            pg8::gemm_phase<512, 512>(lds, S, E);
            {
                const int tid = opaque(tid0);
                const bf16_t* YT = (const bf16_t*)(ws + WS_YT);
                LAS bf16_t* tl = (LAS bf16_t*)lds;
                const int nrt = nMrow * 4;
                for (int t = bid; t < 4 * nrt; t += G) {
                    const int c0 = (t & 3) * 64, r0 = (t >> 2) * 64;
                    __syncthreads();
                    { const int cc = tid >> 3, r8 = (tid & 7) * 8; *(LAS u32x4*)(tl + cc * 72 + r8) = *(const u32x4*)(YT + (size_t)(c0 + cc) * RT + r0 + r8); }
                    __syncthreads();
                    { const int rr = tid >> 3, c8 = (tid & 7) * 8; unsigned short e[8];
#pragma unroll
                        for (int j = 0; j < 8; ++j) e[j] = tl[(c8 + j) * 72 + rr];
                        u32x4 w; w.x = e[0] | ((unsigned)e[1] << 16); w.y = e[2] | ((unsigned)e[3] << 16); w.z = e[4] | ((unsigned)e[5] << 16); w.w = e[6] | ((unsigned)e[7] << 16);
                        *(u32x4*)(YB + (size_t)(r0 + rr) * YW + YC_B + c0 + c8) = w; }
                }
                __syncthreads();
            }
            {
                const int tid = opaque(tid0);
                const bf16_t* LT = (const bf16_t*)(ws + WS_LT); const float* HIN = (const float*)(ws + WS_LHIN);
                const int nrows = nMrow * 256;
                for (int it = bid * 512 + tid; it < nrows * 48; it += G * 512) {
                    const int r = it / 48, c8 = (it - r * 48) * 8, n = r >> 4;
                    const u32x4 gt = *(const u32x4*)(PR + (size_t)r * LDP + PC_AG + c8);
                    const bf16_t* lt = LT + (size_t)r * 1152 + c8;
                    const u32x4 sv = *(const u32x4*)lt, pf = *(const u32x4*)(lt + 384), pb = *(const u32x4*)(lt + 768);
                    const float* hf = HIN + ((size_t)n * 2 + 0) * 384 + c8; const float* hb = hf + 384;
                    const f32x4 hf0 = *(const f32x4*)hf, hf1 = *(const f32x4*)(hf + 4), hb0 = *(const f32x4*)hb, hb1 = *(const f32x4*)(hb + 4);
                    u32x4 w;
                    w.x = cvt_pk_bf16(gelu_f(bflo(gt.x)) * (bflo(sv.x) + bflo(pf.x) * hf0[0] + bflo(pb.x) * hb0[0]), gelu_f(bfhi(gt.x)) * (bfhi(sv.x) + bfhi(pf.x) * hf0[1] + bfhi(pb.x) * hb0[1]));
                    w.y = cvt_pk_bf16(gelu_f(bflo(gt.y)) * (bflo(sv.y) + bflo(pf.y) * hf0[2] + bflo(pb.y) * hb0[2]), gelu_f(bfhi(gt.y)) * (bfhi(sv.y) + bfhi(pf.y) * hf0[3] + bfhi(pb.y) * hb0[3]));
                    w.z = cvt_pk_bf16(gelu_f(bflo(gt.z)) * (bflo(sv.z) + bflo(pf.z) * hf1[0] + bflo(pb.z) * hb1[0]), gelu_f(bfhi(gt.z)) * (bfhi(sv.z) + bfhi(pf.z) * hf1[1] + bfhi(pb.z) * hb1[1]));
                    w.w = cvt_pk_bf16(gelu_f(bflo(gt.w)) * (bflo(sv.w) + bflo(pf.w) * hf1[2] + bflo(pb.w) * hb1[2]), gelu_f(bfhi(gt.w)) * (bfhi(sv.w) + bfhi(pf.w) * hf1[3] + bfhi(pb.w) * hb1[3]));
                    *(u32x4*)(YB + (size_t)r * YW + YC_A + c8) = w;
                }
            }
        }
        SEAM(P0 + 4);
        if (((PHMASK >> 15) & 1) && IN(P0 + 5)) {
            const pg8::TabSched S{PARTS.p + 20 + l * 3, (const char*)ws, 1, nMrow, G, bid};
            pg8::EpiS5Glu E{YB, (const bf16_t*)(ws + WS_GL), a.in[34] + l * 256};
            pg8::gemm_phase<256, 256>(lds, S, E);
        }
        SEAM(P0 + 5);
        if (((PHMASK >> 3) & 1) && IN(P0 + 6)) {
            const pg8::MergeSched S{(const char*)ws, (long long)WS_YB, (long long)(WS_WL + (size_t)l * SZ_WL + SZ_WINR + SZ_WINHY), 64, G, bid, l == 0 ? 64 : 0};
            pg8::EpiGate E{ws + WS_GQ, UB, (bf16_t*)(ws + WS_MGC)};
            pg8::gemm_phase<1280, 1280>(lds, S, E);
        }
        SEAM(P0 + 6);
        if (((PHMASK >> 4) & 1) && IN(P0 + 7)) {
            const pg8::TabSched S{l == 0 ? PARTS.p + 24 : PARTS.p + 14, (const char*)ws, l == 0 ? 2 : 1, l == 0 ? 256 + 64 : 256, G, bid};
            pg8::EpiRes E{PRE, xlat, xctx, MODL + 2048, (float*)(ws + WS_EXTRA)};
            pg8::gemm_phase<1024, 1024>(lds, S, E);
        }
        SEAM(P0 + 7);
        if (((PHMASK >> 5) & 1) && IN(P0 + 8)) {
            const int lane = opaque(tid0) & 63;
            if (l == 1) convert_tiles_pipelined(a, JT_MOE, (LAS float*)lds, bid, G);
            const float* lg = a.in[40] + l * D; const float* lb = a.in[41] + l * D;
            const int nrows = nMrow * 256;
            for (int r = bid * 8 + wave; r < nrows; r += G * 8) {
                const float* mv = MODL + (size_t)(r < RL ? (r >> 12) : 4) * 6144;
                RowV pre;
                if (r < RL) pre = row_load(PRE + (size_t)r * D, lane);
                else { const float* pp = (const float*)(ws + WS_EXTRA) + (size_t)(r - RL) * D; const RowV xin = row_load(ctx_in + (size_t)(r - RL) * D, lane), p0 = row_load(pp, lane), p1 = row_load(pp + (size_t)RC * D, lane), p2 = row_load(pp + (size_t)2 * RC * D, lane), p3 = row_load(pp + (size_t)3 * RC * D, lane);
#pragma unroll
                    for (int i = 0; i < 4; ++i) pre.v[i] = xin.v[i] * ALPHA + ((p0.v[i] + p1.v[i]) + (p2.v[i] + p3.v[i])); }
                const RowV x1 = row_affine(row_norm(pre), lg, lb, lane);
                row_store(r < RL ? a.out + (size_t)r * D : XSC + (size_t)(r - RL) * D, lane, x1);
                const RowV u2 = row_modulate(row_norm(x1), mv + 3072, mv + 4096, lane);
                row_store_bf16(UB + (size_t)r * D, lane, u2);
                if (l == 1) {
                    float lg8[8];
#pragma unroll
                    for (int e = 0; e < 8; ++e) lg8[e] = 0.f;
                    f32x4 rw[32];
#pragma unroll
                    for (int q = 0; q < 16; ++q) { const float* wp = a.in[47] + (size_t)(256 * (q >> 2) + 4 * lane + (q & 3)) * 8; rw[2 * q] = *(const f32x4*)wp; rw[2 * q + 1] = *(const f32x4*)(wp + 4); }
                    PIN16(rw); PIN16(rw + 16);
#pragma unroll
                    for (int i = 0; i < 4; ++i)
#pragma unroll
                        for (int j = 0; j < 4; ++j) { const float uv = u2.v[i][j];
                            const f32x4 w0 = rw[2 * (4 * i + j)], w1 = rw[2 * (4 * i + j) + 1];
                            lg8[0] += uv * w0[0]; lg8[1] += uv * w0[1]; lg8[2] += uv * w0[2]; lg8[3] += uv * w0[3]; lg8[4] += uv * w1[0]; lg8[5] += uv * w1[1]; lg8[6] += uv * w1[2]; lg8[7] += uv * w1[3]; }
#pragma unroll
                    for (int e = 0; e < 8; ++e) lg8[e] = wave_sum(lg8[e]);
                    if (lane == 0) {
                        int i1 = 0; float v1 = lg8[0];
#pragma unroll
                        for (int e = 1; e < 8; ++e) if (lg8[e] > v1) { v1 = lg8[e]; i1 = e; }
                        int i2 = 0; float v2 = -3.0e38f;
#pragma unroll
                        for (int e = 0; e < 8; ++e) if (e != i1 && lg8[e] > v2) { v2 = lg8[e]; i2 = e; }
                        const float e2 = expf(v2 - v1), w1 = 1.f / (1.f + e2), w2 = e2 / (1.f + e2);
                        int* tk = (int*)(ws + WS_TOK) + (size_t)r * 8;
                        tk[0] = i1; tk[1] = i2; ((float*)tk)[2] = w1; ((float*)tk)[3] = w2;
                        tk[4] = (int)atomicAdd(ctl + CW_MOECNT + 64 * i1, 1u); tk[5] = (int)atomicAdd(ctl + CW_MOECNT + 64 * i2, 1u);
                    }
                }
            }
        }
        SEAM(P0 + 8);
        if (l == 0) {
            if (((PHMASK >> 6) & 1) && IN(P0 + 9)) {
                const pg8::TabSched S{PARTS.p + 16, (const char*)ws, 1, 68 * 22, G, bid};
                pg8::EpiSwiglu E{(bf16_t*)(ws + WS_H), FF_DENSE, 0};
                pg8::gemm_phase<1024, 1024>(lds, S, E);
            }
            SEAM(P0 + 9);
            if (((PHMASK >> 7) & 1) && IN(P0 + 10)) {
                const pg8::TabSched S{PARTS.p + 26, (const char*)ws, 3, 256 + 48 + 16, G, bid};
                pg8::EpiRes E{PRE, a.out, XSC, MODL + 5120, (float*)(ws + WS_EXTRA)};
                pg8::gemm_phase<FF_DENSE, FF_DENSE>(lds, S, E);
            }
            SEAM(P0 + 10);
            if (((PHMASK >> 8) & 1) && IN(P0 + 11)) {
                const int lane = opaque(tid0) & 63;
                const float* lg = a.in[42]; const float* lb = a.in[43];
                const float* MODN = MOD + (size_t)5 * 6144;
                for (int r = bid * 8 + wave; r < RT; r += G * 8) {
                    const float* mv = MODN + (size_t)(r < RL ? (r >> 12) : 4) * 6144;
                    RowV pre;
                    if (r < RL) pre = row_load(PRE + (size_t)r * D, lane);
                    else { const float* pp = (const float*)(ws + WS_EXTRA) + (size_t)(r - RL) * D; const RowV xin = row_load(XSC + (size_t)(r - RL) * D, lane), p0 = row_load(pp, lane), p1 = row_load(pp + (size_t)RC * D, lane), p2 = row_load(pp + (size_t)2 * RC * D, lane), p3 = row_load(pp + (size_t)3 * RC * D, lane);
#pragma unroll
                        for (int i = 0; i < 4; ++i) pre.v[i] = xin.v[i] * ALPHA + ((p0.v[i] + p1.v[i]) + (p2.v[i] + p3.v[i])); }
                    const RowV x2 = row_affine(row_norm(pre), lg, lb, lane);
                    row_store(r < RL ? a.out + (size_t)r * D : XSC + (size_t)(r - RL) * D, lane, x2);
                    row_store_bf16(UB + (size_t)r * D, lane, row_modulate(row_norm(x2), mv, mv + 1024, lane));
                }
            }
            SEAM(P0 + 11);
        } else {
            bf16_t* AG = (bf16_t*)(ws + WS_AG); float* slotw = (float*)(ws + WS_SLOTW); int* tile_e = (int*)(ws + WS_TILEE);
            if (((PHMASK >> 9) & 1) && IN(P0 + 9)) {
                const int tid = opaque(tid0), lane = tid & 63;
                int ts[NE + 1]; ts[0] = 0;
#pragma unroll
                for (int e = 0; e < NE; ++e) { const unsigned c = __hip_atomic_load(ctl + CW_MOECNT + 64 * e, __ATOMIC_RELAXED, __HIP_MEMORY_SCOPE_AGENT); ts[e + 1] = ts[e] + (int)((c + 255u) >> 8); }
                if (bid == 0) for (int mt = tid; mt < ts[NE]; mt += 512) { int e = 0;
#pragma unroll
                    for (int k = 1; k < NE; ++k) e += (mt >= ts[k]) ? 1 : 0;
                    tile_e[mt] = e; }
                for (int r = bid * 8 + wave; r < RL; r += G * 8) {
                    int* tk = (int*)(ws + WS_TOK) + (size_t)r * 8;
                    const u32x4 v0 = *(const u32x4*)(UB + (size_t)r * D + lane * 16), v1 = *(const u32x4*)(UB + (size_t)r * D + lane * 16 + 8);
#pragma unroll
                    for (int k = 0; k < 2; ++k) {
                        const int e = tk[k], pos = tk[4 + k];
                        int st = 0;
#pragma unroll
                        for (int q = 0; q < NE; ++q) st = (e == q) ? ts[q] : st;
                        const int srow = st * 256 + pos;
                        *(u32x4*)(AG + (size_t)srow * D + lane * 16) = v0; *(u32x4*)(AG + (size_t)srow * D + lane * 16 + 8) = v1;
                        if (lane == 0) { slotw[srow] = ((const float*)tk)[2 + k]; tk[6 + k] = srow; }
                    }
                }
            }
            SEAM(P0 + 9);
            int ttl = 0;
            if (lo <= P0 + 13 && P0 + 10 < hi) {
#pragma unroll
                for (int e = 0; e < NE; ++e) { const unsigned c = __hip_atomic_load(ctl + CW_MOECNT + 64 * e, __ATOMIC_RELAXED, __HIP_MEMORY_SCOPE_AGENT); ttl += (int)((c + 255u) >> 8); }
                ttl = __builtin_amdgcn_readfirstlane(ttl);
            }
#pragma unroll
            for (int pass = 0; pass < 2; ++pass) {
                const int tile0 = pass * MOE_P0; int ntile = pass == 0 ? (ttl < MOE_P0 ? ttl : MOE_P0) : ttl - MOE_P0; ntile = ntile < 0 ? 0 : (ntile > MOE_HCAP ? MOE_HCAP : ntile);
                if (((PHMASK >> 10) & 1) && IN(P0 + 10 + 2 * pass)) {
                    const pg8::MoeSched S{(const char*)AG + (size_t)tile0 * 256 * 1024 * 2, (const char*)(ws + WS_MOEGU), tile_e, 256u * 1024u * 2u, 256u * 1024u * 2u, (size_t)2 * FF_E * 1024 * 2, 28, 16, tile0, ntile, G, bid};
                    pg8::EpiSwiglu E{(bf16_t*)(ws + WS_HM), FF_E, tile0};
                    pg8::gemm_phase<1024, 1024>(lds, S, E);
                }
                SEAM(P0 + 10 + 2 * pass);
                if (((PHMASK >> 11) & 1) && IN(P0 + 11 + 2 * pass)) {
                    pg8::EpiMoeDown E{AG, slotw, (float*)(ws + WS_O2X)};
                    { const int nfull = pass == 0 ? ntile : (ttl < 128 ? ttl : 128) - MOE_P0, nex = pass == 0 ? 0 : ttl - 128;
                        const pg8::MoeTailSched S{(const char*)(ws + WS_HM), (const char*)(ws + WS_MOED), tile_e, tile0, nfull < 0 ? 0 : nfull, nex < 0 ? 0 : nex, G, bid};
                        pg8::gemm_phase<FF_E, FF_E>(lds, S, E); }
                }
                SEAM(P0 + 11 + 2 * pass);
            }
            if (((PHMASK >> 12) & 1) && IN(P0 + 14)) {
                const int lane = opaque(tid0) & 63;
                const float* lg = a.in[42] + D; const float* lb = a.in[43] + D;
                for (int r = bid * 8 + wave; r < RL; r += G * 8) {
                    const int* tk = (const int*)(ws + WS_TOK) + (size_t)r * 8;
                    const int sa = tk[6], sb = tk[7];
                    const bf16_t* oa = AG + (size_t)sa * D; const bf16_t* ob = AG + (size_t)sb * D;
                    const float* gv = MODL + (size_t)(r >> 12) * 6144 + 5120;
                    RowV x1 = row_load(a.out + (size_t)r * D, lane), gq = row_load(gv, lane), pre;
                    u32x2 va[4], vb[4];
#pragma unroll
                    for (int i = 0; i < 4; ++i) { va[i] = *(const u32x2*)(oa + 256 * i + 4 * lane); vb[i] = *(const u32x2*)(ob + 256 * i + 4 * lane); }
                    asm volatile("" : "+v"(va[0]), "+v"(va[1]), "+v"(va[2]), "+v"(va[3]), "+v"(vb[0]), "+v"(vb[1]), "+v"(vb[2]), "+v"(vb[3]), "+v"(x1.v[0]), "+v"(x1.v[1]), "+v"(x1.v[2]), "+v"(x1.v[3]), "+v"(gq.v[0]), "+v"(gq.v[1]), "+v"(gq.v[2]), "+v"(gq.v[3]));
#pragma unroll
                    for (int i = 0; i < 4; ++i) {
                        f32x4 fa = {bflo(va[i].x), bfhi(va[i].x), bflo(va[i].y), bfhi(va[i].y)}, fb = {bflo(vb[i].x), bfhi(vb[i].x), bflo(vb[i].y), bfhi(vb[i].y)};
                        if (sa >= 128 * 256) { const float* px = (const float*)(ws + WS_O2X) + (size_t)(sa - 128 * 256) * D + 256 * i + 4 * lane; fa = (*(const f32x4*)px + *(const f32x4*)(px + (size_t)2048 * D)) + (*(const f32x4*)(px + (size_t)2 * 2048 * D) + *(const f32x4*)(px + (size_t)3 * 2048 * D)); }
                        if (sb >= 128 * 256) { const float* px = (const float*)(ws + WS_O2X) + (size_t)(sb - 128 * 256) * D + 256 * i + 4 * lane; fb = (*(const f32x4*)px + *(const f32x4*)(px + (size_t)2048 * D)) + (*(const f32x4*)(px + (size_t)2 * 2048 * D) + *(const f32x4*)(px + (size_t)3 * 2048 * D)); }
                        pre.v[i] = x1.v[i] * ALPHA + gq.v[i] * (fa + fb); }
                    row_store(a.out + (size_t)r * D, lane, row_affine(row_norm(pre), lg, lb, lane));
                }
            }
        }
    }
#undef IN
#undef SEAM
}

}

extern "C" void kernel_launch(void* const* d_in, const int* in_sizes, int n_in, void* d_out, int out_size, void* d_ws, size_t ws_size, hipStream_t stream) {
    static int grid = 0;
    if (grid == 0) {
        if (n_in != 51 || ws_size < WS_END) { grid = -1; return; }
        int dev = 0, cus = 0;
        if (hipGetDevice(&dev) != hipSuccess || hipDeviceGetAttribute(&cus, hipDeviceAttributeMultiprocessorCount, dev) != hipSuccess) { grid = -1; return; }
        if (hipFuncSetAttribute((const void*)mk_fwd, hipFuncAttributeMaxDynamicSharedMemorySize, LDS_BYTES) != hipSuccess) { grid = -1; return; }
        grid = cus;
    }
    if (grid < 0) return;
    const float* const* in = (const float* const*)d_in;
    unsigned char* ws = (unsigned char*)d_ws;
    (void)hipMemsetAsync(ws + WS_CTL, 0, CTL_BYTES + al256(2 * 5 * 6144 * 4), stream);
    for (int l = 0; l < 2; ++l) (void)hipMemsetAsync(ws + WS_WL + (size_t)l * SZ_WL + SZ_WINR + (size_t)1152 * 1024 * 2, 0, (size_t)128 * 1024 * 2, stream);
    Args a{};
    for (int i = 0; i < 51; ++i) a.in[i] = in[i];
    a.out = (float*)d_out; a.ws = ws;
    int nlaunch = 0;
    auto run1 = [&](int lo, int hi) { a.ph_lo = lo; a.ph_hi = hi; a.bar_region = nlaunch < 5 ? nlaunch : 5; nlaunch++; hipLaunchKernelGGL(mk_fwd, dim3(grid), dim3(512), LDS_BYTES, stream, a); };
    auto run = [&](int lo, int hi) {
#if defined(SPLIT) && SPLIT
        for (int k = lo; k < hi; ++k) { const int q = (k - 1) % NPH_LAYER, l = (k - 1) / NPH_LAYER; if (k > 0 && (q > 14 || (l == 0 && q > 11) || (l == 1 && q == 0))) continue; run1(k, k + 1); }
#else
        run1(lo, hi);
#endif
    };
    run(0, 1 + 2 * NPH_LAYER);
}
```

```cpp
#include <hip/hip_runtime.h>
#include <stdint.h>
#include <math.h>

#define LAS __attribute__((address_space(3)))
typedef unsigned short bf16_t;
typedef short bf16x8 __attribute__((ext_vector_type(8)));
typedef float f32x4 __attribute__((ext_vector_type(4)));
typedef float f32x2 __attribute__((ext_vector_type(2)));
typedef unsigned u32x4 __attribute__((ext_vector_type(4)));
typedef unsigned u32x2 __attribute__((ext_vector_type(2)));

namespace {
constexpr int D = 1024, NB = 4, SEQ = 4096, CTXL = 256;
constexpr int RL = NB * SEQ, RC = NB * CTXL, RT = RL + RC;
constexpr int IN_COLS = 7040;
constexpr int FF_DENSE = 2816, NE = 8, FF_E = 3584;
constexpr float ALPHA = 1.41421356237309515f;
constexpr int LDP = 1792, PC_AG = 0, PC_AC = 384, PC_D = 768, PC_Q = 1024, PC_K = 1408, PC_G = 1792;
constexpr int NPT = 1280, PT_V = 768;
constexpr int YW = 1280, YC_A = 0, YC_B = 384, YC_C = 640, YC_D = 1024;
constexpr int MOE_P0 = 64, MOE_HCAP = 72;
constexpr int MOE_ROWS_MAX = 2 * RL + NE * 256;

constexpr size_t al256(size_t x) { return (x + 255) & ~(size_t)255; }
constexpr size_t WS_CTL = 0, CTL_BYTES = 131072;
constexpr int CW_BAR = 0;
constexpr int CW_MOECNT = 24576;
constexpr int CW_QUEUE = 28672;
constexpr int CW_HYN = 29696;
constexpr size_t WS_MOD = WS_CTL + CTL_BYTES;
constexpr size_t WS_HYN = WS_MOD + al256(2 * 5 * 6144 * 4);
constexpr size_t WS_S5AB = WS_HYN + 4096;
constexpr size_t WS_S5BB = WS_S5AB + 16384;
constexpr size_t WS_AB16 = WS_S5BB + 262144;
constexpr size_t WS_TILEE = WS_AB16 + 32768;
constexpr size_t WS_TOK = WS_TILEE + 1024;
constexpr size_t WS_SLOTW = WS_TOK + (size_t)RL * 32;
constexpr size_t WS_KFL = al256(WS_SLOTW + (size_t)MOE_ROWS_MAX * 4);
constexpr size_t WS_KFC = WS_KFL + (size_t)2 * 1024 * SEQ * 2;
constexpr size_t WS_XSC = WS_KFC + (size_t)1024 * CTXL * 2;
constexpr size_t WS_UB = WS_XSC + (size_t)RC * D * 4;
constexpr size_t SZ_WINR = (size_t)(1792 + 4096) * 1024 * 2, SZ_WINHY = (size_t)NPT * 1024 * 2, SZ_WBR = (size_t)1024 * 1280 * 2, SZ_WOUT = (size_t)1024 * 1024 * 2;
constexpr size_t SZ_WL = SZ_WINR + SZ_WINHY + SZ_WBR + SZ_WOUT;
constexpr size_t WS_WL = WS_UB + (size_t)RT * D * 2;
constexpr size_t WS_FFGU = WS_WL + 2 * SZ_WL;
constexpr size_t WS_FFD = WS_FFGU + (size_t)2 * FF_DENSE * 1024 * 2;
constexpr size_t WS_WGLU = WS_FFD + (size_t)1024 * FF_DENSE * 2;
constexpr size_t WS_OPS = WS_WGLU + (size_t)2 * 256 * 256 * 2;
constexpr size_t WS_OPY = WS_OPS + (size_t)32 * 256 * 256 * 2;
constexpr size_t WS_LW = WS_OPY + (size_t)32 * 256 * 512 * 2;
constexpr size_t WS_PR = WS_LW + (size_t)48 * 4096 * 2;
constexpr size_t WS_PT = WS_PR + (size_t)RT * 5888 * 2;
constexpr size_t WS_GQ = WS_PR + (size_t)RT * LDP * 2;
constexpr size_t WS_YB = WS_PT + (size_t)NPT * RT * 2;
constexpr size_t WS_PRE = WS_YB + (size_t)RT * YW * 2;
constexpr size_t WS_EXTRA = WS_PRE + (size_t)RT * D * 4;
constexpr size_t SZ_EXTRA = (size_t)2 * RT * 384 * 4 + (size_t)RT * 256 * 4;
constexpr size_t WS_END = WS_EXTRA + SZ_EXTRA;
constexpr int NCHK = RT / 16, NCHKP = 1280;
constexpr size_t WS_US = WS_PRE;
constexpr size_t WS_S5S = WS_US + (size_t)16 * NCHKP * 512 * 2;
constexpr size_t WS_GL = WS_S5S + (size_t)16 * NCHKP * 256 * 4;
static_assert(WS_GL + (size_t)RT * 256 * 2 <= WS_EXTRA, "s5 overlay");
constexpr size_t WS_H = WS_PR;
constexpr size_t WS_MOEGU = WS_PR;
constexpr size_t WS_MOED = WS_MOEGU + (size_t)NE * 2 * FF_E * 1024 * 2;
constexpr size_t WS_HM = WS_MOED + (size_t)NE * 1024 * FF_E * 2;
constexpr size_t WS_LT = WS_EXTRA;
constexpr size_t WS_LAGG = WS_LT + (size_t)RT * 3 * 384 * 2;
constexpr size_t WS_LHIN = WS_LAGG + (size_t)NCHK * 2 * 384 * 8;
constexpr size_t WS_YT = WS_LHIN + (size_t)NCHK * 2 * 384 * 4;
static_assert(WS_YT + (size_t)256 * RT * 2 <= WS_EXTRA + SZ_EXTRA, "lru / hyena overlay");
constexpr size_t WS_MGC = WS_EXTRA + (size_t)4 * RC * D * 4;
constexpr size_t WS_AG = WS_EXTRA;
static_assert(WS_HM + (size_t)MOE_HCAP * 256 * FF_E * 2 <= WS_EXTRA, "moe hidden overlay");
constexpr size_t WS_O2X = WS_PRE + ((size_t)32 << 20);
static_assert(WS_HM + (size_t)MOE_HCAP * 256 * FF_E * 2 <= WS_O2X && WS_O2X + (size_t)4 * 2048 * D * 4 <= WS_EXTRA, "moe excess sums");
static_assert((size_t)MOE_ROWS_MAX * 1024 * 2 <= SZ_EXTRA, "moe gather overlay");
static_assert((size_t)RT * FF_DENSE * 2 <= (size_t)RT * 5888 * 2 && WS_GQ + (size_t)RT * 4096 <= WS_PT, "dense hidden overlay / gate bytes");

__device__ __forceinline__ float sigm(float x) { return __builtin_amdgcn_rcpf(1.f + __builtin_amdgcn_exp2f(-1.44269504089f * x)); }
__device__ __forceinline__ float sigm_acc(float x) { return 1.f / (1.f + expf(-x)); }
__device__ __forceinline__ float silu_acc(float x) { return x / (1.f + expf(-x)); }
__device__ __forceinline__ float gelu_t(float x) { return 0.5f * x * (1.f + tanhf(0.7978845608028654f * (x + 0.044715f * x * x * x))); }
__device__ __forceinline__ float gelu_f(float x) { return x * sigm(1.5957691216057308f * (x + 0.044715f * x * x * x)); }
__device__ __forceinline__ float softplus(float x) { return fmaxf(x, 0.f) + log1pf(expf(-fabsf(x))); }
__device__ __forceinline__ float wave_sum(float v) { for (int o = 32; o; o >>= 1) v += __shfl_xor(v, o); return v; }
__device__ __forceinline__ float wave_max(float v) { for (int o = 32; o; o >>= 1) v = fmaxf(v, __shfl_xor(v, o)); return v; }
__device__ __forceinline__ float bf2f(bf16_t b) { return __uint_as_float(((unsigned)b) << 16); }
__device__ __forceinline__ bf16_t f2bf(float f) { unsigned u = __float_as_uint(f); u += 0x7FFFu + ((u >> 16) & 1u); return (bf16_t)(u >> 16); }
__device__ __forceinline__ unsigned cvt_pk_bf16(float lo, float hi) { unsigned r; asm volatile("v_cvt_pk_bf16_f32 %0, %1, %2" : "=v"(r) : "v"(lo), "v"(hi)); return r; }
__device__ __forceinline__ float bflo(unsigned w) { return __uint_as_float(w << 16); }
__device__ __forceinline__ float bfhi(unsigned w) { return __uint_as_float(w & 0xFFFF0000u); }
__device__ __forceinline__ void row_seq(int r, int& start, int& len, int& pos, int& b) {
    if (r < RL) { b = r >> 12; start = b << 12; len = SEQ; pos = r & 4095; }
    else { const int q = r - RL; b = q >> 8; start = RL + (b << 8); len = CTXL; pos = q & 255; }
}

#define XB_TMO      128
#define XB_XCNT(j)  (256  + 64 * (j))
#define XB_XSUB(j)  (1280 + 64 * (j))
#define XB_XGEN(j)  (2304 + 64 * (j))
#define XB_TOP      3328
#define XB_TOPGEN   3392
#define XCD_BAR_WORDS 3456
#define XB_SPIN_CAP (1u << 18)
__device__ __forceinline__ unsigned xb_ld(unsigned* p)              { return __hip_atomic_load(p, __ATOMIC_RELAXED, __HIP_MEMORY_SCOPE_AGENT); }
__device__ __forceinline__ unsigned xb_add(unsigned* p, unsigned v) { return __hip_atomic_fetch_add(p, v, __ATOMIC_RELAXED, __HIP_MEMORY_SCOPE_AGENT); }
__device__ __forceinline__ unsigned xb_xcc_id() { return (unsigned)__builtin_amdgcn_s_getreg((3 << 11) | 20) & 0xFu; }
#define XB_SPIN(cond, bar) do { unsigned _sp = 0; while (cond) { __builtin_amdgcn_s_sleep(1); \
    if ((++_sp & 255u) == 0u) { if (xb_ld(&(bar)[XB_TMO])) break; if (_sp > XB_SPIN_CAP) { atomicAdd(&(bar)[XB_TMO], 1u); break; } } } } while (0)
struct XcdBarrier { unsigned* bar; unsigned x; volatile LAS unsigned* st; };
__device__ __forceinline__ XcdBarrier xcd_barrier_post(unsigned* bar, volatile LAS unsigned* st) {
    XcdBarrier b; b.bar = bar; b.x = xb_xcc_id(); b.st = st;
    if (threadIdx.x == 0) (void)xb_add(&bar[XB_XCNT(b.x)], 1u);
    return b;
}
__device__ __forceinline__ void xcd_barrier_complete(unsigned* bar, unsigned x, unsigned& nloc, unsigned& nx) {
    const unsigned G = gridDim.x * gridDim.y * gridDim.z;
    unsigned sum, cnt, mine, sp = 0u;
    for (;;) {
        sum = 0u; cnt = 0u; mine = 0u;
#pragma unroll
        for (unsigned j = 0; j < 16; ++j) { const unsigned c = xb_ld(&bar[XB_XCNT(j)]); sum += c; cnt += (c > 0u) ? 1u : 0u; mine = (j == x) ? c : mine; }
        if (sum == G) break;
        __builtin_amdgcn_s_sleep(1);
        if ((++sp & 255u) == 0u) { if (xb_ld(&bar[XB_TMO])) break; if (sp > XB_SPIN_CAP) { atomicAdd(&bar[XB_TMO], 1u); break; } }
    }
    nloc = mine > 0u ? mine : 1u; nx = cnt > 0u ? cnt : 1u;
}
__device__ __forceinline__ void xcd_barrier(const XcdBarrier& b) {
    asm volatile("s_waitcnt vmcnt(0)" ::: "memory");
    __syncthreads();
    if (threadIdx.x == 0) {
        unsigned* bar = b.bar;
        __builtin_amdgcn_s_waitcnt(0);
        unsigned nloc = b.st[0], nx = b.st[1];
        if (nloc == 0u) { xcd_barrier_complete(bar, b.x, nloc, nx); b.st[0] = nloc; b.st[1] = nx; }
        const unsigned old = xb_add(&bar[XB_XSUB(b.x)], 1u);
        const unsigned gen = old / nloc;
        if (old + 1u == (gen + 1u) * nloc) {
            __builtin_amdgcn_fence(__ATOMIC_RELEASE, "agent");
            asm volatile("s_waitcnt vmcnt(0)" ::: "memory");
            const unsigned og = xb_add(&bar[XB_TOP], 1u);
            const unsigned tg = og / nx;
            if (og + 1u == (tg + 1u) * nx) xb_add(&bar[XB_TOPGEN], 1u);
            else XB_SPIN(xb_ld(&bar[XB_TOPGEN]) == tg, bar);
            __builtin_amdgcn_fence(__ATOMIC_ACQUIRE, "agent");
            xb_add(&bar[XB_XGEN(b.x)], 1u);
            asm volatile("s_waitcnt vmcnt(0)" ::: "memory");
        } else {
            XB_SPIN(xb_ld(&bar[XB_XGEN(b.x)]) == gen, bar);
            __builtin_amdgcn_fence(__ATOMIC_ACQUIRE, "agent");
            asm volatile("s_waitcnt vmcnt(0)" ::: "memory");
        }
    }
    __syncthreads();
}

namespace pg8 {
constexpr int BM = 256, BK = 64, HALF = 128, HTB = HALF * BK * 2, STAGE_BYTES = 8 * HTB, NXCD = 8, WGM = 8;
__host__ __device__ __forceinline__ int lds_byte(int r, int c) { const int st = (r >> 4) * 2 + (c >> 5), rr = r & 15, cc = c & 31, ob = rr * 64 + cc * 2; return st * 1024 + (ob ^ (((ob >> 9) & 1) << 5)); }
__host__ __device__ __forceinline__ void stage_rc(int b, int& R, int& C) { const int st = b / 1024, sb = b % 1024, swz = sb ^ (((sb >> 9) & 1) << 5); R = (st >> 1) * 16 + swz / 64; C = (st & 1) * 32 + (swz % 64) / 2; }
__host__ __device__ __forceinline__ int perm32(int rho) { const int n = rho >> 4, i = rho & 15; return 8 * (i >> 2) + 4 * n + (i & 3); }

struct Unit { const char* a; const char* b; int nt; int pm, pn, kind; };

__device__ __forceinline__ void rect_map(int wgid, int nM, int nN, int& pm, int& pn) {
    const int nwg = nM * nN;
    { const int q = nwg / NXCD, r = nwg % NXCD, xcd = wgid % NXCD, off = wgid / NXCD; wgid = (xcd < r ? xcd * (q + 1) : r * (q + 1) + (xcd - r) * q) + off; }
    const int nig = WGM * nN, gid = wgid / nig, fm = gid * WGM, gsz = (nM - fm) < WGM ? (nM - fm) : WGM;
    pm = fm + ((wgid % nig) % gsz); pn = (wgid % nig) / gsz;
}

template <int lda, int ldb, class Epi, class Sched>
__device__ __forceinline__ void gemm_phase(LAS unsigned char* lds, const Sched& S, const Epi& E) {
    int tid_ = threadIdx.x; asm volatile("" : "+v"(tid_));
    const int tid = tid_, wid = __builtin_amdgcn_readfirstlane(tid >> 6), lane = tid & 63, wr = wid >> 2, wc = wid & 3, fr = lane & 15, fq = lane >> 4;
    unsigned voffA[2], voffB[2];
#pragma unroll
    for (int i = 0; i < 2; ++i) { int R, C; stage_rc(tid * 16 + i * 8192, R, C); const int Rb = (R & ~31) + perm32(R & 31);
        voffA[i] = (unsigned)(R * lda + C) * 2u; voffB[i] = (unsigned)(Rb * ldb + C) * 2u; }
    const size_t kstep = (size_t)(BK * 2);
    const size_t hstepA = (size_t)HALF * lda * 2, hstepB = (size_t)HALF * ldb * 2;
    const unsigned ldsw = (unsigned)wid * 1024u;
    const int aoff = lds_byte(wr * 64 + fr, fq * 8), boff = lds_byte(wc * 32 + fr, fq * 8);
#define PG8_SA(b, h) (((b) * 2 + (h)) * HTB)
#define PG8_SB(b, h) ((4 + (b) * 2 + (h)) * HTB)
#define PG8_STAGE(bufoff, gbase, voff) do { _Pragma("unroll") for (int _i = 0; _i < 2; ++_i) \
        __builtin_amdgcn_global_load_lds((const unsigned*)((const char*)(gbase) + (voff)[_i]), (LAS unsigned*)(lds + (bufoff) + ldsw + _i * 8192), 16, 0, 0); } while (0)
#define PG8_LDA(dst, b, h) do { _Pragma("unroll") for (int m = 0; m < 4; ++m) _Pragma("unroll") for (int k = 0; k < 2; ++k) dst[m][k] = *(const LAS bf16x8*)(lds + PG8_SA(b, h) + aoff + m * 2048 + k * 1024); } while (0)
#define PG8_LDB(dst, b, h) do { _Pragma("unroll") for (int n = 0; n < 2; ++n) _Pragma("unroll") for (int k = 0; k < 2; ++k) dst[n][k] = *(const LAS bf16x8*)(lds + PG8_SB(b, h) + boff + n * 2048 + k * 1024); } while (0)
#define PG8_MMA(ai, bj, At, Bt) do { __builtin_amdgcn_s_setprio(1); _Pragma("unroll") for (int m = 0; m < 4; ++m) _Pragma("unroll") for (int n = 0; n < 2; ++n) _Pragma("unroll") for (int k = 0; k < 2; ++k) \
        acc[ai][bj][m][n] = __builtin_amdgcn_mfma_f32_16x16x32_bf16(Bt[n][k], At[m][k], acc[ai][bj][m][n], 0, 0, 0); __builtin_amdgcn_s_setprio(0); } while (0)
#define PG8_WAIT_V(n) asm volatile("s_waitcnt vmcnt(" #n ")" ::: "memory")
#define PG8_WAIT_L(n) asm volatile("s_waitcnt lgkmcnt(" #n ")" ::: "memory")
#define PG8_BAR __builtin_amdgcn_s_barrier()
#define PG8_SCHED __builtin_amdgcn_sched_barrier(0)
    Unit cur, nxt; int ui = 0;
    if (!S.next(0, cur)) return;
    f32x4 acc[2][2][4][2];
#pragma unroll
    for (int a = 0; a < 2; ++a)
#pragma unroll
        for (int b = 0; b < 2; ++b)
#pragma unroll
            for (int m = 0; m < 4; ++m)
#pragma unroll
                for (int n = 0; n < 2; ++n) acc[a][b][m][n] = (f32x4){0.f, 0.f, 0.f, 0.f};
    bf16x8 At[4][2], B0[2][2], B1[2][2];
    const char* cA = cur.a; const char* cB = cur.b;
    PG8_STAGE(PG8_SB(0, 0), cB, voffB); PG8_STAGE(PG8_SA(0, 0), cA, voffA); PG8_STAGE(PG8_SB(0, 1), cB + hstepB, voffB); PG8_STAGE(PG8_SA(0, 1), cA + hstepA, voffA);
    if (wr == 1) PG8_BAR;
    PG8_WAIT_V(4); PG8_BAR;
    PG8_STAGE(PG8_SB(1, 0), cB + kstep, voffB); PG8_STAGE(PG8_SA(1, 0), cA + kstep, voffA); PG8_STAGE(PG8_SB(1, 1), cB + hstepB + kstep, voffB);
    PG8_WAIT_V(6); PG8_BAR;
    for (;;) {
        const bool has_next = S.next(ui + 1, nxt);
        const char* nA = has_next ? nxt.a : cA; const char* nB = has_next ? nxt.b : cB;
        const int nt = cur.nt;
        for (int t = 0; t < nt; t += 2) {
            const bool last = (t == nt - 2);
            const char* a1 = cA + (size_t)(t + 1) * kstep;
            const char* a2 = last ? nA : cA + (size_t)(t + 2) * kstep; const char* b2 = last ? nB : cB + (size_t)(t + 2) * kstep;
            const char* a3 = a2 + kstep; const char* b3 = b2 + kstep;
            PG8_LDB(B0, 0, 0); PG8_SCHED; PG8_LDA(At, 0, 0); PG8_STAGE(PG8_SA(1, 1), a1 + hstepA, voffA);
            PG8_WAIT_L(8); PG8_BAR; PG8_WAIT_L(0); PG8_MMA(0, 0, At, B0); PG8_BAR; PG8_SCHED;
            PG8_LDB(B1, 0, 1); PG8_STAGE(PG8_SB(0, 0), b2, voffB);
            PG8_BAR; PG8_WAIT_L(0); PG8_MMA(0, 1, At, B1); PG8_BAR;
            PG8_LDA(At, 0, 1); PG8_STAGE(PG8_SA(0, 0), a2, voffA);
            PG8_BAR; PG8_WAIT_L(0); PG8_MMA(1, 0, At, B0); PG8_BAR; PG8_SCHED;
            PG8_STAGE(PG8_SB(0, 1), b2 + hstepB, voffB);
            PG8_WAIT_V(6); PG8_BAR; PG8_MMA(1, 1, At, B1); PG8_BAR;
            PG8_LDB(B0, 1, 0); PG8_SCHED; PG8_LDA(At, 1, 0); PG8_STAGE(PG8_SA(0, 1), a2 + hstepA, voffA);
            PG8_WAIT_L(8); PG8_BAR; PG8_WAIT_L(0); PG8_MMA(0, 0, At, B0); PG8_BAR; PG8_SCHED;
            PG8_LDB(B1, 1, 1); PG8_STAGE(PG8_SB(1, 0), b3, voffB);
            PG8_BAR; PG8_WAIT_L(0); PG8_MMA(0, 1, At, B1); PG8_BAR;
            PG8_LDA(At, 1, 1); PG8_STAGE(PG8_SA(1, 0), a3, voffA);
            PG8_BAR; PG8_WAIT_L(0); PG8_MMA(1, 0, At, B0); PG8_BAR; PG8_SCHED;
            PG8_STAGE(PG8_SB(1, 1), b3 + hstepB, voffB);
            PG8_WAIT_V(6); PG8_BAR; PG8_MMA(1, 1, At, B1); PG8_BAR;
        }
        E(acc, cur, wr, wc, fr, fq);
        if (!has_next) break;
#pragma unroll
        for (int a = 0; a < 2; ++a)
#pragma unroll
            for (int b = 0; b < 2; ++b)
#pragma unroll
                for (int m = 0; m < 4; ++m)
#pragma unroll
                    for (int n = 0; n < 2; ++n) acc[a][b][m][n] = (f32x4){0.f, 0.f, 0.f, 0.f};
        cur = nxt; cA = nA; cB = nB; ++ui;
    }
    PG8_WAIT_V(0);
    if (wr == 0) PG8_BAR;
    PG8_BAR;
#undef PG8_SA
#undef PG8_SB
#undef PG8_STAGE
#undef PG8_LDA
#undef PG8_LDB
#undef PG8_MMA
#undef PG8_WAIT_V
#undef PG8_WAIT_L
#undef PG8_BAR
#undef PG8_SCHED
}

struct PartC { long long aOff, bOff; unsigned aStep, bStep; int nM, nN, nt, kind, start, nGrp; unsigned aGrp, bGrp; };
struct TabSched {
    const PartC* parts; const char* ws; int np, total, G, c;
    __device__ __forceinline__ bool next(int i, Unit& u) const {
        const int L = i * G + c; if (L >= total) return false;
        int q = 0;
#pragma unroll
        for (int k = 1; k < 4; ++k) if (k < np && L >= parts[k].start) q = k;
        const PartC P = parts[q];
        const int per = P.nM * P.nN, idx = L - P.start, grp = idx / per;
        int pm, pn; rect_map(idx - grp * per, P.nM, P.nN, pm, pn);
        u.a = ws + P.aOff + (size_t)grp * P.aGrp + (size_t)pm * P.aStep; u.b = ws + P.bOff + (size_t)grp * P.bGrp + (size_t)pn * P.bStep; u.nt = P.nt; u.pm = pm; u.pn = pn; u.kind = P.kind + grp; return true;
    }
};
struct MergeSched {
    const char* ws; long long aOff, bOff; int nM, G, c;
    int nCtx;
    __device__ __forceinline__ bool next(int i, Unit& u) const {
        int T = (i >> 2) * G + c, br = i & 3; bool ctxu = false;
        if (T >= nM * 4) {
            const int j = (i - 4 * ((nM * 4 - c + G - 1) / G)) * G + c;
            if (j < 0 || j >= nCtx) return false;
            T = nM * 4 + (j >> 2); br = j & 3; ctxu = true;
        }
        int pm, pn;
        if (!ctxu) rect_map(T, nM, 4, pm, pn); else { const int t = T - nM * 4; pm = nM + (t >> 2); pn = t & 3; }
        const int ko = br == 0 ? 0 : (br == 1 ? 384 : (br == 2 ? 640 : 1024));
        u.a = ws + aOff + (size_t)pm * (256u * 1280u * 2u) + ko * 2; u.b = ws + bOff + (size_t)pn * (256u * 1280u * 2u) + ko * 2; u.nt = (br & 1) ? 4 : 6; u.pm = pm; u.pn = pn; u.kind = ctxu ? 4 + br : br; return true;
    }
};
struct MoeSched {
    const char* A; const char* B; const int* tile_e; unsigned aStep, bStep; size_t bExp; int nN, nt, tile0, ntile, G, c;
    __device__ __forceinline__ bool next(int i, Unit& u) const {
        const int L = i * G + c; if (L >= ntile * nN) return false;
        const int mt = tile0 + L / nN, pn = L % nN;
        const int e = __builtin_amdgcn_readfirstlane(__hip_atomic_load(tile_e + mt, __ATOMIC_RELAXED, __HIP_MEMORY_SCOPE_AGENT));
        u.a = A + (size_t)(mt - tile0) * aStep; u.b = B + (size_t)e * bExp + (size_t)pn * bStep; u.nt = nt; u.pm = mt; u.pn = pn; u.kind = e; return true;
    }
};

struct MoeTailSched {
    const char* A; const char* B; const int* tile_e; int tile0, nfull, nex, G, c;
    __device__ __forceinline__ bool next(int i, Unit& u) const {
        const int L = i * G + c; int mt, pn, nt = 56, flag = 0; size_t koff = 0;
        if (L < nfull * 4) { mt = tile0 + (L >> 2); pn = L & 3; }
        else { const int idx = L - nfull * 4; if (idx >= nex * 16) return false; const int sp = idx & 3, tu = idx >> 2; mt = 128 + (tu >> 2); pn = tu & 3; nt = 14; koff = (size_t)sp * 14 * 128; flag = 8 + 16 * sp; }
        const int e = __builtin_amdgcn_readfirstlane(__hip_atomic_load(tile_e + mt, __ATOMIC_RELAXED, __HIP_MEMORY_SCOPE_AGENT));
        u.a = A + (size_t)(mt - tile0) * (256u * (unsigned)FF_E * 2u) + koff; u.b = B + (size_t)e * ((size_t)1024 * FF_E * 2) + (size_t)pn * (256u * (unsigned)FF_E * 2u) + koff;
        u.nt = nt; u.pm = mt; u.pn = pn; u.kind = e | flag; return true;
    }
};

#define EPI_ROWS(u) const int row0 = (u).pm * BM + wr * 64 + fr, colt = wc * 32 + 8 * fq
struct EpiProj {
    bf16_t* PRp; bf16_t* PTp; bf16_t* USp; int sig_from; unsigned char* GQp;
    __device__ __forceinline__ void operator()(const f32x4 (&acc)[2][2][4][2], const Unit& u, int wr, int wc, int fr, int fq) const {
        EPI_ROWS(u);
        bf16_t* base = u.kind == 1 ? PTp : PRp; const int ldc = u.kind == 1 ? RT : LDP; const bool sg = (u.kind == 0 && u.pn >= sig_from);
        if (sg) {
#pragma unroll
            for (int ai = 0; ai < 2; ++ai)
#pragma unroll
                for (int m = 0; m < 4; ++m) { unsigned char* rowp = GQp + (size_t)(row0 + ai * HALF + m * 16) * 4096 + (u.pn - sig_from) * BM + colt;
#pragma unroll
                    for (int bj = 0; bj < 2; ++bj) { const f32x4 v0 = acc[ai][bj][m][0], v1 = acc[ai][bj][m][1];
                        unsigned lo = 0u, hi = 0u;
                        lo = __builtin_amdgcn_cvt_pk_u8_f32(sigm(v0[0]) * 255.0f, 0, lo); lo = __builtin_amdgcn_cvt_pk_u8_f32(sigm(v0[1]) * 255.0f, 1, lo); lo = __builtin_amdgcn_cvt_pk_u8_f32(sigm(v0[2]) * 255.0f, 2, lo); lo = __builtin_amdgcn_cvt_pk_u8_f32(sigm(v0[3]) * 255.0f, 3, lo);
                        hi = __builtin_amdgcn_cvt_pk_u8_f32(sigm(v1[0]) * 255.0f, 0, hi); hi = __builtin_amdgcn_cvt_pk_u8_f32(sigm(v1[1]) * 255.0f, 1, hi); hi = __builtin_amdgcn_cvt_pk_u8_f32(sigm(v1[2]) * 255.0f, 2, hi); hi = __builtin_amdgcn_cvt_pk_u8_f32(sigm(v1[3]) * 255.0f, 3, hi);
                        *(u32x2*)(rowp + bj * HALF) = (u32x2){lo, hi}; } }
            return;
        }
#pragma unroll
        for (int ai = 0; ai < 2; ++ai)
#pragma unroll
            for (int m = 0; m < 4; ++m) { bf16_t* rowp = base + (size_t)(row0 + ai * HALF + m * 16) * ldc + u.pn * BM + colt;
#pragma unroll
                for (int bj = 0; bj < 2; ++bj) { f32x4 v0 = acc[ai][bj][m][0], v1 = acc[ai][bj][m][1];
                    if (sg) {
#pragma unroll
                        for (int j = 0; j < 4; ++j) { v0[j] = sigm(v0[j]); v1[j] = sigm(v1[j]); } }
                    u32x4 w; w.x = cvt_pk_bf16(v0[0], v0[1]); w.y = cvt_pk_bf16(v0[2], v0[3]); w.z = cvt_pk_bf16(v1[0], v1[1]); w.w = cvt_pk_bf16(v1[2], v1[3]);
                    *(u32x4*)(rowp + bj * HALF) = w;
                    if (u.kind == 0 && u.pn == 3) { const int r = row0 + ai * HALF + m * 16, cc = colt + bj * HALF;
                        *(u32x4*)(USp + ((size_t)(cc >> 4) * NCHKP + (r >> 4)) * 512 + (r & 15) * 16 + (cc & 15)) = w; } } }
    }
};
struct EpiS5State {
    float* Sp;
    __device__ __forceinline__ void operator()(const f32x4 (&acc)[2][2][4][2], const Unit& u, int wr, int wc, int fr, int fq) const {
        EPI_ROWS(u);
#pragma unroll
        for (int ai = 0; ai < 2; ++ai)
#pragma unroll
            for (int m = 0; m < 4; ++m) { float* op = Sp + ((size_t)u.kind * NCHKP + row0 + ai * HALF + m * 16) * 256 + colt;
#pragma unroll
                for (int bj = 0; bj < 2; ++bj)
#pragma unroll
                    for (int n = 0; n < 2; ++n) *(f32x4*)(op + bj * HALF + 4 * n) = acc[ai][bj][m][n]; }
    }
};
struct EpiS5Main {
    bf16_t* GLp; const bf16_t* PRp; const float* dvec;
    __device__ __forceinline__ void operator()(const f32x4 (&acc)[2][2][4][2], const Unit& u, int wr, int wc, int fr, int fq) const {
        EPI_ROWS(u);
        const int cl = 16 * u.kind + (colt & 15);
        const f32x4 d0 = *(const f32x4*)(dvec + cl), d1 = *(const f32x4*)(dvec + cl + 4);
#pragma unroll
        for (int ai = 0; ai < 2; ++ai) {
            u32x4 uq[4][2];
#pragma unroll
            for (int m = 0; m < 4; ++m) { const int n = row0 + ai * HALF + m * 16;
#pragma unroll
                for (int bj = 0; bj < 2; ++bj) { const int c = colt + bj * HALF, r = 16 * (n < NCHK ? n : 0) + (c >> 4); uq[m][bj] = *(const u32x4*)(PRp + (size_t)r * LDP + PC_D + cl); } }
#pragma unroll
            for (int m = 0; m < 4; ++m) { const int n = row0 + ai * HALF + m * 16; if (n >= NCHK) continue;
#pragma unroll
                for (int bj = 0; bj < 2; ++bj) { const int c = colt + bj * HALF, r = 16 * n + (c >> 4); const u32x4 uv = uq[m][bj];
                    const f32x4 v0 = acc[ai][bj][m][0], v1 = acc[ai][bj][m][1];
                    u32x4 w; w.x = cvt_pk_bf16(gelu_f(v0[0] + d0[0] * bflo(uv.x)), gelu_f(v0[1] + d0[1] * bfhi(uv.x))); w.y = cvt_pk_bf16(gelu_f(v0[2] + d0[2] * bflo(uv.y)), gelu_f(v0[3] + d0[3] * bfhi(uv.y)));
                    w.z = cvt_pk_bf16(gelu_f(v1[0] + d1[0] * bflo(uv.z)), gelu_f(v1[1] + d1[1] * bfhi(uv.z))); w.w = cvt_pk_bf16(gelu_f(v1[2] + d1[2] * bflo(uv.w)), gelu_f(v1[3] + d1[3] * bfhi(uv.w)));
                    *(u32x4*)(GLp + (size_t)r * 256 + cl) = w; } }
        }
    }
};
struct EpiS5Glu {
    bf16_t* YBp; const bf16_t* GLp; const float* bvec;
    __device__ __forceinline__ void operator()(const f32x4 (&acc)[2][2][4][2], const Unit& u, int wr, int wc, int fr, int fq) const {
        EPI_ROWS(u);
        f32x4 bq[2][2];
#pragma unroll
        for (int bj = 0; bj < 2; ++bj) { bq[bj][0] = *(const f32x4*)(bvec + colt + bj * HALF); bq[bj][1] = *(const f32x4*)(bvec + colt + bj * HALF + 4); }
#pragma unroll
        for (int ai = 0; ai < 2; ++ai) {
            u32x4 gq[4][2];
#pragma unroll
            for (int m = 0; m < 4; ++m)
#pragma unroll
                for (int bj = 0; bj < 2; ++bj) gq[m][bj] = *(const u32x4*)(GLp + (size_t)(row0 + ai * HALF + m * 16) * 256 + colt + bj * HALF);
#pragma unroll
            for (int m = 0; m < 4; ++m) { const int r = row0 + ai * HALF + m * 16;
#pragma unroll
                for (int bj = 0; bj < 2; ++bj) { const int c = colt + bj * HALF; const u32x4 gv = gq[m][bj];
                    const f32x4 v0 = acc[ai][bj][m][0] + bq[bj][0], v1 = acc[ai][bj][m][1] + bq[bj][1];
                    u32x4 w; w.x = cvt_pk_bf16(bflo(gv.x) * sigm(v0[0]), bfhi(gv.x) * sigm(v0[1])); w.y = cvt_pk_bf16(bflo(gv.y) * sigm(v0[2]), bfhi(gv.y) * sigm(v0[3]));
                    w.z = cvt_pk_bf16(bflo(gv.z) * sigm(v1[0]), bfhi(gv.z) * sigm(v1[1])); w.w = cvt_pk_bf16(bflo(gv.w) * sigm(v1[2]), bfhi(gv.w) * sigm(v1[3]));
                    *(u32x4*)(YBp + (size_t)r * YW + YC_D + c) = w; } }
        }
    }
};
struct EpiGate {
    const unsigned char* GQp; bf16_t* MGp; bf16_t* MGCp;
    __device__ __forceinline__ void operator()(const f32x4 (&acc)[2][2][4][2], const Unit& u, int wr, int wc, int fr, int fq) const {
        EPI_ROWS(u);
        const int br = u.kind & 3; const bool acc_prev = (u.kind >= 1 && u.kind <= 3);
        bf16_t* OB = u.kind >= 4 ? MGCp + (size_t)br * RC * D - (size_t)RL * D : MGp;
#pragma unroll
        for (int ai = 0; ai < 2; ++ai) {
            u32x2 g[4][2]; u32x4 p[4][2];
#pragma unroll
            for (int m = 0; m < 4; ++m)
#pragma unroll
                for (int bj = 0; bj < 2; ++bj) { const int r = row0 + ai * HALF + m * 16;
                    g[m][bj] = *(const u32x2*)(GQp + (size_t)r * 4096 + br * 1024 + u.pn * BM + colt + bj * HALF);
                    p[m][bj] = acc_prev ? *(const u32x4*)(MGp + (size_t)r * D + u.pn * BM + colt + bj * HALF) : (u32x4){0u, 0u, 0u, 0u}; }
#pragma unroll
            for (int m = 0; m < 4; ++m) { const int r = row0 + ai * HALF + m * 16; bf16_t* mp = OB + (size_t)r * D + u.pn * BM + colt;
#pragma unroll
                for (int bj = 0; bj < 2; ++bj) { const f32x4 v0 = acc[ai][bj][m][0] * (1.0f / 255.0f), v1 = acc[ai][bj][m][1] * (1.0f / 255.0f); const u32x2 gg = g[m][bj]; const u32x4 pp = p[m][bj];
                    const f32x4 o0 = {v0[0] * (float)(gg.x & 255u) + bflo(pp.x), v0[1] * (float)((gg.x >> 8) & 255u) + bfhi(pp.x), v0[2] * (float)((gg.x >> 16) & 255u) + bflo(pp.y), v0[3] * (float)(gg.x >> 24) + bfhi(pp.y)};
                    const f32x4 o1 = {v1[0] * (float)(gg.y & 255u) + bflo(pp.z), v1[1] * (float)((gg.y >> 8) & 255u) + bfhi(pp.z), v1[2] * (float)((gg.y >> 16) & 255u) + bflo(pp.w), v1[3] * (float)(gg.y >> 24) + bfhi(pp.w)};
                    u32x4 w; w.x = cvt_pk_bf16(o0[0], o0[1]); w.y = cvt_pk_bf16(o0[2], o0[3]); w.z = cvt_pk_bf16(o1[0], o1[1]); w.w = cvt_pk_bf16(o1[2], o1[3]);
                    *(u32x4*)(mp + bj * HALF) = w; } }
        }
    }
};
struct EpiRes {
    float* PREp; const float* xlat; const float* xctx; const float* gvec;
    float* partp;
    __device__ __forceinline__ void operator()(const f32x4 (&acc)[2][2][4][2], const Unit& u, int wr, int wc, int fr, int fq) const {
        EPI_ROWS(u);
        if (u.kind != 0) {
            f32x4 gc[2][2];
#pragma unroll
            for (int bj = 0; bj < 2; ++bj)
#pragma unroll
                for (int n = 0; n < 2; ++n) gc[bj][n] = *(const f32x4*)(gvec + (size_t)4 * 6144 + u.pn * BM + colt + bj * HALF + 4 * n);
#pragma unroll
            for (int ai = 0; ai < 2; ++ai)
#pragma unroll
                for (int m = 0; m < 4; ++m) { const int r = row0 + ai * HALF + m * 16; const int c0 = u.pn * BM + colt;
                    float* op = partp + ((size_t)(u.kind - 1) * RC + r) * D + c0;
#pragma unroll
                    for (int bj = 0; bj < 2; ++bj)
#pragma unroll
                        for (int n = 0; n < 2; ++n) *(f32x4*)(op + bj * HALF + 4 * n) = gc[bj][n] * acc[ai][bj][m][n]; }
            return;
        }
        const int c0 = u.pn * BM + colt, rt0 = u.pm * BM;
        const float* gp = gvec + (size_t)(rt0 < RL ? (rt0 >> 12) : 4) * 6144 + c0;
        f32x4 gq[2][2];
#pragma unroll
        for (int bj = 0; bj < 2; ++bj)
#pragma unroll
            for (int n = 0; n < 2; ++n) gq[bj][n] = *(const f32x4*)(gp + bj * HALF + 4 * n);
#pragma unroll
        for (int ai = 0; ai < 2; ++ai)
#pragma unroll
            for (int m = 0; m < 4; ++m) { bf16_t* op = (bf16_t*)PREp + (size_t)(row0 + ai * HALF + m * 16) * D + c0;
#pragma unroll
                for (int bj = 0; bj < 2; ++bj) { const f32x4 v0 = gq[bj][0] * acc[ai][bj][m][0], v1 = gq[bj][1] * acc[ai][bj][m][1];
                    u32x4 w; w.x = cvt_pk_bf16(v0[0], v0[1]); w.y = cvt_pk_bf16(v0[2], v0[3]); w.z = cvt_pk_bf16(v1[0], v1[1]); w.w = cvt_pk_bf16(v1[2], v1[3]);
                    *(u32x4*)(op + bj * HALF) = w; } }
    }
};
struct EpiSwiglu {
    bf16_t* Hp; int ldh; int row_sub;
    __device__ __forceinline__ void operator()(const f32x4 (&acc)[2][2][4][2], const Unit& u, int wr, int wc, int fr, int fq) const {
        const int row0 = (u.pm - row_sub) * BM + wr * 64 + fr, colt = wc * 32 + 8 * fq;
#pragma unroll
        for (int ai = 0; ai < 2; ++ai)
#pragma unroll
            for (int m = 0; m < 4; ++m) { bf16_t* rowp = Hp + (size_t)(row0 + ai * HALF + m * 16) * ldh + u.pn * HALF + colt;
                f32x4 h0, h1;
#pragma unroll
                for (int j = 0; j < 4; ++j) { const float g0 = acc[ai][0][m][0][j], g1 = acc[ai][0][m][1][j];
                    h0[j] = g0 * sigm(g0) * acc[ai][1][m][0][j]; h1[j] = g1 * sigm(g1) * acc[ai][1][m][1][j]; }
                u32x4 w; w.x = cvt_pk_bf16(h0[0], h0[1]); w.y = cvt_pk_bf16(h0[2], h0[3]); w.z = cvt_pk_bf16(h1[0], h1[1]); w.w = cvt_pk_bf16(h1[2], h1[3]);
                *(u32x4*)rowp = w; }
    }
};
struct EpiMoeDown {
    bf16_t* O2; const float* slotw; float* O2X;
    __device__ __forceinline__ void operator()(const f32x4 (&acc)[2][2][4][2], const Unit& u, int wr, int wc, int fr, int fq) const {
        EPI_ROWS(u);
        float wq[2][4];
        if (u.kind & 8) {
            const int sp = (u.kind >> 4) & 3;
#pragma unroll
            for (int ai = 0; ai < 2; ++ai)
#pragma unroll
                for (int m = 0; m < 4; ++m) { const int r = row0 + ai * HALF + m * 16; const float w8 = slotw[r]; float* op = O2X + ((size_t)sp * 2048 + (r - 128 * 256)) * D + u.pn * BM + colt;
#pragma unroll
                    for (int bj = 0; bj < 2; ++bj)
#pragma unroll
                        for (int n = 0; n < 2; ++n) *(f32x4*)(op + bj * HALF + 4 * n) = acc[ai][bj][m][n] * w8; }
            return;
        }
#pragma unroll
        for (int ai = 0; ai < 2; ++ai)
#pragma unroll
            for (int m = 0; m < 4; ++m) wq[ai][m] = slotw[row0 + ai * HALF + m * 16];
#pragma unroll
        for (int ai = 0; ai < 2; ++ai)
#pragma unroll
            for (int m = 0; m < 4; ++m) { const int r = row0 + ai * HALF + m * 16; const float w8 = wq[ai][m];
                bf16_t* rowp = O2 + (size_t)r * D + u.pn * BM + colt;
#pragma unroll
                for (int bj = 0; bj < 2; ++bj) { const f32x4 v0 = acc[ai][bj][m][0] * w8, v1 = acc[ai][bj][m][1] * w8;
                    u32x4 w; w.x = cvt_pk_bf16(v0[0], v0[1]); w.y = cvt_pk_bf16(v0[2], v0[3]); w.z = cvt_pk_bf16(v1[0], v1[1]); w.w = cvt_pk_bf16(v1[2], v1[3]);
                    *(u32x4*)(rowp + bj * HALF) = w; } }
    }
};
}

struct Job { int in_idx; int src_off; int lds; int K; int N; long long dst_off; int ldd; int kcol0; int G, GS, R0; int tile0; };
struct JobTable { Job j[96]; int n; int total; };
constexpr int BIGG = 1 << 30;
constexpr void add_job(JobTable& t, int in_idx, long long src_off, int lds, int K, int N, size_t dst_off, int ldd, int kcol0, int G, int GS, int R0) {
    Job& q = t.j[t.n]; q.in_idx = in_idx; q.src_off = (int)src_off; q.lds = lds; q.K = K; q.N = N; q.dst_off = (long long)dst_off; q.ldd = ldd; q.kcol0 = kcol0; q.G = G; q.GS = GS; q.R0 = R0;
    q.tile0 = t.total; t.total += (K / 64) * (N / 64); t.n++;
}
constexpr JobTable make_jobs(int which) {
    JobTable t{}; t.n = 0; t.total = 0;
    if (which == 0) {
        for (int l = 0; l < 2; ++l) {
            const size_t base = WS_WL + (size_t)l * SZ_WL; const long long wsrc = (long long)l * 1024 * IN_COLS;
            add_job(t, 6, wsrc + 0, IN_COLS, 1024, 768, base, 1024, 0, BIGG, 0, 0);
            add_job(t, 6, wsrc + 2688, IN_COLS, 1024, 256, base, 1024, 0, BIGG, 0, PC_D);
            add_job(t, 6, wsrc + 1536, IN_COLS, 1024, 768, base, 1024, 0, BIGG, 0, PC_Q);
            add_job(t, 6, wsrc + 2944, IN_COLS, 1024, 4096, base, 1024, 0, BIGG, 0, PC_G);
            add_job(t, 6, wsrc + 768, IN_COLS, 1024, 768, base + SZ_WINR, 1024, 0, BIGG, 0, 0);
            add_job(t, 6, wsrc + 2304, IN_COLS, 1024, 384, base + SZ_WINR, 1024, 0, BIGG, 0, PT_V);
            const int kd[4] = {384, 256, 384, 256}, ko[4] = {0, 384, 640, 1024};
            for (int i = 0; i < 4; ++i) add_job(t, 35 + i, (long long)l * kd[i] * 1024, 1024, kd[i], 1024, base + SZ_WINR + SZ_WINHY, 1280, ko[i], BIGG, 0, 0);
            add_job(t, 39, (long long)l * 1024 * 1024, 1024, 1024, 1024, base + SZ_WINR + SZ_WINHY + SZ_WBR, 1024, 0, BIGG, 0, 0);
        }
        for (int q = 0; q < 24; ++q) for (int mat = 0; mat < 2; ++mat)
            add_job(t, mat == 0 ? 9 : 11, (long long)q * 4096, 64, 64, 64, WS_LW + (size_t)(((q / 6) * 2 + mat) * 6 + q % 6) * 4096 * 2, 64, 0, BIGG, 0, 0);
        for (int l = 0; l < 2; ++l) add_job(t, 33, (long long)l * 65536, 256, 256, 256, WS_WGLU + (size_t)l * 256 * 256 * 2, 256, 0, BIGG, 0, 0);
        add_job(t, 44, 0, FF_DENSE, 1024, FF_DENSE, WS_FFGU, 1024, 0, 128, 256, 0);
        add_job(t, 45, 0, FF_DENSE, 1024, FF_DENSE, WS_FFGU, 1024, 0, 128, 256, 128);
        add_job(t, 46, 0, 1024, FF_DENSE, 1024, WS_FFD, FF_DENSE, 0, BIGG, 0, 0);
    } else {
        for (int e = 0; e < NE; ++e) {
            add_job(t, 48, (long long)e * 1024 * FF_E, FF_E, 1024, FF_E, WS_MOEGU + (size_t)e * 2 * FF_E * 1024 * 2, 1024, 0, 128, 256, 0);
            add_job(t, 49, (long long)e * 1024 * FF_E, FF_E, 1024, FF_E, WS_MOEGU + (size_t)e * 2 * FF_E * 1024 * 2, 1024, 0, 128, 256, 128);
            add_job(t, 50, (long long)e * FF_E * 1024, 1024, FF_E, 1024, WS_MOED + (size_t)e * 1024 * FF_E * 2, FF_E, 0, BIGG, 0, 0);
        }
    }
    return t;
}
__device__ const JobTable JT_SMALL = make_jobs(0);
__device__ const JobTable JT_MOE = make_jobs(1);

struct PartTable { pg8::PartC p[32]; };
constexpr pg8::PartC mk_part(size_t aOff, size_t bOff, unsigned aStep, unsigned bStep, int nM, int nN, int nt, int kind, int start) {
    pg8::PartC q{}; q.aOff = (long long)aOff; q.bOff = (long long)bOff; q.aStep = aStep; q.bStep = bStep; q.nM = nM; q.nN = nN; q.nt = nt; q.kind = kind; q.start = start; q.nGrp = 1; q.aGrp = 0; q.bGrp = 0; return q;
}
constexpr PartTable make_parts() {
    PartTable t{};
    for (int l = 0; l < 2; ++l) {
        const size_t WL = WS_WL + (size_t)l * SZ_WL; const int nMrow = l == 0 ? 68 : 64;
        t.p[l * 8 + 0] = mk_part(WS_UB, WL, 256u * 1024u * 2u, 256u * 1024u * 2u, 68, 23, 16, 0, 0);
        t.p[l * 8 + 1] = mk_part(WL + SZ_WINR, WS_UB, 256u * 1024u * 2u, 256u * 1024u * 2u, 5, 68, 16, 1, 68 * 23);
        const int kd[4] = {384, 256, 384, 256}, ko[4] = {0, 384, 640, 1024};
        for (int i = 0; i < 4; ++i) t.p[l * 8 + 2 + i] = mk_part(WS_YB + ko[i] * 2, WL + SZ_WINR + SZ_WINHY + ko[i] * 2, 256u * 1280u * 2u, 256u * 1280u * 2u, nMrow, 4, kd[i] / 64, i, i * nMrow * 4);
        t.p[l * 8 + 6] = mk_part(WS_UB, WL + SZ_WINR + SZ_WINHY + SZ_WBR, 256u * 1024u * 2u, 256u * 1024u * 2u, nMrow, 4, 16, 0, 0);
    }
    for (int l = 0; l < 2; ++l) {
        pg8::PartC q = mk_part(WS_US, WS_OPS + (size_t)l * 16 * 256 * 256 * 2, 256u * 512u * 2u, 0u, 5, 1, 4, 0, 0); q.nGrp = 16; q.aGrp = (unsigned)(NCHKP * 512 * 2); q.bGrp = 256u * 256u * 2u; t.p[18 + l * 3] = q;
        q = mk_part(WS_US, WS_OPY + (size_t)l * 16 * 256 * 512 * 2, 256u * 512u * 2u, 0u, 5, 1, 8, 0, 0); q.nGrp = 16; q.aGrp = (unsigned)(NCHKP * 512 * 2); q.bGrp = 256u * 512u * 2u; t.p[19 + l * 3] = q;
        t.p[20 + l * 3] = mk_part(WS_GL, WS_WGLU + (size_t)l * 256 * 256 * 2, 256u * 256u * 2u, 0u, l == 0 ? 68 : 64, 1, 4, 0, 0);
    }
    {
        const size_t WL0 = WS_WL;
        t.p[24] = mk_part(WS_UB, WL0 + SZ_WINR + SZ_WINHY + SZ_WBR, 256u * 1024u * 2u, 256u * 1024u * 2u, 64, 4, 16, 0, 0);
        pg8::PartC q = mk_part(WS_MGC, WL0 + SZ_WINR + SZ_WINHY + SZ_WBR, 256u * 1024u * 2u, 256u * 1024u * 2u, 4, 4, 16, 1, 256); q.nGrp = 4; q.aGrp = (unsigned)(RC * D * 2); q.bGrp = 0u; t.p[25] = q;
        t.p[26] = mk_part(WS_H, WS_FFD, 256u * (unsigned)FF_DENSE * 2u, 256u * (unsigned)FF_DENSE * 2u, 64, 4, 44, 0, 0);
        q = mk_part(WS_H + (size_t)64 * 256 * FF_DENSE * 2, WS_FFD, 256u * (unsigned)FF_DENSE * 2u, 256u * (unsigned)FF_DENSE * 2u, 4, 4, 12, 1, 256); q.nGrp = 3; q.aGrp = 1536u; q.bGrp = 1536u; t.p[27] = q;
        t.p[28] = mk_part(WS_H + (size_t)64 * 256 * FF_DENSE * 2 + 36 * 128, WS_FFD + 36 * 128, 256u * (unsigned)FF_DENSE * 2u, 256u * (unsigned)FF_DENSE * 2u, 4, 4, 8, 4, 256 + 48);
    }
    t.p[16] = mk_part(WS_UB, WS_FFGU, 256u * 1024u * 2u, 256u * 1024u * 2u, 68, 22, 16, 0, 0);
    t.p[17] = mk_part(WS_H, WS_FFD, 256u * (unsigned)FF_DENSE * 2u, 256u * (unsigned)FF_DENSE * 2u, 68, 4, 44, 0, 0);
    return t;
}
__device__ const PartTable PARTS = make_parts();

struct Args {
    const float* in[51];
    float* out; unsigned char* ws;
    int ph_lo, ph_hi, bar_region, pad0;
};
__device__ __forceinline__ const float* sel_in(const Args& a, int idx) {
    const float* p = a.in[6];
    p = idx == 9 ? a.in[9] : p; p = idx == 11 ? a.in[11] : p; p = idx == 33 ? a.in[33] : p; p = idx == 35 ? a.in[35] : p; p = idx == 36 ? a.in[36] : p; p = idx == 37 ? a.in[37] : p; p = idx == 38 ? a.in[38] : p; p = idx == 39 ? a.in[39] : p;
    p = idx == 44 ? a.in[44] : p; p = idx == 45 ? a.in[45] : p; p = idx == 46 ? a.in[46] : p; p = idx == 48 ? a.in[48] : p; p = idx == 49 ? a.in[49] : p; p = idx == 50 ? a.in[50] : p;
    return p;
}

struct ConvRegs { f32x4 v[4][2]; int jis[4]; };
__device__ __forceinline__ void conv_load(const Args& a, const JobTable& JT, int t0, int stride, ConvRegs& R) {
    int tid = threadIdx.x; asm volatile("" : "+v"(tid));
#pragma unroll
    for (int u = 0; u < 4; ++u) {
        const int t = t0 + u * stride; R.jis[u] = -1;
        if (t < JT.total) {
            int ji = 0;
            for (int k = 1; k < JT.n; ++k) if (t >= JT.j[k].tile0) ji = k;
            R.jis[u] = ji;
            const Job& q = JT.j[ji];
            const int lt = t - q.tile0, nTn = q.N / 64, k0 = (lt / nTn) * 64, n0 = (lt % nTn) * 64;
            const float* src = sel_in(a, q.in_idx) + (size_t)q.src_off + (size_t)k0 * q.lds + n0;
#pragma unroll
            for (int p = 0; p < 2; ++p) R.v[u][p] = *(const f32x4*)(src + (size_t)((tid >> 4) + 32 * p) * q.lds + (tid & 15) * 4);
        }
    }
}
__device__ __forceinline__ void conv_store(const Args& a, const JobTable& JT, LAS float* tile, int t0, int stride, const ConvRegs& R) {
    int tid = threadIdx.x; asm volatile("" : "+v"(tid));
    __syncthreads();
#pragma unroll
    for (int u = 0; u < 4; ++u) if (R.jis[u] >= 0) {
#pragma unroll
        for (int p = 0; p < 2; ++p) { const int kk = (tid >> 4) + 32 * p, nn = (tid & 15) * 4; LAS float* tp = tile + u * (64 * 65) + kk * 65 + nn;
            tp[0] = R.v[u][p][0]; tp[1] = R.v[u][p][1]; tp[2] = R.v[u][p][2]; tp[3] = R.v[u][p][3]; } }
    __syncthreads();
#pragma unroll
    for (int u = 0; u < 4; ++u) if (R.jis[u] >= 0) {
        const Job& q = JT.j[R.jis[u]];
        const int t = t0 + u * stride, lt = t - q.tile0, nTn = q.N / 64, k0 = (lt / nTn) * 64, n0 = (lt % nTn) * 64;
        const int n = tid >> 3, k8 = (tid & 7) * 8, ng = n0 + n;
        const int drow = (ng / q.G) * q.GS + (ng % q.G) + q.R0;
        const LAS float* tp = tile + u * (64 * 65) + n;
        u32x4 w;
        w.x = cvt_pk_bf16(tp[(k8 + 0) * 65], tp[(k8 + 1) * 65]); w.y = cvt_pk_bf16(tp[(k8 + 2) * 65], tp[(k8 + 3) * 65]);
        w.z = cvt_pk_bf16(tp[(k8 + 4) * 65], tp[(k8 + 5) * 65]); w.w = cvt_pk_bf16(tp[(k8 + 6) * 65], tp[(k8 + 7) * 65]);
        *(u32x4*)((bf16_t*)(a.ws + q.dst_off) + (size_t)drow * q.ldd + q.kcol0 + k0 + k8) = w;
    }
}
__device__ __forceinline__ void convert_step(const Args& a, const JobTable& JT, LAS float* tile, int t0, int stride) { ConvRegs R; conv_load(a, JT, t0, stride, R); conv_store(a, JT, tile, t0, stride, R); }
__device__ __forceinline__ void convert_tiles_pipelined(const Args& a, const JobTable& JT, LAS float* tile, int first, int stride) {
    ConvRegs cur; int t0 = first;
    if (t0 >= JT.total) return;
    conv_load(a, JT, t0, stride, cur);
    for (;;) {
        const int tn = t0 + 4 * stride; const bool more = tn < JT.total;
        ConvRegs nxt;
        if (more) conv_load(a, JT, tn, stride, nxt);
        conv_store(a, JT, tile, t0, stride, cur);
        if (!more) break;
        cur = nxt; t0 = tn;
    }
}
__device__ __forceinline__ void convert_tiles(const Args& a, const JobTable& JT, LAS float* tile, int first, int stride) {
    for (int t0 = first; t0 < JT.total; t0 += 4 * stride) convert_step(a, JT, tile, t0, stride);
}

__device__ __forceinline__ int opaque(int v) { asm volatile("" : "+v"(v)); return v; }
#define PIN8(a) asm volatile("" : "+v"((a)[0]), "+v"((a)[1]), "+v"((a)[2]), "+v"((a)[3]), "+v"((a)[4]), "+v"((a)[5]), "+v"((a)[6]), "+v"((a)[7]))
#define PIN16(a) do { PIN8(a); PIN8((a) + 8); } while (0)
struct RowV { f32x4 v[4]; };
__device__ __forceinline__ RowV row_load(const float* p, int lane) { RowV r;
#pragma unroll
    for (int i = 0; i < 4; ++i) r.v[i] = *(const f32x4*)(p + 256 * i + 4 * lane); return r; }
__device__ __forceinline__ RowV row_load_bf16(const bf16_t* p, int lane) { RowV r;
#pragma unroll
    for (int i = 0; i < 4; ++i) { const u32x2 w = *(const u32x2*)(p + 256 * i + 4 * lane); r.v[i] = (f32x4){bflo(w.x), bfhi(w.x), bflo(w.y), bfhi(w.y)}; } return r; }
__device__ __forceinline__ void row_store(float* p, int lane, const RowV& r) {
#pragma unroll
    for (int i = 0; i < 4; ++i) *(f32x4*)(p + 256 * i + 4 * lane) = r.v[i]; }
__device__ __forceinline__ void row_store_bf16(bf16_t* p, int lane, const RowV& r) {
#pragma unroll
    for (int i = 0; i < 4; ++i) { u32x2 w; w.x = cvt_pk_bf16(r.v[i][0], r.v[i][1]); w.y = cvt_pk_bf16(r.v[i][2], r.v[i][3]); *(u32x2*)(p + 256 * i + 4 * lane) = w; } }
__device__ __forceinline__ RowV row_norm(const RowV& x) {
    float s = 0.f;
#pragma unroll
    for (int i = 0; i < 4; ++i) s += (x.v[i][0] + x.v[i][1]) + (x.v[i][2] + x.v[i][3]);
    const float mu = wave_sum(s) * (1.f / D);
    RowV d; float q = 0.f;
#pragma unroll
    for (int i = 0; i < 4; ++i) { d.v[i] = x.v[i] - mu; q += (d.v[i][0] * d.v[i][0] + d.v[i][1] * d.v[i][1]) + (d.v[i][2] * d.v[i][2] + d.v[i][3] * d.v[i][3]); }
    const float rs = rsqrtf(wave_sum(q) * (1.f / D) + 1e-5f);
#pragma unroll
    for (int i = 0; i < 4; ++i) d.v[i] = d.v[i] * rs;
    return d;
}
__device__ __forceinline__ RowV row_affine(const RowV& n, const float* g, const float* b, int lane) {
    RowV o;
#pragma unroll
    for (int i = 0; i < 4; ++i) o.v[i] = n.v[i] * *(const f32x4*)(g + 256 * i + 4 * lane) + *(const f32x4*)(b + 256 * i + 4 * lane);
    return o;
}
__device__ __forceinline__ RowV row_modulate(const RowV& n, const float* sh, const float* sc, int lane) {
    RowV o;
#pragma unroll
    for (int i = 0; i < 4; ++i) o.v[i] = n.v[i] * (*(const f32x4*)(sc + 256 * i + 4 * lane) + 1.0f) + *(const f32x4*)(sh + 256 * i + 4 * lane);
    return o;
}

constexpr int LDS_BYTES = 159744;
constexpr int MISC_OFF = 159488;
constexpr int NPH_LAYER = 16;
#ifndef SPLIT
#define SPLIT 0
#endif

__global__ void __launch_bounds__(512, 2) mk_fwd(Args a) {
    extern __shared__ __attribute__((aligned(16))) unsigned char shm[];
    LAS unsigned char* lds = (LAS unsigned char*)shm;
    volatile LAS unsigned* MISC = (volatile LAS unsigned*)(lds + MISC_OFF);
    const int tid0 = threadIdx.x, wave = __builtin_amdgcn_readfirstlane(tid0 >> 6);
    const int G = gridDim.x, bid = blockIdx.x;
    if (tid0 < (LDS_BYTES - MISC_OFF) / 4) MISC[tid0] = 0u;
    __syncthreads();
    unsigned char* ws = a.ws;
    unsigned* ctl = (unsigned*)(ws + WS_CTL);
    XcdBarrier bar = xcd_barrier_post(ctl + CW_BAR + a.bar_region * XCD_BAR_WORDS, MISC + 8);
    const int lo = a.ph_lo, hi = a.ph_hi;
#ifndef PHMASK
#define PHMASK 0xFFFF
#endif
#define IN(k) (lo <= (k) && (k) < hi)
#define SEAM(k) do { if (lo <= (k) && (k) + 1 < hi) xcd_barrier(bar); } while (0)
    float* MOD = (float*)(ws + WS_MOD);
    bf16_t* UB = (bf16_t*)(ws + WS_UB); bf16_t* PR = (bf16_t*)(ws + WS_PR); bf16_t* PT = (bf16_t*)(ws + WS_PT); bf16_t* YB = (bf16_t*)(ws + WS_YB);
    float* PRE = (float*)(ws + WS_PRE); float* XSC = (float*)(ws + WS_XSC);
    const float* x_in = a.in[0]; const float* ctx_in = a.in[2];

    if (((PHMASK >> 0) & 1) && IN(0)) {
        const int tid = opaque(tid0), lane = tid & 63;
        __syncthreads();
        LAS float* sc = (LAS float*)lds;
        for (int i = tid; i < 5 * 1024; i += 512) { const int r = i >> 10, k = i & 1023; sc[i] = silu_acc(r < 4 ? a.in[1][r * 1024 + k] : a.in[3][k]); }
        __syncthreads();
        for (int u = bid; u < 2 * 96 * 8; u += G) {
            const int l = u / (96 * 8), rem = u % (96 * 8), cg = rem / 8, ks = rem % 8;
            const int n = cg * 64 + lane;
            const float* w = a.in[4] + (size_t)l * 1024 * 6144 + n;
            float a0 = 0, a1 = 0, a2 = 0, a3 = 0, a4 = 0;
            const int kb = ks * 128 + wave * 16;
#pragma unroll 4
            for (int k = kb; k < kb + 16; ++k) { const float wv = w[(size_t)k * 6144]; a0 += sc[k] * wv; a1 += sc[1024 + k] * wv; a2 += sc[2048 + k] * wv; a3 += sc[3072 + k] * wv; a4 += sc[4096 + k] * wv; }
            if (ks == 0 && wave == 0) { const float bb = a.in[5][l * 6144 + n]; a0 += bb; a1 += bb; a2 += bb; a3 += bb; a4 += bb; }
            float* o = MOD + (size_t)l * 5 * 6144 + n;
            atomicAdd(o, a0); atomicAdd(o + 6144, a1); atomicAdd(o + 2 * 6144, a2); atomicAdd(o + 3 * 6144, a3); atomicAdd(o + 4 * 6144, a4);
        }
        __syncthreads();
        for (int u = bid; u < 132; u += G) {
            const bool isc = u >= 128; const int l = isc ? 0 : (u >> 6), blk = isc ? u - 128 : (u & 63), L = isc ? CTXL : SEQ, t0 = blk * 64;
            LAS float* feat = (LAS float*)lds;
            LAS float* h1 = feat + 64 * 33;
            LAS float* h2 = h1 + 4096;
            const float* w1 = a.in[16] + l * 33 * 64; const float* b1 = a.in[17] + l * 64; const float* w2 = a.in[18] + l * 4096; const float* b2 = a.in[19] + l * 64;
            const float* w3 = a.in[20] + (size_t)l * 65536; const float* b3 = a.in[21] + l * 1024; const float* fq = a.in[22] + l * 64;
            __syncthreads();
            for (int i = tid; i < 64 * 33; i += 512) { const int tt = i / 33, f = i - tt * 33, t = t0 + tt; float v;
                if (f == 0) v = (float)t / (float)L;
                else { const int band = (f - 1) % 16 + 1; const int m = (int)(((long)t * band) % L); const double ang = 2.0 * M_PI * (double)m / (double)L; v = f <= 16 ? (float)cos(ang) : (float)sin(ang); }
                feat[i] = v; }
            __syncthreads();
            for (int i = tid; i < 4096; i += 512) { const int tt = i >> 6, j = i & 63; float sacc = b1[j];
                for (int f = 0; f < 33; ++f) sacc += feat[tt * 33 + f] * w1[f * 64 + j];
                h1[i] = sinf(fq[j] * sacc); }
            __syncthreads();
            for (int i = tid; i < 4096; i += 512) { const int tt = i >> 6, j = i & 63; float sacc = b2[j];
                for (int f = 0; f < 64; ++f) sacc += h1[tt * 64 + f] * w2[f * 64 + j];
                h2[i] = sinf(fq[j] * sacc); }
            __syncthreads();
            const float dmin = 3.0701134573253945f, dmax = 15.350567286626973f;
#pragma unroll 1
            for (int jj = 0; jj < 2; ++jj) {
                const int n = tid + 512 * jj, dir = n >> 9, o = (n >> 8) & 1, c = n & 255;
                float wc[64];
#pragma unroll
                for (int i = 0; i < 64; ++i) wc[i] = w3[i * 1024 + n];
                const float bb = b3[n], delta = dmin + (dmax - dmin) * (float)c / 255.0f;
                bf16_t* dst = isc ? (bf16_t*)(ws + WS_KFC) + ((size_t)(dir * 2 + o) * 256 + c) * CTXL + t0 : (bf16_t*)(ws + WS_KFL) + ((size_t)((l * 2 + dir) * 2 + o) * 256 + c) * SEQ + t0;
                float asum = 0.f;
#pragma unroll 1
                for (int tg = 0; tg < 8; ++tg) {
                    float v[8];
#pragma unroll
                    for (int q = 0; q < 8; ++q) { float sacc = bb; const LAS float* hp = h2 + (tg * 8 + q) * 64;
#pragma unroll
                        for (int i = 0; i < 64; ++i) sacc += hp[i] * wc[i];
                        const int t = t0 + tg * 8 + q;
                        v[q] = sacc * expf(-((float)t / (float)L) * delta);
                        if (!(dir == 1 && t == 0)) asum += fabsf(v[q]); }
                    u32x4 w; w.x = cvt_pk_bf16(v[0], v[1]); w.y = cvt_pk_bf16(v[2], v[3]); w.z = cvt_pk_bf16(v[4], v[5]); w.w = cvt_pk_bf16(v[6], v[7]);
                    *(u32x4*)(dst + tg * 8) = w;
                }
                atomicAdd((float*)(ctl + CW_HYN) + (isc ? 1024 + o * 256 + c : (l * 2 + o) * 256 + c), asum);
            }
        }
        __syncthreads();
        for (int uq = bid; uq < 164; uq += G) { if (uq < 132) continue; const int u = uq - 132;
            const int l = u >> 4, g = u & 15;
            LAS float* PW = (LAS float*)lds;
            LAS float* BBs = PW + 2 * 64 * 17 * 2;
            LAS float* Cs = BBs + 2 * 64 * 16 * 2;
            LAS float* KT = Cs + 2 * 16 * 64 * 2;
            __syncthreads();
            if (tid < 128) {
                const int d = tid >> 6, p = tid & 63, idx = l * 2048 + (d * 16 + g) * 64 + p;
                const double ar = a.in[25][idx], ai = a.in[26][idx], dt = exp((double)a.in[27][l * 32 + d * 16 + g]);
                const double mag = exp(dt * ar), abr = mag * cos(dt * ai), abi = mag * sin(dt * ai), den = ar * ar + ai * ai;
                const double fr = ((abr - 1.0) * ar + abi * ai) / den, fi = (abi * ar - (abr - 1.0) * ai) / den;
                double pr = 1.0, pi = 0.0;
                for (int k = 0; k <= 16; ++k) { PW[((d * 64 + p) * 17 + k) * 2] = (float)pr; PW[((d * 64 + p) * 17 + k) * 2 + 1] = (float)pi; const double nr = pr * abr - pi * abi, ni = pr * abi + pi * abr; pr = nr; pi = ni; }
                float* a16 = (float*)(ws + WS_AB16) + ((size_t)((l * 2 + d) * 16 + g) * 64 + p) * 2;
                a16[0] = PW[((d * 64 + p) * 17 + 16) * 2]; a16[1] = PW[((d * 64 + p) * 17 + 16) * 2 + 1];
                for (int i = 0; i < 16; ++i) { const double br = a.in[28][(size_t)idx * 16 + i], bi = a.in[29][(size_t)idx * 16 + i];
                    BBs[((d * 64 + p) * 16 + i) * 2] = (float)(fr * br - fi * bi); BBs[((d * 64 + p) * 16 + i) * 2 + 1] = (float)(fr * bi + fi * br); }
            }
            for (int i = tid; i < 2048; i += 512) { const int d = i >> 10, o = (i >> 6) & 15, p = i & 63; const size_t ci = (size_t)l * 32768 + ((size_t)(d * 16 + g) * 16 + o) * 64 + p;
                Cs[i * 2] = a.in[30][ci]; Cs[i * 2 + 1] = a.in[31][ci]; }
            __syncthreads();
            for (int e = tid; e < 8192; e += 512) { const int d = e >> 12, k = (e >> 8) & 15, o = (e >> 4) & 15, i = e & 15;
                float acc = 0.f;
                for (int p = 0; p < 64; ++p) { const float cr = Cs[((d * 16 + o) * 64 + p) * 2], ci = Cs[((d * 16 + o) * 64 + p) * 2 + 1], pr = PW[((d * 64 + p) * 17 + k) * 2], pi = PW[((d * 64 + p) * 17 + k) * 2 + 1];
                    const float tr = cr * pr - ci * pi, ti = cr * pi + ci * pr;
                    acc += tr * BBs[((d * 64 + p) * 16 + i) * 2] - ti * BBs[((d * 64 + p) * 16 + i) * 2 + 1]; }
                KT[e] = acc; }
            __syncthreads();
            bf16_t* OPS = (bf16_t*)(ws + WS_OPS) + (size_t)(l * 16 + g) * 256 * 256;
            bf16_t* OPY = (bf16_t*)(ws + WS_OPY) + (size_t)(l * 16 + g) * 256 * 512;
            for (int e = tid; e < 256 * 32; e += 512) {
                const int row = e >> 5, c0 = (e & 31) * 8, d = row >> 7, p = (row >> 1) & 63, ri = row & 1, sx = c0 >> 4, i0 = c0 & 15, k = d == 0 ? 15 - sx : sx;
                const float pr = PW[((d * 64 + p) * 17 + k) * 2], pi = PW[((d * 64 + p) * 17 + k) * 2 + 1];
                float v[8];
#pragma unroll
                for (int j = 0; j < 8; ++j) { const float br = BBs[((d * 64 + p) * 16 + i0 + j) * 2], bi = BBs[((d * 64 + p) * 16 + i0 + j) * 2 + 1]; v[j] = ri == 0 ? pr * br - pi * bi : pr * bi + pi * br; }
                u32x4 w; w.x = cvt_pk_bf16(v[0], v[1]); w.y = cvt_pk_bf16(v[2], v[3]); w.z = cvt_pk_bf16(v[4], v[5]); w.w = cvt_pk_bf16(v[6], v[7]);
                *(u32x4*)(OPS + (size_t)row * 256 + c0) = w; }
            for (int e = tid; e < 256 * 64; e += 512) {
                const int row = e >> 6, c0 = (e & 63) * 8, t = row >> 4, o = row & 15;
                float v[8];
                if (c0 < 256) { const int sx = c0 >> 4, i0 = c0 & 15;
#pragma unroll
                    for (int j = 0; j < 8; ++j) { float x = 0.f; if (sx <= t) x += KT[((0 * 16 + (t - sx)) * 16 + o) * 16 + i0 + j]; if (sx >= t) x += KT[((1 * 16 + (sx - t)) * 16 + o) * 16 + i0 + j]; v[j] = x; } }
                else { const int c2 = c0 - 256, d = c2 >> 7, k = d == 0 ? t + 1 : 16 - t;
#pragma unroll
                    for (int j = 0; j < 8; ++j) { const int p = ((c2 + j) >> 1) & 63, ri = (c2 + j) & 1;
                        const float cr = Cs[((d * 16 + o) * 64 + p) * 2], ci = Cs[((d * 16 + o) * 64 + p) * 2 + 1], pr = PW[((d * 64 + p) * 17 + k) * 2], pi = PW[((d * 64 + p) * 17 + k) * 2 + 1];
                        v[j] = ri == 0 ? cr * pr - ci * pi : -(cr * pi + ci * pr); } }
                u32x4 w; w.x = cvt_pk_bf16(v[0], v[1]); w.y = cvt_pk_bf16(v[2], v[3]); w.z = cvt_pk_bf16(v[4], v[5]); w.w = cvt_pk_bf16(v[6], v[7]);
                *(u32x4*)(OPY + (size_t)row * 512 + c0) = w; }
        }
        __syncthreads();
        for (;;) {
            __syncthreads();
            if (tid == 0) MISC[16] = atomicAdd(ctl + CW_QUEUE, 4u);
            __syncthreads();
            const int base = (int)MISC[16];
            if (base >= JT_SMALL.total) break;
            convert_step(a, JT_SMALL, (LAS float*)lds, base, 1);
        }
        __syncthreads();
    }
    SEAM(0);

    for (int l = 0; l < 2; ++l) {
        const int P0 = 1 + l * NPH_LAYER;
        const float* MODL = MOD + (size_t)l * 5 * 6144;
        const unsigned char* WL = ws + WS_WL + (size_t)l * SZ_WL;
        const int nMrow = (l == 0) ? 68 : 64;
        const float* xlat = (l == 0) ? x_in : a.out; const float* xctx = (l == 0) ? ctx_in : XSC;

        if (((PHMASK >> 1) & 1) && l == 0 && IN(P0 + 0)) {
            const int lane = opaque(tid0) & 63;
            for (int r = bid * 8 + wave; r < RT; r += G * 8) {
                const float* src = r < RL ? x_in + (size_t)r * D : ctx_in + (size_t)(r - RL) * D;
                const float* mv = MODL + (size_t)(r < RL ? (r >> 12) : 4) * 6144;
                const RowV n = row_norm(row_load(src, lane));
                row_store_bf16(UB + (size_t)r * D, lane, row_modulate(n, mv, mv + 1024, lane));
            }
        }
        if (l == 0) SEAM(P0 + 0);

        if (((PHMASK >> 2) & 1) && IN(P0 + 1)) {
            const pg8::TabSched S{PARTS.p + l * 8, (const char*)ws, 2, 68 * 23 + 5 * 68, G, bid};
            pg8::EpiProj E{PR, PT, (bf16_t*)(ws + WS_US), 7, ws + WS_GQ};
            pg8::gemm_phase<1024, 1024>(lds, S, E);
        }
        SEAM(P0 + 1);
        if (((PHMASK >> 13) & 1) && IN(P0 + 2)) {
            const int tid = opaque(tid0), lane = tid & 63;
            LAS float* rp = (LAS float*)lds;
            for (int i = tid; i < 6 * 465; i += 512) rp[i] = a.in[24][l * 2790 + i];
            __syncthreads();
            LAS bf16_t* KW = (LAS bf16_t*)(lds + 11264);
            LAS bf16_t* CK = (LAS bf16_t*)(lds + 11264 + 576 * 144);
            LAS bf16_t* VW = (LAS bf16_t*)(lds + 11264);
            LAS bf16_t* CV = (LAS bf16_t*)(lds + 11264 + 64 * 1168);
            const int ngroups = 768 + (l == 0 ? 48 : 0);
            for (int gi = bid; gi < ngroups; gi += G) {
                const bool lat = gi < 768;
                const int combo = lat ? gi >> 5 : (gi - 768) >> 1, b = combo / 6, h = combo - 6 * b;
                const int v = lat ? ((gi & 31) << 3) + wave : (((gi - 768) & 1) << 3) + wave;
                const int r0g = (gi & 31) << 1, rs0 = r0g - 4 < 0 ? 0 : (r0g - 4 > 56 ? 56 : r0g - 4);
                const int ntokw = lat ? ((64 - rs0) < 9 ? (64 - rs0) : 9) * 64 : 0;
                __syncthreads();
                {   const int tid2 = opaque(tid);
#pragma unroll
                    for (int k = 0; k < 9; ++k) { const int c = tid2 + 512 * k, tok = c >> 3, part = c & 7;
                        if (tok < ntokw) *(LAS u32x4*)(KW + tok * 72 + part * 8) = *(const u32x4*)(PR + (size_t)(b * SEQ + rs0 * 64 + tok) * LDP + PC_K + h * 64 + part * 8); }
#pragma unroll
                    for (int k = 0; k < 4; ++k) { const int c = tid2 + 512 * k, tok = c >> 3, part = c & 7;
                        *(LAS u32x4*)(CK + tok * 72 + part * 8) = *(const u32x4*)(PR + (size_t)(RL + b * CTXL + tok) * LDP + PC_K + h * 64 + part * 8); } }
                __syncthreads();
                const int ln2 = opaque(lane), qn = ln2 & 15, g = ln2 >> 4;
                int r = 0, qb, tq, rs = 0, bs = 0, w = 0, cs = 0;
                if (lat) { qb = v & 3; r = v >> 2; rs = r - 4 < 0 ? 0 : (r - 4 > 56 ? 56 : r - 4); bs = qb == 0 ? 0 : (qb == 1 ? 8 : (qb == 2 ? 24 : 32));
                    w = 16 * qb + qn; cs = w - 8 < 0 ? 0 : (w - 8 > 48 ? 48 : w - 8); tq = b * SEQ + r * 64 + w; }
                else { qb = v; tq = RL + b * CTXL + 16 * qb + qn; }
                const int pr0 = rs - rs0;
                const bf16_t* qp = PR + (size_t)tq * LDP + PC_Q + h * 64 + 8 * g;
                const bf16x8 q0 = *(const bf16x8*)qp, q1 = *(const bf16x8*)(qp + 32);
                f32x4 S[32];
                const int koff = 8 * (qn >> 2) + (qn & 3);
                if (lat) {
#pragma unroll
                    for (int p = 0; p < 8; ++p)
#pragma unroll
                        for (int hf = 0; hf < 2; ++hf) { const LAS bf16_t* kp = KW + ((pr0 + p) * 64 + bs + koff + 4 * hf) * 72 + 8 * g;
                            const bf16x8 k0 = *(const LAS bf16x8*)kp, k1 = *(const LAS bf16x8*)(kp + 32);
                            f32x4 acc = {0.f, 0.f, 0.f, 0.f};
                            acc = __builtin_amdgcn_mfma_f32_16x16x32_bf16(k0, q0, acc, 0, 0, 0);
                            acc = __builtin_amdgcn_mfma_f32_16x16x32_bf16(k1, q1, acc, 0, 0, 0);
                            const int rowoff = (h * 15 + (rs + p - r + 7)) * 31;
#pragma unroll
                            for (int j = 0; j < 4; ++j) { const int c = bs + 8 * g + 4 * hf + j; const bool ok = (c >= cs) && (c < cs + 16);
                                const int dc = ok ? c - w + 15 : 0;
                                acc[j] = ok ? acc[j] * 0.125f + rp[rowoff + dc] : -3.0e38f; }
                            S[2 * p + hf] = acc; if (hf == 1 && (p & 1)) __builtin_amdgcn_sched_barrier(0); }
                } else {
#pragma unroll
                    for (int p = 0; p < 16; ++p) S[p] = (f32x4){-3.0e38f, -3.0e38f, -3.0e38f, -3.0e38f};
                }
#pragma unroll
                for (int p = 0; p < 8; ++p)
#pragma unroll
                    for (int hf = 0; hf < 2; ++hf) { const LAS bf16_t* kp = CK + (32 * p + koff + 4 * hf) * 72 + 8 * g;
                        const bf16x8 k0 = *(const LAS bf16x8*)kp, k1 = *(const LAS bf16x8*)(kp + 32);
                        f32x4 acc = {0.f, 0.f, 0.f, 0.f};
                        acc = __builtin_amdgcn_mfma_f32_16x16x32_bf16(k0, q0, acc, 0, 0, 0);
                        acc = __builtin_amdgcn_mfma_f32_16x16x32_bf16(k1, q1, acc, 0, 0, 0);
                        S[16 + 2 * p + hf] = acc * 0.125f; if (hf == 1 && (p & 1)) __builtin_amdgcn_sched_barrier(0); }
                float mx = -3.0e38f;
#pragma unroll
                for (int i = 0; i < 32; ++i) mx = fmaxf(fmaxf(mx, fmaxf(S[i][0], S[i][1])), fmaxf(S[i][2], S[i][3]));
                mx = fmaxf(mx, __shfl_xor(mx, 16)); mx = fmaxf(mx, __shfl_xor(mx, 32));
                float sum = 0.f;
#pragma unroll
                for (int i = 0; i < 32; ++i) {
#pragma unroll
                    for (int j = 0; j < 4; ++j) { const float e = __expf(S[i][j] - mx); S[i][j] = e; sum += e; } }
                sum += __shfl_xor(sum, 16); sum += __shfl_xor(sum, 32);
                const float inv = 1.0f / sum;
                __syncthreads();
                {   const int tid2 = opaque(tid);
#pragma unroll
                    for (int k = 0; k < 9; ++k) { const int c = tid2 + 512 * k, dd = c / 72, part = c - dd * 72;
                        if (part * 8 < ntokw) *(LAS u32x4*)(VW + dd * 584 + part * 8) = *(const u32x4*)(PT + (size_t)(PT_V + h * 64 + dd) * RT + b * SEQ + rs0 * 64 + part * 8); }
#pragma unroll
                    for (int k = 0; k < 4; ++k) { const int c = tid2 + 512 * k, dd = c >> 5, part = c & 31;
                        *(LAS u32x4*)(CV + dd * 264 + part * 8) = *(const u32x4*)(PT + (size_t)(PT_V + h * 64 + dd) * RT + RL + b * CTXL + part * 8); } }
                __syncthreads();
                f32x4 O[4];
#pragma unroll
                for (int dt = 0; dt < 4; ++dt) O[dt] = (f32x4){0.f, 0.f, 0.f, 0.f};
#pragma unroll
                for (int p = 0; p < 16; ++p) {
                    if (p < 8 && !lat) continue;
                    u32x4 pw; pw.x = cvt_pk_bf16(S[2 * p][0], S[2 * p][1]); pw.y = cvt_pk_bf16(S[2 * p][2], S[2 * p][3]); pw.z = cvt_pk_bf16(S[2 * p + 1][0], S[2 * p + 1][1]); pw.w = cvt_pk_bf16(S[2 * p + 1][2], S[2 * p + 1][3]);
                    bf16x8 pf; __builtin_memcpy(&pf, &pw, 16);
#pragma unroll
                    for (int dt = 0; dt < 4; ++dt) { const LAS bf16_t* vp = p < 8 ? VW + (16 * dt + qn) * 584 + (pr0 + p) * 64 + bs + 8 * g : CV + (16 * dt + qn) * 264 + 32 * (p - 8) + 8 * g;
                        O[dt] = __builtin_amdgcn_mfma_f32_16x16x32_bf16(*(const LAS bf16x8*)vp, pf, O[dt], 0, 0, 0); }
                    if (p & 1) __builtin_amdgcn_sched_barrier(0);
                }
                bf16_t* op = YB + (size_t)tq * YW + YC_C + h * 64 + 4 * g;
#pragma unroll
                for (int dt = 0; dt < 4; ++dt) { u32x2 o2; o2.x = cvt_pk_bf16(O[dt][0] * inv, O[dt][1] * inv); o2.y = cvt_pk_bf16(O[dt][2] * inv, O[dt][3] * inv); *(u32x2*)(op + 16 * dt) = o2; }
            }
            __syncthreads();
            {
                const int tid = opaque(tid0), lane = tid & 63;
                LAS float* XC = (LAS float*)lds;
                LAS f32x2* AB = (LAS f32x2*)(lds + 16 * 384 * 4);
                const float* cw = a.in[7] + l * 4 * 384; const float* cb = a.in[8] + l * 384;
                const bf16_t* LW = (const bf16_t*)(ws + WS_LW) + (size_t)l * 24 * 4096;
                bf16_t* LT = (bf16_t*)(ws + WS_LT); f32x2* LAGG = (f32x2*)(ws + WS_LAGG);
                const int dir = (wave >> 2) & 1, ntile = wave & 3, tk = lane & 15, kg = lane >> 4;
                LAS float* CT = (LAS float*)(lds + 16 * 384 * 4 + 2 * 16 * 384 * 8);
                for (int i = tid; i < 768; i += 512) { CT[i] = a.in[10][l * 768 + i]; CT[768 + i] = a.in[12][l * 768 + i]; CT[1536 + i] = -8.0f * softplus(-a.in[13][l * 768 + i]); }
                float cwv[60];
#pragma unroll
                for (int i = 0; i < 12; ++i) { const int idx = tid + 512 * i, ch = idx % 384;
                    cwv[5 * i] = cw[ch]; cwv[5 * i + 1] = cw[384 + ch]; cwv[5 * i + 2] = cw[768 + ch]; cwv[5 * i + 3] = cw[1152 + ch]; cwv[5 * i + 4] = cb[ch]; }
                PIN16(cwv); PIN16(cwv + 16); PIN16(cwv + 32); PIN8(cwv + 48); asm volatile("" : "+v"(cwv[56]), "+v"(cwv[57]), "+v"(cwv[58]), "+v"(cwv[59]));
                for (int n = bid; n < NCHK; n += G) {
                    const int r0 = 16 * n; int start, len, pos0, bb; row_seq(r0, start, len, pos0, bb);
                    __syncthreads();
                    unsigned pin[48];
#pragma unroll
                    for (int i = 0; i < 12; ++i) { const int idx = tid + 512 * i, tok = idx / 384, ch = idx - tok * 384, pos = pos0 + tok;
                        const bf16_t* pr = PR + (size_t)(r0 + tok) * LDP + PC_AC + ch;
                        pin[4 * i + 0] = pos >= 2 ? pr[-2 * LDP] : 0; pin[4 * i + 1] = pos >= 1 ? pr[-LDP] : 0; pin[4 * i + 2] = pr[0]; pin[4 * i + 3] = pos + 1 < len ? pr[LDP] : 0; }
                    PIN16(pin); PIN16(pin + 16); PIN16(pin + 32);
#pragma unroll
                    for (int i = 0; i < 12; ++i) { const int idx = tid + 512 * i, tok = idx / 384, ch = idx - tok * 384;
                        XC[idx] = cwv[5 * i + 4] + cwv[5 * i] * bflo(pin[4 * i]) + cwv[5 * i + 1] * bflo(pin[4 * i + 1]) + cwv[5 * i + 2] * bflo(pin[4 * i + 2]) + cwv[5 * i + 3] * bflo(pin[4 * i + 3]); }
                    __syncthreads();
#pragma unroll 2
                    for (int g = 0; g < 6; ++g) {
                        bf16x8 wq[4];
#pragma unroll
                        for (int ks = 0; ks < 2; ++ks) { const bf16_t* wp = LW + ((size_t)((dir * 2 + 0) * 6 + g) * 64 + 16 * ntile + tk) * 64 + 32 * ks + 8 * kg; wq[2 * ks] = *(const bf16x8*)wp; wq[2 * ks + 1] = *(const bf16x8*)(wp + 6 * 4096); }
                        asm volatile("" : "+v"(wq[0]), "+v"(wq[1]), "+v"(wq[2]), "+v"(wq[3]));
                        f32x4 ar = {0.f, 0.f, 0.f, 0.f}, ai = {0.f, 0.f, 0.f, 0.f};
#pragma unroll
                        for (int ks = 0; ks < 2; ++ks) {
                            const LAS float* xp = XC + tk * 384 + g * 64 + 32 * ks + 8 * kg;
                            const f32x4 x0 = *(const LAS f32x4*)xp, x1 = *(const LAS f32x4*)(xp + 4);
                            u32x4 xw; xw.x = cvt_pk_bf16(x0[0], x0[1]); xw.y = cvt_pk_bf16(x0[2], x0[3]); xw.z = cvt_pk_bf16(x1[0], x1[1]); xw.w = cvt_pk_bf16(x1[2], x1[3]);
                            bf16x8 xf; __builtin_memcpy(&xf, &xw, 16);
                            ar = __builtin_amdgcn_mfma_f32_16x16x32_bf16(xf, wq[2 * ks], ar, 0, 0, 0);
                            ai = __builtin_amdgcn_mfma_f32_16x16x32_bf16(xf, wq[2 * ks + 1], ai, 0, 0, 0);
                        }
                        const int ch = g * 64 + 16 * ntile + tk;
                        const float br = CT[dir * 384 + ch], bi = CT[768 + dir * 384 + ch], sp8 = CT[1536 + dir * 384 + ch];
#pragma unroll
                        for (int j = 0; j < 4; ++j) { const int tok = 4 * kg + j;
                            const float la = sigm(ar[j] + br) * sp8, y = 2.0f * la;
                            const float av = 1.0f + la * (1.0f + la * (0.5f + la * (0.16666667f + la * (0.041666667f + la * 0.0083333333f))));
                            const float om = -y * (1.0f + y * (0.5f + y * (0.16666667f + y * (0.041666667f + y * (0.0083333333f + y * 0.0013888889f)))));
                            const float bt = __builtin_sqrtf(om) * sigm(ai[j] + bi) * XC[tok * 384 + ch];
                            AB[(dir * 16 + tok) * 384 + ch] = (f32x2){av, bt}; }
                    }
                    __syncthreads();
                    if (tid < 384) {
                        float hf = 0.f, pf = 1.f, hb = 0.f, pb = 1.f;
#pragma unroll
                        for (int t = 0; t < 16; ++t) {
                            const f32x2 f = AB[t * 384 + tid], bk = AB[(16 + 15 - t) * 384 + tid];
                            hf = f[0] * hf + f[1]; pf *= f[0]; hb = bk[0] * hb + bk[1]; pb *= bk[0];
                            AB[t * 384 + tid] = (f32x2){pf, hf}; AB[(16 + 15 - t) * 384 + tid] = (f32x2){pb, hb}; }
                        LAGG[((size_t)n * 2 + 0) * 384 + tid] = (f32x2){pf, hf}; LAGG[((size_t)n * 2 + 1) * 384 + tid] = (f32x2){pb, hb};
                    }
                    __syncthreads();
#pragma unroll
                    for (int i = 0; i < 12; ++i) { const int idx = tid + 512 * i, tok = idx / 384, ch = idx - tok * 384;
                        const f32x2 f = AB[idx], bk = AB[16 * 384 + idx];
                        bf16_t* o = LT + (size_t)(r0 + tok) * 1152 + ch;
                        o[0] = f2bf(f[1] + bk[1]); o[384] = f2bf(f[0]); o[768] = f2bf(bk[0]); }
                }
                __syncthreads();
            }
            {
                const int tid = opaque(tid0), lane = tid & 63;
                constexpr int ZS = SEQ + 16;
                LAS bf16_t* R0 = (LAS bf16_t*)lds;
                LAS bf16_t* R1 = R0 + 8224;
                LAS bf16_t* ZA = R1 + 8224;
                const LAS unsigned* Rdw = (const LAS unsigned*)lds;
#define HY_ZF(b, s) ((b) * ZS + ((s) & ~63) + (((((s) >> 3) & 7) ^ (((s) >> 7) & 1)) << 3) + ((s) & 7))
                const float* hcw = a.in[14] + l * 3 * 768; const float* hcb = a.in[15] + l * 768;
                const float* nrm = (const float*)(ctl + CW_HYN);
                bf16_t* YT = (bf16_t*)(ws + WS_YT);
                const int r32 = lane & 31, hh = lane >> 5, il = r32 >> 2, bq = r32 & 3, iblk = 8 * wave + il;
                const int x0b = 4095 - r32 + 8 * hh, par = x0b & 1;
                const int abase = (par ? 4112 : 0) + ((x0b - par) >> 1);
                for (int c = bid; c < 256; c += G) {
                    __syncthreads();
#pragma unroll 1
                    for (int it = tid; it < 3 * 4 * 512; it += 512) {
                        const int arr = it >> 11, b = (it >> 9) & 3, s8 = (it & 511) * 8, ch = arr * 256 + c;
                        const bf16_t* pp = PT + (size_t)ch * RT + b * SEQ + s8;
                        const u32x4 pv = *(const u32x4*)pp;
                        const float w0 = hcw[ch], w1 = hcw[768 + ch], w2 = hcw[1536 + ch], cb0 = hcb[ch];
                        float p[10];
                        p[0] = s8 > 0 ? bf2f(pp[-1]) : 0.f; p[9] = s8 + 8 < SEQ ? bf2f(pp[8]) : 0.f;
                        p[1] = bflo(pv.x); p[2] = bfhi(pv.x); p[3] = bflo(pv.y); p[4] = bfhi(pv.y); p[5] = bflo(pv.z); p[6] = bfhi(pv.z); p[7] = bflo(pv.w); p[8] = bfhi(pv.w);
                        float z[8];
#pragma unroll
                        for (int j = 0; j < 8; ++j) z[j] = cb0 + w0 * p[j] + w1 * p[j + 1] + w2 * p[j + 2];
                        u32x4 w; w.x = cvt_pk_bf16(z[0], z[1]); w.y = cvt_pk_bf16(z[2], z[3]); w.z = cvt_pk_bf16(z[4], z[5]); w.w = cvt_pk_bf16(z[6], z[7]);
                        *(LAS u32x4*)(ZA + arr * 4 * ZS + HY_ZF(b, s8)) = w;
                    }
#pragma unroll 1
                    for (int o = 0; o < 2; ++o) {
                        const bf16_t* kf = (const bf16_t*)(ws + WS_KFL) + ((size_t)((l * 2 + 0) * 2 + o) * 256 + c) * SEQ;
                        const bf16_t* kb = (const bf16_t*)(ws + WS_KFL) + ((size_t)((l * 2 + 1) * 2 + o) * 256 + c) * SEQ;
                        { unsigned tv[16];
#pragma unroll
                          for (int q = 0; q < 16; ++q) { const int x = tid + 512 * q; tv[q] = x < 4096 ? kf[4095 - x] : (x <= 8190 ? kb[x - 4095] : (bf16_t)0); }
                          PIN16(tv);
#pragma unroll
                          for (int q = 0; q < 16; ++q) R0[tid + 512 * q] = (bf16_t)tv[q]; }
                        __syncthreads();
                        for (int x = tid; x < 8192; x += 512) R1[x] = x < 8191 ? R0[x + 1] : (bf16_t)0;
                        __syncthreads();
                        const LAS bf16_t* Z = ZA + (o == 0 ? 0 : 4 * ZS) + bq * ZS;
                        typedef float f32x16 __attribute__((ext_vector_type(16)));
                        f32x16 acc0, acc1;
#pragma unroll
                        for (int q = 0; q < 16; ++q) { acc0[q] = 0.f; acc1[q] = 0.f; }
                        const int dlo = 8 * wave - 63, dhi = 8 * wave + 7;
#define HY_AF(dst, off_) do { const LAS unsigned* a_ = ap + (off_); u32x4 w_ = {a_[0], a_[1], a_[2], a_[3]}; __builtin_memcpy(&dst, &w_, 16); } while (0)
                        {
                            bf16x8 f16, f24;
                            { const LAS unsigned* ap = Rdw + abase - 32 * dlo; HY_AF(f16, 16); HY_AF(f24, 24); }
#pragma unroll 1
                            for (int dl = dlo; dl <= dhi; ++dl) {
                                const int j = iblk - dl; const bool ok = (j >= 0) && (j < 64); const int jc = j < 0 ? 0 : (j > 63 ? 63 : j);
                                const LAS bf16_t* zp = Z + jc * 64; const int sw = (jc >> 1) & 1;
                                const LAS unsigned* ap = Rdw + abase - 32 * dl;
                                bf16x8 bf[4], fm16, fm8, f0, f8;
#pragma unroll
                                for (int kk = 0; kk < 4; ++kk) { bf16x8 t = *(const LAS bf16x8*)(zp + (((2 * kk + hh) ^ sw) << 3)); bf[kk] = ok ? t : (bf16x8){0, 0, 0, 0, 0, 0, 0, 0}; }
                                HY_AF(fm16, -16); HY_AF(fm8, -8); HY_AF(f0, 0); HY_AF(f8, 8);
                                acc0 = __builtin_amdgcn_mfma_f32_32x32x16_bf16(f0, bf[0], acc0, 0, 0, 0);  acc1 = __builtin_amdgcn_mfma_f32_32x32x16_bf16(fm16, bf[0], acc1, 0, 0, 0);
                                acc0 = __builtin_amdgcn_mfma_f32_32x32x16_bf16(f8, bf[1], acc0, 0, 0, 0);  acc1 = __builtin_amdgcn_mfma_f32_32x32x16_bf16(fm8, bf[1], acc1, 0, 0, 0);
                                acc0 = __builtin_amdgcn_mfma_f32_32x32x16_bf16(f16, bf[2], acc0, 0, 0, 0); acc1 = __builtin_amdgcn_mfma_f32_32x32x16_bf16(f0, bf[2], acc1, 0, 0, 0);
                                acc0 = __builtin_amdgcn_mfma_f32_32x32x16_bf16(f24, bf[3], acc0, 0, 0, 0); acc1 = __builtin_amdgcn_mfma_f32_32x32x16_bf16(f8, bf[3], acc1, 0, 0, 0);
                                f16 = fm16; f24 = fm8;
                            }
                        }
#undef HY_AF
                        const float inv = 1.0f / (nrm[(l * 2 + o) * 256 + c] + 1e-6f), hb = a.in[23][(l * 2 + o) * 256 + c];
                        LAS bf16_t* GI = ZA + (o + 1) * 4 * ZS;
                        const LAS bf16_t* ZI = ZA + (o == 0 ? 0 : 4 * ZS);
#pragma unroll
                        for (int q = 0; q < 16; ++q) {
                            const int a0r = (q & 3) + 8 * (q >> 2) + 4 * hh, t0 = 64 * iblk + a0r, t1 = t0 + 32;
                            const int i0 = HY_ZF(bq, t0), i1 = HY_ZF(bq, t1);
                            const float zv0 = bf2f(ZI[i0]), zv1 = bf2f(ZI[i1]);
                            const float y0 = bf2f(GI[i0]) * (acc0[q] * inv + hb * zv0), y1v = bf2f(GI[i1]) * (acc1[q] * inv + hb * zv1);
                            GI[i0] = f2bf(y0); GI[i1] = f2bf(y1v);
                        }
                        __syncthreads();
                    }
                    for (int it = tid; it < 4 * 512; it += 512) { const int b = it >> 9, s8 = (it & 511) * 8;
                        *(u32x4*)(YT + (size_t)c * RT + b * SEQ + s8) = *(const LAS u32x4*)(ZA + 2 * 4 * ZS + HY_ZF(b, s8)); }
                    if (l == 0) {
                        __syncthreads();
                        LAS float* zc = (LAS float*)lds;
                        LAS float* kc = zc + 3072;
                        LAS float* y1c = kc + 1024;
                        for (int it = tid; it < 3072; it += 512) { const int arr = it >> 10, b = (it >> 8) & 3, sx = it & 255, ch = arr * 256 + c;
                            const bf16_t* pp = PT + (size_t)ch * RT + RL + b * CTXL + sx;
                            float z = hcb[ch] + hcw[768 + ch] * bf2f(pp[0]); if (sx > 0) z += hcw[ch] * bf2f(pp[-1]); if (sx + 1 < CTXL) z += hcw[1536 + ch] * bf2f(pp[1]);
                            zc[it] = z; }
                        for (int it = tid; it < 1024; it += 512) { const int o = it >> 9, d = (it & 511) - 256;
                            const bf16_t* kfc = (const bf16_t*)(ws + WS_KFC) + ((size_t)(0 * 2 + o) * 256 + c) * CTXL; const bf16_t* kbc = (const bf16_t*)(ws + WS_KFC) + ((size_t)(1 * 2 + o) * 256 + c) * CTXL;
                            kc[it] = d >= 0 ? bf2f(kfc[d]) : (d > -256 ? bf2f(kbc[-d]) : 0.f); }
                        __syncthreads();
#pragma unroll 1
                        for (int o = 0; o < 2; ++o) {
                            const float inv = 1.0f / (nrm[1024 + o * 256 + c] + 1e-6f), hb = a.in[23][o * 256 + c];
                            for (int it = tid; it < 1024; it += 512) { const int b = it >> 8, t = it & 255;
                                const LAS float* zi = o == 0 ? zc + b * 256 : y1c + b * 256;
                                const LAS float* kk = kc + o * 512 + 256 + t;
                                float acc = 0.f;
#pragma unroll 16
                                for (int sx = 0; sx < CTXL; ++sx) acc += kk[-sx] * zi[sx];
                                const float y = zc[(o + 1) * 1024 + b * 256 + t] * (acc * inv + hb * zi[t]);
                                if (o == 0) y1c[it] = y; else YT[(size_t)c * RT + RL + b * CTXL + t] = f2bf(y); }
                            __syncthreads();
                        }
                    }
                }
#undef HY_ZF
                __syncthreads();
            }
            {
                const pg8::TabSched S{PARTS.p + 18 + l * 3, (const char*)ws, 1, 80, G, bid};
                pg8::EpiS5State E{(float*)(ws + WS_S5S)};
                pg8::gemm_phase<512, 256>(lds, S, E);
            }
        }
        SEAM(P0 + 2);
        if (((PHMASK >> 14) & 1) && IN(P0 + 3)) {
            const int tid = opaque(tid0), lane = tid & 63;
            LAS float* st = (LAS float*)lds;
            const float* S5S = (const float*)(ws + WS_S5S); bf16_t* US = (bf16_t*)(ws + WS_US);
            for (int u = bid; u < 128; u += G) {
                const int d = u & 1, g = (u >> 1) & 15, b = u >> 5;
                __syncthreads();
                for (int i = tid; i < 272 * 32; i += 512) { const int q = i >> 5, c4 = (i & 31) * 4; const int n = q < 16 ? 1024 + 16 * b + q : 256 * b + (q - 16);
                    const f32x4 v = *(const f32x4*)(S5S + ((size_t)g * NCHKP + n) * 256 + d * 128 + c4);
                    st[q * 128 + c4] = v[0]; st[q * 128 + c4 + 1] = v[1]; st[q * 128 + c4 + 2] = v[2]; st[q * 128 + c4 + 3] = v[3]; }
                __syncthreads();
                if (wave == 0) {
                    const float* ab = (const float*)(ws + WS_AB16) + ((size_t)((l * 2 + d) * 16 + g) * 64 + lane) * 2;
                    const float ar = ab[0], ai = ab[1];
                    float hr = 0.f, hi = 0.f;
                    for (int k = 0; k < 272; ++k) {
                        const int q = d == 0 ? k : (k < 16 ? 15 - k : 287 - k);
                        const int n = q < 16 ? 1024 + 16 * b + q : 256 * b + (q - 16);
                        *(unsigned*)(US + ((size_t)g * NCHKP + n) * 512 + 256 + d * 128 + 2 * lane) = cvt_pk_bf16(hr, hi);
                        const float sr = st[q * 128 + 2 * lane], si = st[q * 128 + 2 * lane + 1];
                        const float nr = ar * hr - ai * hi + sr, ni = ar * hi + ai * hr + si;
                        hr = nr; hi = ni;
                    }
                }
            }
            __syncthreads();
            for (int uq = bid; uq < 176; uq += G) { if (uq < 128) continue; const int u = uq - 128;
                const int cb6 = u % 6, d = (u / 6) & 1, b = u / 12;
                LAS f32x2* sa = (LAS f32x2*)lds;
                const f32x2* LAGG = (const f32x2*)(ws + WS_LAGG); float* HIN = (float*)(ws + WS_LHIN);
                __syncthreads();
                for (int i = tid; i < 272 * 64; i += 512) { const int q = i >> 6, c = i & 63; const int n = q < 16 ? 1024 + 16 * b + q : 256 * b + (q - 16);
                    sa[i] = LAGG[((size_t)n * 2 + d) * 384 + cb6 * 64 + c]; }
                __syncthreads();
                if (wave == 0) {
                    float h = 0.f;
                    for (int k = 0; k < 272; ++k) {
                        const int q = d == 0 ? k : (k < 16 ? 15 - k : 287 - k);
                        const int n = q < 16 ? 1024 + 16 * b + q : 256 * b + (q - 16);
                        HIN[((size_t)n * 2 + d) * 384 + cb6 * 64 + lane] = h;
                        const f32x2 v = sa[q * 64 + lane];
                        h = v[0] * h + v[1];
                    }
                }
            }
            __syncthreads();
        }
        SEAM(P0 + 3);
        if (((PHMASK >> 15) & 1) && IN(P0 + 4)) {
            const pg8::TabSched S{PARTS.p + 19 + l * 3, (const char*)ws, 1, 80, G, bid};
            pg8::EpiS5Main E{(bf16_t*)(ws + WS_GL), PR, a.in[32] + l * 256};
            pg8::gemm_phase<512, 512>(lds, S, E);
            {
                const int tid = opaque(tid0);
                const bf16_t* YT = (const bf16_t*)(ws + WS_YT);
                LAS bf16_t* tl = (LAS bf16_t*)lds;
                const int nrt = nMrow * 4;
                for (int t = bid; t < 4 * nrt; t += G) {
                    const int c0 = (t & 3) * 64, r0 = (t >> 2) * 64;
                    __syncthreads();
                    { const int cc = tid >> 3, r8 = (tid & 7) * 8; *(LAS u32x4*)(tl + cc * 72 + r8) = *(const u32x4*)(YT + (size_t)(c0 + cc) * RT + r0 + r8); }
                    __syncthreads();
                    { const int rr = tid >> 3, c8 = (tid & 7) * 8; unsigned short e[8];
#pragma unroll
                        for (int j = 0; j < 8; ++j) e[j] = tl[(c8 + j) * 72 + rr];
                        u32x4 w; w.x = e[0] | ((unsigned)e[1] << 16); w.y = e[2] | ((unsigned)e[3] << 16); w.z = e[4] | ((unsigned)e[5] << 16); w.w = e[6] | ((unsigned)e[7] << 16);
                        *(u32x4*)(YB + (size_t)(r0 + rr) * YW + YC_B + c0 + c8) = w; }
                }
                __syncthreads();
            }
            {
                const int tid = opaque(tid0);
                const bf16_t* LT = (const bf16_t*)(ws + WS_LT); const float* HIN = (const float*)(ws + WS_LHIN);
                const int nrows = nMrow * 256;
                for (int it = bid * 512 + tid; it < nrows * 48; it += G * 512) {
                    const int r = it / 48, c8 = (it - r * 48) * 8, n = r >> 4;
                    const u32x4 gt = *(const u32x4*)(PR + (size_t)r * LDP + PC_AG + c8);
                    const bf16_t* lt = LT + (size_t)r * 1152 + c8;
                    const u32x4 sv = *(const u32x4*)lt, pf = *(const u32x4*)(lt + 384), pb = *(const u32x4*)(lt + 768);
                    const float* hf = HIN + ((size_t)n * 2 + 0) * 384 + c8; const float* hb = hf + 384;
                    const f32x4 hf0 = *(const f32x4*)hf, hf1 = *(const f32x4*)(hf + 4), hb0 = *(const f32x4*)hb, hb1 = *(const f32x4*)(hb + 4);
                    u32x4 w;
                    w.x = cvt_pk_bf16(gelu_f(bflo(gt.x)) * (bflo(sv.x) + bflo(pf.x) * hf0[0] + bflo(pb.x) * hb0[0]), gelu_f(bfhi(gt.x)) * (bfhi(sv.x) + bfhi(pf.x) * hf0[1] + bfhi(pb.x) * hb0[1]));
                    w.y = cvt_pk_bf16(gelu_f(bflo(gt.y)) * (bflo(sv.y) + bflo(pf.y) * hf0[2] + bflo(pb.y) * hb0[2]), gelu_f(bfhi(gt.y)) * (bfhi(sv.y) + bfhi(pf.y) * hf0[3] + bfhi(pb.y) * hb0[3]));
                    w.z = cvt_pk_bf16(gelu_f(bflo(gt.z)) * (bflo(sv.z) + bflo(pf.z) * hf1[0] + bflo(pb.z) * hb1[0]), gelu_f(bfhi(gt.z)) * (bfhi(sv.z) + bfhi(pf.z) * hf1[1] + bfhi(pb.z) * hb1[1]));
                    w.w = cvt_pk_bf16(gelu_f(bflo(gt.w)) * (bflo(sv.w) + bflo(pf.w) * hf1[2] + bflo(pb.w) * hb1[2]), gelu_f(bfhi(gt.w)) * (bfhi(sv.w) + bfhi(pf.w) * hf1[3] + bfhi(pb.w) * hb1[3]));
                    *(u32x4*)(YB + (size_t)r * YW + YC_A + c8) = w;
                }
            }
        }
        SEAM(P0 + 4);
        if (((PHMASK >> 15) & 1) && IN(P0 + 5)) {
            const pg8::TabSched S{PARTS.p + 20 + l * 3, (const char*)ws, 1, nMrow, G, bid};
            pg8::EpiS5Glu E{YB, (const bf16_t*)(ws + WS_GL), a.in[34] + l * 256};
            pg8::gemm_phase<256, 256>(lds, S, E);
        }
        SEAM(P0 + 5);
        if (((PHMASK >> 3) & 1) && IN(P0 + 6)) {
            const pg8::MergeSched S{(const char*)ws, (long long)WS_YB, (long long)(WS_WL + (size_t)l * SZ_WL + SZ_WINR + SZ_WINHY), 64, G, bid, l == 0 ? 64 : 0};
            pg8::EpiGate E{ws + WS_GQ, UB, (bf16_t*)(ws + WS_MGC)};
            pg8::gemm_phase<1280, 1280>(lds, S, E);
        }
        SEAM(P0 + 6);
        if (((PHMASK >> 4) & 1) && IN(P0 + 7)) {
            const pg8::TabSched S{l == 0 ? PARTS.p + 24 : PARTS.p + 14, (const char*)ws, l == 0 ? 2 : 1, l == 0 ? 256 + 64 : 256, G, bid};
            pg8::EpiRes E{PRE, xlat, xctx, MODL + 2048, (float*)(ws + WS_EXTRA)};
            pg8::gemm_phase<1024, 1024>(lds, S, E);
        }
        SEAM(P0 + 7);
        if (((PHMASK >> 5) & 1) && IN(P0 + 8)) {
            const int lane = opaque(tid0) & 63;
            if (l == 1) convert_tiles_pipelined(a, JT_MOE, (LAS float*)lds, bid, G);
            const float* lg = a.in[40] + l * D; const float* lb = a.in[41] + l * D;
            const int nrows = nMrow * 256;
            for (int r = bid * 8 + wave; r < nrows; r += G * 8) {
                const float* mv = MODL + (size_t)(r < RL ? (r >> 12) : 4) * 6144;
                RowV pre;
                if (r < RL) { const RowV xin = row_load(xlat + (size_t)r * D, lane), ga = row_load_bf16((const bf16_t*)PRE + (size_t)r * D, lane);
#pragma unroll
                    for (int i = 0; i < 4; ++i) pre.v[i] = xin.v[i] * ALPHA + ga.v[i]; }
                else { const float* pp = (const float*)(ws + WS_EXTRA) + (size_t)(r - RL) * D; const RowV xin = row_load(ctx_in + (size_t)(r - RL) * D, lane), p0 = row_load(pp, lane), p1 = row_load(pp + (size_t)RC * D, lane), p2 = row_load(pp + (size_t)2 * RC * D, lane), p3 = row_load(pp + (size_t)3 * RC * D, lane);
#pragma unroll
                    for (int i = 0; i < 4; ++i) pre.v[i] = xin.v[i] * ALPHA + ((p0.v[i] + p1.v[i]) + (p2.v[i] + p3.v[i])); }
                const RowV x1 = row_affine(row_norm(pre), lg, lb, lane);
                row_store(r < RL ? a.out + (size_t)r * D : XSC + (size_t)(r - RL) * D, lane, x1);
                const RowV u2 = row_modulate(row_norm(x1), mv + 3072, mv + 4096, lane);
                row_store_bf16(UB + (size_t)r * D, lane, u2);
                if (l == 1) {
                    float lg8[8];
#pragma unroll
                    for (int e = 0; e < 8; ++e) lg8[e] = 0.f;
                    f32x4 rw[32];
#pragma unroll
                    for (int q = 0; q < 16; ++q) { const float* wp = a.in[47] + (size_t)(256 * (q >> 2) + 4 * lane + (q & 3)) * 8; rw[2 * q] = *(const f32x4*)wp; rw[2 * q + 1] = *(const f32x4*)(wp + 4); }
                    PIN16(rw); PIN16(rw + 16);
#pragma unroll
                    for (int i = 0; i < 4; ++i)
#pragma unroll
                        for (int j = 0; j < 4; ++j) { const float uv = u2.v[i][j];
                            const f32x4 w0 = rw[2 * (4 * i + j)], w1 = rw[2 * (4 * i + j) + 1];
                            lg8[0] += uv * w0[0]; lg8[1] += uv * w0[1]; lg8[2] += uv * w0[2]; lg8[3] += uv * w0[3]; lg8[4] += uv * w1[0]; lg8[5] += uv * w1[1]; lg8[6] += uv * w1[2]; lg8[7] += uv * w1[3]; }
#pragma unroll
                    for (int e = 0; e < 8; ++e) lg8[e] = wave_sum(lg8[e]);
                    if (lane == 0) {
                        int i1 = 0; float v1 = lg8[0];
#pragma unroll
                        for (int e = 1; e < 8; ++e) if (lg8[e] > v1) { v1 = lg8[e]; i1 = e; }
                        int i2 = 0; float v2 = -3.0e38f;
#pragma unroll
                        for (int e = 0; e < 8; ++e) if (e != i1 && lg8[e] > v2) { v2 = lg8[e]; i2 = e; }
                        const float e2 = expf(v2 - v1), w1 = 1.f / (1.f + e2), w2 = e2 / (1.f + e2);
                        int* tk = (int*)(ws + WS_TOK) + (size_t)r * 8;
                        tk[0] = i1; tk[1] = i2; ((float*)tk)[2] = w1; ((float*)tk)[3] = w2;
                        tk[4] = (int)atomicAdd(ctl + CW_MOECNT + 64 * i1, 1u); tk[5] = (int)atomicAdd(ctl + CW_MOECNT + 64 * i2, 1u);
                    }
                }
            }
        }
        SEAM(P0 + 8);
        if (l == 0) {
            if (((PHMASK >> 6) & 1) && IN(P0 + 9)) {
                const pg8::TabSched S{PARTS.p + 16, (const char*)ws, 1, 68 * 22, G, bid};
                pg8::EpiSwiglu E{(bf16_t*)(ws + WS_H), FF_DENSE, 0};
                pg8::gemm_phase<1024, 1024>(lds, S, E);
            }
            SEAM(P0 + 9);
            if (((PHMASK >> 7) & 1) && IN(P0 + 10)) {
                const pg8::TabSched S{PARTS.p + 26, (const char*)ws, 3, 256 + 48 + 16, G, bid};
                pg8::EpiRes E{PRE, a.out, XSC, MODL + 5120, (float*)(ws + WS_EXTRA)};
                pg8::gemm_phase<FF_DENSE, FF_DENSE>(lds, S, E);
            }
            SEAM(P0 + 10);
            if (((PHMASK >> 8) & 1) && IN(P0 + 11)) {
                const int lane = opaque(tid0) & 63;
                const float* lg = a.in[42]; const float* lb = a.in[43];
                const float* MODN = MOD + (size_t)5 * 6144;
                for (int r = bid * 8 + wave; r < RT; r += G * 8) {
                    const float* mv = MODN + (size_t)(r < RL ? (r >> 12) : 4) * 6144;
                    RowV pre;
                    if (r < RL) { const RowV xin = row_load(a.out + (size_t)r * D, lane), ga = row_load_bf16((const bf16_t*)PRE + (size_t)r * D, lane);
#pragma unroll
                        for (int i = 0; i < 4; ++i) pre.v[i] = xin.v[i] * ALPHA + ga.v[i]; }
                    else { const float* pp = (const float*)(ws + WS_EXTRA) + (size_t)(r - RL) * D; const RowV xin = row_load(XSC + (size_t)(r - RL) * D, lane), p0 = row_load(pp, lane), p1 = row_load(pp + (size_t)RC * D, lane), p2 = row_load(pp + (size_t)2 * RC * D, lane), p3 = row_load(pp + (size_t)3 * RC * D, lane);
#pragma unroll
                        for (int i = 0; i < 4; ++i) pre.v[i] = xin.v[i] * ALPHA + ((p0.v[i] + p1.v[i]) + (p2.v[i] + p3.v[i])); }
                    const RowV x2 = row_affine(row_norm(pre), lg, lb, lane);
                    row_store(r < RL ? a.out + (size_t)r * D : XSC + (size_t)(r - RL) * D, lane, x2);
                    row_store_bf16(UB + (size_t)r * D, lane, row_modulate(row_norm(x2), mv, mv + 1024, lane));
                }
            }
            SEAM(P0 + 11);
        } else {
            bf16_t* AG = (bf16_t*)(ws + WS_AG); float* slotw = (float*)(ws + WS_SLOTW); int* tile_e = (int*)(ws + WS_TILEE);
            if (((PHMASK >> 9) & 1) && IN(P0 + 9)) {
                const int tid = opaque(tid0), lane = tid & 63;
                int ts[NE + 1]; ts[0] = 0;
#pragma unroll
                for (int e = 0; e < NE; ++e) { const unsigned c = __hip_atomic_load(ctl + CW_MOECNT + 64 * e, __ATOMIC_RELAXED, __HIP_MEMORY_SCOPE_AGENT); ts[e + 1] = ts[e] + (int)((c + 255u) >> 8); }
                if (bid == 0) for (int mt = tid; mt < ts[NE]; mt += 512) { int e = 0;
#pragma unroll
                    for (int k = 1; k < NE; ++k) e += (mt >= ts[k]) ? 1 : 0;
                    tile_e[mt] = e; }
                for (int r = bid * 8 + wave; r < RL; r += G * 8) {
                    int* tk = (int*)(ws + WS_TOK) + (size_t)r * 8;
                    const u32x4 v0 = *(const u32x4*)(UB + (size_t)r * D + lane * 16), v1 = *(const u32x4*)(UB + (size_t)r * D + lane * 16 + 8);
#pragma unroll
                    for (int k = 0; k < 2; ++k) {
                        const int e = tk[k], pos = tk[4 + k];
                        int st = 0;
#pragma unroll
                        for (int q = 0; q < NE; ++q) st = (e == q) ? ts[q] : st;
                        const int srow = st * 256 + pos;
                        *(u32x4*)(AG + (size_t)srow * D + lane * 16) = v0; *(u32x4*)(AG + (size_t)srow * D + lane * 16 + 8) = v1;
                        if (lane == 0) { slotw[srow] = ((const float*)tk)[2 + k]; tk[6 + k] = srow; }
                    }
                }
            }
            SEAM(P0 + 9);
            int ttl = 0;
            if (lo <= P0 + 13 && P0 + 10 < hi) {
#pragma unroll
                for (int e = 0; e < NE; ++e) { const unsigned c = __hip_atomic_load(ctl + CW_MOECNT + 64 * e, __ATOMIC_RELAXED, __HIP_MEMORY_SCOPE_AGENT); ttl += (int)((c + 255u) >> 8); }
                ttl = __builtin_amdgcn_readfirstlane(ttl);
            }
#pragma unroll
            for (int pass = 0; pass < 2; ++pass) {
                const int tile0 = pass * MOE_P0; int ntile = pass == 0 ? (ttl < MOE_P0 ? ttl : MOE_P0) : ttl - MOE_P0; ntile = ntile < 0 ? 0 : (ntile > MOE_HCAP ? MOE_HCAP : ntile);
                if (((PHMASK >> 10) & 1) && IN(P0 + 10 + 2 * pass)) {
                    const pg8::MoeSched S{(const char*)AG + (size_t)tile0 * 256 * 1024 * 2, (const char*)(ws + WS_MOEGU), tile_e, 256u * 1024u * 2u, 256u * 1024u * 2u, (size_t)2 * FF_E * 1024 * 2, 28, 16, tile0, ntile, G, bid};
                    pg8::EpiSwiglu E{(bf16_t*)(ws + WS_HM), FF_E, tile0};
                    pg8::gemm_phase<1024, 1024>(lds, S, E);
                }
                SEAM(P0 + 10 + 2 * pass);
                if (((PHMASK >> 11) & 1) && IN(P0 + 11 + 2 * pass)) {
                    pg8::EpiMoeDown E{AG, slotw, (float*)(ws + WS_O2X)};
                    { const int nfull = pass == 0 ? ntile : (ttl < 128 ? ttl : 128) - MOE_P0, nex = pass == 0 ? 0 : ttl - 128;
                        const pg8::MoeTailSched S{(const char*)(ws + WS_HM), (const char*)(ws + WS_MOED), tile_e, tile0, nfull < 0 ? 0 : nfull, nex < 0 ? 0 : nex, G, bid};
                        pg8::gemm_phase<FF_E, FF_E>(lds, S, E); }
                }
                SEAM(P0 + 11 + 2 * pass);
            }
            if (((PHMASK >> 12) & 1) && IN(P0 + 14)) {
                const int lane = opaque(tid0) & 63;
                const float* lg = a.in[42] + D; const float* lb = a.in[43] + D;
                for (int r = bid * 8 + wave; r < RL; r += G * 8) {
                    const int* tk = (const int*)(ws + WS_TOK) + (size_t)r * 8;
                    const int sa = tk[6], sb = tk[7];
                    const bf16_t* oa = AG + (size_t)sa * D; const bf16_t* ob = AG + (size_t)sb * D;
                    const float* gv = MODL + (size_t)(r >> 12) * 6144 + 5120;
                    RowV x1 = row_load(a.out + (size_t)r * D, lane), gq = row_load(gv, lane), pre;
                    u32x2 va[4], vb[4];
#pragma unroll
                    for (int i = 0; i < 4; ++i) { va[i] = *(const u32x2*)(oa + 256 * i + 4 * lane); vb[i] = *(const u32x2*)(ob + 256 * i + 4 * lane); }
                    asm volatile("" : "+v"(va[0]), "+v"(va[1]), "+v"(va[2]), "+v"(va[3]), "+v"(vb[0]), "+v"(vb[1]), "+v"(vb[2]), "+v"(vb[3]), "+v"(x1.v[0]), "+v"(x1.v[1]), "+v"(x1.v[2]), "+v"(x1.v[3]), "+v"(gq.v[0]), "+v"(gq.v[1]), "+v"(gq.v[2]), "+v"(gq.v[3]));
#pragma unroll
                    for (int i = 0; i < 4; ++i) {
                        f32x4 fa = {bflo(va[i].x), bfhi(va[i].x), bflo(va[i].y), bfhi(va[i].y)}, fb = {bflo(vb[i].x), bfhi(vb[i].x), bflo(vb[i].y), bfhi(vb[i].y)};
                        if (sa >= 128 * 256) { const float* px = (const float*)(ws + WS_O2X) + (size_t)(sa - 128 * 256) * D + 256 * i + 4 * lane; fa = (*(const f32x4*)px + *(const f32x4*)(px + (size_t)2048 * D)) + (*(const f32x4*)(px + (size_t)2 * 2048 * D) + *(const f32x4*)(px + (size_t)3 * 2048 * D)); }
                        if (sb >= 128 * 256) { const float* px = (const float*)(ws + WS_O2X) + (size_t)(sb - 128 * 256) * D + 256 * i + 4 * lane; fb = (*(const f32x4*)px + *(const f32x4*)(px + (size_t)2048 * D)) + (*(const f32x4*)(px + (size_t)2 * 2048 * D) + *(const f32x4*)(px + (size_t)3 * 2048 * D)); }
                        pre.v[i] = x1.v[i] * ALPHA + gq.v[i] * (fa + fb); }
                    row_store(a.out + (size_t)r * D, lane, row_affine(row_norm(pre), lg, lb, lane));
                }
            }
        }
    }
#undef IN
#undef SEAM
}

}

extern "C" void kernel_launch(void* const* d_in, const int* in_sizes, int n_in, void* d_out, int out_size, void* d_ws, size_t ws_size, hipStream_t stream) {
    static int grid = 0;
    if (grid == 0) {
        if (n_in != 51 || ws_size < WS_END) { grid = -1; return; }
        int dev = 0, cus = 0;
        if (hipGetDevice(&dev) != hipSuccess || hipDeviceGetAttribute(&cus, hipDeviceAttributeMultiprocessorCount, dev) != hipSuccess) { grid = -1; return; }
        if (hipFuncSetAttribute((const void*)mk_fwd, hipFuncAttributeMaxDynamicSharedMemorySize, LDS_BYTES) != hipSuccess) { grid = -1; return; }
        grid = cus;
    }
    if (grid < 0) return;
    const float* const* in = (const float* const*)d_in;
    unsigned char* ws = (unsigned char*)d_ws;
    (void)hipMemsetAsync(ws + WS_CTL, 0, CTL_BYTES + al256(2 * 5 * 6144 * 4), stream);
    for (int l = 0; l < 2; ++l) (void)hipMemsetAsync(ws + WS_WL + (size_t)l * SZ_WL + SZ_WINR + (size_t)1152 * 1024 * 2, 0, (size_t)128 * 1024 * 2, stream);
    Args a{};
    for (int i = 0; i < 51; ++i) a.in[i] = in[i];
    a.out = (float*)d_out; a.ws = ws;
    int nlaunch = 0;
    auto run1 = [&](int lo, int hi) { a.ph_lo = lo; a.ph_hi = hi; a.bar_region = nlaunch < 5 ? nlaunch : 5; nlaunch++; hipLaunchKernelGGL(mk_fwd, dim3(grid), dim3(512), LDS_BYTES, stream, a); };
    auto run = [&](int lo, int hi) {
#if defined(SPLIT) && SPLIT
        for (int k = lo; k < hi; ++k) { const int q = (k - 1) % NPH_LAYER, l = (k - 1) / NPH_LAYER; if (k > 0 && (q > 14 || (l == 0 && q > 11) || (l == 1 && q == 0))) continue; run1(k, k + 1); }
#else
        run1(lo, hi);
#endif
    };
    run(0, 1 + 2 * NPH_LAYER);
}
```

```cpp
#include <hip/hip_runtime.h>
#include <stdint.h>
#include <math.h>

#define LAS __attribute__((address_space(3)))
typedef unsigned short bf16_t;
typedef short bf16x8 __attribute__((ext_vector_type(8)));
typedef float f32x4 __attribute__((ext_vector_type(4)));
typedef float f32x2 __attribute__((ext_vector_type(2)));
typedef unsigned u32x4 __attribute__((ext_vector_type(4)));
typedef unsigned u32x2 __attribute__((ext_vector_type(2)));

namespace {
constexpr int D = 1024, NB = 4, SEQ = 4096, CTXL = 256;
constexpr int RL = NB * SEQ, RC = NB * CTXL, RT = RL + RC;
constexpr int IN_COLS = 7040;
constexpr int FF_DENSE = 2816, NE = 8, FF_E = 3584;
constexpr float ALPHA = 1.41421356237309515f;
constexpr int LDP = 1792, PC_AG = 0, PC_AC = 384, PC_D = 768, PC_Q = 1024, PC_K = 1408, PC_G = 1792;
constexpr int NPT = 1280, PT_V = 768;
constexpr int YW = 1280, YC_A = 0, YC_B = 384, YC_C = 640, YC_D = 1024;
constexpr int MOE_P0 = 64, MOE_HCAP = 72;
constexpr int MOE_ROWS_MAX = 2 * RL + NE * 256;

constexpr size_t al256(size_t x) { return (x + 255) & ~(size_t)255; }
constexpr size_t WS_CTL = 0, CTL_BYTES = 131072;
constexpr int CW_BAR = 0;
constexpr int CW_MOECNT = 24576;
constexpr int CW_QUEUE = 28672;
constexpr int CW_HYN = 29696;
constexpr size_t WS_MOD = WS_CTL + CTL_BYTES;
constexpr size_t WS_HYN = WS_MOD + al256(2 * 5 * 6144 * 4);
constexpr size_t WS_S5AB = WS_HYN + 4096;
constexpr size_t WS_S5BB = WS_S5AB + 16384;
constexpr size_t WS_AB16 = WS_S5BB + 262144;
constexpr size_t WS_TILEE = WS_AB16 + 32768;
constexpr size_t WS_TOK = WS_TILEE + 1024;
constexpr size_t WS_SLOTW = WS_TOK + (size_t)RL * 32;
constexpr size_t WS_KFL = al256(WS_SLOTW + (size_t)MOE_ROWS_MAX * 4);
constexpr size_t WS_KFC = WS_KFL + (size_t)2 * 1024 * SEQ * 2;
constexpr size_t WS_XSC = WS_KFC + (size_t)1024 * CTXL * 2;
constexpr size_t WS_UB = WS_XSC + (size_t)RC * D * 4;
constexpr size_t SZ_WINR = (size_t)(1792 + 4096) * 1024 * 2, SZ_WINHY = (size_t)NPT * 1024 * 2, SZ_WBR = (size_t)1024 * 1280 * 2, SZ_WOUT = (size_t)1024 * 1024 * 2;
constexpr size_t SZ_WL = SZ_WINR + SZ_WINHY + SZ_WBR + SZ_WOUT;
constexpr size_t WS_WL = WS_UB + (size_t)RT * D * 2;
constexpr size_t WS_FFGU = WS_WL + 2 * SZ_WL;
constexpr size_t WS_FFD = WS_FFGU + (size_t)2 * FF_DENSE * 1024 * 2;
constexpr size_t WS_WGLU = WS_FFD + (size_t)1024 * FF_DENSE * 2;
constexpr size_t WS_OPS = WS_WGLU + (size_t)2 * 256 * 256 * 2;
constexpr size_t WS_OPY = WS_OPS + (size_t)32 * 256 * 256 * 2;
constexpr size_t WS_LW = WS_OPY + (size_t)32 * 256 * 512 * 2;
constexpr size_t WS_PR = WS_LW + (size_t)48 * 4096 * 2;
constexpr size_t WS_PT = WS_PR + (size_t)RT * 5888 * 2;
constexpr size_t WS_GQ = WS_PR + (size_t)RT * LDP * 2;
constexpr size_t WS_YB = WS_PT + (size_t)NPT * RT * 2;
constexpr size_t WS_PRE = WS_YB + (size_t)RT * YW * 2;
constexpr size_t WS_EXTRA = WS_PRE + (size_t)RT * D * 4;
constexpr size_t SZ_EXTRA = (size_t)2 * RT * 384 * 4 + (size_t)RT * 256 * 4;
constexpr size_t WS_END = WS_EXTRA + SZ_EXTRA;
constexpr int NCHK = RT / 16, NCHKP = 1280;
constexpr size_t WS_US = WS_PRE;
constexpr size_t WS_S5S = WS_US + (size_t)16 * NCHKP * 512 * 2;
constexpr size_t WS_GL = WS_S5S + (size_t)16 * NCHKP * 256 * 4;
static_assert(WS_GL + (size_t)RT * 256 * 2 <= WS_EXTRA, "s5 overlay");
constexpr size_t WS_H = WS_PR;
constexpr size_t WS_MOEGU = WS_PR;
constexpr size_t WS_MOED = WS_MOEGU + (size_t)NE * 2 * FF_E * 1024 * 2;
constexpr size_t WS_HM = WS_MOED + (size_t)NE * 1024 * FF_E * 2;
constexpr size_t WS_LT = WS_EXTRA;
constexpr size_t WS_LAGG = WS_LT + (size_t)RT * 3 * 384 * 2;
constexpr size_t WS_LHIN = WS_LAGG + (size_t)NCHK * 2 * 384 * 8;
constexpr size_t WS_YT = WS_LHIN + (size_t)NCHK * 2 * 384 * 4;
static_assert(WS_YT + (size_t)256 * RT * 2 <= WS_EXTRA + SZ_EXTRA, "lru / hyena overlay");
constexpr size_t WS_MGC = WS_EXTRA + (size_t)4 * RC * D * 4;
constexpr size_t WS_AG = WS_EXTRA;
static_assert(WS_HM + (size_t)MOE_HCAP * 256 * FF_E * 2 <= WS_EXTRA, "moe hidden overlay");
constexpr size_t WS_O2X = WS_PRE + ((size_t)32 << 20);
static_assert(WS_HM + (size_t)MOE_HCAP * 256 * FF_E * 2 <= WS_O2X && WS_O2X + (size_t)4 * 2048 * D * 4 <= WS_EXTRA, "moe excess sums");
static_assert((size_t)MOE_ROWS_MAX * 1024 * 2 <= SZ_EXTRA, "moe gather overlay");
static_assert((size_t)RT * FF_DENSE * 2 <= (size_t)RT * 5888 * 2 && WS_GQ + (size_t)RT * 4096 <= WS_PT, "dense hidden overlay / gate bytes");

__device__ __forceinline__ float sigm(float x) { return __builtin_amdgcn_rcpf(1.f + __builtin_amdgcn_exp2f(-1.44269504089f * x)); }
__device__ __forceinline__ float sigm_acc(float x) { return 1.f / (1.f + expf(-x)); }
__device__ __forceinline__ float silu_acc(float x) { return x / (1.f + expf(-x)); }
__device__ __forceinline__ float gelu_t(float x) { return 0.5f * x * (1.f + tanhf(0.7978845608028654f * (x + 0.044715f * x * x * x))); }
__device__ __forceinline__ float gelu_f(float x) { return x * sigm(1.5957691216057308f * (x + 0.044715f * x * x * x)); }
__device__ __forceinline__ float softplus(float x) { return fmaxf(x, 0.f) + log1pf(expf(-fabsf(x))); }
__device__ __forceinline__ float wave_sum(float v) { for (int o = 32; o; o >>= 1) v += __shfl_xor(v, o); return v; }
__device__ __forceinline__ float wave_max(float v) { for (int o = 32; o; o >>= 1) v = fmaxf(v, __shfl_xor(v, o)); return v; }
__device__ __forceinline__ float bf2f(bf16_t b) { return __uint_as_float(((unsigned)b) << 16); }
__device__ __forceinline__ bf16_t f2bf(float f) { unsigned u = __float_as_uint(f); u += 0x7FFFu + ((u >> 16) & 1u); return (bf16_t)(u >> 16); }
__device__ __forceinline__ unsigned cvt_pk_bf16(float lo, float hi) { unsigned r; asm volatile("v_cvt_pk_bf16_f32 %0, %1, %2" : "=v"(r) : "v"(lo), "v"(hi)); return r; }
__device__ __forceinline__ float bflo(unsigned w) { return __uint_as_float(w << 16); }
__device__ __forceinline__ float bfhi(unsigned w) { return __uint_as_float(w & 0xFFFF0000u); }
__device__ __forceinline__ void row_seq(int r, int& start, int& len, int& pos, int& b) {
    if (r < RL) { b = r >> 12; start = b << 12; len = SEQ; pos = r & 4095; }
    else { const int q = r - RL; b = q >> 8; start = RL + (b << 8); len = CTXL; pos = q & 255; }
}

#define XB_TMO      128
#define XB_XCNT(j)  (256  + 64 * (j))
#define XB_XSUB(j)  (1280 + 64 * (j))
#define XB_XGEN(j)  (2304 + 64 * (j))
#define XB_TOP      3328
#define XB_TOPGEN   3392
#define XCD_BAR_WORDS 3456
#define XB_SPIN_CAP (1u << 18)
__device__ __forceinline__ unsigned xb_ld(unsigned* p)              { return __hip_atomic_load(p, __ATOMIC_RELAXED, __HIP_MEMORY_SCOPE_AGENT); }
__device__ __forceinline__ unsigned xb_add(unsigned* p, unsigned v) { return __hip_atomic_fetch_add(p, v, __ATOMIC_RELAXED, __HIP_MEMORY_SCOPE_AGENT); }
__device__ __forceinline__ unsigned xb_xcc_id() { return (unsigned)__builtin_amdgcn_s_getreg((3 << 11) | 20) & 0xFu; }
#define XB_SPIN(cond, bar) do { unsigned _sp = 0; while (cond) { __builtin_amdgcn_s_sleep(1); \
    if ((++_sp & 255u) == 0u) { if (xb_ld(&(bar)[XB_TMO])) break; if (_sp > XB_SPIN_CAP) { atomicAdd(&(bar)[XB_TMO], 1u); break; } } } } while (0)
struct XcdBarrier { unsigned* bar; unsigned x; volatile LAS unsigned* st; };
__device__ __forceinline__ XcdBarrier xcd_barrier_post(unsigned* bar, volatile LAS unsigned* st) {
    XcdBarrier b; b.bar = bar; b.x = xb_xcc_id(); b.st = st;
    if (threadIdx.x == 0) (void)xb_add(&bar[XB_XCNT(b.x)], 1u);
    return b;
}
__device__ __forceinline__ void xcd_barrier_complete(unsigned* bar, unsigned x, unsigned& nloc, unsigned& nx) {
    const unsigned G = gridDim.x * gridDim.y * gridDim.z;
    unsigned sum, cnt, mine, sp = 0u;
    for (;;) {
        sum = 0u; cnt = 0u; mine = 0u;
#pragma unroll
        for (unsigned j = 0; j < 16; ++j) { const unsigned c = xb_ld(&bar[XB_XCNT(j)]); sum += c; cnt += (c > 0u) ? 1u : 0u; mine = (j == x) ? c : mine; }
        if (sum == G) break;
        __builtin_amdgcn_s_sleep(1);
        if ((++sp & 255u) == 0u) { if (xb_ld(&bar[XB_TMO])) break; if (sp > XB_SPIN_CAP) { atomicAdd(&bar[XB_TMO], 1u); break; } }
    }
    nloc = mine > 0u ? mine : 1u; nx = cnt > 0u ? cnt : 1u;
}
__device__ __forceinline__ void xcd_barrier(const XcdBarrier& b) {
    asm volatile("s_waitcnt vmcnt(0)" ::: "memory");
    __syncthreads();
    if (threadIdx.x == 0) {
        unsigned* bar = b.bar;
        __builtin_amdgcn_s_waitcnt(0);
        unsigned nloc = b.st[0], nx = b.st[1];
        if (nloc == 0u) { xcd_barrier_complete(bar, b.x, nloc, nx); b.st[0] = nloc; b.st[1] = nx; }
        const unsigned old = xb_add(&bar[XB_XSUB(b.x)], 1u);
        const unsigned gen = old / nloc;
        if (old + 1u == (gen + 1u) * nloc) {
            __builtin_amdgcn_fence(__ATOMIC_RELEASE, "agent");
            asm volatile("s_waitcnt vmcnt(0)" ::: "memory");
            const unsigned og = xb_add(&bar[XB_TOP], 1u);
            const unsigned tg = og / nx;
            if (og + 1u == (tg + 1u) * nx) xb_add(&bar[XB_TOPGEN], 1u);
            else XB_SPIN(xb_ld(&bar[XB_TOPGEN]) == tg, bar);
            __builtin_amdgcn_fence(__ATOMIC_ACQUIRE, "agent");
            xb_add(&bar[XB_XGEN(b.x)], 1u);
            asm volatile("s_waitcnt vmcnt(0)" ::: "memory");
        } else {
            XB_SPIN(xb_ld(&bar[XB_XGEN(b.x)]) == gen, bar);
            __builtin_amdgcn_fence(__ATOMIC_ACQUIRE, "agent");
            asm volatile("s_waitcnt vmcnt(0)" ::: "memory");
        }
    }
    __syncthreads();
}

namespace pg8 {
constexpr int BM = 256, BK = 64, HALF = 128, HTB = HALF * BK * 2, STAGE_BYTES = 8 * HTB, NXCD = 8, WGM = 8;
__host__ __device__ __forceinline__ int lds_byte(int r, int c) { const int st = (r >> 4) * 2 + (c >> 5), rr = r & 15, cc = c & 31, ob = rr * 64 + cc * 2; return st * 1024 + (ob ^ (((ob >> 9) & 1) << 5)); }
__host__ __device__ __forceinline__ void stage_rc(int b, int& R, int& C) { const int st = b / 1024, sb = b % 1024, swz = sb ^ (((sb >> 9) & 1) << 5); R = (st >> 1) * 16 + swz / 64; C = (st & 1) * 32 + (swz % 64) / 2; }
__host__ __device__ __forceinline__ int perm32(int rho) { const int n = rho >> 4, i = rho & 15; return 8 * (i >> 2) + 4 * n + (i & 3); }

struct Unit { const char* a; const char* b; int nt; int pm, pn, kind; };

__device__ __forceinline__ void rect_map(int wgid, int nM, int nN, int& pm, int& pn) {
    const int nwg = nM * nN;
    { const int q = nwg / NXCD, r = nwg % NXCD, xcd = wgid % NXCD, off = wgid / NXCD; wgid = (xcd < r ? xcd * (q + 1) : r * (q + 1) + (xcd - r) * q) + off; }
    const int nig = WGM * nN, gid = wgid / nig, fm = gid * WGM, gsz = (nM - fm) < WGM ? (nM - fm) : WGM;
    pm = fm + ((wgid % nig) % gsz); pn = (wgid % nig) / gsz;
}

template <int lda, int ldb, class Epi, class Sched>
__device__ __forceinline__ void gemm_phase(LAS unsigned char* lds, const Sched& S, const Epi& E) {
    int tid_ = threadIdx.x; asm volatile("" : "+v"(tid_));
    const int tid = tid_, wid = __builtin_amdgcn_readfirstlane(tid >> 6), lane = tid & 63, wr = wid >> 2, wc = wid & 3, fr = lane & 15, fq = lane >> 4;
    unsigned voffA[2], voffB[2];
#pragma unroll
    for (int i = 0; i < 2; ++i) { int R, C; stage_rc(tid * 16 + i * 8192, R, C); const int Rb = (R & ~31) + perm32(R & 31);
        voffA[i] = (unsigned)(R * lda + C) * 2u; voffB[i] = (unsigned)(Rb * ldb + C) * 2u; }
    const size_t kstep = (size_t)(BK * 2);
    const size_t hstepA = (size_t)HALF * lda * 2, hstepB = (size_t)HALF * ldb * 2;
    const unsigned ldsw = (unsigned)wid * 1024u;
    const int aoff = lds_byte(wr * 64 + fr, fq * 8), boff = lds_byte(wc * 32 + fr, fq * 8);
#define PG8_SA(b, h) (((b) * 2 + (h)) * HTB)
#define PG8_SB(b, h) ((4 + (b) * 2 + (h)) * HTB)
#define PG8_STAGE(bufoff, gbase, voff) do { _Pragma("unroll") for (int _i = 0; _i < 2; ++_i) \
        __builtin_amdgcn_global_load_lds((const unsigned*)((const char*)(gbase) + (voff)[_i]), (LAS unsigned*)(lds + (bufoff) + ldsw + _i * 8192), 16, 0, 0); } while (0)
#define PG8_LDA(dst, b, h) do { _Pragma("unroll") for (int m = 0; m < 4; ++m) _Pragma("unroll") for (int k = 0; k < 2; ++k) dst[m][k] = *(const LAS bf16x8*)(lds + PG8_SA(b, h) + aoff + m * 2048 + k * 1024); } while (0)
#define PG8_LDB(dst, b, h) do { _Pragma("unroll") for (int n = 0; n < 2; ++n) _Pragma("unroll") for (int k = 0; k < 2; ++k) dst[n][k] = *(const LAS bf16x8*)(lds + PG8_SB(b, h) + boff + n * 2048 + k * 1024); } while (0)
#define PG8_MMA(ai, bj, At, Bt) do { __builtin_amdgcn_s_setprio(1); _Pragma("unroll") for (int m = 0; m < 4; ++m) _Pragma("unroll") for (int n = 0; n < 2; ++n) _Pragma("unroll") for (int k = 0; k < 2; ++k) \
        acc[ai][bj][m][n] = __builtin_amdgcn_mfma_f32_16x16x32_bf16(Bt[n][k], At[m][k], acc[ai][bj][m][n], 0, 0, 0); __builtin_amdgcn_s_setprio(0); } while (0)
#define PG8_WAIT_V(n) asm volatile("s_waitcnt vmcnt(" #n ")" ::: "memory")
#define PG8_WAIT_L(n) asm volatile("s_waitcnt lgkmcnt(" #n ")" ::: "memory")
#define PG8_BAR __builtin_amdgcn_s_barrier()
#define PG8_SCHED __builtin_amdgcn_sched_barrier(0)
    Unit cur, nxt; int ui = 0;
    if (!S.next(0, cur)) return;
    f32x4 acc[2][2][4][2];
#pragma unroll
    for (int a = 0; a < 2; ++a)
#pragma unroll
        for (int b = 0; b < 2; ++b)
#pragma unroll
            for (int m = 0; m < 4; ++m)
#pragma unroll
                for (int n = 0; n < 2; ++n) acc[a][b][m][n] = (f32x4){0.f, 0.f, 0.f, 0.f};
    bf16x8 At[4][2], B0[2][2], B1[2][2];
    const char* cA = cur.a; const char* cB = cur.b;
    PG8_STAGE(PG8_SB(0, 0), cB, voffB); PG8_STAGE(PG8_SA(0, 0), cA, voffA); PG8_STAGE(PG8_SB(0, 1), cB + hstepB, voffB); PG8_STAGE(PG8_SA(0, 1), cA + hstepA, voffA);
    if (wr == 1) PG8_BAR;
    PG8_WAIT_V(4); PG8_BAR;
    PG8_STAGE(PG8_SB(1, 0), cB + kstep, voffB); PG8_STAGE(PG8_SA(1, 0), cA + kstep, voffA); PG8_STAGE(PG8_SB(1, 1), cB + hstepB + kstep, voffB);
    PG8_WAIT_V(6); PG8_BAR;
    for (;;) {
        const bool has_next = S.next(ui + 1, nxt);
        const char* nA = has_next ? nxt.a : cA; const char* nB = has_next ? nxt.b : cB;
        const int nt = cur.nt;
        for (int t = 0; t < nt; t += 2) {
            const bool last = (t == nt - 2);
            const char* a1 = cA + (size_t)(t + 1) * kstep;
            const char* a2 = last ? nA : cA + (size_t)(t + 2) * kstep; const char* b2 = last ? nB : cB + (size_t)(t + 2) * kstep;
            const char* a3 = a2 + kstep; const char* b3 = b2 + kstep;
            PG8_LDB(B0, 0, 0); PG8_SCHED; PG8_LDA(At, 0, 0); PG8_STAGE(PG8_SA(1, 1), a1 + hstepA, voffA);
            PG8_WAIT_L(8); PG8_BAR; PG8_WAIT_L(0); PG8_MMA(0, 0, At, B0); PG8_BAR; PG8_SCHED;
            PG8_LDB(B1, 0, 1); PG8_STAGE(PG8_SB(0, 0), b2, voffB);
            PG8_BAR; PG8_WAIT_L(0); PG8_MMA(0, 1, At, B1); PG8_BAR;
            PG8_LDA(At, 0, 1); PG8_STAGE(PG8_SA(0, 0), a2, voffA);
            PG8_BAR; PG8_WAIT_L(0); PG8_MMA(1, 0, At, B0); PG8_BAR; PG8_SCHED;
            PG8_STAGE(PG8_SB(0, 1), b2 + hstepB, voffB);
            PG8_WAIT_V(6); PG8_BAR; PG8_MMA(1, 1, At, B1); PG8_BAR;
            PG8_LDB(B0, 1, 0); PG8_SCHED; PG8_LDA(At, 1, 0); PG8_STAGE(PG8_SA(0, 1), a2 + hstepA, voffA);
            PG8_WAIT_L(8); PG8_BAR; PG8_WAIT_L(0); PG8_MMA(0, 0, At, B0); PG8_BAR; PG8_SCHED;
            PG8_LDB(B1, 1, 1); PG8_STAGE(PG8_SB(1, 0), b3, voffB);
            PG8_BAR; PG8_WAIT_L(0); PG8_MMA(0, 1, At, B1); PG8_BAR;
            PG8_LDA(At, 1, 1); PG8_STAGE(PG8_SA(1, 0), a3, voffA);
            PG8_BAR; PG8_WAIT_L(0); PG8_MMA(1, 0, At, B0); PG8_BAR; PG8_SCHED;
            PG8_STAGE(PG8_SB(1, 1), b3 + hstepB, voffB);
            PG8_WAIT_V(6); PG8_BAR; PG8_MMA(1, 1, At, B1); PG8_BAR;
        }
        E(acc, cur, wr, wc, fr, fq);
        if (!has_next) break;
#pragma unroll
        for (int a = 0; a < 2; ++a)
#pragma unroll
            for (int b = 0; b < 2; ++b)
#pragma unroll
                for (int m = 0; m < 4; ++m)
#pragma unroll
                    for (int n = 0; n < 2; ++n) acc[a][b][m][n] = (f32x4){0.f, 0.f, 0.f, 0.f};
        cur = nxt; cA = nA; cB = nB; ++ui;
    }
    PG8_WAIT_V(0);
    if (wr == 0) PG8_BAR;
    PG8_BAR;
#undef PG8_SA
#undef PG8_SB
#undef PG8_STAGE
#undef PG8_LDA
#undef PG8_LDB
#undef PG8_MMA
#undef PG8_WAIT_V
#undef PG8_WAIT_L
#undef PG8_BAR
#undef PG8_SCHED
}

struct PartC { long long aOff, bOff; unsigned aStep, bStep; int nM, nN, nt, kind, start, nGrp; unsigned aGrp, bGrp; };
struct TabSched {
    const PartC* parts; const char* ws; int np, total, G, c;
    __device__ __forceinline__ bool next(int i, Unit& u) const {
        const int L = i * G + c; if (L >= total) return false;
        int q = 0;
#pragma unroll
        for (int k = 1; k < 4; ++k) if (k < np && L >= parts[k].start) q = k;
        const PartC P = parts[q];
        const int per = P.nM * P.nN, idx = L - P.start, grp = idx / per;
        int pm, pn; rect_map(idx - grp * per, P.nM, P.nN, pm, pn);
        u.a = ws + P.aOff + (size_t)grp * P.aGrp + (size_t)pm * P.aStep; u.b = ws + P.bOff + (size_t)grp * P.bGrp + (size_t)pn * P.bStep; u.nt = P.nt; u.pm = pm; u.pn = pn; u.kind = P.kind + grp; return true;
    }
};
struct MergeSched {
    const char* ws; long long aOff, bOff; int nM, G, c;
    int nCtx;
    __device__ __forceinline__ bool next(int i, Unit& u) const {
        int T = (i >> 2) * G + c, br = i & 3; bool ctxu = false;
        if (T >= nM * 4) {
            const int j = (i - 4 * ((nM * 4 - c + G - 1) / G)) * G + c;
            if (j < 0 || j >= nCtx) return false;
            T = nM * 4 + (j >> 2); br = j & 3; ctxu = true;
        }
        int pm, pn;
        if (!ctxu) rect_map(T, nM, 4, pm, pn); else { const int t = T - nM * 4; pm = nM + (t >> 2); pn = t & 3; }
        const int ko = br == 0 ? 0 : (br == 1 ? 384 : (br == 2 ? 640 : 1024));
        u.a = ws + aOff + (size_t)pm * (256u * 1280u * 2u) + ko * 2; u.b = ws + bOff + (size_t)pn * (256u * 1280u * 2u) + ko * 2; u.nt = (br & 1) ? 4 : 6; u.pm = pm; u.pn = pn; u.kind = ctxu ? 4 + br : br; return true;
    }
};
struct MoeSched {
    const char* A; const char* B; const int* tile_e; unsigned aStep, bStep; size_t bExp; int nN, nt, tile0, ntile, G, c;
    __device__ __forceinline__ bool next(int i, Unit& u) const {
        const int L = i * G + c; if (L >= ntile * nN) return false;
        const int mt = tile0 + L / nN, pn = L % nN;
        const int e = __builtin_amdgcn_readfirstlane(__hip_atomic_load(tile_e + mt, __ATOMIC_RELAXED, __HIP_MEMORY_SCOPE_AGENT));
        u.a = A + (size_t)(mt - tile0) * aStep; u.b = B + (size_t)e * bExp + (size_t)pn * bStep; u.nt = nt; u.pm = mt; u.pn = pn; u.kind = e; return true;
    }
};

struct MoeTailSched {
    const char* A; const char* B; const int* tile_e; int tile0, nfull, nex, G, c;
    __device__ __forceinline__ bool next(int i, Unit& u) const {
        const int L = i * G + c; int mt, pn, nt = 56, flag = 0; size_t koff = 0;
        if (L < nfull * 4) { mt = tile0 + (L >> 2); pn = L & 3; }
        else { const int idx = L - nfull * 4; if (idx >= nex * 16) return false; const int sp = idx & 3, tu = idx >> 2; mt = 128 + (tu >> 2); pn = tu & 3; nt = 14; koff = (size_t)sp * 14 * 128; flag = 8 + 16 * sp; }
        const int e = __builtin_amdgcn_readfirstlane(__hip_atomic_load(tile_e + mt, __ATOMIC_RELAXED, __HIP_MEMORY_SCOPE_AGENT));
        u.a = A + (size_t)(mt - tile0) * (256u * (unsigned)FF_E * 2u) + koff; u.b = B + (size_t)e * ((size_t)1024 * FF_E * 2) + (size_t)pn * (256u * (unsigned)FF_E * 2u) + koff;
        u.nt = nt; u.pm = mt; u.pn = pn; u.kind = e | flag; return true;
    }
};

#define EPI_ROWS(u) const int row0 = (u).pm * BM + wr * 64 + fr, colt = wc * 32 + 8 * fq
struct EpiProj {
    bf16_t* PRp; bf16_t* PTp; bf16_t* USp; int sig_from; unsigned char* GQp;
    __device__ __forceinline__ void operator()(const f32x4 (&acc)[2][2][4][2], const Unit& u, int wr, int wc, int fr, int fq) const {
        EPI_ROWS(u);
        bf16_t* base = u.kind == 1 ? PTp : PRp; const int ldc = u.kind == 1 ? RT : LDP; const bool sg = (u.kind == 0 && u.pn >= sig_from);
        if (sg) {
#pragma unroll
            for (int ai = 0; ai < 2; ++ai)
#pragma unroll
                for (int m = 0; m < 4; ++m) { unsigned char* rowp = GQp + (size_t)(row0 + ai * HALF + m * 16) * 4096 + (u.pn - sig_from) * BM + colt;
#pragma unroll
                    for (int bj = 0; bj < 2; ++bj) { const f32x4 v0 = acc[ai][bj][m][0], v1 = acc[ai][bj][m][1];
                        unsigned lo = 0u, hi = 0u;
                        lo = __builtin_amdgcn_cvt_pk_u8_f32(sigm(v0[0]) * 255.0f, 0, lo); lo = __builtin_amdgcn_cvt_pk_u8_f32(sigm(v0[1]) * 255.0f, 1, lo); lo = __builtin_amdgcn_cvt_pk_u8_f32(sigm(v0[2]) * 255.0f, 2, lo); lo = __builtin_amdgcn_cvt_pk_u8_f32(sigm(v0[3]) * 255.0f, 3, lo);
                        hi = __builtin_amdgcn_cvt_pk_u8_f32(sigm(v1[0]) * 255.0f, 0, hi); hi = __builtin_amdgcn_cvt_pk_u8_f32(sigm(v1[1]) * 255.0f, 1, hi); hi = __builtin_amdgcn_cvt_pk_u8_f32(sigm(v1[2]) * 255.0f, 2, hi); hi = __builtin_amdgcn_cvt_pk_u8_f32(sigm(v1[3]) * 255.0f, 3, hi);
                        *(u32x2*)(rowp + bj * HALF) = (u32x2){lo, hi}; } }
            return;
        }
#pragma unroll
        for (int ai = 0; ai < 2; ++ai)
#pragma unroll
            for (int m = 0; m < 4; ++m) { bf16_t* rowp = base + (size_t)(row0 + ai * HALF + m * 16) * ldc + u.pn * BM + colt;
#pragma unroll
                for (int bj = 0; bj < 2; ++bj) { f32x4 v0 = acc[ai][bj][m][0], v1 = acc[ai][bj][m][1];
                    if (sg) {
#pragma unroll
                        for (int j = 0; j < 4; ++j) { v0[j] = sigm(v0[j]); v1[j] = sigm(v1[j]); } }
                    u32x4 w; w.x = cvt_pk_bf16(v0[0], v0[1]); w.y = cvt_pk_bf16(v0[2], v0[3]); w.z = cvt_pk_bf16(v1[0], v1[1]); w.w = cvt_pk_bf16(v1[2], v1[3]);
                    *(u32x4*)(rowp + bj * HALF) = w;
                    if (u.kind == 0 && u.pn == 3) { const int r = row0 + ai * HALF + m * 16, cc = colt + bj * HALF;
                        *(u32x4*)(USp + ((size_t)(cc >> 4) * NCHKP + (r >> 4)) * 512 + (r & 15) * 16 + (cc & 15)) = w; } } }
    }
};
struct EpiS5State {
    float* Sp;
    __device__ __forceinline__ void operator()(const f32x4 (&acc)[2][2][4][2], const Unit& u, int wr, int wc, int fr, int fq) const {
        EPI_ROWS(u);
#pragma unroll
        for (int ai = 0; ai < 2; ++ai)
#pragma unroll
            for (int m = 0; m < 4; ++m) { float* op = Sp + ((size_t)u.kind * NCHKP + row0 + ai * HALF + m * 16) * 256 + colt;
#pragma unroll
                for (int bj = 0; bj < 2; ++bj)
#pragma unroll
                    for (int n = 0; n < 2; ++n) *(f32x4*)(op + bj * HALF + 4 * n) = acc[ai][bj][m][n]; }
    }
};
struct EpiS5Main {
    bf16_t* GLp; const bf16_t* PRp; const float* dvec;
    __device__ __forceinline__ void operator()(const f32x4 (&acc)[2][2][4][2], const Unit& u, int wr, int wc, int fr, int fq) const {
        EPI_ROWS(u);
        const int cl = 16 * u.kind + (colt & 15);
        const f32x4 d0 = *(const f32x4*)(dvec + cl), d1 = *(const f32x4*)(dvec + cl + 4);
#pragma unroll
        for (int ai = 0; ai < 2; ++ai) {
            u32x4 uq[4][2];
#pragma unroll
            for (int m = 0; m < 4; ++m) { const int n = row0 + ai * HALF + m * 16;
#pragma unroll
                for (int bj = 0; bj < 2; ++bj) { const int c = colt + bj * HALF, r = 16 * (n < NCHK ? n : 0) + (c >> 4); uq[m][bj] = *(const u32x4*)(PRp + (size_t)r * LDP + PC_D + cl); } }
#pragma unroll
            for (int m = 0; m < 4; ++m) { const int n = row0 + ai * HALF + m * 16; if (n >= NCHK) continue;
#pragma unroll
                for (int bj = 0; bj < 2; ++bj) { const int c = colt + bj * HALF, r = 16 * n + (c >> 4); const u32x4 uv = uq[m][bj];
                    const f32x4 v0 = acc[ai][bj][m][0], v1 = acc[ai][bj][m][1];
                    u32x4 w; w.x = cvt_pk_bf16(gelu_f(v0[0] + d0[0] * bflo(uv.x)), gelu_f(v0[1] + d0[1] * bfhi(uv.x))); w.y = cvt_pk_bf16(gelu_f(v0[2] + d0[2] * bflo(uv.y)), gelu_f(v0[3] + d0[3] * bfhi(uv.y)));
                    w.z = cvt_pk_bf16(gelu_f(v1[0] + d1[0] * bflo(uv.z)), gelu_f(v1[1] + d1[1] * bfhi(uv.z))); w.w = cvt_pk_bf16(gelu_f(v1[2] + d1[2] * bflo(uv.w)), gelu_f(v1[3] + d1[3] * bfhi(uv.w)));
                    *(u32x4*)(GLp + (size_t)r * 256 + cl) = w; } }
        }
    }
};
struct EpiS5Glu {
    bf16_t* YBp; const bf16_t* GLp; const float* bvec;
    __device__ __forceinline__ void operator()(const f32x4 (&acc)[2][2][4][2], const Unit& u, int wr, int wc, int fr, int fq) const {
        EPI_ROWS(u);
        f32x4 bq[2][2];
#pragma unroll
        for (int bj = 0; bj < 2; ++bj) { bq[bj][0] = *(const f32x4*)(bvec + colt + bj * HALF); bq[bj][1] = *(const f32x4*)(bvec + colt + bj * HALF + 4); }
#pragma unroll
        for (int ai = 0; ai < 2; ++ai) {
            u32x4 gq[4][2];
#pragma unroll
            for (int m = 0; m < 4; ++m)
#pragma unroll
                for (int bj = 0; bj < 2; ++bj) gq[m][bj] = *(const u32x4*)(GLp + (size_t)(row0 + ai * HALF + m * 16) * 256 + colt + bj * HALF);
#pragma unroll
            for (int m = 0; m < 4; ++m) { const int r = row0 + ai * HALF + m * 16;
#pragma unroll
                for (int bj = 0; bj < 2; ++bj) { const int c = colt + bj * HALF; const u32x4 gv = gq[m][bj];
                    const f32x4 v0 = acc[ai][bj][m][0] + bq[bj][0], v1 = acc[ai][bj][m][1] + bq[bj][1];
                    u32x4 w; w.x = cvt_pk_bf16(bflo(gv.x) * sigm(v0[0]), bfhi(gv.x) * sigm(v0[1])); w.y = cvt_pk_bf16(bflo(gv.y) * sigm(v0[2]), bfhi(gv.y) * sigm(v0[3]));
                    w.z = cvt_pk_bf16(bflo(gv.z) * sigm(v1[0]), bfhi(gv.z) * sigm(v1[1])); w.w = cvt_pk_bf16(bflo(gv.w) * sigm(v1[2]), bfhi(gv.w) * sigm(v1[3]));
                    *(u32x4*)(YBp + (size_t)r * YW + YC_D + c) = w; } }
        }
    }
};
struct EpiGate {
    const unsigned char* GQp; bf16_t* MGp; bf16_t* MGCp;
    __device__ __forceinline__ void operator()(const f32x4 (&acc)[2][2][4][2], const Unit& u, int wr, int wc, int fr, int fq) const {
        EPI_ROWS(u);
        const int br = u.kind & 3; const bool acc_prev = (u.kind >= 1 && u.kind <= 3);
        bf16_t* OB = u.kind >= 4 ? MGCp + (size_t)br * RC * D - (size_t)RL * D : MGp;
#pragma unroll
        for (int ai = 0; ai < 2; ++ai) {
            u32x2 g[4][2]; u32x4 p[4][2];
#pragma unroll
            for (int m = 0; m < 4; ++m)
#pragma unroll
                for (int bj = 0; bj < 2; ++bj) { const int r = row0 + ai * HALF + m * 16;
                    g[m][bj] = *(const u32x2*)(GQp + (size_t)r * 4096 + br * 1024 + u.pn * BM + colt + bj * HALF);
                    p[m][bj] = acc_prev ? *(const u32x4*)(MGp + (size_t)r * D + u.pn * BM + colt + bj * HALF) : (u32x4){0u, 0u, 0u, 0u}; }
#pragma unroll
            for (int m = 0; m < 4; ++m) { const int r = row0 + ai * HALF + m * 16; bf16_t* mp = OB + (size_t)r * D + u.pn * BM + colt;
#pragma unroll
                for (int bj = 0; bj < 2; ++bj) { const f32x4 v0 = acc[ai][bj][m][0] * (1.0f / 255.0f), v1 = acc[ai][bj][m][1] * (1.0f / 255.0f); const u32x2 gg = g[m][bj]; const u32x4 pp = p[m][bj];
                    const f32x4 o0 = {v0[0] * (float)(gg.x & 255u) + bflo(pp.x), v0[1] * (float)((gg.x >> 8) & 255u) + bfhi(pp.x), v0[2] * (float)((gg.x >> 16) & 255u) + bflo(pp.y), v0[3] * (float)(gg.x >> 24) + bfhi(pp.y)};
                    const f32x4 o1 = {v1[0] * (float)(gg.y & 255u) + bflo(pp.z), v1[1] * (float)((gg.y >> 8) & 255u) + bfhi(pp.z), v1[2] * (float)((gg.y >> 16) & 255u) + bflo(pp.w), v1[3] * (float)(gg.y >> 24) + bfhi(pp.w)};
                    u32x4 w; w.x = cvt_pk_bf16(o0[0], o0[1]); w.y = cvt_pk_bf16(o0[2], o0[3]); w.z = cvt_pk_bf16(o1[0], o1[1]); w.w = cvt_pk_bf16(o1[2], o1[3]);
                    *(u32x4*)(mp + bj * HALF) = w; } }
        }
    }
};
struct EpiRes {
    float* PREp; const float* xlat; const float* xctx; const float* gvec;
    float* partp;
    __device__ __forceinline__ void operator()(const f32x4 (&acc)[2][2][4][2], const Unit& u, int wr, int wc, int fr, int fq) const {
        EPI_ROWS(u);
        if (u.kind != 0) {
            f32x4 gc[2][2];
#pragma unroll
            for (int bj = 0; bj < 2; ++bj)
#pragma unroll
                for (int n = 0; n < 2; ++n) gc[bj][n] = *(const f32x4*)(gvec + (size_t)4 * 6144 + u.pn * BM + colt + bj * HALF + 4 * n);
#pragma unroll
            for (int ai = 0; ai < 2; ++ai)
#pragma unroll
                for (int m = 0; m < 4; ++m) { const int r = row0 + ai * HALF + m * 16; const int c0 = u.pn * BM + colt;
                    float* op = partp + ((size_t)(u.kind - 1) * RC + r) * D + c0;
#pragma unroll
                    for (int bj = 0; bj < 2; ++bj)
#pragma unroll
                        for (int n = 0; n < 2; ++n) *(f32x4*)(op + bj * HALF + 4 * n) = gc[bj][n] * acc[ai][bj][m][n]; }
            return;
        }
        const int c0 = u.pn * BM + colt, rt0 = u.pm * BM;
        const float* gp = gvec + (size_t)(rt0 < RL ? (rt0 >> 12) : 4) * 6144 + c0;
        f32x4 gq[2][2];
#pragma unroll
        for (int bj = 0; bj < 2; ++bj)
#pragma unroll
            for (int n = 0; n < 2; ++n) gq[bj][n] = *(const f32x4*)(gp + bj * HALF + 4 * n);
#pragma unroll
        for (int ai = 0; ai < 2; ++ai)
#pragma unroll
            for (int m = 0; m < 4; ++m) { bf16_t* op = (bf16_t*)PREp + (size_t)(row0 + ai * HALF + m * 16) * D + c0;
#pragma unroll
                for (int bj = 0; bj < 2; ++bj) { const f32x4 v0 = gq[bj][0] * acc[ai][bj][m][0], v1 = gq[bj][1] * acc[ai][bj][m][1];
                    u32x4 w; w.x = cvt_pk_bf16(v0[0], v0[1]); w.y = cvt_pk_bf16(v0[2], v0[3]); w.z = cvt_pk_bf16(v1[0], v1[1]); w.w = cvt_pk_bf16(v1[2], v1[3]);
                    *(u32x4*)(op + bj * HALF) = w; } }
    }
};
struct EpiSwiglu {
    bf16_t* Hp; int ldh; int row_sub;
    __device__ __forceinline__ void operator()(const f32x4 (&acc)[2][2][4][2], const Unit& u, int wr, int wc, int fr, int fq) const {
        const int row0 = (u.pm - row_sub) * BM + wr * 64 + fr, colt = wc * 32 + 8 * fq;
#pragma unroll
        for (int ai = 0; ai < 2; ++ai)
#pragma unroll
            for (int m = 0; m < 4; ++m) { bf16_t* rowp = Hp + (size_t)(row0 + ai * HALF + m * 16) * ldh + u.pn * HALF + colt;
                f32x4 h0, h1;
#pragma unroll
                for (int j = 0; j < 4; ++j) { const float g0 = acc[ai][0][m][0][j], g1 = acc[ai][0][m][1][j];
                    h0[j] = g0 * sigm(g0) * acc[ai][1][m][0][j]; h1[j] = g1 * sigm(g1) * acc[ai][1][m][1][j]; }
                u32x4 w; w.x = cvt_pk_bf16(h0[0], h0[1]); w.y = cvt_pk_bf16(h0[2], h0[3]); w.z = cvt_pk_bf16(h1[0], h1[1]); w.w = cvt_pk_bf16(h1[2], h1[3]);
                *(u32x4*)rowp = w; }
    }
};
struct EpiMoeDown {
    bf16_t* O2; const float* slotw; float* O2X;
    __device__ __forceinline__ void operator()(const f32x4 (&acc)[2][2][4][2], const Unit& u, int wr, int wc, int fr, int fq) const {
        EPI_ROWS(u);
        float wq[2][4];
        if (u.kind & 8) {
            const int sp = (u.kind >> 4) & 3;
#pragma unroll
            for (int ai = 0; ai < 2; ++ai)
#pragma unroll
                for (int m = 0; m < 4; ++m) { const int r = row0 + ai * HALF + m * 16; const float w8 = slotw[r]; float* op = O2X + ((size_t)sp * 2048 + (r - 128 * 256)) * D + u.pn * BM + colt;
#pragma unroll
                    for (int bj = 0; bj < 2; ++bj)
#pragma unroll
                        for (int n = 0; n < 2; ++n) *(f32x4*)(op + bj * HALF + 4 * n) = acc[ai][bj][m][n] * w8; }
            return;
        }
#pragma unroll
        for (int ai = 0; ai < 2; ++ai)
#pragma unroll
            for (int m = 0; m < 4; ++m) wq[ai][m] = slotw[row0 + ai * HALF + m * 16];
#pragma unroll
        for (int ai = 0; ai < 2; ++ai)
#pragma unroll
            for (int m = 0; m < 4; ++m) { const int r = row0 + ai * HALF + m * 16; const float w8 = wq[ai][m];
                bf16_t* rowp = O2 + (size_t)r * D + u.pn * BM + colt;
#pragma unroll
                for (int bj = 0; bj < 2; ++bj) { const f32x4 v0 = acc[ai][bj][m][0] * w8, v1 = acc[ai][bj][m][1] * w8;
                    u32x4 w; w.x = cvt_pk_bf16(v0[0], v0[1]); w.y = cvt_pk_bf16(v0[2], v0[3]); w.z = cvt_pk_bf16(v1[0], v1[1]); w.w = cvt_pk_bf16(v1[2], v1[3]);
                    *(u32x4*)(rowp + bj * HALF) = w; } }
    }
};
}

struct Job { int in_idx; int src_off; int lds; int K; int N; long long dst_off; int ldd; int kcol0; int G, GS, R0; int tile0; };
struct JobTable { Job j[96]; int n; int total; };
constexpr int BIGG = 1 << 30;
constexpr void add_job(JobTable& t, int in_idx, long long src_off, int lds, int K, int N, size_t dst_off, int ldd, int kcol0, int G, int GS, int R0) {
    Job& q = t.j[t.n]; q.in_idx = in_idx; q.src_off = (int)src_off; q.lds = lds; q.K = K; q.N = N; q.dst_off = (long long)dst_off; q.ldd = ldd; q.kcol0 = kcol0; q.G = G; q.GS = GS; q.R0 = R0;
    q.tile0 = t.total; t.total += (K / 64) * (N / 64); t.n++;
}
constexpr JobTable make_jobs(int which) {
    JobTable t{}; t.n = 0; t.total = 0;
    if (which == 0) {
        for (int l = 0; l < 2; ++l) {
            const size_t base = WS_WL + (size_t)l * SZ_WL; const long long wsrc = (long long)l * 1024 * IN_COLS;
            add_job(t, 6, wsrc + 0, IN_COLS, 1024, 768, base, 1024, 0, BIGG, 0, 0);
            add_job(t, 6, wsrc + 2688, IN_COLS, 1024, 256, base, 1024, 0, BIGG, 0, PC_D);
            add_job(t, 6, wsrc + 1536, IN_COLS, 1024, 768, base, 1024, 0, BIGG, 0, PC_Q);
            add_job(t, 6, wsrc + 2944, IN_COLS, 1024, 4096, base, 1024, 0, BIGG, 0, PC_G);
            add_job(t, 6, wsrc + 768, IN_COLS, 1024, 768, base + SZ_WINR, 1024, 0, BIGG, 0, 0);
            add_job(t, 6, wsrc + 2304, IN_COLS, 1024, 384, base + SZ_WINR, 1024, 0, BIGG, 0, PT_V);
            const int kd[4] = {384, 256, 384, 256}, ko[4] = {0, 384, 640, 1024};
            for (int i = 0; i < 4; ++i) add_job(t, 35 + i, (long long)l * kd[i] * 1024, 1024, kd[i], 1024, base + SZ_WINR + SZ_WINHY, 1280, ko[i], BIGG, 0, 0);
            add_job(t, 39, (long long)l * 1024 * 1024, 1024, 1024, 1024, base + SZ_WINR + SZ_WINHY + SZ_WBR, 1024, 0, BIGG, 0, 0);
        }
        for (int q = 0; q < 24; ++q) for (int mat = 0; mat < 2; ++mat)
            add_job(t, mat == 0 ? 9 : 11, (long long)q * 4096, 64, 64, 64, WS_LW + (size_t)(((q / 6) * 2 + mat) * 6 + q % 6) * 4096 * 2, 64, 0, BIGG, 0, 0);
        for (int l = 0; l < 2; ++l) add_job(t, 33, (long long)l * 65536, 256, 256, 256, WS_WGLU + (size_t)l * 256 * 256 * 2, 256, 0, BIGG, 0, 0);
        add_job(t, 44, 0, FF_DENSE, 1024, FF_DENSE, WS_FFGU, 1024, 0, 128, 256, 0);
        add_job(t, 45, 0, FF_DENSE, 1024, FF_DENSE, WS_FFGU, 1024, 0, 128, 256, 128);
        add_job(t, 46, 0, 1024, FF_DENSE, 1024, WS_FFD, FF_DENSE, 0, BIGG, 0, 0);
    } else {
        for (int e = 0; e < NE; ++e) {
            add_job(t, 48, (long long)e * 1024 * FF_E, FF_E, 1024, FF_E, WS_MOEGU + (size_t)e * 2 * FF_E * 1024 * 2, 1024, 0, 128, 256, 0);
            add_job(t, 49, (long long)e * 1024 * FF_E, FF_E, 1024, FF_E, WS_MOEGU + (size_t)e * 2 * FF_E * 1024 * 2, 1024, 0, 128, 256, 128);
            add_job(t, 50, (long long)e * FF_E * 1024, 1024, FF_E, 1024, WS_MOED + (size_t)e * 1024 * FF_E * 2, FF_E, 0, BIGG, 0, 0);
        }
    }
    return t;
}
__device__ const JobTable JT_SMALL = make_jobs(0);
__device__ const JobTable JT_MOE = make_jobs(1);

struct PartTable { pg8::PartC p[32]; };
constexpr pg8::PartC mk_part(size_t aOff, size_t bOff, unsigned aStep, unsigned bStep, int nM, int nN, int nt, int kind, int start) {
    pg8::PartC q{}; q.aOff = (long long)aOff; q.bOff = (long long)bOff; q.aStep = aStep; q.bStep = bStep; q.nM = nM; q.nN = nN; q.nt = nt; q.kind = kind; q.start = start; q.nGrp = 1; q.aGrp = 0; q.bGrp = 0; return q;
}
constexpr PartTable make_parts() {
    PartTable t{};
    for (int l = 0; l < 2; ++l) {
        const size_t WL = WS_WL + (size_t)l * SZ_WL; const int nMrow = l == 0 ? 68 : 64;
        t.p[l * 8 + 0] = mk_part(WS_UB, WL, 256u * 1024u * 2u, 256u * 1024u * 2u, 68, 23, 16, 0, 0);
        t.p[l * 8 + 1] = mk_part(WL + SZ_WINR, WS_UB, 256u * 1024u * 2u, 256u * 1024u * 2u, 5, 68, 16, 1, 68 * 23);
        const int kd[4] = {384, 256, 384, 256}, ko[4] = {0, 384, 640, 1024};
        for (int i = 0; i < 4; ++i) t.p[l * 8 + 2 + i] = mk_part(WS_YB + ko[i] * 2, WL + SZ_WINR + SZ_WINHY + ko[i] * 2, 256u * 1280u * 2u, 256u * 1280u * 2u, nMrow, 4, kd[i] / 64, i, i * nMrow * 4);
        t.p[l * 8 + 6] = mk_part(WS_UB, WL + SZ_WINR + SZ_WINHY + SZ_WBR, 256u * 1024u * 2u, 256u * 1024u * 2u, nMrow, 4, 16, 0, 0);
    }
    for (int l = 0; l < 2; ++l) {
        pg8::PartC q = mk_part(WS_US, WS_OPS + (size_t)l * 16 * 256 * 256 * 2, 256u * 512u * 2u, 0u, 5, 1, 4, 0, 0); q.nGrp = 16; q.aGrp = (unsigned)(NCHKP * 512 * 2); q.bGrp = 256u * 256u * 2u; t.p[18 + l * 3] = q;
        q = mk_part(WS_US, WS_OPY + (size_t)l * 16 * 256 * 512 * 2, 256u * 512u * 2u, 0u, 5, 1, 8, 0, 0); q.nGrp = 16; q.aGrp = (unsigned)(NCHKP * 512 * 2); q.bGrp = 256u * 512u * 2u; t.p[19 + l * 3] = q;
        t.p[20 + l * 3] = mk_part(WS_GL, WS_WGLU + (size_t)l * 256 * 256 * 2, 256u * 256u * 2u, 0u, l == 0 ? 68 : 64, 1, 4, 0, 0);
    }
    {
        const size_t WL0 = WS_WL;
        t.p[24] = mk_part(WS_UB, WL0 + SZ_WINR + SZ_WINHY + SZ_WBR, 256u * 1024u * 2u, 256u * 1024u * 2u, 64, 4, 16, 0, 0);
        pg8::PartC q = mk_part(WS_MGC, WL0 + SZ_WINR + SZ_WINHY + SZ_WBR, 256u * 1024u * 2u, 256u * 1024u * 2u, 4, 4, 16, 1, 256); q.nGrp = 4; q.aGrp = (unsigned)(RC * D * 2); q.bGrp = 0u; t.p[25] = q;
        t.p[26] = mk_part(WS_H, WS_FFD, 256u * (unsigned)FF_DENSE * 2u, 256u * (unsigned)FF_DENSE * 2u, 64, 4, 44, 0, 0);
        q = mk_part(WS_H + (size_t)64 * 256 * FF_DENSE * 2, WS_FFD, 256u * (unsigned)FF_DENSE * 2u, 256u * (unsigned)FF_DENSE * 2u, 4, 4, 12, 1, 256); q.nGrp = 3; q.aGrp = 1536u; q.bGrp = 1536u; t.p[27] = q;
        t.p[28] = mk_part(WS_H + (size_t)64 * 256 * FF_DENSE * 2 + 36 * 128, WS_FFD + 36 * 128, 256u * (unsigned)FF_DENSE * 2u, 256u * (unsigned)FF_DENSE * 2u, 4, 4, 8, 4, 256 + 48);
    }
    t.p[16] = mk_part(WS_UB, WS_FFGU, 256u * 1024u * 2u, 256u * 1024u * 2u, 68, 22, 16, 0, 0);
    t.p[17] = mk_part(WS_H, WS_FFD, 256u * (unsigned)FF_DENSE * 2u, 256u * (unsigned)FF_DENSE * 2u, 68, 4, 44, 0, 0);
    return t;
}
__device__ const PartTable PARTS = make_parts();

struct Args {
    const float* in[51];
    float* out; unsigned char* ws;
    int ph_lo, ph_hi, bar_region, pad0;
};
__device__ __forceinline__ const float* sel_in(const Args& a, int idx) {
    const float* p = a.in[6];
    p = idx == 9 ? a.in[9] : p; p = idx == 11 ? a.in[11] : p; p = idx == 33 ? a.in[33] : p; p = idx == 35 ? a.in[35] : p; p = idx == 36 ? a.in[36] : p; p = idx == 37 ? a.in[37] : p; p = idx == 38 ? a.in[38] : p; p = idx == 39 ? a.in[39] : p;
    p = idx == 44 ? a.in[44] : p; p = idx == 45 ? a.in[45] : p; p = idx == 46 ? a.in[46] : p; p = idx == 48 ? a.in[48] : p; p = idx == 49 ? a.in[49] : p; p = idx == 50 ? a.in[50] : p;
    return p;
}

struct ConvRegs { f32x4 v[4][2]; int jis[4]; };
__device__ __forceinline__ void conv_load(const Args& a, const JobTable& JT, int t0, int stride, ConvRegs& R) {
    int tid = threadIdx.x; asm volatile("" : "+v"(tid));
#pragma unroll
    for (int u = 0; u < 4; ++u) {
        const int t = t0 + u * stride; R.jis[u] = -1;
        if (t < JT.total) {
            int ji = 0;
            for (int k = 1; k < JT.n; ++k) if (t >= JT.j[k].tile0) ji = k;
            R.jis[u] = ji;
            const Job& q = JT.j[ji];
            const int lt = t - q.tile0, nTn = q.N / 64, k0 = (lt / nTn) * 64, n0 = (lt % nTn) * 64;
            const float* src = sel_in(a, q.in_idx) + (size_t)q.src_off + (size_t)k0 * q.lds + n0;
#pragma unroll
            for (int p = 0; p < 2; ++p) R.v[u][p] = *(const f32x4*)(src + (size_t)((tid >> 4) + 32 * p) * q.lds + (tid & 15) * 4);
        }
    }
}
__device__ __forceinline__ void conv_store(const Args& a, const JobTable& JT, LAS float* tile, int t0, int stride, const ConvRegs& R) {
    int tid = threadIdx.x; asm volatile("" : "+v"(tid));
    __syncthreads();
#pragma unroll
    for (int u = 0; u < 4; ++u) if (R.jis[u] >= 0) {
#pragma unroll
        for (int p = 0; p < 2; ++p) { const int kk = (tid >> 4) + 32 * p, nn = (tid & 15) * 4; LAS float* tp = tile + u * (64 * 65) + kk * 65 + nn;
            tp[0] = R.v[u][p][0]; tp[1] = R.v[u][p][1]; tp[2] = R.v[u][p][2]; tp[3] = R.v[u][p][3]; } }
    __syncthreads();
#pragma unroll
    for (int u = 0; u < 4; ++u) if (R.jis[u] >= 0) {
        const Job& q = JT.j[R.jis[u]];
        const int t = t0 + u * stride, lt = t - q.tile0, nTn = q.N / 64, k0 = (lt / nTn) * 64, n0 = (lt % nTn) * 64;
        const int n = tid >> 3, k8 = (tid & 7) * 8, ng = n0 + n;
        const int drow = (ng / q.G) * q.GS + (ng % q.G) + q.R0;
        const LAS float* tp = tile + u * (64 * 65) + n;
        u32x4 w;
        w.x = cvt_pk_bf16(tp[(k8 + 0) * 65], tp[(k8 + 1) * 65]); w.y = cvt_pk_bf16(tp[(k8 + 2) * 65], tp[(k8 + 3) * 65]);
        w.z = cvt_pk_bf16(tp[(k8 + 4) * 65], tp[(k8 + 5) * 65]); w.w = cvt_pk_bf16(tp[(k8 + 6) * 65], tp[(k8 + 7) * 65]);
        *(u32x4*)((bf16_t*)(a.ws + q.dst_off) + (size_t)drow * q.ldd + q.kcol0 + k0 + k8) = w;
    }
}
__device__ __forceinline__ void convert_step(const Args& a, const JobTable& JT, LAS float* tile, int t0, int stride) { ConvRegs R; conv_load(a, JT, t0, stride, R); conv_store(a, JT, tile, t0, stride, R); }
__device__ __forceinline__ void convert_tiles_pipelined(const Args& a, const JobTable& JT, LAS float* tile, int first, int stride) {
    ConvRegs cur; int t0 = first;
    if (t0 >= JT.total) return;
    conv_load(a, JT, t0, stride, cur);
    for (;;) {
        const int tn = t0 + 4 * stride; const bool more = tn < JT.total;
        ConvRegs nxt;
        if (more) conv_load(a, JT, tn, stride, nxt);
        conv_store(a, JT, tile, t0, stride, cur);
        if (!more) break;
        cur = nxt; t0 = tn;
    }
}
__device__ __forceinline__ void convert_tiles(const Args& a, const JobTable& JT, LAS float* tile, int first, int stride) {
    for (int t0 = first; t0 < JT.total; t0 += 4 * stride) convert_step(a, JT, tile, t0, stride);
}

__device__ __forceinline__ int opaque(int v) { asm volatile("" : "+v"(v)); return v; }
#define PIN8(a) asm volatile("" : "+v"((a)[0]), "+v"((a)[1]), "+v"((a)[2]), "+v"((a)[3]), "+v"((a)[4]), "+v"((a)[5]), "+v"((a)[6]), "+v"((a)[7]))
#define PIN16(a) do { PIN8(a); PIN8((a) + 8); } while (0)
struct RowV { f32x4 v[4]; };
__device__ __forceinline__ RowV row_load(const float* p, int lane) { RowV r;
#pragma unroll
    for (int i = 0; i < 4; ++i) r.v[i] = *(const f32x4*)(p + 256 * i + 4 * lane); return r; }
__device__ __forceinline__ RowV row_load_bf16(const bf16_t* p, int lane) { RowV r;
#pragma unroll
    for (int i = 0; i < 4; ++i) { const u32x2 w = *(const u32x2*)(p + 256 * i + 4 * lane); r.v[i] = (f32x4){bflo(w.x), bfhi(w.x), bflo(w.y), bfhi(w.y)}; } return r; }
__device__ __forceinline__ void row_store(float* p, int lane, const RowV& r) {
#pragma unroll
    for (int i = 0; i < 4; ++i) *(f32x4*)(p + 256 * i + 4 * lane) = r.v[i]; }
__device__ __forceinline__ void row_store_bf16(bf16_t* p, int lane, const RowV& r) {
#pragma unroll
    for (int i = 0; i < 4; ++i) { u32x2 w; w.x = cvt_pk_bf16(r.v[i][0], r.v[i][1]); w.y = cvt_pk_bf16(r.v[i][2], r.v[i][3]); *(u32x2*)(p + 256 * i + 4 * lane) = w; } }
__device__ __forceinline__ RowV row_norm(const RowV& x) {
    float s = 0.f;
#pragma unroll
    for (int i = 0; i < 4; ++i) s += (x.v[i][0] + x.v[i][1]) + (x.v[i][2] + x.v[i][3]);
    const float mu = wave_sum(s) * (1.f / D);
    RowV d; float q = 0.f;
#pragma unroll
    for (int i = 0; i < 4; ++i) { d.v[i] = x.v[i] - mu; q += (d.v[i][0] * d.v[i][0] + d.v[i][1] * d.v[i][1]) + (d.v[i][2] * d.v[i][2] + d.v[i][3] * d.v[i][3]); }
    const float rs = rsqrtf(wave_sum(q) * (1.f / D) + 1e-5f);
#pragma unroll
    for (int i = 0; i < 4; ++i) d.v[i] = d.v[i] * rs;
    return d;
}
__device__ __forceinline__ RowV row_affine(const RowV& n, const float* g, const float* b, int lane) {
    RowV o;
#pragma unroll
    for (int i = 0; i < 4; ++i) o.v[i] = n.v[i] * *(const f32x4*)(g + 256 * i + 4 * lane) + *(const f32x4*)(b + 256 * i + 4 * lane);
    return o;
}
__device__ __forceinline__ RowV row_modulate(const RowV& n, const float* sh, const float* sc, int lane) {
    RowV o;
#pragma unroll
    for (int i = 0; i < 4; ++i) o.v[i] = n.v[i] * (*(const f32x4*)(sc + 256 * i + 4 * lane) + 1.0f) + *(const f32x4*)(sh + 256 * i + 4 * lane);
    return o;
}

constexpr int LDS_BYTES = 159744;
constexpr int MISC_OFF = 159488;
constexpr int NPH_LAYER = 16;
#ifndef SPLIT
#define SPLIT 0
#endif

__global__ void __launch_bounds__(512, 2) mk_fwd(Args a) {
    extern __shared__ __attribute__((aligned(16))) unsigned char shm[];
    LAS unsigned char* lds = (LAS unsigned char*)shm;
    volatile LAS unsigned* MISC = (volatile LAS unsigned*)(lds + MISC_OFF);
    const int tid0 = threadIdx.x, wave = __builtin_amdgcn_readfirstlane(tid0 >> 6);
    const int G = gridDim.x, bid = blockIdx.x;
    if (tid0 < (LDS_BYTES - MISC_OFF) / 4) MISC[tid0] = 0u;
    __syncthreads();
    unsigned char* ws = a.ws;
    unsigned* ctl = (unsigned*)(ws + WS_CTL);
    XcdBarrier bar = xcd_barrier_post(ctl + CW_BAR + a.bar_region * XCD_BAR_WORDS, MISC + 8);
    const int lo = a.ph_lo, hi = a.ph_hi;
#ifndef PHMASK
#define PHMASK 0xFFFF
#endif
#define IN(k) (lo <= (k) && (k) < hi)
#define SEAM(k) do { if (lo <= (k) && (k) + 1 < hi) xcd_barrier(bar); } while (0)
    float* MOD = (float*)(ws + WS_MOD);
    bf16_t* UB = (bf16_t*)(ws + WS_UB); bf16_t* PR = (bf16_t*)(ws + WS_PR); bf16_t* PT = (bf16_t*)(ws + WS_PT); bf16_t* YB = (bf16_t*)(ws + WS_YB);
    float* PRE = (float*)(ws + WS_PRE); float* XSC = (float*)(ws + WS_XSC);
    const float* x_in = a.in[0]; const float* ctx_in = a.in[2];

    if (((PHMASK >> 0) & 1) && IN(0)) {
        const int tid = opaque(tid0), lane = tid & 63;
        __syncthreads();
        LAS float* sc = (LAS float*)lds;
        for (int i = tid; i < 5 * 1024; i += 512) { const int r = i >> 10, k = i & 1023; sc[i] = silu_acc(r < 4 ? a.in[1][r * 1024 + k] : a.in[3][k]); }
        __syncthreads();
        for (int u = bid; u < 2 * 96 * 8; u += G) {
            const int l = u / (96 * 8), rem = u % (96 * 8), cg = rem / 8, ks = rem % 8;
            const int n = cg * 64 + lane;
            const float* w = a.in[4] + (size_t)l * 1024 * 6144 + n;
            float a0 = 0, a1 = 0, a2 = 0, a3 = 0, a4 = 0;
            const int kb = ks * 128 + wave * 16;
#pragma unroll 4
            for (int k = kb; k < kb + 16; ++k) { const float wv = w[(size_t)k * 6144]; a0 += sc[k] * wv; a1 += sc[1024 + k] * wv; a2 += sc[2048 + k] * wv; a3 += sc[3072 + k] * wv; a4 += sc[4096 + k] * wv; }
            if (ks == 0 && wave == 0) { const float bb = a.in[5][l * 6144 + n]; a0 += bb; a1 += bb; a2 += bb; a3 += bb; a4 += bb; }
            float* o = MOD + (size_t)l * 5 * 6144 + n;
            atomicAdd(o, a0); atomicAdd(o + 6144, a1); atomicAdd(o + 2 * 6144, a2); atomicAdd(o + 3 * 6144, a3); atomicAdd(o + 4 * 6144, a4);
        }
        __syncthreads();
        for (int u = bid; u < 132; u += G) {
            const bool isc = u >= 128; const int l = isc ? 0 : (u >> 6), blk = isc ? u - 128 : (u & 63), L = isc ? CTXL : SEQ, t0 = blk * 64;
            LAS float* feat = (LAS float*)lds;
            LAS float* h1 = feat + 64 * 33;
            LAS float* h2 = h1 + 4096;
            const float* w1 = a.in[16] + l * 33 * 64; const float* b1 = a.in[17] + l * 64; const float* w2 = a.in[18] + l * 4096; const float* b2 = a.in[19] + l * 64;
            const float* w3 = a.in[20] + (size_t)l * 65536; const float* b3 = a.in[21] + l * 1024; const float* fq = a.in[22] + l * 64;
            __syncthreads();
            for (int i = tid; i < 64 * 33; i += 512) { const int tt = i / 33, f = i - tt * 33, t = t0 + tt; float v;
                if (f == 0) v = (float)t / (float)L;
                else { const int band = (f - 1) % 16 + 1; const int m = (int)(((long)t * band) % L); const double ang = 2.0 * M_PI * (double)m / (double)L; v = f <= 16 ? (float)cos(ang) : (float)sin(ang); }
                feat[i] = v; }
            __syncthreads();
            for (int i = tid; i < 4096; i += 512) { const int tt = i >> 6, j = i & 63; float sacc = b1[j];
                for (int f = 0; f < 33; ++f) sacc += feat[tt * 33 + f] * w1[f * 64 + j];
                h1[i] = sinf(fq[j] * sacc); }
            __syncthreads();
            for (int i = tid; i < 4096; i += 512) { const int tt = i >> 6, j = i & 63; float sacc = b2[j];
                for (int f = 0; f < 64; ++f) sacc += h1[tt * 64 + f] * w2[f * 64 + j];
                h2[i] = sinf(fq[j] * sacc); }
            __syncthreads();
            const float dmin = 3.0701134573253945f, dmax = 15.350567286626973f;
#pragma unroll 1
            for (int jj = 0; jj < 2; ++jj) {
                const int n = tid + 512 * jj, dir = n >> 9, o = (n >> 8) & 1, c = n & 255;
                float wc[64];
#pragma unroll
                for (int i = 0; i < 64; ++i) wc[i] = w3[i * 1024 + n];
                const float bb = b3[n], delta = dmin + (dmax - dmin) * (float)c / 255.0f;
                bf16_t* dst = isc ? (bf16_t*)(ws + WS_KFC) + ((size_t)(dir * 2 + o) * 256 + c) * CTXL + t0 : (bf16_t*)(ws + WS_KFL) + ((size_t)((l * 2 + dir) * 2 + o) * 256 + c) * SEQ + t0;
                float asum = 0.f;
#pragma unroll 1
                for (int tg = 0; tg < 8; ++tg) {
                    float v[8];
#pragma unroll
                    for (int q = 0; q < 8; ++q) { float sacc = bb; const LAS float* hp = h2 + (tg * 8 + q) * 64;
#pragma unroll
                        for (int i = 0; i < 64; ++i) sacc += hp[i] * wc[i];
                        const int t = t0 + tg * 8 + q;
                        v[q] = sacc * expf(-((float)t / (float)L) * delta);
                        if (!(dir == 1 && t == 0)) asum += fabsf(v[q]); }
                    u32x4 w; w.x = cvt_pk_bf16(v[0], v[1]); w.y = cvt_pk_bf16(v[2], v[3]); w.z = cvt_pk_bf16(v[4], v[5]); w.w = cvt_pk_bf16(v[6], v[7]);
                    *(u32x4*)(dst + tg * 8) = w;
                }
                atomicAdd((float*)(ctl + CW_HYN) + (isc ? 1024 + o * 256 + c : (l * 2 + o) * 256 + c), asum);
            }
        }
        __syncthreads();
        for (int uq = bid; uq < 164; uq += G) { if (uq < 132) continue; const int u = uq - 132;
            const int l = u >> 4, g = u & 15;
            LAS float* PW = (LAS float*)lds;
            LAS float* BBs = PW + 2 * 64 * 17 * 2;
            LAS float* Cs = BBs + 2 * 64 * 16 * 2;
            LAS float* KT = Cs + 2 * 16 * 64 * 2;
            __syncthreads();
            if (tid < 128) {
                const int d = tid >> 6, p = tid & 63, idx = l * 2048 + (d * 16 + g) * 64 + p;
                const double ar = a.in[25][idx], ai = a.in[26][idx], dt = exp((double)a.in[27][l * 32 + d * 16 + g]);
                const double mag = exp(dt * ar), abr = mag * cos(dt * ai), abi = mag * sin(dt * ai), den = ar * ar + ai * ai;
                const double fr = ((abr - 1.0) * ar + abi * ai) / den, fi = (abi * ar - (abr - 1.0) * ai) / den;
                double pr = 1.0, pi = 0.0;
                for (int k = 0; k <= 16; ++k) { PW[((d * 64 + p) * 17 + k) * 2] = (float)pr; PW[((d * 64 + p) * 17 + k) * 2 + 1] = (float)pi; const double nr = pr * abr - pi * abi, ni = pr * abi + pi * abr; pr = nr; pi = ni; }
                float* a16 = (float*)(ws + WS_AB16) + ((size_t)((l * 2 + d) * 16 + g) * 64 + p) * 2;
                a16[0] = PW[((d * 64 + p) * 17 + 16) * 2]; a16[1] = PW[((d * 64 + p) * 17 + 16) * 2 + 1];
                for (int i = 0; i < 16; ++i) { const double br = a.in[28][(size_t)idx * 16 + i], bi = a.in[29][(size_t)idx * 16 + i];
                    BBs[((d * 64 + p) * 16 + i) * 2] = (float)(fr * br - fi * bi); BBs[((d * 64 + p) * 16 + i) * 2 + 1] = (float)(fr * bi + fi * br); }
            }
            for (int i = tid; i < 2048; i += 512) { const int d = i >> 10, o = (i >> 6) & 15, p = i & 63; const size_t ci = (size_t)l * 32768 + ((size_t)(d * 16 + g) * 16 + o) * 64 + p;
                Cs[i * 2] = a.in[30][ci]; Cs[i * 2 + 1] = a.in[31][ci]; }
            __syncthreads();
            for (int e = tid; e < 8192; e += 512) { const int d = e >> 12, k = (e >> 8) & 15, o = (e >> 4) & 15, i = e & 15;
                float acc = 0.f;
                for (int p = 0; p < 64; ++p) { const float cr = Cs[((d * 16 + o) * 64 + p) * 2], ci = Cs[((d * 16 + o) * 64 + p) * 2 + 1], pr = PW[((d * 64 + p) * 17 + k) * 2], pi = PW[((d * 64 + p) * 17 + k) * 2 + 1];
                    const float tr = cr * pr - ci * pi, ti = cr * pi + ci * pr;
                    acc += tr * BBs[((d * 64 + p) * 16 + i) * 2] - ti * BBs[((d * 64 + p) * 16 + i) * 2 + 1]; }
                KT[e] = acc; }
            __syncthreads();
            bf16_t* OPS = (bf16_t*)(ws + WS_OPS) + (size_t)(l * 16 + g) * 256 * 256;
            bf16_t* OPY = (bf16_t*)(ws + WS_OPY) + (size_t)(l * 16 + g) * 256 * 512;
            for (int e = tid; e < 256 * 32; e += 512) {
                const int row = e >> 5, c0 = (e & 31) * 8, d = row >> 7, p = (row >> 1) & 63, ri = row & 1, sx = c0 >> 4, i0 = c0 & 15, k = d == 0 ? 15 - sx : sx;
                const float pr = PW[((d * 64 + p) * 17 + k) * 2], pi = PW[((d * 64 + p) * 17 + k) * 2 + 1];
                float v[8];
#pragma unroll
                for (int j = 0; j < 8; ++j) { const float br = BBs[((d * 64 + p) * 16 + i0 + j) * 2], bi = BBs[((d * 64 + p) * 16 + i0 + j) * 2 + 1]; v[j] = ri == 0 ? pr * br - pi * bi : pr * bi + pi * br; }
                u32x4 w; w.x = cvt_pk_bf16(v[0], v[1]); w.y = cvt_pk_bf16(v[2], v[3]); w.z = cvt_pk_bf16(v[4], v[5]); w.w = cvt_pk_bf16(v[6], v[7]);
                *(u32x4*)(OPS + (size_t)row * 256 + c0) = w; }
            for (int e = tid; e < 256 * 64; e += 512) {
                const int row = e >> 6, c0 = (e & 63) * 8, t = row >> 4, o = row & 15;
                float v[8];
                if (c0 < 256) { const int sx = c0 >> 4, i0 = c0 & 15;
#pragma unroll
                    for (int j = 0; j < 8; ++j) { float x = 0.f; if (sx <= t) x += KT[((0 * 16 + (t - sx)) * 16 + o) * 16 + i0 + j]; if (sx >= t) x += KT[((1 * 16 + (sx - t)) * 16 + o) * 16 + i0 + j]; v[j] = x; } }
                else { const int c2 = c0 - 256, d = c2 >> 7, k = d == 0 ? t + 1 : 16 - t;
#pragma unroll
                    for (int j = 0; j < 8; ++j) { const int p = ((c2 + j) >> 1) & 63, ri = (c2 + j) & 1;
                        const float cr = Cs[((d * 16 + o) * 64 + p) * 2], ci = Cs[((d * 16 + o) * 64 + p) * 2 + 1], pr = PW[((d * 64 + p) * 17 + k) * 2], pi = PW[((d * 64 + p) * 17 + k) * 2 + 1];
                        v[j] = ri == 0 ? cr * pr - ci * pi : -(cr * pi + ci * pr); } }
                u32x4 w; w.x = cvt_pk_bf16(v[0], v[1]); w.y = cvt_pk_bf16(v[2], v[3]); w.z = cvt_pk_bf16(v[4], v[5]); w.w = cvt_pk_bf16(v[6], v[7]);
                *(u32x4*)(OPY + (size_t)row * 512 + c0) = w; }
        }
        __syncthreads();
        for (;;) {
            __syncthreads();
            if (tid == 0) MISC[16] = atomicAdd(ctl + CW_QUEUE, 4u);
            __syncthreads();
            const int base = (int)MISC[16];
            if (base >= JT_SMALL.total) break;
            convert_step(a, JT_SMALL, (LAS float*)lds, base, 1);
        }
        __syncthreads();
    }
    SEAM(0);

    for (int l = 0; l < 2; ++l) {
        const int P0 = 1 + l * NPH_LAYER;
        const float* MODL = MOD + (size_t)l * 5 * 6144;
        const unsigned char* WL = ws + WS_WL + (size_t)l * SZ_WL;
        const int nMrow = (l == 0) ? 68 : 64;
        const float* xlat = (l == 0) ? x_in : a.out; const float* xctx = (l == 0) ? ctx_in : XSC;

        if (((PHMASK >> 1) & 1) && l == 0 && IN(P0 + 0)) {
            const int lane = opaque(tid0) & 63;
            for (int r = bid * 8 + wave; r < RT; r += G * 8) {
                const float* src = r < RL ? x_in + (size_t)r * D : ctx_in + (size_t)(r - RL) * D;
                const float* mv = MODL + (size_t)(r < RL ? (r >> 12) : 4) * 6144;
                const RowV n = row_norm(row_load(src, lane));
                row_store_bf16(UB + (size_t)r * D, lane, row_modulate(n, mv, mv + 1024, lane));
            }
        }
        if (l == 0) SEAM(P0 + 0);

        if (((PHMASK >> 2) & 1) && IN(P0 + 1)) {
            const pg8::TabSched S{PARTS.p + l * 8, (const char*)ws, 2, 68 * 23 + 5 * 68, G, bid};
            pg8::EpiProj E{PR, PT, (bf16_t*)(ws + WS_US), 7, ws + WS_GQ};
            pg8::gemm_phase<1024, 1024>(lds, S, E);
        }
        SEAM(P0 + 1);
        if (((PHMASK >> 13) & 1) && IN(P0 + 2)) {
            const int tid = opaque(tid0), lane = tid & 63;
            LAS float* rp = (LAS float*)lds;
            for (int i = tid; i < 6 * 465; i += 512) rp[i] = a.in[24][l * 2790 + i];
            __syncthreads();
            LAS bf16_t* KW = (LAS bf16_t*)(lds + 11264);
            LAS bf16_t* CK = (LAS bf16_t*)(lds + 11264 + 576 * 144);
            LAS bf16_t* VW = (LAS bf16_t*)(lds + 11264);
            LAS bf16_t* CV = (LAS bf16_t*)(lds + 11264 + 64 * 1168);
            const int ngroups = 768 + (l == 0 ? 48 : 0);
            for (int gi = bid; gi < ngroups; gi += G) {
                const bool lat = gi < 768;
                const int combo = lat ? gi >> 5 : (gi - 768) >> 1, b = combo / 6, h = combo - 6 * b;
                const int v = lat ? ((gi & 31) << 3) + wave : (((gi - 768) & 1) << 3) + wave;
                const int r0g = (gi & 31) << 1, rs0 = r0g - 4 < 0 ? 0 : (r0g - 4 > 56 ? 56 : r0g - 4);
                const int ntokw = lat ? ((64 - rs0) < 9 ? (64 - rs0) : 9) * 64 : 0;
                __syncthreads();
                {   const int tid2 = opaque(tid);
#pragma unroll
                    for (int k = 0; k < 9; ++k) { const int c = tid2 + 512 * k, tok = c >> 3, part = c & 7;
                        if (tok < ntokw) *(LAS u32x4*)(KW + tok * 72 + part * 8) = *(const u32x4*)(PR + (size_t)(b * SEQ + rs0 * 64 + tok) * LDP + PC_K + h * 64 + part * 8); }
#pragma unroll
                    for (int k = 0; k < 4; ++k) { const int c = tid2 + 512 * k, tok = c >> 3, part = c & 7;
                        *(LAS u32x4*)(CK + tok * 72 + part * 8) = *(const u32x4*)(PR + (size_t)(RL + b * CTXL + tok) * LDP + PC_K + h * 64 + part * 8); } }
                __syncthreads();
                const int ln2 = opaque(lane), qn = ln2 & 15, g = ln2 >> 4;
                int r = 0, qb, tq, rs = 0, bs = 0, w = 0, cs = 0;
                if (lat) { qb = v & 3; r = v >> 2; rs = r - 4 < 0 ? 0 : (r - 4 > 56 ? 56 : r - 4); bs = qb == 0 ? 0 : (qb == 1 ? 8 : (qb == 2 ? 24 : 32));
                    w = 16 * qb + qn; cs = w - 8 < 0 ? 0 : (w - 8 > 48 ? 48 : w - 8); tq = b * SEQ + r * 64 + w; }
                else { qb = v; tq = RL + b * CTXL + 16 * qb + qn; }
                const int pr0 = rs - rs0;
                const bf16_t* qp = PR + (size_t)tq * LDP + PC_Q + h * 64 + 8 * g;
                const bf16x8 q0 = *(const bf16x8*)qp, q1 = *(const bf16x8*)(qp + 32);
                f32x4 S[32];
                const int koff = 8 * (qn >> 2) + (qn & 3);
                if (lat) {
#pragma unroll
                    for (int p = 0; p < 8; ++p)
#pragma unroll
                        for (int hf = 0; hf < 2; ++hf) { const LAS bf16_t* kp = KW + ((pr0 + p) * 64 + bs + koff + 4 * hf) * 72 + 8 * g;
                            const bf16x8 k0 = *(const LAS bf16x8*)kp, k1 = *(const LAS bf16x8*)(kp + 32);
                            f32x4 acc = {0.f, 0.f, 0.f, 0.f};
                            acc = __builtin_amdgcn_mfma_f32_16x16x32_bf16(k0, q0, acc, 0, 0, 0);
                            acc = __builtin_amdgcn_mfma_f32_16x16x32_bf16(k1, q1, acc, 0, 0, 0);
                            const int rowoff = (h * 15 + (rs + p - r + 7)) * 31;
#pragma unroll
                            for (int j = 0; j < 4; ++j) { const int c = bs + 8 * g + 4 * hf + j; const bool ok = (c >= cs) && (c < cs + 16);
                                const int dc = ok ? c - w + 15 : 0;
                                acc[j] = ok ? acc[j] * 0.125f + rp[rowoff + dc] : -3.0e38f; }
                            S[2 * p + hf] = acc; if (hf == 1 && (p & 1)) __builtin_amdgcn_sched_barrier(0); }
                } else {
#pragma unroll
                    for (int p = 0; p < 16; ++p) S[p] = (f32x4){-3.0e38f, -3.0e38f, -3.0e38f, -3.0e38f};
                }
#pragma unroll
                for (int p = 0; p < 8; ++p)
#pragma unroll
                    for (int hf = 0; hf < 2; ++hf) { const LAS bf16_t* kp = CK + (32 * p + koff + 4 * hf) * 72 + 8 * g;
                        const bf16x8 k0 = *(const LAS bf16x8*)kp, k1 = *(const LAS bf16x8*)(kp + 32);
                        f32x4 acc = {0.f, 0.f, 0.f, 0.f};
                        acc = __builtin_amdgcn_mfma_f32_16x16x32_bf16(k0, q0, acc, 0, 0, 0);
                        acc = __builtin_amdgcn_mfma_f32_16x16x32_bf16(k1, q1, acc, 0, 0, 0);
                        S[16 + 2 * p + hf] = acc * 0.125f; if (hf == 1 && (p & 1)) __builtin_amdgcn_sched_barrier(0); }
                float mx = -3.0e38f;
#pragma unroll
                for (int i = 0; i < 32; ++i) mx = fmaxf(fmaxf(mx, fmaxf(S[i][0], S[i][1])), fmaxf(S[i][2], S[i][3]));
                mx = fmaxf(mx, __shfl_xor(mx, 16)); mx = fmaxf(mx, __shfl_xor(mx, 32));
                float sum = 0.f;
#pragma unroll
                for (int i = 0; i < 32; ++i) {
#pragma unroll
                    for (int j = 0; j < 4; ++j) { const float e = __expf(S[i][j] - mx); S[i][j] = e; sum += e; } }
                sum += __shfl_xor(sum, 16); sum += __shfl_xor(sum, 32);
                const float inv = 1.0f / sum;
                __syncthreads();
                {   const int tid2 = opaque(tid);
#pragma unroll
                    for (int k = 0; k < 9; ++k) { const int c = tid2 + 512 * k, dd = c / 72, part = c - dd * 72;
                        if (part * 8 < ntokw) *(LAS u32x4*)(VW + dd * 584 + part * 8) = *(const u32x4*)(PT + (size_t)(PT_V + h * 64 + dd) * RT + b * SEQ + rs0 * 64 + part * 8); }
#pragma unroll
                    for (int k = 0; k < 4; ++k) { const int c = tid2 + 512 * k, dd = c >> 5, part = c & 31;
                        *(LAS u32x4*)(CV + dd * 264 + part * 8) = *(const u32x4*)(PT + (size_t)(PT_V + h * 64 + dd) * RT + RL + b * CTXL + part * 8); } }
                __syncthreads();
                f32x4 O[4];
#pragma unroll
                for (int dt = 0; dt < 4; ++dt) O[dt] = (f32x4){0.f, 0.f, 0.f, 0.f};
#pragma unroll
                for (int p = 0; p < 16; ++p) {
                    if (p < 8 && !lat) continue;
                    u32x4 pw; pw.x = cvt_pk_bf16(S[2 * p][0], S[2 * p][1]); pw.y = cvt_pk_bf16(S[2 * p][2], S[2 * p][3]); pw.z = cvt_pk_bf16(S[2 * p + 1][0], S[2 * p + 1][1]); pw.w = cvt_pk_bf16(S[2 * p + 1][2], S[2 * p + 1][3]);
                    bf16x8 pf; __builtin_memcpy(&pf, &pw, 16);
#pragma unroll
                    for (int dt = 0; dt < 4; ++dt) { const LAS bf16_t* vp = p < 8 ? VW + (16 * dt + qn) * 584 + (pr0 + p) * 64 + bs + 8 * g : CV + (16 * dt + qn) * 264 + 32 * (p - 8) + 8 * g;
                        O[dt] = __builtin_amdgcn_mfma_f32_16x16x32_bf16(*(const LAS bf16x8*)vp, pf, O[dt], 0, 0, 0); }
                    if (p & 1) __builtin_amdgcn_sched_barrier(0);
                }
                bf16_t* op = YB + (size_t)tq * YW + YC_C + h * 64 + 4 * g;
#pragma unroll
                for (int dt = 0; dt < 4; ++dt) { u32x2 o2; o2.x = cvt_pk_bf16(O[dt][0] * inv, O[dt][1] * inv); o2.y = cvt_pk_bf16(O[dt][2] * inv, O[dt][3] * inv); *(u32x2*)(op + 16 * dt) = o2; }
            }
            __syncthreads();
            {
                const int tid = opaque(tid0), lane = tid & 63;
                LAS float* XC = (LAS float*)lds;
                LAS f32x2* AB = (LAS f32x2*)(lds + 16 * 384 * 4);
                const float* cw = a.in[7] + l * 4 * 384; const float* cb = a.in[8] + l * 384;
                const bf16_t* LW = (const bf16_t*)(ws + WS_LW) + (size_t)l * 24 * 4096;
                bf16_t* LT = (bf16_t*)(ws + WS_LT); f32x2* LAGG = (f32x2*)(ws + WS_LAGG);
                const int dir = (wave >> 2) & 1, ntile = wave & 3, tk = lane & 15, kg = lane >> 4;
                LAS float* CT = (LAS float*)(lds + 16 * 384 * 4 + 2 * 16 * 384 * 8);
                for (int i = tid; i < 768; i += 512) { CT[i] = a.in[10][l * 768 + i]; CT[768 + i] = a.in[12][l * 768 + i]; CT[1536 + i] = -8.0f * softplus(-a.in[13][l * 768 + i]); }
                float cwv[60];
#pragma unroll
                for (int i = 0; i < 12; ++i) { const int idx = tid + 512 * i, ch = idx % 384;
                    cwv[5 * i] = cw[ch]; cwv[5 * i + 1] = cw[384 + ch]; cwv[5 * i + 2] = cw[768 + ch]; cwv[5 * i + 3] = cw[1152 + ch]; cwv[5 * i + 4] = cb[ch]; }
                PIN16(cwv); PIN16(cwv + 16); PIN16(cwv + 32); PIN8(cwv + 48); asm volatile("" : "+v"(cwv[56]), "+v"(cwv[57]), "+v"(cwv[58]), "+v"(cwv[59]));
                for (int n = bid; n < NCHK; n += G) {
                    const int r0 = 16 * n; int start, len, pos0, bb; row_seq(r0, start, len, pos0, bb);
                    __syncthreads();
                    unsigned pin[48];
#pragma unroll
                    for (int i = 0; i < 12; ++i) { const int idx = tid + 512 * i, tok = idx / 384, ch = idx - tok * 384, pos = pos0 + tok;
                        const bf16_t* pr = PR + (size_t)(r0 + tok) * LDP + PC_AC + ch;
                        pin[4 * i + 0] = pos >= 2 ? pr[-2 * LDP] : 0; pin[4 * i + 1] = pos >= 1 ? pr[-LDP] : 0; pin[4 * i + 2] = pr[0]; pin[4 * i + 3] = pos + 1 < len ? pr[LDP] : 0; }
                    PIN16(pin); PIN16(pin + 16); PIN16(pin + 32);
#pragma unroll
                    for (int i = 0; i < 12; ++i) { const int idx = tid + 512 * i, tok = idx / 384, ch = idx - tok * 384;
                        XC[idx] = cwv[5 * i + 4] + cwv[5 * i] * bflo(pin[4 * i]) + cwv[5 * i + 1] * bflo(pin[4 * i + 1]) + cwv[5 * i + 2] * bflo(pin[4 * i + 2]) + cwv[5 * i + 3] * bflo(pin[4 * i + 3]); }
                    __syncthreads();
#pragma unroll 2
                    for (int g = 0; g < 6; ++g) {
                        bf16x8 wq[4];
#pragma unroll
                        for (int ks = 0; ks < 2; ++ks) { const bf16_t* wp = LW + ((size_t)((dir * 2 + 0) * 6 + g) * 64 + 16 * ntile + tk) * 64 + 32 * ks + 8 * kg; wq[2 * ks] = *(const bf16x8*)wp; wq[2 * ks + 1] = *(const bf16x8*)(wp + 6 * 4096); }
                        asm volatile("" : "+v"(wq[0]), "+v"(wq[1]), "+v"(wq[2]), "+v"(wq[3]));
                        f32x4 ar = {0.f, 0.f, 0.f, 0.f}, ai = {0.f, 0.f, 0.f, 0.f};
#pragma unroll
                        for (int ks = 0; ks < 2; ++ks) {
                            const LAS float* xp = XC + tk * 384 + g * 64 + 32 * ks + 8 * kg;
                            const f32x4 x0 = *(const LAS f32x4*)xp, x1 = *(const LAS f32x4*)(xp + 4);
                            u32x4 xw; xw.x = cvt_pk_bf16(x0[0], x0[1]); xw.y = cvt_pk_bf16(x0[2], x0[3]); xw.z = cvt_pk_bf16(x1[0], x1[1]); xw.w = cvt_pk_bf16(x1[2], x1[3]);
                            bf16x8 xf; __builtin_memcpy(&xf, &xw, 16);
                            ar = __builtin_amdgcn_mfma_f32_16x16x32_bf16(xf, wq[2 * ks], ar, 0, 0, 0);
                            ai = __builtin_amdgcn_mfma_f32_16x16x32_bf16(xf, wq[2 * ks + 1], ai, 0, 0, 0);
                        }
                        const int ch = g * 64 + 16 * ntile + tk;
                        const float br = CT[dir * 384 + ch], bi = CT[768 + dir * 384 + ch], sp8 = CT[1536 + dir * 384 + ch];
#pragma unroll
                        for (int j = 0; j < 4; ++j) { const int tok = 4 * kg + j;
                            const float la = sigm(ar[j] + br) * sp8, y = 2.0f * la;
                            const float av = 1.0f + la * (1.0f + la * (0.5f + la * (0.16666667f + la * (0.041666667f + la * 0.0083333333f))));
                            const float om = -y * (1.0f + y * (0.5f + y * (0.16666667f + y * (0.041666667f + y * (0.0083333333f + y * 0.0013888889f)))));
                            const float bt = __builtin_sqrtf(om) * sigm(ai[j] + bi) * XC[tok * 384 + ch];
                            AB[(dir * 16 + tok) * 384 + ch] = (f32x2){av, bt}; }
                    }
                    __syncthreads();
                    if (tid < 384) {
                        float hf = 0.f, pf = 1.f, hb = 0.f, pb = 1.f;
#pragma unroll
                        for (int t = 0; t < 16; ++t) {
                            const f32x2 f = AB[t * 384 + tid], bk = AB[(16 + 15 - t) * 384 + tid];
                            hf = f[0] * hf + f[1]; pf *= f[0]; hb = bk[0] * hb + bk[1]; pb *= bk[0];
                            AB[t * 384 + tid] = (f32x2){pf, hf}; AB[(16 + 15 - t) * 384 + tid] = (f32x2){pb, hb}; }
                        LAGG[((size_t)n * 2 + 0) * 384 + tid] = (f32x2){pf, hf}; LAGG[((size_t)n * 2 + 1) * 384 + tid] = (f32x2){pb, hb};
                    }
                    __syncthreads();
#pragma unroll
                    for (int i = 0; i < 12; ++i) { const int idx = tid + 512 * i, tok = idx / 384, ch = idx - tok * 384;
                        const f32x2 f = AB[idx], bk = AB[16 * 384 + idx];
                        bf16_t* o = LT + (size_t)(r0 + tok) * 1152 + ch;
                        o[0] = f2bf(f[1] + bk[1]); o[384] = f2bf(f[0]); o[768] = f2bf(bk[0]); }
                }
                __syncthreads();
            }
            {
                const int tid = opaque(tid0), lane = tid & 63;
                constexpr int ZS = SEQ + 16;
                LAS bf16_t* R0 = (LAS bf16_t*)lds;
                LAS bf16_t* R1 = R0 + 8224;
                LAS bf16_t* ZA = R1 + 8224;
                const LAS unsigned* Rdw = (const LAS unsigned*)lds;
#define HY_ZF(b, s) ((b) * ZS + ((s) & ~63) + (((((s) >> 3) & 7) ^ (((s) >> 7) & 1)) << 3) + ((s) & 7))
                const float* hcw = a.in[14] + l * 3 * 768; const float* hcb = a.in[15] + l * 768;
                const float* nrm = (const float*)(ctl + CW_HYN);
                bf16_t* YT = (bf16_t*)(ws + WS_YT);
                const int r32 = lane & 31, hh = lane >> 5, il = r32 >> 2, bq = r32 & 3, iblk = 8 * wave + il;
                const int x0b = 4095 - r32 + 8 * hh, par = x0b & 1;
                const int abase = (par ? 4112 : 0) + ((x0b - par) >> 1);
                for (int c = bid; c < 256; c += G) {
                    __syncthreads();
#pragma unroll 1
                    for (int it = tid; it < 3 * 4 * 512; it += 512) {
                        const int arr = it >> 11, b = (it >> 9) & 3, s8 = (it & 511) * 8, ch = arr * 256 + c;
                        const bf16_t* pp = PT + (size_t)ch * RT + b * SEQ + s8;
                        const u32x4 pv = *(const u32x4*)pp;
                        const float w0 = hcw[ch], w1 = hcw[768 + ch], w2 = hcw[1536 + ch], cb0 = hcb[ch];
                        float p[10];
                        p[0] = s8 > 0 ? bf2f(pp[-1]) : 0.f; p[9] = s8 + 8 < SEQ ? bf2f(pp[8]) : 0.f;
                        p[1] = bflo(pv.x); p[2] = bfhi(pv.x); p[3] = bflo(pv.y); p[4] = bfhi(pv.y); p[5] = bflo(pv.z); p[6] = bfhi(pv.z); p[7] = bflo(pv.w); p[8] = bfhi(pv.w);
                        float z[8];
#pragma unroll
                        for (int j = 0; j < 8; ++j) z[j] = cb0 + w0 * p[j] + w1 * p[j + 1] + w2 * p[j + 2];
                        u32x4 w; w.x = cvt_pk_bf16(z[0], z[1]); w.y = cvt_pk_bf16(z[2], z[3]); w.z = cvt_pk_bf16(z[4], z[5]); w.w = cvt_pk_bf16(z[6], z[7]);
                        *(LAS u32x4*)(ZA + arr * 4 * ZS + HY_ZF(b, s8)) = w;
                    }
#pragma unroll 1
                    for (int o = 0; o < 2; ++o) {
                        const bf16_t* kf = (const bf16_t*)(ws + WS_KFL) + ((size_t)((l * 2 + 0) * 2 + o) * 256 + c) * SEQ;
                        const bf16_t* kb = (const bf16_t*)(ws + WS_KFL) + ((size_t)((l * 2 + 1) * 2 + o) * 256 + c) * SEQ;
                        { unsigned tv[16];
#pragma unroll
                          for (int q = 0; q < 16; ++q) { const int x = tid + 512 * q; tv[q] = x < 4096 ? kf[4095 - x] : (x <= 8190 ? kb[x - 4095] : (bf16_t)0); }
                          PIN16(tv);
#pragma unroll
                          for (int q = 0; q < 16; ++q) R0[tid + 512 * q] = (bf16_t)tv[q]; }
                        __syncthreads();
                        for (int x = tid; x < 8192; x += 512) R1[x] = x < 8191 ? R0[x + 1] : (bf16_t)0;
                        __syncthreads();
                        const LAS bf16_t* Z = ZA + (o == 0 ? 0 : 4 * ZS) + bq * ZS;
                        typedef float f32x16 __attribute__((ext_vector_type(16)));
                        f32x16 acc0, acc1;
#pragma unroll
                        for (int q = 0; q < 16; ++q) { acc0[q] = 0.f; acc1[q] = 0.f; }
                        const int dlo = 8 * wave - 63, dhi = 8 * wave + 7;
#define HY_AF(dst, off_) do { const LAS unsigned* a_ = ap + (off_); u32x4 w_ = {a_[0], a_[1], a_[2], a_[3]}; __builtin_memcpy(&dst, &w_, 16); } while (0)
                        {
                            bf16x8 f16, f24;
                            { const LAS unsigned* ap = Rdw + abase - 32 * dlo; HY_AF(f16, 16); HY_AF(f24, 24); }
#pragma unroll 1
                            for (int dl = dlo; dl <= dhi; ++dl) {
                                const int j = iblk - dl; const bool ok = (j >= 0) && (j < 64); const int jc = j < 0 ? 0 : (j > 63 ? 63 : j);
                                const LAS bf16_t* zp = Z + jc * 64; const int sw = (jc >> 1) & 1;
                                const LAS unsigned* ap = Rdw + abase - 32 * dl;
                                bf16x8 bf[4], fm16, fm8, f0, f8;
#pragma unroll
                                for (int kk = 0; kk < 4; ++kk) { bf16x8 t = *(const LAS bf16x8*)(zp + (((2 * kk + hh) ^ sw) << 3)); bf[kk] = ok ? t : (bf16x8){0, 0, 0, 0, 0, 0, 0, 0}; }
                                HY_AF(fm16, -16); HY_AF(fm8, -8); HY_AF(f0, 0); HY_AF(f8, 8);
                                acc0 = __builtin_amdgcn_mfma_f32_32x32x16_bf16(f0, bf[0], acc0, 0, 0, 0);  acc1 = __builtin_amdgcn_mfma_f32_32x32x16_bf16(fm16, bf[0], acc1, 0, 0, 0);
                                acc0 = __builtin_amdgcn_mfma_f32_32x32x16_bf16(f8, bf[1], acc0, 0, 0, 0);  acc1 = __builtin_amdgcn_mfma_f32_32x32x16_bf16(fm8, bf[1], acc1, 0, 0, 0);
                                acc0 = __builtin_amdgcn_mfma_f32_32x32x16_bf16(f16, bf[2], acc0, 0, 0, 0); acc1 = __builtin_amdgcn_mfma_f32_32x32x16_bf16(f0, bf[2], acc1, 0, 0, 0);
                                acc0 = __builtin_amdgcn_mfma_f32_32x32x16_bf16(f24, bf[3], acc0, 0, 0, 0); acc1 = __builtin_amdgcn_mfma_f32_32x32x16_bf16(f8, bf[3], acc1, 0, 0, 0);
                                f16 = fm16; f24 = fm8;
                            }
                        }
#undef HY_AF
                        const float inv = 1.0f / (nrm[(l * 2 + o) * 256 + c] + 1e-6f), hb = a.in[23][(l * 2 + o) * 256 + c];
                        LAS bf16_t* GI = ZA + (o + 1) * 4 * ZS;
                        const LAS bf16_t* ZI = ZA + (o == 0 ? 0 : 4 * ZS);
#pragma unroll
                        for (int q = 0; q < 16; ++q) {
                            const int a0r = (q & 3) + 8 * (q >> 2) + 4 * hh, t0 = 64 * iblk + a0r, t1 = t0 + 32;
                            const int i0 = HY_ZF(bq, t0), i1 = HY_ZF(bq, t1);
                            const float zv0 = bf2f(ZI[i0]), zv1 = bf2f(ZI[i1]);
                            const float y0 = bf2f(GI[i0]) * (acc0[q] * inv + hb * zv0), y1v = bf2f(GI[i1]) * (acc1[q] * inv + hb * zv1);
                            GI[i0] = f2bf(y0); GI[i1] = f2bf(y1v);
                        }
                        __syncthreads();
                    }
                    for (int it = tid; it < 4 * 512; it += 512) { const int b = it >> 9, s8 = (it & 511) * 8;
                        *(u32x4*)(YT + (size_t)c * RT + b * SEQ + s8) = *(const LAS u32x4*)(ZA + 2 * 4 * ZS + HY_ZF(b, s8)); }
                    if (l == 0) {
                        __syncthreads();
                        LAS float* zc = (LAS float*)lds;
                        LAS float* kc = zc + 3072;
                        LAS float* y1c = kc + 1024;
                        for (int it = tid; it < 3072; it += 512) { const int arr = it >> 10, b = (it >> 8) & 3, sx = it & 255, ch = arr * 256 + c;
                            const bf16_t* pp = PT + (size_t)ch * RT + RL + b * CTXL + sx;
                            float z = hcb[ch] + hcw[768 + ch] * bf2f(pp[0]); if (sx > 0) z += hcw[ch] * bf2f(pp[-1]); if (sx + 1 < CTXL) z += hcw[1536 + ch] * bf2f(pp[1]);
                            zc[it] = z; }
                        for (int it = tid; it < 1024; it += 512) { const int o = it >> 9, d = (it & 511) - 256;
                            const bf16_t* kfc = (const bf16_t*)(ws + WS_KFC) + ((size_t)(0 * 2 + o) * 256 + c) * CTXL; const bf16_t* kbc = (const bf16_t*)(ws + WS_KFC) + ((size_t)(1 * 2 + o) * 256 + c) * CTXL;
                            kc[it] = d >= 0 ? bf2f(kfc[d]) : (d > -256 ? bf2f(kbc[-d]) : 0.f); }
                        __syncthreads();
#pragma unroll 1
                        for (int o = 0; o < 2; ++o) {
                            const float inv = 1.0f / (nrm[1024 + o * 256 + c] + 1e-6f), hb = a.in[23][o * 256 + c];
                            for (int it = tid; it < 1024; it += 512) { const int b = it >> 8, t = it & 255;
                                const LAS float* zi = o == 0 ? zc + b * 256 : y1c + b * 256;
                                const LAS float* kk = kc + o * 512 + 256 + t;
                                float acc = 0.f;
#pragma unroll 16
                                for (int sx = 0; sx < CTXL; ++sx) acc += kk[-sx] * zi[sx];
                                const float y = zc[(o + 1) * 1024 + b * 256 + t] * (acc * inv + hb * zi[t]);
                                if (o == 0) y1c[it] = y; else YT[(size_t)c * RT + RL + b * CTXL + t] = f2bf(y); }
                            __syncthreads();
                        }
                    }
                }
#undef HY_ZF
                __syncthreads();
            }
            {
                const pg8::TabSched S{PARTS.p + 18 + l * 3, (const char*)ws, 1, 80, G, bid};
                pg8::EpiS5State E{(float*)(ws + WS_S5S)};
                pg8::gemm_phase<512, 256>(lds, S, E);
            }
        }
        SEAM(P0 + 2);
        if (((PHMASK >> 14) & 1) && IN(P0 + 3)) {
            const int tid = opaque(tid0), lane = tid & 63;
            LAS float* st = (LAS float*)lds;
            const float* S5S = (const float*)(ws + WS_S5S); bf16_t* US = (bf16_t*)(ws + WS_US);
            for (int u = bid; u < 128; u += G) {
                const int d = u & 1, g = (u >> 1) & 15, b = u >> 5;
                __syncthreads();
                for (int i = tid; i < 272 * 32; i += 512) { const int q = i >> 5, c4 = (i & 31) * 4; const int n = q < 16 ? 1024 + 16 * b + q : 256 * b + (q - 16);
                    const f32x4 v = *(const f32x4*)(S5S + ((size_t)g * NCHKP + n) * 256 + d * 128 + c4);
                    st[q * 128 + c4] = v[0]; st[q * 128 + c4 + 1] = v[1]; st[q * 128 + c4 + 2] = v[2]; st[q * 128 + c4 + 3] = v[3]; }
                __syncthreads();
                if (wave == 0) {
                    const float* ab = (const float*)(ws + WS_AB16) + ((size_t)((l * 2 + d) * 16 + g) * 64 + lane) * 2;
                    const float ar = ab[0], ai = ab[1];
                    float hr = 0.f, hi = 0.f;
#pragma unroll 1
                    for (int k0 = 0; k0 < 272; k0 += 8) {
                        f32x2 sv[8]; int nn[8];
#pragma unroll
                        for (int j = 0; j < 8; ++j) { const int k = k0 + j; const int q = d == 0 ? k : (k < 16 ? 15 - k : 287 - k);
                            nn[j] = q < 16 ? 1024 + 16 * b + q : 256 * b + (q - 16); sv[j] = *(const LAS f32x2*)(st + q * 128 + 2 * lane); }
#pragma unroll
                        for (int j = 0; j < 8; ++j) {
                            *(unsigned*)(US + ((size_t)g * NCHKP + nn[j]) * 512 + 256 + d * 128 + 2 * lane) = cvt_pk_bf16(hr, hi);
                            const float nr = ar * hr - ai * hi + sv[j][0], ni = ar * hi + ai * hr + sv[j][1];
                            hr = nr; hi = ni; }
                    }
                }
            }
            __syncthreads();
            for (int uq = bid; uq < 176; uq += G) { if (uq < 128) continue; const int u = uq - 128;
                const int cb6 = u % 6, d = (u / 6) & 1, b = u / 12;
                LAS f32x2* sa = (LAS f32x2*)lds;
                const f32x2* LAGG = (const f32x2*)(ws + WS_LAGG); float* HIN = (float*)(ws + WS_LHIN);
                __syncthreads();
                for (int i = tid; i < 272 * 64; i += 512) { const int q = i >> 6, c = i & 63; const int n = q < 16 ? 1024 + 16 * b + q : 256 * b + (q - 16);
                    sa[i] = LAGG[((size_t)n * 2 + d) * 384 + cb6 * 64 + c]; }
                __syncthreads();
                if (wave == 0) {
                    float h = 0.f;
#pragma unroll 1
                    for (int k0 = 0; k0 < 272; k0 += 8) {
                        f32x2 sv[8]; int nn[8];
#pragma unroll
                        for (int j = 0; j < 8; ++j) { const int k = k0 + j; const int q = d == 0 ? k : (k < 16 ? 15 - k : 287 - k);
                            nn[j] = q < 16 ? 1024 + 16 * b + q : 256 * b + (q - 16); sv[j] = sa[q * 64 + lane]; }
#pragma unroll
                        for (int j = 0; j < 8; ++j) { HIN[((size_t)nn[j] * 2 + d) * 384 + cb6 * 64 + lane] = h; h = sv[j][0] * h + sv[j][1]; }
                    }
                }
            }
            __syncthreads();
        }
        SEAM(P0 + 3);
        if (((PHMASK >> 15) & 1) && IN(P0 + 4)) {
            const pg8::TabSched S{PARTS.p + 19 + l * 3, (const char*)ws, 1, 80, G, bid};
            pg8::EpiS5Main E{(bf16_t*)(ws + WS_GL), PR, a.in[32] + l * 256};
            pg8::gemm_phase<512, 512>(lds, S, E);
            {
                const int tid = opaque(tid0);
                const bf16_t* YT = (const bf16_t*)(ws + WS_YT);
                LAS bf16_t* tl = (LAS bf16_t*)lds;
                const int nrt = nMrow * 4;
                for (int t = bid; t < 4 * nrt; t += G) {
                    const int c0 = (t & 3) * 64, r0 = (t >> 2) * 64;
                    __syncthreads();
                    { const int cc = tid >> 3, r8 = (tid & 7) * 8; *(LAS u32x4*)(tl + cc * 72 + r8) = *(const u32x4*)(YT + (size_t)(c0 + cc) * RT + r0 + r8); }
                    __syncthreads();
                    { const int rr = tid >> 3, c8 = (tid & 7) * 8; unsigned short e[8];
#pragma unroll
                        for (int j = 0; j < 8; ++j) e[j] = tl[(c8 + j) * 72 + rr];
                        u32x4 w; w.x = e[0] | ((unsigned)e[1] << 16); w.y = e[2] | ((unsigned)e[3] << 16); w.z = e[4] | ((unsigned)e[5] << 16); w.w = e[6] | ((unsigned)e[7] << 16);
                        *(u32x4*)(YB + (size_t)(r0 + rr) * YW + YC_B + c0 + c8) = w; }
                }
                __syncthreads();
            }
            {
                const int tid = opaque(tid0);
                const bf16_t* LT = (const bf16_t*)(ws + WS_LT); const float* HIN = (const float*)(ws + WS_LHIN);
                const int nrows = nMrow * 256;
                for (int it = bid * 512 + tid; it < nrows * 48; it += G * 512) {
                    const int r = it / 48, c8 = (it - r * 48) * 8, n = r >> 4;
                    const u32x4 gt = *(const u32x4*)(PR + (size_t)r * LDP + PC_AG + c8);
                    const bf16_t* lt = LT + (size_t)r * 1152 + c8;
                    const u32x4 sv = *(const u32x4*)lt, pf = *(const u32x4*)(lt + 384), pb = *(const u32x4*)(lt + 768);
                    const float* hf = HIN + ((size_t)n * 2 + 0) * 384 + c8; const float* hb = hf + 384;
                    const f32x4 hf0 = *(const f32x4*)hf, hf1 = *(const f32x4*)(hf + 4), hb0 = *(const f32x4*)hb, hb1 = *(const f32x4*)(hb + 4);
                    u32x4 w;
                    w.x = cvt_pk_bf16(gelu_f(bflo(gt.x)) * (bflo(sv.x) + bflo(pf.x) * hf0[0] + bflo(pb.x) * hb0[0]), gelu_f(bfhi(gt.x)) * (bfhi(sv.x) + bfhi(pf.x) * hf0[1] + bfhi(pb.x) * hb0[1]));
                    w.y = cvt_pk_bf16(gelu_f(bflo(gt.y)) * (bflo(sv.y) + bflo(pf.y) * hf0[2] + bflo(pb.y) * hb0[2]), gelu_f(bfhi(gt.y)) * (bfhi(sv.y) + bfhi(pf.y) * hf0[3] + bfhi(pb.y) * hb0[3]));
                    w.z = cvt_pk_bf16(gelu_f(bflo(gt.z)) * (bflo(sv.z) + bflo(pf.z) * hf1[0] + bflo(pb.z) * hb1[0]), gelu_f(bfhi(gt.z)) * (bfhi(sv.z) + bfhi(pf.z) * hf1[1] + bfhi(pb.z) * hb1[1]));
                    w.w = cvt_pk_bf16(gelu_f(bflo(gt.w)) * (bflo(sv.w) + bflo(pf.w) * hf1[2] + bflo(pb.w) * hb1[2]), gelu_f(bfhi(gt.w)) * (bfhi(sv.w) + bfhi(pf.w) * hf1[3] + bfhi(pb.w) * hb1[3]));
                    *(u32x4*)(YB + (size_t)r * YW + YC_A + c8) = w;
                }
            }
        }
        SEAM(P0 + 4);
        if (((PHMASK >> 15) & 1) && IN(P0 + 5)) {
            const pg8::TabSched S{PARTS.p + 20 + l * 3, (const char*)ws, 1, nMrow, G, bid};
            pg8::EpiS5Glu E{YB, (const bf16_t*)(ws + WS_GL), a.in[34] + l * 256};
            pg8::gemm_phase<256, 256>(lds, S, E);
        }
        SEAM(P0 + 5);
        if (((PHMASK >> 3) & 1) && IN(P0 + 6)) {
            const pg8::MergeSched S{(const char*)ws, (long long)WS_YB, (long long)(WS_WL + (size_t)l * SZ_WL + SZ_WINR + SZ_WINHY), 64, G, bid, l == 0 ? 64 : 0};
            pg8::EpiGate E{ws + WS_GQ, UB, (bf16_t*)(ws + WS_MGC)};
            pg8::gemm_phase<1280, 1280>(lds, S, E);
        }
        SEAM(P0 + 6);
        if (((PHMASK >> 4) & 1) && IN(P0 + 7)) {
            const pg8::TabSched S{l == 0 ? PARTS.p + 24 : PARTS.p + 14, (const char*)ws, l == 0 ? 2 : 1, l == 0 ? 256 + 64 : 256, G, bid};
            pg8::EpiRes E{PRE, xlat, xctx, MODL + 2048, (float*)(ws + WS_EXTRA)};
            pg8::gemm_phase<1024, 1024>(lds, S, E);
        }
        SEAM(P0 + 7);
        if (((PHMASK >> 5) & 1) && IN(P0 + 8)) {
            const int lane = opaque(tid0) & 63;
            if (l == 1) convert_tiles_pipelined(a, JT_MOE, (LAS float*)lds, bid, G);
            const float* lg = a.in[40] + l * D; const float* lb = a.in[41] + l * D;
            const int nrows = nMrow * 256;
            for (int r = bid * 8 + wave; r < nrows; r += G * 8) {
                const float* mv = MODL + (size_t)(r < RL ? (r >> 12) : 4) * 6144;
                RowV pre;
                if (r < RL) { const RowV xin = row_load(xlat + (size_t)r * D, lane), ga = row_load_bf16((const bf16_t*)PRE + (size_t)r * D, lane);
#pragma unroll
                    for (int i = 0; i < 4; ++i) pre.v[i] = xin.v[i] * ALPHA + ga.v[i]; }
                else { const float* pp = (const float*)(ws + WS_EXTRA) + (size_t)(r - RL) * D; const RowV xin = row_load(ctx_in + (size_t)(r - RL) * D, lane), p0 = row_load(pp, lane), p1 = row_load(pp + (size_t)RC * D, lane), p2 = row_load(pp + (size_t)2 * RC * D, lane), p3 = row_load(pp + (size_t)3 * RC * D, lane);
#pragma unroll
                    for (int i = 0; i < 4; ++i) pre.v[i] = xin.v[i] * ALPHA + ((p0.v[i] + p1.v[i]) + (p2.v[i] + p3.v[i])); }
                const RowV x1 = row_affine(row_norm(pre), lg, lb, lane);
                row_store(r < RL ? a.out + (size_t)r * D : XSC + (size_t)(r - RL) * D, lane, x1);
                const RowV u2 = row_modulate(row_norm(x1), mv + 3072, mv + 4096, lane);
                row_store_bf16(UB + (size_t)r * D, lane, u2);
                if (l == 1) {
                    float lg8[8];
#pragma unroll
                    for (int e = 0; e < 8; ++e) lg8[e] = 0.f;
                    f32x4 rw[32];
#pragma unroll
                    for (int q = 0; q < 16; ++q) { const float* wp = a.in[47] + (size_t)(256 * (q >> 2) + 4 * lane + (q & 3)) * 8; rw[2 * q] = *(const f32x4*)wp; rw[2 * q + 1] = *(const f32x4*)(wp + 4); }
                    PIN16(rw); PIN16(rw + 16);
#pragma unroll
                    for (int i = 0; i < 4; ++i)
#pragma unroll
                        for (int j = 0; j < 4; ++j) { const float uv = u2.v[i][j];
                            const f32x4 w0 = rw[2 * (4 * i + j)], w1 = rw[2 * (4 * i + j) + 1];
                            lg8[0] += uv * w0[0]; lg8[1] += uv * w0[1]; lg8[2] += uv * w0[2]; lg8[3] += uv * w0[3]; lg8[4] += uv * w1[0]; lg8[5] += uv * w1[1]; lg8[6] += uv * w1[2]; lg8[7] += uv * w1[3]; }
#pragma unroll
                    for (int e = 0; e < 8; ++e) lg8[e] = wave_sum(lg8[e]);
                    if (lane == 0) {
                        int i1 = 0; float v1 = lg8[0];
#pragma unroll
                        for (int e = 1; e < 8; ++e) if (lg8[e] > v1) { v1 = lg8[e]; i1 = e; }
                        int i2 = 0; float v2 = -3.0e38f;
#pragma unroll
                        for (int e = 0; e < 8; ++e) if (e != i1 && lg8[e] > v2) { v2 = lg8[e]; i2 = e; }
                        const float e2 = expf(v2 - v1), w1 = 1.f / (1.f + e2), w2 = e2 / (1.f + e2);
                        int* tk = (int*)(ws + WS_TOK) + (size_t)r * 8;
                        tk[0] = i1; tk[1] = i2; ((float*)tk)[2] = w1; ((float*)tk)[3] = w2;
                        tk[4] = (int)atomicAdd(ctl + CW_MOECNT + 64 * i1, 1u); tk[5] = (int)atomicAdd(ctl + CW_MOECNT + 64 * i2, 1u);
                    }
                }
            }
        }
        SEAM(P0 + 8);
        if (l == 0) {
            if (((PHMASK >> 6) & 1) && IN(P0 + 9)) {
                const pg8::TabSched S{PARTS.p + 16, (const char*)ws, 1, 68 * 22, G, bid};
                pg8::EpiSwiglu E{(bf16_t*)(ws + WS_H), FF_DENSE, 0};
                pg8::gemm_phase<1024, 1024>(lds, S, E);
            }
            SEAM(P0 + 9);
            if (((PHMASK >> 7) & 1) && IN(P0 + 10)) {
                const pg8::TabSched S{PARTS.p + 26, (const char*)ws, 3, 256 + 48 + 16, G, bid};
                pg8::EpiRes E{PRE, a.out, XSC, MODL + 5120, (float*)(ws + WS_EXTRA)};
                pg8::gemm_phase<FF_DENSE, FF_DENSE>(lds, S, E);
            }
            SEAM(P0 + 10);
            if (((PHMASK >> 8) & 1) && IN(P0 + 11)) {
                const int lane = opaque(tid0) & 63;
                const float* lg = a.in[42]; const float* lb = a.in[43];
                const float* MODN = MOD + (size_t)5 * 6144;
                for (int r = bid * 8 + wave; r < RT; r += G * 8) {
                    const float* mv = MODN + (size_t)(r < RL ? (r >> 12) : 4) * 6144;
                    RowV pre;
                    if (r < RL) { const RowV xin = row_load(a.out + (size_t)r * D, lane), ga = row_load_bf16((const bf16_t*)PRE + (size_t)r * D, lane);
#pragma unroll
                        for (int i = 0; i < 4; ++i) pre.v[i] = xin.v[i] * ALPHA + ga.v[i]; }
                    else { const float* pp = (const float*)(ws + WS_EXTRA) + (size_t)(r - RL) * D; const RowV xin = row_load(XSC + (size_t)(r - RL) * D, lane), p0 = row_load(pp, lane), p1 = row_load(pp + (size_t)RC * D, lane), p2 = row_load(pp + (size_t)2 * RC * D, lane), p3 = row_load(pp + (size_t)3 * RC * D, lane);
#pragma unroll
                        for (int i = 0; i < 4; ++i) pre.v[i] = xin.v[i] * ALPHA + ((p0.v[i] + p1.v[i]) + (p2.v[i] + p3.v[i])); }
                    const RowV x2 = row_affine(row_norm(pre), lg, lb, lane);
                    row_store(r < RL ? a.out + (size_t)r * D : XSC + (size_t)(r - RL) * D, lane, x2);
                    row_store_bf16(UB + (size_t)r * D, lane, row_modulate(row_norm(x2), mv, mv + 1024, lane));
                }
            }
            SEAM(P0 + 11);
        } else {
            bf16_t* AG = (bf16_t*)(ws + WS_AG); float* slotw = (float*)(ws + WS_SLOTW); int* tile_e = (int*)(ws + WS_TILEE);
            if (((PHMASK >> 9) & 1) && IN(P0 + 9)) {
                const int tid = opaque(tid0), lane = tid & 63;
                int ts[NE + 1]; ts[0] = 0;
#pragma unroll
                for (int e = 0; e < NE; ++e) { const unsigned c = __hip_atomic_load(ctl + CW_MOECNT + 64 * e, __ATOMIC_RELAXED, __HIP_MEMORY_SCOPE_AGENT); ts[e + 1] = ts[e] + (int)((c + 255u) >> 8); }
                if (bid == 0) for (int mt = tid; mt < ts[NE]; mt += 512) { int e = 0;
#pragma unroll
                    for (int k = 1; k < NE; ++k) e += (mt >= ts[k]) ? 1 : 0;
                    tile_e[mt] = e; }
                for (int r = bid * 8 + wave; r < RL; r += G * 8) {
                    int* tk = (int*)(ws + WS_TOK) + (size_t)r * 8;
                    const u32x4 v0 = *(const u32x4*)(UB + (size_t)r * D + lane * 16), v1 = *(const u32x4*)(UB + (size_t)r * D + lane * 16 + 8);
#pragma unroll
                    for (int k = 0; k < 2; ++k) {
                        const int e = tk[k], pos = tk[4 + k];
                        int st = 0;
#pragma unroll
                        for (int q = 0; q < NE; ++q) st = (e == q) ? ts[q] : st;
                        const int srow = st * 256 + pos;
                        *(u32x4*)(AG + (size_t)srow * D + lane * 16) = v0; *(u32x4*)(AG + (size_t)srow * D + lane * 16 + 8) = v1;
                        if (lane == 0) { slotw[srow] = ((const float*)tk)[2 + k]; tk[6 + k] = srow; }
                    }
                }
            }
            SEAM(P0 + 9);
            int ttl = 0;
            if (lo <= P0 + 13 && P0 + 10 < hi) {
#pragma unroll
                for (int e = 0; e < NE; ++e) { const unsigned c = __hip_atomic_load(ctl + CW_MOECNT + 64 * e, __ATOMIC_RELAXED, __HIP_MEMORY_SCOPE_AGENT); ttl += (int)((c + 255u) >> 8); }
                ttl = __builtin_amdgcn_readfirstlane(ttl);
            }
#pragma unroll
            for (int pass = 0; pass < 2; ++pass) {
                const int tile0 = pass * MOE_P0; int ntile = pass == 0 ? (ttl < MOE_P0 ? ttl : MOE_P0) : ttl - MOE_P0; ntile = ntile < 0 ? 0 : (ntile > MOE_HCAP ? MOE_HCAP : ntile);
                if (((PHMASK >> 10) & 1) && IN(P0 + 10 + 2 * pass)) {
                    const pg8::MoeSched S{(const char*)AG + (size_t)tile0 * 256 * 1024 * 2, (const char*)(ws + WS_MOEGU), tile_e, 256u * 1024u * 2u, 256u * 1024u * 2u, (size_t)2 * FF_E * 1024 * 2, 28, 16, tile0, ntile, G, bid};
                    pg8::EpiSwiglu E{(bf16_t*)(ws + WS_HM), FF_E, tile0};
                    pg8::gemm_phase<1024, 1024>(lds, S, E);
                }
                SEAM(P0 + 10 + 2 * pass);
                if (((PHMASK >> 11) & 1) && IN(P0 + 11 + 2 * pass)) {
                    pg8::EpiMoeDown E{AG, slotw, (float*)(ws + WS_O2X)};
                    { const int nfull = pass == 0 ? ntile : (ttl < 128 ? ttl : 128) - MOE_P0, nex = pass == 0 ? 0 : ttl - 128;
                        const pg8::MoeTailSched S{(const char*)(ws + WS_HM), (const char*)(ws + WS_MOED), tile_e, tile0, nfull < 0 ? 0 : nfull, nex < 0 ? 0 : nex, G, bid};
                        pg8::gemm_phase<FF_E, FF_E>(lds, S, E); }
                }
                SEAM(P0 + 11 + 2 * pass);
            }
            if (((PHMASK >> 12) & 1) && IN(P0 + 14)) {
                const int lane = opaque(tid0) & 63;
                const float* lg = a.in[42] + D; const float* lb = a.in[43] + D;
                for (int r = bid * 8 + wave; r < RL; r += G * 8) {
                    const int* tk = (const int*)(ws + WS_TOK) + (size_t)r * 8;
                    const int sa = tk[6], sb = tk[7];
                    const bf16_t* oa = AG + (size_t)sa * D; const bf16_t* ob = AG + (size_t)sb * D;
                    const float* gv = MODL + (size_t)(r >> 12) * 6144 + 5120;
                    RowV x1 = row_load(a.out + (size_t)r * D, lane), gq = row_load(gv, lane), pre;
                    u32x2 va[4], vb[4];
#pragma unroll
                    for (int i = 0; i < 4; ++i) { va[i] = *(const u32x2*)(oa + 256 * i + 4 * lane); vb[i] = *(const u32x2*)(ob + 256 * i + 4 * lane); }
                    asm volatile("" : "+v"(va[0]), "+v"(va[1]), "+v"(va[2]), "+v"(va[3]), "+v"(vb[0]), "+v"(vb[1]), "+v"(vb[2]), "+v"(vb[3]), "+v"(x1.v[0]), "+v"(x1.v[1]), "+v"(x1.v[2]), "+v"(x1.v[3]), "+v"(gq.v[0]), "+v"(gq.v[1]), "+v"(gq.v[2]), "+v"(gq.v[3]));
#pragma unroll
                    for (int i = 0; i < 4; ++i) {
                        f32x4 fa = {bflo(va[i].x), bfhi(va[i].x), bflo(va[i].y), bfhi(va[i].y)}, fb = {bflo(vb[i].x), bfhi(vb[i].x), bflo(vb[i].y), bfhi(vb[i].y)};
                        if (sa >= 128 * 256) { const float* px = (const float*)(ws + WS_O2X) + (size_t)(sa - 128 * 256) * D + 256 * i + 4 * lane; fa = (*(const f32x4*)px + *(const f32x4*)(px + (size_t)2048 * D)) + (*(const f32x4*)(px + (size_t)2 * 2048 * D) + *(const f32x4*)(px + (size_t)3 * 2048 * D)); }
                        if (sb >= 128 * 256) { const float* px = (const float*)(ws + WS_O2X) + (size_t)(sb - 128 * 256) * D + 256 * i + 4 * lane; fb = (*(const f32x4*)px + *(const f32x4*)(px + (size_t)2048 * D)) + (*(const f32x4*)(px + (size_t)2 * 2048 * D) + *(const f32x4*)(px + (size_t)3 * 2048 * D)); }
                        pre.v[i] = x1.v[i] * ALPHA + gq.v[i] * (fa + fb); }
                    row_store(a.out + (size_t)r * D, lane, row_affine(row_norm(pre), lg, lb, lane));
                }
            }
        }
    }
#undef IN
#undef SEAM
}

}

extern "C" void kernel_launch(void* const* d_in, const int* in_sizes, int n_in, void* d_out, int out_size, void* d_ws, size_t ws_size, hipStream_t stream) {
    static int grid = 0;
    if (grid == 0) {
        if (n_in != 51 || ws_size < WS_END) { grid = -1; return; }
        int dev = 0, cus = 0;
        if (hipGetDevice(&dev) != hipSuccess || hipDeviceGetAttribute(&cus, hipDeviceAttributeMultiprocessorCount, dev) != hipSuccess) { grid = -1; return; }
        if (hipFuncSetAttribute((const void*)mk_fwd, hipFuncAttributeMaxDynamicSharedMemorySize, LDS_BYTES) != hipSuccess) { grid = -1; return; }
        grid = cus;
    }
    if (grid < 0) return;
    const float* const* in = (const float* const*)d_in;
    unsigned char* ws = (unsigned char*)d_ws;
    (void)hipMemsetAsync(ws + WS_CTL, 0, CTL_BYTES + al256(2 * 5 * 6144 * 4), stream);
    for (int l = 0; l < 2; ++l) (void)hipMemsetAsync(ws + WS_WL + (size_t)l * SZ_WL + SZ_WINR + (size_t)1152 * 1024 * 2, 0, (size_t)128 * 1024 * 2, stream);
    Args a{};
    for (int i = 0; i < 51; ++i) a.in[i] = in[i];
    a.out = (float*)d_out; a.ws = ws;
    int nlaunch = 0;
    auto run1 = [&](int lo, int hi) { a.ph_lo = lo; a.ph_hi = hi; a.bar_region = nlaunch < 5 ? nlaunch : 5; nlaunch++; hipLaunchKernelGGL(mk_fwd, dim3(grid), dim3(512), LDS_BYTES, stream, a); };
    auto run = [&](int lo, int hi) {
#if defined(SPLIT) && SPLIT
        for (int k = lo; k < hi; ++k) { const int q = (k - 1) % NPH_LAYER, l = (k - 1) / NPH_LAYER; if (k > 0 && (q > 14 || (l == 0 && q > 11) || (l == 1 && q == 0))) continue; run1(k, k + 1); }
#else
        run1(lo, hi);
#endif
    };
    run(0, 1 + 2 * NPH_LAYER);
}
```

```cpp
#include <hip/hip_runtime.h>
#include <stdint.h>
#include <math.h>

#define LAS __attribute__((address_space(3)))
typedef unsigned short bf16_t;
typedef short bf16x8 __attribute__((ext_vector_type(8)));
typedef float f32x4 __attribute__((ext_vector_type(4)));
typedef float f32x2 __attribute__((ext_vector_type(2)));
typedef unsigned u32x4 __attribute__((ext_vector_type(4)));
typedef unsigned u32x2 __attribute__((ext_vector_type(2)));

namespace {
constexpr int D = 1024, NB = 4, SEQ = 4096, CTXL = 256;
constexpr int RL = NB * SEQ, RC = NB * CTXL, RT = RL + RC;
constexpr int IN_COLS = 7040;
constexpr int FF_DENSE = 2816, NE = 8, FF_E = 3584;
constexpr float ALPHA = 1.41421356237309515f;
constexpr int LDP = 1792, PC_AG = 0, PC_AC = 384, PC_D = 768, PC_Q = 1024, PC_K = 1408, PC_G = 1792;
constexpr int NPT = 1280, PT_V = 768;
constexpr int YW = 1280, YC_A = 0, YC_B = 384, YC_C = 640, YC_D = 1024;
constexpr int MOE_P0 = 64, MOE_HCAP = 72;
constexpr int MOE_ROWS_MAX = 2 * RL + NE * 256;

constexpr size_t al256(size_t x) { return (x + 255) & ~(size_t)255; }
constexpr size_t WS_CTL = 0, CTL_BYTES = 131072;
constexpr int CW_BAR = 0;
constexpr int CW_MOECNT = 24576;
constexpr int CW_QUEUE = 28672;
constexpr int CW_HYN = 29696;
constexpr size_t WS_MOD = WS_CTL + CTL_BYTES;
constexpr size_t WS_HYN = WS_MOD + al256(2 * 5 * 6144 * 4);
constexpr size_t WS_S5AB = WS_HYN + 4096;
constexpr size_t WS_S5BB = WS_S5AB + 16384;
constexpr size_t WS_AB16 = WS_S5BB + 262144;
constexpr size_t WS_TILEE = WS_AB16 + 32768;
constexpr size_t WS_TOK = WS_TILEE + 1024;
constexpr size_t WS_SLOTW = WS_TOK + (size_t)RL * 32;
constexpr size_t WS_KFL = al256(WS_SLOTW + (size_t)MOE_ROWS_MAX * 4);
constexpr size_t WS_KFC = WS_KFL + (size_t)2 * 1024 * SEQ * 2;
constexpr size_t WS_XSC = WS_KFC + (size_t)1024 * CTXL * 2;
constexpr size_t WS_UB = WS_XSC + (size_t)RC * D * 4;
constexpr size_t SZ_WINR = (size_t)(1792 + 4096) * 1024 * 2, SZ_WINHY = (size_t)NPT * 1024 * 2, SZ_WBR = (size_t)1024 * 1280 * 2, SZ_WOUT = (size_t)1024 * 1024 * 2;
constexpr size_t SZ_WL = SZ_WINR + SZ_WINHY + SZ_WBR + SZ_WOUT;
constexpr size_t WS_WL = WS_UB + (size_t)RT * D * 2;
constexpr size_t WS_FFGU = WS_WL + 2 * SZ_WL;
constexpr size_t WS_FFD = WS_FFGU + (size_t)2 * FF_DENSE * 1024 * 2;
constexpr size_t WS_WGLU = WS_FFD + (size_t)1024 * FF_DENSE * 2;
constexpr size_t WS_OPS = WS_WGLU + (size_t)2 * 256 * 256 * 2;
constexpr size_t WS_OPY = WS_OPS + (size_t)32 * 256 * 256 * 2;
constexpr size_t WS_LW = WS_OPY + (size_t)32 * 256 * 512 * 2;
constexpr size_t WS_PR = WS_LW + (size_t)48 * 4096 * 2;
constexpr size_t WS_PT = WS_PR + (size_t)RT * 5888 * 2;
constexpr size_t WS_GQ = WS_PR + (size_t)RT * LDP * 2;
constexpr size_t WS_YB = WS_PT + (size_t)NPT * RT * 2;
constexpr size_t WS_PRE = WS_YB + (size_t)RT * YW * 2;
constexpr size_t WS_EXTRA = WS_PRE + (size_t)RT * D * 4;
constexpr size_t SZ_EXTRA = (size_t)2 * RT * 384 * 4 + (size_t)RT * 256 * 4;
constexpr size_t WS_END = WS_EXTRA + SZ_EXTRA;
constexpr int NCHK = RT / 16, NCHKP = 1280;
constexpr size_t WS_US = WS_PRE;
constexpr size_t WS_S5S = WS_US + (size_t)16 * NCHKP * 512 * 2;
constexpr size_t WS_GL = WS_S5S + (size_t)16 * NCHKP * 256 * 4;
static_assert(WS_GL + (size_t)RT * 256 * 2 <= WS_EXTRA, "s5 overlay");
constexpr size_t WS_H = WS_PR;
constexpr size_t WS_MOEGU = WS_PR;
constexpr size_t WS_MOED = WS_MOEGU + (size_t)NE * 2 * FF_E * 1024 * 2;
constexpr size_t WS_HM = WS_MOED + (size_t)NE * 1024 * FF_E * 2;
constexpr size_t WS_LT = WS_EXTRA;
constexpr size_t WS_LAGG = WS_LT + (size_t)RT * 3 * 384 * 2;
constexpr size_t WS_LHIN = WS_LAGG + (size_t)NCHK * 2 * 384 * 8;
constexpr size_t WS_YT = WS_LHIN + (size_t)NCHK * 2 * 384 * 4;
static_assert(WS_YT + (size_t)256 * RT * 2 <= WS_EXTRA + SZ_EXTRA, "lru / hyena overlay");
constexpr size_t WS_MGC = WS_EXTRA + (size_t)4 * RC * D * 4;
constexpr size_t WS_AG = WS_EXTRA;
static_assert(WS_HM + (size_t)MOE_HCAP * 256 * FF_E * 2 <= WS_EXTRA, "moe hidden overlay");
constexpr size_t WS_O2X = WS_PRE + ((size_t)32 << 20);
static_assert(WS_HM + (size_t)MOE_HCAP * 256 * FF_E * 2 <= WS_O2X && WS_O2X + (size_t)4 * 2048 * D * 4 <= WS_EXTRA, "moe excess sums");
static_assert((size_t)MOE_ROWS_MAX * 1024 * 2 <= SZ_EXTRA, "moe gather overlay");
static_assert((size_t)RT * FF_DENSE * 2 <= (size_t)RT * 5888 * 2 && WS_GQ + (size_t)RT * 4096 <= WS_PT, "dense hidden overlay / gate bytes");

__device__ __forceinline__ float sigm(float x) { return __builtin_amdgcn_rcpf(1.f + __builtin_amdgcn_exp2f(-1.44269504089f * x)); }
__device__ __forceinline__ float sigm_acc(float x) { return 1.f / (1.f + expf(-x)); }
__device__ __forceinline__ float silu_acc(float x) { return x / (1.f + expf(-x)); }
__device__ __forceinline__ float gelu_t(float x) { return 0.5f * x * (1.f + tanhf(0.7978845608028654f * (x + 0.044715f * x * x * x))); }
__device__ __forceinline__ float gelu_f(float x) { return x * sigm(1.5957691216057308f * (x + 0.044715f * x * x * x)); }
__device__ __forceinline__ float softplus(float x) { return fmaxf(x, 0.f) + log1pf(expf(-fabsf(x))); }
__device__ __forceinline__ float wave_sum(float v) { for (int o = 32; o; o >>= 1) v += __shfl_xor(v, o); return v; }
__device__ __forceinline__ float wave_max(float v) { for (int o = 32; o; o >>= 1) v = fmaxf(v, __shfl_xor(v, o)); return v; }
__device__ __forceinline__ float bf2f(bf16_t b) { return __uint_as_float(((unsigned)b) << 16); }
__device__ __forceinline__ bf16_t f2bf(float f) { unsigned u = __float_as_uint(f); u += 0x7FFFu + ((u >> 16) & 1u); return (bf16_t)(u >> 16); }
__device__ __forceinline__ unsigned cvt_pk_bf16(float lo, float hi) { unsigned r; asm volatile("v_cvt_pk_bf16_f32 %0, %1, %2" : "=v"(r) : "v"(lo), "v"(hi)); return r; }
__device__ __forceinline__ float bflo(unsigned w) { return __uint_as_float(w << 16); }
__device__ __forceinline__ float bfhi(unsigned w) { return __uint_as_float(w & 0xFFFF0000u); }
__device__ __forceinline__ void row_seq(int r, int& start, int& len, int& pos, int& b) {
    if (r < RL) { b = r >> 12; start = b << 12; len = SEQ; pos = r & 4095; }
    else { const int q = r - RL; b = q >> 8; start = RL + (b << 8); len = CTXL; pos = q & 255; }
}

#define XB_TMO      128
#define XB_XCNT(j)  (256  + 64 * (j))
#define XB_XSUB(j)  (1280 + 64 * (j))
#define XB_XGEN(j)  (2304 + 64 * (j))
#define XB_TOP      3328
#define XB_TOPGEN   3392
#define XCD_BAR_WORDS 3456
#define XB_SPIN_CAP (1u << 18)
__device__ __forceinline__ unsigned xb_ld(unsigned* p)              { return __hip_atomic_load(p, __ATOMIC_RELAXED, __HIP_MEMORY_SCOPE_AGENT); }
__device__ __forceinline__ unsigned xb_add(unsigned* p, unsigned v) { return __hip_atomic_fetch_add(p, v, __ATOMIC_RELAXED, __HIP_MEMORY_SCOPE_AGENT); }
__device__ __forceinline__ unsigned xb_xcc_id() { return (unsigned)__builtin_amdgcn_s_getreg((3 << 11) | 20) & 0xFu; }
#define XB_SPIN(cond, bar) do { unsigned _sp = 0; while (cond) { __builtin_amdgcn_s_sleep(1); \
    if ((++_sp & 255u) == 0u) { if (xb_ld(&(bar)[XB_TMO])) break; if (_sp > XB_SPIN_CAP) { atomicAdd(&(bar)[XB_TMO], 1u); break; } } } } while (0)
struct XcdBarrier { unsigned* bar; unsigned x; volatile LAS unsigned* st; };
__device__ __forceinline__ XcdBarrier xcd_barrier_post(unsigned* bar, volatile LAS unsigned* st) {
    XcdBarrier b; b.bar = bar; b.x = xb_xcc_id(); b.st = st;
    if (threadIdx.x == 0) (void)xb_add(&bar[XB_XCNT(b.x)], 1u);
    return b;
}
__device__ __forceinline__ void xcd_barrier_complete(unsigned* bar, unsigned x, unsigned& nloc, unsigned& nx) {
    const unsigned G = gridDim.x * gridDim.y * gridDim.z;
    unsigned sum, cnt, mine, sp = 0u;
    for (;;) {
        sum = 0u; cnt = 0u; mine = 0u;
#pragma unroll
        for (unsigned j = 0; j < 16; ++j) { const unsigned c = xb_ld(&bar[XB_XCNT(j)]); sum += c; cnt += (c > 0u) ? 1u : 0u; mine = (j == x) ? c : mine; }
        if (sum == G) break;
        __builtin_amdgcn_s_sleep(1);
        if ((++sp & 255u) == 0u) { if (xb_ld(&bar[XB_TMO])) break; if (sp > XB_SPIN_CAP) { atomicAdd(&bar[XB_TMO], 1u); break; } }
    }
    nloc = mine > 0u ? mine : 1u; nx = cnt > 0u ? cnt : 1u;
}
__device__ __forceinline__ void xcd_barrier(const XcdBarrier& b) {
    asm volatile("s_waitcnt vmcnt(0)" ::: "memory");
    __syncthreads();
    if (threadIdx.x == 0) {
        unsigned* bar = b.bar;
        __builtin_amdgcn_s_waitcnt(0);
        unsigned nloc = b.st[0], nx = b.st[1];
        if (nloc == 0u) { xcd_barrier_complete(bar, b.x, nloc, nx); b.st[0] = nloc; b.st[1] = nx; }
        const unsigned old = xb_add(&bar[XB_XSUB(b.x)], 1u);
        const unsigned gen = old / nloc;
        if (old + 1u == (gen + 1u) * nloc) {
            __builtin_amdgcn_fence(__ATOMIC_RELEASE, "agent");
            asm volatile("s_waitcnt vmcnt(0)" ::: "memory");
            const unsigned og = xb_add(&bar[XB_TOP], 1u);
            const unsigned tg = og / nx;
            if (og + 1u == (tg + 1u) * nx) xb_add(&bar[XB_TOPGEN], 1u);
            else XB_SPIN(xb_ld(&bar[XB_TOPGEN]) == tg, bar);
            __builtin_amdgcn_fence(__ATOMIC_ACQUIRE, "agent");
            xb_add(&bar[XB_XGEN(b.x)], 1u);
            asm volatile("s_waitcnt vmcnt(0)" ::: "memory");
        } else {
            XB_SPIN(xb_ld(&bar[XB_XGEN(b.x)]) == gen, bar);
            __builtin_amdgcn_fence(__ATOMIC_ACQUIRE, "agent");
            asm volatile("s_waitcnt vmcnt(0)" ::: "memory");
        }
    }
    __syncthreads();
}

namespace pg8 {
constexpr int BM = 256, BK = 64, HALF = 128, HTB = HALF * BK * 2, STAGE_BYTES = 8 * HTB, NXCD = 8, WGM = 8;
__host__ __device__ __forceinline__ int lds_byte(int r, int c) { const int st = (r >> 4) * 2 + (c >> 5), rr = r & 15, cc = c & 31, ob = rr * 64 + cc * 2; return st * 1024 + (ob ^ (((ob >> 9) & 1) << 5)); }
__host__ __device__ __forceinline__ void stage_rc(int b, int& R, int& C) { const int st = b / 1024, sb = b % 1024, swz = sb ^ (((sb >> 9) & 1) << 5); R = (st >> 1) * 16 + swz / 64; C = (st & 1) * 32 + (swz % 64) / 2; }
__host__ __device__ __forceinline__ int perm32(int rho) { const int n = rho >> 4, i = rho & 15; return 8 * (i >> 2) + 4 * n + (i & 3); }

struct Unit { const char* a; const char* b; int nt; int pm, pn, kind; };

__device__ __forceinline__ void rect_map(int wgid, int nM, int nN, int& pm, int& pn) {
    const int nwg = nM * nN;
    { const int q = nwg / NXCD, r = nwg % NXCD, xcd = wgid % NXCD, off = wgid / NXCD; wgid = (xcd < r ? xcd * (q + 1) : r * (q + 1) + (xcd - r) * q) + off; }
    const int nig = WGM * nN, gid = wgid / nig, fm = gid * WGM, gsz = (nM - fm) < WGM ? (nM - fm) : WGM;
    pm = fm + ((wgid % nig) % gsz); pn = (wgid % nig) / gsz;
}

template <int lda, int ldb, class Epi, class Sched>
__device__ __forceinline__ void gemm_phase(LAS unsigned char* lds, const Sched& S, const Epi& E) {
    int tid_ = threadIdx.x; asm volatile("" : "+v"(tid_));
    const int tid = tid_, wid = __builtin_amdgcn_readfirstlane(tid >> 6), lane = tid & 63, wr = wid >> 2, wc = wid & 3, fr = lane & 15, fq = lane >> 4;
    unsigned voffA[2], voffB[2];
#pragma unroll
    for (int i = 0; i < 2; ++i) { int R, C; stage_rc(tid * 16 + i * 8192, R, C); const int Rb = (R & ~31) + perm32(R & 31);
        voffA[i] = (unsigned)(R * lda + C) * 2u; voffB[i] = (unsigned)(Rb * ldb + C) * 2u; }
    const size_t kstep = (size_t)(BK * 2);
    const size_t hstepA = (size_t)HALF * lda * 2, hstepB = (size_t)HALF * ldb * 2;
    const unsigned ldsw = (unsigned)wid * 1024u;
    const int aoff = lds_byte(wr * 64 + fr, fq * 8), boff = lds_byte(wc * 32 + fr, fq * 8);
#define PG8_SA(b, h) (((b) * 2 + (h)) * HTB)
#define PG8_SB(b, h) ((4 + (b) * 2 + (h)) * HTB)
#define PG8_STAGE(bufoff, gbase, voff) do { _Pragma("unroll") for (int _i = 0; _i < 2; ++_i) \
        __builtin_amdgcn_global_load_lds((const unsigned*)((const char*)(gbase) + (voff)[_i]), (LAS unsigned*)(lds + (bufoff) + ldsw + _i * 8192), 16, 0, 0); } while (0)
#define PG8_LDA(dst, b, h) do { _Pragma("unroll") for (int m = 0; m < 4; ++m) _Pragma("unroll") for (int k = 0; k < 2; ++k) dst[m][k] = *(const LAS bf16x8*)(lds + PG8_SA(b, h) + aoff + m * 2048 + k * 1024); } while (0)
#define PG8_LDB(dst, b, h) do { _Pragma("unroll") for (int n = 0; n < 2; ++n) _Pragma("unroll") for (int k = 0; k < 2; ++k) dst[n][k] = *(const LAS bf16x8*)(lds + PG8_SB(b, h) + boff + n * 2048 + k * 1024); } while (0)
#define PG8_MMA(ai, bj, At, Bt) do { __builtin_amdgcn_s_setprio(1); _Pragma("unroll") for (int m = 0; m < 4; ++m) _Pragma("unroll") for (int n = 0; n < 2; ++n) _Pragma("unroll") for (int k = 0; k < 2; ++k) \
        acc[ai][bj][m][n] = __builtin_amdgcn_mfma_f32_16x16x32_bf16(Bt[n][k], At[m][k], acc[ai][bj][m][n], 0, 0, 0); __builtin_amdgcn_s_setprio(0); } while (0)
#define PG8_WAIT_V(n) asm volatile("s_waitcnt vmcnt(" #n ")" ::: "memory")
#define PG8_WAIT_L(n) asm volatile("s_waitcnt lgkmcnt(" #n ")" ::: "memory")
#define PG8_BAR __builtin_amdgcn_s_barrier()
#define PG8_SCHED __builtin_amdgcn_sched_barrier(0)
    Unit cur, nxt; int ui = 0;
    if (!S.next(0, cur)) return;
    f32x4 acc[2][2][4][2];
#pragma unroll
    for (int a = 0; a < 2; ++a)
#pragma unroll
        for (int b = 0; b < 2; ++b)
#pragma unroll
            for (int m = 0; m < 4; ++m)
#pragma unroll
                for (int n = 0; n < 2; ++n) acc[a][b][m][n] = (f32x4){0.f, 0.f, 0.f, 0.f};
    bf16x8 At[4][2], B0[2][2], B1[2][2];
    const char* cA = cur.a; const char* cB = cur.b;
    PG8_STAGE(PG8_SB(0, 0), cB, voffB); PG8_STAGE(PG8_SA(0, 0), cA, voffA); PG8_STAGE(PG8_SB(0, 1), cB + hstepB, voffB); PG8_STAGE(PG8_SA(0, 1), cA + hstepA, voffA);
    if (wr == 1) PG8_BAR;
    PG8_WAIT_V(4); PG8_BAR;
    PG8_STAGE(PG8_SB(1, 0), cB + kstep, voffB); PG8_STAGE(PG8_SA(1, 0), cA + kstep, voffA); PG8_STAGE(PG8_SB(1, 1), cB + hstepB + kstep, voffB);
    PG8_WAIT_V(6); PG8_BAR;
    for (;;) {
        const bool has_next = S.next(ui + 1, nxt);
        const char* nA = has_next ? nxt.a : cA; const char* nB = has_next ? nxt.b : cB;
        const int nt = cur.nt;
        for (int t = 0; t < nt; t += 2) {
            const bool last = (t == nt - 2);
            const char* a1 = cA + (size_t)(t + 1) * kstep;
            const char* a2 = last ? nA : cA + (size_t)(t + 2) * kstep; const char* b2 = last ? nB : cB + (size_t)(t + 2) * kstep;
            const char* a3 = a2 + kstep; const char* b3 = b2 + kstep;
            PG8_LDB(B0, 0, 0); PG8_SCHED; PG8_LDA(At, 0, 0); PG8_STAGE(PG8_SA(1, 1), a1 + hstepA, voffA);
            PG8_WAIT_L(8); PG8_BAR; PG8_WAIT_L(0); PG8_MMA(0, 0, At, B0); PG8_BAR; PG8_SCHED;
            PG8_LDB(B1, 0, 1); PG8_STAGE(PG8_SB(0, 0), b2, voffB);
            PG8_BAR; PG8_WAIT_L(0); PG8_MMA(0, 1, At, B1); PG8_BAR;
            PG8_LDA(At, 0, 1); PG8_STAGE(PG8_SA(0, 0), a2, voffA);
            PG8_BAR; PG8_WAIT_L(0); PG8_MMA(1, 0, At, B0); PG8_BAR; PG8_SCHED;
            PG8_STAGE(PG8_SB(0, 1), b2 + hstepB, voffB);
            PG8_WAIT_V(6); PG8_BAR; PG8_MMA(1, 1, At, B1); PG8_BAR;
            PG8_LDB(B0, 1, 0); PG8_SCHED; PG8_LDA(At, 1, 0); PG8_STAGE(PG8_SA(0, 1), a2 + hstepA, voffA);
            PG8_WAIT_L(8); PG8_BAR; PG8_WAIT_L(0); PG8_MMA(0, 0, At, B0); PG8_BAR; PG8_SCHED;
            PG8_LDB(B1, 1, 1); PG8_STAGE(PG8_SB(1, 0), b3, voffB);
            PG8_BAR; PG8_WAIT_L(0); PG8_MMA(0, 1, At, B1); PG8_BAR;
            PG8_LDA(At, 1, 1); PG8_STAGE(PG8_SA(1, 0), a3, voffA);
            PG8_BAR; PG8_WAIT_L(0); PG8_MMA(1, 0, At, B0); PG8_BAR; PG8_SCHED;
            PG8_STAGE(PG8_SB(1, 1), b3 + hstepB, voffB);
            PG8_WAIT_V(6); PG8_BAR; PG8_MMA(1, 1, At, B1); PG8_BAR;
        }
        E(acc, cur, wr, wc, fr, fq);
        if (!has_next) break;
        if (!(Sched::KEEP_ACC && nxt.kind >= 1 && nxt.kind <= 3)) {
#pragma unroll
        for (int a = 0; a < 2; ++a)
#pragma unroll
            for (int b = 0; b < 2; ++b)
#pragma unroll
                for (int m = 0; m < 4; ++m)
#pragma unroll
                    for (int n = 0; n < 2; ++n) acc[a][b][m][n] = (f32x4){0.f, 0.f, 0.f, 0.f};
        }
        cur = nxt; cA = nA; cB = nB; ++ui;
    }
    PG8_WAIT_V(0);
    if (wr == 0) PG8_BAR;
    PG8_BAR;
#undef PG8_SA
#undef PG8_SB
#undef PG8_STAGE
#undef PG8_LDA
#undef PG8_LDB
#undef PG8_MMA
#undef PG8_WAIT_V
#undef PG8_WAIT_L
#undef PG8_BAR
#undef PG8_SCHED
}

struct PartC { long long aOff, bOff; unsigned aStep, bStep; int nM, nN, nt, kind, start, nGrp; unsigned aGrp, bGrp; };
struct TabSched {
    static constexpr bool KEEP_ACC = false;
    const PartC* parts; const char* ws; int np, total, G, c;
    __device__ __forceinline__ bool next(int i, Unit& u) const {
        const int L = i * G + c; if (L >= total) return false;
        int q = 0;
#pragma unroll
        for (int k = 1; k < 4; ++k) if (k < np && L >= parts[k].start) q = k;
        const PartC P = parts[q];
        const int per = P.nM * P.nN, idx = L - P.start, grp = idx / per;
        int pm, pn; rect_map(idx - grp * per, P.nM, P.nN, pm, pn);
        u.a = ws + P.aOff + (size_t)grp * P.aGrp + (size_t)pm * P.aStep; u.b = ws + P.bOff + (size_t)grp * P.bGrp + (size_t)pn * P.bStep; u.nt = P.nt; u.pm = pm; u.pn = pn; u.kind = P.kind + grp; return true;
    }
};
struct MergeSched {
    static constexpr bool KEEP_ACC = true;
    const char* ws; long long aOff, bOff; int nM, G, c;
    int nCtx;
    __device__ __forceinline__ bool next(int i, Unit& u) const {
        int T = (i >> 2) * G + c, br = i & 3; bool ctxu = false;
        if (T >= nM * 4) {
            const int j = (i - 4 * ((nM * 4 - c + G - 1) / G)) * G + c;
            if (j < 0 || j >= nCtx) return false;
            T = nM * 4 + (j >> 2); br = j & 3; ctxu = true;
        }
        int pm, pn;
        if (!ctxu) rect_map(T, nM, 4, pm, pn); else { const int t = T - nM * 4; pm = nM + (t >> 2); pn = t & 3; }
        const int ko = br == 0 ? 0 : (br == 1 ? 384 : (br == 2 ? 640 : 1024));
        u.a = ws + aOff + (size_t)pm * (256u * 1280u * 2u) + ko * 2; u.b = ws + bOff + (size_t)pn * (256u * 1280u * 2u) + ko * 2; u.nt = (br & 1) ? 4 : 6; u.pm = pm; u.pn = pn; u.kind = ctxu ? 4 + br : br; return true;
    }
};
struct MoeSched {
    static constexpr bool KEEP_ACC = false;
    const char* A; const char* B; const int* tile_e; unsigned aStep, bStep; size_t bExp; int nN, nt, tile0, ntile, G, c;
    __device__ __forceinline__ bool next(int i, Unit& u) const {
        const int L = i * G + c; if (L >= ntile * nN) return false;
        const int mt = tile0 + L / nN, pn = L % nN;
        const int e = __builtin_amdgcn_readfirstlane(__hip_atomic_load(tile_e + mt, __ATOMIC_RELAXED, __HIP_MEMORY_SCOPE_AGENT));
        u.a = A + (size_t)(mt - tile0) * aStep; u.b = B + (size_t)e * bExp + (size_t)pn * bStep; u.nt = nt; u.pm = mt; u.pn = pn; u.kind = e; return true;
    }
};

struct MoeTailSched {
    static constexpr bool KEEP_ACC = false;
    const char* A; const char* B; const int* tile_e; int tile0, nfull, nex, G, c;
    __device__ __forceinline__ bool next(int i, Unit& u) const {
        const int L = i * G + c; int mt, pn, nt = 56, flag = 0; size_t koff = 0;
        if (L < nfull * 4) { mt = tile0 + (L >> 2); pn = L & 3; }
        else { const int idx = L - nfull * 4; if (idx >= nex * 16) return false; const int sp = idx & 3, tu = idx >> 2; mt = 128 + (tu >> 2); pn = tu & 3; nt = 14; koff = (size_t)sp * 14 * 128; flag = 8 + 16 * sp; }
        const int e = __builtin_amdgcn_readfirstlane(__hip_atomic_load(tile_e + mt, __ATOMIC_RELAXED, __HIP_MEMORY_SCOPE_AGENT));
        u.a = A + (size_t)(mt - tile0) * (256u * (unsigned)FF_E * 2u) + koff; u.b = B + (size_t)e * ((size_t)1024 * FF_E * 2) + (size_t)pn * (256u * (unsigned)FF_E * 2u) + koff;
        u.nt = nt; u.pm = mt; u.pn = pn; u.kind = e | flag; return true;
    }
};

#define EPI_ROWS(u) const int row0 = (u).pm * BM + wr * 64 + fr, colt = wc * 32 + 8 * fq
struct EpiProj {
    bf16_t* PRp; bf16_t* PTp; bf16_t* USp; int sig_from; unsigned char* GQp;
    __device__ __forceinline__ void operator()(const f32x4 (&acc)[2][2][4][2], const Unit& u, int wr, int wc, int fr, int fq) const {
        EPI_ROWS(u);
        bf16_t* base = u.kind == 1 ? PTp : PRp; const int ldc = u.kind == 1 ? RT : LDP; const bool sg = (u.kind == 0 && u.pn >= sig_from);
        if (sg) {
#pragma unroll
            for (int ai = 0; ai < 2; ++ai)
#pragma unroll
                for (int m = 0; m < 4; ++m) { unsigned char* rowp = GQp + (size_t)(row0 + ai * HALF + m * 16) * 4096 + (u.pn - sig_from) * BM + colt;
#pragma unroll
                    for (int bj = 0; bj < 2; ++bj) { const f32x4 v0 = acc[ai][bj][m][0], v1 = acc[ai][bj][m][1];
                        unsigned lo = 0u, hi = 0u;
                        lo = __builtin_amdgcn_cvt_pk_u8_f32(sigm(v0[0]) * 255.0f, 0, lo); lo = __builtin_amdgcn_cvt_pk_u8_f32(sigm(v0[1]) * 255.0f, 1, lo); lo = __builtin_amdgcn_cvt_pk_u8_f32(sigm(v0[2]) * 255.0f, 2, lo); lo = __builtin_amdgcn_cvt_pk_u8_f32(sigm(v0[3]) * 255.0f, 3, lo);
                        hi = __builtin_amdgcn_cvt_pk_u8_f32(sigm(v1[0]) * 255.0f, 0, hi); hi = __builtin_amdgcn_cvt_pk_u8_f32(sigm(v1[1]) * 255.0f, 1, hi); hi = __builtin_amdgcn_cvt_pk_u8_f32(sigm(v1[2]) * 255.0f, 2, hi); hi = __builtin_amdgcn_cvt_pk_u8_f32(sigm(v1[3]) * 255.0f, 3, hi);
                        *(u32x2*)(rowp + bj * HALF) = (u32x2){lo, hi}; } }
            return;
        }
#pragma unroll
        for (int ai = 0; ai < 2; ++ai)
#pragma unroll
            for (int m = 0; m < 4; ++m) { bf16_t* rowp = base + (size_t)(row0 + ai * HALF + m * 16) * ldc + u.pn * BM + colt;
#pragma unroll
                for (int bj = 0; bj < 2; ++bj) { f32x4 v0 = acc[ai][bj][m][0], v1 = acc[ai][bj][m][1];
                    if (sg) {
#pragma unroll
                        for (int j = 0; j < 4; ++j) { v0[j] = sigm(v0[j]); v1[j] = sigm(v1[j]); } }
                    u32x4 w; w.x = cvt_pk_bf16(v0[0], v0[1]); w.y = cvt_pk_bf16(v0[2], v0[3]); w.z = cvt_pk_bf16(v1[0], v1[1]); w.w = cvt_pk_bf16(v1[2], v1[3]);
                    *(u32x4*)(rowp + bj * HALF) = w;
                    if (u.kind == 0 && u.pn == 3) { const int r = row0 + ai * HALF + m * 16, cc = colt + bj * HALF;
                        *(u32x4*)(USp + ((size_t)(cc >> 4) * NCHKP + (r >> 4)) * 512 + (r & 15) * 16 + (cc & 15)) = w; } } }
    }
};
struct EpiS5State {
    float* Sp;
    __device__ __forceinline__ void operator()(const f32x4 (&acc)[2][2][4][2], const Unit& u, int wr, int wc, int fr, int fq) const {
        EPI_ROWS(u);
#pragma unroll
        for (int ai = 0; ai < 2; ++ai)
#pragma unroll
            for (int m = 0; m < 4; ++m) { float* op = Sp + ((size_t)u.kind * NCHKP + row0 + ai * HALF + m * 16) * 256 + colt;
#pragma unroll
                for (int bj = 0; bj < 2; ++bj)
#pragma unroll
                    for (int n = 0; n < 2; ++n) *(f32x4*)(op + bj * HALF + 4 * n) = acc[ai][bj][m][n]; }
    }
};
struct EpiS5Main {
    bf16_t* GLp; const bf16_t* PRp; const float* dvec;
    __device__ __forceinline__ void operator()(const f32x4 (&acc)[2][2][4][2], const Unit& u, int wr, int wc, int fr, int fq) const {
        EPI_ROWS(u);
        const int cl = 16 * u.kind + (colt & 15);
        const f32x4 d0 = *(const f32x4*)(dvec + cl), d1 = *(const f32x4*)(dvec + cl + 4);
#pragma unroll
        for (int ai = 0; ai < 2; ++ai) {
            u32x4 uq[4][2];
#pragma unroll
            for (int m = 0; m < 4; ++m) { const int n = row0 + ai * HALF + m * 16;
#pragma unroll
                for (int bj = 0; bj < 2; ++bj) { const int c = colt + bj * HALF, r = 16 * (n < NCHK ? n : 0) + (c >> 4); uq[m][bj] = *(const u32x4*)(PRp + (size_t)r * LDP + PC_D + cl); } }
#pragma unroll
            for (int m = 0; m < 4; ++m) { const int n = row0 + ai * HALF + m * 16; if (n >= NCHK) continue;
#pragma unroll
                for (int bj = 0; bj < 2; ++bj) { const int c = colt + bj * HALF, r = 16 * n + (c >> 4); const u32x4 uv = uq[m][bj];
                    const f32x4 v0 = acc[ai][bj][m][0], v1 = acc[ai][bj][m][1];
                    u32x4 w; w.x = cvt_pk_bf16(gelu_f(v0[0] + d0[0] * bflo(uv.x)), gelu_f(v0[1] + d0[1] * bfhi(uv.x))); w.y = cvt_pk_bf16(gelu_f(v0[2] + d0[2] * bflo(uv.y)), gelu_f(v0[3] + d0[3] * bfhi(uv.y)));
                    w.z = cvt_pk_bf16(gelu_f(v1[0] + d1[0] * bflo(uv.z)), gelu_f(v1[1] + d1[1] * bfhi(uv.z))); w.w = cvt_pk_bf16(gelu_f(v1[2] + d1[2] * bflo(uv.w)), gelu_f(v1[3] + d1[3] * bfhi(uv.w)));
                    *(u32x4*)(GLp + (size_t)r * 256 + cl) = w; } }
        }
    }
};
struct EpiS5Glu {
    bf16_t* YBp; const bf16_t* GLp; const float* bvec;
    __device__ __forceinline__ void operator()(const f32x4 (&acc)[2][2][4][2], const Unit& u, int wr, int wc, int fr, int fq) const {
        EPI_ROWS(u);
        f32x4 bq[2][2];
#pragma unroll
        for (int bj = 0; bj < 2; ++bj) { bq[bj][0] = *(const f32x4*)(bvec + colt + bj * HALF); bq[bj][1] = *(const f32x4*)(bvec + colt + bj * HALF + 4); }
#pragma unroll
        for (int ai = 0; ai < 2; ++ai) {
            u32x4 gq[4][2];
#pragma unroll
            for (int m = 0; m < 4; ++m)
#pragma unroll
                for (int bj = 0; bj < 2; ++bj) gq[m][bj] = *(const u32x4*)(GLp + (size_t)(row0 + ai * HALF + m * 16) * 256 + colt + bj * HALF);
#pragma unroll
            for (int m = 0; m < 4; ++m) { const int r = row0 + ai * HALF + m * 16;
#pragma unroll
                for (int bj = 0; bj < 2; ++bj) { const int c = colt + bj * HALF; const u32x4 gv = gq[m][bj];
                    const f32x4 v0 = acc[ai][bj][m][0] + bq[bj][0], v1 = acc[ai][bj][m][1] + bq[bj][1];
                    u32x4 w; w.x = cvt_pk_bf16(bflo(gv.x) * sigm(v0[0]), bfhi(gv.x) * sigm(v0[1])); w.y = cvt_pk_bf16(bflo(gv.y) * sigm(v0[2]), bfhi(gv.y) * sigm(v0[3]));
                    w.z = cvt_pk_bf16(bflo(gv.z) * sigm(v1[0]), bfhi(gv.z) * sigm(v1[1])); w.w = cvt_pk_bf16(bflo(gv.w) * sigm(v1[2]), bfhi(gv.w) * sigm(v1[3]));
                    *(u32x4*)(YBp + (size_t)r * YW + YC_D + c) = w; } }
        }
    }
};
__device__ __forceinline__ float gq8(unsigned w, int j) { return (float)((w >> (8 * j)) & 255u); }
struct EpiGate {
    const unsigned char* GQp; bf16_t* MGp; bf16_t* MGCp;
    __device__ __forceinline__ void operator()(f32x4 (&acc)[2][2][4][2], const Unit& u, int wr, int wc, int fr, int fq) const {
        EPI_ROWS(u);
        const int br = u.kind & 3;
        if (u.kind < 3) {
#pragma unroll
            for (int ai = 0; ai < 2; ++ai) {
                u32x2 ga[4][2], gb[4][2];
#pragma unroll
                for (int m = 0; m < 4; ++m)
#pragma unroll
                    for (int bj = 0; bj < 2; ++bj) { const unsigned char* gp = GQp + (size_t)(row0 + ai * HALF + m * 16) * 4096 + br * 1024 + u.pn * BM + colt + bj * HALF;
                        ga[m][bj] = *(const u32x2*)gp; gb[m][bj] = *(const u32x2*)(gp + 1024); }
#pragma unroll
                for (int m = 0; m < 4; ++m)
#pragma unroll
                    for (int bj = 0; bj < 2; ++bj)
#pragma unroll
                        for (int j = 0; j < 4; ++j) {
                            acc[ai][bj][m][0][j] *= fmaxf(gq8(ga[m][bj].x, j), 1.0f) * __builtin_amdgcn_rcpf(fmaxf(gq8(gb[m][bj].x, j), 1.0f));
                            acc[ai][bj][m][1][j] *= fmaxf(gq8(ga[m][bj].y, j), 1.0f) * __builtin_amdgcn_rcpf(fmaxf(gq8(gb[m][bj].y, j), 1.0f)); }
            }
            return;
        }
        bf16_t* OB = u.kind >= 4 ? MGCp + (size_t)br * RC * D - (size_t)RL * D : MGp;
        const float lo = u.kind >= 4 ? 0.0f : 1.0f;
#pragma unroll
        for (int ai = 0; ai < 2; ++ai) {
            u32x2 g[4][2];
#pragma unroll
            for (int m = 0; m < 4; ++m)
#pragma unroll
                for (int bj = 0; bj < 2; ++bj) g[m][bj] = *(const u32x2*)(GQp + (size_t)(row0 + ai * HALF + m * 16) * 4096 + br * 1024 + u.pn * BM + colt + bj * HALF);
#pragma unroll
            for (int m = 0; m < 4; ++m) { bf16_t* mp = OB + (size_t)(row0 + ai * HALF + m * 16) * D + u.pn * BM + colt;
#pragma unroll
                for (int bj = 0; bj < 2; ++bj) { const f32x4 v0 = acc[ai][bj][m][0] * (1.0f / 255.0f), v1 = acc[ai][bj][m][1] * (1.0f / 255.0f); const u32x2 gg = g[m][bj];
                    const f32x4 o0 = {v0[0] * fmaxf(gq8(gg.x, 0), lo), v0[1] * fmaxf(gq8(gg.x, 1), lo), v0[2] * fmaxf(gq8(gg.x, 2), lo), v0[3] * fmaxf(gq8(gg.x, 3), lo)};
                    const f32x4 o1 = {v1[0] * fmaxf(gq8(gg.y, 0), lo), v1[1] * fmaxf(gq8(gg.y, 1), lo), v1[2] * fmaxf(gq8(gg.y, 2), lo), v1[3] * fmaxf(gq8(gg.y, 3), lo)};
                    u32x4 w; w.x = cvt_pk_bf16(o0[0], o0[1]); w.y = cvt_pk_bf16(o0[2], o0[3]); w.z = cvt_pk_bf16(o1[0], o1[1]); w.w = cvt_pk_bf16(o1[2], o1[3]);
                    *(u32x4*)(mp + bj * HALF) = w; } }
        }
    }
};
struct EpiRes {
    float* PREp; const float* xlat; const float* xctx; const float* gvec;
    float* partp;
    __device__ __forceinline__ void operator()(const f32x4 (&acc)[2][2][4][2], const Unit& u, int wr, int wc, int fr, int fq) const {
        EPI_ROWS(u);
        if (u.kind != 0) {
            f32x4 gc[2][2];
#pragma unroll
            for (int bj = 0; bj < 2; ++bj)
#pragma unroll
                for (int n = 0; n < 2; ++n) gc[bj][n] = *(const f32x4*)(gvec + (size_t)4 * 6144 + u.pn * BM + colt + bj * HALF + 4 * n);
#pragma unroll
            for (int ai = 0; ai < 2; ++ai)
#pragma unroll
                for (int m = 0; m < 4; ++m) { const int r = row0 + ai * HALF + m * 16; const int c0 = u.pn * BM + colt;
                    float* op = partp + ((size_t)(u.kind - 1) * RC + r) * D + c0;
#pragma unroll
                    for (int bj = 0; bj < 2; ++bj)
#pragma unroll
                        for (int n = 0; n < 2; ++n) *(f32x4*)(op + bj * HALF + 4 * n) = gc[bj][n] * acc[ai][bj][m][n]; }
            return;
        }
        const int c0 = u.pn * BM + colt, rt0 = u.pm * BM;
        const float* gp = gvec + (size_t)(rt0 < RL ? (rt0 >> 12) : 4) * 6144 + c0;
        f32x4 gq[2][2];
#pragma unroll
        for (int bj = 0; bj < 2; ++bj)
#pragma unroll
            for (int n = 0; n < 2; ++n) gq[bj][n] = *(const f32x4*)(gp + bj * HALF + 4 * n);
#pragma unroll
        for (int ai = 0; ai < 2; ++ai)
#pragma unroll
            for (int m = 0; m < 4; ++m) { bf16_t* op = (bf16_t*)PREp + (size_t)(row0 + ai * HALF + m * 16) * D + c0;
#pragma unroll
                for (int bj = 0; bj < 2; ++bj) { const f32x4 v0 = gq[bj][0] * acc[ai][bj][m][0], v1 = gq[bj][1] * acc[ai][bj][m][1];
                    u32x4 w; w.x = cvt_pk_bf16(v0[0], v0[1]); w.y = cvt_pk_bf16(v0[2], v0[3]); w.z = cvt_pk_bf16(v1[0], v1[1]); w.w = cvt_pk_bf16(v1[2], v1[3]);
                    *(u32x4*)(op + bj * HALF) = w; } }
    }
};
struct EpiSwiglu {
    bf16_t* Hp; int ldh; int row_sub;
    __device__ __forceinline__ void operator()(const f32x4 (&acc)[2][2][4][2], const Unit& u, int wr, int wc, int fr, int fq) const {
        const int row0 = (u.pm - row_sub) * BM + wr * 64 + fr, colt = wc * 32 + 8 * fq;
#pragma unroll
        for (int ai = 0; ai < 2; ++ai)
#pragma unroll
            for (int m = 0; m < 4; ++m) { bf16_t* rowp = Hp + (size_t)(row0 + ai * HALF + m * 16) * ldh + u.pn * HALF + colt;
                f32x4 h0, h1;
#pragma unroll
                for (int j = 0; j < 4; ++j) { const float g0 = acc[ai][0][m][0][j], g1 = acc[ai][0][m][1][j];
                    h0[j] = g0 * sigm(g0) * acc[ai][1][m][0][j]; h1[j] = g1 * sigm(g1) * acc[ai][1][m][1][j]; }
                u32x4 w; w.x = cvt_pk_bf16(h0[0], h0[1]); w.y = cvt_pk_bf16(h0[2], h0[3]); w.z = cvt_pk_bf16(h1[0], h1[1]); w.w = cvt_pk_bf16(h1[2], h1[3]);
                *(u32x4*)rowp = w; }
    }
};
struct EpiMoeDown {
    bf16_t* O2; const float* slotw; float* O2X;
    __device__ __forceinline__ void operator()(const f32x4 (&acc)[2][2][4][2], const Unit& u, int wr, int wc, int fr, int fq) const {
        EPI_ROWS(u);
        float wq[2][4];
        if (u.kind & 8) {
            const int sp = (u.kind >> 4) & 3;
#pragma unroll
            for (int ai = 0; ai < 2; ++ai)
#pragma unroll
                for (int m = 0; m < 4; ++m) { const int r = row0 + ai * HALF + m * 16; const float w8 = slotw[r]; float* op = O2X + ((size_t)sp * 2048 + (r - 128 * 256)) * D + u.pn * BM + colt;
#pragma unroll
                    for (int bj = 0; bj < 2; ++bj)
#pragma unroll
                        for (int n = 0; n < 2; ++n) *(f32x4*)(op + bj * HALF + 4 * n) = acc[ai][bj][m][n] * w8; }
            return;
        }
#pragma unroll
        for (int ai = 0; ai < 2; ++ai)
#pragma unroll
            for (int m = 0; m < 4; ++m) wq[ai][m] = slotw[row0 + ai * HALF + m * 16];
#pragma unroll
        for (int ai = 0; ai < 2; ++ai)
#pragma unroll
            for (int m = 0; m < 4; ++m) { const int r = row0 + ai * HALF + m * 16; const float w8 = wq[ai][m];
                bf16_t* rowp = O2 + (size_t)r * D + u.pn * BM + colt;
#pragma unroll
                for (int bj = 0; bj < 2; ++bj) { const f32x4 v0 = acc[ai][bj][m][0] * w8, v1 = acc[ai][bj][m][1] * w8;
                    u32x4 w; w.x = cvt_pk_bf16(v0[0], v0[1]); w.y = cvt_pk_bf16(v0[2], v0[3]); w.z = cvt_pk_bf16(v1[0], v1[1]); w.w = cvt_pk_bf16(v1[2], v1[3]);
                    *(u32x4*)(rowp + bj * HALF) = w; } }
    }
};
}

struct Job { int in_idx; int src_off; int lds; int K; int N; long long dst_off; int ldd; int kcol0; int G, GS, R0; int tile0; };
struct JobTable { Job j[96]; int n; int total; };
constexpr int BIGG = 1 << 30;
constexpr void add_job(JobTable& t, int in_idx, long long src_off, int lds, int K, int N, size_t dst_off, int ldd, int kcol0, int G, int GS, int R0) {
    Job& q = t.j[t.n]; q.in_idx = in_idx; q.src_off = (int)src_off; q.lds = lds; q.K = K; q.N = N; q.dst_off = (long long)dst_off; q.ldd = ldd; q.kcol0 = kcol0; q.G = G; q.GS = GS; q.R0 = R0;
    q.tile0 = t.total; t.total += (K / 64) * (N / 64); t.n++;
}
constexpr JobTable make_jobs(int which) {
    JobTable t{}; t.n = 0; t.total = 0;
    if (which == 0) {
        for (int l = 0; l < 2; ++l) {
            const size_t base = WS_WL + (size_t)l * SZ_WL; const long long wsrc = (long long)l * 1024 * IN_COLS;
            add_job(t, 6, wsrc + 0, IN_COLS, 1024, 768, base, 1024, 0, BIGG, 0, 0);
            add_job(t, 6, wsrc + 2688, IN_COLS, 1024, 256, base, 1024, 0, BIGG, 0, PC_D);
            add_job(t, 6, wsrc + 1536, IN_COLS, 1024, 768, base, 1024, 0, BIGG, 0, PC_Q);
            add_job(t, 6, wsrc + 2944, IN_COLS, 1024, 4096, base, 1024, 0, BIGG, 0, PC_G);
            add_job(t, 6, wsrc + 768, IN_COLS, 1024, 768, base + SZ_WINR, 1024, 0, BIGG, 0, 0);
            add_job(t, 6, wsrc + 2304, IN_COLS, 1024, 384, base + SZ_WINR, 1024, 0, BIGG, 0, PT_V);
            const int kd[4] = {384, 256, 384, 256}, ko[4] = {0, 384, 640, 1024};
            for (int i = 0; i < 4; ++i) add_job(t, 35 + i, (long long)l * kd[i] * 1024, 1024, kd[i], 1024, base + SZ_WINR + SZ_WINHY, 1280, ko[i], BIGG, 0, 0);
            add_job(t, 39, (long long)l * 1024 * 1024, 1024, 1024, 1024, base + SZ_WINR + SZ_WINHY + SZ_WBR, 1024, 0, BIGG, 0, 0);
        }
        for (int q = 0; q < 24; ++q) for (int mat = 0; mat < 2; ++mat)
            add_job(t, mat == 0 ? 9 : 11, (long long)q * 4096, 64, 64, 64, WS_LW + (size_t)(((q / 6) * 2 + mat) * 6 + q % 6) * 4096 * 2, 64, 0, BIGG, 0, 0);
        for (int l = 0; l < 2; ++l) add_job(t, 33, (long long)l * 65536, 256, 256, 256, WS_WGLU + (size_t)l * 256 * 256 * 2, 256, 0, BIGG, 0, 0);
        add_job(t, 44, 0, FF_DENSE, 1024, FF_DENSE, WS_FFGU, 1024, 0, 128, 256, 0);
        add_job(t, 45, 0, FF_DENSE, 1024, FF_DENSE, WS_FFGU, 1024, 0, 128, 256, 128);
        add_job(t, 46, 0, 1024, FF_DENSE, 1024, WS_FFD, FF_DENSE, 0, BIGG, 0, 0);
    } else {
        for (int e = 0; e < NE; ++e) {
            add_job(t, 48, (long long)e * 1024 * FF_E, FF_E, 1024, FF_E, WS_MOEGU + (size_t)e * 2 * FF_E * 1024 * 2, 1024, 0, 128, 256, 0);
            add_job(t, 49, (long long)e * 1024 * FF_E, FF_E, 1024, FF_E, WS_MOEGU + (size_t)e * 2 * FF_E * 1024 * 2, 1024, 0, 128, 256, 128);
            add_job(t, 50, (long long)e * FF_E * 1024, 1024, FF_E, 1024, WS_MOED + (size_t)e * 1024 * FF_E * 2, FF_E, 0, BIGG, 0, 0);
        }
    }
    return t;
}
__device__ const JobTable JT_SMALL = make_jobs(0);
__device__ const JobTable JT_MOE = make_jobs(1);

struct PartTable { pg8::PartC p[32]; };
constexpr pg8::PartC mk_part(size_t aOff, size_t bOff, unsigned aStep, unsigned bStep, int nM, int nN, int nt, int kind, int start) {
    pg8::PartC q{}; q.aOff = (long long)aOff; q.bOff = (long long)bOff; q.aStep = aStep; q.bStep = bStep; q.nM = nM; q.nN = nN; q.nt = nt; q.kind = kind; q.start = start; q.nGrp = 1; q.aGrp = 0; q.bGrp = 0; return q;
}
constexpr PartTable make_parts() {
    PartTable t{};
    for (int l = 0; l < 2; ++l) {
        const size_t WL = WS_WL + (size_t)l * SZ_WL; const int nMrow = l == 0 ? 68 : 64;
        t.p[l * 8 + 0] = mk_part(WS_UB, WL, 256u * 1024u * 2u, 256u * 1024u * 2u, 68, 23, 16, 0, 0);
        t.p[l * 8 + 1] = mk_part(WL + SZ_WINR, WS_UB, 256u * 1024u * 2u, 256u * 1024u * 2u, 5, 68, 16, 1, 68 * 23);
        const int kd[4] = {384, 256, 384, 256}, ko[4] = {0, 384, 640, 1024};
        for (int i = 0; i < 4; ++i) t.p[l * 8 + 2 + i] = mk_part(WS_YB + ko[i] * 2, WL + SZ_WINR + SZ_WINHY + ko[i] * 2, 256u * 1280u * 2u, 256u * 1280u * 2u, nMrow, 4, kd[i] / 64, i, i * nMrow * 4);
        t.p[l * 8 + 6] = mk_part(WS_UB, WL + SZ_WINR + SZ_WINHY + SZ_WBR, 256u * 1024u * 2u, 256u * 1024u * 2u, nMrow, 4, 16, 0, 0);
    }
    for (int l = 0; l < 2; ++l) {
        pg8::PartC q = mk_part(WS_US, WS_OPS + (size_t)l * 16 * 256 * 256 * 2, 256u * 512u * 2u, 0u, 5, 1, 4, 0, 0); q.nGrp = 16; q.aGrp = (unsigned)(NCHKP * 512 * 2); q.bGrp = 256u * 256u * 2u; t.p[18 + l * 3] = q;
        q = mk_part(WS_US, WS_OPY + (size_t)l * 16 * 256 * 512 * 2, 256u * 512u * 2u, 0u, 5, 1, 8, 0, 0); q.nGrp = 16; q.aGrp = (unsigned)(NCHKP * 512 * 2); q.bGrp = 256u * 512u * 2u; t.p[19 + l * 3] = q;
        t.p[20 + l * 3] = mk_part(WS_GL, WS_WGLU + (size_t)l * 256 * 256 * 2, 256u * 256u * 2u, 0u, l == 0 ? 68 : 64, 1, 4, 0, 0);
    }
    {
        const size_t WL0 = WS_WL;
        t.p[24] = mk_part(WS_UB, WL0 + SZ_WINR + SZ_WINHY + SZ_WBR, 256u * 1024u * 2u, 256u * 1024u * 2u, 64, 4, 16, 0, 0);
        pg8::PartC q = mk_part(WS_MGC, WL0 + SZ_WINR + SZ_WINHY + SZ_WBR, 256u * 1024u * 2u, 256u * 1024u * 2u, 4, 4, 16, 1, 256); q.nGrp = 4; q.aGrp = (unsigned)(RC * D * 2); q.bGrp = 0u; t.p[25] = q;
        t.p[26] = mk_part(WS_H, WS_FFD, 256u * (unsigned)FF_DENSE * 2u, 256u * (unsigned)FF_DENSE * 2u, 64, 4, 44, 0, 0);
        q = mk_part(WS_H + (size_t)64 * 256 * FF_DENSE * 2, WS_FFD, 256u * (unsigned)FF_DENSE * 2u, 256u * (unsigned)FF_DENSE * 2u, 4, 4, 12, 1, 256); q.nGrp = 3; q.aGrp = 1536u; q.bGrp = 1536u; t.p[27] = q;
        t.p[28] = mk_part(WS_H + (size_t)64 * 256 * FF_DENSE * 2 + 36 * 128, WS_FFD + 36 * 128, 256u * (unsigned)FF_DENSE * 2u, 256u * (unsigned)FF_DENSE * 2u, 4, 4, 8, 4, 256 + 48);
    }
    t.p[16] = mk_part(WS_UB, WS_FFGU, 256u * 1024u * 2u, 256u * 1024u * 2u, 68, 22, 16, 0, 0);
    t.p[17] = mk_part(WS_H, WS_FFD, 256u * (unsigned)FF_DENSE * 2u, 256u * (unsigned)FF_DENSE * 2u, 68, 4, 44, 0, 0);
    return t;
}
__device__ const PartTable PARTS = make_parts();

struct Args {
    const float* in[51];
    float* out; unsigned char* ws;
    int ph_lo, ph_hi, bar_region, pad0;
};
__device__ __forceinline__ const float* sel_in(const Args& a, int idx) {
    const float* p = a.in[6];
    p = idx == 9 ? a.in[9] : p; p = idx == 11 ? a.in[11] : p; p = idx == 33 ? a.in[33] : p; p = idx == 35 ? a.in[35] : p; p = idx == 36 ? a.in[36] : p; p = idx == 37 ? a.in[37] : p; p = idx == 38 ? a.in[38] : p; p = idx == 39 ? a.in[39] : p;
    p = idx == 44 ? a.in[44] : p; p = idx == 45 ? a.in[45] : p; p = idx == 46 ? a.in[46] : p; p = idx == 48 ? a.in[48] : p; p = idx == 49 ? a.in[49] : p; p = idx == 50 ? a.in[50] : p;
    return p;
}

struct ConvRegs { f32x4 v[4][2]; int jis[4]; };
__device__ __forceinline__ void conv_load(const Args& a, const JobTable& JT, int t0, int stride, ConvRegs& R) {
    int tid = threadIdx.x; asm volatile("" : "+v"(tid));
#pragma unroll
    for (int u = 0; u < 4; ++u) {
        const int t = t0 + u * stride; R.jis[u] = -1;
        if (t < JT.total) {
            int ji = 0;
            for (int k = 1; k < JT.n; ++k) if (t >= JT.j[k].tile0) ji = k;
            R.jis[u] = ji;
            const Job& q = JT.j[ji];
            const int lt = t - q.tile0, nTn = q.N / 64, k0 = (lt / nTn) * 64, n0 = (lt % nTn) * 64;
            const float* src = sel_in(a, q.in_idx) + (size_t)q.src_off + (size_t)k0 * q.lds + n0;
#pragma unroll
            for (int p = 0; p < 2; ++p) R.v[u][p] = *(const f32x4*)(src + (size_t)((tid >> 4) + 32 * p) * q.lds + (tid & 15) * 4);
        }
    }
}
__device__ __forceinline__ void conv_store(const Args& a, const JobTable& JT, LAS float* tile, int t0, int stride, const ConvRegs& R) {
    int tid = threadIdx.x; asm volatile("" : "+v"(tid));
    __syncthreads();
#pragma unroll
    for (int u = 0; u < 4; ++u) if (R.jis[u] >= 0) {
#pragma unroll
        for (int p = 0; p < 2; ++p) { const int kk = (tid >> 4) + 32 * p, nn = (tid & 15) * 4; LAS float* tp = tile + u * (64 * 65) + kk * 65 + nn;
            tp[0] = R.v[u][p][0]; tp[1] = R.v[u][p][1]; tp[2] = R.v[u][p][2]; tp[3] = R.v[u][p][3]; } }
    __syncthreads();
#pragma unroll
    for (int u = 0; u < 4; ++u) if (R.jis[u] >= 0) {
        const Job& q = JT.j[R.jis[u]];
        const int t = t0 + u * stride, lt = t - q.tile0, nTn = q.N / 64, k0 = (lt / nTn) * 64, n0 = (lt % nTn) * 64;
        const int n = tid >> 3, k8 = (tid & 7) * 8, ng = n0 + n;
        const int drow = (ng / q.G) * q.GS + (ng % q.G) + q.R0;
        const LAS float* tp = tile + u * (64 * 65) + n;
        u32x4 w;
        w.x = cvt_pk_bf16(tp[(k8 + 0) * 65], tp[(k8 + 1) * 65]); w.y = cvt_pk_bf16(tp[(k8 + 2) * 65], tp[(k8 + 3) * 65]);
        w.z = cvt_pk_bf16(tp[(k8 + 4) * 65], tp[(k8 + 5) * 65]); w.w = cvt_pk_bf16(tp[(k8 + 6) * 65], tp[(k8 + 7) * 65]);
        *(u32x4*)((bf16_t*)(a.ws + q.dst_off) + (size_t)drow * q.ldd + q.kcol0 + k0 + k8) = w;
    }
}
__device__ __forceinline__ void convert_step(const Args& a, const JobTable& JT, LAS float* tile, int t0, int stride) { ConvRegs R; conv_load(a, JT, t0, stride, R); conv_store(a, JT, tile, t0, stride, R); }
__device__ __forceinline__ void convert_tiles_pipelined(const Args& a, const JobTable& JT, LAS float* tile, int first, int stride) {
    ConvRegs cur; int t0 = first;
    if (t0 >= JT.total) return;
    conv_load(a, JT, t0, stride, cur);
    for (;;) {
        const int tn = t0 + 4 * stride; const bool more = tn < JT.total;
        ConvRegs nxt;
        if (more) conv_load(a, JT, tn, stride, nxt);
        conv_store(a, JT, tile, t0, stride, cur);
        if (!more) break;
        cur = nxt; t0 = tn;
    }
}
__device__ __forceinline__ void convert_tiles(const Args& a, const JobTable& JT, LAS float* tile, int first, int stride) {
    for (int t0 = first; t0 < JT.total; t0 += 4 * stride) convert_step(a, JT, tile, t0, stride);
}

__device__ __forceinline__ int opaque(int v) { asm volatile("" : "+v"(v)); return v; }
#define PIN8(a) asm volatile("" : "+v"((a)[0]), "+v"((a)[1]), "+v"((a)[2]), "+v"((a)[3]), "+v"((a)[4]), "+v"((a)[5]), "+v"((a)[6]), "+v"((a)[7]))
#define PIN16(a) do { PIN8(a); PIN8((a) + 8); } while (0)
struct RowV { f32x4 v[4]; };
__device__ __forceinline__ RowV row_load(const float* p, int lane) { RowV r;
#pragma unroll
    for (int i = 0; i < 4; ++i) r.v[i] = *(const f32x4*)(p + 256 * i + 4 * lane); return r; }
__device__ __forceinline__ RowV row_load_bf16(const bf16_t* p, int lane) { RowV r;
#pragma unroll
    for (int i = 0; i < 4; ++i) { const u32x2 w = *(const u32x2*)(p + 256 * i + 4 * lane); r.v[i] = (f32x4){bflo(w.x), bfhi(w.x), bflo(w.y), bfhi(w.y)}; } return r; }
__device__ __forceinline__ void row_store(float* p, int lane, const RowV& r) {
#pragma unroll
    for (int i = 0; i < 4; ++i) *(f32x4*)(p + 256 * i + 4 * lane) = r.v[i]; }
__device__ __forceinline__ void row_store_bf16(bf16_t* p, int lane, const RowV& r) {
#pragma unroll
    for (int i = 0; i < 4; ++i) { u32x2 w; w.x = cvt_pk_bf16(r.v[i][0], r.v[i][1]); w.y = cvt_pk_bf16(r.v[i][2], r.v[i][3]); *(u32x2*)(p + 256 * i + 4 * lane) = w; } }
__device__ __forceinline__ RowV row_norm(const RowV& x) {
    float s = 0.f;
#pragma unroll
    for (int i = 0; i < 4; ++i) s += (x.v[i][0] + x.v[i][1]) + (x.v[i][2] + x.v[i][3]);
    const float mu = wave_sum(s) * (1.f / D);
    RowV d; float q = 0.f;
#pragma unroll
    for (int i = 0; i < 4; ++i) { d.v[i] = x.v[i] - mu; q += (d.v[i][0] * d.v[i][0] + d.v[i][1] * d.v[i][1]) + (d.v[i][2] * d.v[i][2] + d.v[i][3] * d.v[i][3]); }
    const float rs = rsqrtf(wave_sum(q) * (1.f / D) + 1e-5f);
#pragma unroll
    for (int i = 0; i < 4; ++i) d.v[i] = d.v[i] * rs;
    return d;
}
__device__ __forceinline__ RowV row_affine(const RowV& n, const float* g, const float* b, int lane) {
    RowV o;
#pragma unroll
    for (int i = 0; i < 4; ++i) o.v[i] = n.v[i] * *(const f32x4*)(g + 256 * i + 4 * lane) + *(const f32x4*)(b + 256 * i + 4 * lane);
    return o;
}
__device__ __forceinline__ RowV row_modulate(const RowV& n, const float* sh, const float* sc, int lane) {
    RowV o;
#pragma unroll
    for (int i = 0; i < 4; ++i) o.v[i] = n.v[i] * (*(const f32x4*)(sc + 256 * i + 4 * lane) + 1.0f) + *(const f32x4*)(sh + 256 * i + 4 * lane);
    return o;
}

constexpr int LDS_BYTES = 159744;
constexpr int MISC_OFF = 159488;
constexpr int NPH_LAYER = 16;
#ifndef SPLIT
#define SPLIT 0
#endif

__global__ void __launch_bounds__(512, 2) mk_fwd(Args a) {
    extern __shared__ __attribute__((aligned(16))) unsigned char shm[];
    LAS unsigned char* lds = (LAS unsigned char*)shm;
    volatile LAS unsigned* MISC = (volatile LAS unsigned*)(lds + MISC_OFF);
    const int tid0 = threadIdx.x, wave = __builtin_amdgcn_readfirstlane(tid0 >> 6);
    const int G = gridDim.x, bid = blockIdx.x;
    if (tid0 < (LDS_BYTES - MISC_OFF) / 4) MISC[tid0] = 0u;
    __syncthreads();
    unsigned char* ws = a.ws;
    unsigned* ctl = (unsigned*)(ws + WS_CTL);
    XcdBarrier bar = xcd_barrier_post(ctl + CW_BAR + a.bar_region * XCD_BAR_WORDS, MISC + 8);
    const int lo = a.ph_lo, hi = a.ph_hi;
#ifndef PHMASK
#define PHMASK 0xFFFF
#endif
#define IN(k) (lo <= (k) && (k) < hi)
#define SEAM(k) do { if (lo <= (k) && (k) + 1 < hi) xcd_barrier(bar); } while (0)
    float* MOD = (float*)(ws + WS_MOD);
    bf16_t* UB = (bf16_t*)(ws + WS_UB); bf16_t* PR = (bf16_t*)(ws + WS_PR); bf16_t* PT = (bf16_t*)(ws + WS_PT); bf16_t* YB = (bf16_t*)(ws + WS_YB);
    float* PRE = (float*)(ws + WS_PRE); float* XSC = (float*)(ws + WS_XSC);
    const float* x_in = a.in[0]; const float* ctx_in = a.in[2];

    if (((PHMASK >> 0) & 1) && IN(0)) {
        const int tid = opaque(tid0), lane = tid & 63;
        __syncthreads();
        LAS float* sc = (LAS float*)lds;
        for (int i = tid; i < 5 * 1024; i += 512) { const int r = i >> 10, k = i & 1023; sc[i] = silu_acc(r < 4 ? a.in[1][r * 1024 + k] : a.in[3][k]); }
        __syncthreads();
        for (int u = bid; u < 2 * 96 * 8; u += G) {
            const int l = u / (96 * 8), rem = u % (96 * 8), cg = rem / 8, ks = rem % 8;
            const int n = cg * 64 + lane;
            const float* w = a.in[4] + (size_t)l * 1024 * 6144 + n;
            float a0 = 0, a1 = 0, a2 = 0, a3 = 0, a4 = 0;
            const int kb = ks * 128 + wave * 16;
#pragma unroll 4
            for (int k = kb; k < kb + 16; ++k) { const float wv = w[(size_t)k * 6144]; a0 += sc[k] * wv; a1 += sc[1024 + k] * wv; a2 += sc[2048 + k] * wv; a3 += sc[3072 + k] * wv; a4 += sc[4096 + k] * wv; }
            if (ks == 0 && wave == 0) { const float bb = a.in[5][l * 6144 + n]; a0 += bb; a1 += bb; a2 += bb; a3 += bb; a4 += bb; }
            float* o = MOD + (size_t)l * 5 * 6144 + n;
            atomicAdd(o, a0); atomicAdd(o + 6144, a1); atomicAdd(o + 2 * 6144, a2); atomicAdd(o + 3 * 6144, a3); atomicAdd(o + 4 * 6144, a4);
        }
        __syncthreads();
        for (int u = bid; u < 132; u += G) {
            const bool isc = u >= 128; const int l = isc ? 0 : (u >> 6), blk = isc ? u - 128 : (u & 63), L = isc ? CTXL : SEQ, t0 = blk * 64;
            LAS float* feat = (LAS float*)lds;
            LAS float* h1 = feat + 64 * 33;
            LAS float* h2 = h1 + 4096;
            const float* w1 = a.in[16] + l * 33 * 64; const float* b1 = a.in[17] + l * 64; const float* w2 = a.in[18] + l * 4096; const float* b2 = a.in[19] + l * 64;
            const float* w3 = a.in[20] + (size_t)l * 65536; const float* b3 = a.in[21] + l * 1024; const float* fq = a.in[22] + l * 64;
            __syncthreads();
            for (int i = tid; i < 64 * 33; i += 512) { const int tt = i / 33, f = i - tt * 33, t = t0 + tt; float v;
                if (f == 0) v = (float)t / (float)L;
                else { const int band = (f - 1) % 16 + 1; const int m = (int)(((long)t * band) % L); const double ang = 2.0 * M_PI * (double)m / (double)L; v = f <= 16 ? (float)cos(ang) : (float)sin(ang); }
                feat[i] = v; }
            __syncthreads();
            for (int i = tid; i < 4096; i += 512) { const int tt = i >> 6, j = i & 63; float sacc = b1[j];
                for (int f = 0; f < 33; ++f) sacc += feat[tt * 33 + f] * w1[f * 64 + j];
                h1[i] = sinf(fq[j] * sacc); }
            __syncthreads();
            for (int i = tid; i < 4096; i += 512) { const int tt = i >> 6, j = i & 63; float sacc = b2[j];
                for (int f = 0; f < 64; ++f) sacc += h1[tt * 64 + f] * w2[f * 64 + j];
                h2[i] = sinf(fq[j] * sacc); }
            __syncthreads();
            const float dmin = 3.0701134573253945f, dmax = 15.350567286626973f;
#pragma unroll 1
            for (int jj = 0; jj < 2; ++jj) {
                const int n = tid + 512 * jj, dir = n >> 9, o = (n >> 8) & 1, c = n & 255;
                float wc[64];
#pragma unroll
                for (int i = 0; i < 64; ++i) wc[i] = w3[i * 1024 + n];
                const float bb = b3[n], delta = dmin + (dmax - dmin) * (float)c / 255.0f;
                bf16_t* dst = isc ? (bf16_t*)(ws + WS_KFC) + ((size_t)(dir * 2 + o) * 256 + c) * CTXL + t0 : (bf16_t*)(ws + WS_KFL) + ((size_t)((l * 2 + dir) * 2 + o) * 256 + c) * SEQ + t0;
                float asum = 0.f;
#pragma unroll 1
                for (int tg = 0; tg < 8; ++tg) {
                    float v[8];
#pragma unroll
                    for (int q = 0; q < 8; ++q) { float sacc = bb; const LAS float* hp = h2 + (tg * 8 + q) * 64;
#pragma unroll
                        for (int i = 0; i < 64; ++i) sacc += hp[i] * wc[i];
                        const int t = t0 + tg * 8 + q;
                        v[q] = sacc * expf(-((float)t / (float)L) * delta);
                        if (!(dir == 1 && t == 0)) asum += fabsf(v[q]); }
                    u32x4 w; w.x = cvt_pk_bf16(v[0], v[1]); w.y = cvt_pk_bf16(v[2], v[3]); w.z = cvt_pk_bf16(v[4], v[5]); w.w = cvt_pk_bf16(v[6], v[7]);
                    *(u32x4*)(dst + tg * 8) = w;
                }
                atomicAdd((float*)(ctl + CW_HYN) + (isc ? 1024 + o * 256 + c : (l * 2 + o) * 256 + c), asum);
            }
        }
        __syncthreads();
        for (int uq = bid; uq < 164; uq += G) { if (uq < 132) continue; const int u = uq - 132;
            const int l = u >> 4, g = u & 15;
            LAS float* PW = (LAS float*)lds;
            LAS float* BBs = PW + 2 * 64 * 17 * 2;
            LAS float* Cs = BBs + 2 * 64 * 16 * 2;
            LAS float* KT = Cs + 2 * 16 * 64 * 2;
            __syncthreads();
            if (tid < 128) {
                const int d = tid >> 6, p = tid & 63, idx = l * 2048 + (d * 16 + g) * 64 + p;
                const double ar = a.in[25][idx], ai = a.in[26][idx], dt = exp((double)a.in[27][l * 32 + d * 16 + g]);
                const double mag = exp(dt * ar), abr = mag * cos(dt * ai), abi = mag * sin(dt * ai), den = ar * ar + ai * ai;
                const double fr = ((abr - 1.0) * ar + abi * ai) / den, fi = (abi * ar - (abr - 1.0) * ai) / den;
                double pr = 1.0, pi = 0.0;
                for (int k = 0; k <= 16; ++k) { PW[((d * 64 + p) * 17 + k) * 2] = (float)pr; PW[((d * 64 + p) * 17 + k) * 2 + 1] = (float)pi; const double nr = pr * abr - pi * abi, ni = pr * abi + pi * abr; pr = nr; pi = ni; }
                float* a16 = (float*)(ws + WS_AB16) + ((size_t)((l * 2 + d) * 16 + g) * 64 + p) * 2;
                a16[0] = PW[((d * 64 + p) * 17 + 16) * 2]; a16[1] = PW[((d * 64 + p) * 17 + 16) * 2 + 1];
                for (int i = 0; i < 16; ++i) { const double br = a.in[28][(size_t)idx * 16 + i], bi = a.in[29][(size_t)idx * 16 + i];
                    BBs[((d * 64 + p) * 16 + i) * 2] = (float)(fr * br - fi * bi); BBs[((d * 64 + p) * 16 + i) * 2 + 1] = (float)(fr * bi + fi * br); }
            }
            for (int i = tid; i < 2048; i += 512) { const int d = i >> 10, o = (i >> 6) & 15, p = i & 63; const size_t ci = (size_t)l * 32768 + ((size_t)(d * 16 + g) * 16 + o) * 64 + p;
                Cs[i * 2] = a.in[30][ci]; Cs[i * 2 + 1] = a.in[31][ci]; }
            __syncthreads();
            for (int e = tid; e < 8192; e += 512) { const int d = e >> 12, k = (e >> 8) & 15, o = (e >> 4) & 15, i = e & 15;
                float acc = 0.f;
                for (int p = 0; p < 64; ++p) { const float cr = Cs[((d * 16 + o) * 64 + p) * 2], ci = Cs[((d * 16 + o) * 64 + p) * 2 + 1], pr = PW[((d * 64 + p) * 17 + k) * 2], pi = PW[((d * 64 + p) * 17 + k) * 2 + 1];
                    const float tr = cr * pr - ci * pi, ti = cr * pi + ci * pr;
                    acc += tr * BBs[((d * 64 + p) * 16 + i) * 2] - ti * BBs[((d * 64 + p) * 16 + i) * 2 + 1]; }
                KT[e] = acc; }
            __syncthreads();
            bf16_t* OPS = (bf16_t*)(ws + WS_OPS) + (size_t)(l * 16 + g) * 256 * 256;
            bf16_t* OPY = (bf16_t*)(ws + WS_OPY) + (size_t)(l * 16 + g) * 256 * 512;
            for (int e = tid; e < 256 * 32; e += 512) {
                const int row = e >> 5, c0 = (e & 31) * 8, d = row >> 7, p = (row >> 1) & 63, ri = row & 1, sx = c0 >> 4, i0 = c0 & 15, k = d == 0 ? 15 - sx : sx;
                const float pr = PW[((d * 64 + p) * 17 + k) * 2], pi = PW[((d * 64 + p) * 17 + k) * 2 + 1];
                float v[8];
#pragma unroll
                for (int j = 0; j < 8; ++j) { const float br = BBs[((d * 64 + p) * 16 + i0 + j) * 2], bi = BBs[((d * 64 + p) * 16 + i0 + j) * 2 + 1]; v[j] = ri == 0 ? pr * br - pi * bi : pr * bi + pi * br; }
                u32x4 w; w.x = cvt_pk_bf16(v[0], v[1]); w.y = cvt_pk_bf16(v[2], v[3]); w.z = cvt_pk_bf16(v[4], v[5]); w.w = cvt_pk_bf16(v[6], v[7]);
                *(u32x4*)(OPS + (size_t)row * 256 + c0) = w; }
            for (int e = tid; e < 256 * 64; e += 512) {
                const int row = e >> 6, c0 = (e & 63) * 8, t = row >> 4, o = row & 15;
                float v[8];
                if (c0 < 256) { const int sx = c0 >> 4, i0 = c0 & 15;
#pragma unroll
                    for (int j = 0; j < 8; ++j) { float x = 0.f; if (sx <= t) x += KT[((0 * 16 + (t - sx)) * 16 + o) * 16 + i0 + j]; if (sx >= t) x += KT[((1 * 16 + (sx - t)) * 16 + o) * 16 + i0 + j]; v[j] = x; } }
                else { const int c2 = c0 - 256, d = c2 >> 7, k = d == 0 ? t + 1 : 16 - t;
#pragma unroll
                    for (int j = 0; j < 8; ++j) { const int p = ((c2 + j) >> 1) & 63, ri = (c2 + j) & 1;
                        const float cr = Cs[((d * 16 + o) * 64 + p) * 2], ci = Cs[((d * 16 + o) * 64 + p) * 2 + 1], pr = PW[((d * 64 + p) * 17 + k) * 2], pi = PW[((d * 64 + p) * 17 + k) * 2 + 1];
                        v[j] = ri == 0 ? cr * pr - ci * pi : -(cr * pi + ci * pr); } }
                u32x4 w; w.x = cvt_pk_bf16(v[0], v[1]); w.y = cvt_pk_bf16(v[2], v[3]); w.z = cvt_pk_bf16(v[4], v[5]); w.w = cvt_pk_bf16(v[6], v[7]);
                *(u32x4*)(OPY + (size_t)row * 512 + c0) = w; }
        }
        __syncthreads();
        for (;;) {
            __syncthreads();
            if (tid == 0) MISC[16] = atomicAdd(ctl + CW_QUEUE, 4u);
            __syncthreads();
            const int base = (int)MISC[16];
            if (base >= JT_SMALL.total) break;
            convert_step(a, JT_SMALL, (LAS float*)lds, base, 1);
        }
        __syncthreads();
    }
    SEAM(0);

    for (int l = 0; l < 2; ++l) {
        const int P0 = 1 + l * NPH_LAYER;
        const float* MODL = MOD + (size_t)l * 5 * 6144;
        const unsigned char* WL = ws + WS_WL + (size_t)l * SZ_WL;
        const int nMrow = (l == 0) ? 68 : 64;
        const float* xlat = (l == 0) ? x_in : a.out; const float* xctx = (l == 0) ? ctx_in : XSC;

        if (((PHMASK >> 1) & 1) && l == 0 && IN(P0 + 0)) {
            const int lane = opaque(tid0) & 63;
            for (int r = bid * 8 + wave; r < RT; r += G * 8) {
                const float* src = r < RL ? x_in + (size_t)r * D : ctx_in + (size_t)(r - RL) * D;
                const float* mv = MODL + (size_t)(r < RL ? (r >> 12) : 4) * 6144;
                const RowV n = row_norm(row_load(src, lane));
                row_store_bf16(UB + (size_t)r * D, lane, row_modulate(n, mv, mv + 1024, lane));
            }
        }
        if (l == 0) SEAM(P0 + 0);

        if (((PHMASK >> 2) & 1) && IN(P0 + 1)) {
            const pg8::TabSched S{PARTS.p + l * 8, (const char*)ws, 2, 68 * 23 + 5 * 68, G, bid};
            pg8::EpiProj E{PR, PT, (bf16_t*)(ws + WS_US), 7, ws + WS_GQ};
            pg8::gemm_phase<1024, 1024>(lds, S, E);
        }
        SEAM(P0 + 1);
        if (((PHMASK >> 13) & 1) && IN(P0 + 2)) {
            const int tid = opaque(tid0), lane = tid & 63;
            LAS float* rp = (LAS float*)lds;
            for (int i = tid; i < 6 * 465; i += 512) rp[i] = a.in[24][l * 2790 + i];
            __syncthreads();
            LAS bf16_t* KW = (LAS bf16_t*)(lds + 11264);
            LAS bf16_t* CK = (LAS bf16_t*)(lds + 11264 + 576 * 144);
            LAS bf16_t* VW = (LAS bf16_t*)(lds + 11264);
            LAS bf16_t* CV = (LAS bf16_t*)(lds + 11264 + 64 * 1168);
            const int ngroups = 768 + (l == 0 ? 48 : 0);
            for (int gi0 = bid; gi0 < 768 + G; gi0 += G) {
                const int gi = gi0 < 768 ? gi0 : 768 + ((gi0 - 768 + G - 48) % G);
                if (gi >= ngroups) continue;
                const bool lat = gi < 768;
                const int combo = lat ? gi >> 5 : (gi - 768) >> 1, b = combo / 6, h = combo - 6 * b;
                const int v = lat ? ((gi & 31) << 3) + wave : (((gi - 768) & 1) << 3) + wave;
                const int r0g = (gi & 31) << 1, rs0 = r0g - 4 < 0 ? 0 : (r0g - 4 > 56 ? 56 : r0g - 4);
                const int ntokw = lat ? ((64 - rs0) < 9 ? (64 - rs0) : 9) * 64 : 0;
                __syncthreads();
                {   const int tid2 = opaque(tid);
#pragma unroll
                    for (int k = 0; k < 9; ++k) { const int c = tid2 + 512 * k, tok = c >> 3, part = c & 7;
                        if (tok < ntokw) *(LAS u32x4*)(KW + tok * 72 + part * 8) = *(const u32x4*)(PR + (size_t)(b * SEQ + rs0 * 64 + tok) * LDP + PC_K + h * 64 + part * 8); }
#pragma unroll
                    for (int k = 0; k < 4; ++k) { const int c = tid2 + 512 * k, tok = c >> 3, part = c & 7;
                        *(LAS u32x4*)(CK + tok * 72 + part * 8) = *(const u32x4*)(PR + (size_t)(RL + b * CTXL + tok) * LDP + PC_K + h * 64 + part * 8); } }
                __syncthreads();
                const int ln2 = opaque(lane), qn = ln2 & 15, g = ln2 >> 4;
                int r = 0, qb, tq, rs = 0, bs = 0, w = 0, cs = 0;
                if (lat) { qb = v & 3; r = v >> 2; rs = r - 4 < 0 ? 0 : (r - 4 > 56 ? 56 : r - 4); bs = qb == 0 ? 0 : (qb == 1 ? 8 : (qb == 2 ? 24 : 32));
                    w = 16 * qb + qn; cs = w - 8 < 0 ? 0 : (w - 8 > 48 ? 48 : w - 8); tq = b * SEQ + r * 64 + w; }
                else { qb = v; tq = RL + b * CTXL + 16 * qb + qn; }
                const int pr0 = rs - rs0;
                const bf16_t* qp = PR + (size_t)tq * LDP + PC_Q + h * 64 + 8 * g;
                const bf16x8 q0 = *(const bf16x8*)qp, q1 = *(const bf16x8*)(qp + 32);
                f32x4 S[32];
                const int koff = 8 * (qn >> 2) + (qn & 3);
                if (lat) {
#pragma unroll
                    for (int p = 0; p < 8; ++p)
#pragma unroll
                        for (int hf = 0; hf < 2; ++hf) { const LAS bf16_t* kp = KW + ((pr0 + p) * 64 + bs + koff + 4 * hf) * 72 + 8 * g;
                            const bf16x8 k0 = *(const LAS bf16x8*)kp, k1 = *(const LAS bf16x8*)(kp + 32);
                            f32x4 acc = {0.f, 0.f, 0.f, 0.f};
                            acc = __builtin_amdgcn_mfma_f32_16x16x32_bf16(k0, q0, acc, 0, 0, 0);
                            acc = __builtin_amdgcn_mfma_f32_16x16x32_bf16(k1, q1, acc, 0, 0, 0);
                            const int rowoff = (h * 15 + (rs + p - r + 7)) * 31;
#pragma unroll
                            for (int j = 0; j < 4; ++j) { const int c = bs + 8 * g + 4 * hf + j; const bool ok = (c >= cs) && (c < cs + 16);
                                const int dc = ok ? c - w + 15 : 0;
                                acc[j] = ok ? acc[j] * 0.125f + rp[rowoff + dc] : -3.0e38f; }
                            S[2 * p + hf] = acc; if (hf == 1 && (p & 1)) __builtin_amdgcn_sched_barrier(0); }
                } else {
#pragma unroll
                    for (int p = 0; p < 16; ++p) S[p] = (f32x4){-3.0e38f, -3.0e38f, -3.0e38f, -3.0e38f};
                }
#pragma unroll
                for (int p = 0; p < 8; ++p)
#pragma unroll
                    for (int hf = 0; hf < 2; ++hf) { const LAS bf16_t* kp = CK + (32 * p + koff + 4 * hf) * 72 + 8 * g;
                        const bf16x8 k0 = *(const LAS bf16x8*)kp, k1 = *(const LAS bf16x8*)(kp + 32);
                        f32x4 acc = {0.f, 0.f, 0.f, 0.f};
                        acc = __builtin_amdgcn_mfma_f32_16x16x32_bf16(k0, q0, acc, 0, 0, 0);
                        acc = __builtin_amdgcn_mfma_f32_16x16x32_bf16(k1, q1, acc, 0, 0, 0);
                        S[16 + 2 * p + hf] = acc * 0.125f; if (hf == 1 && (p & 1)) __builtin_amdgcn_sched_barrier(0); }
                float mx = -3.0e38f;
#pragma unroll
                for (int i = 0; i < 32; ++i) mx = fmaxf(fmaxf(mx, fmaxf(S[i][0], S[i][1])), fmaxf(S[i][2], S[i][3]));
                mx = fmaxf(mx, __shfl_xor(mx, 16)); mx = fmaxf(mx, __shfl_xor(mx, 32));
                float sum = 0.f;
#pragma unroll
                for (int i = 0; i < 32; ++i) {
#pragma unroll
                    for (int j = 0; j < 4; ++j) { const float e = __expf(S[i][j] - mx); S[i][j] = e; sum += e; } }
                sum += __shfl_xor(sum, 16); sum += __shfl_xor(sum, 32);
                const float inv = 1.0f / sum;
                __syncthreads();
                {   const int tid2 = opaque(tid);
#pragma unroll
                    for (int k = 0; k < 9; ++k) { const int c = tid2 + 512 * k, dd = c / 72, part = c - dd * 72;
                        if (part * 8 < ntokw) *(LAS u32x4*)(VW + dd * 584 + part * 8) = *(const u32x4*)(PT + (size_t)(PT_V + h * 64 + dd) * RT + b * SEQ + rs0 * 64 + part * 8); }
#pragma unroll
                    for (int k = 0; k < 4; ++k) { const int c = tid2 + 512 * k, dd = c >> 5, part = c & 31;
                        *(LAS u32x4*)(CV + dd * 264 + part * 8) = *(const u32x4*)(PT + (size_t)(PT_V + h * 64 + dd) * RT + RL + b * CTXL + part * 8); } }
                __syncthreads();
                f32x4 O[4];
#pragma unroll
                for (int dt = 0; dt < 4; ++dt) O[dt] = (f32x4){0.f, 0.f, 0.f, 0.f};
#pragma unroll
                for (int p = 0; p < 16; ++p) {
                    if (p < 8 && !lat) continue;
                    u32x4 pw; pw.x = cvt_pk_bf16(S[2 * p][0], S[2 * p][1]); pw.y = cvt_pk_bf16(S[2 * p][2], S[2 * p][3]); pw.z = cvt_pk_bf16(S[2 * p + 1][0], S[2 * p + 1][1]); pw.w = cvt_pk_bf16(S[2 * p + 1][2], S[2 * p + 1][3]);
                    bf16x8 pf; __builtin_memcpy(&pf, &pw, 16);
#pragma unroll
                    for (int dt = 0; dt < 4; ++dt) { const LAS bf16_t* vp = p < 8 ? VW + (16 * dt + qn) * 584 + (pr0 + p) * 64 + bs + 8 * g : CV + (16 * dt + qn) * 264 + 32 * (p - 8) + 8 * g;
                        O[dt] = __builtin_amdgcn_mfma_f32_16x16x32_bf16(*(const LAS bf16x8*)vp, pf, O[dt], 0, 0, 0); }
                    if (p & 1) __builtin_amdgcn_sched_barrier(0);
                }
                bf16_t* op = YB + (size_t)tq * YW + YC_C + h * 64 + 4 * g;
#pragma unroll
                for (int dt = 0; dt < 4; ++dt) { u32x2 o2; o2.x = cvt_pk_bf16(O[dt][0] * inv, O[dt][1] * inv); o2.y = cvt_pk_bf16(O[dt][2] * inv, O[dt][3] * inv); *(u32x2*)(op + 16 * dt) = o2; }
            }
            __syncthreads();
            {
                const int tid = opaque(tid0), lane = tid & 63;
                LAS float* XC = (LAS float*)lds;
                LAS f32x2* AB = (LAS f32x2*)(lds + 16 * 384 * 4);
                const float* cw = a.in[7] + l * 4 * 384; const float* cb = a.in[8] + l * 384;
                const bf16_t* LW = (const bf16_t*)(ws + WS_LW) + (size_t)l * 24 * 4096;
                bf16_t* LT = (bf16_t*)(ws + WS_LT); f32x2* LAGG = (f32x2*)(ws + WS_LAGG);
                const int dir = (wave >> 2) & 1, ntile = wave & 3, tk = lane & 15, kg = lane >> 4;
                LAS float* CT = (LAS float*)(lds + 16 * 384 * 4 + 2 * 16 * 384 * 8);
                for (int i = tid; i < 768; i += 512) { CT[i] = a.in[10][l * 768 + i]; CT[768 + i] = a.in[12][l * 768 + i]; CT[1536 + i] = -8.0f * softplus(-a.in[13][l * 768 + i]); }
                float cwv[60];
#pragma unroll
                for (int i = 0; i < 12; ++i) { const int idx = tid + 512 * i, ch = idx % 384;
                    cwv[5 * i] = cw[ch]; cwv[5 * i + 1] = cw[384 + ch]; cwv[5 * i + 2] = cw[768 + ch]; cwv[5 * i + 3] = cw[1152 + ch]; cwv[5 * i + 4] = cb[ch]; }
                PIN16(cwv); PIN16(cwv + 16); PIN16(cwv + 32); PIN8(cwv + 48); asm volatile("" : "+v"(cwv[56]), "+v"(cwv[57]), "+v"(cwv[58]), "+v"(cwv[59]));
                for (int n0 = bid; n0 < 1024 + G; n0 += G) {
                    const int n = n0 < 1024 ? n0 : 1024 + ((n0 - 1024 + G - 112) % G);
                    if (n >= NCHK) continue;
                    const int r0 = 16 * n; int start, len, pos0, bb; row_seq(r0, start, len, pos0, bb);
                    __syncthreads();
                    unsigned pin[48];
#pragma unroll
                    for (int i = 0; i < 12; ++i) { const int idx = tid + 512 * i, tok = idx / 384, ch = idx - tok * 384, pos = pos0 + tok;
                        const bf16_t* pr = PR + (size_t)(r0 + tok) * LDP + PC_AC + ch;
                        pin[4 * i + 0] = pos >= 2 ? pr[-2 * LDP] : 0; pin[4 * i + 1] = pos >= 1 ? pr[-LDP] : 0; pin[4 * i + 2] = pr[0]; pin[4 * i + 3] = pos + 1 < len ? pr[LDP] : 0; }
                    PIN16(pin); PIN16(pin + 16); PIN16(pin + 32);
#pragma unroll
                    for (int i = 0; i < 12; ++i) { const int idx = tid + 512 * i, tok = idx / 384, ch = idx - tok * 384;
                        XC[idx] = cwv[5 * i + 4] + cwv[5 * i] * bflo(pin[4 * i]) + cwv[5 * i + 1] * bflo(pin[4 * i + 1]) + cwv[5 * i + 2] * bflo(pin[4 * i + 2]) + cwv[5 * i + 3] * bflo(pin[4 * i + 3]); }
                    __syncthreads();
#pragma unroll 2
                    for (int g = 0; g < 6; ++g) {
                        bf16x8 wq[4];
#pragma unroll
                        for (int ks = 0; ks < 2; ++ks) { const bf16_t* wp = LW + ((size_t)((dir * 2 + 0) * 6 + g) * 64 + 16 * ntile + tk) * 64 + 32 * ks + 8 * kg; wq[2 * ks] = *(const bf16x8*)wp; wq[2 * ks + 1] = *(const bf16x8*)(wp + 6 * 4096); }
                        asm volatile("" : "+v"(wq[0]), "+v"(wq[1]), "+v"(wq[2]), "+v"(wq[3]));
                        f32x4 ar = {0.f, 0.f, 0.f, 0.f}, ai = {0.f, 0.f, 0.f, 0.f};
#pragma unroll
                        for (int ks = 0; ks < 2; ++ks) {
                            const LAS float* xp = XC + tk * 384 + g * 64 + 32 * ks + 8 * kg;
                            const f32x4 x0 = *(const LAS f32x4*)xp, x1 = *(const LAS f32x4*)(xp + 4);
                            u32x4 xw; xw.x = cvt_pk_bf16(x0[0], x0[1]); xw.y = cvt_pk_bf16(x0[2], x0[3]); xw.z = cvt_pk_bf16(x1[0], x1[1]); xw.w = cvt_pk_bf16(x1[2], x1[3]);
                            bf16x8 xf; __builtin_memcpy(&xf, &xw, 16);
                            ar = __builtin_amdgcn_mfma_f32_16x16x32_bf16(xf, wq[2 * ks], ar, 0, 0, 0);
                            ai = __builtin_amdgcn_mfma_f32_16x16x32_bf16(xf, wq[2 * ks + 1], ai, 0, 0, 0);
                        }
                        const int ch = g * 64 + 16 * ntile + tk;
                        const float br = CT[dir * 384 + ch], bi = CT[768 + dir * 384 + ch], sp8 = CT[1536 + dir * 384 + ch];
#pragma unroll
                        for (int j = 0; j < 4; ++j) { const int tok = 4 * kg + j;
                            const float la = sigm(ar[j] + br) * sp8, y = 2.0f * la;
                            const float av = 1.0f + la * (1.0f + la * (0.5f + la * (0.16666667f + la * (0.041666667f + la * 0.0083333333f))));
                            const float om = -y * (1.0f + y * (0.5f + y * (0.16666667f + y * (0.041666667f + y * (0.0083333333f + y * 0.0013888889f)))));
                            const float bt = __builtin_sqrtf(om) * sigm(ai[j] + bi) * XC[tok * 384 + ch];
                            AB[(dir * 16 + tok) * 384 + ch] = (f32x2){av, bt}; }
                    }
                    __syncthreads();
                    if (tid < 384) {
                        float hf = 0.f, pf = 1.f, hb = 0.f, pb = 1.f;
#pragma unroll
                        for (int t = 0; t < 16; ++t) {
                            const f32x2 f = AB[t * 384 + tid], bk = AB[(16 + 15 - t) * 384 + tid];
                            hf = f[0] * hf + f[1]; pf *= f[0]; hb = bk[0] * hb + bk[1]; pb *= bk[0];
                            AB[t * 384 + tid] = (f32x2){pf, hf}; AB[(16 + 15 - t) * 384 + tid] = (f32x2){pb, hb}; }
                        LAGG[((size_t)n * 2 + 0) * 384 + tid] = (f32x2){pf, hf}; LAGG[((size_t)n * 2 + 1) * 384 + tid] = (f32x2){pb, hb};
                    }
                    __syncthreads();
#pragma unroll
                    for (int i = 0; i < 12; ++i) { const int idx = tid + 512 * i, tok = idx / 384, ch = idx - tok * 384;
                        const f32x2 f = AB[idx], bk = AB[16 * 384 + idx];
                        bf16_t* o = LT + (size_t)(r0 + tok) * 1152 + ch;
                        o[0] = f2bf(f[1] + bk[1]); o[384] = f2bf(f[0]); o[768] = f2bf(bk[0]); }
                }
                __syncthreads();
            }
            {
                const int tid = opaque(tid0), lane = tid & 63;
                constexpr int ZS = SEQ + 16;
                LAS bf16_t* R0 = (LAS bf16_t*)lds;
                LAS bf16_t* R1 = R0 + 8224;
                LAS bf16_t* ZA = R1 + 8224;
                const LAS unsigned* Rdw = (const LAS unsigned*)lds;
#define HY_ZF(b, s) ((b) * ZS + ((s) & ~63) + (((((s) >> 3) & 7) ^ (((s) >> 7) & 1)) << 3) + ((s) & 7))
                const float* hcw = a.in[14] + l * 3 * 768; const float* hcb = a.in[15] + l * 768;
                const float* nrm = (const float*)(ctl + CW_HYN);
                bf16_t* YT = (bf16_t*)(ws + WS_YT);
                const int r32 = lane & 31, hh = lane >> 5, il = r32 >> 2, bq = r32 & 3, iblk = 8 * wave + il;
                const int x0b = 4095 - r32 + 8 * hh, par = x0b & 1;
                const int abase = (par ? 4112 : 0) + ((x0b - par) >> 1);
                for (int c = bid; c < 256; c += G) {
                    __syncthreads();
#pragma unroll 1
                    for (int it = tid; it < 3 * 4 * 512; it += 512) {
                        const int arr = it >> 11, b = (it >> 9) & 3, s8 = (it & 511) * 8, ch = arr * 256 + c;
                        const bf16_t* pp = PT + (size_t)ch * RT + b * SEQ + s8;
                        const u32x4 pv = *(const u32x4*)pp;
                        const float w0 = hcw[ch], w1 = hcw[768 + ch], w2 = hcw[1536 + ch], cb0 = hcb[ch];
                        float p[10];
                        p[0] = s8 > 0 ? bf2f(pp[-1]) : 0.f; p[9] = s8 + 8 < SEQ ? bf2f(pp[8]) : 0.f;
                        p[1] = bflo(pv.x); p[2] = bfhi(pv.x); p[3] = bflo(pv.y); p[4] = bfhi(pv.y); p[5] = bflo(pv.z); p[6] = bfhi(pv.z); p[7] = bflo(pv.w); p[8] = bfhi(pv.w);
                        float z[8];
#pragma unroll
                        for (int j = 0; j < 8; ++j) z[j] = cb0 + w0 * p[j] + w1 * p[j + 1] + w2 * p[j + 2];
                        u32x4 w; w.x = cvt_pk_bf16(z[0], z[1]); w.y = cvt_pk_bf16(z[2], z[3]); w.z = cvt_pk_bf16(z[4], z[5]); w.w = cvt_pk_bf16(z[6], z[7]);
                        *(LAS u32x4*)(ZA + arr * 4 * ZS + HY_ZF(b, s8)) = w;
                    }
#pragma unroll 1
                    for (int o = 0; o < 2; ++o) {
                        const bf16_t* kf = (const bf16_t*)(ws + WS_KFL) + ((size_t)((l * 2 + 0) * 2 + o) * 256 + c) * SEQ;
                        const bf16_t* kb = (const bf16_t*)(ws + WS_KFL) + ((size_t)((l * 2 + 1) * 2 + o) * 256 + c) * SEQ;
                        { unsigned tv[16];
#pragma unroll
                          for (int q = 0; q < 16; ++q) { const int x = tid + 512 * q; tv[q] = x < 4096 ? kf[4095 - x] : (x <= 8190 ? kb[x - 4095] : (bf16_t)0); }
                          PIN16(tv);
#pragma unroll
                          for (int q = 0; q < 16; ++q) R0[tid + 512 * q] = (bf16_t)tv[q]; }
                        __syncthreads();
                        for (int x = tid; x < 8192; x += 512) R1[x] = x < 8191 ? R0[x + 1] : (bf16_t)0;
                        __syncthreads();
                        const LAS bf16_t* Z = ZA + (o == 0 ? 0 : 4 * ZS) + bq * ZS;
                        typedef float f32x16 __attribute__((ext_vector_type(16)));
                        f32x16 acc0, acc1;
#pragma unroll
                        for (int q = 0; q < 16; ++q) { acc0[q] = 0.f; acc1[q] = 0.f; }
                        const int dlo = 8 * wave - 63, dhi = 8 * wave + 7;
#define HY_AF(dst, off_) do { const LAS unsigned* a_ = ap + (off_); u32x4 w_ = {a_[0], a_[1], a_[2], a_[3]}; __builtin_memcpy(&dst, &w_, 16); } while (0)
                        {
                            bf16x8 f16, f24;
                            { const LAS unsigned* ap = Rdw + abase - 32 * dlo; HY_AF(f16, 16); HY_AF(f24, 24); }
#pragma unroll 1
                            for (int dl = dlo; dl <= dhi; ++dl) {
                                const int j = iblk - dl; const bool ok = (j >= 0) && (j < 64); const int jc = j < 0 ? 0 : (j > 63 ? 63 : j);
                                const LAS bf16_t* zp = Z + jc * 64; const int sw = (jc >> 1) & 1;
                                const LAS unsigned* ap = Rdw + abase - 32 * dl;
                                bf16x8 bf[4], fm16, fm8, f0, f8;
#pragma unroll
                                for (int kk = 0; kk < 4; ++kk) { bf16x8 t = *(const LAS bf16x8*)(zp + (((2 * kk + hh) ^ sw) << 3)); bf[kk] = ok ? t : (bf16x8){0, 0, 0, 0, 0, 0, 0, 0}; }
                                HY_AF(fm16, -16); HY_AF(fm8, -8); HY_AF(f0, 0); HY_AF(f8, 8);
                                acc0 = __builtin_amdgcn_mfma_f32_32x32x16_bf16(f0, bf[0], acc0, 0, 0, 0);  acc1 = __builtin_amdgcn_mfma_f32_32x32x16_bf16(fm16, bf[0], acc1, 0, 0, 0);
                                acc0 = __builtin_amdgcn_mfma_f32_32x32x16_bf16(f8, bf[1], acc0, 0, 0, 0);  acc1 = __builtin_amdgcn_mfma_f32_32x32x16_bf16(fm8, bf[1], acc1, 0, 0, 0);
                                acc0 = __builtin_amdgcn_mfma_f32_32x32x16_bf16(f16, bf[2], acc0, 0, 0, 0); acc1 = __builtin_amdgcn_mfma_f32_32x32x16_bf16(f0, bf[2], acc1, 0, 0, 0);
                                acc0 = __builtin_amdgcn_mfma_f32_32x32x16_bf16(f24, bf[3], acc0, 0, 0, 0); acc1 = __builtin_amdgcn_mfma_f32_32x32x16_bf16(f8, bf[3], acc1, 0, 0, 0);
                                f16 = fm16; f24 = fm8;
                            }
                        }
#undef HY_AF
                        const float inv = 1.0f / (nrm[(l * 2 + o) * 256 + c] + 1e-6f), hb = a.in[23][(l * 2 + o) * 256 + c];
                        LAS bf16_t* GI = ZA + (o + 1) * 4 * ZS;
                        const LAS bf16_t* ZI = ZA + (o == 0 ? 0 : 4 * ZS);
#pragma unroll
                        for (int q = 0; q < 16; ++q) {
                            const int a0r = (q & 3) + 8 * (q >> 2) + 4 * hh, t0 = 64 * iblk + a0r, t1 = t0 + 32;
                            const int i0 = HY_ZF(bq, t0), i1 = HY_ZF(bq, t1);
                            const float zv0 = bf2f(ZI[i0]), zv1 = bf2f(ZI[i1]);
                            const float y0 = bf2f(GI[i0]) * (acc0[q] * inv + hb * zv0), y1v = bf2f(GI[i1]) * (acc1[q] * inv + hb * zv1);
                            GI[i0] = f2bf(y0); GI[i1] = f2bf(y1v);
                        }
                        __syncthreads();
                    }
                    for (int it = tid; it < 4 * 512; it += 512) { const int b = it >> 9, s8 = (it & 511) * 8;
                        *(u32x4*)(YT + (size_t)c * RT + b * SEQ + s8) = *(const LAS u32x4*)(ZA + 2 * 4 * ZS + HY_ZF(b, s8)); }
                    if (l == 0) {
                        __syncthreads();
                        LAS float* zc = (LAS float*)lds;
                        LAS float* kc = zc + 3072;
                        LAS float* y1c = kc + 1024;
                        for (int it = tid; it < 3072; it += 512) { const int arr = it >> 10, b = (it >> 8) & 3, sx = it & 255, ch = arr * 256 + c;
                            const bf16_t* pp = PT + (size_t)ch * RT + RL + b * CTXL + sx;
                            float z = hcb[ch] + hcw[768 + ch] * bf2f(pp[0]); if (sx > 0) z += hcw[ch] * bf2f(pp[-1]); if (sx + 1 < CTXL) z += hcw[1536 + ch] * bf2f(pp[1]);
                            zc[it] = z; }
                        for (int it = tid; it < 1024; it += 512) { const int o = it >> 9, d = (it & 511) - 256;
                            const bf16_t* kfc = (const bf16_t*)(ws + WS_KFC) + ((size_t)(0 * 2 + o) * 256 + c) * CTXL; const bf16_t* kbc = (const bf16_t*)(ws + WS_KFC) + ((size_t)(1 * 2 + o) * 256 + c) * CTXL;
                            kc[it] = d >= 0 ? bf2f(kfc[d]) : (d > -256 ? bf2f(kbc[-d]) : 0.f); }
                        __syncthreads();
#pragma unroll 1
                        for (int o = 0; o < 2; ++o) {
                            const float inv = 1.0f / (nrm[1024 + o * 256 + c] + 1e-6f), hb = a.in[23][o * 256 + c];
                            for (int it = tid; it < 1024; it += 512) { const int b = it >> 8, t = it & 255;
                                const LAS float* zi = o == 0 ? zc + b * 256 : y1c + b * 256;
                                const LAS float* kk = kc + o * 512 + 256 + t;
                                float acc = 0.f;
#pragma unroll 16
                                for (int sx = 0; sx < CTXL; ++sx) acc += kk[-sx] * zi[sx];
                                const float y = zc[(o + 1) * 1024 + b * 256 + t] * (acc * inv + hb * zi[t]);
                                if (o == 0) y1c[it] = y; else YT[(size_t)c * RT + RL + b * CTXL + t] = f2bf(y); }
                            __syncthreads();
                        }
                    }
                }
#undef HY_ZF
                __syncthreads();
            }
            {
                const pg8::TabSched S{PARTS.p + 18 + l * 3, (const char*)ws, 1, 80, G, (bid + 80) % G};
                pg8::EpiS5State E{(float*)(ws + WS_S5S)};
                pg8::gemm_phase<512, 256>(lds, S, E);
            }
        }
        SEAM(P0 + 2);
        if (((PHMASK >> 14) & 1) && IN(P0 + 3)) {
            const int tid = opaque(tid0), lane = tid & 63;
            LAS float* st = (LAS float*)lds;
            const float* S5S = (const float*)(ws + WS_S5S); bf16_t* US = (bf16_t*)(ws + WS_US);
            for (int u = bid; u < 128; u += G) {
                const int d = u & 1, g = (u >> 1) & 15, b = u >> 5;
                __syncthreads();
                for (int i = tid; i < 272 * 32; i += 512) { const int q = i >> 5, c4 = (i & 31) * 4; const int n = q < 16 ? 1024 + 16 * b + q : 256 * b + (q - 16);
                    const f32x4 v = *(const f32x4*)(S5S + ((size_t)g * NCHKP + n) * 256 + d * 128 + c4);
                    st[q * 128 + c4] = v[0]; st[q * 128 + c4 + 1] = v[1]; st[q * 128 + c4 + 2] = v[2]; st[q * 128 + c4 + 3] = v[3]; }
                __syncthreads();
                if (wave == 0) {
                    const float* ab = (const float*)(ws + WS_AB16) + ((size_t)((l * 2 + d) * 16 + g) * 64 + lane) * 2;
                    const float ar = ab[0], ai = ab[1];
                    float hr = 0.f, hi = 0.f;
#pragma unroll 1
                    for (int k0 = 0; k0 < 272; k0 += 8) {
                        f32x2 sv[8]; int nn[8];
#pragma unroll
                        for (int j = 0; j < 8; ++j) { const int k = k0 + j; const int q = d == 0 ? k : (k < 16 ? 15 - k : 287 - k);
                            nn[j] = q < 16 ? 1024 + 16 * b + q : 256 * b + (q - 16); sv[j] = *(const LAS f32x2*)(st + q * 128 + 2 * lane); }
#pragma unroll
                        for (int j = 0; j < 8; ++j) {
                            *(unsigned*)(US + ((size_t)g * NCHKP + nn[j]) * 512 + 256 + d * 128 + 2 * lane) = cvt_pk_bf16(hr, hi);
                            const float nr = ar * hr - ai * hi + sv[j][0], ni = ar * hi + ai * hr + sv[j][1];
                            hr = nr; hi = ni; }
                    }
                }
            }
            __syncthreads();
            for (int uq = bid; uq < 176; uq += G) { if (uq < 128) continue; const int u = uq - 128;
                const int cb6 = u % 6, d = (u / 6) & 1, b = u / 12;
                LAS f32x2* sa = (LAS f32x2*)lds;
                const f32x2* LAGG = (const f32x2*)(ws + WS_LAGG); float* HIN = (float*)(ws + WS_LHIN);
                __syncthreads();
                for (int i = tid; i < 272 * 64; i += 512) { const int q = i >> 6, c = i & 63; const int n = q < 16 ? 1024 + 16 * b + q : 256 * b + (q - 16);
                    sa[i] = LAGG[((size_t)n * 2 + d) * 384 + cb6 * 64 + c]; }
                __syncthreads();
                if (wave == 0) {
                    float h = 0.f;
#pragma unroll 1
                    for (int k0 = 0; k0 < 272; k0 += 8) {
                        f32x2 sv[8]; int nn[8];
#pragma unroll
                        for (int j = 0; j < 8; ++j) { const int k = k0 + j; const int q = d == 0 ? k : (k < 16 ? 15 - k : 287 - k);
                            nn[j] = q < 16 ? 1024 + 16 * b + q : 256 * b + (q - 16); sv[j] = sa[q * 64 + lane]; }
#pragma unroll
                        for (int j = 0; j < 8; ++j) { HIN[((size_t)nn[j] * 2 + d) * 384 + cb6 * 64 + lane] = h; h = sv[j][0] * h + sv[j][1]; }
                    }
                }
            }
            __syncthreads();
        }
        SEAM(P0 + 3);
        if (((PHMASK >> 15) & 1) && IN(P0 + 4)) {
            const pg8::TabSched S{PARTS.p + 19 + l * 3, (const char*)ws, 1, 80, G, bid};
            pg8::EpiS5Main E{(bf16_t*)(ws + WS_GL), PR, a.in[32] + l * 256};
            pg8::gemm_phase<512, 512>(lds, S, E);
            {
                const int tid = opaque(tid0);
                const bf16_t* YT = (const bf16_t*)(ws + WS_YT);
                LAS bf16_t* tl = (LAS bf16_t*)lds;
                const int nrt = nMrow * 4;
                const int nb0 = G > 160 ? 80 : 0, vb = bid - nb0, vG = G - nb0;
                if (vb >= 0) for (int t = vb; t < 4 * nrt; t += vG) {
                    const int c0 = (t & 3) * 64, r0 = (t >> 2) * 64;
                    __syncthreads();
                    { const int cc = tid >> 3, r8 = (tid & 7) * 8; *(LAS u32x4*)(tl + cc * 72 + r8) = *(const u32x4*)(YT + (size_t)(c0 + cc) * RT + r0 + r8); }
                    __syncthreads();
                    { const int rr = tid >> 3, c8 = (tid & 7) * 8; unsigned short e[8];
#pragma unroll
                        for (int j = 0; j < 8; ++j) e[j] = tl[(c8 + j) * 72 + rr];
                        u32x4 w; w.x = e[0] | ((unsigned)e[1] << 16); w.y = e[2] | ((unsigned)e[3] << 16); w.z = e[4] | ((unsigned)e[5] << 16); w.w = e[6] | ((unsigned)e[7] << 16);
                        *(u32x4*)(YB + (size_t)(r0 + rr) * YW + YC_B + c0 + c8) = w; }
                }
                __syncthreads();
            }
            {
                const int tid = opaque(tid0);
                const bf16_t* LT = (const bf16_t*)(ws + WS_LT); const float* HIN = (const float*)(ws + WS_LHIN);
                const int nrows = nMrow * 256;
                const int nb0 = G > 160 ? 80 : 0, vb = bid - nb0, vG = G - nb0;
                if (vb >= 0) for (int it = vb * 512 + tid; it < nrows * 48; it += vG * 512) {
                    const int r = it / 48, c8 = (it - r * 48) * 8, n = r >> 4;
                    const u32x4 gt = *(const u32x4*)(PR + (size_t)r * LDP + PC_AG + c8);
                    const bf16_t* lt = LT + (size_t)r * 1152 + c8;
                    const u32x4 sv = *(const u32x4*)lt, pf = *(const u32x4*)(lt + 384), pb = *(const u32x4*)(lt + 768);
                    const float* hf = HIN + ((size_t)n * 2 + 0) * 384 + c8; const float* hb = hf + 384;
                    const f32x4 hf0 = *(const f32x4*)hf, hf1 = *(const f32x4*)(hf + 4), hb0 = *(const f32x4*)hb, hb1 = *(const f32x4*)(hb + 4);
                    u32x4 w;
                    w.x = cvt_pk_bf16(gelu_f(bflo(gt.x)) * (bflo(sv.x) + bflo(pf.x) * hf0[0] + bflo(pb.x) * hb0[0]), gelu_f(bfhi(gt.x)) * (bfhi(sv.x) + bfhi(pf.x) * hf0[1] + bfhi(pb.x) * hb0[1]));
                    w.y = cvt_pk_bf16(gelu_f(bflo(gt.y)) * (bflo(sv.y) + bflo(pf.y) * hf0[2] + bflo(pb.y) * hb0[2]), gelu_f(bfhi(gt.y)) * (bfhi(sv.y) + bfhi(pf.y) * hf0[3] + bfhi(pb.y) * hb0[3]));
                    w.z = cvt_pk_bf16(gelu_f(bflo(gt.z)) * (bflo(sv.z) + bflo(pf.z) * hf1[0] + bflo(pb.z) * hb1[0]), gelu_f(bfhi(gt.z)) * (bfhi(sv.z) + bfhi(pf.z) * hf1[1] + bfhi(pb.z) * hb1[1]));
                    w.w = cvt_pk_bf16(gelu_f(bflo(gt.w)) * (bflo(sv.w) + bflo(pf.w) * hf1[2] + bflo(pb.w) * hb1[2]), gelu_f(bfhi(gt.w)) * (bfhi(sv.w) + bfhi(pf.w) * hf1[3] + bfhi(pb.w) * hb1[3]));
                    *(u32x4*)(YB + (size_t)r * YW + YC_A + c8) = w;
                }
            }
        }
        SEAM(P0 + 4);
        if (((PHMASK >> 15) & 1) && IN(P0 + 5)) {
            const pg8::TabSched S{PARTS.p + 20 + l * 3, (const char*)ws, 1, nMrow, G, bid};
            pg8::EpiS5Glu E{YB, (const bf16_t*)(ws + WS_GL), a.in[34] + l * 256};
            pg8::gemm_phase<256, 256>(lds, S, E);
        }
        SEAM(P0 + 5);
        if (((PHMASK >> 3) & 1) && IN(P0 + 6)) {
            const pg8::MergeSched S{(const char*)ws, (long long)WS_YB, (long long)(WS_WL + (size_t)l * SZ_WL + SZ_WINR + SZ_WINHY), 64, G, bid, l == 0 ? 64 : 0};
            pg8::EpiGate E{ws + WS_GQ, UB, (bf16_t*)(ws + WS_MGC)};
            pg8::gemm_phase<1280, 1280>(lds, S, E);
        }
        SEAM(P0 + 6);
        if (((PHMASK >> 4) & 1) && IN(P0 + 7)) {
            const pg8::TabSched S{l == 0 ? PARTS.p + 24 : PARTS.p + 14, (const char*)ws, l == 0 ? 2 : 1, l == 0 ? 256 + 64 : 256, G, bid};
            pg8::EpiRes E{PRE, xlat, xctx, MODL + 2048, (float*)(ws + WS_EXTRA)};
            pg8::gemm_phase<1024, 1024>(lds, S, E);
        }
        SEAM(P0 + 7);
        if (((PHMASK >> 5) & 1) && IN(P0 + 8)) {
            const int lane = opaque(tid0) & 63;
            if (l == 1) convert_tiles_pipelined(a, JT_MOE, (LAS float*)lds, bid, G);
            const float* lg = a.in[40] + l * D; const float* lb = a.in[41] + l * D;
            const int nrows = nMrow * 256;
            for (int r = bid * 8 + wave; r < nrows; r += G * 8) {
                const float* mv = MODL + (size_t)(r < RL ? (r >> 12) : 4) * 6144;
                RowV pre;
                if (r < RL) { const RowV xin = row_load(xlat + (size_t)r * D, lane), ga = row_load_bf16((const bf16_t*)PRE + (size_t)r * D, lane);
#pragma unroll
                    for (int i = 0; i < 4; ++i) pre.v[i] = xin.v[i] * ALPHA + ga.v[i]; }
                else { const float* pp = (const float*)(ws + WS_EXTRA) + (size_t)(r - RL) * D; const RowV xin = row_load(ctx_in + (size_t)(r - RL) * D, lane), p0 = row_load(pp, lane), p1 = row_load(pp + (size_t)RC * D, lane), p2 = row_load(pp + (size_t)2 * RC * D, lane), p3 = row_load(pp + (size_t)3 * RC * D, lane);
#pragma unroll
                    for (int i = 0; i < 4; ++i) pre.v[i] = xin.v[i] * ALPHA + ((p0.v[i] + p1.v[i]) + (p2.v[i] + p3.v[i])); }
                const RowV x1 = row_affine(row_norm(pre), lg, lb, lane);
                row_store(r < RL ? a.out + (size_t)r * D : XSC + (size_t)(r - RL) * D, lane, x1);
                const RowV u2 = row_modulate(row_norm(x1), mv + 3072, mv + 4096, lane);
                row_store_bf16(UB + (size_t)r * D, lane, u2);
                if (l == 1) {
                    float lg8[8];
#pragma unroll
                    for (int e = 0; e < 8; ++e) lg8[e] = 0.f;
                    f32x4 rw[32];
#pragma unroll
                    for (int q = 0; q < 16; ++q) { const float* wp = a.in[47] + (size_t)(256 * (q >> 2) + 4 * lane + (q & 3)) * 8; rw[2 * q] = *(const f32x4*)wp; rw[2 * q + 1] = *(const f32x4*)(wp + 4); }
                    PIN16(rw); PIN16(rw + 16);
#pragma unroll
                    for (int i = 0; i < 4; ++i)
#pragma unroll
                        for (int j = 0; j < 4; ++j) { const float uv = u2.v[i][j];
                            const f32x4 w0 = rw[2 * (4 * i + j)], w1 = rw[2 * (4 * i + j) + 1];
                            lg8[0] += uv * w0[0]; lg8[1] += uv * w0[1]; lg8[2] += uv * w0[2]; lg8[3] += uv * w0[3]; lg8[4] += uv * w1[0]; lg8[5] += uv * w1[1]; lg8[6] += uv * w1[2]; lg8[7] += uv * w1[3]; }
#pragma unroll
                    for (int e = 0; e < 8; ++e) lg8[e] = wave_sum(lg8[e]);
                    if (lane == 0) {
                        int i1 = 0; float v1 = lg8[0];
#pragma unroll
                        for (int e = 1; e < 8; ++e) if (lg8[e] > v1) { v1 = lg8[e]; i1 = e; }
                        int i2 = 0; float v2 = -3.0e38f;
#pragma unroll
                        for (int e = 0; e < 8; ++e) if (e != i1 && lg8[e] > v2) { v2 = lg8[e]; i2 = e; }
                        const float e2 = expf(v2 - v1), w1 = 1.f / (1.f + e2), w2 = e2 / (1.f + e2);
                        int* tk = (int*)(ws + WS_TOK) + (size_t)r * 8;
                        tk[0] = i1; tk[1] = i2; ((float*)tk)[2] = w1; ((float*)tk)[3] = w2;
                        tk[4] = (int)atomicAdd(ctl + CW_MOECNT + 64 * i1, 1u); tk[5] = (int)atomicAdd(ctl + CW_MOECNT + 64 * i2, 1u);
                    }
                }
            }
        }
        SEAM(P0 + 8);
        if (l == 0) {
            if (((PHMASK >> 6) & 1) && IN(P0 + 9)) {
                const pg8::TabSched S{PARTS.p + 16, (const char*)ws, 1, 68 * 22, G, bid};
                pg8::EpiSwiglu E{(bf16_t*)(ws + WS_H), FF_DENSE, 0};
                pg8::gemm_phase<1024, 1024>(lds, S, E);
            }
            SEAM(P0 + 9);
            if (((PHMASK >> 7) & 1) && IN(P0 + 10)) {
                const pg8::TabSched S{PARTS.p + 26, (const char*)ws, 3, 256 + 48 + 16, G, bid};
                pg8::EpiRes E{PRE, a.out, XSC, MODL + 5120, (float*)(ws + WS_EXTRA)};
                pg8::gemm_phase<FF_DENSE, FF_DENSE>(lds, S, E);
            }
            SEAM(P0 + 10);
            if (((PHMASK >> 8) & 1) && IN(P0 + 11)) {
                const int lane = opaque(tid0) & 63;
                const float* lg = a.in[42]; const float* lb = a.in[43];
                const float* MODN = MOD + (size_t)5 * 6144;
                for (int r = bid * 8 + wave; r < RT; r += G * 8) {
                    const float* mv = MODN + (size_t)(r < RL ? (r >> 12) : 4) * 6144;
                    RowV pre;
                    if (r < RL) { const RowV xin = row_load(a.out + (size_t)r * D, lane), ga = row_load_bf16((const bf16_t*)PRE + (size_t)r * D, lane);
#pragma unroll
                        for (int i = 0; i < 4; ++i) pre.v[i] = xin.v[i] * ALPHA + ga.v[i]; }
                    else { const float* pp = (const float*)(ws + WS_EXTRA) + (size_t)(r - RL) * D; const RowV xin = row_load(XSC + (size_t)(r - RL) * D, lane), p0 = row_load(pp, lane), p1 = row_load(pp + (size_t)RC * D, lane), p2 = row_load(pp + (size_t)2 * RC * D, lane), p3 = row_load(pp + (size_t)3 * RC * D, lane);
#pragma unroll
                        for (int i = 0; i < 4; ++i) pre.v[i] = xin.v[i] * ALPHA + ((p0.v[i] + p1.v[i]) + (p2.v[i] + p3.v[i])); }
                    const RowV x2 = row_affine(row_norm(pre), lg, lb, lane);
                    row_store(r < RL ? a.out + (size_t)r * D : XSC + (size_t)(r - RL) * D, lane, x2);
                    row_store_bf16(UB + (size_t)r * D, lane, row_modulate(row_norm(x2), mv, mv + 1024, lane));
                }
            }
            SEAM(P0 + 11);
        } else {
            bf16_t* AG = (bf16_t*)(ws + WS_AG); float* slotw = (float*)(ws + WS_SLOTW); int* tile_e = (int*)(ws + WS_TILEE);
            if (((PHMASK >> 9) & 1) && IN(P0 + 9)) {
                const int tid = opaque(tid0), lane = tid & 63;
                int ts[NE + 1]; ts[0] = 0;
#pragma unroll
                for (int e = 0; e < NE; ++e) { const unsigned c = __hip_atomic_load(ctl + CW_MOECNT + 64 * e, __ATOMIC_RELAXED, __HIP_MEMORY_SCOPE_AGENT); ts[e + 1] = ts[e] + (int)((c + 255u) >> 8); }
                if (bid == 0) for (int mt = tid; mt < ts[NE]; mt += 512) { int e = 0;
#pragma unroll
                    for (int k = 1; k < NE; ++k) e += (mt >= ts[k]) ? 1 : 0;
                    tile_e[mt] = e; }
                for (int r = bid * 8 + wave; r < RL; r += G * 8) {
                    int* tk = (int*)(ws + WS_TOK) + (size_t)r * 8;
                    const u32x4 v0 = *(const u32x4*)(UB + (size_t)r * D + lane * 16), v1 = *(const u32x4*)(UB + (size_t)r * D + lane * 16 + 8);
#pragma unroll
                    for (int k = 0; k < 2; ++k) {
                        const int e = tk[k], pos = tk[4 + k];
                        int st = 0;
#pragma unroll
                        for (int q = 0; q < NE; ++q) st = (e == q) ? ts[q] : st;
                        const int srow = st * 256 + pos;
                        *(u32x4*)(AG + (size_t)srow * D + lane * 16) = v0; *(u32x4*)(AG + (size_t)srow * D + lane * 16 + 8) = v1;
                        if (lane == 0) { slotw[srow] = ((const float*)tk)[2 + k]; tk[6 + k] = srow; }
                    }
                }
            }
            SEAM(P0 + 9);
            int ttl = 0;
            if (lo <= P0 + 13 && P0 + 10 < hi) {
#pragma unroll
                for (int e = 0; e < NE; ++e) { const unsigned c = __hip_atomic_load(ctl + CW_MOECNT + 64 * e, __ATOMIC_RELAXED, __HIP_MEMORY_SCOPE_AGENT); ttl += (int)((c + 255u) >> 8); }
                ttl = __builtin_amdgcn_readfirstlane(ttl);
            }
#pragma unroll
            for (int pass = 0; pass < 2; ++pass) {
                const int tile0 = pass * MOE_P0; int ntile = pass == 0 ? (ttl < MOE_P0 ? ttl : MOE_P0) : ttl - MOE_P0; ntile = ntile < 0 ? 0 : (ntile > MOE_HCAP ? MOE_HCAP : ntile);
                if (((PHMASK >> 10) & 1) && IN(P0 + 10 + 2 * pass)) {
                    const pg8::MoeSched S{(const char*)AG + (size_t)tile0 * 256 * 1024 * 2, (const char*)(ws + WS_MOEGU), tile_e, 256u * 1024u * 2u, 256u * 1024u * 2u, (size_t)2 * FF_E * 1024 * 2, 28, 16, tile0, ntile, G, bid};
                    pg8::EpiSwiglu E{(bf16_t*)(ws + WS_HM), FF_E, tile0};
                    pg8::gemm_phase<1024, 1024>(lds, S, E);
                }
                SEAM(P0 + 10 + 2 * pass);
                if (((PHMASK >> 11) & 1) && IN(P0 + 11 + 2 * pass)) {
                    pg8::EpiMoeDown E{AG, slotw, (float*)(ws + WS_O2X)};
                    { const int nfull = pass == 0 ? ntile : (ttl < 128 ? ttl : 128) - MOE_P0, nex = pass == 0 ? 0 : ttl - 128;
                        const pg8::MoeTailSched S{(const char*)(ws + WS_HM), (const char*)(ws + WS_MOED), tile_e, tile0, nfull < 0 ? 0 : nfull, nex < 0 ? 0 : nex, G, bid};
                        pg8::gemm_phase<FF_E, FF_E>(lds, S, E); }
                }
                SEAM(P0 + 11 + 2 * pass);
            }
            if (((PHMASK >> 12) & 1) && IN(P0 + 14)) {
                const int lane = opaque(tid0) & 63;
                const float* lg = a.in[42] + D; const float* lb = a.in[43] + D;
                for (int r = bid * 8 + wave; r < RL; r += G * 8) {
                    const int* tk = (const int*)(ws + WS_TOK) + (size_t)r * 8;
                    const int sa = tk[6], sb = tk[7];
                    const bf16_t* oa = AG + (size_t)sa * D; const bf16_t* ob = AG + (size_t)sb * D;
                    const float* gv = MODL + (size_t)(r >> 12) * 6144 + 5120;
                    RowV x1 = row_load(a.out + (size_t)r * D, lane), gq = row_load(gv, lane), pre;
                    u32x2 va[4], vb[4];
#pragma unroll
                    for (int i = 0; i < 4; ++i) { va[i] = *(const u32x2*)(oa + 256 * i + 4 * lane); vb[i] = *(const u32x2*)(ob + 256 * i + 4 * lane); }
                    asm volatile("" : "+v"(va[0]), "+v"(va[1]), "+v"(va[2]), "+v"(va[3]), "+v"(vb[0]), "+v"(vb[1]), "+v"(vb[2]), "+v"(vb[3]), "+v"(x1.v[0]), "+v"(x1.v[1]), "+v"(x1.v[2]), "+v"(x1.v[3]), "+v"(gq.v[0]), "+v"(gq.v[1]), "+v"(gq.v[2]), "+v"(gq.v[3]));
#pragma unroll
                    for (int i = 0; i < 4; ++i) {
                        f32x4 fa = {bflo(va[i].x), bfhi(va[i].x), bflo(va[i].y), bfhi(va[i].y)}, fb = {bflo(vb[i].x), bfhi(vb[i].x), bflo(vb[i].y), bfhi(vb[i].y)};
                        if (sa >= 128 * 256) { const float* px = (const float*)(ws + WS_O2X) + (size_t)(sa - 128 * 256) * D + 256 * i + 4 * lane; fa = (*(const f32x4*)px + *(const f32x4*)(px + (size_t)2048 * D)) + (*(const f32x4*)(px + (size_t)2 * 2048 * D) + *(const f32x4*)(px + (size_t)3 * 2048 * D)); }
                        if (sb >= 128 * 256) { const float* px = (const float*)(ws + WS_O2X) + (size_t)(sb - 128 * 256) * D + 256 * i + 4 * lane; fb = (*(const f32x4*)px + *(const f32x4*)(px + (size_t)2048 * D)) + (*(const f32x4*)(px + (size_t)2 * 2048 * D) + *(const f32x4*)(px + (size_t)3 * 2048 * D)); }
                        pre.v[i] = x1.v[i] * ALPHA + gq.v[i] * (fa + fb); }
                    row_store(a.out + (size_t)r * D, lane, row_affine(row_norm(pre), lg, lb, lane));
                }
            }
        }
    }
#undef IN
#undef SEAM
}

}

extern "C" void kernel_launch(void* const* d_in, const int* in_sizes, int n_in, void* d_out, int out_size, void* d_ws, size_t ws_size, hipStream_t stream) {
    static int grid = 0;
    if (grid == 0) {
        if (n_in != 51 || ws_size < WS_END) { grid = -1; return; }
        int dev = 0, cus = 0;
        if (hipGetDevice(&dev) != hipSuccess || hipDeviceGetAttribute(&cus, hipDeviceAttributeMultiprocessorCount, dev) != hipSuccess) { grid = -1; return; }
        if (hipFuncSetAttribute((const void*)mk_fwd, hipFuncAttributeMaxDynamicSharedMemorySize, LDS_BYTES) != hipSuccess) { grid = -1; return; }
        grid = cus;
    }
    if (grid < 0) return;
    const float* const* in = (const float* const*)d_in;
    unsigned char* ws = (unsigned char*)d_ws;
    (void)hipMemsetAsync(ws + WS_CTL, 0, CTL_BYTES + al256(2 * 5 * 6144 * 4), stream);
    for (int l = 0; l < 2; ++l) (void)hipMemsetAsync(ws + WS_WL + (size_t)l * SZ_WL + SZ_WINR + (size_t)1152 * 1024 * 2, 0, (size_t)128 * 1024 * 2, stream);
    Args a{};
    for (int i = 0; i < 51; ++i) a.in[i] = in[i];
    a.out = (float*)d_out; a.ws = ws;
    int nlaunch = 0;
    auto run1 = [&](int lo, int hi) { a.ph_lo = lo; a.ph_hi = hi; a.bar_region = nlaunch < 5 ? nlaunch : 5; nlaunch++; hipLaunchKernelGGL(mk_fwd, dim3(grid), dim3(512), LDS_BYTES, stream, a); };
    auto run = [&](int lo, int hi) {
#if defined(SPLIT) && SPLIT
        for (int k = lo; k < hi; ++k) { const int q = (k - 1) % NPH_LAYER, l = (k - 1) / NPH_LAYER; if (k > 0 && (q > 14 || (l == 0 && q > 11) || (l == 1 && q == 0))) continue; run1(k, k + 1); }
#else
        run1(lo, hi);
#endif
    };
    run(0, 1 + 2 * NPH_LAYER);
}
```

```cpp
#include <hip/hip_runtime.h>
#include <stdint.h>
#include <math.h>

#define LAS __attribute__((address_space(3)))
typedef unsigned short bf16_t;
typedef short bf16x8 __attribute__((ext_vector_type(8)));
typedef float f32x4 __attribute__((ext_vector_type(4)));
typedef float f32x2 __attribute__((ext_vector_type(2)));
typedef unsigned u32x4 __attribute__((ext_vector_type(4)));
typedef unsigned u32x2 __attribute__((ext_vector_type(2)));

namespace {
constexpr int D = 1024, NB = 4, SEQ = 4096, CTXL = 256;
constexpr int RL = NB * SEQ, RC = NB * CTXL, RT = RL + RC;
constexpr int IN_COLS = 7040;
constexpr int FF_DENSE = 2816, NE = 8, FF_E = 3584;
constexpr float ALPHA = 1.41421356237309515f;
constexpr int LDP = 1792, PC_AG = 0, PC_AC = 384, PC_D = 768, PC_Q = 1024, PC_K = 1408, PC_G = 1792;
constexpr int NPT = 1280, PT_V = 768;
constexpr int YW = 1280, YC_A = 0, YC_B = 384, YC_C = 640, YC_D = 1024;
constexpr int MOE_P0 = 64, MOE_HCAP = 72;
constexpr int MOE_ROWS_MAX = 2 * RL + NE * 256;

constexpr size_t al256(size_t x) { return (x + 255) & ~(size_t)255; }
constexpr size_t WS_CTL = 0, CTL_BYTES = 131072;
constexpr int CW_BAR = 0;
constexpr int CW_MOECNT = 24576;
constexpr int CW_QUEUE = 28672;
constexpr int CW_HYN = 29696;
constexpr size_t WS_MOD = WS_CTL + CTL_BYTES;
constexpr size_t WS_HYN = WS_MOD + al256(2 * 5 * 6144 * 4);
constexpr size_t WS_S5AB = WS_HYN + 4096;
constexpr size_t WS_S5BB = WS_S5AB + 16384;
constexpr size_t WS_AB16 = WS_S5BB + 262144;
constexpr size_t WS_TILEE = WS_AB16 + 32768;
constexpr size_t WS_TOK = WS_TILEE + 1024;
constexpr size_t WS_SLOTW = WS_TOK + (size_t)RL * 32;
constexpr size_t WS_KFL = al256(WS_SLOTW + (size_t)MOE_ROWS_MAX * 4);
constexpr size_t WS_KFC = WS_KFL + (size_t)2 * 1024 * SEQ * 2;
constexpr size_t WS_XSC = WS_KFC + (size_t)1024 * CTXL * 2;
constexpr size_t WS_UB = WS_XSC + (size_t)RC * D * 4;
constexpr size_t SZ_WINR = (size_t)(1792 + 4096) * 1024 * 2, SZ_WINHY = (size_t)NPT * 1024 * 2, SZ_WBR = (size_t)1024 * 1280 * 2, SZ_WOUT = (size_t)1024 * 1024 * 2;
constexpr size_t SZ_WL = SZ_WINR + SZ_WINHY + SZ_WBR + SZ_WOUT;
constexpr size_t WS_WL = WS_UB + (size_t)RT * D * 2;
constexpr size_t WS_FFGU = WS_WL + 2 * SZ_WL;
constexpr size_t WS_FFD = WS_FFGU + (size_t)2 * FF_DENSE * 1024 * 2;
constexpr size_t WS_WGLU = WS_FFD + (size_t)1024 * FF_DENSE * 2;
constexpr size_t WS_OPS = WS_WGLU + (size_t)2 * 256 * 256 * 2;
constexpr size_t WS_OPY = WS_OPS + (size_t)32 * 256 * 256 * 2;
constexpr size_t WS_LW = WS_OPY + (size_t)32 * 256 * 512 * 2;
constexpr size_t WS_PR = WS_LW + (size_t)48 * 4096 * 2;
constexpr size_t WS_PT = WS_PR + (size_t)RT * 5888 * 2;
constexpr size_t WS_GQ = WS_PR + (size_t)RT * LDP * 2;
constexpr size_t WS_YB = WS_PT + (size_t)NPT * RT * 2;
constexpr size_t WS_PRE = WS_YB + (size_t)RT * YW * 2;
constexpr size_t WS_EXTRA = WS_PRE + (size_t)RT * D * 4;
constexpr size_t SZ_EXTRA = (size_t)2 * RT * 384 * 4 + (size_t)RT * 256 * 4;
constexpr size_t WS_END = WS_EXTRA + SZ_EXTRA;
constexpr int NCHK = RT / 16, NCHKP = 1280;
constexpr size_t WS_US = WS_PRE;
constexpr size_t WS_S5S = WS_US + (size_t)16 * NCHKP * 512 * 2;
constexpr size_t WS_GL = WS_S5S + (size_t)16 * NCHKP * 256 * 4;
static_assert(WS_GL + (size_t)RT * 256 * 2 <= WS_EXTRA, "s5 overlay");
constexpr size_t WS_H = WS_PR;
constexpr size_t WS_MOEGU = WS_PR;
constexpr size_t WS_MOED = WS_MOEGU + (size_t)NE * 2 * FF_E * 1024 * 2;
constexpr size_t WS_HM = WS_MOED + (size_t)NE * 1024 * FF_E * 2;
constexpr size_t WS_LT = WS_EXTRA;
constexpr size_t WS_LAGG = WS_LT + (size_t)RT * 3 * 384 * 2;
constexpr size_t WS_LHIN = WS_LAGG + (size_t)NCHK * 2 * 384 * 8;
constexpr size_t WS_YT = WS_LHIN + (size_t)NCHK * 2 * 384 * 4;
static_assert(WS_YT + (size_t)256 * RT * 2 <= WS_EXTRA + SZ_EXTRA, "lru / hyena overlay");
constexpr size_t WS_MGC = WS_EXTRA + (size_t)4 * RC * D * 4;
constexpr size_t WS_AG = WS_EXTRA;
static_assert(WS_HM + (size_t)MOE_HCAP * 256 * FF_E * 2 <= WS_EXTRA, "moe hidden overlay");
constexpr size_t WS_O2X = WS_PRE + ((size_t)32 << 20);
static_assert(WS_HM + (size_t)MOE_HCAP * 256 * FF_E * 2 <= WS_O2X && WS_O2X + (size_t)4 * 2048 * D * 4 <= WS_EXTRA, "moe excess sums");
static_assert((size_t)MOE_ROWS_MAX * 1024 * 2 <= SZ_EXTRA, "moe gather overlay");
static_assert((size_t)RT * FF_DENSE * 2 <= (size_t)RT * 5888 * 2 && WS_GQ + (size_t)RT * 4096 <= WS_PT, "dense hidden overlay / gate bytes");

__device__ __forceinline__ float sigm(float x) { return __builtin_amdgcn_rcpf(1.f + __builtin_amdgcn_exp2f(-1.44269504089f * x)); }
__device__ __forceinline__ float sigm_acc(float x) { return 1.f / (1.f + expf(-x)); }
__device__ __forceinline__ float silu_acc(float x) { return x / (1.f + expf(-x)); }
__device__ __forceinline__ float gelu_t(float x) { return 0.5f * x * (1.f + tanhf(0.7978845608028654f * (x + 0.044715f * x * x * x))); }
__device__ __forceinline__ float gelu_f(float x) { return x * sigm(1.5957691216057308f * (x + 0.044715f * x * x * x)); }
__device__ __forceinline__ float softplus(float x) { return fmaxf(x, 0.f) + log1pf(expf(-fabsf(x))); }
__device__ __forceinline__ float wave_sum(float v) { for (int o = 32; o; o >>= 1) v += __shfl_xor(v, o); return v; }
__device__ __forceinline__ float wave_max(float v) { for (int o = 32; o; o >>= 1) v = fmaxf(v, __shfl_xor(v, o)); return v; }
__device__ __forceinline__ float bf2f(bf16_t b) { return __uint_as_float(((unsigned)b) << 16); }
__device__ __forceinline__ bf16_t f2bf(float f) { unsigned u = __float_as_uint(f); u += 0x7FFFu + ((u >> 16) & 1u); return (bf16_t)(u >> 16); }
__device__ __forceinline__ unsigned cvt_pk_bf16(float lo, float hi) { unsigned r; asm volatile("v_cvt_pk_bf16_f32 %0, %1, %2" : "=v"(r) : "v"(lo), "v"(hi)); return r; }
__device__ __forceinline__ float bflo(unsigned w) { return __uint_as_float(w << 16); }
__device__ __forceinline__ float bfhi(unsigned w) { return __uint_as_float(w & 0xFFFF0000u); }
__device__ __forceinline__ void row_seq(int r, int& start, int& len, int& pos, int& b) {
    if (r < RL) { b = r >> 12; start = b << 12; len = SEQ; pos = r & 4095; }
    else { const int q = r - RL; b = q >> 8; start = RL + (b << 8); len = CTXL; pos = q & 255; }
}

#define XB_TMO      128
#define XB_XCNT(j)  (256  + 64 * (j))
#define XB_XSUB(j)  (1280 + 64 * (j))
#define XB_XGEN(j)  (2304 + 64 * (j))
#define XB_TOP      3328
#define XB_TOPGEN   3392
#define XCD_BAR_WORDS 3456
#define XB_SPIN_CAP (1u << 18)
__device__ __forceinline__ unsigned xb_ld(unsigned* p)              { return __hip_atomic_load(p, __ATOMIC_RELAXED, __HIP_MEMORY_SCOPE_AGENT); }
__device__ __forceinline__ unsigned xb_add(unsigned* p, unsigned v) { return __hip_atomic_fetch_add(p, v, __ATOMIC_RELAXED, __HIP_MEMORY_SCOPE_AGENT); }
__device__ __forceinline__ unsigned xb_xcc_id() { return (unsigned)__builtin_amdgcn_s_getreg((3 << 11) | 20) & 0xFu; }
#define XB_SPIN(cond, bar) do { unsigned _sp = 0; while (cond) { __builtin_amdgcn_s_sleep(1); \
    if ((++_sp & 255u) == 0u) { if (xb_ld(&(bar)[XB_TMO])) break; if (_sp > XB_SPIN_CAP) { atomicAdd(&(bar)[XB_TMO], 1u); break; } } } } while (0)
struct XcdBarrier { unsigned* bar; unsigned x; volatile LAS unsigned* st; };
__device__ __forceinline__ XcdBarrier xcd_barrier_post(unsigned* bar, volatile LAS unsigned* st) {
    XcdBarrier b; b.bar = bar; b.x = xb_xcc_id(); b.st = st;
    if (threadIdx.x == 0) (void)xb_add(&bar[XB_XCNT(b.x)], 1u);
    return b;
}
__device__ __forceinline__ void xcd_barrier_complete(unsigned* bar, unsigned x, unsigned& nloc, unsigned& nx) {
    const unsigned G = gridDim.x * gridDim.y * gridDim.z;
    unsigned sum, cnt, mine, sp = 0u;
    for (;;) {
        sum = 0u; cnt = 0u; mine = 0u;
#pragma unroll
        for (unsigned j = 0; j < 16; ++j) { const unsigned c = xb_ld(&bar[XB_XCNT(j)]); sum += c; cnt += (c > 0u) ? 1u : 0u; mine = (j == x) ? c : mine; }
        if (sum == G) break;
        __builtin_amdgcn_s_sleep(1);
        if ((++sp & 255u) == 0u) { if (xb_ld(&bar[XB_TMO])) break; if (sp > XB_SPIN_CAP) { atomicAdd(&bar[XB_TMO], 1u); break; } }
    }
    nloc = mine > 0u ? mine : 1u; nx = cnt > 0u ? cnt : 1u;
}
__device__ __forceinline__ void xcd_barrier(const XcdBarrier& b) {
    asm volatile("s_waitcnt vmcnt(0)" ::: "memory");
    __syncthreads();
    if (threadIdx.x == 0) {
        unsigned* bar = b.bar;
        __builtin_amdgcn_s_waitcnt(0);
        unsigned nloc = b.st[0], nx = b.st[1];
        if (nloc == 0u) { xcd_barrier_complete(bar, b.x, nloc, nx); b.st[0] = nloc; b.st[1] = nx; }
        const unsigned old = xb_add(&bar[XB_XSUB(b.x)], 1u);
        const unsigned gen = old / nloc;
        if (old + 1u == (gen + 1u) * nloc) {
            __builtin_amdgcn_fence(__ATOMIC_RELEASE, "agent");
            asm volatile("s_waitcnt vmcnt(0)" ::: "memory");
            const unsigned og = xb_add(&bar[XB_TOP], 1u);
            const unsigned tg = og / nx;
            if (og + 1u == (tg + 1u) * nx) xb_add(&bar[XB_TOPGEN], 1u);
            else XB_SPIN(xb_ld(&bar[XB_TOPGEN]) == tg, bar);
            __builtin_amdgcn_fence(__ATOMIC_ACQUIRE, "agent");
            xb_add(&bar[XB_XGEN(b.x)], 1u);
            asm volatile("s_waitcnt vmcnt(0)" ::: "memory");
        } else {
            XB_SPIN(xb_ld(&bar[XB_XGEN(b.x)]) == gen, bar);
            __builtin_amdgcn_fence(__ATOMIC_ACQUIRE, "agent");
            asm volatile("s_waitcnt vmcnt(0)" ::: "memory");
        }
    }
    __syncthreads();
}

namespace pg8 {
constexpr int BM = 256, BK = 64, HALF = 128, HTB = HALF * BK * 2, STAGE_BYTES = 8 * HTB, NXCD = 8, WGM = 8;
__host__ __device__ __forceinline__ int lds_byte(int r, int c) { const int st = (r >> 4) * 2 + (c >> 5), rr = r & 15, cc = c & 31, ob = rr * 64 + cc * 2; return st * 1024 + (ob ^ (((ob >> 9) & 1) << 5)); }
__host__ __device__ __forceinline__ void stage_rc(int b, int& R, int& C) { const int st = b / 1024, sb = b % 1024, swz = sb ^ (((sb >> 9) & 1) << 5); R = (st >> 1) * 16 + swz / 64; C = (st & 1) * 32 + (swz % 64) / 2; }
__host__ __device__ __forceinline__ int perm32(int rho) { const int n = rho >> 4, i = rho & 15; return 8 * (i >> 2) + 4 * n + (i & 3); }

struct Unit { const char* a; const char* b; int nt; int pm, pn, kind; };

__device__ __forceinline__ void rect_map(int wgid, int nM, int nN, int& pm, int& pn) {
    const int nwg = nM * nN;
    { const int q = nwg / NXCD, r = nwg % NXCD, xcd = wgid % NXCD, off = wgid / NXCD; wgid = (xcd < r ? xcd * (q + 1) : r * (q + 1) + (xcd - r) * q) + off; }
    const int nig = WGM * nN, gid = wgid / nig, fm = gid * WGM, gsz = (nM - fm) < WGM ? (nM - fm) : WGM;
    pm = fm + ((wgid % nig) % gsz); pn = (wgid % nig) / gsz;
}

template <int lda, int ldb, class Epi, class Sched>
__device__ __forceinline__ void gemm_phase(LAS unsigned char* lds, const Sched& S, const Epi& E) {
    int tid_ = threadIdx.x; asm volatile("" : "+v"(tid_));
    const int tid = tid_, wid = __builtin_amdgcn_readfirstlane(tid >> 6), lane = tid & 63, wr = wid >> 2, wc = wid & 3, fr = lane & 15, fq = lane >> 4;
    unsigned voffA[2], voffB[2];
#pragma unroll
    for (int i = 0; i < 2; ++i) { int R, C; stage_rc(tid * 16 + i * 8192, R, C); const int Rb = (R & ~31) + perm32(R & 31);
        voffA[i] = (unsigned)(R * lda + C) * 2u; voffB[i] = (unsigned)(Rb * ldb + C) * 2u; }
    const size_t kstep = (size_t)(BK * 2);
    const size_t hstepA = (size_t)HALF * lda * 2, hstepB = (size_t)HALF * ldb * 2;
    const unsigned ldsw = (unsigned)wid * 1024u;
    const int aoff = lds_byte(wr * 64 + fr, fq * 8), boff = lds_byte(wc * 32 + fr, fq * 8);
#define PG8_SA(b, h) (((b) * 2 + (h)) * HTB)
#define PG8_SB(b, h) ((4 + (b) * 2 + (h)) * HTB)
#define PG8_STAGE(bufoff, gbase, voff) do { _Pragma("unroll") for (int _i = 0; _i < 2; ++_i) \
        __builtin_amdgcn_global_load_lds((const unsigned*)((const char*)(gbase) + (voff)[_i]), (LAS unsigned*)(lds + (bufoff) + ldsw + _i * 8192), 16, 0, 0); } while (0)
#define PG8_LDA(dst, b, h) do { _Pragma("unroll") for (int m = 0; m < 4; ++m) _Pragma("unroll") for (int k = 0; k < 2; ++k) dst[m][k] = *(const LAS bf16x8*)(lds + PG8_SA(b, h) + aoff + m * 2048 + k * 1024); } while (0)
#define PG8_LDB(dst, b, h) do { _Pragma("unroll") for (int n = 0; n < 2; ++n) _Pragma("unroll") for (int k = 0; k < 2; ++k) dst[n][k] = *(const LAS bf16x8*)(lds + PG8_SB(b, h) + boff + n * 2048 + k * 1024); } while (0)
#define PG8_MMA(ai, bj, At, Bt) do { __builtin_amdgcn_s_setprio(1); _Pragma("unroll") for (int m = 0; m < 4; ++m) _Pragma("unroll") for (int n = 0; n < 2; ++n) _Pragma("unroll") for (int k = 0; k < 2; ++k) \
        acc[ai][bj][m][n] = __builtin_amdgcn_mfma_f32_16x16x32_bf16(Bt[n][k], At[m][k], acc[ai][bj][m][n], 0, 0, 0); __builtin_amdgcn_s_setprio(0); } while (0)
#define PG8_WAIT_V(n) asm volatile("s_waitcnt vmcnt(" #n ")" ::: "memory")
#define PG8_WAIT_L(n) asm volatile("s_waitcnt lgkmcnt(" #n ")" ::: "memory")
#define PG8_BAR __builtin_amdgcn_s_barrier()
#define PG8_SCHED __builtin_amdgcn_sched_barrier(0)
    Unit cur, nxt; int ui = 0;
    if (!S.next(0, cur)) return;
    f32x4 acc[2][2][4][2];
#pragma unroll
    for (int a = 0; a < 2; ++a)
#pragma unroll
        for (int b = 0; b < 2; ++b)
#pragma unroll
            for (int m = 0; m < 4; ++m)
#pragma unroll
                for (int n = 0; n < 2; ++n) acc[a][b][m][n] = (f32x4){0.f, 0.f, 0.f, 0.f};
    bf16x8 At[4][2], B0[2][2], B1[2][2];
    const char* cA = cur.a; const char* cB = cur.b;
    PG8_STAGE(PG8_SB(0, 0), cB, voffB); PG8_STAGE(PG8_SA(0, 0), cA, voffA); PG8_STAGE(PG8_SB(0, 1), cB + hstepB, voffB); PG8_STAGE(PG8_SA(0, 1), cA + hstepA, voffA);
    if (wr == 1) PG8_BAR;
    PG8_WAIT_V(4); PG8_BAR;
    PG8_STAGE(PG8_SB(1, 0), cB + kstep, voffB); PG8_STAGE(PG8_SA(1, 0), cA + kstep, voffA); PG8_STAGE(PG8_SB(1, 1), cB + hstepB + kstep, voffB);
    PG8_WAIT_V(6); PG8_BAR;
    for (;;) {
        const bool has_next = S.next(ui + 1, nxt);
        const char* nA = has_next ? nxt.a : cA; const char* nB = has_next ? nxt.b : cB;
        const int nt = cur.nt;
        for (int t = 0; t < nt; t += 2) {
            const bool last = (t == nt - 2);
            const char* a1 = cA + (size_t)(t + 1) * kstep;
            const char* a2 = last ? nA : cA + (size_t)(t + 2) * kstep; const char* b2 = last ? nB : cB + (size_t)(t + 2) * kstep;
            const char* a3 = a2 + kstep; const char* b3 = b2 + kstep;
            PG8_LDB(B0, 0, 0); PG8_SCHED; PG8_LDA(At, 0, 0); PG8_STAGE(PG8_SA(1, 1), a1 + hstepA, voffA);
            PG8_WAIT_L(8); PG8_BAR; PG8_WAIT_L(0); PG8_MMA(0, 0, At, B0); PG8_BAR; PG8_SCHED;
            PG8_LDB(B1, 0, 1); PG8_STAGE(PG8_SB(0, 0), b2, voffB);
            PG8_BAR; PG8_WAIT_L(0); PG8_MMA(0, 1, At, B1); PG8_BAR;
            PG8_LDA(At, 0, 1); PG8_STAGE(PG8_SA(0, 0), a2, voffA);
            PG8_BAR; PG8_WAIT_L(0); PG8_MMA(1, 0, At, B0); PG8_BAR; PG8_SCHED;
            PG8_STAGE(PG8_SB(0, 1), b2 + hstepB, voffB);
            PG8_WAIT_V(6); PG8_BAR; PG8_MMA(1, 1, At, B1); PG8_BAR;
            PG8_LDB(B0, 1, 0); PG8_SCHED; PG8_LDA(At, 1, 0); PG8_STAGE(PG8_SA(0, 1), a2 + hstepA, voffA);
            PG8_WAIT_L(8); PG8_BAR; PG8_WAIT_L(0); PG8_MMA(0, 0, At, B0); PG8_BAR; PG8_SCHED;
            PG8_LDB(B1, 1, 1); PG8_STAGE(PG8_SB(1, 0), b3, voffB);
            PG8_BAR; PG8_WAIT_L(0); PG8_MMA(0, 1, At, B1); PG8_BAR;
            PG8_LDA(At, 1, 1); PG8_STAGE(PG8_SA(1, 0), a3, voffA);
            PG8_BAR; PG8_WAIT_L(0); PG8_MMA(1, 0, At, B0); PG8_BAR; PG8_SCHED;
            PG8_STAGE(PG8_SB(1, 1), b3 + hstepB, voffB);
            PG8_WAIT_V(6); PG8_BAR; PG8_MMA(1, 1, At, B1); PG8_BAR;
        }
        E(acc, cur, wr, wc, fr, fq);
        if (!has_next) break;
        if (!(Sched::KEEP_ACC && nxt.kind >= 1 && nxt.kind <= 3)) {
#pragma unroll
        for (int a = 0; a < 2; ++a)
#pragma unroll
            for (int b = 0; b < 2; ++b)
#pragma unroll
                for (int m = 0; m < 4; ++m)
#pragma unroll
                    for (int n = 0; n < 2; ++n) acc[a][b][m][n] = (f32x4){0.f, 0.f, 0.f, 0.f};
        }
        cur = nxt; cA = nA; cB = nB; ++ui;
    }
    PG8_WAIT_V(0);
    if (wr == 0) PG8_BAR;
    PG8_BAR;
#undef PG8_SA
#undef PG8_SB
#undef PG8_STAGE
#undef PG8_LDA
#undef PG8_LDB
#undef PG8_MMA
#undef PG8_WAIT_V
#undef PG8_WAIT_L
#undef PG8_BAR
#undef PG8_SCHED
}

struct PartC { long long aOff, bOff; unsigned aStep, bStep; int nM, nN, nt, kind, start, nGrp; unsigned aGrp, bGrp; };
struct TabSched {
    static constexpr bool KEEP_ACC = false;
    const PartC* parts; const char* ws; int np, total, G, c;
    __device__ __forceinline__ bool next(int i, Unit& u) const {
        const int L = i * G + c; if (L >= total) return false;
        int q = 0;
#pragma unroll
        for (int k = 1; k < 4; ++k) if (k < np && L >= parts[k].start) q = k;
        const PartC P = parts[q];
        const int per = P.nM * P.nN, idx = L - P.start, grp = idx / per;
        int pm, pn; rect_map(idx - grp * per, P.nM, P.nN, pm, pn);
        u.a = ws + P.aOff + (size_t)grp * P.aGrp + (size_t)pm * P.aStep; u.b = ws + P.bOff + (size_t)grp * P.bGrp + (size_t)pn * P.bStep; u.nt = P.nt; u.pm = pm; u.pn = pn; u.kind = P.kind + grp; return true;
    }
};
struct MergeSched {
    static constexpr bool KEEP_ACC = true;
    const char* ws; long long aOff, bOff; int nM, G, c;
    int nCtx;
    __device__ __forceinline__ bool next(int i, Unit& u) const {
        int T = (i >> 2) * G + c, br = i & 3; bool ctxu = false;
        if (T >= nM * 4) {
            const int j = (i - 4 * ((nM * 4 - c + G - 1) / G)) * G + c;
            if (j < 0 || j >= nCtx) return false;
            T = nM * 4 + (j >> 2); br = j & 3; ctxu = true;
        }
        int pm, pn;
        if (!ctxu) rect_map(T, nM, 4, pm, pn); else { const int t = T - nM * 4; pm = nM + (t >> 2); pn = t & 3; }
        const int ko = br == 0 ? 0 : (br == 1 ? 384 : (br == 2 ? 640 : 1024));
        u.a = ws + aOff + (size_t)pm * (256u * 1280u * 2u) + ko * 2; u.b = ws + bOff + (size_t)pn * (256u * 1280u * 2u) + ko * 2; u.nt = (br & 1) ? 4 : 6; u.pm = pm; u.pn = pn; u.kind = ctxu ? 4 + br : br; return true;
    }
};
struct MoeSched {
    static constexpr bool KEEP_ACC = false;
    const char* A; const char* B; const int* tile_e; unsigned aStep, bStep; size_t bExp; int nN, nt, tile0, ntile, G, c;
    __device__ __forceinline__ bool next(int i, Unit& u) const {
        const int L = i * G + c; if (L >= ntile * nN) return false;
        const int mt = tile0 + L / nN, pn = L % nN;
        const int e = __builtin_amdgcn_readfirstlane(__hip_atomic_load(tile_e + mt, __ATOMIC_RELAXED, __HIP_MEMORY_SCOPE_AGENT));
        u.a = A + (size_t)(mt - tile0) * aStep; u.b = B + (size_t)e * bExp + (size_t)pn * bStep; u.nt = nt; u.pm = mt; u.pn = pn; u.kind = e; return true;
    }
};

struct MoeTailSched {
    static constexpr bool KEEP_ACC = false;
    const char* A; const char* B; const int* tile_e; int tile0, nfull, nex, G, c;
    __device__ __forceinline__ bool next(int i, Unit& u) const {
        const int L = i * G + c; int mt, pn, nt = 56, flag = 0; size_t koff = 0;
        if (L < nfull * 4) { mt = tile0 + (L >> 2); pn = L & 3; }
        else { const int idx = L - nfull * 4; if (idx >= nex * 16) return false; const int sp = idx & 3, tu = idx >> 2; mt = 128 + (tu >> 2); pn = tu & 3; nt = 14; koff = (size_t)sp * 14 * 128; flag = 8 + 16 * sp; }
        const int e = __builtin_amdgcn_readfirstlane(__hip_atomic_load(tile_e + mt, __ATOMIC_RELAXED, __HIP_MEMORY_SCOPE_AGENT));
        u.a = A + (size_t)(mt - tile0) * (256u * (unsigned)FF_E * 2u) + koff; u.b = B + (size_t)e * ((size_t)1024 * FF_E * 2) + (size_t)pn * (256u * (unsigned)FF_E * 2u) + koff;
        u.nt = nt; u.pm = mt; u.pn = pn; u.kind = e | flag; return true;
    }
};

#define EPI_ROWS(u) const int row0 = (u).pm * BM + wr * 64 + fr, colt = wc * 32 + 8 * fq
struct EpiProj {
    bf16_t* PRp; bf16_t* PTp; bf16_t* USp; int sig_from; unsigned char* GQp;
    __device__ __forceinline__ void operator()(const f32x4 (&acc)[2][2][4][2], const Unit& u, int wr, int wc, int fr, int fq) const {
        EPI_ROWS(u);
        bf16_t* base = u.kind == 1 ? PTp : PRp; const int ldc = u.kind == 1 ? RT : LDP; const bool sg = (u.kind == 0 && u.pn >= sig_from);
        if (sg) {
#pragma unroll
            for (int ai = 0; ai < 2; ++ai)
#pragma unroll
                for (int m = 0; m < 4; ++m) { unsigned char* rowp = GQp + (size_t)(row0 + ai * HALF + m * 16) * 4096 + (u.pn - sig_from) * BM + colt;
#pragma unroll
                    for (int bj = 0; bj < 2; ++bj) { const f32x4 v0 = acc[ai][bj][m][0], v1 = acc[ai][bj][m][1];
                        unsigned lo = 0u, hi = 0u;
                        lo = __builtin_amdgcn_cvt_pk_u8_f32(sigm(v0[0]) * 255.0f, 0, lo); lo = __builtin_amdgcn_cvt_pk_u8_f32(sigm(v0[1]) * 255.0f, 1, lo); lo = __builtin_amdgcn_cvt_pk_u8_f32(sigm(v0[2]) * 255.0f, 2, lo); lo = __builtin_amdgcn_cvt_pk_u8_f32(sigm(v0[3]) * 255.0f, 3, lo);
                        hi = __builtin_amdgcn_cvt_pk_u8_f32(sigm(v1[0]) * 255.0f, 0, hi); hi = __builtin_amdgcn_cvt_pk_u8_f32(sigm(v1[1]) * 255.0f, 1, hi); hi = __builtin_amdgcn_cvt_pk_u8_f32(sigm(v1[2]) * 255.0f, 2, hi); hi = __builtin_amdgcn_cvt_pk_u8_f32(sigm(v1[3]) * 255.0f, 3, hi);
                        *(u32x2*)(rowp + bj * HALF) = (u32x2){lo, hi}; } }
            return;
        }
#pragma unroll
        for (int ai = 0; ai < 2; ++ai)
#pragma unroll
            for (int m = 0; m < 4; ++m) { bf16_t* rowp = base + (size_t)(row0 + ai * HALF + m * 16) * ldc + u.pn * BM + colt;
#pragma unroll
                for (int bj = 0; bj < 2; ++bj) { f32x4 v0 = acc[ai][bj][m][0], v1 = acc[ai][bj][m][1];
                    if (sg) {
#pragma unroll
                        for (int j = 0; j < 4; ++j) { v0[j] = sigm(v0[j]); v1[j] = sigm(v1[j]); } }
                    u32x4 w; w.x = cvt_pk_bf16(v0[0], v0[1]); w.y = cvt_pk_bf16(v0[2], v0[3]); w.z = cvt_pk_bf16(v1[0], v1[1]); w.w = cvt_pk_bf16(v1[2], v1[3]);
                    *(u32x4*)(rowp + bj * HALF) = w;
                    if (u.kind == 0 && u.pn == 3) { const int r = row0 + ai * HALF + m * 16, cc = colt + bj * HALF;
                        *(u32x4*)(USp + ((size_t)(cc >> 4) * NCHKP + (r >> 4)) * 512 + (r & 15) * 16 + (cc & 15)) = w; } } }
    }
};
struct EpiS5State {
    float* Sp;
    __device__ __forceinline__ void operator()(const f32x4 (&acc)[2][2][4][2], const Unit& u, int wr, int wc, int fr, int fq) const {
        EPI_ROWS(u);
#pragma unroll
        for (int ai = 0; ai < 2; ++ai)
#pragma unroll
            for (int m = 0; m < 4; ++m) { float* op = Sp + ((size_t)u.kind * NCHKP + row0 + ai * HALF + m * 16) * 256 + colt;
#pragma unroll
                for (int bj = 0; bj < 2; ++bj)
#pragma unroll
                    for (int n = 0; n < 2; ++n) *(f32x4*)(op + bj * HALF + 4 * n) = acc[ai][bj][m][n]; }
    }
};
struct EpiS5Main {
    bf16_t* GLp; const bf16_t* PRp; const float* dvec;
    __device__ __forceinline__ void operator()(const f32x4 (&acc)[2][2][4][2], const Unit& u, int wr, int wc, int fr, int fq) const {
        EPI_ROWS(u);
        const int cl = 16 * u.kind + (colt & 15);
        const f32x4 d0 = *(const f32x4*)(dvec + cl), d1 = *(const f32x4*)(dvec + cl + 4);
#pragma unroll
        for (int ai = 0; ai < 2; ++ai) {
            u32x4 uq[4][2];
#pragma unroll
            for (int m = 0; m < 4; ++m) { const int n = row0 + ai * HALF + m * 16;
#pragma unroll
                for (int bj = 0; bj < 2; ++bj) { const int c = colt + bj * HALF, r = 16 * (n < NCHK ? n : 0) + (c >> 4); uq[m][bj] = *(const u32x4*)(PRp + (size_t)r * LDP + PC_D + cl); } }
#pragma unroll
            for (int m = 0; m < 4; ++m) { const int n = row0 + ai * HALF + m * 16; if (n >= NCHK) continue;
#pragma unroll
                for (int bj = 0; bj < 2; ++bj) { const int c = colt + bj * HALF, r = 16 * n + (c >> 4); const u32x4 uv = uq[m][bj];
                    const f32x4 v0 = acc[ai][bj][m][0], v1 = acc[ai][bj][m][1];
                    u32x4 w; w.x = cvt_pk_bf16(gelu_f(v0[0] + d0[0] * bflo(uv.x)), gelu_f(v0[1] + d0[1] * bfhi(uv.x))); w.y = cvt_pk_bf16(gelu_f(v0[2] + d0[2] * bflo(uv.y)), gelu_f(v0[3] + d0[3] * bfhi(uv.y)));
                    w.z = cvt_pk_bf16(gelu_f(v1[0] + d1[0] * bflo(uv.z)), gelu_f(v1[1] + d1[1] * bfhi(uv.z))); w.w = cvt_pk_bf16(gelu_f(v1[2] + d1[2] * bflo(uv.w)), gelu_f(v1[3] + d1[3] * bfhi(uv.w)));
                    *(u32x4*)(GLp + (size_t)r * 256 + cl) = w; } }
        }
    }
};
struct EpiS5Glu {
    bf16_t* YBp; const bf16_t* GLp; const float* bvec;
    __device__ __forceinline__ void operator()(const f32x4 (&acc)[2][2][4][2], const Unit& u, int wr, int wc, int fr, int fq) const {
        EPI_ROWS(u);
        f32x4 bq[2][2];
#pragma unroll
        for (int bj = 0; bj < 2; ++bj) { bq[bj][0] = *(const f32x4*)(bvec + colt + bj * HALF); bq[bj][1] = *(const f32x4*)(bvec + colt + bj * HALF + 4); }
#pragma unroll
        for (int ai = 0; ai < 2; ++ai) {
            u32x4 gq[4][2];
#pragma unroll
            for (int m = 0; m < 4; ++m)
#pragma unroll
                for (int bj = 0; bj < 2; ++bj) gq[m][bj] = *(const u32x4*)(GLp + (size_t)(row0 + ai * HALF + m * 16) * 256 + colt + bj * HALF);
#pragma unroll
            for (int m = 0; m < 4; ++m) { const int r = row0 + ai * HALF + m * 16;
#pragma unroll
                for (int bj = 0; bj < 2; ++bj) { const int c = colt + bj * HALF; const u32x4 gv = gq[m][bj];
                    const f32x4 v0 = acc[ai][bj][m][0] + bq[bj][0], v1 = acc[ai][bj][m][1] + bq[bj][1];
                    u32x4 w; w.x = cvt_pk_bf16(bflo(gv.x) * sigm(v0[0]), bfhi(gv.x) * sigm(v0[1])); w.y = cvt_pk_bf16(bflo(gv.y) * sigm(v0[2]), bfhi(gv.y) * sigm(v0[3]));
                    w.z = cvt_pk_bf16(bflo(gv.z) * sigm(v1[0]), bfhi(gv.z) * sigm(v1[1])); w.w = cvt_pk_bf16(bflo(gv.w) * sigm(v1[2]), bfhi(gv.w) * sigm(v1[3]));
                    *(u32x4*)(YBp + (size_t)r * YW + YC_D + c) = w; } }
        }
    }
};
__device__ __forceinline__ float gq8(unsigned w, int j) { return (float)((w >> (8 * j)) & 255u); }
struct EpiGate {
    const unsigned char* GQp; bf16_t* MGp; bf16_t* MGCp;
    __device__ __forceinline__ void operator()(f32x4 (&acc)[2][2][4][2], const Unit& u, int wr, int wc, int fr, int fq) const {
        EPI_ROWS(u);
        const int br = u.kind & 3;
        if (u.kind < 3) {
#pragma unroll
            for (int ai = 0; ai < 2; ++ai) {
                u32x2 ga[4][2], gb[4][2];
#pragma unroll
                for (int m = 0; m < 4; ++m)
#pragma unroll
                    for (int bj = 0; bj < 2; ++bj) { const unsigned char* gp = GQp + (size_t)(row0 + ai * HALF + m * 16) * 4096 + br * 1024 + u.pn * BM + colt + bj * HALF;
                        ga[m][bj] = *(const u32x2*)gp; gb[m][bj] = *(const u32x2*)(gp + 1024); }
#pragma unroll
                for (int m = 0; m < 4; ++m)
#pragma unroll
                    for (int bj = 0; bj < 2; ++bj)
#pragma unroll
                        for (int j = 0; j < 4; ++j) {
                            acc[ai][bj][m][0][j] *= fmaxf(gq8(ga[m][bj].x, j), 1.0f) * __builtin_amdgcn_rcpf(fmaxf(gq8(gb[m][bj].x, j), 1.0f));
                            acc[ai][bj][m][1][j] *= fmaxf(gq8(ga[m][bj].y, j), 1.0f) * __builtin_amdgcn_rcpf(fmaxf(gq8(gb[m][bj].y, j), 1.0f)); }
            }
            return;
        }
        bf16_t* OB = u.kind >= 4 ? MGCp + (size_t)br * RC * D - (size_t)RL * D : MGp;
        const float lo = u.kind >= 4 ? 0.0f : 1.0f;
#pragma unroll
        for (int ai = 0; ai < 2; ++ai) {
            u32x2 g[4][2];
#pragma unroll
            for (int m = 0; m < 4; ++m)
#pragma unroll
                for (int bj = 0; bj < 2; ++bj) g[m][bj] = *(const u32x2*)(GQp + (size_t)(row0 + ai * HALF + m * 16) * 4096 + br * 1024 + u.pn * BM + colt + bj * HALF);
#pragma unroll
            for (int m = 0; m < 4; ++m) { bf16_t* mp = OB + (size_t)(row0 + ai * HALF + m * 16) * D + u.pn * BM + colt;
#pragma unroll
                for (int bj = 0; bj < 2; ++bj) { const f32x4 v0 = acc[ai][bj][m][0] * (1.0f / 255.0f), v1 = acc[ai][bj][m][1] * (1.0f / 255.0f); const u32x2 gg = g[m][bj];
                    const f32x4 o0 = {v0[0] * fmaxf(gq8(gg.x, 0), lo), v0[1] * fmaxf(gq8(gg.x, 1), lo), v0[2] * fmaxf(gq8(gg.x, 2), lo), v0[3] * fmaxf(gq8(gg.x, 3), lo)};
                    const f32x4 o1 = {v1[0] * fmaxf(gq8(gg.y, 0), lo), v1[1] * fmaxf(gq8(gg.y, 1), lo), v1[2] * fmaxf(gq8(gg.y, 2), lo), v1[3] * fmaxf(gq8(gg.y, 3), lo)};
                    u32x4 w; w.x = cvt_pk_bf16(o0[0], o0[1]); w.y = cvt_pk_bf16(o0[2], o0[3]); w.z = cvt_pk_bf16(o1[0], o1[1]); w.w = cvt_pk_bf16(o1[2], o1[3]);
                    *(u32x4*)(mp + bj * HALF) = w; } }
        }
    }
};
struct EpiRes {
    float* PREp; const float* xlat; const float* xctx; const float* gvec;
    float* partp;
    __device__ __forceinline__ void operator()(const f32x4 (&acc)[2][2][4][2], const Unit& u, int wr, int wc, int fr, int fq) const {
        EPI_ROWS(u);
        if (u.kind != 0) {
            f32x4 gc[2][2];
#pragma unroll
            for (int bj = 0; bj < 2; ++bj)
#pragma unroll
                for (int n = 0; n < 2; ++n) gc[bj][n] = *(const f32x4*)(gvec + (size_t)4 * 6144 + u.pn * BM + colt + bj * HALF + 4 * n);
#pragma unroll
            for (int ai = 0; ai < 2; ++ai)
#pragma unroll
                for (int m = 0; m < 4; ++m) { const int r = row0 + ai * HALF + m * 16; const int c0 = u.pn * BM + colt;
                    float* op = partp + ((size_t)(u.kind - 1) * RC + r) * D + c0;
#pragma unroll
                    for (int bj = 0; bj < 2; ++bj)
#pragma unroll
                        for (int n = 0; n < 2; ++n) *(f32x4*)(op + bj * HALF + 4 * n) = gc[bj][n] * acc[ai][bj][m][n]; }
            return;
        }
        const int c0 = u.pn * BM + colt, rt0 = u.pm * BM;
        const float* gp = gvec + (size_t)(rt0 < RL ? (rt0 >> 12) : 4) * 6144 + c0;
        f32x4 gq[2][2];
#pragma unroll
        for (int bj = 0; bj < 2; ++bj)
#pragma unroll
            for (int n = 0; n < 2; ++n) gq[bj][n] = *(const f32x4*)(gp + bj * HALF + 4 * n);
#pragma unroll
        for (int ai = 0; ai < 2; ++ai)
#pragma unroll
            for (int m = 0; m < 4; ++m) { bf16_t* op = (bf16_t*)PREp + (size_t)(row0 + ai * HALF + m * 16) * D + c0;
#pragma unroll
                for (int bj = 0; bj < 2; ++bj) { const f32x4 v0 = gq[bj][0] * acc[ai][bj][m][0], v1 = gq[bj][1] * acc[ai][bj][m][1];
                    u32x4 w; w.x = cvt_pk_bf16(v0[0], v0[1]); w.y = cvt_pk_bf16(v0[2], v0[3]); w.z = cvt_pk_bf16(v1[0], v1[1]); w.w = cvt_pk_bf16(v1[2], v1[3]);
                    *(u32x4*)(op + bj * HALF) = w; } }
    }
};
struct EpiSwiglu {
    bf16_t* Hp; int ldh; int row_sub;
    __device__ __forceinline__ void operator()(const f32x4 (&acc)[2][2][4][2], const Unit& u, int wr, int wc, int fr, int fq) const {
        const int row0 = (u.pm - row_sub) * BM + wr * 64 + fr, colt = wc * 32 + 8 * fq;
#pragma unroll
        for (int ai = 0; ai < 2; ++ai)
#pragma unroll
            for (int m = 0; m < 4; ++m) { bf16_t* rowp = Hp + (size_t)(row0 + ai * HALF + m * 16) * ldh + u.pn * HALF + colt;
                f32x4 h0, h1;
#pragma unroll
                for (int j = 0; j < 4; ++j) { const float g0 = acc[ai][0][m][0][j], g1 = acc[ai][0][m][1][j];
                    h0[j] = g0 * sigm(g0) * acc[ai][1][m][0][j]; h1[j] = g1 * sigm(g1) * acc[ai][1][m][1][j]; }
                u32x4 w; w.x = cvt_pk_bf16(h0[0], h0[1]); w.y = cvt_pk_bf16(h0[2], h0[3]); w.z = cvt_pk_bf16(h1[0], h1[1]); w.w = cvt_pk_bf16(h1[2], h1[3]);
                *(u32x4*)rowp = w; }
    }
};
struct EpiMoeDown {
    bf16_t* O2; const float* slotw; float* O2X;
    __device__ __forceinline__ void operator()(const f32x4 (&acc)[2][2][4][2], const Unit& u, int wr, int wc, int fr, int fq) const {
        EPI_ROWS(u);
        float wq[2][4];
        if (u.kind & 8) {
            const int sp = (u.kind >> 4) & 3;
#pragma unroll
            for (int ai = 0; ai < 2; ++ai)
#pragma unroll
                for (int m = 0; m < 4; ++m) { const int r = row0 + ai * HALF + m * 16; const float w8 = slotw[r]; float* op = O2X + ((size_t)sp * 2048 + (r - 128 * 256)) * D + u.pn * BM + colt;
#pragma unroll
                    for (int bj = 0; bj < 2; ++bj)
#pragma unroll
                        for (int n = 0; n < 2; ++n) *(f32x4*)(op + bj * HALF + 4 * n) = acc[ai][bj][m][n] * w8; }
            return;
        }
#pragma unroll
        for (int ai = 0; ai < 2; ++ai)
#pragma unroll
            for (int m = 0; m < 4; ++m) wq[ai][m] = slotw[row0 + ai * HALF + m * 16];
#pragma unroll
        for (int ai = 0; ai < 2; ++ai)
#pragma unroll
            for (int m = 0; m < 4; ++m) { const int r = row0 + ai * HALF + m * 16; const float w8 = wq[ai][m];
                bf16_t* rowp = O2 + (size_t)r * D + u.pn * BM + colt;
#pragma unroll
                for (int bj = 0; bj < 2; ++bj) { const f32x4 v0 = acc[ai][bj][m][0] * w8, v1 = acc[ai][bj][m][1] * w8;
                    u32x4 w; w.x = cvt_pk_bf16(v0[0], v0[1]); w.y = cvt_pk_bf16(v0[2], v0[3]); w.z = cvt_pk_bf16(v1[0], v1[1]); w.w = cvt_pk_bf16(v1[2], v1[3]);
                    *(u32x4*)(rowp + bj * HALF) = w; } }
    }
};
}

struct Job { int in_idx; int src_off; int lds; int K; int N; long long dst_off; int ldd; int kcol0; int G, GS, R0; int tile0; };
struct JobTable { Job j[96]; int n; int total; };
constexpr int BIGG = 1 << 30;
constexpr void add_job(JobTable& t, int in_idx, long long src_off, int lds, int K, int N, size_t dst_off, int ldd, int kcol0, int G, int GS, int R0) {
    Job& q = t.j[t.n]; q.in_idx = in_idx; q.src_off = (int)src_off; q.lds = lds; q.K = K; q.N = N; q.dst_off = (long long)dst_off; q.ldd = ldd; q.kcol0 = kcol0; q.G = G; q.GS = GS; q.R0 = R0;
    q.tile0 = t.total; t.total += (K / 64) * (N / 64); t.n++;
}
constexpr JobTable make_jobs(int which) {
    JobTable t{}; t.n = 0; t.total = 0;
    if (which == 0) {
        for (int l = 0; l < 2; ++l) {
            const size_t base = WS_WL + (size_t)l * SZ_WL; const long long wsrc = (long long)l * 1024 * IN_COLS;
            add_job(t, 6, wsrc + 0, IN_COLS, 1024, 768, base, 1024, 0, BIGG, 0, 0);
            add_job(t, 6, wsrc + 2688, IN_COLS, 1024, 256, base, 1024, 0, BIGG, 0, PC_D);
            add_job(t, 6, wsrc + 1536, IN_COLS, 1024, 768, base, 1024, 0, BIGG, 0, PC_Q);
            add_job(t, 6, wsrc + 2944, IN_COLS, 1024, 4096, base, 1024, 0, BIGG, 0, PC_G);
            add_job(t, 6, wsrc + 768, IN_COLS, 1024, 768, base + SZ_WINR, 1024, 0, BIGG, 0, 0);
            add_job(t, 6, wsrc + 2304, IN_COLS, 1024, 384, base + SZ_WINR, 1024, 0, BIGG, 0, PT_V);
            const int kd[4] = {384, 256, 384, 256}, ko[4] = {0, 384, 640, 1024};
            for (int i = 0; i < 4; ++i) add_job(t, 35 + i, (long long)l * kd[i] * 1024, 1024, kd[i], 1024, base + SZ_WINR + SZ_WINHY, 1280, ko[i], BIGG, 0, 0);
            add_job(t, 39, (long long)l * 1024 * 1024, 1024, 1024, 1024, base + SZ_WINR + SZ_WINHY + SZ_WBR, 1024, 0, BIGG, 0, 0);
        }
        for (int q = 0; q < 24; ++q) for (int mat = 0; mat < 2; ++mat)
            add_job(t, mat == 0 ? 9 : 11, (long long)q * 4096, 64, 64, 64, WS_LW + (size_t)(((q / 6) * 2 + mat) * 6 + q % 6) * 4096 * 2, 64, 0, BIGG, 0, 0);
        for (int l = 0; l < 2; ++l) add_job(t, 33, (long long)l * 65536, 256, 256, 256, WS_WGLU + (size_t)l * 256 * 256 * 2, 256, 0, BIGG, 0, 0);
        add_job(t, 44, 0, FF_DENSE, 1024, FF_DENSE, WS_FFGU, 1024, 0, 128, 256, 0);
        add_job(t, 45, 0, FF_DENSE, 1024, FF_DENSE, WS_FFGU, 1024, 0, 128, 256, 128);
        add_job(t, 46, 0, 1024, FF_DENSE, 1024, WS_FFD, FF_DENSE, 0, BIGG, 0, 0);
    } else {
        for (int e = 0; e < NE; ++e) {
            add_job(t, 48, (long long)e * 1024 * FF_E, FF_E, 1024, FF_E, WS_MOEGU + (size_t)e * 2 * FF_E * 1024 * 2, 1024, 0, 128, 256, 0);
            add_job(t, 49, (long long)e * 1024 * FF_E, FF_E, 1024, FF_E, WS_MOEGU + (size_t)e * 2 * FF_E * 1024 * 2, 1024, 0, 128, 256, 128);
            add_job(t, 50, (long long)e * FF_E * 1024, 1024, FF_E, 1024, WS_MOED + (size_t)e * 1024 * FF_E * 2, FF_E, 0, BIGG, 0, 0);
        }
    }
    return t;
}
__device__ const JobTable JT_SMALL = make_jobs(0);
__device__ const JobTable JT_MOE = make_jobs(1);

struct PartTable { pg8::PartC p[32]; };
constexpr pg8::PartC mk_part(size_t aOff, size_t bOff, unsigned aStep, unsigned bStep, int nM, int nN, int nt, int kind, int start) {
    pg8::PartC q{}; q.aOff = (long long)aOff; q.bOff = (long long)bOff; q.aStep = aStep; q.bStep = bStep; q.nM = nM; q.nN = nN; q.nt = nt; q.kind = kind; q.start = start; q.nGrp = 1; q.aGrp = 0; q.bGrp = 0; return q;
}
constexpr PartTable make_parts() {
    PartTable t{};
    for (int l = 0; l < 2; ++l) {
        const size_t WL = WS_WL + (size_t)l * SZ_WL; const int nMrow = l == 0 ? 68 : 64;
        t.p[l * 8 + 0] = mk_part(WS_UB, WL, 256u * 1024u * 2u, 256u * 1024u * 2u, 68, 23, 16, 0, 0);
        t.p[l * 8 + 1] = mk_part(WL + SZ_WINR, WS_UB, 256u * 1024u * 2u, 256u * 1024u * 2u, 5, 68, 16, 1, 68 * 23);
        const int kd[4] = {384, 256, 384, 256}, ko[4] = {0, 384, 640, 1024};
        for (int i = 0; i < 4; ++i) t.p[l * 8 + 2 + i] = mk_part(WS_YB + ko[i] * 2, WL + SZ_WINR + SZ_WINHY + ko[i] * 2, 256u * 1280u * 2u, 256u * 1280u * 2u, nMrow, 4, kd[i] / 64, i, i * nMrow * 4);
        t.p[l * 8 + 6] = mk_part(WS_UB, WL + SZ_WINR + SZ_WINHY + SZ_WBR, 256u * 1024u * 2u, 256u * 1024u * 2u, nMrow, 4, 16, 0, 0);
    }
    for (int l = 0; l < 2; ++l) {
        pg8::PartC q = mk_part(WS_US, WS_OPS + (size_t)l * 16 * 256 * 256 * 2, 256u * 512u * 2u, 0u, 5, 1, 4, 0, 0); q.nGrp = 16; q.aGrp = (unsigned)(NCHKP * 512 * 2); q.bGrp = 256u * 256u * 2u; t.p[18 + l * 3] = q;
        q = mk_part(WS_US, WS_OPY + (size_t)l * 16 * 256 * 512 * 2, 256u * 512u * 2u, 0u, 5, 1, 8, 0, 0); q.nGrp = 16; q.aGrp = (unsigned)(NCHKP * 512 * 2); q.bGrp = 256u * 512u * 2u; t.p[19 + l * 3] = q;
        t.p[20 + l * 3] = mk_part(WS_GL, WS_WGLU + (size_t)l * 256 * 256 * 2, 256u * 256u * 2u, 0u, l == 0 ? 68 : 64, 1, 4, 0, 0);
    }
    {
        const size_t WL0 = WS_WL;
        t.p[24] = mk_part(WS_UB, WL0 + SZ_WINR + SZ_WINHY + SZ_WBR, 256u * 1024u * 2u, 256u * 1024u * 2u, 64, 4, 16, 0, 0);
        pg8::PartC q = mk_part(WS_MGC, WL0 + SZ_WINR + SZ_WINHY + SZ_WBR, 256u * 1024u * 2u, 256u * 1024u * 2u, 4, 4, 16, 1, 256); q.nGrp = 4; q.aGrp = (unsigned)(RC * D * 2); q.bGrp = 0u; t.p[25] = q;
        t.p[26] = mk_part(WS_H, WS_FFD, 256u * (unsigned)FF_DENSE * 2u, 256u * (unsigned)FF_DENSE * 2u, 64, 4, 44, 0, 0);
        q = mk_part(WS_H + (size_t)64 * 256 * FF_DENSE * 2, WS_FFD, 256u * (unsigned)FF_DENSE * 2u, 256u * (unsigned)FF_DENSE * 2u, 4, 4, 12, 1, 256); q.nGrp = 3; q.aGrp = 1536u; q.bGrp = 1536u; t.p[27] = q;
        t.p[28] = mk_part(WS_H + (size_t)64 * 256 * FF_DENSE * 2 + 36 * 128, WS_FFD + 36 * 128, 256u * (unsigned)FF_DENSE * 2u, 256u * (unsigned)FF_DENSE * 2u, 4, 4, 8, 4, 256 + 48);
    }
    t.p[16] = mk_part(WS_UB, WS_FFGU, 256u * 1024u * 2u, 256u * 1024u * 2u, 68, 22, 16, 0, 0);
    t.p[17] = mk_part(WS_H, WS_FFD, 256u * (unsigned)FF_DENSE * 2u, 256u * (unsigned)FF_DENSE * 2u, 68, 4, 44, 0, 0);
    return t;
}
__device__ const PartTable PARTS = make_parts();

struct Args {
    const float* in[51];
    float* out; unsigned char* ws;
    int ph_lo, ph_hi, bar_region, pad0;
};
__device__ __forceinline__ const float* sel_in(const Args& a, int idx) {
    const float* p = a.in[6];
    p = idx == 9 ? a.in[9] : p; p = idx == 11 ? a.in[11] : p; p = idx == 33 ? a.in[33] : p; p = idx == 35 ? a.in[35] : p; p = idx == 36 ? a.in[36] : p; p = idx == 37 ? a.in[37] : p; p = idx == 38 ? a.in[38] : p; p = idx == 39 ? a.in[39] : p;
    p = idx == 44 ? a.in[44] : p; p = idx == 45 ? a.in[45] : p; p = idx == 46 ? a.in[46] : p; p = idx == 48 ? a.in[48] : p; p = idx == 49 ? a.in[49] : p; p = idx == 50 ? a.in[50] : p;
    return p;
}

struct ConvRegs { f32x4 v[4][2]; int jis[4]; };
__device__ __forceinline__ void conv_load(const Args& a, const JobTable& JT, int t0, int stride, ConvRegs& R) {
    int tid = threadIdx.x; asm volatile("" : "+v"(tid));
#pragma unroll
    for (int u = 0; u < 4; ++u) {
        const int t = t0 + u * stride; R.jis[u] = -1;
        if (t < JT.total) {
            int ji = 0;
            for (int k = 1; k < JT.n; ++k) if (t >= JT.j[k].tile0) ji = k;
            R.jis[u] = ji;
            const Job& q = JT.j[ji];
            const int lt = t - q.tile0, nTn = q.N / 64, k0 = (lt / nTn) * 64, n0 = (lt % nTn) * 64;
            const float* src = sel_in(a, q.in_idx) + (size_t)q.src_off + (size_t)k0 * q.lds + n0;
#pragma unroll
            for (int p = 0; p < 2; ++p) R.v[u][p] = *(const f32x4*)(src + (size_t)((tid >> 4) + 32 * p) * q.lds + (tid & 15) * 4);
        }
    }
}
__device__ __forceinline__ void conv_store(const Args& a, const JobTable& JT, LAS float* tile, int t0, int stride, const ConvRegs& R) {
    int tid = threadIdx.x; asm volatile("" : "+v"(tid));
    __syncthreads();
#pragma unroll
    for (int u = 0; u < 4; ++u) if (R.jis[u] >= 0) {
#pragma unroll
        for (int p = 0; p < 2; ++p) { const int kk = (tid >> 4) + 32 * p, nn = (tid & 15) * 4; LAS float* tp = tile + u * (64 * 65) + kk * 65 + nn;
            tp[0] = R.v[u][p][0]; tp[1] = R.v[u][p][1]; tp[2] = R.v[u][p][2]; tp[3] = R.v[u][p][3]; } }
    __syncthreads();
#pragma unroll
    for (int u = 0; u < 4; ++u) if (R.jis[u] >= 0) {
        const Job& q = JT.j[R.jis[u]];
        const int t = t0 + u * stride, lt = t - q.tile0, nTn = q.N / 64, k0 = (lt / nTn) * 64, n0 = (lt % nTn) * 64;
        const int n = tid >> 3, k8 = (tid & 7) * 8, ng = n0 + n;
        const int drow = (ng / q.G) * q.GS + (ng % q.G) + q.R0;
        const LAS float* tp = tile + u * (64 * 65) + n;
        u32x4 w;
        w.x = cvt_pk_bf16(tp[(k8 + 0) * 65], tp[(k8 + 1) * 65]); w.y = cvt_pk_bf16(tp[(k8 + 2) * 65], tp[(k8 + 3) * 65]);
        w.z = cvt_pk_bf16(tp[(k8 + 4) * 65], tp[(k8 + 5) * 65]); w.w = cvt_pk_bf16(tp[(k8 + 6) * 65], tp[(k8 + 7) * 65]);
        *(u32x4*)((bf16_t*)(a.ws + q.dst_off) + (size_t)drow * q.ldd + q.kcol0 + k0 + k8) = w;
    }
}
__device__ __forceinline__ void convert_step(const Args& a, const JobTable& JT, LAS float* tile, int t0, int stride) { ConvRegs R; conv_load(a, JT, t0, stride, R); conv_store(a, JT, tile, t0, stride, R); }
__device__ __forceinline__ void convert_tiles_pipelined(const Args& a, const JobTable& JT, LAS float* tile, int first, int stride) {
    ConvRegs cur; int t0 = first;
    if (t0 >= JT.total) return;
    conv_load(a, JT, t0, stride, cur);
    for (;;) {
        const int tn = t0 + 4 * stride; const bool more = tn < JT.total;
        ConvRegs nxt;
        if (more) conv_load(a, JT, tn, stride, nxt);
        conv_store(a, JT, tile, t0, stride, cur);
        if (!more) break;
        cur = nxt; t0 = tn;
    }
}
__device__ __forceinline__ void convert_tiles(const Args& a, const JobTable& JT, LAS float* tile, int first, int stride) {
    for (int t0 = first; t0 < JT.total; t0 += 4 * stride) convert_step(a, JT, tile, t0, stride);
}

__device__ __forceinline__ int opaque(int v) { asm volatile("" : "+v"(v)); return v; }
#define PIN8(a) asm volatile("" : "+v"((a)[0]), "+v"((a)[1]), "+v"((a)[2]), "+v"((a)[3]), "+v"((a)[4]), "+v"((a)[5]), "+v"((a)[6]), "+v"((a)[7]))
#define PIN16(a) do { PIN8(a); PIN8((a) + 8); } while (0)
struct RowV { f32x4 v[4]; };
__device__ __forceinline__ RowV row_load(const float* p, int lane) { RowV r;
#pragma unroll
    for (int i = 0; i < 4; ++i) r.v[i] = *(const f32x4*)(p + 256 * i + 4 * lane); return r; }
__device__ __forceinline__ RowV row_load_bf16(const bf16_t* p, int lane) { RowV r;
#pragma unroll
    for (int i = 0; i < 4; ++i) { const u32x2 w = *(const u32x2*)(p + 256 * i + 4 * lane); r.v[i] = (f32x4){bflo(w.x), bfhi(w.x), bflo(w.y), bfhi(w.y)}; } return r; }
__device__ __forceinline__ void row_store(float* p, int lane, const RowV& r) {
#pragma unroll
    for (int i = 0; i < 4; ++i) *(f32x4*)(p + 256 * i + 4 * lane) = r.v[i]; }
__device__ __forceinline__ void row_store_bf16(bf16_t* p, int lane, const RowV& r) {
#pragma unroll
    for (int i = 0; i < 4; ++i) { u32x2 w; w.x = cvt_pk_bf16(r.v[i][0], r.v[i][1]); w.y = cvt_pk_bf16(r.v[i][2], r.v[i][3]); *(u32x2*)(p + 256 * i + 4 * lane) = w; } }
__device__ __forceinline__ RowV row_norm(const RowV& x) {
    float s = 0.f;
#pragma unroll
    for (int i = 0; i < 4; ++i) s += (x.v[i][0] + x.v[i][1]) + (x.v[i][2] + x.v[i][3]);
    const float mu = wave_sum(s) * (1.f / D);
    RowV d; float q = 0.f;
#pragma unroll
    for (int i = 0; i < 4; ++i) { d.v[i] = x.v[i] - mu; q += (d.v[i][0] * d.v[i][0] + d.v[i][1] * d.v[i][1]) + (d.v[i][2] * d.v[i][2] + d.v[i][3] * d.v[i][3]); }
    const float rs = rsqrtf(wave_sum(q) * (1.f / D) + 1e-5f);
#pragma unroll
    for (int i = 0; i < 4; ++i) d.v[i] = d.v[i] * rs;
    return d;
}
__device__ __forceinline__ RowV row_affine(const RowV& n, const float* g, const float* b, int lane) {
    RowV o;
#pragma unroll
    for (int i = 0; i < 4; ++i) o.v[i] = n.v[i] * *(const f32x4*)(g + 256 * i + 4 * lane) + *(const f32x4*)(b + 256 * i + 4 * lane);
    return o;
}
__device__ __forceinline__ RowV row_modulate(const RowV& n, const float* sh, const float* sc, int lane) {
    RowV o;
#pragma unroll
    for (int i = 0; i < 4; ++i) o.v[i] = n.v[i] * (*(const f32x4*)(sc + 256 * i + 4 * lane) + 1.0f) + *(const f32x4*)(sh + 256 * i + 4 * lane);
    return o;
}

constexpr int LDS_BYTES = 159744;
constexpr int MISC_OFF = 159488;
constexpr int NPH_LAYER = 16;
#ifndef SPLIT
#define SPLIT 0
#endif

__global__ void __launch_bounds__(512, 2) mk_fwd(Args a) {
    extern __shared__ __attribute__((aligned(16))) unsigned char shm[];
    LAS unsigned char* lds = (LAS unsigned char*)shm;
    volatile LAS unsigned* MISC = (volatile LAS unsigned*)(lds + MISC_OFF);
    const int tid0 = threadIdx.x, wave = __builtin_amdgcn_readfirstlane(tid0 >> 6);
    const int G = gridDim.x, bid = blockIdx.x;
    if (tid0 < (LDS_BYTES - MISC_OFF) / 4) MISC[tid0] = 0u;
    __syncthreads();
    unsigned char* ws = a.ws;
    unsigned* ctl = (unsigned*)(ws + WS_CTL);
    XcdBarrier bar = xcd_barrier_post(ctl + CW_BAR + a.bar_region * XCD_BAR_WORDS, MISC + 8);
    const int lo = a.ph_lo, hi = a.ph_hi;
#ifndef PHMASK
#define PHMASK 0xFFFF
#endif
#define IN(k) (lo <= (k) && (k) < hi)
#define SEAM(k) do { if (lo <= (k) && (k) + 1 < hi) xcd_barrier(bar); } while (0)
    float* MOD = (float*)(ws + WS_MOD);
    bf16_t* UB = (bf16_t*)(ws + WS_UB); bf16_t* PR = (bf16_t*)(ws + WS_PR); bf16_t* PT = (bf16_t*)(ws + WS_PT); bf16_t* YB = (bf16_t*)(ws + WS_YB);
    float* PRE = (float*)(ws + WS_PRE); float* XSC = (float*)(ws + WS_XSC);
    const float* x_in = a.in[0]; const float* ctx_in = a.in[2];

    if (((PHMASK >> 0) & 1) && IN(0)) {
        const int tid = opaque(tid0), lane = tid & 63;
        __syncthreads();
        LAS float* sc = (LAS float*)lds;
        for (int i = tid; i < 5 * 1024; i += 512) { const int r = i >> 10, k = i & 1023; sc[i] = silu_acc(r < 4 ? a.in[1][r * 1024 + k] : a.in[3][k]); }
        __syncthreads();
        LAS float* red = sc + 5 * 1024;
        for (int u = bid; u < 192; u += G) {
            const int l = u / 96, cg = u - l * 96, n = cg * 64 + lane;
            const float* w = a.in[4] + (size_t)l * 1024 * 6144 + n;
            float a0 = 0, a1 = 0, a2 = 0, a3 = 0, a4 = 0;
            const int kb = wave * 128;
#pragma unroll 8
            for (int k = kb; k < kb + 128; ++k) { const float wv = w[(size_t)k * 6144]; a0 += sc[k] * wv; a1 += sc[1024 + k] * wv; a2 += sc[2048 + k] * wv; a3 += sc[3072 + k] * wv; a4 += sc[4096 + k] * wv; }
            __syncthreads();
            red[(wave * 5 + 0) * 64 + lane] = a0; red[(wave * 5 + 1) * 64 + lane] = a1; red[(wave * 5 + 2) * 64 + lane] = a2; red[(wave * 5 + 3) * 64 + lane] = a3; red[(wave * 5 + 4) * 64 + lane] = a4;
            __syncthreads();
            if (tid < 320) { const int r = tid >> 6, c = tid & 63; float sacc = a.in[5][l * 6144 + cg * 64 + c];
#pragma unroll
                for (int wv = 0; wv < 8; ++wv) sacc += red[(wv * 5 + r) * 64 + c];
                MOD[((size_t)l * 5 + r) * 6144 + cg * 64 + c] = sacc; }
        }
        __syncthreads();
        for (int u = bid; u < 132; u += G) {
            const bool isc = u >= 128; const int l = isc ? 0 : (u >> 6), blk = isc ? u - 128 : (u & 63), L = isc ? CTXL : SEQ, t0 = blk * 64;
            LAS float* feat = (LAS float*)lds;
            LAS float* h1 = feat + 64 * 33;
            LAS float* h2 = h1 + 4096;
            const float* w1 = a.in[16] + l * 33 * 64; const float* b1 = a.in[17] + l * 64; const float* w2 = a.in[18] + l * 4096; const float* b2 = a.in[19] + l * 64;
            const float* w3 = a.in[20] + (size_t)l * 65536; const float* b3 = a.in[21] + l * 1024; const float* fq = a.in[22] + l * 64;
            __syncthreads();
            for (int i = tid; i < 64 * 33; i += 512) { const int tt = i / 33, f = i - tt * 33, t = t0 + tt; float v;
                if (f == 0) v = (float)t / (float)L;
                else { const int band = (f - 1) % 16 + 1; const int m = (int)(((long)t * band) % L); const double ang = 2.0 * M_PI * (double)m / (double)L; v = f <= 16 ? (float)cos(ang) : (float)sin(ang); }
                feat[i] = v; }
            __syncthreads();
            for (int i = tid; i < 4096; i += 512) { const int tt = i >> 6, j = i & 63; float sacc = b1[j];
                for (int f = 0; f < 33; ++f) sacc += feat[tt * 33 + f] * w1[f * 64 + j];
                h1[i] = sinf(fq[j] * sacc); }
            __syncthreads();
            for (int i = tid; i < 4096; i += 512) { const int tt = i >> 6, j = i & 63; float sacc = b2[j];
                for (int f = 0; f < 64; ++f) sacc += h1[tt * 64 + f] * w2[f * 64 + j];
                h2[i] = sinf(fq[j] * sacc); }
            __syncthreads();
            const float dmin = 3.0701134573253945f, dmax = 15.350567286626973f;
#pragma unroll 1
            for (int jj = 0; jj < 2; ++jj) {
                const int n = tid + 512 * jj, dir = n >> 9, o = (n >> 8) & 1, c = n & 255;
                float wc[64];
#pragma unroll
                for (int i = 0; i < 64; ++i) wc[i] = w3[i * 1024 + n];
                const float bb = b3[n], delta = dmin + (dmax - dmin) * (float)c / 255.0f;
                bf16_t* dst = isc ? (bf16_t*)(ws + WS_KFC) + ((size_t)(dir * 2 + o) * 256 + c) * CTXL + t0 : (bf16_t*)(ws + WS_KFL) + ((size_t)((l * 2 + dir) * 2 + o) * 256 + c) * SEQ + t0;
                float asum = 0.f;
#pragma unroll 1
                for (int tg = 0; tg < 8; ++tg) {
                    float v[8];
#pragma unroll
                    for (int q = 0; q < 8; ++q) { float sacc = bb; const LAS float* hp = h2 + (tg * 8 + q) * 64;
#pragma unroll
                        for (int i = 0; i < 64; ++i) sacc += hp[i] * wc[i];
                        const int t = t0 + tg * 8 + q;
                        v[q] = sacc * expf(-((float)t / (float)L) * delta);
                        if (!(dir == 1 && t == 0)) asum += fabsf(v[q]); }
                    u32x4 w; w.x = cvt_pk_bf16(v[0], v[1]); w.y = cvt_pk_bf16(v[2], v[3]); w.z = cvt_pk_bf16(v[4], v[5]); w.w = cvt_pk_bf16(v[6], v[7]);
                    *(u32x4*)(dst + tg * 8) = w;
                }
                atomicAdd((float*)(ctl + CW_HYN) + (isc ? 1024 + o * 256 + c : (l * 2 + o) * 256 + c), asum);
            }
        }
        __syncthreads();
        for (int uq = bid; uq < 164; uq += G) { if (uq < 132) continue; const int u = uq - 132;
            const int l = u >> 4, g = u & 15;
            LAS float* PW = (LAS float*)lds;
            LAS float* BBs = PW + 2 * 64 * 17 * 2;
            LAS float* Cs = BBs + 2 * 64 * 16 * 2;
            LAS float* KT = Cs + 2 * 16 * 64 * 2;
            __syncthreads();
            if (tid < 128) {
                const int d = tid >> 6, p = tid & 63, idx = l * 2048 + (d * 16 + g) * 64 + p;
                const double ar = a.in[25][idx], ai = a.in[26][idx], dt = exp((double)a.in[27][l * 32 + d * 16 + g]);
                const double mag = exp(dt * ar), abr = mag * cos(dt * ai), abi = mag * sin(dt * ai), den = ar * ar + ai * ai;
                const double fr = ((abr - 1.0) * ar + abi * ai) / den, fi = (abi * ar - (abr - 1.0) * ai) / den;
                double pr = 1.0, pi = 0.0;
                for (int k = 0; k <= 16; ++k) { PW[((d * 64 + p) * 17 + k) * 2] = (float)pr; PW[((d * 64 + p) * 17 + k) * 2 + 1] = (float)pi; const double nr = pr * abr - pi * abi, ni = pr * abi + pi * abr; pr = nr; pi = ni; }
                float* a16 = (float*)(ws + WS_AB16) + ((size_t)((l * 2 + d) * 16 + g) * 64 + p) * 2;
                a16[0] = PW[((d * 64 + p) * 17 + 16) * 2]; a16[1] = PW[((d * 64 + p) * 17 + 16) * 2 + 1];
                for (int i = 0; i < 16; ++i) { const double br = a.in[28][(size_t)idx * 16 + i], bi = a.in[29][(size_t)idx * 16 + i];
                    BBs[((d * 64 + p) * 16 + i) * 2] = (float)(fr * br - fi * bi); BBs[((d * 64 + p) * 16 + i) * 2 + 1] = (float)(fr * bi + fi * br); }
            }
            for (int i = tid; i < 2048; i += 512) { const int d = i >> 10, o = (i >> 6) & 15, p = i & 63; const size_t ci = (size_t)l * 32768 + ((size_t)(d * 16 + g) * 16 + o) * 64 + p;
                Cs[i * 2] = a.in[30][ci]; Cs[i * 2 + 1] = a.in[31][ci]; }
            __syncthreads();
            for (int e = tid; e < 8192; e += 512) { const int d = e >> 12, k = (e >> 8) & 15, o = (e >> 4) & 15, i = e & 15;
                float acc = 0.f;
                for (int p = 0; p < 64; ++p) { const float cr = Cs[((d * 16 + o) * 64 + p) * 2], ci = Cs[((d * 16 + o) * 64 + p) * 2 + 1], pr = PW[((d * 64 + p) * 17 + k) * 2], pi = PW[((d * 64 + p) * 17 + k) * 2 + 1];
                    const float tr = cr * pr - ci * pi, ti = cr * pi + ci * pr;
                    acc += tr * BBs[((d * 64 + p) * 16 + i) * 2] - ti * BBs[((d * 64 + p) * 16 + i) * 2 + 1]; }
                KT[e] = acc; }
            __syncthreads();
            bf16_t* OPS = (bf16_t*)(ws + WS_OPS) + (size_t)(l * 16 + g) * 256 * 256;
            bf16_t* OPY = (bf16_t*)(ws + WS_OPY) + (size_t)(l * 16 + g) * 256 * 512;
            for (int e = tid; e < 256 * 32; e += 512) {
                const int row = e >> 5, c0 = (e & 31) * 8, d = row >> 7, p = (row >> 1) & 63, ri = row & 1, sx = c0 >> 4, i0 = c0 & 15, k = d == 0 ? 15 - sx : sx;
                const float pr = PW[((d * 64 + p) * 17 + k) * 2], pi = PW[((d * 64 + p) * 17 + k) * 2 + 1];
                float v[8];
#pragma unroll
                for (int j = 0; j < 8; ++j) { const float br = BBs[((d * 64 + p) * 16 + i0 + j) * 2], bi = BBs[((d * 64 + p) * 16 + i0 + j) * 2 + 1]; v[j] = ri == 0 ? pr * br - pi * bi : pr * bi + pi * br; }
                u32x4 w; w.x = cvt_pk_bf16(v[0], v[1]); w.y = cvt_pk_bf16(v[2], v[3]); w.z = cvt_pk_bf16(v[4], v[5]); w.w = cvt_pk_bf16(v[6], v[7]);
                *(u32x4*)(OPS + (size_t)row * 256 + c0) = w; }
            for (int e = tid; e < 256 * 64; e += 512) {
                const int row = e >> 6, c0 = (e & 63) * 8, t = row >> 4, o = row & 15;
                float v[8];
                if (c0 < 256) { const int sx = c0 >> 4, i0 = c0 & 15;
#pragma unroll
                    for (int j = 0; j < 8; ++j) { float x = 0.f; if (sx <= t) x += KT[((0 * 16 + (t - sx)) * 16 + o) * 16 + i0 + j]; if (sx >= t) x += KT[((1 * 16 + (sx - t)) * 16 + o) * 16 + i0 + j]; v[j] = x; } }
                else { const int c2 = c0 - 256, d = c2 >> 7, k = d == 0 ? t + 1 : 16 - t;
#pragma unroll
                    for (int j = 0; j < 8; ++j) { const int p = ((c2 + j) >> 1) & 63, ri = (c2 + j) & 1;
                        const float cr = Cs[((d * 16 + o) * 64 + p) * 2], ci = Cs[((d * 16 + o) * 64 + p) * 2 + 1], pr = PW[((d * 64 + p) * 17 + k) * 2], pi = PW[((d * 64 + p) * 17 + k) * 2 + 1];
                        v[j] = ri == 0 ? cr * pr - ci * pi : -(cr * pi + ci * pr); } }
                u32x4 w; w.x = cvt_pk_bf16(v[0], v[1]); w.y = cvt_pk_bf16(v[2], v[3]); w.z = cvt_pk_bf16(v[4], v[5]); w.w = cvt_pk_bf16(v[6], v[7]);
                *(u32x4*)(OPY + (size_t)row * 512 + c0) = w; }
        }
        __syncthreads();
        for (;;) {
            __syncthreads();
            if (tid == 0) MISC[16] = atomicAdd(ctl + CW_QUEUE, 4u);
            __syncthreads();
            const int base = (int)MISC[16];
            if (base >= JT_SMALL.total) break;
            convert_step(a, JT_SMALL, (LAS float*)lds, base, 1);
        }
        __syncthreads();
    }
    SEAM(0);

    for (int l = 0; l < 2; ++l) {
        const int P0 = 1 + l * NPH_LAYER;
        const float* MODL = MOD + (size_t)l * 5 * 6144;
        const unsigned char* WL = ws + WS_WL + (size_t)l * SZ_WL;
        const int nMrow = (l == 0) ? 68 : 64;
        const float* xlat = (l == 0) ? x_in : a.out; const float* xctx = (l == 0) ? ctx_in : XSC;

        if (((PHMASK >> 1) & 1) && l == 0 && IN(P0 + 0)) {
            const int lane = opaque(tid0) & 63;
            for (int r = bid * 8 + wave; r < RT; r += G * 8) {
                const float* src = r < RL ? x_in + (size_t)r * D : ctx_in + (size_t)(r - RL) * D;
                const float* mv = MODL + (size_t)(r < RL ? (r >> 12) : 4) * 6144;
                const RowV n = row_norm(row_load(src, lane));
                row_store_bf16(UB + (size_t)r * D, lane, row_modulate(n, mv, mv + 1024, lane));
            }
        }
        if (l == 0) SEAM(P0 + 0);

        if (((PHMASK >> 2) & 1) && IN(P0 + 1)) {
            const pg8::TabSched S{PARTS.p + l * 8, (const char*)ws, 2, 68 * 23 + 5 * 68, G, bid};
            pg8::EpiProj E{PR, PT, (bf16_t*)(ws + WS_US), 7, ws + WS_GQ};
            pg8::gemm_phase<1024, 1024>(lds, S, E);
        }
        SEAM(P0 + 1);
        if (((PHMASK >> 13) & 1) && IN(P0 + 2)) {
            const int tid = opaque(tid0), lane = tid & 63;
            LAS float* rp = (LAS float*)lds;
            for (int i = tid; i < 6 * 465; i += 512) rp[i] = a.in[24][l * 2790 + i];
            __syncthreads();
            LAS bf16_t* KW = (LAS bf16_t*)(lds + 11264);
            LAS bf16_t* CK = (LAS bf16_t*)(lds + 11264 + 576 * 144);
            LAS bf16_t* VW = (LAS bf16_t*)(lds + 11264);
            LAS bf16_t* CV = (LAS bf16_t*)(lds + 11264 + 64 * 1168);
            const int ngroups = 768 + (l == 0 ? 48 : 0);
            for (int gi0 = bid; gi0 < 768 + G; gi0 += G) {
                const int gi = gi0 < 768 ? gi0 : 768 + ((gi0 - 768 + G - 48) % G);
                if (gi >= ngroups) continue;
                const bool lat = gi < 768;
                const int combo = lat ? gi >> 5 : (gi - 768) >> 1, b = combo / 6, h = combo - 6 * b;
                const int v = lat ? ((gi & 31) << 3) + wave : (((gi - 768) & 1) << 3) + wave;
                const int r0g = (gi & 31) << 1, rs0 = r0g - 4 < 0 ? 0 : (r0g - 4 > 56 ? 56 : r0g - 4);
                const int ntokw = lat ? ((64 - rs0) < 9 ? (64 - rs0) : 9) * 64 : 0;
                __syncthreads();
                {   const int tid2 = opaque(tid);
#pragma unroll
                    for (int k = 0; k < 9; ++k) { const int c = tid2 + 512 * k, tok = c >> 3, part = c & 7;
                        if (tok < ntokw) *(LAS u32x4*)(KW + tok * 72 + part * 8) = *(const u32x4*)(PR + (size_t)(b * SEQ + rs0 * 64 + tok) * LDP + PC_K + h * 64 + part * 8); }
#pragma unroll
                    for (int k = 0; k < 4; ++k) { const int c = tid2 + 512 * k, tok = c >> 3, part = c & 7;
                        *(LAS u32x4*)(CK + tok * 72 + part * 8) = *(const u32x4*)(PR + (size_t)(RL + b * CTXL + tok) * LDP + PC_K + h * 64 + part * 8); } }
                __syncthreads();
                const int ln2 = opaque(lane), qn = ln2 & 15, g = ln2 >> 4;
                int r = 0, qb, tq, rs = 0, bs = 0, w = 0, cs = 0;
                if (lat) { qb = v & 3; r = v >> 2; rs = r - 4 < 0 ? 0 : (r - 4 > 56 ? 56 : r - 4); bs = qb == 0 ? 0 : (qb == 1 ? 8 : (qb == 2 ? 24 : 32));
                    w = 16 * qb + qn; cs = w - 8 < 0 ? 0 : (w - 8 > 48 ? 48 : w - 8); tq = b * SEQ + r * 64 + w; }
                else { qb = v; tq = RL + b * CTXL + 16 * qb + qn; }
                const int pr0 = rs - rs0;
                const bf16_t* qp = PR + (size_t)tq * LDP + PC_Q + h * 64 + 8 * g;
                const bf16x8 q0 = *(const bf16x8*)qp, q1 = *(const bf16x8*)(qp + 32);
                f32x4 S[32];
                const int koff = 8 * (qn >> 2) + (qn & 3);
                if (lat) {
#pragma unroll
                    for (int p = 0; p < 8; ++p)
#pragma unroll
                        for (int hf = 0; hf < 2; ++hf) { const LAS bf16_t* kp = KW + ((pr0 + p) * 64 + bs + koff + 4 * hf) * 72 + 8 * g;
                            const bf16x8 k0 = *(const LAS bf16x8*)kp, k1 = *(const LAS bf16x8*)(kp + 32);
                            f32x4 acc = {0.f, 0.f, 0.f, 0.f};
                            acc = __builtin_amdgcn_mfma_f32_16x16x32_bf16(k0, q0, acc, 0, 0, 0);
                            acc = __builtin_amdgcn_mfma_f32_16x16x32_bf16(k1, q1, acc, 0, 0, 0);
                            const int rowoff = (h * 15 + (rs + p - r + 7)) * 31;
#pragma unroll
                            for (int j = 0; j < 4; ++j) { const int c = bs + 8 * g + 4 * hf + j; const bool ok = (c >= cs) && (c < cs + 16);
                                const int dc = ok ? c - w + 15 : 0;
                                acc[j] = ok ? acc[j] * 0.125f + rp[rowoff + dc] : -3.0e38f; }
                            S[2 * p + hf] = acc; if (hf == 1 && (p & 1)) __builtin_amdgcn_sched_barrier(0); }
                } else {
#pragma unroll
                    for (int p = 0; p < 16; ++p) S[p] = (f32x4){-3.0e38f, -3.0e38f, -3.0e38f, -3.0e38f};
                }
#pragma unroll
                for (int p = 0; p < 8; ++p)
#pragma unroll
                    for (int hf = 0; hf < 2; ++hf) { const LAS bf16_t* kp = CK + (32 * p + koff + 4 * hf) * 72 + 8 * g;
                        const bf16x8 k0 = *(const LAS bf16x8*)kp, k1 = *(const LAS bf16x8*)(kp + 32);
                        f32x4 acc = {0.f, 0.f, 0.f, 0.f};
                        acc = __builtin_amdgcn_mfma_f32_16x16x32_bf16(k0, q0, acc, 0, 0, 0);
                        acc = __builtin_amdgcn_mfma_f32_16x16x32_bf16(k1, q1, acc, 0, 0, 0);
                        S[16 + 2 * p + hf] = acc * 0.125f; if (hf == 1 && (p & 1)) __builtin_amdgcn_sched_barrier(0); }
                float mx = -3.0e38f;
#pragma unroll
                for (int i = 0; i < 32; ++i) mx = fmaxf(fmaxf(mx, fmaxf(S[i][0], S[i][1])), fmaxf(S[i][2], S[i][3]));
                mx = fmaxf(mx, __shfl_xor(mx, 16)); mx = fmaxf(mx, __shfl_xor(mx, 32));
                float sum = 0.f;
#pragma unroll
                for (int i = 0; i < 32; ++i) {
#pragma unroll
                    for (int j = 0; j < 4; ++j) { const float e = __expf(S[i][j] - mx); S[i][j] = e; sum += e; } }
                sum += __shfl_xor(sum, 16); sum += __shfl_xor(sum, 32);
                const float inv = 1.0f / sum;
                __syncthreads();
                {   const int tid2 = opaque(tid);
#pragma unroll
                    for (int k = 0; k < 9; ++k) { const int c = tid2 + 512 * k, dd = c / 72, part = c - dd * 72;
                        if (part * 8 < ntokw) *(LAS u32x4*)(VW + dd * 584 + part * 8) = *(const u32x4*)(PT + (size_t)(PT_V + h * 64 + dd) * RT + b * SEQ + rs0 * 64 + part * 8); }
#pragma unroll
                    for (int k = 0; k < 4; ++k) { const int c = tid2 + 512 * k, dd = c >> 5, part = c & 31;
                        *(LAS u32x4*)(CV + dd * 264 + part * 8) = *(const u32x4*)(PT + (size_t)(PT_V + h * 64 + dd) * RT + RL + b * CTXL + part * 8); } }
                __syncthreads();
                f32x4 O[4];
#pragma unroll
                for (int dt = 0; dt < 4; ++dt) O[dt] = (f32x4){0.f, 0.f, 0.f, 0.f};
#pragma unroll
                for (int p = 0; p < 16; ++p) {
                    if (p < 8 && !lat) continue;
                    u32x4 pw; pw.x = cvt_pk_bf16(S[2 * p][0], S[2 * p][1]); pw.y = cvt_pk_bf16(S[2 * p][2], S[2 * p][3]); pw.z = cvt_pk_bf16(S[2 * p + 1][0], S[2 * p + 1][1]); pw.w = cvt_pk_bf16(S[2 * p + 1][2], S[2 * p + 1][3]);
                    bf16x8 pf; __builtin_memcpy(&pf, &pw, 16);
#pragma unroll
                    for (int dt = 0; dt < 4; ++dt) { const LAS bf16_t* vp = p < 8 ? VW + (16 * dt + qn) * 584 + (pr0 + p) * 64 + bs + 8 * g : CV + (16 * dt + qn) * 264 + 32 * (p - 8) + 8 * g;
                        O[dt] = __builtin_amdgcn_mfma_f32_16x16x32_bf16(*(const LAS bf16x8*)vp, pf, O[dt], 0, 0, 0); }
                    if (p & 1) __builtin_amdgcn_sched_barrier(0);
                }
                bf16_t* op = YB + (size_t)tq * YW + YC_C + h * 64 + 4 * g;
#pragma unroll
                for (int dt = 0; dt < 4; ++dt) { u32x2 o2; o2.x = cvt_pk_bf16(O[dt][0] * inv, O[dt][1] * inv); o2.y = cvt_pk_bf16(O[dt][2] * inv, O[dt][3] * inv); *(u32x2*)(op + 16 * dt) = o2; }
            }
            __syncthreads();
            {
                const int tid = opaque(tid0), lane = tid & 63;
                LAS float* XC = (LAS float*)lds;
                LAS f32x2* AB = (LAS f32x2*)(lds + 16 * 384 * 4);
                const float* cw = a.in[7] + l * 4 * 384; const float* cb = a.in[8] + l * 384;
                const bf16_t* LW = (const bf16_t*)(ws + WS_LW) + (size_t)l * 24 * 4096;
                bf16_t* LT = (bf16_t*)(ws + WS_LT); f32x2* LAGG = (f32x2*)(ws + WS_LAGG);
                const int dir = (wave >> 2) & 1, ntile = wave & 3, tk = lane & 15, kg = lane >> 4;
                LAS float* CT = (LAS float*)(lds + 16 * 384 * 4 + 2 * 16 * 384 * 8);
                for (int i = tid; i < 768; i += 512) { CT[i] = a.in[10][l * 768 + i]; CT[768 + i] = a.in[12][l * 768 + i]; CT[1536 + i] = -8.0f * softplus(-a.in[13][l * 768 + i]); }
                float cwv[60];
#pragma unroll
                for (int i = 0; i < 12; ++i) { const int idx = tid + 512 * i, ch = idx % 384;
                    cwv[5 * i] = cw[ch]; cwv[5 * i + 1] = cw[384 + ch]; cwv[5 * i + 2] = cw[768 + ch]; cwv[5 * i + 3] = cw[1152 + ch]; cwv[5 * i + 4] = cb[ch]; }
                PIN16(cwv); PIN16(cwv + 16); PIN16(cwv + 32); PIN8(cwv + 48); asm volatile("" : "+v"(cwv[56]), "+v"(cwv[57]), "+v"(cwv[58]), "+v"(cwv[59]));
                for (int n0 = bid; n0 < 1024 + G; n0 += G) {
                    const int n = n0 < 1024 ? n0 : 1024 + ((n0 - 1024 + G - 112) % G);
                    if (n >= NCHK) continue;
                    const int r0 = 16 * n; int start, len, pos0, bb; row_seq(r0, start, len, pos0, bb);
                    __syncthreads();
                    unsigned pin[48];
#pragma unroll
                    for (int i = 0; i < 12; ++i) { const int idx = tid + 512 * i, tok = idx / 384, ch = idx - tok * 384, pos = pos0 + tok;
                        const bf16_t* pr = PR + (size_t)(r0 + tok) * LDP + PC_AC + ch;
                        pin[4 * i + 0] = pos >= 2 ? pr[-2 * LDP] : 0; pin[4 * i + 1] = pos >= 1 ? pr[-LDP] : 0; pin[4 * i + 2] = pr[0]; pin[4 * i + 3] = pos + 1 < len ? pr[LDP] : 0; }
                    PIN16(pin); PIN16(pin + 16); PIN16(pin + 32);
#pragma unroll
                    for (int i = 0; i < 12; ++i) { const int idx = tid + 512 * i, tok = idx / 384, ch = idx - tok * 384;
                        XC[idx] = cwv[5 * i + 4] + cwv[5 * i] * bflo(pin[4 * i]) + cwv[5 * i + 1] * bflo(pin[4 * i + 1]) + cwv[5 * i + 2] * bflo(pin[4 * i + 2]) + cwv[5 * i + 3] * bflo(pin[4 * i + 3]); }
                    __syncthreads();
#pragma unroll 2
                    for (int g = 0; g < 6; ++g) {
                        bf16x8 wq[4];
#pragma unroll
                        for (int ks = 0; ks < 2; ++ks) { const bf16_t* wp = LW + ((size_t)((dir * 2 + 0) * 6 + g) * 64 + 16 * ntile + tk) * 64 + 32 * ks + 8 * kg; wq[2 * ks] = *(const bf16x8*)wp; wq[2 * ks + 1] = *(const bf16x8*)(wp + 6 * 4096); }
                        asm volatile("" : "+v"(wq[0]), "+v"(wq[1]), "+v"(wq[2]), "+v"(wq[3]));
                        f32x4 ar = {0.f, 0.f, 0.f, 0.f}, ai = {0.f, 0.f, 0.f, 0.f};
#pragma unroll
                        for (int ks = 0; ks < 2; ++ks) {
                            const LAS float* xp = XC + tk * 384 + g * 64 + 32 * ks + 8 * kg;
                            const f32x4 x0 = *(const LAS f32x4*)xp, x1 = *(const LAS f32x4*)(xp + 4);
                            u32x4 xw; xw.x = cvt_pk_bf16(x0[0], x0[1]); xw.y = cvt_pk_bf16(x0[2], x0[3]); xw.z = cvt_pk_bf16(x1[0], x1[1]); xw.w = cvt_pk_bf16(x1[2], x1[3]);
                            bf16x8 xf; __builtin_memcpy(&xf, &xw, 16);
                            ar = __builtin_amdgcn_mfma_f32_16x16x32_bf16(xf, wq[2 * ks], ar, 0, 0, 0);
                            ai = __builtin_amdgcn_mfma_f32_16x16x32_bf16(xf, wq[2 * ks + 1], ai, 0, 0, 0);
                        }
                        const int ch = g * 64 + 16 * ntile + tk;
                        const float br = CT[dir * 384 + ch], bi = CT[768 + dir * 384 + ch], sp8 = CT[1536 + dir * 384 + ch];
#pragma unroll
                        for (int j = 0; j < 4; ++j) { const int tok = 4 * kg + j;
                            const float la = sigm(ar[j] + br) * sp8, y = 2.0f * la;
                            const float av = 1.0f + la * (1.0f + la * (0.5f + la * (0.16666667f + la * (0.041666667f + la * 0.0083333333f))));
                            const float om = -y * (1.0f + y * (0.5f + y * (0.16666667f + y * (0.041666667f + y * (0.0083333333f + y * 0.0013888889f)))));
                            const float bt = __builtin_sqrtf(om) * sigm(ai[j] + bi) * XC[tok * 384 + ch];
                            AB[(dir * 16 + tok) * 384 + ch] = (f32x2){av, bt}; }
                    }
                    __syncthreads();
                    if (tid < 384) {
                        float hf = 0.f, pf = 1.f, hb = 0.f, pb = 1.f;
#pragma unroll
                        for (int t = 0; t < 16; ++t) {
                            const f32x2 f = AB[t * 384 + tid], bk = AB[(16 + 15 - t) * 384 + tid];
                            hf = f[0] * hf + f[1]; pf *= f[0]; hb = bk[0] * hb + bk[1]; pb *= bk[0];
                            AB[t * 384 + tid] = (f32x2){pf, hf}; AB[(16 + 15 - t) * 384 + tid] = (f32x2){pb, hb}; }
                        LAGG[((size_t)n * 2 + 0) * 384 + tid] = (f32x2){pf, hf}; LAGG[((size_t)n * 2 + 1) * 384 + tid] = (f32x2){pb, hb};
                    }
                    __syncthreads();
#pragma unroll
                    for (int i = 0; i < 12; ++i) { const int idx = tid + 512 * i, tok = idx / 384, ch = idx - tok * 384;
                        const f32x2 f = AB[idx], bk = AB[16 * 384 + idx];
                        bf16_t* o = LT + (size_t)(r0 + tok) * 1152 + ch;
                        o[0] = f2bf(f[1] + bk[1]); o[384] = f2bf(f[0]); o[768] = f2bf(bk[0]); }
                }
                __syncthreads();
            }
            {
                const int tid = opaque(tid0), lane = tid & 63;
                constexpr int ZS = SEQ + 16;
                LAS bf16_t* R0 = (LAS bf16_t*)lds;
                LAS bf16_t* R1 = R0 + 8224;
                LAS bf16_t* ZA = R1 + 8224;
                const LAS unsigned* Rdw = (const LAS unsigned*)lds;
#define HY_ZF(b, s) ((b) * ZS + ((s) & ~63) + (((((s) >> 3) & 7) ^ (((s) >> 7) & 1)) << 3) + ((s) & 7))
                const float* hcw = a.in[14] + l * 3 * 768; const float* hcb = a.in[15] + l * 768;
                const float* nrm = (const float*)(ctl + CW_HYN);
                bf16_t* YT = (bf16_t*)(ws + WS_YT);
                const int r32 = lane & 31, hh = lane >> 5, il = r32 >> 2, bq = r32 & 3, iblk = 8 * wave + il;
                const int x0b = 4095 - r32 + 8 * hh, par = x0b & 1;
                const int abase = (par ? 4112 : 0) + ((x0b - par) >> 1);
                for (int c = bid; c < 256; c += G) {
                    __syncthreads();
#pragma unroll 1
                    for (int it = tid; it < 3 * 4 * 512; it += 512) {
                        const int arr = it >> 11, b = (it >> 9) & 3, s8 = (it & 511) * 8, ch = arr * 256 + c;
                        const bf16_t* pp = PT + (size_t)ch * RT + b * SEQ + s8;
                        const u32x4 pv = *(const u32x4*)pp;
                        const float w0 = hcw[ch], w1 = hcw[768 + ch], w2 = hcw[1536 + ch], cb0 = hcb[ch];
                        float p[10];
                        p[0] = s8 > 0 ? bf2f(pp[-1]) : 0.f; p[9] = s8 + 8 < SEQ ? bf2f(pp[8]) : 0.f;
                        p[1] = bflo(pv.x); p[2] = bfhi(pv.x); p[3] = bflo(pv.y); p[4] = bfhi(pv.y); p[5] = bflo(pv.z); p[6] = bfhi(pv.z); p[7] = bflo(pv.w); p[8] = bfhi(pv.w);
                        float z[8];
#pragma unroll
                        for (int j = 0; j < 8; ++j) z[j] = cb0 + w0 * p[j] + w1 * p[j + 1] + w2 * p[j + 2];
                        u32x4 w; w.x = cvt_pk_bf16(z[0], z[1]); w.y = cvt_pk_bf16(z[2], z[3]); w.z = cvt_pk_bf16(z[4], z[5]); w.w = cvt_pk_bf16(z[6], z[7]);
                        *(LAS u32x4*)(ZA + arr * 4 * ZS + HY_ZF(b, s8)) = w;
                    }
#pragma unroll 1
                    for (int o = 0; o < 2; ++o) {
                        const bf16_t* kf = (const bf16_t*)(ws + WS_KFL) + ((size_t)((l * 2 + 0) * 2 + o) * 256 + c) * SEQ;
                        const bf16_t* kb = (const bf16_t*)(ws + WS_KFL) + ((size_t)((l * 2 + 1) * 2 + o) * 256 + c) * SEQ;
                        { unsigned tv[16];
#pragma unroll
                          for (int q = 0; q < 16; ++q) { const int x = tid + 512 * q; tv[q] = x < 4096 ? kf[4095 - x] : (x <= 8190 ? kb[x - 4095] : (bf16_t)0); }
                          PIN16(tv);
#pragma unroll
                          for (int q = 0; q < 16; ++q) R0[tid + 512 * q] = (bf16_t)tv[q]; }
                        __syncthreads();
                        for (int x = tid; x < 8192; x += 512) R1[x] = x < 8191 ? R0[x + 1] : (bf16_t)0;
                        __syncthreads();
                        const LAS bf16_t* Z = ZA + (o == 0 ? 0 : 4 * ZS) + bq * ZS;
                        typedef float f32x16 __attribute__((ext_vector_type(16)));
                        f32x16 acc0, acc1;
#pragma unroll
                        for (int q = 0; q < 16; ++q) { acc0[q] = 0.f; acc1[q] = 0.f; }
                        const int dlo = 8 * wave - 63, dhi = 8 * wave + 7;
#define HY_AF(dst, off_) do { const LAS unsigned* a_ = ap + (off_); u32x4 w_ = {a_[0], a_[1], a_[2], a_[3]}; __builtin_memcpy(&dst, &w_, 16); } while (0)
                        {
                            bf16x8 f16, f24;
                            { const LAS unsigned* ap = Rdw + abase - 32 * dlo; HY_AF(f16, 16); HY_AF(f24, 24); }
#pragma unroll 1
                            for (int dl = dlo; dl <= dhi; ++dl) {
                                const int j = iblk - dl; const bool ok = (j >= 0) && (j < 64); const int jc = j < 0 ? 0 : (j > 63 ? 63 : j);
                                const LAS bf16_t* zp = Z + jc * 64; const int sw = (jc >> 1) & 1;
                                const LAS unsigned* ap = Rdw + abase - 32 * dl;
                                bf16x8 bf[4], fm16, fm8, f0, f8;
#pragma unroll
                                for (int kk = 0; kk < 4; ++kk) { bf16x8 t = *(const LAS bf16x8*)(zp + (((2 * kk + hh) ^ sw) << 3)); bf[kk] = ok ? t : (bf16x8){0, 0, 0, 0, 0, 0, 0, 0}; }
                                HY_AF(fm16, -16); HY_AF(fm8, -8); HY_AF(f0, 0); HY_AF(f8, 8);
                                acc0 = __builtin_amdgcn_mfma_f32_32x32x16_bf16(f0, bf[0], acc0, 0, 0, 0);  acc1 = __builtin_amdgcn_mfma_f32_32x32x16_bf16(fm16, bf[0], acc1, 0, 0, 0);
                                acc0 = __builtin_amdgcn_mfma_f32_32x32x16_bf16(f8, bf[1], acc0, 0, 0, 0);  acc1 = __builtin_amdgcn_mfma_f32_32x32x16_bf16(fm8, bf[1], acc1, 0, 0, 0);
                                acc0 = __builtin_amdgcn_mfma_f32_32x32x16_bf16(f16, bf[2], acc0, 0, 0, 0); acc1 = __builtin_amdgcn_mfma_f32_32x32x16_bf16(f0, bf[2], acc1, 0, 0, 0);
                                acc0 = __builtin_amdgcn_mfma_f32_32x32x16_bf16(f24, bf[3], acc0, 0, 0, 0); acc1 = __builtin_amdgcn_mfma_f32_32x32x16_bf16(f8, bf[3], acc1, 0, 0, 0);
                                f16 = fm16; f24 = fm8;
                            }
                        }
#undef HY_AF
                        const float inv = 1.0f / (nrm[(l * 2 + o) * 256 + c] + 1e-6f), hb = a.in[23][(l * 2 + o) * 256 + c];
                        LAS bf16_t* GI = ZA + (o + 1) * 4 * ZS;
                        const LAS bf16_t* ZI = ZA + (o == 0 ? 0 : 4 * ZS);
#pragma unroll
                        for (int q = 0; q < 16; ++q) {
                            const int a0r = (q & 3) + 8 * (q >> 2) + 4 * hh, t0 = 64 * iblk + a0r, t1 = t0 + 32;
                            const int i0 = HY_ZF(bq, t0), i1 = HY_ZF(bq, t1);
                            const float zv0 = bf2f(ZI[i0]), zv1 = bf2f(ZI[i1]);
                            const float y0 = bf2f(GI[i0]) * (acc0[q] * inv + hb * zv0), y1v = bf2f(GI[i1]) * (acc1[q] * inv + hb * zv1);
                            GI[i0] = f2bf(y0); GI[i1] = f2bf(y1v);
                        }
                        __syncthreads();
                    }
                    for (int it = tid; it < 4 * 512; it += 512) { const int b = it >> 9, s8 = (it & 511) * 8;
                        *(u32x4*)(YT + (size_t)c * RT + b * SEQ + s8) = *(const LAS u32x4*)(ZA + 2 * 4 * ZS + HY_ZF(b, s8)); }
                    if (l == 0) {
                        __syncthreads();
                        LAS float* zc = (LAS float*)lds;
                        LAS float* kc = zc + 3072;
                        LAS float* y1c = kc + 1024;
                        for (int it = tid; it < 3072; it += 512) { const int arr = it >> 10, b = (it >> 8) & 3, sx = it & 255, ch = arr * 256 + c;
                            const bf16_t* pp = PT + (size_t)ch * RT + RL + b * CTXL + sx;
                            float z = hcb[ch] + hcw[768 + ch] * bf2f(pp[0]); if (sx > 0) z += hcw[ch] * bf2f(pp[-1]); if (sx + 1 < CTXL) z += hcw[1536 + ch] * bf2f(pp[1]);
                            zc[it] = z; }
                        for (int it = tid; it < 1024; it += 512) { const int o = it >> 9, d = (it & 511) - 256;
                            const bf16_t* kfc = (const bf16_t*)(ws + WS_KFC) + ((size_t)(0 * 2 + o) * 256 + c) * CTXL; const bf16_t* kbc = (const bf16_t*)(ws + WS_KFC) + ((size_t)(1 * 2 + o) * 256 + c) * CTXL;
                            kc[it] = d >= 0 ? bf2f(kfc[d]) : (d > -256 ? bf2f(kbc[-d]) : 0.f); }
                        __syncthreads();
#pragma unroll 1
                        for (int o = 0; o < 2; ++o) {
                            const float inv = 1.0f / (nrm[1024 + o * 256 + c] + 1e-6f), hb = a.in[23][o * 256 + c];
                            for (int it = tid; it < 1024; it += 512) { const int b = it >> 8, t = it & 255;
                                const LAS float* zi = o == 0 ? zc + b * 256 : y1c + b * 256;
                                const LAS float* kk = kc + o * 512 + 256 + t;
                                float acc = 0.f;
#pragma unroll 16
                                for (int sx = 0; sx < CTXL; ++sx) acc += kk[-sx] * zi[sx];
                                const float y = zc[(o + 1) * 1024 + b * 256 + t] * (acc * inv + hb * zi[t]);
                                if (o == 0) y1c[it] = y; else YT[(size_t)c * RT + RL + b * CTXL + t] = f2bf(y); }
                            __syncthreads();
                        }
                    }
                }
#undef HY_ZF
                __syncthreads();
            }
            {
                const pg8::TabSched S{PARTS.p + 18 + l * 3, (const char*)ws, 1, 80, G, (bid + 80) % G};
                pg8::EpiS5State E{(float*)(ws + WS_S5S)};
                pg8::gemm_phase<512, 256>(lds, S, E);
            }
        }
        SEAM(P0 + 2);
        if (((PHMASK >> 14) & 1) && IN(P0 + 3)) {
            const int tid = opaque(tid0), lane = tid & 63;
            LAS float* st = (LAS float*)lds;
            const float* S5S = (const float*)(ws + WS_S5S); bf16_t* US = (bf16_t*)(ws + WS_US);
            for (int u = bid; u < 128; u += G) {
                const int d = u & 1, g = (u >> 1) & 15, b = u >> 5;
                __syncthreads();
                for (int i = tid; i < 272 * 32; i += 512) { const int q = i >> 5, c4 = (i & 31) * 4; const int n = q < 16 ? 1024 + 16 * b + q : 256 * b + (q - 16);
                    const f32x4 v = *(const f32x4*)(S5S + ((size_t)g * NCHKP + n) * 256 + d * 128 + c4);
                    st[q * 128 + c4] = v[0]; st[q * 128 + c4 + 1] = v[1]; st[q * 128 + c4 + 2] = v[2]; st[q * 128 + c4 + 3] = v[3]; }
                __syncthreads();
                if (wave == 0) {
                    const float* ab = (const float*)(ws + WS_AB16) + ((size_t)((l * 2 + d) * 16 + g) * 64 + lane) * 2;
                    const float ar = ab[0], ai = ab[1];
                    float hr = 0.f, hi = 0.f;
#pragma unroll 1
                    for (int k0 = 0; k0 < 272; k0 += 8) {
                        f32x2 sv[8]; int nn[8];
#pragma unroll
                        for (int j = 0; j < 8; ++j) { const int k = k0 + j; const int q = d == 0 ? k : (k < 16 ? 15 - k : 287 - k);
                            nn[j] = q < 16 ? 1024 + 16 * b + q : 256 * b + (q - 16); sv[j] = *(const LAS f32x2*)(st + q * 128 + 2 * lane); }
#pragma unroll
                        for (int j = 0; j < 8; ++j) {
                            *(unsigned*)(US + ((size_t)g * NCHKP + nn[j]) * 512 + 256 + d * 128 + 2 * lane) = cvt_pk_bf16(hr, hi);
                            const float nr = ar * hr - ai * hi + sv[j][0], ni = ar * hi + ai * hr + sv[j][1];
                            hr = nr; hi = ni; }
                    }
                }
            }
            __syncthreads();
            for (int uq = bid; uq < 176; uq += G) { if (uq < 128) continue; const int u = uq - 128;
                const int cb6 = u % 6, d = (u / 6) & 1, b = u / 12;
                LAS f32x2* sa = (LAS f32x2*)lds;
                const f32x2* LAGG = (const f32x2*)(ws + WS_LAGG); float* HIN = (float*)(ws + WS_LHIN);
                __syncthreads();
                for (int i = tid; i < 272 * 64; i += 512) { const int q = i >> 6, c = i & 63; const int n = q < 16 ? 1024 + 16 * b + q : 256 * b + (q - 16);
                    sa[i] = LAGG[((size_t)n * 2 + d) * 384 + cb6 * 64 + c]; }
                __syncthreads();
                if (wave == 0) {
                    float h = 0.f;
#pragma unroll 1
                    for (int k0 = 0; k0 < 272; k0 += 8) {
                        f32x2 sv[8]; int nn[8];
#pragma unroll
                        for (int j = 0; j < 8; ++j) { const int k = k0 + j; const int q = d == 0 ? k : (k < 16 ? 15 - k : 287 - k);
                            nn[j] = q < 16 ? 1024 + 16 * b + q : 256 * b + (q - 16); sv[j] = sa[q * 64 + lane]; }
#pragma unroll
                        for (int j = 0; j < 8; ++j) { HIN[((size_t)nn[j] * 2 + d) * 384 + cb6 * 64 + lane] = h; h = sv[j][0] * h + sv[j][1]; }
                    }
                }
            }
            __syncthreads();
        }
        SEAM(P0 + 3);
        if (((PHMASK >> 15) & 1) && IN(P0 + 4)) {
            const pg8::TabSched S{PARTS.p + 19 + l * 3, (const char*)ws, 1, 80, G, bid};
            pg8::EpiS5Main E{(bf16_t*)(ws + WS_GL), PR, a.in[32] + l * 256};
            pg8::gemm_phase<512, 512>(lds, S, E);
            {
                const int tid = opaque(tid0);
                const bf16_t* YT = (const bf16_t*)(ws + WS_YT);
                LAS bf16_t* tl = (LAS bf16_t*)lds;
                const int nrt = nMrow * 4;
                const int nb0 = G > 160 ? 80 : 0, vb = bid - nb0, vG = G - nb0;
                if (vb >= 0) for (int t = vb; t < 4 * nrt; t += vG) {
                    const int c0 = (t & 3) * 64, r0 = (t >> 2) * 64;
                    __syncthreads();
                    { const int cc = tid >> 3, r8 = (tid & 7) * 8; *(LAS u32x4*)(tl + cc * 72 + r8) = *(const u32x4*)(YT + (size_t)(c0 + cc) * RT + r0 + r8); }
                    __syncthreads();
                    { const int rr = tid >> 3, c8 = (tid & 7) * 8; unsigned short e[8];
#pragma unroll
                        for (int j = 0; j < 8; ++j) e[j] = tl[(c8 + j) * 72 + rr];
                        u32x4 w; w.x = e[0] | ((unsigned)e[1] << 16); w.y = e[2] | ((unsigned)e[3] << 16); w.z = e[4] | ((unsigned)e[5] << 16); w.w = e[6] | ((unsigned)e[7] << 16);
                        *(u32x4*)(YB + (size_t)(r0 + rr) * YW + YC_B + c0 + c8) = w; }
                }
                __syncthreads();
            }
            {
                const int tid = opaque(tid0);
                const bf16_t* LT = (const bf16_t*)(ws + WS_LT); const float* HIN = (const float*)(ws + WS_LHIN);
                const int nrows = nMrow * 256;
                const int nb0 = G > 160 ? 80 : 0, vb = bid - nb0, vG = G - nb0;
                if (vb >= 0) for (int it = vb * 512 + tid; it < nrows * 48; it += vG * 512) {
                    const int r = it / 48, c8 = (it - r * 48) * 8, n = r >> 4;
                    const u32x4 gt = *(const u32x4*)(PR + (size_t)r * LDP + PC_AG + c8);
                    const bf16_t* lt = LT + (size_t)r * 1152 + c8;
                    const u32x4 sv = *(const u32x4*)lt, pf = *(const u32x4*)(lt + 384), pb = *(const u32x4*)(lt + 768);
                    const float* hf = HIN + ((size_t)n * 2 + 0) * 384 + c8; const float* hb = hf + 384;
                    const f32x4 hf0 = *(const f32x4*)hf, hf1 = *(const f32x4*)(hf + 4), hb0 = *(const f32x4*)hb, hb1 = *(const f32x4*)(hb + 4);
                    u32x4 w;
                    w.x = cvt_pk_bf16(gelu_f(bflo(gt.x)) * (bflo(sv.x) + bflo(pf.x) * hf0[0] + bflo(pb.x) * hb0[0]), gelu_f(bfhi(gt.x)) * (bfhi(sv.x) + bfhi(pf.x) * hf0[1] + bfhi(pb.x) * hb0[1]));
                    w.y = cvt_pk_bf16(gelu_f(bflo(gt.y)) * (bflo(sv.y) + bflo(pf.y) * hf0[2] + bflo(pb.y) * hb0[2]), gelu_f(bfhi(gt.y)) * (bfhi(sv.y) + bfhi(pf.y) * hf0[3] + bfhi(pb.y) * hb0[3]));
                    w.z = cvt_pk_bf16(gelu_f(bflo(gt.z)) * (bflo(sv.z) + bflo(pf.z) * hf1[0] + bflo(pb.z) * hb1[0]), gelu_f(bfhi(gt.z)) * (bfhi(sv.z) + bfhi(pf.z) * hf1[1] + bfhi(pb.z) * hb1[1]));
                    w.w = cvt_pk_bf16(gelu_f(bflo(gt.w)) * (bflo(sv.w) + bflo(pf.w) * hf1[2] + bflo(pb.w) * hb1[2]), gelu_f(bfhi(gt.w)) * (bfhi(sv.w) + bfhi(pf.w) * hf1[3] + bfhi(pb.w) * hb1[3]));
                    *(u32x4*)(YB + (size_t)r * YW + YC_A + c8) = w;
                }
            }
        }
        SEAM(P0 + 4);
        if (((PHMASK >> 15) & 1) && IN(P0 + 5)) {
            const pg8::TabSched S{PARTS.p + 20 + l * 3, (const char*)ws, 1, nMrow, G, bid};
            pg8::EpiS5Glu E{YB, (const bf16_t*)(ws + WS_GL), a.in[34] + l * 256};
            pg8::gemm_phase<256, 256>(lds, S, E);
        }
        SEAM(P0 + 5);
        if (((PHMASK >> 3) & 1) && IN(P0 + 6)) {
            const pg8::MergeSched S{(const char*)ws, (long long)WS_YB, (long long)(WS_WL + (size_t)l * SZ_WL + SZ_WINR + SZ_WINHY), 64, G, bid, l == 0 ? 64 : 0};
            pg8::EpiGate E{ws + WS_GQ, UB, (bf16_t*)(ws + WS_MGC)};
            pg8::gemm_phase<1280, 1280>(lds, S, E);
        }
        SEAM(P0 + 6);
        if (((PHMASK >> 4) & 1) && IN(P0 + 7)) {
            const pg8::TabSched S{l == 0 ? PARTS.p + 24 : PARTS.p + 14, (const char*)ws, l == 0 ? 2 : 1, l == 0 ? 256 + 64 : 256, G, bid};
            pg8::EpiRes E{PRE, xlat, xctx, MODL + 2048, (float*)(ws + WS_EXTRA)};
            pg8::gemm_phase<1024, 1024>(lds, S, E);
        }
        SEAM(P0 + 7);
        if (((PHMASK >> 5) & 1) && IN(P0 + 8)) {
            const int lane = opaque(tid0) & 63;
            if (l == 1) convert_tiles_pipelined(a, JT_MOE, (LAS float*)lds, bid, G);
            const float* lg = a.in[40] + l * D; const float* lb = a.in[41] + l * D;
            const int nrows = nMrow * 256;
            for (int r = bid * 8 + wave; r < nrows; r += G * 8) {
                const float* mv = MODL + (size_t)(r < RL ? (r >> 12) : 4) * 6144;
                RowV pre;
                if (r < RL) { const RowV xin = row_load(xlat + (size_t)r * D, lane), ga = row_load_bf16((const bf16_t*)PRE + (size_t)r * D, lane);
#pragma unroll
                    for (int i = 0; i < 4; ++i) pre.v[i] = xin.v[i] * ALPHA + ga.v[i]; }
                else { const float* pp = (const float*)(ws + WS_EXTRA) + (size_t)(r - RL) * D; const RowV xin = row_load(ctx_in + (size_t)(r - RL) * D, lane), p0 = row_load(pp, lane), p1 = row_load(pp + (size_t)RC * D, lane), p2 = row_load(pp + (size_t)2 * RC * D, lane), p3 = row_load(pp + (size_t)3 * RC * D, lane);
#pragma unroll
                    for (int i = 0; i < 4; ++i) pre.v[i] = xin.v[i] * ALPHA + ((p0.v[i] + p1.v[i]) + (p2.v[i] + p3.v[i])); }
                const RowV x1 = row_affine(row_norm(pre), lg, lb, lane);
                row_store(r < RL ? a.out + (size_t)r * D : XSC + (size_t)(r - RL) * D, lane, x1);
                const RowV u2 = row_modulate(row_norm(x1), mv + 3072, mv + 4096, lane);
                row_store_bf16(UB + (size_t)r * D, lane, u2);
                if (l == 1) {
                    float lg8[8];
#pragma unroll
                    for (int e = 0; e < 8; ++e) lg8[e] = 0.f;
                    f32x4 rw[32];
#pragma unroll
                    for (int q = 0; q < 16; ++q) { const float* wp = a.in[47] + (size_t)(256 * (q >> 2) + 4 * lane + (q & 3)) * 8; rw[2 * q] = *(const f32x4*)wp; rw[2 * q + 1] = *(const f32x4*)(wp + 4); }
                    PIN16(rw); PIN16(rw + 16);
#pragma unroll
                    for (int i = 0; i < 4; ++i)
#pragma unroll
                        for (int j = 0; j < 4; ++j) { const float uv = u2.v[i][j];
                            const f32x4 w0 = rw[2 * (4 * i + j)], w1 = rw[2 * (4 * i + j) + 1];
                            lg8[0] += uv * w0[0]; lg8[1] += uv * w0[1]; lg8[2] += uv * w0[2]; lg8[3] += uv * w0[3]; lg8[4] += uv * w1[0]; lg8[5] += uv * w1[1]; lg8[6] += uv * w1[2]; lg8[7] += uv * w1[3]; }
#pragma unroll
                    for (int e = 0; e < 8; ++e) lg8[e] = wave_sum(lg8[e]);
                    if (lane == 0) {
                        int i1 = 0; float v1 = lg8[0];
#pragma unroll
                        for (int e = 1; e < 8; ++e) if (lg8[e] > v1) { v1 = lg8[e]; i1 = e; }
                        int i2 = 0; float v2 = -3.0e38f;
#pragma unroll
                        for (int e = 0; e < 8; ++e) if (e != i1 && lg8[e] > v2) { v2 = lg8[e]; i2 = e; }
                        const float e2 = expf(v2 - v1), w1 = 1.f / (1.f + e2), w2 = e2 / (1.f + e2);
                        int* tk = (int*)(ws + WS_TOK) + (size_t)r * 8;
                        tk[0] = i1; tk[1] = i2; ((float*)tk)[2] = w1; ((float*)tk)[3] = w2;
                        tk[4] = (int)atomicAdd(ctl + CW_MOECNT + 64 * i1, 1u); tk[5] = (int)atomicAdd(ctl + CW_MOECNT + 64 * i2, 1u);
                    }
                }
            }
        }
        SEAM(P0 + 8);
        if (l == 0) {
            if (((PHMASK >> 6) & 1) && IN(P0 + 9)) {
                const pg8::TabSched S{PARTS.p + 16, (const char*)ws, 1, 68 * 22, G, bid};
                pg8::EpiSwiglu E{(bf16_t*)(ws + WS_H), FF_DENSE, 0};
                pg8::gemm_phase<1024, 1024>(lds, S, E);
            }
            SEAM(P0 + 9);
            if (((PHMASK >> 7) & 1) && IN(P0 + 10)) {
                const pg8::TabSched S{PARTS.p + 26, (const char*)ws, 3, 256 + 48 + 16, G, bid};
                pg8::EpiRes E{PRE, a.out, XSC, MODL + 5120, (float*)(ws + WS_EXTRA)};
                pg8::gemm_phase<FF_DENSE, FF_DENSE>(lds, S, E);
            }
            SEAM(P0 + 10);
            if (((PHMASK >> 8) & 1) && IN(P0 + 11)) {
                const int lane = opaque(tid0) & 63;
                const float* lg = a.in[42]; const float* lb = a.in[43];
                const float* MODN = MOD + (size_t)5 * 6144;
                for (int r = bid * 8 + wave; r < RT; r += G * 8) {
                    const float* mv = MODN + (size_t)(r < RL ? (r >> 12) : 4) * 6144;
                    RowV pre;
                    if (r < RL) { const RowV xin = row_load(a.out + (size_t)r * D, lane), ga = row_load_bf16((const bf16_t*)PRE + (size_t)r * D, lane);
#pragma unroll
                        for (int i = 0; i < 4; ++i) pre.v[i] = xin.v[i] * ALPHA + ga.v[i]; }
                    else { const float* pp = (const float*)(ws + WS_EXTRA) + (size_t)(r - RL) * D; const RowV xin = row_load(XSC + (size_t)(r - RL) * D, lane), p0 = row_load(pp, lane), p1 = row_load(pp + (size_t)RC * D, lane), p2 = row_load(pp + (size_t)2 * RC * D, lane), p3 = row_load(pp + (size_t)3 * RC * D, lane);
#pragma unroll
                        for (int i = 0; i < 4; ++i) pre.v[i] = xin.v[i] * ALPHA + ((p0.v[i] + p1.v[i]) + (p2.v[i] + p3.v[i])); }
                    const RowV x2 = row_affine(row_norm(pre), lg, lb, lane);
                    row_store(r < RL ? a.out + (size_t)r * D : XSC + (size_t)(r - RL) * D, lane, x2);
                    row_store_bf16(UB + (size_t)r * D, lane, row_modulate(row_norm(x2), mv, mv + 1024, lane));
                }
            }
            SEAM(P0 + 11);
        } else {
            bf16_t* AG = (bf16_t*)(ws + WS_AG); float* slotw = (float*)(ws + WS_SLOTW); int* tile_e = (int*)(ws + WS_TILEE);
            if (((PHMASK >> 9) & 1) && IN(P0 + 9)) {
                const int tid = opaque(tid0), lane = tid & 63;
                int ts[NE + 1]; ts[0] = 0;
#pragma unroll
                for (int e = 0; e < NE; ++e) { const unsigned c = __hip_atomic_load(ctl + CW_MOECNT + 64 * e, __ATOMIC_RELAXED, __HIP_MEMORY_SCOPE_AGENT); ts[e + 1] = ts[e] + (int)((c + 255u) >> 8); }
                if (bid == 0) for (int mt = tid; mt < ts[NE]; mt += 512) { int e = 0;
#pragma unroll
                    for (int k = 1; k < NE; ++k) e += (mt >= ts[k]) ? 1 : 0;
                    tile_e[mt] = e; }
                for (int r = bid * 8 + wave; r < RL; r += G * 8) {
                    int* tk = (int*)(ws + WS_TOK) + (size_t)r * 8;
                    const u32x4 v0 = *(const u32x4*)(UB + (size_t)r * D + lane * 16), v1 = *(const u32x4*)(UB + (size_t)r * D + lane * 16 + 8);
#pragma unroll
                    for (int k = 0; k < 2; ++k) {
                        const int e = tk[k], pos = tk[4 + k];
                        int st = 0;
#pragma unroll
                        for (int q = 0; q < NE; ++q) st = (e == q) ? ts[q] : st;
                        const int srow = st * 256 + pos;
                        *(u32x4*)(AG + (size_t)srow * D + lane * 16) = v0; *(u32x4*)(AG + (size_t)srow * D + lane * 16 + 8) = v1;
                        if (lane == 0) { slotw[srow] = ((const float*)tk)[2 + k]; tk[6 + k] = srow; }
                    }
                }
            }
            SEAM(P0 + 9);
            int ttl = 0;
            if (lo <= P0 + 13 && P0 + 10 < hi) {
#pragma unroll
                for (int e = 0; e < NE; ++e) { const unsigned c = __hip_atomic_load(ctl + CW_MOECNT + 64 * e, __ATOMIC_RELAXED, __HIP_MEMORY_SCOPE_AGENT); ttl += (int)((c + 255u) >> 8); }
                ttl = __builtin_amdgcn_readfirstlane(ttl);
            }
#pragma unroll
            for (int pass = 0; pass < 2; ++pass) {
                const int tile0 = pass * MOE_P0; int ntile = pass == 0 ? (ttl < MOE_P0 ? ttl : MOE_P0) : ttl - MOE_P0; ntile = ntile < 0 ? 0 : (ntile > MOE_HCAP ? MOE_HCAP : ntile);
                if (((PHMASK >> 10) & 1) && IN(P0 + 10 + 2 * pass)) {
                    const pg8::MoeSched S{(const char*)AG + (size_t)tile0 * 256 * 1024 * 2, (const char*)(ws + WS_MOEGU), tile_e, 256u * 1024u * 2u, 256u * 1024u * 2u, (size_t)2 * FF_E * 1024 * 2, 28, 16, tile0, ntile, G, bid};
                    pg8::EpiSwiglu E{(bf16_t*)(ws + WS_HM), FF_E, tile0};
                    pg8::gemm_phase<1024, 1024>(lds, S, E);
                }
                SEAM(P0 + 10 + 2 * pass);
                if (((PHMASK >> 11) & 1) && IN(P0 + 11 + 2 * pass)) {
                    pg8::EpiMoeDown E{AG, slotw, (float*)(ws + WS_O2X)};
                    { const int nfull = pass == 0 ? ntile : (ttl < 128 ? ttl : 128) - MOE_P0, nex = pass == 0 ? 0 : ttl - 128;
                        const pg8::MoeTailSched S{(const char*)(ws + WS_HM), (const char*)(ws + WS_MOED), tile_e, tile0, nfull < 0 ? 0 : nfull, nex < 0 ? 0 : nex, G, bid};
                        pg8::gemm_phase<FF_E, FF_E>(lds, S, E); }
                }
                SEAM(P0 + 11 + 2 * pass);
            }
            if (((PHMASK >> 12) & 1) && IN(P0 + 14)) {
                const int lane = opaque(tid0) & 63;
                const float* lg = a.in[42] + D; const float* lb = a.in[43] + D;
                for (int r = bid * 8 + wave; r < RL; r += G * 8) {
                    const int* tk = (const int*)(ws + WS_TOK) + (size_t)r * 8;
                    const int sa = tk[6], sb = tk[7];
                    const bf16_t* oa = AG + (size_t)sa * D; const bf16_t* ob = AG + (size_t)sb * D;
                    const float* gv = MODL + (size_t)(r >> 12) * 6144 + 5120;
                    RowV x1 = row_load(a.out + (size_t)r * D, lane), gq = row_load(gv, lane), pre;
                    u32x2 va[4], vb[4];
#pragma unroll
                    for (int i = 0; i < 4; ++i) { va[i] = *(const u32x2*)(oa + 256 * i + 4 * lane); vb[i] = *(const u32x2*)(ob + 256 * i + 4 * lane); }
                    asm volatile("" : "+v"(va[0]), "+v"(va[1]), "+v"(va[2]), "+v"(va[3]), "+v"(vb[0]), "+v"(vb[1]), "+v"(vb[2]), "+v"(vb[3]), "+v"(x1.v[0]), "+v"(x1.v[1]), "+v"(x1.v[2]), "+v"(x1.v[3]), "+v"(gq.v[0]), "+v"(gq.v[1]), "+v"(gq.v[2]), "+v"(gq.v[3]));
#pragma unroll
                    for (int i = 0; i < 4; ++i) {
                        f32x4 fa = {bflo(va[i].x), bfhi(va[i].x), bflo(va[i].y), bfhi(va[i].y)}, fb = {bflo(vb[i].x), bfhi(vb[i].x), bflo(vb[i].y), bfhi(vb[i].y)};
                        if (sa >= 128 * 256) { const float* px = (const float*)(ws + WS_O2X) + (size_t)(sa - 128 * 256) * D + 256 * i + 4 * lane; fa = (*(const f32x4*)px + *(const f32x4*)(px + (size_t)2048 * D)) + (*(const f32x4*)(px + (size_t)2 * 2048 * D) + *(const f32x4*)(px + (size_t)3 * 2048 * D)); }
                        if (sb >= 128 * 256) { const float* px = (const float*)(ws + WS_O2X) + (size_t)(sb - 128 * 256) * D + 256 * i + 4 * lane; fb = (*(const f32x4*)px + *(const f32x4*)(px + (size_t)2048 * D)) + (*(const f32x4*)(px + (size_t)2 * 2048 * D) + *(const f32x4*)(px + (size_t)3 * 2048 * D)); }
                        pre.v[i] = x1.v[i] * ALPHA + gq.v[i] * (fa + fb); }
                    row_store(a.out + (size_t)r * D, lane, row_affine(row_norm(pre), lg, lb, lane));
                }
            }
        }
    }
#undef IN
#undef SEAM
}

}

extern "C" void kernel_launch(void* const* d_in, const int* in_sizes, int n_in, void* d_out, int out_size, void* d_ws, size_t ws_size, hipStream_t stream) {
    static int grid = 0;
    if (grid == 0) {
        if (n_in != 51 || ws_size < WS_END) { grid = -1; return; }
        int dev = 0, cus = 0;
        if (hipGetDevice(&dev) != hipSuccess || hipDeviceGetAttribute(&cus, hipDeviceAttributeMultiprocessorCount, dev) != hipSuccess) { grid = -1; return; }
        if (hipFuncSetAttribute((const void*)mk_fwd, hipFuncAttributeMaxDynamicSharedMemorySize, LDS_BYTES) != hipSuccess) { grid = -1; return; }
        grid = cus;
    }
    if (grid < 0) return;
    const float* const* in = (const float* const*)d_in;
    unsigned char* ws = (unsigned char*)d_ws;
    (void)hipMemsetAsync(ws + WS_CTL, 0, CTL_BYTES + al256(2 * 5 * 6144 * 4), stream);
    for (int l = 0; l < 2; ++l) (void)hipMemsetAsync(ws + WS_WL + (size_t)l * SZ_WL + SZ_WINR + (size_t)1152 * 1024 * 2, 0, (size_t)128 * 1024 * 2, stream);
    Args a{};
    for (int i = 0; i < 51; ++i) a.in[i] = in[i];
    a.out = (float*)d_out; a.ws = ws;
    int nlaunch = 0;
    auto run1 = [&](int lo, int hi) { a.ph_lo = lo; a.ph_hi = hi; a.bar_region = nlaunch < 5 ? nlaunch : 5; nlaunch++; hipLaunchKernelGGL(mk_fwd, dim3(grid), dim3(512), LDS_BYTES, stream, a); };
    auto run = [&](int lo, int hi) {
#if defined(SPLIT) && SPLIT
        for (int k = lo; k < hi; ++k) { const int q = (k - 1) % NPH_LAYER, l = (k - 1) / NPH_LAYER; if (k > 0 && (q > 14 || (l == 0 && q > 11) || (l == 1 && q == 0))) continue; run1(k, k + 1); }
#else
        run1(lo, hi);
#endif
    };
    run(0, 1 + 2 * NPH_LAYER);
}
```

```cpp
#include <hip/hip_runtime.h>
#include <stdint.h>
#include <math.h>

#define LAS __attribute__((address_space(3)))
typedef unsigned short bf16_t;
typedef short bf16x8 __attribute__((ext_vector_type(8)));
typedef float f32x4 __attribute__((ext_vector_type(4)));
typedef float f32x2 __attribute__((ext_vector_type(2)));
typedef unsigned u32x4 __attribute__((ext_vector_type(4)));
typedef unsigned u32x2 __attribute__((ext_vector_type(2)));

namespace {
constexpr int D = 1024, NB = 4, SEQ = 4096, CTXL = 256;
constexpr int RL = NB * SEQ, RC = NB * CTXL, RT = RL + RC;
constexpr int IN_COLS = 7040;
constexpr int FF_DENSE = 2816, NE = 8, FF_E = 3584;
constexpr float ALPHA = 1.41421356237309515f;
constexpr int LDP = 1792, PC_AG = 0, PC_AC = 384, PC_D = 768, PC_Q = 1024, PC_K = 1408, PC_G = 1792;
constexpr int NPT = 1280, PT_V = 768;
constexpr int YW = 1280, YC_A = 0, YC_B = 384, YC_C = 640, YC_D = 1024;
constexpr int MOE_P0 = 64, MOE_HCAP = 72;
constexpr int MOE_ROWS_MAX = 2 * RL + NE * 256;

constexpr size_t al256(size_t x) { return (x + 255) & ~(size_t)255; }
constexpr size_t WS_CTL = 0, CTL_BYTES = 131072;
constexpr int CW_BAR = 0;
constexpr int CW_MOECNT = 24576;
constexpr int CW_QUEUE = 28672;
constexpr int CW_HYN = 29696;
constexpr size_t WS_MOD = WS_CTL + CTL_BYTES;
constexpr size_t WS_HYN = WS_MOD + al256(2 * 5 * 6144 * 4);
constexpr size_t WS_S5AB = WS_HYN + 4096;
constexpr size_t WS_S5BB = WS_S5AB + 16384;
constexpr size_t WS_AB16 = WS_S5BB + 262144;
constexpr size_t WS_TILEE = WS_AB16 + 32768;
constexpr size_t WS_TOK = WS_TILEE + 1024;
constexpr size_t WS_SLOTW = WS_TOK + (size_t)RL * 32;
constexpr size_t WS_KFL = al256(WS_SLOTW + (size_t)MOE_ROWS_MAX * 4);
constexpr size_t WS_KFC = WS_KFL + (size_t)2 * 1024 * SEQ * 2;
constexpr size_t WS_XSC = WS_KFC + (size_t)1024 * CTXL * 2;
constexpr size_t WS_UB = WS_XSC + (size_t)RC * D * 4;
constexpr size_t SZ_WINR = (size_t)(1792 + 4096) * 1024 * 2, SZ_WINHY = (size_t)NPT * 1024 * 2, SZ_WBR = (size_t)1024 * 1280 * 2, SZ_WOUT = (size_t)1024 * 1024 * 2;
constexpr size_t SZ_WL = SZ_WINR + SZ_WINHY + SZ_WBR + SZ_WOUT;
constexpr size_t WS_WL = WS_UB + (size_t)RT * D * 2;
constexpr size_t WS_FFGU = WS_WL + 2 * SZ_WL;
constexpr size_t WS_FFD = WS_FFGU + (size_t)2 * FF_DENSE * 1024 * 2;
constexpr size_t WS_WGLU = WS_FFD + (size_t)1024 * FF_DENSE * 2;
constexpr size_t WS_OPS = WS_WGLU + (size_t)2 * 256 * 256 * 2;
constexpr size_t WS_OPY = WS_OPS + (size_t)32 * 256 * 256 * 2;
constexpr size_t WS_LW = WS_OPY + (size_t)32 * 256 * 512 * 2;
constexpr size_t WS_PR = WS_LW + (size_t)48 * 4096 * 2;
constexpr size_t WS_PT = WS_PR + (size_t)RT * 5888 * 2;
constexpr size_t WS_GQ = WS_PR + (size_t)RT * LDP * 2;
constexpr size_t WS_YB = WS_PT + (size_t)NPT * RT * 2;
constexpr size_t WS_PRE = WS_YB + (size_t)RT * YW * 2;
constexpr size_t WS_EXTRA = WS_PRE + (size_t)RT * D * 4;
constexpr size_t SZ_EXTRA = (size_t)2 * RT * 384 * 4 + (size_t)RT * 256 * 4;
constexpr size_t WS_END = WS_EXTRA + SZ_EXTRA;
constexpr int NCHK = RT / 16, NCHKP = 1280;
constexpr size_t WS_US = WS_PRE;
constexpr size_t WS_S5S = WS_US + (size_t)16 * NCHKP * 512 * 2;
constexpr size_t WS_GL = WS_S5S + (size_t)16 * NCHKP * 256 * 4;
static_assert(WS_GL + (size_t)RT * 256 * 2 <= WS_EXTRA, "s5 overlay");
constexpr size_t WS_H = WS_PR;
constexpr size_t WS_MOEGU = WS_PR;
constexpr size_t WS_MOED = WS_MOEGU + (size_t)NE * 2 * FF_E * 1024 * 2;
constexpr size_t WS_HM = WS_MOED + (size_t)NE * 1024 * FF_E * 2;
constexpr size_t WS_LT = WS_EXTRA;
constexpr size_t WS_LAGG = WS_LT + (size_t)RT * 3 * 384 * 2;
constexpr size_t WS_LHIN = WS_LAGG + (size_t)NCHK * 2 * 384 * 8;
constexpr size_t WS_YT = WS_LHIN + (size_t)NCHK * 2 * 384 * 4;
static_assert(WS_YT + (size_t)256 * RT * 2 <= WS_EXTRA + SZ_EXTRA, "lru / hyena overlay");
constexpr size_t WS_MGC = WS_EXTRA + (size_t)4 * RC * D * 4;
constexpr size_t WS_AG = WS_EXTRA;
static_assert(WS_HM + (size_t)MOE_HCAP * 256 * FF_E * 2 <= WS_EXTRA, "moe hidden overlay");
constexpr size_t WS_O2X = WS_PRE + ((size_t)32 << 20);
static_assert(WS_HM + (size_t)MOE_HCAP * 256 * FF_E * 2 <= WS_O2X && WS_O2X + (size_t)4 * 2048 * D * 4 <= WS_EXTRA, "moe excess sums");
static_assert((size_t)MOE_ROWS_MAX * 1024 * 2 <= SZ_EXTRA, "moe gather overlay");
static_assert((size_t)RT * FF_DENSE * 2 <= (size_t)RT * 5888 * 2 && WS_GQ + (size_t)RT * 4096 <= WS_PT, "dense hidden overlay / gate bytes");

__device__ __forceinline__ float sigm(float x) { return __builtin_amdgcn_rcpf(1.f + __builtin_amdgcn_exp2f(-1.44269504089f * x)); }
__device__ __forceinline__ float sigm_acc(float x) { return 1.f / (1.f + expf(-x)); }
__device__ __forceinline__ float silu_acc(float x) { return x / (1.f + expf(-x)); }
__device__ __forceinline__ float gelu_t(float x) { return 0.5f * x * (1.f + tanhf(0.7978845608028654f * (x + 0.044715f * x * x * x))); }
__device__ __forceinline__ float gelu_f(float x) { return x * sigm(1.5957691216057308f * (x + 0.044715f * x * x * x)); }
__device__ __forceinline__ float softplus(float x) { return fmaxf(x, 0.f) + log1pf(expf(-fabsf(x))); }
template <int CTRL> __device__ __forceinline__ float dpp_mov(float v) { return __int_as_float(__builtin_amdgcn_update_dpp(0, __float_as_int(v), CTRL, 0xf, 0xf, false)); }
__device__ __forceinline__ float wave_sum(float v) {
    v += dpp_mov<0xB1>(v);
    v += dpp_mov<0x4E>(v);
    v += dpp_mov<0x141>(v);
    v += dpp_mov<0x140>(v);
    const int iv = __float_as_int(v);
    return (__int_as_float(__builtin_amdgcn_readlane(iv, 0)) + __int_as_float(__builtin_amdgcn_readlane(iv, 16))) + (__int_as_float(__builtin_amdgcn_readlane(iv, 32)) + __int_as_float(__builtin_amdgcn_readlane(iv, 48)));
}
__device__ __forceinline__ float wave_max(float v) {
    v = fmaxf(v, dpp_mov<0xB1>(v)); v = fmaxf(v, dpp_mov<0x4E>(v)); v = fmaxf(v, dpp_mov<0x141>(v)); v = fmaxf(v, dpp_mov<0x140>(v));
    const int iv = __float_as_int(v);
    return fmaxf(fmaxf(__int_as_float(__builtin_amdgcn_readlane(iv, 0)), __int_as_float(__builtin_amdgcn_readlane(iv, 16))), fmaxf(__int_as_float(__builtin_amdgcn_readlane(iv, 32)), __int_as_float(__builtin_amdgcn_readlane(iv, 48))));
}
__device__ __forceinline__ float bf2f(bf16_t b) { return __uint_as_float(((unsigned)b) << 16); }
__device__ __forceinline__ bf16_t f2bf(float f) { unsigned u = __float_as_uint(f); u += 0x7FFFu + ((u >> 16) & 1u); return (bf16_t)(u >> 16); }
__device__ __forceinline__ unsigned cvt_pk_bf16(float lo, float hi) { unsigned r; asm volatile("v_cvt_pk_bf16_f32 %0, %1, %2" : "=v"(r) : "v"(lo), "v"(hi)); return r; }
__device__ __forceinline__ float bflo(unsigned w) { return __uint_as_float(w << 16); }
__device__ __forceinline__ float bfhi(unsigned w) { return __uint_as_float(w & 0xFFFF0000u); }
__device__ __forceinline__ void row_seq(int r, int& start, int& len, int& pos, int& b) {
    if (r < RL) { b = r >> 12; start = b << 12; len = SEQ; pos = r & 4095; }
    else { const int q = r - RL; b = q >> 8; start = RL + (b << 8); len = CTXL; pos = q & 255; }
}

#define XB_TMO      128
#define XB_XCNT(j)  (256  + 64 * (j))
#define XB_XSUB(j)  (1280 + 64 * (j))
#define XB_XGEN(j)  (2304 + 64 * (j))
#define XB_TOP      3328
#define XB_TOPGEN   3392
#define XCD_BAR_WORDS 3456
#define XB_SPIN_CAP (1u << 18)
__device__ __forceinline__ unsigned xb_ld(unsigned* p)              { return __hip_atomic_load(p, __ATOMIC_RELAXED, __HIP_MEMORY_SCOPE_AGENT); }
__device__ __forceinline__ unsigned xb_add(unsigned* p, unsigned v) { return __hip_atomic_fetch_add(p, v, __ATOMIC_RELAXED, __HIP_MEMORY_SCOPE_AGENT); }
__device__ __forceinline__ unsigned xb_xcc_id() { return (unsigned)__builtin_amdgcn_s_getreg((3 << 11) | 20) & 0xFu; }
#define XB_SPIN(cond, bar) do { unsigned _sp = 0; while (cond) { __builtin_amdgcn_s_sleep(1); \
    if ((++_sp & 255u) == 0u) { if (xb_ld(&(bar)[XB_TMO])) break; if (_sp > XB_SPIN_CAP) { atomicAdd(&(bar)[XB_TMO], 1u); break; } } } } while (0)
struct XcdBarrier { unsigned* bar; unsigned x; volatile LAS unsigned* st; };
__device__ __forceinline__ XcdBarrier xcd_barrier_post(unsigned* bar, volatile LAS unsigned* st) {
    XcdBarrier b; b.bar = bar; b.x = xb_xcc_id(); b.st = st;
    if (threadIdx.x == 0) (void)xb_add(&bar[XB_XCNT(b.x)], 1u);
    return b;
}
__device__ __forceinline__ void xcd_barrier_complete(unsigned* bar, unsigned x, unsigned& nloc, unsigned& nx) {
    const unsigned G = gridDim.x * gridDim.y * gridDim.z;
    unsigned sum, cnt, mine, sp = 0u;
    for (;;) {
        sum = 0u; cnt = 0u; mine = 0u;
#pragma unroll
        for (unsigned j = 0; j < 16; ++j) { const unsigned c = xb_ld(&bar[XB_XCNT(j)]); sum += c; cnt += (c > 0u) ? 1u : 0u; mine = (j == x) ? c : mine; }
        if (sum == G) break;
        __builtin_amdgcn_s_sleep(1);
        if ((++sp & 255u) == 0u) { if (xb_ld(&bar[XB_TMO])) break; if (sp > XB_SPIN_CAP) { atomicAdd(&bar[XB_TMO], 1u); break; } }
    }
    nloc = mine > 0u ? mine : 1u; nx = cnt > 0u ? cnt : 1u;
}
__device__ __forceinline__ void xcd_barrier(const XcdBarrier& b) {
    asm volatile("s_waitcnt vmcnt(0)" ::: "memory");
    __syncthreads();
    if (threadIdx.x == 0) {
        unsigned* bar = b.bar;
        __builtin_amdgcn_s_waitcnt(0);
        unsigned nloc = b.st[0], nx = b.st[1];
        if (nloc == 0u) { xcd_barrier_complete(bar, b.x, nloc, nx); b.st[0] = nloc; b.st[1] = nx; }
        const unsigned old = xb_add(&bar[XB_XSUB(b.x)], 1u);
        const unsigned gen = old / nloc;
        if (old + 1u == (gen + 1u) * nloc) {
            __builtin_amdgcn_fence(__ATOMIC_RELEASE, "agent");
            asm volatile("s_waitcnt vmcnt(0)" ::: "memory");
            const unsigned og = xb_add(&bar[XB_TOP], 1u);
            const unsigned tg = og / nx;
            if (og + 1u == (tg + 1u) * nx) xb_add(&bar[XB_TOPGEN], 1u);
            else XB_SPIN(xb_ld(&bar[XB_TOPGEN]) == tg, bar);
            __builtin_amdgcn_fence(__ATOMIC_ACQUIRE, "agent");
            xb_add(&bar[XB_XGEN(b.x)], 1u);
            asm volatile("s_waitcnt vmcnt(0)" ::: "memory");
        } else {
            XB_SPIN(xb_ld(&bar[XB_XGEN(b.x)]) == gen, bar);
            __builtin_amdgcn_fence(__ATOMIC_ACQUIRE, "agent");
            asm volatile("s_waitcnt vmcnt(0)" ::: "memory");
        }
    }
    __syncthreads();
}

namespace pg8 {
constexpr int BM = 256, BK = 64, HALF = 128, HTB = HALF * BK * 2, STAGE_BYTES = 8 * HTB, NXCD = 8, WGM = 8;
__host__ __device__ __forceinline__ int lds_byte(int r, int c) { const int st = (r >> 4) * 2 + (c >> 5), rr = r & 15, cc = c & 31, ob = rr * 64 + cc * 2; return st * 1024 + (ob ^ (((ob >> 9) & 1) << 5)); }
__host__ __device__ __forceinline__ void stage_rc(int b, int& R, int& C) { const int st = b / 1024, sb = b % 1024, swz = sb ^ (((sb >> 9) & 1) << 5); R = (st >> 1) * 16 + swz / 64; C = (st & 1) * 32 + (swz % 64) / 2; }
__host__ __device__ __forceinline__ int perm32(int rho) { const int n = rho >> 4, i = rho & 15; return 8 * (i >> 2) + 4 * n + (i & 3); }

struct Unit { const char* a; const char* b; int nt; int pm, pn, kind; };

__device__ __forceinline__ void rect_map(int wgid, int nM, int nN, int& pm, int& pn) {
    const int nwg = nM * nN;
    { const int q = nwg / NXCD, r = nwg % NXCD, xcd = wgid % NXCD, off = wgid / NXCD; wgid = (xcd < r ? xcd * (q + 1) : r * (q + 1) + (xcd - r) * q) + off; }
    const int nig = WGM * nN, gid = wgid / nig, fm = gid * WGM, gsz = (nM - fm) < WGM ? (nM - fm) : WGM;
    pm = fm + ((wgid % nig) % gsz); pn = (wgid % nig) / gsz;
}

template <int lda, int ldb, class Epi, class Sched>
__device__ __forceinline__ void gemm_phase(LAS unsigned char* lds, const Sched& S, const Epi& E) {
    int tid_ = threadIdx.x; asm volatile("" : "+v"(tid_));
    const int tid = tid_, wid = __builtin_amdgcn_readfirstlane(tid >> 6), lane = tid & 63, wr = wid >> 2, wc = wid & 3, fr = lane & 15, fq = lane >> 4;
    unsigned voffA[2], voffB[2];
#pragma unroll
    for (int i = 0; i < 2; ++i) { int R, C; stage_rc(tid * 16 + i * 8192, R, C); const int Rb = (R & ~31) + perm32(R & 31);
        voffA[i] = (unsigned)(R * lda + C) * 2u; voffB[i] = (unsigned)(Rb * ldb + C) * 2u; }
    const size_t kstep = (size_t)(BK * 2);
    const size_t hstepA = (size_t)HALF * lda * 2, hstepB = (size_t)HALF * ldb * 2;
    const unsigned ldsw = (unsigned)wid * 1024u;
    const int aoff = lds_byte(wr * 64 + fr, fq * 8), boff = lds_byte(wc * 32 + fr, fq * 8);
#define PG8_SA(b, h) (((b) * 2 + (h)) * HTB)
#define PG8_SB(b, h) ((4 + (b) * 2 + (h)) * HTB)
#define PG8_STAGE(bufoff, gbase, voff) do { _Pragma("unroll") for (int _i = 0; _i < 2; ++_i) \
        __builtin_amdgcn_global_load_lds((const unsigned*)((const char*)(gbase) + (voff)[_i]), (LAS unsigned*)(lds + (bufoff) + ldsw + _i * 8192), 16, 0, 0); } while (0)
#define PG8_LDA(dst, b, h) do { _Pragma("unroll") for (int m = 0; m < 4; ++m) _Pragma("unroll") for (int k = 0; k < 2; ++k) dst[m][k] = *(const LAS bf16x8*)(lds + PG8_SA(b, h) + aoff + m * 2048 + k * 1024); } while (0)
#define PG8_LDB(dst, b, h) do { _Pragma("unroll") for (int n = 0; n < 2; ++n) _Pragma("unroll") for (int k = 0; k < 2; ++k) dst[n][k] = *(const LAS bf16x8*)(lds + PG8_SB(b, h) + boff + n * 2048 + k * 1024); } while (0)
#define PG8_MMA(ai, bj, At, Bt) do { __builtin_amdgcn_s_setprio(1); _Pragma("unroll") for (int m = 0; m < 4; ++m) _Pragma("unroll") for (int n = 0; n < 2; ++n) _Pragma("unroll") for (int k = 0; k < 2; ++k) \
        acc[ai][bj][m][n] = __builtin_amdgcn_mfma_f32_16x16x32_bf16(Bt[n][k], At[m][k], acc[ai][bj][m][n], 0, 0, 0); __builtin_amdgcn_s_setprio(0); } while (0)
#define PG8_WAIT_V(n) asm volatile("s_waitcnt vmcnt(" #n ")" ::: "memory")
#define PG8_WAIT_L(n) asm volatile("s_waitcnt lgkmcnt(" #n ")" ::: "memory")
#define PG8_BAR __builtin_amdgcn_s_barrier()
#define PG8_SCHED __builtin_amdgcn_sched_barrier(0)
    Unit cur, nxt; int ui = 0;
    if (!S.next(0, cur)) return;
    f32x4 acc[2][2][4][2];
#pragma unroll
    for (int a = 0; a < 2; ++a)
#pragma unroll
        for (int b = 0; b < 2; ++b)
#pragma unroll
            for (int m = 0; m < 4; ++m)
#pragma unroll
                for (int n = 0; n < 2; ++n) acc[a][b][m][n] = (f32x4){0.f, 0.f, 0.f, 0.f};
    bf16x8 At[4][2], B0[2][2], B1[2][2];
    const char* cA = cur.a; const char* cB = cur.b;
    PG8_STAGE(PG8_SB(0, 0), cB, voffB); PG8_STAGE(PG8_SA(0, 0), cA, voffA); PG8_STAGE(PG8_SB(0, 1), cB + hstepB, voffB); PG8_STAGE(PG8_SA(0, 1), cA + hstepA, voffA);
    if (wr == 1) PG8_BAR;
    PG8_WAIT_V(4); PG8_BAR;
    PG8_STAGE(PG8_SB(1, 0), cB + kstep, voffB); PG8_STAGE(PG8_SA(1, 0), cA + kstep, voffA); PG8_STAGE(PG8_SB(1, 1), cB + hstepB + kstep, voffB);
    PG8_WAIT_V(6); PG8_BAR;
    for (;;) {
        const bool has_next = S.next(ui + 1, nxt);
        const char* nA = has_next ? nxt.a : cA; const char* nB = has_next ? nxt.b : cB;
        const int nt = cur.nt;
        for (int t = 0; t < nt; t += 2) {
            const bool last = (t == nt - 2);
            const char* a1 = cA + (size_t)(t + 1) * kstep;
            const char* a2 = last ? nA : cA + (size_t)(t + 2) * kstep; const char* b2 = last ? nB : cB + (size_t)(t + 2) * kstep;
            const char* a3 = a2 + kstep; const char* b3 = b2 + kstep;
            PG8_LDB(B0, 0, 0); PG8_SCHED; PG8_LDA(At, 0, 0); PG8_STAGE(PG8_SA(1, 1), a1 + hstepA, voffA);
            PG8_WAIT_L(8); PG8_BAR; PG8_WAIT_L(0); PG8_MMA(0, 0, At, B0); PG8_BAR; PG8_SCHED;
            PG8_LDB(B1, 0, 1); PG8_STAGE(PG8_SB(0, 0), b2, voffB);
            PG8_BAR; PG8_WAIT_L(0); PG8_MMA(0, 1, At, B1); PG8_BAR;
            PG8_LDA(At, 0, 1); PG8_STAGE(PG8_SA(0, 0), a2, voffA);
            PG8_BAR; PG8_WAIT_L(0); PG8_MMA(1, 0, At, B0); PG8_BAR; PG8_SCHED;
            PG8_STAGE(PG8_SB(0, 1), b2 + hstepB, voffB);
            PG8_WAIT_V(6); PG8_BAR; PG8_MMA(1, 1, At, B1); PG8_BAR;
            PG8_LDB(B0, 1, 0); PG8_SCHED; PG8_LDA(At, 1, 0); PG8_STAGE(PG8_SA(0, 1), a2 + hstepA, voffA);
            PG8_WAIT_L(8); PG8_BAR; PG8_WAIT_L(0); PG8_MMA(0, 0, At, B0); PG8_BAR; PG8_SCHED;
            PG8_LDB(B1, 1, 1); PG8_STAGE(PG8_SB(1, 0), b3, voffB);
            PG8_BAR; PG8_WAIT_L(0); PG8_MMA(0, 1, At, B1); PG8_BAR;
            PG8_LDA(At, 1, 1); PG8_STAGE(PG8_SA(1, 0), a3, voffA);
            PG8_BAR; PG8_WAIT_L(0); PG8_MMA(1, 0, At, B0); PG8_BAR; PG8_SCHED;
            PG8_STAGE(PG8_SB(1, 1), b3 + hstepB, voffB);
            PG8_WAIT_V(6); PG8_BAR; PG8_MMA(1, 1, At, B1); PG8_BAR;
        }
        E(acc, cur, wr, wc, fr, fq);
        if (!has_next) break;
        if (!(Sched::KEEP_ACC && nxt.kind >= 1 && nxt.kind <= 3)) {
#pragma unroll
        for (int a = 0; a < 2; ++a)
#pragma unroll
            for (int b = 0; b < 2; ++b)
#pragma unroll
                for (int m = 0; m < 4; ++m)
#pragma unroll
                    for (int n = 0; n < 2; ++n) acc[a][b][m][n] = (f32x4){0.f, 0.f, 0.f, 0.f};
        }
        cur = nxt; cA = nA; cB = nB; ++ui;
    }
    PG8_WAIT_V(0);
    if (wr == 0) PG8_BAR;
    PG8_BAR;
#undef PG8_SA
#undef PG8_SB
#undef PG8_STAGE
#undef PG8_LDA
#undef PG8_LDB
#undef PG8_MMA
#undef PG8_WAIT_V
#undef PG8_WAIT_L
#undef PG8_BAR
#undef PG8_SCHED
}

struct PartC { long long aOff, bOff; unsigned aStep, bStep; int nM, nN, nt, kind, start, nGrp; unsigned aGrp, bGrp; };
struct TabSched {
    static constexpr bool KEEP_ACC = false;
    const PartC* parts; const char* ws; int np, total, G, c;
    __device__ __forceinline__ bool next(int i, Unit& u) const {
        const int L = i * G + c; if (L >= total) return false;
        int q = 0;
#pragma unroll
        for (int k = 1; k < 4; ++k) if (k < np && L >= parts[k].start) q = k;
        const PartC P = parts[q];
        const int per = P.nM * P.nN, idx = L - P.start, grp = idx / per;
        int pm, pn; rect_map(idx - grp * per, P.nM, P.nN, pm, pn);
        u.a = ws + P.aOff + (size_t)grp * P.aGrp + (size_t)pm * P.aStep; u.b = ws + P.bOff + (size_t)grp * P.bGrp + (size_t)pn * P.bStep; u.nt = P.nt; u.pm = pm; u.pn = pn; u.kind = P.kind + grp; return true;
    }
};
struct MergeSched {
    static constexpr bool KEEP_ACC = true;
    const char* ws; long long aOff, bOff; int nM, G, c;
    int nCtx;
    __device__ __forceinline__ bool next(int i, Unit& u) const {
        int T = (i >> 2) * G + c, br = i & 3; bool ctxu = false;
        if (T >= nM * 4) {
            const int j = (i - 4 * ((nM * 4 - c + G - 1) / G)) * G + c;
            if (j < 0 || j >= nCtx) return false;
            T = nM * 4 + (j >> 2); br = j & 3; ctxu = true;
        }
        int pm, pn;
        if (!ctxu) rect_map(T, nM, 4, pm, pn); else { const int t = T - nM * 4; pm = nM + (t >> 2); pn = t & 3; }
        const int ko = br == 0 ? 0 : (br == 1 ? 384 : (br == 2 ? 640 : 1024));
        u.a = ws + aOff + (size_t)pm * (256u * 1280u * 2u) + ko * 2; u.b = ws + bOff + (size_t)pn * (256u * 1280u * 2u) + ko * 2; u.nt = (br & 1) ? 4 : 6; u.pm = pm; u.pn = pn; u.kind = ctxu ? 4 + br : br; return true;
    }
};
struct MoeSched {
    static constexpr bool KEEP_ACC = false;
    const char* A; const char* B; const int* tile_e; unsigned aStep, bStep; size_t bExp; int nN, nt, tile0, ntile, G, c;
    __device__ __forceinline__ bool next(int i, Unit& u) const {
        const int L = i * G + c; if (L >= ntile * nN) return false;
        const int mt = tile0 + L / nN, pn = L % nN;
        const int e = __builtin_amdgcn_readfirstlane(__hip_atomic_load(tile_e + mt, __ATOMIC_RELAXED, __HIP_MEMORY_SCOPE_AGENT));
        u.a = A + (size_t)(mt - tile0) * aStep; u.b = B + (size_t)e * bExp + (size_t)pn * bStep; u.nt = nt; u.pm = mt; u.pn = pn; u.kind = e; return true;
    }
};

struct MoeTailSched {
    static constexpr bool KEEP_ACC = false;
    const char* A; const char* B; const int* tile_e; int tile0, nfull, nex, G, c;
    __device__ __forceinline__ bool next(int i, Unit& u) const {
        const int L = i * G + c; int mt, pn, nt = 56, flag = 0; size_t koff = 0;
        if (L < nfull * 4) { mt = tile0 + (L >> 2); pn = L & 3; }
        else { const int idx = L - nfull * 4; if (idx >= nex * 16) return false; const int sp = idx & 3, tu = idx >> 2; mt = 128 + (tu >> 2); pn = tu & 3; nt = 14; koff = (size_t)sp * 14 * 128; flag = 8 + 16 * sp; }
        const int e = __builtin_amdgcn_readfirstlane(__hip_atomic_load(tile_e + mt, __ATOMIC_RELAXED, __HIP_MEMORY_SCOPE_AGENT));
        u.a = A + (size_t)(mt - tile0) * (256u * (unsigned)FF_E * 2u) + koff; u.b = B + (size_t)e * ((size_t)1024 * FF_E * 2) + (size_t)pn * (256u * (unsigned)FF_E * 2u) + koff;
        u.nt = nt; u.pm = mt; u.pn = pn; u.kind = e | flag; return true;
    }
};

#define EPI_ROWS(u) const int row0 = (u).pm * BM + wr * 64 + fr, colt = wc * 32 + 8 * fq
struct EpiProj {
    bf16_t* PRp; bf16_t* PTp; bf16_t* USp; int sig_from; unsigned char* GQp;
    __device__ __forceinline__ void operator()(const f32x4 (&acc)[2][2][4][2], const Unit& u, int wr, int wc, int fr, int fq) const {
        EPI_ROWS(u);
        bf16_t* base = u.kind == 1 ? PTp : PRp; const int ldc = u.kind == 1 ? RT : LDP; const bool sg = (u.kind == 0 && u.pn >= sig_from);
        if (sg) {
#pragma unroll
            for (int ai = 0; ai < 2; ++ai)
#pragma unroll
                for (int m = 0; m < 4; ++m) { unsigned char* rowp = GQp + (size_t)(row0 + ai * HALF + m * 16) * 4096 + (u.pn - sig_from) * BM + colt;
#pragma unroll
                    for (int bj = 0; bj < 2; ++bj) { const f32x4 v0 = acc[ai][bj][m][0], v1 = acc[ai][bj][m][1];
                        unsigned lo = 0u, hi = 0u;
                        lo = __builtin_amdgcn_cvt_pk_u8_f32(sigm(v0[0]) * 255.0f, 0, lo); lo = __builtin_amdgcn_cvt_pk_u8_f32(sigm(v0[1]) * 255.0f, 1, lo); lo = __builtin_amdgcn_cvt_pk_u8_f32(sigm(v0[2]) * 255.0f, 2, lo); lo = __builtin_amdgcn_cvt_pk_u8_f32(sigm(v0[3]) * 255.0f, 3, lo);
                        hi = __builtin_amdgcn_cvt_pk_u8_f32(sigm(v1[0]) * 255.0f, 0, hi); hi = __builtin_amdgcn_cvt_pk_u8_f32(sigm(v1[1]) * 255.0f, 1, hi); hi = __builtin_amdgcn_cvt_pk_u8_f32(sigm(v1[2]) * 255.0f, 2, hi); hi = __builtin_amdgcn_cvt_pk_u8_f32(sigm(v1[3]) * 255.0f, 3, hi);
                        *(u32x2*)(rowp + bj * HALF) = (u32x2){lo, hi}; } }
            return;
        }
#pragma unroll
        for (int ai = 0; ai < 2; ++ai)
#pragma unroll
            for (int m = 0; m < 4; ++m) { bf16_t* rowp = base + (size_t)(row0 + ai * HALF + m * 16) * ldc + u.pn * BM + colt;
#pragma unroll
                for (int bj = 0; bj < 2; ++bj) { f32x4 v0 = acc[ai][bj][m][0], v1 = acc[ai][bj][m][1];
                    if (sg) {
#pragma unroll
                        for (int j = 0; j < 4; ++j) { v0[j] = sigm(v0[j]); v1[j] = sigm(v1[j]); } }
                    u32x4 w; w.x = cvt_pk_bf16(v0[0], v0[1]); w.y = cvt_pk_bf16(v0[2], v0[3]); w.z = cvt_pk_bf16(v1[0], v1[1]); w.w = cvt_pk_bf16(v1[2], v1[3]);
                    *(u32x4*)(rowp + bj * HALF) = w;
                    if (u.kind == 0 && u.pn == 3) { const int r = row0 + ai * HALF + m * 16, cc = colt + bj * HALF;
                        *(u32x4*)(USp + ((size_t)(cc >> 4) * NCHKP + (r >> 4)) * 512 + (r & 15) * 16 + (cc & 15)) = w; } } }
    }
};
struct EpiS5State {
    float* Sp;
    __device__ __forceinline__ void operator()(const f32x4 (&acc)[2][2][4][2], const Unit& u, int wr, int wc, int fr, int fq) const {
        EPI_ROWS(u);
#pragma unroll
        for (int ai = 0; ai < 2; ++ai)
#pragma unroll
            for (int m = 0; m < 4; ++m) { float* op = Sp + ((size_t)u.kind * NCHKP + row0 + ai * HALF + m * 16) * 256 + colt;
#pragma unroll
                for (int bj = 0; bj < 2; ++bj)
#pragma unroll
                    for (int n = 0; n < 2; ++n) *(f32x4*)(op + bj * HALF + 4 * n) = acc[ai][bj][m][n]; }
    }
};
struct EpiS5Main {
    bf16_t* GLp; const bf16_t* PRp; const float* dvec;
    __device__ __forceinline__ void operator()(const f32x4 (&acc)[2][2][4][2], const Unit& u, int wr, int wc, int fr, int fq) const {
        EPI_ROWS(u);
        const int cl = 16 * u.kind + (colt & 15);
        const f32x4 d0 = *(const f32x4*)(dvec + cl), d1 = *(const f32x4*)(dvec + cl + 4);
#pragma unroll
        for (int ai = 0; ai < 2; ++ai) {
            u32x4 uq[4][2];
#pragma unroll
            for (int m = 0; m < 4; ++m) { const int n = row0 + ai * HALF + m * 16;
#pragma unroll
                for (int bj = 0; bj < 2; ++bj) { const int c = colt + bj * HALF, r = 16 * (n < NCHK ? n : 0) + (c >> 4); uq[m][bj] = *(const u32x4*)(PRp + (size_t)r * LDP + PC_D + cl); } }
#pragma unroll
            for (int m = 0; m < 4; ++m) { const int n = row0 + ai * HALF + m * 16; if (n >= NCHK) continue;
#pragma unroll
                for (int bj = 0; bj < 2; ++bj) { const int c = colt + bj * HALF, r = 16 * n + (c >> 4); const u32x4 uv = uq[m][bj];
                    const f32x4 v0 = acc[ai][bj][m][0], v1 = acc[ai][bj][m][1];
                    u32x4 w; w.x = cvt_pk_bf16(gelu_f(v0[0] + d0[0] * bflo(uv.x)), gelu_f(v0[1] + d0[1] * bfhi(uv.x))); w.y = cvt_pk_bf16(gelu_f(v0[2] + d0[2] * bflo(uv.y)), gelu_f(v0[3] + d0[3] * bfhi(uv.y)));
                    w.z = cvt_pk_bf16(gelu_f(v1[0] + d1[0] * bflo(uv.z)), gelu_f(v1[1] + d1[1] * bfhi(uv.z))); w.w = cvt_pk_bf16(gelu_f(v1[2] + d1[2] * bflo(uv.w)), gelu_f(v1[3] + d1[3] * bfhi(uv.w)));
                    *(u32x4*)(GLp + (size_t)r * 256 + cl) = w; } }
        }
    }
};
struct EpiS5Glu {
    bf16_t* YBp; const bf16_t* GLp; const float* bvec;
    __device__ __forceinline__ void operator()(const f32x4 (&acc)[2][2][4][2], const Unit& u, int wr, int wc, int fr, int fq) const {
        EPI_ROWS(u);
        f32x4 bq[2][2];
#pragma unroll
        for (int bj = 0; bj < 2; ++bj) { bq[bj][0] = *(const f32x4*)(bvec + colt + bj * HALF); bq[bj][1] = *(const f32x4*)(bvec + colt + bj * HALF + 4); }
#pragma unroll
        for (int ai = 0; ai < 2; ++ai) {
            u32x4 gq[4][2];
#pragma unroll
            for (int m = 0; m < 4; ++m)
#pragma unroll
                for (int bj = 0; bj < 2; ++bj) gq[m][bj] = *(const u32x4*)(GLp + (size_t)(row0 + ai * HALF + m * 16) * 256 + colt + bj * HALF);
#pragma unroll
            for (int m = 0; m < 4; ++m) { const int r = row0 + ai * HALF + m * 16;
#pragma unroll
                for (int bj = 0; bj < 2; ++bj) { const int c = colt + bj * HALF; const u32x4 gv = gq[m][bj];
                    const f32x4 v0 = acc[ai][bj][m][0] + bq[bj][0], v1 = acc[ai][bj][m][1] + bq[bj][1];
                    u32x4 w; w.x = cvt_pk_bf16(bflo(gv.x) * sigm(v0[0]), bfhi(gv.x) * sigm(v0[1])); w.y = cvt_pk_bf16(bflo(gv.y) * sigm(v0[2]), bfhi(gv.y) * sigm(v0[3]));
                    w.z = cvt_pk_bf16(bflo(gv.z) * sigm(v1[0]), bfhi(gv.z) * sigm(v1[1])); w.w = cvt_pk_bf16(bflo(gv.w) * sigm(v1[2]), bfhi(gv.w) * sigm(v1[3]));
                    *(u32x4*)(YBp + (size_t)r * YW + YC_D + c) = w; } }
        }
    }
};
__device__ __forceinline__ float gq8(unsigned w, int j) { return (float)((w >> (8 * j)) & 255u); }
struct EpiGate {
    const unsigned char* GQp; bf16_t* MGp; bf16_t* MGCp;
    __device__ __forceinline__ void operator()(f32x4 (&acc)[2][2][4][2], const Unit& u, int wr, int wc, int fr, int fq) const {
        EPI_ROWS(u);
        const int br = u.kind & 3;
        if (u.kind < 3) {
#pragma unroll
            for (int ai = 0; ai < 2; ++ai) {
                u32x2 ga[4][2], gb[4][2];
#pragma unroll
                for (int m = 0; m < 4; ++m)
#pragma unroll
                    for (int bj = 0; bj < 2; ++bj) { const unsigned char* gp = GQp + (size_t)(row0 + ai * HALF + m * 16) * 4096 + br * 1024 + u.pn * BM + colt + bj * HALF;
                        ga[m][bj] = *(const u32x2*)gp; gb[m][bj] = *(const u32x2*)(gp + 1024); }
#pragma unroll
                for (int m = 0; m < 4; ++m)
#pragma unroll
                    for (int bj = 0; bj < 2; ++bj)
#pragma unroll
                        for (int j = 0; j < 4; ++j) {
                            acc[ai][bj][m][0][j] *= fmaxf(gq8(ga[m][bj].x, j), 1.0f) * __builtin_amdgcn_rcpf(fmaxf(gq8(gb[m][bj].x, j), 1.0f));
                            acc[ai][bj][m][1][j] *= fmaxf(gq8(ga[m][bj].y, j), 1.0f) * __builtin_amdgcn_rcpf(fmaxf(gq8(gb[m][bj].y, j), 1.0f)); }
            }
            return;
        }
        bf16_t* OB = u.kind >= 4 ? MGCp + (size_t)br * RC * D - (size_t)RL * D : MGp;
        const float lo = u.kind >= 4 ? 0.0f : 1.0f;
#pragma unroll
        for (int ai = 0; ai < 2; ++ai) {
            u32x2 g[4][2];
#pragma unroll
            for (int m = 0; m < 4; ++m)
#pragma unroll
                for (int bj = 0; bj < 2; ++bj) g[m][bj] = *(const u32x2*)(GQp + (size_t)(row0 + ai * HALF + m * 16) * 4096 + br * 1024 + u.pn * BM + colt + bj * HALF);
#pragma unroll
            for (int m = 0; m < 4; ++m) { bf16_t* mp = OB + (size_t)(row0 + ai * HALF + m * 16) * D + u.pn * BM + colt;
#pragma unroll
                for (int bj = 0; bj < 2; ++bj) { const f32x4 v0 = acc[ai][bj][m][0] * (1.0f / 255.0f), v1 = acc[ai][bj][m][1] * (1.0f / 255.0f); const u32x2 gg = g[m][bj];
                    const f32x4 o0 = {v0[0] * fmaxf(gq8(gg.x, 0), lo), v0[1] * fmaxf(gq8(gg.x, 1), lo), v0[2] * fmaxf(gq8(gg.x, 2), lo), v0[3] * fmaxf(gq8(gg.x, 3), lo)};
                    const f32x4 o1 = {v1[0] * fmaxf(gq8(gg.y, 0), lo), v1[1] * fmaxf(gq8(gg.y, 1), lo), v1[2] * fmaxf(gq8(gg.y, 2), lo), v1[3] * fmaxf(gq8(gg.y, 3), lo)};
                    u32x4 w; w.x = cvt_pk_bf16(o0[0], o0[1]); w.y = cvt_pk_bf16(o0[2], o0[3]); w.z = cvt_pk_bf16(o1[0], o1[1]); w.w = cvt_pk_bf16(o1[2], o1[3]);
                    *(u32x4*)(mp + bj * HALF) = w; } }
        }
    }
};
struct EpiRes {
    float* PREp; const float* xlat; const float* xctx; const float* gvec;
    float* partp;
    __device__ __forceinline__ void operator()(const f32x4 (&acc)[2][2][4][2], const Unit& u, int wr, int wc, int fr, int fq) const {
        EPI_ROWS(u);
        if (u.kind != 0) {
            f32x4 gc[2][2];
#pragma unroll
            for (int bj = 0; bj < 2; ++bj)
#pragma unroll
                for (int n = 0; n < 2; ++n) gc[bj][n] = *(const f32x4*)(gvec + (size_t)4 * 6144 + u.pn * BM + colt + bj * HALF + 4 * n);
#pragma unroll
            for (int ai = 0; ai < 2; ++ai)
#pragma unroll
                for (int m = 0; m < 4; ++m) { const int r = row0 + ai * HALF + m * 16; const int c0 = u.pn * BM + colt;
                    float* op = partp + ((size_t)(u.kind - 1) * RC + r) * D + c0;
#pragma unroll
                    for (int bj = 0; bj < 2; ++bj)
#pragma unroll
                        for (int n = 0; n < 2; ++n) *(f32x4*)(op + bj * HALF + 4 * n) = gc[bj][n] * acc[ai][bj][m][n]; }
            return;
        }
        const int c0 = u.pn * BM + colt, rt0 = u.pm * BM;
        const float* gp = gvec + (size_t)(rt0 < RL ? (rt0 >> 12) : 4) * 6144 + c0;
        f32x4 gq[2][2];
#pragma unroll
        for (int bj = 0; bj < 2; ++bj)
#pragma unroll
            for (int n = 0; n < 2; ++n) gq[bj][n] = *(const f32x4*)(gp + bj * HALF + 4 * n);
#pragma unroll
        for (int ai = 0; ai < 2; ++ai)
#pragma unroll
            for (int m = 0; m < 4; ++m) { bf16_t* op = (bf16_t*)PREp + (size_t)(row0 + ai * HALF + m * 16) * D + c0;
#pragma unroll
                for (int bj = 0; bj < 2; ++bj) { const f32x4 v0 = gq[bj][0] * acc[ai][bj][m][0], v1 = gq[bj][1] * acc[ai][bj][m][1];
                    u32x4 w; w.x = cvt_pk_bf16(v0[0], v0[1]); w.y = cvt_pk_bf16(v0[2], v0[3]); w.z = cvt_pk_bf16(v1[0], v1[1]); w.w = cvt_pk_bf16(v1[2], v1[3]);
                    *(u32x4*)(op + bj * HALF) = w; } }
    }
};
struct EpiSwiglu {
    bf16_t* Hp; int ldh; int row_sub;
    __device__ __forceinline__ void operator()(const f32x4 (&acc)[2][2][4][2], const Unit& u, int wr, int wc, int fr, int fq) const {
        const int row0 = (u.pm - row_sub) * BM + wr * 64 + fr, colt = wc * 32 + 8 * fq;
#pragma unroll
        for (int ai = 0; ai < 2; ++ai)
#pragma unroll
            for (int m = 0; m < 4; ++m) { bf16_t* rowp = Hp + (size_t)(row0 + ai * HALF + m * 16) * ldh + u.pn * HALF + colt;
                f32x4 h0, h1;
#pragma unroll
                for (int j = 0; j < 4; ++j) { const float g0 = acc[ai][0][m][0][j], g1 = acc[ai][0][m][1][j];
                    h0[j] = g0 * sigm(g0) * acc[ai][1][m][0][j]; h1[j] = g1 * sigm(g1) * acc[ai][1][m][1][j]; }
                u32x4 w; w.x = cvt_pk_bf16(h0[0], h0[1]); w.y = cvt_pk_bf16(h0[2], h0[3]); w.z = cvt_pk_bf16(h1[0], h1[1]); w.w = cvt_pk_bf16(h1[2], h1[3]);
                *(u32x4*)rowp = w; }
    }
};
struct EpiMoeDown {
    bf16_t* O2; const float* slotw; float* O2X;
    __device__ __forceinline__ void operator()(const f32x4 (&acc)[2][2][4][2], const Unit& u, int wr, int wc, int fr, int fq) const {
        EPI_ROWS(u);
        float wq[2][4];
        if (u.kind & 8) {
            const int sp = (u.kind >> 4) & 3;
#pragma unroll
            for (int ai = 0; ai < 2; ++ai)
#pragma unroll
                for (int m = 0; m < 4; ++m) { const int r = row0 + ai * HALF + m * 16; const float w8 = slotw[r]; float* op = O2X + ((size_t)sp * 2048 + (r - 128 * 256)) * D + u.pn * BM + colt;
#pragma unroll
                    for (int bj = 0; bj < 2; ++bj)
#pragma unroll
                        for (int n = 0; n < 2; ++n) *(f32x4*)(op + bj * HALF + 4 * n) = acc[ai][bj][m][n] * w8; }
            return;
        }
#pragma unroll
        for (int ai = 0; ai < 2; ++ai)
#pragma unroll
            for (int m = 0; m < 4; ++m) wq[ai][m] = slotw[row0 + ai * HALF + m * 16];
#pragma unroll
        for (int ai = 0; ai < 2; ++ai)
#pragma unroll
            for (int m = 0; m < 4; ++m) { const int r = row0 + ai * HALF + m * 16; const float w8 = wq[ai][m];
                bf16_t* rowp = O2 + (size_t)r * D + u.pn * BM + colt;
#pragma unroll
                for (int bj = 0; bj < 2; ++bj) { const f32x4 v0 = acc[ai][bj][m][0] * w8, v1 = acc[ai][bj][m][1] * w8;
                    u32x4 w; w.x = cvt_pk_bf16(v0[0], v0[1]); w.y = cvt_pk_bf16(v0[2], v0[3]); w.z = cvt_pk_bf16(v1[0], v1[1]); w.w = cvt_pk_bf16(v1[2], v1[3]);
                    *(u32x4*)(rowp + bj * HALF) = w; } }
    }
};
}

struct Job { int in_idx; int src_off; int lds; int K; int N; long long dst_off; int ldd; int kcol0; int G, GS, R0; int tile0; };
struct JobTable { Job j[96]; int n; int total; };
constexpr int BIGG = 1 << 30;
constexpr void add_job(JobTable& t, int in_idx, long long src_off, int lds, int K, int N, size_t dst_off, int ldd, int kcol0, int G, int GS, int R0) {
    Job& q = t.j[t.n]; q.in_idx = in_idx; q.src_off = (int)src_off; q.lds = lds; q.K = K; q.N = N; q.dst_off = (long long)dst_off; q.ldd = ldd; q.kcol0 = kcol0; q.G = G; q.GS = GS; q.R0 = R0;
    q.tile0 = t.total; t.total += (K / 64) * (N / 64); t.n++;
}
constexpr JobTable make_jobs(int which) {
    JobTable t{}; t.n = 0; t.total = 0;
    if (which == 0) {
        for (int l = 0; l < 2; ++l) {
            const size_t base = WS_WL + (size_t)l * SZ_WL; const long long wsrc = (long long)l * 1024 * IN_COLS;
            add_job(t, 6, wsrc + 0, IN_COLS, 1024, 768, base, 1024, 0, BIGG, 0, 0);
            add_job(t, 6, wsrc + 2688, IN_COLS, 1024, 256, base, 1024, 0, BIGG, 0, PC_D);
            add_job(t, 6, wsrc + 1536, IN_COLS, 1024, 768, base, 1024, 0, BIGG, 0, PC_Q);
            add_job(t, 6, wsrc + 2944, IN_COLS, 1024, 4096, base, 1024, 0, BIGG, 0, PC_G);
            add_job(t, 6, wsrc + 768, IN_COLS, 1024, 768, base + SZ_WINR, 1024, 0, BIGG, 0, 0);
            add_job(t, 6, wsrc + 2304, IN_COLS, 1024, 384, base + SZ_WINR, 1024, 0, BIGG, 0, PT_V);
            const int kd[4] = {384, 256, 384, 256}, ko[4] = {0, 384, 640, 1024};
            for (int i = 0; i < 4; ++i) add_job(t, 35 + i, (long long)l * kd[i] * 1024, 1024, kd[i], 1024, base + SZ_WINR + SZ_WINHY, 1280, ko[i], BIGG, 0, 0);
            add_job(t, 39, (long long)l * 1024 * 1024, 1024, 1024, 1024, base + SZ_WINR + SZ_WINHY + SZ_WBR, 1024, 0, BIGG, 0, 0);
        }
        for (int q = 0; q < 24; ++q) for (int mat = 0; mat < 2; ++mat)
            add_job(t, mat == 0 ? 9 : 11, (long long)q * 4096, 64, 64, 64, WS_LW + (size_t)(((q / 6) * 2 + mat) * 6 + q % 6) * 4096 * 2, 64, 0, BIGG, 0, 0);
        for (int l = 0; l < 2; ++l) add_job(t, 33, (long long)l * 65536, 256, 256, 256, WS_WGLU + (size_t)l * 256 * 256 * 2, 256, 0, BIGG, 0, 0);
        add_job(t, 44, 0, FF_DENSE, 1024, FF_DENSE, WS_FFGU, 1024, 0, 128, 256, 0);
        add_job(t, 45, 0, FF_DENSE, 1024, FF_DENSE, WS_FFGU, 1024, 0, 128, 256, 128);
        add_job(t, 46, 0, 1024, FF_DENSE, 1024, WS_FFD, FF_DENSE, 0, BIGG, 0, 0);
    } else {
        for (int e = 0; e < NE; ++e) {
            add_job(t, 48, (long long)e * 1024 * FF_E, FF_E, 1024, FF_E, WS_MOEGU + (size_t)e * 2 * FF_E * 1024 * 2, 1024, 0, 128, 256, 0);
            add_job(t, 49, (long long)e * 1024 * FF_E, FF_E, 1024, FF_E, WS_MOEGU + (size_t)e * 2 * FF_E * 1024 * 2, 1024, 0, 128, 256, 128);
            add_job(t, 50, (long long)e * FF_E * 1024, 1024, FF_E, 1024, WS_MOED + (size_t)e * 1024 * FF_E * 2, FF_E, 0, BIGG, 0, 0);
        }
    }
    return t;
}
__device__ const JobTable JT_SMALL = make_jobs(0);
__device__ const JobTable JT_MOE = make_jobs(1);

struct PartTable { pg8::PartC p[32]; };
constexpr pg8::PartC mk_part(size_t aOff, size_t bOff, unsigned aStep, unsigned bStep, int nM, int nN, int nt, int kind, int start) {
    pg8::PartC q{}; q.aOff = (long long)aOff; q.bOff = (long long)bOff; q.aStep = aStep; q.bStep = bStep; q.nM = nM; q.nN = nN; q.nt = nt; q.kind = kind; q.start = start; q.nGrp = 1; q.aGrp = 0; q.bGrp = 0; return q;
}
constexpr PartTable make_parts() {
    PartTable t{};
    for (int l = 0; l < 2; ++l) {
        const size_t WL = WS_WL + (size_t)l * SZ_WL; const int nMrow = l == 0 ? 68 : 64;
        t.p[l * 8 + 0] = mk_part(WS_UB, WL, 256u * 1024u * 2u, 256u * 1024u * 2u, 68, 23, 16, 0, 0);
        t.p[l * 8 + 1] = mk_part(WL + SZ_WINR, WS_UB, 256u * 1024u * 2u, 256u * 1024u * 2u, 5, 68, 16, 1, 68 * 23);
        const int kd[4] = {384, 256, 384, 256}, ko[4] = {0, 384, 640, 1024};
        for (int i = 0; i < 4; ++i) t.p[l * 8 + 2 + i] = mk_part(WS_YB + ko[i] * 2, WL + SZ_WINR + SZ_WINHY + ko[i] * 2, 256u * 1280u * 2u, 256u * 1280u * 2u, nMrow, 4, kd[i] / 64, i, i * nMrow * 4);
        t.p[l * 8 + 6] = mk_part(WS_UB, WL + SZ_WINR + SZ_WINHY + SZ_WBR, 256u * 1024u * 2u, 256u * 1024u * 2u, nMrow, 4, 16, 0, 0);
    }
    for (int l = 0; l < 2; ++l) {
        pg8::PartC q = mk_part(WS_US, WS_OPS + (size_t)l * 16 * 256 * 256 * 2, 256u * 512u * 2u, 0u, 5, 1, 4, 0, 0); q.nGrp = 16; q.aGrp = (unsigned)(NCHKP * 512 * 2); q.bGrp = 256u * 256u * 2u; t.p[18 + l * 3] = q;
        q = mk_part(WS_US, WS_OPY + (size_t)l * 16 * 256 * 512 * 2, 256u * 512u * 2u, 0u, 5, 1, 8, 0, 0); q.nGrp = 16; q.aGrp = (unsigned)(NCHKP * 512 * 2); q.bGrp = 256u * 512u * 2u; t.p[19 + l * 3] = q;
        t.p[20 + l * 3] = mk_part(WS_GL, WS_WGLU + (size_t)l * 256 * 256 * 2, 256u * 256u * 2u, 0u, l == 0 ? 68 : 64, 1, 4, 0, 0);
    }
    {
        const size_t WL0 = WS_WL;
        t.p[24] = mk_part(WS_UB, WL0 + SZ_WINR + SZ_WINHY + SZ_WBR, 256u * 1024u * 2u, 256u * 1024u * 2u, 64, 4, 16, 0, 0);
        pg8::PartC q = mk_part(WS_MGC, WL0 + SZ_WINR + SZ_WINHY + SZ_WBR, 256u * 1024u * 2u, 256u * 1024u * 2u, 4, 4, 16, 1, 256); q.nGrp = 4; q.aGrp = (unsigned)(RC * D * 2); q.bGrp = 0u; t.p[25] = q;
        t.p[26] = mk_part(WS_H, WS_FFD, 256u * (unsigned)FF_DENSE * 2u, 256u * (unsigned)FF_DENSE * 2u, 64, 4, 44, 0, 0);
        q = mk_part(WS_H + (size_t)64 * 256 * FF_DENSE * 2, WS_FFD, 256u * (unsigned)FF_DENSE * 2u, 256u * (unsigned)FF_DENSE * 2u, 4, 4, 12, 1, 256); q.nGrp = 3; q.aGrp = 1536u; q.bGrp = 1536u; t.p[27] = q;
        t.p[28] = mk_part(WS_H + (size_t)64 * 256 * FF_DENSE * 2 + 36 * 128, WS_FFD + 36 * 128, 256u * (unsigned)FF_DENSE * 2u, 256u * (unsigned)FF_DENSE * 2u, 4, 4, 8, 4, 256 + 48);
    }
    t.p[16] = mk_part(WS_UB, WS_FFGU, 256u * 1024u * 2u, 256u * 1024u * 2u, 68, 22, 16, 0, 0);
    t.p[17] = mk_part(WS_H, WS_FFD, 256u * (unsigned)FF_DENSE * 2u, 256u * (unsigned)FF_DENSE * 2u, 68, 4, 44, 0, 0);
    return t;
}
__device__ const PartTable PARTS = make_parts();

struct Args {
    const float* in[51];
    float* out; unsigned char* ws;
    int ph_lo, ph_hi, bar_region, pad0;
};
__device__ __forceinline__ const float* sel_in(const Args& a, int idx) {
    const float* p = a.in[6];
    p = idx == 9 ? a.in[9] : p; p = idx == 11 ? a.in[11] : p; p = idx == 33 ? a.in[33] : p; p = idx == 35 ? a.in[35] : p; p = idx == 36 ? a.in[36] : p; p = idx == 37 ? a.in[37] : p; p = idx == 38 ? a.in[38] : p; p = idx == 39 ? a.in[39] : p;
    p = idx == 44 ? a.in[44] : p; p = idx == 45 ? a.in[45] : p; p = idx == 46 ? a.in[46] : p; p = idx == 48 ? a.in[48] : p; p = idx == 49 ? a.in[49] : p; p = idx == 50 ? a.in[50] : p;
    return p;
}

struct ConvRegs { f32x4 v[4][2]; int jis[4]; };
__device__ __forceinline__ void conv_load(const Args& a, const JobTable& JT, int t0, int stride, ConvRegs& R) {
    int tid = threadIdx.x; asm volatile("" : "+v"(tid));
#pragma unroll
    for (int u = 0; u < 4; ++u) {
        const int t = t0 + u * stride; R.jis[u] = -1;
        if (t < JT.total) {
            int ji = 0;
            for (int k = 1; k < JT.n; ++k) if (t >= JT.j[k].tile0) ji = k;
            R.jis[u] = ji;
            const Job& q = JT.j[ji];
            const int lt = t - q.tile0, nTn = q.N / 64, k0 = (lt / nTn) * 64, n0 = (lt % nTn) * 64;
            const float* src = sel_in(a, q.in_idx) + (size_t)q.src_off + (size_t)k0 * q.lds + n0;
#pragma unroll
            for (int p = 0; p < 2; ++p) R.v[u][p] = *(const f32x4*)(src + (size_t)((tid >> 4) + 32 * p) * q.lds + (tid & 15) * 4);
        }
    }
}
__device__ __forceinline__ void conv_store(const Args& a, const JobTable& JT, LAS float* tile, int t0, int stride, const ConvRegs& R) {
    int tid = threadIdx.x; asm volatile("" : "+v"(tid));
    __syncthreads();
#pragma unroll
    for (int u = 0; u < 4; ++u) if (R.jis[u] >= 0) {
#pragma unroll
        for (int p = 0; p < 2; ++p) { const int kk = (tid >> 4) + 32 * p, nn = (tid & 15) * 4; LAS float* tp = tile + u * (64 * 65) + kk * 65 + nn;
            tp[0] = R.v[u][p][0]; tp[1] = R.v[u][p][1]; tp[2] = R.v[u][p][2]; tp[3] = R.v[u][p][3]; } }
    __syncthreads();
#pragma unroll
    for (int u = 0; u < 4; ++u) if (R.jis[u] >= 0) {
        const Job& q = JT.j[R.jis[u]];
        const int t = t0 + u * stride, lt = t - q.tile0, nTn = q.N / 64, k0 = (lt / nTn) * 64, n0 = (lt % nTn) * 64;
        const int n = tid >> 3, k8 = (tid & 7) * 8, ng = n0 + n;
        const int drow = (ng / q.G) * q.GS + (ng % q.G) + q.R0;
        const LAS float* tp = tile + u * (64 * 65) + n;
        u32x4 w;
        w.x = cvt_pk_bf16(tp[(k8 + 0) * 65], tp[(k8 + 1) * 65]); w.y = cvt_pk_bf16(tp[(k8 + 2) * 65], tp[(k8 + 3) * 65]);
        w.z = cvt_pk_bf16(tp[(k8 + 4) * 65], tp[(k8 + 5) * 65]); w.w = cvt_pk_bf16(tp[(k8 + 6) * 65], tp[(k8 + 7) * 65]);
        *(u32x4*)((bf16_t*)(a.ws + q.dst_off) + (size_t)drow * q.ldd + q.kcol0 + k0 + k8) = w;
    }
}
__device__ __forceinline__ void convert_step(const Args& a, const JobTable& JT, LAS float* tile, int t0, int stride) { ConvRegs R; conv_load(a, JT, t0, stride, R); conv_store(a, JT, tile, t0, stride, R); }
__device__ __forceinline__ void convert_tiles_pipelined(const Args& a, const JobTable& JT, LAS float* tile, int first, int stride) {
    ConvRegs cur; int t0 = first;
    if (t0 >= JT.total) return;
    conv_load(a, JT, t0, stride, cur);
    for (;;) {
        const int tn = t0 + 4 * stride; const bool more = tn < JT.total;
        ConvRegs nxt;
        if (more) conv_load(a, JT, tn, stride, nxt);
        conv_store(a, JT, tile, t0, stride, cur);
        if (!more) break;
        cur = nxt; t0 = tn;
    }
}
__device__ __forceinline__ void convert_tiles(const Args& a, const JobTable& JT, LAS float* tile, int first, int stride) {
    for (int t0 = first; t0 < JT.total; t0 += 4 * stride) convert_step(a, JT, tile, t0, stride);
}

__device__ __forceinline__ int opaque(int v) { asm volatile("" : "+v"(v)); return v; }
#define PIN8(a) asm volatile("" : "+v"((a)[0]), "+v"((a)[1]), "+v"((a)[2]), "+v"((a)[3]), "+v"((a)[4]), "+v"((a)[5]), "+v"((a)[6]), "+v"((a)[7]))
#define PIN16(a) do { PIN8(a); PIN8((a) + 8); } while (0)
struct RowV { f32x4 v[4]; };
__device__ __forceinline__ RowV row_load(const float* p, int lane) { RowV r;
#pragma unroll
    for (int i = 0; i < 4; ++i) r.v[i] = *(const f32x4*)(p + 256 * i + 4 * lane); return r; }
__device__ __forceinline__ RowV row_load_bf16(const bf16_t* p, int lane) { RowV r;
#pragma unroll
    for (int i = 0; i < 4; ++i) { const u32x2 w = *(const u32x2*)(p + 256 * i + 4 * lane); r.v[i] = (f32x4){bflo(w.x), bfhi(w.x), bflo(w.y), bfhi(w.y)}; } return r; }
__device__ __forceinline__ void row_store(float* p, int lane, const RowV& r) {
#pragma unroll
    for (int i = 0; i < 4; ++i) *(f32x4*)(p + 256 * i + 4 * lane) = r.v[i]; }
__device__ __forceinline__ void row_store_bf16(bf16_t* p, int lane, const RowV& r) {
#pragma unroll
    for (int i = 0; i < 4; ++i) { u32x2 w; w.x = cvt_pk_bf16(r.v[i][0], r.v[i][1]); w.y = cvt_pk_bf16(r.v[i][2], r.v[i][3]); *(u32x2*)(p + 256 * i + 4 * lane) = w; } }
__device__ __forceinline__ RowV row_norm(const RowV& x) {
    float s = 0.f;
#pragma unroll
    for (int i = 0; i < 4; ++i) s += (x.v[i][0] + x.v[i][1]) + (x.v[i][2] + x.v[i][3]);
    const float mu = wave_sum(s) * (1.f / D);
    RowV d; float q = 0.f;
#pragma unroll
    for (int i = 0; i < 4; ++i) { d.v[i] = x.v[i] - mu; q += (d.v[i][0] * d.v[i][0] + d.v[i][1] * d.v[i][1]) + (d.v[i][2] * d.v[i][2] + d.v[i][3] * d.v[i][3]); }
    const float rs = rsqrtf(wave_sum(q) * (1.f / D) + 1e-5f);
#pragma unroll
    for (int i = 0; i < 4; ++i) d.v[i] = d.v[i] * rs;
    return d;
}
__device__ __forceinline__ RowV row_affine(const RowV& n, const float* g, const float* b, int lane) {
    RowV o;
#pragma unroll
    for (int i = 0; i < 4; ++i) o.v[i] = n.v[i] * *(const f32x4*)(g + 256 * i + 4 * lane) + *(const f32x4*)(b + 256 * i + 4 * lane);
    return o;
}
__device__ __forceinline__ RowV row_modulate(const RowV& n, const float* sh, const float* sc, int lane) {
    RowV o;
#pragma unroll
    for (int i = 0; i < 4; ++i) o.v[i] = n.v[i] * (*(const f32x4*)(sc + 256 * i + 4 * lane) + 1.0f) + *(const f32x4*)(sh + 256 * i + 4 * lane);
    return o;
}

constexpr int LDS_BYTES = 159744;
constexpr int MISC_OFF = 159488;
constexpr int NPH_LAYER = 16;
#ifndef SPLIT
#define SPLIT 0
#endif

__global__ void __launch_bounds__(512, 2) mk_fwd(Args a) {
    extern __shared__ __attribute__((aligned(16))) unsigned char shm[];
    LAS unsigned char* lds = (LAS unsigned char*)shm;
    volatile LAS unsigned* MISC = (volatile LAS unsigned*)(lds + MISC_OFF);
    const int tid0 = threadIdx.x, wave = __builtin_amdgcn_readfirstlane(tid0 >> 6);
    const int G = gridDim.x, bid = blockIdx.x;
    if (tid0 < (LDS_BYTES - MISC_OFF) / 4) MISC[tid0] = 0u;
    __syncthreads();
    unsigned char* ws = a.ws;
    unsigned* ctl = (unsigned*)(ws + WS_CTL);
    XcdBarrier bar = xcd_barrier_post(ctl + CW_BAR + a.bar_region * XCD_BAR_WORDS, MISC + 8);
    const int lo = a.ph_lo, hi = a.ph_hi;
#ifndef PHMASK
#define PHMASK 0xFFFF
#endif
#define IN(k) (lo <= (k) && (k) < hi)
#define SEAM(k) do { if (lo <= (k) && (k) + 1 < hi) xcd_barrier(bar); } while (0)
    float* MOD = (float*)(ws + WS_MOD);
    bf16_t* UB = (bf16_t*)(ws + WS_UB); bf16_t* PR = (bf16_t*)(ws + WS_PR); bf16_t* PT = (bf16_t*)(ws + WS_PT); bf16_t* YB = (bf16_t*)(ws + WS_YB);
    float* PRE = (float*)(ws + WS_PRE); float* XSC = (float*)(ws + WS_XSC);
    const float* x_in = a.in[0]; const float* ctx_in = a.in[2];

    if (((PHMASK >> 0) & 1) && IN(0)) {
        const int tid = opaque(tid0), lane = tid & 63;
        __syncthreads();
        LAS float* sc = (LAS float*)lds;
        for (int i = tid; i < 5 * 1024; i += 512) { const int r = i >> 10, k = i & 1023; sc[i] = silu_acc(r < 4 ? a.in[1][r * 1024 + k] : a.in[3][k]); }
        __syncthreads();
        LAS float* red = sc + 5 * 1024;
        for (int u = bid; u < 192; u += G) {
            const int l = u / 96, cg = u - l * 96, n = cg * 64 + lane;
            const float* w = a.in[4] + (size_t)l * 1024 * 6144 + n;
            float a0 = 0, a1 = 0, a2 = 0, a3 = 0, a4 = 0;
            const int kb = wave * 128;
#pragma unroll 8
            for (int k = kb; k < kb + 128; ++k) { const float wv = w[(size_t)k * 6144]; a0 += sc[k] * wv; a1 += sc[1024 + k] * wv; a2 += sc[2048 + k] * wv; a3 += sc[3072 + k] * wv; a4 += sc[4096 + k] * wv; }
            __syncthreads();
            red[(wave * 5 + 0) * 64 + lane] = a0; red[(wave * 5 + 1) * 64 + lane] = a1; red[(wave * 5 + 2) * 64 + lane] = a2; red[(wave * 5 + 3) * 64 + lane] = a3; red[(wave * 5 + 4) * 64 + lane] = a4;
            __syncthreads();
            if (tid < 320) { const int r = tid >> 6, c = tid & 63; float sacc = a.in[5][l * 6144 + cg * 64 + c];
#pragma unroll
                for (int wv = 0; wv < 8; ++wv) sacc += red[(wv * 5 + r) * 64 + c];
                MOD[((size_t)l * 5 + r) * 6144 + cg * 64 + c] = sacc; }
        }
        __syncthreads();
        for (int u = bid; u < 132; u += G) {
            const bool isc = u >= 128; const int l = isc ? 0 : (u >> 6), blk = isc ? u - 128 : (u & 63), L = isc ? CTXL : SEQ, t0 = blk * 64;
            LAS float* feat = (LAS float*)lds;
            LAS float* h1 = feat + 64 * 33;
            LAS float* h2 = h1 + 4096;
            const float* w1 = a.in[16] + l * 33 * 64; const float* b1 = a.in[17] + l * 64; const float* w2 = a.in[18] + l * 4096; const float* b2 = a.in[19] + l * 64;
            const float* w3 = a.in[20] + (size_t)l * 65536; const float* b3 = a.in[21] + l * 1024; const float* fq = a.in[22] + l * 64;
            __syncthreads();
            for (int i = tid; i < 64 * 33; i += 512) { const int tt = i / 33, f = i - tt * 33, t = t0 + tt; float v;
                if (f == 0) v = (float)t / (float)L;
                else { const int band = (f - 1) % 16 + 1; const int m = (int)(((long)t * band) % L); const double ang = 2.0 * M_PI * (double)m / (double)L; v = f <= 16 ? (float)cos(ang) : (float)sin(ang); }
                feat[i] = v; }
            __syncthreads();
            for (int i = tid; i < 4096; i += 512) { const int tt = i >> 6, j = i & 63; float sacc = b1[j];
                for (int f = 0; f < 33; ++f) sacc += feat[tt * 33 + f] * w1[f * 64 + j];
                h1[i] = sinf(fq[j] * sacc); }
            __syncthreads();
            for (int i = tid; i < 4096; i += 512) { const int tt = i >> 6, j = i & 63; float sacc = b2[j];
                for (int f = 0; f < 64; ++f) sacc += h1[tt * 64 + f] * w2[f * 64 + j];
                h2[i] = sinf(fq[j] * sacc); }
            __syncthreads();
            const float dmin = 3.0701134573253945f, dmax = 15.350567286626973f;
#pragma unroll 1
            for (int jj = 0; jj < 2; ++jj) {
                const int n = tid + 512 * jj, dir = n >> 9, o = (n >> 8) & 1, c = n & 255;
                float wc[64];
#pragma unroll
                for (int i = 0; i < 64; ++i) wc[i] = w3[i * 1024 + n];
                const float bb = b3[n], delta = dmin + (dmax - dmin) * (float)c / 255.0f;
                bf16_t* dst = isc ? (bf16_t*)(ws + WS_KFC) + ((size_t)(dir * 2 + o) * 256 + c) * CTXL + t0 : (bf16_t*)(ws + WS_KFL) + ((size_t)((l * 2 + dir) * 2 + o) * 256 + c) * SEQ + t0;
                float asum = 0.f;
#pragma unroll 1
                for (int tg = 0; tg < 8; ++tg) {
                    float v[8];
#pragma unroll
                    for (int q = 0; q < 8; ++q) { float sacc = bb; const LAS float* hp = h2 + (tg * 8 + q) * 64;
#pragma unroll
                        for (int i = 0; i < 64; ++i) sacc += hp[i] * wc[i];
                        const int t = t0 + tg * 8 + q;
                        v[q] = sacc * expf(-((float)t / (float)L) * delta);
                        if (!(dir == 1 && t == 0)) asum += fabsf(v[q]); }
                    u32x4 w; w.x = cvt_pk_bf16(v[0], v[1]); w.y = cvt_pk_bf16(v[2], v[3]); w.z = cvt_pk_bf16(v[4], v[5]); w.w = cvt_pk_bf16(v[6], v[7]);
                    *(u32x4*)(dst + tg * 8) = w;
                }
                atomicAdd((float*)(ctl + CW_HYN) + (isc ? 1024 + o * 256 + c : (l * 2 + o) * 256 + c), asum);
            }
        }
        __syncthreads();
        for (int uq = bid; uq < 164; uq += G) { if (uq < 132) continue; const int u = uq - 132;
            const int l = u >> 4, g = u & 15;
            LAS float* PW = (LAS float*)lds;
            LAS float* BBs = PW + 2 * 64 * 17 * 2;
            LAS float* Cs = BBs + 2 * 64 * 16 * 2;
            LAS float* KT = Cs + 2 * 16 * 64 * 2;
            __syncthreads();
            if (tid < 128) {
                const int d = tid >> 6, p = tid & 63, idx = l * 2048 + (d * 16 + g) * 64 + p;
                const double ar = a.in[25][idx], ai = a.in[26][idx], dt = exp((double)a.in[27][l * 32 + d * 16 + g]);
                const double mag = exp(dt * ar), abr = mag * cos(dt * ai), abi = mag * sin(dt * ai), den = ar * ar + ai * ai;
                const double fr = ((abr - 1.0) * ar + abi * ai) / den, fi = (abi * ar - (abr - 1.0) * ai) / den;
                double pr = 1.0, pi = 0.0;
                for (int k = 0; k <= 16; ++k) { PW[((d * 64 + p) * 17 + k) * 2] = (float)pr; PW[((d * 64 + p) * 17 + k) * 2 + 1] = (float)pi; const double nr = pr * abr - pi * abi, ni = pr * abi + pi * abr; pr = nr; pi = ni; }
                float* a16 = (float*)(ws + WS_AB16) + ((size_t)((l * 2 + d) * 16 + g) * 64 + p) * 2;
                a16[0] = PW[((d * 64 + p) * 17 + 16) * 2]; a16[1] = PW[((d * 64 + p) * 17 + 16) * 2 + 1];
                for (int i = 0; i < 16; ++i) { const double br = a.in[28][(size_t)idx * 16 + i], bi = a.in[29][(size_t)idx * 16 + i];
                    BBs[((d * 64 + p) * 16 + i) * 2] = (float)(fr * br - fi * bi); BBs[((d * 64 + p) * 16 + i) * 2 + 1] = (float)(fr * bi + fi * br); }
            }
            for (int i = tid; i < 2048; i += 512) { const int d = i >> 10, o = (i >> 6) & 15, p = i & 63; const size_t ci = (size_t)l * 32768 + ((size_t)(d * 16 + g) * 16 + o) * 64 + p;
                Cs[i * 2] = a.in[30][ci]; Cs[i * 2 + 1] = a.in[31][ci]; }
            __syncthreads();
            for (int e = tid; e < 8192; e += 512) { const int d = e >> 12, k = (e >> 8) & 15, o = (e >> 4) & 15, i = e & 15;
                float acc = 0.f;
                for (int p = 0; p < 64; ++p) { const float cr = Cs[((d * 16 + o) * 64 + p) * 2], ci = Cs[((d * 16 + o) * 64 + p) * 2 + 1], pr = PW[((d * 64 + p) * 17 + k) * 2], pi = PW[((d * 64 + p) * 17 + k) * 2 + 1];
                    const float tr = cr * pr - ci * pi, ti = cr * pi + ci * pr;
                    acc += tr * BBs[((d * 64 + p) * 16 + i) * 2] - ti * BBs[((d * 64 + p) * 16 + i) * 2 + 1]; }
                KT[e] = acc; }
            __syncthreads();
            bf16_t* OPS = (bf16_t*)(ws + WS_OPS) + (size_t)(l * 16 + g) * 256 * 256;
            bf16_t* OPY = (bf16_t*)(ws + WS_OPY) + (size_t)(l * 16 + g) * 256 * 512;
            for (int e = tid; e < 256 * 32; e += 512) {
                const int row = e >> 5, c0 = (e & 31) * 8, d = row >> 7, p = (row >> 1) & 63, ri = row & 1, sx = c0 >> 4, i0 = c0 & 15, k = d == 0 ? 15 - sx : sx;
                const float pr = PW[((d * 64 + p) * 17 + k) * 2], pi = PW[((d * 64 + p) * 17 + k) * 2 + 1];
                float v[8];
#pragma unroll
                for (int j = 0; j < 8; ++j) { const float br = BBs[((d * 64 + p) * 16 + i0 + j) * 2], bi = BBs[((d * 64 + p) * 16 + i0 + j) * 2 + 1]; v[j] = ri == 0 ? pr * br - pi * bi : pr * bi + pi * br; }
                u32x4 w; w.x = cvt_pk_bf16(v[0], v[1]); w.y = cvt_pk_bf16(v[2], v[3]); w.z = cvt_pk_bf16(v[4], v[5]); w.w = cvt_pk_bf16(v[6], v[7]);
                *(u32x4*)(OPS + (size_t)row * 256 + c0) = w; }
            for (int e = tid; e < 256 * 64; e += 512) {
                const int row = e >> 6, c0 = (e & 63) * 8, t = row >> 4, o = row & 15;
                float v[8];
                if (c0 < 256) { const int sx = c0 >> 4, i0 = c0 & 15;
#pragma unroll
                    for (int j = 0; j < 8; ++j) { float x = 0.f; if (sx <= t) x += KT[((0 * 16 + (t - sx)) * 16 + o) * 16 + i0 + j]; if (sx >= t) x += KT[((1 * 16 + (sx - t)) * 16 + o) * 16 + i0 + j]; v[j] = x; } }
                else { const int c2 = c0 - 256, d = c2 >> 7, k = d == 0 ? t + 1 : 16 - t;
#pragma unroll
                    for (int j = 0; j < 8; ++j) { const int p = ((c2 + j) >> 1) & 63, ri = (c2 + j) & 1;
                        const float cr = Cs[((d * 16 + o) * 64 + p) * 2], ci = Cs[((d * 16 + o) * 64 + p) * 2 + 1], pr = PW[((d * 64 + p) * 17 + k) * 2], pi = PW[((d * 64 + p) * 17 + k) * 2 + 1];
                        v[j] = ri == 0 ? cr * pr - ci * pi : -(cr * pi + ci * pr); } }
                u32x4 w; w.x = cvt_pk_bf16(v[0], v[1]); w.y = cvt_pk_bf16(v[2], v[3]); w.z = cvt_pk_bf16(v[4], v[5]); w.w = cvt_pk_bf16(v[6], v[7]);
                *(u32x4*)(OPY + (size_t)row * 512 + c0) = w; }
        }
        __syncthreads();
        for (;;) {
            __syncthreads();
            if (tid == 0) MISC[16] = atomicAdd(ctl + CW_QUEUE, 4u);
            __syncthreads();
            const int base = (int)MISC[16];
            if (base >= JT_SMALL.total) break;
            convert_step(a, JT_SMALL, (LAS float*)lds, base, 1);
        }
        __syncthreads();
    }
    SEAM(0);

    for (int l = 0; l < 2; ++l) {
        const int P0 = 1 + l * NPH_LAYER;
        const float* MODL = MOD + (size_t)l * 5 * 6144;
        const unsigned char* WL = ws + WS_WL + (size_t)l * SZ_WL;
        const int nMrow = (l == 0) ? 68 : 64;
        const float* xlat = (l == 0) ? x_in : a.out; const float* xctx = (l == 0) ? ctx_in : XSC;

        if (((PHMASK >> 1) & 1) && l == 0 && IN(P0 + 0)) {
            const int lane = opaque(tid0) & 63;
            for (int r = bid * 8 + wave; r < RT; r += G * 8) {
                const float* src = r < RL ? x_in + (size_t)r * D : ctx_in + (size_t)(r - RL) * D;
                const float* mv = MODL + (size_t)(r < RL ? (r >> 12) : 4) * 6144;
                const RowV n = row_norm(row_load(src, lane));
                row_store_bf16(UB + (size_t)r * D, lane, row_modulate(n, mv, mv + 1024, lane));
            }
        }
        if (l == 0) SEAM(P0 + 0);

        if (((PHMASK >> 2) & 1) && IN(P0 + 1)) {
            const pg8::TabSched S{PARTS.p + l * 8, (const char*)ws, 2, 68 * 23 + 5 * 68, G, bid};
            pg8::EpiProj E{PR, PT, (bf16_t*)(ws + WS_US), 7, ws + WS_GQ};
            pg8::gemm_phase<1024, 1024>(lds, S, E);
        }
        SEAM(P0 + 1);
        if (((PHMASK >> 13) & 1) && IN(P0 + 2)) {
            const int tid = opaque(tid0), lane = tid & 63;
            LAS float* rp = (LAS float*)lds;
            for (int i = tid; i < 6 * 465; i += 512) rp[i] = a.in[24][l * 2790 + i];
            __syncthreads();
            LAS bf16_t* KW = (LAS bf16_t*)(lds + 11264);
            LAS bf16_t* CK = (LAS bf16_t*)(lds + 11264 + 576 * 144);
            LAS bf16_t* VW = (LAS bf16_t*)(lds + 11264);
            LAS bf16_t* CV = (LAS bf16_t*)(lds + 11264 + 64 * 1168);
            const int ngroups = 768 + (l == 0 ? 48 : 0);
            for (int gi0 = bid; gi0 < 768 + G; gi0 += G) {
                const int gi = gi0 < 768 ? gi0 : 768 + ((gi0 - 768 + G - 48) % G);
                if (gi >= ngroups) continue;
                const bool lat = gi < 768;
                const int combo = lat ? gi >> 5 : (gi - 768) >> 1, b = combo / 6, h = combo - 6 * b;
                const int v = lat ? ((gi & 31) << 3) + wave : (((gi - 768) & 1) << 3) + wave;
                const int r0g = (gi & 31) << 1, rs0 = r0g - 4 < 0 ? 0 : (r0g - 4 > 56 ? 56 : r0g - 4);
                const int ntokw = lat ? ((64 - rs0) < 9 ? (64 - rs0) : 9) * 64 : 0;
                __syncthreads();
                {   const int tid2 = opaque(tid);
#pragma unroll
                    for (int k = 0; k < 9; ++k) { const int c = tid2 + 512 * k, tok = c >> 3, part = c & 7;
                        if (tok < ntokw) *(LAS u32x4*)(KW + tok * 72 + part * 8) = *(const u32x4*)(PR + (size_t)(b * SEQ + rs0 * 64 + tok) * LDP + PC_K + h * 64 + part * 8); }
#pragma unroll
                    for (int k = 0; k < 4; ++k) { const int c = tid2 + 512 * k, tok = c >> 3, part = c & 7;
                        *(LAS u32x4*)(CK + tok * 72 + part * 8) = *(const u32x4*)(PR + (size_t)(RL + b * CTXL + tok) * LDP + PC_K + h * 64 + part * 8); } }
                __syncthreads();
                const int ln2 = opaque(lane), qn = ln2 & 15, g = ln2 >> 4;
                int r = 0, qb, tq, rs = 0, bs = 0, w = 0, cs = 0;
                if (lat) { qb = v & 3; r = v >> 2; rs = r - 4 < 0 ? 0 : (r - 4 > 56 ? 56 : r - 4); bs = qb == 0 ? 0 : (qb == 1 ? 8 : (qb == 2 ? 24 : 32));
                    w = 16 * qb + qn; cs = w - 8 < 0 ? 0 : (w - 8 > 48 ? 48 : w - 8); tq = b * SEQ + r * 64 + w; }
                else { qb = v; tq = RL + b * CTXL + 16 * qb + qn; }
                const int pr0 = rs - rs0;
                const bf16_t* qp = PR + (size_t)tq * LDP + PC_Q + h * 64 + 8 * g;
                const bf16x8 q0 = *(const bf16x8*)qp, q1 = *(const bf16x8*)(qp + 32);
                f32x4 S[32];
                const int koff = 8 * (qn >> 2) + (qn & 3);
                if (lat) {
#pragma unroll
                    for (int p = 0; p < 8; ++p)
#pragma unroll
                        for (int hf = 0; hf < 2; ++hf) { const LAS bf16_t* kp = KW + ((pr0 + p) * 64 + bs + koff + 4 * hf) * 72 + 8 * g;
                            const bf16x8 k0 = *(const LAS bf16x8*)kp, k1 = *(const LAS bf16x8*)(kp + 32);
                            f32x4 acc = {0.f, 0.f, 0.f, 0.f};
                            acc = __builtin_amdgcn_mfma_f32_16x16x32_bf16(k0, q0, acc, 0, 0, 0);
                            acc = __builtin_amdgcn_mfma_f32_16x16x32_bf16(k1, q1, acc, 0, 0, 0);
                            const int rowoff = (h * 15 + (rs + p - r + 7)) * 31;
#pragma unroll
                            for (int j = 0; j < 4; ++j) { const int c = bs + 8 * g + 4 * hf + j; const bool ok = (c >= cs) && (c < cs + 16);
                                const int dc = ok ? c - w + 15 : 0;
                                acc[j] = ok ? acc[j] * 0.125f + rp[rowoff + dc] : -3.0e38f; }
                            S[2 * p + hf] = acc; if (hf == 1 && (p & 1)) __builtin_amdgcn_sched_barrier(0); }
                } else {
#pragma unroll
                    for (int p = 0; p < 16; ++p) S[p] = (f32x4){-3.0e38f, -3.0e38f, -3.0e38f, -3.0e38f};
                }
#pragma unroll
                for (int p = 0; p < 8; ++p)
#pragma unroll
                    for (int hf = 0; hf < 2; ++hf) { const LAS bf16_t* kp = CK + (32 * p + koff + 4 * hf) * 72 + 8 * g;
                        const bf16x8 k0 = *(const LAS bf16x8*)kp, k1 = *(const LAS bf16x8*)(kp + 32);
                        f32x4 acc = {0.f, 0.f, 0.f, 0.f};
                        acc = __builtin_amdgcn_mfma_f32_16x16x32_bf16(k0, q0, acc, 0, 0, 0);
                        acc = __builtin_amdgcn_mfma_f32_16x16x32_bf16(k1, q1, acc, 0, 0, 0);
                        S[16 + 2 * p + hf] = acc * 0.125f; if (hf == 1 && (p & 1)) __builtin_amdgcn_sched_barrier(0); }
                float mx = -3.0e38f;
#pragma unroll
                for (int i = 0; i < 32; ++i) mx = fmaxf(fmaxf(mx, fmaxf(S[i][0], S[i][1])), fmaxf(S[i][2], S[i][3]));
                mx = fmaxf(mx, __shfl_xor(mx, 16)); mx = fmaxf(mx, __shfl_xor(mx, 32));
                float sum = 0.f;
#pragma unroll
                for (int i = 0; i < 32; ++i) {
#pragma unroll
                    for (int j = 0; j < 4; ++j) { const float e = __expf(S[i][j] - mx); S[i][j] = e; sum += e; } }
                sum += __shfl_xor(sum, 16); sum += __shfl_xor(sum, 32);
                const float inv = 1.0f / sum;
                __syncthreads();
                {   const int tid2 = opaque(tid);
#pragma unroll
                    for (int k = 0; k < 9; ++k) { const int c = tid2 + 512 * k, dd = c / 72, part = c - dd * 72;
                        if (part * 8 < ntokw) *(LAS u32x4*)(VW + dd * 584 + part * 8) = *(const u32x4*)(PT + (size_t)(PT_V + h * 64 + dd) * RT + b * SEQ + rs0 * 64 + part * 8); }
#pragma unroll
                    for (int k = 0; k < 4; ++k) { const int c = tid2 + 512 * k, dd = c >> 5, part = c & 31;
                        *(LAS u32x4*)(CV + dd * 264 + part * 8) = *(const u32x4*)(PT + (size_t)(PT_V + h * 64 + dd) * RT + RL + b * CTXL + part * 8); } }
                __syncthreads();
                f32x4 O[4];
#pragma unroll
                for (int dt = 0; dt < 4; ++dt) O[dt] = (f32x4){0.f, 0.f, 0.f, 0.f};
#pragma unroll
                for (int p = 0; p < 16; ++p) {
                    if (p < 8 && !lat) continue;
                    u32x4 pw; pw.x = cvt_pk_bf16(S[2 * p][0], S[2 * p][1]); pw.y = cvt_pk_bf16(S[2 * p][2], S[2 * p][3]); pw.z = cvt_pk_bf16(S[2 * p + 1][0], S[2 * p + 1][1]); pw.w = cvt_pk_bf16(S[2 * p + 1][2], S[2 * p + 1][3]);
                    bf16x8 pf; __builtin_memcpy(&pf, &pw, 16);
#pragma unroll
                    for (int dt = 0; dt < 4; ++dt) { const LAS bf16_t* vp = p < 8 ? VW + (16 * dt + qn) * 584 + (pr0 + p) * 64 + bs + 8 * g : CV + (16 * dt + qn) * 264 + 32 * (p - 8) + 8 * g;
                        O[dt] = __builtin_amdgcn_mfma_f32_16x16x32_bf16(*(const LAS bf16x8*)vp, pf, O[dt], 0, 0, 0); }
                    if (p & 1) __builtin_amdgcn_sched_barrier(0);
                }
                bf16_t* op = YB + (size_t)tq * YW + YC_C + h * 64 + 4 * g;
#pragma unroll
                for (int dt = 0; dt < 4; ++dt) { u32x2 o2; o2.x = cvt_pk_bf16(O[dt][0] * inv, O[dt][1] * inv); o2.y = cvt_pk_bf16(O[dt][2] * inv, O[dt][3] * inv); *(u32x2*)(op + 16 * dt) = o2; }
            }
            __syncthreads();
            {
                const int tid = opaque(tid0), lane = tid & 63;
                LAS float* XC = (LAS float*)lds;
                LAS f32x2* AB = (LAS f32x2*)(lds + 16 * 384 * 4);
                const float* cw = a.in[7] + l * 4 * 384; const float* cb = a.in[8] + l * 384;
                const bf16_t* LW = (const bf16_t*)(ws + WS_LW) + (size_t)l * 24 * 4096;
                bf16_t* LT = (bf16_t*)(ws + WS_LT); f32x2* LAGG = (f32x2*)(ws + WS_LAGG);
                const int dir = (wave >> 2) & 1, ntile = wave & 3, tk = lane & 15, kg = lane >> 4;
                LAS float* CT = (LAS float*)(lds + 16 * 384 * 4 + 2 * 16 * 384 * 8);
                for (int i = tid; i < 768; i += 512) { CT[i] = a.in[10][l * 768 + i]; CT[768 + i] = a.in[12][l * 768 + i]; CT[1536 + i] = -8.0f * softplus(-a.in[13][l * 768 + i]); }
                float cwv[60];
#pragma unroll
                for (int i = 0; i < 12; ++i) { const int idx = tid + 512 * i, ch = idx % 384;
                    cwv[5 * i] = cw[ch]; cwv[5 * i + 1] = cw[384 + ch]; cwv[5 * i + 2] = cw[768 + ch]; cwv[5 * i + 3] = cw[1152 + ch]; cwv[5 * i + 4] = cb[ch]; }
                PIN16(cwv); PIN16(cwv + 16); PIN16(cwv + 32); PIN8(cwv + 48); asm volatile("" : "+v"(cwv[56]), "+v"(cwv[57]), "+v"(cwv[58]), "+v"(cwv[59]));
                for (int n0 = bid; n0 < 1024 + G; n0 += G) {
                    const int n = n0 < 1024 ? n0 : 1024 + ((n0 - 1024 + G - 112) % G);
                    if (n >= NCHK) continue;
                    const int r0 = 16 * n; int start, len, pos0, bb; row_seq(r0, start, len, pos0, bb);
                    __syncthreads();
                    unsigned pin[48];
#pragma unroll
                    for (int i = 0; i < 12; ++i) { const int idx = tid + 512 * i, tok = idx / 384, ch = idx - tok * 384, pos = pos0 + tok;
                        const bf16_t* pr = PR + (size_t)(r0 + tok) * LDP + PC_AC + ch;
                        pin[4 * i + 0] = pos >= 2 ? pr[-2 * LDP] : 0; pin[4 * i + 1] = pos >= 1 ? pr[-LDP] : 0; pin[4 * i + 2] = pr[0]; pin[4 * i + 3] = pos + 1 < len ? pr[LDP] : 0; }
                    PIN16(pin); PIN16(pin + 16); PIN16(pin + 32);
#pragma unroll
                    for (int i = 0; i < 12; ++i) { const int idx = tid + 512 * i, tok = idx / 384, ch = idx - tok * 384;
                        XC[idx] = cwv[5 * i + 4] + cwv[5 * i] * bflo(pin[4 * i]) + cwv[5 * i + 1] * bflo(pin[4 * i + 1]) + cwv[5 * i + 2] * bflo(pin[4 * i + 2]) + cwv[5 * i + 3] * bflo(pin[4 * i + 3]); }
                    __syncthreads();
#pragma unroll 2
                    for (int g = 0; g < 6; ++g) {
                        bf16x8 wq[4];
#pragma unroll
                        for (int ks = 0; ks < 2; ++ks) { const bf16_t* wp = LW + ((size_t)((dir * 2 + 0) * 6 + g) * 64 + 16 * ntile + tk) * 64 + 32 * ks + 8 * kg; wq[2 * ks] = *(const bf16x8*)wp; wq[2 * ks + 1] = *(const bf16x8*)(wp + 6 * 4096); }
                        asm volatile("" : "+v"(wq[0]), "+v"(wq[1]), "+v"(wq[2]), "+v"(wq[3]));
                        f32x4 ar = {0.f, 0.f, 0.f, 0.f}, ai = {0.f, 0.f, 0.f, 0.f};
#pragma unroll
                        for (int ks = 0; ks < 2; ++ks) {
                            const LAS float* xp = XC + tk * 384 + g * 64 + 32 * ks + 8 * kg;
                            const f32x4 x0 = *(const LAS f32x4*)xp, x1 = *(const LAS f32x4*)(xp + 4);
                            u32x4 xw; xw.x = cvt_pk_bf16(x0[0], x0[1]); xw.y = cvt_pk_bf16(x0[2], x0[3]); xw.z = cvt_pk_bf16(x1[0], x1[1]); xw.w = cvt_pk_bf16(x1[2], x1[3]);
                            bf16x8 xf; __builtin_memcpy(&xf, &xw, 16);
                            ar = __builtin_amdgcn_mfma_f32_16x16x32_bf16(xf, wq[2 * ks], ar, 0, 0, 0);
                            ai = __builtin_amdgcn_mfma_f32_16x16x32_bf16(xf, wq[2 * ks + 1], ai, 0, 0, 0);
                        }
                        const int ch = g * 64 + 16 * ntile + tk;
                        const float br = CT[dir * 384 + ch], bi = CT[768 + dir * 384 + ch], sp8 = CT[1536 + dir * 384 + ch];
#pragma unroll
                        for (int j = 0; j < 4; ++j) { const int tok = 4 * kg + j;
                            const float la = sigm(ar[j] + br) * sp8, y = 2.0f * la;
                            const float av = 1.0f + la * (1.0f + la * (0.5f + la * (0.16666667f + la * (0.041666667f + la * 0.0083333333f))));
                            const float om = -y * (1.0f + y * (0.5f + y * (0.16666667f + y * (0.041666667f + y * (0.0083333333f + y * 0.0013888889f)))));
                            const float bt = __builtin_sqrtf(om) * sigm(ai[j] + bi) * XC[tok * 384 + ch];
                            AB[(dir * 16 + tok) * 384 + ch] = (f32x2){av, bt}; }
                    }
                    __syncthreads();
                    if (tid < 384) {
                        float hf = 0.f, pf = 1.f, hb = 0.f, pb = 1.f;
#pragma unroll
                        for (int t = 0; t < 16; ++t) {
                            const f32x2 f = AB[t * 384 + tid], bk = AB[(16 + 15 - t) * 384 + tid];
                            hf = f[0] * hf + f[1]; pf *= f[0]; hb = bk[0] * hb + bk[1]; pb *= bk[0];
                            AB[t * 384 + tid] = (f32x2){pf, hf}; AB[(16 + 15 - t) * 384 + tid] = (f32x2){pb, hb}; }
                        LAGG[((size_t)n * 2 + 0) * 384 + tid] = (f32x2){pf, hf}; LAGG[((size_t)n * 2 + 1) * 384 + tid] = (f32x2){pb, hb};
                    }
                    __syncthreads();
#pragma unroll
                    for (int i = 0; i < 12; ++i) { const int idx = tid + 512 * i, tok = idx / 384, ch = idx - tok * 384;
                        const f32x2 f = AB[idx], bk = AB[16 * 384 + idx];
                        bf16_t* o = LT + (size_t)(r0 + tok) * 1152 + ch;
                        o[0] = f2bf(f[1] + bk[1]); o[384] = f2bf(f[0]); o[768] = f2bf(bk[0]); }
                }
                __syncthreads();
            }
            {
                const int tid = opaque(tid0), lane = tid & 63;
                constexpr int ZS = SEQ + 16;
                LAS bf16_t* R0 = (LAS bf16_t*)lds;
                LAS bf16_t* R1 = R0 + 8224;
                LAS bf16_t* ZA = R1 + 8224;
                const LAS unsigned* Rdw = (const LAS unsigned*)lds;
#define HY_ZF(b, s) ((b) * ZS + ((s) & ~63) + (((((s) >> 3) & 7) ^ (((s) >> 7) & 1)) << 3) + ((s) & 7))
                const float* hcw = a.in[14] + l * 3 * 768; const float* hcb = a.in[15] + l * 768;
                const float* nrm = (const float*)(ctl + CW_HYN);
                bf16_t* YT = (bf16_t*)(ws + WS_YT);
                const int r32 = lane & 31, hh = lane >> 5, il = r32 >> 2, bq = r32 & 3, iblk = 8 * wave + il;
                const int x0b = 4095 - r32 + 8 * hh, par = x0b & 1;
                const int abase = (par ? 4112 : 0) + ((x0b - par) >> 1);
                for (int c = bid; c < 256; c += G) {
                    __syncthreads();
#pragma unroll 1
                    for (int it = tid; it < 3 * 4 * 512; it += 512) {
                        const int arr = it >> 11, b = (it >> 9) & 3, s8 = (it & 511) * 8, ch = arr * 256 + c;
                        const bf16_t* pp = PT + (size_t)ch * RT + b * SEQ + s8;
                        const u32x4 pv = *(const u32x4*)pp;
                        const float w0 = hcw[ch], w1 = hcw[768 + ch], w2 = hcw[1536 + ch], cb0 = hcb[ch];
                        float p[10];
                        p[0] = s8 > 0 ? bf2f(pp[-1]) : 0.f; p[9] = s8 + 8 < SEQ ? bf2f(pp[8]) : 0.f;
                        p[1] = bflo(pv.x); p[2] = bfhi(pv.x); p[3] = bflo(pv.y); p[4] = bfhi(pv.y); p[5] = bflo(pv.z); p[6] = bfhi(pv.z); p[7] = bflo(pv.w); p[8] = bfhi(pv.w);
                        float z[8];
#pragma unroll
                        for (int j = 0; j < 8; ++j) z[j] = cb0 + w0 * p[j] + w1 * p[j + 1] + w2 * p[j + 2];
                        u32x4 w; w.x = cvt_pk_bf16(z[0], z[1]); w.y = cvt_pk_bf16(z[2], z[3]); w.z = cvt_pk_bf16(z[4], z[5]); w.w = cvt_pk_bf16(z[6], z[7]);
                        *(LAS u32x4*)(ZA + arr * 4 * ZS + HY_ZF(b, s8)) = w;
                    }
#pragma unroll 1
                    for (int o = 0; o < 2; ++o) {
                        const bf16_t* kf = (const bf16_t*)(ws + WS_KFL) + ((size_t)((l * 2 + 0) * 2 + o) * 256 + c) * SEQ;
                        const bf16_t* kb = (const bf16_t*)(ws + WS_KFL) + ((size_t)((l * 2 + 1) * 2 + o) * 256 + c) * SEQ;
                        { unsigned tv[16];
#pragma unroll
                          for (int q = 0; q < 16; ++q) { const int x = tid + 512 * q; tv[q] = x < 4096 ? kf[4095 - x] : (x <= 8190 ? kb[x - 4095] : (bf16_t)0); }
                          PIN16(tv);
#pragma unroll
                          for (int q = 0; q < 16; ++q) R0[tid + 512 * q] = (bf16_t)tv[q]; }
                        __syncthreads();
                        for (int x = tid; x < 8192; x += 512) R1[x] = x < 8191 ? R0[x + 1] : (bf16_t)0;
                        __syncthreads();
                        const LAS bf16_t* Z = ZA + (o == 0 ? 0 : 4 * ZS) + bq * ZS;
                        typedef float f32x16 __attribute__((ext_vector_type(16)));
                        f32x16 acc0, acc1;
#pragma unroll
                        for (int q = 0; q < 16; ++q) { acc0[q] = 0.f; acc1[q] = 0.f; }
                        const int dlo = 8 * wave - 63, dhi = 8 * wave + 7;
#define HY_AF(dst, off_) do { const LAS unsigned* a_ = ap + (off_); u32x4 w_ = {a_[0], a_[1], a_[2], a_[3]}; __builtin_memcpy(&dst, &w_, 16); } while (0)
                        {
                            bf16x8 f16, f24;
                            { const LAS unsigned* ap = Rdw + abase - 32 * dlo; HY_AF(f16, 16); HY_AF(f24, 24); }
#pragma unroll 1
                            for (int dl = dlo; dl <= dhi; ++dl) {
                                const int j = iblk - dl; const bool ok = (j >= 0) && (j < 64); const int jc = j < 0 ? 0 : (j > 63 ? 63 : j);
                                const LAS bf16_t* zp = Z + jc * 64; const int sw = (jc >> 1) & 1;
                                const LAS unsigned* ap = Rdw + abase - 32 * dl;
                                bf16x8 bf[4], fm16, fm8, f0, f8;
#pragma unroll
                                for (int kk = 0; kk < 4; ++kk) { bf16x8 t = *(const LAS bf16x8*)(zp + (((2 * kk + hh) ^ sw) << 3)); bf[kk] = ok ? t : (bf16x8){0, 0, 0, 0, 0, 0, 0, 0}; }
                                HY_AF(fm16, -16); HY_AF(fm8, -8); HY_AF(f0, 0); HY_AF(f8, 8);
                                acc0 = __builtin_amdgcn_mfma_f32_32x32x16_bf16(f0, bf[0], acc0, 0, 0, 0);  acc1 = __builtin_amdgcn_mfma_f32_32x32x16_bf16(fm16, bf[0], acc1, 0, 0, 0);
                                acc0 = __builtin_amdgcn_mfma_f32_32x32x16_bf16(f8, bf[1], acc0, 0, 0, 0);  acc1 = __builtin_amdgcn_mfma_f32_32x32x16_bf16(fm8, bf[1], acc1, 0, 0, 0);
                                acc0 = __builtin_amdgcn_mfma_f32_32x32x16_bf16(f16, bf[2], acc0, 0, 0, 0); acc1 = __builtin_amdgcn_mfma_f32_32x32x16_bf16(f0, bf[2], acc1, 0, 0, 0);
                                acc0 = __builtin_amdgcn_mfma_f32_32x32x16_bf16(f24, bf[3], acc0, 0, 0, 0); acc1 = __builtin_amdgcn_mfma_f32_32x32x16_bf16(f8, bf[3], acc1, 0, 0, 0);
                                f16 = fm16; f24 = fm8;
                            }
                        }
#undef HY_AF
                        const float inv = 1.0f / (nrm[(l * 2 + o) * 256 + c] + 1e-6f), hb = a.in[23][(l * 2 + o) * 256 + c];
                        LAS bf16_t* GI = ZA + (o + 1) * 4 * ZS;
                        const LAS bf16_t* ZI = ZA + (o == 0 ? 0 : 4 * ZS);
#pragma unroll
                        for (int q = 0; q < 16; ++q) {
                            const int a0r = (q & 3) + 8 * (q >> 2) + 4 * hh, t0 = 64 * iblk + a0r, t1 = t0 + 32;
                            const int i0 = HY_ZF(bq, t0), i1 = HY_ZF(bq, t1);
                            const float zv0 = bf2f(ZI[i0]), zv1 = bf2f(ZI[i1]);
                            const float y0 = bf2f(GI[i0]) * (acc0[q] * inv + hb * zv0), y1v = bf2f(GI[i1]) * (acc1[q] * inv + hb * zv1);
                            GI[i0] = f2bf(y0); GI[i1] = f2bf(y1v);
                        }
                        __syncthreads();
                    }
                    for (int it = tid; it < 4 * 512; it += 512) { const int b = it >> 9, s8 = (it & 511) * 8;
                        *(u32x4*)(YT + (size_t)c * RT + b * SEQ + s8) = *(const LAS u32x4*)(ZA + 2 * 4 * ZS + HY_ZF(b, s8)); }
                    if (l == 0) {
                        __syncthreads();
                        LAS float* zc = (LAS float*)lds;
                        LAS float* kc = zc + 3072;
                        LAS float* y1c = kc + 1024;
                        for (int it = tid; it < 3072; it += 512) { const int arr = it >> 10, b = (it >> 8) & 3, sx = it & 255, ch = arr * 256 + c;
                            const bf16_t* pp = PT + (size_t)ch * RT + RL + b * CTXL + sx;
                            float z = hcb[ch] + hcw[768 + ch] * bf2f(pp[0]); if (sx > 0) z += hcw[ch] * bf2f(pp[-1]); if (sx + 1 < CTXL) z += hcw[1536 + ch] * bf2f(pp[1]);
                            zc[it] = z; }
                        for (int it = tid; it < 1024; it += 512) { const int o = it >> 9, d = (it & 511) - 256;
                            const bf16_t* kfc = (const bf16_t*)(ws + WS_KFC) + ((size_t)(0 * 2 + o) * 256 + c) * CTXL; const bf16_t* kbc = (const bf16_t*)(ws + WS_KFC) + ((size_t)(1 * 2 + o) * 256 + c) * CTXL;
                            kc[it] = d >= 0 ? bf2f(kfc[d]) : (d > -256 ? bf2f(kbc[-d]) : 0.f); }
                        __syncthreads();
#pragma unroll 1
                        for (int o = 0; o < 2; ++o) {
                            const float inv = 1.0f / (nrm[1024 + o * 256 + c] + 1e-6f), hb = a.in[23][o * 256 + c];
                            for (int it = tid; it < 1024; it += 512) { const int b = it >> 8, t = it & 255;
                                const LAS float* zi = o == 0 ? zc + b * 256 : y1c + b * 256;
                                const LAS float* kk = kc + o * 512 + 256 + t;
                                float acc = 0.f;
#pragma unroll 16
                                for (int sx = 0; sx < CTXL; ++sx) acc += kk[-sx] * zi[sx];
                                const float y = zc[(o + 1) * 1024 + b * 256 + t] * (acc * inv + hb * zi[t]);
                                if (o == 0) y1c[it] = y; else YT[(size_t)c * RT + RL + b * CTXL + t] = f2bf(y); }
                            __syncthreads();
                        }
                    }
                }
#undef HY_ZF
                __syncthreads();
            }
            {
                const pg8::TabSched S{PARTS.p + 18 + l * 3, (const char*)ws, 1, 80, G, (bid + 80) % G};
                pg8::EpiS5State E{(float*)(ws + WS_S5S)};
                pg8::gemm_phase<512, 256>(lds, S, E);
            }
        }
        SEAM(P0 + 2);
        if (((PHMASK >> 14) & 1) && IN(P0 + 3)) {
            const int tid = opaque(tid0), lane = tid & 63;
            LAS float* st = (LAS float*)lds;
            const float* S5S = (const float*)(ws + WS_S5S); bf16_t* US = (bf16_t*)(ws + WS_US);
            for (int u = bid; u < 128; u += G) {
                const int d = u & 1, g = (u >> 1) & 15, b = u >> 5;
                __syncthreads();
                for (int i = tid; i < 272 * 32; i += 512) { const int q = i >> 5, c4 = (i & 31) * 4; const int n = q < 16 ? 1024 + 16 * b + q : 256 * b + (q - 16);
                    const f32x4 v = *(const f32x4*)(S5S + ((size_t)g * NCHKP + n) * 256 + d * 128 + c4);
                    st[q * 128 + c4] = v[0]; st[q * 128 + c4 + 1] = v[1]; st[q * 128 + c4 + 2] = v[2]; st[q * 128 + c4 + 3] = v[3]; }
                __syncthreads();
                if (wave == 0) {
                    const float* ab = (const float*)(ws + WS_AB16) + ((size_t)((l * 2 + d) * 16 + g) * 64 + lane) * 2;
                    const float ar = ab[0], ai = ab[1];
                    float hr = 0.f, hi = 0.f;
#pragma unroll 1
                    for (int k0 = 0; k0 < 272; k0 += 8) {
                        f32x2 sv[8]; int nn[8];
#pragma unroll
                        for (int j = 0; j < 8; ++j) { const int k = k0 + j; const int q = d == 0 ? k : (k < 16 ? 15 - k : 287 - k);
                            nn[j] = q < 16 ? 1024 + 16 * b + q : 256 * b + (q - 16); sv[j] = *(const LAS f32x2*)(st + q * 128 + 2 * lane); }
#pragma unroll
                        for (int j = 0; j < 8; ++j) {
                            *(unsigned*)(US + ((size_t)g * NCHKP + nn[j]) * 512 + 256 + d * 128 + 2 * lane) = cvt_pk_bf16(hr, hi);
                            const float nr = ar * hr - ai * hi + sv[j][0], ni = ar * hi + ai * hr + sv[j][1];
                            hr = nr; hi = ni; }
                    }
                }
            }
            __syncthreads();
            for (int uq = bid; uq < 176; uq += G) { if (uq < 128) continue; const int u = uq - 128;
                const int cb6 = u % 6, d = (u / 6) & 1, b = u / 12;
                LAS f32x2* sa = (LAS f32x2*)lds;
                const f32x2* LAGG = (const f32x2*)(ws + WS_LAGG); float* HIN = (float*)(ws + WS_LHIN);
                __syncthreads();
                for (int i = tid; i < 272 * 64; i += 512) { const int q = i >> 6, c = i & 63; const int n = q < 16 ? 1024 + 16 * b + q : 256 * b + (q - 16);
                    sa[i] = LAGG[((size_t)n * 2 + d) * 384 + cb6 * 64 + c]; }
                __syncthreads();
                if (wave == 0) {
                    float h = 0.f;
#pragma unroll 1
                    for (int k0 = 0; k0 < 272; k0 += 8) {
                        f32x2 sv[8]; int nn[8];
#pragma unroll
                        for (int j = 0; j < 8; ++j) { const int k = k0 + j; const int q = d == 0 ? k : (k < 16 ? 15 - k : 287 - k);
                            nn[j] = q < 16 ? 1024 + 16 * b + q : 256 * b + (q - 16); sv[j] = sa[q * 64 + lane]; }
#pragma unroll
                        for (int j = 0; j < 8; ++j) { HIN[((size_t)nn[j] * 2 + d) * 384 + cb6 * 64 + lane] = h; h = sv[j][0] * h + sv[j][1]; }
                    }
                }
            }
            __syncthreads();
        }
        SEAM(P0 + 3);
        if (((PHMASK >> 15) & 1) && IN(P0 + 4)) {
            const pg8::TabSched S{PARTS.p + 19 + l * 3, (const char*)ws, 1, 80, G, bid};
            pg8::EpiS5Main E{(bf16_t*)(ws + WS_GL), PR, a.in[32] + l * 256};
            pg8::gemm_phase<512, 512>(lds, S, E);
            {
                const int tid = opaque(tid0);
                const bf16_t* YT = (const bf16_t*)(ws + WS_YT);
                LAS bf16_t* tl = (LAS bf16_t*)lds;
                const int nrt = nMrow * 4;
                const int nb0 = G > 160 ? 80 : 0, vb = bid - nb0, vG = G - nb0;
                if (vb >= 0) for (int t = vb; t < 4 * nrt; t += vG) {
                    const int c0 = (t & 3) * 64, r0 = (t >> 2) * 64;
                    __syncthreads();
                    { const int cc = tid >> 3, r8 = (tid & 7) * 8; *(LAS u32x4*)(tl + cc * 72 + r8) = *(const u32x4*)(YT + (size_t)(c0 + cc) * RT + r0 + r8); }
                    __syncthreads();
                    { const int rr = tid >> 3, c8 = (tid & 7) * 8; unsigned short e[8];
#pragma unroll
                        for (int j = 0; j < 8; ++j) e[j] = tl[(c8 + j) * 72 + rr];
                        u32x4 w; w.x = e[0] | ((unsigned)e[1] << 16); w.y = e[2] | ((unsigned)e[3] << 16); w.z = e[4] | ((unsigned)e[5] << 16); w.w = e[6] | ((unsigned)e[7] << 16);
                        *(u32x4*)(YB + (size_t)(r0 + rr) * YW + YC_B + c0 + c8) = w; }
                }
                __syncthreads();
            }
            {
                const int tid = opaque(tid0);
                const bf16_t* LT = (const bf16_t*)(ws + WS_LT); const float* HIN = (const float*)(ws + WS_LHIN);
                const int nrows = nMrow * 256;
                const int nb0 = G > 160 ? 80 : 0, vb = bid - nb0, vG = G - nb0;
                if (vb >= 0) for (int it = vb * 512 + tid; it < nrows * 48; it += vG * 512) {
                    const int r = it / 48, c8 = (it - r * 48) * 8, n = r >> 4;
                    const u32x4 gt = *(const u32x4*)(PR + (size_t)r * LDP + PC_AG + c8);
                    const bf16_t* lt = LT + (size_t)r * 1152 + c8;
                    const u32x4 sv = *(const u32x4*)lt, pf = *(const u32x4*)(lt + 384), pb = *(const u32x4*)(lt + 768);
                    const float* hf = HIN + ((size_t)n * 2 + 0) * 384 + c8; const float* hb = hf + 384;
                    const f32x4 hf0 = *(const f32x4*)hf, hf1 = *(const f32x4*)(hf + 4), hb0 = *(const f32x4*)hb, hb1 = *(const f32x4*)(hb + 4);
                    u32x4 w;
                    w.x = cvt_pk_bf16(gelu_f(bflo(gt.x)) * (bflo(sv.x) + bflo(pf.x) * hf0[0] + bflo(pb.x) * hb0[0]), gelu_f(bfhi(gt.x)) * (bfhi(sv.x) + bfhi(pf.x) * hf0[1] + bfhi(pb.x) * hb0[1]));
                    w.y = cvt_pk_bf16(gelu_f(bflo(gt.y)) * (bflo(sv.y) + bflo(pf.y) * hf0[2] + bflo(pb.y) * hb0[2]), gelu_f(bfhi(gt.y)) * (bfhi(sv.y) + bfhi(pf.y) * hf0[3] + bfhi(pb.y) * hb0[3]));
                    w.z = cvt_pk_bf16(gelu_f(bflo(gt.z)) * (bflo(sv.z) + bflo(pf.z) * hf1[0] + bflo(pb.z) * hb1[0]), gelu_f(bfhi(gt.z)) * (bfhi(sv.z) + bfhi(pf.z) * hf1[1] + bfhi(pb.z) * hb1[1]));
                    w.w = cvt_pk_bf16(gelu_f(bflo(gt.w)) * (bflo(sv.w) + bflo(pf.w) * hf1[2] + bflo(pb.w) * hb1[2]), gelu_f(bfhi(gt.w)) * (bfhi(sv.w) + bfhi(pf.w) * hf1[3] + bfhi(pb.w) * hb1[3]));
                    *(u32x4*)(YB + (size_t)r * YW + YC_A + c8) = w;
                }
            }
        }
        SEAM(P0 + 4);
        if (((PHMASK >> 15) & 1) && IN(P0 + 5)) {
            const pg8::TabSched S{PARTS.p + 20 + l * 3, (const char*)ws, 1, nMrow, G, bid};
            pg8::EpiS5Glu E{YB, (const bf16_t*)(ws + WS_GL), a.in[34] + l * 256};
            pg8::gemm_phase<256, 256>(lds, S, E);
        }
        SEAM(P0 + 5);
        if (((PHMASK >> 3) & 1) && IN(P0 + 6)) {
            const pg8::MergeSched S{(const char*)ws, (long long)WS_YB, (long long)(WS_WL + (size_t)l * SZ_WL + SZ_WINR + SZ_WINHY), 64, G, bid, l == 0 ? 64 : 0};
            pg8::EpiGate E{ws + WS_GQ, UB, (bf16_t*)(ws + WS_MGC)};
            pg8::gemm_phase<1280, 1280>(lds, S, E);
        }
        SEAM(P0 + 6);
        if (((PHMASK >> 4) & 1) && IN(P0 + 7)) {
            const pg8::TabSched S{l == 0 ? PARTS.p + 24 : PARTS.p + 14, (const char*)ws, l == 0 ? 2 : 1, l == 0 ? 256 + 64 : 256, G, bid};
            pg8::EpiRes E{PRE, xlat, xctx, MODL + 2048, (float*)(ws + WS_EXTRA)};
            pg8::gemm_phase<1024, 1024>(lds, S, E);
        }
        SEAM(P0 + 7);
        if (((PHMASK >> 5) & 1) && IN(P0 + 8)) {
            const int lane = opaque(tid0) & 63;
            if (l == 1) convert_tiles_pipelined(a, JT_MOE, (LAS float*)lds, bid, G);
            const float* lg = a.in[40] + l * D; const float* lb = a.in[41] + l * D;
            const int nrows = nMrow * 256;
            for (int r = bid * 8 + wave; r < nrows; r += G * 8) {
                const float* mv = MODL + (size_t)(r < RL ? (r >> 12) : 4) * 6144;
                RowV pre;
                if (r < RL) { const RowV xin = row_load(xlat + (size_t)r * D, lane), ga = row_load_bf16((const bf16_t*)PRE + (size_t)r * D, lane);
#pragma unroll
                    for (int i = 0; i < 4; ++i) pre.v[i] = xin.v[i] * ALPHA + ga.v[i]; }
                else { const float* pp = (const float*)(ws + WS_EXTRA) + (size_t)(r - RL) * D; const RowV xin = row_load(ctx_in + (size_t)(r - RL) * D, lane), p0 = row_load(pp, lane), p1 = row_load(pp + (size_t)RC * D, lane), p2 = row_load(pp + (size_t)2 * RC * D, lane), p3 = row_load(pp + (size_t)3 * RC * D, lane);
#pragma unroll
                    for (int i = 0; i < 4; ++i) pre.v[i] = xin.v[i] * ALPHA + ((p0.v[i] + p1.v[i]) + (p2.v[i] + p3.v[i])); }
                const RowV x1 = row_affine(row_norm(pre), lg, lb, lane);
                row_store(r < RL ? a.out + (size_t)r * D : XSC + (size_t)(r - RL) * D, lane, x1);
                const RowV u2 = row_modulate(row_norm(x1), mv + 3072, mv + 4096, lane);
                row_store_bf16(UB + (size_t)r * D, lane, u2);
                if (l == 1) {
                    float lg8[8];
#pragma unroll
                    for (int e = 0; e < 8; ++e) lg8[e] = 0.f;
                    f32x4 rw[32];
#pragma unroll
                    for (int q = 0; q < 16; ++q) { const float* wp = a.in[47] + (size_t)(256 * (q >> 2) + 4 * lane + (q & 3)) * 8; rw[2 * q] = *(const f32x4*)wp; rw[2 * q + 1] = *(const f32x4*)(wp + 4); }
                    PIN16(rw); PIN16(rw + 16);
#pragma unroll
                    for (int i = 0; i < 4; ++i)
#pragma unroll
                        for (int j = 0; j < 4; ++j) { const float uv = u2.v[i][j];
                            const f32x4 w0 = rw[2 * (4 * i + j)], w1 = rw[2 * (4 * i + j) + 1];
                            lg8[0] += uv * w0[0]; lg8[1] += uv * w0[1]; lg8[2] += uv * w0[2]; lg8[3] += uv * w0[3]; lg8[4] += uv * w1[0]; lg8[5] += uv * w1[1]; lg8[6] += uv * w1[2]; lg8[7] += uv * w1[3]; }
#pragma unroll
                    for (int e = 0; e < 8; ++e) lg8[e] = wave_sum(lg8[e]);
                    if (lane == 0) {
                        int i1 = 0; float v1 = lg8[0];
#pragma unroll
                        for (int e = 1; e < 8; ++e) if (lg8[e] > v1) { v1 = lg8[e]; i1 = e; }
                        int i2 = 0; float v2 = -3.0e38f;
#pragma unroll
                        for (int e = 0; e < 8; ++e) if (e != i1 && lg8[e] > v2) { v2 = lg8[e]; i2 = e; }
                        const float e2 = expf(v2 - v1), w1 = 1.f / (1.f + e2), w2 = e2 / (1.f + e2);
                        int* tk = (int*)(ws + WS_TOK) + (size_t)r * 8;
                        tk[0] = i1; tk[1] = i2; ((float*)tk)[2] = w1; ((float*)tk)[3] = w2;
                        tk[4] = (int)atomicAdd(ctl + CW_MOECNT + 64 * i1, 1u); tk[5] = (int)atomicAdd(ctl + CW_MOECNT + 64 * i2, 1u);
                    }
                }
            }
        }
        SEAM(P0 + 8);
        if (l == 0) {
            if (((PHMASK >> 6) & 1) && IN(P0 + 9)) {
                const pg8::TabSched S{PARTS.p + 16, (const char*)ws, 1, 68 * 22, G, bid};
                pg8::EpiSwiglu E{(bf16_t*)(ws + WS_H), FF_DENSE, 0};
                pg8::gemm_phase<1024, 1024>(lds, S, E);
            }
            SEAM(P0 + 9);
            if (((PHMASK >> 7) & 1) && IN(P0 + 10)) {
                const pg8::TabSched S{PARTS.p + 26, (const char*)ws, 3, 256 + 48 + 16, G, bid};
                pg8::EpiRes E{PRE, a.out, XSC, MODL + 5120, (float*)(ws + WS_EXTRA)};
                pg8::gemm_phase<FF_DENSE, FF_DENSE>(lds, S, E);
            }
            SEAM(P0 + 10);
            if (((PHMASK >> 8) & 1) && IN(P0 + 11)) {
                const int lane = opaque(tid0) & 63;
                const float* lg = a.in[42]; const float* lb = a.in[43];
                const float* MODN = MOD + (size_t)5 * 6144;
                for (int r = bid * 8 + wave; r < RT; r += G * 8) {
                    const float* mv = MODN + (size_t)(r < RL ? (r >> 12) : 4) * 6144;
                    RowV pre;
                    if (r < RL) { const RowV xin = row_load(a.out + (size_t)r * D, lane), ga = row_load_bf16((const bf16_t*)PRE + (size_t)r * D, lane);
#pragma unroll
                        for (int i = 0; i < 4; ++i) pre.v[i] = xin.v[i] * ALPHA + ga.v[i]; }
                    else { const float* pp = (const float*)(ws + WS_EXTRA) + (size_t)(r - RL) * D; const RowV xin = row_load(XSC + (size_t)(r - RL) * D, lane), p0 = row_load(pp, lane), p1 = row_load(pp + (size_t)RC * D, lane), p2 = row_load(pp + (size_t)2 * RC * D, lane), p3 = row_load(pp + (size_t)3 * RC * D, lane);
#pragma unroll
                        for (int i = 0; i < 4; ++i) pre.v[i] = xin.v[i] * ALPHA + ((p0.v[i] + p1.v[i]) + (p2.v[i] + p3.v[i])); }
                    const RowV x2 = row_affine(row_norm(pre), lg, lb, lane);
                    row_store(r < RL ? a.out + (size_t)r * D : XSC + (size_t)(r - RL) * D, lane, x2);
                    row_store_bf16(UB + (size_t)r * D, lane, row_modulate(row_norm(x2), mv, mv + 1024, lane));
                }
            }
            SEAM(P0 + 11);
        } else {
            bf16_t* AG = (bf16_t*)(ws + WS_AG); float* slotw = (float*)(ws + WS_SLOTW); int* tile_e = (int*)(ws + WS_TILEE);
            if (((PHMASK >> 9) & 1) && IN(P0 + 9)) {
                const int tid = opaque(tid0), lane = tid & 63;
                int ts[NE + 1]; ts[0] = 0;
#pragma unroll
                for (int e = 0; e < NE; ++e) { const unsigned c = __hip_atomic_load(ctl + CW_MOECNT + 64 * e, __ATOMIC_RELAXED, __HIP_MEMORY_SCOPE_AGENT); ts[e + 1] = ts[e] + (int)((c + 255u) >> 8); }
                if (bid == 0) for (int mt = tid; mt < ts[NE]; mt += 512) { int e = 0;
#pragma unroll
                    for (int k = 1; k < NE; ++k) e += (mt >= ts[k]) ? 1 : 0;
                    tile_e[mt] = e; }
                for (int r = bid * 8 + wave; r < RL; r += G * 8) {
                    int* tk = (int*)(ws + WS_TOK) + (size_t)r * 8;
                    const u32x4 v0 = *(const u32x4*)(UB + (size_t)r * D + lane * 16), v1 = *(const u32x4*)(UB + (size_t)r * D + lane * 16 + 8);
#pragma unroll
                    for (int k = 0; k < 2; ++k) {
                        const int e = tk[k], pos = tk[4 + k];
                        int st = 0;
#pragma unroll
                        for (int q = 0; q < NE; ++q) st = (e == q) ? ts[q] : st;
                        const int srow = st * 256 + pos;
                        *(u32x4*)(AG + (size_t)srow * D + lane * 16) = v0; *(u32x4*)(AG + (size_t)srow * D + lane * 16 + 8) = v1;
                        if (lane == 0) { slotw[srow] = ((const float*)tk)[2 + k]; tk[6 + k] = srow; }
                    }
                }
            }
            SEAM(P0 + 9);
            int ttl = 0;
            if (lo <= P0 + 13 && P0 + 10 < hi) {
#pragma unroll
                for (int e = 0; e < NE; ++e) { const unsigned c = __hip_atomic_load(ctl + CW_MOECNT + 64 * e, __ATOMIC_RELAXED, __HIP_MEMORY_SCOPE_AGENT); ttl += (int)((c + 255u) >> 8); }
                ttl = __builtin_amdgcn_readfirstlane(ttl);
            }
#pragma unroll
            for (int pass = 0; pass < 2; ++pass) {
                const int tile0 = pass * MOE_P0; int ntile = pass == 0 ? (ttl < MOE_P0 ? ttl : MOE_P0) : ttl - MOE_P0; ntile = ntile < 0 ? 0 : (ntile > MOE_HCAP ? MOE_HCAP : ntile);
                if (((PHMASK >> 10) & 1) && IN(P0 + 10 + 2 * pass)) {
                    const pg8::MoeSched S{(const char*)AG + (size_t)tile0 * 256 * 1024 * 2, (const char*)(ws + WS_MOEGU), tile_e, 256u * 1024u * 2u, 256u * 1024u * 2u, (size_t)2 * FF_E * 1024 * 2, 28, 16, tile0, ntile, G, bid};
                    pg8::EpiSwiglu E{(bf16_t*)(ws + WS_HM), FF_E, tile0};
                    pg8::gemm_phase<1024, 1024>(lds, S, E);
                }
                SEAM(P0 + 10 + 2 * pass);
                if (((PHMASK >> 11) & 1) && IN(P0 + 11 + 2 * pass)) {
                    pg8::EpiMoeDown E{AG, slotw, (float*)(ws + WS_O2X)};
                    { const int nfull = pass == 0 ? ntile : (ttl < 128 ? ttl : 128) - MOE_P0, nex = pass == 0 ? 0 : ttl - 128;
                        const pg8::MoeTailSched S{(const char*)(ws + WS_HM), (const char*)(ws + WS_MOED), tile_e, tile0, nfull < 0 ? 0 : nfull, nex < 0 ? 0 : nex, G, bid};
                        pg8::gemm_phase<FF_E, FF_E>(lds, S, E); }
                }
                SEAM(P0 + 11 + 2 * pass);
            }
            if (((PHMASK >> 12) & 1) && IN(P0 + 14)) {
                const int lane = opaque(tid0) & 63;
                const float* lg = a.in[42] + D; const float* lb = a.in[43] + D;
                for (int r = bid * 8 + wave; r < RL; r += G * 8) {
                    const int* tk = (const int*)(ws + WS_TOK) + (size_t)r * 8;
                    const int sa = tk[6], sb = tk[7];
                    const bf16_t* oa = AG + (size_t)sa * D; const bf16_t* ob = AG + (size_t)sb * D;
                    const float* gv = MODL + (size_t)(r >> 12) * 6144 + 5120;
                    RowV x1 = row_load(a.out + (size_t)r * D, lane), gq = row_load(gv, lane), pre;
                    u32x2 va[4], vb[4];
#pragma unroll
                    for (int i = 0; i < 4; ++i) { va[i] = *(const u32x2*)(oa + 256 * i + 4 * lane); vb[i] = *(const u32x2*)(ob + 256 * i + 4 * lane); }
                    asm volatile("" : "+v"(va[0]), "+v"(va[1]), "+v"(va[2]), "+v"(va[3]), "+v"(vb[0]), "+v"(vb[1]), "+v"(vb[2]), "+v"(vb[3]), "+v"(x1.v[0]), "+v"(x1.v[1]), "+v"(x1.v[2]), "+v"(x1.v[3]), "+v"(gq.v[0]), "+v"(gq.v[1]), "+v"(gq.v[2]), "+v"(gq.v[3]));
#pragma unroll
                    for (int i = 0; i < 4; ++i) {
                        f32x4 fa = {bflo(va[i].x), bfhi(va[i].x), bflo(va[i].y), bfhi(va[i].y)}, fb = {bflo(vb[i].x), bfhi(vb[i].x), bflo(vb[i].y), bfhi(vb[i].y)};
                        if (sa >= 128 * 256) { const float* px = (const float*)(ws + WS_O2X) + (size_t)(sa - 128 * 256) * D + 256 * i + 4 * lane; fa = (*(const f32x4*)px + *(const f32x4*)(px + (size_t)2048 * D)) + (*(const f32x4*)(px + (size_t)2 * 2048 * D) + *(const f32x4*)(px + (size_t)3 * 2048 * D)); }
                        if (sb >= 128 * 256) { const float* px = (const float*)(ws + WS_O2X) + (size_t)(sb - 128 * 256) * D + 256 * i + 4 * lane; fb = (*(const f32x4*)px + *(const f32x4*)(px + (size_t)2048 * D)) + (*(const f32x4*)(px + (size_t)2 * 2048 * D) + *(const f32x4*)(px + (size_t)3 * 2048 * D)); }
                        pre.v[i] = x1.v[i] * ALPHA + gq.v[i] * (fa + fb); }
                    row_store(a.out + (size_t)r * D, lane, row_affine(row_norm(pre), lg, lb, lane));
                }
            }
        }
    }
#undef IN
#undef SEAM
}

}

extern "C" void kernel_launch(void* const* d_in, const int* in_sizes, int n_in, void* d_out, int out_size, void* d_ws, size_t ws_size, hipStream_t stream) {
    static int grid = 0;
    if (grid == 0) {
        if (n_in != 51 || ws_size < WS_END) { grid = -1; return; }
        int dev = 0, cus = 0;
        if (hipGetDevice(&dev) != hipSuccess || hipDeviceGetAttribute(&cus, hipDeviceAttributeMultiprocessorCount, dev) != hipSuccess) { grid = -1; return; }
        if (hipFuncSetAttribute((const void*)mk_fwd, hipFuncAttributeMaxDynamicSharedMemorySize, LDS_BYTES) != hipSuccess) { grid = -1; return; }
        grid = cus;
    }
    if (grid < 0) return;
    const float* const* in = (const float* const*)d_in;
    unsigned char* ws = (unsigned char*)d_ws;
    (void)hipMemsetAsync(ws + WS_CTL, 0, CTL_BYTES + al256(2 * 5 * 6144 * 4), stream);
    for (int l = 0; l < 2; ++l) (void)hipMemsetAsync(ws + WS_WL + (size_t)l * SZ_WL + SZ_WINR + (size_t)1152 * 1024 * 2, 0, (size_t)128 * 1024 * 2, stream);
    Args a{};
    for (int i = 0; i < 51; ++i) a.in[i] = in[i];
    a.out = (float*)d_out; a.ws = ws;
    int nlaunch = 0;
    auto run1 = [&](int lo, int hi) { a.ph_lo = lo; a.ph_hi = hi; a.bar_region = nlaunch < 5 ? nlaunch : 5; nlaunch++; hipLaunchKernelGGL(mk_fwd, dim3(grid), dim3(512), LDS_BYTES, stream, a); };
    auto run = [&](int lo, int hi) {
#if defined(SPLIT) && SPLIT
        for (int k = lo; k < hi; ++k) { const int q = (k - 1) % NPH_LAYER, l = (k - 1) / NPH_LAYER; if (k > 0 && (q > 14 || (l == 0 && q > 11) || (l == 1 && q == 0))) continue; run1(k, k + 1); }
#else
        run1(lo, hi);
#endif
    };
    run(0, 1 + 2 * NPH_LAYER);
}
```

```cpp
#include <hip/hip_runtime.h>
#include <stdint.h>
#include <math.h>

#define LAS __attribute__((address_space(3)))
typedef unsigned short bf16_t;
typedef short bf16x8 __attribute__((ext_vector_type(8)));
typedef float f32x4 __attribute__((ext_vector_type(4)));
typedef float f32x2 __attribute__((ext_vector_type(2)));
typedef unsigned u32x4 __attribute__((ext_vector_type(4)));
typedef unsigned u32x2 __attribute__((ext_vector_type(2)));

namespace {
constexpr int D = 1024, NB = 4, SEQ = 4096, CTXL = 256;
constexpr int RL = NB * SEQ, RC = NB * CTXL, RT = RL + RC;
constexpr int IN_COLS = 7040;
constexpr int FF_DENSE = 2816, NE = 8, FF_E = 3584;
constexpr float ALPHA = 1.41421356237309515f;
constexpr int LDP = 1792, PC_AG = 0, PC_AC = 384, PC_D = 768, PC_Q = 1024, PC_K = 1408, PC_G = 1792;
constexpr int NPT = 1280, PT_V = 768;
constexpr int YW = 1280, YC_A = 0, YC_B = 384, YC_C = 640, YC_D = 1024;
constexpr int MOE_P0 = 64, MOE_HCAP = 72;
constexpr int MOE_ROWS_MAX = 2 * RL + NE * 256;

constexpr size_t al256(size_t x) { return (x + 255) & ~(size_t)255; }
constexpr size_t WS_CTL = 0, CTL_BYTES = 131072;
constexpr int CW_BAR = 0;
constexpr int CW_MOECNT = 24576;
constexpr int CW_QUEUE = 28672;
constexpr int CW_HYN = 29696;
constexpr size_t WS_MOD = WS_CTL + CTL_BYTES;
constexpr size_t WS_HYN = WS_MOD + al256(2 * 5 * 6144 * 4);
constexpr size_t WS_S5AB = WS_HYN + 4096;
constexpr size_t WS_S5BB = WS_S5AB + 16384;
constexpr size_t WS_AB16 = WS_S5BB + 262144;
constexpr size_t WS_TILEE = WS_AB16 + 32768;
constexpr size_t WS_TOK = WS_TILEE + 1024;
constexpr size_t WS_SLOTW = WS_TOK + (size_t)RL * 32;
constexpr size_t WS_KFL = al256(WS_SLOTW + (size_t)MOE_ROWS_MAX * 4);
constexpr size_t WS_KFC = WS_KFL + (size_t)2 * 1024 * SEQ * 2;
constexpr size_t WS_XSC = WS_KFC + (size_t)1024 * CTXL * 2;
constexpr size_t WS_UB = WS_XSC + (size_t)RC * D * 4;
constexpr size_t SZ_WINR = (size_t)(1792 + 4096) * 1024 * 2, SZ_WINHY = (size_t)NPT * 1024 * 2, SZ_WBR = (size_t)1024 * 1280 * 2, SZ_WOUT = (size_t)1024 * 1024 * 2;
constexpr size_t SZ_WL = SZ_WINR + SZ_WINHY + SZ_WBR + SZ_WOUT;
constexpr size_t WS_WL = WS_UB + (size_t)RT * D * 2;
constexpr size_t WS_FFGU = WS_WL + 2 * SZ_WL;
constexpr size_t WS_FFD = WS_FFGU + (size_t)2 * FF_DENSE * 1024 * 2;
constexpr size_t WS_WGLU = WS_FFD + (size_t)1024 * FF_DENSE * 2;
constexpr size_t WS_OPS = WS_WGLU + (size_t)2 * 256 * 256 * 2;
constexpr size_t WS_OPY = WS_OPS + (size_t)32 * 256 * 256 * 2;
constexpr size_t WS_LW = WS_OPY + (size_t)32 * 256 * 512 * 2;
constexpr size_t WS_PR = WS_LW + (size_t)48 * 4096 * 2;
constexpr size_t WS_PT = WS_PR + (size_t)RT * 5888 * 2;
constexpr size_t WS_GQ = WS_PR + (size_t)RT * LDP * 2;
constexpr size_t WS_YB = WS_PT + (size_t)NPT * RT * 2;
constexpr size_t WS_PRE = WS_YB + (size_t)RT * YW * 2;
constexpr size_t WS_EXTRA = WS_PRE + (size_t)RT * D * 4;
constexpr size_t SZ_EXTRA = (size_t)2 * RT * 384 * 4 + (size_t)RT * 256 * 4;
constexpr size_t WS_END = WS_EXTRA + SZ_EXTRA;
constexpr int NCHK = RT / 16, NCHKP = 1280;
constexpr size_t WS_US = WS_PRE;
constexpr size_t WS_S5S = WS_US + (size_t)16 * NCHKP * 512 * 2;
constexpr size_t WS_GL = WS_S5S + (size_t)16 * NCHKP * 256 * 4;
static_assert(WS_GL + (size_t)RT * 256 * 2 <= WS_EXTRA, "s5 overlay");
constexpr size_t WS_H = WS_PR;
constexpr size_t WS_MOEGU = WS_PR;
constexpr size_t WS_MOED = WS_GQ + (size_t)RT * 4096;
constexpr size_t WS_HM = WS_MOED + (size_t)NE * 1024 * FF_E * 2;
static_assert(WS_MOEGU + (size_t)NE * 2 * FF_E * 1024 * 2 <= WS_MOED && (size_t)RT * FF_DENSE * 2 <= WS_MOED - WS_PR, "moe gate/up weights and the dense hidden must stay clear of the down weights");
constexpr size_t WS_LT = WS_EXTRA;
constexpr size_t WS_LAGG = WS_LT + (size_t)RT * 3 * 384 * 2;
constexpr size_t WS_LHIN = WS_LAGG + (size_t)NCHK * 2 * 384 * 8;
constexpr size_t WS_YT = WS_LHIN + (size_t)NCHK * 2 * 384 * 4;
static_assert(WS_YT + (size_t)256 * RT * 2 <= WS_EXTRA + SZ_EXTRA, "lru / hyena overlay");
constexpr size_t WS_MGC = WS_EXTRA + (size_t)4 * RC * D * 4;
constexpr size_t WS_AG = WS_EXTRA;
static_assert(WS_HM + (size_t)MOE_HCAP * 256 * FF_E * 2 <= WS_EXTRA, "moe hidden overlay");
constexpr size_t WS_O2X = WS_PRE + ((size_t)32 << 20);
static_assert(WS_HM + (size_t)MOE_HCAP * 256 * FF_E * 2 <= WS_O2X && WS_O2X + (size_t)4 * 2048 * D * 4 <= WS_EXTRA, "moe excess sums");
static_assert((size_t)MOE_ROWS_MAX * 1024 * 2 <= SZ_EXTRA, "moe gather overlay");
static_assert((size_t)RT * FF_DENSE * 2 <= (size_t)RT * 5888 * 2 && WS_GQ + (size_t)RT * 4096 <= WS_PT, "dense hidden overlay / gate bytes");

__device__ __forceinline__ float sigm(float x) { return __builtin_amdgcn_rcpf(1.f + __builtin_amdgcn_exp2f(-1.44269504089f * x)); }
__device__ __forceinline__ float sigm_acc(float x) { return 1.f / (1.f + expf(-x)); }
__device__ __forceinline__ float silu_acc(float x) { return x / (1.f + expf(-x)); }
__device__ __forceinline__ float gelu_t(float x) { return 0.5f * x * (1.f + tanhf(0.7978845608028654f * (x + 0.044715f * x * x * x))); }
__device__ __forceinline__ float gelu_f(float x) { return x * sigm(1.5957691216057308f * (x + 0.044715f * x * x * x)); }
__device__ __forceinline__ float softplus(float x) { return fmaxf(x, 0.f) + log1pf(expf(-fabsf(x))); }
template <int CTRL> __device__ __forceinline__ float dpp_mov(float v) { return __int_as_float(__builtin_amdgcn_update_dpp(0, __float_as_int(v), CTRL, 0xf, 0xf, false)); }
__device__ __forceinline__ float wave_sum(float v) {
    v += dpp_mov<0xB1>(v);
    v += dpp_mov<0x4E>(v);
    v += dpp_mov<0x141>(v);
    v += dpp_mov<0x140>(v);
    const int iv = __float_as_int(v);
    return (__int_as_float(__builtin_amdgcn_readlane(iv, 0)) + __int_as_float(__builtin_amdgcn_readlane(iv, 16))) + (__int_as_float(__builtin_amdgcn_readlane(iv, 32)) + __int_as_float(__builtin_amdgcn_readlane(iv, 48)));
}
__device__ __forceinline__ float wave_max(float v) {
    v = fmaxf(v, dpp_mov<0xB1>(v)); v = fmaxf(v, dpp_mov<0x4E>(v)); v = fmaxf(v, dpp_mov<0x141>(v)); v = fmaxf(v, dpp_mov<0x140>(v));
    const int iv = __float_as_int(v);
    return fmaxf(fmaxf(__int_as_float(__builtin_amdgcn_readlane(iv, 0)), __int_as_float(__builtin_amdgcn_readlane(iv, 16))), fmaxf(__int_as_float(__builtin_amdgcn_readlane(iv, 32)), __int_as_float(__builtin_amdgcn_readlane(iv, 48))));
}
__device__ __forceinline__ float bf2f(bf16_t b) { return __uint_as_float(((unsigned)b) << 16); }
__device__ __forceinline__ bf16_t f2bf(float f) { unsigned u = __float_as_uint(f); u += 0x7FFFu + ((u >> 16) & 1u); return (bf16_t)(u >> 16); }
__device__ __forceinline__ unsigned cvt_pk_bf16(float lo, float hi) { unsigned r; asm volatile("v_cvt_pk_bf16_f32 %0, %1, %2" : "=v"(r) : "v"(lo), "v"(hi)); return r; }
__device__ __forceinline__ float bflo(unsigned w) { return __uint_as_float(w << 16); }
__device__ __forceinline__ float bfhi(unsigned w) { return __uint_as_float(w & 0xFFFF0000u); }
__device__ __forceinline__ void row_seq(int r, int& start, int& len, int& pos, int& b) {
    if (r < RL) { b = r >> 12; start = b << 12; len = SEQ; pos = r & 4095; }
    else { const int q = r - RL; b = q >> 8; start = RL + (b << 8); len = CTXL; pos = q & 255; }
}

#define XB_TMO      128
#define XB_XCNT(j)  (256  + 64 * (j))
#define XB_XSUB(j)  (1280 + 64 * (j))
#define XB_XGEN(j)  (2304 + 64 * (j))
#define XB_TOP      3328
#define XB_TOPGEN   3392
#define XCD_BAR_WORDS 3456
#define XB_SPIN_CAP (1u << 18)
__device__ __forceinline__ unsigned xb_ld(unsigned* p)              { return __hip_atomic_load(p, __ATOMIC_RELAXED, __HIP_MEMORY_SCOPE_AGENT); }
__device__ __forceinline__ unsigned xb_add(unsigned* p, unsigned v) { return __hip_atomic_fetch_add(p, v, __ATOMIC_RELAXED, __HIP_MEMORY_SCOPE_AGENT); }
__device__ __forceinline__ unsigned xb_xcc_id() { return (unsigned)__builtin_amdgcn_s_getreg((3 << 11) | 20) & 0xFu; }
#define XB_SPIN(cond, bar) do { unsigned _sp = 0; while (cond) { __builtin_amdgcn_s_sleep(1); \
    if ((++_sp & 255u) == 0u) { if (xb_ld(&(bar)[XB_TMO])) break; if (_sp > XB_SPIN_CAP) { atomicAdd(&(bar)[XB_TMO], 1u); break; } } } } while (0)
struct XcdBarrier { unsigned* bar; unsigned x; volatile LAS unsigned* st; };
__device__ __forceinline__ XcdBarrier xcd_barrier_post(unsigned* bar, volatile LAS unsigned* st) {
    XcdBarrier b; b.bar = bar; b.x = xb_xcc_id(); b.st = st;
    if (threadIdx.x == 0) (void)xb_add(&bar[XB_XCNT(b.x)], 1u);
    return b;
}
__device__ __forceinline__ void xcd_barrier_complete(unsigned* bar, unsigned x, unsigned& nloc, unsigned& nx) {
    const unsigned G = gridDim.x * gridDim.y * gridDim.z;
    unsigned sum, cnt, mine, sp = 0u;
    for (;;) {
        sum = 0u; cnt = 0u; mine = 0u;
#pragma unroll
        for (unsigned j = 0; j < 16; ++j) { const unsigned c = xb_ld(&bar[XB_XCNT(j)]); sum += c; cnt += (c > 0u) ? 1u : 0u; mine = (j == x) ? c : mine; }
        if (sum == G) break;
        __builtin_amdgcn_s_sleep(1);
        if ((++sp & 255u) == 0u) { if (xb_ld(&bar[XB_TMO])) break; if (sp > XB_SPIN_CAP) { atomicAdd(&bar[XB_TMO], 1u); break; } }
    }
    nloc = mine > 0u ? mine : 1u; nx = cnt > 0u ? cnt : 1u;
}
__device__ __forceinline__ void xcd_barrier(const XcdBarrier& b) {
    asm volatile("s_waitcnt vmcnt(0)" ::: "memory");
    __syncthreads();
    if (threadIdx.x == 0) {
        unsigned* bar = b.bar;
        __builtin_amdgcn_s_waitcnt(0);
        unsigned nloc = b.st[0], nx = b.st[1];
        if (nloc == 0u) { xcd_barrier_complete(bar, b.x, nloc, nx); b.st[0] = nloc; b.st[1] = nx; }
        const unsigned old = xb_add(&bar[XB_XSUB(b.x)], 1u);
        const unsigned gen = old / nloc;
        if (old + 1u == (gen + 1u) * nloc) {
            __builtin_amdgcn_fence(__ATOMIC_RELEASE, "agent");
            asm volatile("s_waitcnt vmcnt(0)" ::: "memory");
            const unsigned og = xb_add(&bar[XB_TOP], 1u);
            const unsigned tg = og / nx;
            if (og + 1u == (tg + 1u) * nx) xb_add(&bar[XB_TOPGEN], 1u);
            else XB_SPIN(xb_ld(&bar[XB_TOPGEN]) == tg, bar);
            __builtin_amdgcn_fence(__ATOMIC_ACQUIRE, "agent");
            xb_add(&bar[XB_XGEN(b.x)], 1u);
            asm volatile("s_waitcnt vmcnt(0)" ::: "memory");
        } else {
            XB_SPIN(xb_ld(&bar[XB_XGEN(b.x)]) == gen, bar);
            __builtin_amdgcn_fence(__ATOMIC_ACQUIRE, "agent");
            asm volatile("s_waitcnt vmcnt(0)" ::: "memory");
        }
    }
    __syncthreads();
}

namespace pg8 {
constexpr int BM = 256, BK = 64, HALF = 128, HTB = HALF * BK * 2, STAGE_BYTES = 8 * HTB, NXCD = 8, WGM = 8;
__host__ __device__ __forceinline__ int lds_byte(int r, int c) { const int st = (r >> 4) * 2 + (c >> 5), rr = r & 15, cc = c & 31, ob = rr * 64 + cc * 2; return st * 1024 + (ob ^ (((ob >> 9) & 1) << 5)); }
__host__ __device__ __forceinline__ void stage_rc(int b, int& R, int& C) { const int st = b / 1024, sb = b % 1024, swz = sb ^ (((sb >> 9) & 1) << 5); R = (st >> 1) * 16 + swz / 64; C = (st & 1) * 32 + (swz % 64) / 2; }
__host__ __device__ __forceinline__ int perm32(int rho) { const int n = rho >> 4, i = rho & 15; return 8 * (i >> 2) + 4 * n + (i & 3); }

struct Unit { const char* a; const char* b; int nt; int pm, pn, kind; };

__device__ __forceinline__ void rect_map(int wgid, int nM, int nN, int& pm, int& pn) {
    const int nwg = nM * nN;
    { const int q = nwg / NXCD, r = nwg % NXCD, xcd = wgid % NXCD, off = wgid / NXCD; wgid = (xcd < r ? xcd * (q + 1) : r * (q + 1) + (xcd - r) * q) + off; }
    const int nig = WGM * nN, gid = wgid / nig, fm = gid * WGM, gsz = (nM - fm) < WGM ? (nM - fm) : WGM;
    pm = fm + ((wgid % nig) % gsz); pn = (wgid % nig) / gsz;
}

template <int lda, int ldb, class Epi, class Sched>
__device__ __forceinline__ void gemm_phase(LAS unsigned char* lds, const Sched& S, const Epi& E) {
    int tid_ = threadIdx.x; asm volatile("" : "+v"(tid_));
    const int tid = tid_, wid = __builtin_amdgcn_readfirstlane(tid >> 6), lane = tid & 63, wr = wid >> 2, wc = wid & 3, fr = lane & 15, fq = lane >> 4;
    unsigned voffA[2], voffB[2];
#pragma unroll
    for (int i = 0; i < 2; ++i) { int R, C; stage_rc(tid * 16 + i * 8192, R, C); const int Rb = (R & ~31) + perm32(R & 31);
        voffA[i] = (unsigned)(R * lda + C) * 2u; voffB[i] = (unsigned)(Rb * ldb + C) * 2u; }
    const size_t kstep = (size_t)(BK * 2);
    const size_t hstepA = (size_t)HALF * lda * 2, hstepB = (size_t)HALF * ldb * 2;
    const unsigned ldsw = (unsigned)wid * 1024u;
    const int aoff = lds_byte(wr * 64 + fr, fq * 8), boff = lds_byte(wc * 32 + fr, fq * 8);
#define PG8_SA(b, h) (((b) * 2 + (h)) * HTB)
#define PG8_SB(b, h) ((4 + (b) * 2 + (h)) * HTB)
#define PG8_STAGE(bufoff, gbase, voff) do { _Pragma("unroll") for (int _i = 0; _i < 2; ++_i) \
        __builtin_amdgcn_global_load_lds((const unsigned*)((const char*)(gbase) + (voff)[_i]), (LAS unsigned*)(lds + (bufoff) + ldsw + _i * 8192), 16, 0, 0); } while (0)
#define PG8_LDA(dst, b, h) do { _Pragma("unroll") for (int m = 0; m < 4; ++m) _Pragma("unroll") for (int k = 0; k < 2; ++k) dst[m][k] = *(const LAS bf16x8*)(lds + PG8_SA(b, h) + aoff + m * 2048 + k * 1024); } while (0)
#define PG8_LDB(dst, b, h) do { _Pragma("unroll") for (int n = 0; n < 2; ++n) _Pragma("unroll") for (int k = 0; k < 2; ++k) dst[n][k] = *(const LAS bf16x8*)(lds + PG8_SB(b, h) + boff + n * 2048 + k * 1024); } while (0)
#define PG8_MMA(ai, bj, At, Bt) do { __builtin_amdgcn_s_setprio(1); _Pragma("unroll") for (int m = 0; m < 4; ++m) _Pragma("unroll") for (int n = 0; n < 2; ++n) _Pragma("unroll") for (int k = 0; k < 2; ++k) \
        acc[ai][bj][m][n] = __builtin_amdgcn_mfma_f32_16x16x32_bf16(Bt[n][k], At[m][k], acc[ai][bj][m][n], 0, 0, 0); __builtin_amdgcn_s_setprio(0); } while (0)
#define PG8_WAIT_V(n) asm volatile("s_waitcnt vmcnt(" #n ")" ::: "memory")
#define PG8_WAIT_L(n) asm volatile("s_waitcnt lgkmcnt(" #n ")" ::: "memory")
#define PG8_BAR __builtin_amdgcn_s_barrier()
#define PG8_SCHED __builtin_amdgcn_sched_barrier(0)
    Unit cur, nxt; int ui = 0;
    if (!S.next(0, cur)) return;
    f32x4 acc[2][2][4][2];
#pragma unroll
    for (int a = 0; a < 2; ++a)
#pragma unroll
        for (int b = 0; b < 2; ++b)
#pragma unroll
            for (int m = 0; m < 4; ++m)
#pragma unroll
                for (int n = 0; n < 2; ++n) acc[a][b][m][n] = (f32x4){0.f, 0.f, 0.f, 0.f};
    bf16x8 At[4][2], B0[2][2], B1[2][2];
    const char* cA = cur.a; const char* cB = cur.b;
    PG8_STAGE(PG8_SB(0, 0), cB, voffB); PG8_STAGE(PG8_SA(0, 0), cA, voffA); PG8_STAGE(PG8_SB(0, 1), cB + hstepB, voffB); PG8_STAGE(PG8_SA(0, 1), cA + hstepA, voffA);
    if (wr == 1) PG8_BAR;
    PG8_WAIT_V(4); PG8_BAR;
    PG8_STAGE(PG8_SB(1, 0), cB + kstep, voffB); PG8_STAGE(PG8_SA(1, 0), cA + kstep, voffA); PG8_STAGE(PG8_SB(1, 1), cB + hstepB + kstep, voffB);
    PG8_WAIT_V(6); PG8_BAR;
    for (;;) {
        const bool has_next = S.next(ui + 1, nxt);
        const char* nA = has_next ? nxt.a : cA; const char* nB = has_next ? nxt.b : cB;
        const int nt = cur.nt;
        for (int t = 0; t < nt; t += 2) {
            const bool last = (t == nt - 2);
            const char* a1 = cA + (size_t)(t + 1) * kstep;
            const char* a2 = last ? nA : cA + (size_t)(t + 2) * kstep; const char* b2 = last ? nB : cB + (size_t)(t + 2) * kstep;
            const char* a3 = a2 + kstep; const char* b3 = b2 + kstep;
            PG8_LDB(B0, 0, 0); PG8_SCHED; PG8_LDA(At, 0, 0); PG8_STAGE(PG8_SA(1, 1), a1 + hstepA, voffA);
            PG8_WAIT_L(8); PG8_BAR; PG8_WAIT_L(0); PG8_MMA(0, 0, At, B0); PG8_BAR; PG8_SCHED;
            PG8_LDB(B1, 0, 1); PG8_STAGE(PG8_SB(0, 0), b2, voffB);
            PG8_BAR; PG8_WAIT_L(0); PG8_MMA(0, 1, At, B1); PG8_BAR;
            PG8_LDA(At, 0, 1); PG8_STAGE(PG8_SA(0, 0), a2, voffA);
            PG8_BAR; PG8_WAIT_L(0); PG8_MMA(1, 0, At, B0); PG8_BAR; PG8_SCHED;
            PG8_STAGE(PG8_SB(0, 1), b2 + hstepB, voffB);
            PG8_WAIT_V(6); PG8_BAR; PG8_MMA(1, 1, At, B1); PG8_BAR;
            PG8_LDB(B0, 1, 0); PG8_SCHED; PG8_LDA(At, 1, 0); PG8_STAGE(PG8_SA(0, 1), a2 + hstepA, voffA);
            PG8_WAIT_L(8); PG8_BAR; PG8_WAIT_L(0); PG8_MMA(0, 0, At, B0); PG8_BAR; PG8_SCHED;
            PG8_LDB(B1, 1, 1); PG8_STAGE(PG8_SB(1, 0), b3, voffB);
            PG8_BAR; PG8_WAIT_L(0); PG8_MMA(0, 1, At, B1); PG8_BAR;
            PG8_LDA(At, 1, 1); PG8_STAGE(PG8_SA(1, 0), a3, voffA);
            PG8_BAR; PG8_WAIT_L(0); PG8_MMA(1, 0, At, B0); PG8_BAR; PG8_SCHED;
            PG8_STAGE(PG8_SB(1, 1), b3 + hstepB, voffB);
            PG8_WAIT_V(6); PG8_BAR; PG8_MMA(1, 1, At, B1); PG8_BAR;
        }
        E(acc, cur, wr, wc, fr, fq);
        if (!has_next) break;
        if (!(Sched::KEEP_ACC && nxt.kind >= 1 && nxt.kind <= 3)) {
#pragma unroll
        for (int a = 0; a < 2; ++a)
#pragma unroll
            for (int b = 0; b < 2; ++b)
#pragma unroll
                for (int m = 0; m < 4; ++m)
#pragma unroll
                    for (int n = 0; n < 2; ++n) acc[a][b][m][n] = (f32x4){0.f, 0.f, 0.f, 0.f};
        }
        cur = nxt; cA = nA; cB = nB; ++ui;
    }
    PG8_WAIT_V(0);
    if (wr == 0) PG8_BAR;
    PG8_BAR;
#undef PG8_SA
#undef PG8_SB
#undef PG8_STAGE
#undef PG8_LDA
#undef PG8_LDB
#undef PG8_MMA
#undef PG8_WAIT_V
#undef PG8_WAIT_L
#undef PG8_BAR
#undef PG8_SCHED
}

struct PartC { long long aOff, bOff; unsigned aStep, bStep; int nM, nN, nt, kind, start, nGrp; unsigned aGrp, bGrp; };
struct TabSched {
    static constexpr bool KEEP_ACC = false;
    const PartC* parts; const char* ws; int np, total, G, c;
    __device__ __forceinline__ bool next(int i, Unit& u) const {
        const int L = i * G + c; if (L >= total) return false;
        int q = 0;
#pragma unroll
        for (int k = 1; k < 4; ++k) if (k < np && L >= parts[k].start) q = k;
        const PartC P = parts[q];
        const int per = P.nM * P.nN, idx = L - P.start, grp = idx / per;
        int pm, pn; rect_map(idx - grp * per, P.nM, P.nN, pm, pn);
        u.a = ws + P.aOff + (size_t)grp * P.aGrp + (size_t)pm * P.aStep; u.b = ws + P.bOff + (size_t)grp * P.bGrp + (size_t)pn * P.bStep; u.nt = P.nt; u.pm = pm; u.pn = pn; u.kind = P.kind + grp; return true;
    }
};
struct MergeSched {
    static constexpr bool KEEP_ACC = true;
    const char* ws; long long aOff, bOff; int nM, G, c;
    int nCtx;
    __device__ __forceinline__ bool next(int i, Unit& u) const {
        int T = (i >> 2) * G + c, br = i & 3; bool ctxu = false;
        if (T >= nM * 4) {
            const int j = (i - 4 * ((nM * 4 - c + G - 1) / G)) * G + c;
            if (j < 0 || j >= nCtx) return false;
            T = nM * 4 + (j >> 2); br = j & 3; ctxu = true;
        }
        int pm, pn;
        if (!ctxu) rect_map(T, nM, 4, pm, pn); else { const int t = T - nM * 4; pm = nM + (t >> 2); pn = t & 3; }
        const int ko = br == 0 ? 0 : (br == 1 ? 384 : (br == 2 ? 640 : 1024));
        u.a = ws + aOff + (size_t)pm * (256u * 1280u * 2u) + ko * 2; u.b = ws + bOff + (size_t)pn * (256u * 1280u * 2u) + ko * 2; u.nt = (br & 1) ? 4 : 6; u.pm = pm; u.pn = pn; u.kind = ctxu ? 4 + br : br; return true;
    }
};
struct MoeSched {
    static constexpr bool KEEP_ACC = false;
    const char* A; const char* B; const int* tile_e; unsigned aStep, bStep; size_t bExp; int nN, nt, tile0, ntile, G, c;
    __device__ __forceinline__ bool next(int i, Unit& u) const {
        const int L = i * G + c; if (L >= ntile * nN) return false;
        const int mt = tile0 + L / nN, pn = L % nN;
        const int e = __builtin_amdgcn_readfirstlane(__hip_atomic_load(tile_e + mt, __ATOMIC_RELAXED, __HIP_MEMORY_SCOPE_AGENT));
        u.a = A + (size_t)(mt - tile0) * aStep; u.b = B + (size_t)e * bExp + (size_t)pn * bStep; u.nt = nt; u.pm = mt; u.pn = pn; u.kind = e; return true;
    }
};

struct MoeTailSched {
    static constexpr bool KEEP_ACC = false;
    const char* A; const char* B; const int* tile_e; int tile0, nfull, nex, G, c;
    __device__ __forceinline__ bool next(int i, Unit& u) const {
        const int L = i * G + c; int mt, pn, nt = 56, flag = 0; size_t koff = 0;
        if (L < nfull * 4) { mt = tile0 + (L >> 2); pn = L & 3; }
        else { const int idx = L - nfull * 4; if (idx >= nex * 16) return false; const int sp = idx & 3, tu = idx >> 2; mt = 128 + (tu >> 2); pn = tu & 3; nt = 14; koff = (size_t)sp * 14 * 128; flag = 8 + 16 * sp; }
        const int e = __builtin_amdgcn_readfirstlane(__hip_atomic_load(tile_e + mt, __ATOMIC_RELAXED, __HIP_MEMORY_SCOPE_AGENT));
        u.a = A + (size_t)(mt - tile0) * (256u * (unsigned)FF_E * 2u) + koff; u.b = B + (size_t)e * ((size_t)1024 * FF_E * 2) + (size_t)pn * (256u * (unsigned)FF_E * 2u) + koff;
        u.nt = nt; u.pm = mt; u.pn = pn; u.kind = e | flag; return true;
    }
};

#define EPI_ROWS(u) const int row0 = (u).pm * BM + wr * 64 + fr, colt = wc * 32 + 8 * fq
struct EpiProj {
    bf16_t* PRp; bf16_t* PTp; bf16_t* USp; int sig_from; unsigned char* GQp;
    __device__ __forceinline__ void operator()(const f32x4 (&acc)[2][2][4][2], const Unit& u, int wr, int wc, int fr, int fq) const {
        EPI_ROWS(u);
        bf16_t* base = u.kind == 1 ? PTp : PRp; const int ldc = u.kind == 1 ? RT : LDP; const bool sg = (u.kind == 0 && u.pn >= sig_from);
        if (sg) {
#pragma unroll
            for (int ai = 0; ai < 2; ++ai)
#pragma unroll
                for (int m = 0; m < 4; ++m) { unsigned char* rowp = GQp + (size_t)(row0 + ai * HALF + m * 16) * 4096 + (u.pn - sig_from) * BM + colt;
#pragma unroll
                    for (int bj = 0; bj < 2; ++bj) { const f32x4 v0 = acc[ai][bj][m][0], v1 = acc[ai][bj][m][1];
                        unsigned lo = 0u, hi = 0u;
                        lo = __builtin_amdgcn_cvt_pk_u8_f32(sigm(v0[0]) * 255.0f, 0, lo); lo = __builtin_amdgcn_cvt_pk_u8_f32(sigm(v0[1]) * 255.0f, 1, lo); lo = __builtin_amdgcn_cvt_pk_u8_f32(sigm(v0[2]) * 255.0f, 2, lo); lo = __builtin_amdgcn_cvt_pk_u8_f32(sigm(v0[3]) * 255.0f, 3, lo);
                        hi = __builtin_amdgcn_cvt_pk_u8_f32(sigm(v1[0]) * 255.0f, 0, hi); hi = __builtin_amdgcn_cvt_pk_u8_f32(sigm(v1[1]) * 255.0f, 1, hi); hi = __builtin_amdgcn_cvt_pk_u8_f32(sigm(v1[2]) * 255.0f, 2, hi); hi = __builtin_amdgcn_cvt_pk_u8_f32(sigm(v1[3]) * 255.0f, 3, hi);
                        *(u32x2*)(rowp + bj * HALF) = (u32x2){lo, hi}; } }
            return;
        }
#pragma unroll
        for (int ai = 0; ai < 2; ++ai)
#pragma unroll
            for (int m = 0; m < 4; ++m) { bf16_t* rowp = base + (size_t)(row0 + ai * HALF + m * 16) * ldc + u.pn * BM + colt;
#pragma unroll
                for (int bj = 0; bj < 2; ++bj) { f32x4 v0 = acc[ai][bj][m][0], v1 = acc[ai][bj][m][1];
                    if (sg) {
#pragma unroll
                        for (int j = 0; j < 4; ++j) { v0[j] = sigm(v0[j]); v1[j] = sigm(v1[j]); } }
                    u32x4 w; w.x = cvt_pk_bf16(v0[0], v0[1]); w.y = cvt_pk_bf16(v0[2], v0[3]); w.z = cvt_pk_bf16(v1[0], v1[1]); w.w = cvt_pk_bf16(v1[2], v1[3]);
                    *(u32x4*)(rowp + bj * HALF) = w;
                    if (u.kind == 0 && u.pn == 3) { const int r = row0 + ai * HALF + m * 16, cc = colt + bj * HALF;
                        *(u32x4*)(USp + ((size_t)(cc >> 4) * NCHKP + (r >> 4)) * 512 + (r & 15) * 16 + (cc & 15)) = w; } } }
    }
};
struct EpiS5State {
    float* Sp;
    __device__ __forceinline__ void operator()(const f32x4 (&acc)[2][2][4][2], const Unit& u, int wr, int wc, int fr, int fq) const {
        EPI_ROWS(u);
#pragma unroll
        for (int ai = 0; ai < 2; ++ai)
#pragma unroll
            for (int m = 0; m < 4; ++m) { float* op = Sp + ((size_t)u.kind * NCHKP + row0 + ai * HALF + m * 16) * 256 + colt;
#pragma unroll
                for (int bj = 0; bj < 2; ++bj)
#pragma unroll
                    for (int n = 0; n < 2; ++n) *(f32x4*)(op + bj * HALF + 4 * n) = acc[ai][bj][m][n]; }
    }
};
struct EpiS5Main {
    bf16_t* GLp; const bf16_t* PRp; const float* dvec;
    __device__ __forceinline__ void operator()(const f32x4 (&acc)[2][2][4][2], const Unit& u, int wr, int wc, int fr, int fq) const {
        EPI_ROWS(u);
        const int cl = 16 * u.kind + (colt & 15);
        const f32x4 d0 = *(const f32x4*)(dvec + cl), d1 = *(const f32x4*)(dvec + cl + 4);
#pragma unroll
        for (int ai = 0; ai < 2; ++ai) {
            u32x4 uq[4][2];
#pragma unroll
            for (int m = 0; m < 4; ++m) { const int n = row0 + ai * HALF + m * 16;
#pragma unroll
                for (int bj = 0; bj < 2; ++bj) { const int c = colt + bj * HALF, r = 16 * (n < NCHK ? n : 0) + (c >> 4); uq[m][bj] = *(const u32x4*)(PRp + (size_t)r * LDP + PC_D + cl); } }
#pragma unroll
            for (int m = 0; m < 4; ++m) { const int n = row0 + ai * HALF + m * 16; if (n >= NCHK) continue;
#pragma unroll
                for (int bj = 0; bj < 2; ++bj) { const int c = colt + bj * HALF, r = 16 * n + (c >> 4); const u32x4 uv = uq[m][bj];
                    const f32x4 v0 = acc[ai][bj][m][0], v1 = acc[ai][bj][m][1];
                    u32x4 w; w.x = cvt_pk_bf16(gelu_f(v0[0] + d0[0] * bflo(uv.x)), gelu_f(v0[1] + d0[1] * bfhi(uv.x))); w.y = cvt_pk_bf16(gelu_f(v0[2] + d0[2] * bflo(uv.y)), gelu_f(v0[3] + d0[3] * bfhi(uv.y)));
                    w.z = cvt_pk_bf16(gelu_f(v1[0] + d1[0] * bflo(uv.z)), gelu_f(v1[1] + d1[1] * bfhi(uv.z))); w.w = cvt_pk_bf16(gelu_f(v1[2] + d1[2] * bflo(uv.w)), gelu_f(v1[3] + d1[3] * bfhi(uv.w)));
                    *(u32x4*)(GLp + (size_t)r * 256 + cl) = w; } }
        }
    }
};
struct EpiS5Glu {
    bf16_t* YBp; const bf16_t* GLp; const float* bvec;
    __device__ __forceinline__ void operator()(const f32x4 (&acc)[2][2][4][2], const Unit& u, int wr, int wc, int fr, int fq) const {
        EPI_ROWS(u);
        f32x4 bq[2][2];
#pragma unroll
        for (int bj = 0; bj < 2; ++bj) { bq[bj][0] = *(const f32x4*)(bvec + colt + bj * HALF); bq[bj][1] = *(const f32x4*)(bvec + colt + bj * HALF + 4); }
#pragma unroll
        for (int ai = 0; ai < 2; ++ai) {
            u32x4 gq[4][2];
#pragma unroll
            for (int m = 0; m < 4; ++m)
#pragma unroll
                for (int bj = 0; bj < 2; ++bj) gq[m][bj] = *(const u32x4*)(GLp + (size_t)(row0 + ai * HALF + m * 16) * 256 + colt + bj * HALF);
#pragma unroll
            for (int m = 0; m < 4; ++m) { const int r = row0 + ai * HALF + m * 16;
#pragma unroll
                for (int bj = 0; bj < 2; ++bj) { const int c = colt + bj * HALF; const u32x4 gv = gq[m][bj];
                    const f32x4 v0 = acc[ai][bj][m][0] + bq[bj][0], v1 = acc[ai][bj][m][1] + bq[bj][1];
                    u32x4 w; w.x = cvt_pk_bf16(bflo(gv.x) * sigm(v0[0]), bfhi(gv.x) * sigm(v0[1])); w.y = cvt_pk_bf16(bflo(gv.y) * sigm(v0[2]), bfhi(gv.y) * sigm(v0[3]));
                    w.z = cvt_pk_bf16(bflo(gv.z) * sigm(v1[0]), bfhi(gv.z) * sigm(v1[1])); w.w = cvt_pk_bf16(bflo(gv.w) * sigm(v1[2]), bfhi(gv.w) * sigm(v1[3]));
                    *(u32x4*)(YBp + (size_t)r * YW + YC_D + c) = w; } }
        }
    }
};
__device__ __forceinline__ float gq8(unsigned w, int j) { return (float)((w >> (8 * j)) & 255u); }
struct EpiGate {
    const unsigned char* GQp; bf16_t* MGp; bf16_t* MGCp;
    __device__ __forceinline__ void operator()(f32x4 (&acc)[2][2][4][2], const Unit& u, int wr, int wc, int fr, int fq) const {
        EPI_ROWS(u);
        const int br = u.kind & 3;
        if (u.kind < 3) {
#pragma unroll
            for (int ai = 0; ai < 2; ++ai) {
                u32x2 ga[4][2], gb[4][2];
#pragma unroll
                for (int m = 0; m < 4; ++m)
#pragma unroll
                    for (int bj = 0; bj < 2; ++bj) { const unsigned char* gp = GQp + (size_t)(row0 + ai * HALF + m * 16) * 4096 + br * 1024 + u.pn * BM + colt + bj * HALF;
                        ga[m][bj] = *(const u32x2*)gp; gb[m][bj] = *(const u32x2*)(gp + 1024); }
#pragma unroll
                for (int m = 0; m < 4; ++m)
#pragma unroll
                    for (int bj = 0; bj < 2; ++bj)
#pragma unroll
                        for (int j = 0; j < 4; ++j) {
                            acc[ai][bj][m][0][j] *= fmaxf(gq8(ga[m][bj].x, j), 1.0f) * __builtin_amdgcn_rcpf(fmaxf(gq8(gb[m][bj].x, j), 1.0f));
                            acc[ai][bj][m][1][j] *= fmaxf(gq8(ga[m][bj].y, j), 1.0f) * __builtin_amdgcn_rcpf(fmaxf(gq8(gb[m][bj].y, j), 1.0f)); }
            }
            return;
        }
        bf16_t* OB = u.kind >= 4 ? MGCp + (size_t)br * RC * D - (size_t)RL * D : MGp;
        const float lo = u.kind >= 4 ? 0.0f : 1.0f;
#pragma unroll
        for (int ai = 0; ai < 2; ++ai) {
            u32x2 g[4][2];
#pragma unroll
            for (int m = 0; m < 4; ++m)
#pragma unroll
                for (int bj = 0; bj < 2; ++bj) g[m][bj] = *(const u32x2*)(GQp + (size_t)(row0 + ai * HALF + m * 16) * 4096 + br * 1024 + u.pn * BM + colt + bj * HALF);
#pragma unroll
            for (int m = 0; m < 4; ++m) { bf16_t* mp = OB + (size_t)(row0 + ai * HALF + m * 16) * D + u.pn * BM + colt;
#pragma unroll
                for (int bj = 0; bj < 2; ++bj) { const f32x4 v0 = acc[ai][bj][m][0] * (1.0f / 255.0f), v1 = acc[ai][bj][m][1] * (1.0f / 255.0f); const u32x2 gg = g[m][bj];
                    const f32x4 o0 = {v0[0] * fmaxf(gq8(gg.x, 0), lo), v0[1] * fmaxf(gq8(gg.x, 1), lo), v0[2] * fmaxf(gq8(gg.x, 2), lo), v0[3] * fmaxf(gq8(gg.x, 3), lo)};
                    const f32x4 o1 = {v1[0] * fmaxf(gq8(gg.y, 0), lo), v1[1] * fmaxf(gq8(gg.y, 1), lo), v1[2] * fmaxf(gq8(gg.y, 2), lo), v1[3] * fmaxf(gq8(gg.y, 3), lo)};
                    u32x4 w; w.x = cvt_pk_bf16(o0[0], o0[1]); w.y = cvt_pk_bf16(o0[2], o0[3]); w.z = cvt_pk_bf16(o1[0], o1[1]); w.w = cvt_pk_bf16(o1[2], o1[3]);
                    *(u32x4*)(mp + bj * HALF) = w; } }
        }
    }
};
struct EpiRes {
    float* PREp; const float* xlat; const float* xctx; const float* gvec;
    float* partp;
    __device__ __forceinline__ void operator()(const f32x4 (&acc)[2][2][4][2], const Unit& u, int wr, int wc, int fr, int fq) const {
        EPI_ROWS(u);
        if (u.kind != 0) {
            f32x4 gc[2][2];
#pragma unroll
            for (int bj = 0; bj < 2; ++bj)
#pragma unroll
                for (int n = 0; n < 2; ++n) gc[bj][n] = *(const f32x4*)(gvec + (size_t)4 * 6144 + u.pn * BM + colt + bj * HALF + 4 * n);
#pragma unroll
            for (int ai = 0; ai < 2; ++ai)
#pragma unroll
                for (int m = 0; m < 4; ++m) { const int r = row0 + ai * HALF + m * 16; const int c0 = u.pn * BM + colt;
                    float* op = partp + ((size_t)(u.kind - 1) * RC + r) * D + c0;
#pragma unroll
                    for (int bj = 0; bj < 2; ++bj)
#pragma unroll
                        for (int n = 0; n < 2; ++n) *(f32x4*)(op + bj * HALF + 4 * n) = gc[bj][n] * acc[ai][bj][m][n]; }
            return;
        }
        const int c0 = u.pn * BM + colt, rt0 = u.pm * BM;
        const float* gp = gvec + (size_t)(rt0 < RL ? (rt0 >> 12) : 4) * 6144 + c0;
        f32x4 gq[2][2];
#pragma unroll
        for (int bj = 0; bj < 2; ++bj)
#pragma unroll
            for (int n = 0; n < 2; ++n) gq[bj][n] = *(const f32x4*)(gp + bj * HALF + 4 * n);
#pragma unroll
        for (int ai = 0; ai < 2; ++ai)
#pragma unroll
            for (int m = 0; m < 4; ++m) { bf16_t* op = (bf16_t*)PREp + (size_t)(row0 + ai * HALF + m * 16) * D + c0;
#pragma unroll
                for (int bj = 0; bj < 2; ++bj) { const f32x4 v0 = gq[bj][0] * acc[ai][bj][m][0], v1 = gq[bj][1] * acc[ai][bj][m][1];
                    u32x4 w; w.x = cvt_pk_bf16(v0[0], v0[1]); w.y = cvt_pk_bf16(v0[2], v0[3]); w.z = cvt_pk_bf16(v1[0], v1[1]); w.w = cvt_pk_bf16(v1[2], v1[3]);
                    *(u32x4*)(op + bj * HALF) = w; } }
    }
};
struct EpiSwiglu {
    bf16_t* Hp; int ldh; int row_sub;
    __device__ __forceinline__ void operator()(const f32x4 (&acc)[2][2][4][2], const Unit& u, int wr, int wc, int fr, int fq) const {
        const int row0 = (u.pm - row_sub) * BM + wr * 64 + fr, colt = wc * 32 + 8 * fq;
#pragma unroll
        for (int ai = 0; ai < 2; ++ai)
#pragma unroll
            for (int m = 0; m < 4; ++m) { bf16_t* rowp = Hp + (size_t)(row0 + ai * HALF + m * 16) * ldh + u.pn * HALF + colt;
                f32x4 h0, h1;
#pragma unroll
                for (int j = 0; j < 4; ++j) { const float g0 = acc[ai][0][m][0][j], g1 = acc[ai][0][m][1][j];
                    h0[j] = g0 * sigm(g0) * acc[ai][1][m][0][j]; h1[j] = g1 * sigm(g1) * acc[ai][1][m][1][j]; }
                u32x4 w; w.x = cvt_pk_bf16(h0[0], h0[1]); w.y = cvt_pk_bf16(h0[2], h0[3]); w.z = cvt_pk_bf16(h1[0], h1[1]); w.w = cvt_pk_bf16(h1[2], h1[3]);
                *(u32x4*)rowp = w; }
    }
};
struct EpiMoeDown {
    bf16_t* O2; const float* slotw; float* O2X;
    __device__ __forceinline__ void operator()(const f32x4 (&acc)[2][2][4][2], const Unit& u, int wr, int wc, int fr, int fq) const {
        EPI_ROWS(u);
        float wq[2][4];
        if (u.kind & 8) {
            const int sp = (u.kind >> 4) & 3;
#pragma unroll
            for (int ai = 0; ai < 2; ++ai)
#pragma unroll
                for (int m = 0; m < 4; ++m) { const int r = row0 + ai * HALF + m * 16; const float w8 = slotw[r]; float* op = O2X + ((size_t)sp * 2048 + (r - 128 * 256)) * D + u.pn * BM + colt;
#pragma unroll
                    for (int bj = 0; bj < 2; ++bj)
#pragma unroll
                        for (int n = 0; n < 2; ++n) *(f32x4*)(op + bj * HALF + 4 * n) = acc[ai][bj][m][n] * w8; }
            return;
        }
#pragma unroll
        for (int ai = 0; ai < 2; ++ai)
#pragma unroll
            for (int m = 0; m < 4; ++m) wq[ai][m] = slotw[row0 + ai * HALF + m * 16];
#pragma unroll
        for (int ai = 0; ai < 2; ++ai)
#pragma unroll
            for (int m = 0; m < 4; ++m) { const int r = row0 + ai * HALF + m * 16; const float w8 = wq[ai][m];
                bf16_t* rowp = O2 + (size_t)r * D + u.pn * BM + colt;
#pragma unroll
                for (int bj = 0; bj < 2; ++bj) { const f32x4 v0 = acc[ai][bj][m][0] * w8, v1 = acc[ai][bj][m][1] * w8;
                    u32x4 w; w.x = cvt_pk_bf16(v0[0], v0[1]); w.y = cvt_pk_bf16(v0[2], v0[3]); w.z = cvt_pk_bf16(v1[0], v1[1]); w.w = cvt_pk_bf16(v1[2], v1[3]);
                    *(u32x4*)(rowp + bj * HALF) = w; } }
    }
};
}

struct Job { int in_idx; int src_off; int lds; int K; int N; long long dst_off; int ldd; int kcol0; int G, GS, R0; int tile0; };
struct JobTable { Job j[96]; int n; int total; };
constexpr int BIGG = 1 << 30;
constexpr void add_job(JobTable& t, int in_idx, long long src_off, int lds, int K, int N, size_t dst_off, int ldd, int kcol0, int G, int GS, int R0) {
    Job& q = t.j[t.n]; q.in_idx = in_idx; q.src_off = (int)src_off; q.lds = lds; q.K = K; q.N = N; q.dst_off = (long long)dst_off; q.ldd = ldd; q.kcol0 = kcol0; q.G = G; q.GS = GS; q.R0 = R0;
    q.tile0 = t.total; t.total += (K / 64) * (N / 64); t.n++;
}
constexpr JobTable make_jobs(int which) {
    JobTable t{}; t.n = 0; t.total = 0;
    if (which == 0) {
        for (int l = 0; l < 2; ++l) {
            const size_t base = WS_WL + (size_t)l * SZ_WL; const long long wsrc = (long long)l * 1024 * IN_COLS;
            add_job(t, 6, wsrc + 0, IN_COLS, 1024, 768, base, 1024, 0, BIGG, 0, 0);
            add_job(t, 6, wsrc + 2688, IN_COLS, 1024, 256, base, 1024, 0, BIGG, 0, PC_D);
            add_job(t, 6, wsrc + 1536, IN_COLS, 1024, 768, base, 1024, 0, BIGG, 0, PC_Q);
            add_job(t, 6, wsrc + 2944, IN_COLS, 1024, 4096, base, 1024, 0, BIGG, 0, PC_G);
            add_job(t, 6, wsrc + 768, IN_COLS, 1024, 768, base + SZ_WINR, 1024, 0, BIGG, 0, 0);
            add_job(t, 6, wsrc + 2304, IN_COLS, 1024, 384, base + SZ_WINR, 1024, 0, BIGG, 0, PT_V);
            const int kd[4] = {384, 256, 384, 256}, ko[4] = {0, 384, 640, 1024};
            for (int i = 0; i < 4; ++i) add_job(t, 35 + i, (long long)l * kd[i] * 1024, 1024, kd[i], 1024, base + SZ_WINR + SZ_WINHY, 1280, ko[i], BIGG, 0, 0);
            add_job(t, 39, (long long)l * 1024 * 1024, 1024, 1024, 1024, base + SZ_WINR + SZ_WINHY + SZ_WBR, 1024, 0, BIGG, 0, 0);
        }
        for (int q = 0; q < 24; ++q) for (int mat = 0; mat < 2; ++mat)
            add_job(t, mat == 0 ? 9 : 11, (long long)q * 4096, 64, 64, 64, WS_LW + (size_t)(((q / 6) * 2 + mat) * 6 + q % 6) * 4096 * 2, 64, 0, BIGG, 0, 0);
        for (int l = 0; l < 2; ++l) add_job(t, 33, (long long)l * 65536, 256, 256, 256, WS_WGLU + (size_t)l * 256 * 256 * 2, 256, 0, BIGG, 0, 0);
        add_job(t, 44, 0, FF_DENSE, 1024, FF_DENSE, WS_FFGU, 1024, 0, 128, 256, 0);
        add_job(t, 45, 0, FF_DENSE, 1024, FF_DENSE, WS_FFGU, 1024, 0, 128, 256, 128);
        add_job(t, 46, 0, 1024, FF_DENSE, 1024, WS_FFD, FF_DENSE, 0, BIGG, 0, 0);
    } else if (which == 1) {
        for (int e = 0; e < NE; ++e) {
            add_job(t, 48, (long long)e * 1024 * FF_E, FF_E, 1024, FF_E, WS_MOEGU + (size_t)e * 2 * FF_E * 1024 * 2, 1024, 0, 128, 256, 0);
            add_job(t, 49, (long long)e * 1024 * FF_E, FF_E, 1024, FF_E, WS_MOEGU + (size_t)e * 2 * FF_E * 1024 * 2, 1024, 0, 128, 256, 128);
        }
    } else { for (int e = 0; e < NE; ++e) add_job(t, 50, (long long)e * FF_E * 1024, 1024, FF_E, 1024, WS_MOED + (size_t)e * 1024 * FF_E * 2, FF_E, 0, BIGG, 0, 0);
    }
    return t;
}
__device__ const JobTable JT_SMALL = make_jobs(0);
__device__ const JobTable JT_MOE = make_jobs(1);
__device__ const JobTable JT_MOED = make_jobs(2);

struct PartTable { pg8::PartC p[32]; };
constexpr pg8::PartC mk_part(size_t aOff, size_t bOff, unsigned aStep, unsigned bStep, int nM, int nN, int nt, int kind, int start) {
    pg8::PartC q{}; q.aOff = (long long)aOff; q.bOff = (long long)bOff; q.aStep = aStep; q.bStep = bStep; q.nM = nM; q.nN = nN; q.nt = nt; q.kind = kind; q.start = start; q.nGrp = 1; q.aGrp = 0; q.bGrp = 0; return q;
}
constexpr PartTable make_parts() {
    PartTable t{};
    for (int l = 0; l < 2; ++l) {
        const size_t WL = WS_WL + (size_t)l * SZ_WL; const int nMrow = l == 0 ? 68 : 64;
        t.p[l * 8 + 0] = mk_part(WS_UB, WL, 256u * 1024u * 2u, 256u * 1024u * 2u, 68, 23, 16, 0, 0);
        t.p[l * 8 + 1] = mk_part(WL + SZ_WINR, WS_UB, 256u * 1024u * 2u, 256u * 1024u * 2u, 5, 68, 16, 1, 68 * 23);
        const int kd[4] = {384, 256, 384, 256}, ko[4] = {0, 384, 640, 1024};
        for (int i = 0; i < 4; ++i) t.p[l * 8 + 2 + i] = mk_part(WS_YB + ko[i] * 2, WL + SZ_WINR + SZ_WINHY + ko[i] * 2, 256u * 1280u * 2u, 256u * 1280u * 2u, nMrow, 4, kd[i] / 64, i, i * nMrow * 4);
        t.p[l * 8 + 6] = mk_part(WS_UB, WL + SZ_WINR + SZ_WINHY + SZ_WBR, 256u * 1024u * 2u, 256u * 1024u * 2u, nMrow, 4, 16, 0, 0);
    }
    for (int l = 0; l < 2; ++l) {
        pg8::PartC q = mk_part(WS_US, WS_OPS + (size_t)l * 16 * 256 * 256 * 2, 256u * 512u * 2u, 0u, 5, 1, 4, 0, 0); q.nGrp = 16; q.aGrp = (unsigned)(NCHKP * 512 * 2); q.bGrp = 256u * 256u * 2u; t.p[18 + l * 3] = q;
        q = mk_part(WS_US, WS_OPY + (size_t)l * 16 * 256 * 512 * 2, 256u * 512u * 2u, 0u, 5, 1, 8, 0, 0); q.nGrp = 16; q.aGrp = (unsigned)(NCHKP * 512 * 2); q.bGrp = 256u * 512u * 2u; t.p[19 + l * 3] = q;
        t.p[20 + l * 3] = mk_part(WS_GL, WS_WGLU + (size_t)l * 256 * 256 * 2, 256u * 256u * 2u, 0u, l == 0 ? 68 : 64, 1, 4, 0, 0);
    }
    {
        const size_t WL0 = WS_WL;
        t.p[24] = mk_part(WS_UB, WL0 + SZ_WINR + SZ_WINHY + SZ_WBR, 256u * 1024u * 2u, 256u * 1024u * 2u, 64, 4, 16, 0, 0);
        pg8::PartC q = mk_part(WS_MGC, WL0 + SZ_WINR + SZ_WINHY + SZ_WBR, 256u * 1024u * 2u, 256u * 1024u * 2u, 4, 4, 16, 1, 256); q.nGrp = 4; q.aGrp = (unsigned)(RC * D * 2); q.bGrp = 0u; t.p[25] = q;
        t.p[26] = mk_part(WS_H, WS_FFD, 256u * (unsigned)FF_DENSE * 2u, 256u * (unsigned)FF_DENSE * 2u, 64, 4, 44, 0, 0);
        q = mk_part(WS_H + (size_t)64 * 256 * FF_DENSE * 2, WS_FFD, 256u * (unsigned)FF_DENSE * 2u, 256u * (unsigned)FF_DENSE * 2u, 4, 4, 12, 1, 256); q.nGrp = 3; q.aGrp = 1536u; q.bGrp = 1536u; t.p[27] = q;
        t.p[28] = mk_part(WS_H + (size_t)64 * 256 * FF_DENSE * 2 + 36 * 128, WS_FFD + 36 * 128, 256u * (unsigned)FF_DENSE * 2u, 256u * (unsigned)FF_DENSE * 2u, 4, 4, 8, 4, 256 + 48);
    }
    t.p[16] = mk_part(WS_UB, WS_FFGU, 256u * 1024u * 2u, 256u * 1024u * 2u, 68, 22, 16, 0, 0);
    t.p[17] = mk_part(WS_H, WS_FFD, 256u * (unsigned)FF_DENSE * 2u, 256u * (unsigned)FF_DENSE * 2u, 68, 4, 44, 0, 0);
    return t;
}
__device__ const PartTable PARTS = make_parts();

struct Args {
    const float* in[51];
    float* out; unsigned char* ws;
    int ph_lo, ph_hi, bar_region, pad0;
};
__device__ __forceinline__ const float* sel_in(const Args& a, int idx) {
    const float* p = a.in[6];
    p = idx == 9 ? a.in[9] : p; p = idx == 11 ? a.in[11] : p; p = idx == 33 ? a.in[33] : p; p = idx == 35 ? a.in[35] : p; p = idx == 36 ? a.in[36] : p; p = idx == 37 ? a.in[37] : p; p = idx == 38 ? a.in[38] : p; p = idx == 39 ? a.in[39] : p;
    p = idx == 44 ? a.in[44] : p; p = idx == 45 ? a.in[45] : p; p = idx == 46 ? a.in[46] : p; p = idx == 48 ? a.in[48] : p; p = idx == 49 ? a.in[49] : p; p = idx == 50 ? a.in[50] : p;
    return p;
}

struct ConvRegs { f32x4 v[4][2]; int jis[4]; };
__device__ __forceinline__ void conv_load(const Args& a, const JobTable& JT, int t0, int stride, ConvRegs& R) {
    int tid = threadIdx.x; asm volatile("" : "+v"(tid));
#pragma unroll
    for (int u = 0; u < 4; ++u) {
        const int t = t0 + u * stride; R.jis[u] = -1;
        if (t < JT.total) {
            int ji = 0;
            for (int k = 1; k < JT.n; ++k) if (t >= JT.j[k].tile0) ji = k;
            R.jis[u] = ji;
            const Job& q = JT.j[ji];
            const int lt = t - q.tile0, nTn = q.N / 64, k0 = (lt / nTn) * 64, n0 = (lt % nTn) * 64;
            const float* src = sel_in(a, q.in_idx) + (size_t)q.src_off + (size_t)k0 * q.lds + n0;
#pragma unroll
            for (int p = 0; p < 2; ++p) R.v[u][p] = *(const f32x4*)(src + (size_t)((tid >> 4) + 32 * p) * q.lds + (tid & 15) * 4);
        }
    }
}
__device__ __forceinline__ void conv_store(const Args& a, const JobTable& JT, LAS float* tile, int t0, int stride, const ConvRegs& R) {
    int tid = threadIdx.x; asm volatile("" : "+v"(tid));
    __syncthreads();
#pragma unroll
    for (int u = 0; u < 4; ++u) if (R.jis[u] >= 0) {
#pragma unroll
        for (int p = 0; p < 2; ++p) { const int kk = (tid >> 4) + 32 * p, nn = (tid & 15) * 4; LAS float* tp = tile + u * (64 * 65) + kk * 65 + nn;
            tp[0] = R.v[u][p][0]; tp[1] = R.v[u][p][1]; tp[2] = R.v[u][p][2]; tp[3] = R.v[u][p][3]; } }
    __syncthreads();
#pragma unroll
    for (int u = 0; u < 4; ++u) if (R.jis[u] >= 0) {
        const Job& q = JT.j[R.jis[u]];
        const int t = t0 + u * stride, lt = t - q.tile0, nTn = q.N / 64, k0 = (lt / nTn) * 64, n0 = (lt % nTn) * 64;
        const int n = tid >> 3, k8 = (tid & 7) * 8, ng = n0 + n;
        const int drow = (ng / q.G) * q.GS + (ng % q.G) + q.R0;
        const LAS float* tp = tile + u * (64 * 65) + n;
        u32x4 w;
        w.x = cvt_pk_bf16(tp[(k8 + 0) * 65], tp[(k8 + 1) * 65]); w.y = cvt_pk_bf16(tp[(k8 + 2) * 65], tp[(k8 + 3) * 65]);
        w.z = cvt_pk_bf16(tp[(k8 + 4) * 65], tp[(k8 + 5) * 65]); w.w = cvt_pk_bf16(tp[(k8 + 6) * 65], tp[(k8 + 7) * 65]);
        *(u32x4*)((bf16_t*)(a.ws + q.dst_off) + (size_t)drow * q.ldd + q.kcol0 + k0 + k8) = w;
    }
}
__device__ __forceinline__ void convert_step(const Args& a, const JobTable& JT, LAS float* tile, int t0, int stride) { ConvRegs R; conv_load(a, JT, t0, stride, R); conv_store(a, JT, tile, t0, stride, R); }
__device__ __forceinline__ void convert_tiles_pipelined(const Args& a, const JobTable& JT, LAS float* tile, int first, int stride) {
    ConvRegs cur; int t0 = first;
    if (t0 >= JT.total) return;
    conv_load(a, JT, t0, stride, cur);
    for (;;) {
        const int tn = t0 + 4 * stride; const bool more = tn < JT.total;
        ConvRegs nxt;
        if (more) conv_load(a, JT, tn, stride, nxt);
        conv_store(a, JT, tile, t0, stride, cur);
        if (!more) break;
        cur = nxt; t0 = tn;
    }
}
__device__ __forceinline__ void convert_tiles(const Args& a, const JobTable& JT, LAS float* tile, int first, int stride) {
    for (int t0 = first; t0 < JT.total; t0 += 4 * stride) convert_step(a, JT, tile, t0, stride);
}

__device__ __forceinline__ int opaque(int v) { asm volatile("" : "+v"(v)); return v; }
__device__ __forceinline__ void pull_convert(const Args& a, const JobTable& JT, LAS unsigned char* lds, volatile LAS unsigned* misc, unsigned* qcnt, int max_steps) {
    for (int st = 0; st < max_steps; ++st) {
        __syncthreads();
        if (threadIdx.x == 0) misc[16] = atomicAdd(qcnt, 4u);
        __syncthreads();
        const int base = (int)misc[16];
        if (base >= JT.total) break;
        convert_step(a, JT, (LAS float*)lds, base, 1);
    }
}
#define PIN8(a) asm volatile("" : "+v"((a)[0]), "+v"((a)[1]), "+v"((a)[2]), "+v"((a)[3]), "+v"((a)[4]), "+v"((a)[5]), "+v"((a)[6]), "+v"((a)[7]))
#define PIN16(a) do { PIN8(a); PIN8((a) + 8); } while (0)
struct RowV { f32x4 v[4]; };
__device__ __forceinline__ RowV row_load(const float* p, int lane) { RowV r;
#pragma unroll
    for (int i = 0; i < 4; ++i) r.v[i] = *(const f32x4*)(p + 256 * i + 4 * lane); return r; }
__device__ __forceinline__ RowV row_load_bf16(const bf16_t* p, int lane) { RowV r;
#pragma unroll
    for (int i = 0; i < 4; ++i) { const u32x2 w = *(const u32x2*)(p + 256 * i + 4 * lane); r.v[i] = (f32x4){bflo(w.x), bfhi(w.x), bflo(w.y), bfhi(w.y)}; } return r; }
__device__ __forceinline__ void row_store(float* p, int lane, const RowV& r) {
#pragma unroll
    for (int i = 0; i < 4; ++i) *(f32x4*)(p + 256 * i + 4 * lane) = r.v[i]; }
__device__ __forceinline__ void row_store_bf16(bf16_t* p, int lane, const RowV& r) {
#pragma unroll
    for (int i = 0; i < 4; ++i) { u32x2 w; w.x = cvt_pk_bf16(r.v[i][0], r.v[i][1]); w.y = cvt_pk_bf16(r.v[i][2], r.v[i][3]); *(u32x2*)(p + 256 * i + 4 * lane) = w; } }
__device__ __forceinline__ RowV row_norm(const RowV& x) {
    float s = 0.f;
#pragma unroll
    for (int i = 0; i < 4; ++i) s += (x.v[i][0] + x.v[i][1]) + (x.v[i][2] + x.v[i][3]);
    const float mu = wave_sum(s) * (1.f / D);
    RowV d; float q = 0.f;
#pragma unroll
    for (int i = 0; i < 4; ++i) { d.v[i] = x.v[i] - mu; q += (d.v[i][0] * d.v[i][0] + d.v[i][1] * d.v[i][1]) + (d.v[i][2] * d.v[i][2] + d.v[i][3] * d.v[i][3]); }
    const float rs = rsqrtf(wave_sum(q) * (1.f / D) + 1e-5f);
#pragma unroll
    for (int i = 0; i < 4; ++i) d.v[i] = d.v[i] * rs;
    return d;
}
__device__ __forceinline__ RowV row_affine(const RowV& n, const float* g, const float* b, int lane) {
    RowV o;
#pragma unroll
    for (int i = 0; i < 4; ++i) o.v[i] = n.v[i] * *(const f32x4*)(g + 256 * i + 4 * lane) + *(const f32x4*)(b + 256 * i + 4 * lane);
    return o;
}
__device__ __forceinline__ RowV row_modulate(const RowV& n, const float* sh, const float* sc, int lane) {
    RowV o;
#pragma unroll
    for (int i = 0; i < 4; ++i) o.v[i] = n.v[i] * (*(const f32x4*)(sc + 256 * i + 4 * lane) + 1.0f) + *(const f32x4*)(sh + 256 * i + 4 * lane);
    return o;
}

constexpr int LDS_BYTES = 159744;
constexpr int MISC_OFF = 159488;
constexpr int NPH_LAYER = 16;
#ifndef SPLIT
#define SPLIT 0
#endif

__global__ void __launch_bounds__(512, 2) mk_fwd(Args a) {
    extern __shared__ __attribute__((aligned(16))) unsigned char shm[];
    LAS unsigned char* lds = (LAS unsigned char*)shm;
    volatile LAS unsigned* MISC = (volatile LAS unsigned*)(lds + MISC_OFF);
    const int tid0 = threadIdx.x, wave = __builtin_amdgcn_readfirstlane(tid0 >> 6);
    const int G = gridDim.x, bid = blockIdx.x;
    if (tid0 < (LDS_BYTES - MISC_OFF) / 4) MISC[tid0] = 0u;
    __syncthreads();
    unsigned char* ws = a.ws;
    unsigned* ctl = (unsigned*)(ws + WS_CTL);
    XcdBarrier bar = xcd_barrier_post(ctl + CW_BAR + a.bar_region * XCD_BAR_WORDS, MISC + 8);
    const int lo = a.ph_lo, hi = a.ph_hi;
#ifndef PHMASK
#define PHMASK 0xFFFF
#endif
#define IN(k) (lo <= (k) && (k) < hi)
#define SEAM(k) do { if (lo <= (k) && (k) + 1 < hi) xcd_barrier(bar); } while (0)
    float* MOD = (float*)(ws + WS_MOD);
    bf16_t* UB = (bf16_t*)(ws + WS_UB); bf16_t* PR = (bf16_t*)(ws + WS_PR); bf16_t* PT = (bf16_t*)(ws + WS_PT); bf16_t* YB = (bf16_t*)(ws + WS_YB);
    float* PRE = (float*)(ws + WS_PRE); float* XSC = (float*)(ws + WS_XSC);
    const float* x_in = a.in[0]; const float* ctx_in = a.in[2];

    if (((PHMASK >> 0) & 1) && IN(0)) {
        const int tid = opaque(tid0), lane = tid & 63;
        __syncthreads();
        LAS float* sc = (LAS float*)lds;
        for (int i = tid; i < 5 * 1024; i += 512) { const int r = i >> 10, k = i & 1023; sc[i] = silu_acc(r < 4 ? a.in[1][r * 1024 + k] : a.in[3][k]); }
        __syncthreads();
        LAS float* red = sc + 5 * 1024;
        for (int u = bid; u < 192; u += G) {
            const int l = u / 96, cg = u - l * 96, n = cg * 64 + lane;
            const float* w = a.in[4] + (size_t)l * 1024 * 6144 + n;
            float a0 = 0, a1 = 0, a2 = 0, a3 = 0, a4 = 0;
            const int kb = wave * 128;
#pragma unroll 8
            for (int k = kb; k < kb + 128; ++k) { const float wv = w[(size_t)k * 6144]; a0 += sc[k] * wv; a1 += sc[1024 + k] * wv; a2 += sc[2048 + k] * wv; a3 += sc[3072 + k] * wv; a4 += sc[4096 + k] * wv; }
            __syncthreads();
            red[(wave * 5 + 0) * 64 + lane] = a0; red[(wave * 5 + 1) * 64 + lane] = a1; red[(wave * 5 + 2) * 64 + lane] = a2; red[(wave * 5 + 3) * 64 + lane] = a3; red[(wave * 5 + 4) * 64 + lane] = a4;
            __syncthreads();
            if (tid < 320) { const int r = tid >> 6, c = tid & 63; float sacc = a.in[5][l * 6144 + cg * 64 + c];
#pragma unroll
                for (int wv = 0; wv < 8; ++wv) sacc += red[(wv * 5 + r) * 64 + c];
                MOD[((size_t)l * 5 + r) * 6144 + cg * 64 + c] = sacc; }
        }
        __syncthreads();
        for (int u = bid; u < 132; u += G) {
            const bool isc = u >= 128; const int l = isc ? 0 : (u >> 6), blk = isc ? u - 128 : (u & 63), L = isc ? CTXL : SEQ, t0 = blk * 64;
            LAS float* feat = (LAS float*)lds;
            LAS float* h1 = feat + 64 * 33;
            LAS float* h2 = h1 + 4096;
            const float* w1 = a.in[16] + l * 33 * 64; const float* b1 = a.in[17] + l * 64; const float* w2 = a.in[18] + l * 4096; const float* b2 = a.in[19] + l * 64;
            const float* w3 = a.in[20] + (size_t)l * 65536; const float* b3 = a.in[21] + l * 1024; const float* fq = a.in[22] + l * 64;
            __syncthreads();
            for (int i = tid; i < 64 * 33; i += 512) { const int tt = i / 33, f = i - tt * 33, t = t0 + tt; float v;
                if (f == 0) v = (float)t / (float)L;
                else { const int band = (f - 1) % 16 + 1; const int m = (int)(((long)t * band) % L); const double ang = 2.0 * M_PI * (double)m / (double)L; v = f <= 16 ? (float)cos(ang) : (float)sin(ang); }
                feat[i] = v; }
            __syncthreads();
            for (int i = tid; i < 4096; i += 512) { const int tt = i >> 6, j = i & 63; float sacc = b1[j];
                for (int f = 0; f < 33; ++f) sacc += feat[tt * 33 + f] * w1[f * 64 + j];
                h1[i] = sinf(fq[j] * sacc); }
            __syncthreads();
            for (int i = tid; i < 4096; i += 512) { const int tt = i >> 6, j = i & 63; float sacc = b2[j];
                for (int f = 0; f < 64; ++f) sacc += h1[tt * 64 + f] * w2[f * 64 + j];
                h2[i] = sinf(fq[j] * sacc); }
            __syncthreads();
            const float dmin = 3.0701134573253945f, dmax = 15.350567286626973f;
#pragma unroll 1
            for (int jj = 0; jj < 2; ++jj) {
                const int n = tid + 512 * jj, dir = n >> 9, o = (n >> 8) & 1, c = n & 255;
                float wc[64];
#pragma unroll
                for (int i = 0; i < 64; ++i) wc[i] = w3[i * 1024 + n];
                const float bb = b3[n], delta = dmin + (dmax - dmin) * (float)c / 255.0f;
                bf16_t* dst = isc ? (bf16_t*)(ws + WS_KFC) + ((size_t)(dir * 2 + o) * 256 + c) * CTXL + t0 : (bf16_t*)(ws + WS_KFL) + ((size_t)((l * 2 + dir) * 2 + o) * 256 + c) * SEQ + t0;
                float asum = 0.f;
#pragma unroll 1
                for (int tg = 0; tg < 8; ++tg) {
                    float v[8];
#pragma unroll
                    for (int q = 0; q < 8; ++q) { float sacc = bb; const LAS float* hp = h2 + (tg * 8 + q) * 64;
#pragma unroll
                        for (int i = 0; i < 64; ++i) sacc += hp[i] * wc[i];
                        const int t = t0 + tg * 8 + q;
                        v[q] = sacc * expf(-((float)t / (float)L) * delta);
                        if (!(dir == 1 && t == 0)) asum += fabsf(v[q]); }
                    u32x4 w; w.x = cvt_pk_bf16(v[0], v[1]); w.y = cvt_pk_bf16(v[2], v[3]); w.z = cvt_pk_bf16(v[4], v[5]); w.w = cvt_pk_bf16(v[6], v[7]);
                    *(u32x4*)(dst + tg * 8) = w;
                }
                atomicAdd((float*)(ctl + CW_HYN) + (isc ? 1024 + o * 256 + c : (l * 2 + o) * 256 + c), asum);
            }
        }
        __syncthreads();
        for (int uq = bid; uq < 164; uq += G) { if (uq < 132) continue; const int u = uq - 132;
            const int l = u >> 4, g = u & 15;
            LAS float* PW = (LAS float*)lds;
            LAS float* BBs = PW + 2 * 64 * 17 * 2;
            LAS float* Cs = BBs + 2 * 64 * 16 * 2;
            LAS float* KT = Cs + 2 * 16 * 64 * 2;
            __syncthreads();
            if (tid < 128) {
                const int d = tid >> 6, p = tid & 63, idx = l * 2048 + (d * 16 + g) * 64 + p;
                const double ar = a.in[25][idx], ai = a.in[26][idx], dt = exp((double)a.in[27][l * 32 + d * 16 + g]);
                const double mag = exp(dt * ar), abr = mag * cos(dt * ai), abi = mag * sin(dt * ai), den = ar * ar + ai * ai;
                const double fr = ((abr - 1.0) * ar + abi * ai) / den, fi = (abi * ar - (abr - 1.0) * ai) / den;
                double pr = 1.0, pi = 0.0;
                for (int k = 0; k <= 16; ++k) { PW[((d * 64 + p) * 17 + k) * 2] = (float)pr; PW[((d * 64 + p) * 17 + k) * 2 + 1] = (float)pi; const double nr = pr * abr - pi * abi, ni = pr * abi + pi * abr; pr = nr; pi = ni; }
                float* a16 = (float*)(ws + WS_AB16) + ((size_t)((l * 2 + d) * 16 + g) * 64 + p) * 2;
                a16[0] = PW[((d * 64 + p) * 17 + 16) * 2]; a16[1] = PW[((d * 64 + p) * 17 + 16) * 2 + 1];
                for (int i = 0; i < 16; ++i) { const double br = a.in[28][(size_t)idx * 16 + i], bi = a.in[29][(size_t)idx * 16 + i];
                    BBs[((d * 64 + p) * 16 + i) * 2] = (float)(fr * br - fi * bi); BBs[((d * 64 + p) * 16 + i) * 2 + 1] = (float)(fr * bi + fi * br); }
            }
            for (int i = tid; i < 2048; i += 512) { const int d = i >> 10, o = (i >> 6) & 15, p = i & 63; const size_t ci = (size_t)l * 32768 + ((size_t)(d * 16 + g) * 16 + o) * 64 + p;
                Cs[i * 2] = a.in[30][ci]; Cs[i * 2 + 1] = a.in[31][ci]; }
            __syncthreads();
            for (int e = tid; e < 8192; e += 512) { const int d = e >> 12, k = (e >> 8) & 15, o = (e >> 4) & 15, i = e & 15;
                float acc = 0.f;
                for (int p = 0; p < 64; ++p) { const float cr = Cs[((d * 16 + o) * 64 + p) * 2], ci = Cs[((d * 16 + o) * 64 + p) * 2 + 1], pr = PW[((d * 64 + p) * 17 + k) * 2], pi = PW[((d * 64 + p) * 17 + k) * 2 + 1];
                    const float tr = cr * pr - ci * pi, ti = cr * pi + ci * pr;
                    acc += tr * BBs[((d * 64 + p) * 16 + i) * 2] - ti * BBs[((d * 64 + p) * 16 + i) * 2 + 1]; }
                KT[e] = acc; }
            __syncthreads();
            bf16_t* OPS = (bf16_t*)(ws + WS_OPS) + (size_t)(l * 16 + g) * 256 * 256;
            bf16_t* OPY = (bf16_t*)(ws + WS_OPY) + (size_t)(l * 16 + g) * 256 * 512;
            for (int e = tid; e < 256 * 32; e += 512) {
                const int row = e >> 5, c0 = (e & 31) * 8, d = row >> 7, p = (row >> 1) & 63, ri = row & 1, sx = c0 >> 4, i0 = c0 & 15, k = d == 0 ? 15 - sx : sx;
                const float pr = PW[((d * 64 + p) * 17 + k) * 2], pi = PW[((d * 64 + p) * 17 + k) * 2 + 1];
                float v[8];
#pragma unroll
                for (int j = 0; j < 8; ++j) { const float br = BBs[((d * 64 + p) * 16 + i0 + j) * 2], bi = BBs[((d * 64 + p) * 16 + i0 + j) * 2 + 1]; v[j] = ri == 0 ? pr * br - pi * bi : pr * bi + pi * br; }
                u32x4 w; w.x = cvt_pk_bf16(v[0], v[1]); w.y = cvt_pk_bf16(v[2], v[3]); w.z = cvt_pk_bf16(v[4], v[5]); w.w = cvt_pk_bf16(v[6], v[7]);
                *(u32x4*)(OPS + (size_t)row * 256 + c0) = w; }
            for (int e = tid; e < 256 * 64; e += 512) {
                const int row = e >> 6, c0 = (e & 63) * 8, t = row >> 4, o = row & 15;
                float v[8];
                if (c0 < 256) { const int sx = c0 >> 4, i0 = c0 & 15;
#pragma unroll
                    for (int j = 0; j < 8; ++j) { float x = 0.f; if (sx <= t) x += KT[((0 * 16 + (t - sx)) * 16 + o) * 16 + i0 + j]; if (sx >= t) x += KT[((1 * 16 + (sx - t)) * 16 + o) * 16 + i0 + j]; v[j] = x; } }
                else { const int c2 = c0 - 256, d = c2 >> 7, k = d == 0 ? t + 1 : 16 - t;
#pragma unroll
                    for (int j = 0; j < 8; ++j) { const int p = ((c2 + j) >> 1) & 63, ri = (c2 + j) & 1;
                        const float cr = Cs[((d * 16 + o) * 64 + p) * 2], ci = Cs[((d * 16 + o) * 64 + p) * 2 + 1], pr = PW[((d * 64 + p) * 17 + k) * 2], pi = PW[((d * 64 + p) * 17 + k) * 2 + 1];
                        v[j] = ri == 0 ? cr * pr - ci * pi : -(cr * pi + ci * pr); } }
                u32x4 w; w.x = cvt_pk_bf16(v[0], v[1]); w.y = cvt_pk_bf16(v[2], v[3]); w.z = cvt_pk_bf16(v[4], v[5]); w.w = cvt_pk_bf16(v[6], v[7]);
                *(u32x4*)(OPY + (size_t)row * 512 + c0) = w; }
        }
        __syncthreads();
        for (;;) {
            __syncthreads();
            if (tid == 0) MISC[16] = atomicAdd(ctl + CW_QUEUE, 4u);
            __syncthreads();
            const int base = (int)MISC[16];
            if (base >= JT_SMALL.total) break;
            convert_step(a, JT_SMALL, (LAS float*)lds, base, 1);
        }
        __syncthreads();
    }
    SEAM(0);

    for (int l = 0; l < 2; ++l) {
        const int P0 = 1 + l * NPH_LAYER;
        const float* MODL = MOD + (size_t)l * 5 * 6144;
        const unsigned char* WL = ws + WS_WL + (size_t)l * SZ_WL;
        const int nMrow = (l == 0) ? 68 : 64;
        const float* xlat = (l == 0) ? x_in : a.out; const float* xctx = (l == 0) ? ctx_in : XSC;

        if (((PHMASK >> 1) & 1) && l == 0 && IN(P0 + 0)) {
            const int lane = opaque(tid0) & 63;
            for (int r = bid * 8 + wave; r < RT; r += G * 8) {
                const float* src = r < RL ? x_in + (size_t)r * D : ctx_in + (size_t)(r - RL) * D;
                const float* mv = MODL + (size_t)(r < RL ? (r >> 12) : 4) * 6144;
                const RowV n = row_norm(row_load(src, lane));
                row_store_bf16(UB + (size_t)r * D, lane, row_modulate(n, mv, mv + 1024, lane));
            }
        }
        if (l == 0) SEAM(P0 + 0);

        if (((PHMASK >> 2) & 1) && IN(P0 + 1)) {
            const pg8::TabSched S{PARTS.p + l * 8, (const char*)ws, 2, 68 * 23 + 5 * 68, G, bid};
            pg8::EpiProj E{PR, PT, (bf16_t*)(ws + WS_US), 7, ws + WS_GQ};
            pg8::gemm_phase<1024, 1024>(lds, S, E);
        }
        SEAM(P0 + 1);
        if (((PHMASK >> 13) & 1) && IN(P0 + 2)) {
            const int tid = opaque(tid0), lane = tid & 63;
            LAS float* rp = (LAS float*)lds;
            for (int i = tid; i < 6 * 465; i += 512) rp[i] = a.in[24][l * 2790 + i];
            __syncthreads();
            LAS bf16_t* KW = (LAS bf16_t*)(lds + 11264);
            LAS bf16_t* CK = (LAS bf16_t*)(lds + 11264 + 576 * 144);
            LAS bf16_t* VW = (LAS bf16_t*)(lds + 11264);
            LAS bf16_t* CV = (LAS bf16_t*)(lds + 11264 + 64 * 1168);
            const int ngroups = 768 + (l == 0 ? 48 : 0);
            for (int gi0 = bid; gi0 < 768 + G; gi0 += G) {
                const int gi = gi0 < 768 ? gi0 : 768 + ((gi0 - 768 + G - 48) % G);
                if (gi >= ngroups) continue;
                const bool lat = gi < 768;
                const int combo = lat ? gi >> 5 : (gi - 768) >> 1, b = combo / 6, h = combo - 6 * b;
                const int v = lat ? ((gi & 31) << 3) + wave : (((gi - 768) & 1) << 3) + wave;
                const int r0g = (gi & 31) << 1, rs0 = r0g - 4 < 0 ? 0 : (r0g - 4 > 56 ? 56 : r0g - 4);
                const int ntokw = lat ? ((64 - rs0) < 9 ? (64 - rs0) : 9) * 64 : 0;
                __syncthreads();
                {   const int tid2 = opaque(tid);
#pragma unroll
                    for (int k = 0; k < 9; ++k) { const int c = tid2 + 512 * k, tok = c >> 3, part = c & 7;
                        if (tok < ntokw) *(LAS u32x4*)(KW + tok * 72 + part * 8) = *(const u32x4*)(PR + (size_t)(b * SEQ + rs0 * 64 + tok) * LDP + PC_K + h * 64 + part * 8); }
#pragma unroll
                    for (int k = 0; k < 4; ++k) { const int c = tid2 + 512 * k, tok = c >> 3, part = c & 7;
                        *(LAS u32x4*)(CK + tok * 72 + part * 8) = *(const u32x4*)(PR + (size_t)(RL + b * CTXL + tok) * LDP + PC_K + h * 64 + part * 8); } }
                __syncthreads();
                const int ln2 = opaque(lane), qn = ln2 & 15, g = ln2 >> 4;
                int r = 0, qb, tq, rs = 0, bs = 0, w = 0, cs = 0;
                if (lat) { qb = v & 3; r = v >> 2; rs = r - 4 < 0 ? 0 : (r - 4 > 56 ? 56 : r - 4); bs = qb == 0 ? 0 : (qb == 1 ? 8 : (qb == 2 ? 24 : 32));
                    w = 16 * qb + qn; cs = w - 8 < 0 ? 0 : (w - 8 > 48 ? 48 : w - 8); tq = b * SEQ + r * 64 + w; }
                else { qb = v; tq = RL + b * CTXL + 16 * qb + qn; }
                const int pr0 = rs - rs0;
                const bf16_t* qp = PR + (size_t)tq * LDP + PC_Q + h * 64 + 8 * g;
                const bf16x8 q0 = *(const bf16x8*)qp, q1 = *(const bf16x8*)(qp + 32);
                f32x4 S[32];
                const int koff = 8 * (qn >> 2) + (qn & 3);
                if (lat) {
#pragma unroll
                    for (int p = 0; p < 8; ++p)
#pragma unroll
                        for (int hf = 0; hf < 2; ++hf) { const LAS bf16_t* kp = KW + ((pr0 + p) * 64 + bs + koff + 4 * hf) * 72 + 8 * g;
                            const bf16x8 k0 = *(const LAS bf16x8*)kp, k1 = *(const LAS bf16x8*)(kp + 32);
                            f32x4 acc = {0.f, 0.f, 0.f, 0.f};
                            acc = __builtin_amdgcn_mfma_f32_16x16x32_bf16(k0, q0, acc, 0, 0, 0);
                            acc = __builtin_amdgcn_mfma_f32_16x16x32_bf16(k1, q1, acc, 0, 0, 0);
                            const int rowoff = (h * 15 + (rs + p - r + 7)) * 31;
#pragma unroll
                            for (int j = 0; j < 4; ++j) { const int c = bs + 8 * g + 4 * hf + j; const bool ok = (c >= cs) && (c < cs + 16);
                                const int dc = ok ? c - w + 15 : 0;
                                acc[j] = ok ? acc[j] * 0.125f + rp[rowoff + dc] : -3.0e38f; }
                            S[2 * p + hf] = acc; if (hf == 1 && (p & 1)) __builtin_amdgcn_sched_barrier(0); }
                } else {
#pragma unroll
                    for (int p = 0; p < 16; ++p) S[p] = (f32x4){-3.0e38f, -3.0e38f, -3.0e38f, -3.0e38f};
                }
#pragma unroll
                for (int p = 0; p < 8; ++p)
#pragma unroll
                    for (int hf = 0; hf < 2; ++hf) { const LAS bf16_t* kp = CK + (32 * p + koff + 4 * hf) * 72 + 8 * g;
                        const bf16x8 k0 = *(const LAS bf16x8*)kp, k1 = *(const LAS bf16x8*)(kp + 32);
                        f32x4 acc = {0.f, 0.f, 0.f, 0.f};
                        acc = __builtin_amdgcn_mfma_f32_16x16x32_bf16(k0, q0, acc, 0, 0, 0);
                        acc = __builtin_amdgcn_mfma_f32_16x16x32_bf16(k1, q1, acc, 0, 0, 0);
                        S[16 + 2 * p + hf] = acc * 0.125f; if (hf == 1 && (p & 1)) __builtin_amdgcn_sched_barrier(0); }
                float mx = -3.0e38f;
#pragma unroll
                for (int i = 0; i < 32; ++i) mx = fmaxf(fmaxf(mx, fmaxf(S[i][0], S[i][1])), fmaxf(S[i][2], S[i][3]));
                mx = fmaxf(mx, __shfl_xor(mx, 16)); mx = fmaxf(mx, __shfl_xor(mx, 32));
                float sum = 0.f;
#pragma unroll
                for (int i = 0; i < 32; ++i) {
#pragma unroll
                    for (int j = 0; j < 4; ++j) { const float e = __expf(S[i][j] - mx); S[i][j] = e; sum += e; } }
                sum += __shfl_xor(sum, 16); sum += __shfl_xor(sum, 32);
                const float inv = 1.0f / sum;
                __syncthreads();
                {   const int tid2 = opaque(tid);
#pragma unroll
                    for (int k = 0; k < 9; ++k) { const int c = tid2 + 512 * k, dd = c / 72, part = c - dd * 72;
                        if (part * 8 < ntokw) *(LAS u32x4*)(VW + dd * 584 + part * 8) = *(const u32x4*)(PT + (size_t)(PT_V + h * 64 + dd) * RT + b * SEQ + rs0 * 64 + part * 8); }
#pragma unroll
                    for (int k = 0; k < 4; ++k) { const int c = tid2 + 512 * k, dd = c >> 5, part = c & 31;
                        *(LAS u32x4*)(CV + dd * 264 + part * 8) = *(const u32x4*)(PT + (size_t)(PT_V + h * 64 + dd) * RT + RL + b * CTXL + part * 8); } }
                __syncthreads();
                f32x4 O[4];
#pragma unroll
                for (int dt = 0; dt < 4; ++dt) O[dt] = (f32x4){0.f, 0.f, 0.f, 0.f};
#pragma unroll
                for (int p = 0; p < 16; ++p) {
                    if (p < 8 && !lat) continue;
                    u32x4 pw; pw.x = cvt_pk_bf16(S[2 * p][0], S[2 * p][1]); pw.y = cvt_pk_bf16(S[2 * p][2], S[2 * p][3]); pw.z = cvt_pk_bf16(S[2 * p + 1][0], S[2 * p + 1][1]); pw.w = cvt_pk_bf16(S[2 * p + 1][2], S[2 * p + 1][3]);
                    bf16x8 pf; __builtin_memcpy(&pf, &pw, 16);
#pragma unroll
                    for (int dt = 0; dt < 4; ++dt) { const LAS bf16_t* vp = p < 8 ? VW + (16 * dt + qn) * 584 + (pr0 + p) * 64 + bs + 8 * g : CV + (16 * dt + qn) * 264 + 32 * (p - 8) + 8 * g;
                        O[dt] = __builtin_amdgcn_mfma_f32_16x16x32_bf16(*(const LAS bf16x8*)vp, pf, O[dt], 0, 0, 0); }
                    if (p & 1) __builtin_amdgcn_sched_barrier(0);
                }
                bf16_t* op = YB + (size_t)tq * YW + YC_C + h * 64 + 4 * g;
#pragma unroll
                for (int dt = 0; dt < 4; ++dt) { u32x2 o2; o2.x = cvt_pk_bf16(O[dt][0] * inv, O[dt][1] * inv); o2.y = cvt_pk_bf16(O[dt][2] * inv, O[dt][3] * inv); *(u32x2*)(op + 16 * dt) = o2; }
            }
            __syncthreads();
            {
                const int tid = opaque(tid0), lane = tid & 63;
                LAS float* XC = (LAS float*)lds;
                LAS f32x2* AB = (LAS f32x2*)(lds + 16 * 384 * 4);
                const float* cw = a.in[7] + l * 4 * 384; const float* cb = a.in[8] + l * 384;
                const bf16_t* LW = (const bf16_t*)(ws + WS_LW) + (size_t)l * 24 * 4096;
                bf16_t* LT = (bf16_t*)(ws + WS_LT); f32x2* LAGG = (f32x2*)(ws + WS_LAGG);
                const int dir = (wave >> 2) & 1, ntile = wave & 3, tk = lane & 15, kg = lane >> 4;
                LAS float* CT = (LAS float*)(lds + 16 * 384 * 4 + 2 * 16 * 384 * 8);
                for (int i = tid; i < 768; i += 512) { CT[i] = a.in[10][l * 768 + i]; CT[768 + i] = a.in[12][l * 768 + i]; CT[1536 + i] = -8.0f * softplus(-a.in[13][l * 768 + i]); }
                float cwv[60];
#pragma unroll
                for (int i = 0; i < 12; ++i) { const int idx = tid + 512 * i, ch = idx % 384;
                    cwv[5 * i] = cw[ch]; cwv[5 * i + 1] = cw[384 + ch]; cwv[5 * i + 2] = cw[768 + ch]; cwv[5 * i + 3] = cw[1152 + ch]; cwv[5 * i + 4] = cb[ch]; }
                PIN16(cwv); PIN16(cwv + 16); PIN16(cwv + 32); PIN8(cwv + 48); asm volatile("" : "+v"(cwv[56]), "+v"(cwv[57]), "+v"(cwv[58]), "+v"(cwv[59]));
                for (int n0 = bid; n0 < 1024 + G; n0 += G) {
                    const int n = n0 < 1024 ? n0 : 1024 + ((n0 - 1024 + G - 112) % G);
                    if (n >= NCHK) continue;
                    const int r0 = 16 * n; int start, len, pos0, bb; row_seq(r0, start, len, pos0, bb);
                    __syncthreads();
                    unsigned pin[48];
#pragma unroll
                    for (int i = 0; i < 12; ++i) { const int idx = tid + 512 * i, tok = idx / 384, ch = idx - tok * 384, pos = pos0 + tok;
                        const bf16_t* pr = PR + (size_t)(r0 + tok) * LDP + PC_AC + ch;
                        pin[4 * i + 0] = pos >= 2 ? pr[-2 * LDP] : 0; pin[4 * i + 1] = pos >= 1 ? pr[-LDP] : 0; pin[4 * i + 2] = pr[0]; pin[4 * i + 3] = pos + 1 < len ? pr[LDP] : 0; }
                    PIN16(pin); PIN16(pin + 16); PIN16(pin + 32);
#pragma unroll
                    for (int i = 0; i < 12; ++i) { const int idx = tid + 512 * i, tok = idx / 384, ch = idx - tok * 384;
                        XC[idx] = cwv[5 * i + 4] + cwv[5 * i] * bflo(pin[4 * i]) + cwv[5 * i + 1] * bflo(pin[4 * i + 1]) + cwv[5 * i + 2] * bflo(pin[4 * i + 2]) + cwv[5 * i + 3] * bflo(pin[4 * i + 3]); }
                    __syncthreads();
#pragma unroll 2
                    for (int g = 0; g < 6; ++g) {
                        bf16x8 wq[4];
#pragma unroll
                        for (int ks = 0; ks < 2; ++ks) { const bf16_t* wp = LW + ((size_t)((dir * 2 + 0) * 6 + g) * 64 + 16 * ntile + tk) * 64 + 32 * ks + 8 * kg; wq[2 * ks] = *(const bf16x8*)wp; wq[2 * ks + 1] = *(const bf16x8*)(wp + 6 * 4096); }
                        asm volatile("" : "+v"(wq[0]), "+v"(wq[1]), "+v"(wq[2]), "+v"(wq[3]));
                        f32x4 ar = {0.f, 0.f, 0.f, 0.f}, ai = {0.f, 0.f, 0.f, 0.f};
#pragma unroll
                        for (int ks = 0; ks < 2; ++ks) {
                            const LAS float* xp = XC + tk * 384 + g * 64 + 32 * ks + 8 * kg;
                            const f32x4 x0 = *(const LAS f32x4*)xp, x1 = *(const LAS f32x4*)(xp + 4);
                            u32x4 xw; xw.x = cvt_pk_bf16(x0[0], x0[1]); xw.y = cvt_pk_bf16(x0[2], x0[3]); xw.z = cvt_pk_bf16(x1[0], x1[1]); xw.w = cvt_pk_bf16(x1[2], x1[3]);
                            bf16x8 xf; __builtin_memcpy(&xf, &xw, 16);
                            ar = __builtin_amdgcn_mfma_f32_16x16x32_bf16(xf, wq[2 * ks], ar, 0, 0, 0);
                            ai = __builtin_amdgcn_mfma_f32_16x16x32_bf16(xf, wq[2 * ks + 1], ai, 0, 0, 0);
                        }
                        const int ch = g * 64 + 16 * ntile + tk;
                        const float br = CT[dir * 384 + ch], bi = CT[768 + dir * 384 + ch], sp8 = CT[1536 + dir * 384 + ch];
#pragma unroll
                        for (int j = 0; j < 4; ++j) { const int tok = 4 * kg + j;
                            const float la = sigm(ar[j] + br) * sp8, y = 2.0f * la;
                            const float av = 1.0f + la * (1.0f + la * (0.5f + la * (0.16666667f + la * (0.041666667f + la * 0.0083333333f))));
                            const float om = -y * (1.0f + y * (0.5f + y * (0.16666667f + y * (0.041666667f + y * (0.0083333333f + y * 0.0013888889f)))));
                            const float bt = __builtin_sqrtf(om) * sigm(ai[j] + bi) * XC[tok * 384 + ch];
                            AB[(dir * 16 + tok) * 384 + ch] = (f32x2){av, bt}; }
                    }
                    __syncthreads();
                    if (tid < 384) {
                        float hf = 0.f, pf = 1.f, hb = 0.f, pb = 1.f;
#pragma unroll
                        for (int t = 0; t < 16; ++t) {
                            const f32x2 f = AB[t * 384 + tid], bk = AB[(16 + 15 - t) * 384 + tid];
                            hf = f[0] * hf + f[1]; pf *= f[0]; hb = bk[0] * hb + bk[1]; pb *= bk[0];
                            AB[t * 384 + tid] = (f32x2){pf, hf}; AB[(16 + 15 - t) * 384 + tid] = (f32x2){pb, hb}; }
                        LAGG[((size_t)n * 2 + 0) * 384 + tid] = (f32x2){pf, hf}; LAGG[((size_t)n * 2 + 1) * 384 + tid] = (f32x2){pb, hb};
                    }
                    __syncthreads();
#pragma unroll
                    for (int i = 0; i < 12; ++i) { const int idx = tid + 512 * i, tok = idx / 384, ch = idx - tok * 384;
                        const f32x2 f = AB[idx], bk = AB[16 * 384 + idx];
                        bf16_t* o = LT + (size_t)(r0 + tok) * 1152 + ch;
                        o[0] = f2bf(f[1] + bk[1]); o[384] = f2bf(f[0]); o[768] = f2bf(bk[0]); }
                }
                __syncthreads();
            }
            {
                const int tid = opaque(tid0), lane = tid & 63;
                constexpr int ZS = SEQ + 16;
                LAS bf16_t* R0 = (LAS bf16_t*)lds;
                LAS bf16_t* R1 = R0 + 8224;
                LAS bf16_t* ZA = R1 + 8224;
                const LAS unsigned* Rdw = (const LAS unsigned*)lds;
#define HY_ZF(b, s) ((b) * ZS + ((s) & ~63) + (((((s) >> 3) & 7) ^ (((s) >> 7) & 1)) << 3) + ((s) & 7))
                const float* hcw = a.in[14] + l * 3 * 768; const float* hcb = a.in[15] + l * 768;
                const float* nrm = (const float*)(ctl + CW_HYN);
                bf16_t* YT = (bf16_t*)(ws + WS_YT);
                const int r32 = lane & 31, hh = lane >> 5, il = r32 >> 2, bq = r32 & 3, iblk = 8 * wave + il;
                const int x0b = 4095 - r32 + 8 * hh, par = x0b & 1;
                const int abase = (par ? 4112 : 0) + ((x0b - par) >> 1);
                for (int c = bid; c < 256; c += G) {
                    __syncthreads();
#pragma unroll 1
                    for (int it = tid; it < 3 * 4 * 512; it += 512) {
                        const int arr = it >> 11, b = (it >> 9) & 3, s8 = (it & 511) * 8, ch = arr * 256 + c;
                        const bf16_t* pp = PT + (size_t)ch * RT + b * SEQ + s8;
                        const u32x4 pv = *(const u32x4*)pp;
                        const float w0 = hcw[ch], w1 = hcw[768 + ch], w2 = hcw[1536 + ch], cb0 = hcb[ch];
                        float p[10];
                        p[0] = s8 > 0 ? bf2f(pp[-1]) : 0.f; p[9] = s8 + 8 < SEQ ? bf2f(pp[8]) : 0.f;
                        p[1] = bflo(pv.x); p[2] = bfhi(pv.x); p[3] = bflo(pv.y); p[4] = bfhi(pv.y); p[5] = bflo(pv.z); p[6] = bfhi(pv.z); p[7] = bflo(pv.w); p[8] = bfhi(pv.w);
                        float z[8];
#pragma unroll
                        for (int j = 0; j < 8; ++j) z[j] = cb0 + w0 * p[j] + w1 * p[j + 1] + w2 * p[j + 2];
                        u32x4 w; w.x = cvt_pk_bf16(z[0], z[1]); w.y = cvt_pk_bf16(z[2], z[3]); w.z = cvt_pk_bf16(z[4], z[5]); w.w = cvt_pk_bf16(z[6], z[7]);
                        *(LAS u32x4*)(ZA + arr * 4 * ZS + HY_ZF(b, s8)) = w;
                    }
#pragma unroll 1
                    for (int o = 0; o < 2; ++o) {
                        const bf16_t* kf = (const bf16_t*)(ws + WS_KFL) + ((size_t)((l * 2 + 0) * 2 + o) * 256 + c) * SEQ;
                        const bf16_t* kb = (const bf16_t*)(ws + WS_KFL) + ((size_t)((l * 2 + 1) * 2 + o) * 256 + c) * SEQ;
                        { unsigned tv[16];
#pragma unroll
                          for (int q = 0; q < 16; ++q) { const int x = tid + 512 * q; tv[q] = x < 4096 ? kf[4095 - x] : (x <= 8190 ? kb[x - 4095] : (bf16_t)0); }
                          PIN16(tv);
#pragma unroll
                          for (int q = 0; q < 16; ++q) R0[tid + 512 * q] = (bf16_t)tv[q]; }
                        __syncthreads();
                        for (int x = tid; x < 8192; x += 512) R1[x] = x < 8191 ? R0[x + 1] : (bf16_t)0;
                        __syncthreads();
                        const LAS bf16_t* Z = ZA + (o == 0 ? 0 : 4 * ZS) + bq * ZS;
                        typedef float f32x16 __attribute__((ext_vector_type(16)));
                        f32x16 acc0, acc1;
#pragma unroll
                        for (int q = 0; q < 16; ++q) { acc0[q] = 0.f; acc1[q] = 0.f; }
                        const int dlo = 8 * wave - 63, dhi = 8 * wave + 7;
#define HY_AF(dst, off_) do { const LAS unsigned* a_ = ap + (off_); u32x4 w_ = {a_[0], a_[1], a_[2], a_[3]}; __builtin_memcpy(&dst, &w_, 16); } while (0)
                        {
                            bf16x8 f16, f24;
                            { const LAS unsigned* ap = Rdw + abase - 32 * dlo; HY_AF(f16, 16); HY_AF(f24, 24); }
#pragma unroll 1
                            for (int dl = dlo; dl <= dhi; ++dl) {
                                const int j = iblk - dl; const bool ok = (j >= 0) && (j < 64); const int jc = j < 0 ? 0 : (j > 63 ? 63 : j);
                                const LAS bf16_t* zp = Z + jc * 64; const int sw = (jc >> 1) & 1;
                                const LAS unsigned* ap = Rdw + abase - 32 * dl;
                                bf16x8 bf[4], fm16, fm8, f0, f8;
#pragma unroll
                                for (int kk = 0; kk < 4; ++kk) { bf16x8 t = *(const LAS bf16x8*)(zp + (((2 * kk + hh) ^ sw) << 3)); bf[kk] = ok ? t : (bf16x8){0, 0, 0, 0, 0, 0, 0, 0}; }
                                HY_AF(fm16, -16); HY_AF(fm8, -8); HY_AF(f0, 0); HY_AF(f8, 8);
                                acc0 = __builtin_amdgcn_mfma_f32_32x32x16_bf16(f0, bf[0], acc0, 0, 0, 0);  acc1 = __builtin_amdgcn_mfma_f32_32x32x16_bf16(fm16, bf[0], acc1, 0, 0, 0);
                                acc0 = __builtin_amdgcn_mfma_f32_32x32x16_bf16(f8, bf[1], acc0, 0, 0, 0);  acc1 = __builtin_amdgcn_mfma_f32_32x32x16_bf16(fm8, bf[1], acc1, 0, 0, 0);
                                acc0 = __builtin_amdgcn_mfma_f32_32x32x16_bf16(f16, bf[2], acc0, 0, 0, 0); acc1 = __builtin_amdgcn_mfma_f32_32x32x16_bf16(f0, bf[2], acc1, 0, 0, 0);
                                acc0 = __builtin_amdgcn_mfma_f32_32x32x16_bf16(f24, bf[3], acc0, 0, 0, 0); acc1 = __builtin_amdgcn_mfma_f32_32x32x16_bf16(f8, bf[3], acc1, 0, 0, 0);
                                f16 = fm16; f24 = fm8;
                            }
                        }
#undef HY_AF
                        const float inv = 1.0f / (nrm[(l * 2 + o) * 256 + c] + 1e-6f), hb = a.in[23][(l * 2 + o) * 256 + c];
                        LAS bf16_t* GI = ZA + (o + 1) * 4 * ZS;
                        const LAS bf16_t* ZI = ZA + (o == 0 ? 0 : 4 * ZS);
#pragma unroll
                        for (int q = 0; q < 16; ++q) {
                            const int a0r = (q & 3) + 8 * (q >> 2) + 4 * hh, t0 = 64 * iblk + a0r, t1 = t0 + 32;
                            const int i0 = HY_ZF(bq, t0), i1 = HY_ZF(bq, t1);
                            const float zv0 = bf2f(ZI[i0]), zv1 = bf2f(ZI[i1]);
                            const float y0 = bf2f(GI[i0]) * (acc0[q] * inv + hb * zv0), y1v = bf2f(GI[i1]) * (acc1[q] * inv + hb * zv1);
                            GI[i0] = f2bf(y0); GI[i1] = f2bf(y1v);
                        }
                        __syncthreads();
                    }
                    for (int it = tid; it < 4 * 512; it += 512) { const int b = it >> 9, s8 = (it & 511) * 8;
                        *(u32x4*)(YT + (size_t)c * RT + b * SEQ + s8) = *(const LAS u32x4*)(ZA + 2 * 4 * ZS + HY_ZF(b, s8)); }
                    if (l == 0) {
                        __syncthreads();
                        LAS float* zc = (LAS float*)lds;
                        LAS float* kc = zc + 3072;
                        LAS float* y1c = kc + 1024;
                        for (int it = tid; it < 3072; it += 512) { const int arr = it >> 10, b = (it >> 8) & 3, sx = it & 255, ch = arr * 256 + c;
                            const bf16_t* pp = PT + (size_t)ch * RT + RL + b * CTXL + sx;
                            float z = hcb[ch] + hcw[768 + ch] * bf2f(pp[0]); if (sx > 0) z += hcw[ch] * bf2f(pp[-1]); if (sx + 1 < CTXL) z += hcw[1536 + ch] * bf2f(pp[1]);
                            zc[it] = z; }
                        for (int it = tid; it < 1024; it += 512) { const int o = it >> 9, d = (it & 511) - 256;
                            const bf16_t* kfc = (const bf16_t*)(ws + WS_KFC) + ((size_t)(0 * 2 + o) * 256 + c) * CTXL; const bf16_t* kbc = (const bf16_t*)(ws + WS_KFC) + ((size_t)(1 * 2 + o) * 256 + c) * CTXL;
                            kc[it] = d >= 0 ? bf2f(kfc[d]) : (d > -256 ? bf2f(kbc[-d]) : 0.f); }
                        __syncthreads();
#pragma unroll 1
                        for (int o = 0; o < 2; ++o) {
                            const float inv = 1.0f / (nrm[1024 + o * 256 + c] + 1e-6f), hb = a.in[23][o * 256 + c];
                            for (int it = tid; it < 1024; it += 512) { const int b = it >> 8, t = it & 255;
                                const LAS float* zi = o == 0 ? zc + b * 256 : y1c + b * 256;
                                const LAS float* kk = kc + o * 512 + 256 + t;
                                float acc = 0.f;
#pragma unroll 16
                                for (int sx = 0; sx < CTXL; ++sx) acc += kk[-sx] * zi[sx];
                                const float y = zc[(o + 1) * 1024 + b * 256 + t] * (acc * inv + hb * zi[t]);
                                if (o == 0) y1c[it] = y; else YT[(size_t)c * RT + RL + b * CTXL + t] = f2bf(y); }
                            __syncthreads();
                        }
                    }
                }
#undef HY_ZF
                __syncthreads();
            }
            {
                const pg8::TabSched S{PARTS.p + 18 + l * 3, (const char*)ws, 1, 80, G, (bid + 80) % G};
                pg8::EpiS5State E{(float*)(ws + WS_S5S)};
                pg8::gemm_phase<512, 256>(lds, S, E);
            }
        }
        SEAM(P0 + 2);
        if (((PHMASK >> 14) & 1) && IN(P0 + 3)) {
            const int tid = opaque(tid0), lane = tid & 63;
            LAS float* st = (LAS float*)lds;
            const float* S5S = (const float*)(ws + WS_S5S); bf16_t* US = (bf16_t*)(ws + WS_US);
            for (int u = bid; u < 128; u += G) {
                const int d = u & 1, g = (u >> 1) & 15, b = u >> 5;
                __syncthreads();
                for (int i = tid; i < 272 * 32; i += 512) { const int q = i >> 5, c4 = (i & 31) * 4; const int n = q < 16 ? 1024 + 16 * b + q : 256 * b + (q - 16);
                    const f32x4 v = *(const f32x4*)(S5S + ((size_t)g * NCHKP + n) * 256 + d * 128 + c4);
                    st[q * 128 + c4] = v[0]; st[q * 128 + c4 + 1] = v[1]; st[q * 128 + c4 + 2] = v[2]; st[q * 128 + c4 + 3] = v[3]; }
                __syncthreads();
                if (wave == 0) {
                    const float* ab = (const float*)(ws + WS_AB16) + ((size_t)((l * 2 + d) * 16 + g) * 64 + lane) * 2;
                    const float ar = ab[0], ai = ab[1];
                    float hr = 0.f, hi = 0.f;
#pragma unroll 1
                    for (int k0 = 0; k0 < 272; k0 += 8) {
                        f32x2 sv[8]; int nn[8];
#pragma unroll
                        for (int j = 0; j < 8; ++j) { const int k = k0 + j; const int q = d == 0 ? k : (k < 16 ? 15 - k : 287 - k);
                            nn[j] = q < 16 ? 1024 + 16 * b + q : 256 * b + (q - 16); sv[j] = *(const LAS f32x2*)(st + q * 128 + 2 * lane); }
#pragma unroll
                        for (int j = 0; j < 8; ++j) {
                            *(unsigned*)(US + ((size_t)g * NCHKP + nn[j]) * 512 + 256 + d * 128 + 2 * lane) = cvt_pk_bf16(hr, hi);
                            const float nr = ar * hr - ai * hi + sv[j][0], ni = ar * hi + ai * hr + sv[j][1];
                            hr = nr; hi = ni; }
                    }
                }
            }
            __syncthreads();
            for (int uq = bid; uq < 176; uq += G) { if (uq < 128) continue; const int u = uq - 128;
                const int cb6 = u % 6, d = (u / 6) & 1, b = u / 12;
                LAS f32x2* sa = (LAS f32x2*)lds;
                const f32x2* LAGG = (const f32x2*)(ws + WS_LAGG); float* HIN = (float*)(ws + WS_LHIN);
                __syncthreads();
                for (int i = tid; i < 272 * 64; i += 512) { const int q = i >> 6, c = i & 63; const int n = q < 16 ? 1024 + 16 * b + q : 256 * b + (q - 16);
                    sa[i] = LAGG[((size_t)n * 2 + d) * 384 + cb6 * 64 + c]; }
                __syncthreads();
                if (wave == 0) {
                    float h = 0.f;
#pragma unroll 1
                    for (int k0 = 0; k0 < 272; k0 += 8) {
                        f32x2 sv[8]; int nn[8];
#pragma unroll
                        for (int j = 0; j < 8; ++j) { const int k = k0 + j; const int q = d == 0 ? k : (k < 16 ? 15 - k : 287 - k);
                            nn[j] = q < 16 ? 1024 + 16 * b + q : 256 * b + (q - 16); sv[j] = sa[q * 64 + lane]; }
#pragma unroll
                        for (int j = 0; j < 8; ++j) { HIN[((size_t)nn[j] * 2 + d) * 384 + cb6 * 64 + lane] = h; h = sv[j][0] * h + sv[j][1]; }
                    }
                }
            }
            __syncthreads();
            if (bid >= 176) pull_convert(a, JT_MOED, lds, MISC, ctl + CW_QUEUE + 64, 3);
        }
        SEAM(P0 + 3);
        if (((PHMASK >> 15) & 1) && IN(P0 + 4)) {
            const pg8::TabSched S{PARTS.p + 19 + l * 3, (const char*)ws, 1, 80, G, bid};
            pg8::EpiS5Main E{(bf16_t*)(ws + WS_GL), PR, a.in[32] + l * 256};
            pg8::gemm_phase<512, 512>(lds, S, E);
            {
                const int tid = opaque(tid0);
                const bf16_t* YT = (const bf16_t*)(ws + WS_YT);
                LAS bf16_t* tl = (LAS bf16_t*)lds;
                const int nrt = nMrow * 4;
                const int nb0 = G > 160 ? 80 : 0, vb = bid - nb0, vG = G - nb0;
                if (vb >= 0) for (int t = vb; t < 4 * nrt; t += vG) {
                    const int c0 = (t & 3) * 64, r0 = (t >> 2) * 64;
                    __syncthreads();
                    { const int cc = tid >> 3, r8 = (tid & 7) * 8; *(LAS u32x4*)(tl + cc * 72 + r8) = *(const u32x4*)(YT + (size_t)(c0 + cc) * RT + r0 + r8); }
                    __syncthreads();
                    { const int rr = tid >> 3, c8 = (tid & 7) * 8; unsigned short e[8];
#pragma unroll
                        for (int j = 0; j < 8; ++j) e[j] = tl[(c8 + j) * 72 + rr];
                        u32x4 w; w.x = e[0] | ((unsigned)e[1] << 16); w.y = e[2] | ((unsigned)e[3] << 16); w.z = e[4] | ((unsigned)e[5] << 16); w.w = e[6] | ((unsigned)e[7] << 16);
                        *(u32x4*)(YB + (size_t)(r0 + rr) * YW + YC_B + c0 + c8) = w; }
                }
                __syncthreads();
            }
            {
                const int tid = opaque(tid0);
                const bf16_t* LT = (const bf16_t*)(ws + WS_LT); const float* HIN = (const float*)(ws + WS_LHIN);
                const int nrows = nMrow * 256;
                const int nb0 = G > 160 ? 80 : 0, vb = bid - nb0, vG = G - nb0;
                if (vb >= 0) for (int it = vb * 512 + tid; it < nrows * 48; it += vG * 512) {
                    const int r = it / 48, c8 = (it - r * 48) * 8, n = r >> 4;
                    const u32x4 gt = *(const u32x4*)(PR + (size_t)r * LDP + PC_AG + c8);
                    const bf16_t* lt = LT + (size_t)r * 1152 + c8;
                    const u32x4 sv = *(const u32x4*)lt, pf = *(const u32x4*)(lt + 384), pb = *(const u32x4*)(lt + 768);
                    const float* hf = HIN + ((size_t)n * 2 + 0) * 384 + c8; const float* hb = hf + 384;
                    const f32x4 hf0 = *(const f32x4*)hf, hf1 = *(const f32x4*)(hf + 4), hb0 = *(const f32x4*)hb, hb1 = *(const f32x4*)(hb + 4);
                    u32x4 w;
                    w.x = cvt_pk_bf16(gelu_f(bflo(gt.x)) * (bflo(sv.x) + bflo(pf.x) * hf0[0] + bflo(pb.x) * hb0[0]), gelu_f(bfhi(gt.x)) * (bfhi(sv.x) + bfhi(pf.x) * hf0[1] + bfhi(pb.x) * hb0[1]));
                    w.y = cvt_pk_bf16(gelu_f(bflo(gt.y)) * (bflo(sv.y) + bflo(pf.y) * hf0[2] + bflo(pb.y) * hb0[2]), gelu_f(bfhi(gt.y)) * (bfhi(sv.y) + bfhi(pf.y) * hf0[3] + bfhi(pb.y) * hb0[3]));
                    w.z = cvt_pk_bf16(gelu_f(bflo(gt.z)) * (bflo(sv.z) + bflo(pf.z) * hf1[0] + bflo(pb.z) * hb1[0]), gelu_f(bfhi(gt.z)) * (bfhi(sv.z) + bfhi(pf.z) * hf1[1] + bfhi(pb.z) * hb1[1]));
                    w.w = cvt_pk_bf16(gelu_f(bflo(gt.w)) * (bflo(sv.w) + bflo(pf.w) * hf1[2] + bflo(pb.w) * hb1[2]), gelu_f(bfhi(gt.w)) * (bfhi(sv.w) + bfhi(pf.w) * hf1[3] + bfhi(pb.w) * hb1[3]));
                    *(u32x4*)(YB + (size_t)r * YW + YC_A + c8) = w;
                }
                if (vb >= 0) pull_convert(a, JT_MOED, lds, MISC, ctl + CW_QUEUE + 64, 5);
            }
        }
        SEAM(P0 + 4);
        if (((PHMASK >> 15) & 1) && IN(P0 + 5)) {
            const pg8::TabSched S{PARTS.p + 20 + l * 3, (const char*)ws, 1, nMrow, G, bid};
            pg8::EpiS5Glu E{YB, (const bf16_t*)(ws + WS_GL), a.in[34] + l * 256};
            pg8::gemm_phase<256, 256>(lds, S, E);
            if (bid >= nMrow) pull_convert(a, JT_MOED, lds, MISC, ctl + CW_QUEUE + 64, 3);
        }
        SEAM(P0 + 5);
        if (((PHMASK >> 3) & 1) && IN(P0 + 6)) {
            const pg8::MergeSched S{(const char*)ws, (long long)WS_YB, (long long)(WS_WL + (size_t)l * SZ_WL + SZ_WINR + SZ_WINHY), 64, G, bid, l == 0 ? 64 : 0};
            pg8::EpiGate E{ws + WS_GQ, UB, (bf16_t*)(ws + WS_MGC)};
            pg8::gemm_phase<1280, 1280>(lds, S, E);
        }
        SEAM(P0 + 6);
        if (((PHMASK >> 4) & 1) && IN(P0 + 7)) {
            const pg8::TabSched S{l == 0 ? PARTS.p + 24 : PARTS.p + 14, (const char*)ws, l == 0 ? 2 : 1, l == 0 ? 256 + 64 : 256, G, bid};
            pg8::EpiRes E{PRE, xlat, xctx, MODL + 2048, (float*)(ws + WS_EXTRA)};
            pg8::gemm_phase<1024, 1024>(lds, S, E);
        }
        SEAM(P0 + 7);
        if (((PHMASK >> 5) & 1) && IN(P0 + 8)) {
            const int lane = opaque(tid0) & 63;
            if (l == 1) { pull_convert(a, JT_MOED, lds, MISC, ctl + CW_QUEUE + 64, 1 << 30); convert_tiles_pipelined(a, JT_MOE, (LAS float*)lds, bid, G); }
            const float* lg = a.in[40] + l * D; const float* lb = a.in[41] + l * D;
            const int nrows = nMrow * 256;
            for (int r = bid * 8 + wave; r < nrows; r += G * 8) {
                const float* mv = MODL + (size_t)(r < RL ? (r >> 12) : 4) * 6144;
                RowV pre;
                if (r < RL) { const RowV xin = row_load(xlat + (size_t)r * D, lane), ga = row_load_bf16((const bf16_t*)PRE + (size_t)r * D, lane);
#pragma unroll
                    for (int i = 0; i < 4; ++i) pre.v[i] = xin.v[i] * ALPHA + ga.v[i]; }
                else { const float* pp = (const float*)(ws + WS_EXTRA) + (size_t)(r - RL) * D; const RowV xin = row_load(ctx_in + (size_t)(r - RL) * D, lane), p0 = row_load(pp, lane), p1 = row_load(pp + (size_t)RC * D, lane), p2 = row_load(pp + (size_t)2 * RC * D, lane), p3 = row_load(pp + (size_t)3 * RC * D, lane);
#pragma unroll
                    for (int i = 0; i < 4; ++i) pre.v[i] = xin.v[i] * ALPHA + ((p0.v[i] + p1.v[i]) + (p2.v[i] + p3.v[i])); }
                const RowV x1 = row_affine(row_norm(pre), lg, lb, lane);
                row_store(r < RL ? a.out + (size_t)r * D : XSC + (size_t)(r - RL) * D, lane, x1);
                const RowV u2 = row_modulate(row_norm(x1), mv + 3072, mv + 4096, lane);
                row_store_bf16(UB + (size_t)r * D, lane, u2);
                if (l == 1) {
                    float lg8[8];
#pragma unroll
                    for (int e = 0; e < 8; ++e) lg8[e] = 0.f;
                    f32x4 rw[32];
#pragma unroll
                    for (int q = 0; q < 16; ++q) { const float* wp = a.in[47] + (size_t)(256 * (q >> 2) + 4 * lane + (q & 3)) * 8; rw[2 * q] = *(const f32x4*)wp; rw[2 * q + 1] = *(const f32x4*)(wp + 4); }
                    PIN16(rw); PIN16(rw + 16);
#pragma unroll
                    for (int i = 0; i < 4; ++i)
#pragma unroll
                        for (int j = 0; j < 4; ++j) { const float uv = u2.v[i][j];
                            const f32x4 w0 = rw[2 * (4 * i + j)], w1 = rw[2 * (4 * i + j) + 1];
                            lg8[0] += uv * w0[0]; lg8[1] += uv * w0[1]; lg8[2] += uv * w0[2]; lg8[3] += uv * w0[3]; lg8[4] += uv * w1[0]; lg8[5] += uv * w1[1]; lg8[6] += uv * w1[2]; lg8[7] += uv * w1[3]; }
#pragma unroll
                    for (int e = 0; e < 8; ++e) lg8[e] = wave_sum(lg8[e]);
                    if (lane == 0) {
                        int i1 = 0; float v1 = lg8[0];
#pragma unroll
                        for (int e = 1; e < 8; ++e) if (lg8[e] > v1) { v1 = lg8[e]; i1 = e; }
                        int i2 = 0; float v2 = -3.0e38f;
#pragma unroll
                        for (int e = 0; e < 8; ++e) if (e != i1 && lg8[e] > v2) { v2 = lg8[e]; i2 = e; }
                        const float e2 = expf(v2 - v1), w1 = 1.f / (1.f + e2), w2 = e2 / (1.f + e2);
                        int* tk = (int*)(ws + WS_TOK) + (size_t)r * 8;
                        tk[0] = i1; tk[1] = i2; ((float*)tk)[2] = w1; ((float*)tk)[3] = w2;
                        tk[4] = (int)atomicAdd(ctl + CW_MOECNT + 64 * i1, 1u); tk[5] = (int)atomicAdd(ctl + CW_MOECNT + 64 * i2, 1u);
                    }
                }
            }
        }
        SEAM(P0 + 8);
        if (l == 0) {
            if (((PHMASK >> 6) & 1) && IN(P0 + 9)) {
                const pg8::TabSched S{PARTS.p + 16, (const char*)ws, 1, 68 * 22, G, bid};
                pg8::EpiSwiglu E{(bf16_t*)(ws + WS_H), FF_DENSE, 0};
                pg8::gemm_phase<1024, 1024>(lds, S, E);
            }
            SEAM(P0 + 9);
            if (((PHMASK >> 7) & 1) && IN(P0 + 10)) {
                const pg8::TabSched S{PARTS.p + 26, (const char*)ws, 3, 256 + 48 + 16, G, bid};
                pg8::EpiRes E{PRE, a.out, XSC, MODL + 5120, (float*)(ws + WS_EXTRA)};
                pg8::gemm_phase<FF_DENSE, FF_DENSE>(lds, S, E);
            }
            SEAM(P0 + 10);
            if (((PHMASK >> 8) & 1) && IN(P0 + 11)) {
                const int lane = opaque(tid0) & 63;
                const float* lg = a.in[42]; const float* lb = a.in[43];
                const float* MODN = MOD + (size_t)5 * 6144;
                for (int r = bid * 8 + wave; r < RT; r += G * 8) {
                    const float* mv = MODN + (size_t)(r < RL ? (r >> 12) : 4) * 6144;
                    RowV pre;
                    if (r < RL) { const RowV xin = row_load(a.out + (size_t)r * D, lane), ga = row_load_bf16((const bf16_t*)PRE + (size_t)r * D, lane);
#pragma unroll
                        for (int i = 0; i < 4; ++i) pre.v[i] = xin.v[i] * ALPHA + ga.v[i]; }
                    else { const float* pp = (const float*)(ws + WS_EXTRA) + (size_t)(r - RL) * D; const RowV xin = row_load(XSC + (size_t)(r - RL) * D, lane), p0 = row_load(pp, lane), p1 = row_load(pp + (size_t)RC * D, lane), p2 = row_load(pp + (size_t)2 * RC * D, lane), p3 = row_load(pp + (size_t)3 * RC * D, lane);
#pragma unroll
                        for (int i = 0; i < 4; ++i) pre.v[i] = xin.v[i] * ALPHA + ((p0.v[i] + p1.v[i]) + (p2.v[i] + p3.v[i])); }
                    const RowV x2 = row_affine(row_norm(pre), lg, lb, lane);
                    row_store(r < RL ? a.out + (size_t)r * D : XSC + (size_t)(r - RL) * D, lane, x2);
                    row_store_bf16(UB + (size_t)r * D, lane, row_modulate(row_norm(x2), mv, mv + 1024, lane));
                }
            }
            SEAM(P0 + 11);
        } else {
            bf16_t* AG = (bf16_t*)(ws + WS_AG); float* slotw = (float*)(ws + WS_SLOTW); int* tile_e = (int*)(ws + WS_TILEE);
            if (((PHMASK >> 9) & 1) && IN(P0 + 9)) {
                const int tid = opaque(tid0), lane = tid & 63;
                int ts[NE + 1]; ts[0] = 0;
#pragma unroll
                for (int e = 0; e < NE; ++e) { const unsigned c = __hip_atomic_load(ctl + CW_MOECNT + 64 * e, __ATOMIC_RELAXED, __HIP_MEMORY_SCOPE_AGENT); ts[e + 1] = ts[e] + (int)((c + 255u) >> 8); }
                if (bid == 0) for (int mt = tid; mt < ts[NE]; mt += 512) { int e = 0;
#pragma unroll
                    for (int k = 1; k < NE; ++k) e += (mt >= ts[k]) ? 1 : 0;
                    tile_e[mt] = e; }
                for (int r = bid * 8 + wave; r < RL; r += G * 8) {
                    int* tk = (int*)(ws + WS_TOK) + (size_t)r * 8;
                    const u32x4 v0 = *(const u32x4*)(UB + (size_t)r * D + lane * 16), v1 = *(const u32x4*)(UB + (size_t)r * D + lane * 16 + 8);
#pragma unroll
                    for (int k = 0; k < 2; ++k) {
                        const int e = tk[k], pos = tk[4 + k];
                        int st = 0;
#pragma unroll
                        for (int q = 0; q < NE; ++q) st = (e == q) ? ts[q] : st;
                        const int srow = st * 256 + pos;
                        *(u32x4*)(AG + (size_t)srow * D + lane * 16) = v0; *(u32x4*)(AG + (size_t)srow * D + lane * 16 + 8) = v1;
                        if (lane == 0) { slotw[srow] = ((const float*)tk)[2 + k]; tk[6 + k] = srow; }
                    }
                }
            }
            SEAM(P0 + 9);
            int ttl = 0;
            if (lo <= P0 + 13 && P0 + 10 < hi) {
#pragma unroll
                for (int e = 0; e < NE; ++e) { const unsigned c = __hip_atomic_load(ctl + CW_MOECNT + 64 * e, __ATOMIC_RELAXED, __HIP_MEMORY_SCOPE_AGENT); ttl += (int)((c + 255u) >> 8); }
                ttl = __builtin_amdgcn_readfirstlane(ttl);
            }
#pragma unroll
            for (int pass = 0; pass < 2; ++pass) {
                const int tile0 = pass * MOE_P0; int ntile = pass == 0 ? (ttl < MOE_P0 ? ttl : MOE_P0) : ttl - MOE_P0; ntile = ntile < 0 ? 0 : (ntile > MOE_HCAP ? MOE_HCAP : ntile);
                if (((PHMASK >> 10) & 1) && IN(P0 + 10 + 2 * pass)) {
                    const pg8::MoeSched S{(const char*)AG + (size_t)tile0 * 256 * 1024 * 2, (const char*)(ws + WS_MOEGU), tile_e, 256u * 1024u * 2u, 256u * 1024u * 2u, (size_t)2 * FF_E * 1024 * 2, 28, 16, tile0, ntile, G, bid};
                    pg8::EpiSwiglu E{(bf16_t*)(ws + WS_HM), FF_E, tile0};
                    pg8::gemm_phase<1024, 1024>(lds, S, E);
                }
                SEAM(P0 + 10 + 2 * pass);
                if (((PHMASK >> 11) & 1) && IN(P0 + 11 + 2 * pass)) {
                    pg8::EpiMoeDown E{AG, slotw, (float*)(ws + WS_O2X)};
                    { const int nfull = pass == 0 ? ntile : (ttl < 128 ? ttl : 128) - MOE_P0, nex = pass == 0 ? 0 : ttl - 128;
                        const pg8::MoeTailSched S{(const char*)(ws + WS_HM), (const char*)(ws + WS_MOED), tile_e, tile0, nfull < 0 ? 0 : nfull, nex < 0 ? 0 : nex, G, bid};
                        pg8::gemm_phase<FF_E, FF_E>(lds, S, E); }
                }
                SEAM(P0 + 11 + 2 * pass);
            }
            if (((PHMASK >> 12) & 1) && IN(P0 + 14)) {
                const int lane = opaque(tid0) & 63;
                const float* lg = a.in[42] + D; const float* lb = a.in[43] + D;
                for (int r = bid * 8 + wave; r < RL; r += G * 8) {
                    const int* tk = (const int*)(ws + WS_TOK) + (size_t)r * 8;
                    const int sa = tk[6], sb = tk[7];
                    const bf16_t* oa = AG + (size_t)sa * D; const bf16_t* ob = AG + (size_t)sb * D;
                    const float* gv = MODL + (size_t)(r >> 12) * 6144 + 5120;
                    RowV x1 = row_load(a.out + (size_t)r * D, lane), gq = row_load(gv, lane), pre;
                    u32x2 va[4], vb[4];
#pragma unroll
                    for (int i = 0; i < 4; ++i) { va[i] = *(const u32x2*)(oa + 256 * i + 4 * lane); vb[i] = *(const u32x2*)(ob + 256 * i + 4 * lane); }
                    asm volatile("" : "+v"(va[0]), "+v"(va[1]), "+v"(va[2]), "+v"(va[3]), "+v"(vb[0]), "+v"(vb[1]), "+v"(vb[2]), "+v"(vb[3]), "+v"(x1.v[0]), "+v"(x1.v[1]), "+v"(x1.v[2]), "+v"(x1.v[3]), "+v"(gq.v[0]), "+v"(gq.v[1]), "+v"(gq.v[2]), "+v"(gq.v[3]));
#pragma unroll
                    for (int i = 0; i < 4; ++i) {
                        f32x4 fa = {bflo(va[i].x), bfhi(va[i].x), bflo(va[i].y), bfhi(va[i].y)}, fb = {bflo(vb[i].x), bfhi(vb[i].x), bflo(vb[i].y), bfhi(vb[i].y)};
                        if (sa >= 128 * 256) { const float* px = (const float*)(ws + WS_O2X) + (size_t)(sa - 128 * 256) * D + 256 * i + 4 * lane; fa = (*(const f32x4*)px + *(const f32x4*)(px + (size_t)2048 * D)) + (*(const f32x4*)(px + (size_t)2 * 2048 * D) + *(const f32x4*)(px + (size_t)3 * 2048 * D)); }
                        if (sb >= 128 * 256) { const float* px = (const float*)(ws + WS_O2X) + (size_t)(sb - 128 * 256) * D + 256 * i + 4 * lane; fb = (*(const f32x4*)px + *(const f32x4*)(px + (size_t)2048 * D)) + (*(const f32x4*)(px + (size_t)2 * 2048 * D) + *(const f32x4*)(px + (size_t)3 * 2048 * D)); }
                        pre.v[i] = x1.v[i] * ALPHA + gq.v[i] * (fa + fb); }
                    row_store(a.out + (size_t)r * D, lane, row_affine(row_norm(pre), lg, lb, lane));
                }
            }
        }
    }
#undef IN
#undef SEAM
}

}

extern "C" void kernel_launch(void* const* d_in, const int* in_sizes, int n_in, void* d_out, int out_size, void* d_ws, size_t ws_size, hipStream_t stream) {
    static int grid = 0;
    if (grid == 0) {
        if (n_in != 51 || ws_size < WS_END) { grid = -1; return; }
        int dev = 0, cus = 0;
        if (hipGetDevice(&dev) != hipSuccess || hipDeviceGetAttribute(&cus, hipDeviceAttributeMultiprocessorCount, dev) != hipSuccess) { grid = -1; return; }
        if (hipFuncSetAttribute((const void*)mk_fwd, hipFuncAttributeMaxDynamicSharedMemorySize, LDS_BYTES) != hipSuccess) { grid = -1; return; }
        grid = cus;
    }
    if (grid < 0) return;
    const float* const* in = (const float* const*)d_in;
    unsigned char* ws = (unsigned char*)d_ws;
    (void)hipMemsetAsync(ws + WS_CTL, 0, CTL_BYTES + al256(2 * 5 * 6144 * 4), stream);
    for (int l = 0; l < 2; ++l) (void)hipMemsetAsync(ws + WS_WL + (size_t)l * SZ_WL + SZ_WINR + (size_t)1152 * 1024 * 2, 0, (size_t)128 * 1024 * 2, stream);
    Args a{};
    for (int i = 0; i < 51; ++i) a.in[i] = in[i];
    a.out = (float*)d_out; a.ws = ws;
    int nlaunch = 0;
    auto run1 = [&](int lo, int hi) { a.ph_lo = lo; a.ph_hi = hi; a.bar_region = nlaunch < 5 ? nlaunch : 5; nlaunch++; hipLaunchKernelGGL(mk_fwd, dim3(grid), dim3(512), LDS_BYTES, stream, a); };
    auto run = [&](int lo, int hi) {
#if defined(SPLIT) && SPLIT
        for (int k = lo; k < hi; ++k) { const int q = (k - 1) % NPH_LAYER, l = (k - 1) / NPH_LAYER; if (k > 0 && (q > 14 || (l == 0 && q > 11) || (l == 1 && q == 0))) continue; run1(k, k + 1); }
#else
        run1(lo, hi);
#endif
    };
    run(0, 1 + 2 * NPH_LAYER);
}
```

```cpp
#include <hip/hip_runtime.h>
#include <stdint.h>
#include <math.h>

#define LAS __attribute__((address_space(3)))
typedef unsigned short bf16_t;
typedef short bf16x8 __attribute__((ext_vector_type(8)));
typedef float f32x4 __attribute__((ext_vector_type(4)));
typedef float f32x2 __attribute__((ext_vector_type(2)));
typedef unsigned u32x4 __attribute__((ext_vector_type(4)));
typedef unsigned u32x2 __attribute__((ext_vector_type(2)));

namespace {
constexpr int D = 1024, NB = 4, SEQ = 4096, CTXL = 256;
constexpr int RL = NB * SEQ, RC = NB * CTXL, RT = RL + RC;
constexpr int IN_COLS = 7040;
constexpr int FF_DENSE = 2816, NE = 8, FF_E = 3584;
constexpr float ALPHA = 1.41421356237309515f;
constexpr int LDP = 1792, PC_AG = 0, PC_AC = 384, PC_D = 768, PC_Q = 1024, PC_K = 1408, PC_G = 1792;
constexpr int NPT = 1280, PT_V = 768;
constexpr int YW = 1280, YC_A = 0, YC_B = 384, YC_C = 640, YC_D = 1024;
constexpr int MOE_P0 = 64, MOE_HCAP = 72;
constexpr int MOE_ROWS_MAX = 2 * RL + NE * 256;

constexpr size_t al256(size_t x) { return (x + 255) & ~(size_t)255; }
constexpr size_t WS_CTL = 0, CTL_BYTES = 131072;
constexpr int CW_BAR = 0;
constexpr int CW_MOECNT = 24576;
constexpr int CW_QUEUE = 28672;
constexpr int CW_HYN = 29696;
constexpr size_t WS_MOD = WS_CTL + CTL_BYTES;
constexpr size_t WS_HYN = WS_MOD + al256(2 * 5 * 6144 * 4);
constexpr size_t WS_S5AB = WS_HYN + 4096;
constexpr size_t WS_S5BB = WS_S5AB + 16384;
constexpr size_t WS_AB16 = WS_S5BB + 262144;
constexpr size_t WS_TILEE = WS_AB16 + 32768;
constexpr size_t WS_TOK = WS_TILEE + 1024;
constexpr size_t WS_SLOTW = WS_TOK + (size_t)RL * 32;
constexpr size_t WS_KFL = al256(WS_SLOTW + (size_t)MOE_ROWS_MAX * 4);
constexpr size_t WS_KFC = WS_KFL + (size_t)2 * 1024 * SEQ * 2;
constexpr size_t WS_XSC = WS_KFC + (size_t)1024 * CTXL * 2;
constexpr size_t WS_UB = WS_XSC + (size_t)RC * D * 4;
constexpr size_t SZ_WINR = (size_t)(1792 + 4096) * 1024 * 2, SZ_WINHY = (size_t)NPT * 1024 * 2, SZ_WBR = (size_t)1024 * 1280 * 2, SZ_WOUT = (size_t)1024 * 1024 * 2;
constexpr size_t SZ_WL = SZ_WINR + SZ_WINHY + SZ_WBR + SZ_WOUT;
constexpr size_t WS_WL = WS_UB + (size_t)RT * D * 2;
constexpr size_t WS_FFGU = WS_WL + 2 * SZ_WL;
constexpr size_t WS_FFD = WS_FFGU + (size_t)2 * FF_DENSE * 1024 * 2;
constexpr size_t WS_WGLU = WS_FFD + (size_t)1024 * FF_DENSE * 2;
constexpr size_t WS_OPS = WS_WGLU + (size_t)2 * 256 * 256 * 2;
constexpr size_t WS_OPY = WS_OPS + (size_t)32 * 256 * 256 * 2;
constexpr size_t WS_LW = WS_OPY + (size_t)32 * 256 * 512 * 2;
constexpr size_t WS_PR = WS_LW + (size_t)48 * 4096 * 2;
constexpr size_t WS_PT = WS_PR + (size_t)RT * 5888 * 2;
constexpr size_t WS_GQ = WS_PR + (size_t)RT * LDP * 2;
constexpr size_t WS_YB = WS_PT + (size_t)NPT * RT * 2;
constexpr size_t WS_PRE = WS_YB + (size_t)RT * YW * 2;
constexpr size_t WS_EXTRA = WS_PRE + (size_t)RT * D * 4;
constexpr size_t SZ_EXTRA = (size_t)2 * RT * 384 * 4 + (size_t)RT * 256 * 4;
constexpr size_t WS_END = WS_EXTRA + SZ_EXTRA;
constexpr int NCHK = RT / 16, NCHKP = 1280;
constexpr size_t WS_US = WS_PRE;
constexpr size_t WS_S5S = WS_US + (size_t)16 * NCHKP * 512 * 2;
constexpr size_t WS_GL = WS_S5S + (size_t)16 * NCHKP * 256 * 4;
static_assert(WS_GL + (size_t)RT * 256 * 2 <= WS_EXTRA, "s5 overlay");
constexpr size_t WS_H = WS_PR;
constexpr size_t WS_MOEGU = WS_PR;
constexpr size_t WS_MOED = WS_GQ + (size_t)RT * 4096;
constexpr size_t WS_HM = WS_MOED + (size_t)NE * 1024 * FF_E * 2;
static_assert(WS_MOEGU + (size_t)NE * 2 * FF_E * 1024 * 2 <= WS_MOED && (size_t)RT * FF_DENSE * 2 <= WS_MOED - WS_PR, "moe gate/up weights and the dense hidden must stay clear of the down weights");
constexpr size_t WS_LT = WS_EXTRA;
constexpr size_t WS_LAGG = WS_LT + (size_t)RT * 3 * 384 * 2;
constexpr size_t WS_LHIN = WS_LAGG + (size_t)NCHK * 2 * 384 * 8;
constexpr size_t WS_YT = WS_LHIN + (size_t)NCHK * 2 * 384 * 4;
static_assert(WS_YT + (size_t)256 * RT * 2 <= WS_EXTRA + SZ_EXTRA, "lru / hyena overlay");
constexpr size_t WS_MGC = WS_EXTRA + (size_t)4 * RC * D * 4;
constexpr size_t WS_AG = WS_EXTRA;
static_assert(WS_HM + (size_t)MOE_HCAP * 256 * FF_E * 2 <= WS_EXTRA, "moe hidden overlay");
constexpr size_t WS_O2X = WS_PRE + ((size_t)32 << 20);
static_assert(WS_HM + (size_t)MOE_HCAP * 256 * FF_E * 2 <= WS_O2X && WS_O2X + (size_t)4 * 2048 * D * 4 <= WS_EXTRA, "moe excess sums");
static_assert((size_t)MOE_ROWS_MAX * 1024 * 2 <= SZ_EXTRA, "moe gather overlay");
static_assert((size_t)RT * FF_DENSE * 2 <= (size_t)RT * 5888 * 2 && WS_GQ + (size_t)RT * 4096 <= WS_PT, "dense hidden overlay / gate bytes");

__device__ __forceinline__ float sigm(float x) { return __builtin_amdgcn_rcpf(1.f + __builtin_amdgcn_exp2f(-1.44269504089f * x)); }
__device__ __forceinline__ float sigm_acc(float x) { return 1.f / (1.f + expf(-x)); }
__device__ __forceinline__ float silu_acc(float x) { return x / (1.f + expf(-x)); }
__device__ __forceinline__ float gelu_t(float x) { return 0.5f * x * (1.f + tanhf(0.7978845608028654f * (x + 0.044715f * x * x * x))); }
__device__ __forceinline__ float gelu_f(float x) { return x * sigm(1.5957691216057308f * (x + 0.044715f * x * x * x)); }
__device__ __forceinline__ float softplus(float x) { return fmaxf(x, 0.f) + log1pf(expf(-fabsf(x))); }
template <int CTRL> __device__ __forceinline__ float dpp_mov(float v) { return __int_as_float(__builtin_amdgcn_update_dpp(0, __float_as_int(v), CTRL, 0xf, 0xf, false)); }
__device__ __forceinline__ float wave_sum(float v) {
    v += dpp_mov<0xB1>(v);
    v += dpp_mov<0x4E>(v);
    v += dpp_mov<0x141>(v);
    v += dpp_mov<0x140>(v);
    const int iv = __float_as_int(v);
    return (__int_as_float(__builtin_amdgcn_readlane(iv, 0)) + __int_as_float(__builtin_amdgcn_readlane(iv, 16))) + (__int_as_float(__builtin_amdgcn_readlane(iv, 32)) + __int_as_float(__builtin_amdgcn_readlane(iv, 48)));
}
__device__ __forceinline__ float wave_max(float v) {
    v = fmaxf(v, dpp_mov<0xB1>(v)); v = fmaxf(v, dpp_mov<0x4E>(v)); v = fmaxf(v, dpp_mov<0x141>(v)); v = fmaxf(v, dpp_mov<0x140>(v));
    const int iv = __float_as_int(v);
    return fmaxf(fmaxf(__int_as_float(__builtin_amdgcn_readlane(iv, 0)), __int_as_float(__builtin_amdgcn_readlane(iv, 16))), fmaxf(__int_as_float(__builtin_amdgcn_readlane(iv, 32)), __int_as_float(__builtin_amdgcn_readlane(iv, 48))));
}
__device__ __forceinline__ float bf2f(bf16_t b) { return __uint_as_float(((unsigned)b) << 16); }
__device__ __forceinline__ bf16_t f2bf(float f) { unsigned u = __float_as_uint(f); u += 0x7FFFu + ((u >> 16) & 1u); return (bf16_t)(u >> 16); }
__device__ __forceinline__ unsigned cvt_pk_bf16(float lo, float hi) { unsigned r; asm volatile("v_cvt_pk_bf16_f32 %0, %1, %2" : "=v"(r) : "v"(lo), "v"(hi)); return r; }
__device__ __forceinline__ float bflo(unsigned w) { return __uint_as_float(w << 16); }
__device__ __forceinline__ float bfhi(unsigned w) { return __uint_as_float(w & 0xFFFF0000u); }
__device__ __forceinline__ void row_seq(int r, int& start, int& len, int& pos, int& b) {
    if (r < RL) { b = r >> 12; start = b << 12; len = SEQ; pos = r & 4095; }
    else { const int q = r - RL; b = q >> 8; start = RL + (b << 8); len = CTXL; pos = q & 255; }
}

#define XB_TMO      128
#define XB_XCNT(j)  (256  + 64 * (j))
#define XB_XSUB(j)  (1280 + 64 * (j))
#define XB_XGEN(j)  (2304 + 64 * (j))
#define XB_TOP      3328
#define XB_TOPGEN   3392
#define XCD_BAR_WORDS 3456
#define XB_SPIN_CAP (1u << 18)
__device__ __forceinline__ unsigned xb_ld(unsigned* p)              { return __hip_atomic_load(p, __ATOMIC_RELAXED, __HIP_MEMORY_SCOPE_AGENT); }
__device__ __forceinline__ unsigned xb_add(unsigned* p, unsigned v) { return __hip_atomic_fetch_add(p, v, __ATOMIC_RELAXED, __HIP_MEMORY_SCOPE_AGENT); }
__device__ __forceinline__ unsigned xb_xcc_id() { return (unsigned)__builtin_amdgcn_s_getreg((3 << 11) | 20) & 0xFu; }
#define XB_SPIN(cond, bar) do { unsigned _sp = 0; while (cond) { __builtin_amdgcn_s_sleep(1); \
    if ((++_sp & 255u) == 0u) { if (xb_ld(&(bar)[XB_TMO])) break; if (_sp > XB_SPIN_CAP) { atomicAdd(&(bar)[XB_TMO], 1u); break; } } } } while (0)
struct XcdBarrier { unsigned* bar; unsigned x; volatile LAS unsigned* st; };
__device__ __forceinline__ XcdBarrier xcd_barrier_post(unsigned* bar, volatile LAS unsigned* st) {
    XcdBarrier b; b.bar = bar; b.x = xb_xcc_id(); b.st = st;
    if (threadIdx.x == 0) (void)xb_add(&bar[XB_XCNT(b.x)], 1u);
    return b;
}
__device__ __forceinline__ void xcd_barrier_complete(unsigned* bar, unsigned x, unsigned& nloc, unsigned& nx) {
    const unsigned G = gridDim.x * gridDim.y * gridDim.z;
    unsigned sum, cnt, mine, sp = 0u;
    for (;;) {
        sum = 0u; cnt = 0u; mine = 0u;
#pragma unroll
        for (unsigned j = 0; j < 16; ++j) { const unsigned c = xb_ld(&bar[XB_XCNT(j)]); sum += c; cnt += (c > 0u) ? 1u : 0u; mine = (j == x) ? c : mine; }
        if (sum == G) break;
        __builtin_amdgcn_s_sleep(1);
        if ((++sp & 255u) == 0u) { if (xb_ld(&bar[XB_TMO])) break; if (sp > XB_SPIN_CAP) { atomicAdd(&bar[XB_TMO], 1u); break; } }
    }
    nloc = mine > 0u ? mine : 1u; nx = cnt > 0u ? cnt : 1u;
}
__device__ __forceinline__ void xcd_barrier(const XcdBarrier& b) {
    asm volatile("s_waitcnt vmcnt(0)" ::: "memory");
    __syncthreads();
    if (threadIdx.x == 0) {
        unsigned* bar = b.bar;
        __builtin_amdgcn_s_waitcnt(0);
        unsigned nloc = b.st[0], nx = b.st[1];
        if (nloc == 0u) { xcd_barrier_complete(bar, b.x, nloc, nx); b.st[0] = nloc; b.st[1] = nx; }
        const unsigned old = xb_add(&bar[XB_XSUB(b.x)], 1u);
        const unsigned gen = old / nloc;
        if (old + 1u == (gen + 1u) * nloc) {
            __builtin_amdgcn_fence(__ATOMIC_RELEASE, "agent");
            asm volatile("s_waitcnt vmcnt(0)" ::: "memory");
            const unsigned og = xb_add(&bar[XB_TOP], 1u);
            const unsigned tg = og / nx;
            if (og + 1u == (tg + 1u) * nx) xb_add(&bar[XB_TOPGEN], 1u);
            else XB_SPIN(xb_ld(&bar[XB_TOPGEN]) == tg, bar);
            __builtin_amdgcn_fence(__ATOMIC_ACQUIRE, "agent");
            xb_add(&bar[XB_XGEN(b.x)], 1u);
            asm volatile("s_waitcnt vmcnt(0)" ::: "memory");
        } else {
            XB_SPIN(xb_ld(&bar[XB_XGEN(b.x)]) == gen, bar);
            __builtin_amdgcn_fence(__ATOMIC_ACQUIRE, "agent");
            asm volatile("s_waitcnt vmcnt(0)" ::: "memory");
        }
    }
    __syncthreads();
}

#define SLOT_M2 3
#define SLOT_M3 2
#define SLOT_GLU 1
#define SLOT_G1 2
namespace pg8 {
constexpr int BM = 256, BK = 64, HALF = 128, HTB = HALF * BK * 2, STAGE_BYTES = 8 * HTB, NXCD = 8, WGM = 8;
__host__ __device__ __forceinline__ int lds_byte(int r, int c) { const int st = (r >> 4) * 2 + (c >> 5), rr = r & 15, cc = c & 31, ob = rr * 64 + cc * 2; return st * 1024 + (ob ^ (((ob >> 9) & 1) << 5)); }
__host__ __device__ __forceinline__ void stage_rc(int b, int& R, int& C) { const int st = b / 1024, sb = b % 1024, swz = sb ^ (((sb >> 9) & 1) << 5); R = (st >> 1) * 16 + swz / 64; C = (st & 1) * 32 + (swz % 64) / 2; }
__host__ __device__ __forceinline__ int perm32(int rho) { const int n = rho >> 4, i = rho & 15; return 8 * (i >> 2) + 4 * n + (i & 3); }

struct Unit { const char* a; const char* b; int nt; int pm, pn, kind; };

template <int WGM = 8>
__device__ __forceinline__ void rect_map(int wgid, int nM, int nN, int& pm, int& pn) {
    const int nwg = nM * nN;
    { const int q = nwg / NXCD, r = nwg % NXCD, xcd = wgid % NXCD, off = wgid / NXCD; wgid = (xcd < r ? xcd * (q + 1) : r * (q + 1) + (xcd - r) * q) + off; }
    const int nig = WGM * nN, gid = wgid / nig, fm = gid * WGM, gsz = (nM - fm) < WGM ? (nM - fm) : WGM;
    pm = fm + ((wgid % nig) % gsz); pn = (wgid % nig) / gsz;
}

template <int lda, int ldb, int KSTEP = 128, class Epi, class Sched>
__device__ __forceinline__ void gemm_phase(LAS unsigned char* lds, const Sched& S, const Epi& E) {
    int tid_ = threadIdx.x; asm volatile("" : "+v"(tid_));
    const int tid = tid_, wid = __builtin_amdgcn_readfirstlane(tid >> 6), lane = tid & 63, wr = wid >> 2, wc = wid & 3, fr = lane & 15, fq = lane >> 4;
    unsigned voffA[2], voffB[2];
#pragma unroll
    for (int i = 0; i < 2; ++i) { int R, C; stage_rc(tid * 16 + i * 8192, R, C); const int Rb = (R & ~31) + perm32(R & 31);
        voffA[i] = (unsigned)(R * lda + C) * 2u; voffB[i] = (unsigned)(Rb * ldb + C) * 2u; }
    const size_t kstep = (size_t)KSTEP;
    const size_t hstepA = (size_t)HALF * lda * 2, hstepB = (size_t)HALF * ldb * 2;
    const unsigned ldsw = (unsigned)wid * 1024u;
    const int aoff = lds_byte(wr * 64 + fr, fq * 8), boff = lds_byte(wc * 32 + fr, fq * 8);
#define PG8_SA(b, h) (((b) * 2 + (h)) * HTB)
#define PG8_SB(b, h) ((4 + (b) * 2 + (h)) * HTB)
#define PG8_STAGE(bufoff, gbase, voff) do { _Pragma("unroll") for (int _i = 0; _i < 2; ++_i) \
        __builtin_amdgcn_global_load_lds((const unsigned*)((const char*)(gbase) + (voff)[_i]), (LAS unsigned*)(lds + (bufoff) + ldsw + _i * 8192), 16, 0, 0); } while (0)
#define PG8_LDA(dst, b, h) do { _Pragma("unroll") for (int m = 0; m < 4; ++m) _Pragma("unroll") for (int k = 0; k < 2; ++k) dst[m][k] = *(const LAS bf16x8*)(lds + PG8_SA(b, h) + aoff + m * 2048 + k * 1024); } while (0)
#define PG8_LDB(dst, b, h) do { _Pragma("unroll") for (int n = 0; n < 2; ++n) _Pragma("unroll") for (int k = 0; k < 2; ++k) dst[n][k] = *(const LAS bf16x8*)(lds + PG8_SB(b, h) + boff + n * 2048 + k * 1024); } while (0)
#define PG8_MMA(ai, bj, At, Bt) do { __builtin_amdgcn_s_setprio(1); _Pragma("unroll") for (int m = 0; m < 4; ++m) _Pragma("unroll") for (int n = 0; n < 2; ++n) _Pragma("unroll") for (int k = 0; k < 2; ++k) \
        acc[ai][bj][m][n] = __builtin_amdgcn_mfma_f32_16x16x32_bf16(Bt[n][k], At[m][k], acc[ai][bj][m][n], 0, 0, 0); __builtin_amdgcn_s_setprio(0); } while (0)
#define PG8_WAIT_V(n) asm volatile("s_waitcnt vmcnt(" #n ")" ::: "memory")
#define PG8_WAIT_L(n) asm volatile("s_waitcnt lgkmcnt(" #n ")" ::: "memory")
#define PG8_BAR __builtin_amdgcn_s_barrier()
#define PG8_SCHED __builtin_amdgcn_sched_barrier(0)
    Unit cur, nxt; int ui = 0;
    if (!S.next(0, cur)) return;
    f32x4 acc[2][2][4][2];
#pragma unroll
    for (int a = 0; a < 2; ++a)
#pragma unroll
        for (int b = 0; b < 2; ++b)
#pragma unroll
            for (int m = 0; m < 4; ++m)
#pragma unroll
                for (int n = 0; n < 2; ++n) acc[a][b][m][n] = (f32x4){0.f, 0.f, 0.f, 0.f};
    bf16x8 At[4][2], B0[2][2], B1[2][2];
    const char* cA = cur.a; const char* cB = cur.b;
    PG8_STAGE(PG8_SB(0, 0), cB, voffB); PG8_STAGE(PG8_SA(0, 0), cA, voffA); PG8_STAGE(PG8_SB(0, 1), cB + hstepB, voffB); PG8_STAGE(PG8_SA(0, 1), cA + hstepA, voffA);
    if (wr == 1) PG8_BAR;
    PG8_WAIT_V(4); PG8_BAR;
    PG8_STAGE(PG8_SB(1, 0), cB + kstep, voffB); PG8_STAGE(PG8_SA(1, 0), cA + kstep, voffA); PG8_STAGE(PG8_SB(1, 1), cB + hstepB + kstep, voffB);
    PG8_WAIT_V(6); PG8_BAR;
    for (;;) {
        const bool has_next = S.next(ui + 1, nxt);
        const char* nA = has_next ? nxt.a : cA; const char* nB = has_next ? nxt.b : cB;
        const int nt = cur.nt;
        for (int t = 0; t < nt; t += 2) {
            const bool last = (t == nt - 2);
            const char* a1 = cA + (size_t)(t + 1) * kstep;
            const char* a2 = last ? nA : cA + (size_t)(t + 2) * kstep; const char* b2 = last ? nB : cB + (size_t)(t + 2) * kstep;
            const char* a3 = a2 + kstep; const char* b3 = b2 + kstep;
            PG8_LDB(B0, 0, 0); PG8_SCHED; PG8_LDA(At, 0, 0); PG8_STAGE(PG8_SA(1, 1), a1 + hstepA, voffA);
            PG8_WAIT_L(8); PG8_BAR; PG8_WAIT_L(0); PG8_MMA(0, 0, At, B0); PG8_BAR; PG8_SCHED;
            PG8_LDB(B1, 0, 1); PG8_STAGE(PG8_SB(0, 0), b2, voffB);
            PG8_BAR; PG8_WAIT_L(0); PG8_MMA(0, 1, At, B1); PG8_BAR;
            PG8_LDA(At, 0, 1); PG8_STAGE(PG8_SA(0, 0), a2, voffA);
            PG8_BAR; PG8_WAIT_L(0); PG8_MMA(1, 0, At, B0); PG8_BAR; PG8_SCHED;
            PG8_STAGE(PG8_SB(0, 1), b2 + hstepB, voffB);
            PG8_WAIT_V(6); PG8_BAR; PG8_MMA(1, 1, At, B1); PG8_BAR;
            PG8_LDB(B0, 1, 0); PG8_SCHED; PG8_LDA(At, 1, 0); PG8_STAGE(PG8_SA(0, 1), a2 + hstepA, voffA);
            PG8_WAIT_L(8); PG8_BAR; PG8_WAIT_L(0); PG8_MMA(0, 0, At, B0); PG8_BAR; PG8_SCHED;
            PG8_LDB(B1, 1, 1); PG8_STAGE(PG8_SB(1, 0), b3, voffB);
            PG8_BAR; PG8_WAIT_L(0); PG8_MMA(0, 1, At, B1); PG8_BAR;
            PG8_LDA(At, 1, 1); PG8_STAGE(PG8_SA(1, 0), a3, voffA);
            PG8_BAR; PG8_WAIT_L(0); PG8_MMA(1, 0, At, B0); PG8_BAR; PG8_SCHED;
            PG8_STAGE(PG8_SB(1, 1), b3 + hstepB, voffB);
            PG8_WAIT_V(6); PG8_BAR; PG8_MMA(1, 1, At, B1); PG8_BAR;
        }
        E(acc, cur, wr, wc, fr, fq);
        if (!has_next) break;
        if (!(Sched::KEEP_ACC && nxt.kind >= 1 && nxt.kind <= 3)) {
#pragma unroll
        for (int a = 0; a < 2; ++a)
#pragma unroll
            for (int b = 0; b < 2; ++b)
#pragma unroll
                for (int m = 0; m < 4; ++m)
#pragma unroll
                    for (int n = 0; n < 2; ++n) acc[a][b][m][n] = (f32x4){0.f, 0.f, 0.f, 0.f};
        }
        cur = nxt; cA = nA; cB = nB; ++ui;
    }
    PG8_WAIT_V(0);
    if (wr == 0) PG8_BAR;
    PG8_BAR;
#undef PG8_SA
#undef PG8_SB
#undef PG8_STAGE
#undef PG8_LDA
#undef PG8_LDB
#undef PG8_MMA
#undef PG8_WAIT_V
#undef PG8_WAIT_L
#undef PG8_BAR
#undef PG8_SCHED
}

struct PartC { long long aOff, bOff; unsigned aStep, bStep; int nM, nN, nt, kind, start, nGrp; unsigned aGrp, bGrp; };
struct TabSched {
    static constexpr bool KEEP_ACC = false;
    const PartC* parts; const char* ws; int np, total, G, c;
    __device__ __forceinline__ bool next(int i, Unit& u) const {
        const int L = i * G + c; if (L >= total) return false;
        int q = 0;
#pragma unroll
        for (int k = 1; k < 4; ++k) if (k < np && L >= parts[k].start) q = k;
        const PartC P = parts[q];
        const int per = P.nM * P.nN, idx = L - P.start, grp = idx / per;
        int pm, pn; rect_map(idx - grp * per, P.nM, P.nN, pm, pn);
        u.a = ws + P.aOff + (size_t)grp * P.aGrp + (size_t)pm * P.aStep; u.b = ws + P.bOff + (size_t)grp * P.bGrp + (size_t)pn * P.bStep; u.nt = P.nt; u.pm = pm; u.pn = pn; u.kind = P.kind + grp; return true;
    }
};
struct MergeSched {
    static constexpr bool KEEP_ACC = true;
    const char* ws; long long aOff, bOff; int nM, G, c;
    int nCtx;
    __device__ __forceinline__ bool next(int i, Unit& u) const {
        int T = (i >> 2) * G + c, br = i & 3; bool ctxu = false;
        if (T >= nM * 4) {
            const int j = (i - 4 * ((nM * 4 - c + G - 1) / G)) * G + c;
            if (j < 0 || j >= nCtx) return false;
            T = nM * 4 + (j >> 2); br = j & 3; ctxu = true;
        }
        int pm, pn;
        if (!ctxu) rect_map(T, nM, 4, pm, pn); else { const int t = T - nM * 4; pm = nM + (t >> 2); pn = t & 3; }
        const int ko = br == 0 ? 0 : (br == 1 ? 384 : (br == 2 ? 640 : 1024));
        u.a = ws + aOff + (size_t)pm * (256u * 1280u * 2u) + ko * 2; u.b = ws + bOff + (size_t)pn * (256u * 1280u * 2u) + ko * 2; u.nt = (br & 1) ? 4 : 6; u.pm = pm; u.pn = pn; u.kind = ctxu ? 4 + br : br; return true;
    }
};
struct MoeSched {
    static constexpr bool KEEP_ACC = false;
    const char* A; const char* B; const LAS int* tile_e; unsigned aStep, bStep; size_t bExp; int nN, nt, tile0, ntile, G, c;
    __device__ __forceinline__ bool next(int i, Unit& u) const {
        const int L = i * G + c; if (L >= ntile * nN) return false;
        const int pm = L / nN, pn = L % nN;
        const int mt = tile0 + pm;
        const int e = __builtin_amdgcn_readfirstlane(tile_e[mt]);
        u.a = A + (size_t)(mt - tile0) * aStep; u.b = B + (size_t)e * bExp + (size_t)pn * bStep; u.nt = nt; u.pm = mt; u.pn = pn; u.kind = e; return true;
    }
};

struct MoeTailSched {
    static constexpr bool KEEP_ACC = false;
    const char* A; const char* B; const LAS int* tile_e; int tile0, nfull, nex, G, c;
    __device__ __forceinline__ bool next(int i, Unit& u) const {
        const int L = i * G + c; int mt, pn, nt = 56, flag = 0; size_t koff = 0;
        if (L < nfull * 4) { int pm; rect_map(L, nfull, 4, pm, pn); mt = tile0 + pm; }
        else { const int idx = L - nfull * 4; if (idx >= nex * 16) return false; const int sp = idx & 3, tu = idx >> 2; mt = 128 + (tu >> 2); pn = tu & 3; nt = 14; koff = (size_t)sp * 14 * 32768; flag = 8 + 16 * sp; }
        const int e = __builtin_amdgcn_readfirstlane(tile_e[mt]);
        u.a = A + (size_t)(mt - tile0) * (256u * (unsigned)FF_E * 2u) + koff; u.b = B + (size_t)e * ((size_t)1024 * FF_E * 2) + (size_t)pn * (256u * (unsigned)FF_E * 2u) + koff;
        u.nt = nt; u.pm = mt; u.pn = pn; u.kind = e | flag; return true;
    }
};

#define EPI_ROWS(u) const int row0 = (u).pm * BM + wr * 64 + fr, colt = wc * 32 + 8 * fq
struct EpiProj {
    bf16_t* PRp; bf16_t* PTp; bf16_t* USp; int sig_from; unsigned char* GQp;
    __device__ __forceinline__ void operator()(const f32x4 (&acc)[2][2][4][2], const Unit& u, int wr, int wc, int fr, int fq) const {
        EPI_ROWS(u);
        bf16_t* base = u.kind == 1 ? PTp : PRp; const int ldc = u.kind == 1 ? RT : LDP; const bool sg = (u.kind == 0 && u.pn >= sig_from);
        if (sg) {
            unsigned char* tb = GQp + ((size_t)u.pm * 16 + (u.pn - sig_from)) * 65536 + (wr * 4 + wc) * 8192 + (fq * 16 + fr) * 16;
#pragma unroll
            for (int ai = 0; ai < 2; ++ai)
#pragma unroll
                for (int m = 0; m < 4; ++m) { u32x4 w4;
#pragma unroll
                    for (int bj = 0; bj < 2; ++bj) { const f32x4 v0 = acc[ai][bj][m][0], v1 = acc[ai][bj][m][1];
                        unsigned lo = 0u, hi = 0u;
                        lo = __builtin_amdgcn_cvt_pk_u8_f32(sigm(v0[0]) * 255.0f, 0, lo); lo = __builtin_amdgcn_cvt_pk_u8_f32(sigm(v0[1]) * 255.0f, 1, lo); lo = __builtin_amdgcn_cvt_pk_u8_f32(sigm(v0[2]) * 255.0f, 2, lo); lo = __builtin_amdgcn_cvt_pk_u8_f32(sigm(v0[3]) * 255.0f, 3, lo);
                        hi = __builtin_amdgcn_cvt_pk_u8_f32(sigm(v1[0]) * 255.0f, 0, hi); hi = __builtin_amdgcn_cvt_pk_u8_f32(sigm(v1[1]) * 255.0f, 1, hi); hi = __builtin_amdgcn_cvt_pk_u8_f32(sigm(v1[2]) * 255.0f, 2, hi); hi = __builtin_amdgcn_cvt_pk_u8_f32(sigm(v1[3]) * 255.0f, 3, hi);
                        if (bj == 0) { w4.x = lo; w4.y = hi; } else { w4.z = lo; w4.w = hi; } }
                    *(u32x4*)(tb + (ai * 4 + m) * 1024) = w4; }
            return;
        }
#pragma unroll
        for (int ai = 0; ai < 2; ++ai)
#pragma unroll
            for (int m = 0; m < 4; ++m) { bf16_t* rowp = base + (size_t)(row0 + ai * HALF + m * 16) * ldc + u.pn * BM + colt;
#pragma unroll
                for (int bj = 0; bj < 2; ++bj) { f32x4 v0 = acc[ai][bj][m][0], v1 = acc[ai][bj][m][1];
                    if (sg) {
#pragma unroll
                        for (int j = 0; j < 4; ++j) { v0[j] = sigm(v0[j]); v1[j] = sigm(v1[j]); } }
                    u32x4 w; w.x = cvt_pk_bf16(v0[0], v0[1]); w.y = cvt_pk_bf16(v0[2], v0[3]); w.z = cvt_pk_bf16(v1[0], v1[1]); w.w = cvt_pk_bf16(v1[2], v1[3]);
                    *(u32x4*)(rowp + bj * HALF) = w;
                    if (u.kind == 0 && u.pn == 3) { const int r = row0 + ai * HALF + m * 16, cc = colt + bj * HALF;
                        *(u32x4*)(USp + ((size_t)(cc >> 4) * NCHKP + (r >> 4)) * 512 + (r & 15) * 16 + (cc & 15)) = w; } } }
    }
};
struct EpiS5State {
    float* Sp;
    __device__ __forceinline__ void operator()(const f32x4 (&acc)[2][2][4][2], const Unit& u, int wr, int wc, int fr, int fq) const {
        EPI_ROWS(u);
#pragma unroll
        for (int ai = 0; ai < 2; ++ai)
#pragma unroll
            for (int m = 0; m < 4; ++m) { float* op = Sp + ((size_t)u.kind * NCHKP + row0 + ai * HALF + m * 16) * 256 + colt;
#pragma unroll
                for (int bj = 0; bj < 2; ++bj)
#pragma unroll
                    for (int n = 0; n < 2; ++n) *(f32x4*)(op + bj * HALF + 4 * n) = acc[ai][bj][m][n]; }
    }
};
struct EpiS5Main {
    bf16_t* GLp; const bf16_t* PRp; const float* dvec;
    __device__ __forceinline__ void operator()(const f32x4 (&acc)[2][2][4][2], const Unit& u, int wr, int wc, int fr, int fq) const {
        EPI_ROWS(u);
        const int cl = 16 * u.kind + (colt & 15);
        const f32x4 d0 = *(const f32x4*)(dvec + cl), d1 = *(const f32x4*)(dvec + cl + 4);
#pragma unroll
        for (int ai = 0; ai < 2; ++ai) {
            u32x4 uq[4][2];
#pragma unroll
            for (int m = 0; m < 4; ++m) { const int n = row0 + ai * HALF + m * 16;
#pragma unroll
                for (int bj = 0; bj < 2; ++bj) { const int c = colt + bj * HALF, r = 16 * (n < NCHK ? n : 0) + (c >> 4); uq[m][bj] = *(const u32x4*)(PRp + (size_t)r * LDP + PC_D + cl); } }
#pragma unroll
            for (int m = 0; m < 4; ++m) { const int n = row0 + ai * HALF + m * 16; if (n >= NCHK) continue;
#pragma unroll
                for (int bj = 0; bj < 2; ++bj) { const int c = colt + bj * HALF, r = 16 * n + (c >> 4); const u32x4 uv = uq[m][bj];
                    const f32x4 v0 = acc[ai][bj][m][0], v1 = acc[ai][bj][m][1];
                    u32x4 w; w.x = cvt_pk_bf16(gelu_f(v0[0] + d0[0] * bflo(uv.x)), gelu_f(v0[1] + d0[1] * bfhi(uv.x))); w.y = cvt_pk_bf16(gelu_f(v0[2] + d0[2] * bflo(uv.y)), gelu_f(v0[3] + d0[3] * bfhi(uv.y)));
                    w.z = cvt_pk_bf16(gelu_f(v1[0] + d1[0] * bflo(uv.z)), gelu_f(v1[1] + d1[1] * bfhi(uv.z))); w.w = cvt_pk_bf16(gelu_f(v1[2] + d1[2] * bflo(uv.w)), gelu_f(v1[3] + d1[3] * bfhi(uv.w)));
                    *(u32x4*)(GLp + (size_t)r * 256 + cl) = w; } }
        }
    }
};
struct EpiS5Glu {
    bf16_t* YBp; const bf16_t* GLp; const float* bvec;
    __device__ __forceinline__ void operator()(const f32x4 (&acc)[2][2][4][2], const Unit& u, int wr, int wc, int fr, int fq) const {
        EPI_ROWS(u);
        f32x4 bq[2][2];
#pragma unroll
        for (int bj = 0; bj < 2; ++bj) { bq[bj][0] = *(const f32x4*)(bvec + colt + bj * HALF); bq[bj][1] = *(const f32x4*)(bvec + colt + bj * HALF + 4); }
#pragma unroll
        for (int ai = 0; ai < 2; ++ai) {
            u32x4 gq[4][2];
#pragma unroll
            for (int m = 0; m < 4; ++m)
#pragma unroll
                for (int bj = 0; bj < 2; ++bj) gq[m][bj] = *(const u32x4*)(GLp + (size_t)(row0 + ai * HALF + m * 16) * 256 + colt + bj * HALF);
#pragma unroll
            for (int m = 0; m < 4; ++m) { const int r = row0 + ai * HALF + m * 16;
#pragma unroll
                for (int bj = 0; bj < 2; ++bj) { const int c = colt + bj * HALF; const u32x4 gv = gq[m][bj];
                    const f32x4 v0 = acc[ai][bj][m][0] + bq[bj][0], v1 = acc[ai][bj][m][1] + bq[bj][1];
                    u32x4 w; w.x = cvt_pk_bf16(bflo(gv.x) * sigm(v0[0]), bfhi(gv.x) * sigm(v0[1])); w.y = cvt_pk_bf16(bflo(gv.y) * sigm(v0[2]), bfhi(gv.y) * sigm(v0[3]));
                    w.z = cvt_pk_bf16(bflo(gv.z) * sigm(v1[0]), bfhi(gv.z) * sigm(v1[1])); w.w = cvt_pk_bf16(bflo(gv.w) * sigm(v1[2]), bfhi(gv.w) * sigm(v1[3]));
                    *(u32x4*)(YBp + (size_t)r * YW + YC_D + c) = w; } }
        }
    }
};
__device__ __forceinline__ float gq8(unsigned w, int j) { return (float)((w >> (8 * j)) & 255u); }
struct EpiGate {
    const unsigned char* GQp; bf16_t* MGp; bf16_t* MGCp;
    __device__ __forceinline__ void operator()(f32x4 (&acc)[2][2][4][2], const Unit& u, int wr, int wc, int fr, int fq) const {
        EPI_ROWS(u);
        const int br = u.kind & 3;
        const unsigned char* tb = GQp + ((size_t)u.pm * 16 + br * 4 + u.pn) * 65536 + (wr * 4 + wc) * 8192 + (fq * 16 + fr) * 16;
        if (u.kind < 3) {
#pragma unroll
            for (int ai = 0; ai < 2; ++ai) {
                u32x2 ga[4][2], gb[4][2];
#pragma unroll
                for (int m = 0; m < 4; ++m) { const u32x4 a4 = *(const u32x4*)(tb + (ai * 4 + m) * 1024), b4 = *(const u32x4*)(tb + 4 * 65536 + (ai * 4 + m) * 1024);
                    ga[m][0] = (u32x2){a4.x, a4.y}; ga[m][1] = (u32x2){a4.z, a4.w}; gb[m][0] = (u32x2){b4.x, b4.y}; gb[m][1] = (u32x2){b4.z, b4.w}; }
#pragma unroll
                for (int m = 0; m < 4; ++m)
#pragma unroll
                    for (int bj = 0; bj < 2; ++bj)
#pragma unroll
                        for (int j = 0; j < 4; ++j) {
                            acc[ai][bj][m][0][j] *= fmaxf(gq8(ga[m][bj].x, j), 1.0f) * __builtin_amdgcn_rcpf(fmaxf(gq8(gb[m][bj].x, j), 1.0f));
                            acc[ai][bj][m][1][j] *= fmaxf(gq8(ga[m][bj].y, j), 1.0f) * __builtin_amdgcn_rcpf(fmaxf(gq8(gb[m][bj].y, j), 1.0f)); }
            }
            return;
        }
        bf16_t* OB = u.kind >= 4 ? MGCp + (size_t)br * RC * D - (size_t)RL * D : MGp;
        const float lo = u.kind >= 4 ? 0.0f : 1.0f;
#pragma unroll
        for (int ai = 0; ai < 2; ++ai) {
            u32x2 g[4][2];
#pragma unroll
            for (int m = 0; m < 4; ++m) { const u32x4 g4 = *(const u32x4*)(tb + (ai * 4 + m) * 1024); g[m][0] = (u32x2){g4.x, g4.y}; g[m][1] = (u32x2){g4.z, g4.w}; }
#pragma unroll
            for (int m = 0; m < 4; ++m) { bf16_t* mp = OB + (size_t)(row0 + ai * HALF + m * 16) * D + u.pn * BM + colt;
#pragma unroll
                for (int bj = 0; bj < 2; ++bj) { const f32x4 v0 = acc[ai][bj][m][0] * (1.0f / 255.0f), v1 = acc[ai][bj][m][1] * (1.0f / 255.0f); const u32x2 gg = g[m][bj];
                    const f32x4 o0 = {v0[0] * fmaxf(gq8(gg.x, 0), lo), v0[1] * fmaxf(gq8(gg.x, 1), lo), v0[2] * fmaxf(gq8(gg.x, 2), lo), v0[3] * fmaxf(gq8(gg.x, 3), lo)};
                    const f32x4 o1 = {v1[0] * fmaxf(gq8(gg.y, 0), lo), v1[1] * fmaxf(gq8(gg.y, 1), lo), v1[2] * fmaxf(gq8(gg.y, 2), lo), v1[3] * fmaxf(gq8(gg.y, 3), lo)};
                    u32x4 w; w.x = cvt_pk_bf16(o0[0], o0[1]); w.y = cvt_pk_bf16(o0[2], o0[3]); w.z = cvt_pk_bf16(o1[0], o1[1]); w.w = cvt_pk_bf16(o1[2], o1[3]);
                    *(u32x4*)(mp + bj * HALF) = w; } }
        }
    }
};
struct EpiRes {
    float* PREp; const float* xlat; const float* xctx; const float* gvec;
    float* partp;
    __device__ __forceinline__ void operator()(const f32x4 (&acc)[2][2][4][2], const Unit& u, int wr, int wc, int fr, int fq) const {
        EPI_ROWS(u);
        if (u.kind != 0) {
            f32x4 gc[2][2];
#pragma unroll
            for (int bj = 0; bj < 2; ++bj)
#pragma unroll
                for (int n = 0; n < 2; ++n) gc[bj][n] = *(const f32x4*)(gvec + (size_t)4 * 6144 + u.pn * BM + colt + bj * HALF + 4 * n);
#pragma unroll
            for (int ai = 0; ai < 2; ++ai)
#pragma unroll
                for (int m = 0; m < 4; ++m) { const int r = row0 + ai * HALF + m * 16; const int c0 = u.pn * BM + colt;
                    float* op = partp + ((size_t)(u.kind - 1) * RC + r) * D + c0;
#pragma unroll
                    for (int bj = 0; bj < 2; ++bj)
#pragma unroll
                        for (int n = 0; n < 2; ++n) *(f32x4*)(op + bj * HALF + 4 * n) = gc[bj][n] * acc[ai][bj][m][n]; }
            return;
        }
        const int c0 = u.pn * BM + colt, rt0 = u.pm * BM;
        const float* gp = gvec + (size_t)(rt0 < RL ? (rt0 >> 12) : 4) * 6144 + c0;
        f32x4 gq[2][2];
#pragma unroll
        for (int bj = 0; bj < 2; ++bj)
#pragma unroll
            for (int n = 0; n < 2; ++n) gq[bj][n] = *(const f32x4*)(gp + bj * HALF + 4 * n);
#pragma unroll
        for (int ai = 0; ai < 2; ++ai)
#pragma unroll
            for (int m = 0; m < 4; ++m) { bf16_t* op = (bf16_t*)PREp + (size_t)(row0 + ai * HALF + m * 16) * D + c0;
#pragma unroll
                for (int bj = 0; bj < 2; ++bj) { const f32x4 v0 = gq[bj][0] * acc[ai][bj][m][0], v1 = gq[bj][1] * acc[ai][bj][m][1];
                    u32x4 w; w.x = cvt_pk_bf16(v0[0], v0[1]); w.y = cvt_pk_bf16(v0[2], v0[3]); w.z = cvt_pk_bf16(v1[0], v1[1]); w.w = cvt_pk_bf16(v1[2], v1[3]);
                    *(u32x4*)(op + bj * HALF) = w; } }
    }
};
struct EpiSwiglu {
    bf16_t* Hp; int ldh; int row_sub; bool blk;
    __device__ __forceinline__ void operator()(const f32x4 (&acc)[2][2][4][2], const Unit& u, int wr, int wc, int fr, int fq) const {
        const int row0 = (u.pm - row_sub) * BM + wr * 64 + fr, colt = wc * 32 + 8 * fq;
#pragma unroll
        for (int ai = 0; ai < 2; ++ai)
#pragma unroll
            for (int m = 0; m < 4; ++m) { bf16_t* rowp = blk ? Hp + ((size_t)((u.pm - row_sub) * (ldh >> 6) + u.pn * 2 + (wc >> 1)) << 14) + (wr * 64 + fr + ai * HALF + m * 16) * 64 + (wc & 1) * 32 + 8 * fq
                                                             : Hp + (size_t)(row0 + ai * HALF + m * 16) * ldh + u.pn * HALF + colt;
                f32x4 h0, h1;
#pragma unroll
                for (int j = 0; j < 4; ++j) { const float g0 = acc[ai][0][m][0][j], g1 = acc[ai][0][m][1][j];
                    h0[j] = g0 * sigm(g0) * acc[ai][1][m][0][j]; h1[j] = g1 * sigm(g1) * acc[ai][1][m][1][j]; }
                u32x4 w; w.x = cvt_pk_bf16(h0[0], h0[1]); w.y = cvt_pk_bf16(h0[2], h0[3]); w.z = cvt_pk_bf16(h1[0], h1[1]); w.w = cvt_pk_bf16(h1[2], h1[3]);
                *(u32x4*)rowp = w; }
    }
};
struct EpiMoeDown {
    bf16_t* O2; const float* slotw; float* O2X;
    __device__ __forceinline__ void operator()(const f32x4 (&acc)[2][2][4][2], const Unit& u, int wr, int wc, int fr, int fq) const {
        EPI_ROWS(u);
        float wq[2][4];
        if (u.kind & 8) {
            const int sp = (u.kind >> 4) & 3;
#pragma unroll
            for (int ai = 0; ai < 2; ++ai)
#pragma unroll
                for (int m = 0; m < 4; ++m) { const int r = row0 + ai * HALF + m * 16; const float w8 = slotw[r]; float* op = O2X + ((size_t)sp * 2048 + (r - 128 * 256)) * D + u.pn * BM + colt;
#pragma unroll
                    for (int bj = 0; bj < 2; ++bj)
#pragma unroll
                        for (int n = 0; n < 2; ++n) *(f32x4*)(op + bj * HALF + 4 * n) = acc[ai][bj][m][n] * w8; }
            return;
        }
#pragma unroll
        for (int ai = 0; ai < 2; ++ai)
#pragma unroll
            for (int m = 0; m < 4; ++m) wq[ai][m] = slotw[row0 + ai * HALF + m * 16];
#pragma unroll
        for (int ai = 0; ai < 2; ++ai)
#pragma unroll
            for (int m = 0; m < 4; ++m) { const int r = row0 + ai * HALF + m * 16; const float w8 = wq[ai][m];
                bf16_t* rowp = O2 + (size_t)r * D + u.pn * BM + colt;
#pragma unroll
                for (int bj = 0; bj < 2; ++bj) { const f32x4 v0 = acc[ai][bj][m][0] * w8, v1 = acc[ai][bj][m][1] * w8;
                    u32x4 w; w.x = cvt_pk_bf16(v0[0], v0[1]); w.y = cvt_pk_bf16(v0[2], v0[3]); w.z = cvt_pk_bf16(v1[0], v1[1]); w.w = cvt_pk_bf16(v1[2], v1[3]);
                    *(u32x4*)(rowp + bj * HALF) = w; } }
    }
};
}

struct Job { int in_idx; int src_off; int lds; int K; int N; long long dst_off; int ldd; int kcol0; int G, GS, R0; int tile0; int blk; };
struct JobTable { Job j[96]; int n; int total; };
constexpr int BIGG = 1 << 30;
constexpr void add_job(JobTable& t, int in_idx, long long src_off, int lds, int K, int N, size_t dst_off, int ldd, int kcol0, int G, int GS, int R0) {
    Job& q = t.j[t.n]; q.in_idx = in_idx; q.src_off = (int)src_off; q.lds = lds; q.K = K; q.N = N; q.dst_off = (long long)dst_off; q.ldd = ldd; q.kcol0 = kcol0; q.G = G; q.GS = GS; q.R0 = R0;
    q.tile0 = t.total; t.total += (K / 64) * (N / 64); t.n++;
}
constexpr JobTable make_jobs(int which) {
    JobTable t{}; t.n = 0; t.total = 0;
    if (which == 0) {
        {   const int l = 0; const size_t base = WS_WL + (size_t)l * SZ_WL; const long long wsrc = (long long)l * 1024 * IN_COLS;
            add_job(t, 6, wsrc + 0, IN_COLS, 1024, 768, base, 1024, 0, BIGG, 0, 0);
            add_job(t, 6, wsrc + 2688, IN_COLS, 1024, 256, base, 1024, 0, BIGG, 0, PC_D);
            add_job(t, 6, wsrc + 1536, IN_COLS, 1024, 768, base, 1024, 0, BIGG, 0, PC_Q);
            add_job(t, 6, wsrc + 2944, IN_COLS, 1024, 4096, base, 1024, 0, BIGG, 0, PC_G);
            add_job(t, 6, wsrc + 768, IN_COLS, 1024, 768, base + SZ_WINR, 1024, 0, BIGG, 0, 0);
            add_job(t, 6, wsrc + 2304, IN_COLS, 1024, 384, base + SZ_WINR, 1024, 0, BIGG, 0, PT_V);
        }
        for (int q = 0; q < 24; ++q) for (int mat = 0; mat < 2; ++mat)
            add_job(t, mat == 0 ? 9 : 11, (long long)q * 4096, 64, 64, 64, WS_LW + (size_t)(((q / 6) * 2 + mat) * 6 + q % 6) * 4096 * 2, 64, 0, BIGG, 0, 0);
        for (int l = 0; l < 2; ++l) add_job(t, 33, (long long)l * 65536, 256, 256, 256, WS_WGLU + (size_t)l * 256 * 256 * 2, 256, 0, BIGG, 0, 0);
        {   const int kd[4] = {384, 256, 384, 256}, ko[4] = {0, 384, 640, 1024}; const size_t base = WS_WL;
            for (int i = 0; i < 4; ++i) add_job(t, 35 + i, 0, 1024, kd[i], 1024, base + SZ_WINR + SZ_WINHY, 1280, ko[i], BIGG, 0, 0);
            add_job(t, 39, 0, 1024, 1024, 1024, base + SZ_WINR + SZ_WINHY + SZ_WBR, 1024, 0, BIGG, 0, 0);
        }
    } else if (which == 1) {
        for (int e = 0; e < NE; ++e) {
            add_job(t, 48, (long long)e * 1024 * FF_E, FF_E, 1024, FF_E, WS_MOEGU + (size_t)e * 2 * FF_E * 1024 * 2, 1024, 0, 128, 256, 0);
            add_job(t, 49, (long long)e * 1024 * FF_E, FF_E, 1024, FF_E, WS_MOEGU + (size_t)e * 2 * FF_E * 1024 * 2, 1024, 0, 128, 256, 128);
        }
    } else {
        const int kd[4] = {384, 256, 384, 256}, ko[4] = {0, 384, 640, 1024};
        add_job(t, 44, 0, FF_DENSE, 1024, FF_DENSE, WS_FFGU, 1024, 0, 128, 256, 0);
        add_job(t, 45, 0, FF_DENSE, 1024, FF_DENSE, WS_FFGU, 1024, 0, 128, 256, 128);
        add_job(t, 46, 0, 1024, FF_DENSE, 1024, WS_FFD, FF_DENSE, 0, BIGG, 0, 0); t.j[t.n - 1].blk = 1;
        {   const int l = 1; const size_t base = WS_WL + (size_t)l * SZ_WL; const long long wsrc = (long long)l * 1024 * IN_COLS;
            add_job(t, 6, wsrc + 0, IN_COLS, 1024, 768, base, 1024, 0, BIGG, 0, 0);
            add_job(t, 6, wsrc + 2688, IN_COLS, 1024, 256, base, 1024, 0, BIGG, 0, PC_D);
            add_job(t, 6, wsrc + 1536, IN_COLS, 1024, 768, base, 1024, 0, BIGG, 0, PC_Q);
            add_job(t, 6, wsrc + 2944, IN_COLS, 1024, 4096, base, 1024, 0, BIGG, 0, PC_G);
            add_job(t, 6, wsrc + 768, IN_COLS, 1024, 768, base + SZ_WINR, 1024, 0, BIGG, 0, 0);
            add_job(t, 6, wsrc + 2304, IN_COLS, 1024, 384, base + SZ_WINR, 1024, 0, BIGG, 0, PT_V);
            for (int i = 0; i < 4; ++i) add_job(t, 35 + i, (long long)l * kd[i] * 1024, 1024, kd[i], 1024, base + SZ_WINR + SZ_WINHY, 1280, ko[i], BIGG, 0, 0);
            add_job(t, 39, (long long)l * 1024 * 1024, 1024, 1024, 1024, base + SZ_WINR + SZ_WINHY + SZ_WBR, 1024, 0, BIGG, 0, 0);
        }
        for (int e = 0; e < NE; ++e) { add_job(t, 50, (long long)e * FF_E * 1024, 1024, FF_E, 1024, WS_MOED + (size_t)e * 1024 * FF_E * 2, FF_E, 0, BIGG, 0, 0); t.j[t.n - 1].blk = 1; }
    }
    return t;
}
__device__ const JobTable JT_SMALL = make_jobs(0);
__device__ const JobTable JT_MOE = make_jobs(1);
__device__ const JobTable JT_BG = make_jobs(2);
constexpr int BG_LIM_FF = make_jobs(2).j[3].tile0, BG_LIM_S1 = make_jobs(2).j[14].tile0;

struct PartTable { pg8::PartC p[32]; };
constexpr pg8::PartC mk_part(size_t aOff, size_t bOff, unsigned aStep, unsigned bStep, int nM, int nN, int nt, int kind, int start) {
    pg8::PartC q{}; q.aOff = (long long)aOff; q.bOff = (long long)bOff; q.aStep = aStep; q.bStep = bStep; q.nM = nM; q.nN = nN; q.nt = nt; q.kind = kind; q.start = start; q.nGrp = 1; q.aGrp = 0; q.bGrp = 0; return q;
}
constexpr PartTable make_parts() {
    PartTable t{};
    for (int l = 0; l < 2; ++l) {
        const size_t WL = WS_WL + (size_t)l * SZ_WL; const int nMrow = l == 0 ? 68 : 64;
        t.p[l * 8 + 0] = mk_part(WS_UB, WL, 256u * 1024u * 2u, 256u * 1024u * 2u, 68, 23, 16, 0, 0);
        t.p[l * 8 + 1] = mk_part(WL + SZ_WINR, WS_UB, 256u * 1024u * 2u, 256u * 1024u * 2u, 5, 68, 16, 1, 68 * 23);
        const int kd[4] = {384, 256, 384, 256}, ko[4] = {0, 384, 640, 1024};
        for (int i = 0; i < 4; ++i) t.p[l * 8 + 2 + i] = mk_part(WS_YB + ko[i] * 2, WL + SZ_WINR + SZ_WINHY + ko[i] * 2, 256u * 1280u * 2u, 256u * 1280u * 2u, nMrow, 4, kd[i] / 64, i, i * nMrow * 4);
        t.p[l * 8 + 6] = mk_part(WS_UB, WL + SZ_WINR + SZ_WINHY + SZ_WBR, 256u * 1024u * 2u, 256u * 1024u * 2u, nMrow, 4, 16, 0, 0);
    }
    for (int l = 0; l < 2; ++l) {
        pg8::PartC q = mk_part(WS_US, WS_OPS + (size_t)l * 16 * 256 * 256 * 2, 256u * 512u * 2u, 0u, 5, 1, 4, 0, 0); q.nGrp = 16; q.aGrp = (unsigned)(NCHKP * 512 * 2); q.bGrp = 256u * 256u * 2u; t.p[18 + l * 3] = q;
        q = mk_part(WS_US, WS_OPY + (size_t)l * 16 * 256 * 512 * 2, 256u * 512u * 2u, 0u, 5, 1, 8, 0, 0); q.nGrp = 16; q.aGrp = (unsigned)(NCHKP * 512 * 2); q.bGrp = 256u * 512u * 2u; t.p[19 + l * 3] = q;
        t.p[20 + l * 3] = mk_part(WS_GL, WS_WGLU + (size_t)l * 256 * 256 * 2, 256u * 256u * 2u, 0u, l == 0 ? 68 : 64, 1, 4, 0, 0);
    }
    {
        const size_t WL0 = WS_WL;
        t.p[24] = mk_part(WS_UB, WL0 + SZ_WINR + SZ_WINHY + SZ_WBR, 256u * 1024u * 2u, 256u * 1024u * 2u, 64, 4, 16, 0, 0);
        pg8::PartC q = mk_part(WS_MGC, WL0 + SZ_WINR + SZ_WINHY + SZ_WBR, 256u * 1024u * 2u, 256u * 1024u * 2u, 4, 4, 16, 1, 256); q.nGrp = 4; q.aGrp = (unsigned)(RC * D * 2); q.bGrp = 0u; t.p[25] = q;
        t.p[26] = mk_part(WS_H, WS_FFD, 256u * (unsigned)FF_DENSE * 2u, 256u * (unsigned)FF_DENSE * 2u, 64, 4, 44, 0, 0);
        q = mk_part(WS_H + (size_t)64 * 256 * FF_DENSE * 2, WS_FFD, 256u * (unsigned)FF_DENSE * 2u, 256u * (unsigned)FF_DENSE * 2u, 4, 4, 12, 1, 256); q.nGrp = 3; q.aGrp = 12u * 32768u; q.bGrp = 12u * 32768u; t.p[27] = q;
        t.p[28] = mk_part(WS_H + (size_t)64 * 256 * FF_DENSE * 2 + 36 * 32768, WS_FFD + 36 * 32768, 256u * (unsigned)FF_DENSE * 2u, 256u * (unsigned)FF_DENSE * 2u, 4, 4, 8, 4, 256 + 48);
    }
    t.p[16] = mk_part(WS_UB, WS_FFGU, 256u * 1024u * 2u, 256u * 1024u * 2u, 68, 22, 16, 0, 0);
    t.p[17] = mk_part(WS_H, WS_FFD, 256u * (unsigned)FF_DENSE * 2u, 256u * (unsigned)FF_DENSE * 2u, 68, 4, 44, 0, 0);
    return t;
}
__device__ const PartTable PARTS = make_parts();

struct Args {
    const float* in[51];
    float* out; unsigned char* ws;
    int ph_lo, ph_hi, bar_region, pad0;
};
__device__ __forceinline__ const float* sel_in(const Args& a, int idx) {
    const float* p = a.in[6];
    p = idx == 9 ? a.in[9] : p; p = idx == 11 ? a.in[11] : p; p = idx == 33 ? a.in[33] : p; p = idx == 35 ? a.in[35] : p; p = idx == 36 ? a.in[36] : p; p = idx == 37 ? a.in[37] : p; p = idx == 38 ? a.in[38] : p; p = idx == 39 ? a.in[39] : p;
    p = idx == 44 ? a.in[44] : p; p = idx == 45 ? a.in[45] : p; p = idx == 46 ? a.in[46] : p; p = idx == 48 ? a.in[48] : p; p = idx == 49 ? a.in[49] : p; p = idx == 50 ? a.in[50] : p;
    return p;
}

struct ConvRegs { f32x4 v[4][2]; int jis[4]; };
__device__ __forceinline__ void conv_load(const Args& a, const JobTable& JT, int t0, int stride, ConvRegs& R) {
    int tid = threadIdx.x; asm volatile("" : "+v"(tid));
#pragma unroll
    for (int u = 0; u < 4; ++u) {
        const int t = t0 + u * stride; R.jis[u] = -1;
        if (t < JT.total) {
            int ji = 0;
            for (int k = 1; k < JT.n; ++k) if (t >= JT.j[k].tile0) ji = k;
            R.jis[u] = ji;
            const Job& q = JT.j[ji];
            const int lt = t - q.tile0, nTn = q.N / 64, k0 = (lt / nTn) * 64, n0 = (lt % nTn) * 64;
            const float* src = sel_in(a, q.in_idx) + (size_t)q.src_off + (size_t)k0 * q.lds + n0;
#pragma unroll
            for (int p = 0; p < 2; ++p) R.v[u][p] = *(const f32x4*)(src + (size_t)((tid >> 4) + 32 * p) * q.lds + (tid & 15) * 4);
        }
    }
}
__device__ __forceinline__ void conv_store(const Args& a, const JobTable& JT, LAS float* tile, int t0, int stride, const ConvRegs& R) {
    int tid = threadIdx.x; asm volatile("" : "+v"(tid));
    __syncthreads();
#pragma unroll
    for (int u = 0; u < 4; ++u) if (R.jis[u] >= 0) {
#pragma unroll
        for (int p = 0; p < 2; ++p) { const int kk = (tid >> 4) + 32 * p, nn = (tid & 15) * 4; LAS float* tp = tile + u * (64 * 65) + kk * 65 + nn;
            tp[0] = R.v[u][p][0]; tp[1] = R.v[u][p][1]; tp[2] = R.v[u][p][2]; tp[3] = R.v[u][p][3]; } }
    __syncthreads();
#pragma unroll
    for (int u = 0; u < 4; ++u) if (R.jis[u] >= 0) {
        const Job& q = JT.j[R.jis[u]];
        const int t = t0 + u * stride, lt = t - q.tile0, nTn = q.N / 64, k0 = (lt / nTn) * 64, n0 = (lt % nTn) * 64;
        const int n = tid >> 3, k8 = (tid & 7) * 8, ng = n0 + n;
        const int drow = (ng / q.G) * q.GS + (ng % q.G) + q.R0;
        const LAS float* tp = tile + u * (64 * 65) + n;
        u32x4 w;
        w.x = cvt_pk_bf16(tp[(k8 + 0) * 65], tp[(k8 + 1) * 65]); w.y = cvt_pk_bf16(tp[(k8 + 2) * 65], tp[(k8 + 3) * 65]);
        w.z = cvt_pk_bf16(tp[(k8 + 4) * 65], tp[(k8 + 5) * 65]); w.w = cvt_pk_bf16(tp[(k8 + 6) * 65], tp[(k8 + 7) * 65]);
        const int kk = q.kcol0 + k0 + k8;
        *(u32x4*)((bf16_t*)(a.ws + q.dst_off) + (q.blk ? ((size_t)((drow >> 8) * (q.ldd >> 6) + (kk >> 6)) << 14) + (size_t)((drow & 255) * 64 + (kk & 63)) : (size_t)drow * q.ldd + kk)) = w;
    }
}
__device__ __forceinline__ void convert_step(const Args& a, const JobTable& JT, LAS float* tile, int t0, int stride) { ConvRegs R; conv_load(a, JT, t0, stride, R); conv_store(a, JT, tile, t0, stride, R); }
__device__ __forceinline__ void convert_tiles_pipelined(const Args& a, const JobTable& JT, LAS float* tile, int first, int stride) {
    ConvRegs cur; int t0 = first;
    if (t0 >= JT.total) return;
    conv_load(a, JT, t0, stride, cur);
    for (;;) {
        const int tn = t0 + 4 * stride; const bool more = tn < JT.total;
        ConvRegs nxt;
        if (more) conv_load(a, JT, tn, stride, nxt);
        conv_store(a, JT, tile, t0, stride, cur);
        if (!more) break;
        cur = nxt; t0 = tn;
    }
}
__device__ __forceinline__ void convert_tiles(const Args& a, const JobTable& JT, LAS float* tile, int first, int stride) {
    for (int t0 = first; t0 < JT.total; t0 += 4 * stride) convert_step(a, JT, tile, t0, stride);
}

__device__ __forceinline__ int opaque(int v) { asm volatile("" : "+v"(v)); return v; }
__device__ __forceinline__ void pull_convert(const Args& a, const JobTable& JT, LAS unsigned char* lds, volatile LAS unsigned* misc, unsigned* qcnt, int max_steps, int limit = 1 << 30) {
    const int lim = limit < JT.total ? limit : JT.total;
    for (int st = 0; st < max_steps; ++st) {
        __syncthreads();
        if (threadIdx.x == 0) { const unsigned h = __hip_atomic_load(qcnt, __ATOMIC_RELAXED, __HIP_MEMORY_SCOPE_AGENT); misc[16] = (int)h < lim ? atomicAdd(qcnt, 4u) : 0x7FFFFFFFu; }
        __syncthreads();
        const int base = (int)misc[16];
        if (base >= JT.total) break;
        convert_step(a, JT, (LAS float*)lds, base, 1);
    }
}
#define PIN8(a) asm volatile("" : "+v"((a)[0]), "+v"((a)[1]), "+v"((a)[2]), "+v"((a)[3]), "+v"((a)[4]), "+v"((a)[5]), "+v"((a)[6]), "+v"((a)[7]))
#define PIN16(a) do { PIN8(a); PIN8((a) + 8); } while (0)
struct RowV { f32x4 v[4]; };
__device__ __forceinline__ RowV row_load(const float* p, int lane) { RowV r;
#pragma unroll
    for (int i = 0; i < 4; ++i) r.v[i] = *(const f32x4*)(p + 256 * i + 4 * lane); return r; }
__device__ __forceinline__ RowV row_load_bf16(const bf16_t* p, int lane) { RowV r;
#pragma unroll
    for (int i = 0; i < 4; ++i) { const u32x2 w = *(const u32x2*)(p + 256 * i + 4 * lane); r.v[i] = (f32x4){bflo(w.x), bfhi(w.x), bflo(w.y), bfhi(w.y)}; } return r; }
__device__ __forceinline__ void row_store(float* p, int lane, const RowV& r) {
#pragma unroll
    for (int i = 0; i < 4; ++i) *(f32x4*)(p + 256 * i + 4 * lane) = r.v[i]; }
__device__ __forceinline__ void row_store_bf16(bf16_t* p, int lane, const RowV& r) {
#pragma unroll
    for (int i = 0; i < 4; ++i) { u32x2 w; w.x = cvt_pk_bf16(r.v[i][0], r.v[i][1]); w.y = cvt_pk_bf16(r.v[i][2], r.v[i][3]); *(u32x2*)(p + 256 * i + 4 * lane) = w; } }
__device__ __forceinline__ RowV row_norm(const RowV& x) {
    float s = 0.f;
#pragma unroll
    for (int i = 0; i < 4; ++i) s += (x.v[i][0] + x.v[i][1]) + (x.v[i][2] + x.v[i][3]);
    const float mu = wave_sum(s) * (1.f / D);
    RowV d; float q = 0.f;
#pragma unroll
    for (int i = 0; i < 4; ++i) { d.v[i] = x.v[i] - mu; q += (d.v[i][0] * d.v[i][0] + d.v[i][1] * d.v[i][1]) + (d.v[i][2] * d.v[i][2] + d.v[i][3] * d.v[i][3]); }
    const float rs = rsqrtf(wave_sum(q) * (1.f / D) + 1e-5f);
#pragma unroll
    for (int i = 0; i < 4; ++i) d.v[i] = d.v[i] * rs;
    return d;
}
__device__ __forceinline__ RowV row_affine(const RowV& n, const float* g, const float* b, int lane) {
    RowV o;
#pragma unroll
    for (int i = 0; i < 4; ++i) o.v[i] = n.v[i] * *(const f32x4*)(g + 256 * i + 4 * lane) + *(const f32x4*)(b + 256 * i + 4 * lane);
    return o;
}
__device__ __forceinline__ RowV row_modulate(const RowV& n, const float* sh, const float* sc, int lane) {
    RowV o;
#pragma unroll
    for (int i = 0; i < 4; ++i) o.v[i] = n.v[i] * (*(const f32x4*)(sc + 256 * i + 4 * lane) + 1.0f) + *(const f32x4*)(sh + 256 * i + 4 * lane);
    return o;
}

constexpr int LDS_BYTES = 159744;
constexpr int MISC_OFF = 159488;
constexpr int NPH_LAYER = 16;
#ifndef SPLIT
#define SPLIT 0
#endif

__global__ void __launch_bounds__(512, 2) mk_fwd(Args a) {
    extern __shared__ __attribute__((aligned(16))) unsigned char shm[];
    LAS unsigned char* lds = (LAS unsigned char*)shm;
    volatile LAS unsigned* MISC = (volatile LAS unsigned*)(lds + MISC_OFF);
    const int tid0 = threadIdx.x, wave = __builtin_amdgcn_readfirstlane(tid0 >> 6);
    const int G = gridDim.x, bid = blockIdx.x;
    if (tid0 < (LDS_BYTES - MISC_OFF) / 4) MISC[tid0] = 0u;
    __syncthreads();
    unsigned char* ws = a.ws;
    unsigned* ctl = (unsigned*)(ws + WS_CTL);
    XcdBarrier bar = xcd_barrier_post(ctl + CW_BAR + a.bar_region * XCD_BAR_WORDS, MISC + 8);
    const int lo = a.ph_lo, hi = a.ph_hi;
#ifndef PHMASK
#define PHMASK 0xFFFF
#endif
#define IN(k) (lo <= (k) && (k) < hi)
#define SEAM(k) do { if (lo <= (k) && (k) + 1 < hi) xcd_barrier(bar); } while (0)
    float* MOD = (float*)(ws + WS_MOD);
    bf16_t* UB = (bf16_t*)(ws + WS_UB); bf16_t* PR = (bf16_t*)(ws + WS_PR); bf16_t* PT = (bf16_t*)(ws + WS_PT); bf16_t* YB = (bf16_t*)(ws + WS_YB);
    float* PRE = (float*)(ws + WS_PRE); float* XSC = (float*)(ws + WS_XSC);
    const float* x_in = a.in[0]; const float* ctx_in = a.in[2];

    if (((PHMASK >> 0) & 1) && IN(0)) {
        const int tid = opaque(tid0), lane = tid & 63;
        for (int i = bid * 512 + tid; i < 2 * 16384; i += G * 512)
            *(u32x4*)(ws + WS_WL + (size_t)(i >> 14) * SZ_WL + SZ_WINR + (size_t)1152 * 1024 * 2 + (size_t)(i & 16383) * 16) = (u32x4){0u, 0u, 0u, 0u};
        const int mod0 = G == 256 ? bid - 164 : bid, modstep = G == 256 ? 92 : G;
        __syncthreads();
        LAS float* sc = (LAS float*)lds;
        if (mod0 >= 0) for (int i = tid; i < 5 * 1024; i += 512) { const int r = i >> 10, k = i & 1023; sc[i] = silu_acc(r < 4 ? a.in[1][r * 1024 + k] : a.in[3][k]); }
        __syncthreads();
        LAS float* red = sc + 5 * 1024;
        for (int u = mod0; u >= 0 && u < 192; u += modstep) {
            const int l = u / 96, cg = u - l * 96, n = cg * 64 + lane;
            const float* w = a.in[4] + (size_t)l * 1024 * 6144 + n;
            float a0 = 0, a1 = 0, a2 = 0, a3 = 0, a4 = 0;
            const int kb = wave * 128;
#pragma unroll 16
            for (int k = kb; k < kb + 128; ++k) { const float wv = w[(size_t)k * 6144]; a0 += sc[k] * wv; a1 += sc[1024 + k] * wv; a2 += sc[2048 + k] * wv; a3 += sc[3072 + k] * wv; a4 += sc[4096 + k] * wv; }
            __syncthreads();
            red[(wave * 5 + 0) * 64 + lane] = a0; red[(wave * 5 + 1) * 64 + lane] = a1; red[(wave * 5 + 2) * 64 + lane] = a2; red[(wave * 5 + 3) * 64 + lane] = a3; red[(wave * 5 + 4) * 64 + lane] = a4;
            __syncthreads();
            if (tid < 320) { const int r = tid >> 6, c = tid & 63; float sacc = a.in[5][l * 6144 + cg * 64 + c];
#pragma unroll
                for (int wv = 0; wv < 8; ++wv) sacc += red[(wv * 5 + r) * 64 + c];
                MOD[((size_t)l * 5 + r) * 6144 + cg * 64 + c] = sacc; }
        }
        __syncthreads();
        for (int u = bid; u < 132; u += G) {
            const bool isc = u >= 128; const int l = isc ? 0 : (u >> 6), blk = isc ? u - 128 : (u & 63), L = isc ? CTXL : SEQ, t0 = blk * 64;
            LAS float* feat = (LAS float*)lds;
            LAS float* h1 = feat + 64 * 33;
            LAS float* h2 = h1 + 4096;
            const float* w1 = a.in[16] + l * 33 * 64; const float* b1 = a.in[17] + l * 64; const float* w2 = a.in[18] + l * 4096; const float* b2 = a.in[19] + l * 64;
            const float* w3 = a.in[20] + (size_t)l * 65536; const float* b3 = a.in[21] + l * 1024; const float* fq = a.in[22] + l * 64;
            __syncthreads();
            for (int i = tid; i < 64 * 33; i += 512) { const int tt = i / 33, f = i - tt * 33, t = t0 + tt; float v;
                if (f == 0) v = (float)t / (float)L;
                else { const int band = (f - 1) % 16 + 1; const int m = (int)(((long)t * band) % L); const float x = 2.0f * (float)m / (float)L;
                    v = f <= 16 ? cospif(x) : sinpif(x); }
                feat[i] = v; }
            __syncthreads();
            {
                float wj[64];
#pragma unroll
                for (int f = 0; f < 33; ++f) wj[f] = w1[f * 64 + lane];
                const float fj = fq[lane], bj1 = b1[lane], bj2 = b2[lane];
#pragma unroll 1
                for (int k = 0; k < 8; ++k) { const int tt = wave + 8 * k; float sacc = bj1;
#pragma unroll
                    for (int f = 0; f < 33; ++f) sacc += feat[tt * 33 + f] * wj[f];
                    h1[tt * 64 + lane] = sinf(fj * sacc); }
                __syncthreads();
#pragma unroll
                for (int f = 0; f < 64; ++f) wj[f] = w2[f * 64 + lane];
#pragma unroll 1
                for (int k = 0; k < 8; ++k) { const int tt = wave + 8 * k; float sacc = bj2;
#pragma unroll
                    for (int f4 = 0; f4 < 16; ++f4) { const f32x4 hv = *(const LAS f32x4*)(h1 + tt * 64 + 4 * f4);
                        sacc += hv[0] * wj[4 * f4]; sacc += hv[1] * wj[4 * f4 + 1]; sacc += hv[2] * wj[4 * f4 + 2]; sacc += hv[3] * wj[4 * f4 + 3]; }
                    h2[tt * 64 + lane] = sinf(fj * sacc); }
            }
            __syncthreads();
            const float dmin = 3.0701134573253945f, dmax = 15.350567286626973f;
            {
                const int fr = lane & 15, fq = lane >> 4;
                bf16x8 ah[4][2], al[4][2];
#pragma unroll
                for (int rb = 0; rb < 4; ++rb)
#pragma unroll
                    for (int ks = 0; ks < 2; ++ks) { const LAS float* hp = h2 + (16 * rb + fr) * 64 + 32 * ks + 8 * fq;
#pragma unroll
                        for (int j = 0; j < 8; ++j) { const float x = hp[j]; const bf16_t hi = f2bf(x); ah[rb][ks][j] = (short)hi; al[rb][ks][j] = (short)f2bf(x - bf2f(hi)); } }
#pragma unroll 1
                for (int cbl = 0; cbl < 8; ++cbl) {
                    const int n = wave * 128 + cbl * 16 + fr, dir = n >> 9, o = (n >> 8) & 1, c = n & 255;
                    float wv[2][8];
#pragma unroll
                    for (int ks = 0; ks < 2; ++ks)
#pragma unroll
                        for (int j = 0; j < 8; ++j) wv[ks][j] = w3[(32 * ks + 8 * fq + j) * 1024 + n];
                    const float bb = b3[n], delta = dmin + (dmax - dmin) * (float)c / 255.0f;
                    bf16x8 bh[2], bl[2];
#pragma unroll
                    for (int ks = 0; ks < 2; ++ks)
#pragma unroll
                        for (int j = 0; j < 8; ++j) { const float x = wv[ks][j]; const bf16_t hi = f2bf(x); bh[ks][j] = (short)hi; bl[ks][j] = (short)f2bf(x - bf2f(hi)); }
                    bf16_t* dst = isc ? (bf16_t*)(ws + WS_KFC) + ((size_t)(dir * 2 + o) * 256 + c) * CTXL + t0 : (bf16_t*)(ws + WS_KFL) + ((size_t)((l * 2 + dir) * 2 + o) * 256 + c) * SEQ + t0;
                    float asum = 0.f;
#pragma unroll
                    for (int rb = 0; rb < 4; ++rb) {
                        f32x4 acc = {0.f, 0.f, 0.f, 0.f};
#pragma unroll
                        for (int ks = 0; ks < 2; ++ks) {
                            acc = __builtin_amdgcn_mfma_f32_16x16x32_bf16(ah[rb][ks], bh[ks], acc, 0, 0, 0);
                            acc = __builtin_amdgcn_mfma_f32_16x16x32_bf16(al[rb][ks], bh[ks], acc, 0, 0, 0);
                            acc = __builtin_amdgcn_mfma_f32_16x16x32_bf16(ah[rb][ks], bl[ks], acc, 0, 0, 0); }
                        float v[4];
#pragma unroll
                        for (int r = 0; r < 4; ++r) { const int t = t0 + 16 * rb + 4 * fq + r;
                            v[r] = (acc[r] + bb) * expf(-((float)t / (float)L) * delta);
                            if (!(dir == 1 && t == 0)) asum += fabsf(v[r]); }
                        u32x2 w; w.x = cvt_pk_bf16(v[0], v[1]); w.y = cvt_pk_bf16(v[2], v[3]);
                        *(u32x2*)(dst + 16 * rb + 4 * fq) = w;
                    }
                    asum += __shfl_xor(asum, 16); asum += __shfl_xor(asum, 32);
                    if (fq == 0) atomicAdd((float*)(ctl + CW_HYN) + (isc ? 1024 + o * 256 + c : (l * 2 + o) * 256 + c), asum);
                }
            }
        }
        __syncthreads();
        for (int uq = bid; uq < 164; uq += G) { if (uq < 132) continue; const int u = uq - 132;
            const int l = u >> 4, g = u & 15;
            LAS float* PW = (LAS float*)lds;
            LAS float* BBs = PW + 2 * 64 * 17 * 2;
            LAS float* Cs = BBs + 2 * 64 * 16 * 2;
            LAS float* KT = Cs + 2 * 16 * 64 * 2;
            __syncthreads();
            if (tid < 128) {
                const int d = tid >> 6, p = tid & 63, idx = l * 2048 + (d * 16 + g) * 64 + p;
                const double ar = a.in[25][idx], ai = a.in[26][idx], dt = exp((double)a.in[27][l * 32 + d * 16 + g]);
                const double mag = exp(dt * ar), abr = mag * cos(dt * ai), abi = mag * sin(dt * ai), den = ar * ar + ai * ai;
                const double fr = ((abr - 1.0) * ar + abi * ai) / den, fi = (abi * ar - (abr - 1.0) * ai) / den;
                double pr = 1.0, pi = 0.0;
                for (int k = 0; k <= 16; ++k) { PW[((d * 64 + p) * 17 + k) * 2] = (float)pr; PW[((d * 64 + p) * 17 + k) * 2 + 1] = (float)pi; const double nr = pr * abr - pi * abi, ni = pr * abi + pi * abr; pr = nr; pi = ni; }
                float* a16 = (float*)(ws + WS_AB16) + ((size_t)((l * 2 + d) * 16 + g) * 64 + p) * 2;
                a16[0] = PW[((d * 64 + p) * 17 + 16) * 2]; a16[1] = PW[((d * 64 + p) * 17 + 16) * 2 + 1];
                for (int i = 0; i < 16; ++i) { const double br = a.in[28][(size_t)idx * 16 + i], bi = a.in[29][(size_t)idx * 16 + i];
                    BBs[((d * 64 + p) * 16 + i) * 2] = (float)(fr * br - fi * bi); BBs[((d * 64 + p) * 16 + i) * 2 + 1] = (float)(fr * bi + fi * br); }
            }
            for (int i = tid; i < 2048; i += 512) { const int d = i >> 10, o = (i >> 6) & 15, p = i & 63; const size_t ci = (size_t)l * 32768 + ((size_t)(d * 16 + g) * 16 + o) * 64 + p;
                Cs[i * 2] = a.in[30][ci]; Cs[i * 2 + 1] = a.in[31][ci]; }
            __syncthreads();
            {
                const int d = tid >> 8, o = (tid >> 4) & 15, i = tid & 15;
                float acc[16];
#pragma unroll
                for (int k = 0; k < 16; ++k) acc[k] = 0.f;
#pragma unroll 2
                for (int p = 0; p < 64; ++p) { const float cr = Cs[((d * 16 + o) * 64 + p) * 2], ci = Cs[((d * 16 + o) * 64 + p) * 2 + 1], br = BBs[((d * 64 + p) * 16 + i) * 2], bi = BBs[((d * 64 + p) * 16 + i) * 2 + 1];
                    const float tr = cr * br - ci * bi, ti = cr * bi + ci * br;
                    const LAS float* pw = PW + (d * 64 + p) * 34;
#pragma unroll
                    for (int k = 0; k < 16; ++k) acc[k] += tr * pw[2 * k] - ti * pw[2 * k + 1]; }
#pragma unroll
                for (int k = 0; k < 16; ++k) KT[((d * 16 + k) * 16 + o) * 16 + i] = acc[k];
            }
            __syncthreads();
            bf16_t* OPS = (bf16_t*)(ws + WS_OPS) + (size_t)(l * 16 + g) * 256 * 256;
            bf16_t* OPY = (bf16_t*)(ws + WS_OPY) + (size_t)(l * 16 + g) * 256 * 512;
            for (int e = tid; e < 256 * 32; e += 512) {
                const int row = e >> 5, c0 = (e & 31) * 8, d = row >> 7, p = (row >> 1) & 63, ri = row & 1, sx = c0 >> 4, i0 = c0 & 15, k = d == 0 ? 15 - sx : sx;
                const float pr = PW[((d * 64 + p) * 17 + k) * 2], pi = PW[((d * 64 + p) * 17 + k) * 2 + 1];
                float v[8];
#pragma unroll
                for (int j = 0; j < 8; ++j) { const float br = BBs[((d * 64 + p) * 16 + i0 + j) * 2], bi = BBs[((d * 64 + p) * 16 + i0 + j) * 2 + 1]; v[j] = ri == 0 ? pr * br - pi * bi : pr * bi + pi * br; }
                u32x4 w; w.x = cvt_pk_bf16(v[0], v[1]); w.y = cvt_pk_bf16(v[2], v[3]); w.z = cvt_pk_bf16(v[4], v[5]); w.w = cvt_pk_bf16(v[6], v[7]);
                *(u32x4*)(OPS + (size_t)row * 256 + c0) = w; }
            for (int e = tid; e < 256 * 64; e += 512) {
                const int row = e >> 6, c0 = (e & 63) * 8, t = row >> 4, o = row & 15;
                float v[8];
                if (c0 < 256) { const int sx = c0 >> 4, i0 = c0 & 15;
#pragma unroll
                    for (int j = 0; j < 8; ++j) { float x = 0.f; if (sx <= t) x += KT[((0 * 16 + (t - sx)) * 16 + o) * 16 + i0 + j]; if (sx >= t) x += KT[((1 * 16 + (sx - t)) * 16 + o) * 16 + i0 + j]; v[j] = x; } }
                else { const int c2 = c0 - 256, d = c2 >> 7, k = d == 0 ? t + 1 : 16 - t;
#pragma unroll
                    for (int j = 0; j < 8; ++j) { const int p = ((c2 + j) >> 1) & 63, ri = (c2 + j) & 1;
                        const float cr = Cs[((d * 16 + o) * 64 + p) * 2], ci = Cs[((d * 16 + o) * 64 + p) * 2 + 1], pr = PW[((d * 64 + p) * 17 + k) * 2], pi = PW[((d * 64 + p) * 17 + k) * 2 + 1];
                        v[j] = ri == 0 ? cr * pr - ci * pi : -(cr * pi + ci * pr); } }
                u32x4 w; w.x = cvt_pk_bf16(v[0], v[1]); w.y = cvt_pk_bf16(v[2], v[3]); w.z = cvt_pk_bf16(v[4], v[5]); w.w = cvt_pk_bf16(v[6], v[7]);
                *(u32x4*)(OPY + (size_t)row * 512 + c0) = w; }
        }
        __syncthreads();
        for (;;) {
            __syncthreads();
            if (tid == 0) MISC[16] = atomicAdd(ctl + CW_QUEUE, 4u);
            __syncthreads();
            const int base = (int)MISC[16];
            if (base >= JT_SMALL.total) break;
            convert_step(a, JT_SMALL, (LAS float*)lds, base, 1);
        }
        __syncthreads();
    }
    SEAM(0);

    for (int l = 0; l < 2; ++l) {
        const int P0 = 1 + l * NPH_LAYER;
        const float* MODL = MOD + (size_t)l * 5 * 6144;
        const unsigned char* WL = ws + WS_WL + (size_t)l * SZ_WL;
        const int nMrow = (l == 0) ? 68 : 64;
        const float* xlat = (l == 0) ? x_in : a.out; const float* xctx = (l == 0) ? ctx_in : XSC;

        if (((PHMASK >> 1) & 1) && l == 0 && IN(P0 + 0)) {
            const int lane = opaque(tid0) & 63;
            for (int r = bid * 8 + wave; r < RT; r += G * 8) {
                const float* src = r < RL ? x_in + (size_t)r * D : ctx_in + (size_t)(r - RL) * D;
                const float* mv = MODL + (size_t)(r < RL ? (r >> 12) : 4) * 6144;
                const RowV n = row_norm(row_load(src, lane));
                row_store_bf16(UB + (size_t)r * D, lane, row_modulate(n, mv, mv + 1024, lane));
            }
        }
        if (l == 0) SEAM(P0 + 0);

        if (((PHMASK >> 2) & 1) && IN(P0 + 1)) {
            const pg8::TabSched S{PARTS.p + l * 8, (const char*)ws, 2, 68 * 23 + 5 * 68, G, bid};
            pg8::EpiProj E{PR, PT, (bf16_t*)(ws + WS_US), 7, ws + WS_GQ};
            pg8::gemm_phase<1024, 1024>(lds, S, E);
            if (G == 256 && bid >= 112) pull_convert(a, JT_BG, lds, MISC, ctl + CW_QUEUE + 64, SLOT_G1);
        }
        SEAM(P0 + 1);
        if (((PHMASK >> 13) & 1) && IN(P0 + 2)) {
            const int tid = opaque(tid0), lane = tid & 63;
            LAS float* rp = (LAS float*)lds;
            for (int i = tid; i < 6 * 465; i += 512) rp[i] = a.in[24][l * 2790 + i];
            __syncthreads();
            LAS bf16_t* KW = (LAS bf16_t*)(lds + 11264);
            LAS bf16_t* CK = (LAS bf16_t*)(lds + 11264 + 576 * 144);
            LAS bf16_t* VW = (LAS bf16_t*)(lds + 11264);
            LAS bf16_t* CV = (LAS bf16_t*)(lds + 11264 + 64 * 1168);
            const int ngroups = 768 + (l == 0 ? 48 : 0);
            for (int gi0 = bid; gi0 < 768 + G; gi0 += G) {
                const int gi = gi0 < 768 ? gi0 : 768 + ((gi0 - 768 + G - 48) % G);
                if (gi >= ngroups) continue;
                const bool lat = gi < 768;
                const int combo = lat ? gi >> 5 : (gi - 768) >> 1, b = combo / 6, h = combo - 6 * b;
                const int v = lat ? ((gi & 31) << 3) + wave : (((gi - 768) & 1) << 3) + wave;
                const int r0g = (gi & 31) << 1, rs0 = r0g - 4 < 0 ? 0 : (r0g - 4 > 56 ? 56 : r0g - 4);
                const int ntokw = lat ? ((64 - rs0) < 9 ? (64 - rs0) : 9) * 64 : 0;
                __syncthreads();
                {   const int tid2 = opaque(tid);
#pragma unroll
                    for (int k = 0; k < 9; ++k) { const int c = tid2 + 512 * k, tok = c >> 3, part = c & 7;
                        if (tok < ntokw) *(LAS u32x4*)(KW + tok * 72 + part * 8) = *(const u32x4*)(PR + (size_t)(b * SEQ + rs0 * 64 + tok) * LDP + PC_K + h * 64 + part * 8); }
#pragma unroll
                    for (int k = 0; k < 4; ++k) { const int c = tid2 + 512 * k, tok = c >> 3, part = c & 7;
                        *(LAS u32x4*)(CK + tok * 72 + part * 8) = *(const u32x4*)(PR + (size_t)(RL + b * CTXL + tok) * LDP + PC_K + h * 64 + part * 8); } }
                __syncthreads();
                const int ln2 = opaque(lane), qn = ln2 & 15, g = ln2 >> 4;
                int r = 0, qb, tq, rs = 0, bs = 0, w = 0, cs = 0;
                if (lat) { qb = v & 3; r = v >> 2; rs = r - 4 < 0 ? 0 : (r - 4 > 56 ? 56 : r - 4); bs = qb == 0 ? 0 : (qb == 1 ? 8 : (qb == 2 ? 24 : 32));
                    w = 16 * qb + qn; cs = w - 8 < 0 ? 0 : (w - 8 > 48 ? 48 : w - 8); tq = b * SEQ + r * 64 + w; }
                else { qb = v; tq = RL + b * CTXL + 16 * qb + qn; }
                const int pr0 = rs - rs0;
                const bf16_t* qp = PR + (size_t)tq * LDP + PC_Q + h * 64 + 8 * g;
                const bf16x8 q0 = *(const bf16x8*)qp, q1 = *(const bf16x8*)(qp + 32);
                f32x4 S[32];
                const int koff = 8 * (qn >> 2) + (qn & 3);
                if (lat) {
#pragma unroll
                    for (int p = 0; p < 8; ++p)
#pragma unroll
                        for (int hf = 0; hf < 2; ++hf) { const LAS bf16_t* kp = KW + ((pr0 + p) * 64 + bs + koff + 4 * hf) * 72 + 8 * g;
                            const bf16x8 k0 = *(const LAS bf16x8*)kp, k1 = *(const LAS bf16x8*)(kp + 32);
                            f32x4 acc = {0.f, 0.f, 0.f, 0.f};
                            acc = __builtin_amdgcn_mfma_f32_16x16x32_bf16(k0, q0, acc, 0, 0, 0);
                            acc = __builtin_amdgcn_mfma_f32_16x16x32_bf16(k1, q1, acc, 0, 0, 0);
                            const int rowoff = (h * 15 + (rs + p - r + 7)) * 31;
#pragma unroll
                            for (int j = 0; j < 4; ++j) { const int c = bs + 8 * g + 4 * hf + j; const bool ok = (c >= cs) && (c < cs + 16);
                                const int dc = ok ? c - w + 15 : 0;
                                acc[j] = ok ? acc[j] * 0.125f + rp[rowoff + dc] : -3.0e38f; }
                            S[2 * p + hf] = acc; if (hf == 1 && (p & 1)) __builtin_amdgcn_sched_barrier(0); }
                } else {
#pragma unroll
                    for (int p = 0; p < 16; ++p) S[p] = (f32x4){-3.0e38f, -3.0e38f, -3.0e38f, -3.0e38f};
                }
#pragma unroll
                for (int p = 0; p < 8; ++p)
#pragma unroll
                    for (int hf = 0; hf < 2; ++hf) { const LAS bf16_t* kp = CK + (32 * p + koff + 4 * hf) * 72 + 8 * g;
                        const bf16x8 k0 = *(const LAS bf16x8*)kp, k1 = *(const LAS bf16x8*)(kp + 32);
                        f32x4 acc = {0.f, 0.f, 0.f, 0.f};
                        acc = __builtin_amdgcn_mfma_f32_16x16x32_bf16(k0, q0, acc, 0, 0, 0);
                        acc = __builtin_amdgcn_mfma_f32_16x16x32_bf16(k1, q1, acc, 0, 0, 0);
                        S[16 + 2 * p + hf] = acc * 0.125f; if (hf == 1 && (p & 1)) __builtin_amdgcn_sched_barrier(0); }
                float mx = -3.0e38f;
#pragma unroll
                for (int i = 0; i < 32; ++i) mx = fmaxf(fmaxf(mx, fmaxf(S[i][0], S[i][1])), fmaxf(S[i][2], S[i][3]));
                mx = fmaxf(mx, __shfl_xor(mx, 16)); mx = fmaxf(mx, __shfl_xor(mx, 32));
                float sum = 0.f;
#pragma unroll
                for (int i = 0; i < 32; ++i) {
#pragma unroll
                    for (int j = 0; j < 4; ++j) { const float e = __expf(S[i][j] - mx); S[i][j] = e; sum += e; } }
                sum += __shfl_xor(sum, 16); sum += __shfl_xor(sum, 32);
                const float inv = 1.0f / sum;
                __syncthreads();
                {   const int tid2 = opaque(tid);
#pragma unroll
                    for (int k = 0; k < 9; ++k) { const int c = tid2 + 512 * k, dd = c / 72, part = c - dd * 72;
                        if (part * 8 < ntokw) *(LAS u32x4*)(VW + dd * 584 + part * 8) = *(const u32x4*)(PT + (size_t)(PT_V + h * 64 + dd) * RT + b * SEQ + rs0 * 64 + part * 8); }
#pragma unroll
                    for (int k = 0; k < 4; ++k) { const int c = tid2 + 512 * k, dd = c >> 5, part = c & 31;
                        *(LAS u32x4*)(CV + dd * 264 + part * 8) = *(const u32x4*)(PT + (size_t)(PT_V + h * 64 + dd) * RT + RL + b * CTXL + part * 8); } }
                __syncthreads();
                f32x4 O[4];
#pragma unroll
                for (int dt = 0; dt < 4; ++dt) O[dt] = (f32x4){0.f, 0.f, 0.f, 0.f};
#pragma unroll
                for (int p = 0; p < 16; ++p) {
                    if (p < 8 && !lat) continue;
                    u32x4 pw; pw.x = cvt_pk_bf16(S[2 * p][0], S[2 * p][1]); pw.y = cvt_pk_bf16(S[2 * p][2], S[2 * p][3]); pw.z = cvt_pk_bf16(S[2 * p + 1][0], S[2 * p + 1][1]); pw.w = cvt_pk_bf16(S[2 * p + 1][2], S[2 * p + 1][3]);
                    bf16x8 pf; __builtin_memcpy(&pf, &pw, 16);
#pragma unroll
                    for (int dt = 0; dt < 4; ++dt) { const LAS bf16_t* vp = p < 8 ? VW + (16 * dt + qn) * 584 + (pr0 + p) * 64 + bs + 8 * g : CV + (16 * dt + qn) * 264 + 32 * (p - 8) + 8 * g;
                        O[dt] = __builtin_amdgcn_mfma_f32_16x16x32_bf16(*(const LAS bf16x8*)vp, pf, O[dt], 0, 0, 0); }
                    if (p & 1) __builtin_amdgcn_sched_barrier(0);
                }
                bf16_t* op = YB + (size_t)tq * YW + YC_C + h * 64 + 4 * g;
#pragma unroll
                for (int dt = 0; dt < 4; ++dt) { u32x2 o2; o2.x = cvt_pk_bf16(O[dt][0] * inv, O[dt][1] * inv); o2.y = cvt_pk_bf16(O[dt][2] * inv, O[dt][3] * inv); *(u32x2*)(op + 16 * dt) = o2; }
            }
            __syncthreads();
            {
                const int tid = opaque(tid0), lane = tid & 63;
                LAS float* XC = (LAS float*)lds;
                LAS f32x2* AB = (LAS f32x2*)(lds + 16 * 384 * 4);
                const float* cw = a.in[7] + l * 4 * 384; const float* cb = a.in[8] + l * 384;
                const bf16_t* LW = (const bf16_t*)(ws + WS_LW) + (size_t)l * 24 * 4096;
                bf16_t* LT = (bf16_t*)(ws + WS_LT); f32x2* LAGG = (f32x2*)(ws + WS_LAGG);
                const int dir = (wave >> 2) & 1, ntile = wave & 3, tk = lane & 15, kg = lane >> 4;
                LAS float* CT = (LAS float*)(lds + 16 * 384 * 4 + 2 * 16 * 384 * 8);
                for (int i = tid; i < 768; i += 512) { CT[i] = a.in[10][l * 768 + i]; CT[768 + i] = a.in[12][l * 768 + i]; CT[1536 + i] = -8.0f * softplus(-a.in[13][l * 768 + i]); }
                float cwv[60];
#pragma unroll
                for (int i = 0; i < 12; ++i) { const int idx = tid + 512 * i, ch = idx % 384;
                    cwv[5 * i] = cw[ch]; cwv[5 * i + 1] = cw[384 + ch]; cwv[5 * i + 2] = cw[768 + ch]; cwv[5 * i + 3] = cw[1152 + ch]; cwv[5 * i + 4] = cb[ch]; }
                PIN16(cwv); PIN16(cwv + 16); PIN16(cwv + 32); PIN8(cwv + 48); asm volatile("" : "+v"(cwv[56]), "+v"(cwv[57]), "+v"(cwv[58]), "+v"(cwv[59]));
                for (int n0 = bid; n0 < 1024 + G; n0 += G) {
                    const int n = n0 < 1024 ? n0 : 1024 + ((n0 - 1024 + G - 112) % G);
                    if (n >= NCHK) continue;
                    const int r0 = 16 * n; int start, len, pos0, bb; row_seq(r0, start, len, pos0, bb);
                    __syncthreads();
                    unsigned pin[48];
#pragma unroll
                    for (int i = 0; i < 12; ++i) { const int idx = tid + 512 * i, tok = idx / 384, ch = idx - tok * 384, pos = pos0 + tok;
                        const bf16_t* pr = PR + (size_t)(r0 + tok) * LDP + PC_AC + ch;
                        pin[4 * i + 0] = pos >= 2 ? pr[-2 * LDP] : 0; pin[4 * i + 1] = pos >= 1 ? pr[-LDP] : 0; pin[4 * i + 2] = pr[0]; pin[4 * i + 3] = pos + 1 < len ? pr[LDP] : 0; }
                    PIN16(pin); PIN16(pin + 16); PIN16(pin + 32);
#pragma unroll
                    for (int i = 0; i < 12; ++i) { const int idx = tid + 512 * i, tok = idx / 384, ch = idx - tok * 384;
                        XC[idx] = cwv[5 * i + 4] + cwv[5 * i] * bflo(pin[4 * i]) + cwv[5 * i + 1] * bflo(pin[4 * i + 1]) + cwv[5 * i + 2] * bflo(pin[4 * i + 2]) + cwv[5 * i + 3] * bflo(pin[4 * i + 3]); }
                    __syncthreads();
#pragma unroll 2
                    for (int g = 0; g < 6; ++g) {
                        bf16x8 wq[4];
#pragma unroll
                        for (int ks = 0; ks < 2; ++ks) { const bf16_t* wp = LW + ((size_t)((dir * 2 + 0) * 6 + g) * 64 + 16 * ntile + tk) * 64 + 32 * ks + 8 * kg; wq[2 * ks] = *(const bf16x8*)wp; wq[2 * ks + 1] = *(const bf16x8*)(wp + 6 * 4096); }
                        asm volatile("" : "+v"(wq[0]), "+v"(wq[1]), "+v"(wq[2]), "+v"(wq[3]));
                        f32x4 ar = {0.f, 0.f, 0.f, 0.f}, ai = {0.f, 0.f, 0.f, 0.f};
#pragma unroll
                        for (int ks = 0; ks < 2; ++ks) {
                            const LAS float* xp = XC + tk * 384 + g * 64 + 32 * ks + 8 * kg;
                            const f32x4 x0 = *(const LAS f32x4*)xp, x1 = *(const LAS f32x4*)(xp + 4);
                            u32x4 xw; xw.x = cvt_pk_bf16(x0[0], x0[1]); xw.y = cvt_pk_bf16(x0[2], x0[3]); xw.z = cvt_pk_bf16(x1[0], x1[1]); xw.w = cvt_pk_bf16(x1[2], x1[3]);
                            bf16x8 xf; __builtin_memcpy(&xf, &xw, 16);
                            ar = __builtin_amdgcn_mfma_f32_16x16x32_bf16(xf, wq[2 * ks], ar, 0, 0, 0);
                            ai = __builtin_amdgcn_mfma_f32_16x16x32_bf16(xf, wq[2 * ks + 1], ai, 0, 0, 0);
                        }
                        const int ch = g * 64 + 16 * ntile + tk;
                        const float br = CT[dir * 384 + ch], bi = CT[768 + dir * 384 + ch], sp8 = CT[1536 + dir * 384 + ch];
#pragma unroll
                        for (int j = 0; j < 4; ++j) { const int tok = 4 * kg + j;
                            const float la = sigm(ar[j] + br) * sp8, y = 2.0f * la;
                            const float av = 1.0f + la * (1.0f + la * (0.5f + la * (0.16666667f + la * (0.041666667f + la * 0.0083333333f))));
                            const float om = -y * (1.0f + y * (0.5f + y * (0.16666667f + y * (0.041666667f + y * (0.0083333333f + y * 0.0013888889f)))));
                            const float bt = __builtin_sqrtf(om) * sigm(ai[j] + bi) * XC[tok * 384 + ch];
                            AB[(dir * 16 + tok) * 384 + ch] = (f32x2){av, bt}; }
                    }
                    __syncthreads();
                    if (tid < 384) {
                        float hf = 0.f, pf = 1.f, hb = 0.f, pb = 1.f;
#pragma unroll
                        for (int t = 0; t < 16; ++t) {
                            const f32x2 f = AB[t * 384 + tid], bk = AB[(16 + 15 - t) * 384 + tid];
                            hf = f[0] * hf + f[1]; pf *= f[0]; hb = bk[0] * hb + bk[1]; pb *= bk[0];
                            AB[t * 384 + tid] = (f32x2){pf, hf}; AB[(16 + 15 - t) * 384 + tid] = (f32x2){pb, hb}; }
                        LAGG[((size_t)n * 2 + 0) * 384 + tid] = (f32x2){pf, hf}; LAGG[((size_t)n * 2 + 1) * 384 + tid] = (f32x2){pb, hb};
                    }
                    __syncthreads();
#pragma unroll
                    for (int i = 0; i < 12; ++i) { const int idx = tid + 512 * i, tok = idx / 384, ch = idx - tok * 384;
                        const f32x2 f = AB[idx], bk = AB[16 * 384 + idx];
                        bf16_t* o = LT + (size_t)(r0 + tok) * 1152 + ch;
                        o[0] = f2bf(f[1] + bk[1]); o[384] = f2bf(f[0]); o[768] = f2bf(bk[0]); }
                }
                __syncthreads();
            }
            {
                const int tid = opaque(tid0), lane = tid & 63;
                constexpr int ZS = SEQ + 16;
                LAS bf16_t* R0 = (LAS bf16_t*)lds;
                LAS bf16_t* R1 = R0 + 8224;
                LAS bf16_t* ZA = R1 + 8224;
                const LAS unsigned* Rdw = (const LAS unsigned*)lds;
#define HY_ZF(b, s) ((b) * ZS + ((s) & ~63) + (((((s) >> 3) & 7) ^ (((s) >> 7) & 1)) << 3) + ((s) & 7))
                const float* hcw = a.in[14] + l * 3 * 768; const float* hcb = a.in[15] + l * 768;
                const float* nrm = (const float*)(ctl + CW_HYN);
                bf16_t* YT = (bf16_t*)(ws + WS_YT);
                const int r32 = lane & 31, hh = lane >> 5, il = r32 >> 2, bq = r32 & 3, iblk = 8 * wave + il;
                const int x0b = 4095 - r32 + 8 * hh, par = x0b & 1;
                const int abase = (par ? 4112 : 0) + ((x0b - par) >> 1);
                for (int c = bid; c < 256; c += G) {
                    __syncthreads();
#pragma unroll 1
                    for (int it = tid; it < 3 * 4 * 512; it += 512) {
                        const int arr = it >> 11, b = (it >> 9) & 3, s8 = (it & 511) * 8, ch = arr * 256 + c;
                        const bf16_t* pp = PT + (size_t)ch * RT + b * SEQ + s8;
                        const u32x4 pv = *(const u32x4*)pp;
                        const float w0 = hcw[ch], w1 = hcw[768 + ch], w2 = hcw[1536 + ch], cb0 = hcb[ch];
                        float p[10];
                        p[0] = s8 > 0 ? bf2f(pp[-1]) : 0.f; p[9] = s8 + 8 < SEQ ? bf2f(pp[8]) : 0.f;
                        p[1] = bflo(pv.x); p[2] = bfhi(pv.x); p[3] = bflo(pv.y); p[4] = bfhi(pv.y); p[5] = bflo(pv.z); p[6] = bfhi(pv.z); p[7] = bflo(pv.w); p[8] = bfhi(pv.w);
                        float z[8];
#pragma unroll
                        for (int j = 0; j < 8; ++j) z[j] = cb0 + w0 * p[j] + w1 * p[j + 1] + w2 * p[j + 2];
                        u32x4 w; w.x = cvt_pk_bf16(z[0], z[1]); w.y = cvt_pk_bf16(z[2], z[3]); w.z = cvt_pk_bf16(z[4], z[5]); w.w = cvt_pk_bf16(z[6], z[7]);
                        *(LAS u32x4*)(ZA + arr * 4 * ZS + HY_ZF(b, s8)) = w;
                    }
#pragma unroll 1
                    for (int o = 0; o < 2; ++o) {
                        const bf16_t* kf = (const bf16_t*)(ws + WS_KFL) + ((size_t)((l * 2 + 0) * 2 + o) * 256 + c) * SEQ;
                        const bf16_t* kb = (const bf16_t*)(ws + WS_KFL) + ((size_t)((l * 2 + 1) * 2 + o) * 256 + c) * SEQ;
                        { unsigned tv[16];
#pragma unroll
                          for (int q = 0; q < 16; ++q) { const int x = tid + 512 * q; tv[q] = x < 4096 ? kf[4095 - x] : (x <= 8190 ? kb[x - 4095] : (bf16_t)0); }
                          PIN16(tv);
#pragma unroll
                          for (int q = 0; q < 16; ++q) R0[tid + 512 * q] = (bf16_t)tv[q]; }
                        __syncthreads();
                        for (int x = tid; x < 8192; x += 512) R1[x] = x < 8191 ? R0[x + 1] : (bf16_t)0;
                        __syncthreads();
                        const LAS bf16_t* Z = ZA + (o == 0 ? 0 : 4 * ZS) + bq * ZS;
                        typedef float f32x16 __attribute__((ext_vector_type(16)));
                        f32x16 acc0, acc1;
#pragma unroll
                        for (int q = 0; q < 16; ++q) { acc0[q] = 0.f; acc1[q] = 0.f; }
                        const int dlo = 8 * wave - 63, dhi = 8 * wave + 7;
#define HY_AF(dst, off_) do { const LAS unsigned* a_ = ap + (off_); u32x4 w_ = {a_[0], a_[1], a_[2], a_[3]}; __builtin_memcpy(&dst, &w_, 16); } while (0)
                        {
                            bf16x8 f16, f24;
                            { const LAS unsigned* ap = Rdw + abase - 32 * dlo; HY_AF(f16, 16); HY_AF(f24, 24); }
#pragma unroll 1
                            for (int dl = dlo; dl <= dhi; ++dl) {
                                const int j = iblk - dl; const bool ok = (j >= 0) && (j < 64); const int jc = j < 0 ? 0 : (j > 63 ? 63 : j);
                                const LAS bf16_t* zp = Z + jc * 64; const int sw = (jc >> 1) & 1;
                                const LAS unsigned* ap = Rdw + abase - 32 * dl;
                                bf16x8 bf[4], fm16, fm8, f0, f8;
#pragma unroll
                                for (int kk = 0; kk < 4; ++kk) { bf16x8 t = *(const LAS bf16x8*)(zp + (((2 * kk + hh) ^ sw) << 3)); bf[kk] = ok ? t : (bf16x8){0, 0, 0, 0, 0, 0, 0, 0}; }
                                HY_AF(fm16, -16); HY_AF(fm8, -8); HY_AF(f0, 0); HY_AF(f8, 8);
                                acc0 = __builtin_amdgcn_mfma_f32_32x32x16_bf16(f0, bf[0], acc0, 0, 0, 0);  acc1 = __builtin_amdgcn_mfma_f32_32x32x16_bf16(fm16, bf[0], acc1, 0, 0, 0);
                                acc0 = __builtin_amdgcn_mfma_f32_32x32x16_bf16(f8, bf[1], acc0, 0, 0, 0);  acc1 = __builtin_amdgcn_mfma_f32_32x32x16_bf16(fm8, bf[1], acc1, 0, 0, 0);
                                acc0 = __builtin_amdgcn_mfma_f32_32x32x16_bf16(f16, bf[2], acc0, 0, 0, 0); acc1 = __builtin_amdgcn_mfma_f32_32x32x16_bf16(f0, bf[2], acc1, 0, 0, 0);
                                acc0 = __builtin_amdgcn_mfma_f32_32x32x16_bf16(f24, bf[3], acc0, 0, 0, 0); acc1 = __builtin_amdgcn_mfma_f32_32x32x16_bf16(f8, bf[3], acc1, 0, 0, 0);
                                f16 = fm16; f24 = fm8;
                            }
                        }
#undef HY_AF
                        const float inv = 1.0f / (nrm[(l * 2 + o) * 256 + c] + 1e-6f), hb = a.in[23][(l * 2 + o) * 256 + c];
                        LAS bf16_t* GI = ZA + (o + 1) * 4 * ZS;
                        const LAS bf16_t* ZI = ZA + (o == 0 ? 0 : 4 * ZS);
#pragma unroll
                        for (int q = 0; q < 16; ++q) {
                            const int a0r = (q & 3) + 8 * (q >> 2) + 4 * hh, t0 = 64 * iblk + a0r, t1 = t0 + 32;
                            const int i0 = HY_ZF(bq, t0), i1 = HY_ZF(bq, t1);
                            const float zv0 = bf2f(ZI[i0]), zv1 = bf2f(ZI[i1]);
                            const float y0 = bf2f(GI[i0]) * (acc0[q] * inv + hb * zv0), y1v = bf2f(GI[i1]) * (acc1[q] * inv + hb * zv1);
                            GI[i0] = f2bf(y0); GI[i1] = f2bf(y1v);
                        }
                        __syncthreads();
                    }
                    for (int it = tid; it < 4 * 512; it += 512) { const int b = it >> 9, s8 = (it & 511) * 8;
                        *(u32x4*)(YT + (size_t)c * RT + b * SEQ + s8) = *(const LAS u32x4*)(ZA + 2 * 4 * ZS + HY_ZF(b, s8)); }
                    if (l == 0) {
                        __syncthreads();
                        LAS float* zc = (LAS float*)lds;
                        LAS float* kc = zc + 3072;
                        LAS float* y1c = kc + 1024;
                        for (int it = tid; it < 3072; it += 512) { const int arr = it >> 10, b = (it >> 8) & 3, sx = it & 255, ch = arr * 256 + c;
                            const bf16_t* pp = PT + (size_t)ch * RT + RL + b * CTXL + sx;
                            float z = hcb[ch] + hcw[768 + ch] * bf2f(pp[0]); if (sx > 0) z += hcw[ch] * bf2f(pp[-1]); if (sx + 1 < CTXL) z += hcw[1536 + ch] * bf2f(pp[1]);
                            zc[it] = z; }
                        for (int it = tid; it < 1024; it += 512) { const int o = it >> 9, d = (it & 511) - 256;
                            const bf16_t* kfc = (const bf16_t*)(ws + WS_KFC) + ((size_t)(0 * 2 + o) * 256 + c) * CTXL; const bf16_t* kbc = (const bf16_t*)(ws + WS_KFC) + ((size_t)(1 * 2 + o) * 256 + c) * CTXL;
                            kc[it] = d >= 0 ? bf2f(kfc[d]) : (d > -256 ? bf2f(kbc[-d]) : 0.f); }
                        __syncthreads();
#pragma unroll 1
                        for (int o = 0; o < 2; ++o) {
                            const float inv = 1.0f / (nrm[1024 + o * 256 + c] + 1e-6f), hb = a.in[23][o * 256 + c];
                            for (int it = tid; it < 1024; it += 512) { const int b = it >> 8, t = it & 255;
                                const LAS float* zi = o == 0 ? zc + b * 256 : y1c + b * 256;
                                const LAS float* kk = kc + o * 512 + 256 + t;
                                float acc = 0.f;
#pragma unroll 16
                                for (int sx = 0; sx < CTXL; ++sx) acc += kk[-sx] * zi[sx];
                                const float y = zc[(o + 1) * 1024 + b * 256 + t] * (acc * inv + hb * zi[t]);
                                if (o == 0) y1c[it] = y; else YT[(size_t)c * RT + RL + b * CTXL + t] = f2bf(y); }
                            __syncthreads();
                        }
                    }
                }
#undef HY_ZF
                __syncthreads();
            }
            {
                const pg8::TabSched S{PARTS.p + 18 + l * 3, (const char*)ws, 1, 80, G, (bid + 80) % G};
                pg8::EpiS5State E{(float*)(ws + WS_S5S)};
                pg8::gemm_phase<512, 256>(lds, S, E);
            }
        }
        SEAM(P0 + 2);
        if (((PHMASK >> 14) & 1) && IN(P0 + 3)) {
            const int tid = opaque(tid0), lane = tid & 63;
            LAS float* st = (LAS float*)lds;
            const float* S5S = (const float*)(ws + WS_S5S); bf16_t* US = (bf16_t*)(ws + WS_US);
            for (int u = bid; u < 128; u += G) {
                const int d = u & 1, g = (u >> 1) & 15, b = u >> 5;
                __syncthreads();
                for (int i = tid; i < 272 * 32; i += 512) { const int q = i >> 5, c4 = (i & 31) * 4; const int n = q < 16 ? 1024 + 16 * b + q : 256 * b + (q - 16);
                    const f32x4 v = *(const f32x4*)(S5S + ((size_t)g * NCHKP + n) * 256 + d * 128 + c4);
                    st[q * 128 + c4] = v[0]; st[q * 128 + c4 + 1] = v[1]; st[q * 128 + c4 + 2] = v[2]; st[q * 128 + c4 + 3] = v[3]; }
                __syncthreads();
                if (wave == 0) {
                    const float* ab = (const float*)(ws + WS_AB16) + ((size_t)((l * 2 + d) * 16 + g) * 64 + lane) * 2;
                    const float ar = ab[0], ai = ab[1];
                    float hr = 0.f, hi = 0.f;
#pragma unroll 1
                    for (int k0 = 0; k0 < 272; k0 += 8) {
                        f32x2 sv[8]; int nn[8];
#pragma unroll
                        for (int j = 0; j < 8; ++j) { const int k = k0 + j; const int q = d == 0 ? k : (k < 16 ? 15 - k : 287 - k);
                            nn[j] = q < 16 ? 1024 + 16 * b + q : 256 * b + (q - 16); sv[j] = *(const LAS f32x2*)(st + q * 128 + 2 * lane); }
#pragma unroll
                        for (int j = 0; j < 8; ++j) {
                            *(unsigned*)(US + ((size_t)g * NCHKP + nn[j]) * 512 + 256 + d * 128 + 2 * lane) = cvt_pk_bf16(hr, hi);
                            const float nr = ar * hr - ai * hi + sv[j][0], ni = ar * hi + ai * hr + sv[j][1];
                            hr = nr; hi = ni; }
                    }
                }
            }
            __syncthreads();
            for (int uq = bid; uq < 176; uq += G) { if (uq < 128) continue; const int u = uq - 128;
                const int cb6 = u % 6, d = (u / 6) & 1, b = u / 12;
                LAS f32x2* sa = (LAS f32x2*)lds;
                const f32x2* LAGG = (const f32x2*)(ws + WS_LAGG); float* HIN = (float*)(ws + WS_LHIN);
                __syncthreads();
                for (int i = tid; i < 272 * 64; i += 512) { const int q = i >> 6, c = i & 63; const int n = q < 16 ? 1024 + 16 * b + q : 256 * b + (q - 16);
                    sa[i] = LAGG[((size_t)n * 2 + d) * 384 + cb6 * 64 + c]; }
                __syncthreads();
                if (wave == 0) {
                    float h = 0.f;
#pragma unroll 1
                    for (int k0 = 0; k0 < 272; k0 += 8) {
                        f32x2 sv[8]; int nn[8];
#pragma unroll
                        for (int j = 0; j < 8; ++j) { const int k = k0 + j; const int q = d == 0 ? k : (k < 16 ? 15 - k : 287 - k);
                            nn[j] = q < 16 ? 1024 + 16 * b + q : 256 * b + (q - 16); sv[j] = sa[q * 64 + lane]; }
#pragma unroll
                        for (int j = 0; j < 8; ++j) { HIN[((size_t)nn[j] * 2 + d) * 384 + cb6 * 64 + lane] = h; h = sv[j][0] * h + sv[j][1]; }
                    }
                }
            }
            __syncthreads();
            if (bid >= 176) pull_convert(a, JT_BG, lds, MISC, ctl + CW_QUEUE + 64, SLOT_M2);
        }
        SEAM(P0 + 3);
        if (((PHMASK >> 15) & 1) && IN(P0 + 4)) {
            const pg8::TabSched S{PARTS.p + 19 + l * 3, (const char*)ws, 1, 80, G, bid};
            pg8::EpiS5Main E{(bf16_t*)(ws + WS_GL), PR, a.in[32] + l * 256};
            pg8::gemm_phase<512, 512>(lds, S, E);
            {
                const int tid = opaque(tid0);
                const bf16_t* YT = (const bf16_t*)(ws + WS_YT);
                LAS bf16_t* tl = (LAS bf16_t*)lds;
                const int nrt = nMrow * 4;
                const int nb0 = G > 160 ? 80 : 0, vb = bid - nb0, vG = G - nb0;
                if (vb >= 0) for (int t = vb; t < 4 * nrt; t += vG) {
                    const int c0 = (t & 3) * 64, r0 = (t >> 2) * 64;
                    __syncthreads();
                    { const int cc = tid >> 3, r8 = (tid & 7) * 8; *(LAS u32x4*)(tl + cc * 72 + r8) = *(const u32x4*)(YT + (size_t)(c0 + cc) * RT + r0 + r8); }
                    __syncthreads();
                    { const int rr = tid >> 3, c8 = (tid & 7) * 8; unsigned short e[8];
#pragma unroll
                        for (int j = 0; j < 8; ++j) e[j] = tl[(c8 + j) * 72 + rr];
                        u32x4 w; w.x = e[0] | ((unsigned)e[1] << 16); w.y = e[2] | ((unsigned)e[3] << 16); w.z = e[4] | ((unsigned)e[5] << 16); w.w = e[6] | ((unsigned)e[7] << 16);
                        *(u32x4*)(YB + (size_t)(r0 + rr) * YW + YC_B + c0 + c8) = w; }
                }
                __syncthreads();
            }
            {
                const int tid = opaque(tid0);
                const bf16_t* LT = (const bf16_t*)(ws + WS_LT); const float* HIN = (const float*)(ws + WS_LHIN);
                const int nrows = nMrow * 256;
                const int nb0 = G > 160 ? 80 : 0, vb = bid - nb0, vG = G - nb0;
                if (vb >= 0) for (int it = vb * 512 + tid; it < nrows * 48; it += vG * 512) {
                    const int r = it / 48, c8 = (it - r * 48) * 8, n = r >> 4;
                    const u32x4 gt = *(const u32x4*)(PR + (size_t)r * LDP + PC_AG + c8);
                    const bf16_t* lt = LT + (size_t)r * 1152 + c8;
                    const u32x4 sv = *(const u32x4*)lt, pf = *(const u32x4*)(lt + 384), pb = *(const u32x4*)(lt + 768);
                    const float* hf = HIN + ((size_t)n * 2 + 0) * 384 + c8; const float* hb = hf + 384;
                    const f32x4 hf0 = *(const f32x4*)hf, hf1 = *(const f32x4*)(hf + 4), hb0 = *(const f32x4*)hb, hb1 = *(const f32x4*)(hb + 4);
                    u32x4 w;
                    w.x = cvt_pk_bf16(gelu_f(bflo(gt.x)) * (bflo(sv.x) + bflo(pf.x) * hf0[0] + bflo(pb.x) * hb0[0]), gelu_f(bfhi(gt.x)) * (bfhi(sv.x) + bfhi(pf.x) * hf0[1] + bfhi(pb.x) * hb0[1]));
                    w.y = cvt_pk_bf16(gelu_f(bflo(gt.y)) * (bflo(sv.y) + bflo(pf.y) * hf0[2] + bflo(pb.y) * hb0[2]), gelu_f(bfhi(gt.y)) * (bfhi(sv.y) + bfhi(pf.y) * hf0[3] + bfhi(pb.y) * hb0[3]));
                    w.z = cvt_pk_bf16(gelu_f(bflo(gt.z)) * (bflo(sv.z) + bflo(pf.z) * hf1[0] + bflo(pb.z) * hb1[0]), gelu_f(bfhi(gt.z)) * (bfhi(sv.z) + bfhi(pf.z) * hf1[1] + bfhi(pb.z) * hb1[1]));
                    w.w = cvt_pk_bf16(gelu_f(bflo(gt.w)) * (bflo(sv.w) + bflo(pf.w) * hf1[2] + bflo(pb.w) * hb1[2]), gelu_f(bfhi(gt.w)) * (bfhi(sv.w) + bfhi(pf.w) * hf1[3] + bfhi(pb.w) * hb1[3]));
                    *(u32x4*)(YB + (size_t)r * YW + YC_A + c8) = w;
                }
                if (vb >= 0) pull_convert(a, JT_BG, lds, MISC, ctl + CW_QUEUE + 64, SLOT_M3);
            }
        }
        SEAM(P0 + 4);
        if (((PHMASK >> 15) & 1) && IN(P0 + 5)) {
            const pg8::TabSched S{PARTS.p + 20 + l * 3, (const char*)ws, 1, nMrow, G, bid};
            pg8::EpiS5Glu E{YB, (const bf16_t*)(ws + WS_GL), a.in[34] + l * 256};
            pg8::gemm_phase<256, 256>(lds, S, E);
            if (bid >= nMrow) pull_convert(a, JT_BG, lds, MISC, ctl + CW_QUEUE + 64, SLOT_GLU);
        }
        SEAM(P0 + 5);
        if (((PHMASK >> 3) & 1) && IN(P0 + 6)) {
            const pg8::MergeSched S{(const char*)ws, (long long)WS_YB, (long long)(WS_WL + (size_t)l * SZ_WL + SZ_WINR + SZ_WINHY), 64, G, bid, l == 0 ? 64 : 0};
            pg8::EpiGate E{ws + WS_GQ, UB, (bf16_t*)(ws + WS_MGC)};
            pg8::gemm_phase<1280, 1280>(lds, S, E);
        }
        SEAM(P0 + 6);
        if (((PHMASK >> 4) & 1) && IN(P0 + 7)) {
            const pg8::TabSched S{l == 0 ? PARTS.p + 24 : PARTS.p + 14, (const char*)ws, l == 0 ? 2 : 1, l == 0 ? 256 + 64 : 256, G, bid};
            pg8::EpiRes E{PRE, xlat, xctx, MODL + 2048, (float*)(ws + WS_EXTRA)};
            pg8::gemm_phase<1024, 1024>(lds, S, E);
        }
        SEAM(P0 + 7);
        if (((PHMASK >> 5) & 1) && IN(P0 + 8)) {
            const int lane = opaque(tid0) & 63;
            if (l == 0) pull_convert(a, JT_BG, lds, MISC, ctl + CW_QUEUE + 64, 1 << 30, BG_LIM_FF);
            if (l == 1) { pull_convert(a, JT_BG, lds, MISC, ctl + CW_QUEUE + 64, 1 << 30); convert_tiles_pipelined(a, JT_MOE, (LAS float*)lds, bid, G); }
            const float* lg = a.in[40] + l * D; const float* lb = a.in[41] + l * D;
            const int nrows = nMrow * 256;
            for (int r = bid * 8 + wave; r < nrows; r += G * 8) {
                const float* mv = MODL + (size_t)(r < RL ? (r >> 12) : 4) * 6144;
                RowV pre;
                if (r < RL) { const RowV xin = row_load(xlat + (size_t)r * D, lane), ga = row_load_bf16((const bf16_t*)PRE + (size_t)r * D, lane);
#pragma unroll
                    for (int i = 0; i < 4; ++i) pre.v[i] = xin.v[i] * ALPHA + ga.v[i]; }
                else { const float* pp = (const float*)(ws + WS_EXTRA) + (size_t)(r - RL) * D; const RowV xin = row_load(ctx_in + (size_t)(r - RL) * D, lane), p0 = row_load(pp, lane), p1 = row_load(pp + (size_t)RC * D, lane), p2 = row_load(pp + (size_t)2 * RC * D, lane), p3 = row_load(pp + (size_t)3 * RC * D, lane);
#pragma unroll
                    for (int i = 0; i < 4; ++i) pre.v[i] = xin.v[i] * ALPHA + ((p0.v[i] + p1.v[i]) + (p2.v[i] + p3.v[i])); }
                const RowV x1 = row_affine(row_norm(pre), lg, lb, lane);
                row_store(r < RL ? a.out + (size_t)r * D : XSC + (size_t)(r - RL) * D, lane, x1);
                const RowV u2 = row_modulate(row_norm(x1), mv + 3072, mv + 4096, lane);
                row_store_bf16(UB + (size_t)r * D, lane, u2);
                if (l == 1) {
                    float lg8[8];
#pragma unroll
                    for (int e = 0; e < 8; ++e) lg8[e] = 0.f;
                    f32x4 rw[32];
#pragma unroll
                    for (int q = 0; q < 16; ++q) { const float* wp = a.in[47] + (size_t)(256 * (q >> 2) + 4 * lane + (q & 3)) * 8; rw[2 * q] = *(const f32x4*)wp; rw[2 * q + 1] = *(const f32x4*)(wp + 4); }
                    PIN16(rw); PIN16(rw + 16);
#pragma unroll
                    for (int i = 0; i < 4; ++i)
#pragma unroll
                        for (int j = 0; j < 4; ++j) { const float uv = u2.v[i][j];
                            const f32x4 w0 = rw[2 * (4 * i + j)], w1 = rw[2 * (4 * i + j) + 1];
                            lg8[0] += uv * w0[0]; lg8[1] += uv * w0[1]; lg8[2] += uv * w0[2]; lg8[3] += uv * w0[3]; lg8[4] += uv * w1[0]; lg8[5] += uv * w1[1]; lg8[6] += uv * w1[2]; lg8[7] += uv * w1[3]; }
#pragma unroll
                    for (int e = 0; e < 8; ++e) lg8[e] = wave_sum(lg8[e]);
                    if (lane == 0) {
                        int i1 = 0; float v1 = lg8[0];
#pragma unroll
                        for (int e = 1; e < 8; ++e) if (lg8[e] > v1) { v1 = lg8[e]; i1 = e; }
                        int i2 = 0; float v2 = -3.0e38f;
#pragma unroll
                        for (int e = 0; e < 8; ++e) if (e != i1 && lg8[e] > v2) { v2 = lg8[e]; i2 = e; }
                        const float e2 = expf(v2 - v1), w1 = 1.f / (1.f + e2), w2 = e2 / (1.f + e2);
                        int* tk = (int*)(ws + WS_TOK) + (size_t)r * 8;
                        tk[0] = i1; tk[1] = i2; ((float*)tk)[2] = w1; ((float*)tk)[3] = w2;
                        tk[4] = (int)atomicAdd(ctl + CW_MOECNT + 64 * i1, 1u); tk[5] = (int)atomicAdd(ctl + CW_MOECNT + 64 * i2, 1u);
                    }
                }
            }
        }
        SEAM(P0 + 8);
        if (l == 0) {
            if (((PHMASK >> 6) & 1) && IN(P0 + 9)) {
                const pg8::TabSched S{PARTS.p + 16, (const char*)ws, 1, 68 * 22, G, bid};
                pg8::EpiSwiglu E{(bf16_t*)(ws + WS_H), FF_DENSE, 0, true};
                pg8::gemm_phase<1024, 1024>(lds, S, E);
            }
            SEAM(P0 + 9);
            if (((PHMASK >> 7) & 1) && IN(P0 + 10)) {
                const pg8::TabSched S{PARTS.p + 26, (const char*)ws, 3, 256 + 48 + 16, G, bid};
                pg8::EpiRes E{PRE, a.out, XSC, MODL + 5120, (float*)(ws + WS_EXTRA)};
                pg8::gemm_phase<64, 64, 32768>(lds, S, E);
            }
            SEAM(P0 + 10);
            if (((PHMASK >> 8) & 1) && IN(P0 + 11)) {
                const int lane = opaque(tid0) & 63;
                pull_convert(a, JT_BG, lds, MISC, ctl + CW_QUEUE + 64, 1 << 30, BG_LIM_S1);
                const float* lg = a.in[42]; const float* lb = a.in[43];
                const float* MODN = MOD + (size_t)5 * 6144;
                for (int r = bid * 8 + wave; r < RT; r += G * 8) {
                    const float* mv = MODN + (size_t)(r < RL ? (r >> 12) : 4) * 6144;
                    RowV pre;
                    if (r < RL) { const RowV xin = row_load(a.out + (size_t)r * D, lane), ga = row_load_bf16((const bf16_t*)PRE + (size_t)r * D, lane);
#pragma unroll
                        for (int i = 0; i < 4; ++i) pre.v[i] = xin.v[i] * ALPHA + ga.v[i]; }
                    else { const float* pp = (const float*)(ws + WS_EXTRA) + (size_t)(r - RL) * D; const RowV xin = row_load(XSC + (size_t)(r - RL) * D, lane), p0 = row_load(pp, lane), p1 = row_load(pp + (size_t)RC * D, lane), p2 = row_load(pp + (size_t)2 * RC * D, lane), p3 = row_load(pp + (size_t)3 * RC * D, lane);
#pragma unroll
                        for (int i = 0; i < 4; ++i) pre.v[i] = xin.v[i] * ALPHA + ((p0.v[i] + p1.v[i]) + (p2.v[i] + p3.v[i])); }
                    const RowV x2 = row_affine(row_norm(pre), lg, lb, lane);
                    row_store(r < RL ? a.out + (size_t)r * D : XSC + (size_t)(r - RL) * D, lane, x2);
                    row_store_bf16(UB + (size_t)r * D, lane, row_modulate(row_norm(x2), mv, mv + 1024, lane));
                }
            }
            SEAM(P0 + 11);
        } else {
            bf16_t* AG = (bf16_t*)(ws + WS_AG); float* slotw = (float*)(ws + WS_SLOTW); int* tile_e = (int*)(ws + WS_TILEE);
            if (((PHMASK >> 9) & 1) && IN(P0 + 9)) {
                const int tid = opaque(tid0), lane = tid & 63;
                int ts[NE + 1]; ts[0] = 0;
#pragma unroll
                for (int e = 0; e < NE; ++e) { const unsigned c = __hip_atomic_load(ctl + CW_MOECNT + 64 * e, __ATOMIC_RELAXED, __HIP_MEMORY_SCOPE_AGENT); ts[e + 1] = ts[e] + (int)((c + 255u) >> 8); }
                if (bid == 0) for (int mt = tid; mt < ts[NE]; mt += 512) { int e = 0;
#pragma unroll
                    for (int k = 1; k < NE; ++k) e += (mt >= ts[k]) ? 1 : 0;
                    tile_e[mt] = e; }
                for (int r = bid * 8 + wave; r < RL; r += G * 8) {
                    int* tk = (int*)(ws + WS_TOK) + (size_t)r * 8;
                    const u32x4 v0 = *(const u32x4*)(UB + (size_t)r * D + lane * 16), v1 = *(const u32x4*)(UB + (size_t)r * D + lane * 16 + 8);
#pragma unroll
                    for (int k = 0; k < 2; ++k) {
                        const int e = tk[k], pos = tk[4 + k];
                        int st = 0;
#pragma unroll
                        for (int q = 0; q < NE; ++q) st = (e == q) ? ts[q] : st;
                        const int srow = st * 256 + pos;
                        *(u32x4*)(AG + (size_t)srow * D + lane * 16) = v0; *(u32x4*)(AG + (size_t)srow * D + lane * 16 + 8) = v1;
                        if (lane == 0) { slotw[srow] = ((const float*)tk)[2 + k]; tk[6 + k] = srow; }
                    }
                }
            }
            SEAM(P0 + 9);
            int ttl = 0;
            LAS int* te_lds = (LAS int*)(lds + 131072);
            if (lo <= P0 + 13 && P0 + 10 < hi) {
                int ts[NE + 1]; ts[0] = 0;
#pragma unroll
                for (int e = 0; e < NE; ++e) { const unsigned c = __hip_atomic_load(ctl + CW_MOECNT + 64 * e, __ATOMIC_RELAXED, __HIP_MEMORY_SCOPE_AGENT); ts[e + 1] = ts[e] + (int)((c + 255u) >> 8); }
                ttl = __builtin_amdgcn_readfirstlane(ts[NE]);
                if (tid0 < 160) { int e = 0;
#pragma unroll
                    for (int k = 1; k < NE; ++k) e += (tid0 >= ts[k]) ? 1 : 0;
                    te_lds[tid0] = e; }
                __syncthreads();
            }
#pragma unroll
            for (int pass = 0; pass < 2; ++pass) {
                const int tile0 = pass * MOE_P0; int ntile = pass == 0 ? (ttl < MOE_P0 ? ttl : MOE_P0) : ttl - MOE_P0; ntile = ntile < 0 ? 0 : (ntile > MOE_HCAP ? MOE_HCAP : ntile);
                if (((PHMASK >> 10) & 1) && IN(P0 + 10 + 2 * pass)) {
                    const pg8::MoeSched S{(const char*)AG + (size_t)tile0 * 256 * 1024 * 2, (const char*)(ws + WS_MOEGU), te_lds, 256u * 1024u * 2u, 256u * 1024u * 2u, (size_t)2 * FF_E * 1024 * 2, 28, 16, tile0, ntile, G, bid};
                    pg8::EpiSwiglu E{(bf16_t*)(ws + WS_HM), FF_E, tile0, true};
                    pg8::gemm_phase<1024, 1024>(lds, S, E);
                }
                SEAM(P0 + 10 + 2 * pass);
                if (((PHMASK >> 11) & 1) && IN(P0 + 11 + 2 * pass)) {
                    pg8::EpiMoeDown E{AG, slotw, (float*)(ws + WS_O2X)};
                    { const int nfull = pass == 0 ? ntile : (ttl < 128 ? ttl : 128) - MOE_P0, nex = pass == 0 ? 0 : ttl - 128;
                        const pg8::MoeTailSched S{(const char*)(ws + WS_HM), (const char*)(ws + WS_MOED), te_lds, tile0, nfull < 0 ? 0 : nfull, nex < 0 ? 0 : nex, G, bid};
                        pg8::gemm_phase<64, 64, 32768>(lds, S, E); }
                }
                SEAM(P0 + 11 + 2 * pass);
            }
            if (((PHMASK >> 12) & 1) && IN(P0 + 14)) {
                const int lane = opaque(tid0) & 63;
                const float* lg = a.in[42] + D; const float* lb = a.in[43] + D;
                for (int r = bid * 8 + wave; r < RL; r += G * 8) {
                    const int* tk = (const int*)(ws + WS_TOK) + (size_t)r * 8;
                    const int sa = tk[6], sb = tk[7];
                    const bf16_t* oa = AG + (size_t)sa * D; const bf16_t* ob = AG + (size_t)sb * D;
                    const float* gv = MODL + (size_t)(r >> 12) * 6144 + 5120;
                    RowV x1 = row_load(a.out + (size_t)r * D, lane), gq = row_load(gv, lane), pre;
                    u32x2 va[4], vb[4];
#pragma unroll
                    for (int i = 0; i < 4; ++i) { va[i] = *(const u32x2*)(oa + 256 * i + 4 * lane); vb[i] = *(const u32x2*)(ob + 256 * i + 4 * lane); }
                    asm volatile("" : "+v"(va[0]), "+v"(va[1]), "+v"(va[2]), "+v"(va[3]), "+v"(vb[0]), "+v"(vb[1]), "+v"(vb[2]), "+v"(vb[3]), "+v"(x1.v[0]), "+v"(x1.v[1]), "+v"(x1.v[2]), "+v"(x1.v[3]), "+v"(gq.v[0]), "+v"(gq.v[1]), "+v"(gq.v[2]), "+v"(gq.v[3]));
#pragma unroll
                    for (int i = 0; i < 4; ++i) {
                        f32x4 fa = {bflo(va[i].x), bfhi(va[i].x), bflo(va[i].y), bfhi(va[i].y)}, fb = {bflo(vb[i].x), bfhi(vb[i].x), bflo(vb[i].y), bfhi(vb[i].y)};
                        if (sa >= 128 * 256) { const float* px = (const float*)(ws + WS_O2X) + (size_t)(sa - 128 * 256) * D + 256 * i + 4 * lane; fa = (*(const f32x4*)px + *(const f32x4*)(px + (size_t)2048 * D)) + (*(const f32x4*)(px + (size_t)2 * 2048 * D) + *(const f32x4*)(px + (size_t)3 * 2048 * D)); }
                        if (sb >= 128 * 256) { const float* px = (const float*)(ws + WS_O2X) + (size_t)(sb - 128 * 256) * D + 256 * i + 4 * lane; fb = (*(const f32x4*)px + *(const f32x4*)(px + (size_t)2048 * D)) + (*(const f32x4*)(px + (size_t)2 * 2048 * D) + *(const f32x4*)(px + (size_t)3 * 2048 * D)); }
                        pre.v[i] = x1.v[i] * ALPHA + gq.v[i] * (fa + fb); }
                    row_store(a.out + (size_t)r * D, lane, row_affine(row_norm(pre), lg, lb, lane));
                }
            }
        }
    }
#undef IN
#undef SEAM
}

}

extern "C" void kernel_launch(void* const* d_in, const int* in_sizes, int n_in, void* d_out, int out_size, void* d_ws, size_t ws_size, hipStream_t stream) {
    static int grid = 0;
    if (grid == 0) {
        if (n_in != 51 || ws_size < WS_END) { grid = -1; return; }
        int dev = 0, cus = 0;
        if (hipGetDevice(&dev) != hipSuccess || hipDeviceGetAttribute(&cus, hipDeviceAttributeMultiprocessorCount, dev) != hipSuccess) { grid = -1; return; }
        if (hipFuncSetAttribute((const void*)mk_fwd, hipFuncAttributeMaxDynamicSharedMemorySize, LDS_BYTES) != hipSuccess) { grid = -1; return; }
        grid = cus;
    }
    if (grid < 0) return;
    const float* const* in = (const float* const*)d_in;
    unsigned char* ws = (unsigned char*)d_ws;
    (void)hipMemsetAsync(ws + WS_CTL, 0, CTL_BYTES, stream);
    Args a{};
    for (int i = 0; i < 51; ++i) a.in[i] = in[i];
    a.out = (float*)d_out; a.ws = ws;
    int nlaunch = 0;
    auto run1 = [&](int lo, int hi) { a.ph_lo = lo; a.ph_hi = hi; a.bar_region = nlaunch < 5 ? nlaunch : 5; nlaunch++; hipLaunchKernelGGL(mk_fwd, dim3(grid), dim3(512), LDS_BYTES, stream, a); };
    auto run = [&](int lo, int hi) {
#if defined(SPLIT) && SPLIT
        for (int k = lo; k < hi; ++k) { const int q = (k - 1) % NPH_LAYER, l = (k - 1) / NPH_LAYER; if (k > 0 && (q > 14 || (l == 0 && q > 11) || (l == 1 && q == 0))) continue; run1(k, k + 1); }
#else
        run1(lo, hi);
#endif
    };
    run(0, 1 + 2 * NPH_LAYER);
}
```
